# Optimizing an MI355X kernel written in HIP

```python
import math
import jax, jax.numpy as jnp
from jax import lax
import numpy as np

D_MODEL = 1024
BATCH = 4
SEQ = 4096
DEPTH = 1

ROPE_THETA = 500000.0
NORM_EPS = 1e-6
Q_BLOCK = 128
DA_HEADS = 8
DA_HEAD_DIM = 64
DA_ROT = DA_HEAD_DIM // 4
DA_QK_W = DA_HEADS * 2 * DA_HEAD_DIM
DA_V_W = DA_HEADS * 2 * DA_HEAD_DIM
MLA_HEADS = 8
MLA_Q_LORA = 768
MLA_KV_LORA = 512
MLA_NOPE = 128
MLA_ROPE = 64
MLA_V = 128
N_EXPERTS = 32
TOP_K = 4
D_FF_EXPERT = 1024
SWIGLU_ALPHA = 1.702
SWIGLU_LIMIT = 7.0
EXPERT_BLOCK = 128
IN_SPLITS = (DA_QK_W, DA_QK_W, DA_V_W, MLA_Q_LORA, MLA_KV_LORA, MLA_ROPE, 2 * D_MODEL)
IN_WIDTH = sum(IN_SPLITS)
IN_OFFSETS = [int(o) for o in np.cumsum(IN_SPLITS)[:-1]]

kernel_name = "hybrid_diffattn_mla_gated_moe_encoder"


def rms_norm(x, g):
    xf = x.astype(jnp.float32)
    y = xf * lax.rsqrt(jnp.mean(xf * xf, axis=-1, keepdims=True) + NORM_EPS)
    return (y * g.astype(jnp.float32)).astype(x.dtype)


def apply_rope(x, positions, rot_dim):
    half = rot_dim // 2
    inv = ROPE_THETA ** (-jnp.arange(0, rot_dim, 2, dtype=jnp.float32) / rot_dim)
    ang = positions.astype(jnp.float32)[..., None] * inv
    shape = ang.shape[:2] + (1,) * (x.ndim - 3) + (half,)
    c = jnp.cos(ang).reshape(shape).astype(x.dtype)
    s = jnp.sin(ang).reshape(shape).astype(x.dtype)
    x1 = x[..., :half]
    x2 = x[..., half:rot_dim]
    return jnp.concatenate([x1 * c - x2 * s, x2 * c + x1 * s, x[..., rot_dim:]], axis=-1)


def _to_blocks(t):
    b, s = t.shape[:2]
    t = t.reshape((b, s // Q_BLOCK, Q_BLOCK) + t.shape[2:])
    return jnp.moveaxis(t, 1, 0)


def _from_blocks(t):
    t = jnp.moveaxis(t, 0, 1)
    return t.reshape((t.shape[0], t.shape[1] * t.shape[2]) + t.shape[3:])


def diff_attention(q, k, v, lam, lam_init, g_subln):
    scale = DA_HEAD_DIM ** -0.5

    def one_block(qb):
        s = jnp.einsum('bqhmd,bkhmd->bhmqk', qb, k).astype(jnp.float32) * scale
        p = jax.nn.softmax(s, axis=-1)
        a = (p[:, :, 0] - lam * p[:, :, 1]).astype(v.dtype)
        return jnp.einsum('bhqk,bkhe->bqhe', a, v)

    o = _from_blocks(lax.map(one_block, _to_blocks(q)))
    o = rms_norm(o, g_subln) * (1.0 - lam_init)
    return o.reshape(o.shape[:2] + (-1,))


def mla_attention(c_q, c_kv, k_rope, positions, g_q, g_kv, w_uq, w_ukv):
    b, s = c_q.shape[:2]
    q = (rms_norm(c_q, g_q) @ w_uq).reshape(b, s, MLA_HEADS, MLA_NOPE + MLA_ROPE)
    q_nope = q[..., :MLA_NOPE]
    q_rope = apply_rope(q[..., MLA_NOPE:], positions, MLA_ROPE)
    kv = (rms_norm(c_kv, g_kv) @ w_ukv).reshape(b, s, MLA_HEADS, MLA_NOPE + MLA_V)
    k_nope = kv[..., :MLA_NOPE]
    v = kv[..., MLA_NOPE:]
    k_r = apply_rope(k_rope, positions, MLA_ROPE)
    scale = (MLA_NOPE + MLA_ROPE) ** -0.5

    def one_block(qs):
        qn, qr = qs
        sc = (jnp.einsum('bqhd,bkhd->bhqk', qn, k_nope)
              + jnp.einsum('bqhr,bkr->bhqk', qr, k_r))
        p = jax.nn.softmax(sc.astype(jnp.float32) * scale, axis=-1).astype(v.dtype)
        return jnp.einsum('bhqk,bkhe->bqhe', p, v)

    o = _from_blocks(lax.map(one_block, (_to_blocks(q_nope), _to_blocks(q_rope))))
    return o.reshape(b, s, MLA_HEADS * MLA_V)


def moe_ffn(h, w_router, b_router, w_gate, b_gate, w_up, b_up, w_down, b_down):
    b, s, d = h.shape
    t = b * s
    hf = h.reshape(t, d)
    logits = (hf @ w_router + b_router).astype(jnp.float32)
    top_val, top_idx = lax.top_k(logits, TOP_K)
    top_w = jax.nn.softmax(top_val, axis=-1).astype(h.dtype)
    n_assign = t * TOP_K
    e_flat = top_idx.reshape(-1).astype(jnp.int32)
    w_flat = top_w.reshape(-1)
    tok_flat = jnp.arange(n_assign, dtype=jnp.int32) // TOP_K
    order = jnp.argsort(e_flat)
    e_sorted = e_flat[order]
    counts = jnp.bincount(e_flat, length=N_EXPERTS).astype(jnp.int32)
    padded = (counts + EXPERT_BLOCK - 1) // EXPERT_BLOCK * EXPERT_BLOCK
    padded_end = jnp.cumsum(padded)
    padded_start = padded_end - padded
    start = jnp.cumsum(counts) - counts
    dest = padded_start[e_sorted] + jnp.arange(n_assign, dtype=jnp.int32) - start[e_sorted]
    n_blocks = -(-n_assign // EXPERT_BLOCK) + N_EXPERTS
    n_rows = n_blocks * EXPERT_BLOCK
    row_tok = jnp.zeros((n_rows,), jnp.int32).at[dest].set(tok_flat[order])
    row_w = jnp.zeros((n_rows,), h.dtype).at[dest].set(w_flat[order])
    block_e = jnp.minimum(
        jnp.searchsorted(padded_end, jnp.arange(n_blocks, dtype=jnp.int32) * EXPERT_BLOCK,
                         side='right'), N_EXPERTS - 1)
    xs = hf[row_tok].reshape(n_blocks, EXPERT_BLOCK, d)

    def expert_block(args):
        xb, e = args
        gate = jnp.minimum(xb @ w_gate[e] + b_gate[e], SWIGLU_LIMIT)
        up = jnp.clip(xb @ w_up[e] + b_up[e], -SWIGLU_LIMIT, SWIGLU_LIMIT)
        act = (up + 1.0) * (gate * jax.nn.sigmoid(SWIGLU_ALPHA * gate))
        return act @ w_down[e] + b_down[e]

    ys = lax.map(expert_block, (xs, block_e)).reshape(n_rows, d)
    out = jax.ops.segment_sum(ys * row_w[:, None], row_tok, num_segments=t)
    return out.reshape(b, s, d)


def setup_inputs(seed: int = 0) -> dict:
    key = jax.random.key(seed)
    ks = iter(jax.random.split(key, 40))
    L = DEPTH

    def nrm(shape, scale):
        return jax.random.normal(next(ks), shape, jnp.float32) * scale

    def gain(shape):
        return 1.0 + nrm(shape, 0.02)

    x = jax.random.normal(next(ks), (BATCH, SEQ, D_MODEL), jnp.float32)
    offs = jax.random.randint(next(ks), (BATCH, 1), 0, SEQ, dtype=jnp.int32)
    positions = jnp.arange(SEQ, dtype=jnp.int32)[None, :] + offs
    E, F, D = N_EXPERTS, D_FF_EXPERT, D_MODEL
    return {
        "x": x,
        "positions": positions,
        "g_mix": gain((L, D)),
        "w_in": nrm((L, D, IN_WIDTH), D ** -0.5),
        "lam_q1": nrm((L, DA_HEAD_DIM), 0.1),
        "lam_k1": nrm((L, DA_HEAD_DIM), 0.1),
        "lam_q2": nrm((L, DA_HEAD_DIM), 0.1),
        "lam_k2": nrm((L, DA_HEAD_DIM), 0.1),
        "g_subln": gain((L, 2 * DA_HEAD_DIM)),
        "g_q": gain((L, MLA_Q_LORA)),
        "g_kv": gain((L, MLA_KV_LORA)),
        "w_uq": nrm((L, MLA_Q_LORA, MLA_HEADS * (MLA_NOPE + MLA_ROPE)), MLA_Q_LORA ** -0.5),
        "w_ukv": nrm((L, MLA_KV_LORA, MLA_HEADS * (MLA_NOPE + MLA_V)), MLA_KV_LORA ** -0.5),
        "w_o_diff": nrm((L, DA_V_W, D), DA_V_W ** -0.5),
        "w_o_mla": nrm((L, MLA_HEADS * MLA_V, D), (MLA_HEADS * MLA_V) ** -0.5),
        "b_gates": nrm((L, 2 * D), 0.1),
        "w_out": nrm((L, D, D), D ** -0.5),
        "g_ffn": gain((L, D)),
        "w_router": nrm((L, D, E), D ** -0.5),
        "b_router": nrm((L, E), 0.01),
        "w_gate": nrm((L, E, D, F), D ** -0.5),
        "b_gate": nrm((L, E, F), 0.02),
        "w_up": nrm((L, E, D, F), D ** -0.5),
        "b_up": nrm((L, E, F), 0.02),
        "w_down": nrm((L, E, F, D), F ** -0.5),
        "b_down": nrm((L, E, D), 0.02),
        "g_final": gain((D,)),
    }


def reference(x, positions, g_mix, w_in, lam_q1, lam_k1, lam_q2, lam_k2, g_subln, g_q, g_kv,
              w_uq, w_ukv, w_o_diff, w_o_mla, b_gates, w_out, g_ffn, w_router, b_router,
              w_gate, b_gate, w_up, b_up, w_down, b_down, g_final):
    b, s, d = x.shape
    for l in range(DEPTH):
        h = rms_norm(x, g_mix[l])
        z = h @ w_in[l]
        z_qa, z_ka, z_va, z_cq, z_ckv, z_kr, z_g = jnp.split(z, IN_OFFSETS, axis=-1)

        q_a = apply_rope(z_qa.reshape(b, s, DA_HEADS, 2, DA_HEAD_DIM), positions, DA_ROT)
        k_a = apply_rope(z_ka.reshape(b, s, DA_HEADS, 2, DA_HEAD_DIM), positions, DA_ROT)
        v_a = z_va.reshape(b, s, DA_HEADS, 2 * DA_HEAD_DIM)
        lam_init = 0.8 - 0.6 * math.exp(-0.3 * l)
        lam = (jnp.exp(jnp.sum(lam_q1[l].astype(jnp.float32) * lam_k1[l].astype(jnp.float32)))
               - jnp.exp(jnp.sum(lam_q2[l].astype(jnp.float32) * lam_k2[l].astype(jnp.float32)))
               + lam_init)
        o_a = diff_attention(q_a, k_a, v_a, lam, lam_init, g_subln[l])

        o_b = mla_attention(z_cq, z_ckv, z_kr, positions, g_q[l], g_kv[l], w_uq[l], w_ukv[l])

        gates = jax.nn.sigmoid(z_g + b_gates[l]).reshape(b, s, 2, d)
        merged = gates[:, :, 0] * (o_a @ w_o_diff[l]) + gates[:, :, 1] * (o_b @ w_o_mla[l])
        x = x + merged @ w_out[l]

        x = x + moe_ffn(rms_norm(x, g_ffn[l]), w_router[l], b_router[l], w_gate[l], b_gate[l],
                        w_up[l], b_up[l], w_down[l], b_down[l])
    return rms_norm(x, g_final)
```

```cpp
#include <hip/hip_runtime.h>
#include <cstdio>
#include <cstdint>

#ifndef MK_PER_PHASE
#define MK_PER_PHASE 0
#endif

#ifndef DBG_OUT
#define DBG_OUT 0
#endif
#ifndef DBG_SKIP
#define DBG_SKIP 0
#endif
#ifndef ATT_MASK
#define ATT_MASK 3
#endif
#ifndef PH_MASK
#define PH_MASK 0x3ff
#endif
#define LAS __attribute__((address_space(3)))
#define GAS __attribute__((address_space(1)))
typedef unsigned short bf16_t;
typedef short bf16x8 __attribute__((ext_vector_type(8)));
typedef short s16x4 __attribute__((ext_vector_type(4)));
typedef float f32x2 __attribute__((ext_vector_type(2)));
typedef float f32x4 __attribute__((ext_vector_type(4)));
typedef float f32x16 __attribute__((ext_vector_type(16)));
typedef unsigned u32x2 __attribute__((ext_vector_type(2)));
typedef unsigned u32x4 __attribute__((ext_vector_type(4)));

constexpr int NB = 4, SEQ = 4096, T = NB * SEQ, D = 1024;
constexpr int NEXP = 32, TOPK = 4, FF = 1024;
constexpr int N_IN = 6656;
constexpr int QL = 768, KVL = 512;
constexpr float EPS = 1e-6f;
constexpr float LAM_INIT = 0.2f;
constexpr int NPHASE = 10;

constexpr size_t MiB = 1u << 20;
constexpr size_t WS_CTL = 0, CTL_ZERO_BYTES = 1 * MiB;
constexpr size_t WS_BT_IN = 2 * MiB;
constexpr size_t WS_BT_UQ = 15 * MiB;
constexpr size_t WS_BT_UKV = 18 * MiB;
constexpr size_t WS_BT_OD = 20 * MiB, WS_BT_OM = 22 * MiB, WS_BT_OUT = 24 * MiB;
constexpr size_t WS_ROPEA = 26 * MiB;
constexpr size_t WS_ROPEM = 27 * MiB;
constexpr size_t WS_SQ = 31 * MiB;
constexpr size_t WS_SQP = 1 * MiB;
constexpr size_t WS_H = 32 * MiB;
constexpr size_t WS_QA = 64 * MiB, WS_KA = 96 * MiB, WS_VA = 128 * MiB;
constexpr size_t WS_CQ = 160 * MiB, WS_CKV = 184 * MiB, WS_KR = 200 * MiB;
constexpr size_t WS_SQ2 = 202 * MiB;
constexpr size_t WS_GATES = 208 * MiB;
constexpr size_t WS_QM = 272 * MiB;
constexpr size_t WS_KV = 320 * MiB;
constexpr size_t WS_OB = 384 * MiB;
constexpr size_t WS_MRG = 416 * MiB;
constexpr size_t WS_STASH = 448 * MiB;
constexpr size_t WS_ROWTOK = 2 * MiB;
constexpr size_t WS_ASSIGN = 4 * MiB;
constexpr size_t WS_BT_D = 32 * MiB;
constexpr size_t WS_BT_GU = 96 * MiB;
constexpr size_t WS_H2 = 224 * MiB;
constexpr size_t WS_ACT = 256 * MiB;
constexpr size_t WS_Y = 96 * MiB;
constexpr size_t WS_END = 512 * MiB;
constexpr int CW_COUNT = 64;
constexpr int CW_BAR = 4096;

constexpr int RING_BYTES = 131072;
constexpr int TAB_OFF = RING_BYTES;
constexpr int TAB_BYTES = 8192;
constexpr int MISC_OFF = TAB_OFF + TAB_BYTES;
constexpr int LDS_BYTES = 147456;

typedef __bf16 bf16x2_t __attribute__((ext_vector_type(2)));
__device__ __forceinline__ unsigned cvt_pk_bf16(float lo, float hi) { const f32x2 v = {lo, hi}; return __builtin_bit_cast(unsigned, __builtin_convertvector(v, bf16x2_t)); }
__device__ __forceinline__ float bf_lo(unsigned w) { return __uint_as_float(w << 16); }
__device__ __forceinline__ float bf_hi(unsigned w) { return __uint_as_float(w & 0xffff0000u); }
__device__ __forceinline__ float wave_sum(float v) {
#pragma unroll
    for (int o = 1; o < 64; o <<= 1) v += __shfl_xor(v, o);
    return v;
}
__device__ __forceinline__ float sigmoidf_(float x) { return __builtin_amdgcn_rcpf(1.0f + __builtin_amdgcn_exp2f(-1.4426950408889634f * x)); }
#define LDS_WAIT() asm volatile("s_waitcnt lgkmcnt(0)" ::: "memory")
#define VM_WAIT() asm volatile("s_waitcnt vmcnt(0)" ::: "memory")

#define XB_TMO      128
#define XB_XCNT(j)  (256  + 64 * (j))
#define XB_XSUB(j)  (1280 + 64 * (j))
#define XB_XGEN(j)  (2304 + 64 * (j))
#define XB_TOP      3328
#define XB_TOPGEN   3392
#define XCD_BAR_WORDS 3456
#define XB_SPIN_CAP (1u << 20)
__device__ __forceinline__ unsigned xb_ld(unsigned* p)              { return __hip_atomic_load(p, __ATOMIC_RELAXED, __HIP_MEMORY_SCOPE_AGENT); }
__device__ __forceinline__ unsigned xb_add(unsigned* p, unsigned v) { return __hip_atomic_fetch_add(p, v, __ATOMIC_RELAXED, __HIP_MEMORY_SCOPE_AGENT); }
__device__ __forceinline__ unsigned xb_xcc_id() { return (unsigned)__builtin_amdgcn_s_getreg((3 << 11) | 20) & 0xFu; }
#define XB_SPIN(cond, bar) do { unsigned _sp = 0; while (cond) { __builtin_amdgcn_s_sleep(1); \
    if ((++_sp & 255u) == 0u) { if (xb_ld(&(bar)[XB_TMO])) break; if (_sp > XB_SPIN_CAP) { atomicAdd(&(bar)[XB_TMO], 1u); break; } } } } while (0)
struct XcdBarrier { unsigned* bar; unsigned x; volatile LAS unsigned* st; };
__device__ __forceinline__ XcdBarrier xcd_barrier_post(unsigned* bar, volatile LAS unsigned* st) {
    XcdBarrier b; b.bar = bar; b.x = xb_xcc_id(); b.st = st;
    if (threadIdx.x == 0) (void)xb_add(&bar[XB_XCNT(b.x)], 1u);
    return b;
}
__device__ __forceinline__ void xcd_barrier_complete(unsigned* bar, unsigned x, unsigned& nloc, unsigned& nx) {
    const unsigned G = gridDim.x * gridDim.y * gridDim.z;
    unsigned sum, cnt, mine, sp = 0u;
    for (;;) {
        sum = 0u; cnt = 0u; mine = 0u;
#pragma unroll
        for (unsigned j = 0; j < 16; ++j) { const unsigned c = xb_ld(&bar[XB_XCNT(j)]); sum += c; cnt += (c > 0u) ? 1u : 0u; mine = (j == x) ? c : mine; }
        if (sum == G) break;
        __builtin_amdgcn_s_sleep(1);
        if ((++sp & 255u) == 0u) { if (xb_ld(&bar[XB_TMO])) break; if (sp > XB_SPIN_CAP) { atomicAdd(&bar[XB_TMO], 1u); break; } }
    }
    nloc = mine > 0u ? mine : 1u; nx = cnt > 0u ? cnt : 1u;
}
__device__ __forceinline__ void xcd_barrier(const XcdBarrier& b) {
    asm volatile("s_waitcnt vmcnt(0)" ::: "memory");
    __syncthreads();
    if (threadIdx.x == 0) {
        unsigned* bar = b.bar;
        __builtin_amdgcn_s_waitcnt(0);
        unsigned nloc = b.st[0], nx = b.st[1];
        if (nloc == 0u) { xcd_barrier_complete(bar, b.x, nloc, nx); b.st[0] = nloc; b.st[1] = nx; }
        const unsigned old = xb_add(&bar[XB_XSUB(b.x)], 1u);
        const unsigned gen = old / nloc;
        if (old + 1u == (gen + 1u) * nloc) {
            __builtin_amdgcn_fence(__ATOMIC_RELEASE, "agent");
            asm volatile("s_waitcnt vmcnt(0)" ::: "memory");
            const unsigned og = xb_add(&bar[XB_TOP], 1u);
            const unsigned tg = og / nx;
            if (og + 1u == (tg + 1u) * nx) xb_add(&bar[XB_TOPGEN], 1u);
            else XB_SPIN(xb_ld(&bar[XB_TOPGEN]) == tg, bar);
            __builtin_amdgcn_fence(__ATOMIC_ACQUIRE, "agent");
            xb_add(&bar[XB_XGEN(b.x)], 1u);
            asm volatile("s_waitcnt vmcnt(0)" ::: "memory");
        } else {
            XB_SPIN(xb_ld(&bar[XB_XGEN(b.x)]) == gen, bar);
            __builtin_amdgcn_fence(__ATOMIC_ACQUIRE, "agent");
            asm volatile("s_waitcnt vmcnt(0)" ::: "memory");
        }
    }
    __syncthreads();
}

namespace pg8 {
constexpr int BM = 256, BK = 64, HALF = 128, HTB = HALF * BK * 2, STAGE_BYTES = 8 * HTB, NXCD = 8, WGM = 8;
__host__ __device__ __forceinline__ int lds_byte(int r, int c) { const int st = (r >> 4) * 2 + (c >> 5), rr = r & 15, cc = c & 31, ob = rr * 64 + cc * 2; return st * 1024 + (ob ^ (((ob >> 9) & 1) << 5)); }
__host__ __device__ __forceinline__ void stage_rc(int b, int& R, int& C) { const int st = b / 1024, sb = b % 1024, swz = sb ^ (((sb >> 9) & 1) << 5); R = (st >> 1) * 16 + swz / 64; C = (st & 1) * 32 + (swz % 64) / 2; }
__host__ __device__ __forceinline__ int perm32(int rho) { const int n = rho >> 4, i = rho & 15; return 8 * (i >> 2) + 4 * n + (i & 3); }

struct Unit { int pm, pn, pb, e, rbase, cnt; };
struct Gemm { const bf16_t* A; const bf16_t* Bt; int K; };

struct DenseOrder {
    int nM, nN, nwg, G, c;
    __device__ void init(int nM_, int nN_, int G_, int c_) { nM = nM_; nN = nN_; nwg = nM * nN; G = G_; c = c_; }
    __device__ __forceinline__ bool next(int i, Unit& u) const {
        const long L = (long)i * G + c; if (L >= nwg) return false;
        int wgid = (int)L; { const int q = nwg / NXCD, r = nwg % NXCD, xcd = wgid % NXCD, off = wgid / NXCD; wgid = (xcd < r ? xcd * (q + 1) : r * (q + 1) + (xcd - r) * q) + off; }
        const int nig = WGM * nN, gid = wgid / nig, fm = gid * WGM, gsz = (nM - fm) < WGM ? (nM - fm) : WGM;
        u.pm = fm + ((wgid % nig) % gsz); u.pn = (wgid % nig) / gsz; if (DBG_SKIP & 128) u.pn = nN - 1 - u.pn; u.pb = u.pn; u.e = 0; u.rbase = 0; u.cnt = 0; return true;
    }
    __device__ __forceinline__ int a_row(const Unit&, int) const { return 0; }
};
struct MoeOrder {
    int nM, nN, nwg, G, c; const LAS int* t2e; const LAS int* tstart; const LAS int* cnt; const int* rowtok;
    __device__ void init(int nM_, int nN_, int G_, int c_) { nM = nM_; nN = nN_; nwg = nM * nN; G = G_; c = c_; }
    __device__ __forceinline__ bool next(int i, Unit& u) const {
        const long L = (long)i * G + c; if (L >= nwg) return false;
        int wgid = (int)L; { const int q = nwg / NXCD, r = nwg % NXCD, xcd = wgid % NXCD, off = wgid / NXCD; wgid = (xcd < r ? xcd * (q + 1) : r * (q + 1) + (xcd - r) * q) + off; }
        const int nig = WGM * nN, gid = wgid / nig, fm = gid * WGM, gsz = (nM - fm) < WGM ? (nM - fm) : WGM;
        u.pm = fm + ((wgid % nig) % gsz); u.pn = (wgid % nig) / gsz;
        const int e = t2e[u.pm]; u.e = e; u.pb = e * nN + u.pn; u.rbase = (u.pm - tstart[e]) * 256; u.cnt = cnt[e]; return true;
    }
    __device__ __forceinline__ int a_row(const Unit& u, int r) const { const int rank = u.rbase + r; return rank < u.cnt ? rowtok[u.e * T + rank] : 0; }
};

template <class Epi, class Sched, bool GATHER, bool ALIGN_EPI>
__device__ __forceinline__ void gemm_phase(LAS unsigned char* lds, const Gemm g, const Sched& S, const Epi& E) {
    const int tid = threadIdx.x, wid = __builtin_amdgcn_readfirstlane(tid >> 6), lane = tid & 63, wr = wid >> 2, wc = wid & 3, fr = lane & 15, fq = lane >> 4;
    const int K = g.K, nt = K / BK;
    unsigned voffA[2], voffB[2]; int Rv[2], Cv[2];
#pragma unroll
    for (int i = 0; i < 2; ++i) { int R, C; stage_rc(tid * 16 + i * 8192, R, C); const int Rb = Epi::PERM ? ((R & ~31) + perm32(R & 31)) : R;
        voffA[i] = (unsigned)(R * K + C) * 2u; voffB[i] = (unsigned)(Rb * K + C) * 2u; Rv[i] = R; Cv[i] = C; }
    const size_t kstep = (size_t)(BK * 2);
    const size_t hstep = (size_t)HALF * K * 2;
    const size_t tstep = 2 * hstep;
    const unsigned ldsw = (unsigned)wid * 1024u;
    const int aoff = lds_byte(wr * 64 + fr, fq * 8), boff = lds_byte(wc * 32 + fr, fq * 8);
#define PG8_SA(b, h) (((b) * 2 + (h)) * HTB)
#define PG8_SB(b, h) ((4 + (b) * 2 + (h)) * HTB)
#define PG8_STAGE(bufoff, gbase, voff) do { _Pragma("unroll") for (int _i = 0; _i < 2; ++_i) \
        __builtin_amdgcn_global_load_lds((const unsigned*)((const char*)(gbase) + (voff)[_i]), (LAS unsigned*)(lds + (bufoff) + ldsw + _i * 8192), 16, 0, 0); } while (0)
#define PG8_LDA(dst, b, h) do { _Pragma("unroll") for (int m = 0; m < 4; ++m) _Pragma("unroll") for (int k = 0; k < 2; ++k) dst[m][k] = *(const LAS bf16x8*)(lds + PG8_SA(b, h) + aoff + m * 2048 + k * 1024); } while (0)
#define PG8_LDB(dst, b, h) do { _Pragma("unroll") for (int n = 0; n < 2; ++n) _Pragma("unroll") for (int k = 0; k < 2; ++k) dst[n][k] = *(const LAS bf16x8*)(lds + PG8_SB(b, h) + boff + n * 2048 + k * 1024); } while (0)
#define PG8_MMA(ai, bj, At, Bt) do { __builtin_amdgcn_s_setprio(1); _Pragma("unroll") for (int m = 0; m < 4; ++m) _Pragma("unroll") for (int n = 0; n < 2; ++n) _Pragma("unroll") for (int k = 0; k < 2; ++k) \
        acc[ai][bj][m][n] = __builtin_amdgcn_mfma_f32_16x16x32_bf16(Bt[n][k], At[m][k], acc[ai][bj][m][n], 0, 0, 0); __builtin_amdgcn_s_setprio(0); } while (0)
#define PG8_WAIT_V(n) asm volatile("s_waitcnt vmcnt(" #n ")" ::: "memory")
#define PG8_WAIT_L(n) asm volatile("s_waitcnt lgkmcnt(" #n ")" ::: "memory")
#define PG8_BAR __builtin_amdgcn_s_barrier()
#define PG8_SCHED __builtin_amdgcn_sched_barrier(0)
    Unit cur, nxt; int ui = 0;
    if (!S.next(0, cur)) return;
    f32x4 acc[2][2][4][2];
#pragma unroll
    for (int a = 0; a < 2; ++a)
#pragma unroll
        for (int b = 0; b < 2; ++b)
#pragma unroll
            for (int m = 0; m < 4; ++m)
#pragma unroll
                for (int n = 0; n < 2; ++n) acc[a][b][m][n] = (f32x4){0.f, 0.f, 0.f, 0.f};
    bf16x8 At[4][2], B0[2][2], B1[2][2];
    unsigned gC0[2], gC1[2], gN0[2], gN1[2];
    if constexpr (GATHER) {
#pragma unroll
        for (int i = 0; i < 2; ++i) { gC0[i] = (unsigned)S.a_row(cur, Rv[i]) * (unsigned)(K * 2) + (unsigned)Cv[i] * 2u; gC1[i] = (unsigned)S.a_row(cur, HALF + Rv[i]) * (unsigned)(K * 2) + (unsigned)Cv[i] * 2u; gN0[i] = gC0[i]; gN1[i] = gC1[i]; }
    }
    const char* cA = GATHER ? (const char*)g.A : (const char*)g.A + (size_t)cur.pm * tstep; const char* cB = (const char*)g.Bt + (size_t)cur.pb * tstep;
#define PG8_STAGE_A(bufoff, p, h, o0, o1) do { if constexpr (GATHER) { if ((h) == 0) PG8_STAGE(bufoff, p, o0); else PG8_STAGE(bufoff, p, o1); } else { PG8_STAGE(bufoff, (p) + (h) * hstep, voffA); } } while (0)
    PG8_STAGE(PG8_SB(0, 0), cB, voffB); PG8_STAGE(PG8_SB(0, 1), cB + hstep, voffB); PG8_STAGE_A(PG8_SA(0, 0), cA, 0, gC0, gC1); PG8_STAGE_A(PG8_SA(0, 1), cA, 1, gC0, gC1);
    if (wr == 1) PG8_BAR;
    PG8_WAIT_V(2); PG8_BAR;
    PG8_STAGE(PG8_SB(1, 0), cB + kstep, voffB); PG8_STAGE_A(PG8_SA(1, 0), cA + kstep, 0, gC0, gC1); PG8_STAGE(PG8_SB(1, 1), cB + hstep + kstep, voffB);
    PG8_WAIT_V(6); PG8_BAR;
    for (;;) {
        const bool has_next = S.next(ui + 1, nxt);
        const char* nA = GATHER ? (const char*)g.A : (has_next ? (const char*)g.A + (size_t)nxt.pm * tstep : cA); const char* nB = has_next ? (const char*)g.Bt + (size_t)nxt.pb * tstep : cB;
        if constexpr (GATHER) { if (has_next) {
#pragma unroll
            for (int i = 0; i < 2; ++i) { gN0[i] = (unsigned)S.a_row(nxt, Rv[i]) * (unsigned)(K * 2) + (unsigned)Cv[i] * 2u; gN1[i] = (unsigned)S.a_row(nxt, HALF + Rv[i]) * (unsigned)(K * 2) + (unsigned)Cv[i] * 2u; } } }
        for (int t = 0; t < nt; t += 2) {
            const bool last = (t == nt - 2);
            const char* a1 = cA + (size_t)(t + 1) * kstep;
            const char* a2 = last ? nA : cA + (size_t)(t + 2) * kstep; const char* b2 = last ? nB : cB + (size_t)(t + 2) * kstep;
            const char* a3 = a2 + kstep; const char* b3 = b2 + kstep;
            unsigned s0[2], s1[2];
            if constexpr (GATHER) { s0[0] = last ? gN0[0] : gC0[0]; s0[1] = last ? gN0[1] : gC0[1]; s1[0] = last ? gN1[0] : gC1[0]; s1[1] = last ? gN1[1] : gC1[1]; }
            PG8_LDB(B0, 0, 0); PG8_LDB(B1, 0, 1); PG8_SCHED; PG8_LDA(At, 0, 0); PG8_STAGE_A(PG8_SA(1, 1), a1, 1, gC0, gC1);
            PG8_WAIT_V(8); PG8_WAIT_L(0); PG8_BAR; PG8_MMA(0, 0, At, B0); PG8_MMA(0, 1, At, B1); PG8_BAR; PG8_SCHED;
            PG8_LDA(At, 0, 1); PG8_STAGE(PG8_SB(0, 0), b2, voffB); PG8_STAGE(PG8_SB(0, 1), b2 + hstep, voffB); PG8_STAGE_A(PG8_SA(0, 0), a2, 0, s0, s1);
            PG8_WAIT_V(8); PG8_WAIT_L(0); PG8_BAR; PG8_MMA(1, 0, At, B0); PG8_MMA(1, 1, At, B1); PG8_BAR; PG8_SCHED;
            PG8_LDB(B0, 1, 0); PG8_LDB(B1, 1, 1); PG8_SCHED; PG8_LDA(At, 1, 0); PG8_STAGE_A(PG8_SA(0, 1), a2, 1, s0, s1);
            PG8_WAIT_V(8); PG8_WAIT_L(0); PG8_BAR; PG8_MMA(0, 0, At, B0); PG8_MMA(0, 1, At, B1); PG8_BAR; PG8_SCHED;
            PG8_LDA(At, 1, 1); PG8_STAGE(PG8_SB(1, 0), b3, voffB); PG8_STAGE(PG8_SB(1, 1), b3 + hstep, voffB); PG8_STAGE_A(PG8_SA(1, 0), a3, 0, s0, s1);
            PG8_WAIT_V(8); PG8_WAIT_L(0); PG8_BAR; PG8_MMA(1, 0, At, B0); PG8_MMA(1, 1, At, B1); PG8_BAR; PG8_SCHED;
        }
        if constexpr (ALIGN_EPI) { if (wr == 0) PG8_BAR; }
        E(acc, cur, wr, wc, fr, fq);
        if (!has_next) break;
#pragma unroll
        for (int a = 0; a < 2; ++a)
#pragma unroll
            for (int b = 0; b < 2; ++b)
#pragma unroll
                for (int m = 0; m < 4; ++m)
#pragma unroll
                    for (int n = 0; n < 2; ++n) acc[a][b][m][n] = (f32x4){0.f, 0.f, 0.f, 0.f};
        cur = nxt; cA = nA; cB = nB; ++ui;
        if constexpr (GATHER) { gC0[0] = gN0[0]; gC0[1] = gN0[1]; gC1[0] = gN1[0]; gC1[1] = gN1[1]; }
        if constexpr (ALIGN_EPI) { if (wr == 1) PG8_BAR; }
    }
    PG8_WAIT_V(0);
    if constexpr (!ALIGN_EPI) { if (wr == 0) PG8_BAR; }
    PG8_BAR;
#undef PG8_SA
#undef PG8_SB
#undef PG8_STAGE
#undef PG8_STAGE_A
#undef PG8_LDA
#undef PG8_LDB
#undef PG8_MMA
#undef PG8_WAIT_V
#undef PG8_WAIT_L
#undef PG8_BAR
#undef PG8_SCHED
}

__device__ __forceinline__ u32x4 pack8(const f32x4& v0, const f32x4& v1) { u32x4 w; w.x = cvt_pk_bf16(v0[0], v0[1]); w.y = cvt_pk_bf16(v0[2], v0[3]); w.z = cvt_pk_bf16(v1[0], v1[1]); w.w = cvt_pk_bf16(v1[2], v1[3]); return w; }
__device__ __forceinline__ void rope4(f32x4& v0, f32x4& v1, const float* cs) {
    const f32x4 a = *(const f32x4*)cs, b = *(const f32x4*)(cs + 4);
    float x1, x2;
    x1 = v0[0]; x2 = v0[1]; v0[0] = x1 * a[0] - x2 * a[1]; v0[1] = x2 * a[0] + x1 * a[1];
    x1 = v0[2]; x2 = v0[3]; v0[2] = x1 * a[2] - x2 * a[3]; v0[3] = x2 * a[2] + x1 * a[3];
    x1 = v1[0]; x2 = v1[1]; v1[0] = x1 * b[0] - x2 * b[1]; v1[1] = x2 * b[0] + x1 * b[1];
    x1 = v1[2]; x2 = v1[3]; v1[2] = x1 * b[2] - x2 * b[3]; v1[3] = x2 * b[2] + x1 * b[3];
}

struct EpiIn {
    static constexpr bool PERM = true;
    bf16_t *qa, *ka, *va, *cq, *ckv, *gates, *kr; const float *ropeA, *ropeM, *bg; float* sq;
    __device__ __forceinline__ void operator()(const f32x4 (&acc)[2][2][4][2], const Unit& u, int wr, int wc, int fr, int fq) const {
        const int pn = u.pn, row0 = u.pm * BM + wr * 64 + fr, cl = wc * 32 + 8 * fq;
        if (pn < 8) {
            bf16_t* dst = pn < 4 ? qa : ka; const int colt = (pn & 3) * 256; const bool rot = ((wc & 1) == 0) && (fq < 2);
#pragma unroll
            for (int ai = 0; ai < 2; ++ai)
#pragma unroll
                for (int m = 0; m < 4; ++m) { const int row = row0 + ai * HALF + m * 16;
#pragma unroll
                    for (int bj = 0; bj < 2; ++bj) { f32x4 v0 = acc[ai][bj][m][0], v1 = acc[ai][bj][m][1];
                        if (rot) rope4(v0, v1, ropeA + (size_t)row * 16 + fq * 8);
                        *(u32x4*)(dst + (size_t)row * 1024 + colt + bj * HALF + cl) = pack8(v0, v1); } }
        } else if (pn < 12) {
            const int colt = (pn - 8) * 256;
#pragma unroll
            for (int ai = 0; ai < 2; ++ai)
#pragma unroll
                for (int m = 0; m < 4; ++m) { const int row = row0 + ai * HALF + m * 16;
#pragma unroll
                    for (int bj = 0; bj < 2; ++bj) *(u32x4*)(va + (size_t)row * 1024 + colt + bj * HALF + cl) = pack8(acc[ai][bj][m][0], acc[ai][bj][m][1]); }
        } else if (pn < 17) {
            const bool isq = pn < 15; bf16_t* dst = isq ? cq : ckv; const int ld = isq ? QL : KVL, colt = (isq ? pn - 12 : pn - 15) * 256, tq = pn - 12;
#pragma unroll
            for (int ai = 0; ai < 2; ++ai)
#pragma unroll
                for (int m = 0; m < 4; ++m) { const int row = row0 + ai * HALF + m * 16; float s = 0.f;
#pragma unroll
                    for (int bj = 0; bj < 2; ++bj) { const f32x4 v0 = acc[ai][bj][m][0], v1 = acc[ai][bj][m][1];
                        s += (v0[0] * v0[0] + v0[1] * v0[1]) + (v0[2] * v0[2] + v0[3] * v0[3]) + (v1[0] * v1[0] + v1[1] * v1[1]) + (v1[2] * v1[2] + v1[3] * v1[3]);
                        *(u32x4*)(dst + (size_t)row * ld + colt + bj * HALF + cl) = pack8(v0, v1); }
                    s += __shfl_xor(s, 16); s += __shfl_xor(s, 32);
                    if (fq == 0) sq[(size_t)row * 20 + tq * 4 + wc] = s; }
        } else if (pn < 25) {
            const int colt = (pn - 17) * 256;
            f32x4 bv[2][2];
#pragma unroll
            for (int bj = 0; bj < 2; ++bj) { bv[bj][0] = *(const f32x4*)(bg + colt + bj * HALF + cl); bv[bj][1] = *(const f32x4*)(bg + colt + bj * HALF + cl + 4); if (DBG_SKIP & 256) { bv[bj][0] = bv[bj][0] * 0.f; bv[bj][1] = bv[bj][1] * 0.f; } }
#pragma unroll
            for (int ai = 0; ai < 2; ++ai)
#pragma unroll
                for (int m = 0; m < 4; ++m) { const int row = row0 + ai * HALF + m * 16;
#pragma unroll
                    for (int bj = 0; bj < 2; ++bj) { f32x4 v0 = acc[ai][bj][m][0] + bv[bj][0], v1 = acc[ai][bj][m][1] + bv[bj][1];
#pragma unroll
                        for (int j = 0; j < 4; ++j) { if (!(DBG_SKIP & 512)) { v0[j] = sigmoidf_(v0[j]); v1[j] = sigmoidf_(v1[j]); } }
                        *(u32x4*)(gates + (size_t)row * 2048 + colt + bj * HALF + cl) = pack8(v0, v1); } }
        } else {
            if (wc < 2) {
#pragma unroll
                for (int ai = 0; ai < 2; ++ai)
#pragma unroll
                    for (int m = 0; m < 4; ++m) { const int row = row0 + ai * HALF + m * 16;
                        f32x4 v0 = acc[ai][0][m][0], v1 = acc[ai][0][m][1];
                        rope4(v0, v1, ropeM + (size_t)row * 64 + (wc * 16 + fq * 4) * 2);
                        *(u32x4*)(kr + (size_t)row * 64 + cl) = pack8(v0, v1); }
            }
        }
    }
};
template <bool ISQ> struct EpiUp {
    static constexpr bool PERM = true;
    bf16_t* out; const float* sq; const float* ropeM;
    __device__ __forceinline__ void operator()(const f32x4 (&acc)[2][2][4][2], const Unit& u, int wr, int wc, int fr, int fq) const {
        const int row0 = u.pm * BM + wr * 64 + fr, cl = wc * 32 + 8 * fq; constexpr int LD = ISQ ? 1536 : 2048;
#pragma unroll
        for (int ai = 0; ai < 2; ++ai)
#pragma unroll
            for (int m = 0; m < 4; ++m) { const int row = row0 + ai * HALF + m * 16; float s;
                if (ISQ) { const f32x4 a = *(const f32x4*)(sq + (size_t)row * 20), b = *(const f32x4*)(sq + (size_t)row * 20 + 4), c = *(const f32x4*)(sq + (size_t)row * 20 + 8);
                    s = ((a[0] + a[1]) + (a[2] + a[3])) + ((b[0] + b[1]) + (b[2] + b[3])) + ((c[0] + c[1]) + (c[2] + c[3])); }
                else { const f32x4 a = *(const f32x4*)(sq + (size_t)row * 20 + 12), b = *(const f32x4*)(sq + (size_t)row * 20 + 16);
                    s = ((a[0] + a[1]) + (a[2] + a[3])) + ((b[0] + b[1]) + (b[2] + b[3])); }
                const float rstd = __builtin_amdgcn_rsqf(s * (ISQ ? 1.0f / QL : 1.0f / KVL) + EPS);
#pragma unroll
                for (int bj = 0; bj < 2; ++bj) { const int col = u.pn * BM + bj * HALF + cl; f32x4 v0 = acc[ai][bj][m][0] * rstd, v1 = acc[ai][bj][m][1] * rstd;
                    if (ISQ) { const int off = col % 192; if (off >= 128) rope4(v0, v1, ropeM + (size_t)row * 64 + (off - 128)); }
                    *(u32x4*)(out + (size_t)row * LD + col) = pack8(v0, v1); } }
    }
};
template <int WHICH> struct EpiGate {
    static constexpr bool PERM = true;
    bf16_t* mrg; const bf16_t* gates;
    __device__ __forceinline__ void operator()(const f32x4 (&acc)[2][2][4][2], const Unit& u, int wr, int wc, int fr, int fq) const {
        const int row0 = u.pm * BM + wr * 64 + fr, cl = wc * 32 + 8 * fq;
#pragma unroll
        for (int ai = 0; ai < 2; ++ai)
#pragma unroll
            for (int m = 0; m < 4; ++m) { const int row = row0 + ai * HALF + m * 16;
#pragma unroll
                for (int bj = 0; bj < 2; ++bj) { const int col = u.pn * BM + bj * HALF + cl;
                    const u32x4 gw = *(const u32x4*)(gates + (size_t)row * 2048 + WHICH * 1024 + col);
                    f32x4 v0 = acc[ai][bj][m][0], v1 = acc[ai][bj][m][1];
                    if ((DBG_SKIP & 8) && WHICH == 0) { v0 = v0 * 0.f; v1 = v1 * 0.f; } if ((DBG_SKIP & 16) && WHICH == 1) { v0 = v0 * 0.f; v1 = v1 * 0.f; }
                    v0[0] *= bf_lo(gw.x); v0[1] *= bf_hi(gw.x); v0[2] *= bf_lo(gw.y); v0[3] *= bf_hi(gw.y); v1[0] *= bf_lo(gw.z); v1[1] *= bf_hi(gw.z); v1[2] *= bf_lo(gw.w); v1[3] *= bf_hi(gw.w);
                    if (WHICH == 1) { const u32x4 tw = *(const u32x4*)(mrg + (size_t)row * 1024 + col);
                        v0[0] += bf_lo(tw.x); v0[1] += bf_hi(tw.x); v0[2] += bf_lo(tw.y); v0[3] += bf_hi(tw.y); v1[0] += bf_lo(tw.z); v1[1] += bf_hi(tw.z); v1[2] += bf_lo(tw.w); v1[3] += bf_hi(tw.w); }
                    *(u32x4*)(mrg + (size_t)row * 1024 + col) = pack8(v0, v1); } }
    }
};
struct EpiRes {
    static constexpr bool PERM = false;
    const float* x; float* out;
    __device__ __forceinline__ void operator()(const f32x4 (&acc)[2][2][4][2], const Unit& u, int wr, int wc, int fr, int fq) const {
        const int row0 = u.pm * BM + wr * 64 + fr, col0 = u.pn * BM + wc * 32 + 4 * fq;
#pragma unroll
        for (int ai = 0; ai < 2; ++ai)
#pragma unroll
            for (int m = 0; m < 4; ++m) { const size_t off = (size_t)(row0 + ai * HALF + m * 16) * 1024 + col0;
#pragma unroll
                for (int bj = 0; bj < 2; ++bj)
#pragma unroll
                    for (int n = 0; n < 2; ++n) *(f32x4*)(out + off + bj * HALF + n * 16) = *(const f32x4*)(x + off + bj * HALF + n * 16) + ((DBG_SKIP & 2) ? 0.f : 1.f) * acc[ai][bj][m][n]; }
    }
};
struct EpiSwiglu {
    static constexpr bool PERM = true;
    bf16_t* act; const float *bgate, *bup;
    __device__ __forceinline__ void operator()(const f32x4 (&acc)[2][2][4][2], const Unit& u, int wr, int wc, int fr, int fq) const {
        const int row0 = u.pm * BM + wr * 64 + fr, f0 = u.pn * HALF + wc * 32 + 8 * fq;
        f32x4 bgv[2], buv[2];
#pragma unroll
        for (int n = 0; n < 2; ++n) { bgv[n] = *(const f32x4*)(bgate + (size_t)u.e * FF + f0 + 4 * n); buv[n] = *(const f32x4*)(bup + (size_t)u.e * FF + f0 + 4 * n); }
#pragma unroll
        for (int ai = 0; ai < 2; ++ai)
#pragma unroll
            for (int m = 0; m < 4; ++m) { const int row = row0 + ai * HALF + m * 16; f32x4 o[2];
#pragma unroll
                for (int n = 0; n < 2; ++n) { const f32x4 gt = acc[ai][0][m][n] + bgv[n], up = acc[ai][1][m][n] + buv[n];
#pragma unroll
                    for (int j = 0; j < 4; ++j) { const float gg = fminf(gt[j], 7.0f), uu = fminf(fmaxf(up[j], -7.0f), 7.0f); o[n][j] = (uu + 1.0f) * (gg * sigmoidf_(1.702f * gg)); } }
                *(u32x4*)(act + (size_t)row * FF + f0) = pack8(o[0], o[1]); }
    }
};
struct EpiDown {
    static constexpr bool PERM = true;
    bf16_t* y; const float* bd;
    __device__ __forceinline__ void operator()(const f32x4 (&acc)[2][2][4][2], const Unit& u, int wr, int wc, int fr, int fq) const {
        const int row0 = u.pm * BM + wr * 64 + fr, cl = wc * 32 + 8 * fq;
        f32x4 bv[2][2];
#pragma unroll
        for (int bj = 0; bj < 2; ++bj) { const int col = u.pn * BM + bj * HALF + cl; bv[bj][0] = *(const f32x4*)(bd + (size_t)u.e * D + col); bv[bj][1] = *(const f32x4*)(bd + (size_t)u.e * D + col + 4); }
#pragma unroll
        for (int ai = 0; ai < 2; ++ai)
#pragma unroll
            for (int m = 0; m < 4; ++m) { const int row = row0 + ai * HALF + m * 16;
#pragma unroll
                for (int bj = 0; bj < 2; ++bj) { const int col = u.pn * BM + bj * HALF + cl;
                    *(u32x4*)(y + (size_t)row * D + col) = pack8(acc[ai][bj][m][0] + bv[bj][0], acc[ai][bj][m][1] + bv[bj][1]); } }
    }
};
}

namespace att {
constexpr int NW = 8, QBLK = 32, KVBLK = 64;
constexpr int SHM_V = KVBLK * 128 * 2;
#define SBAR() __builtin_amdgcn_sched_barrier(0)
#define KSW(row, colB) ((row) * 128 + ((colB) ^ ((((row) >> 1) & 7) << 4)))
__device__ __forceinline__ int crow(int r, int hi) { return (r & 3) + 8 * (r >> 2) + 4 * hi; }
struct Src { const bf16_t* Q; const bf16_t* K; const bf16_t* K2; const bf16_t* V; int ldq, ldk, ldk2, ldv; };

__device__ __forceinline__ void partialSM(f32x16& p0, f32x16& p1, float& m_reg, float& mn, float& alpha, const float C, const float thr) {
  float pmax = p0[0];
#pragma unroll
  for (int r = 1; r < 16; ++r) pmax = fmaxf(pmax, p0[r]);
#pragma unroll
  for (int r = 0; r < 16; ++r) pmax = fmaxf(pmax, p1[r]);
  { auto rr = __builtin_amdgcn_permlane32_swap(__float_as_uint(pmax), __float_as_uint(pmax), false, false);
    pmax = fmaxf(__uint_as_float(rr[0]), __uint_as_float(rr[1])); }
  if (__builtin_expect(__all(pmax - m_reg <= thr), 1)) { mn = m_reg; alpha = 1.f; }
  else { mn = fmaxf(m_reg, pmax); alpha = __builtin_amdgcn_exp2f((m_reg - mn) * C); m_reg = mn; }
  const float mnC = -mn * C;
#pragma unroll
  for (int r = 0; r < 16; ++r) p0[r] = fmaf(p0[r], C, mnC);
#pragma unroll
  for (int r = 0; r < 16; ++r) p1[r] = fmaf(p1[r], C, mnC);
#pragma unroll
  for (int r = 0; r < 16; ++r) p0[r] = __builtin_amdgcn_exp2f(p0[r]);
}
__device__ __forceinline__ void finishSM(f32x16& p0, f32x16& p1, float alpha, float& l_reg, bf16x8& pa0, bf16x8& pa1, bf16x8& pa2, bf16x8& pa3) {
#pragma unroll
  for (int r = 0; r < 16; ++r) p1[r] = __builtin_amdgcn_exp2f(p1[r]);
  float ps = 0;
#pragma unroll
  for (int r = 0; r < 16; ++r) ps += p0[r];
#pragma unroll
  for (int r = 0; r < 16; ++r) ps += p1[r];
  { auto rr = __builtin_amdgcn_permlane32_swap(__float_as_uint(ps), __float_as_uint(ps), false, false);
    ps = __uint_as_float(rr[0]) + __uint_as_float(rr[1]); }
  l_reg = l_reg * alpha + ps;
#define PK4(P, BASE, OUT) do { unsigned a0 = cvt_pk_bf16(P[BASE + 0], P[BASE + 1]), a1 = cvt_pk_bf16(P[BASE + 2], P[BASE + 3]);   \
    unsigned b0 = cvt_pk_bf16(P[BASE + 4], P[BASE + 5]), b1 = cvt_pk_bf16(P[BASE + 6], P[BASE + 7]);                              \
    auto r0 = __builtin_amdgcn_permlane32_swap(a0, b0, false, false); auto r1 = __builtin_amdgcn_permlane32_swap(a1, b1, false, false); \
    u32x4 w = {r0[0], r1[0], r0[1], r1[1]}; OUT = *reinterpret_cast<bf16x8*>(&w); } while (0)
  PK4(p0, 0, pa0); PK4(p0, 8, pa1); PK4(p1, 0, pa2); PK4(p1, 8, pa3);
#undef PK4
}
template <int DQK> __device__ __forceinline__ void qkt(f32x16& p0, f32x16& p1, const LAS char* Ks, const bf16x8* qr, int r32, int hi) {
  p0 = f32x16{}; p1 = f32x16{};
#pragma unroll
  for (int d0 = 0; d0 < DQK / 16; ++d0) { const int sub = d0 >> 2, cb = ((d0 & 3) * 16 + hi * 8) * 2;
    const bf16x8 b0 = *(const LAS bf16x8*)(Ks + sub * 8192 + KSW(r32, cb));
    const bf16x8 b1 = *(const LAS bf16x8*)(Ks + sub * 8192 + KSW(32 + r32, cb));
    p0 = __builtin_amdgcn_mfma_f32_32x32x16_bf16(b0, qr[d0], p0, 0, 0, 0);
    p1 = __builtin_amdgcn_mfma_f32_32x32x16_bf16(b1, qr[d0], p1, 0, 0, 0); }
}
__device__ __forceinline__ int v_st(int k, int c) { const int kk = (k & ~0xC) | ((k & 4) << 1) | ((k & 8) >> 1); return ((kk >> 3) * 4 + (c >> 5)) * 512 + ((kk & 7) * 32 + (c & 31)) * 2; }
__device__ __forceinline__ int v_rd_base(int lane) { return ((lane & 3) << 3) | (((lane >> 2) & 3) << 6) | (((lane >> 4) & 1) << 5) | (((lane >> 5) & 1) << 8); }
constexpr int v_rd_off(int d0, int ks, int half) { return d0 * 512 + ks * 4096 + half * 2048; }
template <int OFF> __device__ __forceinline__ s16x4 tr_read(int vb) {
  s16x4 r; asm volatile("ds_read_b64_tr_b16 %0, %1 offset:%2" : "=&v"(r) : "v"(vb), "i"(OFF) : "memory"); return r;
}
template <int D0> __device__ __forceinline__ void pv_one(f32x16& od, int vb, bf16x8 pa0, bf16x8 pa1, bf16x8 pa2, bf16x8 pa3) {
  const s16x4 l0 = tr_read<v_rd_off(D0, 0, 0)>(vb), h0 = tr_read<v_rd_off(D0, 0, 1)>(vb), l1 = tr_read<v_rd_off(D0, 1, 0)>(vb), h1 = tr_read<v_rd_off(D0, 1, 1)>(vb);
  const s16x4 l2 = tr_read<v_rd_off(D0, 2, 0)>(vb), h2 = tr_read<v_rd_off(D0, 2, 1)>(vb), l3 = tr_read<v_rd_off(D0, 3, 0)>(vb), h3 = tr_read<v_rd_off(D0, 3, 1)>(vb);
  asm volatile("s_waitcnt lgkmcnt(0)" ::: "memory"); SBAR();
#define PK(L, H) (bf16x8){L[0], L[1], L[2], L[3], H[0], H[1], H[2], H[3]}
  od = __builtin_amdgcn_mfma_f32_32x32x16_bf16(pa0, PK(l0, h0), od, 0, 0, 0);
  od = __builtin_amdgcn_mfma_f32_32x32x16_bf16(pa1, PK(l1, h1), od, 0, 0, 0);
  od = __builtin_amdgcn_mfma_f32_32x32x16_bf16(pa2, PK(l2, h2), od, 0, 0, 0);
  od = __builtin_amdgcn_mfma_f32_32x32x16_bf16(pa3, PK(l3, h3), od, 0, 0, 0);
#undef PK
}
__device__ __forceinline__ void pv_d0(f32x16* o, int vb, bf16x8 pa0, bf16x8 pa1, bf16x8 pa2, bf16x8 pa3) {
  pv_one<0>(o[0], vb, pa0, pa1, pa2, pa3); pv_one<1>(o[1], vb, pa0, pa1, pa2, pa3); pv_one<2>(o[2], vb, pa0, pa1, pa2, pa3); pv_one<3>(o[3], vb, pa0, pa1, pa2, pa3);
}
template <int DQK>
__device__ __forceinline__ void attn_core(const Src in, const float C, const float thr, const int seq, LAS char* lds, f32x16 (&o)[4]) {
  constexpr int NSUB = DQK / 64, SHM_K = NSUB * 8192;
  const int tid = threadIdx.x, wid = __builtin_amdgcn_readfirstlane(tid >> 6), lane = tid & 63, r32 = lane & 31, hi = lane >> 5;
  LAS char* V_lds = lds; LAS char* K_lds = lds + 3 * SHM_V;
  LAS float* ws = (LAS float*)(lds + 3 * SHM_V + 3 * SHM_K) + wid * 64; LAS float* li_l = ws; LAS float* al_l = ws + 32;
  float m_reg = -1e30f, l_reg = 0;
#pragma unroll
  for (int d = 0; d < 4; ++d) o[d] = f32x16{};
  bf16x8 qr[DQK / 16];
  const bf16_t* Qw = in.Q + (size_t)(wid * QBLK + r32) * in.ldq + hi * 8;
#pragma unroll
  for (int d0 = 0; d0 < DQK / 16; ++d0) qr[d0] = *(const bf16x8*)(Qw + d0 * 16);
  const int krow = wid * 8 + (lane >> 3), kslot = (lane & 7) ^ ((krow >> 1) & 7);
  const unsigned koff = (unsigned)(krow * in.ldk + kslot * 8) * 2u, k2off = (unsigned)(krow * in.ldk2 + kslot * 8) * 2u;
  unsigned voff[2];
#pragma unroll
  for (int i = 0; i < 2; ++i) { const int p = i * 8192 + wid * 1024 + lane * 16, st = p >> 9, wq = (p & 511) >> 1, kk = (st >> 2) * 8 + (wq >> 5), cl = wq & 31;
    const int k = (kk & ~0xC) | ((kk & 4) << 1) | ((kk & 8) >> 1); voff[i] = (unsigned)(k * in.ldv + (st & 3) * 32 + cl) * 2u; }
  const int vb0 = (int)(unsigned)(size_t)V_lds + v_rd_base(lane);
  const unsigned ldsw = (unsigned)wid * 1024u;
#define GLDS(gp, lp) __builtin_amdgcn_global_load_lds((const unsigned*)(gp), (LAS unsigned*)(lp), 16, 0, 0)
#define ISSUE_K(t, b) do { const char* kb_ = (const char*)in.K + (size_t)(t) * (KVBLK * 2) * in.ldk; \
    _Pragma("unroll") for (int s_ = 0; s_ < NSUB; ++s_) { if (s_ < 2) GLDS(kb_ + s_ * 128 + koff, K_lds + (b) * SHM_K + s_ * 8192 + ldsw); \
      else GLDS((const char*)in.K2 + (size_t)(t) * (KVBLK * 2) * in.ldk2 + k2off, K_lds + (b) * SHM_K + s_ * 8192 + ldsw); } } while (0)
#define ISSUE_V(t, b) do { const char* vb_ = (const char*)in.V + (size_t)(t) * (KVBLK * 2) * in.ldv; \
    GLDS(vb_ + voff[0], V_lds + (b) * SHM_V + ldsw); GLDS(vb_ + voff[1], V_lds + (b) * SHM_V + 8192 + ldsw); } while (0)
#define WAITV(n) asm volatile("s_waitcnt vmcnt(%0)" :: "n"((DBG_SKIP & 4) ? 0 : (n)) : "memory")
#define WBAR() do { asm volatile("" ::: "memory"); __builtin_amdgcn_s_barrier(); asm volatile("" ::: "memory"); } while (0)
#define RESC(a) do { if (__any((a) < 1.f)) { if (hi == 0) al_l[r32] = (a); asm volatile("s_waitcnt lgkmcnt(0)" ::: "memory"); \
    _Pragma("unroll") for (int d = 0; d < 4; ++d) _Pragma("unroll") for (int r = 0; r < 16; ++r) o[d][r] *= al_l[crow(r, hi)]; } } while (0)
#define NXT3(x) ((x) == 2 ? 0 : (x) + 1)
  constexpr int NI = NSUB + 2;
  f32x16 pA0, pA1, pB0, pB1; float mnA, mnB, alA, alB; bf16x8 pa0, pa1, pa2, pa3; const int NT = seq / KVBLK;
  ISSUE_K(0, 0); ISSUE_K(1, 1); ISSUE_V(0, 0);
  WAITV(NI); WBAR();
  ISSUE_K(2, 2); ISSUE_V(1, 1);
  qkt<DQK>(pA0, pA1, K_lds, qr, r32, hi); partialSM(pA0, pA1, m_reg, mnA, alA, C, thr);
  int bq = 1;
  for (int j = 1; j + 1 < NT; j += 2) {
    { const int b1 = NXT3(bq), b2 = NXT3(b1);
      WAITV(NI); WBAR();
      ISSUE_K(j + 2, b2); ISSUE_V(j + 1, b1);
      SBAR(); qkt<DQK>(pB0, pB1, K_lds + bq * SHM_K, qr, r32, hi);
      finishSM(pA0, pA1, alA, l_reg, pa0, pa1, pa2, pa3); SBAR();
      pv_d0(o, vb0 + b2 * SHM_V, pa0, pa1, pa2, pa3); partialSM(pB0, pB1, m_reg, mnB, alB, C, thr);
      RESC(alB); bq = b1; }
    { const int b1 = NXT3(bq), b2 = NXT3(b1);
      WAITV(NI); WBAR();
      if (j + 3 < NT) ISSUE_K(j + 3, b2);
      ISSUE_V(j + 2, b1);
      SBAR(); qkt<DQK>(pA0, pA1, K_lds + bq * SHM_K, qr, r32, hi);
      finishSM(pB0, pB1, alB, l_reg, pa0, pa1, pa2, pa3); SBAR();
      pv_d0(o, vb0 + b2 * SHM_V, pa0, pa1, pa2, pa3); partialSM(pA0, pA1, m_reg, mnA, alA, C, thr);
      RESC(alA); bq = b1; }
  }
  { const int b2 = NXT3(NXT3(bq));
    WAITV(2); WBAR();
    SBAR(); qkt<DQK>(pB0, pB1, K_lds + bq * SHM_K, qr, r32, hi);
    finishSM(pA0, pA1, alA, l_reg, pa0, pa1, pa2, pa3); SBAR();
    pv_d0(o, vb0 + b2 * SHM_V, pa0, pa1, pa2, pa3); partialSM(pB0, pB1, m_reg, mnB, alB, C, thr);
    RESC(alB); }
  WAITV(0); WBAR();
  finishSM(pB0, pB1, alB, l_reg, pa0, pa1, pa2, pa3); SBAR();
  pv_d0(o, vb0 + bq * SHM_V, pa0, pa1, pa2, pa3);
  if (hi == 0) li_l[r32] = l_reg; asm volatile("s_waitcnt lgkmcnt(0)" ::: "memory");
#pragma unroll
  for (int r = 0; r < 16; ++r) { const float rl = __builtin_amdgcn_rcpf(li_l[crow(r, hi)]);
#pragma unroll
    for (int d = 0; d < 4; ++d) o[d][r] *= rl; }
  asm volatile("s_waitcnt lgkmcnt(0)" ::: "memory"); WBAR();
#undef GLDS
#undef ISSUE_K
#undef ISSUE_V
#undef WAITV
#undef WBAR
#undef RESC
#undef NXT3
}
}

constexpr int NWAVES = 8;
struct Args { const void* in[27]; float* out; unsigned char* ws; int ph_lo, ph_hi; };

__constant__ float c_invA[8] = {1.0f, 0.19392274474868576f, 0.03760603093086393f, 0.007292664737217109f, 0.001414213562373095f, 0.0002742481756762073f, 5.318295896944988e-05f, 1.031338537721246e-05f};
__constant__ float c_invM[32] = {1.0f, 0.6636012376960885f, 0.44036660267178046f, 0.2922278225730151f, 0.19392274474868576f, 0.12868737343265052f, 0.08539710028576561f, 0.05666962144529105f,
    0.03760603093086393f, 0.024955408670558694f, 0.016560440080994446f, 0.010989528534539826f, 0.007292664737217109f, 0.004839421345719893f, 0.003211445994752591f, 0.0021311195369119653f,
    0.001414213562373095f, 0.0009384738703573802f, 0.000622772421914596f, 0.0004132725499855165f, 0.0002742481756762073f, 0.00018199142881462546f, 0.00012076973741146504f, 8.01429472224798e-05f,
    5.318295896944988e-05f, 3.529227739646723e-05f, 2.341999896140934e-05f, 1.5541540297632344e-05f, 1.031338537721246e-05f, 6.8439753011549275e-06f, 4.5416704806078695e-06f, 3.013858152139171e-06f};

__device__ __forceinline__ int permDA(int i) { return i < 16 ? (i >> 1) + 8 * (i & 1) : i; }
__device__ __forceinline__ int permM(int i) { return (i >> 1) + 32 * (i & 1); }
__device__ __forceinline__ int src_in(int j) {
    if (j < 2048) return (j & ~63) + permDA(j & 63);
    if (j < 4352) return j;
    if (j < 6400) return 4416 + (j - 4352);
    if (j < 6464) return 4352 + permM(j - 6400);
    return -1;
}
__device__ __forceinline__ int src_uq(int j) { const int hd = j / 192, off = j % 192; return off < 128 ? j : hd * 192 + 128 + permM(off - 128); }

__device__ __forceinline__ void tr_item(const float* W, int K, int N, bf16_t* WT, int n0, int k0, int scol, const float* rs, LAS float* scr, int lane) {
#pragma unroll 8
    for (int i = 0; i < 32; ++i) { const int kk = 2 * i + (lane >> 5); float v = 0.f; if (scol >= 0) { v = W[(size_t)(k0 + kk) * N + scol]; if (rs) v *= rs[k0 + kk]; } scr[kk * 33 + (lane & 31)] = v; }
    LDS_WAIT(); asm volatile("" ::: "memory");
    const int c = lane & 7;
#pragma unroll
    for (int j = 0; j < 4; ++j) { const int n = (lane >> 3) + 8 * j; const LAS float* s = scr + (8 * c) * 33 + n;
        u32x4 o; o.x = cvt_pk_bf16(s[0 * 33], s[1 * 33]); o.y = cvt_pk_bf16(s[2 * 33], s[3 * 33]); o.z = cvt_pk_bf16(s[4 * 33], s[5 * 33]); o.w = cvt_pk_bf16(s[6 * 33], s[7 * 33]);
        *(u32x4*)(WT + (size_t)(n0 + n) * K + k0 + 8 * c) = o; }
    LDS_WAIT(); asm volatile("" ::: "memory");
}

__global__ void __launch_bounds__(NWAVES * 64, 2) fwd(Args args) {
    extern __shared__ __attribute__((aligned(16))) unsigned char lds_raw[];
    LAS unsigned char* lds = (LAS unsigned char*)lds_raw;
    volatile LAS unsigned* MISC = (volatile LAS unsigned*)(lds + MISC_OFF);
    const int tid = threadIdx.x, lane = tid & 63, wave = __builtin_amdgcn_readfirstlane(tid >> 6);
    const int G = gridDim.x, bx = blockIdx.x;
    unsigned char* ws = args.ws;
    unsigned* ctl = (unsigned*)(ws + WS_CTL);
    const int lo = args.ph_lo, hi_ph = args.ph_hi;
    if (tid < 32) MISC[tid] = 0u;
    __syncthreads();
    XcdBarrier bar; bar.bar = ctl + CW_BAR; bar.x = 0; bar.st = nullptr;
    if (!MK_PER_PHASE) bar = xcd_barrier_post(ctl + CW_BAR, MISC + 8);
#define IN(k) (((PH_MASK >> (k)) & 1) && lo <= (k) && (k) < hi_ph)
#define SEAM(k) do { if (IN(k) && IN((k) + 1)) xcd_barrier(bar); } while (0)
    const int gw = bx * NWAVES + wave, NGW = G * NWAVES;

    const float* x = (const float*)args.in[0]; const int* positions = (const int*)args.in[1];
    bf16_t* Bt_in = (bf16_t*)(ws + WS_BT_IN); bf16_t* Bt_uq = (bf16_t*)(ws + WS_BT_UQ); bf16_t* Bt_ukv = (bf16_t*)(ws + WS_BT_UKV);
    bf16_t* Bt_od = (bf16_t*)(ws + WS_BT_OD); bf16_t* Bt_om = (bf16_t*)(ws + WS_BT_OM); bf16_t* Bt_out = (bf16_t*)(ws + WS_BT_OUT);
    float* ropeA = (float*)(ws + WS_ROPEA); float* ropeM = (float*)(ws + WS_ROPEM); float* sq = (float*)(ws + WS_SQ2);
    bf16_t* hbuf = (bf16_t*)(ws + WS_H); bf16_t* oa = hbuf;
    bf16_t* qa = (bf16_t*)(ws + WS_QA); bf16_t* ka = (bf16_t*)(ws + WS_KA); bf16_t* va = (bf16_t*)(ws + WS_VA);
    bf16_t* cq = (bf16_t*)(ws + WS_CQ); bf16_t* ckv = (bf16_t*)(ws + WS_CKV); bf16_t* kr = (bf16_t*)(ws + WS_KR);
    bf16_t* gates = (bf16_t*)(ws + WS_GATES); bf16_t* qm = (bf16_t*)(ws + WS_QM); bf16_t* kv = (bf16_t*)(ws + WS_KV);
    bf16_t* ob = (bf16_t*)(ws + WS_OB); bf16_t* mrg = (bf16_t*)(ws + WS_MRG); float* stash = (float*)(ws + WS_STASH);
    int* rowtok = (int*)(ws + WS_ROWTOK); u32x2* assign = (u32x2*)(ws + WS_ASSIGN);
    bf16_t* Bt_d = (bf16_t*)(ws + WS_BT_D); bf16_t* Bt_gu = (bf16_t*)(ws + WS_BT_GU); bf16_t* h2 = (bf16_t*)(ws + WS_H2);
    bf16_t* act = (bf16_t*)(ws + WS_ACT); bf16_t* ybuf = (bf16_t*)(ws + WS_Y);
    unsigned* count = ctl + CW_COUNT;

    if (IN(0)) {
        LAS float* scr = (LAS float*)(lds + wave * 16384);
        const float* w_in = (const float*)args.in[3]; const float* g_q = (const float*)args.in[9]; const float* g_kv = (const float*)args.in[10];
        const float* w_uq = (const float*)args.in[11]; const float* w_ukv = (const float*)args.in[12];
        const float* w_od = (const float*)args.in[13]; const float* w_om = (const float*)args.in[14]; const float* w_out = (const float*)args.in[16];
        constexpr int I_IN = 16 * (N_IN / 32), I_UQ = (QL / 64) * (1536 / 32), I_UKV = (KVL / 64) * (2048 / 32), I_O = 16 * 32;
        constexpr int NITEMS = I_IN + I_UQ + I_UKV + 3 * I_O;
        for (int it = gw; it < NITEMS; it += NGW) {
            int r = it; const int li = lane & 31;
            if (r < I_IN) { const int nblk = N_IN / 32, kb = r / nblk, nb = r % nblk; tr_item(w_in, D, 6464, Bt_in, nb * 32, kb * 64, src_in(nb * 32 + li), nullptr, scr, lane); continue; } r -= I_IN;
            if (r < I_UQ) { const int nblk = 1536 / 32, kb = r / nblk, nb = r % nblk; tr_item(w_uq, QL, 1536, Bt_uq, nb * 32, kb * 64, src_uq(nb * 32 + li), g_q, scr, lane); continue; } r -= I_UQ;
            if (r < I_UKV) { const int nblk = 2048 / 32, kb = r / nblk, nb = r % nblk; tr_item(w_ukv, KVL, 2048, Bt_ukv, nb * 32, kb * 64, nb * 32 + li, g_kv, scr, lane); continue; } r -= I_UKV;
            const int which = r / I_O; r -= which * I_O; const int kb = r / 32, nb = r % 32;
            tr_item(which == 0 ? w_od : (which == 1 ? w_om : w_out), D, D, which == 0 ? Bt_od : (which == 1 ? Bt_om : Bt_out), nb * 32, kb * 64, nb * 32 + li, nullptr, scr, lane);
        }
        const float* g_mix = (const float*)args.in[2];
        for (int m = gw; m < T; m += NGW) {
            const f32x4* xr = (const f32x4*)(x + (size_t)m * D) + lane; f32x4 v[4]; float s = 0.f;
#pragma unroll
            for (int j = 0; j < 4; ++j) { v[j] = xr[64 * j]; s += (v[j][0] * v[j][0] + v[j][1] * v[j][1]) + (v[j][2] * v[j][2] + v[j][3] * v[j][3]); }
            const float rstd = __builtin_amdgcn_rsqf(wave_sum(s) * (1.f / D) + EPS);
            u32x2* o8 = (u32x2*)(hbuf + (size_t)m * D) + lane;
#pragma unroll
            for (int j = 0; j < 4; ++j) { const f32x4 gg = *((const f32x4*)g_mix + lane + 64 * j); u32x2 w; w.x = cvt_pk_bf16(v[j][0] * rstd * gg[0], v[j][1] * rstd * gg[1]); w.y = cvt_pk_bf16(v[j][2] * rstd * gg[2], v[j][3] * rstd * gg[3]); o8[64 * j] = w; }
        }
        for (int idx = bx * 512 + tid; idx < T * 40; idx += G * 512) {
            const int t = idx / 40, i = idx % 40; const float inv = i < 8 ? c_invA[i] : c_invM[i - 8];
            const float ang = (float)positions[t] * inv;
            const double rev = (double)ang * 0.15915494309189535; const float fr_ = (float)(rev - __builtin_rint(rev));
            const float cs = __builtin_amdgcn_cosf(fr_), sn = __builtin_amdgcn_sinf(fr_);
            float* dst = i < 8 ? ropeA + ((size_t)t * 8 + i) * 2 : ropeM + ((size_t)t * 32 + (i - 8)) * 2; dst[0] = cs; dst[1] = sn;
        }
    }
    SEAM(0);
    if (IN(1)) {
        pg8::Gemm g{hbuf, Bt_in, D}; pg8::DenseOrder S; S.init(T / 256, N_IN / 256, G, bx);
        pg8::EpiIn E{qa, ka, va, cq, ckv, gates, kr, ropeA, ropeM, (const float*)args.in[15], sq};
        pg8::gemm_phase<pg8::EpiIn, pg8::DenseOrder, false, true>(lds, g, S, E);
    }
    SEAM(1);
    if (IN(2)) {
        { pg8::Gemm g{cq, Bt_uq, QL}; pg8::DenseOrder S; S.init(T / 256, 1536 / 256, G, bx); pg8::EpiUp<true> E{qm, sq, ropeM};
          pg8::gemm_phase<pg8::EpiUp<true>, pg8::DenseOrder, false, true>(lds, g, S, E); }
        { pg8::Gemm g{ckv, Bt_ukv, KVL}; pg8::DenseOrder S; S.init(T / 256, 2048 / 256, G, G - 1 - bx); pg8::EpiUp<false> E{kv, sq, ropeM};
          pg8::gemm_phase<pg8::EpiUp<false>, pg8::DenseOrder, false, true>(lds, g, S, E); }
    }
    SEAM(2);
    if (IN(3)) {
        const int wid = tid >> 6, r32 = lane & 31, hi = lane >> 5;
        float lam;
        { const float* lq1 = (const float*)args.in[4]; const float* lk1 = (const float*)args.in[5]; const float* lq2 = (const float*)args.in[6]; const float* lk2 = (const float*)args.in[7];
          const float s1 = wave_sum(lq1[lane] * lk1[lane]), s2 = wave_sum(lq2[lane] * lk2[lane]); lam = __expf(s1) - __expf(s2) + LAM_INIT; }
        const float* g_sub = (const float*)args.in[8];
        float gs[4];
#pragma unroll
        for (int d = 0; d < 4; ++d) gs[d] = g_sub[d * 32 + r32] * (1.0f - LAM_INIT);
        for (int L = bx; L < 1024; L += G) {
            const int typ = L >> 9; int u = L & 511;
            if (G == 256) { const int c = L & 255; u = (L & 256) + (c & 7) * 32 + (c >> 3); }
            const int bh = u >> 4, qb = u & 15, b = bh >> 3, h = bh & 7;
            const size_t q0 = (size_t)b * SEQ + qb * 256, k0 = (size_t)b * SEQ;
            f32x16 o[4];
            if (typ == 0 && (DBG_SKIP & 32)) {
                for (int i = tid; i < 256 * 128; i += 512) { const size_t a = (q0 + (i >> 7)) * 1024 + h * 128 + (i & 127);
                    const float v = (DBG_SKIP & 64) ? x[a] : __uint_as_float((unsigned)qa[a] << 16) + __uint_as_float((unsigned)ka[a] << 16) + __uint_as_float((unsigned)va[a] << 16);
                    oa[a] = (bf16_t)(cvt_pk_bf16(v, 0.f) & 0xffffu); }
            } else
            if (typ == 0 && (ATT_MASK & 1)) {
                f32x4* st = (f32x4*)(stash + ((size_t)(bx * 8 + wid) * 64 + lane) * 64);
                { att::Src in{qa + q0 * 1024 + h * 128, ka + k0 * 1024 + h * 128, nullptr, va + k0 * 1024 + h * 128, 1024, 1024, 0, 1024};
                  att::attn_core<64>(in, 0.125f * 1.4426950408889634f, 8.f / 0.125f, SEQ, (LAS char*)lds, o); }
#pragma unroll
                for (int d = 0; d < 4; ++d)
#pragma unroll
                    for (int q4 = 0; q4 < 4; ++q4) st[d * 4 + q4] = (f32x4){o[d][4 * q4], o[d][4 * q4 + 1], o[d][4 * q4 + 2], o[d][4 * q4 + 3]};
                { att::Src in{qa + q0 * 1024 + h * 128 + 64, ka + k0 * 1024 + h * 128 + 64, nullptr, va + k0 * 1024 + h * 128, 1024, 1024, 0, 1024};
                  att::attn_core<64>(in, 0.125f * 1.4426950408889634f, 8.f / 0.125f, SEQ, (LAS char*)lds, o); }
                asm volatile("" : "+v"(st) :: "memory");
                float ss[16];
#pragma unroll
                for (int r = 0; r < 16; ++r) ss[r] = 0.f;
#pragma unroll
                for (int d = 0; d < 4; ++d) {
#pragma unroll
                    for (int q4 = 0; q4 < 4; ++q4) { const f32x4 sv = st[d * 4 + q4];
#pragma unroll
                        for (int j = 0; j < 4; ++j) { const int r = 4 * q4 + j; const float v = sv[j] - lam * o[d][r]; o[d][r] = v; ss[r] += v * v; } }
                    asm volatile("" ::: "memory"); }
#pragma unroll
                for (int r = 0; r < 16; ++r) {
#pragma unroll
                    for (int msk = 1; msk < 32; msk <<= 1) ss[r] += __shfl_xor(ss[r], msk);
                    ss[r] = __builtin_amdgcn_rsqf(ss[r] * (1.0f / 128.0f) + EPS); }
                bf16_t* Ow = oa + (q0 + wid * 32) * 1024 + h * 128 + r32; asm volatile("" : "+v"(Ow));
#pragma unroll
                for (int r = 0; r < 16; ++r) { const int orow = att::crow(r, hi);
#pragma unroll
                    for (int d = 0; d < 4; ++d) Ow[(size_t)orow * 1024 + d * 32] = (bf16_t)(cvt_pk_bf16(o[d][r] * ss[r] * gs[d], 0.f) & 0xffffu); }
            } else if (ATT_MASK & 2) {
                { att::Src in{qm + q0 * 1536 + h * 192, kv + k0 * 2048 + h * 256, kr + k0 * 64, kv + k0 * 2048 + h * 256 + 128, 1536, 2048, 64, 2048};
                  att::attn_core<192>(in, 0.07216878364870322f * 1.4426950408889634f, 8.f / 0.07216878364870322f, SEQ, (LAS char*)lds, o); }
                bf16_t* Ow = ob + (q0 + wid * 32) * 1024 + h * 128 + r32; asm volatile("" : "+v"(Ow));
#pragma unroll
                for (int r = 0; r < 16; ++r) { const int orow = att::crow(r, hi);
#pragma unroll
                    for (int d = 0; d < 4; ++d) Ow[(size_t)orow * 1024 + d * 32] = (bf16_t)(cvt_pk_bf16(o[d][r], 0.f) & 0xffffu); }
            }
        }
    }
    SEAM(3);
    if (IN(4)) {
        { pg8::Gemm g{oa, Bt_od, D}; pg8::DenseOrder S; S.init(T / 256, 4, G, bx); pg8::EpiGate<0> E{mrg, gates};
          pg8::gemm_phase<pg8::EpiGate<0>, pg8::DenseOrder, false, true>(lds, g, S, E); }
        VM_WAIT(); __syncthreads();
        { pg8::Gemm g{ob, Bt_om, D}; pg8::DenseOrder S; S.init(T / 256, 4, G, bx); pg8::EpiGate<1> E{mrg, gates};
          pg8::gemm_phase<pg8::EpiGate<1>, pg8::DenseOrder, false, true>(lds, g, S, E); }
    }
    SEAM(4);
    if (IN(5)) {
        pg8::Gemm g{mrg, Bt_out, D}; pg8::DenseOrder S; S.init(T / 256, 4, G, bx); pg8::EpiRes E{x, args.out};
        pg8::gemm_phase<pg8::EpiRes, pg8::DenseOrder, false, true>(lds, g, S, E);
    }
    SEAM(5);
    if (IN(6)) {
        const float* g_ffn = (const float*)args.in[17]; const float* w_router = (const float*)args.in[18]; const float* b_router = (const float*)args.in[19];
        LAS float* wr_l = (LAS float*)lds;
        LAS int* lcount = (LAS int*)(lds + TAB_OFF); LAS int* gbase = lcount + 32; LAS unsigned* asg_e = (LAS unsigned*)(lcount + 64); LAS float* asg_w = (LAS float*)(lcount + 64 + 256);
        for (int i = tid; i < D * NEXP; i += 512) { const int d = i >> 5, e = i & 31; wr_l[e * 1024 + d] = w_router[i]; }
        for (int chunk = bx; chunk < T / 64; chunk += G) {
            if (tid < 32) lcount[tid] = 0;
            __syncthreads();
            for (int j2 = 0; j2 < 8; ++j2) {
                const int tl = wave * 8 + j2, t = chunk * 64 + tl;
                const f32x4* xr = (const f32x4*)(args.out + (size_t)t * D) + lane; f32x4 v[4]; float s = 0.f;
#pragma unroll
                for (int j = 0; j < 4; ++j) { v[j] = xr[64 * j]; s += (v[j][0] * v[j][0] + v[j][1] * v[j][1]) + (v[j][2] * v[j][2] + v[j][3] * v[j][3]); }
                const float rstd = __builtin_amdgcn_rsqf(wave_sum(s) * (1.f / D) + EPS);
                u32x2* o8 = (u32x2*)(h2 + (size_t)t * D) + lane;
#pragma unroll
                for (int j = 0; j < 4; ++j) { const f32x4 gg = *((const f32x4*)g_ffn + lane + 64 * j); v[j] = v[j] * rstd * gg; u32x2 w; w.x = cvt_pk_bf16(v[j][0], v[j][1]); w.y = cvt_pk_bf16(v[j][2], v[j][3]); o8[64 * j] = w; }
                float my = -3.0e38f;
                for (int e = 0; e < NEXP; ++e) { float a = 0.f;
#pragma unroll
                    for (int j = 0; j < 4; ++j) { const f32x4 w4 = *(const LAS f32x4*)(wr_l + e * 1024 + 4 * lane + 256 * j); a += (v[j][0] * w4[0] + v[j][1] * w4[1]) + (v[j][2] * w4[2] + v[j][3] * w4[3]); }
                    a = wave_sum(a); if (lane == e) my = a + b_router[e]; }
                float tv[4]; int te[4];
#pragma unroll
                for (int k = 0; k < 4; ++k) { float bv = my; int bi = lane;
#pragma unroll
                    for (int o = 1; o < 64; o <<= 1) { const float ov = __shfl_xor(bv, o); const int oi = __shfl_xor(bi, o); if (ov > bv || (ov == bv && oi < bi)) { bv = ov; bi = oi; } }
                    tv[k] = bv; te[k] = bi; if (lane == bi) my = -3.0e38f; }
                const float p1 = __expf(tv[1] - tv[0]), p2 = __expf(tv[2] - tv[0]), p3 = __expf(tv[3] - tv[0]), inv = 1.0f / (1.0f + p1 + p2 + p3);
                if (lane < 4) { const int e = lane == 0 ? te[0] : (lane == 1 ? te[1] : (lane == 2 ? te[2] : te[3])); const float w = (lane == 0 ? 1.0f : (lane == 1 ? p1 : (lane == 2 ? p2 : p3))) * inv;
                    const int lr = __hip_atomic_fetch_add((LAS int*)&lcount[e], 1, __ATOMIC_RELAXED, __HIP_MEMORY_SCOPE_WORKGROUP);
                    asg_e[tl * 4 + lane] = ((unsigned)e << 16) | (unsigned)lr; asg_w[tl * 4 + lane] = w; }
            }
            __syncthreads();
            if (tid < 32) gbase[tid] = (int)__hip_atomic_fetch_add(count + tid, (unsigned)lcount[tid], __ATOMIC_RELAXED, __HIP_MEMORY_SCOPE_AGENT);
            __syncthreads();
            if (tid < 256) { const unsigned ae = asg_e[tid]; const int e = ae >> 16, rank = gbase[e] + (int)(ae & 0xffffu); const int t = chunk * 64 + (tid >> 2);
                rowtok[e * T + rank] = t; u32x2 a; a.x = ((unsigned)e << 16) | (unsigned)rank; a.y = __float_as_uint(asg_w[tid]); assign[(size_t)t * 4 + (tid & 3)] = a; }
            __syncthreads();
        }
        __syncthreads();
        LAS float* scr = (LAS float*)(lds + wave * 16384);
        const float* w_gate = (const float*)args.in[20]; const float* w_up = (const float*)args.in[22]; const float* w_down = (const float*)args.in[24];
        constexpr int I_GU = 16 * 64, I_D = 16 * 32, I_E = I_GU + I_D;
        for (int it = gw; it < NEXP * I_E; it += NGW) {
            const int e = it / I_E; int r = it % I_E; const int li = lane & 31;
            if (r < I_GU) { const int kb = r / 64, nb = r % 64, j = nb * 32, ct = j >> 8, half = (j >> 7) & 1, f = ct * 128 + (j & 127);
                tr_item((half ? w_up : w_gate) + (size_t)e * D * FF, D, FF, Bt_gu + (size_t)e * 2048 * D, j, kb * 64, f + li, nullptr, scr, lane); }
            else { r -= I_GU; const int kb = r / 32, nb = r % 32; tr_item(w_down + (size_t)e * FF * D, FF, D, Bt_d + (size_t)e * D * FF, nb * 32, kb * 64, nb * 32 + li, nullptr, scr, lane); }
        }
    }
    SEAM(6);
    LAS int* t_cnt = (LAS int*)(lds + TAB_OFF + 4096); LAS int* t_start = t_cnt + 32; LAS int* t_t2e = t_start + 40;
    if (IN(7) || IN(8) || IN(9)) {
        __syncthreads();
        if (tid < 32) t_cnt[tid] = (int)__hip_atomic_load(count + tid, __ATOMIC_RELAXED, __HIP_MEMORY_SCOPE_AGENT);
        __syncthreads();
        if (tid == 0) { int s = 0; for (int e = 0; e < NEXP; ++e) { t_start[e] = s; s += (t_cnt[e] + 255) >> 8; } t_start[32] = s; }
        __syncthreads();
        if (tid < 32) { for (int rt = t_start[tid]; rt < t_start[tid + 1]; ++rt) t_t2e[rt] = tid; }
        __syncthreads();
    }
    if (IN(7)) {
        pg8::Gemm g{h2, Bt_gu, D}; pg8::MoeOrder S; S.init(t_start[32], 8, G, bx); S.t2e = t_t2e; S.tstart = t_start; S.cnt = t_cnt; S.rowtok = rowtok;
        pg8::EpiSwiglu E{act, (const float*)args.in[21], (const float*)args.in[23]};
        pg8::gemm_phase<pg8::EpiSwiglu, pg8::MoeOrder, true, true>(lds, g, S, E);
    }
    SEAM(7);
    if (IN(8)) {
        pg8::Gemm g{act, Bt_d, FF}; pg8::MoeOrder S; S.init(t_start[32], 4, G, bx); S.t2e = t_t2e; S.tstart = t_start; S.cnt = t_cnt; S.rowtok = rowtok;
        pg8::EpiDown E{ybuf, (const float*)args.in[25]};
        pg8::gemm_phase<pg8::EpiDown, pg8::MoeOrder, false, true>(lds, g, S, E);
    }
    SEAM(8);
    if (IN(9) && DBG_OUT) {
        const bf16_t* src = DBG_OUT == 1 ? gates : DBG_OUT == 2 ? gates + 1024 : DBG_OUT == 3 ? qa : DBG_OUT == 4 ? ka : DBG_OUT == 5 ? va : DBG_OUT == 6 ? mrg : DBG_OUT == 7 ? oa : DBG_OUT == 9 ? Bt_in : ob;
        const int ld = DBG_OUT <= 2 ? 2048 : 1024;
        for (size_t i = (size_t)bx * 512 + tid; i < (size_t)T * 1024; i += (size_t)G * 512) args.out[i] = (DBG_OUT == 9 && i >= (size_t)N_IN * 1024) ? 0.f : __uint_as_float((unsigned)src[(i >> 10) * ld + (i & 1023)] << 16);
    } else
    if (IN(9)) {
        const float* g_fin = (const float*)args.in[26];
        for (int t = gw; t < T; t += NGW) {
            f32x4* xr = (f32x4*)(args.out + (size_t)t * D) + lane; f32x4 v[4];
#pragma unroll
            for (int j = 0; j < 4; ++j) v[j] = xr[64 * j];
#pragma unroll
            for (int k = 0; k < ((DBG_SKIP & 1) ? 0 : 4); ++k) { const u32x2 a = assign[(size_t)t * 4 + k]; const int e = a.x >> 16, rank = a.x & 0xffffu; const float w = __uint_as_float(a.y);
                const u32x2* yr = (const u32x2*)(ybuf + ((size_t)t_start[e] * 256 + rank) * D) + lane;
#pragma unroll
                for (int j = 0; j < 4; ++j) { const u32x2 yw = yr[64 * j]; v[j][0] += w * bf_lo(yw.x); v[j][1] += w * bf_hi(yw.x); v[j][2] += w * bf_lo(yw.y); v[j][3] += w * bf_hi(yw.y); } }
            float s = 0.f;
#pragma unroll
            for (int j = 0; j < 4; ++j) s += (v[j][0] * v[j][0] + v[j][1] * v[j][1]) + (v[j][2] * v[j][2] + v[j][3] * v[j][3]);
            const float rstd = __builtin_amdgcn_rsqf(wave_sum(s) * (1.f / D) + EPS);
#pragma unroll
            for (int j = 0; j < 4; ++j) { const f32x4 gg = *((const f32x4*)g_fin + lane + 64 * j); xr[64 * j] = v[j] * rstd * gg; }
        }
    }
#undef IN
#undef SEAM
}

extern "C" void kernel_launch(void* const* d_in, const int* in_sizes, int n_in, void* d_out, int out_size, void* d_ws, size_t ws_size, hipStream_t stream) {
    static int grid = 0;
    if (grid == 0) {
        if (n_in != 27 || in_sizes[0] != T * D || out_size != T * D || ws_size < WS_END) { fprintf(stderr, "kernel_launch: unexpected shapes (n_in %d, in0 %d, out %d, ws %zu < %zu)\n", n_in, n_in > 0 ? in_sizes[0] : -1, out_size, ws_size, (size_t)WS_END); grid = -1; return; }
        int dev = 0, cus = 0, per_cu = 0;
        if (hipGetDevice(&dev) != hipSuccess || hipDeviceGetAttribute(&cus, hipDeviceAttributeMultiprocessorCount, dev) != hipSuccess) { grid = -1; return; }
        if (hipFuncSetAttribute((const void*)fwd, hipFuncAttributeMaxDynamicSharedMemorySize, LDS_BYTES) != hipSuccess) { fprintf(stderr, "kernel_launch: hipFuncSetAttribute failed\n"); grid = -1; return; }
        if (hipOccupancyMaxActiveBlocksPerMultiprocessor(&per_cu, (const void*)fwd, NWAVES * 64, LDS_BYTES) != hipSuccess || per_cu < 1) fprintf(stderr, "kernel_launch: occupancy query says %d\n", per_cu);
        (void)hipGetLastError();
        grid = cus;
    }
    if (grid < 0) return;
    if (hipMemsetAsync((char*)d_ws + WS_CTL, 0, CTL_ZERO_BYTES, stream) != hipSuccess) return;
    Args a{};
    for (int i = 0; i < 27; ++i) a.in[i] = d_in[i];
    a.out = (float*)d_out; a.ws = (unsigned char*)d_ws;
#if MK_PER_PHASE
    for (int p = 0; p < NPHASE; ++p) { a.ph_lo = p; a.ph_hi = p + 1; hipLaunchKernelGGL(fwd, dim3(grid), dim3(NWAVES * 64), LDS_BYTES, stream, a); }
#else
    a.ph_lo = 0; a.ph_hi = NPHASE; hipLaunchKernelGGL(fwd, dim3(grid), dim3(NWAVES * 64), LDS_BYTES, stream, a);
#endif
}
```

```cpp
#include <hip/hip_runtime.h>
#include <cstdio>
#include <cstdint>

#ifndef MK_PER_PHASE
#define MK_PER_PHASE 0
#endif

#ifndef PROBE_PHASE
#define PROBE_PHASE -1
#endif
#ifndef DBG_OUT
#define DBG_OUT 0
#endif
#ifndef DBG_SKIP
#define DBG_SKIP 0
#endif
#ifndef ATT_MASK
#define ATT_MASK 3
#endif
#ifndef PH_MASK
#define PH_MASK 0x3ff
#endif
#define LAS __attribute__((address_space(3)))
#define GAS __attribute__((address_space(1)))
typedef unsigned short bf16_t;
typedef short bf16x8 __attribute__((ext_vector_type(8)));
typedef short s16x4 __attribute__((ext_vector_type(4)));
typedef float f32x2 __attribute__((ext_vector_type(2)));
typedef float f32x4 __attribute__((ext_vector_type(4)));
typedef float f32x16 __attribute__((ext_vector_type(16)));
typedef unsigned u32x2 __attribute__((ext_vector_type(2)));
typedef unsigned u32x4 __attribute__((ext_vector_type(4)));

constexpr int NB = 4, SEQ = 4096, T = NB * SEQ, D = 1024;
constexpr int NEXP = 32, TOPK = 4, FF = 1024;
constexpr int N_IN = 6656;
constexpr int QL = 768, KVL = 512;
constexpr float EPS = 1e-6f;
constexpr float LAM_INIT = 0.2f;
constexpr int NPHASE = 10;

constexpr size_t MiB = 1u << 20;
constexpr size_t WS_CTL = 0, CTL_ZERO_BYTES = 1 * MiB;
constexpr size_t WS_BT_IN = 2 * MiB;
constexpr size_t WS_BT_UQ = 15 * MiB;
constexpr size_t WS_BT_UKV = 18 * MiB;
constexpr size_t WS_BT_OD = 20 * MiB, WS_BT_OM = 22 * MiB, WS_BT_OUT = 24 * MiB;
constexpr size_t WS_ROPEA = 26 * MiB;
constexpr size_t WS_ROPEM = 27 * MiB;
constexpr size_t WS_SQ = 31 * MiB;
constexpr size_t WS_SQP = 1 * MiB;
constexpr size_t WS_H = 32 * MiB;
constexpr size_t WS_QA = 64 * MiB, WS_KA = 96 * MiB, WS_VA = 128 * MiB;
constexpr size_t WS_CQ = 160 * MiB, WS_CKV = 184 * MiB, WS_KR = 200 * MiB;
constexpr size_t WS_SQ2 = 202 * MiB;
constexpr size_t WS_GATES = 208 * MiB;
constexpr size_t WS_QM = 272 * MiB;
constexpr size_t WS_KV = 320 * MiB;
constexpr size_t WS_OB = 384 * MiB;
constexpr size_t WS_MRG = 416 * MiB;
constexpr size_t WS_STASH = 448 * MiB;
constexpr size_t WS_ROWTOK = 2 * MiB;
constexpr size_t WS_ASSIGN = 4 * MiB;
constexpr size_t WS_BT_D = 32 * MiB;
constexpr size_t WS_BT_GU = 96 * MiB;
constexpr size_t WS_H2 = 224 * MiB;
constexpr size_t WS_ACT = 256 * MiB;
constexpr size_t WS_Y = 96 * MiB;
constexpr size_t WS_END = 512 * MiB;
constexpr int CW_COUNT = 64;
constexpr int CW_BAR = 4096;

constexpr int RING_BYTES = 131072;
constexpr int TAB_OFF = RING_BYTES;
constexpr int TAB_BYTES = 8192;
constexpr int MISC_OFF = TAB_OFF + TAB_BYTES;
constexpr int LDS_BYTES = 147456;

typedef __bf16 bf16x2_t __attribute__((ext_vector_type(2)));
__device__ __forceinline__ unsigned cvt_pk_bf16(float lo, float hi) { const f32x2 v = {lo, hi}; return __builtin_bit_cast(unsigned, __builtin_convertvector(v, bf16x2_t)); }
__device__ __forceinline__ float bf_lo(unsigned w) { return __uint_as_float(w << 16); }
__device__ __forceinline__ float bf_hi(unsigned w) { return __uint_as_float(w & 0xffff0000u); }
__device__ __forceinline__ float wave_sum(float v) {
#pragma unroll
    for (int o = 1; o < 64; o <<= 1) v += __shfl_xor(v, o);
    return v;
}
__device__ __forceinline__ float sigmoidf_(float x) { return __builtin_amdgcn_rcpf(1.0f + __builtin_amdgcn_exp2f(-1.4426950408889634f * x)); }
#define LDS_WAIT() asm volatile("s_waitcnt lgkmcnt(0)" ::: "memory")
#define VM_WAIT() asm volatile("s_waitcnt vmcnt(0)" ::: "memory")

#define XB_TMO      128
#define XB_XCNT(j)  (256  + 64 * (j))
#define XB_XSUB(j)  (1280 + 64 * (j))
#define XB_XGEN(j)  (2304 + 64 * (j))
#define XB_TOP      3328
#define XB_TOPGEN   3392
#define XCD_BAR_WORDS 3456
#define XB_SPIN_CAP (1u << 20)
__device__ __forceinline__ unsigned xb_ld(unsigned* p)              { return __hip_atomic_load(p, __ATOMIC_RELAXED, __HIP_MEMORY_SCOPE_AGENT); }
__device__ __forceinline__ unsigned xb_add(unsigned* p, unsigned v) { return __hip_atomic_fetch_add(p, v, __ATOMIC_RELAXED, __HIP_MEMORY_SCOPE_AGENT); }
__device__ __forceinline__ unsigned xb_xcc_id() { return (unsigned)__builtin_amdgcn_s_getreg((3 << 11) | 20) & 0xFu; }
#define XB_SPIN(cond, bar) do { unsigned _sp = 0; while (cond) { __builtin_amdgcn_s_sleep(1); \
    if ((++_sp & 255u) == 0u) { if (xb_ld(&(bar)[XB_TMO])) break; if (_sp > XB_SPIN_CAP) { atomicAdd(&(bar)[XB_TMO], 1u); break; } } } } while (0)
struct XcdBarrier { unsigned* bar; unsigned x; volatile LAS unsigned* st; };
__device__ __forceinline__ XcdBarrier xcd_barrier_post(unsigned* bar, volatile LAS unsigned* st) {
    XcdBarrier b; b.bar = bar; b.x = xb_xcc_id(); b.st = st;
    if (threadIdx.x == 0) (void)xb_add(&bar[XB_XCNT(b.x)], 1u);
    return b;
}
__device__ __forceinline__ void xcd_barrier_complete(unsigned* bar, unsigned x, unsigned& nloc, unsigned& nx) {
    const unsigned G = gridDim.x * gridDim.y * gridDim.z;
    unsigned sum, cnt, mine, sp = 0u;
    for (;;) {
        sum = 0u; cnt = 0u; mine = 0u;
#pragma unroll
        for (unsigned j = 0; j < 16; ++j) { const unsigned c = xb_ld(&bar[XB_XCNT(j)]); sum += c; cnt += (c > 0u) ? 1u : 0u; mine = (j == x) ? c : mine; }
        if (sum == G) break;
        __builtin_amdgcn_s_sleep(1);
        if ((++sp & 255u) == 0u) { if (xb_ld(&bar[XB_TMO])) break; if (sp > XB_SPIN_CAP) { atomicAdd(&bar[XB_TMO], 1u); break; } }
    }
    nloc = mine > 0u ? mine : 1u; nx = cnt > 0u ? cnt : 1u;
}
__device__ __forceinline__ void xcd_barrier(const XcdBarrier& b) {
    asm volatile("s_waitcnt vmcnt(0)" ::: "memory");
    __syncthreads();
    if (threadIdx.x == 0) {
        unsigned* bar = b.bar;
        __builtin_amdgcn_s_waitcnt(0);
        unsigned nloc = b.st[0], nx = b.st[1];
        if (nloc == 0u) { xcd_barrier_complete(bar, b.x, nloc, nx); b.st[0] = nloc; b.st[1] = nx; }
        const unsigned old = xb_add(&bar[XB_XSUB(b.x)], 1u);
        const unsigned gen = old / nloc;
        if (old + 1u == (gen + 1u) * nloc) {
            __builtin_amdgcn_fence(__ATOMIC_RELEASE, "agent");
            asm volatile("s_waitcnt vmcnt(0)" ::: "memory");
            const unsigned og = xb_add(&bar[XB_TOP], 1u);
            const unsigned tg = og / nx;
            if (og + 1u == (tg + 1u) * nx) xb_add(&bar[XB_TOPGEN], 1u);
            else XB_SPIN(xb_ld(&bar[XB_TOPGEN]) == tg, bar);
            __builtin_amdgcn_fence(__ATOMIC_ACQUIRE, "agent");
            xb_add(&bar[XB_XGEN(b.x)], 1u);
            asm volatile("s_waitcnt vmcnt(0)" ::: "memory");
        } else {
            XB_SPIN(xb_ld(&bar[XB_XGEN(b.x)]) == gen, bar);
            __builtin_amdgcn_fence(__ATOMIC_ACQUIRE, "agent");
            asm volatile("s_waitcnt vmcnt(0)" ::: "memory");
        }
    }
    __syncthreads();
}

namespace pg8 {
constexpr int BM = 256, BK = 64, HALF = 128, HTB = HALF * BK * 2, STAGE_BYTES = 8 * HTB, NXCD = 8, WGM = 8;
__host__ __device__ __forceinline__ int lds_byte(int r, int c) { const int st = (r >> 4) * 2 + (c >> 5), rr = r & 15, cc = c & 31, ob = rr * 64 + cc * 2; return st * 1024 + (ob ^ (((ob >> 9) & 1) << 5)); }
__host__ __device__ __forceinline__ void stage_rc(int b, int& R, int& C) { const int st = b / 1024, sb = b % 1024, swz = sb ^ (((sb >> 9) & 1) << 5); R = (st >> 1) * 16 + swz / 64; C = (st & 1) * 32 + (swz % 64) / 2; }
__host__ __device__ __forceinline__ int perm32(int rho) { const int n = rho >> 4, i = rho & 15; return 8 * (i >> 2) + 4 * n + (i & 3); }

struct Unit { int pm, pn, pb, e, rbase, cnt; };
struct Gemm { const bf16_t* A; const bf16_t* Bt; int K; };

struct DenseOrder {
    int nM, nN, nwg, G, c;
    __device__ void init(int nM_, int nN_, int G_, int c_) { nM = nM_; nN = nN_; nwg = nM * nN; G = G_; c = c_; }
    __device__ __forceinline__ bool next(int i, Unit& u) const {
        const long L = (long)i * G + c; if (L >= nwg) return false;
        int wgid = (int)L; { const int q = nwg / NXCD, r = nwg % NXCD, xcd = wgid % NXCD, off = wgid / NXCD; wgid = (xcd < r ? xcd * (q + 1) : r * (q + 1) + (xcd - r) * q) + off; }
        const int nig = WGM * nN, gid = wgid / nig, fm = gid * WGM, gsz = (nM - fm) < WGM ? (nM - fm) : WGM;
        u.pm = fm + ((wgid % nig) % gsz); u.pn = (wgid % nig) / gsz; if (DBG_SKIP & 128) u.pn = nN - 1 - u.pn; u.pb = u.pn; u.e = 0; u.rbase = 0; u.cnt = 0; return true;
    }
    __device__ __forceinline__ int a_row(const Unit&, int) const { return 0; }
};
struct MoeOrder {
    int nM, nN, nwg, G, c; const LAS int* t2e; const LAS int* tstart; const LAS int* cnt; const int* rowtok;
    __device__ void init(int nM_, int nN_, int G_, int c_) { nM = nM_; nN = nN_; nwg = nM * nN; G = G_; c = c_; }
    __device__ __forceinline__ bool next(int i, Unit& u) const {
        const long L = (long)i * G + c; if (L >= nwg) return false;
        int wgid = (int)L; { const int q = nwg / NXCD, r = nwg % NXCD, xcd = wgid % NXCD, off = wgid / NXCD; wgid = (xcd < r ? xcd * (q + 1) : r * (q + 1) + (xcd - r) * q) + off; }
        const int nig = WGM * nN, gid = wgid / nig, fm = gid * WGM, gsz = (nM - fm) < WGM ? (nM - fm) : WGM;
        u.pm = fm + ((wgid % nig) % gsz); u.pn = (wgid % nig) / gsz;
        const int e = t2e[u.pm]; u.e = e; u.pb = e * nN + u.pn; u.rbase = (u.pm - tstart[e]) * 256; u.cnt = cnt[e]; return true;
    }
    __device__ __forceinline__ int a_row(const Unit& u, int r) const { const int rank = u.rbase + r; return rank < u.cnt ? rowtok[u.e * T + rank] : 0; }
};

template <class Epi, class Sched, bool GATHER, bool ALIGN_EPI>
__device__ __forceinline__ void gemm_phase(LAS unsigned char* lds, const Gemm g, const Sched& S, const Epi& E) {
    const int tid = threadIdx.x, wid = __builtin_amdgcn_readfirstlane(tid >> 6), lane = tid & 63, wr = wid >> 2, wc = wid & 3, fr = lane & 15, fq = lane >> 4;
    const int K = g.K, nt = K / BK;
    unsigned voffA[2], voffB[2]; int Rv[2], Cv[2];
#pragma unroll
    for (int i = 0; i < 2; ++i) { int R, C; stage_rc(tid * 16 + i * 8192, R, C); const int Rb = Epi::PERM ? ((R & ~31) + perm32(R & 31)) : R;
        voffA[i] = (unsigned)(R * K + C) * 2u; voffB[i] = (unsigned)(Rb * K + C) * 2u; Rv[i] = R; Cv[i] = C; }
    const size_t kstep = (size_t)(BK * 2);
    const size_t hstep = (size_t)HALF * K * 2;
    const size_t tstep = 2 * hstep;
    const unsigned ldsw = (unsigned)wid * 1024u;
    const int aoff = lds_byte(wr * 64 + fr, fq * 8), boff = lds_byte(wc * 32 + fr, fq * 8);
#define PG8_SA(b, h) (((b) * 2 + (h)) * HTB)
#define PG8_SB(b, h) ((4 + (b) * 2 + (h)) * HTB)
#define PG8_STAGE(bufoff, gbase, voff) do { _Pragma("unroll") for (int _i = 0; _i < 2; ++_i) \
        __builtin_amdgcn_global_load_lds((const unsigned*)((const char*)(gbase) + (voff)[_i]), (LAS unsigned*)(lds + (bufoff) + ldsw + _i * 8192), 16, 0, 0); } while (0)
#define PG8_LDA(dst, b, h) do { _Pragma("unroll") for (int m = 0; m < 4; ++m) _Pragma("unroll") for (int k = 0; k < 2; ++k) dst[m][k] = *(const LAS bf16x8*)(lds + PG8_SA(b, h) + aoff + m * 2048 + k * 1024); } while (0)
#define PG8_LDB(dst, b, h) do { _Pragma("unroll") for (int n = 0; n < 2; ++n) _Pragma("unroll") for (int k = 0; k < 2; ++k) dst[n][k] = *(const LAS bf16x8*)(lds + PG8_SB(b, h) + boff + n * 2048 + k * 1024); } while (0)
#define PG8_MMA(ai, bj, At, Bt) do { __builtin_amdgcn_s_setprio(1); _Pragma("unroll") for (int m = 0; m < 4; ++m) _Pragma("unroll") for (int n = 0; n < 2; ++n) _Pragma("unroll") for (int k = 0; k < 2; ++k) \
        acc[ai][bj][m][n] = __builtin_amdgcn_mfma_f32_16x16x32_bf16(Bt[n][k], At[m][k], acc[ai][bj][m][n], 0, 0, 0); __builtin_amdgcn_s_setprio(0); } while (0)
#define PG8_WAIT_V(n) asm volatile("s_waitcnt vmcnt(" #n ")" ::: "memory")
#define PG8_WAIT_L(n) asm volatile("s_waitcnt lgkmcnt(" #n ")" ::: "memory")
#define PG8_BAR __builtin_amdgcn_s_barrier()
#define PG8_SCHED __builtin_amdgcn_sched_barrier(0)
    Unit cur, nxt; int ui = 0;
    if (!S.next(0, cur)) return;
    f32x4 acc[2][2][4][2];
#pragma unroll
    for (int a = 0; a < 2; ++a)
#pragma unroll
        for (int b = 0; b < 2; ++b)
#pragma unroll
            for (int m = 0; m < 4; ++m)
#pragma unroll
                for (int n = 0; n < 2; ++n) acc[a][b][m][n] = (f32x4){0.f, 0.f, 0.f, 0.f};
    bf16x8 At[4][2], B0[2][2], B1[2][2];
    unsigned gC0[2], gC1[2], gN0[2], gN1[2];
    if constexpr (GATHER) {
#pragma unroll
        for (int i = 0; i < 2; ++i) { gC0[i] = (unsigned)S.a_row(cur, Rv[i]) * (unsigned)(K * 2) + (unsigned)Cv[i] * 2u; gC1[i] = (unsigned)S.a_row(cur, HALF + Rv[i]) * (unsigned)(K * 2) + (unsigned)Cv[i] * 2u; gN0[i] = gC0[i]; gN1[i] = gC1[i]; }
    }
    const char* cA = GATHER ? (const char*)g.A : (const char*)g.A + (size_t)cur.pm * tstep; const char* cB = (const char*)g.Bt + (size_t)cur.pb * tstep;
#define PG8_STAGE_A(bufoff, p, h, o0, o1) do { if constexpr (GATHER) { if ((h) == 0) PG8_STAGE(bufoff, p, o0); else PG8_STAGE(bufoff, p, o1); } else { PG8_STAGE(bufoff, (p) + (h) * hstep, voffA); } } while (0)
    PG8_STAGE(PG8_SB(0, 0), cB, voffB); PG8_STAGE(PG8_SB(0, 1), cB + hstep, voffB); PG8_STAGE_A(PG8_SA(0, 0), cA, 0, gC0, gC1); PG8_STAGE_A(PG8_SA(0, 1), cA, 1, gC0, gC1);
    if (wr == 1) PG8_BAR;
    PG8_WAIT_V(2); PG8_BAR;
    PG8_STAGE(PG8_SB(1, 0), cB + kstep, voffB); PG8_STAGE_A(PG8_SA(1, 0), cA + kstep, 0, gC0, gC1); PG8_STAGE(PG8_SB(1, 1), cB + hstep + kstep, voffB);
    PG8_WAIT_V(6); PG8_BAR;
    for (;;) {
        const bool has_next = S.next(ui + 1, nxt);
        const char* nA = GATHER ? (const char*)g.A : (has_next ? (const char*)g.A + (size_t)nxt.pm * tstep : cA); const char* nB = has_next ? (const char*)g.Bt + (size_t)nxt.pb * tstep : cB;
        if constexpr (GATHER) { if (has_next) {
#pragma unroll
            for (int i = 0; i < 2; ++i) { gN0[i] = (unsigned)S.a_row(nxt, Rv[i]) * (unsigned)(K * 2) + (unsigned)Cv[i] * 2u; gN1[i] = (unsigned)S.a_row(nxt, HALF + Rv[i]) * (unsigned)(K * 2) + (unsigned)Cv[i] * 2u; } } }
        for (int t = 0; t < nt; t += 2) {
            const bool last = (t == nt - 2);
            const char* a1 = cA + (size_t)(t + 1) * kstep;
            const char* a2 = last ? nA : cA + (size_t)(t + 2) * kstep; const char* b2 = last ? nB : cB + (size_t)(t + 2) * kstep;
            const char* a3 = a2 + kstep; const char* b3 = b2 + kstep;
            unsigned s0[2], s1[2];
            if constexpr (GATHER) { s0[0] = last ? gN0[0] : gC0[0]; s0[1] = last ? gN0[1] : gC0[1]; s1[0] = last ? gN1[0] : gC1[0]; s1[1] = last ? gN1[1] : gC1[1]; }
            PG8_LDB(B0, 0, 0); PG8_LDB(B1, 0, 1); PG8_SCHED; PG8_LDA(At, 0, 0); PG8_STAGE_A(PG8_SA(1, 1), a1, 1, gC0, gC1);
            PG8_WAIT_V(8); PG8_WAIT_L(0); PG8_BAR; PG8_MMA(0, 0, At, B0); PG8_MMA(0, 1, At, B1); PG8_BAR; PG8_SCHED;
            PG8_LDA(At, 0, 1); PG8_STAGE(PG8_SB(0, 0), b2, voffB); PG8_STAGE(PG8_SB(0, 1), b2 + hstep, voffB); PG8_STAGE_A(PG8_SA(0, 0), a2, 0, s0, s1);
            PG8_WAIT_V(8); PG8_WAIT_L(0); PG8_BAR; PG8_MMA(1, 0, At, B0); PG8_MMA(1, 1, At, B1); PG8_BAR; PG8_SCHED;
            PG8_LDB(B0, 1, 0); PG8_LDB(B1, 1, 1); PG8_SCHED; PG8_LDA(At, 1, 0); PG8_STAGE_A(PG8_SA(0, 1), a2, 1, s0, s1);
            PG8_WAIT_V(8); PG8_WAIT_L(0); PG8_BAR; PG8_MMA(0, 0, At, B0); PG8_MMA(0, 1, At, B1); PG8_BAR; PG8_SCHED;
            PG8_LDA(At, 1, 1); PG8_STAGE(PG8_SB(1, 0), b3, voffB); PG8_STAGE(PG8_SB(1, 1), b3 + hstep, voffB); PG8_STAGE_A(PG8_SA(1, 0), a3, 0, s0, s1);
            PG8_WAIT_V(8); PG8_WAIT_L(0); PG8_BAR; PG8_MMA(1, 0, At, B0); PG8_MMA(1, 1, At, B1); PG8_BAR; PG8_SCHED;
        }
        if constexpr (ALIGN_EPI) { if (wr == 0) PG8_BAR; }
        E(acc, cur, wr, wc, fr, fq);
        if (!has_next) break;
#pragma unroll
        for (int a = 0; a < 2; ++a)
#pragma unroll
            for (int b = 0; b < 2; ++b)
#pragma unroll
                for (int m = 0; m < 4; ++m)
#pragma unroll
                    for (int n = 0; n < 2; ++n) acc[a][b][m][n] = (f32x4){0.f, 0.f, 0.f, 0.f};
        cur = nxt; cA = nA; cB = nB; ++ui;
        if constexpr (GATHER) { gC0[0] = gN0[0]; gC0[1] = gN0[1]; gC1[0] = gN1[0]; gC1[1] = gN1[1]; }
        if constexpr (ALIGN_EPI) { if (wr == 1) PG8_BAR; }
    }
    PG8_WAIT_V(0);
    if constexpr (!ALIGN_EPI) { if (wr == 0) PG8_BAR; }
    PG8_BAR;
#undef PG8_SA
#undef PG8_SB
#undef PG8_STAGE
#undef PG8_STAGE_A
#undef PG8_LDA
#undef PG8_LDB
#undef PG8_MMA
#undef PG8_WAIT_V
#undef PG8_WAIT_L
#undef PG8_BAR
#undef PG8_SCHED
}

__device__ __forceinline__ u32x4 pack8(const f32x4& v0, const f32x4& v1) { u32x4 w; w.x = cvt_pk_bf16(v0[0], v0[1]); w.y = cvt_pk_bf16(v0[2], v0[3]); w.z = cvt_pk_bf16(v1[0], v1[1]); w.w = cvt_pk_bf16(v1[2], v1[3]); return w; }
__device__ __forceinline__ void rope4(f32x4& v0, f32x4& v1, const float* cs) {
    const f32x4 a = *(const f32x4*)cs, b = *(const f32x4*)(cs + 4);
    float x1, x2;
    x1 = v0[0]; x2 = v0[1]; v0[0] = x1 * a[0] - x2 * a[1]; v0[1] = x2 * a[0] + x1 * a[1];
    x1 = v0[2]; x2 = v0[3]; v0[2] = x1 * a[2] - x2 * a[3]; v0[3] = x2 * a[2] + x1 * a[3];
    x1 = v1[0]; x2 = v1[1]; v1[0] = x1 * b[0] - x2 * b[1]; v1[1] = x2 * b[0] + x1 * b[1];
    x1 = v1[2]; x2 = v1[3]; v1[2] = x1 * b[2] - x2 * b[3]; v1[3] = x2 * b[2] + x1 * b[3];
}

struct EpiIn {
    static constexpr bool PERM = true;
    bf16_t *qa, *ka, *va, *cq, *ckv, *gates, *kr; const float *ropeA, *ropeM, *bg; float* sq;
    __device__ __forceinline__ void operator()(const f32x4 (&acc)[2][2][4][2], const Unit& u, int wr, int wc, int fr, int fq) const {
        const int pn = u.pn, row0 = u.pm * BM + wr * 64 + fr, cl = wc * 32 + 8 * fq;
        if (pn < 8) {
            bf16_t* dst = pn < 4 ? qa : ka; const int colt = (pn & 3) * 256; const bool rot = ((wc & 1) == 0) && (fq < 2);
#pragma unroll
            for (int ai = 0; ai < 2; ++ai)
#pragma unroll
                for (int m = 0; m < 4; ++m) { const int row = row0 + ai * HALF + m * 16;
#pragma unroll
                    for (int bj = 0; bj < 2; ++bj) { f32x4 v0 = acc[ai][bj][m][0], v1 = acc[ai][bj][m][1];
                        if (rot) rope4(v0, v1, ropeA + (size_t)row * 16 + fq * 8);
                        *(u32x4*)(dst + (size_t)row * 1024 + colt + bj * HALF + cl) = pack8(v0, v1); } }
        } else if (pn < 12) {
            const int colt = (pn - 8) * 256;
#pragma unroll
            for (int ai = 0; ai < 2; ++ai)
#pragma unroll
                for (int m = 0; m < 4; ++m) { const int row = row0 + ai * HALF + m * 16;
#pragma unroll
                    for (int bj = 0; bj < 2; ++bj) *(u32x4*)(va + (size_t)row * 1024 + colt + bj * HALF + cl) = pack8(acc[ai][bj][m][0], acc[ai][bj][m][1]); }
        } else if (pn < 17) {
            const bool isq = pn < 15; bf16_t* dst = isq ? cq : ckv; const int ld = isq ? QL : KVL, colt = (isq ? pn - 12 : pn - 15) * 256, tq = pn - 12;
#pragma unroll
            for (int ai = 0; ai < 2; ++ai)
#pragma unroll
                for (int m = 0; m < 4; ++m) { const int row = row0 + ai * HALF + m * 16; float s = 0.f;
#pragma unroll
                    for (int bj = 0; bj < 2; ++bj) { const f32x4 v0 = acc[ai][bj][m][0], v1 = acc[ai][bj][m][1];
                        s += (v0[0] * v0[0] + v0[1] * v0[1]) + (v0[2] * v0[2] + v0[3] * v0[3]) + (v1[0] * v1[0] + v1[1] * v1[1]) + (v1[2] * v1[2] + v1[3] * v1[3]);
                        *(u32x4*)(dst + (size_t)row * ld + colt + bj * HALF + cl) = pack8(v0, v1); }
                    s += __shfl_xor(s, 16); s += __shfl_xor(s, 32);
                    if (fq == 0) sq[(size_t)row * 20 + tq * 4 + wc] = s; }
        } else if (pn < 25) {
            const int colt = (pn - 17) * 256;
            f32x4 bv[2][2];
#pragma unroll
            for (int bj = 0; bj < 2; ++bj) { bv[bj][0] = *(const f32x4*)(bg + colt + bj * HALF + cl); bv[bj][1] = *(const f32x4*)(bg + colt + bj * HALF + cl + 4); if (DBG_SKIP & 256) { bv[bj][0] = bv[bj][0] * 0.f; bv[bj][1] = bv[bj][1] * 0.f; } }
#pragma unroll
            for (int ai = 0; ai < 2; ++ai)
#pragma unroll
                for (int m = 0; m < 4; ++m) { const int row = row0 + ai * HALF + m * 16;
#pragma unroll
                    for (int bj = 0; bj < 2; ++bj) { f32x4 v0 = acc[ai][bj][m][0] + bv[bj][0], v1 = acc[ai][bj][m][1] + bv[bj][1];
#pragma unroll
                        for (int j = 0; j < 4; ++j) { if (!(DBG_SKIP & 512)) { v0[j] = sigmoidf_(v0[j]); v1[j] = sigmoidf_(v1[j]); } }
                        *(u32x4*)(gates + (size_t)row * 2048 + colt + bj * HALF + cl) = pack8(v0, v1); } }
        } else {
            if (wc < 2) {
#pragma unroll
                for (int ai = 0; ai < 2; ++ai)
#pragma unroll
                    for (int m = 0; m < 4; ++m) { const int row = row0 + ai * HALF + m * 16;
                        f32x4 v0 = acc[ai][0][m][0], v1 = acc[ai][0][m][1];
                        rope4(v0, v1, ropeM + (size_t)row * 64 + (wc * 16 + fq * 4) * 2);
                        *(u32x4*)(kr + (size_t)row * 64 + cl) = pack8(v0, v1); }
            }
        }
    }
};
template <bool ISQ> struct EpiUp {
    static constexpr bool PERM = true;
    bf16_t* out; const float* sq; const float* ropeM;
    __device__ __forceinline__ void operator()(const f32x4 (&acc)[2][2][4][2], const Unit& u, int wr, int wc, int fr, int fq) const {
        const int row0 = u.pm * BM + wr * 64 + fr, cl = wc * 32 + 8 * fq; constexpr int LD = ISQ ? 1536 : 2048;
#pragma unroll
        for (int ai = 0; ai < 2; ++ai)
#pragma unroll
            for (int m = 0; m < 4; ++m) { const int row = row0 + ai * HALF + m * 16; float s;
                if (ISQ) { const f32x4 a = *(const f32x4*)(sq + (size_t)row * 20), b = *(const f32x4*)(sq + (size_t)row * 20 + 4), c = *(const f32x4*)(sq + (size_t)row * 20 + 8);
                    s = ((a[0] + a[1]) + (a[2] + a[3])) + ((b[0] + b[1]) + (b[2] + b[3])) + ((c[0] + c[1]) + (c[2] + c[3])); }
                else { const f32x4 a = *(const f32x4*)(sq + (size_t)row * 20 + 12), b = *(const f32x4*)(sq + (size_t)row * 20 + 16);
                    s = ((a[0] + a[1]) + (a[2] + a[3])) + ((b[0] + b[1]) + (b[2] + b[3])); }
                const float rstd = __builtin_amdgcn_rsqf(s * (ISQ ? 1.0f / QL : 1.0f / KVL) + EPS);
#pragma unroll
                for (int bj = 0; bj < 2; ++bj) { const int col = u.pn * BM + bj * HALF + cl; f32x4 v0 = acc[ai][bj][m][0] * rstd, v1 = acc[ai][bj][m][1] * rstd;
                    if (ISQ) { const int off = col % 192; if (off >= 128) rope4(v0, v1, ropeM + (size_t)row * 64 + (off - 128)); }
                    *(u32x4*)(out + (size_t)row * LD + col) = pack8(v0, v1); } }
    }
};
template <int WHICH> struct EpiGate {
    static constexpr bool PERM = true;
    bf16_t* mrg; const bf16_t* gates;
    __device__ __forceinline__ void operator()(const f32x4 (&acc)[2][2][4][2], const Unit& u, int wr, int wc, int fr, int fq) const {
        const int row0 = u.pm * BM + wr * 64 + fr, cl = wc * 32 + 8 * fq;
#pragma unroll
        for (int ai = 0; ai < 2; ++ai)
#pragma unroll
            for (int m = 0; m < 4; ++m) { const int row = row0 + ai * HALF + m * 16;
#pragma unroll
                for (int bj = 0; bj < 2; ++bj) { const int col = u.pn * BM + bj * HALF + cl;
                    const u32x4 gw = *(const u32x4*)(gates + (size_t)row * 2048 + WHICH * 1024 + col);
                    f32x4 v0 = acc[ai][bj][m][0], v1 = acc[ai][bj][m][1];
                    if ((DBG_SKIP & 8) && WHICH == 0) { v0 = v0 * 0.f; v1 = v1 * 0.f; } if ((DBG_SKIP & 16) && WHICH == 1) { v0 = v0 * 0.f; v1 = v1 * 0.f; }
                    v0[0] *= bf_lo(gw.x); v0[1] *= bf_hi(gw.x); v0[2] *= bf_lo(gw.y); v0[3] *= bf_hi(gw.y); v1[0] *= bf_lo(gw.z); v1[1] *= bf_hi(gw.z); v1[2] *= bf_lo(gw.w); v1[3] *= bf_hi(gw.w);
                    if (WHICH == 1) { const u32x4 tw = *(const u32x4*)(mrg + (size_t)row * 1024 + col);
                        v0[0] += bf_lo(tw.x); v0[1] += bf_hi(tw.x); v0[2] += bf_lo(tw.y); v0[3] += bf_hi(tw.y); v1[0] += bf_lo(tw.z); v1[1] += bf_hi(tw.z); v1[2] += bf_lo(tw.w); v1[3] += bf_hi(tw.w); }
                    *(u32x4*)(mrg + (size_t)row * 1024 + col) = pack8(v0, v1); } }
    }
};
struct EpiRes {
    static constexpr bool PERM = false;
    const float* x; float* out;
    __device__ __forceinline__ void operator()(const f32x4 (&acc)[2][2][4][2], const Unit& u, int wr, int wc, int fr, int fq) const {
        const int row0 = u.pm * BM + wr * 64 + fr, col0 = u.pn * BM + wc * 32 + 4 * fq;
#pragma unroll
        for (int ai = 0; ai < 2; ++ai)
#pragma unroll
            for (int m = 0; m < 4; ++m) { const size_t off = (size_t)(row0 + ai * HALF + m * 16) * 1024 + col0;
#pragma unroll
                for (int bj = 0; bj < 2; ++bj)
#pragma unroll
                    for (int n = 0; n < 2; ++n) *(f32x4*)(out + off + bj * HALF + n * 16) = *(const f32x4*)(x + off + bj * HALF + n * 16) + ((DBG_SKIP & 2) ? 0.f : 1.f) * acc[ai][bj][m][n]; }
    }
};
struct EpiSwiglu {
    static constexpr bool PERM = true;
    bf16_t* act; const float *bgate, *bup;
    __device__ __forceinline__ void operator()(const f32x4 (&acc)[2][2][4][2], const Unit& u, int wr, int wc, int fr, int fq) const {
        const int row0 = u.pm * BM + wr * 64 + fr, f0 = u.pn * HALF + wc * 32 + 8 * fq;
        f32x4 bgv[2], buv[2];
#pragma unroll
        for (int n = 0; n < 2; ++n) { bgv[n] = *(const f32x4*)(bgate + (size_t)u.e * FF + f0 + 4 * n); buv[n] = *(const f32x4*)(bup + (size_t)u.e * FF + f0 + 4 * n); }
#pragma unroll
        for (int ai = 0; ai < 2; ++ai)
#pragma unroll
            for (int m = 0; m < 4; ++m) { const int row = row0 + ai * HALF + m * 16; f32x4 o[2];
#pragma unroll
                for (int n = 0; n < 2; ++n) { const f32x4 gt = acc[ai][0][m][n] + bgv[n], up = acc[ai][1][m][n] + buv[n];
#pragma unroll
                    for (int j = 0; j < 4; ++j) { const float gg = fminf(gt[j], 7.0f), uu = fminf(fmaxf(up[j], -7.0f), 7.0f); o[n][j] = (uu + 1.0f) * (gg * sigmoidf_(1.702f * gg)); } }
                *(u32x4*)(act + (size_t)row * FF + f0) = pack8(o[0], o[1]); }
    }
};
struct EpiDown {
    static constexpr bool PERM = true;
    bf16_t* y; const float* bd;
    __device__ __forceinline__ void operator()(const f32x4 (&acc)[2][2][4][2], const Unit& u, int wr, int wc, int fr, int fq) const {
        const int row0 = u.pm * BM + wr * 64 + fr, cl = wc * 32 + 8 * fq;
        f32x4 bv[2][2];
#pragma unroll
        for (int bj = 0; bj < 2; ++bj) { const int col = u.pn * BM + bj * HALF + cl; bv[bj][0] = *(const f32x4*)(bd + (size_t)u.e * D + col); bv[bj][1] = *(const f32x4*)(bd + (size_t)u.e * D + col + 4); }
#pragma unroll
        for (int ai = 0; ai < 2; ++ai)
#pragma unroll
            for (int m = 0; m < 4; ++m) { const int row = row0 + ai * HALF + m * 16;
#pragma unroll
                for (int bj = 0; bj < 2; ++bj) { const int col = u.pn * BM + bj * HALF + cl;
                    *(u32x4*)(y + (size_t)row * D + col) = pack8(acc[ai][bj][m][0] + bv[bj][0], acc[ai][bj][m][1] + bv[bj][1]); } }
    }
};
}

namespace att {
constexpr int NW = 8, QBLK = 32, KVBLK = 64;
constexpr int SHM_V = KVBLK * 128 * 2;
#define SBAR() __builtin_amdgcn_sched_barrier(0)
#define KSW(row, colB) ((row) * 128 + ((colB) ^ ((((row) >> 1) & 7) << 4)))
__device__ __forceinline__ int crow(int r, int hi) { return (r & 3) + 8 * (r >> 2) + 4 * hi; }
struct Src { const bf16_t* Q; const bf16_t* K; const bf16_t* K2; const bf16_t* V; int ldq, ldk, ldk2, ldv; };

__device__ __forceinline__ void partialSM(f32x16& p0, f32x16& p1, float& m_reg, float& mn, float& alpha, const float C, const float thr) {
  float pmax = p0[0];
#pragma unroll
  for (int r = 1; r < 16; ++r) pmax = fmaxf(pmax, p0[r]);
#pragma unroll
  for (int r = 0; r < 16; ++r) pmax = fmaxf(pmax, p1[r]);
  { auto rr = __builtin_amdgcn_permlane32_swap(__float_as_uint(pmax), __float_as_uint(pmax), false, false);
    pmax = fmaxf(__uint_as_float(rr[0]), __uint_as_float(rr[1])); }
  if (__builtin_expect(__all(pmax - m_reg <= thr), 1)) { mn = m_reg; alpha = 1.f; }
  else { mn = fmaxf(m_reg, pmax); alpha = __builtin_amdgcn_exp2f((m_reg - mn) * C); m_reg = mn; }
  const float mnC = -mn * C;
#pragma unroll
  for (int r = 0; r < 16; ++r) p0[r] = fmaf(p0[r], C, mnC);
#pragma unroll
  for (int r = 0; r < 16; ++r) p1[r] = fmaf(p1[r], C, mnC);
#pragma unroll
  for (int r = 0; r < 16; ++r) p0[r] = __builtin_amdgcn_exp2f(p0[r]);
}
__device__ __forceinline__ void finishSM(f32x16& p0, f32x16& p1, float alpha, float& l_reg, bf16x8& pa0, bf16x8& pa1, bf16x8& pa2, bf16x8& pa3) {
#pragma unroll
  for (int r = 0; r < 16; ++r) p1[r] = __builtin_amdgcn_exp2f(p1[r]);
  float ps = 0;
#pragma unroll
  for (int r = 0; r < 16; ++r) ps += p0[r];
#pragma unroll
  for (int r = 0; r < 16; ++r) ps += p1[r];
  { auto rr = __builtin_amdgcn_permlane32_swap(__float_as_uint(ps), __float_as_uint(ps), false, false);
    ps = __uint_as_float(rr[0]) + __uint_as_float(rr[1]); }
  l_reg = l_reg * alpha + ps;
#define PK4(P, BASE, OUT) do { unsigned a0 = cvt_pk_bf16(P[BASE + 0], P[BASE + 1]), a1 = cvt_pk_bf16(P[BASE + 2], P[BASE + 3]);   \
    unsigned b0 = cvt_pk_bf16(P[BASE + 4], P[BASE + 5]), b1 = cvt_pk_bf16(P[BASE + 6], P[BASE + 7]);                              \
    auto r0 = __builtin_amdgcn_permlane32_swap(a0, b0, false, false); auto r1 = __builtin_amdgcn_permlane32_swap(a1, b1, false, false); \
    u32x4 w = {r0[0], r1[0], r0[1], r1[1]}; OUT = *reinterpret_cast<bf16x8*>(&w); } while (0)
  PK4(p0, 0, pa0); PK4(p0, 8, pa1); PK4(p1, 0, pa2); PK4(p1, 8, pa3);
#undef PK4
}
template <int DQK> __device__ __forceinline__ void qkt(f32x16& p0, f32x16& p1, const LAS char* Ks, const bf16x8* qr, int r32, int hi) {
  p0 = f32x16{}; p1 = f32x16{};
#pragma unroll
  for (int d0 = 0; d0 < DQK / 16; ++d0) { const int sub = d0 >> 2, cb = ((d0 & 3) * 16 + hi * 8) * 2;
    const bf16x8 b0 = *(const LAS bf16x8*)(Ks + sub * 8192 + KSW(r32, cb));
    const bf16x8 b1 = *(const LAS bf16x8*)(Ks + sub * 8192 + KSW(32 + r32, cb));
    p0 = __builtin_amdgcn_mfma_f32_32x32x16_bf16(b0, qr[d0], p0, 0, 0, 0);
    p1 = __builtin_amdgcn_mfma_f32_32x32x16_bf16(b1, qr[d0], p1, 0, 0, 0); }
}
__device__ __forceinline__ int v_st(int k, int c) { const int kk = (k & ~0xC) | ((k & 4) << 1) | ((k & 8) >> 1); return ((kk >> 3) * 4 + (c >> 5)) * 512 + ((kk & 7) * 32 + (c & 31)) * 2; }
__device__ __forceinline__ int v_rd_base(int lane) { return ((lane & 3) << 3) | (((lane >> 2) & 3) << 6) | (((lane >> 4) & 1) << 5) | (((lane >> 5) & 1) << 8); }
constexpr int v_rd_off(int d0, int ks, int half) { return d0 * 512 + ks * 4096 + half * 2048; }
template <int OFF> __device__ __forceinline__ s16x4 tr_read(int vb) {
  s16x4 r; asm volatile("ds_read_b64_tr_b16 %0, %1 offset:%2" : "=&v"(r) : "v"(vb), "i"(OFF) : "memory"); return r;
}
template <int D0> __device__ __forceinline__ void pv_one(f32x16& od, int vb, bf16x8 pa0, bf16x8 pa1, bf16x8 pa2, bf16x8 pa3) {
  const s16x4 l0 = tr_read<v_rd_off(D0, 0, 0)>(vb), h0 = tr_read<v_rd_off(D0, 0, 1)>(vb), l1 = tr_read<v_rd_off(D0, 1, 0)>(vb), h1 = tr_read<v_rd_off(D0, 1, 1)>(vb);
  const s16x4 l2 = tr_read<v_rd_off(D0, 2, 0)>(vb), h2 = tr_read<v_rd_off(D0, 2, 1)>(vb), l3 = tr_read<v_rd_off(D0, 3, 0)>(vb), h3 = tr_read<v_rd_off(D0, 3, 1)>(vb);
  asm volatile("s_waitcnt lgkmcnt(0)" ::: "memory"); SBAR();
#define PK(L, H) (bf16x8){L[0], L[1], L[2], L[3], H[0], H[1], H[2], H[3]}
  od = __builtin_amdgcn_mfma_f32_32x32x16_bf16(pa0, PK(l0, h0), od, 0, 0, 0);
  od = __builtin_amdgcn_mfma_f32_32x32x16_bf16(pa1, PK(l1, h1), od, 0, 0, 0);
  od = __builtin_amdgcn_mfma_f32_32x32x16_bf16(pa2, PK(l2, h2), od, 0, 0, 0);
  od = __builtin_amdgcn_mfma_f32_32x32x16_bf16(pa3, PK(l3, h3), od, 0, 0, 0);
#undef PK
}
__device__ __forceinline__ void pv_d0(f32x16* o, int vb, bf16x8 pa0, bf16x8 pa1, bf16x8 pa2, bf16x8 pa3) {
  pv_one<0>(o[0], vb, pa0, pa1, pa2, pa3); pv_one<1>(o[1], vb, pa0, pa1, pa2, pa3); pv_one<2>(o[2], vb, pa0, pa1, pa2, pa3); pv_one<3>(o[3], vb, pa0, pa1, pa2, pa3);
}
template <int DQK>
__device__ __forceinline__ void attn_core(const Src in, const float C, const float thr, const int seq, LAS char* lds, f32x16 (&o)[4]) {
  constexpr int NSUB = DQK / 64, SHM_K = NSUB * 8192;
  const int tid = threadIdx.x, wid = __builtin_amdgcn_readfirstlane(tid >> 6), lane = tid & 63, r32 = lane & 31, hi = lane >> 5;
  LAS char* V_lds = lds; LAS char* K_lds = lds + 3 * SHM_V;
  LAS float* ws = (LAS float*)(lds + 3 * SHM_V + 3 * SHM_K) + wid * 64; LAS float* li_l = ws; LAS float* al_l = ws + 32;
  float m_reg = -1e30f, l_reg = 0;
#pragma unroll
  for (int d = 0; d < 4; ++d) o[d] = f32x16{};
  bf16x8 qr[DQK / 16];
  const bf16_t* Qw = in.Q + (size_t)(wid * QBLK + r32) * in.ldq + hi * 8;
#pragma unroll
  for (int d0 = 0; d0 < DQK / 16; ++d0) qr[d0] = *(const bf16x8*)(Qw + d0 * 16);
  const int krow = wid * 8 + (lane >> 3), kslot = (lane & 7) ^ ((krow >> 1) & 7);
  const unsigned koff = (unsigned)(krow * in.ldk + kslot * 8) * 2u, k2off = (unsigned)(krow * in.ldk2 + kslot * 8) * 2u;
  unsigned voff[2];
#pragma unroll
  for (int i = 0; i < 2; ++i) { const int p = i * 8192 + wid * 1024 + lane * 16, st = p >> 9, wq = (p & 511) >> 1, kk = (st >> 2) * 8 + (wq >> 5), cl = wq & 31;
    const int k = (kk & ~0xC) | ((kk & 4) << 1) | ((kk & 8) >> 1); voff[i] = (unsigned)(k * in.ldv + (st & 3) * 32 + cl) * 2u; }
  const int vb0 = (int)(unsigned)(size_t)V_lds + v_rd_base(lane);
  const unsigned ldsw = (unsigned)wid * 1024u;
#define GLDS(gp, lp) __builtin_amdgcn_global_load_lds((const unsigned*)(gp), (LAS unsigned*)(lp), 16, 0, 0)
#define ISSUE_K(t, b) do { const char* kb_ = (const char*)in.K + (size_t)(t) * (KVBLK * 2) * in.ldk; \
    _Pragma("unroll") for (int s_ = 0; s_ < NSUB; ++s_) { if (s_ < 2) GLDS(kb_ + s_ * 128 + koff, K_lds + (b) * SHM_K + s_ * 8192 + ldsw); \
      else GLDS((const char*)in.K2 + (size_t)(t) * (KVBLK * 2) * in.ldk2 + k2off, K_lds + (b) * SHM_K + s_ * 8192 + ldsw); } } while (0)
#define ISSUE_V(t, b) do { const char* vb_ = (const char*)in.V + (size_t)(t) * (KVBLK * 2) * in.ldv; \
    GLDS(vb_ + voff[0], V_lds + (b) * SHM_V + ldsw); GLDS(vb_ + voff[1], V_lds + (b) * SHM_V + 8192 + ldsw); } while (0)
#define WAITV(n) asm volatile("s_waitcnt vmcnt(%0)" :: "n"((DBG_SKIP & 4) ? 0 : (n)) : "memory")
#define WBAR() do { asm volatile("" ::: "memory"); __builtin_amdgcn_s_barrier(); asm volatile("" ::: "memory"); } while (0)
#define RESC(a) do { if (__any((a) < 1.f)) { if (hi == 0) al_l[r32] = (a); asm volatile("s_waitcnt lgkmcnt(0)" ::: "memory"); \
    _Pragma("unroll") for (int d = 0; d < 4; ++d) _Pragma("unroll") for (int r = 0; r < 16; ++r) o[d][r] *= al_l[crow(r, hi)]; } } while (0)
#define NXT3(x) ((x) == 2 ? 0 : (x) + 1)
  constexpr int NI = NSUB + 2;
  f32x16 pA0, pA1, pB0, pB1; float mnA, mnB, alA, alB; bf16x8 pa0, pa1, pa2, pa3; const int NT = seq / KVBLK;
  ISSUE_K(0, 0); ISSUE_K(1, 1); ISSUE_V(0, 0);
  WAITV(NI); WBAR();
  ISSUE_K(2, 2); ISSUE_V(1, 1);
  qkt<DQK>(pA0, pA1, K_lds, qr, r32, hi); partialSM(pA0, pA1, m_reg, mnA, alA, C, thr);
  int bq = 1;
  for (int j = 1; j + 1 < NT; j += 2) {
    { const int b1 = NXT3(bq), b2 = NXT3(b1);
      WAITV(NI); WBAR();
      ISSUE_K(j + 2, b2); ISSUE_V(j + 1, b1);
      SBAR(); qkt<DQK>(pB0, pB1, K_lds + bq * SHM_K, qr, r32, hi);
      finishSM(pA0, pA1, alA, l_reg, pa0, pa1, pa2, pa3); SBAR();
      pv_d0(o, vb0 + b2 * SHM_V, pa0, pa1, pa2, pa3); partialSM(pB0, pB1, m_reg, mnB, alB, C, thr);
      RESC(alB); bq = b1; }
    { const int b1 = NXT3(bq), b2 = NXT3(b1);
      WAITV(NI); WBAR();
      if (j + 3 < NT) ISSUE_K(j + 3, b2);
      ISSUE_V(j + 2, b1);
      SBAR(); qkt<DQK>(pA0, pA1, K_lds + bq * SHM_K, qr, r32, hi);
      finishSM(pB0, pB1, alB, l_reg, pa0, pa1, pa2, pa3); SBAR();
      pv_d0(o, vb0 + b2 * SHM_V, pa0, pa1, pa2, pa3); partialSM(pA0, pA1, m_reg, mnA, alA, C, thr);
      RESC(alA); bq = b1; }
  }
  { const int b2 = NXT3(NXT3(bq));
    WAITV(2); WBAR();
    SBAR(); qkt<DQK>(pB0, pB1, K_lds + bq * SHM_K, qr, r32, hi);
    finishSM(pA0, pA1, alA, l_reg, pa0, pa1, pa2, pa3); SBAR();
    pv_d0(o, vb0 + b2 * SHM_V, pa0, pa1, pa2, pa3); partialSM(pB0, pB1, m_reg, mnB, alB, C, thr);
    RESC(alB); }
  WAITV(0); WBAR();
  finishSM(pB0, pB1, alB, l_reg, pa0, pa1, pa2, pa3); SBAR();
  pv_d0(o, vb0 + bq * SHM_V, pa0, pa1, pa2, pa3);
  if (hi == 0) li_l[r32] = l_reg; asm volatile("s_waitcnt lgkmcnt(0)" ::: "memory");
#pragma unroll
  for (int r = 0; r < 16; ++r) { const float rl = __builtin_amdgcn_rcpf(li_l[crow(r, hi)]);
#pragma unroll
    for (int d = 0; d < 4; ++d) o[d][r] *= rl; }
  asm volatile("s_waitcnt lgkmcnt(0)" ::: "memory"); WBAR();
#undef GLDS
#undef ISSUE_K
#undef ISSUE_V
#undef WAITV
#undef WBAR
#undef RESC
#undef NXT3
}
}

constexpr int NWAVES = 8;
struct Args { const void* in[27]; float* out; unsigned char* ws; int ph_lo, ph_hi, li, pad; };

__constant__ float c_invA[8] = {1.0f, 0.19392274474868576f, 0.03760603093086393f, 0.007292664737217109f, 0.001414213562373095f, 0.0002742481756762073f, 5.318295896944988e-05f, 1.031338537721246e-05f};
__constant__ float c_invM[32] = {1.0f, 0.6636012376960885f, 0.44036660267178046f, 0.2922278225730151f, 0.19392274474868576f, 0.12868737343265052f, 0.08539710028576561f, 0.05666962144529105f,
    0.03760603093086393f, 0.024955408670558694f, 0.016560440080994446f, 0.010989528534539826f, 0.007292664737217109f, 0.004839421345719893f, 0.003211445994752591f, 0.0021311195369119653f,
    0.001414213562373095f, 0.0009384738703573802f, 0.000622772421914596f, 0.0004132725499855165f, 0.0002742481756762073f, 0.00018199142881462546f, 0.00012076973741146504f, 8.01429472224798e-05f,
    5.318295896944988e-05f, 3.529227739646723e-05f, 2.341999896140934e-05f, 1.5541540297632344e-05f, 1.031338537721246e-05f, 6.8439753011549275e-06f, 4.5416704806078695e-06f, 3.013858152139171e-06f};

__device__ __forceinline__ int permDA(int i) { return i < 16 ? (i >> 1) + 8 * (i & 1) : i; }
__device__ __forceinline__ int permM(int i) { return (i >> 1) + 32 * (i & 1); }
__device__ __forceinline__ int src_in(int j) {
    if (j < 2048) return (j & ~63) + permDA(j & 63);
    if (j < 4352) return j;
    if (j < 6400) return 4416 + (j - 4352);
    if (j < 6464) return 4352 + permM(j - 6400);
    return -1;
}
__device__ __forceinline__ int src_uq(int j) { const int hd = j / 192, off = j % 192; return off < 128 ? j : hd * 192 + 128 + permM(off - 128); }

__device__ __forceinline__ void tr_item(const float* W, int K, int N, bf16_t* WT, int n0, int k0, int scol, const float* rs, LAS float* scr, int lane) {
#pragma unroll 8
    for (int i = 0; i < 32; ++i) { const int kk = 2 * i + (lane >> 5); float v = 0.f; if (scol >= 0) { v = W[(size_t)(k0 + kk) * N + scol]; if (rs) v *= rs[k0 + kk]; } scr[kk * 33 + (lane & 31)] = v; }
    LDS_WAIT(); asm volatile("" ::: "memory");
    const int c = lane & 7;
#pragma unroll
    for (int j = 0; j < 4; ++j) { const int n = (lane >> 3) + 8 * j; const LAS float* s = scr + (8 * c) * 33 + n;
        u32x4 o; o.x = cvt_pk_bf16(s[0 * 33], s[1 * 33]); o.y = cvt_pk_bf16(s[2 * 33], s[3 * 33]); o.z = cvt_pk_bf16(s[4 * 33], s[5 * 33]); o.w = cvt_pk_bf16(s[6 * 33], s[7 * 33]);
        *(u32x4*)(WT + (size_t)(n0 + n) * K + k0 + 8 * c) = o; }
    LDS_WAIT(); asm volatile("" ::: "memory");
}

__device__ __forceinline__ void cvt_tile64(const float* W, int N, bf16_t* WT, int Kd, int k0, int n0, int drow0, int lane) {
    const int g = lane >> 4, x = lane & 15;
    const float* src = W + (size_t)(k0 + 16 * g) * N + n0 + 4 * x;
    f32x4 v[16];
#pragma unroll
    for (int i = 0; i < 16; ++i) v[i] = __builtin_nontemporal_load((const f32x4*)(src + (size_t)i * N));
#pragma unroll
    for (int j = 0; j < 4; ++j) { u32x4 lo, hi;
        lo.x = cvt_pk_bf16(v[0][j], v[1][j]); lo.y = cvt_pk_bf16(v[2][j], v[3][j]); lo.z = cvt_pk_bf16(v[4][j], v[5][j]); lo.w = cvt_pk_bf16(v[6][j], v[7][j]);
        hi.x = cvt_pk_bf16(v[8][j], v[9][j]); hi.y = cvt_pk_bf16(v[10][j], v[11][j]); hi.z = cvt_pk_bf16(v[12][j], v[13][j]); hi.w = cvt_pk_bf16(v[14][j], v[15][j]);
        bf16_t* d = WT + (size_t)(drow0 + 4 * x + j) * Kd + k0 + 16 * g;
        *(u32x4*)d = lo; *(u32x4*)(d + 8) = hi; }
}

__global__ void __launch_bounds__(NWAVES * 64, 2) fwd(Args args) {
    extern __shared__ __attribute__((aligned(16))) unsigned char lds_raw[];
    LAS unsigned char* lds = (LAS unsigned char*)lds_raw;
    volatile LAS unsigned* MISC = (volatile LAS unsigned*)(lds + MISC_OFF);
    const int tid = threadIdx.x, lane = tid & 63, wave = __builtin_amdgcn_readfirstlane(tid >> 6);
    const int G = gridDim.x, bx = blockIdx.x;
    unsigned char* ws = args.ws;
    unsigned* ctl = (unsigned*)(ws + WS_CTL);
    const int lo = args.ph_lo, hi_ph = args.ph_hi;
    if (tid < 32) MISC[tid] = 0u;
    __syncthreads();
    XcdBarrier bar; bar.bar = ctl + CW_BAR + args.li * XCD_BAR_WORDS; bar.x = 0; bar.st = nullptr;
    if (!MK_PER_PHASE) bar = xcd_barrier_post(ctl + CW_BAR + args.li * XCD_BAR_WORDS, MISC + 8);
#define IN(k) (((PH_MASK >> (k)) & 1) && lo <= (k) && (k) < hi_ph)
#define SEAM(k) do { if (IN(k) && IN((k) + 1)) xcd_barrier(bar); } while (0)
    const int gw = bx * NWAVES + wave, NGW = G * NWAVES;

    const float* x = (const float*)args.in[0]; const int* positions = (const int*)args.in[1];
    bf16_t* Bt_in = (bf16_t*)(ws + WS_BT_IN); bf16_t* Bt_uq = (bf16_t*)(ws + WS_BT_UQ); bf16_t* Bt_ukv = (bf16_t*)(ws + WS_BT_UKV);
    bf16_t* Bt_od = (bf16_t*)(ws + WS_BT_OD); bf16_t* Bt_om = (bf16_t*)(ws + WS_BT_OM); bf16_t* Bt_out = (bf16_t*)(ws + WS_BT_OUT);
    float* ropeA = (float*)(ws + WS_ROPEA); float* ropeM = (float*)(ws + WS_ROPEM); float* sq = (float*)(ws + WS_SQ2);
    bf16_t* hbuf = (bf16_t*)(ws + WS_H); bf16_t* oa = hbuf;
    bf16_t* qa = (bf16_t*)(ws + WS_QA); bf16_t* ka = (bf16_t*)(ws + WS_KA); bf16_t* va = (bf16_t*)(ws + WS_VA);
    bf16_t* cq = (bf16_t*)(ws + WS_CQ); bf16_t* ckv = (bf16_t*)(ws + WS_CKV); bf16_t* kr = (bf16_t*)(ws + WS_KR);
    bf16_t* gates = (bf16_t*)(ws + WS_GATES); bf16_t* qm = (bf16_t*)(ws + WS_QM); bf16_t* kv = (bf16_t*)(ws + WS_KV);
    bf16_t* ob = (bf16_t*)(ws + WS_OB); bf16_t* mrg = (bf16_t*)(ws + WS_MRG); float* stash = (float*)(ws + WS_STASH);
    int* rowtok = (int*)(ws + WS_ROWTOK); u32x2* assign = (u32x2*)(ws + WS_ASSIGN);
    bf16_t* Bt_d = (bf16_t*)(ws + WS_BT_D); bf16_t* Bt_gu = (bf16_t*)(ws + WS_BT_GU); bf16_t* h2 = (bf16_t*)(ws + WS_H2);
    bf16_t* act = (bf16_t*)(ws + WS_ACT); bf16_t* ybuf = (bf16_t*)(ws + WS_Y);
    unsigned* count = ctl + CW_COUNT;

    if (IN(0)) {
        LAS float* scr = (LAS float*)(lds + wave * 16384);
        const float* w_in = (const float*)args.in[3]; const float* g_q = (const float*)args.in[9]; const float* g_kv = (const float*)args.in[10];
        const float* w_uq = (const float*)args.in[11]; const float* w_ukv = (const float*)args.in[12];
        const float* w_od = (const float*)args.in[13]; const float* w_om = (const float*)args.in[14]; const float* w_out = (const float*)args.in[16];
        constexpr int I_IN = 16 * (N_IN / 32), I_UQ = (QL / 64) * (1536 / 32), I_UKV = (KVL / 64) * (2048 / 32), I_O = 16 * 32;
        constexpr int NITEMS = I_IN + I_UQ + I_UKV + 3 * I_O;
        for (int it = gw; it < NITEMS; it += NGW) {
            int r = it; const int li = lane & 31;
            if (r < I_IN) { const int nblk = N_IN / 32, kb = r / nblk, nb = r % nblk; tr_item(w_in, D, 6464, Bt_in, nb * 32, kb * 64, src_in(nb * 32 + li), nullptr, scr, lane); continue; } r -= I_IN;
            if (r < I_UQ) { const int nblk = 1536 / 32, kb = r / nblk, nb = r % nblk; tr_item(w_uq, QL, 1536, Bt_uq, nb * 32, kb * 64, src_uq(nb * 32 + li), g_q, scr, lane); continue; } r -= I_UQ;
            if (r < I_UKV) { const int nblk = 2048 / 32, kb = r / nblk, nb = r % nblk; tr_item(w_ukv, KVL, 2048, Bt_ukv, nb * 32, kb * 64, nb * 32 + li, g_kv, scr, lane); continue; } r -= I_UKV;
            const int which = r / I_O; r -= which * I_O; const int kb = r / 32, nb = r % 32;
            tr_item(which == 0 ? w_od : (which == 1 ? w_om : w_out), D, D, which == 0 ? Bt_od : (which == 1 ? Bt_om : Bt_out), nb * 32, kb * 64, nb * 32 + li, nullptr, scr, lane);
        }
        const float* g_mix = (const float*)args.in[2];
        for (int m = gw; m < T; m += NGW) {
            const f32x4* xr = (const f32x4*)(x + (size_t)m * D) + lane; f32x4 v[4]; float s = 0.f;
#pragma unroll
            for (int j = 0; j < 4; ++j) { v[j] = xr[64 * j]; s += (v[j][0] * v[j][0] + v[j][1] * v[j][1]) + (v[j][2] * v[j][2] + v[j][3] * v[j][3]); }
            const float rstd = __builtin_amdgcn_rsqf(wave_sum(s) * (1.f / D) + EPS);
            u32x2* o8 = (u32x2*)(hbuf + (size_t)m * D) + lane;
#pragma unroll
            for (int j = 0; j < 4; ++j) { const f32x4 gg = *((const f32x4*)g_mix + lane + 64 * j); u32x2 w; w.x = cvt_pk_bf16(v[j][0] * rstd * gg[0], v[j][1] * rstd * gg[1]); w.y = cvt_pk_bf16(v[j][2] * rstd * gg[2], v[j][3] * rstd * gg[3]); o8[64 * j] = w; }
        }
        for (int idx = bx * 512 + tid; idx < T * 40; idx += G * 512) {
            const int t = idx / 40, i = idx % 40; const float inv = i < 8 ? c_invA[i] : c_invM[i - 8];
            const float ang = (float)positions[t] * inv;
            const double rev = (double)ang * 0.15915494309189535; const float fr_ = (float)(rev - __builtin_rint(rev));
            const float cs = __builtin_amdgcn_cosf(fr_), sn = __builtin_amdgcn_sinf(fr_);
            float* dst = i < 8 ? ropeA + ((size_t)t * 8 + i) * 2 : ropeM + ((size_t)t * 32 + (i - 8)) * 2; dst[0] = cs; dst[1] = sn;
        }
    }
    SEAM(0);
    if (IN(1)) {
        pg8::Gemm g{hbuf, Bt_in, D}; pg8::DenseOrder S; S.init(T / 256, N_IN / 256, G, bx);
        pg8::EpiIn E{qa, ka, va, cq, ckv, gates, kr, ropeA, ropeM, (const float*)args.in[15], sq};
        pg8::gemm_phase<pg8::EpiIn, pg8::DenseOrder, false, true>(lds, g, S, E);
    }
    SEAM(1);
    if (IN(2)) {
        { pg8::Gemm g{cq, Bt_uq, QL}; pg8::DenseOrder S; S.init(T / 256, 1536 / 256, G, bx); pg8::EpiUp<true> E{qm, sq, ropeM};
          pg8::gemm_phase<pg8::EpiUp<true>, pg8::DenseOrder, false, true>(lds, g, S, E); }
        { pg8::Gemm g{ckv, Bt_ukv, KVL}; pg8::DenseOrder S; S.init(T / 256, 2048 / 256, G, G - 1 - bx); pg8::EpiUp<false> E{kv, sq, ropeM};
          pg8::gemm_phase<pg8::EpiUp<false>, pg8::DenseOrder, false, true>(lds, g, S, E); }
    }
    SEAM(2);
    if (IN(3)) {
        const int wid = tid >> 6, r32 = lane & 31, hi = lane >> 5;
        float lam;
        { const float* lq1 = (const float*)args.in[4]; const float* lk1 = (const float*)args.in[5]; const float* lq2 = (const float*)args.in[6]; const float* lk2 = (const float*)args.in[7];
          const float s1 = wave_sum(lq1[lane] * lk1[lane]), s2 = wave_sum(lq2[lane] * lk2[lane]); lam = __expf(s1) - __expf(s2) + LAM_INIT; }
        const float* g_sub = (const float*)args.in[8];
        float gs[4];
#pragma unroll
        for (int d = 0; d < 4; ++d) gs[d] = g_sub[d * 32 + r32] * (1.0f - LAM_INIT);
        for (int L = bx; L < 1024; L += G) {
            const int typ = L >> 9; int u = L & 511;
            if (G == 256) { const int c = L & 255; u = (L & 256) + (c & 7) * 32 + (c >> 3); }
            const int bh = u >> 4, qb = u & 15, b = bh >> 3, h = bh & 7;
            const size_t q0 = (size_t)b * SEQ + qb * 256, k0 = (size_t)b * SEQ;
            f32x16 o[4];
            if (typ == 0 && (DBG_SKIP & 32)) {
                for (int i = tid; i < 256 * 128; i += 512) { const size_t a = (q0 + (i >> 7)) * 1024 + h * 128 + (i & 127);
                    const float v = (DBG_SKIP & 64) ? x[a] : __uint_as_float((unsigned)qa[a] << 16) + __uint_as_float((unsigned)ka[a] << 16) + __uint_as_float((unsigned)va[a] << 16);
                    oa[a] = (bf16_t)(cvt_pk_bf16(v, 0.f) & 0xffffu); }
            } else
            if (typ == 0 && (ATT_MASK & 1)) {
                f32x4* st = (f32x4*)(stash + ((size_t)(bx * 8 + wid) * 64 + lane) * 64);
                { att::Src in{qa + q0 * 1024 + h * 128, ka + k0 * 1024 + h * 128, nullptr, va + k0 * 1024 + h * 128, 1024, 1024, 0, 1024};
                  att::attn_core<64>(in, 0.125f * 1.4426950408889634f, 8.f / 0.125f, SEQ, (LAS char*)lds, o); }
#pragma unroll
                for (int d = 0; d < 4; ++d)
#pragma unroll
                    for (int q4 = 0; q4 < 4; ++q4) st[d * 4 + q4] = (f32x4){o[d][4 * q4], o[d][4 * q4 + 1], o[d][4 * q4 + 2], o[d][4 * q4 + 3]};
                { att::Src in{qa + q0 * 1024 + h * 128 + 64, ka + k0 * 1024 + h * 128 + 64, nullptr, va + k0 * 1024 + h * 128, 1024, 1024, 0, 1024};
                  att::attn_core<64>(in, 0.125f * 1.4426950408889634f, 8.f / 0.125f, SEQ, (LAS char*)lds, o); }
                asm volatile("" : "+v"(st) :: "memory");
                float ss[16];
#pragma unroll
                for (int r = 0; r < 16; ++r) ss[r] = 0.f;
#pragma unroll
                for (int d = 0; d < 4; ++d) {
#pragma unroll
                    for (int q4 = 0; q4 < 4; ++q4) { const f32x4 sv = st[d * 4 + q4];
#pragma unroll
                        for (int j = 0; j < 4; ++j) { const int r = 4 * q4 + j; const float v = sv[j] - lam * o[d][r]; o[d][r] = v; ss[r] += v * v; } }
                    asm volatile("" ::: "memory"); }
#pragma unroll
                for (int r = 0; r < 16; ++r) {
#pragma unroll
                    for (int msk = 1; msk < 32; msk <<= 1) ss[r] += __shfl_xor(ss[r], msk);
                    ss[r] = __builtin_amdgcn_rsqf(ss[r] * (1.0f / 128.0f) + EPS); }
                bf16_t* Ow = oa + (q0 + wid * 32) * 1024 + h * 128 + r32; asm volatile("" : "+v"(Ow));
#pragma unroll
                for (int r = 0; r < 16; ++r) { const int orow = att::crow(r, hi);
#pragma unroll
                    for (int d = 0; d < 4; ++d) Ow[(size_t)orow * 1024 + d * 32] = (bf16_t)(cvt_pk_bf16(o[d][r] * ss[r] * gs[d], 0.f) & 0xffffu); }
            } else if (ATT_MASK & 2) {
                { att::Src in{qm + q0 * 1536 + h * 192, kv + k0 * 2048 + h * 256, kr + k0 * 64, kv + k0 * 2048 + h * 256 + 128, 1536, 2048, 64, 2048};
                  att::attn_core<192>(in, 0.07216878364870322f * 1.4426950408889634f, 8.f / 0.07216878364870322f, SEQ, (LAS char*)lds, o); }
                bf16_t* Ow = ob + (q0 + wid * 32) * 1024 + h * 128 + r32; asm volatile("" : "+v"(Ow));
#pragma unroll
                for (int r = 0; r < 16; ++r) { const int orow = att::crow(r, hi);
#pragma unroll
                    for (int d = 0; d < 4; ++d) Ow[(size_t)orow * 1024 + d * 32] = (bf16_t)(cvt_pk_bf16(o[d][r], 0.f) & 0xffffu); }
            }
        }
    }
    SEAM(3);
    if (IN(4)) {
        { pg8::Gemm g{oa, Bt_od, D}; pg8::DenseOrder S; S.init(T / 256, 4, G, bx); pg8::EpiGate<0> E{mrg, gates};
          pg8::gemm_phase<pg8::EpiGate<0>, pg8::DenseOrder, false, true>(lds, g, S, E); }
        VM_WAIT(); __syncthreads();
        { pg8::Gemm g{ob, Bt_om, D}; pg8::DenseOrder S; S.init(T / 256, 4, G, bx); pg8::EpiGate<1> E{mrg, gates};
          pg8::gemm_phase<pg8::EpiGate<1>, pg8::DenseOrder, false, true>(lds, g, S, E); }
    }
    SEAM(4);
    if (IN(5)) {
        pg8::Gemm g{mrg, Bt_out, D}; pg8::DenseOrder S; S.init(T / 256, 4, G, bx); pg8::EpiRes E{x, args.out};
        pg8::gemm_phase<pg8::EpiRes, pg8::DenseOrder, false, true>(lds, g, S, E);
    }
    SEAM(5);
    if (IN(6)) {
        const float* g_ffn = (const float*)args.in[17]; const float* w_router = (const float*)args.in[18]; const float* b_router = (const float*)args.in[19];
        LAS float* wr_l = (LAS float*)lds;
        LAS int* lcount = (LAS int*)(lds + TAB_OFF); LAS int* gbase = lcount + 32; LAS unsigned* asg_e = (LAS unsigned*)(lcount + 64); LAS float* asg_w = (LAS float*)(lcount + 64 + 256);
        for (int i = tid; i < D * NEXP; i += 512) { const int e = i >> 10, d = i & 1023; wr_l[i] = w_router[d * NEXP + e]; }
        const int ex = (lane >> 1) & 31;
        LAS float* lg = (LAS float*)(lds + TAB_OFF + 4096) + wave * 80;
        const float my_b = b_router[ex];
        for (int chunk = bx; chunk < T / 64; chunk += G) {
            if (tid < 32) lcount[tid] = 0;
            __syncthreads();
#pragma unroll 1
            for (int j2 = 0; j2 < 4; ++j2) {
                const int tl = wave * 8 + j2 * 2, t = chunk * 64 + tl;
                f32x4 va[4], vb[4]; float sa = 0.f, sb = 0.f;
                { const f32x4* xa = (const f32x4*)(args.out + (size_t)t * D) + lane; const f32x4* xb = xa + D / 4;
#pragma unroll
                  for (int j = 0; j < 4; ++j) { va[j] = xa[64 * j]; vb[j] = xb[64 * j]; }
#pragma unroll
                  for (int j = 0; j < 4; ++j) { sa += (va[j][0] * va[j][0] + va[j][1] * va[j][1]) + (va[j][2] * va[j][2] + va[j][3] * va[j][3]); sb += (vb[j][0] * vb[j][0] + vb[j][1] * vb[j][1]) + (vb[j][2] * vb[j][2] + vb[j][3] * vb[j][3]); } }
                const float ra = __builtin_amdgcn_rsqf(wave_sum(sa) * (1.f / D) + EPS), rb = __builtin_amdgcn_rsqf(wave_sum(sb) * (1.f / D) + EPS);
                { u32x2* oa8 = (u32x2*)(h2 + (size_t)t * D) + lane; u32x2* ob8 = oa8 + D / 4;
#pragma unroll
                  for (int j = 0; j < 4; ++j) { const f32x4 gg = *((const f32x4*)g_ffn + lane + 64 * j); va[j] = va[j] * ra * gg; vb[j] = vb[j] * rb * gg;
                    u32x2 w; w.x = cvt_pk_bf16(va[j][0], va[j][1]); w.y = cvt_pk_bf16(va[j][2], va[j][3]); oa8[64 * j] = w;
                    w.x = cvt_pk_bf16(vb[j][0], vb[j][1]); w.y = cvt_pk_bf16(vb[j][2], vb[j][3]); ob8[64 * j] = w; } }
                float aa[32], ab[32];
#pragma unroll
                for (int e = 0; e < NEXP; ++e) { float a = 0.f, b = 0.f;
#pragma unroll
                    for (int j = 0; j < 4; ++j) { const f32x4 w4 = *(const LAS f32x4*)(wr_l + e * 1024 + 4 * lane + 256 * j);
                        a += (va[j][0] * w4[0] + va[j][1] * w4[1]) + (va[j][2] * w4[2] + va[j][3] * w4[3]); b += (vb[j][0] * w4[0] + vb[j][1] * w4[1]) + (vb[j][2] * w4[2] + vb[j][3] * w4[3]); }
                    aa[e] = a; ab[e] = b; }
#define TRED(arr, n, msk) _Pragma("unroll") for (int i_ = 0; i_ < (n); ++i_) { const bool up_ = (lane & (msk)) != 0; const float keep_ = up_ ? arr[(n) + i_] : arr[i_], give_ = up_ ? arr[i_] : arr[(n) + i_]; arr[i_] = keep_ + __shfl_xor(give_, (msk)); }
                TRED(aa, 16, 32) TRED(aa, 8, 16) TRED(aa, 4, 8) TRED(aa, 2, 4) TRED(aa, 1, 2)
                TRED(ab, 16, 32) TRED(ab, 8, 16) TRED(ab, 4, 8) TRED(ab, 2, 4) TRED(ab, 1, 2)
#undef TRED
                const float la = aa[0] + __shfl_xor(aa[0], 1) + my_b, lb = ab[0] + __shfl_xor(ab[0], 1) + my_b;
#pragma unroll
                for (int tk = 0; tk < 2; ++tk) {
                    const float v = tk ? lb : la; int rank = 0;
                    if (!(lane & 1)) lg[tk * 32 + ex] = v;
                    LDS_WAIT();
#pragma unroll
                    for (int q = 0; q < 8; ++q) { const f32x4 s4 = *(const LAS f32x4*)(lg + tk * 32 + 4 * q);
#pragma unroll
                        for (int jj = 0; jj < 4; ++jj) rank += (s4[jj] > v || (s4[jj] == v && (4 * q + jj) < ex)) ? 1 : 0; }
                    if (rank < 4 && !(lane & 1)) lg[64 + tk * 4 + rank] = v;
                    LDS_WAIT();
                    const f32x4 tv = *(const LAS f32x4*)(lg + 64 + tk * 4);
                    const float p1 = __expf(tv[1] - tv[0]), p2 = __expf(tv[2] - tv[0]), p3 = __expf(tv[3] - tv[0]), inv = 1.0f / (1.0f + p1 + p2 + p3);
                    if (rank < 4 && !(lane & 1)) { const float w = (rank == 0 ? 1.0f : (rank == 1 ? p1 : (rank == 2 ? p2 : p3))) * inv;
                        const int lr = __hip_atomic_fetch_add((LAS int*)&lcount[ex], 1, __ATOMIC_RELAXED, __HIP_MEMORY_SCOPE_WORKGROUP);
                        asg_e[(tl + tk) * 4 + rank] = ((unsigned)ex << 16) | (unsigned)lr; asg_w[(tl + tk) * 4 + rank] = w; }
                }
            }
            __syncthreads();
            if (tid < 32) gbase[tid] = (int)__hip_atomic_fetch_add(count + tid, (unsigned)lcount[tid], __ATOMIC_RELAXED, __HIP_MEMORY_SCOPE_AGENT);
            __syncthreads();
            if (tid < 256) { const unsigned ae = asg_e[tid]; const int e = ae >> 16, rank = gbase[e] + (int)(ae & 0xffffu); const int t = chunk * 64 + (tid >> 2);
                rowtok[e * T + rank] = t; u32x2 a; a.x = ((unsigned)e << 16) | (unsigned)rank; a.y = __float_as_uint(asg_w[tid]); assign[(size_t)t * 4 + (tid & 3)] = a; }
            __syncthreads();
        }
        const float* w_gate = (const float*)args.in[20]; const float* w_up = (const float*)args.in[22]; const float* w_down = (const float*)args.in[24];
        for (int it = gw; it < NEXP * 768; it += NGW) {
            const int e = it / 768, r = it % 768, mat = r >> 8, kb = (r >> 4) & 15, nb = r & 15, f0 = nb * 64;
            if (mat < 2) cvt_tile64((mat ? w_up : w_gate) + (size_t)e * D * FF, FF, Bt_gu + (size_t)e * 2048 * D, D, kb * 64, f0, 256 * (f0 >> 7) + mat * 128 + (f0 & 127), lane);
            else cvt_tile64(w_down + (size_t)e * FF * D, D, Bt_d + (size_t)e * D * FF, FF, kb * 64, f0, f0, lane);
        }
    }
    SEAM(6);
    LAS int* t_cnt = (LAS int*)(lds + TAB_OFF + 4096); LAS int* t_start = t_cnt + 32; LAS int* t_t2e = t_start + 40;
    if (IN(7) || IN(8) || IN(9)) {
        __syncthreads();
        if (tid < 32) t_cnt[tid] = (int)__hip_atomic_load(count + tid, __ATOMIC_RELAXED, __HIP_MEMORY_SCOPE_AGENT);
        __syncthreads();
        if (tid == 0) { int s = 0; for (int e = 0; e < NEXP; ++e) { t_start[e] = s; s += (t_cnt[e] + 255) >> 8; } t_start[32] = s; }
        __syncthreads();
        if (tid < 32) { for (int rt = t_start[tid]; rt < t_start[tid + 1]; ++rt) t_t2e[rt] = tid; }
        __syncthreads();
    }
    if (IN(7)) {
        pg8::Gemm g{h2, Bt_gu, D}; pg8::MoeOrder S; S.init(t_start[32], 8, G, bx); S.t2e = t_t2e; S.tstart = t_start; S.cnt = t_cnt; S.rowtok = rowtok;
        pg8::EpiSwiglu E{act, (const float*)args.in[21], (const float*)args.in[23]};
        pg8::gemm_phase<pg8::EpiSwiglu, pg8::MoeOrder, true, true>(lds, g, S, E);
    }
    SEAM(7);
    if (IN(8)) {
        pg8::Gemm g{act, Bt_d, FF}; pg8::MoeOrder S; S.init(t_start[32], 4, G, bx); S.t2e = t_t2e; S.tstart = t_start; S.cnt = t_cnt; S.rowtok = rowtok;
        pg8::EpiDown E{ybuf, (const float*)args.in[25]};
        pg8::gemm_phase<pg8::EpiDown, pg8::MoeOrder, false, true>(lds, g, S, E);
    }
    SEAM(8);
    if (IN(9) && DBG_OUT) {
        const bf16_t* src = DBG_OUT == 1 ? gates : DBG_OUT == 2 ? gates + 1024 : DBG_OUT == 3 ? qa : DBG_OUT == 4 ? ka : DBG_OUT == 5 ? va : DBG_OUT == 6 ? mrg : DBG_OUT == 7 ? oa : DBG_OUT == 9 ? Bt_in : ob;
        const int ld = DBG_OUT <= 2 ? 2048 : 1024;
        for (size_t i = (size_t)bx * 512 + tid; i < (size_t)T * 1024; i += (size_t)G * 512) args.out[i] = (DBG_OUT == 9 && i >= (size_t)N_IN * 1024) ? 0.f : __uint_as_float((unsigned)src[(i >> 10) * ld + (i & 1023)] << 16);
    } else
    if (IN(9)) {
        const float* g_fin = (const float*)args.in[26];
        for (int t = gw; t < T; t += NGW) {
            f32x4* xr = (f32x4*)(args.out + (size_t)t * D) + lane; f32x4 v[4];
#pragma unroll
            for (int j = 0; j < 4; ++j) v[j] = xr[64 * j];
#pragma unroll
            for (int k = 0; k < ((DBG_SKIP & 1) ? 0 : 4); ++k) { const u32x2 a = assign[(size_t)t * 4 + k]; const int e = a.x >> 16, rank = a.x & 0xffffu; const float w = __uint_as_float(a.y);
                const u32x2* yr = (const u32x2*)(ybuf + ((size_t)t_start[e] * 256 + rank) * D) + lane;
#pragma unroll
                for (int j = 0; j < 4; ++j) { const u32x2 yw = yr[64 * j]; v[j][0] += w * bf_lo(yw.x); v[j][1] += w * bf_hi(yw.x); v[j][2] += w * bf_lo(yw.y); v[j][3] += w * bf_hi(yw.y); } }
            float s = 0.f;
#pragma unroll
            for (int j = 0; j < 4; ++j) s += (v[j][0] * v[j][0] + v[j][1] * v[j][1]) + (v[j][2] * v[j][2] + v[j][3] * v[j][3]);
            const float rstd = __builtin_amdgcn_rsqf(wave_sum(s) * (1.f / D) + EPS);
#pragma unroll
            for (int j = 0; j < 4; ++j) { const f32x4 gg = *((const f32x4*)g_fin + lane + 64 * j); xr[64 * j] = v[j] * rstd * gg; }
        }
    }
#undef IN
#undef SEAM
}

extern "C" void kernel_launch(void* const* d_in, const int* in_sizes, int n_in, void* d_out, int out_size, void* d_ws, size_t ws_size, hipStream_t stream) {
    static int grid = 0;
    if (grid == 0) {
        if (n_in != 27 || in_sizes[0] != T * D || out_size != T * D || ws_size < WS_END) { fprintf(stderr, "kernel_launch: unexpected shapes (n_in %d, in0 %d, out %d, ws %zu < %zu)\n", n_in, n_in > 0 ? in_sizes[0] : -1, out_size, ws_size, (size_t)WS_END); grid = -1; return; }
        int dev = 0, cus = 0, per_cu = 0;
        if (hipGetDevice(&dev) != hipSuccess || hipDeviceGetAttribute(&cus, hipDeviceAttributeMultiprocessorCount, dev) != hipSuccess) { grid = -1; return; }
        if (hipFuncSetAttribute((const void*)fwd, hipFuncAttributeMaxDynamicSharedMemorySize, LDS_BYTES) != hipSuccess) { fprintf(stderr, "kernel_launch: hipFuncSetAttribute failed\n"); grid = -1; return; }
        if (hipOccupancyMaxActiveBlocksPerMultiprocessor(&per_cu, (const void*)fwd, NWAVES * 64, LDS_BYTES) != hipSuccess || per_cu < 1) fprintf(stderr, "kernel_launch: occupancy query says %d\n", per_cu);
        (void)hipGetLastError();
        grid = cus;
    }
    if (grid < 0) return;
    if (hipMemsetAsync((char*)d_ws + WS_CTL, 0, CTL_ZERO_BYTES, stream) != hipSuccess) return;
    Args a{};
    for (int i = 0; i < 27; ++i) a.in[i] = d_in[i];
    a.out = (float*)d_out; a.ws = (unsigned char*)d_ws;
#if MK_PER_PHASE
    for (int p = 0; p < NPHASE; ++p) { a.ph_lo = p; a.ph_hi = p + 1; hipLaunchKernelGGL(fwd, dim3(grid), dim3(NWAVES * 64), LDS_BYTES, stream, a); }
#elif PROBE_PHASE >= 0
    a.ph_lo = 0; a.ph_hi = PROBE_PHASE + 1; a.li = 0; hipLaunchKernelGGL(fwd, dim3(grid), dim3(NWAVES * 64), LDS_BYTES, stream, a);
    a.ph_lo = PROBE_PHASE; a.ph_hi = NPHASE; a.li = 1; hipLaunchKernelGGL(fwd, dim3(grid), dim3(NWAVES * 64), LDS_BYTES, stream, a);
#else
    a.ph_lo = 0; a.ph_hi = NPHASE; hipLaunchKernelGGL(fwd, dim3(grid), dim3(NWAVES * 64), LDS_BYTES, stream, a);
#endif
}
```

```cpp
#include <hip/hip_runtime.h>
#include <cstdio>
#include <cstdint>

#ifndef MK_PER_PHASE
#define MK_PER_PHASE 0
#endif

#ifndef PROBE_PHASE
#define PROBE_PHASE -1
#endif
#ifndef ATT_DUP
#define ATT_DUP 0
#endif
#ifndef DBG_OUT
#define DBG_OUT 0
#endif
#ifndef DBG_SKIP
#define DBG_SKIP 0
#endif
#ifndef ATT_MASK
#define ATT_MASK 3
#endif
#ifndef PH_MASK
#define PH_MASK 0x3ff
#endif
#define LAS __attribute__((address_space(3)))
#define GAS __attribute__((address_space(1)))
typedef unsigned short bf16_t;
typedef short bf16x8 __attribute__((ext_vector_type(8)));
typedef short s16x4 __attribute__((ext_vector_type(4)));
typedef float f32x2 __attribute__((ext_vector_type(2)));
typedef float f32x4 __attribute__((ext_vector_type(4)));
typedef float f32x16 __attribute__((ext_vector_type(16)));
typedef unsigned u32x2 __attribute__((ext_vector_type(2)));
typedef unsigned u32x4 __attribute__((ext_vector_type(4)));

constexpr int NB = 4, SEQ = 4096, T = NB * SEQ, D = 1024;
constexpr int NEXP = 32, TOPK = 4, FF = 1024;
constexpr int N_IN = 6656;
constexpr int QL = 768, KVL = 512;
constexpr float EPS = 1e-6f;
constexpr float LAM_INIT = 0.2f;
constexpr int NPHASE = 10;

constexpr size_t MiB = 1u << 20;
constexpr size_t WS_CTL = 0, CTL_ZERO_BYTES = 1 * MiB;
constexpr size_t WS_BT_IN = 2 * MiB;
constexpr size_t WS_BT_UQ = 15 * MiB;
constexpr size_t WS_BT_UKV = 18 * MiB;
constexpr size_t WS_BT_OD = 20 * MiB, WS_BT_OM = 22 * MiB, WS_BT_OUT = 24 * MiB;
constexpr size_t WS_ROPEA = 26 * MiB;
constexpr size_t WS_ROPEM = 27 * MiB;
constexpr size_t WS_SQ = 31 * MiB;
constexpr size_t WS_SQP = 1 * MiB;
constexpr size_t WS_H = 32 * MiB;
constexpr size_t WS_QA = 64 * MiB, WS_KA = 96 * MiB, WS_VA = 128 * MiB;
constexpr size_t WS_CQ = 160 * MiB, WS_CKV = 184 * MiB, WS_KR = 200 * MiB;
constexpr size_t WS_SQ2 = 202 * MiB;
constexpr size_t WS_GATES = 208 * MiB;
constexpr size_t WS_QM = 272 * MiB;
constexpr size_t WS_KV = 320 * MiB;
constexpr size_t WS_OB = 384 * MiB;
constexpr size_t WS_MRG = 416 * MiB;
constexpr size_t WS_STASH = 448 * MiB;
constexpr size_t WS_ROWTOK = 2 * MiB;
constexpr size_t WS_ASSIGN = 4 * MiB;
constexpr size_t WS_BT_D = 32 * MiB;
constexpr size_t WS_BT_GU = 96 * MiB;
constexpr size_t WS_H2 = 224 * MiB;
constexpr size_t WS_ACT = 256 * MiB;
constexpr size_t WS_Y = 96 * MiB;
constexpr size_t WS_END = 512 * MiB;
constexpr int CW_COUNT = 64;
constexpr int CW_BAR = 4096;

constexpr int RING_BYTES = 131072;
constexpr int TAB_OFF = RING_BYTES;
constexpr int TAB_BYTES = 8192;
constexpr int MISC_OFF = TAB_OFF + TAB_BYTES;
constexpr int LDS_BYTES = 147456;

typedef __bf16 bf16x2_t __attribute__((ext_vector_type(2)));
__device__ __forceinline__ unsigned cvt_pk_bf16(float lo, float hi) { const f32x2 v = {lo, hi}; return __builtin_bit_cast(unsigned, __builtin_convertvector(v, bf16x2_t)); }
__device__ __forceinline__ float bf_lo(unsigned w) { return __uint_as_float(w << 16); }
__device__ __forceinline__ float bf_hi(unsigned w) { return __uint_as_float(w & 0xffff0000u); }
__device__ __forceinline__ float wave_sum(float v) {
#pragma unroll
    for (int o = 1; o < 64; o <<= 1) v += __shfl_xor(v, o);
    return v;
}
__device__ __forceinline__ float sigmoidf_(float x) { return __builtin_amdgcn_rcpf(1.0f + __builtin_amdgcn_exp2f(-1.4426950408889634f * x)); }
#define LDS_WAIT() asm volatile("s_waitcnt lgkmcnt(0)" ::: "memory")
#define VM_WAIT() asm volatile("s_waitcnt vmcnt(0)" ::: "memory")

#define XB_TMO      128
#define XB_XCNT(j)  (256  + 64 * (j))
#define XB_XSUB(j)  (1280 + 64 * (j))
#define XB_XGEN(j)  (2304 + 64 * (j))
#define XB_TOP      3328
#define XB_TOPGEN   3392
#define XCD_BAR_WORDS 3456
#define XB_SPIN_CAP (1u << 20)
__device__ __forceinline__ unsigned xb_ld(unsigned* p)              { return __hip_atomic_load(p, __ATOMIC_RELAXED, __HIP_MEMORY_SCOPE_AGENT); }
__device__ __forceinline__ unsigned xb_add(unsigned* p, unsigned v) { return __hip_atomic_fetch_add(p, v, __ATOMIC_RELAXED, __HIP_MEMORY_SCOPE_AGENT); }
__device__ __forceinline__ unsigned xb_xcc_id() { return (unsigned)__builtin_amdgcn_s_getreg((3 << 11) | 20) & 0xFu; }
#define XB_SPIN(cond, bar) do { unsigned _sp = 0; while (cond) { __builtin_amdgcn_s_sleep(1); \
    if ((++_sp & 255u) == 0u) { if (xb_ld(&(bar)[XB_TMO])) break; if (_sp > XB_SPIN_CAP) { atomicAdd(&(bar)[XB_TMO], 1u); break; } } } } while (0)
struct XcdBarrier { unsigned* bar; unsigned x; volatile LAS unsigned* st; };
__device__ __forceinline__ XcdBarrier xcd_barrier_post(unsigned* bar, volatile LAS unsigned* st) {
    XcdBarrier b; b.bar = bar; b.x = xb_xcc_id(); b.st = st;
    if (threadIdx.x == 0) (void)xb_add(&bar[XB_XCNT(b.x)], 1u);
    return b;
}
__device__ __forceinline__ void xcd_barrier_complete(unsigned* bar, unsigned x, unsigned& nloc, unsigned& nx) {
    const unsigned G = gridDim.x * gridDim.y * gridDim.z;
    unsigned sum, cnt, mine, sp = 0u;
    for (;;) {
        sum = 0u; cnt = 0u; mine = 0u;
#pragma unroll
        for (unsigned j = 0; j < 16; ++j) { const unsigned c = xb_ld(&bar[XB_XCNT(j)]); sum += c; cnt += (c > 0u) ? 1u : 0u; mine = (j == x) ? c : mine; }
        if (sum == G) break;
        __builtin_amdgcn_s_sleep(1);
        if ((++sp & 255u) == 0u) { if (xb_ld(&bar[XB_TMO])) break; if (sp > XB_SPIN_CAP) { atomicAdd(&bar[XB_TMO], 1u); break; } }
    }
    nloc = mine > 0u ? mine : 1u; nx = cnt > 0u ? cnt : 1u;
}
__device__ __forceinline__ void xcd_barrier(const XcdBarrier& b) {
    asm volatile("s_waitcnt vmcnt(0)" ::: "memory");
    __syncthreads();
    if (threadIdx.x == 0) {
        unsigned* bar = b.bar;
        __builtin_amdgcn_s_waitcnt(0);
        unsigned nloc = b.st[0], nx = b.st[1];
        if (nloc == 0u) { xcd_barrier_complete(bar, b.x, nloc, nx); b.st[0] = nloc; b.st[1] = nx; }
        const unsigned old = xb_add(&bar[XB_XSUB(b.x)], 1u);
        const unsigned gen = old / nloc;
        if (old + 1u == (gen + 1u) * nloc) {
            __builtin_amdgcn_fence(__ATOMIC_RELEASE, "agent");
            asm volatile("s_waitcnt vmcnt(0)" ::: "memory");
            const unsigned og = xb_add(&bar[XB_TOP], 1u);
            const unsigned tg = og / nx;
            if (og + 1u == (tg + 1u) * nx) xb_add(&bar[XB_TOPGEN], 1u);
            else XB_SPIN(xb_ld(&bar[XB_TOPGEN]) == tg, bar);
            __builtin_amdgcn_fence(__ATOMIC_ACQUIRE, "agent");
            xb_add(&bar[XB_XGEN(b.x)], 1u);
            asm volatile("s_waitcnt vmcnt(0)" ::: "memory");
        } else {
            XB_SPIN(xb_ld(&bar[XB_XGEN(b.x)]) == gen, bar);
            __builtin_amdgcn_fence(__ATOMIC_ACQUIRE, "agent");
            asm volatile("s_waitcnt vmcnt(0)" ::: "memory");
        }
    }
    __syncthreads();
}

namespace pg8 {
constexpr int BM = 256, BK = 64, HALF = 128, HTB = HALF * BK * 2, STAGE_BYTES = 8 * HTB, NXCD = 8, WGM = 8;
__host__ __device__ __forceinline__ int lds_byte(int r, int c) { const int st = (r >> 4) * 2 + (c >> 5), rr = r & 15, cc = c & 31, ob = rr * 64 + cc * 2; return st * 1024 + (ob ^ (((ob >> 9) & 1) << 5)); }
__host__ __device__ __forceinline__ void stage_rc(int b, int& R, int& C) { const int st = b / 1024, sb = b % 1024, swz = sb ^ (((sb >> 9) & 1) << 5); R = (st >> 1) * 16 + swz / 64; C = (st & 1) * 32 + (swz % 64) / 2; }
__host__ __device__ __forceinline__ int perm32(int rho) { const int n = rho >> 4, i = rho & 15; return 8 * (i >> 2) + 4 * n + (i & 3); }

struct Unit { int pm, pn, pb, e, rbase, cnt; };
struct Gemm { const bf16_t* A; const bf16_t* Bt; int K; };

struct DenseOrder {
    int nM, nN, nwg, G, c;
    __device__ void init(int nM_, int nN_, int G_, int c_) { nM = nM_; nN = nN_; nwg = nM * nN; G = G_; c = c_; }
    __device__ __forceinline__ bool next(int i, Unit& u) const {
        const long L = (long)i * G + c; if (L >= nwg) return false;
        int wgid = (int)L; { const int q = nwg / NXCD, r = nwg % NXCD, xcd = wgid % NXCD, off = wgid / NXCD; wgid = (xcd < r ? xcd * (q + 1) : r * (q + 1) + (xcd - r) * q) + off; }
        const int nig = WGM * nN, gid = wgid / nig, fm = gid * WGM, gsz = (nM - fm) < WGM ? (nM - fm) : WGM;
        u.pm = fm + ((wgid % nig) % gsz); u.pn = (wgid % nig) / gsz; if (DBG_SKIP & 128) u.pn = nN - 1 - u.pn; u.pb = u.pn; u.e = 0; u.rbase = 0; u.cnt = 0; return true;
    }
    __device__ __forceinline__ int a_row(const Unit&, int) const { return 0; }
};
struct MoeOrder {
    int nM, nN, nwg, G, c; const LAS int* t2e; const LAS int* tstart; const LAS int* cnt; const int* rowtok;
    __device__ void init(int nM_, int nN_, int G_, int c_) { nM = nM_; nN = nN_; nwg = nM * nN; G = G_; c = c_; }
    __device__ __forceinline__ bool next(int i, Unit& u) const {
        const long L = (long)i * G + c; if (L >= nwg) return false;
        int wgid = (int)L; { const int q = nwg / NXCD, r = nwg % NXCD, xcd = wgid % NXCD, off = wgid / NXCD; wgid = (xcd < r ? xcd * (q + 1) : r * (q + 1) + (xcd - r) * q) + off; }
        const int nig = WGM * nN, gid = wgid / nig, fm = gid * WGM, gsz = (nM - fm) < WGM ? (nM - fm) : WGM;
        u.pm = fm + ((wgid % nig) % gsz); u.pn = (wgid % nig) / gsz;
        const int e = t2e[u.pm]; u.e = e; u.pb = e * nN + u.pn; u.rbase = (u.pm - tstart[e]) * 256; u.cnt = cnt[e]; return true;
    }
    __device__ __forceinline__ int a_row(const Unit& u, int r) const { const int rank = u.rbase + r; return rank < u.cnt ? rowtok[u.e * T + rank] : 0; }
};

template <class Epi, class Sched, bool GATHER, bool ALIGN_EPI>
__device__ __forceinline__ void gemm_phase(LAS unsigned char* lds, const Gemm g, const Sched& S, const Epi& E) {
    const int tid = threadIdx.x, wid = __builtin_amdgcn_readfirstlane(tid >> 6), lane = tid & 63, wr = wid >> 2, wc = wid & 3, fr = lane & 15, fq = lane >> 4;
    const int K = g.K, nt = K / BK;
    unsigned voffA[2], voffB[2]; int Rv[2], Cv[2];
#pragma unroll
    for (int i = 0; i < 2; ++i) { int R, C; stage_rc(tid * 16 + i * 8192, R, C); const int Rb = Epi::PERM ? ((R & ~31) + perm32(R & 31)) : R;
        voffA[i] = (unsigned)(R * K + C) * 2u; voffB[i] = (unsigned)(Rb * K + C) * 2u; Rv[i] = R; Cv[i] = C; }
    const size_t kstep = (size_t)(BK * 2);
    const size_t hstep = (size_t)HALF * K * 2;
    const size_t tstep = 2 * hstep;
    const unsigned ldsw = (unsigned)wid * 1024u;
    const int aoff = lds_byte(wr * 64 + fr, fq * 8), boff = lds_byte(wc * 32 + fr, fq * 8);
#define PG8_SA(b, h) (((b) * 2 + (h)) * HTB)
#define PG8_SB(b, h) ((4 + (b) * 2 + (h)) * HTB)
#define PG8_STAGE(bufoff, gbase, voff) do { _Pragma("unroll") for (int _i = 0; _i < 2; ++_i) \
        __builtin_amdgcn_global_load_lds((const unsigned*)((const char*)(gbase) + (voff)[_i]), (LAS unsigned*)(lds + (bufoff) + ldsw + _i * 8192), 16, 0, 0); } while (0)
#define PG8_LDA(dst, b, h) do { _Pragma("unroll") for (int m = 0; m < 4; ++m) _Pragma("unroll") for (int k = 0; k < 2; ++k) dst[m][k] = *(const LAS bf16x8*)(lds + PG8_SA(b, h) + aoff + m * 2048 + k * 1024); } while (0)
#define PG8_LDB(dst, b, h) do { _Pragma("unroll") for (int n = 0; n < 2; ++n) _Pragma("unroll") for (int k = 0; k < 2; ++k) dst[n][k] = *(const LAS bf16x8*)(lds + PG8_SB(b, h) + boff + n * 2048 + k * 1024); } while (0)
#define PG8_MMA(ai, bj, At, Bt) do { __builtin_amdgcn_s_setprio(1); _Pragma("unroll") for (int m = 0; m < 4; ++m) _Pragma("unroll") for (int n = 0; n < 2; ++n) _Pragma("unroll") for (int k = 0; k < 2; ++k) \
        acc[ai][bj][m][n] = __builtin_amdgcn_mfma_f32_16x16x32_bf16(Bt[n][k], At[m][k], acc[ai][bj][m][n], 0, 0, 0); __builtin_amdgcn_s_setprio(0); } while (0)
#define PG8_WAIT_V(n) asm volatile("s_waitcnt vmcnt(" #n ")" ::: "memory")
#define PG8_WAIT_L(n) asm volatile("s_waitcnt lgkmcnt(" #n ")" ::: "memory")
#define PG8_BAR __builtin_amdgcn_s_barrier()
#define PG8_SCHED __builtin_amdgcn_sched_barrier(0)
    Unit cur, nxt; int ui = 0;
    if (!S.next(0, cur)) return;
    f32x4 acc[2][2][4][2];
#pragma unroll
    for (int a = 0; a < 2; ++a)
#pragma unroll
        for (int b = 0; b < 2; ++b)
#pragma unroll
            for (int m = 0; m < 4; ++m)
#pragma unroll
                for (int n = 0; n < 2; ++n) acc[a][b][m][n] = (f32x4){0.f, 0.f, 0.f, 0.f};
    bf16x8 At[4][2], B0[2][2], B1[2][2];
    unsigned gC0[2], gC1[2], gN0[2], gN1[2];
    if constexpr (GATHER) {
#pragma unroll
        for (int i = 0; i < 2; ++i) { gC0[i] = (unsigned)S.a_row(cur, Rv[i]) * (unsigned)(K * 2) + (unsigned)Cv[i] * 2u; gC1[i] = (unsigned)S.a_row(cur, HALF + Rv[i]) * (unsigned)(K * 2) + (unsigned)Cv[i] * 2u; gN0[i] = gC0[i]; gN1[i] = gC1[i]; }
    }
    const char* cA = GATHER ? (const char*)g.A : (const char*)g.A + (size_t)cur.pm * tstep; const char* cB = (const char*)g.Bt + (size_t)cur.pb * tstep;
#define PG8_STAGE_A(bufoff, p, h, o0, o1) do { if constexpr (GATHER) { if ((h) == 0) PG8_STAGE(bufoff, p, o0); else PG8_STAGE(bufoff, p, o1); } else { PG8_STAGE(bufoff, (p) + (h) * hstep, voffA); } } while (0)
    PG8_STAGE(PG8_SB(0, 0), cB, voffB); PG8_STAGE(PG8_SB(0, 1), cB + hstep, voffB); PG8_STAGE_A(PG8_SA(0, 0), cA, 0, gC0, gC1); PG8_STAGE_A(PG8_SA(0, 1), cA, 1, gC0, gC1);
    if (wr == 1) PG8_BAR;
    PG8_WAIT_V(2); PG8_BAR;
    PG8_STAGE(PG8_SB(1, 0), cB + kstep, voffB); PG8_STAGE_A(PG8_SA(1, 0), cA + kstep, 0, gC0, gC1); PG8_STAGE(PG8_SB(1, 1), cB + hstep + kstep, voffB);
    PG8_WAIT_V(6); PG8_BAR;
    for (;;) {
        const bool has_next = S.next(ui + 1, nxt);
        const char* nA = GATHER ? (const char*)g.A : (has_next ? (const char*)g.A + (size_t)nxt.pm * tstep : cA); const char* nB = has_next ? (const char*)g.Bt + (size_t)nxt.pb * tstep : cB;
        if constexpr (GATHER) { if (has_next) {
#pragma unroll
            for (int i = 0; i < 2; ++i) { gN0[i] = (unsigned)S.a_row(nxt, Rv[i]) * (unsigned)(K * 2) + (unsigned)Cv[i] * 2u; gN1[i] = (unsigned)S.a_row(nxt, HALF + Rv[i]) * (unsigned)(K * 2) + (unsigned)Cv[i] * 2u; } } }
        for (int t = 0; t < nt; t += 2) {
            const bool last = (t == nt - 2);
            const char* a1 = cA + (size_t)(t + 1) * kstep;
            const char* a2 = last ? nA : cA + (size_t)(t + 2) * kstep; const char* b2 = last ? nB : cB + (size_t)(t + 2) * kstep;
            const char* a3 = a2 + kstep; const char* b3 = b2 + kstep;
            unsigned s0[2], s1[2];
            if constexpr (GATHER) { s0[0] = last ? gN0[0] : gC0[0]; s0[1] = last ? gN0[1] : gC0[1]; s1[0] = last ? gN1[0] : gC1[0]; s1[1] = last ? gN1[1] : gC1[1]; }
            PG8_LDB(B0, 0, 0); PG8_LDB(B1, 0, 1); PG8_SCHED; PG8_LDA(At, 0, 0); PG8_STAGE_A(PG8_SA(1, 1), a1, 1, gC0, gC1);
            PG8_WAIT_V(8); PG8_WAIT_L(0); PG8_BAR; PG8_MMA(0, 0, At, B0); PG8_MMA(0, 1, At, B1); PG8_BAR; PG8_SCHED;
            PG8_LDA(At, 0, 1); PG8_STAGE(PG8_SB(0, 0), b2, voffB); PG8_STAGE(PG8_SB(0, 1), b2 + hstep, voffB); PG8_STAGE_A(PG8_SA(0, 0), a2, 0, s0, s1);
            PG8_WAIT_V(8); PG8_WAIT_L(0); PG8_BAR; PG8_MMA(1, 0, At, B0); PG8_MMA(1, 1, At, B1); PG8_BAR; PG8_SCHED;
            PG8_LDB(B0, 1, 0); PG8_LDB(B1, 1, 1); PG8_SCHED; PG8_LDA(At, 1, 0); PG8_STAGE_A(PG8_SA(0, 1), a2, 1, s0, s1);
            PG8_WAIT_V(8); PG8_WAIT_L(0); PG8_BAR; PG8_MMA(0, 0, At, B0); PG8_MMA(0, 1, At, B1); PG8_BAR; PG8_SCHED;
            PG8_LDA(At, 1, 1); PG8_STAGE(PG8_SB(1, 0), b3, voffB); PG8_STAGE(PG8_SB(1, 1), b3 + hstep, voffB); PG8_STAGE_A(PG8_SA(1, 0), a3, 0, s0, s1);
            PG8_WAIT_V(8); PG8_WAIT_L(0); PG8_BAR; PG8_MMA(1, 0, At, B0); PG8_MMA(1, 1, At, B1); PG8_BAR; PG8_SCHED;
        }
        if constexpr (ALIGN_EPI) { if (wr == 0) PG8_BAR; }
        E(acc, cur, wr, wc, fr, fq);
        if (!has_next) break;
#pragma unroll
        for (int a = 0; a < 2; ++a)
#pragma unroll
            for (int b = 0; b < 2; ++b)
#pragma unroll
                for (int m = 0; m < 4; ++m)
#pragma unroll
                    for (int n = 0; n < 2; ++n) acc[a][b][m][n] = (f32x4){0.f, 0.f, 0.f, 0.f};
        cur = nxt; cA = nA; cB = nB; ++ui;
        if constexpr (GATHER) { gC0[0] = gN0[0]; gC0[1] = gN0[1]; gC1[0] = gN1[0]; gC1[1] = gN1[1]; }
        if constexpr (ALIGN_EPI) { if (wr == 1) PG8_BAR; }
    }
    PG8_WAIT_V(0);
    if constexpr (!ALIGN_EPI) { if (wr == 0) PG8_BAR; }
    PG8_BAR;
#undef PG8_SA
#undef PG8_SB
#undef PG8_STAGE
#undef PG8_STAGE_A
#undef PG8_LDA
#undef PG8_LDB
#undef PG8_MMA
#undef PG8_WAIT_V
#undef PG8_WAIT_L
#undef PG8_BAR
#undef PG8_SCHED
}

__device__ __forceinline__ u32x4 pack8(const f32x4& v0, const f32x4& v1) { u32x4 w; w.x = cvt_pk_bf16(v0[0], v0[1]); w.y = cvt_pk_bf16(v0[2], v0[3]); w.z = cvt_pk_bf16(v1[0], v1[1]); w.w = cvt_pk_bf16(v1[2], v1[3]); return w; }
__device__ __forceinline__ void rope4(f32x4& v0, f32x4& v1, const float* cs) {
    const f32x4 a = *(const f32x4*)cs, b = *(const f32x4*)(cs + 4);
    float x1, x2;
    x1 = v0[0]; x2 = v0[1]; v0[0] = x1 * a[0] - x2 * a[1]; v0[1] = x2 * a[0] + x1 * a[1];
    x1 = v0[2]; x2 = v0[3]; v0[2] = x1 * a[2] - x2 * a[3]; v0[3] = x2 * a[2] + x1 * a[3];
    x1 = v1[0]; x2 = v1[1]; v1[0] = x1 * b[0] - x2 * b[1]; v1[1] = x2 * b[0] + x1 * b[1];
    x1 = v1[2]; x2 = v1[3]; v1[2] = x1 * b[2] - x2 * b[3]; v1[3] = x2 * b[2] + x1 * b[3];
}

struct EpiIn {
    static constexpr bool PERM = true;
    bf16_t *qa, *ka, *va, *cq, *ckv, *gates, *kr; const float *ropeA, *ropeM, *bg; float* sq;
    __device__ __forceinline__ void operator()(const f32x4 (&acc)[2][2][4][2], const Unit& u, int wr, int wc, int fr, int fq) const {
        const int pn = u.pn, row0 = u.pm * BM + wr * 64 + fr, cl = wc * 32 + 8 * fq;
        if (pn < 8) {
            bf16_t* dst = pn < 4 ? qa : ka; const int colt = (pn & 3) * 256; const bool rot = ((wc & 1) == 0) && (fq < 2);
#pragma unroll
            for (int ai = 0; ai < 2; ++ai)
#pragma unroll
                for (int m = 0; m < 4; ++m) { const int row = row0 + ai * HALF + m * 16;
#pragma unroll
                    for (int bj = 0; bj < 2; ++bj) { f32x4 v0 = acc[ai][bj][m][0], v1 = acc[ai][bj][m][1];
                        if (rot) rope4(v0, v1, ropeA + (size_t)row * 16 + fq * 8);
                        *(u32x4*)(dst + (size_t)row * 1024 + colt + bj * HALF + cl) = pack8(v0, v1); } }
        } else if (pn < 12) {
            const int colt = (pn - 8) * 256;
#pragma unroll
            for (int ai = 0; ai < 2; ++ai)
#pragma unroll
                for (int m = 0; m < 4; ++m) { const int row = row0 + ai * HALF + m * 16;
#pragma unroll
                    for (int bj = 0; bj < 2; ++bj) *(u32x4*)(va + (size_t)row * 1024 + colt + bj * HALF + cl) = pack8(acc[ai][bj][m][0], acc[ai][bj][m][1]); }
        } else if (pn < 17) {
            const bool isq = pn < 15; bf16_t* dst = isq ? cq : ckv; const int ld = isq ? QL : KVL, colt = (isq ? pn - 12 : pn - 15) * 256, tq = pn - 12;
#pragma unroll
            for (int ai = 0; ai < 2; ++ai)
#pragma unroll
                for (int m = 0; m < 4; ++m) { const int row = row0 + ai * HALF + m * 16; float s = 0.f;
#pragma unroll
                    for (int bj = 0; bj < 2; ++bj) { const f32x4 v0 = acc[ai][bj][m][0], v1 = acc[ai][bj][m][1];
                        s += (v0[0] * v0[0] + v0[1] * v0[1]) + (v0[2] * v0[2] + v0[3] * v0[3]) + (v1[0] * v1[0] + v1[1] * v1[1]) + (v1[2] * v1[2] + v1[3] * v1[3]);
                        *(u32x4*)(dst + (size_t)row * ld + colt + bj * HALF + cl) = pack8(v0, v1); }
                    s += __shfl_xor(s, 16); s += __shfl_xor(s, 32);
                    if (fq == 0) sq[(size_t)row * 20 + tq * 4 + wc] = s; }
        } else if (pn < 25) {
            const int colt = (pn - 17) * 256;
            f32x4 bv[2][2];
#pragma unroll
            for (int bj = 0; bj < 2; ++bj) { bv[bj][0] = *(const f32x4*)(bg + colt + bj * HALF + cl); bv[bj][1] = *(const f32x4*)(bg + colt + bj * HALF + cl + 4); if (DBG_SKIP & 256) { bv[bj][0] = bv[bj][0] * 0.f; bv[bj][1] = bv[bj][1] * 0.f; } }
#pragma unroll
            for (int ai = 0; ai < 2; ++ai)
#pragma unroll
                for (int m = 0; m < 4; ++m) { const int row = row0 + ai * HALF + m * 16;
#pragma unroll
                    for (int bj = 0; bj < 2; ++bj) { f32x4 v0 = acc[ai][bj][m][0] + bv[bj][0], v1 = acc[ai][bj][m][1] + bv[bj][1];
#pragma unroll
                        for (int j = 0; j < 4; ++j) { if (!(DBG_SKIP & 512)) { v0[j] = sigmoidf_(v0[j]); v1[j] = sigmoidf_(v1[j]); } }
                        *(u32x4*)(gates + (size_t)row * 2048 + colt + bj * HALF + cl) = pack8(v0, v1); } }
        } else {
            if (wc < 2) {
#pragma unroll
                for (int ai = 0; ai < 2; ++ai)
#pragma unroll
                    for (int m = 0; m < 4; ++m) { const int row = row0 + ai * HALF + m * 16;
                        f32x4 v0 = acc[ai][0][m][0], v1 = acc[ai][0][m][1];
                        rope4(v0, v1, ropeM + (size_t)row * 64 + (wc * 16 + fq * 4) * 2);
                        *(u32x4*)(kr + (size_t)row * 64 + cl) = pack8(v0, v1); }
            }
        }
    }
};
template <bool ISQ> struct EpiUp {
    static constexpr bool PERM = true;
    bf16_t* out; const float* sq; const float* ropeM;
    __device__ __forceinline__ void operator()(const f32x4 (&acc)[2][2][4][2], const Unit& u, int wr, int wc, int fr, int fq) const {
        const int row0 = u.pm * BM + wr * 64 + fr, cl = wc * 32 + 8 * fq; constexpr int LD = ISQ ? 1536 : 2048;
#pragma unroll
        for (int ai = 0; ai < 2; ++ai)
#pragma unroll
            for (int m = 0; m < 4; ++m) { const int row = row0 + ai * HALF + m * 16; float s;
                if (ISQ) { const f32x4 a = *(const f32x4*)(sq + (size_t)row * 20), b = *(const f32x4*)(sq + (size_t)row * 20 + 4), c = *(const f32x4*)(sq + (size_t)row * 20 + 8);
                    s = ((a[0] + a[1]) + (a[2] + a[3])) + ((b[0] + b[1]) + (b[2] + b[3])) + ((c[0] + c[1]) + (c[2] + c[3])); }
                else { const f32x4 a = *(const f32x4*)(sq + (size_t)row * 20 + 12), b = *(const f32x4*)(sq + (size_t)row * 20 + 16);
                    s = ((a[0] + a[1]) + (a[2] + a[3])) + ((b[0] + b[1]) + (b[2] + b[3])); }
                const float rstd = __builtin_amdgcn_rsqf(s * (ISQ ? 1.0f / QL : 1.0f / KVL) + EPS);
#pragma unroll
                for (int bj = 0; bj < 2; ++bj) { const int col = u.pn * BM + bj * HALF + cl; f32x4 v0 = acc[ai][bj][m][0] * rstd, v1 = acc[ai][bj][m][1] * rstd;
                    if (ISQ) { const int off = col % 192; if (off >= 128) rope4(v0, v1, ropeM + (size_t)row * 64 + (off - 128)); }
                    *(u32x4*)(out + (size_t)row * LD + col) = pack8(v0, v1); } }
    }
};
template <int WHICH> struct EpiGate {
    static constexpr bool PERM = true;
    bf16_t* mrg; const bf16_t* gates;
    __device__ __forceinline__ void operator()(const f32x4 (&acc)[2][2][4][2], const Unit& u, int wr, int wc, int fr, int fq) const {
        const int row0 = u.pm * BM + wr * 64 + fr, cl = wc * 32 + 8 * fq;
#pragma unroll
        for (int ai = 0; ai < 2; ++ai)
#pragma unroll
            for (int m = 0; m < 4; ++m) { const int row = row0 + ai * HALF + m * 16;
#pragma unroll
                for (int bj = 0; bj < 2; ++bj) { const int col = u.pn * BM + bj * HALF + cl;
                    const u32x4 gw = *(const u32x4*)(gates + (size_t)row * 2048 + WHICH * 1024 + col);
                    f32x4 v0 = acc[ai][bj][m][0], v1 = acc[ai][bj][m][1];
                    if ((DBG_SKIP & 8) && WHICH == 0) { v0 = v0 * 0.f; v1 = v1 * 0.f; } if ((DBG_SKIP & 16) && WHICH == 1) { v0 = v0 * 0.f; v1 = v1 * 0.f; }
                    v0[0] *= bf_lo(gw.x); v0[1] *= bf_hi(gw.x); v0[2] *= bf_lo(gw.y); v0[3] *= bf_hi(gw.y); v1[0] *= bf_lo(gw.z); v1[1] *= bf_hi(gw.z); v1[2] *= bf_lo(gw.w); v1[3] *= bf_hi(gw.w);
                    if (WHICH == 1) { const u32x4 tw = *(const u32x4*)(mrg + (size_t)row * 1024 + col);
                        v0[0] += bf_lo(tw.x); v0[1] += bf_hi(tw.x); v0[2] += bf_lo(tw.y); v0[3] += bf_hi(tw.y); v1[0] += bf_lo(tw.z); v1[1] += bf_hi(tw.z); v1[2] += bf_lo(tw.w); v1[3] += bf_hi(tw.w); }
                    *(u32x4*)(mrg + (size_t)row * 1024 + col) = pack8(v0, v1); } }
    }
};
struct EpiRes {
    static constexpr bool PERM = false;
    const float* x; float* out;
    __device__ __forceinline__ void operator()(const f32x4 (&acc)[2][2][4][2], const Unit& u, int wr, int wc, int fr, int fq) const {
        const int row0 = u.pm * BM + wr * 64 + fr, col0 = u.pn * BM + wc * 32 + 4 * fq;
#pragma unroll
        for (int ai = 0; ai < 2; ++ai)
#pragma unroll
            for (int m = 0; m < 4; ++m) { const size_t off = (size_t)(row0 + ai * HALF + m * 16) * 1024 + col0;
#pragma unroll
                for (int bj = 0; bj < 2; ++bj)
#pragma unroll
                    for (int n = 0; n < 2; ++n) *(f32x4*)(out + off + bj * HALF + n * 16) = *(const f32x4*)(x + off + bj * HALF + n * 16) + ((DBG_SKIP & 2) ? 0.f : 1.f) * acc[ai][bj][m][n]; }
    }
};
struct EpiSwiglu {
    static constexpr bool PERM = true;
    bf16_t* act; const float *bgate, *bup;
    __device__ __forceinline__ void operator()(const f32x4 (&acc)[2][2][4][2], const Unit& u, int wr, int wc, int fr, int fq) const {
        const int row0 = u.pm * BM + wr * 64 + fr, f0 = u.pn * HALF + wc * 32 + 8 * fq;
        f32x4 bgv[2], buv[2];
#pragma unroll
        for (int n = 0; n < 2; ++n) { bgv[n] = *(const f32x4*)(bgate + (size_t)u.e * FF + f0 + 4 * n); buv[n] = *(const f32x4*)(bup + (size_t)u.e * FF + f0 + 4 * n); }
#pragma unroll
        for (int ai = 0; ai < 2; ++ai)
#pragma unroll
            for (int m = 0; m < 4; ++m) { const int row = row0 + ai * HALF + m * 16; f32x4 o[2];
#pragma unroll
                for (int n = 0; n < 2; ++n) { const f32x4 gt = acc[ai][0][m][n] + bgv[n], up = acc[ai][1][m][n] + buv[n];
#pragma unroll
                    for (int j = 0; j < 4; ++j) { const float gg = fminf(gt[j], 7.0f), uu = fminf(fmaxf(up[j], -7.0f), 7.0f); o[n][j] = (uu + 1.0f) * (gg * sigmoidf_(1.702f * gg)); } }
                *(u32x4*)(act + (size_t)row * FF + f0) = pack8(o[0], o[1]); }
    }
};
struct EpiDown {
    static constexpr bool PERM = true;
    bf16_t* y; const float* bd;
    __device__ __forceinline__ void operator()(const f32x4 (&acc)[2][2][4][2], const Unit& u, int wr, int wc, int fr, int fq) const {
        const int row0 = u.pm * BM + wr * 64 + fr, cl = wc * 32 + 8 * fq;
        f32x4 bv[2][2];
#pragma unroll
        for (int bj = 0; bj < 2; ++bj) { const int col = u.pn * BM + bj * HALF + cl; bv[bj][0] = *(const f32x4*)(bd + (size_t)u.e * D + col); bv[bj][1] = *(const f32x4*)(bd + (size_t)u.e * D + col + 4); }
#pragma unroll
        for (int ai = 0; ai < 2; ++ai)
#pragma unroll
            for (int m = 0; m < 4; ++m) { const int row = row0 + ai * HALF + m * 16;
#pragma unroll
                for (int bj = 0; bj < 2; ++bj) { const int col = u.pn * BM + bj * HALF + cl;
                    *(u32x4*)(y + (size_t)row * D + col) = pack8(acc[ai][bj][m][0] + bv[bj][0], acc[ai][bj][m][1] + bv[bj][1]); } }
    }
};
}

namespace att {
constexpr int NW = 8, QBLK = 32, KVBLK = 64;
constexpr int SHM_V = KVBLK * 128 * 2;
#define SBAR() __builtin_amdgcn_sched_barrier(0)
#define KSW(row, colB) ((row) * 128 + ((colB) ^ ((((row) >> 1) & 7) << 4)))
__device__ __forceinline__ int crow(int r, int hi) { return (r & 3) + 8 * (r >> 2) + 4 * hi; }
struct Src { const bf16_t* Q; const bf16_t* K; const bf16_t* K2; const bf16_t* V; int ldq, ldk, ldk2, ldv; };

__device__ __forceinline__ void partialSM(f32x16& p0, f32x16& p1, float& m_reg, float& mn, float& alpha, const float C, const float thr) {
  float pmax = p0[0];
#pragma unroll
  for (int r = 1; r < 16; ++r) pmax = fmaxf(pmax, p0[r]);
#pragma unroll
  for (int r = 0; r < 16; ++r) pmax = fmaxf(pmax, p1[r]);
  { auto rr = __builtin_amdgcn_permlane32_swap(__float_as_uint(pmax), __float_as_uint(pmax), false, false);
    pmax = fmaxf(__uint_as_float(rr[0]), __uint_as_float(rr[1])); }
  if (__builtin_expect(__all(pmax - m_reg <= thr), 1)) { mn = m_reg; alpha = 1.f; }
  else { mn = fmaxf(m_reg, pmax); alpha = __builtin_amdgcn_exp2f((m_reg - mn) * C); m_reg = mn; }
  const float mnC = -mn * C;
#pragma unroll
  for (int r = 0; r < 16; ++r) p0[r] = fmaf(p0[r], C, mnC);
#pragma unroll
  for (int r = 0; r < 16; ++r) p1[r] = fmaf(p1[r], C, mnC);
#pragma unroll
  for (int r = 0; r < 16; ++r) p0[r] = __builtin_amdgcn_exp2f(p0[r]);
#if ATT_DUP == 1
  { float d_[16];
#pragma unroll
    for (int r = 0; r < 16; ++r) { d_[r] = __builtin_amdgcn_exp2f(p1[r]); d_[r] = fmaf(d_[r], C, mnC); }
#pragma unroll
    for (int r = 0; r < 16; ++r) asm volatile("" :: "v"(d_[r])); }
#endif
}
__device__ __forceinline__ void finishSM(f32x16& p0, f32x16& p1, float alpha, float& l_reg, bf16x8& pa0, bf16x8& pa1, bf16x8& pa2, bf16x8& pa3) {
#pragma unroll
  for (int r = 0; r < 16; ++r) p1[r] = __builtin_amdgcn_exp2f(p1[r]);
  float ps = 0;
#pragma unroll
  for (int r = 0; r < 16; ++r) ps += p0[r];
#pragma unroll
  for (int r = 0; r < 16; ++r) ps += p1[r];
  { auto rr = __builtin_amdgcn_permlane32_swap(__float_as_uint(ps), __float_as_uint(ps), false, false);
    ps = __uint_as_float(rr[0]) + __uint_as_float(rr[1]); }
  l_reg = l_reg * alpha + ps;
#define PK4(P, BASE, OUT) do { unsigned a0 = cvt_pk_bf16(P[BASE + 0], P[BASE + 1]), a1 = cvt_pk_bf16(P[BASE + 2], P[BASE + 3]);   \
    unsigned b0 = cvt_pk_bf16(P[BASE + 4], P[BASE + 5]), b1 = cvt_pk_bf16(P[BASE + 6], P[BASE + 7]);                              \
    auto r0 = __builtin_amdgcn_permlane32_swap(a0, b0, false, false); auto r1 = __builtin_amdgcn_permlane32_swap(a1, b1, false, false); \
    u32x4 w = {r0[0], r1[0], r0[1], r1[1]}; OUT = *reinterpret_cast<bf16x8*>(&w); } while (0)
  PK4(p0, 0, pa0); PK4(p0, 8, pa1); PK4(p1, 0, pa2); PK4(p1, 8, pa3);
#undef PK4
}
template <int DQK> __device__ __forceinline__ void qkt(f32x16& p0, f32x16& p1, const LAS char* Ks, const bf16x8* qr, int r32, int hi) {
  p0 = f32x16{}; p1 = f32x16{};
#pragma unroll
  for (int d0 = 0; d0 < DQK / 16; ++d0) { const int sub = d0 >> 2, cb = ((d0 & 3) * 16 + hi * 8) * 2;
    const bf16x8 b0 = *(const LAS bf16x8*)(Ks + sub * 8192 + KSW(r32, cb));
    const bf16x8 b1 = *(const LAS bf16x8*)(Ks + sub * 8192 + KSW(32 + r32, cb));
    p0 = __builtin_amdgcn_mfma_f32_32x32x16_bf16(b0, qr[d0], p0, 0, 0, 0);
    p1 = __builtin_amdgcn_mfma_f32_32x32x16_bf16(b1, qr[d0], p1, 0, 0, 0); }
#if ATT_DUP == 2
  if constexpr (DQK == 64) { bf16x8 zq = {0, 0, 0, 0, 0, 0, 0, 0}; asm volatile("" : "+v"(zq));
    const bf16x8 bz = *(const LAS bf16x8*)(Ks + KSW(r32, hi * 16));
#pragma unroll
    for (int d0 = 0; d0 < 2; ++d0) { p0 = __builtin_amdgcn_mfma_f32_32x32x16_bf16(bz, zq, p0, 0, 0, 0); p1 = __builtin_amdgcn_mfma_f32_32x32x16_bf16(bz, zq, p1, 0, 0, 0); } }
#endif
}
__device__ __forceinline__ int v_st(int k, int c) { const int kk = (k & ~0xC) | ((k & 4) << 1) | ((k & 8) >> 1); return ((kk >> 3) * 4 + (c >> 5)) * 512 + ((kk & 7) * 32 + (c & 31)) * 2; }
__device__ __forceinline__ int v_rd_base(int lane) { return ((lane & 3) << 3) | (((lane >> 2) & 3) << 6) | (((lane >> 4) & 1) << 5) | (((lane >> 5) & 1) << 8); }
constexpr int v_rd_off(int d0, int ks, int half) { return d0 * 512 + ks * 4096 + half * 2048; }
template <int OFF> __device__ __forceinline__ s16x4 tr_read(int vb) {
  s16x4 r; asm volatile("ds_read_b64_tr_b16 %0, %1 offset:%2" : "=&v"(r) : "v"(vb), "i"(OFF) : "memory"); return r;
}
template <int KS> __device__ __forceinline__ void pv_step(f32x16* o, int vb, bf16x8 pa) {
  s16x4 l0, h0, l1, h1, l2, h2, l3, h3;
  l0 = tr_read<v_rd_off(0, KS, 0)>(vb); h0 = tr_read<v_rd_off(0, KS, 1)>(vb); l1 = tr_read<v_rd_off(1, KS, 0)>(vb); h1 = tr_read<v_rd_off(1, KS, 1)>(vb);
  l2 = tr_read<v_rd_off(2, KS, 0)>(vb); h2 = tr_read<v_rd_off(2, KS, 1)>(vb); l3 = tr_read<v_rd_off(3, KS, 0)>(vb); h3 = tr_read<v_rd_off(3, KS, 1)>(vb);
  asm volatile("s_waitcnt lgkmcnt(0)" ::: "memory"); SBAR();
#define PK(L, H) (bf16x8){L[0], L[1], L[2], L[3], H[0], H[1], H[2], H[3]}
  o[0] = __builtin_amdgcn_mfma_f32_32x32x16_bf16(pa, PK(l0, h0), o[0], 0, 0, 0);
  o[1] = __builtin_amdgcn_mfma_f32_32x32x16_bf16(pa, PK(l1, h1), o[1], 0, 0, 0);
  o[2] = __builtin_amdgcn_mfma_f32_32x32x16_bf16(pa, PK(l2, h2), o[2], 0, 0, 0);
  o[3] = __builtin_amdgcn_mfma_f32_32x32x16_bf16(pa, PK(l3, h3), o[3], 0, 0, 0);
#undef PK
}
__device__ __forceinline__ void pv_d0(f32x16* o, int vb, bf16x8 pa0, bf16x8 pa1, bf16x8 pa2, bf16x8 pa3) {
  pv_step<0>(o, vb, pa0); pv_step<1>(o, vb, pa1); pv_step<2>(o, vb, pa2); pv_step<3>(o, vb, pa3);
}
template <int DQK>
__device__ __forceinline__ void attn_core(const Src in, const float C, const float thr, const int seq, LAS char* lds, f32x16 (&o)[4]) {
  constexpr int NSUB = DQK / 64, SHM_K = NSUB * 8192;
  const int tid = threadIdx.x, wid = __builtin_amdgcn_readfirstlane(tid >> 6), lane = tid & 63, r32 = lane & 31, hi = lane >> 5;
  LAS char* V_lds = lds; LAS char* K_lds = lds + 3 * SHM_V;
  LAS float* ws = (LAS float*)(lds + 3 * SHM_V + 3 * SHM_K) + wid * 64; LAS float* li_l = ws; LAS float* al_l = ws + 32;
  float m_reg = -1e30f, l_reg = 0;
#pragma unroll
  for (int d = 0; d < 4; ++d) o[d] = f32x16{};
  bf16x8 qr[DQK / 16];
  const bf16_t* Qw = in.Q + (size_t)(wid * QBLK + r32) * in.ldq + hi * 8;
#pragma unroll
  for (int d0 = 0; d0 < DQK / 16; ++d0) qr[d0] = *(const bf16x8*)(Qw + d0 * 16);
  const int krow = wid * 8 + (lane >> 3), kslot = (lane & 7) ^ ((krow >> 1) & 7);
  const unsigned koff = (unsigned)(krow * in.ldk + kslot * 8) * 2u, k2off = (unsigned)(krow * in.ldk2 + kslot * 8) * 2u;
  unsigned voff[2];
#pragma unroll
  for (int i = 0; i < 2; ++i) { const int p = i * 8192 + wid * 1024 + lane * 16, st = p >> 9, wq = (p & 511) >> 1, kk = (st >> 2) * 8 + (wq >> 5), cl = wq & 31;
    const int k = (kk & ~0xC) | ((kk & 4) << 1) | ((kk & 8) >> 1); voff[i] = (unsigned)(k * in.ldv + (st & 3) * 32 + cl) * 2u; }
  const int vb0 = (int)(unsigned)(size_t)V_lds + v_rd_base(lane);
  const unsigned ldsw = (unsigned)wid * 1024u;
#define GLDS(gp, lp) __builtin_amdgcn_global_load_lds((const unsigned*)(gp), (LAS unsigned*)(lp), 16, 0, 0)
#define ISSUE_K(t, b) do { const char* kb_ = (const char*)in.K + (size_t)(t) * (KVBLK * 2) * in.ldk; \
    _Pragma("unroll") for (int s_ = 0; s_ < NSUB; ++s_) { if (s_ < 2) GLDS(kb_ + s_ * 128 + koff, K_lds + (b) * SHM_K + s_ * 8192 + ldsw); \
      else GLDS((const char*)in.K2 + (size_t)(t) * (KVBLK * 2) * in.ldk2 + k2off, K_lds + (b) * SHM_K + s_ * 8192 + ldsw); } } while (0)
#define ISSUE_V(t, b) do { const char* vb_ = (const char*)in.V + (size_t)(t) * (KVBLK * 2) * in.ldv; \
    GLDS(vb_ + voff[0], V_lds + (b) * SHM_V + ldsw); GLDS(vb_ + voff[1], V_lds + (b) * SHM_V + 8192 + ldsw); \
    if (ATT_DUP == 3) { GLDS(vb_ + voff[0], V_lds + (b) * SHM_V + ldsw); GLDS(vb_ + voff[1], V_lds + (b) * SHM_V + 8192 + ldsw); } } while (0)
#define WAITV(n) asm volatile("s_waitcnt vmcnt(%0)" :: "n"((DBG_SKIP & 4) ? 0 : (n)) : "memory")
#define WBAR() do { asm volatile("" ::: "memory"); __builtin_amdgcn_s_barrier(); asm volatile("" ::: "memory"); } while (0)
#define RESC(a) do { if (__any((a) < 1.f)) { if (hi == 0) al_l[r32] = (a); asm volatile("s_waitcnt lgkmcnt(0)" ::: "memory"); \
    _Pragma("unroll") for (int d = 0; d < 4; ++d) _Pragma("unroll") for (int r = 0; r < 16; ++r) o[d][r] *= al_l[crow(r, hi)]; } } while (0)
#define NXT3(x) ((x) == 2 ? 0 : (x) + 1)
  constexpr int NI = NSUB + (ATT_DUP == 3 ? 4 : 2), NV = (ATT_DUP == 3 ? 4 : 2);
  f32x16 pA0, pA1, pB0, pB1; float mnA, mnB, alA, alB; bf16x8 pa0, pa1, pa2, pa3; const int NT = seq / KVBLK;
  const bool lead = wid < 4;
  ISSUE_K(0, 0); ISSUE_K(1, 1); ISSUE_V(0, 0);
  if (!lead) { WAITV(NI); WBAR(); }
  WAITV(NI); WBAR();
  ISSUE_K(2, 2);
  qkt<DQK>(pA0, pA1, K_lds, qr, r32, hi);
  WAITV(NI); WBAR();
  ISSUE_V(1, 1);
  partialSM(pA0, pA1, m_reg, mnA, alA, C, thr);
  WAITV(NI); WBAR();
  int bq = 1;
  for (int j = 1; j + 3 < NT; j += 2) {
    { const int b1 = NXT3(bq), b2 = NXT3(b1);
      ISSUE_K(j + 2, b2);
      SBAR(); qkt<DQK>(pB0, pB1, K_lds + bq * SHM_K, qr, r32, hi);
      finishSM(pA0, pA1, alA, l_reg, pa0, pa1, pa2, pa3); SBAR();
      WAITV(NI); WBAR();
      ISSUE_V(j + 1, b1);
      pv_d0(o, vb0 + b2 * SHM_V, pa0, pa1, pa2, pa3); partialSM(pB0, pB1, m_reg, mnB, alB, C, thr);
      RESC(alB); bq = b1;
      WAITV(NI); WBAR(); }
    { const int b1 = NXT3(bq), b2 = NXT3(b1);
      ISSUE_K(j + 3, b2);
      SBAR(); qkt<DQK>(pA0, pA1, K_lds + bq * SHM_K, qr, r32, hi);
      finishSM(pB0, pB1, alB, l_reg, pa0, pa1, pa2, pa3); SBAR();
      WAITV(NI); WBAR();
      ISSUE_V(j + 2, b1);
      pv_d0(o, vb0 + b2 * SHM_V, pa0, pa1, pa2, pa3); partialSM(pA0, pA1, m_reg, mnA, alA, C, thr);
      RESC(alA); bq = b1;
      WAITV(NI); WBAR(); }
  }
  { const int b1 = NXT3(bq), b2 = NXT3(b1);
    ISSUE_K(NT - 1, b2);
    SBAR(); qkt<DQK>(pB0, pB1, K_lds + bq * SHM_K, qr, r32, hi);
    finishSM(pA0, pA1, alA, l_reg, pa0, pa1, pa2, pa3); SBAR();
    WAITV(NI); WBAR();
    ISSUE_V(NT - 2, b1);
    pv_d0(o, vb0 + b2 * SHM_V, pa0, pa1, pa2, pa3); partialSM(pB0, pB1, m_reg, mnB, alB, C, thr);
    RESC(alB); bq = b1;
    WAITV(NI); WBAR(); }
  { const int b1 = NXT3(bq), b2 = NXT3(b1);
    SBAR(); qkt<DQK>(pA0, pA1, K_lds + bq * SHM_K, qr, r32, hi);
    finishSM(pB0, pB1, alB, l_reg, pa0, pa1, pa2, pa3); SBAR();
    WAITV(NV); WBAR();
    ISSUE_V(NT - 1, b1);
    pv_d0(o, vb0 + b2 * SHM_V, pa0, pa1, pa2, pa3); partialSM(pA0, pA1, m_reg, mnA, alA, C, thr);
    RESC(alA); bq = b1;
    WAITV(NV); WBAR(); }
  { const int b2 = NXT3(NXT3(bq));
    SBAR(); qkt<DQK>(pB0, pB1, K_lds + bq * SHM_K, qr, r32, hi);
    finishSM(pA0, pA1, alA, l_reg, pa0, pa1, pa2, pa3); SBAR();
    WAITV(0); WBAR();
    pv_d0(o, vb0 + b2 * SHM_V, pa0, pa1, pa2, pa3); partialSM(pB0, pB1, m_reg, mnB, alB, C, thr);
    RESC(alB);
    WBAR(); }
  finishSM(pB0, pB1, alB, l_reg, pa0, pa1, pa2, pa3); SBAR();
  pv_d0(o, vb0 + bq * SHM_V, pa0, pa1, pa2, pa3);
  if (lead) { WBAR(); }
  if (hi == 0) li_l[r32] = l_reg; asm volatile("s_waitcnt lgkmcnt(0)" ::: "memory");
#pragma unroll
  for (int r = 0; r < 16; ++r) { const float rl = __builtin_amdgcn_rcpf(li_l[crow(r, hi)]);
#pragma unroll
    for (int d = 0; d < 4; ++d) o[d][r] *= rl; }
  asm volatile("s_waitcnt lgkmcnt(0)" ::: "memory"); WBAR();
#undef GLDS
#undef ISSUE_K
#undef ISSUE_V
#undef WAITV
#undef WBAR
#undef RESC
#undef NXT3
}
}

constexpr int NWAVES = 8;
struct Args { const void* in[27]; float* out; unsigned char* ws; int ph_lo, ph_hi, li, pad; };

__constant__ float c_invA[8] = {1.0f, 0.19392274474868576f, 0.03760603093086393f, 0.007292664737217109f, 0.001414213562373095f, 0.0002742481756762073f, 5.318295896944988e-05f, 1.031338537721246e-05f};
__constant__ float c_invM[32] = {1.0f, 0.6636012376960885f, 0.44036660267178046f, 0.2922278225730151f, 0.19392274474868576f, 0.12868737343265052f, 0.08539710028576561f, 0.05666962144529105f,
    0.03760603093086393f, 0.024955408670558694f, 0.016560440080994446f, 0.010989528534539826f, 0.007292664737217109f, 0.004839421345719893f, 0.003211445994752591f, 0.0021311195369119653f,
    0.001414213562373095f, 0.0009384738703573802f, 0.000622772421914596f, 0.0004132725499855165f, 0.0002742481756762073f, 0.00018199142881462546f, 0.00012076973741146504f, 8.01429472224798e-05f,
    5.318295896944988e-05f, 3.529227739646723e-05f, 2.341999896140934e-05f, 1.5541540297632344e-05f, 1.031338537721246e-05f, 6.8439753011549275e-06f, 4.5416704806078695e-06f, 3.013858152139171e-06f};

__device__ __forceinline__ int permDA(int i) { return i < 16 ? (i >> 1) + 8 * (i & 1) : i; }
__device__ __forceinline__ int permM(int i) { return (i >> 1) + 32 * (i & 1); }
__device__ __forceinline__ int src_in(int j) {
    if (j < 2048) return (j & ~63) + permDA(j & 63);
    if (j < 4352) return j;
    if (j < 6400) return 4416 + (j - 4352);
    if (j < 6464) return 4352 + permM(j - 6400);
    return -1;
}
__device__ __forceinline__ int src_uq(int j) { const int hd = j / 192, off = j % 192; return off < 128 ? j : hd * 192 + 128 + permM(off - 128); }

__device__ __forceinline__ void tr_item(const float* W, int K, int N, bf16_t* WT, int n0, int k0, int scol, const float* rs, LAS float* scr, int lane) {
#pragma unroll 8
    for (int i = 0; i < 32; ++i) { const int kk = 2 * i + (lane >> 5); float v = 0.f; if (scol >= 0) { v = W[(size_t)(k0 + kk) * N + scol]; if (rs) v *= rs[k0 + kk]; } scr[kk * 33 + (lane & 31)] = v; }
    LDS_WAIT(); asm volatile("" ::: "memory");
    const int c = lane & 7;
#pragma unroll
    for (int j = 0; j < 4; ++j) { const int n = (lane >> 3) + 8 * j; const LAS float* s = scr + (8 * c) * 33 + n;
        u32x4 o; o.x = cvt_pk_bf16(s[0 * 33], s[1 * 33]); o.y = cvt_pk_bf16(s[2 * 33], s[3 * 33]); o.z = cvt_pk_bf16(s[4 * 33], s[5 * 33]); o.w = cvt_pk_bf16(s[6 * 33], s[7 * 33]);
        *(u32x4*)(WT + (size_t)(n0 + n) * K + k0 + 8 * c) = o; }
    LDS_WAIT(); asm volatile("" ::: "memory");
}

__device__ __forceinline__ void cvt_tile64(const float* W, int N, bf16_t* WT, int Kd, int k0, int n0, int drow0, int lane) {
    const int g = lane >> 4, x = lane & 15;
    const float* src = W + (size_t)(k0 + 16 * g) * N + n0 + 4 * x;
    f32x4 v[16];
#pragma unroll
    for (int i = 0; i < 16; ++i) v[i] = __builtin_nontemporal_load((const f32x4*)(src + (size_t)i * N));
#pragma unroll
    for (int j = 0; j < 4; ++j) { u32x4 lo, hi;
        lo.x = cvt_pk_bf16(v[0][j], v[1][j]); lo.y = cvt_pk_bf16(v[2][j], v[3][j]); lo.z = cvt_pk_bf16(v[4][j], v[5][j]); lo.w = cvt_pk_bf16(v[6][j], v[7][j]);
        hi.x = cvt_pk_bf16(v[8][j], v[9][j]); hi.y = cvt_pk_bf16(v[10][j], v[11][j]); hi.z = cvt_pk_bf16(v[12][j], v[13][j]); hi.w = cvt_pk_bf16(v[14][j], v[15][j]);
        bf16_t* d = WT + (size_t)(drow0 + 4 * x + j) * Kd + k0 + 16 * g;
        *(u32x4*)d = lo; *(u32x4*)(d + 8) = hi; }
}

__global__ void __launch_bounds__(NWAVES * 64, 2) fwd(Args args) {
#define KARGS() const __attribute__((address_space(4))) unsigned long long* ka_ = (const __attribute__((address_space(4))) unsigned long long*)__builtin_amdgcn_kernarg_segment_ptr(); asm volatile("" : "+s"(ka_))
#define AIN(i) ((const void*)ka_[i])
#define AOUT ((float*)ka_[27])
#define AWS ((unsigned char*)ka_[28])
    extern __shared__ __attribute__((aligned(16))) unsigned char lds_raw[];
    LAS unsigned char* lds = (LAS unsigned char*)lds_raw;
    volatile LAS unsigned* MISC = (volatile LAS unsigned*)(lds + MISC_OFF);
    const int tid = threadIdx.x, wave = __builtin_amdgcn_readfirstlane(tid >> 6);
#define LANE_DECL int lane; asm volatile("v_and_b32 %0, 63, %1" : "=v"(lane) : "v"(threadIdx.x))
    const int G = gridDim.x, bx = blockIdx.x;
    unsigned* ctl = (unsigned*)(args.ws + WS_CTL);
    const int lo = args.ph_lo, hi_ph = args.ph_hi;
    if (tid < 32) MISC[tid] = 0u;
    __syncthreads();
    XcdBarrier bar; bar.bar = ctl + CW_BAR + args.li * XCD_BAR_WORDS; bar.x = 0; bar.st = nullptr;
    if (!MK_PER_PHASE) bar = xcd_barrier_post(ctl + CW_BAR + args.li * XCD_BAR_WORDS, MISC + 8);
#define IN(k) (((PH_MASK >> (k)) & 1) && lo <= (k) && (k) < hi_ph)
#define SEAM(k) do { if (IN(k) && IN((k) + 1)) xcd_barrier(bar); } while (0)
    const int gw = bx * NWAVES + wave, NGW = G * NWAVES;

#define xin ((const float*)AIN(0))
#define positions ((const int*)AIN(1))
#define Bt_in ((bf16_t*)(AWS + WS_BT_IN))
#define Bt_uq ((bf16_t*)(AWS + WS_BT_UQ))
#define Bt_ukv ((bf16_t*)(AWS + WS_BT_UKV))
#define Bt_od ((bf16_t*)(AWS + WS_BT_OD))
#define Bt_om ((bf16_t*)(AWS + WS_BT_OM))
#define Bt_out ((bf16_t*)(AWS + WS_BT_OUT))
#define ropeA ((float*)(AWS + WS_ROPEA))
#define ropeM ((float*)(AWS + WS_ROPEM))
#define sq ((float*)(AWS + WS_SQ2))
#define hbuf ((bf16_t*)(AWS + WS_H))
#define oa ((bf16_t*)(AWS + WS_H))
#define qa ((bf16_t*)(AWS + WS_QA))
#define ka ((bf16_t*)(AWS + WS_KA))
#define va ((bf16_t*)(AWS + WS_VA))
#define cq ((bf16_t*)(AWS + WS_CQ))
#define ckv ((bf16_t*)(AWS + WS_CKV))
#define kr ((bf16_t*)(AWS + WS_KR))
#define gates ((bf16_t*)(AWS + WS_GATES))
#define qm ((bf16_t*)(AWS + WS_QM))
#define kv ((bf16_t*)(AWS + WS_KV))
#define ob ((bf16_t*)(AWS + WS_OB))
#define mrg ((bf16_t*)(AWS + WS_MRG))
#define stash ((float*)(AWS + WS_STASH))
#define rowtok_p ((int*)(AWS + WS_ROWTOK))
#define assign ((u32x2*)(AWS + WS_ASSIGN))
#define Bt_d ((bf16_t*)(AWS + WS_BT_D))
#define Bt_gu ((bf16_t*)(AWS + WS_BT_GU))
#define h2 ((bf16_t*)(AWS + WS_H2))
#define act ((bf16_t*)(AWS + WS_ACT))
#define ybuf ((bf16_t*)(AWS + WS_Y))
#define count ((unsigned*)(AWS + WS_CTL) + CW_COUNT)

    if (IN(0)) {
        KARGS();
        LANE_DECL;
        LAS float* scr = (LAS float*)(lds + wave * 16384);
        const float* w_in = (const float*)AIN(3); const float* g_q = (const float*)AIN(9); const float* g_kv = (const float*)AIN(10);
        const float* w_uq = (const float*)AIN(11); const float* w_ukv = (const float*)AIN(12);
        const float* w_od = (const float*)AIN(13); const float* w_om = (const float*)AIN(14); const float* w_out = (const float*)AIN(16);
        constexpr int I_IN = 16 * (N_IN / 32), I_UQ = (QL / 64) * (1536 / 32), I_UKV = (KVL / 64) * (2048 / 32), I_O = 16 * 32;
        constexpr int NITEMS = I_IN + I_UQ + I_UKV + 3 * I_O;
        for (int it = gw; it < NITEMS; it += NGW) {
            int r = it; const int li = lane & 31;
            if (r < I_IN) { const int nblk = N_IN / 32, kb = r / nblk, nb = r % nblk; tr_item(w_in, D, 6464, Bt_in, nb * 32, kb * 64, src_in(nb * 32 + li), nullptr, scr, lane); continue; } r -= I_IN;
            if (r < I_UQ) { const int nblk = 1536 / 32, kb = r / nblk, nb = r % nblk; tr_item(w_uq, QL, 1536, Bt_uq, nb * 32, kb * 64, src_uq(nb * 32 + li), g_q, scr, lane); continue; } r -= I_UQ;
            if (r < I_UKV) { const int nblk = 2048 / 32, kb = r / nblk, nb = r % nblk; tr_item(w_ukv, KVL, 2048, Bt_ukv, nb * 32, kb * 64, nb * 32 + li, g_kv, scr, lane); continue; } r -= I_UKV;
            const int which = r / I_O; r -= which * I_O; const int kb = r / 32, nb = r % 32;
            tr_item(which == 0 ? w_od : (which == 1 ? w_om : w_out), D, D, which == 0 ? Bt_od : (which == 1 ? Bt_om : Bt_out), nb * 32, kb * 64, nb * 32 + li, nullptr, scr, lane);
        }
        const float* g_mix = (const float*)AIN(2);
        for (int m = gw; m < T; m += NGW) {
            const f32x4* xr = (const f32x4*)(xin + (size_t)m * D) + lane; f32x4 v[4]; float s = 0.f;
#pragma unroll
            for (int j = 0; j < 4; ++j) { v[j] = xr[64 * j]; s += (v[j][0] * v[j][0] + v[j][1] * v[j][1]) + (v[j][2] * v[j][2] + v[j][3] * v[j][3]); }
            const float rstd = __builtin_amdgcn_rsqf(wave_sum(s) * (1.f / D) + EPS);
            u32x2* o8 = (u32x2*)(hbuf + (size_t)m * D) + lane;
#pragma unroll
            for (int j = 0; j < 4; ++j) { const f32x4 gg = *((const f32x4*)g_mix + lane + 64 * j); u32x2 w; w.x = cvt_pk_bf16(v[j][0] * rstd * gg[0], v[j][1] * rstd * gg[1]); w.y = cvt_pk_bf16(v[j][2] * rstd * gg[2], v[j][3] * rstd * gg[3]); o8[64 * j] = w; }
        }
        for (int idx = bx * 512 + tid; idx < T * 40; idx += G * 512) {
            const int t = idx / 40, i = idx % 40; const float inv = i < 8 ? c_invA[i] : c_invM[i - 8];
            const float ang = (float)positions[t] * inv;
            const double rev = (double)ang * 0.15915494309189535; const float fr_ = (float)(rev - __builtin_rint(rev));
            const float cs = __builtin_amdgcn_cosf(fr_), sn = __builtin_amdgcn_sinf(fr_);
            float* dst = i < 8 ? ropeA + ((size_t)t * 8 + i) * 2 : ropeM + ((size_t)t * 32 + (i - 8)) * 2; dst[0] = cs; dst[1] = sn;
        }
    }
    SEAM(0);
    if (IN(1)) {
        KARGS();
        pg8::Gemm g{hbuf, Bt_in, D}; pg8::DenseOrder S; S.init(T / 256, N_IN / 256, G, bx);
        pg8::EpiIn E{qa, ka, va, cq, ckv, gates, kr, ropeA, ropeM, (const float*)AIN(15), sq};
        pg8::gemm_phase<pg8::EpiIn, pg8::DenseOrder, false, true>(lds, g, S, E);
    }
    SEAM(1);
    if (IN(2)) {
        KARGS();
        { pg8::Gemm g{cq, Bt_uq, QL}; pg8::DenseOrder S; S.init(T / 256, 1536 / 256, G, bx); pg8::EpiUp<true> E{qm, sq, ropeM};
          pg8::gemm_phase<pg8::EpiUp<true>, pg8::DenseOrder, false, true>(lds, g, S, E); }
        { pg8::Gemm g{ckv, Bt_ukv, KVL}; pg8::DenseOrder S; S.init(T / 256, 2048 / 256, G, G - 1 - bx); pg8::EpiUp<false> E{kv, sq, ropeM};
          pg8::gemm_phase<pg8::EpiUp<false>, pg8::DenseOrder, false, true>(lds, g, S, E); }
    }
    SEAM(2);
    if (IN(3)) {
        KARGS();
        const int lane = threadIdx.x & 63;
        const int wid = tid >> 6, r32 = lane & 31, hi = lane >> 5;
        for (int L = bx; L < 1024; L += G) {
            const int typ = L >> 9; int u = L & 511;
#if PROBE_PHASE == 3 && defined(PROBE_ATT)
            if (args.li == 1 && lo == 3 && typ != PROBE_ATT) continue;
#endif
            if (G == 256) { const int c = L & 255; u = (L & 256) + (c & 7) * 32 + (c >> 3); }
            const int bh = u >> 4, qb = u & 15, b = bh >> 3, h = bh & 7;
            const size_t q0 = (size_t)b * SEQ + qb * 256, k0 = (size_t)b * SEQ;
            f32x16 o[4];
            if (typ == 0 && (DBG_SKIP & 32)) {
                for (int i = tid; i < 256 * 128; i += 512) { const size_t a = (q0 + (i >> 7)) * 1024 + h * 128 + (i & 127);
                    const float v = (DBG_SKIP & 64) ? xin[a] : __uint_as_float((unsigned)qa[a] << 16) + __uint_as_float((unsigned)ka[a] << 16) + __uint_as_float((unsigned)va[a] << 16);
                    oa[a] = (bf16_t)(cvt_pk_bf16(v, 0.f) & 0xffffu); }
            } else
            if (typ == 0 && (ATT_MASK & 1)) {
                f32x4* st = (f32x4*)(stash + ((size_t)(bx * 8 + wid) * 64 + lane) * 64);
                { att::Src in{qa + q0 * 1024 + h * 128, ka + k0 * 1024 + h * 128, nullptr, va + k0 * 1024 + h * 128, 1024, 1024, 0, 1024};
                  att::attn_core<64>(in, 0.125f * 1.4426950408889634f, 8.f / 0.125f, SEQ, (LAS char*)lds, o); }
#pragma unroll
                for (int d = 0; d < 4; ++d)
#pragma unroll
                    for (int q4 = 0; q4 < 4; ++q4) st[d * 4 + q4] = (f32x4){o[d][4 * q4], o[d][4 * q4 + 1], o[d][4 * q4 + 2], o[d][4 * q4 + 3]};
                { att::Src in{qa + q0 * 1024 + h * 128 + 64, ka + k0 * 1024 + h * 128 + 64, nullptr, va + k0 * 1024 + h * 128, 1024, 1024, 0, 1024};
                  att::attn_core<64>(in, 0.125f * 1.4426950408889634f, 8.f / 0.125f, SEQ, (LAS char*)lds, o); }
                asm volatile("" : "+v"(st) :: "memory");
                float lam;
                { const float* lq1 = (const float*)AIN(4); const float* lk1 = (const float*)AIN(5); const float* lq2 = (const float*)AIN(6); const float* lk2 = (const float*)AIN(7);
                  const float s1 = wave_sum(lq1[lane] * lk1[lane]), s2 = wave_sum(lq2[lane] * lk2[lane]); lam = __expf(s1) - __expf(s2) + LAM_INIT; }
                float ss[16];
#pragma unroll
                for (int r = 0; r < 16; ++r) ss[r] = 0.f;
#pragma unroll
                for (int d = 0; d < 4; ++d) {
#pragma unroll
                    for (int q4 = 0; q4 < 4; ++q4) { const f32x4 sv = st[d * 4 + q4];
#pragma unroll
                        for (int j = 0; j < 4; ++j) { const int r = 4 * q4 + j; const float v = sv[j] - lam * o[d][r]; o[d][r] = v; ss[r] += v * v; } }
                    asm volatile("" ::: "memory"); }
#pragma unroll
                for (int r = 0; r < 16; ++r) {
#pragma unroll
                    for (int msk = 1; msk < 32; msk <<= 1) ss[r] += __shfl_xor(ss[r], msk);
                    ss[r] = __builtin_amdgcn_rsqf(ss[r] * (1.0f / 128.0f) + EPS); }
                bf16_t* Ow = oa + (q0 + wid * 32) * 1024 + h * 128 + r32; asm volatile("" : "+v"(Ow));
                float gs[4];
#pragma unroll
                for (int d = 0; d < 4; ++d) gs[d] = ((const float*)AIN(8))[d * 32 + r32] * (1.0f - LAM_INIT);
#pragma unroll
                for (int r = 0; r < 16; ++r) { const int orow = att::crow(r, hi);
#pragma unroll
                    for (int d = 0; d < 4; ++d) Ow[(size_t)orow * 1024 + d * 32] = (bf16_t)(cvt_pk_bf16(o[d][r] * ss[r] * gs[d], 0.f) & 0xffffu); }
            } else if (ATT_MASK & 2) {
                { att::Src in{qm + q0 * 1536 + h * 192, kv + k0 * 2048 + h * 256, kr + k0 * 64, kv + k0 * 2048 + h * 256 + 128, 1536, 2048, 64, 2048};
                  att::attn_core<192>(in, 0.07216878364870322f * 1.4426950408889634f, 8.f / 0.07216878364870322f, SEQ, (LAS char*)lds, o); }
                bf16_t* Ow = ob + (q0 + wid * 32) * 1024 + h * 128 + r32; asm volatile("" : "+v"(Ow));
#pragma unroll
                for (int r = 0; r < 16; ++r) { const int orow = att::crow(r, hi);
#pragma unroll
                    for (int d = 0; d < 4; ++d) Ow[(size_t)orow * 1024 + d * 32] = (bf16_t)(cvt_pk_bf16(o[d][r], 0.f) & 0xffffu); }
            }
        }
    }
    SEAM(3);
    if (IN(4)) {
        KARGS();
        { pg8::Gemm g{oa, Bt_od, D}; pg8::DenseOrder S; S.init(T / 256, 4, G, bx); pg8::EpiGate<0> E{mrg, gates};
          pg8::gemm_phase<pg8::EpiGate<0>, pg8::DenseOrder, false, true>(lds, g, S, E); }
        VM_WAIT(); __syncthreads();
        { pg8::Gemm g{ob, Bt_om, D}; pg8::DenseOrder S; S.init(T / 256, 4, G, bx); pg8::EpiGate<1> E{mrg, gates};
          pg8::gemm_phase<pg8::EpiGate<1>, pg8::DenseOrder, false, true>(lds, g, S, E); }
    }
    SEAM(4);
    if (IN(5)) {
        KARGS();
        pg8::Gemm g{mrg, Bt_out, D}; pg8::DenseOrder S; S.init(T / 256, 4, G, bx); pg8::EpiRes E{xin, AOUT};
        pg8::gemm_phase<pg8::EpiRes, pg8::DenseOrder, false, true>(lds, g, S, E);
    }
    SEAM(5);
    if (IN(6)) {
        KARGS();
        LANE_DECL;
        const float* g_ffn = (const float*)AIN(17); const float* w_router = (const float*)AIN(18); const float* b_router = (const float*)AIN(19);
        constexpr int WRS = 1028;
        LAS float* wr_l = (LAS float*)lds;
        LAS int* lcount = (LAS int*)(lds + TAB_OFF + 1024); LAS int* gbase = lcount + 32; LAS unsigned* asg_e = (LAS unsigned*)(lcount + 64); LAS float* asg_w = (LAS float*)(lcount + 64 + 256);
        LAS int* sync_w = (LAS int*)(lds + TAB_OFF + 512);
        for (int i = tid; i < D * NEXP; i += 512) wr_l[(i & 31) * WRS + (i >> 5)] = w_router[i];
        if (tid < 32) lcount[tid] = 0;
        if (tid < 2) sync_w[tid] = 0;
        __syncthreads();
        const int ex = (lane >> 1) & 31;
        LAS float* lg = (LAS float*)(lds + TAB_OFF + 4096) + wave * 80;
        const int chunk = bx;
        if (wave < 4 && chunk < T / 64) {
            const float my_b = b_router[ex];
#pragma unroll 1
            for (int j2 = 0; j2 < 8; ++j2) {
                const int tl = wave * 16 + j2 * 2, t = chunk * 64 + tl;
                f32x4 xva[4], xvb[4]; float sa = 0.f, sb = 0.f;
                { const f32x4* xa = (const f32x4*)(AOUT + (size_t)t * D) + lane; const f32x4* xb = xa + D / 4;
#pragma unroll
                  for (int j = 0; j < 4; ++j) { xva[j] = xa[64 * j]; xvb[j] = xb[64 * j]; }
#pragma unroll
                  for (int j = 0; j < 4; ++j) { sa += (xva[j][0] * xva[j][0] + xva[j][1] * xva[j][1]) + (xva[j][2] * xva[j][2] + xva[j][3] * xva[j][3]); sb += (xvb[j][0] * xvb[j][0] + xvb[j][1] * xvb[j][1]) + (xvb[j][2] * xvb[j][2] + xvb[j][3] * xvb[j][3]); } }
                const float ra = __builtin_amdgcn_rsqf(wave_sum(sa) * (1.f / D) + EPS), rb = __builtin_amdgcn_rsqf(wave_sum(sb) * (1.f / D) + EPS);
                { u32x2* oa8 = (u32x2*)(h2 + (size_t)t * D) + lane; u32x2* ob8 = oa8 + D / 4;
#pragma unroll
                  for (int j = 0; j < 4; ++j) { const f32x4 gg = *((const f32x4*)g_ffn + lane + 64 * j); xva[j] = xva[j] * ra * gg; xvb[j] = xvb[j] * rb * gg;
                    u32x2 w; w.x = cvt_pk_bf16(xva[j][0], xva[j][1]); w.y = cvt_pk_bf16(xva[j][2], xva[j][3]); oa8[64 * j] = w;
                    w.x = cvt_pk_bf16(xvb[j][0], xvb[j][1]); w.y = cvt_pk_bf16(xvb[j][2], xvb[j][3]); ob8[64 * j] = w; } }
                float aa[32], ab[32];
#pragma unroll
                for (int e = 0; e < NEXP; ++e) { float a = 0.f, b = 0.f;
#pragma unroll
                    for (int j = 0; j < 4; ++j) { const f32x4 w4 = *(const LAS f32x4*)(wr_l + e * WRS + 4 * lane + 256 * j);
                        a += (xva[j][0] * w4[0] + xva[j][1] * w4[1]) + (xva[j][2] * w4[2] + xva[j][3] * w4[3]); b += (xvb[j][0] * w4[0] + xvb[j][1] * w4[1]) + (xvb[j][2] * w4[2] + xvb[j][3] * w4[3]); }
                    aa[e] = a; ab[e] = b; }
#define TRED(arr, n, msk) _Pragma("unroll") for (int i_ = 0; i_ < (n); ++i_) { const bool up_ = (lane & (msk)) != 0; const float keep_ = up_ ? arr[(n) + i_] : arr[i_], give_ = up_ ? arr[i_] : arr[(n) + i_]; arr[i_] = keep_ + __shfl_xor(give_, (msk)); }
                TRED(aa, 16, 32) TRED(aa, 8, 16) TRED(aa, 4, 8) TRED(aa, 2, 4) TRED(aa, 1, 2)
                TRED(ab, 16, 32) TRED(ab, 8, 16) TRED(ab, 4, 8) TRED(ab, 2, 4) TRED(ab, 1, 2)
#undef TRED
                const float la = aa[0] + __shfl_xor(aa[0], 1) + my_b, lb = ab[0] + __shfl_xor(ab[0], 1) + my_b;
#pragma unroll
                for (int tk = 0; tk < 2; ++tk) {
                    const float v = tk ? lb : la; int rank = 0;
                    if (!(lane & 1)) lg[tk * 32 + ex] = v;
                    LDS_WAIT();
#pragma unroll
                    for (int q = 0; q < 8; ++q) { const f32x4 s4 = *(const LAS f32x4*)(lg + tk * 32 + 4 * q);
#pragma unroll
                        for (int jj = 0; jj < 4; ++jj) rank += (s4[jj] > v || (s4[jj] == v && (4 * q + jj) < ex)) ? 1 : 0; }
                    if (rank < 4 && !(lane & 1)) lg[64 + tk * 4 + rank] = v;
                    LDS_WAIT();
                    const f32x4 tv = *(const LAS f32x4*)(lg + 64 + tk * 4);
                    const float p1 = __expf(tv[1] - tv[0]), p2 = __expf(tv[2] - tv[0]), p3 = __expf(tv[3] - tv[0]), inv = 1.0f / (1.0f + p1 + p2 + p3);
                    if (rank < 4 && !(lane & 1)) { const float w = (rank == 0 ? 1.0f : (rank == 1 ? p1 : (rank == 2 ? p2 : p3))) * inv;
                        const int lr = __hip_atomic_fetch_add((LAS int*)&lcount[ex], 1, __ATOMIC_RELAXED, __HIP_MEMORY_SCOPE_WORKGROUP);
                        asg_e[(tl + tk) * 4 + rank] = ((unsigned)ex << 16) | (unsigned)lr; asg_w[(tl + tk) * 4 + rank] = w; }
                }
            }
            LDS_WAIT();
            if (lane == 0) __hip_atomic_fetch_add((LAS int*)&sync_w[0], 1, __ATOMIC_RELAXED, __HIP_MEMORY_SCOPE_WORKGROUP);
            if (wave == 0) {
                while (__hip_atomic_load((LAS int*)&sync_w[0], __ATOMIC_RELAXED, __HIP_MEMORY_SCOPE_WORKGROUP) < 4) __builtin_amdgcn_s_sleep(4);
                asm volatile("s_waitcnt lgkmcnt(0)" ::: "memory");
                if (lane < 32) gbase[lane] = (int)__hip_atomic_fetch_add(count + lane, (unsigned)lcount[lane], __ATOMIC_RELAXED, __HIP_MEMORY_SCOPE_AGENT);
                LDS_WAIT();
#pragma unroll
                for (int q = 0; q < 4; ++q) { const int a_ = q * 64 + lane; const unsigned ae = asg_e[a_]; const int e = ae >> 16, rank = gbase[e] + (int)(ae & 0xffffu); const int t = chunk * 64 + (a_ >> 2);
                    rowtok_p[e * T + rank] = t; u32x2 av; av.x = ((unsigned)e << 16) | (unsigned)rank; av.y = __float_as_uint(asg_w[a_]); assign[(size_t)t * 4 + (a_ & 3)] = av; }
            }
        }
        const float* w_gate = (const float*)AIN(20); const float* w_up = (const float*)AIN(22); const float* w_down = (const float*)AIN(24);
        const int per_wg = (NEXP * 768 + G - 1) / G;
        for (;;) {
            int it = 0; if (lane == 0) it = __hip_atomic_fetch_add((LAS int*)&sync_w[1], 1, __ATOMIC_RELAXED, __HIP_MEMORY_SCOPE_WORKGROUP);
            it = __builtin_amdgcn_readfirstlane(it); const int item = bx * per_wg + it;
            if (it >= per_wg || item >= NEXP * 768) break;
            const int e = item / 768, r = item % 768, mat = r >> 8, kb = (r >> 4) & 15, nb = r & 15, f0 = nb * 64;
            if (mat < 2) cvt_tile64((mat ? w_up : w_gate) + (size_t)e * D * FF, FF, Bt_gu + (size_t)e * 2048 * D, D, kb * 64, f0, 256 * (f0 >> 7) + mat * 128 + (f0 & 127), lane);
            else cvt_tile64(w_down + (size_t)e * FF * D, D, Bt_d + (size_t)e * D * FF, FF, kb * 64, f0, f0, lane);
        }
    }
    SEAM(6);
    LAS int* t_cnt = (LAS int*)(lds + TAB_OFF + 4096); LAS int* t_start = t_cnt + 32; LAS int* t_t2e = t_start + 40;
    if (IN(7) || IN(8) || IN(9)) {
        KARGS();
        __syncthreads();
        if (tid < 32) t_cnt[tid] = (int)__hip_atomic_load(count + tid, __ATOMIC_RELAXED, __HIP_MEMORY_SCOPE_AGENT);
        __syncthreads();
        if (tid == 0) { int s = 0; for (int e = 0; e < NEXP; ++e) { t_start[e] = s; s += (t_cnt[e] + 255) >> 8; } t_start[32] = s; }
        __syncthreads();
        if (tid < 32) { for (int rt = t_start[tid]; rt < t_start[tid + 1]; ++rt) t_t2e[rt] = tid; }
        __syncthreads();
    }
    if (IN(7)) {
        KARGS();
        pg8::Gemm g{h2, Bt_gu, D}; pg8::MoeOrder S; S.init(t_start[32], 8, G, bx); S.t2e = t_t2e; S.tstart = t_start; S.cnt = t_cnt; S.rowtok = rowtok_p;
        pg8::EpiSwiglu E{act, (const float*)AIN(21), (const float*)AIN(23)};
        pg8::gemm_phase<pg8::EpiSwiglu, pg8::MoeOrder, true, true>(lds, g, S, E);
    }
    SEAM(7);
    if (IN(8)) {
        KARGS();
        pg8::Gemm g{act, Bt_d, FF}; pg8::MoeOrder S; S.init(t_start[32], 4, G, bx); S.t2e = t_t2e; S.tstart = t_start; S.cnt = t_cnt; S.rowtok = rowtok_p;
        pg8::EpiDown E{ybuf, (const float*)AIN(25)};
        pg8::gemm_phase<pg8::EpiDown, pg8::MoeOrder, false, true>(lds, g, S, E);
    }
    SEAM(8);
    if (IN(9) && DBG_OUT) {
        KARGS();
        const bf16_t* src = DBG_OUT == 1 ? gates : DBG_OUT == 2 ? gates + 1024 : DBG_OUT == 3 ? qa : DBG_OUT == 4 ? ka : DBG_OUT == 5 ? va : DBG_OUT == 6 ? mrg : DBG_OUT == 7 ? oa : DBG_OUT == 9 ? Bt_in : ob;
        const int ld = DBG_OUT <= 2 ? 2048 : 1024;
        for (size_t i = (size_t)bx * 512 + tid; i < (size_t)T * 1024; i += (size_t)G * 512) AOUT[i] = (DBG_OUT == 9 && i >= (size_t)N_IN * 1024) ? 0.f : __uint_as_float((unsigned)src[(i >> 10) * ld + (i & 1023)] << 16);
    } else
    if (IN(9)) {
        KARGS();
        LANE_DECL;
        const float* g_fin = (const float*)AIN(26);
        for (int t = gw; t < T; t += NGW) {
            f32x4* xr = (f32x4*)(AOUT + (size_t)t * D) + lane; f32x4 v[4];
#pragma unroll
            for (int j = 0; j < 4; ++j) v[j] = xr[64 * j];
#pragma unroll
            for (int k = 0; k < ((DBG_SKIP & 1) ? 0 : 4); ++k) { const u32x2 a = assign[(size_t)t * 4 + k]; const int e = a.x >> 16, rank = a.x & 0xffffu; const float w = __uint_as_float(a.y);
                const u32x2* yr = (const u32x2*)(ybuf + ((size_t)t_start[e] * 256 + rank) * D) + lane;
#pragma unroll
                for (int j = 0; j < 4; ++j) { const u32x2 yw = yr[64 * j]; v[j][0] += w * bf_lo(yw.x); v[j][1] += w * bf_hi(yw.x); v[j][2] += w * bf_lo(yw.y); v[j][3] += w * bf_hi(yw.y); } }
            float s = 0.f;
#pragma unroll
            for (int j = 0; j < 4; ++j) s += (v[j][0] * v[j][0] + v[j][1] * v[j][1]) + (v[j][2] * v[j][2] + v[j][3] * v[j][3]);
            const float rstd = __builtin_amdgcn_rsqf(wave_sum(s) * (1.f / D) + EPS);
#pragma unroll
            for (int j = 0; j < 4; ++j) { const f32x4 gg = *((const f32x4*)g_fin + lane + 64 * j); xr[64 * j] = v[j] * rstd * gg; }
        }
    }
#undef IN
#undef SEAM
#undef KARGS
#undef AIN
#undef AOUT
#undef AWS
#undef xin
#undef positions
#undef Bt_in
#undef Bt_uq
#undef Bt_ukv
#undef Bt_od
#undef Bt_om
#undef Bt_out
#undef ropeA
#undef ropeM
#undef sq
#undef hbuf
#undef oa
#undef qa
#undef ka
#undef va
#undef cq
#undef ckv
#undef kr
#undef gates
#undef qm
#undef kv
#undef ob
#undef mrg
#undef stash
#undef rowtok_p
#undef assign
#undef Bt_d
#undef Bt_gu
#undef h2
#undef act
#undef ybuf
#undef count
}

extern "C" void kernel_launch(void* const* d_in, const int* in_sizes, int n_in, void* d_out, int out_size, void* d_ws, size_t ws_size, hipStream_t stream) {
    static int grid = 0;
    if (grid == 0) {
        if (n_in != 27 || in_sizes[0] != T * D || out_size != T * D || ws_size < WS_END) { fprintf(stderr, "kernel_launch: unexpected shapes (n_in %d, in0 %d, out %d, ws %zu < %zu)\n", n_in, n_in > 0 ? in_sizes[0] : -1, out_size, ws_size, (size_t)WS_END); grid = -1; return; }
        int dev = 0, cus = 0, per_cu = 0;
        if (hipGetDevice(&dev) != hipSuccess || hipDeviceGetAttribute(&cus, hipDeviceAttributeMultiprocessorCount, dev) != hipSuccess) { grid = -1; return; }
        if (hipFuncSetAttribute((const void*)fwd, hipFuncAttributeMaxDynamicSharedMemorySize, LDS_BYTES) != hipSuccess) { fprintf(stderr, "kernel_launch: hipFuncSetAttribute failed\n"); grid = -1; return; }
        if (hipOccupancyMaxActiveBlocksPerMultiprocessor(&per_cu, (const void*)fwd, NWAVES * 64, LDS_BYTES) != hipSuccess || per_cu < 1) fprintf(stderr, "kernel_launch: occupancy query says %d\n", per_cu);
        (void)hipGetLastError();
        grid = cus;
    }
    if (grid < 0) return;
    if (hipMemsetAsync((char*)d_ws + WS_CTL, 0, CTL_ZERO_BYTES, stream) != hipSuccess) return;
    Args a{};
    for (int i = 0; i < 27; ++i) a.in[i] = d_in[i];
    a.out = (float*)d_out; a.ws = (unsigned char*)d_ws;
#if MK_PER_PHASE
    for (int p = 0; p < NPHASE; ++p) { a.ph_lo = p; a.ph_hi = p + 1; hipLaunchKernelGGL(fwd, dim3(grid), dim3(NWAVES * 64), LDS_BYTES, stream, a); }
#elif PROBE_PHASE >= 0
    a.ph_lo = 0; a.ph_hi = PROBE_PHASE + 1; a.li = 0; hipLaunchKernelGGL(fwd, dim3(grid), dim3(NWAVES * 64), LDS_BYTES, stream, a);
    a.ph_lo = PROBE_PHASE; a.ph_hi = NPHASE; a.li = 1; hipLaunchKernelGGL(fwd, dim3(grid), dim3(NWAVES * 64), LDS_BYTES, stream, a);
#else
    a.ph_lo = 0; a.ph_hi = NPHASE; hipLaunchKernelGGL(fwd, dim3(grid), dim3(NWAVES * 64), LDS_BYTES, stream, a);
#endif
}
```

```cpp
#include <hip/hip_runtime.h>
#include <cstdio>
#include <cstdint>

#ifndef MK_PER_PHASE
#define MK_PER_PHASE 0
#endif

#ifndef PROBE_PHASE
#define PROBE_PHASE -1
#endif
#ifndef ATT_DUP
#define ATT_DUP 0
#endif
#ifndef DBG_OUT
#define DBG_OUT 0
#endif
#ifndef DBG_SKIP
#define DBG_SKIP 0
#endif
#ifndef ATT_MASK
#define ATT_MASK 3
#endif
#ifndef PH_MASK
#define PH_MASK 0x3ff
#endif
#define LAS __attribute__((address_space(3)))
#define GAS __attribute__((address_space(1)))
typedef unsigned short bf16_t;
typedef short bf16x8 __attribute__((ext_vector_type(8)));
typedef short s16x4 __attribute__((ext_vector_type(4)));
typedef float f32x2 __attribute__((ext_vector_type(2)));
typedef float f32x4 __attribute__((ext_vector_type(4)));
typedef float f32x16 __attribute__((ext_vector_type(16)));
typedef unsigned u32x2 __attribute__((ext_vector_type(2)));
typedef unsigned u32x4 __attribute__((ext_vector_type(4)));

constexpr int NB = 4, SEQ = 4096, T = NB * SEQ, D = 1024;
constexpr int NEXP = 32, TOPK = 4, FF = 1024;
constexpr int N_IN = 6656;
constexpr int QL = 768, KVL = 512;
constexpr float EPS = 1e-6f;
constexpr float LAM_INIT = 0.2f;
constexpr int NPHASE = 10;

constexpr size_t MiB = 1u << 20;
constexpr size_t WS_CTL = 0, CTL_ZERO_BYTES = 1 * MiB;
constexpr size_t WS_BT_IN = 2 * MiB;
constexpr size_t WS_BT_UQ = 15 * MiB;
constexpr size_t WS_BT_UKV = 18 * MiB;
constexpr size_t WS_BT_OD = 20 * MiB, WS_BT_OM = 22 * MiB, WS_BT_OUT = 24 * MiB;
constexpr size_t WS_ROPEA = 26 * MiB;
constexpr size_t WS_ROPEM = 27 * MiB;
constexpr size_t WS_SQ = 31 * MiB;
constexpr size_t WS_SQP = 1 * MiB;
constexpr size_t WS_H = 32 * MiB;
constexpr size_t WS_QA = 64 * MiB, WS_KA = 96 * MiB, WS_VA = 128 * MiB;
constexpr size_t WS_CQ = 160 * MiB, WS_CKV = 184 * MiB, WS_KR = 200 * MiB;
constexpr size_t WS_SQ2 = 202 * MiB;
constexpr size_t WS_GATES = 208 * MiB;
constexpr size_t WS_QM = 272 * MiB;
constexpr size_t WS_KV = 320 * MiB;
constexpr size_t WS_OB = 384 * MiB;
constexpr size_t WS_MRG = 416 * MiB;
constexpr size_t WS_STASH = 448 * MiB;
constexpr size_t WS_ROWTOK = 2 * MiB;
constexpr size_t WS_ASSIGN = 4 * MiB;
constexpr size_t WS_BT_D = 32 * MiB;
constexpr size_t WS_BT_GU = 96 * MiB;
constexpr size_t WS_H2 = 224 * MiB;
constexpr size_t WS_ACT = 256 * MiB;
constexpr size_t WS_Y = 96 * MiB;
constexpr size_t WS_END = 512 * MiB;
constexpr int CW_COUNT = 64;
constexpr int CW_BAR = 4096;

constexpr int RING_BYTES = 131072;
constexpr int TAB_OFF = RING_BYTES;
constexpr int TAB_BYTES = 8192;
constexpr int MISC_OFF = TAB_OFF + TAB_BYTES;
constexpr int LDS_BYTES = 147456;

typedef __bf16 bf16x2_t __attribute__((ext_vector_type(2)));
__device__ __forceinline__ unsigned cvt_pk_bf16(float lo, float hi) { const f32x2 v = {lo, hi}; return __builtin_bit_cast(unsigned, __builtin_convertvector(v, bf16x2_t)); }
__device__ __forceinline__ float bf_lo(unsigned w) { return __uint_as_float(w << 16); }
__device__ __forceinline__ float bf_hi(unsigned w) { return __uint_as_float(w & 0xffff0000u); }
__device__ __forceinline__ float wave_sum(float v) {
#pragma unroll
    for (int o = 1; o < 64; o <<= 1) v += __shfl_xor(v, o);
    return v;
}
__device__ __forceinline__ float sigmoidf_(float x) { return __builtin_amdgcn_rcpf(1.0f + __builtin_amdgcn_exp2f(-1.4426950408889634f * x)); }
#define LDS_WAIT() asm volatile("s_waitcnt lgkmcnt(0)" ::: "memory")
#define VM_WAIT() asm volatile("s_waitcnt vmcnt(0)" ::: "memory")

#define XB_TMO      128
#define XB_XCNT(j)  (256  + 64 * (j))
#define XB_XSUB(j)  (1280 + 64 * (j))
#define XB_XGEN(j)  (2304 + 64 * (j))
#define XB_TOP      3328
#define XB_TOPGEN   3392
#define XCD_BAR_WORDS 3456
#define XB_SPIN_CAP (1u << 20)
__device__ __forceinline__ unsigned xb_ld(unsigned* p)              { return __hip_atomic_load(p, __ATOMIC_RELAXED, __HIP_MEMORY_SCOPE_AGENT); }
__device__ __forceinline__ unsigned xb_add(unsigned* p, unsigned v) { return __hip_atomic_fetch_add(p, v, __ATOMIC_RELAXED, __HIP_MEMORY_SCOPE_AGENT); }
__device__ __forceinline__ unsigned xb_xcc_id() { return (unsigned)__builtin_amdgcn_s_getreg((3 << 11) | 20) & 0xFu; }
#define XB_SPIN(cond, bar) do { unsigned _sp = 0; while (cond) { __builtin_amdgcn_s_sleep(1); \
    if ((++_sp & 255u) == 0u) { if (xb_ld(&(bar)[XB_TMO])) break; if (_sp > XB_SPIN_CAP) { atomicAdd(&(bar)[XB_TMO], 1u); break; } } } } while (0)
struct XcdBarrier { unsigned* bar; unsigned x; volatile LAS unsigned* st; };
__device__ __forceinline__ XcdBarrier xcd_barrier_post(unsigned* bar, volatile LAS unsigned* st) {
    XcdBarrier b; b.bar = bar; b.x = xb_xcc_id(); b.st = st;
    if (threadIdx.x == 0) (void)xb_add(&bar[XB_XCNT(b.x)], 1u);
    return b;
}
__device__ __forceinline__ void xcd_barrier_complete(unsigned* bar, unsigned x, unsigned& nloc, unsigned& nx) {
    const unsigned G = gridDim.x * gridDim.y * gridDim.z;
    unsigned sum, cnt, mine, sp = 0u;
    for (;;) {
        sum = 0u; cnt = 0u; mine = 0u;
#pragma unroll
        for (unsigned j = 0; j < 16; ++j) { const unsigned c = xb_ld(&bar[XB_XCNT(j)]); sum += c; cnt += (c > 0u) ? 1u : 0u; mine = (j == x) ? c : mine; }
        if (sum == G) break;
        __builtin_amdgcn_s_sleep(1);
        if ((++sp & 255u) == 0u) { if (xb_ld(&bar[XB_TMO])) break; if (sp > XB_SPIN_CAP) { atomicAdd(&bar[XB_TMO], 1u); break; } }
    }
    nloc = mine > 0u ? mine : 1u; nx = cnt > 0u ? cnt : 1u;
}
__device__ __forceinline__ void xcd_barrier(const XcdBarrier& b) {
    asm volatile("s_waitcnt vmcnt(0)" ::: "memory");
    __syncthreads();
    if (threadIdx.x == 0) {
        unsigned* bar = b.bar;
        __builtin_amdgcn_s_waitcnt(0);
        unsigned nloc = b.st[0], nx = b.st[1];
        if (nloc == 0u) { xcd_barrier_complete(bar, b.x, nloc, nx); b.st[0] = nloc; b.st[1] = nx; }
        const unsigned old = xb_add(&bar[XB_XSUB(b.x)], 1u);
        const unsigned gen = old / nloc;
        if (old + 1u == (gen + 1u) * nloc) {
            __builtin_amdgcn_fence(__ATOMIC_RELEASE, "agent");
            asm volatile("s_waitcnt vmcnt(0)" ::: "memory");
            const unsigned og = xb_add(&bar[XB_TOP], 1u);
            const unsigned tg = og / nx;
            if (og + 1u == (tg + 1u) * nx) xb_add(&bar[XB_TOPGEN], 1u);
            else XB_SPIN(xb_ld(&bar[XB_TOPGEN]) == tg, bar);
            __builtin_amdgcn_fence(__ATOMIC_ACQUIRE, "agent");
            xb_add(&bar[XB_XGEN(b.x)], 1u);
            asm volatile("s_waitcnt vmcnt(0)" ::: "memory");
        } else {
            XB_SPIN(xb_ld(&bar[XB_XGEN(b.x)]) == gen, bar);
            __builtin_amdgcn_fence(__ATOMIC_ACQUIRE, "agent");
            asm volatile("s_waitcnt vmcnt(0)" ::: "memory");
        }
    }
    __syncthreads();
}

namespace pg8 {
constexpr int BM = 256, BK = 64, HALF = 128, HTB = HALF * BK * 2, STAGE_BYTES = 8 * HTB, NXCD = 8, WGM = 8;
__host__ __device__ __forceinline__ int lds_byte(int r, int c) { const int st = (r >> 4) * 2 + (c >> 5), rr = r & 15, cc = c & 31, ob = rr * 64 + cc * 2; return st * 1024 + (ob ^ (((ob >> 9) & 1) << 5)); }
__host__ __device__ __forceinline__ void stage_rc(int b, int& R, int& C) { const int st = b / 1024, sb = b % 1024, swz = sb ^ (((sb >> 9) & 1) << 5); R = (st >> 1) * 16 + swz / 64; C = (st & 1) * 32 + (swz % 64) / 2; }
__host__ __device__ __forceinline__ int perm32(int rho) { const int n = rho >> 4, i = rho & 15; return 8 * (i >> 2) + 4 * n + (i & 3); }

struct Unit { int pm, pn, pb, e, rbase, cnt; };
struct Gemm { const bf16_t* A; const bf16_t* Bt; int K; };

struct DenseOrder {
    int nM, nN, nwg, G, c;
    __device__ void init(int nM_, int nN_, int G_, int c_) { nM = nM_; nN = nN_; nwg = nM * nN; G = G_; c = c_; }
    __device__ __forceinline__ bool next(int i, Unit& u) const {
        const long L = (long)i * G + c; if (L >= nwg) return false;
        int wgid = (int)L; { const int q = nwg / NXCD, r = nwg % NXCD, xcd = wgid % NXCD, off = wgid / NXCD; wgid = (xcd < r ? xcd * (q + 1) : r * (q + 1) + (xcd - r) * q) + off; }
        const int nig = WGM * nN, gid = wgid / nig, fm = gid * WGM, gsz = (nM - fm) < WGM ? (nM - fm) : WGM;
        u.pm = fm + ((wgid % nig) % gsz); u.pn = (wgid % nig) / gsz; if (DBG_SKIP & 128) u.pn = nN - 1 - u.pn; u.pb = u.pn; u.e = 0; u.rbase = 0; u.cnt = 0; return true;
    }
    __device__ __forceinline__ int a_row(const Unit&, int) const { return 0; }
};
struct MoeOrder {
    int nM, nN, nwg, G, c; const LAS int* t2e; const LAS int* tstart; const LAS int* cnt; const int* rowtok;
    __device__ void init(int nM_, int nN_, int G_, int c_) { nM = nM_; nN = nN_; nwg = nM * nN; G = G_; c = c_; }
    __device__ __forceinline__ bool next(int i, Unit& u) const {
        const long L = (long)i * G + c; if (L >= nwg) return false;
        int wgid = (int)L; { const int q = nwg / NXCD, r = nwg % NXCD, xcd = wgid % NXCD, off = wgid / NXCD; wgid = (xcd < r ? xcd * (q + 1) : r * (q + 1) + (xcd - r) * q) + off; }
        const int nig = WGM * nN, gid = wgid / nig, fm = gid * WGM, gsz = (nM - fm) < WGM ? (nM - fm) : WGM;
        u.pm = fm + ((wgid % nig) % gsz); u.pn = (wgid % nig) / gsz;
        const int e = t2e[u.pm]; u.e = e; u.pb = e * nN + u.pn; u.rbase = (u.pm - tstart[e]) * 256; u.cnt = cnt[e]; return true;
    }
    __device__ __forceinline__ int a_row(const Unit& u, int r) const { const int rank = u.rbase + r; return rank < u.cnt ? rowtok[u.e * T + rank] : 0; }
};

template <class Epi, class Sched, bool GATHER, bool ALIGN_EPI>
__device__ __forceinline__ void gemm_phase(LAS unsigned char* lds, const Gemm g, const Sched& S, const Epi& E) {
    const int tid = threadIdx.x, wid = __builtin_amdgcn_readfirstlane(tid >> 6), lane = tid & 63, wr = wid >> 2, wc = wid & 3, fr = lane & 15, fq = lane >> 4;
    const int K = g.K, nt = K / BK;
    unsigned voffA[2], voffB[2]; int Rv[2], Cv[2];
#pragma unroll
    for (int i = 0; i < 2; ++i) { int R, C; stage_rc(tid * 16 + i * 8192, R, C); const int Rb = Epi::PERM ? ((R & ~31) + perm32(R & 31)) : R;
        voffA[i] = (unsigned)(R * K + C) * 2u; voffB[i] = (unsigned)(Rb * K + C) * 2u; Rv[i] = R; Cv[i] = C; }
    const size_t kstep = (size_t)(BK * 2);
    const size_t hstep = (size_t)HALF * K * 2;
    const size_t tstep = 2 * hstep;
    const unsigned ldsw = (unsigned)wid * 1024u;
    const int aoff = lds_byte(wr * 64 + fr, fq * 8), boff = lds_byte(wc * 32 + fr, fq * 8);
#define PG8_SA(b, h) (((b) * 2 + (h)) * HTB)
#define PG8_SB(b, h) ((4 + (b) * 2 + (h)) * HTB)
#define PG8_STAGE(bufoff, gbase, voff) do { _Pragma("unroll") for (int _i = 0; _i < 2; ++_i) \
        __builtin_amdgcn_global_load_lds((const unsigned*)((const char*)(gbase) + (voff)[_i]), (LAS unsigned*)(lds + (bufoff) + ldsw + _i * 8192), 16, 0, 0); } while (0)
#define PG8_LDA(dst, b, h) do { _Pragma("unroll") for (int m = 0; m < 4; ++m) _Pragma("unroll") for (int k = 0; k < 2; ++k) dst[m][k] = *(const LAS bf16x8*)(lds + PG8_SA(b, h) + aoff + m * 2048 + k * 1024); } while (0)
#define PG8_LDB(dst, b, h) do { _Pragma("unroll") for (int n = 0; n < 2; ++n) _Pragma("unroll") for (int k = 0; k < 2; ++k) dst[n][k] = *(const LAS bf16x8*)(lds + PG8_SB(b, h) + boff + n * 2048 + k * 1024); } while (0)
#define PG8_MMA(ai, bj, At, Bt) do { __builtin_amdgcn_s_setprio(1); _Pragma("unroll") for (int m = 0; m < 4; ++m) _Pragma("unroll") for (int n = 0; n < 2; ++n) _Pragma("unroll") for (int k = 0; k < 2; ++k) \
        acc[ai][bj][m][n] = __builtin_amdgcn_mfma_f32_16x16x32_bf16(Bt[n][k], At[m][k], acc[ai][bj][m][n], 0, 0, 0); __builtin_amdgcn_s_setprio(0); } while (0)
#define PG8_WAIT_V(n) asm volatile("s_waitcnt vmcnt(" #n ")" ::: "memory")
#define PG8_WAIT_L(n) asm volatile("s_waitcnt lgkmcnt(" #n ")" ::: "memory")
#define PG8_BAR __builtin_amdgcn_s_barrier()
#define PG8_SCHED __builtin_amdgcn_sched_barrier(0)
    Unit cur, nxt; int ui = 0;
    if (!S.next(0, cur)) return;
    f32x4 acc[2][2][4][2];
#pragma unroll
    for (int a = 0; a < 2; ++a)
#pragma unroll
        for (int b = 0; b < 2; ++b)
#pragma unroll
            for (int m = 0; m < 4; ++m)
#pragma unroll
                for (int n = 0; n < 2; ++n) acc[a][b][m][n] = (f32x4){0.f, 0.f, 0.f, 0.f};
    bf16x8 At[4][2], B0[2][2], B1[2][2];
    unsigned gC0[2], gC1[2], gN0[2], gN1[2];
    if constexpr (GATHER) {
#pragma unroll
        for (int i = 0; i < 2; ++i) { gC0[i] = (unsigned)S.a_row(cur, Rv[i]) * (unsigned)(K * 2) + (unsigned)Cv[i] * 2u; gC1[i] = (unsigned)S.a_row(cur, HALF + Rv[i]) * (unsigned)(K * 2) + (unsigned)Cv[i] * 2u; gN0[i] = gC0[i]; gN1[i] = gC1[i]; }
    }
    const char* cA = GATHER ? (const char*)g.A : (const char*)g.A + (size_t)cur.pm * tstep; const char* cB = (const char*)g.Bt + (size_t)cur.pb * tstep;
#define PG8_STAGE_A(bufoff, p, h, o0, o1) do { if constexpr (GATHER) { if ((h) == 0) PG8_STAGE(bufoff, p, o0); else PG8_STAGE(bufoff, p, o1); } else { PG8_STAGE(bufoff, (p) + (h) * hstep, voffA); } } while (0)
    PG8_STAGE(PG8_SB(0, 0), cB, voffB); PG8_STAGE(PG8_SB(0, 1), cB + hstep, voffB); PG8_STAGE_A(PG8_SA(0, 0), cA, 0, gC0, gC1); PG8_STAGE_A(PG8_SA(0, 1), cA, 1, gC0, gC1);
    if (wr == 1) PG8_BAR;
    PG8_WAIT_V(2); PG8_BAR;
    PG8_STAGE(PG8_SB(1, 0), cB + kstep, voffB); PG8_STAGE_A(PG8_SA(1, 0), cA + kstep, 0, gC0, gC1); PG8_STAGE(PG8_SB(1, 1), cB + hstep + kstep, voffB);
    PG8_WAIT_V(6); PG8_BAR;
    for (;;) {
        const bool has_next = S.next(ui + 1, nxt);
        const char* nA = GATHER ? (const char*)g.A : (has_next ? (const char*)g.A + (size_t)nxt.pm * tstep : cA); const char* nB = has_next ? (const char*)g.Bt + (size_t)nxt.pb * tstep : cB;
        if constexpr (GATHER) { if (has_next) {
#pragma unroll
            for (int i = 0; i < 2; ++i) { gN0[i] = (unsigned)S.a_row(nxt, Rv[i]) * (unsigned)(K * 2) + (unsigned)Cv[i] * 2u; gN1[i] = (unsigned)S.a_row(nxt, HALF + Rv[i]) * (unsigned)(K * 2) + (unsigned)Cv[i] * 2u; } } }
        for (int t = 0; t < nt; t += 2) {
            const bool last = (t == nt - 2);
            const char* a1 = cA + (size_t)(t + 1) * kstep;
            const char* a2 = last ? nA : cA + (size_t)(t + 2) * kstep; const char* b2 = last ? nB : cB + (size_t)(t + 2) * kstep;
            const char* a3 = a2 + kstep; const char* b3 = b2 + kstep;
            unsigned s0[2], s1[2];
            if constexpr (GATHER) { s0[0] = last ? gN0[0] : gC0[0]; s0[1] = last ? gN0[1] : gC0[1]; s1[0] = last ? gN1[0] : gC1[0]; s1[1] = last ? gN1[1] : gC1[1]; }
            PG8_LDB(B0, 0, 0); PG8_LDB(B1, 0, 1); PG8_SCHED; PG8_LDA(At, 0, 0); PG8_STAGE_A(PG8_SA(1, 1), a1, 1, gC0, gC1);
            PG8_WAIT_V(8); PG8_WAIT_L(0); PG8_BAR; PG8_MMA(0, 0, At, B0); PG8_MMA(0, 1, At, B1); PG8_BAR; PG8_SCHED;
            PG8_LDA(At, 0, 1); PG8_STAGE(PG8_SB(0, 0), b2, voffB); PG8_STAGE(PG8_SB(0, 1), b2 + hstep, voffB); PG8_STAGE_A(PG8_SA(0, 0), a2, 0, s0, s1);
            PG8_WAIT_V(8); PG8_WAIT_L(0); PG8_BAR; PG8_MMA(1, 0, At, B0); PG8_MMA(1, 1, At, B1); PG8_BAR; PG8_SCHED;
            PG8_LDB(B0, 1, 0); PG8_LDB(B1, 1, 1); PG8_SCHED; PG8_LDA(At, 1, 0); PG8_STAGE_A(PG8_SA(0, 1), a2, 1, s0, s1);
            PG8_WAIT_V(8); PG8_WAIT_L(0); PG8_BAR; PG8_MMA(0, 0, At, B0); PG8_MMA(0, 1, At, B1); PG8_BAR; PG8_SCHED;
            PG8_LDA(At, 1, 1); PG8_STAGE(PG8_SB(1, 0), b3, voffB); PG8_STAGE(PG8_SB(1, 1), b3 + hstep, voffB); PG8_STAGE_A(PG8_SA(1, 0), a3, 0, s0, s1);
            PG8_WAIT_V(8); PG8_WAIT_L(0); PG8_BAR; PG8_MMA(1, 0, At, B0); PG8_MMA(1, 1, At, B1); PG8_BAR; PG8_SCHED;
        }
        if constexpr (ALIGN_EPI) { if (wr == 0) PG8_BAR; }
        E(acc, cur, wr, wc, fr, fq);
        if (!has_next) break;
#pragma unroll
        for (int a = 0; a < 2; ++a)
#pragma unroll
            for (int b = 0; b < 2; ++b)
#pragma unroll
                for (int m = 0; m < 4; ++m)
#pragma unroll
                    for (int n = 0; n < 2; ++n) acc[a][b][m][n] = (f32x4){0.f, 0.f, 0.f, 0.f};
        cur = nxt; cA = nA; cB = nB; ++ui;
        if constexpr (GATHER) { gC0[0] = gN0[0]; gC0[1] = gN0[1]; gC1[0] = gN1[0]; gC1[1] = gN1[1]; }
        if constexpr (ALIGN_EPI) { if (wr == 1) PG8_BAR; }
    }
    PG8_WAIT_V(0);
    if constexpr (!ALIGN_EPI) { if (wr == 0) PG8_BAR; }
    PG8_BAR;
#undef PG8_SA
#undef PG8_SB
#undef PG8_STAGE
#undef PG8_STAGE_A
#undef PG8_LDA
#undef PG8_LDB
#undef PG8_MMA
#undef PG8_WAIT_V
#undef PG8_WAIT_L
#undef PG8_BAR
#undef PG8_SCHED
}

__device__ __forceinline__ u32x4 pack8(const f32x4& v0, const f32x4& v1) { u32x4 w; w.x = cvt_pk_bf16(v0[0], v0[1]); w.y = cvt_pk_bf16(v0[2], v0[3]); w.z = cvt_pk_bf16(v1[0], v1[1]); w.w = cvt_pk_bf16(v1[2], v1[3]); return w; }
__device__ __forceinline__ void rope4(f32x4& v0, f32x4& v1, const float* cs) {
    const f32x4 a = *(const f32x4*)cs, b = *(const f32x4*)(cs + 4);
    float x1, x2;
    x1 = v0[0]; x2 = v0[1]; v0[0] = x1 * a[0] - x2 * a[1]; v0[1] = x2 * a[0] + x1 * a[1];
    x1 = v0[2]; x2 = v0[3]; v0[2] = x1 * a[2] - x2 * a[3]; v0[3] = x2 * a[2] + x1 * a[3];
    x1 = v1[0]; x2 = v1[1]; v1[0] = x1 * b[0] - x2 * b[1]; v1[1] = x2 * b[0] + x1 * b[1];
    x1 = v1[2]; x2 = v1[3]; v1[2] = x1 * b[2] - x2 * b[3]; v1[3] = x2 * b[2] + x1 * b[3];
}

struct EpiIn {
    static constexpr bool PERM = true;
    bf16_t *qa, *ka, *va, *cq, *ckv, *gates, *kr; const float *ropeA, *ropeM, *bg; float* sq;
    __device__ __forceinline__ void operator()(const f32x4 (&acc)[2][2][4][2], const Unit& u, int wr, int wc, int fr, int fq) const {
        const int pn = u.pn, row0 = u.pm * BM + wr * 64 + fr, cl = wc * 32 + 8 * fq;
        if (pn < 8) {
            bf16_t* dst = pn < 4 ? qa : ka; const int colt = (pn & 3) * 256; const bool rot = ((wc & 1) == 0) && (fq < 2);
#pragma unroll
            for (int ai = 0; ai < 2; ++ai)
#pragma unroll
                for (int m = 0; m < 4; ++m) { const int row = row0 + ai * HALF + m * 16;
#pragma unroll
                    for (int bj = 0; bj < 2; ++bj) { f32x4 v0 = acc[ai][bj][m][0], v1 = acc[ai][bj][m][1];
                        if (rot) rope4(v0, v1, ropeA + (size_t)row * 16 + fq * 8);
                        *(u32x4*)(dst + (size_t)row * 1024 + colt + bj * HALF + cl) = pack8(v0, v1); } }
        } else if (pn < 12) {
            const int colt = (pn - 8) * 256;
#pragma unroll
            for (int ai = 0; ai < 2; ++ai)
#pragma unroll
                for (int m = 0; m < 4; ++m) { const int row = row0 + ai * HALF + m * 16;
#pragma unroll
                    for (int bj = 0; bj < 2; ++bj) *(u32x4*)(va + (size_t)row * 1024 + colt + bj * HALF + cl) = pack8(acc[ai][bj][m][0], acc[ai][bj][m][1]); }
        } else if (pn < 17) {
            const bool isq = pn < 15; bf16_t* dst = isq ? cq : ckv; const int ld = isq ? QL : KVL, colt = (isq ? pn - 12 : pn - 15) * 256, tq = pn - 12;
#pragma unroll
            for (int ai = 0; ai < 2; ++ai)
#pragma unroll
                for (int m = 0; m < 4; ++m) { const int row = row0 + ai * HALF + m * 16; float s = 0.f;
#pragma unroll
                    for (int bj = 0; bj < 2; ++bj) { const f32x4 v0 = acc[ai][bj][m][0], v1 = acc[ai][bj][m][1];
                        s += (v0[0] * v0[0] + v0[1] * v0[1]) + (v0[2] * v0[2] + v0[3] * v0[3]) + (v1[0] * v1[0] + v1[1] * v1[1]) + (v1[2] * v1[2] + v1[3] * v1[3]);
                        *(u32x4*)(dst + (size_t)row * ld + colt + bj * HALF + cl) = pack8(v0, v1); }
                    s += __shfl_xor(s, 16); s += __shfl_xor(s, 32);
                    if (fq == 0) sq[(size_t)row * 20 + tq * 4 + wc] = s; }
        } else if (pn < 25) {
            const int colt = (pn - 17) * 256;
            f32x4 bv[2][2];
#pragma unroll
            for (int bj = 0; bj < 2; ++bj) { bv[bj][0] = *(const f32x4*)(bg + colt + bj * HALF + cl); bv[bj][1] = *(const f32x4*)(bg + colt + bj * HALF + cl + 4); if (DBG_SKIP & 256) { bv[bj][0] = bv[bj][0] * 0.f; bv[bj][1] = bv[bj][1] * 0.f; } }
#pragma unroll
            for (int ai = 0; ai < 2; ++ai)
#pragma unroll
                for (int m = 0; m < 4; ++m) { const int row = row0 + ai * HALF + m * 16;
#pragma unroll
                    for (int bj = 0; bj < 2; ++bj) { f32x4 v0 = acc[ai][bj][m][0] + bv[bj][0], v1 = acc[ai][bj][m][1] + bv[bj][1];
#pragma unroll
                        for (int j = 0; j < 4; ++j) { if (!(DBG_SKIP & 512)) { v0[j] = sigmoidf_(v0[j]); v1[j] = sigmoidf_(v1[j]); } }
                        *(u32x4*)(gates + (size_t)row * 2048 + colt + bj * HALF + cl) = pack8(v0, v1); } }
        } else {
            if (wc < 2) {
#pragma unroll
                for (int ai = 0; ai < 2; ++ai)
#pragma unroll
                    for (int m = 0; m < 4; ++m) { const int row = row0 + ai * HALF + m * 16;
                        f32x4 v0 = acc[ai][0][m][0], v1 = acc[ai][0][m][1];
                        rope4(v0, v1, ropeM + (size_t)row * 64 + (wc * 16 + fq * 4) * 2);
                        *(u32x4*)(kr + (size_t)row * 64 + cl) = pack8(v0, v1); }
            }
        }
    }
};
template <bool ISQ> struct EpiUp {
    static constexpr bool PERM = true;
    bf16_t* out; const float* sq; const float* ropeM;
    __device__ __forceinline__ void operator()(const f32x4 (&acc)[2][2][4][2], const Unit& u, int wr, int wc, int fr, int fq) const {
        const int row0 = u.pm * BM + wr * 64 + fr, cl = wc * 32 + 8 * fq; constexpr int LD = ISQ ? 1536 : 2048;
#pragma unroll
        for (int ai = 0; ai < 2; ++ai)
#pragma unroll
            for (int m = 0; m < 4; ++m) { const int row = row0 + ai * HALF + m * 16; float s;
                if (ISQ) { const f32x4 a = *(const f32x4*)(sq + (size_t)row * 20), b = *(const f32x4*)(sq + (size_t)row * 20 + 4), c = *(const f32x4*)(sq + (size_t)row * 20 + 8);
                    s = ((a[0] + a[1]) + (a[2] + a[3])) + ((b[0] + b[1]) + (b[2] + b[3])) + ((c[0] + c[1]) + (c[2] + c[3])); }
                else { const f32x4 a = *(const f32x4*)(sq + (size_t)row * 20 + 12), b = *(const f32x4*)(sq + (size_t)row * 20 + 16);
                    s = ((a[0] + a[1]) + (a[2] + a[3])) + ((b[0] + b[1]) + (b[2] + b[3])); }
                const float rstd = __builtin_amdgcn_rsqf(s * (ISQ ? 1.0f / QL : 1.0f / KVL) + EPS);
#pragma unroll
                for (int bj = 0; bj < 2; ++bj) { const int col = u.pn * BM + bj * HALF + cl; f32x4 v0 = acc[ai][bj][m][0] * rstd, v1 = acc[ai][bj][m][1] * rstd;
                    if (ISQ) { const int off = col % 192; if (off >= 128) rope4(v0, v1, ropeM + (size_t)row * 64 + (off - 128)); }
                    *(u32x4*)(out + (size_t)row * LD + col) = pack8(v0, v1); } }
    }
};
template <int WHICH> struct EpiGate {
    static constexpr bool PERM = true;
    bf16_t* mrg; const bf16_t* gates;
    __device__ __forceinline__ void operator()(const f32x4 (&acc)[2][2][4][2], const Unit& u, int wr, int wc, int fr, int fq) const {
        const int row0 = u.pm * BM + wr * 64 + fr, cl = wc * 32 + 8 * fq;
#pragma unroll
        for (int ai = 0; ai < 2; ++ai)
#pragma unroll
            for (int m = 0; m < 4; ++m) { const int row = row0 + ai * HALF + m * 16;
#pragma unroll
                for (int bj = 0; bj < 2; ++bj) { const int col = u.pn * BM + bj * HALF + cl;
                    const u32x4 gw = *(const u32x4*)(gates + (size_t)row * 2048 + WHICH * 1024 + col);
                    f32x4 v0 = acc[ai][bj][m][0], v1 = acc[ai][bj][m][1];
                    if ((DBG_SKIP & 8) && WHICH == 0) { v0 = v0 * 0.f; v1 = v1 * 0.f; } if ((DBG_SKIP & 16) && WHICH == 1) { v0 = v0 * 0.f; v1 = v1 * 0.f; }
                    v0[0] *= bf_lo(gw.x); v0[1] *= bf_hi(gw.x); v0[2] *= bf_lo(gw.y); v0[3] *= bf_hi(gw.y); v1[0] *= bf_lo(gw.z); v1[1] *= bf_hi(gw.z); v1[2] *= bf_lo(gw.w); v1[3] *= bf_hi(gw.w);
                    if (WHICH == 1) { const u32x4 tw = *(const u32x4*)(mrg + (size_t)row * 1024 + col);
                        v0[0] += bf_lo(tw.x); v0[1] += bf_hi(tw.x); v0[2] += bf_lo(tw.y); v0[3] += bf_hi(tw.y); v1[0] += bf_lo(tw.z); v1[1] += bf_hi(tw.z); v1[2] += bf_lo(tw.w); v1[3] += bf_hi(tw.w); }
                    *(u32x4*)(mrg + (size_t)row * 1024 + col) = pack8(v0, v1); } }
    }
};
struct EpiRes {
    static constexpr bool PERM = false;
    const float* x; float* out;
    __device__ __forceinline__ void operator()(const f32x4 (&acc)[2][2][4][2], const Unit& u, int wr, int wc, int fr, int fq) const {
        const int row0 = u.pm * BM + wr * 64 + fr, col0 = u.pn * BM + wc * 32 + 4 * fq;
#pragma unroll
        for (int ai = 0; ai < 2; ++ai)
#pragma unroll
            for (int m = 0; m < 4; ++m) { const size_t off = (size_t)(row0 + ai * HALF + m * 16) * 1024 + col0;
#pragma unroll
                for (int bj = 0; bj < 2; ++bj)
#pragma unroll
                    for (int n = 0; n < 2; ++n) *(f32x4*)(out + off + bj * HALF + n * 16) = *(const f32x4*)(x + off + bj * HALF + n * 16) + ((DBG_SKIP & 2) ? 0.f : 1.f) * acc[ai][bj][m][n]; }
    }
};
struct EpiSwiglu {
    static constexpr bool PERM = true;
    bf16_t* act; const float *bgate, *bup;
    __device__ __forceinline__ void operator()(const f32x4 (&acc)[2][2][4][2], const Unit& u, int wr, int wc, int fr, int fq) const {
        const int row0 = u.pm * BM + wr * 64 + fr, f0 = u.pn * HALF + wc * 32 + 8 * fq;
        f32x4 bgv[2], buv[2];
#pragma unroll
        for (int n = 0; n < 2; ++n) { bgv[n] = *(const f32x4*)(bgate + (size_t)u.e * FF + f0 + 4 * n); buv[n] = *(const f32x4*)(bup + (size_t)u.e * FF + f0 + 4 * n); }
#pragma unroll
        for (int ai = 0; ai < 2; ++ai)
#pragma unroll
            for (int m = 0; m < 4; ++m) { const int row = row0 + ai * HALF + m * 16; f32x4 o[2];
#pragma unroll
                for (int n = 0; n < 2; ++n) { const f32x4 gt = acc[ai][0][m][n] + bgv[n], up = acc[ai][1][m][n] + buv[n];
#pragma unroll
                    for (int j = 0; j < 4; ++j) { const float gg = fminf(gt[j], 7.0f), uu = fminf(fmaxf(up[j], -7.0f), 7.0f); o[n][j] = (uu + 1.0f) * (gg * sigmoidf_(1.702f * gg)); } }
                *(u32x4*)(act + (size_t)row * FF + f0) = pack8(o[0], o[1]); }
    }
};
struct EpiDown {
    static constexpr bool PERM = true;
    bf16_t* y; const float* bd;
    __device__ __forceinline__ void operator()(const f32x4 (&acc)[2][2][4][2], const Unit& u, int wr, int wc, int fr, int fq) const {
        const int row0 = u.pm * BM + wr * 64 + fr, cl = wc * 32 + 8 * fq;
        f32x4 bv[2][2];
#pragma unroll
        for (int bj = 0; bj < 2; ++bj) { const int col = u.pn * BM + bj * HALF + cl; bv[bj][0] = *(const f32x4*)(bd + (size_t)u.e * D + col); bv[bj][1] = *(const f32x4*)(bd + (size_t)u.e * D + col + 4); }
#pragma unroll
        for (int ai = 0; ai < 2; ++ai)
#pragma unroll
            for (int m = 0; m < 4; ++m) { const int row = row0 + ai * HALF + m * 16;
#pragma unroll
                for (int bj = 0; bj < 2; ++bj) { const int col = u.pn * BM + bj * HALF + cl;
                    *(u32x4*)(y + (size_t)row * D + col) = pack8(acc[ai][bj][m][0] + bv[bj][0], acc[ai][bj][m][1] + bv[bj][1]); } }
    }
};
}

namespace att {
constexpr int NW = 8, QBLK = 32, KVBLK = 64;
constexpr int SHM_V = KVBLK * 128 * 2;
#define SBAR() __builtin_amdgcn_sched_barrier(0)
#define KSW(row, colB) ((row) * 128 + ((colB) ^ ((((row) >> 1) & 7) << 4)))
__device__ __forceinline__ int crow(int r, int hi) { return (r & 3) + 8 * (r >> 2) + 4 * hi; }
struct Src { const bf16_t* Q; const bf16_t* K; const bf16_t* K2; const bf16_t* V; int ldq, ldk, ldk2, ldv; };

__device__ __forceinline__ void partialSM(f32x16& p0, f32x16& p1, float& m_reg, float& mn, float& alpha, const float C, const float thr) {
  float pmax = p0[0];
#pragma unroll
  for (int r = 1; r < 16; ++r) pmax = fmaxf(pmax, p0[r]);
#pragma unroll
  for (int r = 0; r < 16; ++r) pmax = fmaxf(pmax, p1[r]);
  { auto rr = __builtin_amdgcn_permlane32_swap(__float_as_uint(pmax), __float_as_uint(pmax), false, false);
    pmax = fmaxf(__uint_as_float(rr[0]), __uint_as_float(rr[1])); }
  if (__builtin_expect(__all(pmax - m_reg <= thr), 1)) { mn = m_reg; alpha = 1.f; }
  else { mn = fmaxf(m_reg, pmax); alpha = __builtin_amdgcn_exp2f((m_reg - mn) * C); m_reg = mn; }
  const float mnC = -mn * C;
#pragma unroll
  for (int r = 0; r < 16; ++r) p0[r] = fmaf(p0[r], C, mnC);
#pragma unroll
  for (int r = 0; r < 16; ++r) p1[r] = fmaf(p1[r], C, mnC);
#pragma unroll
  for (int r = 0; r < 16; ++r) p0[r] = __builtin_amdgcn_exp2f(p0[r]);
#if ATT_DUP == 1
  { float d_[16];
#pragma unroll
    for (int r = 0; r < 16; ++r) { d_[r] = __builtin_amdgcn_exp2f(p1[r]); d_[r] = fmaf(d_[r], C, mnC); }
#pragma unroll
    for (int r = 0; r < 16; ++r) asm volatile("" :: "v"(d_[r])); }
#endif
}
__device__ __forceinline__ void finishSM(f32x16& p0, f32x16& p1, float alpha, float& l_reg, bf16x8& pa0, bf16x8& pa1, bf16x8& pa2, bf16x8& pa3) {
#pragma unroll
  for (int r = 0; r < 16; ++r) p1[r] = __builtin_amdgcn_exp2f(p1[r]);
  float ps = 0;
#pragma unroll
  for (int r = 0; r < 16; ++r) ps += p0[r];
#pragma unroll
  for (int r = 0; r < 16; ++r) ps += p1[r];
  { auto rr = __builtin_amdgcn_permlane32_swap(__float_as_uint(ps), __float_as_uint(ps), false, false);
    ps = __uint_as_float(rr[0]) + __uint_as_float(rr[1]); }
  l_reg = l_reg * alpha + ps;
#define PK4(P, BASE, OUT) do { unsigned a0 = cvt_pk_bf16(P[BASE + 0], P[BASE + 1]), a1 = cvt_pk_bf16(P[BASE + 2], P[BASE + 3]);   \
    unsigned b0 = cvt_pk_bf16(P[BASE + 4], P[BASE + 5]), b1 = cvt_pk_bf16(P[BASE + 6], P[BASE + 7]);                              \
    auto r0 = __builtin_amdgcn_permlane32_swap(a0, b0, false, false); auto r1 = __builtin_amdgcn_permlane32_swap(a1, b1, false, false); \
    u32x4 w = {r0[0], r1[0], r0[1], r1[1]}; OUT = *reinterpret_cast<bf16x8*>(&w); } while (0)
  PK4(p0, 0, pa0); PK4(p0, 8, pa1); PK4(p1, 0, pa2); PK4(p1, 8, pa3);
#undef PK4
}
template <int DQK> __device__ __forceinline__ void qkt(f32x16& p0, f32x16& p1, const LAS char* Ks, const bf16x8* qr, int r32, int hi) {
  p0 = f32x16{}; p1 = f32x16{};
#pragma unroll
  for (int d0 = 0; d0 < DQK / 16; ++d0) { const int sub = d0 >> 2, cb = ((d0 & 3) * 16 + hi * 8) * 2;
    const bf16x8 b0 = *(const LAS bf16x8*)(Ks + sub * 8192 + KSW(r32, cb));
    const bf16x8 b1 = *(const LAS bf16x8*)(Ks + sub * 8192 + KSW(32 + r32, cb));
    p0 = __builtin_amdgcn_mfma_f32_32x32x16_bf16(b0, qr[d0], p0, 0, 0, 0);
    p1 = __builtin_amdgcn_mfma_f32_32x32x16_bf16(b1, qr[d0], p1, 0, 0, 0); }
#if ATT_DUP == 2
  if constexpr (DQK == 64) { bf16x8 zq = {0, 0, 0, 0, 0, 0, 0, 0}; asm volatile("" : "+v"(zq));
    const bf16x8 bz = *(const LAS bf16x8*)(Ks + KSW(r32, hi * 16));
#pragma unroll
    for (int d0 = 0; d0 < 2; ++d0) { p0 = __builtin_amdgcn_mfma_f32_32x32x16_bf16(bz, zq, p0, 0, 0, 0); p1 = __builtin_amdgcn_mfma_f32_32x32x16_bf16(bz, zq, p1, 0, 0, 0); } }
#endif
}
__device__ __forceinline__ int v_st(int k, int c) { const int kk = (k & ~0xC) | ((k & 4) << 1) | ((k & 8) >> 1); return ((kk >> 3) * 4 + (c >> 5)) * 512 + ((kk & 7) * 32 + (c & 31)) * 2; }
__device__ __forceinline__ int v_rd_base(int lane) { return ((lane & 3) << 3) | (((lane >> 2) & 3) << 6) | (((lane >> 4) & 1) << 5) | (((lane >> 5) & 1) << 8); }
constexpr int v_rd_off(int d0, int ks, int half) { return d0 * 512 + ks * 4096 + half * 2048; }
template <int OFF> __device__ __forceinline__ s16x4 tr_read(int vb) {
  s16x4 r; asm volatile("ds_read_b64_tr_b16 %0, %1 offset:%2" : "=&v"(r) : "v"(vb), "i"(OFF) : "memory"); return r;
}
template <int KS> __device__ __forceinline__ void pv_step(f32x16* o, int vb, bf16x8 pa) {
  s16x4 l0, h0, l1, h1, l2, h2, l3, h3;
  l0 = tr_read<v_rd_off(0, KS, 0)>(vb); h0 = tr_read<v_rd_off(0, KS, 1)>(vb); l1 = tr_read<v_rd_off(1, KS, 0)>(vb); h1 = tr_read<v_rd_off(1, KS, 1)>(vb);
  l2 = tr_read<v_rd_off(2, KS, 0)>(vb); h2 = tr_read<v_rd_off(2, KS, 1)>(vb); l3 = tr_read<v_rd_off(3, KS, 0)>(vb); h3 = tr_read<v_rd_off(3, KS, 1)>(vb);
  asm volatile("s_waitcnt lgkmcnt(0)" ::: "memory"); SBAR();
#define PK(L, H) (bf16x8){L[0], L[1], L[2], L[3], H[0], H[1], H[2], H[3]}
  o[0] = __builtin_amdgcn_mfma_f32_32x32x16_bf16(pa, PK(l0, h0), o[0], 0, 0, 0);
  o[1] = __builtin_amdgcn_mfma_f32_32x32x16_bf16(pa, PK(l1, h1), o[1], 0, 0, 0);
  o[2] = __builtin_amdgcn_mfma_f32_32x32x16_bf16(pa, PK(l2, h2), o[2], 0, 0, 0);
  o[3] = __builtin_amdgcn_mfma_f32_32x32x16_bf16(pa, PK(l3, h3), o[3], 0, 0, 0);
#undef PK
}
__device__ __forceinline__ void pv_d0(f32x16* o, int vb, bf16x8 pa0, bf16x8 pa1, bf16x8 pa2, bf16x8 pa3) {
  pv_step<0>(o, vb, pa0); pv_step<1>(o, vb, pa1); pv_step<2>(o, vb, pa2); pv_step<3>(o, vb, pa3);
}
template <int DQK>
__device__ __forceinline__ void attn_core(const Src in, const float C, const float thr, const int seq, LAS char* lds, f32x16 (&o)[4]) {
  constexpr int NSUB = DQK / 64, SHM_K = NSUB * 8192;
  const int tid = threadIdx.x, wid = __builtin_amdgcn_readfirstlane(tid >> 6), lane = tid & 63, r32 = lane & 31, hi = lane >> 5;
  LAS char* V_lds = lds; LAS char* K_lds = lds + 3 * SHM_V;
  LAS float* ws = (LAS float*)(lds + 3 * SHM_V + 3 * SHM_K) + wid * 64; LAS float* li_l = ws; LAS float* al_l = ws + 32;
  float m_reg = -1e30f, l_reg = 0;
#pragma unroll
  for (int d = 0; d < 4; ++d) o[d] = f32x16{};
  bf16x8 qr[DQK / 16];
  const bf16_t* Qw = in.Q + (size_t)(wid * QBLK + r32) * in.ldq + hi * 8;
#pragma unroll
  for (int d0 = 0; d0 < DQK / 16; ++d0) qr[d0] = *(const bf16x8*)(Qw + d0 * 16);
  const int krow = wid * 8 + (lane >> 3), kslot = (lane & 7) ^ ((krow >> 1) & 7);
  const unsigned koff = (unsigned)(krow * in.ldk + kslot * 8) * 2u, k2off = (unsigned)(krow * in.ldk2 + kslot * 8) * 2u;
  unsigned voff[2];
#pragma unroll
  for (int i = 0; i < 2; ++i) { const int p = i * 8192 + wid * 1024 + lane * 16, st = p >> 9, wq = (p & 511) >> 1, kk = (st >> 2) * 8 + (wq >> 5), cl = wq & 31;
    const int k = (kk & ~0xC) | ((kk & 4) << 1) | ((kk & 8) >> 1); voff[i] = (unsigned)(k * in.ldv + (st & 3) * 32 + cl) * 2u; }
  const int vb0 = (int)(unsigned)(size_t)V_lds + v_rd_base(lane);
  const unsigned ldsw = (unsigned)wid * 1024u;
#define GLDS(gp, lp) __builtin_amdgcn_global_load_lds((const unsigned*)(gp), (LAS unsigned*)(lp), 16, 0, 0)
#define ISSUE_K(t, b) do { const char* kb_ = (const char*)in.K + (size_t)(t) * (KVBLK * 2) * in.ldk; \
    _Pragma("unroll") for (int s_ = 0; s_ < NSUB; ++s_) { if (s_ < 2) GLDS(kb_ + s_ * 128 + koff, K_lds + (b) * SHM_K + s_ * 8192 + ldsw); \
      else GLDS((const char*)in.K2 + (size_t)(t) * (KVBLK * 2) * in.ldk2 + k2off, K_lds + (b) * SHM_K + s_ * 8192 + ldsw); } } while (0)
#define ISSUE_V(t, b) do { const char* vb_ = (const char*)in.V + (size_t)(t) * (KVBLK * 2) * in.ldv; \
    GLDS(vb_ + voff[0], V_lds + (b) * SHM_V + ldsw); GLDS(vb_ + voff[1], V_lds + (b) * SHM_V + 8192 + ldsw); \
    if (ATT_DUP == 3) { GLDS(vb_ + voff[0], V_lds + (b) * SHM_V + ldsw); GLDS(vb_ + voff[1], V_lds + (b) * SHM_V + 8192 + ldsw); } } while (0)
#define WAITV(n) asm volatile("s_waitcnt vmcnt(%0)" :: "n"((DBG_SKIP & 4) ? 0 : (n)) : "memory")
#define WBAR() do { asm volatile("" ::: "memory"); __builtin_amdgcn_s_barrier(); asm volatile("" ::: "memory"); } while (0)
#define RESC(a) do { if (__any((a) < 1.f)) { if (hi == 0) al_l[r32] = (a); asm volatile("s_waitcnt lgkmcnt(0)" ::: "memory"); \
    _Pragma("unroll") for (int d = 0; d < 4; ++d) _Pragma("unroll") for (int r = 0; r < 16; ++r) o[d][r] *= al_l[crow(r, hi)]; } } while (0)
#define NXT3(x) ((x) == 2 ? 0 : (x) + 1)
  constexpr int NI = NSUB + (ATT_DUP == 3 ? 4 : 2), NV = (ATT_DUP == 3 ? 4 : 2);
  f32x16 pA0, pA1, pB0, pB1; float mnA, mnB, alA, alB; bf16x8 pa0, pa1, pa2, pa3; const int NT = seq / KVBLK;
  const bool lead = wid < 4;
  ISSUE_K(0, 0); ISSUE_K(1, 1); ISSUE_V(0, 0);
  if (!lead) { WAITV(NI); WBAR(); }
  WAITV(NI); WBAR();
  ISSUE_K(2, 2);
  qkt<DQK>(pA0, pA1, K_lds, qr, r32, hi);
  WAITV(NI); WBAR();
  ISSUE_V(1, 1);
  partialSM(pA0, pA1, m_reg, mnA, alA, C, thr);
  WAITV(NI); WBAR();
  int bq = 1;
  for (int j = 1; j + 3 < NT; j += 2) {
    { const int b1 = NXT3(bq), b2 = NXT3(b1);
      ISSUE_K(j + 2, b2);
      SBAR(); qkt<DQK>(pB0, pB1, K_lds + bq * SHM_K, qr, r32, hi);
      finishSM(pA0, pA1, alA, l_reg, pa0, pa1, pa2, pa3); SBAR();
      WAITV(NI); WBAR();
      ISSUE_V(j + 1, b1);
      pv_d0(o, vb0 + b2 * SHM_V, pa0, pa1, pa2, pa3); partialSM(pB0, pB1, m_reg, mnB, alB, C, thr);
      RESC(alB); bq = b1;
      WAITV(NI); WBAR(); }
    { const int b1 = NXT3(bq), b2 = NXT3(b1);
      ISSUE_K(j + 3, b2);
      SBAR(); qkt<DQK>(pA0, pA1, K_lds + bq * SHM_K, qr, r32, hi);
      finishSM(pB0, pB1, alB, l_reg, pa0, pa1, pa2, pa3); SBAR();
      WAITV(NI); WBAR();
      ISSUE_V(j + 2, b1);
      pv_d0(o, vb0 + b2 * SHM_V, pa0, pa1, pa2, pa3); partialSM(pA0, pA1, m_reg, mnA, alA, C, thr);
      RESC(alA); bq = b1;
      WAITV(NI); WBAR(); }
  }
  { const int b1 = NXT3(bq), b2 = NXT3(b1);
    ISSUE_K(NT - 1, b2);
    SBAR(); qkt<DQK>(pB0, pB1, K_lds + bq * SHM_K, qr, r32, hi);
    finishSM(pA0, pA1, alA, l_reg, pa0, pa1, pa2, pa3); SBAR();
    WAITV(NI); WBAR();
    ISSUE_V(NT - 2, b1);
    pv_d0(o, vb0 + b2 * SHM_V, pa0, pa1, pa2, pa3); partialSM(pB0, pB1, m_reg, mnB, alB, C, thr);
    RESC(alB); bq = b1;
    WAITV(NI); WBAR(); }
  { const int b1 = NXT3(bq), b2 = NXT3(b1);
    SBAR(); qkt<DQK>(pA0, pA1, K_lds + bq * SHM_K, qr, r32, hi);
    finishSM(pB0, pB1, alB, l_reg, pa0, pa1, pa2, pa3); SBAR();
    WAITV(NV); WBAR();
    ISSUE_V(NT - 1, b1);
    pv_d0(o, vb0 + b2 * SHM_V, pa0, pa1, pa2, pa3); partialSM(pA0, pA1, m_reg, mnA, alA, C, thr);
    RESC(alA); bq = b1;
    WAITV(NV); WBAR(); }
  { const int b2 = NXT3(NXT3(bq));
    SBAR(); qkt<DQK>(pB0, pB1, K_lds + bq * SHM_K, qr, r32, hi);
    finishSM(pA0, pA1, alA, l_reg, pa0, pa1, pa2, pa3); SBAR();
    WAITV(0); WBAR();
    pv_d0(o, vb0 + b2 * SHM_V, pa0, pa1, pa2, pa3); partialSM(pB0, pB1, m_reg, mnB, alB, C, thr);
    RESC(alB);
    WBAR(); }
  finishSM(pB0, pB1, alB, l_reg, pa0, pa1, pa2, pa3); SBAR();
  pv_d0(o, vb0 + bq * SHM_V, pa0, pa1, pa2, pa3);
  if (lead) { WBAR(); }
  if (hi == 0) li_l[r32] = l_reg; asm volatile("s_waitcnt lgkmcnt(0)" ::: "memory");
#pragma unroll
  for (int r = 0; r < 16; ++r) { const float rl = __builtin_amdgcn_rcpf(li_l[crow(r, hi)]);
#pragma unroll
    for (int d = 0; d < 4; ++d) o[d][r] *= rl; }
  asm volatile("s_waitcnt lgkmcnt(0)" ::: "memory"); WBAR();
#undef GLDS
#undef ISSUE_K
#undef ISSUE_V
#undef WAITV
#undef WBAR
#undef RESC
#undef NXT3
}
}

constexpr int NWAVES = 8;
struct Args { const void* in[27]; float* out; unsigned char* ws; int ph_lo, ph_hi, li, pad; };

__constant__ float c_invA[8] = {1.0f, 0.19392274474868576f, 0.03760603093086393f, 0.007292664737217109f, 0.001414213562373095f, 0.0002742481756762073f, 5.318295896944988e-05f, 1.031338537721246e-05f};
__constant__ float c_invM[32] = {1.0f, 0.6636012376960885f, 0.44036660267178046f, 0.2922278225730151f, 0.19392274474868576f, 0.12868737343265052f, 0.08539710028576561f, 0.05666962144529105f,
    0.03760603093086393f, 0.024955408670558694f, 0.016560440080994446f, 0.010989528534539826f, 0.007292664737217109f, 0.004839421345719893f, 0.003211445994752591f, 0.0021311195369119653f,
    0.001414213562373095f, 0.0009384738703573802f, 0.000622772421914596f, 0.0004132725499855165f, 0.0002742481756762073f, 0.00018199142881462546f, 0.00012076973741146504f, 8.01429472224798e-05f,
    5.318295896944988e-05f, 3.529227739646723e-05f, 2.341999896140934e-05f, 1.5541540297632344e-05f, 1.031338537721246e-05f, 6.8439753011549275e-06f, 4.5416704806078695e-06f, 3.013858152139171e-06f};

__device__ __forceinline__ int permDA(int i) { return i < 16 ? (i >> 1) + 8 * (i & 1) : i; }
__device__ __forceinline__ int permM(int i) { return (i >> 1) + 32 * (i & 1); }
__device__ __forceinline__ int src_in(int j) {
    if (j < 2048) return (j & ~63) + permDA(j & 63);
    if (j < 4352) return j;
    if (j < 6400) return 4416 + (j - 4352);
    if (j < 6464) return 4352 + permM(j - 6400);
    return -1;
}
__device__ __forceinline__ int src_uq(int j) { const int hd = j / 192, off = j % 192; return off < 128 ? j : hd * 192 + 128 + permM(off - 128); }

__device__ __forceinline__ void tr_item(const float* W, int K, int N, bf16_t* WT, int n0, int k0, int scol, const float* rs, LAS float* scr, int lane) {
#pragma unroll 8
    for (int i = 0; i < 32; ++i) { const int kk = 2 * i + (lane >> 5); float v = 0.f; if (scol >= 0) { v = W[(size_t)(k0 + kk) * N + scol]; if (rs) v *= rs[k0 + kk]; } scr[kk * 33 + (lane & 31)] = v; }
    LDS_WAIT(); asm volatile("" ::: "memory");
    const int c = lane & 7;
#pragma unroll
    for (int j = 0; j < 4; ++j) { const int n = (lane >> 3) + 8 * j; const LAS float* s = scr + (8 * c) * 33 + n;
        u32x4 o; o.x = cvt_pk_bf16(s[0 * 33], s[1 * 33]); o.y = cvt_pk_bf16(s[2 * 33], s[3 * 33]); o.z = cvt_pk_bf16(s[4 * 33], s[5 * 33]); o.w = cvt_pk_bf16(s[6 * 33], s[7 * 33]);
        *(u32x4*)(WT + (size_t)(n0 + n) * K + k0 + 8 * c) = o; }
    LDS_WAIT(); asm volatile("" ::: "memory");
}

template <int MODE = 0>
__device__ __forceinline__ void cvt_tile64(const float* W, int N, bf16_t* WT, int Kd, int k0, int n0, int drow0, int lane, const float* rs = nullptr) {
    const int g = lane >> 4, x = lane & 15;
    const float* src = W + (size_t)(k0 + 16 * g) * N + n0 + 4 * x;
    f32x4 v[16];
#pragma unroll
    for (int i = 0; i < 16; ++i) v[i] = __builtin_nontemporal_load((const f32x4*)(src + (size_t)i * N));
    if (rs) {
#pragma unroll
        for (int i = 0; i < 16; ++i) v[i] = v[i] * rs[k0 + 16 * g + i];
    }
#pragma unroll
    for (int j = 0; j < 4; ++j) { u32x4 lo, hi;
        lo.x = cvt_pk_bf16(v[0][j], v[1][j]); lo.y = cvt_pk_bf16(v[2][j], v[3][j]); lo.z = cvt_pk_bf16(v[4][j], v[5][j]); lo.w = cvt_pk_bf16(v[6][j], v[7][j]);
        hi.x = cvt_pk_bf16(v[8][j], v[9][j]); hi.y = cvt_pk_bf16(v[10][j], v[11][j]); hi.z = cvt_pk_bf16(v[12][j], v[13][j]); hi.w = cvt_pk_bf16(v[14][j], v[15][j]);
        const int c = 4 * x + j;
        const int dr = MODE == 1 ? 2 * (c & 31) + (c >> 5) : (MODE == 2 ? (c < 16 ? 2 * (c & 7) + (c >> 3) : c) : c);
        bf16_t* d = WT + (size_t)(drow0 + dr) * Kd + k0 + 16 * g;
        *(u32x4*)d = lo; *(u32x4*)(d + 8) = hi; }
}

__global__ void __launch_bounds__(NWAVES * 64, 2) fwd(Args args) {
#define KARGS() const __attribute__((address_space(4))) unsigned long long* ka_ = (const __attribute__((address_space(4))) unsigned long long*)__builtin_amdgcn_kernarg_segment_ptr(); asm volatile("" : "+s"(ka_))
#define AIN(i) ((const void*)ka_[i])
#define AOUT ((float*)ka_[27])
#define AWS ((unsigned char*)ka_[28])
    extern __shared__ __attribute__((aligned(16))) unsigned char lds_raw[];
    LAS unsigned char* lds = (LAS unsigned char*)lds_raw;
    volatile LAS unsigned* MISC = (volatile LAS unsigned*)(lds + MISC_OFF);
    const int tid = threadIdx.x, wave = __builtin_amdgcn_readfirstlane(tid >> 6);
#define LANE_DECL int lane; asm volatile("v_and_b32 %0, 63, %1" : "=v"(lane) : "v"(threadIdx.x))
    const int G = gridDim.x, bx = blockIdx.x;
    unsigned* ctl = (unsigned*)(args.ws + WS_CTL);
    const int lo = args.ph_lo, hi_ph = args.ph_hi;
    if (tid < 32) MISC[tid] = 0u;
    __syncthreads();
    XcdBarrier bar; bar.bar = ctl + CW_BAR + args.li * XCD_BAR_WORDS; bar.x = 0; bar.st = nullptr;
    if (!MK_PER_PHASE) bar = xcd_barrier_post(ctl + CW_BAR + args.li * XCD_BAR_WORDS, MISC + 8);
#define IN(k) (((PH_MASK >> (k)) & 1) && lo <= (k) && (k) < hi_ph)
#define SEAM(k) do { if (IN(k) && IN((k) + 1)) xcd_barrier(bar); } while (0)
    const int gw = bx * NWAVES + wave, NGW = G * NWAVES;

#define xin ((const float*)AIN(0))
#define positions ((const int*)AIN(1))
#define Bt_in ((bf16_t*)(AWS + WS_BT_IN))
#define Bt_uq ((bf16_t*)(AWS + WS_BT_UQ))
#define Bt_ukv ((bf16_t*)(AWS + WS_BT_UKV))
#define Bt_od ((bf16_t*)(AWS + WS_BT_OD))
#define Bt_om ((bf16_t*)(AWS + WS_BT_OM))
#define Bt_out ((bf16_t*)(AWS + WS_BT_OUT))
#define ropeA ((float*)(AWS + WS_ROPEA))
#define ropeM ((float*)(AWS + WS_ROPEM))
#define sq ((float*)(AWS + WS_SQ2))
#define hbuf ((bf16_t*)(AWS + WS_H))
#define oa ((bf16_t*)(AWS + WS_H))
#define qa ((bf16_t*)(AWS + WS_QA))
#define ka ((bf16_t*)(AWS + WS_KA))
#define va ((bf16_t*)(AWS + WS_VA))
#define cq ((bf16_t*)(AWS + WS_CQ))
#define ckv ((bf16_t*)(AWS + WS_CKV))
#define kr ((bf16_t*)(AWS + WS_KR))
#define gates ((bf16_t*)(AWS + WS_GATES))
#define qm ((bf16_t*)(AWS + WS_QM))
#define kv ((bf16_t*)(AWS + WS_KV))
#define ob ((bf16_t*)(AWS + WS_OB))
#define mrg ((bf16_t*)(AWS + WS_MRG))
#define stash ((float*)(AWS + WS_STASH))
#define rowtok_p ((int*)(AWS + WS_ROWTOK))
#define assign ((u32x2*)(AWS + WS_ASSIGN))
#define Bt_d ((bf16_t*)(AWS + WS_BT_D))
#define Bt_gu ((bf16_t*)(AWS + WS_BT_GU))
#define h2 ((bf16_t*)(AWS + WS_H2))
#define act ((bf16_t*)(AWS + WS_ACT))
#define ybuf ((bf16_t*)(AWS + WS_Y))
#define count ((unsigned*)(AWS + WS_CTL) + CW_COUNT)

    if (IN(0)) {
        KARGS();
        LANE_DECL;
        const float* w_in = (const float*)AIN(3); const float* g_q = (const float*)AIN(9); const float* g_kv = (const float*)AIN(10);
        const float* w_uq = (const float*)AIN(11); const float* w_ukv = (const float*)AIN(12);
        const float* w_od = (const float*)AIN(13); const float* w_om = (const float*)AIN(14); const float* w_out = (const float*)AIN(16);
        constexpr int I_IN = 16 * 101, I_PAD = 16 * 3, I_UQ = 12 * 24, I_UKV = 8 * 32, I_O = 16 * 16;
        constexpr int NITEMS = I_IN + I_PAD + I_UQ + I_UKV + 3 * I_O;
        for (int it = gw; it < NITEMS; it += NGW) {
            int r = it;
            if (r < I_IN) { const int kb = r / 101, cb = r % 101, n0 = cb * 64;
                if (n0 < 2048) cvt_tile64<2>(w_in, 6464, Bt_in, D, kb * 64, n0, n0, lane);
                else if (n0 < 4352) cvt_tile64<0>(w_in, 6464, Bt_in, D, kb * 64, n0, n0, lane);
                else if (n0 < 4416) cvt_tile64<1>(w_in, 6464, Bt_in, D, kb * 64, n0, 6400, lane);
                else cvt_tile64<0>(w_in, 6464, Bt_in, D, kb * 64, n0, n0 - 64, lane);
                continue; } r -= I_IN;
            if (r < I_PAD) { const int kb = r / 3, rb = r % 3; const int g = lane >> 4, x4 = lane & 15;
#pragma unroll
                for (int j = 0; j < 4; ++j) { bf16_t* d = Bt_in + (size_t)(6464 + rb * 64 + 4 * x4 + j) * D + kb * 64 + 16 * g; *(u32x4*)d = (u32x4){0u, 0u, 0u, 0u}; *(u32x4*)(d + 8) = (u32x4){0u, 0u, 0u, 0u}; }
                continue; } r -= I_PAD;
            if (r < I_UQ) { const int kb = r / 24, cb = r % 24, n0 = cb * 64;
                if ((cb % 3) == 2) cvt_tile64<1>(w_uq, 1536, Bt_uq, QL, kb * 64, n0, n0, lane, g_q); else cvt_tile64<0>(w_uq, 1536, Bt_uq, QL, kb * 64, n0, n0, lane, g_q);
                continue; } r -= I_UQ;
            if (r < I_UKV) { const int kb = r / 32, cb = r % 32; cvt_tile64<0>(w_ukv, 2048, Bt_ukv, KVL, kb * 64, cb * 64, cb * 64, lane, g_kv); continue; } r -= I_UKV;
            const int which = r / I_O; r -= which * I_O; const int kb = r / 16, cb = r % 16;
            cvt_tile64<0>(which == 0 ? w_od : (which == 1 ? w_om : w_out), D, which == 0 ? Bt_od : (which == 1 ? Bt_om : Bt_out), D, kb * 64, cb * 64, cb * 64, lane);
        }
        const float* g_mix = (const float*)AIN(2);
        for (int m = gw * 4; m < T; m += NGW * 4) {
            f32x4 v[4][4]; float ss[4];
#pragma unroll
            for (int q = 0; q < 4; ++q) { const f32x4* xr = (const f32x4*)(xin + (size_t)(m + q) * D) + lane;
#pragma unroll
                for (int j = 0; j < 4; ++j) v[q][j] = xr[64 * j]; }
#pragma unroll
            for (int q = 0; q < 4; ++q) { float s = 0.f;
#pragma unroll
                for (int j = 0; j < 4; ++j) s += (v[q][j][0] * v[q][j][0] + v[q][j][1] * v[q][j][1]) + (v[q][j][2] * v[q][j][2] + v[q][j][3] * v[q][j][3]);
                ss[q] = __builtin_amdgcn_rsqf(wave_sum(s) * (1.f / D) + EPS); }
#pragma unroll
            for (int j = 0; j < 4; ++j) { const f32x4 gg = *((const f32x4*)g_mix + lane + 64 * j);
#pragma unroll
                for (int q = 0; q < 4; ++q) { u32x2 w; w.x = cvt_pk_bf16(v[q][j][0] * ss[q] * gg[0], v[q][j][1] * ss[q] * gg[1]); w.y = cvt_pk_bf16(v[q][j][2] * ss[q] * gg[2], v[q][j][3] * ss[q] * gg[3]);
                    ((u32x2*)(hbuf + (size_t)(m + q) * D) + lane)[64 * j] = w; } }
        }
        for (int idx = bx * 512 + tid; idx < T * 40; idx += G * 512) {
            const int t = idx / 40, i = idx % 40; const float inv = i < 8 ? c_invA[i] : c_invM[i - 8];
            const float ang = (float)positions[t] * inv;
            const double rev = (double)ang * 0.15915494309189535; const float fr_ = (float)(rev - __builtin_rint(rev));
            const float cs = __builtin_amdgcn_cosf(fr_), sn = __builtin_amdgcn_sinf(fr_);
            float* dst = i < 8 ? ropeA + ((size_t)t * 8 + i) * 2 : ropeM + ((size_t)t * 32 + (i - 8)) * 2; dst[0] = cs; dst[1] = sn;
        }
    }
    SEAM(0);
    if (IN(1)) {
        KARGS();
        pg8::Gemm g{hbuf, Bt_in, D}; pg8::DenseOrder S; S.init(T / 256, N_IN / 256, G, bx);
        pg8::EpiIn E{qa, ka, va, cq, ckv, gates, kr, ropeA, ropeM, (const float*)AIN(15), sq};
        pg8::gemm_phase<pg8::EpiIn, pg8::DenseOrder, false, true>(lds, g, S, E);
    }
    SEAM(1);
    if (IN(2)) {
        KARGS();
        { pg8::Gemm g{cq, Bt_uq, QL}; pg8::DenseOrder S; S.init(T / 256, 1536 / 256, G, bx); pg8::EpiUp<true> E{qm, sq, ropeM};
          pg8::gemm_phase<pg8::EpiUp<true>, pg8::DenseOrder, false, true>(lds, g, S, E); }
        { pg8::Gemm g{ckv, Bt_ukv, KVL}; pg8::DenseOrder S; S.init(T / 256, 2048 / 256, G, G - 1 - bx); pg8::EpiUp<false> E{kv, sq, ropeM};
          pg8::gemm_phase<pg8::EpiUp<false>, pg8::DenseOrder, false, true>(lds, g, S, E); }
    }
    SEAM(2);
    if (IN(3)) {
        KARGS();
        const int lane = threadIdx.x & 63;
        const int wid = tid >> 6, r32 = lane & 31, hi = lane >> 5;
        for (int L = bx; L < 1024; L += G) {
            const int typ = L >> 9; int u = L & 511;
#if PROBE_PHASE == 3 && defined(PROBE_ATT)
            if (args.li == 1 && lo == 3 && typ != PROBE_ATT) continue;
#endif
            if (G == 256) { const int c = L & 255; u = (L & 256) + (c & 7) * 32 + (c >> 3); }
            const int bh = u >> 4, qb = u & 15, b = bh >> 3, h = bh & 7;
            const size_t q0 = (size_t)b * SEQ + qb * 256, k0 = (size_t)b * SEQ;
            f32x16 o[4];
            if (typ == 0 && (DBG_SKIP & 32)) {
                for (int i = tid; i < 256 * 128; i += 512) { const size_t a = (q0 + (i >> 7)) * 1024 + h * 128 + (i & 127);
                    const float v = (DBG_SKIP & 64) ? xin[a] : __uint_as_float((unsigned)qa[a] << 16) + __uint_as_float((unsigned)ka[a] << 16) + __uint_as_float((unsigned)va[a] << 16);
                    oa[a] = (bf16_t)(cvt_pk_bf16(v, 0.f) & 0xffffu); }
            } else
            if (typ == 0 && (ATT_MASK & 1)) {
                f32x4* st = (f32x4*)(stash + ((size_t)(bx * 8 + wid) * 64 + lane) * 64);
                { att::Src in{qa + q0 * 1024 + h * 128, ka + k0 * 1024 + h * 128, nullptr, va + k0 * 1024 + h * 128, 1024, 1024, 0, 1024};
                  att::attn_core<64>(in, 0.125f * 1.4426950408889634f, 8.f / 0.125f, SEQ, (LAS char*)lds, o); }
#pragma unroll
                for (int d = 0; d < 4; ++d)
#pragma unroll
                    for (int q4 = 0; q4 < 4; ++q4) st[d * 4 + q4] = (f32x4){o[d][4 * q4], o[d][4 * q4 + 1], o[d][4 * q4 + 2], o[d][4 * q4 + 3]};
                { att::Src in{qa + q0 * 1024 + h * 128 + 64, ka + k0 * 1024 + h * 128 + 64, nullptr, va + k0 * 1024 + h * 128, 1024, 1024, 0, 1024};
                  att::attn_core<64>(in, 0.125f * 1.4426950408889634f, 8.f / 0.125f, SEQ, (LAS char*)lds, o); }
                asm volatile("" : "+v"(st) :: "memory");
                float lam;
                { const float* lq1 = (const float*)AIN(4); const float* lk1 = (const float*)AIN(5); const float* lq2 = (const float*)AIN(6); const float* lk2 = (const float*)AIN(7);
                  const float s1 = wave_sum(lq1[lane] * lk1[lane]), s2 = wave_sum(lq2[lane] * lk2[lane]); lam = __expf(s1) - __expf(s2) + LAM_INIT; }
                float ss[16];
#pragma unroll
                for (int r = 0; r < 16; ++r) ss[r] = 0.f;
#pragma unroll
                for (int d = 0; d < 4; ++d) {
#pragma unroll
                    for (int q4 = 0; q4 < 4; ++q4) { const f32x4 sv = st[d * 4 + q4];
#pragma unroll
                        for (int j = 0; j < 4; ++j) { const int r = 4 * q4 + j; const float v = sv[j] - lam * o[d][r]; o[d][r] = v; ss[r] += v * v; } }
                    asm volatile("" ::: "memory"); }
#pragma unroll
                for (int r = 0; r < 16; ++r) {
#pragma unroll
                    for (int msk = 1; msk < 32; msk <<= 1) ss[r] += __shfl_xor(ss[r], msk);
                    ss[r] = __builtin_amdgcn_rsqf(ss[r] * (1.0f / 128.0f) + EPS); }
                bf16_t* Ow = oa + (q0 + wid * 32) * 1024 + h * 128 + r32; asm volatile("" : "+v"(Ow));
                float gs[4];
#pragma unroll
                for (int d = 0; d < 4; ++d) gs[d] = ((const float*)AIN(8))[d * 32 + r32] * (1.0f - LAM_INIT);
#pragma unroll
                for (int r = 0; r < 16; ++r) { const int orow = att::crow(r, hi);
#pragma unroll
                    for (int d = 0; d < 4; ++d) Ow[(size_t)orow * 1024 + d * 32] = (bf16_t)(cvt_pk_bf16(o[d][r] * ss[r] * gs[d], 0.f) & 0xffffu); }
            } else if (ATT_MASK & 2) {
                { att::Src in{qm + q0 * 1536 + h * 192, kv + k0 * 2048 + h * 256, kr + k0 * 64, kv + k0 * 2048 + h * 256 + 128, 1536, 2048, 64, 2048};
                  att::attn_core<192>(in, 0.07216878364870322f * 1.4426950408889634f, 8.f / 0.07216878364870322f, SEQ, (LAS char*)lds, o); }
                bf16_t* Ow = ob + (q0 + wid * 32) * 1024 + h * 128 + r32; asm volatile("" : "+v"(Ow));
#pragma unroll
                for (int r = 0; r < 16; ++r) { const int orow = att::crow(r, hi);
#pragma unroll
                    for (int d = 0; d < 4; ++d) Ow[(size_t)orow * 1024 + d * 32] = (bf16_t)(cvt_pk_bf16(o[d][r], 0.f) & 0xffffu); }
            }
        }
    }
    SEAM(3);
    if (IN(4)) {
        KARGS();
        { pg8::Gemm g{oa, Bt_od, D}; pg8::DenseOrder S; S.init(T / 256, 4, G, bx); pg8::EpiGate<0> E{mrg, gates};
          pg8::gemm_phase<pg8::EpiGate<0>, pg8::DenseOrder, false, true>(lds, g, S, E); }
        VM_WAIT(); __syncthreads();
        { pg8::Gemm g{ob, Bt_om, D}; pg8::DenseOrder S; S.init(T / 256, 4, G, bx); pg8::EpiGate<1> E{mrg, gates};
          pg8::gemm_phase<pg8::EpiGate<1>, pg8::DenseOrder, false, true>(lds, g, S, E); }
    }
    SEAM(4);
    if (IN(5)) {
        KARGS();
        pg8::Gemm g{mrg, Bt_out, D}; pg8::DenseOrder S; S.init(T / 256, 4, G, bx); pg8::EpiRes E{xin, AOUT};
        pg8::gemm_phase<pg8::EpiRes, pg8::DenseOrder, false, true>(lds, g, S, E);
    }
    SEAM(5);
    if (IN(6)) {
        KARGS();
        LANE_DECL;
        const float* g_ffn = (const float*)AIN(17); const float* w_router = (const float*)AIN(18); const float* b_router = (const float*)AIN(19);
        constexpr int WRS = 1028;
        LAS float* wr_l = (LAS float*)lds;
        LAS int* lcount = (LAS int*)(lds + TAB_OFF + 1024); LAS int* gbase = lcount + 32; LAS unsigned* asg_e = (LAS unsigned*)(lcount + 64); LAS float* asg_w = (LAS float*)(lcount + 64 + 256);
        LAS int* sync_w = (LAS int*)(lds + TAB_OFF + 512);
        for (int i = tid; i < D * NEXP; i += 512) wr_l[(i & 31) * WRS + (i >> 5)] = w_router[i];
        if (tid < 32) lcount[tid] = 0;
        if (tid < 2) sync_w[tid] = 0;
        __syncthreads();
        const int ex = (lane >> 1) & 31;
        LAS float* lg = (LAS float*)(lds + TAB_OFF + 4096) + wave * 80;
        const int chunk = bx;
        if (wave < 4 && chunk < T / 64) {
            const float my_b = b_router[ex];
#pragma unroll 1
            for (int j2 = 0; j2 < 8; ++j2) {
                const int tl = wave * 16 + j2 * 2, t = chunk * 64 + tl;
                f32x4 xva[4], xvb[4]; float sa = 0.f, sb = 0.f;
                { const f32x4* xa = (const f32x4*)(AOUT + (size_t)t * D) + lane; const f32x4* xb = xa + D / 4;
#pragma unroll
                  for (int j = 0; j < 4; ++j) { xva[j] = xa[64 * j]; xvb[j] = xb[64 * j]; }
#pragma unroll
                  for (int j = 0; j < 4; ++j) { sa += (xva[j][0] * xva[j][0] + xva[j][1] * xva[j][1]) + (xva[j][2] * xva[j][2] + xva[j][3] * xva[j][3]); sb += (xvb[j][0] * xvb[j][0] + xvb[j][1] * xvb[j][1]) + (xvb[j][2] * xvb[j][2] + xvb[j][3] * xvb[j][3]); } }
                const float ra = __builtin_amdgcn_rsqf(wave_sum(sa) * (1.f / D) + EPS), rb = __builtin_amdgcn_rsqf(wave_sum(sb) * (1.f / D) + EPS);
                { u32x2* oa8 = (u32x2*)(h2 + (size_t)t * D) + lane; u32x2* ob8 = oa8 + D / 4;
#pragma unroll
                  for (int j = 0; j < 4; ++j) { const f32x4 gg = *((const f32x4*)g_ffn + lane + 64 * j); xva[j] = xva[j] * ra * gg; xvb[j] = xvb[j] * rb * gg;
                    u32x2 w; w.x = cvt_pk_bf16(xva[j][0], xva[j][1]); w.y = cvt_pk_bf16(xva[j][2], xva[j][3]); oa8[64 * j] = w;
                    w.x = cvt_pk_bf16(xvb[j][0], xvb[j][1]); w.y = cvt_pk_bf16(xvb[j][2], xvb[j][3]); ob8[64 * j] = w; } }
                float aa[32], ab[32];
#pragma unroll
                for (int e = 0; e < NEXP; ++e) { float a = 0.f, b = 0.f;
#pragma unroll
                    for (int j = 0; j < 4; ++j) { const f32x4 w4 = *(const LAS f32x4*)(wr_l + e * WRS + 4 * lane + 256 * j);
                        a += (xva[j][0] * w4[0] + xva[j][1] * w4[1]) + (xva[j][2] * w4[2] + xva[j][3] * w4[3]); b += (xvb[j][0] * w4[0] + xvb[j][1] * w4[1]) + (xvb[j][2] * w4[2] + xvb[j][3] * w4[3]); }
                    aa[e] = a; ab[e] = b; }
#define TRED(arr, n, msk) _Pragma("unroll") for (int i_ = 0; i_ < (n); ++i_) { const bool up_ = (lane & (msk)) != 0; const float keep_ = up_ ? arr[(n) + i_] : arr[i_], give_ = up_ ? arr[i_] : arr[(n) + i_]; arr[i_] = keep_ + __shfl_xor(give_, (msk)); }
                TRED(aa, 16, 32) TRED(aa, 8, 16) TRED(aa, 4, 8) TRED(aa, 2, 4) TRED(aa, 1, 2)
                TRED(ab, 16, 32) TRED(ab, 8, 16) TRED(ab, 4, 8) TRED(ab, 2, 4) TRED(ab, 1, 2)
#undef TRED
                const float la = aa[0] + __shfl_xor(aa[0], 1) + my_b, lb = ab[0] + __shfl_xor(ab[0], 1) + my_b;
#pragma unroll
                for (int tk = 0; tk < 2; ++tk) {
                    const float v = tk ? lb : la; int rank = 0;
                    if (!(lane & 1)) lg[tk * 32 + ex] = v;
                    LDS_WAIT();
#pragma unroll
                    for (int q = 0; q < 8; ++q) { const f32x4 s4 = *(const LAS f32x4*)(lg + tk * 32 + 4 * q);
#pragma unroll
                        for (int jj = 0; jj < 4; ++jj) rank += (s4[jj] > v || (s4[jj] == v && (4 * q + jj) < ex)) ? 1 : 0; }
                    if (rank < 4 && !(lane & 1)) lg[64 + tk * 4 + rank] = v;
                    LDS_WAIT();
                    const f32x4 tv = *(const LAS f32x4*)(lg + 64 + tk * 4);
                    const float p1 = __expf(tv[1] - tv[0]), p2 = __expf(tv[2] - tv[0]), p3 = __expf(tv[3] - tv[0]), inv = 1.0f / (1.0f + p1 + p2 + p3);
                    if (rank < 4 && !(lane & 1)) { const float w = (rank == 0 ? 1.0f : (rank == 1 ? p1 : (rank == 2 ? p2 : p3))) * inv;
                        const int lr = __hip_atomic_fetch_add((LAS int*)&lcount[ex], 1, __ATOMIC_RELAXED, __HIP_MEMORY_SCOPE_WORKGROUP);
                        asg_e[(tl + tk) * 4 + rank] = ((unsigned)ex << 16) | (unsigned)lr; asg_w[(tl + tk) * 4 + rank] = w; }
                }
            }
            LDS_WAIT();
            if (lane == 0) __hip_atomic_fetch_add((LAS int*)&sync_w[0], 1, __ATOMIC_RELAXED, __HIP_MEMORY_SCOPE_WORKGROUP);
            if (wave == 0) {
                while (__hip_atomic_load((LAS int*)&sync_w[0], __ATOMIC_RELAXED, __HIP_MEMORY_SCOPE_WORKGROUP) < 4) __builtin_amdgcn_s_sleep(4);
                asm volatile("s_waitcnt lgkmcnt(0)" ::: "memory");
                if (lane < 32) gbase[lane] = (int)__hip_atomic_fetch_add(count + lane, (unsigned)lcount[lane], __ATOMIC_RELAXED, __HIP_MEMORY_SCOPE_AGENT);
                LDS_WAIT();
#pragma unroll
                for (int q = 0; q < 4; ++q) { const int a_ = q * 64 + lane; const unsigned ae = asg_e[a_]; const int e = ae >> 16, rank = gbase[e] + (int)(ae & 0xffffu); const int t = chunk * 64 + (a_ >> 2);
                    rowtok_p[e * T + rank] = t; u32x2 av; av.x = ((unsigned)e << 16) | (unsigned)rank; av.y = __float_as_uint(asg_w[a_]); assign[(size_t)t * 4 + (a_ & 3)] = av; }
            }
        }
        const float* w_gate = (const float*)AIN(20); const float* w_up = (const float*)AIN(22); const float* w_down = (const float*)AIN(24);
        const int per_wg = (NEXP * 768 + G - 1) / G;
        for (;;) {
            int it = 0; if (lane == 0) it = __hip_atomic_fetch_add((LAS int*)&sync_w[1], 1, __ATOMIC_RELAXED, __HIP_MEMORY_SCOPE_WORKGROUP);
            it = __builtin_amdgcn_readfirstlane(it); const int item = bx * per_wg + it;
            if (it >= per_wg || item >= NEXP * 768) break;
            const int e = item / 768, r = item % 768, mat = r >> 8, kb = (r >> 4) & 15, nb = r & 15, f0 = nb * 64;
            if (mat < 2) cvt_tile64((mat ? w_up : w_gate) + (size_t)e * D * FF, FF, Bt_gu + (size_t)e * 2048 * D, D, kb * 64, f0, 256 * (f0 >> 7) + mat * 128 + (f0 & 127), lane);
            else cvt_tile64(w_down + (size_t)e * FF * D, D, Bt_d + (size_t)e * D * FF, FF, kb * 64, f0, f0, lane);
        }
    }
    SEAM(6);
    LAS int* t_cnt = (LAS int*)(lds + TAB_OFF + 4096); LAS int* t_start = t_cnt + 32; LAS int* t_t2e = t_start + 40;
    if (IN(7) || IN(8) || IN(9)) {
        KARGS();
        __syncthreads();
        if (tid < 32) t_cnt[tid] = (int)__hip_atomic_load(count + tid, __ATOMIC_RELAXED, __HIP_MEMORY_SCOPE_AGENT);
        __syncthreads();
        if (tid == 0) { int s = 0; for (int e = 0; e < NEXP; ++e) { t_start[e] = s; s += (t_cnt[e] + 255) >> 8; } t_start[32] = s; }
        __syncthreads();
        if (tid < 32) { for (int rt = t_start[tid]; rt < t_start[tid + 1]; ++rt) t_t2e[rt] = tid; }
        __syncthreads();
    }
    if (IN(7)) {
        KARGS();
        pg8::Gemm g{h2, Bt_gu, D}; pg8::MoeOrder S; S.init(t_start[32], 8, G, bx); S.t2e = t_t2e; S.tstart = t_start; S.cnt = t_cnt; S.rowtok = rowtok_p;
        pg8::EpiSwiglu E{act, (const float*)AIN(21), (const float*)AIN(23)};
        pg8::gemm_phase<pg8::EpiSwiglu, pg8::MoeOrder, true, true>(lds, g, S, E);
    }
    SEAM(7);
    if (IN(8)) {
        KARGS();
        pg8::Gemm g{act, Bt_d, FF}; pg8::MoeOrder S; S.init(t_start[32], 4, G, bx); S.t2e = t_t2e; S.tstart = t_start; S.cnt = t_cnt; S.rowtok = rowtok_p;
        pg8::EpiDown E{ybuf, (const float*)AIN(25)};
        pg8::gemm_phase<pg8::EpiDown, pg8::MoeOrder, false, true>(lds, g, S, E);
    }
    SEAM(8);
    if (IN(9) && DBG_OUT) {
        KARGS();
        const bf16_t* src = DBG_OUT == 1 ? gates : DBG_OUT == 2 ? gates + 1024 : DBG_OUT == 3 ? qa : DBG_OUT == 4 ? ka : DBG_OUT == 5 ? va : DBG_OUT == 6 ? mrg : DBG_OUT == 7 ? oa : DBG_OUT == 9 ? Bt_in : ob;
        const int ld = DBG_OUT <= 2 ? 2048 : 1024;
        for (size_t i = (size_t)bx * 512 + tid; i < (size_t)T * 1024; i += (size_t)G * 512) AOUT[i] = (DBG_OUT == 9 && i >= (size_t)N_IN * 1024) ? 0.f : __uint_as_float((unsigned)src[(i >> 10) * ld + (i & 1023)] << 16);
    } else
    if (IN(9)) {
        KARGS();
        LANE_DECL;
        const float* g_fin = (const float*)AIN(26);
        for (int t0 = gw * 2; t0 < T; t0 += NGW * 2) {
            f32x4 v[2][4]; u32x2 as_[2][4];
#pragma unroll
            for (int q = 0; q < 2; ++q) { const f32x4* xr = (const f32x4*)(AOUT + (size_t)(t0 + q) * D) + lane;
#pragma unroll
                for (int j = 0; j < 4; ++j) v[q][j] = xr[64 * j];
#pragma unroll
                for (int k = 0; k < 4; ++k) as_[q][k] = assign[(size_t)(t0 + q) * 4 + k]; }
            u32x2 yw[2][4][4];
#pragma unroll
            for (int q = 0; q < 2; ++q)
#pragma unroll
                for (int k = 0; k < 4; ++k) { const int e = as_[q][k].x >> 16, rank = as_[q][k].x & 0xffffu;
                    const u32x2* yr = (const u32x2*)(ybuf + ((size_t)t_start[e] * 256 + rank) * D) + lane;
#pragma unroll
                    for (int j = 0; j < 4; ++j) yw[q][k][j] = yr[64 * j]; }
#pragma unroll
            for (int q = 0; q < 2; ++q) {
#pragma unroll
                for (int k = 0; k < 4; ++k) { const float w = __uint_as_float(as_[q][k].y);
#pragma unroll
                    for (int j = 0; j < 4; ++j) { const u32x2 y = yw[q][k][j]; v[q][j][0] += w * bf_lo(y.x); v[q][j][1] += w * bf_hi(y.x); v[q][j][2] += w * bf_lo(y.y); v[q][j][3] += w * bf_hi(y.y); } }
                float s = 0.f;
#pragma unroll
                for (int j = 0; j < 4; ++j) s += (v[q][j][0] * v[q][j][0] + v[q][j][1] * v[q][j][1]) + (v[q][j][2] * v[q][j][2] + v[q][j][3] * v[q][j][3]);
                const float rstd = __builtin_amdgcn_rsqf(wave_sum(s) * (1.f / D) + EPS);
                f32x4* xo = (f32x4*)(AOUT + (size_t)(t0 + q) * D) + lane;
#pragma unroll
                for (int j = 0; j < 4; ++j) { const f32x4 gg = *((const f32x4*)g_fin + lane + 64 * j); xo[64 * j] = v[q][j] * rstd * gg; } }
        }
    }
#undef IN
#undef SEAM
#undef KARGS
#undef AIN
#undef AOUT
#undef AWS
#undef xin
#undef positions
#undef Bt_in
#undef Bt_uq
#undef Bt_ukv
#undef Bt_od
#undef Bt_om
#undef Bt_out
#undef ropeA
#undef ropeM
#undef sq
#undef hbuf
#undef oa
#undef qa
#undef ka
#undef va
#undef cq
#undef ckv
#undef kr
#undef gates
#undef qm
#undef kv
#undef ob
#undef mrg
#undef stash
#undef rowtok_p
#undef assign
#undef Bt_d
#undef Bt_gu
#undef h2
#undef act
#undef ybuf
#undef count
}

extern "C" void kernel_launch(void* const* d_in, const int* in_sizes, int n_in, void* d_out, int out_size, void* d_ws, size_t ws_size, hipStream_t stream) {
    static int grid = 0;
    if (grid == 0) {
        if (n_in != 27 || in_sizes[0] != T * D || out_size != T * D || ws_size < WS_END) { fprintf(stderr, "kernel_launch: unexpected shapes (n_in %d, in0 %d, out %d, ws %zu < %zu)\n", n_in, n_in > 0 ? in_sizes[0] : -1, out_size, ws_size, (size_t)WS_END); grid = -1; return; }
        int dev = 0, cus = 0, per_cu = 0;
        if (hipGetDevice(&dev) != hipSuccess || hipDeviceGetAttribute(&cus, hipDeviceAttributeMultiprocessorCount, dev) != hipSuccess) { grid = -1; return; }
        if (hipFuncSetAttribute((const void*)fwd, hipFuncAttributeMaxDynamicSharedMemorySize, LDS_BYTES) != hipSuccess) { fprintf(stderr, "kernel_launch: hipFuncSetAttribute failed\n"); grid = -1; return; }
        if (hipOccupancyMaxActiveBlocksPerMultiprocessor(&per_cu, (const void*)fwd, NWAVES * 64, LDS_BYTES) != hipSuccess || per_cu < 1) fprintf(stderr, "kernel_launch: occupancy query says %d\n", per_cu);
        (void)hipGetLastError();
        grid = cus;
    }
    if (grid < 0) return;
    if (hipMemsetAsync((char*)d_ws + WS_CTL, 0, CTL_ZERO_BYTES, stream) != hipSuccess) return;
    Args a{};
    for (int i = 0; i < 27; ++i) a.in[i] = d_in[i];
    a.out = (float*)d_out; a.ws = (unsigned char*)d_ws;
#if MK_PER_PHASE
    for (int p = 0; p < NPHASE; ++p) { a.ph_lo = p; a.ph_hi = p + 1; hipLaunchKernelGGL(fwd, dim3(grid), dim3(NWAVES * 64), LDS_BYTES, stream, a); }
#elif PROBE_PHASE >= 0
    a.ph_lo = 0; a.ph_hi = PROBE_PHASE + 1; a.li = 0; hipLaunchKernelGGL(fwd, dim3(grid), dim3(NWAVES * 64), LDS_BYTES, stream, a);
    a.ph_lo = PROBE_PHASE; a.ph_hi = NPHASE; a.li = 1; hipLaunchKernelGGL(fwd, dim3(grid), dim3(NWAVES * 64), LDS_BYTES, stream, a);
#else
    a.ph_lo = 0; a.ph_hi = NPHASE; hipLaunchKernelGGL(fwd, dim3(grid), dim3(NWAVES * 64), LDS_BYTES, stream, a);
#endif
}
```

```cpp
#include <hip/hip_runtime.h>
#include <cstdio>
#include <cstdint>

#ifndef MK_PER_PHASE
#define MK_PER_PHASE 0
#endif

#ifndef PROBE_PHASE
#define PROBE_PHASE -1
#endif
#ifndef ATT_DUP
#define ATT_DUP 0
#endif
#ifndef DBG_OUT
#define DBG_OUT 0
#endif
#ifndef DBG_SKIP
#define DBG_SKIP 0
#endif
#ifndef ATT_MASK
#define ATT_MASK 3
#endif
#ifndef PH_MASK
#define PH_MASK 0x3ff
#endif
#define LAS __attribute__((address_space(3)))
#define GAS __attribute__((address_space(1)))
typedef unsigned short bf16_t;
typedef short bf16x8 __attribute__((ext_vector_type(8)));
typedef short s16x4 __attribute__((ext_vector_type(4)));
typedef float f32x2 __attribute__((ext_vector_type(2)));
typedef float f32x4 __attribute__((ext_vector_type(4)));
typedef float f32x16 __attribute__((ext_vector_type(16)));
typedef unsigned u32x2 __attribute__((ext_vector_type(2)));
typedef unsigned u32x4 __attribute__((ext_vector_type(4)));

constexpr int NB = 4, SEQ = 4096, T = NB * SEQ, D = 1024;
constexpr int NEXP = 32, TOPK = 4, FF = 1024;
constexpr int N_IN = 6656;
constexpr int QL = 768, KVL = 512;
constexpr float EPS = 1e-6f;
constexpr float LAM_INIT = 0.2f;
constexpr int NPHASE = 10;

constexpr size_t MiB = 1u << 20;
constexpr size_t WS_CTL = 0, CTL_ZERO_BYTES = 1 * MiB;
constexpr size_t WS_BT_IN = 2 * MiB;
constexpr size_t WS_BT_UQ = 15 * MiB;
constexpr size_t WS_BT_UKV = 18 * MiB;
constexpr size_t WS_BT_OD = 20 * MiB, WS_BT_OM = 22 * MiB, WS_BT_OUT = 24 * MiB;
constexpr size_t WS_ROPEA = 26 * MiB;
constexpr size_t WS_ROPEM = 27 * MiB;
constexpr size_t WS_SQ = 31 * MiB;
constexpr size_t WS_SQP = 1 * MiB;
constexpr size_t WS_H = 32 * MiB;
constexpr size_t WS_QA = 64 * MiB, WS_KA = 96 * MiB, WS_VA = 128 * MiB;
constexpr size_t WS_CQ = 160 * MiB, WS_CKV = 184 * MiB, WS_KR = 200 * MiB;
constexpr size_t WS_SQ2 = 202 * MiB;
constexpr size_t WS_GATES = 208 * MiB;
constexpr size_t WS_QM = 272 * MiB;
constexpr size_t WS_KV = 320 * MiB;
constexpr size_t WS_OB = 384 * MiB;
constexpr size_t WS_MRG = 416 * MiB;
constexpr size_t WS_STASH = 448 * MiB;
constexpr size_t WS_ROWTOK = 2 * MiB;
constexpr size_t WS_ASSIGN = 4 * MiB;
constexpr size_t WS_BT_D = 32 * MiB;
constexpr size_t WS_BT_GU = 96 * MiB;
constexpr size_t WS_H2 = 224 * MiB;
constexpr size_t WS_ACT = 256 * MiB;
constexpr size_t WS_Y = 96 * MiB;
constexpr size_t WS_END = 512 * MiB;
constexpr int CW_COUNT = 64;
constexpr int CW_BAR = 4096;

constexpr int RING_BYTES = 131072;
constexpr int TAB_OFF = RING_BYTES;
constexpr int TAB_BYTES = 8192;
constexpr int MISC_OFF = TAB_OFF + TAB_BYTES;
constexpr int LDS_BYTES = 147456;

typedef __bf16 bf16x2_t __attribute__((ext_vector_type(2)));
__device__ __forceinline__ unsigned cvt_pk_bf16(float lo, float hi) { const f32x2 v = {lo, hi}; return __builtin_bit_cast(unsigned, __builtin_convertvector(v, bf16x2_t)); }
__device__ __forceinline__ float bf_lo(unsigned w) { return __uint_as_float(w << 16); }
__device__ __forceinline__ float bf_hi(unsigned w) { return __uint_as_float(w & 0xffff0000u); }
__device__ __forceinline__ float wave_sum(float v) {
#pragma unroll
    for (int o = 1; o < 64; o <<= 1) v += __shfl_xor(v, o);
    return v;
}
__device__ __forceinline__ float sigmoidf_(float x) { return __builtin_amdgcn_rcpf(1.0f + __builtin_amdgcn_exp2f(-1.4426950408889634f * x)); }
#define LDS_WAIT() asm volatile("s_waitcnt lgkmcnt(0)" ::: "memory")
#define VM_WAIT() asm volatile("s_waitcnt vmcnt(0)" ::: "memory")

#define XB_TMO      128
#define XB_XCNT(j)  (256  + 64 * (j))
#define XB_XSUB(j)  (1280 + 64 * (j))
#define XB_XGEN(j)  (2304 + 64 * (j))
#define XB_TOP      3328
#define XB_TOPGEN   3392
#define XCD_BAR_WORDS 3456
#define XB_SPIN_CAP (1u << 20)
__device__ __forceinline__ unsigned xb_ld(unsigned* p)              { return __hip_atomic_load(p, __ATOMIC_RELAXED, __HIP_MEMORY_SCOPE_AGENT); }
__device__ __forceinline__ unsigned xb_add(unsigned* p, unsigned v) { return __hip_atomic_fetch_add(p, v, __ATOMIC_RELAXED, __HIP_MEMORY_SCOPE_AGENT); }
__device__ __forceinline__ unsigned xb_xcc_id() { return (unsigned)__builtin_amdgcn_s_getreg((3 << 11) | 20) & 0xFu; }
#define XB_SPIN(cond, bar) do { unsigned _sp = 0; while (cond) { __builtin_amdgcn_s_sleep(1); \
    if ((++_sp & 255u) == 0u) { if (xb_ld(&(bar)[XB_TMO])) break; if (_sp > XB_SPIN_CAP) { atomicAdd(&(bar)[XB_TMO], 1u); break; } } } } while (0)
struct XcdBarrier { unsigned* bar; unsigned x; volatile LAS unsigned* st; };
__device__ __forceinline__ XcdBarrier xcd_barrier_post(unsigned* bar, volatile LAS unsigned* st) {
    XcdBarrier b; b.bar = bar; b.x = xb_xcc_id(); b.st = st;
    if (threadIdx.x == 0) (void)xb_add(&bar[XB_XCNT(b.x)], 1u);
    return b;
}
__device__ __forceinline__ void xcd_barrier_complete(unsigned* bar, unsigned x, unsigned& nloc, unsigned& nx) {
    const unsigned G = gridDim.x * gridDim.y * gridDim.z;
    unsigned sum, cnt, mine, sp = 0u;
    for (;;) {
        sum = 0u; cnt = 0u; mine = 0u;
#pragma unroll
        for (unsigned j = 0; j < 16; ++j) { const unsigned c = xb_ld(&bar[XB_XCNT(j)]); sum += c; cnt += (c > 0u) ? 1u : 0u; mine = (j == x) ? c : mine; }
        if (sum == G) break;
        __builtin_amdgcn_s_sleep(1);
        if ((++sp & 255u) == 0u) { if (xb_ld(&bar[XB_TMO])) break; if (sp > XB_SPIN_CAP) { atomicAdd(&bar[XB_TMO], 1u); break; } }
    }
    nloc = mine > 0u ? mine : 1u; nx = cnt > 0u ? cnt : 1u;
}
__device__ __forceinline__ void xcd_barrier(const XcdBarrier& b) {
    asm volatile("s_waitcnt vmcnt(0)" ::: "memory");
    __syncthreads();
    if (threadIdx.x == 0) {
        unsigned* bar = b.bar;
        __builtin_amdgcn_s_waitcnt(0);
        unsigned nloc = b.st[0], nx = b.st[1];
        if (nloc == 0u) { xcd_barrier_complete(bar, b.x, nloc, nx); b.st[0] = nloc; b.st[1] = nx; }
        const unsigned old = xb_add(&bar[XB_XSUB(b.x)], 1u);
        const unsigned gen = old / nloc;
        if (old + 1u == (gen + 1u) * nloc) {
            __builtin_amdgcn_fence(__ATOMIC_RELEASE, "agent");
            asm volatile("s_waitcnt vmcnt(0)" ::: "memory");
            const unsigned og = xb_add(&bar[XB_TOP], 1u);
            const unsigned tg = og / nx;
            if (og + 1u == (tg + 1u) * nx) xb_add(&bar[XB_TOPGEN], 1u);
            else XB_SPIN(xb_ld(&bar[XB_TOPGEN]) == tg, bar);
            __builtin_amdgcn_fence(__ATOMIC_ACQUIRE, "agent");
            xb_add(&bar[XB_XGEN(b.x)], 1u);
            asm volatile("s_waitcnt vmcnt(0)" ::: "memory");
        } else {
            XB_SPIN(xb_ld(&bar[XB_XGEN(b.x)]) == gen, bar);
            __builtin_amdgcn_fence(__ATOMIC_ACQUIRE, "agent");
            asm volatile("s_waitcnt vmcnt(0)" ::: "memory");
        }
    }
    __syncthreads();
}

namespace pg8 {
constexpr int BM = 256, BK = 64, HALF = 128, HTB = HALF * BK * 2, STAGE_BYTES = 8 * HTB, NXCD = 8, WGM = 8;
__host__ __device__ __forceinline__ int lds_byte(int r, int c) { const int st = (r >> 4) * 2 + (c >> 5), rr = r & 15, cc = c & 31, ob = rr * 64 + cc * 2; return st * 1024 + (ob ^ (((ob >> 9) & 1) << 5)); }
__host__ __device__ __forceinline__ void stage_rc(int b, int& R, int& C) { const int st = b / 1024, sb = b % 1024, swz = sb ^ (((sb >> 9) & 1) << 5); R = (st >> 1) * 16 + swz / 64; C = (st & 1) * 32 + (swz % 64) / 2; }
__host__ __device__ __forceinline__ int perm32(int rho) { const int n = rho >> 4, i = rho & 15; return 8 * (i >> 2) + 4 * n + (i & 3); }

struct Unit { int pm, pn, pb, e, rbase, cnt; };
struct Gemm { const bf16_t* A; const bf16_t* Bt; int K; };

struct DenseOrder {
    int nM, nN, nwg, G, c;
    __device__ void init(int nM_, int nN_, int G_, int c_) { nM = nM_; nN = nN_; nwg = nM * nN; G = G_; c = c_; }
    __device__ __forceinline__ bool next(int i, Unit& u) const {
        const long L = (long)i * G + c; if (L >= nwg) return false;
        int wgid = (int)L; { const int q = nwg / NXCD, r = nwg % NXCD, xcd = wgid % NXCD, off = wgid / NXCD; wgid = (xcd < r ? xcd * (q + 1) : r * (q + 1) + (xcd - r) * q) + off; }
        const int nig = WGM * nN, gid = wgid / nig, fm = gid * WGM, gsz = (nM - fm) < WGM ? (nM - fm) : WGM;
        u.pm = fm + ((wgid % nig) % gsz); u.pn = (wgid % nig) / gsz; if (DBG_SKIP & 128) u.pn = nN - 1 - u.pn; u.pb = u.pn; u.e = 0; u.rbase = 0; u.cnt = 0; return true;
    }
    __device__ __forceinline__ int a_row(const Unit&, int) const { return 0; }
};
struct MoeOrder {
    int nM, nN, nwg, G, c; const LAS int* t2e; const LAS int* tstart; const LAS int* cnt; const int* rowtok;
    __device__ void init(int nM_, int nN_, int G_, int c_) { nM = nM_; nN = nN_; nwg = nM * nN; G = G_; c = c_; }
    __device__ __forceinline__ bool next(int i, Unit& u) const {
        const long L = (long)i * G + c; if (L >= nwg) return false;
        int wgid = (int)L; { const int q = nwg / NXCD, r = nwg % NXCD, xcd = wgid % NXCD, off = wgid / NXCD; wgid = (xcd < r ? xcd * (q + 1) : r * (q + 1) + (xcd - r) * q) + off; }
        const int nig = WGM * nN, gid = wgid / nig, fm = gid * WGM, gsz = (nM - fm) < WGM ? (nM - fm) : WGM;
        u.pm = fm + ((wgid % nig) % gsz); u.pn = (wgid % nig) / gsz;
        const int e = t2e[u.pm]; u.e = e; u.pb = e * nN + u.pn; u.rbase = (u.pm - tstart[e]) * 256; u.cnt = cnt[e]; return true;
    }
    __device__ __forceinline__ int a_row(const Unit& u, int r) const { const int rank = u.rbase + r; return rank < u.cnt ? rowtok[u.e * T + rank] : 0; }
};

template <class Epi, class Sched, bool GATHER, bool ALIGN_EPI>
__device__ __forceinline__ void gemm_phase(LAS unsigned char* lds, const Gemm g, const Sched& S, const Epi& E) {
    const int tid = threadIdx.x, wid = __builtin_amdgcn_readfirstlane(tid >> 6), lane = tid & 63, wr = wid >> 2, wc = wid & 3, fr = lane & 15, fq = lane >> 4;
    const int K = g.K, nt = K / BK;
    unsigned voffA[2], voffB[2]; int Rv[2], Cv[2];
#pragma unroll
    for (int i = 0; i < 2; ++i) { int R, C; stage_rc(tid * 16 + i * 8192, R, C); const int Rb = Epi::PERM ? ((R & ~31) + perm32(R & 31)) : R;
        voffA[i] = (unsigned)(R * K + C) * 2u; voffB[i] = (unsigned)(Rb * K + C) * 2u; Rv[i] = R; Cv[i] = C; }
    const size_t kstep = (size_t)(BK * 2);
    const size_t hstep = (size_t)HALF * K * 2;
    const size_t tstep = 2 * hstep;
    const unsigned ldsw = (unsigned)wid * 1024u;
    const int aoff = lds_byte(wr * 64 + fr, fq * 8), boff = lds_byte(wc * 32 + fr, fq * 8);
#define PG8_SA(b, h) (((b) * 2 + (h)) * HTB)
#define PG8_SB(b, h) ((4 + (b) * 2 + (h)) * HTB)
#define PG8_STAGE(bufoff, gbase, voff) do { _Pragma("unroll") for (int _i = 0; _i < 2; ++_i) \
        __builtin_amdgcn_global_load_lds((const unsigned*)((const char*)(gbase) + (voff)[_i]), (LAS unsigned*)(lds + (bufoff) + ldsw + _i * 8192), 16, 0, 0); } while (0)
#define PG8_LDA(dst, b, h) do { _Pragma("unroll") for (int m = 0; m < 4; ++m) _Pragma("unroll") for (int k = 0; k < 2; ++k) dst[m][k] = *(const LAS bf16x8*)(lds + PG8_SA(b, h) + aoff + m * 2048 + k * 1024); } while (0)
#define PG8_LDB(dst, b, h) do { _Pragma("unroll") for (int n = 0; n < 2; ++n) _Pragma("unroll") for (int k = 0; k < 2; ++k) dst[n][k] = *(const LAS bf16x8*)(lds + PG8_SB(b, h) + boff + n * 2048 + k * 1024); } while (0)
#define PG8_MMA(ai, bj, At, Bt) do { __builtin_amdgcn_s_setprio(1); _Pragma("unroll") for (int m = 0; m < 4; ++m) _Pragma("unroll") for (int n = 0; n < 2; ++n) _Pragma("unroll") for (int k = 0; k < 2; ++k) \
        acc[ai][bj][m][n] = __builtin_amdgcn_mfma_f32_16x16x32_bf16(Bt[n][k], At[m][k], acc[ai][bj][m][n], 0, 0, 0); __builtin_amdgcn_s_setprio(0); } while (0)
#define PG8_WAIT_V(n) asm volatile("s_waitcnt vmcnt(" #n ")" ::: "memory")
#define PG8_WAIT_L(n) asm volatile("s_waitcnt lgkmcnt(" #n ")" ::: "memory")
#define PG8_BAR __builtin_amdgcn_s_barrier()
#define PG8_SCHED __builtin_amdgcn_sched_barrier(0)
    Unit cur, nxt; int ui = 0;
    if (!S.next(0, cur)) return;
    f32x4 acc[2][2][4][2];
#pragma unroll
    for (int a = 0; a < 2; ++a)
#pragma unroll
        for (int b = 0; b < 2; ++b)
#pragma unroll
            for (int m = 0; m < 4; ++m)
#pragma unroll
                for (int n = 0; n < 2; ++n) acc[a][b][m][n] = (f32x4){0.f, 0.f, 0.f, 0.f};
    bf16x8 At[4][2], B0[2][2], B1[2][2];
    unsigned gC0[2], gC1[2], gN0[2], gN1[2];
    if constexpr (GATHER) {
#pragma unroll
        for (int i = 0; i < 2; ++i) { gC0[i] = (unsigned)S.a_row(cur, Rv[i]) * (unsigned)(K * 2) + (unsigned)Cv[i] * 2u; gC1[i] = (unsigned)S.a_row(cur, HALF + Rv[i]) * (unsigned)(K * 2) + (unsigned)Cv[i] * 2u; gN0[i] = gC0[i]; gN1[i] = gC1[i]; }
    }
    const char* cA = GATHER ? (const char*)g.A : (const char*)g.A + (size_t)cur.pm * tstep; const char* cB = (const char*)g.Bt + (size_t)cur.pb * tstep;
#define PG8_STAGE_A(bufoff, p, h, o0, o1) do { if constexpr (GATHER) { if ((h) == 0) PG8_STAGE(bufoff, p, o0); else PG8_STAGE(bufoff, p, o1); } else { PG8_STAGE(bufoff, (p) + (h) * hstep, voffA); } } while (0)
    PG8_STAGE(PG8_SB(0, 0), cB, voffB); PG8_STAGE(PG8_SB(0, 1), cB + hstep, voffB); PG8_STAGE_A(PG8_SA(0, 0), cA, 0, gC0, gC1); PG8_STAGE_A(PG8_SA(0, 1), cA, 1, gC0, gC1);
    if (wr == 1) PG8_BAR;
    PG8_WAIT_V(2); PG8_BAR;
    PG8_STAGE(PG8_SB(1, 0), cB + kstep, voffB); PG8_STAGE_A(PG8_SA(1, 0), cA + kstep, 0, gC0, gC1); PG8_STAGE(PG8_SB(1, 1), cB + hstep + kstep, voffB);
    PG8_WAIT_V(6); PG8_BAR;
    for (;;) {
        const bool has_next = S.next(ui + 1, nxt);
        const char* nA = GATHER ? (const char*)g.A : (has_next ? (const char*)g.A + (size_t)nxt.pm * tstep : cA); const char* nB = has_next ? (const char*)g.Bt + (size_t)nxt.pb * tstep : cB;
        if constexpr (GATHER) { if (has_next) {
#pragma unroll
            for (int i = 0; i < 2; ++i) { gN0[i] = (unsigned)S.a_row(nxt, Rv[i]) * (unsigned)(K * 2) + (unsigned)Cv[i] * 2u; gN1[i] = (unsigned)S.a_row(nxt, HALF + Rv[i]) * (unsigned)(K * 2) + (unsigned)Cv[i] * 2u; } } }
        for (int t = 0; t < nt; t += 2) {
            const bool last = (t == nt - 2);
            const char* a1 = cA + (size_t)(t + 1) * kstep;
            const char* a2 = last ? nA : cA + (size_t)(t + 2) * kstep; const char* b2 = last ? nB : cB + (size_t)(t + 2) * kstep;
            const char* a3 = a2 + kstep; const char* b3 = b2 + kstep;
            unsigned s0[2], s1[2];
            if constexpr (GATHER) { s0[0] = last ? gN0[0] : gC0[0]; s0[1] = last ? gN0[1] : gC0[1]; s1[0] = last ? gN1[0] : gC1[0]; s1[1] = last ? gN1[1] : gC1[1]; }
            PG8_LDB(B0, 0, 0); PG8_LDB(B1, 0, 1); PG8_SCHED; PG8_LDA(At, 0, 0); PG8_STAGE_A(PG8_SA(1, 1), a1, 1, gC0, gC1);
            PG8_WAIT_V(8); PG8_WAIT_L(0); PG8_BAR; PG8_MMA(0, 0, At, B0); PG8_MMA(0, 1, At, B1); PG8_BAR; PG8_SCHED;
            PG8_LDA(At, 0, 1); PG8_STAGE(PG8_SB(0, 0), b2, voffB); PG8_STAGE(PG8_SB(0, 1), b2 + hstep, voffB); PG8_STAGE_A(PG8_SA(0, 0), a2, 0, s0, s1);
            PG8_WAIT_V(8); PG8_WAIT_L(0); PG8_BAR; PG8_MMA(1, 0, At, B0); PG8_MMA(1, 1, At, B1); PG8_BAR; PG8_SCHED;
            PG8_LDB(B0, 1, 0); PG8_LDB(B1, 1, 1); PG8_SCHED; PG8_LDA(At, 1, 0); PG8_STAGE_A(PG8_SA(0, 1), a2, 1, s0, s1);
            PG8_WAIT_V(8); PG8_WAIT_L(0); PG8_BAR; PG8_MMA(0, 0, At, B0); PG8_MMA(0, 1, At, B1); PG8_BAR; PG8_SCHED;
            PG8_LDA(At, 1, 1); PG8_STAGE(PG8_SB(1, 0), b3, voffB); PG8_STAGE(PG8_SB(1, 1), b3 + hstep, voffB); PG8_STAGE_A(PG8_SA(1, 0), a3, 0, s0, s1);
            PG8_WAIT_V(8); PG8_WAIT_L(0); PG8_BAR; PG8_MMA(1, 0, At, B0); PG8_MMA(1, 1, At, B1); PG8_BAR; PG8_SCHED;
        }
        if constexpr (ALIGN_EPI) { if (wr == 0) PG8_BAR; }
        E(acc, cur, wr, wc, fr, fq);
        if (!has_next) break;
#pragma unroll
        for (int a = 0; a < 2; ++a)
#pragma unroll
            for (int b = 0; b < 2; ++b)
#pragma unroll
                for (int m = 0; m < 4; ++m)
#pragma unroll
                    for (int n = 0; n < 2; ++n) acc[a][b][m][n] = (f32x4){0.f, 0.f, 0.f, 0.f};
        cur = nxt; cA = nA; cB = nB; ++ui;
        if constexpr (GATHER) { gC0[0] = gN0[0]; gC0[1] = gN0[1]; gC1[0] = gN1[0]; gC1[1] = gN1[1]; }
        if constexpr (ALIGN_EPI) { if (wr == 1) PG8_BAR; }
    }
    PG8_WAIT_V(0);
    if constexpr (!ALIGN_EPI) { if (wr == 0) PG8_BAR; }
    PG8_BAR;
#undef PG8_SA
#undef PG8_SB
#undef PG8_STAGE
#undef PG8_STAGE_A
#undef PG8_LDA
#undef PG8_LDB
#undef PG8_MMA
#undef PG8_WAIT_V
#undef PG8_WAIT_L
#undef PG8_BAR
#undef PG8_SCHED
}

__device__ __forceinline__ u32x4 pack8(const f32x4& v0, const f32x4& v1) { u32x4 w; w.x = cvt_pk_bf16(v0[0], v0[1]); w.y = cvt_pk_bf16(v0[2], v0[3]); w.z = cvt_pk_bf16(v1[0], v1[1]); w.w = cvt_pk_bf16(v1[2], v1[3]); return w; }
__device__ __forceinline__ void rope4(f32x4& v0, f32x4& v1, const float* cs) {
    const f32x4 a = *(const f32x4*)cs, b = *(const f32x4*)(cs + 4);
    float x1, x2;
    x1 = v0[0]; x2 = v0[1]; v0[0] = x1 * a[0] - x2 * a[1]; v0[1] = x2 * a[0] + x1 * a[1];
    x1 = v0[2]; x2 = v0[3]; v0[2] = x1 * a[2] - x2 * a[3]; v0[3] = x2 * a[2] + x1 * a[3];
    x1 = v1[0]; x2 = v1[1]; v1[0] = x1 * b[0] - x2 * b[1]; v1[1] = x2 * b[0] + x1 * b[1];
    x1 = v1[2]; x2 = v1[3]; v1[2] = x1 * b[2] - x2 * b[3]; v1[3] = x2 * b[2] + x1 * b[3];
}

struct EpiIn {
    static constexpr bool PERM = true;
    bf16_t *qa, *ka, *va, *cq, *ckv, *gates, *kr; const float *ropeA, *ropeM, *bg; float* sq;
    __device__ __forceinline__ void operator()(const f32x4 (&acc)[2][2][4][2], const Unit& u, int wr, int wc, int fr, int fq) const {
        const int pn = u.pn, row0 = u.pm * BM + wr * 64 + fr, cl = wc * 32 + 8 * fq;
        if (pn < 8) {
            bf16_t* dst = pn < 4 ? qa : ka; const int colt = (pn & 3) * 256; const bool rot = ((wc & 1) == 0) && (fq < 2);
#pragma unroll
            for (int ai = 0; ai < 2; ++ai)
#pragma unroll
                for (int m = 0; m < 4; ++m) { const int row = row0 + ai * HALF + m * 16;
#pragma unroll
                    for (int bj = 0; bj < 2; ++bj) { f32x4 v0 = acc[ai][bj][m][0], v1 = acc[ai][bj][m][1];
                        if (rot) rope4(v0, v1, ropeA + (size_t)row * 16 + fq * 8);
                        *(u32x4*)(dst + (size_t)row * 1024 + colt + bj * HALF + cl) = pack8(v0, v1); } }
        } else if (pn < 12) {
            const int colt = (pn - 8) * 256;
#pragma unroll
            for (int ai = 0; ai < 2; ++ai)
#pragma unroll
                for (int m = 0; m < 4; ++m) { const int row = row0 + ai * HALF + m * 16;
#pragma unroll
                    for (int bj = 0; bj < 2; ++bj) *(u32x4*)(va + (size_t)row * 1024 + colt + bj * HALF + cl) = pack8(acc[ai][bj][m][0], acc[ai][bj][m][1]); }
        } else if (pn < 17) {
            const bool isq = pn < 15; bf16_t* dst = isq ? cq : ckv; const int ld = isq ? QL : KVL, colt = (isq ? pn - 12 : pn - 15) * 256, tq = pn - 12;
#pragma unroll
            for (int ai = 0; ai < 2; ++ai)
#pragma unroll
                for (int m = 0; m < 4; ++m) { const int row = row0 + ai * HALF + m * 16; float s = 0.f;
#pragma unroll
                    for (int bj = 0; bj < 2; ++bj) { const f32x4 v0 = acc[ai][bj][m][0], v1 = acc[ai][bj][m][1];
                        s += (v0[0] * v0[0] + v0[1] * v0[1]) + (v0[2] * v0[2] + v0[3] * v0[3]) + (v1[0] * v1[0] + v1[1] * v1[1]) + (v1[2] * v1[2] + v1[3] * v1[3]);
                        *(u32x4*)(dst + (size_t)row * ld + colt + bj * HALF + cl) = pack8(v0, v1); }
                    s += __shfl_xor(s, 16); s += __shfl_xor(s, 32);
                    if (fq == 0) sq[(size_t)row * 20 + tq * 4 + wc] = s; }
        } else if (pn < 25) {
            const int colt = (pn - 17) * 256;
            f32x4 bv[2][2];
#pragma unroll
            for (int bj = 0; bj < 2; ++bj) { bv[bj][0] = *(const f32x4*)(bg + colt + bj * HALF + cl); bv[bj][1] = *(const f32x4*)(bg + colt + bj * HALF + cl + 4); if (DBG_SKIP & 256) { bv[bj][0] = bv[bj][0] * 0.f; bv[bj][1] = bv[bj][1] * 0.f; } }
#pragma unroll
            for (int ai = 0; ai < 2; ++ai)
#pragma unroll
                for (int m = 0; m < 4; ++m) { const int row = row0 + ai * HALF + m * 16;
#pragma unroll
                    for (int bj = 0; bj < 2; ++bj) { f32x4 v0 = acc[ai][bj][m][0] + bv[bj][0], v1 = acc[ai][bj][m][1] + bv[bj][1];
#pragma unroll
                        for (int j = 0; j < 4; ++j) { if (!(DBG_SKIP & 512)) { v0[j] = sigmoidf_(v0[j]); v1[j] = sigmoidf_(v1[j]); } }
                        *(u32x4*)(gates + (size_t)row * 2048 + colt + bj * HALF + cl) = pack8(v0, v1); } }
        } else {
            if (wc < 2) {
#pragma unroll
                for (int ai = 0; ai < 2; ++ai)
#pragma unroll
                    for (int m = 0; m < 4; ++m) { const int row = row0 + ai * HALF + m * 16;
                        f32x4 v0 = acc[ai][0][m][0], v1 = acc[ai][0][m][1];
                        rope4(v0, v1, ropeM + (size_t)row * 64 + (wc * 16 + fq * 4) * 2);
                        *(u32x4*)(kr + (size_t)row * 64 + cl) = pack8(v0, v1); }
            }
        }
    }
};
template <bool ISQ> struct EpiUp {
    static constexpr bool PERM = true;
    bf16_t* out; const float* sq; const float* ropeM;
    __device__ __forceinline__ void operator()(const f32x4 (&acc)[2][2][4][2], const Unit& u, int wr, int wc, int fr, int fq) const {
        const int row0 = u.pm * BM + wr * 64 + fr, cl = wc * 32 + 8 * fq; constexpr int LD = ISQ ? 1536 : 2048;
#pragma unroll
        for (int ai = 0; ai < 2; ++ai)
#pragma unroll
            for (int m = 0; m < 4; ++m) { const int row = row0 + ai * HALF + m * 16; float s;
                if (ISQ) { const f32x4 a = *(const f32x4*)(sq + (size_t)row * 20), b = *(const f32x4*)(sq + (size_t)row * 20 + 4), c = *(const f32x4*)(sq + (size_t)row * 20 + 8);
                    s = ((a[0] + a[1]) + (a[2] + a[3])) + ((b[0] + b[1]) + (b[2] + b[3])) + ((c[0] + c[1]) + (c[2] + c[3])); }
                else { const f32x4 a = *(const f32x4*)(sq + (size_t)row * 20 + 12), b = *(const f32x4*)(sq + (size_t)row * 20 + 16);
                    s = ((a[0] + a[1]) + (a[2] + a[3])) + ((b[0] + b[1]) + (b[2] + b[3])); }
                const float rstd = __builtin_amdgcn_rsqf(s * (ISQ ? 1.0f / QL : 1.0f / KVL) + EPS);
#pragma unroll
                for (int bj = 0; bj < 2; ++bj) { const int col = u.pn * BM + bj * HALF + cl; f32x4 v0 = acc[ai][bj][m][0] * rstd, v1 = acc[ai][bj][m][1] * rstd;
                    if (ISQ) { const int off = col % 192; if (off >= 128) rope4(v0, v1, ropeM + (size_t)row * 64 + (off - 128)); }
                    *(u32x4*)(out + (size_t)row * LD + col) = pack8(v0, v1); } }
    }
};
template <int WHICH> struct EpiGate {
    static constexpr bool PERM = true;
    bf16_t* mrg; const bf16_t* gates;
    __device__ __forceinline__ void operator()(const f32x4 (&acc)[2][2][4][2], const Unit& u, int wr, int wc, int fr, int fq) const {
        const int row0 = u.pm * BM + wr * 64 + fr, cl = wc * 32 + 8 * fq;
#pragma unroll
        for (int ai = 0; ai < 2; ++ai)
#pragma unroll
            for (int m = 0; m < 4; ++m) { const int row = row0 + ai * HALF + m * 16;
#pragma unroll
                for (int bj = 0; bj < 2; ++bj) { const int col = u.pn * BM + bj * HALF + cl;
                    const u32x4 gw = *(const u32x4*)(gates + (size_t)row * 2048 + WHICH * 1024 + col);
                    f32x4 v0 = acc[ai][bj][m][0], v1 = acc[ai][bj][m][1];
                    if ((DBG_SKIP & 8) && WHICH == 0) { v0 = v0 * 0.f; v1 = v1 * 0.f; } if ((DBG_SKIP & 16) && WHICH == 1) { v0 = v0 * 0.f; v1 = v1 * 0.f; }
                    v0[0] *= bf_lo(gw.x); v0[1] *= bf_hi(gw.x); v0[2] *= bf_lo(gw.y); v0[3] *= bf_hi(gw.y); v1[0] *= bf_lo(gw.z); v1[1] *= bf_hi(gw.z); v1[2] *= bf_lo(gw.w); v1[3] *= bf_hi(gw.w);
                    if (WHICH == 1) { const u32x4 tw = *(const u32x4*)(mrg + (size_t)row * 1024 + col);
                        v0[0] += bf_lo(tw.x); v0[1] += bf_hi(tw.x); v0[2] += bf_lo(tw.y); v0[3] += bf_hi(tw.y); v1[0] += bf_lo(tw.z); v1[1] += bf_hi(tw.z); v1[2] += bf_lo(tw.w); v1[3] += bf_hi(tw.w); }
                    *(u32x4*)(mrg + (size_t)row * 1024 + col) = pack8(v0, v1); } }
    }
};
struct EpiRes {
    static constexpr bool PERM = false;
    const float* x; float* out;
    __device__ __forceinline__ void operator()(const f32x4 (&acc)[2][2][4][2], const Unit& u, int wr, int wc, int fr, int fq) const {
        const int row0 = u.pm * BM + wr * 64 + fr, col0 = u.pn * BM + wc * 32 + 4 * fq;
#pragma unroll
        for (int ai = 0; ai < 2; ++ai)
#pragma unroll
            for (int m = 0; m < 4; ++m) { const size_t off = (size_t)(row0 + ai * HALF + m * 16) * 1024 + col0;
#pragma unroll
                for (int bj = 0; bj < 2; ++bj)
#pragma unroll
                    for (int n = 0; n < 2; ++n) *(f32x4*)(out + off + bj * HALF + n * 16) = *(const f32x4*)(x + off + bj * HALF + n * 16) + ((DBG_SKIP & 2) ? 0.f : 1.f) * acc[ai][bj][m][n]; }
    }
};
struct EpiSwiglu {
    static constexpr bool PERM = true;
    bf16_t* act; const float *bgate, *bup;
    __device__ __forceinline__ void operator()(const f32x4 (&acc)[2][2][4][2], const Unit& u, int wr, int wc, int fr, int fq) const {
        const int row0 = u.pm * BM + wr * 64 + fr, f0 = u.pn * HALF + wc * 32 + 8 * fq;
        f32x4 bgv[2], buv[2];
#pragma unroll
        for (int n = 0; n < 2; ++n) { bgv[n] = *(const f32x4*)(bgate + (size_t)u.e * FF + f0 + 4 * n); buv[n] = *(const f32x4*)(bup + (size_t)u.e * FF + f0 + 4 * n); }
#pragma unroll
        for (int ai = 0; ai < 2; ++ai)
#pragma unroll
            for (int m = 0; m < 4; ++m) { const int row = row0 + ai * HALF + m * 16; f32x4 o[2];
#pragma unroll
                for (int n = 0; n < 2; ++n) { const f32x4 gt = acc[ai][0][m][n] + bgv[n], up = acc[ai][1][m][n] + buv[n];
#pragma unroll
                    for (int j = 0; j < 4; ++j) { const float gg = fminf(gt[j], 7.0f), uu = fminf(fmaxf(up[j], -7.0f), 7.0f); o[n][j] = (uu + 1.0f) * (gg * sigmoidf_(1.702f * gg)); } }
                *(u32x4*)(act + (size_t)row * FF + f0) = pack8(o[0], o[1]); }
    }
};
struct EpiDown {
    static constexpr bool PERM = true;
    bf16_t* y; const float* bd;
    __device__ __forceinline__ void operator()(const f32x4 (&acc)[2][2][4][2], const Unit& u, int wr, int wc, int fr, int fq) const {
        const int row0 = u.pm * BM + wr * 64 + fr, cl = wc * 32 + 8 * fq;
        f32x4 bv[2][2];
#pragma unroll
        for (int bj = 0; bj < 2; ++bj) { const int col = u.pn * BM + bj * HALF + cl; bv[bj][0] = *(const f32x4*)(bd + (size_t)u.e * D + col); bv[bj][1] = *(const f32x4*)(bd + (size_t)u.e * D + col + 4); }
#pragma unroll
        for (int ai = 0; ai < 2; ++ai)
#pragma unroll
            for (int m = 0; m < 4; ++m) { const int row = row0 + ai * HALF + m * 16;
#pragma unroll
                for (int bj = 0; bj < 2; ++bj) { const int col = u.pn * BM + bj * HALF + cl;
                    *(u32x4*)(y + (size_t)row * D + col) = pack8(acc[ai][bj][m][0] + bv[bj][0], acc[ai][bj][m][1] + bv[bj][1]); } }
    }
};
}

namespace att {
constexpr int NW = 8, QBLK = 32, KVBLK = 64;
constexpr int SHM_V = KVBLK * 128 * 2;
#define SBAR() __builtin_amdgcn_sched_barrier(0)
#define KSW(row, colB) ((row) * 128 + ((colB) ^ ((((row) >> 1) & 7) << 4)))
__device__ __forceinline__ int crow(int r, int hi) { return (r & 3) + 8 * (r >> 2) + 4 * hi; }
struct Src { const bf16_t* Q; const bf16_t* K; const bf16_t* K2; const bf16_t* V; int ldq, ldk, ldk2, ldv; };

__device__ __forceinline__ void partialSM(f32x16& p0, f32x16& p1, float& m_reg, float& mn, float& alpha, const float C, const float thr) {
  float pmax;
  { float a0 = fmaxf(fmaxf(p0[0], p0[1]), p0[2]), a1 = fmaxf(fmaxf(p0[3], p0[4]), p0[5]), a2 = fmaxf(fmaxf(p1[0], p1[1]), p1[2]), a3 = fmaxf(fmaxf(p1[3], p1[4]), p1[5]);
#pragma unroll
    for (int r = 6; r < 16; r += 2) { a0 = fmaxf(fmaxf(a0, p0[r]), p0[r + 1]); a2 = fmaxf(fmaxf(a2, p1[r]), p1[r + 1]); }
    pmax = fmaxf(fmaxf(a0, a1), fmaxf(a2, a3)); }
  { auto rr = __builtin_amdgcn_permlane32_swap(__float_as_uint(pmax), __float_as_uint(pmax), false, false);
    pmax = fmaxf(__uint_as_float(rr[0]), __uint_as_float(rr[1])); }
  if (__builtin_expect(__all(pmax - m_reg <= thr), 1)) { mn = m_reg; alpha = 1.f; }
  else { mn = fmaxf(m_reg, pmax); alpha = __builtin_amdgcn_exp2f((m_reg - mn) * C); m_reg = mn; }
  const float mnC = -mn * C;
#pragma unroll
  for (int r = 0; r < 16; ++r) p0[r] = fmaf(p0[r], C, mnC);
#pragma unroll
  for (int r = 0; r < 16; ++r) p1[r] = fmaf(p1[r], C, mnC);
#pragma unroll
  for (int r = 0; r < 16; ++r) p0[r] = __builtin_amdgcn_exp2f(p0[r]);
#if ATT_DUP == 1
  { float d_[16];
#pragma unroll
    for (int r = 0; r < 16; ++r) { d_[r] = __builtin_amdgcn_exp2f(p1[r]); d_[r] = fmaf(d_[r], C, mnC); }
#pragma unroll
    for (int r = 0; r < 16; ++r) asm volatile("" :: "v"(d_[r])); }
#endif
}
__device__ __forceinline__ void finishSM(f32x16& p0, f32x16& p1, float alpha, float& l_reg, bf16x8& pa0, bf16x8& pa1, bf16x8& pa2, bf16x8& pa3) {
#pragma unroll
  for (int r = 0; r < 16; ++r) p1[r] = __builtin_amdgcn_exp2f(p1[r]);
  float ps;
  { float s0 = p0[0] + p0[1], s1 = p0[2] + p0[3], s2 = p1[0] + p1[1], s3 = p1[2] + p1[3];
#pragma unroll
    for (int r = 4; r < 16; r += 4) { s0 += p0[r] + p0[r + 1]; s1 += p0[r + 2] + p0[r + 3]; s2 += p1[r] + p1[r + 1]; s3 += p1[r + 2] + p1[r + 3]; }
    ps = (s0 + s1) + (s2 + s3); }
  { auto rr = __builtin_amdgcn_permlane32_swap(__float_as_uint(ps), __float_as_uint(ps), false, false);
    ps = __uint_as_float(rr[0]) + __uint_as_float(rr[1]); }
  l_reg = l_reg * alpha + ps;
#define PK4(P, BASE, OUT) do { unsigned a0 = cvt_pk_bf16(P[BASE + 0], P[BASE + 1]), a1 = cvt_pk_bf16(P[BASE + 2], P[BASE + 3]);   \
    unsigned b0 = cvt_pk_bf16(P[BASE + 4], P[BASE + 5]), b1 = cvt_pk_bf16(P[BASE + 6], P[BASE + 7]);                              \
    auto r0 = __builtin_amdgcn_permlane32_swap(a0, b0, false, false); auto r1 = __builtin_amdgcn_permlane32_swap(a1, b1, false, false); \
    u32x4 w = {r0[0], r1[0], r0[1], r1[1]}; OUT = *reinterpret_cast<bf16x8*>(&w); } while (0)
  PK4(p0, 0, pa0); PK4(p0, 8, pa1); PK4(p1, 0, pa2); PK4(p1, 8, pa3);
#undef PK4
}
template <int DQK> __device__ __forceinline__ void qkt(f32x16& p0, f32x16& p1, const LAS char* Ks, const bf16x8* qr, int r32, int hi) {
  p0 = f32x16{}; p1 = f32x16{};
#pragma unroll
  for (int d0 = 0; d0 < DQK / 16; ++d0) { const int sub = d0 >> 2, cb = ((d0 & 3) * 16 + hi * 8) * 2;
    const bf16x8 b0 = *(const LAS bf16x8*)(Ks + sub * 8192 + KSW(r32, cb));
    const bf16x8 b1 = *(const LAS bf16x8*)(Ks + sub * 8192 + KSW(32 + r32, cb));
    p0 = __builtin_amdgcn_mfma_f32_32x32x16_bf16(b0, qr[d0], p0, 0, 0, 0);
    p1 = __builtin_amdgcn_mfma_f32_32x32x16_bf16(b1, qr[d0], p1, 0, 0, 0); }
#if ATT_DUP == 2
  if constexpr (DQK == 64) { bf16x8 zq = {0, 0, 0, 0, 0, 0, 0, 0}; asm volatile("" : "+v"(zq));
    const bf16x8 bz = *(const LAS bf16x8*)(Ks + KSW(r32, hi * 16));
#pragma unroll
    for (int d0 = 0; d0 < 2; ++d0) { p0 = __builtin_amdgcn_mfma_f32_32x32x16_bf16(bz, zq, p0, 0, 0, 0); p1 = __builtin_amdgcn_mfma_f32_32x32x16_bf16(bz, zq, p1, 0, 0, 0); } }
#endif
}
__device__ __forceinline__ int v_st(int k, int c) { const int kk = (k & ~0xC) | ((k & 4) << 1) | ((k & 8) >> 1); return ((kk >> 3) * 4 + (c >> 5)) * 512 + ((kk & 7) * 32 + (c & 31)) * 2; }
__device__ __forceinline__ int v_rd_base(int lane) { return ((lane & 3) << 3) | (((lane >> 2) & 3) << 6) | (((lane >> 4) & 1) << 5) | (((lane >> 5) & 1) << 8); }
constexpr int v_rd_off(int d0, int ks, int half) { return d0 * 512 + ks * 4096 + half * 2048; }
template <int OFF> __device__ __forceinline__ s16x4 tr_read(int vb) {
  s16x4 r; asm volatile("ds_read_b64_tr_b16 %0, %1 offset:%2" : "=&v"(r) : "v"(vb), "i"(OFF) : "memory"); return r;
}
template <int KS> __device__ __forceinline__ void pv_step(f32x16* o, int vb, bf16x8 pa) {
  s16x4 l0, h0, l1, h1, l2, h2, l3, h3;
  l0 = tr_read<v_rd_off(0, KS, 0)>(vb); h0 = tr_read<v_rd_off(0, KS, 1)>(vb); l1 = tr_read<v_rd_off(1, KS, 0)>(vb); h1 = tr_read<v_rd_off(1, KS, 1)>(vb);
  l2 = tr_read<v_rd_off(2, KS, 0)>(vb); h2 = tr_read<v_rd_off(2, KS, 1)>(vb); l3 = tr_read<v_rd_off(3, KS, 0)>(vb); h3 = tr_read<v_rd_off(3, KS, 1)>(vb);
  asm volatile("s_waitcnt lgkmcnt(0)" ::: "memory"); SBAR();
#define PK(L, H) (bf16x8){L[0], L[1], L[2], L[3], H[0], H[1], H[2], H[3]}
  o[0] = __builtin_amdgcn_mfma_f32_32x32x16_bf16(pa, PK(l0, h0), o[0], 0, 0, 0);
  o[1] = __builtin_amdgcn_mfma_f32_32x32x16_bf16(pa, PK(l1, h1), o[1], 0, 0, 0);
  o[2] = __builtin_amdgcn_mfma_f32_32x32x16_bf16(pa, PK(l2, h2), o[2], 0, 0, 0);
  o[3] = __builtin_amdgcn_mfma_f32_32x32x16_bf16(pa, PK(l3, h3), o[3], 0, 0, 0);
#undef PK
}
__device__ __forceinline__ void pv_d0(f32x16* o, int vb, bf16x8 pa0, bf16x8 pa1, bf16x8 pa2, bf16x8 pa3) {
  pv_step<0>(o, vb, pa0); pv_step<1>(o, vb, pa1); pv_step<2>(o, vb, pa2); pv_step<3>(o, vb, pa3);
}
template <int DQK>
__device__ __forceinline__ void attn_core(const Src in, const float C, const float thr, const int seq, LAS char* lds, f32x16 (&o)[4]) {
  constexpr int NSUB = DQK / 64, SHM_K = NSUB * 8192;
  int lane; asm volatile("v_and_b32 %0, 63, %1" : "=v"(lane) : "v"(threadIdx.x));
  const int tid = threadIdx.x, wid = __builtin_amdgcn_readfirstlane(tid >> 6), r32 = lane & 31, hi = (lane >> 5) & 1;
  LAS char* V_lds = lds; LAS char* K_lds = lds + 3 * SHM_V;
  LAS float* ws = (LAS float*)(lds + 3 * SHM_V + 3 * SHM_K) + wid * 64; LAS float* li_l = ws; LAS float* al_l = ws + 32;
  float m_reg = -1e30f, l_reg = 0;
#pragma unroll
  for (int d = 0; d < 4; ++d) o[d] = f32x16{};
  bf16x8 qr[DQK / 16];
  const bf16_t* Qw = in.Q + (size_t)(wid * QBLK + r32) * in.ldq + hi * 8;
#pragma unroll
  for (int d0 = 0; d0 < DQK / 16; ++d0) qr[d0] = *(const bf16x8*)(Qw + d0 * 16);
  const int krow = wid * 8 + (lane >> 3), kslot = (lane & 7) ^ ((krow >> 1) & 7);
  const unsigned koff = (unsigned)(krow * in.ldk + kslot * 8) * 2u, k2off = (unsigned)(krow * in.ldk2 + kslot * 8) * 2u;
  unsigned voff[2];
#pragma unroll
  for (int i = 0; i < 2; ++i) { const int p = i * 8192 + wid * 1024 + lane * 16, st = p >> 9, wq = (p & 511) >> 1, kk = (st >> 2) * 8 + (wq >> 5), cl = wq & 31;
    const int k = (kk & ~0xC) | ((kk & 4) << 1) | ((kk & 8) >> 1); voff[i] = (unsigned)(k * in.ldv + (st & 3) * 32 + cl) * 2u; }
  const int vb0 = (int)(unsigned)(size_t)V_lds + v_rd_base(lane);
  const unsigned ldsw = (unsigned)wid * 1024u;
#define GLDS(gp, lp) __builtin_amdgcn_global_load_lds((const unsigned*)(gp), (LAS unsigned*)(lp), 16, 0, 0)
#define ISSUE_K(t, b) do { const char* kb_ = (const char*)in.K + (size_t)(t) * (KVBLK * 2) * in.ldk; \
    _Pragma("unroll") for (int s_ = 0; s_ < NSUB; ++s_) { if (s_ < 2) GLDS(kb_ + s_ * 128 + koff, K_lds + (b) * SHM_K + s_ * 8192 + ldsw); \
      else GLDS((const char*)in.K2 + (size_t)(t) * (KVBLK * 2) * in.ldk2 + k2off, K_lds + (b) * SHM_K + s_ * 8192 + ldsw); } } while (0)
#define ISSUE_V(t, b) do { const char* vb_ = (const char*)in.V + (size_t)(t) * (KVBLK * 2) * in.ldv; \
    GLDS(vb_ + voff[0], V_lds + (b) * SHM_V + ldsw); GLDS(vb_ + voff[1], V_lds + (b) * SHM_V + 8192 + ldsw); \
    if (ATT_DUP == 3) { GLDS(vb_ + voff[0], V_lds + (b) * SHM_V + ldsw); GLDS(vb_ + voff[1], V_lds + (b) * SHM_V + 8192 + ldsw); } } while (0)
#define WAITV(n) asm volatile("s_waitcnt vmcnt(%0)" :: "n"((DBG_SKIP & 4) ? 0 : (n)) : "memory")
#define WBAR() do { asm volatile("" ::: "memory"); __builtin_amdgcn_s_barrier(); asm volatile("" ::: "memory"); } while (0)
#define RESC(a) do { if (__any((a) < 1.f)) { if (hi == 0) al_l[r32] = (a); asm volatile("s_waitcnt lgkmcnt(0)" ::: "memory"); \
    _Pragma("unroll") for (int d = 0; d < 4; ++d) _Pragma("unroll") for (int r = 0; r < 16; ++r) o[d][r] *= al_l[crow(r, hi)]; } } while (0)
#define NXT3(x) ((x) == 2 ? 0 : (x) + 1)
  constexpr int NI = NSUB + (ATT_DUP == 3 ? 4 : 2), NV = (ATT_DUP == 3 ? 4 : 2);
  f32x16 pA0, pA1, pB0, pB1; float mnA, mnB, alA, alB; bf16x8 pa0, pa1, pa2, pa3; const int NT = seq / KVBLK;
  const bool lead = wid < 4;
  ISSUE_K(0, 0); ISSUE_K(1, 1); ISSUE_V(0, 0);
  if (!lead) { WAITV(NI); WBAR(); }
  WAITV(NI); WBAR();
  ISSUE_K(2, 2);
  qkt<DQK>(pA0, pA1, K_lds, qr, r32, hi);
  WAITV(NI); WBAR();
  ISSUE_V(1, 1);
  partialSM(pA0, pA1, m_reg, mnA, alA, C, thr);
  WAITV(NI); WBAR();
  int bq = 1;
  for (int j = 1; j + 3 < NT; j += 2) {
    { const int b1 = NXT3(bq), b2 = NXT3(b1);
      ISSUE_K(j + 2, b2);
      SBAR(); qkt<DQK>(pB0, pB1, K_lds + bq * SHM_K, qr, r32, hi);
      finishSM(pA0, pA1, alA, l_reg, pa0, pa1, pa2, pa3); SBAR();
      WAITV(NI); WBAR();
      ISSUE_V(j + 1, b1);
      pv_d0(o, vb0 + b2 * SHM_V, pa0, pa1, pa2, pa3); partialSM(pB0, pB1, m_reg, mnB, alB, C, thr);
      RESC(alB); bq = b1;
      WAITV(NI); WBAR(); }
    { const int b1 = NXT3(bq), b2 = NXT3(b1);
      ISSUE_K(j + 3, b2);
      SBAR(); qkt<DQK>(pA0, pA1, K_lds + bq * SHM_K, qr, r32, hi);
      finishSM(pB0, pB1, alB, l_reg, pa0, pa1, pa2, pa3); SBAR();
      WAITV(NI); WBAR();
      ISSUE_V(j + 2, b1);
      pv_d0(o, vb0 + b2 * SHM_V, pa0, pa1, pa2, pa3); partialSM(pA0, pA1, m_reg, mnA, alA, C, thr);
      RESC(alA); bq = b1;
      WAITV(NI); WBAR(); }
  }
  { const int b1 = NXT3(bq), b2 = NXT3(b1);
    ISSUE_K(NT - 1, b2);
    SBAR(); qkt<DQK>(pB0, pB1, K_lds + bq * SHM_K, qr, r32, hi);
    finishSM(pA0, pA1, alA, l_reg, pa0, pa1, pa2, pa3); SBAR();
    WAITV(NI); WBAR();
    ISSUE_V(NT - 2, b1);
    pv_d0(o, vb0 + b2 * SHM_V, pa0, pa1, pa2, pa3); partialSM(pB0, pB1, m_reg, mnB, alB, C, thr);
    RESC(alB); bq = b1;
    WAITV(NI); WBAR(); }
  { const int b1 = NXT3(bq), b2 = NXT3(b1);
    SBAR(); qkt<DQK>(pA0, pA1, K_lds + bq * SHM_K, qr, r32, hi);
    finishSM(pB0, pB1, alB, l_reg, pa0, pa1, pa2, pa3); SBAR();
    WAITV(NV); WBAR();
    ISSUE_V(NT - 1, b1);
    pv_d0(o, vb0 + b2 * SHM_V, pa0, pa1, pa2, pa3); partialSM(pA0, pA1, m_reg, mnA, alA, C, thr);
    RESC(alA); bq = b1;
    WAITV(NV); WBAR(); }
  { const int b2 = NXT3(NXT3(bq));
    SBAR(); qkt<DQK>(pB0, pB1, K_lds + bq * SHM_K, qr, r32, hi);
    finishSM(pA0, pA1, alA, l_reg, pa0, pa1, pa2, pa3); SBAR();
    WAITV(0); WBAR();
    pv_d0(o, vb0 + b2 * SHM_V, pa0, pa1, pa2, pa3); partialSM(pB0, pB1, m_reg, mnB, alB, C, thr);
    RESC(alB);
    WBAR(); }
  finishSM(pB0, pB1, alB, l_reg, pa0, pa1, pa2, pa3); SBAR();
  pv_d0(o, vb0 + bq * SHM_V, pa0, pa1, pa2, pa3);
  if (lead) { WBAR(); }
  if (hi == 0) li_l[r32] = l_reg; asm volatile("s_waitcnt lgkmcnt(0)" ::: "memory");
#pragma unroll
  for (int r = 0; r < 16; ++r) { const float rl = __builtin_amdgcn_rcpf(li_l[crow(r, hi)]);
#pragma unroll
    for (int d = 0; d < 4; ++d) o[d][r] *= rl; }
  asm volatile("s_waitcnt lgkmcnt(0)" ::: "memory"); WBAR();
#undef GLDS
#undef ISSUE_K
#undef ISSUE_V
#undef WAITV
#undef WBAR
#undef RESC
#undef NXT3
}
template <int DQK>
__device__ __forceinline__ void attn_core_seq(const Src in, const float C, const float thr, const int seq, LAS char* lds, f32x16 (&o)[4]) {
  constexpr int NSUB = DQK / 64, SHM_K = NSUB * 8192;
  const int tid = threadIdx.x, wid = __builtin_amdgcn_readfirstlane(tid >> 6), lane = tid & 63, r32 = lane & 31, hi = lane >> 5;
  LAS char* V_lds = lds; LAS char* K_lds = lds + 3 * SHM_V;
  LAS float* ws = (LAS float*)(lds + 3 * SHM_V + 3 * SHM_K) + wid * 64; LAS float* li_l = ws; LAS float* al_l = ws + 32;
  float m_reg = -1e30f, l_reg = 0;
#pragma unroll
  for (int d = 0; d < 4; ++d) o[d] = f32x16{};
  bf16x8 qr[DQK / 16];
  const bf16_t* Qw = in.Q + (size_t)(wid * QBLK + r32) * in.ldq + hi * 8;
#pragma unroll
  for (int d0 = 0; d0 < DQK / 16; ++d0) qr[d0] = *(const bf16x8*)(Qw + d0 * 16);
  const int krow = wid * 8 + (lane >> 3), kslot = (lane & 7) ^ ((krow >> 1) & 7);
  const unsigned koff = (unsigned)(krow * in.ldk + kslot * 8) * 2u, k2off = (unsigned)(krow * in.ldk2 + kslot * 8) * 2u;
  unsigned voff[2];
#pragma unroll
  for (int i = 0; i < 2; ++i) { const int p = i * 8192 + wid * 1024 + lane * 16, st = p >> 9, wq = (p & 511) >> 1, kk = (st >> 2) * 8 + (wq >> 5), cl = wq & 31;
    const int k = (kk & ~0xC) | ((kk & 4) << 1) | ((kk & 8) >> 1); voff[i] = (unsigned)(k * in.ldv + (st & 3) * 32 + cl) * 2u; }
  const int vb0 = (int)(unsigned)(size_t)V_lds + v_rd_base(lane);
  const unsigned ldsw = (unsigned)wid * 1024u;
#define GLDS(gp, lp) __builtin_amdgcn_global_load_lds((const unsigned*)(gp), (LAS unsigned*)(lp), 16, 0, 0)
#define ISSUE_K(t, b) do { const char* kb_ = (const char*)in.K + (size_t)(t) * (KVBLK * 2) * in.ldk; \
    _Pragma("unroll") for (int s_ = 0; s_ < NSUB; ++s_) { if (s_ < 2) GLDS(kb_ + s_ * 128 + koff, K_lds + (b) * SHM_K + s_ * 8192 + ldsw); \
      else GLDS((const char*)in.K2 + (size_t)(t) * (KVBLK * 2) * in.ldk2 + k2off, K_lds + (b) * SHM_K + s_ * 8192 + ldsw); } } while (0)
#define ISSUE_V(t, b) do { const char* vb_ = (const char*)in.V + (size_t)(t) * (KVBLK * 2) * in.ldv; \
    GLDS(vb_ + voff[0], V_lds + (b) * SHM_V + ldsw); GLDS(vb_ + voff[1], V_lds + (b) * SHM_V + 8192 + ldsw); } while (0)
#define WAITV(n) asm volatile("s_waitcnt vmcnt(%0)" :: "n"(n) : "memory")
#define WBAR() do { asm volatile("" ::: "memory"); __builtin_amdgcn_s_barrier(); asm volatile("" ::: "memory"); } while (0)
#define RESC(a) do { if (__any((a) < 1.f)) { if (hi == 0) al_l[r32] = (a); asm volatile("s_waitcnt lgkmcnt(0)" ::: "memory"); \
    _Pragma("unroll") for (int d = 0; d < 4; ++d) _Pragma("unroll") for (int r = 0; r < 16; ++r) o[d][r] *= al_l[crow(r, hi)]; } } while (0)
#define NXT3(x) ((x) == 2 ? 0 : (x) + 1)
  constexpr int NI = NSUB + 2;
  f32x16 p0, p1; float mn, al; bf16x8 pa0, pa1, pa2, pa3; const int NT = seq / KVBLK;
  ISSUE_K(0, 0); ISSUE_V(0, 0); ISSUE_K(1, 1); ISSUE_V(1, 1);
  int bq = 0;
  for (int j = 0; j + 1 < NT; ++j) {
    const int b1 = NXT3(bq), b2 = NXT3(b1);
    WAITV(NI); WBAR();
    if (j + 2 < NT) { ISSUE_K(j + 2, b2); ISSUE_V(j + 2, b2); }
    else { ISSUE_K(NT - 1, b2); ISSUE_V(NT - 1, b2); }
    qkt<DQK>(p0, p1, K_lds + bq * SHM_K, qr, r32, hi); partialSM(p0, p1, m_reg, mn, al, C, thr);
    RESC(al);
    finishSM(p0, p1, al, l_reg, pa0, pa1, pa2, pa3); SBAR();
    pv_d0(o, vb0 + bq * SHM_V, pa0, pa1, pa2, pa3);
    bq = b1;
  }
  WAITV(NI); WBAR();
  qkt<DQK>(p0, p1, K_lds + bq * SHM_K, qr, r32, hi); partialSM(p0, p1, m_reg, mn, al, C, thr);
  RESC(al);
  finishSM(p0, p1, al, l_reg, pa0, pa1, pa2, pa3); SBAR();
  pv_d0(o, vb0 + bq * SHM_V, pa0, pa1, pa2, pa3);
  WAITV(0);
  if (hi == 0) li_l[r32] = l_reg; asm volatile("s_waitcnt lgkmcnt(0)" ::: "memory");
#pragma unroll
  for (int r = 0; r < 16; ++r) { const float rl = __builtin_amdgcn_rcpf(li_l[crow(r, hi)]);
#pragma unroll
    for (int d = 0; d < 4; ++d) o[d][r] *= rl; }
  asm volatile("s_waitcnt lgkmcnt(0)" ::: "memory"); WBAR();
#undef GLDS
#undef ISSUE_K
#undef ISSUE_V
#undef WAITV
#undef WBAR
#undef RESC
#undef NXT3
}
__device__ __forceinline__ void attn_core_da2(const Src in, const float C, const float thr, const int seq, LAS char* lds, f32x16 (&o1)[4], f32x16 (&o2)[4]) {
  constexpr int NSUB = 2, SHM_K = NSUB * 8192;
  const int tid = threadIdx.x, wid = __builtin_amdgcn_readfirstlane(tid >> 6), lane = tid & 63, r32 = lane & 31, hi = lane >> 5;
  LAS char* V_lds = lds; LAS char* K_lds = lds + 3 * SHM_V;
  LAS float* ws = (LAS float*)(lds + 3 * SHM_V + 3 * SHM_K) + wid * 64; LAS float* li_l = ws; LAS float* al_l = ws + 32;
  float m1 = -1e30f, l1 = 0, m2 = -1e30f, l2 = 0;
#pragma unroll
  for (int d = 0; d < 4; ++d) { o1[d] = f32x16{}; o2[d] = f32x16{}; }
  bf16x8 q1[4], q2[4];
  const bf16_t* Qw = in.Q + (size_t)(wid * QBLK + r32) * in.ldq + hi * 8;
#pragma unroll
  for (int d0 = 0; d0 < 4; ++d0) { q1[d0] = *(const bf16x8*)(Qw + d0 * 16); q2[d0] = *(const bf16x8*)(Qw + 64 + d0 * 16); }
  const int krow = wid * 8 + (lane >> 3), kslot = (lane & 7) ^ ((krow >> 1) & 7);
  const unsigned koff = (unsigned)(krow * in.ldk + kslot * 8) * 2u;
  unsigned voff[2];
#pragma unroll
  for (int i = 0; i < 2; ++i) { const int p = i * 8192 + wid * 1024 + lane * 16, st = p >> 9, wq = (p & 511) >> 1, kk = (st >> 2) * 8 + (wq >> 5), cl = wq & 31;
    const int k = (kk & ~0xC) | ((kk & 4) << 1) | ((kk & 8) >> 1); voff[i] = (unsigned)(k * in.ldv + (st & 3) * 32 + cl) * 2u; }
  const int vb0 = (int)(unsigned)(size_t)V_lds + v_rd_base(lane);
  const unsigned ldsw = (unsigned)wid * 1024u;
#define GLDS(gp, lp) __builtin_amdgcn_global_load_lds((const unsigned*)(gp), (LAS unsigned*)(lp), 16, 0, 0)
#define ISSUE_KV(t, b) do { const char* kb_ = (const char*)in.K + (size_t)(t) * (KVBLK * 2) * in.ldk; const char* vb_ = (const char*)in.V + (size_t)(t) * (KVBLK * 2) * in.ldv; \
    GLDS(kb_ + koff, K_lds + (b) * SHM_K + ldsw); GLDS(kb_ + 128 + koff, K_lds + (b) * SHM_K + 8192 + ldsw); \
    GLDS(vb_ + voff[0], V_lds + (b) * SHM_V + ldsw); GLDS(vb_ + voff[1], V_lds + (b) * SHM_V + 8192 + ldsw); } while (0)
#define WAITV(n) asm volatile("s_waitcnt vmcnt(%0)" :: "n"(n) : "memory")
#define WBAR() do { asm volatile("" ::: "memory"); __builtin_amdgcn_s_barrier(); asm volatile("" ::: "memory"); } while (0)
#define RESC(oo, a) do { if (__any((a) < 1.f)) { if (hi == 0) al_l[r32] = (a); asm volatile("s_waitcnt lgkmcnt(0)" ::: "memory"); \
    _Pragma("unroll") for (int d = 0; d < 4; ++d) _Pragma("unroll") for (int r = 0; r < 16; ++r) oo[d][r] *= al_l[crow(r, hi)]; asm volatile("s_waitcnt lgkmcnt(0)" ::: "memory"); } } while (0)
#define NXT3(x) ((x) == 2 ? 0 : (x) + 1)
#define TILE_BODY(b) do { f32x16 p0, p1; float mn, al; bf16x8 pa0, pa1, pa2, pa3; \
    qkt<64>(p0, p1, K_lds + (b) * SHM_K, q1, r32, hi); partialSM(p0, p1, m1, mn, al, C, thr); RESC(o1, al); \
    finishSM(p0, p1, al, l1, pa0, pa1, pa2, pa3); SBAR(); pv_d0(o1, vb0 + (b) * SHM_V, pa0, pa1, pa2, pa3); SBAR(); \
    qkt<64>(p0, p1, K_lds + (b) * SHM_K + 8192, q2, r32, hi); partialSM(p0, p1, m2, mn, al, C, thr); RESC(o2, al); \
    finishSM(p0, p1, al, l2, pa0, pa1, pa2, pa3); SBAR(); pv_d0(o2, vb0 + (b) * SHM_V, pa0, pa1, pa2, pa3); SBAR(); } while (0)
  const int NT = seq / KVBLK;
  ISSUE_KV(0, 0); ISSUE_KV(1, 1);
  int bq = 0;
  for (int j = 0; j + 1 < NT; ++j) {
    const int b1 = NXT3(bq), b2 = NXT3(b1);
    WAITV(4); WBAR();
    if (j + 2 < NT) ISSUE_KV(j + 2, b2); else ISSUE_KV(NT - 1, b2);
    TILE_BODY(bq);
    bq = b1;
  }
  WAITV(4); WBAR();
  TILE_BODY(bq);
  WAITV(0);
  if (hi == 0) { li_l[r32] = l1; al_l[r32] = l2; } asm volatile("s_waitcnt lgkmcnt(0)" ::: "memory");
#pragma unroll
  for (int r = 0; r < 16; ++r) { const float ra = __builtin_amdgcn_rcpf(li_l[crow(r, hi)]), rb = __builtin_amdgcn_rcpf(al_l[crow(r, hi)]);
#pragma unroll
    for (int d = 0; d < 4; ++d) { o1[d][r] *= ra; o2[d][r] *= rb; } }
  asm volatile("s_waitcnt lgkmcnt(0)" ::: "memory"); WBAR();
#undef GLDS
#undef ISSUE_KV
#undef WAITV
#undef WBAR
#undef RESC
#undef NXT3
#undef TILE_BODY
}
}

constexpr int NWAVES = 8;
struct Args { const void* in[27]; float* out; unsigned char* ws; int ph_lo, ph_hi, li, pad; };

__constant__ float c_invA[8] = {1.0f, 0.19392274474868576f, 0.03760603093086393f, 0.007292664737217109f, 0.001414213562373095f, 0.0002742481756762073f, 5.318295896944988e-05f, 1.031338537721246e-05f};
__constant__ float c_invM[32] = {1.0f, 0.6636012376960885f, 0.44036660267178046f, 0.2922278225730151f, 0.19392274474868576f, 0.12868737343265052f, 0.08539710028576561f, 0.05666962144529105f,
    0.03760603093086393f, 0.024955408670558694f, 0.016560440080994446f, 0.010989528534539826f, 0.007292664737217109f, 0.004839421345719893f, 0.003211445994752591f, 0.0021311195369119653f,
    0.001414213562373095f, 0.0009384738703573802f, 0.000622772421914596f, 0.0004132725499855165f, 0.0002742481756762073f, 0.00018199142881462546f, 0.00012076973741146504f, 8.01429472224798e-05f,
    5.318295896944988e-05f, 3.529227739646723e-05f, 2.341999896140934e-05f, 1.5541540297632344e-05f, 1.031338537721246e-05f, 6.8439753011549275e-06f, 4.5416704806078695e-06f, 3.013858152139171e-06f};

__device__ __forceinline__ int permDA(int i) { return i < 16 ? (i >> 1) + 8 * (i & 1) : i; }
__device__ __forceinline__ int permM(int i) { return (i >> 1) + 32 * (i & 1); }
__device__ __forceinline__ int src_in(int j) {
    if (j < 2048) return (j & ~63) + permDA(j & 63);
    if (j < 4352) return j;
    if (j < 6400) return 4416 + (j - 4352);
    if (j < 6464) return 4352 + permM(j - 6400);
    return -1;
}
__device__ __forceinline__ int src_uq(int j) { const int hd = j / 192, off = j % 192; return off < 128 ? j : hd * 192 + 128 + permM(off - 128); }

__device__ __forceinline__ void tr_item(const float* W, int K, int N, bf16_t* WT, int n0, int k0, int scol, const float* rs, LAS float* scr, int lane) {
#pragma unroll 8
    for (int i = 0; i < 32; ++i) { const int kk = 2 * i + (lane >> 5); float v = 0.f; if (scol >= 0) { v = W[(size_t)(k0 + kk) * N + scol]; if (rs) v *= rs[k0 + kk]; } scr[kk * 33 + (lane & 31)] = v; }
    LDS_WAIT(); asm volatile("" ::: "memory");
    const int c = lane & 7;
#pragma unroll
    for (int j = 0; j < 4; ++j) { const int n = (lane >> 3) + 8 * j; const LAS float* s = scr + (8 * c) * 33 + n;
        u32x4 o; o.x = cvt_pk_bf16(s[0 * 33], s[1 * 33]); o.y = cvt_pk_bf16(s[2 * 33], s[3 * 33]); o.z = cvt_pk_bf16(s[4 * 33], s[5 * 33]); o.w = cvt_pk_bf16(s[6 * 33], s[7 * 33]);
        *(u32x4*)(WT + (size_t)(n0 + n) * K + k0 + 8 * c) = o; }
    LDS_WAIT(); asm volatile("" ::: "memory");
}

template <int MODE = 0>
__device__ __forceinline__ void cvt_tile64(const float* W, int N, bf16_t* WT, int Kd, int k0, int n0, int drow0, int lane, const float* rs = nullptr) {
    const int g = lane >> 4, x = lane & 15;
    const float* src = W + (size_t)(k0 + 16 * g) * N + n0 + 4 * x;
    f32x4 v[16];
#pragma unroll
    for (int i = 0; i < 16; ++i) v[i] = __builtin_nontemporal_load((const f32x4*)(src + (size_t)i * N));
    if (rs) {
#pragma unroll
        for (int i = 0; i < 16; ++i) v[i] = v[i] * rs[k0 + 16 * g + i];
    }
#pragma unroll
    for (int j = 0; j < 4; ++j) { u32x4 lo, hi;
        lo.x = cvt_pk_bf16(v[0][j], v[1][j]); lo.y = cvt_pk_bf16(v[2][j], v[3][j]); lo.z = cvt_pk_bf16(v[4][j], v[5][j]); lo.w = cvt_pk_bf16(v[6][j], v[7][j]);
        hi.x = cvt_pk_bf16(v[8][j], v[9][j]); hi.y = cvt_pk_bf16(v[10][j], v[11][j]); hi.z = cvt_pk_bf16(v[12][j], v[13][j]); hi.w = cvt_pk_bf16(v[14][j], v[15][j]);
        const int c = 4 * x + j;
        const int dr = MODE == 1 ? 2 * (c & 31) + (c >> 5) : (MODE == 2 ? (c < 16 ? 2 * (c & 7) + (c >> 3) : c) : c);
        bf16_t* d = WT + (size_t)(drow0 + dr) * Kd + k0 + 16 * g;
        *(u32x4*)d = lo; *(u32x4*)(d + 8) = hi; }
}

__global__ void __launch_bounds__(NWAVES * 64, 2) fwd(Args args) {
#define KARGS() const __attribute__((address_space(4))) unsigned long long* ka_ = (const __attribute__((address_space(4))) unsigned long long*)__builtin_amdgcn_kernarg_segment_ptr(); asm volatile("" : "+s"(ka_))
#define AIN(i) ((const void*)ka_[i])
#define AOUT ((float*)ka_[27])
#define AWS ((unsigned char*)ka_[28])
    extern __shared__ __attribute__((aligned(16))) unsigned char lds_raw[];
    LAS unsigned char* lds = (LAS unsigned char*)lds_raw;
    volatile LAS unsigned* MISC = (volatile LAS unsigned*)(lds + MISC_OFF);
    const int tid = threadIdx.x, wave = __builtin_amdgcn_readfirstlane(tid >> 6);
#define LANE_DECL int lane; asm volatile("v_and_b32 %0, 63, %1" : "=v"(lane) : "v"(threadIdx.x))
    const int G = gridDim.x, bx = blockIdx.x;
    unsigned* ctl = (unsigned*)(args.ws + WS_CTL);
    const int lo = args.ph_lo, hi_ph = args.ph_hi;
    if (tid < 32) MISC[tid] = 0u;
    __syncthreads();
    XcdBarrier bar; bar.bar = ctl + CW_BAR + args.li * XCD_BAR_WORDS; bar.x = 0; bar.st = nullptr;
    if (!MK_PER_PHASE) bar = xcd_barrier_post(ctl + CW_BAR + args.li * XCD_BAR_WORDS, MISC + 8);
#define IN(k) (((PH_MASK >> (k)) & 1) && lo <= (k) && (k) < hi_ph)
#define SEAM(k) do { if (IN(k) && IN((k) + 1)) xcd_barrier(bar); } while (0)
    const int gw = bx * NWAVES + wave, NGW = G * NWAVES;

#define xin ((const float*)AIN(0))
#define positions ((const int*)AIN(1))
#define Bt_in ((bf16_t*)(AWS + WS_BT_IN))
#define Bt_uq ((bf16_t*)(AWS + WS_BT_UQ))
#define Bt_ukv ((bf16_t*)(AWS + WS_BT_UKV))
#define Bt_od ((bf16_t*)(AWS + WS_BT_OD))
#define Bt_om ((bf16_t*)(AWS + WS_BT_OM))
#define Bt_out ((bf16_t*)(AWS + WS_BT_OUT))
#define ropeA ((float*)(AWS + WS_ROPEA))
#define ropeM ((float*)(AWS + WS_ROPEM))
#define sq ((float*)(AWS + WS_SQ2))
#define hbuf ((bf16_t*)(AWS + WS_H))
#define oa ((bf16_t*)(AWS + WS_H))
#define qa ((bf16_t*)(AWS + WS_QA))
#define ka ((bf16_t*)(AWS + WS_KA))
#define va ((bf16_t*)(AWS + WS_VA))
#define cq ((bf16_t*)(AWS + WS_CQ))
#define ckv ((bf16_t*)(AWS + WS_CKV))
#define kr ((bf16_t*)(AWS + WS_KR))
#define gates ((bf16_t*)(AWS + WS_GATES))
#define qm ((bf16_t*)(AWS + WS_QM))
#define kv ((bf16_t*)(AWS + WS_KV))
#define ob ((bf16_t*)(AWS + WS_OB))
#define mrg ((bf16_t*)(AWS + WS_MRG))
#define stash ((float*)(AWS + WS_STASH))
#define rowtok_p ((int*)(AWS + WS_ROWTOK))
#define assign ((u32x2*)(AWS + WS_ASSIGN))
#define Bt_d ((bf16_t*)(AWS + WS_BT_D))
#define Bt_gu ((bf16_t*)(AWS + WS_BT_GU))
#define h2 ((bf16_t*)(AWS + WS_H2))
#define act ((bf16_t*)(AWS + WS_ACT))
#define ybuf ((bf16_t*)(AWS + WS_Y))
#define count ((unsigned*)(AWS + WS_CTL) + CW_COUNT)

    if (IN(0)) {
        KARGS();
        LANE_DECL;
        const float* w_in = (const float*)AIN(3); const float* g_q = (const float*)AIN(9); const float* g_kv = (const float*)AIN(10);
        const float* w_uq = (const float*)AIN(11); const float* w_ukv = (const float*)AIN(12);
        const float* w_od = (const float*)AIN(13); const float* w_om = (const float*)AIN(14); const float* w_out = (const float*)AIN(16);
        constexpr int I_IN = 16 * 101, I_PAD = 16 * 3, I_UQ = 12 * 24, I_UKV = 8 * 32, I_O = 16 * 16;
        constexpr int NITEMS = I_IN + I_PAD + I_UQ + I_UKV + 3 * I_O;
        for (int it = gw; it < NITEMS; it += NGW) {
            int r = it;
            if (r < I_IN) { const int kb = r / 101, cb = r % 101, n0 = cb * 64;
                if (n0 < 2048) cvt_tile64<2>(w_in, 6464, Bt_in, D, kb * 64, n0, n0, lane);
                else if (n0 < 4352) cvt_tile64<0>(w_in, 6464, Bt_in, D, kb * 64, n0, n0, lane);
                else if (n0 < 4416) cvt_tile64<1>(w_in, 6464, Bt_in, D, kb * 64, n0, 6400, lane);
                else cvt_tile64<0>(w_in, 6464, Bt_in, D, kb * 64, n0, n0 - 64, lane);
                continue; } r -= I_IN;
            if (r < I_PAD) { const int kb = r / 3, rb = r % 3; const int g = lane >> 4, x4 = lane & 15;
#pragma unroll
                for (int j = 0; j < 4; ++j) { bf16_t* d = Bt_in + (size_t)(6464 + rb * 64 + 4 * x4 + j) * D + kb * 64 + 16 * g; *(u32x4*)d = (u32x4){0u, 0u, 0u, 0u}; *(u32x4*)(d + 8) = (u32x4){0u, 0u, 0u, 0u}; }
                continue; } r -= I_PAD;
            if (r < I_UQ) { const int kb = r / 24, cb = r % 24, n0 = cb * 64;
                if ((cb % 3) == 2) cvt_tile64<1>(w_uq, 1536, Bt_uq, QL, kb * 64, n0, n0, lane, g_q); else cvt_tile64<0>(w_uq, 1536, Bt_uq, QL, kb * 64, n0, n0, lane, g_q);
                continue; } r -= I_UQ;
            if (r < I_UKV) { const int kb = r / 32, cb = r % 32; cvt_tile64<0>(w_ukv, 2048, Bt_ukv, KVL, kb * 64, cb * 64, cb * 64, lane, g_kv); continue; } r -= I_UKV;
            const int which = r / I_O; r -= which * I_O; const int kb = r / 16, cb = r % 16;
            cvt_tile64<0>(which == 0 ? w_od : (which == 1 ? w_om : w_out), D, which == 0 ? Bt_od : (which == 1 ? Bt_om : Bt_out), D, kb * 64, cb * 64, cb * 64, lane);
        }
        const float* g_mix = (const float*)AIN(2);
        for (int m = gw * 4; m < T; m += NGW * 4) {
            f32x4 v[4][4]; float ss[4];
#pragma unroll
            for (int q = 0; q < 4; ++q) { const f32x4* xr = (const f32x4*)(xin + (size_t)(m + q) * D) + lane;
#pragma unroll
                for (int j = 0; j < 4; ++j) v[q][j] = xr[64 * j]; }
#pragma unroll
            for (int q = 0; q < 4; ++q) { float s = 0.f;
#pragma unroll
                for (int j = 0; j < 4; ++j) s += (v[q][j][0] * v[q][j][0] + v[q][j][1] * v[q][j][1]) + (v[q][j][2] * v[q][j][2] + v[q][j][3] * v[q][j][3]);
                ss[q] = __builtin_amdgcn_rsqf(wave_sum(s) * (1.f / D) + EPS); }
#pragma unroll
            for (int j = 0; j < 4; ++j) { const f32x4 gg = *((const f32x4*)g_mix + lane + 64 * j);
#pragma unroll
                for (int q = 0; q < 4; ++q) { u32x2 w; w.x = cvt_pk_bf16(v[q][j][0] * ss[q] * gg[0], v[q][j][1] * ss[q] * gg[1]); w.y = cvt_pk_bf16(v[q][j][2] * ss[q] * gg[2], v[q][j][3] * ss[q] * gg[3]);
                    ((u32x2*)(hbuf + (size_t)(m + q) * D) + lane)[64 * j] = w; } }
        }
        for (int idx = bx * 512 + tid; idx < T * 40; idx += G * 512) {
            const int t = idx / 40, i = idx % 40; const float inv = i < 8 ? c_invA[i] : c_invM[i - 8];
            const float ang = (float)positions[t] * inv;
            const double rev = (double)ang * 0.15915494309189535; const float fr_ = (float)(rev - __builtin_rint(rev));
            const float cs = __builtin_amdgcn_cosf(fr_), sn = __builtin_amdgcn_sinf(fr_);
            float* dst = i < 8 ? ropeA + ((size_t)t * 8 + i) * 2 : ropeM + ((size_t)t * 32 + (i - 8)) * 2; dst[0] = cs; dst[1] = sn;
        }
    }
    SEAM(0);
    if (IN(1)) {
        KARGS();
        pg8::Gemm g{hbuf, Bt_in, D}; pg8::DenseOrder S; S.init(T / 256, N_IN / 256, G, bx);
        pg8::EpiIn E{qa, ka, va, cq, ckv, gates, kr, ropeA, ropeM, (const float*)AIN(15), sq};
        pg8::gemm_phase<pg8::EpiIn, pg8::DenseOrder, false, true>(lds, g, S, E);
    }
    SEAM(1);
    if (IN(2)) {
        KARGS();
        { pg8::Gemm g{cq, Bt_uq, QL}; pg8::DenseOrder S; S.init(T / 256, 1536 / 256, G, bx); pg8::EpiUp<true> E{qm, sq, ropeM};
          pg8::gemm_phase<pg8::EpiUp<true>, pg8::DenseOrder, false, true>(lds, g, S, E); }
        { pg8::Gemm g{ckv, Bt_ukv, KVL}; pg8::DenseOrder S; S.init(T / 256, 2048 / 256, G, G - 1 - bx); pg8::EpiUp<false> E{kv, sq, ropeM};
          pg8::gemm_phase<pg8::EpiUp<false>, pg8::DenseOrder, false, true>(lds, g, S, E); }
    }
    SEAM(2);
    if (IN(3)) {
        KARGS();
        const int lane = threadIdx.x & 63;
        const int wid = wave;
#define UNIT_DECODE(L) int u = (L) & 511; if (G == 256) { const int c = (L) & 255; u = ((L) & 256) + (c & 7) * 32 + (c >> 3); } \
            const int bh = u >> 4, qb = u & 15, b = bh >> 3, h = bh & 7; const size_t q0 = (size_t)b * SEQ + qb * 256, k0 = (size_t)b * SEQ
        for (int L = bx; L < 512; L += G) {
#if PROBE_PHASE == 3 && defined(PROBE_ATT)
            if (args.li == 1 && lo == 3 && PROBE_ATT != 0) continue;
#endif
            UNIT_DECODE(L);
            f32x16 o[4], o2[4];
            { att::Src in{qa + q0 * 1024 + h * 128, ka + k0 * 1024 + h * 128, nullptr, va + k0 * 1024 + h * 128, 1024, 1024, 0, 1024};
              att::attn_core_da2(in, 0.125f * 1.4426950408889634f, 8.f / 0.125f, SEQ, (LAS char*)lds, o, o2); }
            float lam;
            { const float* lq1 = (const float*)AIN(4); const float* lk1 = (const float*)AIN(5); const float* lq2 = (const float*)AIN(6); const float* lk2 = (const float*)AIN(7);
              const float s1 = wave_sum(lq1[lane] * lk1[lane]), s2 = wave_sum(lq2[lane] * lk2[lane]); lam = __expf(s1) - __expf(s2) + LAM_INIT; }
            float ss[16];
#pragma unroll
            for (int r = 0; r < 16; ++r) ss[r] = 0.f;
#pragma unroll
            for (int d = 0; d < 4; ++d)
#pragma unroll
                for (int r = 0; r < 16; ++r) { const float v = o[d][r] - lam * o2[d][r]; o[d][r] = v; ss[r] += v * v; }
#pragma unroll
            for (int r = 0; r < 16; ++r) {
#pragma unroll
                for (int msk = 1; msk < 32; msk <<= 1) ss[r] += __shfl_xor(ss[r], msk);
                ss[r] = __builtin_amdgcn_rsqf(ss[r] * (1.0f / 128.0f) + EPS); }
            int ln2; asm volatile("v_and_b32 %0, 63, %1" : "=v"(ln2) : "v"(threadIdx.x));
            const int hi2 = ln2 >> 5, r32e = ln2 & 31;
            bf16_t* Ow = oa + (q0 + wid * 32 + 4 * hi2) * 1024 + h * 128 + r32e;
            float gs[4];
#pragma unroll
            for (int d = 0; d < 4; ++d) gs[d] = ((const float*)AIN(8))[d * 32 + r32e] * (1.0f - LAM_INIT);
#pragma unroll
            for (int r = 0; r < 16; ++r) { const int orow = att::crow(r, 0);
#pragma unroll
                for (int d = 0; d < 4; ++d) Ow[orow * 1024 + d * 32] = (bf16_t)(cvt_pk_bf16(o[d][r] * ss[r] * gs[d], 0.f) & 0xffffu); }
        }
        for (int L = 512 + bx; L < 1024; L += G) {
#if PROBE_PHASE == 3 && defined(PROBE_ATT)
            if (args.li == 1 && lo == 3 && PROBE_ATT != 1) continue;
#endif
            UNIT_DECODE(L);
            f32x16 o[4];
            { att::Src in{qm + q0 * 1536 + h * 192, kv + k0 * 2048 + h * 256, kr + k0 * 64, kv + k0 * 2048 + h * 256 + 128, 1536, 2048, 64, 2048};
              att::attn_core<192>(in, 0.07216878364870322f * 1.4426950408889634f, 8.f / 0.07216878364870322f, SEQ, (LAS char*)lds, o); }
            int ln2; asm volatile("v_and_b32 %0, 63, %1" : "=v"(ln2) : "v"(threadIdx.x));
            const int hi2 = ln2 >> 5, r32e = ln2 & 31;
            bf16_t* Ow = ob + (q0 + wid * 32 + 4 * hi2) * 1024 + h * 128 + r32e;
#pragma unroll
            for (int r = 0; r < 16; ++r) { const int orow = att::crow(r, 0);
#pragma unroll
                for (int d = 0; d < 4; ++d) Ow[orow * 1024 + d * 32] = (bf16_t)(cvt_pk_bf16(o[d][r], 0.f) & 0xffffu); }
        }
#undef UNIT_DECODE
    }
    SEAM(3);
    if (IN(4)) {
        KARGS();
        { pg8::Gemm g{oa, Bt_od, D}; pg8::DenseOrder S; S.init(T / 256, 4, G, bx); pg8::EpiGate<0> E{mrg, gates};
          pg8::gemm_phase<pg8::EpiGate<0>, pg8::DenseOrder, false, true>(lds, g, S, E); }
        VM_WAIT(); __syncthreads();
        { pg8::Gemm g{ob, Bt_om, D}; pg8::DenseOrder S; S.init(T / 256, 4, G, bx); pg8::EpiGate<1> E{mrg, gates};
          pg8::gemm_phase<pg8::EpiGate<1>, pg8::DenseOrder, false, true>(lds, g, S, E); }
    }
    SEAM(4);
    if (IN(5)) {
        KARGS();
        pg8::Gemm g{mrg, Bt_out, D}; pg8::DenseOrder S; S.init(T / 256, 4, G, bx); pg8::EpiRes E{xin, AOUT};
        pg8::gemm_phase<pg8::EpiRes, pg8::DenseOrder, false, true>(lds, g, S, E);
    }
    SEAM(5);
    if (IN(6)) {
        KARGS();
        LANE_DECL;
        const float* g_ffn = (const float*)AIN(17); const float* w_router = (const float*)AIN(18); const float* b_router = (const float*)AIN(19);
        constexpr int WRS = 1028;
        LAS float* wr_l = (LAS float*)lds;
        LAS int* lcount = (LAS int*)(lds + TAB_OFF + 1024); LAS int* gbase = lcount + 32; LAS unsigned* asg_e = (LAS unsigned*)(lcount + 64); LAS float* asg_w = (LAS float*)(lcount + 64 + 256);
        LAS int* sync_w = (LAS int*)(lds + TAB_OFF + 512);
        for (int i = tid; i < D * NEXP; i += 512) wr_l[(i & 31) * WRS + (i >> 5)] = w_router[i];
        if (tid < 32) lcount[tid] = 0;
        if (tid < 2) sync_w[tid] = 0;
        __syncthreads();
        const int ex = (lane >> 1) & 31;
        LAS float* lg = (LAS float*)(lds + TAB_OFF + 4096) + wave * 80;
        const int chunk = bx;
        if (wave < 4 && chunk < T / 64) {
            const float my_b = b_router[ex];
#pragma unroll 1
            for (int j2 = 0; j2 < 8; ++j2) {
                const int tl = wave * 16 + j2 * 2, t = chunk * 64 + tl;
                f32x4 xva[4], xvb[4]; float sa = 0.f, sb = 0.f;
                { const f32x4* xa = (const f32x4*)(AOUT + (size_t)t * D) + lane; const f32x4* xb = xa + D / 4;
#pragma unroll
                  for (int j = 0; j < 4; ++j) { xva[j] = xa[64 * j]; xvb[j] = xb[64 * j]; }
#pragma unroll
                  for (int j = 0; j < 4; ++j) { sa += (xva[j][0] * xva[j][0] + xva[j][1] * xva[j][1]) + (xva[j][2] * xva[j][2] + xva[j][3] * xva[j][3]); sb += (xvb[j][0] * xvb[j][0] + xvb[j][1] * xvb[j][1]) + (xvb[j][2] * xvb[j][2] + xvb[j][3] * xvb[j][3]); } }
                const float ra = __builtin_amdgcn_rsqf(wave_sum(sa) * (1.f / D) + EPS), rb = __builtin_amdgcn_rsqf(wave_sum(sb) * (1.f / D) + EPS);
                { u32x2* oa8 = (u32x2*)(h2 + (size_t)t * D) + lane; u32x2* ob8 = oa8 + D / 4;
#pragma unroll
                  for (int j = 0; j < 4; ++j) { const f32x4 gg = *((const f32x4*)g_ffn + lane + 64 * j); xva[j] = xva[j] * ra * gg; xvb[j] = xvb[j] * rb * gg;
                    u32x2 w; w.x = cvt_pk_bf16(xva[j][0], xva[j][1]); w.y = cvt_pk_bf16(xva[j][2], xva[j][3]); oa8[64 * j] = w;
                    w.x = cvt_pk_bf16(xvb[j][0], xvb[j][1]); w.y = cvt_pk_bf16(xvb[j][2], xvb[j][3]); ob8[64 * j] = w; } }
                float aa[32], ab[32];
#pragma unroll
                for (int e = 0; e < NEXP; ++e) { float a = 0.f, b = 0.f;
#pragma unroll
                    for (int j = 0; j < 4; ++j) { const f32x4 w4 = *(const LAS f32x4*)(wr_l + e * WRS + 4 * lane + 256 * j);
                        a += (xva[j][0] * w4[0] + xva[j][1] * w4[1]) + (xva[j][2] * w4[2] + xva[j][3] * w4[3]); b += (xvb[j][0] * w4[0] + xvb[j][1] * w4[1]) + (xvb[j][2] * w4[2] + xvb[j][3] * w4[3]); }
                    aa[e] = a; ab[e] = b; }
#define TRED(arr, n, msk) _Pragma("unroll") for (int i_ = 0; i_ < (n); ++i_) { const bool up_ = (lane & (msk)) != 0; const float keep_ = up_ ? arr[(n) + i_] : arr[i_], give_ = up_ ? arr[i_] : arr[(n) + i_]; arr[i_] = keep_ + __shfl_xor(give_, (msk)); }
                TRED(aa, 16, 32) TRED(aa, 8, 16) TRED(aa, 4, 8) TRED(aa, 2, 4) TRED(aa, 1, 2)
                TRED(ab, 16, 32) TRED(ab, 8, 16) TRED(ab, 4, 8) TRED(ab, 2, 4) TRED(ab, 1, 2)
#undef TRED
                const float la = aa[0] + __shfl_xor(aa[0], 1) + my_b, lb = ab[0] + __shfl_xor(ab[0], 1) + my_b;
#pragma unroll
                for (int tk = 0; tk < 2; ++tk) {
                    const float v = tk ? lb : la; int rank = 0;
                    if (!(lane & 1)) lg[tk * 32 + ex] = v;
                    LDS_WAIT();
#pragma unroll
                    for (int q = 0; q < 8; ++q) { const f32x4 s4 = *(const LAS f32x4*)(lg + tk * 32 + 4 * q);
#pragma unroll
                        for (int jj = 0; jj < 4; ++jj) rank += (s4[jj] > v || (s4[jj] == v && (4 * q + jj) < ex)) ? 1 : 0; }
                    if (rank < 4 && !(lane & 1)) lg[64 + tk * 4 + rank] = v;
                    LDS_WAIT();
                    const f32x4 tv = *(const LAS f32x4*)(lg + 64 + tk * 4);
                    const float p1 = __expf(tv[1] - tv[0]), p2 = __expf(tv[2] - tv[0]), p3 = __expf(tv[3] - tv[0]), inv = 1.0f / (1.0f + p1 + p2 + p3);
                    if (rank < 4 && !(lane & 1)) { const float w = (rank == 0 ? 1.0f : (rank == 1 ? p1 : (rank == 2 ? p2 : p3))) * inv;
                        const int lr = __hip_atomic_fetch_add((LAS int*)&lcount[ex], 1, __ATOMIC_RELAXED, __HIP_MEMORY_SCOPE_WORKGROUP);
                        asg_e[(tl + tk) * 4 + rank] = ((unsigned)ex << 16) | (unsigned)lr; asg_w[(tl + tk) * 4 + rank] = w; }
                }
            }
            LDS_WAIT();
            if (lane == 0) __hip_atomic_fetch_add((LAS int*)&sync_w[0], 1, __ATOMIC_RELAXED, __HIP_MEMORY_SCOPE_WORKGROUP);
            if (wave == 0) {
                while (__hip_atomic_load((LAS int*)&sync_w[0], __ATOMIC_RELAXED, __HIP_MEMORY_SCOPE_WORKGROUP) < 4) __builtin_amdgcn_s_sleep(4);
                asm volatile("s_waitcnt lgkmcnt(0)" ::: "memory");
                if (lane < 32) gbase[lane] = (int)__hip_atomic_fetch_add(count + lane, (unsigned)lcount[lane], __ATOMIC_RELAXED, __HIP_MEMORY_SCOPE_AGENT);
                LDS_WAIT();
#pragma unroll
                for (int q = 0; q < 4; ++q) { const int a_ = q * 64 + lane; const unsigned ae = asg_e[a_]; const int e = ae >> 16, rank = gbase[e] + (int)(ae & 0xffffu); const int t = chunk * 64 + (a_ >> 2);
                    rowtok_p[e * T + rank] = t; u32x2 av; av.x = ((unsigned)e << 16) | (unsigned)rank; av.y = __float_as_uint(asg_w[a_]); assign[(size_t)t * 4 + (a_ & 3)] = av; }
            }
        }
        const float* w_gate = (const float*)AIN(20); const float* w_up = (const float*)AIN(22); const float* w_down = (const float*)AIN(24);
        const int per_wg = (NEXP * 768 + G - 1) / G;
        for (;;) {
            int it = 0; if (lane == 0) it = __hip_atomic_fetch_add((LAS int*)&sync_w[1], 1, __ATOMIC_RELAXED, __HIP_MEMORY_SCOPE_WORKGROUP);
            it = __builtin_amdgcn_readfirstlane(it); const int item = bx * per_wg + it;
            if (it >= per_wg || item >= NEXP * 768) break;
            const int e = item / 768, r = item % 768, mat = r >> 8, kb = (r >> 4) & 15, nb = r & 15, f0 = nb * 64;
            if (mat < 2) cvt_tile64((mat ? w_up : w_gate) + (size_t)e * D * FF, FF, Bt_gu + (size_t)e * 2048 * D, D, kb * 64, f0, 256 * (f0 >> 7) + mat * 128 + (f0 & 127), lane);
            else cvt_tile64(w_down + (size_t)e * FF * D, D, Bt_d + (size_t)e * D * FF, FF, kb * 64, f0, f0, lane);
        }
    }
    SEAM(6);
    LAS int* t_cnt = (LAS int*)(lds + TAB_OFF + 4096); LAS int* t_start = t_cnt + 32; LAS int* t_t2e = t_start + 40;
    if (IN(7) || IN(8) || IN(9)) {
        KARGS();
        __syncthreads();
        if (tid < 32) t_cnt[tid] = (int)__hip_atomic_load(count + tid, __ATOMIC_RELAXED, __HIP_MEMORY_SCOPE_AGENT);
        __syncthreads();
        if (tid == 0) { int s = 0; for (int e = 0; e < NEXP; ++e) { t_start[e] = s; s += (t_cnt[e] + 255) >> 8; } t_start[32] = s; }
        __syncthreads();
        if (tid < 32) { for (int rt = t_start[tid]; rt < t_start[tid + 1]; ++rt) t_t2e[rt] = tid; }
        __syncthreads();
    }
    if (IN(7)) {
        KARGS();
        pg8::Gemm g{h2, Bt_gu, D}; pg8::MoeOrder S; S.init(t_start[32], 8, G, bx); S.t2e = t_t2e; S.tstart = t_start; S.cnt = t_cnt; S.rowtok = rowtok_p;
        pg8::EpiSwiglu E{act, (const float*)AIN(21), (const float*)AIN(23)};
        pg8::gemm_phase<pg8::EpiSwiglu, pg8::MoeOrder, true, true>(lds, g, S, E);
    }
    SEAM(7);
    if (IN(8)) {
        KARGS();
        pg8::Gemm g{act, Bt_d, FF}; pg8::MoeOrder S; S.init(t_start[32], 4, G, bx); S.t2e = t_t2e; S.tstart = t_start; S.cnt = t_cnt; S.rowtok = rowtok_p;
        pg8::EpiDown E{ybuf, (const float*)AIN(25)};
        pg8::gemm_phase<pg8::EpiDown, pg8::MoeOrder, false, true>(lds, g, S, E);
    }
    SEAM(8);
    if (IN(9) && DBG_OUT) {
        KARGS();
        const bf16_t* src = DBG_OUT == 1 ? gates : DBG_OUT == 2 ? gates + 1024 : DBG_OUT == 3 ? qa : DBG_OUT == 4 ? ka : DBG_OUT == 5 ? va : DBG_OUT == 6 ? mrg : DBG_OUT == 7 ? oa : DBG_OUT == 9 ? Bt_in : ob;
        const int ld = DBG_OUT <= 2 ? 2048 : 1024;
        for (size_t i = (size_t)bx * 512 + tid; i < (size_t)T * 1024; i += (size_t)G * 512) AOUT[i] = (DBG_OUT == 9 && i >= (size_t)N_IN * 1024) ? 0.f : __uint_as_float((unsigned)src[(i >> 10) * ld + (i & 1023)] << 16);
    } else
    if (IN(9)) {
        KARGS();
        LANE_DECL;
        const float* g_fin = (const float*)AIN(26);
        for (int t0 = gw * 2; t0 < T; t0 += NGW * 2) {
            f32x4 v[2][4]; u32x2 as_[2][4];
#pragma unroll
            for (int q = 0; q < 2; ++q) { const f32x4* xr = (const f32x4*)(AOUT + (size_t)(t0 + q) * D) + lane;
#pragma unroll
                for (int j = 0; j < 4; ++j) v[q][j] = xr[64 * j];
#pragma unroll
                for (int k = 0; k < 4; ++k) as_[q][k] = assign[(size_t)(t0 + q) * 4 + k]; }
            u32x2 yw[2][4][4];
#pragma unroll
            for (int q = 0; q < 2; ++q)
#pragma unroll
                for (int k = 0; k < 4; ++k) { const int e = as_[q][k].x >> 16, rank = as_[q][k].x & 0xffffu;
                    const u32x2* yr = (const u32x2*)(ybuf + ((size_t)t_start[e] * 256 + rank) * D) + lane;
#pragma unroll
                    for (int j = 0; j < 4; ++j) yw[q][k][j] = yr[64 * j]; }
#pragma unroll
            for (int q = 0; q < 2; ++q) {
#pragma unroll
                for (int k = 0; k < 4; ++k) { const float w = __uint_as_float(as_[q][k].y);
#pragma unroll
                    for (int j = 0; j < 4; ++j) { const u32x2 y = yw[q][k][j]; v[q][j][0] += w * bf_lo(y.x); v[q][j][1] += w * bf_hi(y.x); v[q][j][2] += w * bf_lo(y.y); v[q][j][3] += w * bf_hi(y.y); } }
                float s = 0.f;
#pragma unroll
                for (int j = 0; j < 4; ++j) s += (v[q][j][0] * v[q][j][0] + v[q][j][1] * v[q][j][1]) + (v[q][j][2] * v[q][j][2] + v[q][j][3] * v[q][j][3]);
                const float rstd = __builtin_amdgcn_rsqf(wave_sum(s) * (1.f / D) + EPS);
                f32x4* xo = (f32x4*)(AOUT + (size_t)(t0 + q) * D) + lane;
#pragma unroll
                for (int j = 0; j < 4; ++j) { const f32x4 gg = *((const f32x4*)g_fin + lane + 64 * j); xo[64 * j] = v[q][j] * rstd * gg; } }
        }
    }
#undef IN
#undef SEAM
#undef KARGS
#undef AIN
#undef AOUT
#undef AWS
#undef xin
#undef positions
#undef Bt_in
#undef Bt_uq
#undef Bt_ukv
#undef Bt_od
#undef Bt_om
#undef Bt_out
#undef ropeA
#undef ropeM
#undef sq
#undef hbuf
#undef oa
#undef qa
#undef ka
#undef va
#undef cq
#undef ckv
#undef kr
#undef gates
#undef qm
#undef kv
#undef ob
#undef mrg
#undef stash
#undef rowtok_p
#undef assign
#undef Bt_d
#undef Bt_gu
#undef h2
#undef act
#undef ybuf
#undef count
}

extern "C" void kernel_launch(void* const* d_in, const int* in_sizes, int n_in, void* d_out, int out_size, void* d_ws, size_t ws_size, hipStream_t stream) {
    static int grid = 0;
    if (grid == 0) {
        if (n_in != 27 || in_sizes[0] != T * D || out_size != T * D || ws_size < WS_END) { fprintf(stderr, "kernel_launch: unexpected shapes (n_in %d, in0 %d, out %d, ws %zu < %zu)\n", n_in, n_in > 0 ? in_sizes[0] : -1, out_size, ws_size, (size_t)WS_END); grid = -1; return; }
        int dev = 0, cus = 0, per_cu = 0;
        if (hipGetDevice(&dev) != hipSuccess || hipDeviceGetAttribute(&cus, hipDeviceAttributeMultiprocessorCount, dev) != hipSuccess) { grid = -1; return; }
        if (hipFuncSetAttribute((const void*)fwd, hipFuncAttributeMaxDynamicSharedMemorySize, LDS_BYTES) != hipSuccess) { fprintf(stderr, "kernel_launch: hipFuncSetAttribute failed\n"); grid = -1; return; }
        if (hipOccupancyMaxActiveBlocksPerMultiprocessor(&per_cu, (const void*)fwd, NWAVES * 64, LDS_BYTES) != hipSuccess || per_cu < 1) fprintf(stderr, "kernel_launch: occupancy query says %d\n", per_cu);
        (void)hipGetLastError();
        grid = cus;
    }
    if (grid < 0) return;
    if (hipMemsetAsync((char*)d_ws + WS_CTL, 0, CTL_ZERO_BYTES, stream) != hipSuccess) return;
    Args a{};
    for (int i = 0; i < 27; ++i) a.in[i] = d_in[i];
    a.out = (float*)d_out; a.ws = (unsigned char*)d_ws;
#if MK_PER_PHASE
    for (int p = 0; p < NPHASE; ++p) { a.ph_lo = p; a.ph_hi = p + 1; hipLaunchKernelGGL(fwd, dim3(grid), dim3(NWAVES * 64), LDS_BYTES, stream, a); }
#elif PROBE_PHASE >= 0
    a.ph_lo = 0; a.ph_hi = PROBE_PHASE + 1; a.li = 0; hipLaunchKernelGGL(fwd, dim3(grid), dim3(NWAVES * 64), LDS_BYTES, stream, a);
    a.ph_lo = PROBE_PHASE; a.ph_hi = NPHASE; a.li = 1; hipLaunchKernelGGL(fwd, dim3(grid), dim3(NWAVES * 64), LDS_BYTES, stream, a);
#else
    a.ph_lo = 0; a.ph_hi = NPHASE; hipLaunchKernelGGL(fwd, dim3(grid), dim3(NWAVES * 64), LDS_BYTES, stream, a);
#endif
}
```

```cpp
#include <hip/hip_runtime.h>
#include <cstdio>
#include <cstdint>

#ifndef MK_PER_PHASE
#define MK_PER_PHASE 0
#endif

#ifndef PROBE_PHASE
#define PROBE_PHASE -1
#endif
#ifndef ATT_DUP
#define ATT_DUP 0
#endif
#ifndef DBG_OUT
#define DBG_OUT 0
#endif
#ifndef DBG_SKIP
#define DBG_SKIP 0
#endif
#ifndef ATT_MASK
#define ATT_MASK 3
#endif
#ifndef PH_MASK
#define PH_MASK 0x3ff
#endif
#define LAS __attribute__((address_space(3)))
#define GAS __attribute__((address_space(1)))
typedef unsigned short bf16_t;
typedef short bf16x8 __attribute__((ext_vector_type(8)));
typedef short s16x4 __attribute__((ext_vector_type(4)));
typedef float f32x2 __attribute__((ext_vector_type(2)));
typedef float f32x4 __attribute__((ext_vector_type(4)));
typedef float f32x16 __attribute__((ext_vector_type(16)));
typedef unsigned u32x2 __attribute__((ext_vector_type(2)));
typedef unsigned u32x4 __attribute__((ext_vector_type(4)));

constexpr int NB = 4, SEQ = 4096, T = NB * SEQ, D = 1024;
constexpr int NEXP = 32, TOPK = 4, FF = 1024;
constexpr int N_IN = 6656;
constexpr int QL = 768, KVL = 512;
constexpr float EPS = 1e-6f;
constexpr float LAM_INIT = 0.2f;
constexpr int NPHASE = 10;

constexpr size_t MiB = 1u << 20;
constexpr size_t WS_CTL = 0, CTL_ZERO_BYTES = 1 * MiB;
constexpr size_t WS_BT_IN = 2 * MiB;
constexpr size_t WS_BT_UQ = 15 * MiB;
constexpr size_t WS_BT_UKV = 18 * MiB;
constexpr size_t WS_BT_OD = 20 * MiB, WS_BT_OM = 22 * MiB, WS_BT_OUT = 24 * MiB;
constexpr size_t WS_ROPEA = 26 * MiB;
constexpr size_t WS_ROPEM = 27 * MiB;
constexpr size_t WS_SQ = 31 * MiB;
constexpr size_t WS_SQP = 1 * MiB;
constexpr size_t WS_H = 32 * MiB;
constexpr size_t WS_QA = 64 * MiB, WS_KA = 96 * MiB, WS_VA = 128 * MiB;
constexpr size_t WS_CQ = 160 * MiB, WS_CKV = 184 * MiB, WS_KR = 200 * MiB;
constexpr size_t WS_SQ2 = 202 * MiB;
constexpr size_t WS_GATES = 208 * MiB;
constexpr size_t WS_QM = 272 * MiB;
constexpr size_t WS_KV = 320 * MiB;
constexpr size_t WS_OB = 384 * MiB;
constexpr size_t WS_MRG = 416 * MiB;
constexpr size_t WS_STASH = 448 * MiB;
constexpr size_t WS_ROWTOK = 2 * MiB;
constexpr size_t WS_ASSIGN = 4 * MiB;
constexpr size_t WS_BT_D = 32 * MiB;
constexpr size_t WS_BT_GU = 96 * MiB;
constexpr size_t WS_H2 = 224 * MiB;
constexpr size_t WS_ACT = 256 * MiB;
constexpr size_t WS_Y = 96 * MiB;
constexpr size_t WS_END = 512 * MiB;
constexpr int CW_COUNT = 64;
constexpr int CW_BAR = 4096;

constexpr int RING_BYTES = 131072;
constexpr int TAB_OFF = RING_BYTES;
constexpr int TAB_BYTES = 8192;
constexpr int MISC_OFF = TAB_OFF + TAB_BYTES;
constexpr int LDS_BYTES = 147456;

typedef __bf16 bf16x2_t __attribute__((ext_vector_type(2)));
__device__ __forceinline__ unsigned cvt_pk_bf16(float lo, float hi) { const f32x2 v = {lo, hi}; return __builtin_bit_cast(unsigned, __builtin_convertvector(v, bf16x2_t)); }
__device__ __forceinline__ float bf_lo(unsigned w) { return __uint_as_float(w << 16); }
__device__ __forceinline__ float bf_hi(unsigned w) { return __uint_as_float(w & 0xffff0000u); }
__device__ __forceinline__ float wave_sum(float v) {
#pragma unroll
    for (int o = 1; o < 64; o <<= 1) v += __shfl_xor(v, o);
    return v;
}
__device__ __forceinline__ float sigmoidf_(float x) { return __builtin_amdgcn_rcpf(1.0f + __builtin_amdgcn_exp2f(-1.4426950408889634f * x)); }
#define LDS_WAIT() asm volatile("s_waitcnt lgkmcnt(0)" ::: "memory")
#define VM_WAIT() asm volatile("s_waitcnt vmcnt(0)" ::: "memory")

#define XB_TMO      128
#define XB_XCNT(j)  (256  + 64 * (j))
#define XB_XSUB(j)  (1280 + 64 * (j))
#define XB_XGEN(j)  (2304 + 64 * (j))
#define XB_TOP      3328
#define XB_TOPGEN   3392
#define XCD_BAR_WORDS 3456
#define XB_SPIN_CAP (1u << 20)
__device__ __forceinline__ unsigned xb_ld(unsigned* p)              { return __hip_atomic_load(p, __ATOMIC_RELAXED, __HIP_MEMORY_SCOPE_AGENT); }
__device__ __forceinline__ unsigned xb_add(unsigned* p, unsigned v) { return __hip_atomic_fetch_add(p, v, __ATOMIC_RELAXED, __HIP_MEMORY_SCOPE_AGENT); }
__device__ __forceinline__ unsigned xb_xcc_id() { return (unsigned)__builtin_amdgcn_s_getreg((3 << 11) | 20) & 0xFu; }
#define XB_SPIN(cond, bar) do { unsigned _sp = 0; while (cond) { __builtin_amdgcn_s_sleep(1); \
    if ((++_sp & 255u) == 0u) { if (xb_ld(&(bar)[XB_TMO])) break; if (_sp > XB_SPIN_CAP) { atomicAdd(&(bar)[XB_TMO], 1u); break; } } } } while (0)
struct XcdBarrier { unsigned* bar; unsigned x; volatile LAS unsigned* st; };
__device__ __forceinline__ XcdBarrier xcd_barrier_post(unsigned* bar, volatile LAS unsigned* st) {
    XcdBarrier b; b.bar = bar; b.x = xb_xcc_id(); b.st = st;
    if (threadIdx.x == 0) (void)xb_add(&bar[XB_XCNT(b.x)], 1u);
    return b;
}
__device__ __forceinline__ void xcd_barrier_complete(unsigned* bar, unsigned x, unsigned& nloc, unsigned& nx) {
    const unsigned G = gridDim.x * gridDim.y * gridDim.z;
    unsigned sum, cnt, mine, sp = 0u;
    for (;;) {
        sum = 0u; cnt = 0u; mine = 0u;
#pragma unroll
        for (unsigned j = 0; j < 16; ++j) { const unsigned c = xb_ld(&bar[XB_XCNT(j)]); sum += c; cnt += (c > 0u) ? 1u : 0u; mine = (j == x) ? c : mine; }
        if (sum == G) break;
        __builtin_amdgcn_s_sleep(1);
        if ((++sp & 255u) == 0u) { if (xb_ld(&bar[XB_TMO])) break; if (sp > XB_SPIN_CAP) { atomicAdd(&bar[XB_TMO], 1u); break; } }
    }
    nloc = mine > 0u ? mine : 1u; nx = cnt > 0u ? cnt : 1u;
}
__device__ __forceinline__ void xcd_barrier(const XcdBarrier& b) {
    asm volatile("s_waitcnt vmcnt(0)" ::: "memory");
    __syncthreads();
    if (threadIdx.x == 0) {
        unsigned* bar = b.bar;
        __builtin_amdgcn_s_waitcnt(0);
        unsigned nloc = b.st[0], nx = b.st[1];
        if (nloc == 0u) { xcd_barrier_complete(bar, b.x, nloc, nx); b.st[0] = nloc; b.st[1] = nx; }
        const unsigned old = xb_add(&bar[XB_XSUB(b.x)], 1u);
        const unsigned gen = old / nloc;
        if (old + 1u == (gen + 1u) * nloc) {
            __builtin_amdgcn_fence(__ATOMIC_RELEASE, "agent");
            asm volatile("s_waitcnt vmcnt(0)" ::: "memory");
            const unsigned og = xb_add(&bar[XB_TOP], 1u);
            const unsigned tg = og / nx;
            if (og + 1u == (tg + 1u) * nx) xb_add(&bar[XB_TOPGEN], 1u);
            else XB_SPIN(xb_ld(&bar[XB_TOPGEN]) == tg, bar);
            __builtin_amdgcn_fence(__ATOMIC_ACQUIRE, "agent");
            xb_add(&bar[XB_XGEN(b.x)], 1u);
            asm volatile("s_waitcnt vmcnt(0)" ::: "memory");
        } else {
            XB_SPIN(xb_ld(&bar[XB_XGEN(b.x)]) == gen, bar);
            __builtin_amdgcn_fence(__ATOMIC_ACQUIRE, "agent");
            asm volatile("s_waitcnt vmcnt(0)" ::: "memory");
        }
    }
    __syncthreads();
}

namespace pg8 {
constexpr int BM = 256, BK = 64, HALF = 128, HTB = HALF * BK * 2, STAGE_BYTES = 8 * HTB, NXCD = 8, WGM = 8;
__host__ __device__ __forceinline__ int lds_byte(int r, int c) { const int st = (r >> 4) * 2 + (c >> 5), rr = r & 15, cc = c & 31, ob = rr * 64 + cc * 2; return st * 1024 + (ob ^ (((ob >> 9) & 1) << 5)); }
__host__ __device__ __forceinline__ void stage_rc(int b, int& R, int& C) { const int st = b / 1024, sb = b % 1024, swz = sb ^ (((sb >> 9) & 1) << 5); R = (st >> 1) * 16 + swz / 64; C = (st & 1) * 32 + (swz % 64) / 2; }
__host__ __device__ __forceinline__ int perm32(int rho) { const int n = rho >> 4, i = rho & 15; return 8 * (i >> 2) + 4 * n + (i & 3); }

struct Unit { int pm, pn, pb, e, rbase, cnt; };
struct Gemm { const bf16_t* A; const bf16_t* Bt; int K; };

struct DenseOrder {
    int nM, nN, nwg, G, c;
    __device__ void init(int nM_, int nN_, int G_, int c_) { nM = nM_; nN = nN_; nwg = nM * nN; G = G_; c = c_; }
    __device__ __forceinline__ bool next(int i, Unit& u) const {
        const long L = (long)i * G + c; if (L >= nwg) return false;
        int wgid = (int)L; { const int q = nwg / NXCD, r = nwg % NXCD, xcd = wgid % NXCD, off = wgid / NXCD; wgid = (xcd < r ? xcd * (q + 1) : r * (q + 1) + (xcd - r) * q) + off; }
        const int nig = WGM * nN, gid = wgid / nig, fm = gid * WGM, gsz = (nM - fm) < WGM ? (nM - fm) : WGM;
        u.pm = fm + ((wgid % nig) % gsz); u.pn = (wgid % nig) / gsz; if (DBG_SKIP & 128) u.pn = nN - 1 - u.pn; u.pb = u.pn; u.e = 0; u.rbase = 0; u.cnt = 0; return true;
    }
    __device__ __forceinline__ int a_row(const Unit&, int) const { return 0; }
};
struct MoeOrder {
    int nM, nN, nwg, G, c; const LAS int* t2e; const LAS int* tstart; const LAS int* cnt; const int* rowtok;
    __device__ void init(int nM_, int nN_, int G_, int c_) { nM = nM_; nN = nN_; nwg = nM * nN; G = G_; c = c_; }
    __device__ __forceinline__ bool next(int i, Unit& u) const {
        const long L = (long)i * G + c; if (L >= nwg) return false;
        int wgid = (int)L; { const int q = nwg / NXCD, r = nwg % NXCD, xcd = wgid % NXCD, off = wgid / NXCD; wgid = (xcd < r ? xcd * (q + 1) : r * (q + 1) + (xcd - r) * q) + off; }
        const int nig = WGM * nN, gid = wgid / nig, fm = gid * WGM, gsz = (nM - fm) < WGM ? (nM - fm) : WGM;
        u.pm = fm + ((wgid % nig) % gsz); u.pn = (wgid % nig) / gsz;
        const int e = __builtin_amdgcn_readfirstlane(t2e[u.pm]); u.e = e; u.pb = e * nN + u.pn; u.rbase = (u.pm - __builtin_amdgcn_readfirstlane(tstart[e])) * 256; u.cnt = __builtin_amdgcn_readfirstlane(cnt[e]); return true;
    }
    __device__ __forceinline__ int a_row(const Unit& u, int r) const { const int rank = u.rbase + r; return rank < u.cnt ? rowtok[u.e * T + rank] : 0; }
};

template <class Epi, class Sched, bool GATHER, bool ALIGN_EPI>
__device__ __forceinline__ void gemm_phase(LAS unsigned char* lds, const Gemm g, const Sched& S, const Epi& E) {
    const int tid = threadIdx.x, wid = __builtin_amdgcn_readfirstlane(tid >> 6), lane = tid & 63, wr = wid >> 2, wc = wid & 3, fr = lane & 15, fq = lane >> 4;
    const int K = g.K, nt = K / BK;
    unsigned voffA[2], voffB[2]; int Rv[2], Cv[2];
#pragma unroll
    for (int i = 0; i < 2; ++i) { int R, C; stage_rc(tid * 16 + i * 8192, R, C); const int Rb = Epi::PERM ? ((R & ~31) + perm32(R & 31)) : R;
        voffA[i] = (unsigned)(R * K + C) * 2u; voffB[i] = (unsigned)(Rb * K + C) * 2u; Rv[i] = R; Cv[i] = C; }
    const size_t kstep = (size_t)(BK * 2);
    const size_t hstep = (size_t)HALF * K * 2;
    const size_t tstep = 2 * hstep;
    const unsigned ldsw = (unsigned)wid * 1024u;
    const int aoff = lds_byte(wr * 64 + fr, fq * 8), boff = lds_byte(wc * 32 + fr, fq * 8);
#define PG8_SA(b, h) (((b) * 2 + (h)) * HTB)
#define PG8_SB(b, h) ((4 + (b) * 2 + (h)) * HTB)
#define PG8_STAGE(bufoff, gbase, voff) do { _Pragma("unroll") for (int _i = 0; _i < 2; ++_i) \
        __builtin_amdgcn_global_load_lds((const unsigned*)((const char*)(gbase) + (voff)[_i]), (LAS unsigned*)(lds + (bufoff) + ldsw + _i * 8192), 16, 0, 0); } while (0)
#define PG8_LDA(dst, b, h) do { _Pragma("unroll") for (int m = 0; m < 4; ++m) _Pragma("unroll") for (int k = 0; k < 2; ++k) dst[m][k] = *(const LAS bf16x8*)(lds + PG8_SA(b, h) + aoff + m * 2048 + k * 1024); } while (0)
#define PG8_LDB(dst, b, h) do { _Pragma("unroll") for (int n = 0; n < 2; ++n) _Pragma("unroll") for (int k = 0; k < 2; ++k) dst[n][k] = *(const LAS bf16x8*)(lds + PG8_SB(b, h) + boff + n * 2048 + k * 1024); } while (0)
#define PG8_MMA(ai, bj, At, Bt) do { __builtin_amdgcn_s_setprio(1); _Pragma("unroll") for (int m = 0; m < 4; ++m) _Pragma("unroll") for (int n = 0; n < 2; ++n) _Pragma("unroll") for (int k = 0; k < 2; ++k) \
        acc[ai][bj][m][n] = __builtin_amdgcn_mfma_f32_16x16x32_bf16(Bt[n][k], At[m][k], acc[ai][bj][m][n], 0, 0, 0); __builtin_amdgcn_s_setprio(0); } while (0)
#define PG8_WAIT_V(n) asm volatile("s_waitcnt vmcnt(" #n ")" ::: "memory")
#define PG8_WAIT_L(n) asm volatile("s_waitcnt lgkmcnt(" #n ")" ::: "memory")
#define PG8_BAR __builtin_amdgcn_s_barrier()
#define PG8_SCHED __builtin_amdgcn_sched_barrier(0)
    Unit cur, nxt; int ui = 0;
    if (!S.next(0, cur)) return;
    f32x4 acc[2][2][4][2];
#pragma unroll
    for (int a = 0; a < 2; ++a)
#pragma unroll
        for (int b = 0; b < 2; ++b)
#pragma unroll
            for (int m = 0; m < 4; ++m)
#pragma unroll
                for (int n = 0; n < 2; ++n) acc[a][b][m][n] = (f32x4){0.f, 0.f, 0.f, 0.f};
    bf16x8 At[4][2], B0[2][2], B1[2][2];
    unsigned gC0[2], gC1[2], gN0[2], gN1[2];
    if constexpr (GATHER) {
#pragma unroll
        for (int i = 0; i < 2; ++i) { gC0[i] = (unsigned)S.a_row(cur, Rv[i]) * (unsigned)(K * 2) + (unsigned)Cv[i] * 2u; gC1[i] = (unsigned)S.a_row(cur, HALF + Rv[i]) * (unsigned)(K * 2) + (unsigned)Cv[i] * 2u; gN0[i] = gC0[i]; gN1[i] = gC1[i]; }
    }
    const char* cA = GATHER ? (const char*)g.A : (const char*)g.A + (size_t)cur.pm * tstep; const char* cB = (const char*)g.Bt + (size_t)cur.pb * tstep;
#define PG8_STAGE_A(bufoff, p, h, o0, o1) do { if constexpr (GATHER) { if ((h) == 0) PG8_STAGE(bufoff, p, o0); else PG8_STAGE(bufoff, p, o1); } else { PG8_STAGE(bufoff, (p) + (h) * hstep, voffA); } } while (0)
    PG8_STAGE(PG8_SB(0, 0), cB, voffB); PG8_STAGE(PG8_SB(0, 1), cB + hstep, voffB); PG8_STAGE_A(PG8_SA(0, 0), cA, 0, gC0, gC1); PG8_STAGE_A(PG8_SA(0, 1), cA, 1, gC0, gC1);
    if (wr == 1) PG8_BAR;
    PG8_WAIT_V(2); PG8_BAR;
    PG8_STAGE(PG8_SB(1, 0), cB + kstep, voffB); PG8_STAGE_A(PG8_SA(1, 0), cA + kstep, 0, gC0, gC1); PG8_STAGE(PG8_SB(1, 1), cB + hstep + kstep, voffB);
    PG8_WAIT_V(6); PG8_BAR;
    for (;;) {
        const bool has_next = S.next(ui + 1, nxt);
        const char* nA = GATHER ? (const char*)g.A : (has_next ? (const char*)g.A + (size_t)nxt.pm * tstep : cA); const char* nB = has_next ? (const char*)g.Bt + (size_t)nxt.pb * tstep : cB;
        if constexpr (GATHER) { if (has_next) {
#pragma unroll
            for (int i = 0; i < 2; ++i) { gN0[i] = (unsigned)S.a_row(nxt, Rv[i]) * (unsigned)(K * 2) + (unsigned)Cv[i] * 2u; gN1[i] = (unsigned)S.a_row(nxt, HALF + Rv[i]) * (unsigned)(K * 2) + (unsigned)Cv[i] * 2u; } } }
        for (int t = 0; t < nt; t += 2) {
            const bool last = (t == nt - 2);
            const char* a1 = cA + (size_t)(t + 1) * kstep;
            const char* a2 = last ? nA : cA + (size_t)(t + 2) * kstep; const char* b2 = last ? nB : cB + (size_t)(t + 2) * kstep;
            const char* a3 = a2 + kstep; const char* b3 = b2 + kstep;
            unsigned s0[2], s1[2];
            if constexpr (GATHER) { s0[0] = last ? gN0[0] : gC0[0]; s0[1] = last ? gN0[1] : gC0[1]; s1[0] = last ? gN1[0] : gC1[0]; s1[1] = last ? gN1[1] : gC1[1]; }
            PG8_LDB(B0, 0, 0); PG8_LDB(B1, 0, 1); PG8_SCHED; PG8_LDA(At, 0, 0); PG8_STAGE_A(PG8_SA(1, 1), a1, 1, gC0, gC1);
            PG8_WAIT_V(8); PG8_WAIT_L(0); PG8_BAR; PG8_MMA(0, 0, At, B0); PG8_MMA(0, 1, At, B1); PG8_BAR; PG8_SCHED;
            PG8_LDA(At, 0, 1); PG8_STAGE(PG8_SB(0, 0), b2, voffB); PG8_STAGE(PG8_SB(0, 1), b2 + hstep, voffB); PG8_STAGE_A(PG8_SA(0, 0), a2, 0, s0, s1);
            PG8_WAIT_V(8); PG8_WAIT_L(0); PG8_BAR; PG8_MMA(1, 0, At, B0); PG8_MMA(1, 1, At, B1); PG8_BAR; PG8_SCHED;
            PG8_LDB(B0, 1, 0); PG8_LDB(B1, 1, 1); PG8_SCHED; PG8_LDA(At, 1, 0); PG8_STAGE_A(PG8_SA(0, 1), a2, 1, s0, s1);
            PG8_WAIT_V(8); PG8_WAIT_L(0); PG8_BAR; PG8_MMA(0, 0, At, B0); PG8_MMA(0, 1, At, B1); PG8_BAR; PG8_SCHED;
            PG8_LDA(At, 1, 1); PG8_STAGE(PG8_SB(1, 0), b3, voffB); PG8_STAGE(PG8_SB(1, 1), b3 + hstep, voffB); PG8_STAGE_A(PG8_SA(1, 0), a3, 0, s0, s1);
            PG8_WAIT_V(8); PG8_WAIT_L(0); PG8_BAR; PG8_MMA(1, 0, At, B0); PG8_MMA(1, 1, At, B1); PG8_BAR; PG8_SCHED;
        }
        if constexpr (ALIGN_EPI) { if (wr == 0) PG8_BAR; }
        E(acc, cur, wr, wc, fr, fq);
        if (!has_next) break;
#pragma unroll
        for (int a = 0; a < 2; ++a)
#pragma unroll
            for (int b = 0; b < 2; ++b)
#pragma unroll
                for (int m = 0; m < 4; ++m)
#pragma unroll
                    for (int n = 0; n < 2; ++n) acc[a][b][m][n] = (f32x4){0.f, 0.f, 0.f, 0.f};
        cur = nxt; cA = nA; cB = nB; ++ui;
        if constexpr (GATHER) { gC0[0] = gN0[0]; gC0[1] = gN0[1]; gC1[0] = gN1[0]; gC1[1] = gN1[1]; }
        if constexpr (ALIGN_EPI) { if (wr == 1) PG8_BAR; }
    }
    PG8_WAIT_V(0);
    if constexpr (!ALIGN_EPI) { if (wr == 0) PG8_BAR; }
    PG8_BAR;
#undef PG8_SA
#undef PG8_SB
#undef PG8_STAGE
#undef PG8_STAGE_A
#undef PG8_LDA
#undef PG8_LDB
#undef PG8_MMA
#undef PG8_WAIT_V
#undef PG8_WAIT_L
#undef PG8_BAR
#undef PG8_SCHED
}

__device__ __forceinline__ u32x4 pack8(const f32x4& v0, const f32x4& v1) { u32x4 w; w.x = cvt_pk_bf16(v0[0], v0[1]); w.y = cvt_pk_bf16(v0[2], v0[3]); w.z = cvt_pk_bf16(v1[0], v1[1]); w.w = cvt_pk_bf16(v1[2], v1[3]); return w; }
__device__ __forceinline__ void rope4(f32x4& v0, f32x4& v1, const float* cs) {
    const f32x4 a = *(const f32x4*)cs, b = *(const f32x4*)(cs + 4);
    float x1, x2;
    x1 = v0[0]; x2 = v0[1]; v0[0] = x1 * a[0] - x2 * a[1]; v0[1] = x2 * a[0] + x1 * a[1];
    x1 = v0[2]; x2 = v0[3]; v0[2] = x1 * a[2] - x2 * a[3]; v0[3] = x2 * a[2] + x1 * a[3];
    x1 = v1[0]; x2 = v1[1]; v1[0] = x1 * b[0] - x2 * b[1]; v1[1] = x2 * b[0] + x1 * b[1];
    x1 = v1[2]; x2 = v1[3]; v1[2] = x1 * b[2] - x2 * b[3]; v1[3] = x2 * b[2] + x1 * b[3];
}

struct EpiIn {
    static constexpr bool PERM = true;
    bf16_t *qa, *ka, *va, *cq, *ckv, *gates, *kr; const float *ropeA, *ropeM, *bg; float* sq;
    __device__ __forceinline__ void operator()(const f32x4 (&acc)[2][2][4][2], const Unit& u, int wr, int wc, int fr, int fq) const {
        const int pn = u.pn, row0 = u.pm * BM + wr * 64 + fr, cl = wc * 32 + 8 * fq;
        if (pn < 8) {
            bf16_t* dst = pn < 4 ? qa : ka; const int colt = (pn & 3) * 256; const bool rot = ((wc & 1) == 0) && (fq < 2);
#pragma unroll
            for (int ai = 0; ai < 2; ++ai)
#pragma unroll
                for (int m = 0; m < 4; ++m) { const int row = row0 + ai * HALF + m * 16;
#pragma unroll
                    for (int bj = 0; bj < 2; ++bj) { f32x4 v0 = acc[ai][bj][m][0], v1 = acc[ai][bj][m][1];
                        if (rot) rope4(v0, v1, ropeA + (size_t)row * 16 + fq * 8);
                        *(u32x4*)(dst + (size_t)row * 1024 + colt + bj * HALF + cl) = pack8(v0, v1); } }
        } else if (pn < 12) {
            const int colt = (pn - 8) * 256;
#pragma unroll
            for (int ai = 0; ai < 2; ++ai)
#pragma unroll
                for (int m = 0; m < 4; ++m) { const int row = row0 + ai * HALF + m * 16;
#pragma unroll
                    for (int bj = 0; bj < 2; ++bj) *(u32x4*)(va + (size_t)row * 1024 + colt + bj * HALF + cl) = pack8(acc[ai][bj][m][0], acc[ai][bj][m][1]); }
        } else if (pn < 17) {
            const bool isq = pn < 15; bf16_t* dst = isq ? cq : ckv; const int ld = isq ? QL : KVL, colt = (isq ? pn - 12 : pn - 15) * 256, tq = pn - 12;
#pragma unroll
            for (int ai = 0; ai < 2; ++ai)
#pragma unroll
                for (int m = 0; m < 4; ++m) { const int row = row0 + ai * HALF + m * 16; float s = 0.f;
#pragma unroll
                    for (int bj = 0; bj < 2; ++bj) { const f32x4 v0 = acc[ai][bj][m][0], v1 = acc[ai][bj][m][1];
                        s += (v0[0] * v0[0] + v0[1] * v0[1]) + (v0[2] * v0[2] + v0[3] * v0[3]) + (v1[0] * v1[0] + v1[1] * v1[1]) + (v1[2] * v1[2] + v1[3] * v1[3]);
                        *(u32x4*)(dst + (size_t)row * ld + colt + bj * HALF + cl) = pack8(v0, v1); }
                    s += __shfl_xor(s, 16); s += __shfl_xor(s, 32);
                    if (fq == 0) sq[(size_t)row * 20 + tq * 4 + wc] = s; }
        } else if (pn < 25) {
            const int colt = (pn - 17) * 256;
            f32x4 bv[2][2];
#pragma unroll
            for (int bj = 0; bj < 2; ++bj) { bv[bj][0] = *(const f32x4*)(bg + colt + bj * HALF + cl); bv[bj][1] = *(const f32x4*)(bg + colt + bj * HALF + cl + 4); if (DBG_SKIP & 256) { bv[bj][0] = bv[bj][0] * 0.f; bv[bj][1] = bv[bj][1] * 0.f; } }
#pragma unroll
            for (int ai = 0; ai < 2; ++ai)
#pragma unroll
                for (int m = 0; m < 4; ++m) { const int row = row0 + ai * HALF + m * 16;
#pragma unroll
                    for (int bj = 0; bj < 2; ++bj) { f32x4 v0 = acc[ai][bj][m][0] + bv[bj][0], v1 = acc[ai][bj][m][1] + bv[bj][1];
#pragma unroll
                        for (int j = 0; j < 4; ++j) { if (!(DBG_SKIP & 512)) { v0[j] = sigmoidf_(v0[j]); v1[j] = sigmoidf_(v1[j]); } }
                        *(u32x4*)(gates + (size_t)row * 2048 + colt + bj * HALF + cl) = pack8(v0, v1); } }
        } else {
            if (wc < 2) {
#pragma unroll
                for (int ai = 0; ai < 2; ++ai)
#pragma unroll
                    for (int m = 0; m < 4; ++m) { const int row = row0 + ai * HALF + m * 16;
                        f32x4 v0 = acc[ai][0][m][0], v1 = acc[ai][0][m][1];
                        rope4(v0, v1, ropeM + (size_t)row * 64 + (wc * 16 + fq * 4) * 2);
                        *(u32x4*)(kr + (size_t)row * 64 + cl) = pack8(v0, v1); }
            }
        }
    }
};
template <bool ISQ> struct EpiUp {
    static constexpr bool PERM = true;
    bf16_t* out; const float* sq; const float* ropeM;
    __device__ __forceinline__ void operator()(const f32x4 (&acc)[2][2][4][2], const Unit& u, int wr, int wc, int fr, int fq) const {
        const int row0 = u.pm * BM + wr * 64 + fr, cl = wc * 32 + 8 * fq; constexpr int LD = ISQ ? 1536 : 2048;
#pragma unroll
        for (int ai = 0; ai < 2; ++ai)
#pragma unroll
            for (int m = 0; m < 4; ++m) { const int row = row0 + ai * HALF + m * 16; float s;
                if (ISQ) { const f32x4 a = *(const f32x4*)(sq + (size_t)row * 20), b = *(const f32x4*)(sq + (size_t)row * 20 + 4), c = *(const f32x4*)(sq + (size_t)row * 20 + 8);
                    s = ((a[0] + a[1]) + (a[2] + a[3])) + ((b[0] + b[1]) + (b[2] + b[3])) + ((c[0] + c[1]) + (c[2] + c[3])); }
                else { const f32x4 a = *(const f32x4*)(sq + (size_t)row * 20 + 12), b = *(const f32x4*)(sq + (size_t)row * 20 + 16);
                    s = ((a[0] + a[1]) + (a[2] + a[3])) + ((b[0] + b[1]) + (b[2] + b[3])); }
                const float rstd = __builtin_amdgcn_rsqf(s * (ISQ ? 1.0f / QL : 1.0f / KVL) + EPS);
#pragma unroll
                for (int bj = 0; bj < 2; ++bj) { const int col = u.pn * BM + bj * HALF + cl; f32x4 v0 = acc[ai][bj][m][0] * rstd, v1 = acc[ai][bj][m][1] * rstd;
                    if (ISQ) { const int off = col % 192; if (off >= 128) rope4(v0, v1, ropeM + (size_t)row * 64 + (off - 128)); }
                    *(u32x4*)(out + (size_t)row * LD + col) = pack8(v0, v1); } }
    }
};
template <int WHICH> struct EpiGate {
    static constexpr bool PERM = true;
    bf16_t* mrg; const bf16_t* gates;
    __device__ __forceinline__ void operator()(const f32x4 (&acc)[2][2][4][2], const Unit& u, int wr, int wc, int fr, int fq) const {
        const int row0 = u.pm * BM + wr * 64 + fr, cl = wc * 32 + 8 * fq;
#pragma unroll
        for (int ai = 0; ai < 2; ++ai)
#pragma unroll
            for (int m = 0; m < 4; ++m) { const int row = row0 + ai * HALF + m * 16;
#pragma unroll
                for (int bj = 0; bj < 2; ++bj) { const int col = u.pn * BM + bj * HALF + cl;
                    const u32x4 gw = *(const u32x4*)(gates + (size_t)row * 2048 + WHICH * 1024 + col);
                    f32x4 v0 = acc[ai][bj][m][0], v1 = acc[ai][bj][m][1];
                    if ((DBG_SKIP & 8) && WHICH == 0) { v0 = v0 * 0.f; v1 = v1 * 0.f; } if ((DBG_SKIP & 16) && WHICH == 1) { v0 = v0 * 0.f; v1 = v1 * 0.f; }
                    v0[0] *= bf_lo(gw.x); v0[1] *= bf_hi(gw.x); v0[2] *= bf_lo(gw.y); v0[3] *= bf_hi(gw.y); v1[0] *= bf_lo(gw.z); v1[1] *= bf_hi(gw.z); v1[2] *= bf_lo(gw.w); v1[3] *= bf_hi(gw.w);
                    if (WHICH == 1) { const u32x4 tw = *(const u32x4*)(mrg + (size_t)row * 1024 + col);
                        v0[0] += bf_lo(tw.x); v0[1] += bf_hi(tw.x); v0[2] += bf_lo(tw.y); v0[3] += bf_hi(tw.y); v1[0] += bf_lo(tw.z); v1[1] += bf_hi(tw.z); v1[2] += bf_lo(tw.w); v1[3] += bf_hi(tw.w); }
                    *(u32x4*)(mrg + (size_t)row * 1024 + col) = pack8(v0, v1); } }
    }
};
struct EpiRes {
    static constexpr bool PERM = false;
    const float* x; float* out;
    __device__ __forceinline__ void operator()(const f32x4 (&acc)[2][2][4][2], const Unit& u, int wr, int wc, int fr, int fq) const {
        const int row0 = u.pm * BM + wr * 64 + fr, col0 = u.pn * BM + wc * 32 + 4 * fq;
#pragma unroll
        for (int ai = 0; ai < 2; ++ai)
#pragma unroll
            for (int m = 0; m < 4; ++m) { const size_t off = (size_t)(row0 + ai * HALF + m * 16) * 1024 + col0;
#pragma unroll
                for (int bj = 0; bj < 2; ++bj)
#pragma unroll
                    for (int n = 0; n < 2; ++n) *(f32x4*)(out + off + bj * HALF + n * 16) = *(const f32x4*)(x + off + bj * HALF + n * 16) + ((DBG_SKIP & 2) ? 0.f : 1.f) * acc[ai][bj][m][n]; }
    }
};
struct EpiSwiglu {
    static constexpr bool PERM = true;
    bf16_t* act; const float *bgate, *bup;
    __device__ __forceinline__ void operator()(const f32x4 (&acc)[2][2][4][2], const Unit& u, int wr, int wc, int fr, int fq) const {
        const int row0 = u.pm * BM + wr * 64 + fr, f0 = u.pn * HALF + wc * 32 + 8 * fq;
        f32x4 bgv[2], buv[2];
#pragma unroll
        for (int n = 0; n < 2; ++n) { bgv[n] = *(const f32x4*)(bgate + (size_t)u.e * FF + f0 + 4 * n); buv[n] = *(const f32x4*)(bup + (size_t)u.e * FF + f0 + 4 * n); }
#pragma unroll
        for (int ai = 0; ai < 2; ++ai)
#pragma unroll
            for (int m = 0; m < 4; ++m) { const int row = row0 + ai * HALF + m * 16; f32x4 o[2];
#pragma unroll
                for (int n = 0; n < 2; ++n) { const f32x4 gt = acc[ai][0][m][n] + bgv[n], up = acc[ai][1][m][n] + buv[n];
#pragma unroll
                    for (int j = 0; j < 4; ++j) { const float gg = fminf(gt[j], 7.0f), uu = fminf(fmaxf(up[j], -7.0f), 7.0f); o[n][j] = (uu + 1.0f) * (gg * sigmoidf_(1.702f * gg)); } }
                *(u32x4*)(act + (size_t)row * FF + f0) = pack8(o[0], o[1]); }
    }
};
struct EpiDown {
    static constexpr bool PERM = true;
    bf16_t* y; const float* bd;
    __device__ __forceinline__ void operator()(const f32x4 (&acc)[2][2][4][2], const Unit& u, int wr, int wc, int fr, int fq) const {
        const int row0 = u.pm * BM + wr * 64 + fr, cl = wc * 32 + 8 * fq;
        f32x4 bv[2][2];
#pragma unroll
        for (int bj = 0; bj < 2; ++bj) { const int col = u.pn * BM + bj * HALF + cl; bv[bj][0] = *(const f32x4*)(bd + (size_t)u.e * D + col); bv[bj][1] = *(const f32x4*)(bd + (size_t)u.e * D + col + 4); }
#pragma unroll
        for (int ai = 0; ai < 2; ++ai)
#pragma unroll
            for (int m = 0; m < 4; ++m) { const int row = row0 + ai * HALF + m * 16;
#pragma unroll
                for (int bj = 0; bj < 2; ++bj) { const int col = u.pn * BM + bj * HALF + cl;
                    *(u32x4*)(y + (size_t)row * D + col) = pack8(acc[ai][bj][m][0] + bv[bj][0], acc[ai][bj][m][1] + bv[bj][1]); } }
    }
};
}

namespace att {
constexpr int NW = 8, QBLK = 32, KVBLK = 64;
constexpr int SHM_V = KVBLK * 128 * 2;
#define SBAR() __builtin_amdgcn_sched_barrier(0)
#define KSW(row, colB) ((row) * 128 + ((colB) ^ ((((row) >> 1) & 7) << 4)))
__device__ __forceinline__ int crow(int r, int hi) { return (r & 3) + 8 * (r >> 2) + 4 * hi; }
struct Src { const bf16_t* Q; const bf16_t* K; const bf16_t* K2; const bf16_t* V; int ldq, ldk, ldk2, ldv; };

__device__ __forceinline__ void partialSM(f32x16& p0, f32x16& p1, float& m_reg, float& mn, float& alpha, const float C, const float thr) {
  float pmax;
  { float a0 = fmaxf(fmaxf(p0[0], p0[1]), p0[2]), a1 = fmaxf(fmaxf(p0[3], p0[4]), p0[5]), a2 = fmaxf(fmaxf(p1[0], p1[1]), p1[2]), a3 = fmaxf(fmaxf(p1[3], p1[4]), p1[5]);
#pragma unroll
    for (int r = 6; r < 16; r += 2) { a0 = fmaxf(fmaxf(a0, p0[r]), p0[r + 1]); a2 = fmaxf(fmaxf(a2, p1[r]), p1[r + 1]); }
    pmax = fmaxf(fmaxf(a0, a1), fmaxf(a2, a3)); }
  { auto rr = __builtin_amdgcn_permlane32_swap(__float_as_uint(pmax), __float_as_uint(pmax), false, false);
    pmax = fmaxf(__uint_as_float(rr[0]), __uint_as_float(rr[1])); }
  if (__builtin_expect(__all(pmax - m_reg <= thr), 1)) { mn = m_reg; alpha = 1.f; }
  else { mn = fmaxf(m_reg, pmax); alpha = __builtin_amdgcn_exp2f((m_reg - mn) * C); m_reg = mn; }
  const float mnC = -mn * C;
#pragma unroll
  for (int r = 0; r < 16; ++r) p0[r] = fmaf(p0[r], C, mnC);
#pragma unroll
  for (int r = 0; r < 16; ++r) p1[r] = fmaf(p1[r], C, mnC);
#pragma unroll
  for (int r = 0; r < 16; ++r) p0[r] = __builtin_amdgcn_exp2f(p0[r]);
#if ATT_DUP == 1
  { float d_[16];
#pragma unroll
    for (int r = 0; r < 16; ++r) { d_[r] = __builtin_amdgcn_exp2f(p1[r]); d_[r] = fmaf(d_[r], C, mnC); }
#pragma unroll
    for (int r = 0; r < 16; ++r) asm volatile("" :: "v"(d_[r])); }
#endif
}
__device__ __forceinline__ void finishSM(f32x16& p0, f32x16& p1, float alpha, float& l_reg, bf16x8& pa0, bf16x8& pa1, bf16x8& pa2, bf16x8& pa3) {
#pragma unroll
  for (int r = 0; r < 16; ++r) p1[r] = __builtin_amdgcn_exp2f(p1[r]);
  float ps;
  { float s0 = p0[0] + p0[1], s1 = p0[2] + p0[3], s2 = p1[0] + p1[1], s3 = p1[2] + p1[3];
#pragma unroll
    for (int r = 4; r < 16; r += 4) { s0 += p0[r] + p0[r + 1]; s1 += p0[r + 2] + p0[r + 3]; s2 += p1[r] + p1[r + 1]; s3 += p1[r + 2] + p1[r + 3]; }
    ps = (s0 + s1) + (s2 + s3); }
  { auto rr = __builtin_amdgcn_permlane32_swap(__float_as_uint(ps), __float_as_uint(ps), false, false);
    ps = __uint_as_float(rr[0]) + __uint_as_float(rr[1]); }
  l_reg = l_reg * alpha + ps;
#define PK4(P, BASE, OUT) do { unsigned a0 = cvt_pk_bf16(P[BASE + 0], P[BASE + 1]), a1 = cvt_pk_bf16(P[BASE + 2], P[BASE + 3]);   \
    unsigned b0 = cvt_pk_bf16(P[BASE + 4], P[BASE + 5]), b1 = cvt_pk_bf16(P[BASE + 6], P[BASE + 7]);                              \
    auto r0 = __builtin_amdgcn_permlane32_swap(a0, b0, false, false); auto r1 = __builtin_amdgcn_permlane32_swap(a1, b1, false, false); \
    u32x4 w = {r0[0], r1[0], r0[1], r1[1]}; OUT = *reinterpret_cast<bf16x8*>(&w); } while (0)
  PK4(p0, 0, pa0); PK4(p0, 8, pa1); PK4(p1, 0, pa2); PK4(p1, 8, pa3);
#undef PK4
}
template <int DQK> __device__ __forceinline__ void qkt(f32x16& p0, f32x16& p1, const LAS char* Ks, const bf16x8* qr, int r32, int hi) {
  p0 = f32x16{}; p1 = f32x16{};
#pragma unroll
  for (int d0 = 0; d0 < DQK / 16; ++d0) { const int sub = d0 >> 2, cb = ((d0 & 3) * 16 + hi * 8) * 2;
    const bf16x8 b0 = *(const LAS bf16x8*)(Ks + sub * 8192 + KSW(r32, cb));
    const bf16x8 b1 = *(const LAS bf16x8*)(Ks + sub * 8192 + KSW(32 + r32, cb));
    p0 = __builtin_amdgcn_mfma_f32_32x32x16_bf16(b0, qr[d0], p0, 0, 0, 0);
    p1 = __builtin_amdgcn_mfma_f32_32x32x16_bf16(b1, qr[d0], p1, 0, 0, 0); }
#if ATT_DUP == 2
  if constexpr (DQK == 64) { bf16x8 zq = {0, 0, 0, 0, 0, 0, 0, 0}; asm volatile("" : "+v"(zq));
    const bf16x8 bz = *(const LAS bf16x8*)(Ks + KSW(r32, hi * 16));
#pragma unroll
    for (int d0 = 0; d0 < 2; ++d0) { p0 = __builtin_amdgcn_mfma_f32_32x32x16_bf16(bz, zq, p0, 0, 0, 0); p1 = __builtin_amdgcn_mfma_f32_32x32x16_bf16(bz, zq, p1, 0, 0, 0); } }
#endif
}
__device__ __forceinline__ int v_st(int k, int c) { const int kk = (k & ~0xC) | ((k & 4) << 1) | ((k & 8) >> 1); return ((kk >> 3) * 4 + (c >> 5)) * 512 + ((kk & 7) * 32 + (c & 31)) * 2; }
__device__ __forceinline__ int v_rd_base(int lane) { return ((lane & 3) << 3) | (((lane >> 2) & 3) << 6) | (((lane >> 4) & 1) << 5) | (((lane >> 5) & 1) << 8); }
constexpr int v_rd_off(int d0, int ks, int half) { return d0 * 512 + ks * 4096 + half * 2048; }
template <int OFF> __device__ __forceinline__ s16x4 tr_read(int vb) {
  s16x4 r; asm volatile("ds_read_b64_tr_b16 %0, %1 offset:%2" : "=&v"(r) : "v"(vb), "i"(OFF) : "memory"); return r;
}
template <int KS> __device__ __forceinline__ void pv_step(f32x16* o, int vb, bf16x8 pa) {
  s16x4 l0, h0, l1, h1, l2, h2, l3, h3;
  l0 = tr_read<v_rd_off(0, KS, 0)>(vb); h0 = tr_read<v_rd_off(0, KS, 1)>(vb); l1 = tr_read<v_rd_off(1, KS, 0)>(vb); h1 = tr_read<v_rd_off(1, KS, 1)>(vb);
  l2 = tr_read<v_rd_off(2, KS, 0)>(vb); h2 = tr_read<v_rd_off(2, KS, 1)>(vb); l3 = tr_read<v_rd_off(3, KS, 0)>(vb); h3 = tr_read<v_rd_off(3, KS, 1)>(vb);
  asm volatile("s_waitcnt lgkmcnt(0)" ::: "memory"); SBAR();
#define PK(L, H) (bf16x8){L[0], L[1], L[2], L[3], H[0], H[1], H[2], H[3]}
  o[0] = __builtin_amdgcn_mfma_f32_32x32x16_bf16(pa, PK(l0, h0), o[0], 0, 0, 0);
  o[1] = __builtin_amdgcn_mfma_f32_32x32x16_bf16(pa, PK(l1, h1), o[1], 0, 0, 0);
  o[2] = __builtin_amdgcn_mfma_f32_32x32x16_bf16(pa, PK(l2, h2), o[2], 0, 0, 0);
  o[3] = __builtin_amdgcn_mfma_f32_32x32x16_bf16(pa, PK(l3, h3), o[3], 0, 0, 0);
#undef PK
}
__device__ __forceinline__ void pv_d0(f32x16* o, int vb, bf16x8 pa0, bf16x8 pa1, bf16x8 pa2, bf16x8 pa3) {
  pv_step<0>(o, vb, pa0); pv_step<1>(o, vb, pa1); pv_step<2>(o, vb, pa2); pv_step<3>(o, vb, pa3);
}
template <int DQK>
__device__ __forceinline__ void attn_core(const Src in, const float C, const float thr, const int seq, LAS char* lds, f32x16 (&o)[4]) {
  constexpr int NSUB = DQK / 64, SHM_K = NSUB * 8192;
  int lane; asm volatile("v_and_b32 %0, 63, %1" : "=v"(lane) : "v"(threadIdx.x));
  const int tid = threadIdx.x, wid = __builtin_amdgcn_readfirstlane(tid >> 6), r32 = lane & 31, hi = (lane >> 5) & 1;
  LAS char* V_lds = lds; LAS char* K_lds = lds + 3 * SHM_V;
  LAS float* ws = (LAS float*)(lds + 3 * SHM_V + 3 * SHM_K) + wid * 64; LAS float* li_l = ws; LAS float* al_l = ws + 32;
  float m_reg = -1e30f, l_reg = 0;
#pragma unroll
  for (int d = 0; d < 4; ++d) o[d] = f32x16{};
  bf16x8 qr[DQK / 16];
  const bf16_t* Qw = in.Q + (size_t)(wid * QBLK + r32) * in.ldq + hi * 8;
#pragma unroll
  for (int d0 = 0; d0 < DQK / 16; ++d0) qr[d0] = *(const bf16x8*)(Qw + d0 * 16);
  const int krow = wid * 8 + (lane >> 3), kslot = (lane & 7) ^ ((krow >> 1) & 7);
  const unsigned koff = (unsigned)(krow * in.ldk + kslot * 8) * 2u, k2off = (unsigned)(krow * in.ldk2 + kslot * 8) * 2u;
  unsigned voff[2];
#pragma unroll
  for (int i = 0; i < 2; ++i) { const int p = i * 8192 + wid * 1024 + lane * 16, st = p >> 9, wq = (p & 511) >> 1, kk = (st >> 2) * 8 + (wq >> 5), cl = wq & 31;
    const int k = (kk & ~0xC) | ((kk & 4) << 1) | ((kk & 8) >> 1); voff[i] = (unsigned)(k * in.ldv + (st & 3) * 32 + cl) * 2u; }
  const int vb0 = (int)(unsigned)(size_t)V_lds + v_rd_base(lane);
  const unsigned ldsw = (unsigned)wid * 1024u;
#define GLDS(gp, lp) __builtin_amdgcn_global_load_lds((const unsigned*)(gp), (LAS unsigned*)(lp), 16, 0, 0)
#define ISSUE_K(t, b) do { const char* kb_ = (const char*)in.K + (size_t)(t) * (KVBLK * 2) * in.ldk; \
    _Pragma("unroll") for (int s_ = 0; s_ < NSUB; ++s_) { if (s_ < 2) GLDS(kb_ + s_ * 128 + koff, K_lds + (b) * SHM_K + s_ * 8192 + ldsw); \
      else GLDS((const char*)in.K2 + (size_t)(t) * (KVBLK * 2) * in.ldk2 + k2off, K_lds + (b) * SHM_K + s_ * 8192 + ldsw); } } while (0)
#define ISSUE_V(t, b) do { const char* vb_ = (const char*)in.V + (size_t)(t) * (KVBLK * 2) * in.ldv; \
    GLDS(vb_ + voff[0], V_lds + (b) * SHM_V + ldsw); GLDS(vb_ + voff[1], V_lds + (b) * SHM_V + 8192 + ldsw); \
    if (ATT_DUP == 3) { GLDS(vb_ + voff[0], V_lds + (b) * SHM_V + ldsw); GLDS(vb_ + voff[1], V_lds + (b) * SHM_V + 8192 + ldsw); } } while (0)
#define WAITV(n) asm volatile("s_waitcnt vmcnt(%0)" :: "n"((DBG_SKIP & 4) ? 0 : (n)) : "memory")
#define WBAR() do { asm volatile("" ::: "memory"); __builtin_amdgcn_s_barrier(); asm volatile("" ::: "memory"); } while (0)
#define RESC(a) do { if (__any((a) < 1.f)) { if (hi == 0) al_l[r32] = (a); asm volatile("s_waitcnt lgkmcnt(0)" ::: "memory"); \
    _Pragma("unroll") for (int d = 0; d < 4; ++d) _Pragma("unroll") for (int r = 0; r < 16; ++r) o[d][r] *= al_l[crow(r, hi)]; } } while (0)
#define NXT3(x) ((x) == 2 ? 0 : (x) + 1)
  constexpr int NI = NSUB + (ATT_DUP == 3 ? 4 : 2), NV = (ATT_DUP == 3 ? 4 : 2);
  f32x16 pA0, pA1, pB0, pB1; float mnA, mnB, alA, alB; bf16x8 pa0, pa1, pa2, pa3; const int NT = seq / KVBLK;
  const bool lead = wid < 4;
  ISSUE_K(0, 0); ISSUE_K(1, 1); ISSUE_V(0, 0);
  if (!lead) { WAITV(NI); WBAR(); }
  WAITV(NI); WBAR();
  ISSUE_K(2, 2);
  qkt<DQK>(pA0, pA1, K_lds, qr, r32, hi);
  WAITV(NI); WBAR();
  ISSUE_V(1, 1);
  partialSM(pA0, pA1, m_reg, mnA, alA, C, thr);
  WAITV(NI); WBAR();
  int bq = 1;
  for (int j = 1; j + 3 < NT; j += 2) {
    { const int b1 = NXT3(bq), b2 = NXT3(b1);
      ISSUE_K(j + 2, b2);
      SBAR(); qkt<DQK>(pB0, pB1, K_lds + bq * SHM_K, qr, r32, hi);
      finishSM(pA0, pA1, alA, l_reg, pa0, pa1, pa2, pa3); SBAR();
      WAITV(NI); WBAR();
      ISSUE_V(j + 1, b1);
      pv_d0(o, vb0 + b2 * SHM_V, pa0, pa1, pa2, pa3); partialSM(pB0, pB1, m_reg, mnB, alB, C, thr);
      RESC(alB); bq = b1;
      WAITV(NI); WBAR(); }
    { const int b1 = NXT3(bq), b2 = NXT3(b1);
      ISSUE_K(j + 3, b2);
      SBAR(); qkt<DQK>(pA0, pA1, K_lds + bq * SHM_K, qr, r32, hi);
      finishSM(pB0, pB1, alB, l_reg, pa0, pa1, pa2, pa3); SBAR();
      WAITV(NI); WBAR();
      ISSUE_V(j + 2, b1);
      pv_d0(o, vb0 + b2 * SHM_V, pa0, pa1, pa2, pa3); partialSM(pA0, pA1, m_reg, mnA, alA, C, thr);
      RESC(alA); bq = b1;
      WAITV(NI); WBAR(); }
  }
  { const int b1 = NXT3(bq), b2 = NXT3(b1);
    ISSUE_K(NT - 1, b2);
    SBAR(); qkt<DQK>(pB0, pB1, K_lds + bq * SHM_K, qr, r32, hi);
    finishSM(pA0, pA1, alA, l_reg, pa0, pa1, pa2, pa3); SBAR();
    WAITV(NI); WBAR();
    ISSUE_V(NT - 2, b1);
    pv_d0(o, vb0 + b2 * SHM_V, pa0, pa1, pa2, pa3); partialSM(pB0, pB1, m_reg, mnB, alB, C, thr);
    RESC(alB); bq = b1;
    WAITV(NI); WBAR(); }
  { const int b1 = NXT3(bq), b2 = NXT3(b1);
    SBAR(); qkt<DQK>(pA0, pA1, K_lds + bq * SHM_K, qr, r32, hi);
    finishSM(pB0, pB1, alB, l_reg, pa0, pa1, pa2, pa3); SBAR();
    WAITV(NV); WBAR();
    ISSUE_V(NT - 1, b1);
    pv_d0(o, vb0 + b2 * SHM_V, pa0, pa1, pa2, pa3); partialSM(pA0, pA1, m_reg, mnA, alA, C, thr);
    RESC(alA); bq = b1;
    WAITV(NV); WBAR(); }
  { const int b2 = NXT3(NXT3(bq));
    SBAR(); qkt<DQK>(pB0, pB1, K_lds + bq * SHM_K, qr, r32, hi);
    finishSM(pA0, pA1, alA, l_reg, pa0, pa1, pa2, pa3); SBAR();
    WAITV(0); WBAR();
    pv_d0(o, vb0 + b2 * SHM_V, pa0, pa1, pa2, pa3); partialSM(pB0, pB1, m_reg, mnB, alB, C, thr);
    RESC(alB);
    WBAR(); }
  finishSM(pB0, pB1, alB, l_reg, pa0, pa1, pa2, pa3); SBAR();
  pv_d0(o, vb0 + bq * SHM_V, pa0, pa1, pa2, pa3);
  if (lead) { WBAR(); }
  if (hi == 0) li_l[r32] = l_reg; asm volatile("s_waitcnt lgkmcnt(0)" ::: "memory");
#pragma unroll
  for (int r = 0; r < 16; ++r) { const float rl = __builtin_amdgcn_rcpf(li_l[crow(r, hi)]);
#pragma unroll
    for (int d = 0; d < 4; ++d) o[d][r] *= rl; }
  asm volatile("s_waitcnt lgkmcnt(0)" ::: "memory"); WBAR();
#undef GLDS
#undef ISSUE_K
#undef ISSUE_V
#undef WAITV
#undef WBAR
#undef RESC
#undef NXT3
}
template <int DQK>
__device__ __forceinline__ void attn_core_seq(const Src in, const float C, const float thr, const int seq, LAS char* lds, f32x16 (&o)[4]) {
  constexpr int NSUB = DQK / 64, SHM_K = NSUB * 8192;
  const int tid = threadIdx.x, wid = __builtin_amdgcn_readfirstlane(tid >> 6), lane = tid & 63, r32 = lane & 31, hi = lane >> 5;
  LAS char* V_lds = lds; LAS char* K_lds = lds + 3 * SHM_V;
  LAS float* ws = (LAS float*)(lds + 3 * SHM_V + 3 * SHM_K) + wid * 64; LAS float* li_l = ws; LAS float* al_l = ws + 32;
  float m_reg = -1e30f, l_reg = 0;
#pragma unroll
  for (int d = 0; d < 4; ++d) o[d] = f32x16{};
  bf16x8 qr[DQK / 16];
  const bf16_t* Qw = in.Q + (size_t)(wid * QBLK + r32) * in.ldq + hi * 8;
#pragma unroll
  for (int d0 = 0; d0 < DQK / 16; ++d0) qr[d0] = *(const bf16x8*)(Qw + d0 * 16);
  const int krow = wid * 8 + (lane >> 3), kslot = (lane & 7) ^ ((krow >> 1) & 7);
  const unsigned koff = (unsigned)(krow * in.ldk + kslot * 8) * 2u, k2off = (unsigned)(krow * in.ldk2 + kslot * 8) * 2u;
  unsigned voff[2];
#pragma unroll
  for (int i = 0; i < 2; ++i) { const int p = i * 8192 + wid * 1024 + lane * 16, st = p >> 9, wq = (p & 511) >> 1, kk = (st >> 2) * 8 + (wq >> 5), cl = wq & 31;
    const int k = (kk & ~0xC) | ((kk & 4) << 1) | ((kk & 8) >> 1); voff[i] = (unsigned)(k * in.ldv + (st & 3) * 32 + cl) * 2u; }
  const int vb0 = (int)(unsigned)(size_t)V_lds + v_rd_base(lane);
  const unsigned ldsw = (unsigned)wid * 1024u;
#define GLDS(gp, lp) __builtin_amdgcn_global_load_lds((const unsigned*)(gp), (LAS unsigned*)(lp), 16, 0, 0)
#define ISSUE_K(t, b) do { const char* kb_ = (const char*)in.K + (size_t)(t) * (KVBLK * 2) * in.ldk; \
    _Pragma("unroll") for (int s_ = 0; s_ < NSUB; ++s_) { if (s_ < 2) GLDS(kb_ + s_ * 128 + koff, K_lds + (b) * SHM_K + s_ * 8192 + ldsw); \
      else GLDS((const char*)in.K2 + (size_t)(t) * (KVBLK * 2) * in.ldk2 + k2off, K_lds + (b) * SHM_K + s_ * 8192 + ldsw); } } while (0)
#define ISSUE_V(t, b) do { const char* vb_ = (const char*)in.V + (size_t)(t) * (KVBLK * 2) * in.ldv; \
    GLDS(vb_ + voff[0], V_lds + (b) * SHM_V + ldsw); GLDS(vb_ + voff[1], V_lds + (b) * SHM_V + 8192 + ldsw); } while (0)
#define WAITV(n) asm volatile("s_waitcnt vmcnt(%0)" :: "n"(n) : "memory")
#define WBAR() do { asm volatile("" ::: "memory"); __builtin_amdgcn_s_barrier(); asm volatile("" ::: "memory"); } while (0)
#define RESC(a) do { if (__any((a) < 1.f)) { if (hi == 0) al_l[r32] = (a); asm volatile("s_waitcnt lgkmcnt(0)" ::: "memory"); \
    _Pragma("unroll") for (int d = 0; d < 4; ++d) _Pragma("unroll") for (int r = 0; r < 16; ++r) o[d][r] *= al_l[crow(r, hi)]; } } while (0)
#define NXT3(x) ((x) == 2 ? 0 : (x) + 1)
  constexpr int NI = NSUB + 2;
  f32x16 p0, p1; float mn, al; bf16x8 pa0, pa1, pa2, pa3; const int NT = seq / KVBLK;
  ISSUE_K(0, 0); ISSUE_V(0, 0); ISSUE_K(1, 1); ISSUE_V(1, 1);
  int bq = 0;
  for (int j = 0; j + 1 < NT; ++j) {
    const int b1 = NXT3(bq), b2 = NXT3(b1);
    WAITV(NI); WBAR();
    if (j + 2 < NT) { ISSUE_K(j + 2, b2); ISSUE_V(j + 2, b2); }
    else { ISSUE_K(NT - 1, b2); ISSUE_V(NT - 1, b2); }
    qkt<DQK>(p0, p1, K_lds + bq * SHM_K, qr, r32, hi); partialSM(p0, p1, m_reg, mn, al, C, thr);
    RESC(al);
    finishSM(p0, p1, al, l_reg, pa0, pa1, pa2, pa3); SBAR();
    pv_d0(o, vb0 + bq * SHM_V, pa0, pa1, pa2, pa3);
    bq = b1;
  }
  WAITV(NI); WBAR();
  qkt<DQK>(p0, p1, K_lds + bq * SHM_K, qr, r32, hi); partialSM(p0, p1, m_reg, mn, al, C, thr);
  RESC(al);
  finishSM(p0, p1, al, l_reg, pa0, pa1, pa2, pa3); SBAR();
  pv_d0(o, vb0 + bq * SHM_V, pa0, pa1, pa2, pa3);
  WAITV(0);
  if (hi == 0) li_l[r32] = l_reg; asm volatile("s_waitcnt lgkmcnt(0)" ::: "memory");
#pragma unroll
  for (int r = 0; r < 16; ++r) { const float rl = __builtin_amdgcn_rcpf(li_l[crow(r, hi)]);
#pragma unroll
    for (int d = 0; d < 4; ++d) o[d][r] *= rl; }
  asm volatile("s_waitcnt lgkmcnt(0)" ::: "memory"); WBAR();
#undef GLDS
#undef ISSUE_K
#undef ISSUE_V
#undef WAITV
#undef WBAR
#undef RESC
#undef NXT3
}
__device__ __forceinline__ void attn_core_da2(const Src in, const float C, const float thr, const int seq, LAS char* lds, f32x16 (&o1)[4], f32x16 (&o2)[4]) {
  constexpr int NSUB = 2, SHM_K = NSUB * 8192;
  const int tid = threadIdx.x, wid = __builtin_amdgcn_readfirstlane(tid >> 6), lane = tid & 63, r32 = lane & 31, hi = lane >> 5;
  LAS char* V_lds = lds; LAS char* K_lds = lds + 3 * SHM_V;
  LAS float* ws = (LAS float*)(lds + 3 * SHM_V + 3 * SHM_K) + wid * 64; LAS float* li_l = ws; LAS float* al_l = ws + 32;
  float m1 = -1e30f, l1 = 0, m2 = -1e30f, l2 = 0;
#pragma unroll
  for (int d = 0; d < 4; ++d) { o1[d] = f32x16{}; o2[d] = f32x16{}; }
  bf16x8 q1[4], q2[4];
  const bf16_t* Qw = in.Q + (size_t)(wid * QBLK + r32) * in.ldq + hi * 8;
#pragma unroll
  for (int d0 = 0; d0 < 4; ++d0) { q1[d0] = *(const bf16x8*)(Qw + d0 * 16); q2[d0] = *(const bf16x8*)(Qw + 64 + d0 * 16); }
  const int krow = wid * 8 + (lane >> 3), kslot = (lane & 7) ^ ((krow >> 1) & 7);
  const unsigned koff = (unsigned)(krow * in.ldk + kslot * 8) * 2u;
  unsigned voff[2];
#pragma unroll
  for (int i = 0; i < 2; ++i) { const int p = i * 8192 + wid * 1024 + lane * 16, st = p >> 9, wq = (p & 511) >> 1, kk = (st >> 2) * 8 + (wq >> 5), cl = wq & 31;
    const int k = (kk & ~0xC) | ((kk & 4) << 1) | ((kk & 8) >> 1); voff[i] = (unsigned)(k * in.ldv + (st & 3) * 32 + cl) * 2u; }
  const int vb0 = (int)(unsigned)(size_t)V_lds + v_rd_base(lane);
  const unsigned ldsw = (unsigned)wid * 1024u;
#define GLDS(gp, lp) __builtin_amdgcn_global_load_lds((const unsigned*)(gp), (LAS unsigned*)(lp), 16, 0, 0)
#define ISSUE_KV(t, b) do { const char* kb_ = (const char*)in.K + (size_t)(t) * (KVBLK * 2) * in.ldk; const char* vb_ = (const char*)in.V + (size_t)(t) * (KVBLK * 2) * in.ldv; \
    GLDS(kb_ + koff, K_lds + (b) * SHM_K + ldsw); GLDS(kb_ + 128 + koff, K_lds + (b) * SHM_K + 8192 + ldsw); \
    GLDS(vb_ + voff[0], V_lds + (b) * SHM_V + ldsw); GLDS(vb_ + voff[1], V_lds + (b) * SHM_V + 8192 + ldsw); } while (0)
#define WAITV(n) asm volatile("s_waitcnt vmcnt(%0)" :: "n"(n) : "memory")
#define WBAR() do { asm volatile("" ::: "memory"); __builtin_amdgcn_s_barrier(); asm volatile("" ::: "memory"); } while (0)
#define RESC(oo, a) do { if (__any((a) < 1.f)) { if (hi == 0) al_l[r32] = (a); asm volatile("s_waitcnt lgkmcnt(0)" ::: "memory"); \
    _Pragma("unroll") for (int d = 0; d < 4; ++d) _Pragma("unroll") for (int r = 0; r < 16; ++r) oo[d][r] *= al_l[crow(r, hi)]; asm volatile("s_waitcnt lgkmcnt(0)" ::: "memory"); } } while (0)
#define NXT3(x) ((x) == 2 ? 0 : (x) + 1)
#define TILE_BODY(b) do { f32x16 p0, p1; float mn, al; bf16x8 pa0, pa1, pa2, pa3; \
    qkt<64>(p0, p1, K_lds + (b) * SHM_K, q1, r32, hi); partialSM(p0, p1, m1, mn, al, C, thr); RESC(o1, al); \
    finishSM(p0, p1, al, l1, pa0, pa1, pa2, pa3); SBAR(); pv_d0(o1, vb0 + (b) * SHM_V, pa0, pa1, pa2, pa3); SBAR(); \
    qkt<64>(p0, p1, K_lds + (b) * SHM_K + 8192, q2, r32, hi); partialSM(p0, p1, m2, mn, al, C, thr); RESC(o2, al); \
    finishSM(p0, p1, al, l2, pa0, pa1, pa2, pa3); SBAR(); pv_d0(o2, vb0 + (b) * SHM_V, pa0, pa1, pa2, pa3); SBAR(); } while (0)
  const int NT = seq / KVBLK;
  ISSUE_KV(0, 0); ISSUE_KV(1, 1);
  int bq = 0;
  for (int j = 0; j + 1 < NT; ++j) {
    const int b1 = NXT3(bq), b2 = NXT3(b1);
    WAITV(4); WBAR();
    if (j + 2 < NT) ISSUE_KV(j + 2, b2); else ISSUE_KV(NT - 1, b2);
    TILE_BODY(bq);
    bq = b1;
  }
  WAITV(4); WBAR();
  TILE_BODY(bq);
  WAITV(0);
  if (hi == 0) { li_l[r32] = l1; al_l[r32] = l2; } asm volatile("s_waitcnt lgkmcnt(0)" ::: "memory");
#pragma unroll
  for (int r = 0; r < 16; ++r) { const float ra = __builtin_amdgcn_rcpf(li_l[crow(r, hi)]), rb = __builtin_amdgcn_rcpf(al_l[crow(r, hi)]);
#pragma unroll
    for (int d = 0; d < 4; ++d) { o1[d][r] *= ra; o2[d][r] *= rb; } }
  asm volatile("s_waitcnt lgkmcnt(0)" ::: "memory"); WBAR();
#undef GLDS
#undef ISSUE_KV
#undef WAITV
#undef WBAR
#undef RESC
#undef NXT3
#undef TILE_BODY
}
}

constexpr int NWAVES = 8;
struct Args { const void* in[27]; float* out; unsigned char* ws; int ph_lo, ph_hi, li, pad; };

__constant__ float c_invA[8] = {1.0f, 0.19392274474868576f, 0.03760603093086393f, 0.007292664737217109f, 0.001414213562373095f, 0.0002742481756762073f, 5.318295896944988e-05f, 1.031338537721246e-05f};
__constant__ float c_invM[32] = {1.0f, 0.6636012376960885f, 0.44036660267178046f, 0.2922278225730151f, 0.19392274474868576f, 0.12868737343265052f, 0.08539710028576561f, 0.05666962144529105f,
    0.03760603093086393f, 0.024955408670558694f, 0.016560440080994446f, 0.010989528534539826f, 0.007292664737217109f, 0.004839421345719893f, 0.003211445994752591f, 0.0021311195369119653f,
    0.001414213562373095f, 0.0009384738703573802f, 0.000622772421914596f, 0.0004132725499855165f, 0.0002742481756762073f, 0.00018199142881462546f, 0.00012076973741146504f, 8.01429472224798e-05f,
    5.318295896944988e-05f, 3.529227739646723e-05f, 2.341999896140934e-05f, 1.5541540297632344e-05f, 1.031338537721246e-05f, 6.8439753011549275e-06f, 4.5416704806078695e-06f, 3.013858152139171e-06f};

__device__ __forceinline__ int permDA(int i) { return i < 16 ? (i >> 1) + 8 * (i & 1) : i; }
__device__ __forceinline__ int permM(int i) { return (i >> 1) + 32 * (i & 1); }
__device__ __forceinline__ int src_in(int j) {
    if (j < 2048) return (j & ~63) + permDA(j & 63);
    if (j < 4352) return j;
    if (j < 6400) return 4416 + (j - 4352);
    if (j < 6464) return 4352 + permM(j - 6400);
    return -1;
}
__device__ __forceinline__ int src_uq(int j) { const int hd = j / 192, off = j % 192; return off < 128 ? j : hd * 192 + 128 + permM(off - 128); }

__device__ __forceinline__ void tr_item(const float* W, int K, int N, bf16_t* WT, int n0, int k0, int scol, const float* rs, LAS float* scr, int lane) {
#pragma unroll 8
    for (int i = 0; i < 32; ++i) { const int kk = 2 * i + (lane >> 5); float v = 0.f; if (scol >= 0) { v = W[(size_t)(k0 + kk) * N + scol]; if (rs) v *= rs[k0 + kk]; } scr[kk * 33 + (lane & 31)] = v; }
    LDS_WAIT(); asm volatile("" ::: "memory");
    const int c = lane & 7;
#pragma unroll
    for (int j = 0; j < 4; ++j) { const int n = (lane >> 3) + 8 * j; const LAS float* s = scr + (8 * c) * 33 + n;
        u32x4 o; o.x = cvt_pk_bf16(s[0 * 33], s[1 * 33]); o.y = cvt_pk_bf16(s[2 * 33], s[3 * 33]); o.z = cvt_pk_bf16(s[4 * 33], s[5 * 33]); o.w = cvt_pk_bf16(s[6 * 33], s[7 * 33]);
        *(u32x4*)(WT + (size_t)(n0 + n) * K + k0 + 8 * c) = o; }
    LDS_WAIT(); asm volatile("" ::: "memory");
}

template <int MODE = 0>
__device__ __forceinline__ void cvt_tile64(const float* W, int N, bf16_t* WT, int Kd, int k0, int n0, int drow0, int lane, const float* rs = nullptr) {
    const int g = lane >> 4, x = lane & 15;
    const float* src = W + (size_t)(k0 + 16 * g) * N + n0 + 4 * x;
    f32x4 v[16];
#pragma unroll
    for (int i = 0; i < 16; ++i) v[i] = __builtin_nontemporal_load((const f32x4*)(src + (size_t)i * N));
    if (rs) {
#pragma unroll
        for (int i = 0; i < 16; ++i) v[i] = v[i] * rs[k0 + 16 * g + i];
    }
#pragma unroll
    for (int j = 0; j < 4; ++j) { u32x4 lo, hi;
        lo.x = cvt_pk_bf16(v[0][j], v[1][j]); lo.y = cvt_pk_bf16(v[2][j], v[3][j]); lo.z = cvt_pk_bf16(v[4][j], v[5][j]); lo.w = cvt_pk_bf16(v[6][j], v[7][j]);
        hi.x = cvt_pk_bf16(v[8][j], v[9][j]); hi.y = cvt_pk_bf16(v[10][j], v[11][j]); hi.z = cvt_pk_bf16(v[12][j], v[13][j]); hi.w = cvt_pk_bf16(v[14][j], v[15][j]);
        const int c = 4 * x + j;
        const int dr = MODE == 1 ? 2 * (c & 31) + (c >> 5) : (MODE == 2 ? (c < 16 ? 2 * (c & 7) + (c >> 3) : c) : c);
        bf16_t* d = WT + (size_t)(drow0 + dr) * Kd + k0 + 16 * g;
        *(u32x4*)d = lo; *(u32x4*)(d + 8) = hi; }
}

__global__ void __launch_bounds__(NWAVES * 64, 2) fwd(Args args) {
#define KARGS() const __attribute__((address_space(4))) unsigned long long* ka_ = (const __attribute__((address_space(4))) unsigned long long*)__builtin_amdgcn_kernarg_segment_ptr(); asm volatile("" : "+s"(ka_))
#define AIN(i) ((const void*)ka_[i])
#define AOUT ((float*)ka_[27])
#define AWS ((unsigned char*)ka_[28])
    extern __shared__ __attribute__((aligned(16))) unsigned char lds_raw[];
    LAS unsigned char* lds = (LAS unsigned char*)lds_raw;
    volatile LAS unsigned* MISC = (volatile LAS unsigned*)(lds + MISC_OFF);
    const int tid = threadIdx.x, wave = __builtin_amdgcn_readfirstlane(tid >> 6);
#define LANE_DECL int lane; asm volatile("v_and_b32 %0, 63, %1" : "=v"(lane) : "v"(threadIdx.x))
    const int G = gridDim.x, bx = blockIdx.x;
    unsigned* ctl = (unsigned*)(args.ws + WS_CTL);
    const int lo = args.ph_lo, hi_ph = args.ph_hi;
    if (tid < 32) MISC[tid] = 0u;
    __syncthreads();
    XcdBarrier bar; bar.bar = ctl + CW_BAR + args.li * XCD_BAR_WORDS; bar.x = 0; bar.st = nullptr;
    if (!MK_PER_PHASE) bar = xcd_barrier_post(ctl + CW_BAR + args.li * XCD_BAR_WORDS, MISC + 8);
#define IN(k) (((PH_MASK >> (k)) & 1) && lo <= (k) && (k) < hi_ph)
#define SEAM(k) do { if (IN(k) && IN((k) + 1)) xcd_barrier(bar); } while (0)
    const int gw = bx * NWAVES + wave, NGW = G * NWAVES;

#define xin ((const float*)AIN(0))
#define positions ((const int*)AIN(1))
#define Bt_in ((bf16_t*)(AWS + WS_BT_IN))
#define Bt_uq ((bf16_t*)(AWS + WS_BT_UQ))
#define Bt_ukv ((bf16_t*)(AWS + WS_BT_UKV))
#define Bt_od ((bf16_t*)(AWS + WS_BT_OD))
#define Bt_om ((bf16_t*)(AWS + WS_BT_OM))
#define Bt_out ((bf16_t*)(AWS + WS_BT_OUT))
#define ropeA ((float*)(AWS + WS_ROPEA))
#define ropeM ((float*)(AWS + WS_ROPEM))
#define sq ((float*)(AWS + WS_SQ2))
#define hbuf ((bf16_t*)(AWS + WS_H))
#define oa ((bf16_t*)(AWS + WS_H))
#define qa ((bf16_t*)(AWS + WS_QA))
#define ka ((bf16_t*)(AWS + WS_KA))
#define va ((bf16_t*)(AWS + WS_VA))
#define cq ((bf16_t*)(AWS + WS_CQ))
#define ckv ((bf16_t*)(AWS + WS_CKV))
#define kr ((bf16_t*)(AWS + WS_KR))
#define gates ((bf16_t*)(AWS + WS_GATES))
#define qm ((bf16_t*)(AWS + WS_QM))
#define kv ((bf16_t*)(AWS + WS_KV))
#define ob ((bf16_t*)(AWS + WS_OB))
#define mrg ((bf16_t*)(AWS + WS_MRG))
#define stash ((float*)(AWS + WS_STASH))
#define rowtok_p ((int*)(AWS + WS_ROWTOK))
#define assign ((u32x2*)(AWS + WS_ASSIGN))
#define Bt_d ((bf16_t*)(AWS + WS_BT_D))
#define Bt_gu ((bf16_t*)(AWS + WS_BT_GU))
#define h2 ((bf16_t*)(AWS + WS_H2))
#define act ((bf16_t*)(AWS + WS_ACT))
#define ybuf ((bf16_t*)(AWS + WS_Y))
#define count ((unsigned*)(AWS + WS_CTL) + CW_COUNT)

    if (IN(0)) {
        KARGS();
        LANE_DECL;
        const float* w_in = (const float*)AIN(3); const float* g_q = (const float*)AIN(9); const float* g_kv = (const float*)AIN(10);
        const float* w_uq = (const float*)AIN(11); const float* w_ukv = (const float*)AIN(12);
        const float* w_od = (const float*)AIN(13); const float* w_om = (const float*)AIN(14); const float* w_out = (const float*)AIN(16);
        constexpr int I_IN = 16 * 101, I_PAD = 16 * 3, I_UQ = 12 * 24, I_UKV = 8 * 32, I_O = 16 * 16;
        constexpr int NITEMS = I_IN + I_PAD + I_UQ + I_UKV + 3 * I_O;
        for (int it = gw; it < NITEMS; it += NGW) {
            int r = it;
            if (r < I_IN) { const int kb = r / 101, cb = r % 101, n0 = cb * 64;
                if (n0 < 2048) cvt_tile64<2>(w_in, 6464, Bt_in, D, kb * 64, n0, n0, lane);
                else if (n0 < 4352) cvt_tile64<0>(w_in, 6464, Bt_in, D, kb * 64, n0, n0, lane);
                else if (n0 < 4416) cvt_tile64<1>(w_in, 6464, Bt_in, D, kb * 64, n0, 6400, lane);
                else cvt_tile64<0>(w_in, 6464, Bt_in, D, kb * 64, n0, n0 - 64, lane);
                continue; } r -= I_IN;
            if (r < I_PAD) { const int kb = r / 3, rb = r % 3; const int g = lane >> 4, x4 = lane & 15;
#pragma unroll
                for (int j = 0; j < 4; ++j) { bf16_t* d = Bt_in + (size_t)(6464 + rb * 64 + 4 * x4 + j) * D + kb * 64 + 16 * g; *(u32x4*)d = (u32x4){0u, 0u, 0u, 0u}; *(u32x4*)(d + 8) = (u32x4){0u, 0u, 0u, 0u}; }
                continue; } r -= I_PAD;
            if (r < I_UQ) { const int kb = r / 24, cb = r % 24, n0 = cb * 64;
                if ((cb % 3) == 2) cvt_tile64<1>(w_uq, 1536, Bt_uq, QL, kb * 64, n0, n0, lane, g_q); else cvt_tile64<0>(w_uq, 1536, Bt_uq, QL, kb * 64, n0, n0, lane, g_q);
                continue; } r -= I_UQ;
            if (r < I_UKV) { const int kb = r / 32, cb = r % 32; cvt_tile64<0>(w_ukv, 2048, Bt_ukv, KVL, kb * 64, cb * 64, cb * 64, lane, g_kv); continue; } r -= I_UKV;
            const int which = r / I_O; r -= which * I_O; const int kb = r / 16, cb = r % 16;
            cvt_tile64<0>(which == 0 ? w_od : (which == 1 ? w_om : w_out), D, which == 0 ? Bt_od : (which == 1 ? Bt_om : Bt_out), D, kb * 64, cb * 64, cb * 64, lane);
        }
        const float* g_mix = (const float*)AIN(2);
        for (int m = gw * 4; m < T; m += NGW * 4) {
            f32x4 v[4][4]; float ss[4];
#pragma unroll
            for (int q = 0; q < 4; ++q) { const f32x4* xr = (const f32x4*)(xin + (size_t)(m + q) * D) + lane;
#pragma unroll
                for (int j = 0; j < 4; ++j) v[q][j] = xr[64 * j]; }
#pragma unroll
            for (int q = 0; q < 4; ++q) { float s = 0.f;
#pragma unroll
                for (int j = 0; j < 4; ++j) s += (v[q][j][0] * v[q][j][0] + v[q][j][1] * v[q][j][1]) + (v[q][j][2] * v[q][j][2] + v[q][j][3] * v[q][j][3]);
                ss[q] = __builtin_amdgcn_rsqf(wave_sum(s) * (1.f / D) + EPS); }
#pragma unroll
            for (int j = 0; j < 4; ++j) { const f32x4 gg = *((const f32x4*)g_mix + lane + 64 * j);
#pragma unroll
                for (int q = 0; q < 4; ++q) { u32x2 w; w.x = cvt_pk_bf16(v[q][j][0] * ss[q] * gg[0], v[q][j][1] * ss[q] * gg[1]); w.y = cvt_pk_bf16(v[q][j][2] * ss[q] * gg[2], v[q][j][3] * ss[q] * gg[3]);
                    ((u32x2*)(hbuf + (size_t)(m + q) * D) + lane)[64 * j] = w; } }
        }
        for (int idx = bx * 512 + tid; idx < T * 40; idx += G * 512) {
            const int t = idx / 40, i = idx % 40; const float inv = i < 8 ? c_invA[i] : c_invM[i - 8];
            const float ang = (float)positions[t] * inv;
            const double rev = (double)ang * 0.15915494309189535; const float fr_ = (float)(rev - __builtin_rint(rev));
            const float cs = __builtin_amdgcn_cosf(fr_), sn = __builtin_amdgcn_sinf(fr_);
            float* dst = i < 8 ? ropeA + ((size_t)t * 8 + i) * 2 : ropeM + ((size_t)t * 32 + (i - 8)) * 2; dst[0] = cs; dst[1] = sn;
        }
    }
    SEAM(0);
    if (IN(1)) {
        KARGS();
        pg8::Gemm g{hbuf, Bt_in, D}; pg8::DenseOrder S; S.init(T / 256, N_IN / 256, G, bx);
        pg8::EpiIn E{qa, ka, va, cq, ckv, gates, kr, ropeA, ropeM, (const float*)AIN(15), sq};
        pg8::gemm_phase<pg8::EpiIn, pg8::DenseOrder, false, true>(lds, g, S, E);
    }
    SEAM(1);
    if (IN(2)) {
        KARGS();
        { pg8::Gemm g{cq, Bt_uq, QL}; pg8::DenseOrder S; S.init(T / 256, 1536 / 256, G, bx); pg8::EpiUp<true> E{qm, sq, ropeM};
          pg8::gemm_phase<pg8::EpiUp<true>, pg8::DenseOrder, false, true>(lds, g, S, E); }
        { pg8::Gemm g{ckv, Bt_ukv, KVL}; pg8::DenseOrder S; S.init(T / 256, 2048 / 256, G, G - 1 - bx); pg8::EpiUp<false> E{kv, sq, ropeM};
          pg8::gemm_phase<pg8::EpiUp<false>, pg8::DenseOrder, false, true>(lds, g, S, E); }
    }
    SEAM(2);
    if (IN(3)) {
        KARGS();
        const int lane = threadIdx.x & 63;
        const int wid = wave;
#define UNIT_DECODE(L) int u = (L) & 511; if (G == 256) { const int c = (L) & 255; u = ((L) & 256) + (c & 7) * 32 + (c >> 3); } \
            const int bh = u >> 4, qb = u & 15, b = bh >> 3, h = bh & 7; const size_t q0 = (size_t)b * SEQ + qb * 256, k0 = (size_t)b * SEQ
        for (int L = bx; L < 512; L += G) {
#if PROBE_PHASE == 3 && defined(PROBE_ATT)
            if (args.li == 1 && lo == 3 && PROBE_ATT != 0) continue;
#endif
            UNIT_DECODE(L);
            f32x16 o[4], o2[4];
            { att::Src in{qa + q0 * 1024 + h * 128, ka + k0 * 1024 + h * 128, nullptr, va + k0 * 1024 + h * 128, 1024, 1024, 0, 1024};
              att::attn_core_da2(in, 0.125f * 1.4426950408889634f, 8.f / 0.125f, SEQ, (LAS char*)lds, o, o2); }
            float lam;
            { const float* lq1 = (const float*)AIN(4); const float* lk1 = (const float*)AIN(5); const float* lq2 = (const float*)AIN(6); const float* lk2 = (const float*)AIN(7);
              const float s1 = wave_sum(lq1[lane] * lk1[lane]), s2 = wave_sum(lq2[lane] * lk2[lane]); lam = __expf(s1) - __expf(s2) + LAM_INIT; }
            float ss[16];
#pragma unroll
            for (int r = 0; r < 16; ++r) ss[r] = 0.f;
#pragma unroll
            for (int d = 0; d < 4; ++d)
#pragma unroll
                for (int r = 0; r < 16; ++r) { const float v = o[d][r] - lam * o2[d][r]; o[d][r] = v; ss[r] += v * v; }
#pragma unroll
            for (int r = 0; r < 16; ++r) {
#pragma unroll
                for (int msk = 1; msk < 32; msk <<= 1) ss[r] += __shfl_xor(ss[r], msk);
                ss[r] = __builtin_amdgcn_rsqf(ss[r] * (1.0f / 128.0f) + EPS); }
            int ln2; asm volatile("v_and_b32 %0, 63, %1" : "=v"(ln2) : "v"(threadIdx.x));
            const int hi2 = ln2 >> 5, r32e = ln2 & 31;
            bf16_t* Ow = oa + (q0 + wid * 32 + 4 * hi2) * 1024 + h * 128 + r32e;
            float gs[4];
#pragma unroll
            for (int d = 0; d < 4; ++d) gs[d] = ((const float*)AIN(8))[d * 32 + r32e] * (1.0f - LAM_INIT);
#pragma unroll
            for (int r = 0; r < 16; ++r) { const int orow = att::crow(r, 0);
#pragma unroll
                for (int d = 0; d < 4; ++d) Ow[orow * 1024 + d * 32] = (bf16_t)(cvt_pk_bf16(o[d][r] * ss[r] * gs[d], 0.f) & 0xffffu); }
        }
        for (int L = 512 + bx; L < 1024; L += G) {
#if PROBE_PHASE == 3 && defined(PROBE_ATT)
            if (args.li == 1 && lo == 3 && PROBE_ATT != 1) continue;
#endif
            UNIT_DECODE(L);
            f32x16 o[4];
            { att::Src in{qm + q0 * 1536 + h * 192, kv + k0 * 2048 + h * 256, kr + k0 * 64, kv + k0 * 2048 + h * 256 + 128, 1536, 2048, 64, 2048};
              att::attn_core<192>(in, 0.07216878364870322f * 1.4426950408889634f, 8.f / 0.07216878364870322f, SEQ, (LAS char*)lds, o); }
            int ln2; asm volatile("v_and_b32 %0, 63, %1" : "=v"(ln2) : "v"(threadIdx.x));
            const int hi2 = ln2 >> 5, r32e = ln2 & 31;
            bf16_t* Ow = ob + (q0 + wid * 32 + 4 * hi2) * 1024 + h * 128 + r32e;
#pragma unroll
            for (int r = 0; r < 16; ++r) { const int orow = att::crow(r, 0);
#pragma unroll
                for (int d = 0; d < 4; ++d) Ow[orow * 1024 + d * 32] = (bf16_t)(cvt_pk_bf16(o[d][r], 0.f) & 0xffffu); }
        }
#undef UNIT_DECODE
    }
    SEAM(3);
    if (IN(4)) {
        KARGS();
        { pg8::Gemm g{oa, Bt_od, D}; pg8::DenseOrder S; S.init(T / 256, 4, G, bx); pg8::EpiGate<0> E{mrg, gates};
          pg8::gemm_phase<pg8::EpiGate<0>, pg8::DenseOrder, false, true>(lds, g, S, E); }
        VM_WAIT(); __syncthreads();
        { pg8::Gemm g{ob, Bt_om, D}; pg8::DenseOrder S; S.init(T / 256, 4, G, bx); pg8::EpiGate<1> E{mrg, gates};
          pg8::gemm_phase<pg8::EpiGate<1>, pg8::DenseOrder, false, true>(lds, g, S, E); }
    }
    SEAM(4);
    if (IN(5)) {
        KARGS();
        pg8::Gemm g{mrg, Bt_out, D}; pg8::DenseOrder S; S.init(T / 256, 4, G, bx); pg8::EpiRes E{xin, AOUT};
        pg8::gemm_phase<pg8::EpiRes, pg8::DenseOrder, false, true>(lds, g, S, E);
    }
    SEAM(5);
    if (IN(6)) {
        KARGS();
        LANE_DECL;
        const float* g_ffn = (const float*)AIN(17); const float* w_router = (const float*)AIN(18); const float* b_router = (const float*)AIN(19);
        constexpr int WRS = 1028;
        LAS float* wr_l = (LAS float*)lds;
        LAS int* lcount = (LAS int*)(lds + TAB_OFF + 1024); LAS int* gbase = lcount + 32; LAS unsigned* asg_e = (LAS unsigned*)(lcount + 64); LAS float* asg_w = (LAS float*)(lcount + 64 + 256);
        LAS int* sync_w = (LAS int*)(lds + TAB_OFF + 512);
        for (int i = tid; i < D * NEXP; i += 512) wr_l[(i & 31) * WRS + (i >> 5)] = w_router[i];
        if (tid < 32) lcount[tid] = 0;
        if (tid < 2) sync_w[tid] = 0;
        __syncthreads();
        const int ex = (lane >> 1) & 31;
        LAS float* lg = (LAS float*)(lds + TAB_OFF + 4096) + wave * 80;
        const int chunk = bx;
        if (wave < 4 && chunk < T / 64) {
            const float my_b = b_router[ex];
#pragma unroll 1
            for (int j2 = 0; j2 < 8; ++j2) {
                const int tl = wave * 16 + j2 * 2, t = chunk * 64 + tl;
                f32x4 xva[4], xvb[4]; float sa = 0.f, sb = 0.f;
                { const f32x4* xa = (const f32x4*)(AOUT + (size_t)t * D) + lane; const f32x4* xb = xa + D / 4;
#pragma unroll
                  for (int j = 0; j < 4; ++j) { xva[j] = xa[64 * j]; xvb[j] = xb[64 * j]; }
#pragma unroll
                  for (int j = 0; j < 4; ++j) { sa += (xva[j][0] * xva[j][0] + xva[j][1] * xva[j][1]) + (xva[j][2] * xva[j][2] + xva[j][3] * xva[j][3]); sb += (xvb[j][0] * xvb[j][0] + xvb[j][1] * xvb[j][1]) + (xvb[j][2] * xvb[j][2] + xvb[j][3] * xvb[j][3]); } }
                const float ra = __builtin_amdgcn_rsqf(wave_sum(sa) * (1.f / D) + EPS), rb = __builtin_amdgcn_rsqf(wave_sum(sb) * (1.f / D) + EPS);
                { u32x2* oa8 = (u32x2*)(h2 + (size_t)t * D) + lane; u32x2* ob8 = oa8 + D / 4;
#pragma unroll
                  for (int j = 0; j < 4; ++j) { const f32x4 gg = *((const f32x4*)g_ffn + lane + 64 * j); xva[j] = xva[j] * ra * gg; xvb[j] = xvb[j] * rb * gg;
                    u32x2 w; w.x = cvt_pk_bf16(xva[j][0], xva[j][1]); w.y = cvt_pk_bf16(xva[j][2], xva[j][3]); oa8[64 * j] = w;
                    w.x = cvt_pk_bf16(xvb[j][0], xvb[j][1]); w.y = cvt_pk_bf16(xvb[j][2], xvb[j][3]); ob8[64 * j] = w; } }
                float aa[32], ab[32];
#pragma unroll
                for (int e = 0; e < NEXP; ++e) { float a = 0.f, b = 0.f;
#pragma unroll
                    for (int j = 0; j < 4; ++j) { const f32x4 w4 = *(const LAS f32x4*)(wr_l + e * WRS + 4 * lane + 256 * j);
                        a += (xva[j][0] * w4[0] + xva[j][1] * w4[1]) + (xva[j][2] * w4[2] + xva[j][3] * w4[3]); b += (xvb[j][0] * w4[0] + xvb[j][1] * w4[1]) + (xvb[j][2] * w4[2] + xvb[j][3] * w4[3]); }
                    aa[e] = a; ab[e] = b; }
#define TRED(arr, n, msk) _Pragma("unroll") for (int i_ = 0; i_ < (n); ++i_) { const bool up_ = (lane & (msk)) != 0; const float keep_ = up_ ? arr[(n) + i_] : arr[i_], give_ = up_ ? arr[i_] : arr[(n) + i_]; arr[i_] = keep_ + __shfl_xor(give_, (msk)); }
                TRED(aa, 16, 32) TRED(aa, 8, 16) TRED(aa, 4, 8) TRED(aa, 2, 4) TRED(aa, 1, 2)
                TRED(ab, 16, 32) TRED(ab, 8, 16) TRED(ab, 4, 8) TRED(ab, 2, 4) TRED(ab, 1, 2)
#undef TRED
                const float la = aa[0] + __shfl_xor(aa[0], 1) + my_b, lb = ab[0] + __shfl_xor(ab[0], 1) + my_b;
#pragma unroll
                for (int tk = 0; tk < 2; ++tk) {
                    const float v = tk ? lb : la; int rank = 0;
                    if (!(lane & 1)) lg[tk * 32 + ex] = v;
                    LDS_WAIT();
#pragma unroll
                    for (int q = 0; q < 8; ++q) { const f32x4 s4 = *(const LAS f32x4*)(lg + tk * 32 + 4 * q);
#pragma unroll
                        for (int jj = 0; jj < 4; ++jj) rank += (s4[jj] > v || (s4[jj] == v && (4 * q + jj) < ex)) ? 1 : 0; }
                    if (rank < 4 && !(lane & 1)) lg[64 + tk * 4 + rank] = v;
                    LDS_WAIT();
                    const f32x4 tv = *(const LAS f32x4*)(lg + 64 + tk * 4);
                    const float p1 = __expf(tv[1] - tv[0]), p2 = __expf(tv[2] - tv[0]), p3 = __expf(tv[3] - tv[0]), inv = 1.0f / (1.0f + p1 + p2 + p3);
                    if (rank < 4 && !(lane & 1)) { const float w = (rank == 0 ? 1.0f : (rank == 1 ? p1 : (rank == 2 ? p2 : p3))) * inv;
                        const int lr = __hip_atomic_fetch_add((LAS int*)&lcount[ex], 1, __ATOMIC_RELAXED, __HIP_MEMORY_SCOPE_WORKGROUP);
                        asg_e[(tl + tk) * 4 + rank] = ((unsigned)ex << 16) | (unsigned)lr; asg_w[(tl + tk) * 4 + rank] = w; }
                }
            }
            LDS_WAIT();
            if (lane == 0) __hip_atomic_fetch_add((LAS int*)&sync_w[0], 1, __ATOMIC_RELAXED, __HIP_MEMORY_SCOPE_WORKGROUP);
            if (wave == 0) {
                while (__hip_atomic_load((LAS int*)&sync_w[0], __ATOMIC_RELAXED, __HIP_MEMORY_SCOPE_WORKGROUP) < 4) __builtin_amdgcn_s_sleep(4);
                asm volatile("s_waitcnt lgkmcnt(0)" ::: "memory");
                if (lane < 32) gbase[lane] = (int)__hip_atomic_fetch_add(count + lane, (unsigned)lcount[lane], __ATOMIC_RELAXED, __HIP_MEMORY_SCOPE_AGENT);
                LDS_WAIT();
#pragma unroll
                for (int q = 0; q < 4; ++q) { const int a_ = q * 64 + lane; const unsigned ae = asg_e[a_]; const int e = ae >> 16, rank = gbase[e] + (int)(ae & 0xffffu); const int t = chunk * 64 + (a_ >> 2);
                    rowtok_p[e * T + rank] = t; u32x2 av; av.x = ((unsigned)e << 16) | (unsigned)rank; av.y = __float_as_uint(asg_w[a_]); assign[(size_t)t * 4 + (a_ & 3)] = av; }
            }
        }
        const float* w_gate = (const float*)AIN(20); const float* w_up = (const float*)AIN(22); const float* w_down = (const float*)AIN(24);
        const int per_wg = (NEXP * 768 + G - 1) / G;
        for (;;) {
            int it = 0; if (lane == 0) it = __hip_atomic_fetch_add((LAS int*)&sync_w[1], 1, __ATOMIC_RELAXED, __HIP_MEMORY_SCOPE_WORKGROUP);
            it = __builtin_amdgcn_readfirstlane(it); const int item = bx * per_wg + it;
            if (it >= per_wg || item >= NEXP * 768) break;
            const int e = item / 768, r = item % 768, mat = r >> 8, kb = (r >> 4) & 15, nb = r & 15, f0 = nb * 64;
            if (mat < 2) cvt_tile64((mat ? w_up : w_gate) + (size_t)e * D * FF, FF, Bt_gu + (size_t)e * 2048 * D, D, kb * 64, f0, 256 * (f0 >> 7) + mat * 128 + (f0 & 127), lane);
            else cvt_tile64(w_down + (size_t)e * FF * D, D, Bt_d + (size_t)e * D * FF, FF, kb * 64, f0, f0, lane);
        }
    }
    SEAM(6);
    LAS int* t_cnt = (LAS int*)(lds + TAB_OFF + 4096); LAS int* t_start = t_cnt + 32; LAS int* t_t2e = t_start + 40;
    if (IN(7) || IN(8) || IN(9)) {
        KARGS();
        __syncthreads();
        if (tid < 32) t_cnt[tid] = (int)__hip_atomic_load(count + tid, __ATOMIC_RELAXED, __HIP_MEMORY_SCOPE_AGENT);
        __syncthreads();
        if (tid == 0) { int s = 0; for (int e = 0; e < NEXP; ++e) { t_start[e] = s; s += (t_cnt[e] + 255) >> 8; } t_start[32] = s; }
        __syncthreads();
        if (tid < 32) { for (int rt = t_start[tid]; rt < t_start[tid + 1]; ++rt) t_t2e[rt] = tid; }
        __syncthreads();
    }
    if (IN(7)) {
        KARGS();
        pg8::Gemm g{h2, Bt_gu, D}; pg8::MoeOrder S; S.init(__builtin_amdgcn_readfirstlane(t_start[32]), 8, G, bx); S.t2e = t_t2e; S.tstart = t_start; S.cnt = t_cnt; S.rowtok = rowtok_p;
        pg8::EpiSwiglu E{act, (const float*)AIN(21), (const float*)AIN(23)};
        pg8::gemm_phase<pg8::EpiSwiglu, pg8::MoeOrder, true, true>(lds, g, S, E);
    }
    SEAM(7);
    if (IN(8)) {
        KARGS();
        pg8::Gemm g{act, Bt_d, FF}; pg8::MoeOrder S; S.init(__builtin_amdgcn_readfirstlane(t_start[32]), 4, G, bx); S.t2e = t_t2e; S.tstart = t_start; S.cnt = t_cnt; S.rowtok = rowtok_p;
        pg8::EpiDown E{ybuf, (const float*)AIN(25)};
        pg8::gemm_phase<pg8::EpiDown, pg8::MoeOrder, false, true>(lds, g, S, E);
    }
    SEAM(8);
    if (IN(9) && DBG_OUT) {
        KARGS();
        const bf16_t* src = DBG_OUT == 1 ? gates : DBG_OUT == 2 ? gates + 1024 : DBG_OUT == 3 ? qa : DBG_OUT == 4 ? ka : DBG_OUT == 5 ? va : DBG_OUT == 6 ? mrg : DBG_OUT == 7 ? oa : DBG_OUT == 9 ? Bt_in : ob;
        const int ld = DBG_OUT <= 2 ? 2048 : 1024;
        for (size_t i = (size_t)bx * 512 + tid; i < (size_t)T * 1024; i += (size_t)G * 512) AOUT[i] = (DBG_OUT == 9 && i >= (size_t)N_IN * 1024) ? 0.f : __uint_as_float((unsigned)src[(i >> 10) * ld + (i & 1023)] << 16);
    } else
    if (IN(9)) {
        KARGS();
        LANE_DECL;
        const float* g_fin = (const float*)AIN(26);
        for (int t0 = gw * 2; t0 < T; t0 += NGW * 2) {
            f32x4 v[2][4]; u32x2 as_[2][4];
#pragma unroll
            for (int q = 0; q < 2; ++q) { const f32x4* xr = (const f32x4*)(AOUT + (size_t)(t0 + q) * D) + lane;
#pragma unroll
                for (int j = 0; j < 4; ++j) v[q][j] = xr[64 * j];
#pragma unroll
                for (int k = 0; k < 4; ++k) as_[q][k] = assign[(size_t)(t0 + q) * 4 + k]; }
            u32x2 yw[2][4][4];
#pragma unroll
            for (int q = 0; q < 2; ++q)
#pragma unroll
                for (int k = 0; k < 4; ++k) { const int e = as_[q][k].x >> 16, rank = as_[q][k].x & 0xffffu;
                    const u32x2* yr = (const u32x2*)(ybuf + ((size_t)t_start[e] * 256 + rank) * D) + lane;
#pragma unroll
                    for (int j = 0; j < 4; ++j) yw[q][k][j] = yr[64 * j]; }
#pragma unroll
            for (int q = 0; q < 2; ++q) {
#pragma unroll
                for (int k = 0; k < 4; ++k) { const float w = (DBG_SKIP & 1) ? 0.f : __uint_as_float(as_[q][k].y);
#pragma unroll
                    for (int j = 0; j < 4; ++j) { const u32x2 y = yw[q][k][j]; v[q][j][0] += w * bf_lo(y.x); v[q][j][1] += w * bf_hi(y.x); v[q][j][2] += w * bf_lo(y.y); v[q][j][3] += w * bf_hi(y.y); } }
                float s = 0.f;
#pragma unroll
                for (int j = 0; j < 4; ++j) s += (v[q][j][0] * v[q][j][0] + v[q][j][1] * v[q][j][1]) + (v[q][j][2] * v[q][j][2] + v[q][j][3] * v[q][j][3]);
                const float rstd = __builtin_amdgcn_rsqf(wave_sum(s) * (1.f / D) + EPS);
                f32x4* xo = (f32x4*)(AOUT + (size_t)(t0 + q) * D) + lane;
#pragma unroll
                for (int j = 0; j < 4; ++j) { const f32x4 gg = *((const f32x4*)g_fin + lane + 64 * j); xo[64 * j] = v[q][j] * rstd * gg; } }
        }
    }
#undef IN
#undef SEAM
#undef KARGS
#undef AIN
#undef AOUT
#undef AWS
#undef xin
#undef positions
#undef Bt_in
#undef Bt_uq
#undef Bt_ukv
#undef Bt_od
#undef Bt_om
#undef Bt_out
#undef ropeA
#undef ropeM
#undef sq
#undef hbuf
#undef oa
#undef qa
#undef ka
#undef va
#undef cq
#undef ckv
#undef kr
#undef gates
#undef qm
#undef kv
#undef ob
#undef mrg
#undef stash
#undef rowtok_p
#undef assign
#undef Bt_d
#undef Bt_gu
#undef h2
#undef act
#undef ybuf
#undef count
}

extern "C" void kernel_launch(void* const* d_in, const int* in_sizes, int n_in, void* d_out, int out_size, void* d_ws, size_t ws_size, hipStream_t stream) {
    static int grid = 0;
    if (grid == 0) {
        if (n_in != 27 || in_sizes[0] != T * D || out_size != T * D || ws_size < WS_END) { fprintf(stderr, "kernel_launch: unexpected shapes (n_in %d, in0 %d, out %d, ws %zu < %zu)\n", n_in, n_in > 0 ? in_sizes[0] : -1, out_size, ws_size, (size_t)WS_END); grid = -1; return; }
        int dev = 0, cus = 0, per_cu = 0;
        if (hipGetDevice(&dev) != hipSuccess || hipDeviceGetAttribute(&cus, hipDeviceAttributeMultiprocessorCount, dev) != hipSuccess) { grid = -1; return; }
        if (hipFuncSetAttribute((const void*)fwd, hipFuncAttributeMaxDynamicSharedMemorySize, LDS_BYTES) != hipSuccess) { fprintf(stderr, "kernel_launch: hipFuncSetAttribute failed\n"); grid = -1; return; }
        if (hipOccupancyMaxActiveBlocksPerMultiprocessor(&per_cu, (const void*)fwd, NWAVES * 64, LDS_BYTES) != hipSuccess || per_cu < 1) fprintf(stderr, "kernel_launch: occupancy query says %d\n", per_cu);
        (void)hipGetLastError();
        grid = cus;
    }
    if (grid < 0) return;
    if (hipMemsetAsync((char*)d_ws + WS_CTL, 0, CTL_ZERO_BYTES, stream) != hipSuccess) return;
    Args a{};
    for (int i = 0; i < 27; ++i) a.in[i] = d_in[i];
    a.out = (float*)d_out; a.ws = (unsigned char*)d_ws;
#if MK_PER_PHASE
    for (int p = 0; p < NPHASE; ++p) { a.ph_lo = p; a.ph_hi = p + 1; hipLaunchKernelGGL(fwd, dim3(grid), dim3(NWAVES * 64), LDS_BYTES, stream, a); }
#elif PROBE_PHASE >= 0
    a.ph_lo = 0; a.ph_hi = PROBE_PHASE + 1; a.li = 0; hipLaunchKernelGGL(fwd, dim3(grid), dim3(NWAVES * 64), LDS_BYTES, stream, a);
    a.ph_lo = PROBE_PHASE; a.ph_hi = NPHASE; a.li = 1; hipLaunchKernelGGL(fwd, dim3(grid), dim3(NWAVES * 64), LDS_BYTES, stream, a);
#else
    a.ph_lo = 0; a.ph_hi = NPHASE; hipLaunchKernelGGL(fwd, dim3(grid), dim3(NWAVES * 64), LDS_BYTES, stream, a);
#endif
}
```

```cpp
#include <hip/hip_runtime.h>
#include <cstdio>
#include <cstdint>

#ifndef MK_PER_PHASE
#define MK_PER_PHASE 0
#endif

#ifndef PROBE_PHASE
#define PROBE_PHASE -1
#endif
#ifndef ATT_DUP
#define ATT_DUP 0
#endif
#ifndef DBG_OUT
#define DBG_OUT 0
#endif
#ifndef DBG_SKIP
#define DBG_SKIP 0
#endif
#ifndef ATT_MASK
#define ATT_MASK 3
#endif
#ifndef PH_MASK
#define PH_MASK 0x3ff
#endif
#define LAS __attribute__((address_space(3)))
#define GAS __attribute__((address_space(1)))
typedef unsigned short bf16_t;
typedef short bf16x8 __attribute__((ext_vector_type(8)));
typedef short s16x4 __attribute__((ext_vector_type(4)));
typedef float f32x2 __attribute__((ext_vector_type(2)));
typedef float f32x4 __attribute__((ext_vector_type(4)));
typedef float f32x16 __attribute__((ext_vector_type(16)));
typedef unsigned u32x2 __attribute__((ext_vector_type(2)));
typedef unsigned u32x4 __attribute__((ext_vector_type(4)));

constexpr int NB = 4, SEQ = 4096, T = NB * SEQ, D = 1024;
constexpr int NEXP = 32, TOPK = 4, FF = 1024;
constexpr int N_IN = 6656;
constexpr int QL = 768, KVL = 512;
constexpr float EPS = 1e-6f;
constexpr float LAM_INIT = 0.2f;
constexpr int NPHASE = 10;

constexpr size_t MiB = 1u << 20;
constexpr size_t WS_CTL = 0, CTL_ZERO_BYTES = 1 * MiB;
constexpr size_t WS_BT_IN = 2 * MiB;
constexpr size_t WS_BT_UQ = 15 * MiB;
constexpr size_t WS_BT_UKV = 18 * MiB;
constexpr size_t WS_BT_OD = 20 * MiB, WS_BT_OM = 22 * MiB, WS_BT_OUT = 24 * MiB;
constexpr size_t WS_ROPEA = 26 * MiB;
constexpr size_t WS_ROPEM = 27 * MiB;
constexpr size_t WS_SQ = 31 * MiB;
constexpr size_t WS_SQP = 1 * MiB;
constexpr size_t WS_H = 32 * MiB;
constexpr size_t WS_QA = 64 * MiB, WS_KA = 96 * MiB, WS_VA = 128 * MiB;
constexpr size_t WS_CQ = 160 * MiB, WS_CKV = 184 * MiB, WS_KR = 200 * MiB;
constexpr size_t WS_SQ2 = 202 * MiB;
constexpr size_t WS_GATES = 208 * MiB;
constexpr size_t WS_QM = 272 * MiB;
constexpr size_t WS_KV = 320 * MiB;
constexpr size_t WS_OB = 384 * MiB;
constexpr size_t WS_MRG = 416 * MiB;
constexpr size_t WS_STASH = 448 * MiB;
constexpr size_t WS_ROWTOK = 2 * MiB;
constexpr size_t WS_ASSIGN = 4 * MiB;
constexpr size_t WS_BT_D = 32 * MiB;
constexpr size_t WS_BT_GU = 96 * MiB;
constexpr size_t WS_H2 = 224 * MiB;
constexpr size_t WS_ACT = 256 * MiB;
constexpr size_t WS_Y = 96 * MiB;
constexpr size_t WS_END = 512 * MiB;
constexpr int CW_COUNT = 64;
constexpr int CW_BAR = 4096;

constexpr int RING_BYTES = 131072;
constexpr int TAB_OFF = RING_BYTES;
constexpr int TAB_BYTES = 8192;
constexpr int MISC_OFF = TAB_OFF + TAB_BYTES;
constexpr int LDS_BYTES = 147456;

typedef __bf16 bf16x2_t __attribute__((ext_vector_type(2)));
__device__ __forceinline__ unsigned cvt_pk_bf16(float lo, float hi) { const f32x2 v = {lo, hi}; return __builtin_bit_cast(unsigned, __builtin_convertvector(v, bf16x2_t)); }
__device__ __forceinline__ float bf_lo(unsigned w) { return __uint_as_float(w << 16); }
__device__ __forceinline__ float bf_hi(unsigned w) { return __uint_as_float(w & 0xffff0000u); }
__device__ __forceinline__ float wave_sum(float v) {
#pragma unroll
    for (int o = 1; o < 64; o <<= 1) v += __shfl_xor(v, o);
    return v;
}
__device__ __forceinline__ float sigmoidf_(float x) { return __builtin_amdgcn_rcpf(1.0f + __builtin_amdgcn_exp2f(-1.4426950408889634f * x)); }
#define LDS_WAIT() asm volatile("s_waitcnt lgkmcnt(0)" ::: "memory")
#define VM_WAIT() asm volatile("s_waitcnt vmcnt(0)" ::: "memory")

#define XB_TMO      128
#define XB_XCNT(j)  (256  + 64 * (j))
#define XB_XSUB(j)  (1280 + 64 * (j))
#define XB_XGEN(j)  (2304 + 64 * (j))
#define XB_TOP      3328
#define XB_TOPGEN   3392
#define XCD_BAR_WORDS 3456
#define XB_SPIN_CAP (1u << 20)
__device__ __forceinline__ unsigned xb_ld(unsigned* p)              { return __hip_atomic_load(p, __ATOMIC_RELAXED, __HIP_MEMORY_SCOPE_AGENT); }
__device__ __forceinline__ unsigned xb_add(unsigned* p, unsigned v) { return __hip_atomic_fetch_add(p, v, __ATOMIC_RELAXED, __HIP_MEMORY_SCOPE_AGENT); }
__device__ __forceinline__ unsigned xb_xcc_id() { return (unsigned)__builtin_amdgcn_s_getreg((3 << 11) | 20) & 0xFu; }
#define XB_SPIN(cond, bar) do { unsigned _sp = 0; while (cond) { __builtin_amdgcn_s_sleep(1); \
    if ((++_sp & 255u) == 0u) { if (xb_ld(&(bar)[XB_TMO])) break; if (_sp > XB_SPIN_CAP) { atomicAdd(&(bar)[XB_TMO], 1u); break; } } } } while (0)
struct XcdBarrier { unsigned* bar; unsigned x; volatile LAS unsigned* st; };
__device__ __forceinline__ XcdBarrier xcd_barrier_post(unsigned* bar, volatile LAS unsigned* st) {
    XcdBarrier b; b.bar = bar; b.x = xb_xcc_id(); b.st = st;
    if (threadIdx.x == 0) (void)xb_add(&bar[XB_XCNT(b.x)], 1u);
    return b;
}
__device__ __forceinline__ void xcd_barrier_complete(unsigned* bar, unsigned x, unsigned& nloc, unsigned& nx) {
    const unsigned G = gridDim.x * gridDim.y * gridDim.z;
    unsigned sum, cnt, mine, sp = 0u;
    for (;;) {
        sum = 0u; cnt = 0u; mine = 0u;
#pragma unroll
        for (unsigned j = 0; j < 16; ++j) { const unsigned c = xb_ld(&bar[XB_XCNT(j)]); sum += c; cnt += (c > 0u) ? 1u : 0u; mine = (j == x) ? c : mine; }
        if (sum == G) break;
        __builtin_amdgcn_s_sleep(1);
        if ((++sp & 255u) == 0u) { if (xb_ld(&bar[XB_TMO])) break; if (sp > XB_SPIN_CAP) { atomicAdd(&bar[XB_TMO], 1u); break; } }
    }
    nloc = mine > 0u ? mine : 1u; nx = cnt > 0u ? cnt : 1u;
}
__device__ __forceinline__ void xcd_barrier(const XcdBarrier& b) {
    asm volatile("s_waitcnt vmcnt(0)" ::: "memory");
    __syncthreads();
    if (threadIdx.x == 0) {
        unsigned* bar = b.bar;
        __builtin_amdgcn_s_waitcnt(0);
        unsigned nloc = b.st[0], nx = b.st[1];
        if (nloc == 0u) { xcd_barrier_complete(bar, b.x, nloc, nx); b.st[0] = nloc; b.st[1] = nx; }
        const unsigned old = xb_add(&bar[XB_XSUB(b.x)], 1u);
        const unsigned gen = old / nloc;
        if (old + 1u == (gen + 1u) * nloc) {
            __builtin_amdgcn_fence(__ATOMIC_RELEASE, "agent");
            asm volatile("s_waitcnt vmcnt(0)" ::: "memory");
            const unsigned og = xb_add(&bar[XB_TOP], 1u);
            const unsigned tg = og / nx;
            if (og + 1u == (tg + 1u) * nx) xb_add(&bar[XB_TOPGEN], 1u);
            else XB_SPIN(xb_ld(&bar[XB_TOPGEN]) == tg, bar);
            __builtin_amdgcn_fence(__ATOMIC_ACQUIRE, "agent");
            xb_add(&bar[XB_XGEN(b.x)], 1u);
            asm volatile("s_waitcnt vmcnt(0)" ::: "memory");
        } else {
            XB_SPIN(xb_ld(&bar[XB_XGEN(b.x)]) == gen, bar);
            __builtin_amdgcn_fence(__ATOMIC_ACQUIRE, "agent");
            asm volatile("s_waitcnt vmcnt(0)" ::: "memory");
        }
    }
    __syncthreads();
}

namespace pg8 {
constexpr int BM = 256, BK = 64, HALF = 128, HTB = HALF * BK * 2, STAGE_BYTES = 8 * HTB, NXCD = 8, WGM = 8;
__host__ __device__ __forceinline__ int lds_byte(int r, int c) { const int st = (r >> 4) * 2 + (c >> 5), rr = r & 15, cc = c & 31, ob = rr * 64 + cc * 2; return st * 1024 + (ob ^ (((ob >> 9) & 1) << 5)); }
__host__ __device__ __forceinline__ void stage_rc(int b, int& R, int& C) { const int st = b / 1024, sb = b % 1024, swz = sb ^ (((sb >> 9) & 1) << 5); R = (st >> 1) * 16 + swz / 64; C = (st & 1) * 32 + (swz % 64) / 2; }
__host__ __device__ __forceinline__ int perm32(int rho) { const int n = rho >> 4, i = rho & 15; return 8 * (i >> 2) + 4 * n + (i & 3); }

struct Unit { int pm, pn, pb, e, rbase, cnt; };
struct Gemm { const bf16_t* A; const bf16_t* Bt; int K; };

struct DenseOrder {
    int nM, nN, nwg, G, c, pn0;
    __device__ void init(int nM_, int nN_, int G_, int c_, int pn0_ = 0) { nM = nM_; nN = nN_; nwg = nM * nN; G = G_; c = c_; pn0 = pn0_; }
    __device__ __forceinline__ bool next(int i, Unit& u) const {
        const long L = (long)i * G + c; if (L >= nwg) return false;
        int wgid = (int)L; { const int q = nwg / NXCD, r = nwg % NXCD, xcd = wgid % NXCD, off = wgid / NXCD; wgid = (xcd < r ? xcd * (q + 1) : r * (q + 1) + (xcd - r) * q) + off; }
        const int nig = WGM * nN, gid = wgid / nig, fm = gid * WGM, gsz = (nM - fm) < WGM ? (nM - fm) : WGM;
        u.pm = fm + ((wgid % nig) % gsz); u.pn = pn0 + (wgid % nig) / gsz; u.pb = u.pn; u.e = 0; u.rbase = 0; u.cnt = 0; return true;
    }
    __device__ __forceinline__ int a_row(const Unit&, int) const { return 0; }
};
struct MoeOrder {
    int nM, nN, nwg, G, c; const LAS int* t2e; const LAS int* tstart; const LAS int* cnt; const int* rowtok;
    __device__ void init(int nM_, int nN_, int G_, int c_) { nM = nM_; nN = nN_; nwg = nM * nN; G = G_; c = c_; }
    __device__ __forceinline__ bool next(int i, Unit& u) const {
        const long L = (long)i * G + c; if (L >= nwg) return false;
        int wgid = (int)L; { const int q = nwg / NXCD, r = nwg % NXCD, xcd = wgid % NXCD, off = wgid / NXCD; wgid = (xcd < r ? xcd * (q + 1) : r * (q + 1) + (xcd - r) * q) + off; }
        const int nig = WGM * nN, gid = wgid / nig, fm = gid * WGM, gsz = (nM - fm) < WGM ? (nM - fm) : WGM;
        u.pm = fm + ((wgid % nig) % gsz); u.pn = (wgid % nig) / gsz;
        const int e = __builtin_amdgcn_readfirstlane(t2e[u.pm]); u.e = e; u.pb = e * nN + u.pn; u.rbase = (u.pm - __builtin_amdgcn_readfirstlane(tstart[e])) * 256; u.cnt = __builtin_amdgcn_readfirstlane(cnt[e]); return true;
    }
    __device__ __forceinline__ int a_row(const Unit& u, int r) const { const int rank = u.rbase + r; return rank < u.cnt ? rowtok[u.e * T + rank] : 0; }
};

template <class Epi, class Sched, bool GATHER, bool ALIGN_EPI>
__device__ __forceinline__ void gemm_phase(LAS unsigned char* lds, const Gemm g, const Sched& S, const Epi& E) {
    const int tid = threadIdx.x, wid = __builtin_amdgcn_readfirstlane(tid >> 6), lane = tid & 63, wr = wid >> 2, wc = wid & 3, fr = lane & 15, fq = lane >> 4;
    const int K = g.K, nt = K / BK;
    unsigned voffA[2], voffB[2]; int Rv[2], Cv[2];
#pragma unroll
    for (int i = 0; i < 2; ++i) { int R, C; stage_rc(tid * 16 + i * 8192, R, C); const int Rb = Epi::PERM ? ((R & ~31) + perm32(R & 31)) : R;
        voffA[i] = (unsigned)(R * K + C) * 2u; voffB[i] = (unsigned)(Rb * K + C) * 2u; Rv[i] = R; Cv[i] = C; }
    const size_t kstep = (size_t)(BK * 2);
    const size_t hstep = (size_t)HALF * K * 2;
    const size_t tstep = 2 * hstep;
    const unsigned ldsw = (unsigned)wid * 1024u;
    const int aoff = lds_byte(wr * 64 + fr, fq * 8), boff = lds_byte(wc * 32 + fr, fq * 8);
#define PG8_SA(b, h) (((b) * 2 + (h)) * HTB)
#define PG8_SB(b, h) ((4 + (b) * 2 + (h)) * HTB)
#define PG8_STAGE(bufoff, gbase, voff) do { _Pragma("unroll") for (int _i = 0; _i < 2; ++_i) \
        __builtin_amdgcn_global_load_lds((const unsigned*)((const char*)(gbase) + (voff)[_i]), (LAS unsigned*)(lds + (bufoff) + ldsw + _i * 8192), 16, 0, 0); } while (0)
#define PG8_LDA(dst, b, h) do { _Pragma("unroll") for (int m = 0; m < 4; ++m) _Pragma("unroll") for (int k = 0; k < 2; ++k) dst[m][k] = *(const LAS bf16x8*)(lds + PG8_SA(b, h) + aoff + m * 2048 + k * 1024); } while (0)
#define PG8_LDB(dst, b, h) do { _Pragma("unroll") for (int n = 0; n < 2; ++n) _Pragma("unroll") for (int k = 0; k < 2; ++k) dst[n][k] = *(const LAS bf16x8*)(lds + PG8_SB(b, h) + boff + n * 2048 + k * 1024); } while (0)
#define PG8_MMA(ai, bj, At, Bt) do { __builtin_amdgcn_s_setprio(1); _Pragma("unroll") for (int m = 0; m < 4; ++m) _Pragma("unroll") for (int n = 0; n < 2; ++n) _Pragma("unroll") for (int k = 0; k < 2; ++k) \
        acc[ai][bj][m][n] = __builtin_amdgcn_mfma_f32_16x16x32_bf16(Bt[n][k], At[m][k], acc[ai][bj][m][n], 0, 0, 0); __builtin_amdgcn_s_setprio(0); } while (0)
#define PG8_WAIT_V(n) asm volatile("s_waitcnt vmcnt(" #n ")" ::: "memory")
#define PG8_WAIT_L(n) asm volatile("s_waitcnt lgkmcnt(" #n ")" ::: "memory")
#define PG8_BAR __builtin_amdgcn_s_barrier()
#define PG8_SCHED __builtin_amdgcn_sched_barrier(0)
    Unit cur, nxt; int ui = 0;
    if (!S.next(0, cur)) return;
    f32x4 acc[2][2][4][2];
#pragma unroll
    for (int a = 0; a < 2; ++a)
#pragma unroll
        for (int b = 0; b < 2; ++b)
#pragma unroll
            for (int m = 0; m < 4; ++m)
#pragma unroll
                for (int n = 0; n < 2; ++n) acc[a][b][m][n] = (f32x4){0.f, 0.f, 0.f, 0.f};
    bf16x8 At[4][2], B0[2][2], B1[2][2];
    unsigned gC0[2], gC1[2], gN0[2], gN1[2];
    if constexpr (GATHER) {
#pragma unroll
        for (int i = 0; i < 2; ++i) { gC0[i] = (unsigned)S.a_row(cur, Rv[i]) * (unsigned)(K * 2) + (unsigned)Cv[i] * 2u; gC1[i] = (unsigned)S.a_row(cur, HALF + Rv[i]) * (unsigned)(K * 2) + (unsigned)Cv[i] * 2u; gN0[i] = gC0[i]; gN1[i] = gC1[i]; }
    }
    const char* cA = GATHER ? (const char*)g.A : (const char*)g.A + (size_t)cur.pm * tstep; const char* cB = (const char*)g.Bt + (size_t)cur.pb * tstep;
#define PG8_STAGE_A(bufoff, p, h, o0, o1) do { if constexpr (GATHER) { if ((h) == 0) PG8_STAGE(bufoff, p, o0); else PG8_STAGE(bufoff, p, o1); } else { PG8_STAGE(bufoff, (p) + (h) * hstep, voffA); } } while (0)
    PG8_STAGE(PG8_SB(0, 0), cB, voffB); PG8_STAGE(PG8_SB(0, 1), cB + hstep, voffB); PG8_STAGE_A(PG8_SA(0, 0), cA, 0, gC0, gC1); PG8_STAGE_A(PG8_SA(0, 1), cA, 1, gC0, gC1);
    if (wr == 1) PG8_BAR;
    PG8_WAIT_V(2); PG8_BAR;
    PG8_STAGE(PG8_SB(1, 0), cB + kstep, voffB); PG8_STAGE_A(PG8_SA(1, 0), cA + kstep, 0, gC0, gC1); PG8_STAGE(PG8_SB(1, 1), cB + hstep + kstep, voffB);
    PG8_WAIT_V(6); PG8_BAR;
    for (;;) {
        const bool has_next = S.next(ui + 1, nxt);
        const char* nA = GATHER ? (const char*)g.A : (has_next ? (const char*)g.A + (size_t)nxt.pm * tstep : cA); const char* nB = has_next ? (const char*)g.Bt + (size_t)nxt.pb * tstep : cB;
        if constexpr (GATHER) { if (has_next) {
#pragma unroll
            for (int i = 0; i < 2; ++i) { gN0[i] = (unsigned)S.a_row(nxt, Rv[i]) * (unsigned)(K * 2) + (unsigned)Cv[i] * 2u; gN1[i] = (unsigned)S.a_row(nxt, HALF + Rv[i]) * (unsigned)(K * 2) + (unsigned)Cv[i] * 2u; } } }
        for (int t = 0; t < nt; t += 2) {
            const bool last = (t == nt - 2);
            const char* a1 = cA + (size_t)(t + 1) * kstep;
            const char* a2 = last ? nA : cA + (size_t)(t + 2) * kstep; const char* b2 = last ? nB : cB + (size_t)(t + 2) * kstep;
            const char* a3 = a2 + kstep; const char* b3 = b2 + kstep;
            unsigned s0[2], s1[2];
            if constexpr (GATHER) { s0[0] = last ? gN0[0] : gC0[0]; s0[1] = last ? gN0[1] : gC0[1]; s1[0] = last ? gN1[0] : gC1[0]; s1[1] = last ? gN1[1] : gC1[1]; }
            PG8_LDB(B0, 0, 0); PG8_LDB(B1, 0, 1); PG8_SCHED; PG8_LDA(At, 0, 0); PG8_STAGE_A(PG8_SA(1, 1), a1, 1, gC0, gC1);
            PG8_WAIT_V(8); PG8_WAIT_L(0); PG8_BAR; PG8_MMA(0, 0, At, B0); PG8_MMA(0, 1, At, B1); PG8_BAR; PG8_SCHED;
            PG8_LDA(At, 0, 1); PG8_STAGE(PG8_SB(0, 0), b2, voffB); PG8_STAGE(PG8_SB(0, 1), b2 + hstep, voffB); PG8_STAGE_A(PG8_SA(0, 0), a2, 0, s0, s1);
            PG8_WAIT_V(8); PG8_WAIT_L(0); PG8_BAR; PG8_MMA(1, 0, At, B0); PG8_MMA(1, 1, At, B1); PG8_BAR; PG8_SCHED;
            PG8_LDB(B0, 1, 0); PG8_LDB(B1, 1, 1); PG8_SCHED; PG8_LDA(At, 1, 0); PG8_STAGE_A(PG8_SA(0, 1), a2, 1, s0, s1);
            PG8_WAIT_V(8); PG8_WAIT_L(0); PG8_BAR; PG8_MMA(0, 0, At, B0); PG8_MMA(0, 1, At, B1); PG8_BAR; PG8_SCHED;
            PG8_LDA(At, 1, 1); PG8_STAGE(PG8_SB(1, 0), b3, voffB); PG8_STAGE(PG8_SB(1, 1), b3 + hstep, voffB); PG8_STAGE_A(PG8_SA(1, 0), a3, 0, s0, s1);
            PG8_WAIT_V(8); PG8_WAIT_L(0); PG8_BAR; PG8_MMA(1, 0, At, B0); PG8_MMA(1, 1, At, B1); PG8_BAR; PG8_SCHED;
        }
        if constexpr (ALIGN_EPI) { if (wr == 0) PG8_BAR; }
        E(acc, cur, wr, wc, fr, fq);
        if (!has_next) break;
#pragma unroll
        for (int a = 0; a < 2; ++a)
#pragma unroll
            for (int b = 0; b < 2; ++b)
#pragma unroll
                for (int m = 0; m < 4; ++m)
#pragma unroll
                    for (int n = 0; n < 2; ++n) acc[a][b][m][n] = (f32x4){0.f, 0.f, 0.f, 0.f};
        cur = nxt; cA = nA; cB = nB; ++ui;
        if constexpr (GATHER) { gC0[0] = gN0[0]; gC0[1] = gN0[1]; gC1[0] = gN1[0]; gC1[1] = gN1[1]; }
        if constexpr (ALIGN_EPI) { if (wr == 1) PG8_BAR; }
    }
    PG8_WAIT_V(0);
    if constexpr (!ALIGN_EPI) { if (wr == 0) PG8_BAR; }
    PG8_BAR;
#undef PG8_SA
#undef PG8_SB
#undef PG8_STAGE
#undef PG8_STAGE_A
#undef PG8_LDA
#undef PG8_LDB
#undef PG8_MMA
#undef PG8_WAIT_V
#undef PG8_WAIT_L
#undef PG8_BAR
#undef PG8_SCHED
}

__device__ __forceinline__ u32x4 pack8(const f32x4& v0, const f32x4& v1) { u32x4 w; w.x = cvt_pk_bf16(v0[0], v0[1]); w.y = cvt_pk_bf16(v0[2], v0[3]); w.z = cvt_pk_bf16(v1[0], v1[1]); w.w = cvt_pk_bf16(v1[2], v1[3]); return w; }
__device__ __forceinline__ void rope4(f32x4& v0, f32x4& v1, const float* cs) {
    const f32x4 a = *(const f32x4*)cs, b = *(const f32x4*)(cs + 4);
    float x1, x2;
    x1 = v0[0]; x2 = v0[1]; v0[0] = x1 * a[0] - x2 * a[1]; v0[1] = x2 * a[0] + x1 * a[1];
    x1 = v0[2]; x2 = v0[3]; v0[2] = x1 * a[2] - x2 * a[3]; v0[3] = x2 * a[2] + x1 * a[3];
    x1 = v1[0]; x2 = v1[1]; v1[0] = x1 * b[0] - x2 * b[1]; v1[1] = x2 * b[0] + x1 * b[1];
    x1 = v1[2]; x2 = v1[3]; v1[2] = x1 * b[2] - x2 * b[3]; v1[3] = x2 * b[2] + x1 * b[3];
}

struct EpiIn {
    static constexpr bool PERM = true;
    bf16_t *qa, *ka, *va, *cq, *ckv, *gates, *kr; const float *ropeA, *ropeM, *bg; float* sq;
    __device__ __forceinline__ void operator()(const f32x4 (&acc)[2][2][4][2], const Unit& u, int wr, int wc, int fr, int fq) const {
        const int pn = u.pn, row0 = u.pm * BM + wr * 64 + fr, cl = wc * 32 + 8 * fq;
        if (pn < 8) {
            bf16_t* dst = pn < 4 ? qa : ka; const int colt = (pn & 3) * 256; const bool rot = ((wc & 1) == 0) && (fq < 2);
#pragma unroll
            for (int ai = 0; ai < 2; ++ai)
#pragma unroll
                for (int m = 0; m < 4; ++m) { const int row = row0 + ai * HALF + m * 16;
#pragma unroll
                    for (int bj = 0; bj < 2; ++bj) { f32x4 v0 = acc[ai][bj][m][0], v1 = acc[ai][bj][m][1];
                        if (rot) rope4(v0, v1, ropeA + (size_t)row * 16 + fq * 8);
                        *(u32x4*)(dst + (size_t)row * 1024 + colt + bj * HALF + cl) = pack8(v0, v1); } }
        } else if (pn < 12) {
            const int colt = (pn - 8) * 256;
#pragma unroll
            for (int ai = 0; ai < 2; ++ai)
#pragma unroll
                for (int m = 0; m < 4; ++m) { const int row = row0 + ai * HALF + m * 16;
#pragma unroll
                    for (int bj = 0; bj < 2; ++bj) *(u32x4*)(va + (size_t)row * 1024 + colt + bj * HALF + cl) = pack8(acc[ai][bj][m][0], acc[ai][bj][m][1]); }
        } else if (pn < 17) {
            const bool isq = pn < 15; bf16_t* dst = isq ? cq : ckv; const int ld = isq ? QL : KVL, colt = (isq ? pn - 12 : pn - 15) * 256, tq = pn - 12;
#pragma unroll
            for (int ai = 0; ai < 2; ++ai)
#pragma unroll
                for (int m = 0; m < 4; ++m) { const int row = row0 + ai * HALF + m * 16; float s = 0.f;
#pragma unroll
                    for (int bj = 0; bj < 2; ++bj) { const f32x4 v0 = acc[ai][bj][m][0], v1 = acc[ai][bj][m][1];
                        s += (v0[0] * v0[0] + v0[1] * v0[1]) + (v0[2] * v0[2] + v0[3] * v0[3]) + (v1[0] * v1[0] + v1[1] * v1[1]) + (v1[2] * v1[2] + v1[3] * v1[3]);
                        *(u32x4*)(dst + (size_t)row * ld + colt + bj * HALF + cl) = pack8(v0, v1); }
                    s += __shfl_xor(s, 16); s += __shfl_xor(s, 32);
                    if (fq == 0) sq[(size_t)row * 20 + tq * 4 + wc] = s; }
        } else if (pn != 23) {
            const int colt = (pn < 23 ? pn - 17 : pn - 18) * 256;
            f32x4 bv[2][2];
#pragma unroll
            for (int bj = 0; bj < 2; ++bj) { bv[bj][0] = *(const f32x4*)(bg + colt + bj * HALF + cl); bv[bj][1] = *(const f32x4*)(bg + colt + bj * HALF + cl + 4); if (DBG_SKIP & 256) { bv[bj][0] = bv[bj][0] * 0.f; bv[bj][1] = bv[bj][1] * 0.f; } }
#pragma unroll
            for (int ai = 0; ai < 2; ++ai)
#pragma unroll
                for (int m = 0; m < 4; ++m) { const int row = row0 + ai * HALF + m * 16;
#pragma unroll
                    for (int bj = 0; bj < 2; ++bj) { f32x4 v0 = acc[ai][bj][m][0] + bv[bj][0], v1 = acc[ai][bj][m][1] + bv[bj][1];
#pragma unroll
                        for (int j = 0; j < 4; ++j) { if (!(DBG_SKIP & 512)) { v0[j] = sigmoidf_(v0[j]); v1[j] = sigmoidf_(v1[j]); } }
                        *(u32x4*)(gates + (size_t)row * 2048 + colt + bj * HALF + cl) = pack8(v0, v1); } }
        } else {
            if (wc < 2) {
#pragma unroll
                for (int ai = 0; ai < 2; ++ai)
#pragma unroll
                    for (int m = 0; m < 4; ++m) { const int row = row0 + ai * HALF + m * 16;
                        f32x4 v0 = acc[ai][0][m][0], v1 = acc[ai][0][m][1];
                        rope4(v0, v1, ropeM + (size_t)row * 64 + (wc * 16 + fq * 4) * 2);
                        *(u32x4*)(kr + (size_t)row * 64 + cl) = pack8(v0, v1); }
            }
        }
    }
};
template <bool ISQ> struct EpiUp {
    static constexpr bool PERM = true;
    bf16_t* out; const float* sq; const float* ropeM;
    __device__ __forceinline__ void operator()(const f32x4 (&acc)[2][2][4][2], const Unit& u, int wr, int wc, int fr, int fq) const {
        const int row0 = u.pm * BM + wr * 64 + fr, cl = wc * 32 + 8 * fq; constexpr int LD = ISQ ? 1536 : 2048;
#pragma unroll
        for (int ai = 0; ai < 2; ++ai)
#pragma unroll
            for (int m = 0; m < 4; ++m) { const int row = row0 + ai * HALF + m * 16; float s;
                if (ISQ) { const f32x4 a = *(const f32x4*)(sq + (size_t)row * 20), b = *(const f32x4*)(sq + (size_t)row * 20 + 4), c = *(const f32x4*)(sq + (size_t)row * 20 + 8);
                    s = ((a[0] + a[1]) + (a[2] + a[3])) + ((b[0] + b[1]) + (b[2] + b[3])) + ((c[0] + c[1]) + (c[2] + c[3])); }
                else { const f32x4 a = *(const f32x4*)(sq + (size_t)row * 20 + 12), b = *(const f32x4*)(sq + (size_t)row * 20 + 16);
                    s = ((a[0] + a[1]) + (a[2] + a[3])) + ((b[0] + b[1]) + (b[2] + b[3])); }
                const float rstd = __builtin_amdgcn_rsqf(s * (ISQ ? 1.0f / QL : 1.0f / KVL) + EPS);
#pragma unroll
                for (int bj = 0; bj < 2; ++bj) { const int col = u.pn * BM + bj * HALF + cl; f32x4 v0 = acc[ai][bj][m][0] * rstd, v1 = acc[ai][bj][m][1] * rstd;
                    if (ISQ) { const int off = col % 192; if (off >= 128) rope4(v0, v1, ropeM + (size_t)row * 64 + (off - 128)); }
                    *(u32x4*)(out + (size_t)row * LD + col) = pack8(v0, v1); } }
    }
};
template <int WHICH> struct EpiGate {
    static constexpr bool PERM = true;
    bf16_t* mrg; const bf16_t* gates;
    __device__ __forceinline__ void operator()(const f32x4 (&acc)[2][2][4][2], const Unit& u, int wr, int wc, int fr, int fq) const {
        const int row0 = u.pm * BM + wr * 64 + fr, cl = wc * 32 + 8 * fq;
#pragma unroll
        for (int ai = 0; ai < 2; ++ai)
#pragma unroll
            for (int m = 0; m < 4; ++m) { const int row = row0 + ai * HALF + m * 16;
#pragma unroll
                for (int bj = 0; bj < 2; ++bj) { const int col = u.pn * BM + bj * HALF + cl;
                    const u32x4 gw = *(const u32x4*)(gates + (size_t)row * 2048 + WHICH * 1024 + col);
                    f32x4 v0 = acc[ai][bj][m][0], v1 = acc[ai][bj][m][1];
                    if ((DBG_SKIP & 8) && WHICH == 0) { v0 = v0 * 0.f; v1 = v1 * 0.f; } if ((DBG_SKIP & 16) && WHICH == 1) { v0 = v0 * 0.f; v1 = v1 * 0.f; }
                    v0[0] *= bf_lo(gw.x); v0[1] *= bf_hi(gw.x); v0[2] *= bf_lo(gw.y); v0[3] *= bf_hi(gw.y); v1[0] *= bf_lo(gw.z); v1[1] *= bf_hi(gw.z); v1[2] *= bf_lo(gw.w); v1[3] *= bf_hi(gw.w);
                    if (WHICH == 1) { const u32x4 tw = *(const u32x4*)(mrg + (size_t)row * 1024 + col);
                        v0[0] += bf_lo(tw.x); v0[1] += bf_hi(tw.x); v0[2] += bf_lo(tw.y); v0[3] += bf_hi(tw.y); v1[0] += bf_lo(tw.z); v1[1] += bf_hi(tw.z); v1[2] += bf_lo(tw.w); v1[3] += bf_hi(tw.w); }
                    *(u32x4*)(mrg + (size_t)row * 1024 + col) = pack8(v0, v1); } }
    }
};
struct EpiRes {
    static constexpr bool PERM = false;
    const float* x; float* out;
    __device__ __forceinline__ void operator()(const f32x4 (&acc)[2][2][4][2], const Unit& u, int wr, int wc, int fr, int fq) const {
        const int row0 = u.pm * BM + wr * 64 + fr, col0 = u.pn * BM + wc * 32 + 4 * fq;
#pragma unroll
        for (int ai = 0; ai < 2; ++ai)
#pragma unroll
            for (int m = 0; m < 4; ++m) { const size_t off = (size_t)(row0 + ai * HALF + m * 16) * 1024 + col0;
#pragma unroll
                for (int bj = 0; bj < 2; ++bj)
#pragma unroll
                    for (int n = 0; n < 2; ++n) *(f32x4*)(out + off + bj * HALF + n * 16) = *(const f32x4*)(x + off + bj * HALF + n * 16) + ((DBG_SKIP & 2) ? 0.f : 1.f) * acc[ai][bj][m][n]; }
    }
};
struct EpiSwiglu {
    static constexpr bool PERM = true;
    bf16_t* act; const float *bgate, *bup;
    __device__ __forceinline__ void operator()(const f32x4 (&acc)[2][2][4][2], const Unit& u, int wr, int wc, int fr, int fq) const {
        const int row0 = u.pm * BM + wr * 64 + fr, f0 = u.pn * HALF + wc * 32 + 8 * fq;
        f32x4 bgv[2], buv[2];
#pragma unroll
        for (int n = 0; n < 2; ++n) { bgv[n] = *(const f32x4*)(bgate + (size_t)u.e * FF + f0 + 4 * n); buv[n] = *(const f32x4*)(bup + (size_t)u.e * FF + f0 + 4 * n); }
#pragma unroll
        for (int ai = 0; ai < 2; ++ai)
#pragma unroll
            for (int m = 0; m < 4; ++m) { const int row = row0 + ai * HALF + m * 16; f32x4 o[2];
#pragma unroll
                for (int n = 0; n < 2; ++n) { const f32x4 gt = acc[ai][0][m][n] + bgv[n], up = acc[ai][1][m][n] + buv[n];
#pragma unroll
                    for (int j = 0; j < 4; ++j) { const float gg = fminf(gt[j], 7.0f), uu = fminf(fmaxf(up[j], -7.0f), 7.0f); o[n][j] = (uu + 1.0f) * (gg * sigmoidf_(1.702f * gg)); } }
                *(u32x4*)(act + (size_t)row * FF + f0) = pack8(o[0], o[1]); }
    }
};
struct EpiDown {
    static constexpr bool PERM = true;
    bf16_t* y; const float* bd;
    __device__ __forceinline__ void operator()(const f32x4 (&acc)[2][2][4][2], const Unit& u, int wr, int wc, int fr, int fq) const {
        const int row0 = u.pm * BM + wr * 64 + fr, cl = wc * 32 + 8 * fq;
        f32x4 bv[2][2];
#pragma unroll
        for (int bj = 0; bj < 2; ++bj) { const int col = u.pn * BM + bj * HALF + cl; bv[bj][0] = *(const f32x4*)(bd + (size_t)u.e * D + col); bv[bj][1] = *(const f32x4*)(bd + (size_t)u.e * D + col + 4); }
#pragma unroll
        for (int ai = 0; ai < 2; ++ai)
#pragma unroll
            for (int m = 0; m < 4; ++m) { const int row = row0 + ai * HALF + m * 16;
#pragma unroll
                for (int bj = 0; bj < 2; ++bj) { const int col = u.pn * BM + bj * HALF + cl;
                    *(u32x4*)(y + (size_t)row * D + col) = pack8(acc[ai][bj][m][0] + bv[bj][0], acc[ai][bj][m][1] + bv[bj][1]); } }
    }
};
}

namespace att {
constexpr int NW = 8, QBLK = 32, KVBLK = 64;
constexpr int SHM_V = KVBLK * 128 * 2;
#define SBAR() __builtin_amdgcn_sched_barrier(0)
#define KSW(row, colB) ((row) * 128 + ((colB) ^ ((((row) >> 1) & 7) << 4)))
__device__ __forceinline__ int crow(int r, int hi) { return (r & 3) + 8 * (r >> 2) + 4 * hi; }
struct Src { const bf16_t* Q; const bf16_t* K; const bf16_t* K2; const bf16_t* V; int ldq, ldk, ldk2, ldv; };

__device__ __forceinline__ void partialSM(f32x16& p0, f32x16& p1, float& m_reg, float& mn, float& alpha, const float C, const float thr) {
  float pmax;
  { float a0 = fmaxf(fmaxf(p0[0], p0[1]), p0[2]), a1 = fmaxf(fmaxf(p0[3], p0[4]), p0[5]), a2 = fmaxf(fmaxf(p1[0], p1[1]), p1[2]), a3 = fmaxf(fmaxf(p1[3], p1[4]), p1[5]);
#pragma unroll
    for (int r = 6; r < 16; r += 2) { a0 = fmaxf(fmaxf(a0, p0[r]), p0[r + 1]); a2 = fmaxf(fmaxf(a2, p1[r]), p1[r + 1]); }
    pmax = fmaxf(fmaxf(a0, a1), fmaxf(a2, a3)); }
  { auto rr = __builtin_amdgcn_permlane32_swap(__float_as_uint(pmax), __float_as_uint(pmax), false, false);
    pmax = fmaxf(__uint_as_float(rr[0]), __uint_as_float(rr[1])); }
  if (__builtin_expect(__all(pmax - m_reg <= thr), 1)) { mn = m_reg; alpha = 1.f; }
  else { mn = fmaxf(m_reg, pmax); alpha = __builtin_amdgcn_exp2f((m_reg - mn) * C); m_reg = mn; }
  const float mnC = -mn * C;
#pragma unroll
  for (int r = 0; r < 16; ++r) p0[r] = fmaf(p0[r], C, mnC);
#pragma unroll
  for (int r = 0; r < 16; ++r) p1[r] = fmaf(p1[r], C, mnC);
#pragma unroll
  for (int r = 0; r < 16; ++r) p0[r] = __builtin_amdgcn_exp2f(p0[r]);
#if ATT_DUP == 1
  { float d_[16];
#pragma unroll
    for (int r = 0; r < 16; ++r) { d_[r] = __builtin_amdgcn_exp2f(p1[r]); d_[r] = fmaf(d_[r], C, mnC); }
#pragma unroll
    for (int r = 0; r < 16; ++r) asm volatile("" :: "v"(d_[r])); }
#endif
}
__device__ __forceinline__ void finishSM(f32x16& p0, f32x16& p1, float alpha, float& l_reg, bf16x8& pa0, bf16x8& pa1, bf16x8& pa2, bf16x8& pa3) {
#pragma unroll
  for (int r = 0; r < 16; ++r) p1[r] = __builtin_amdgcn_exp2f(p1[r]);
  float ps;
  { float s0 = p0[0] + p0[1], s1 = p0[2] + p0[3], s2 = p1[0] + p1[1], s3 = p1[2] + p1[3];
#pragma unroll
    for (int r = 4; r < 16; r += 4) { s0 += p0[r] + p0[r + 1]; s1 += p0[r + 2] + p0[r + 3]; s2 += p1[r] + p1[r + 1]; s3 += p1[r + 2] + p1[r + 3]; }
    ps = (s0 + s1) + (s2 + s3); }
  { auto rr = __builtin_amdgcn_permlane32_swap(__float_as_uint(ps), __float_as_uint(ps), false, false);
    ps = __uint_as_float(rr[0]) + __uint_as_float(rr[1]); }
  l_reg = l_reg * alpha + ps;
#define PK4(P, BASE, OUT) do { unsigned a0 = cvt_pk_bf16(P[BASE + 0], P[BASE + 1]), a1 = cvt_pk_bf16(P[BASE + 2], P[BASE + 3]);   \
    unsigned b0 = cvt_pk_bf16(P[BASE + 4], P[BASE + 5]), b1 = cvt_pk_bf16(P[BASE + 6], P[BASE + 7]);                              \
    auto r0 = __builtin_amdgcn_permlane32_swap(a0, b0, false, false); auto r1 = __builtin_amdgcn_permlane32_swap(a1, b1, false, false); \
    u32x4 w = {r0[0], r1[0], r0[1], r1[1]}; OUT = *reinterpret_cast<bf16x8*>(&w); } while (0)
  PK4(p0, 0, pa0); PK4(p0, 8, pa1); PK4(p1, 0, pa2); PK4(p1, 8, pa3);
#undef PK4
}
template <int DQK> __device__ __forceinline__ void qkt(f32x16& p0, f32x16& p1, const LAS char* Ks, const bf16x8* qr, int r32, int hi) {
  p0 = f32x16{}; p1 = f32x16{};
#pragma unroll
  for (int d0 = 0; d0 < DQK / 16; ++d0) { const int sub = d0 >> 2, cb = ((d0 & 3) * 16 + hi * 8) * 2;
    const bf16x8 b0 = *(const LAS bf16x8*)(Ks + sub * 8192 + KSW(r32, cb));
    const bf16x8 b1 = *(const LAS bf16x8*)(Ks + sub * 8192 + KSW(32 + r32, cb));
    p0 = __builtin_amdgcn_mfma_f32_32x32x16_bf16(b0, qr[d0], p0, 0, 0, 0);
    p1 = __builtin_amdgcn_mfma_f32_32x32x16_bf16(b1, qr[d0], p1, 0, 0, 0); }
#if ATT_DUP == 2
  if constexpr (DQK == 64) { bf16x8 zq = {0, 0, 0, 0, 0, 0, 0, 0}; asm volatile("" : "+v"(zq));
    const bf16x8 bz = *(const LAS bf16x8*)(Ks + KSW(r32, hi * 16));
#pragma unroll
    for (int d0 = 0; d0 < 2; ++d0) { p0 = __builtin_amdgcn_mfma_f32_32x32x16_bf16(bz, zq, p0, 0, 0, 0); p1 = __builtin_amdgcn_mfma_f32_32x32x16_bf16(bz, zq, p1, 0, 0, 0); } }
#endif
}
__device__ __forceinline__ int v_st(int k, int c) { const int kk = (k & ~0xC) | ((k & 4) << 1) | ((k & 8) >> 1); return ((kk >> 3) * 4 + (c >> 5)) * 512 + ((kk & 7) * 32 + (c & 31)) * 2; }
__device__ __forceinline__ int v_rd_base(int lane) { return ((lane & 3) << 3) | (((lane >> 2) & 3) << 6) | (((lane >> 4) & 1) << 5) | (((lane >> 5) & 1) << 8); }
constexpr int v_rd_off(int d0, int ks, int half) { return d0 * 512 + ks * 4096 + half * 2048; }
template <int OFF> __device__ __forceinline__ s16x4 tr_read(int vb) {
  s16x4 r; asm volatile("ds_read_b64_tr_b16 %0, %1 offset:%2" : "=&v"(r) : "v"(vb), "i"(OFF) : "memory"); return r;
}
template <int KS> __device__ __forceinline__ void pv_step(f32x16* o, int vb, bf16x8 pa) {
  s16x4 l0, h0, l1, h1, l2, h2, l3, h3;
  l0 = tr_read<v_rd_off(0, KS, 0)>(vb); h0 = tr_read<v_rd_off(0, KS, 1)>(vb); l1 = tr_read<v_rd_off(1, KS, 0)>(vb); h1 = tr_read<v_rd_off(1, KS, 1)>(vb);
  l2 = tr_read<v_rd_off(2, KS, 0)>(vb); h2 = tr_read<v_rd_off(2, KS, 1)>(vb); l3 = tr_read<v_rd_off(3, KS, 0)>(vb); h3 = tr_read<v_rd_off(3, KS, 1)>(vb);
  asm volatile("s_waitcnt lgkmcnt(0)" ::: "memory"); SBAR();
#define PK(L, H) (bf16x8){L[0], L[1], L[2], L[3], H[0], H[1], H[2], H[3]}
  o[0] = __builtin_amdgcn_mfma_f32_32x32x16_bf16(pa, PK(l0, h0), o[0], 0, 0, 0);
  o[1] = __builtin_amdgcn_mfma_f32_32x32x16_bf16(pa, PK(l1, h1), o[1], 0, 0, 0);
  o[2] = __builtin_amdgcn_mfma_f32_32x32x16_bf16(pa, PK(l2, h2), o[2], 0, 0, 0);
  o[3] = __builtin_amdgcn_mfma_f32_32x32x16_bf16(pa, PK(l3, h3), o[3], 0, 0, 0);
#undef PK
}
__device__ __forceinline__ void pv_d0(f32x16* o, int vb, bf16x8 pa0, bf16x8 pa1, bf16x8 pa2, bf16x8 pa3) {
  pv_step<0>(o, vb, pa0); pv_step<1>(o, vb, pa1); pv_step<2>(o, vb, pa2); pv_step<3>(o, vb, pa3);
}
template <int DQK>
__device__ __forceinline__ void attn_core(const Src in, const float C, const float thr, const int seq, LAS char* lds, f32x16 (&o)[4]) {
  constexpr int NSUB = DQK / 64, SHM_K = NSUB * 8192;
  int lane; asm volatile("v_and_b32 %0, 63, %1" : "=v"(lane) : "v"(threadIdx.x));
  const int tid = threadIdx.x, wid = __builtin_amdgcn_readfirstlane(tid >> 6), r32 = lane & 31, hi = (lane >> 5) & 1;
  LAS char* V_lds = lds; LAS char* K_lds = lds + 3 * SHM_V;
  LAS float* ws = (LAS float*)(lds + 3 * SHM_V + 3 * SHM_K) + wid * 64; LAS float* li_l = ws; LAS float* al_l = ws + 32;
  float m_reg = -1e30f, l_reg = 0;
#pragma unroll
  for (int d = 0; d < 4; ++d) o[d] = f32x16{};
  bf16x8 qr[DQK / 16];
  const bf16_t* Qw = in.Q + (size_t)(wid * QBLK + r32) * in.ldq + hi * 8;
#pragma unroll
  for (int d0 = 0; d0 < DQK / 16; ++d0) qr[d0] = *(const bf16x8*)(Qw + d0 * 16);
  const int krow = wid * 8 + (lane >> 3), kslot = (lane & 7) ^ ((krow >> 1) & 7);
  const unsigned koff = (unsigned)(krow * in.ldk + kslot * 8) * 2u, k2off = (unsigned)(krow * in.ldk2 + kslot * 8) * 2u;
  unsigned voff[2];
#pragma unroll
  for (int i = 0; i < 2; ++i) { const int p = i * 8192 + wid * 1024 + lane * 16, st = p >> 9, wq = (p & 511) >> 1, kk = (st >> 2) * 8 + (wq >> 5), cl = wq & 31;
    const int k = (kk & ~0xC) | ((kk & 4) << 1) | ((kk & 8) >> 1); voff[i] = (unsigned)(k * in.ldv + (st & 3) * 32 + cl) * 2u; }
  const int vb0 = (int)(unsigned)(size_t)V_lds + v_rd_base(lane);
  const unsigned ldsw = (unsigned)wid * 1024u;
#define GLDS(gp, lp) __builtin_amdgcn_global_load_lds((const unsigned*)(gp), (LAS unsigned*)(lp), 16, 0, 0)
#define ISSUE_K(t, b) do { const char* kb_ = (const char*)in.K + (size_t)(t) * (KVBLK * 2) * in.ldk; \
    _Pragma("unroll") for (int s_ = 0; s_ < NSUB; ++s_) { if (s_ < 2) GLDS(kb_ + s_ * 128 + koff, K_lds + (b) * SHM_K + s_ * 8192 + ldsw); \
      else GLDS((const char*)in.K2 + (size_t)(t) * (KVBLK * 2) * in.ldk2 + k2off, K_lds + (b) * SHM_K + s_ * 8192 + ldsw); } } while (0)
#define ISSUE_V(t, b) do { const char* vb_ = (const char*)in.V + (size_t)(t) * (KVBLK * 2) * in.ldv; \
    GLDS(vb_ + voff[0], V_lds + (b) * SHM_V + ldsw); GLDS(vb_ + voff[1], V_lds + (b) * SHM_V + 8192 + ldsw); \
    if (ATT_DUP == 3) { GLDS(vb_ + voff[0], V_lds + (b) * SHM_V + ldsw); GLDS(vb_ + voff[1], V_lds + (b) * SHM_V + 8192 + ldsw); } } while (0)
#define WAITV(n) asm volatile("s_waitcnt vmcnt(%0)" :: "n"((DBG_SKIP & 4) ? 0 : (n)) : "memory")
#define WBAR() do { asm volatile("" ::: "memory"); __builtin_amdgcn_s_barrier(); asm volatile("" ::: "memory"); } while (0)
#define RESC(a) do { if (__any((a) < 1.f)) { if (hi == 0) al_l[r32] = (a); asm volatile("s_waitcnt lgkmcnt(0)" ::: "memory"); \
    _Pragma("unroll") for (int d = 0; d < 4; ++d) _Pragma("unroll") for (int r = 0; r < 16; ++r) o[d][r] *= al_l[crow(r, hi)]; } } while (0)
#define NXT3(x) ((x) == 2 ? 0 : (x) + 1)
  constexpr int NI = NSUB + (ATT_DUP == 3 ? 4 : 2), NV = (ATT_DUP == 3 ? 4 : 2);
  f32x16 pA0, pA1, pB0, pB1; float mnA, mnB, alA, alB; bf16x8 pa0, pa1, pa2, pa3; const int NT = seq / KVBLK;
  const bool lead = wid < 4;
  ISSUE_K(0, 0); ISSUE_K(1, 1); ISSUE_V(0, 0);
  if (!lead) { WAITV(NI); WBAR(); }
  WAITV(NI); WBAR();
  ISSUE_K(2, 2);
  qkt<DQK>(pA0, pA1, K_lds, qr, r32, hi);
  WAITV(NI); WBAR();
  ISSUE_V(1, 1);
  partialSM(pA0, pA1, m_reg, mnA, alA, C, thr);
  WAITV(NI); WBAR();
  int bq = 1;
  for (int j = 1; j + 3 < NT; j += 2) {
    { const int b1 = NXT3(bq), b2 = NXT3(b1);
      ISSUE_K(j + 2, b2);
      SBAR(); qkt<DQK>(pB0, pB1, K_lds + bq * SHM_K, qr, r32, hi);
      finishSM(pA0, pA1, alA, l_reg, pa0, pa1, pa2, pa3); SBAR();
      WAITV(NI); WBAR();
      ISSUE_V(j + 1, b1);
      pv_d0(o, vb0 + b2 * SHM_V, pa0, pa1, pa2, pa3); partialSM(pB0, pB1, m_reg, mnB, alB, C, thr);
      RESC(alB); bq = b1;
      WAITV(NI); WBAR(); }
    { const int b1 = NXT3(bq), b2 = NXT3(b1);
      ISSUE_K(j + 3, b2);
      SBAR(); qkt<DQK>(pA0, pA1, K_lds + bq * SHM_K, qr, r32, hi);
      finishSM(pB0, pB1, alB, l_reg, pa0, pa1, pa2, pa3); SBAR();
      WAITV(NI); WBAR();
      ISSUE_V(j + 2, b1);
      pv_d0(o, vb0 + b2 * SHM_V, pa0, pa1, pa2, pa3); partialSM(pA0, pA1, m_reg, mnA, alA, C, thr);
      RESC(alA); bq = b1;
      WAITV(NI); WBAR(); }
  }
  { const int b1 = NXT3(bq), b2 = NXT3(b1);
    ISSUE_K(NT - 1, b2);
    SBAR(); qkt<DQK>(pB0, pB1, K_lds + bq * SHM_K, qr, r32, hi);
    finishSM(pA0, pA1, alA, l_reg, pa0, pa1, pa2, pa3); SBAR();
    WAITV(NI); WBAR();
    ISSUE_V(NT - 2, b1);
    pv_d0(o, vb0 + b2 * SHM_V, pa0, pa1, pa2, pa3); partialSM(pB0, pB1, m_reg, mnB, alB, C, thr);
    RESC(alB); bq = b1;
    WAITV(NI); WBAR(); }
  { const int b1 = NXT3(bq), b2 = NXT3(b1);
    SBAR(); qkt<DQK>(pA0, pA1, K_lds + bq * SHM_K, qr, r32, hi);
    finishSM(pB0, pB1, alB, l_reg, pa0, pa1, pa2, pa3); SBAR();
    WAITV(NV); WBAR();
    ISSUE_V(NT - 1, b1);
    pv_d0(o, vb0 + b2 * SHM_V, pa0, pa1, pa2, pa3); partialSM(pA0, pA1, m_reg, mnA, alA, C, thr);
    RESC(alA); bq = b1;
    WAITV(NV); WBAR(); }
  { const int b2 = NXT3(NXT3(bq));
    SBAR(); qkt<DQK>(pB0, pB1, K_lds + bq * SHM_K, qr, r32, hi);
    finishSM(pA0, pA1, alA, l_reg, pa0, pa1, pa2, pa3); SBAR();
    WAITV(0); WBAR();
    pv_d0(o, vb0 + b2 * SHM_V, pa0, pa1, pa2, pa3); partialSM(pB0, pB1, m_reg, mnB, alB, C, thr);
    RESC(alB);
    WBAR(); }
  finishSM(pB0, pB1, alB, l_reg, pa0, pa1, pa2, pa3); SBAR();
  pv_d0(o, vb0 + bq * SHM_V, pa0, pa1, pa2, pa3);
  if (lead) { WBAR(); }
  if (hi == 0) li_l[r32] = l_reg; asm volatile("s_waitcnt lgkmcnt(0)" ::: "memory");
#pragma unroll
  for (int r = 0; r < 16; ++r) { const float rl = __builtin_amdgcn_rcpf(li_l[crow(r, hi)]);
#pragma unroll
    for (int d = 0; d < 4; ++d) o[d][r] *= rl; }
  asm volatile("s_waitcnt lgkmcnt(0)" ::: "memory"); WBAR();
#undef GLDS
#undef ISSUE_K
#undef ISSUE_V
#undef WAITV
#undef WBAR
#undef RESC
#undef NXT3
}
template <int DQK>
__device__ __forceinline__ void attn_core_seq(const Src in, const float C, const float thr, const int seq, LAS char* lds, f32x16 (&o)[4]) {
  constexpr int NSUB = DQK / 64, SHM_K = NSUB * 8192;
  const int tid = threadIdx.x, wid = __builtin_amdgcn_readfirstlane(tid >> 6), lane = tid & 63, r32 = lane & 31, hi = lane >> 5;
  LAS char* V_lds = lds; LAS char* K_lds = lds + 3 * SHM_V;
  LAS float* ws = (LAS float*)(lds + 3 * SHM_V + 3 * SHM_K) + wid * 64; LAS float* li_l = ws; LAS float* al_l = ws + 32;
  float m_reg = -1e30f, l_reg = 0;
#pragma unroll
  for (int d = 0; d < 4; ++d) o[d] = f32x16{};
  bf16x8 qr[DQK / 16];
  const bf16_t* Qw = in.Q + (size_t)(wid * QBLK + r32) * in.ldq + hi * 8;
#pragma unroll
  for (int d0 = 0; d0 < DQK / 16; ++d0) qr[d0] = *(const bf16x8*)(Qw + d0 * 16);
  const int krow = wid * 8 + (lane >> 3), kslot = (lane & 7) ^ ((krow >> 1) & 7);
  const unsigned koff = (unsigned)(krow * in.ldk + kslot * 8) * 2u, k2off = (unsigned)(krow * in.ldk2 + kslot * 8) * 2u;
  unsigned voff[2];
#pragma unroll
  for (int i = 0; i < 2; ++i) { const int p = i * 8192 + wid * 1024 + lane * 16, st = p >> 9, wq = (p & 511) >> 1, kk = (st >> 2) * 8 + (wq >> 5), cl = wq & 31;
    const int k = (kk & ~0xC) | ((kk & 4) << 1) | ((kk & 8) >> 1); voff[i] = (unsigned)(k * in.ldv + (st & 3) * 32 + cl) * 2u; }
  const int vb0 = (int)(unsigned)(size_t)V_lds + v_rd_base(lane);
  const unsigned ldsw = (unsigned)wid * 1024u;
#define GLDS(gp, lp) __builtin_amdgcn_global_load_lds((const unsigned*)(gp), (LAS unsigned*)(lp), 16, 0, 0)
#define ISSUE_K(t, b) do { const char* kb_ = (const char*)in.K + (size_t)(t) * (KVBLK * 2) * in.ldk; \
    _Pragma("unroll") for (int s_ = 0; s_ < NSUB; ++s_) { if (s_ < 2) GLDS(kb_ + s_ * 128 + koff, K_lds + (b) * SHM_K + s_ * 8192 + ldsw); \
      else GLDS((const char*)in.K2 + (size_t)(t) * (KVBLK * 2) * in.ldk2 + k2off, K_lds + (b) * SHM_K + s_ * 8192 + ldsw); } } while (0)
#define ISSUE_V(t, b) do { const char* vb_ = (const char*)in.V + (size_t)(t) * (KVBLK * 2) * in.ldv; \
    GLDS(vb_ + voff[0], V_lds + (b) * SHM_V + ldsw); GLDS(vb_ + voff[1], V_lds + (b) * SHM_V + 8192 + ldsw); } while (0)
#define WAITV(n) asm volatile("s_waitcnt vmcnt(%0)" :: "n"(n) : "memory")
#define WBAR() do { asm volatile("" ::: "memory"); __builtin_amdgcn_s_barrier(); asm volatile("" ::: "memory"); } while (0)
#define RESC(a) do { if (__any((a) < 1.f)) { if (hi == 0) al_l[r32] = (a); asm volatile("s_waitcnt lgkmcnt(0)" ::: "memory"); \
    _Pragma("unroll") for (int d = 0; d < 4; ++d) _Pragma("unroll") for (int r = 0; r < 16; ++r) o[d][r] *= al_l[crow(r, hi)]; } } while (0)
#define NXT3(x) ((x) == 2 ? 0 : (x) + 1)
  constexpr int NI = NSUB + 2;
  f32x16 p0, p1; float mn, al; bf16x8 pa0, pa1, pa2, pa3; const int NT = seq / KVBLK;
  ISSUE_K(0, 0); ISSUE_V(0, 0); ISSUE_K(1, 1); ISSUE_V(1, 1);
  int bq = 0;
  for (int j = 0; j + 1 < NT; ++j) {
    const int b1 = NXT3(bq), b2 = NXT3(b1);
    WAITV(NI); WBAR();
    if (j + 2 < NT) { ISSUE_K(j + 2, b2); ISSUE_V(j + 2, b2); }
    else { ISSUE_K(NT - 1, b2); ISSUE_V(NT - 1, b2); }
    qkt<DQK>(p0, p1, K_lds + bq * SHM_K, qr, r32, hi); partialSM(p0, p1, m_reg, mn, al, C, thr);
    RESC(al);
    finishSM(p0, p1, al, l_reg, pa0, pa1, pa2, pa3); SBAR();
    pv_d0(o, vb0 + bq * SHM_V, pa0, pa1, pa2, pa3);
    bq = b1;
  }
  WAITV(NI); WBAR();
  qkt<DQK>(p0, p1, K_lds + bq * SHM_K, qr, r32, hi); partialSM(p0, p1, m_reg, mn, al, C, thr);
  RESC(al);
  finishSM(p0, p1, al, l_reg, pa0, pa1, pa2, pa3); SBAR();
  pv_d0(o, vb0 + bq * SHM_V, pa0, pa1, pa2, pa3);
  WAITV(0);
  if (hi == 0) li_l[r32] = l_reg; asm volatile("s_waitcnt lgkmcnt(0)" ::: "memory");
#pragma unroll
  for (int r = 0; r < 16; ++r) { const float rl = __builtin_amdgcn_rcpf(li_l[crow(r, hi)]);
#pragma unroll
    for (int d = 0; d < 4; ++d) o[d][r] *= rl; }
  asm volatile("s_waitcnt lgkmcnt(0)" ::: "memory"); WBAR();
#undef GLDS
#undef ISSUE_K
#undef ISSUE_V
#undef WAITV
#undef WBAR
#undef RESC
#undef NXT3
}
__device__ __forceinline__ void attn_core_da2(const Src in, const float C, const float thr, const int seq, LAS char* lds, f32x16 (&o1)[4], f32x16 (&o2)[4]) {
  constexpr int NSUB = 2, SHM_K = NSUB * 8192;
  const int tid = threadIdx.x, wid = __builtin_amdgcn_readfirstlane(tid >> 6), lane = tid & 63, r32 = lane & 31, hi = lane >> 5;
  LAS char* V_lds = lds; LAS char* K_lds = lds + 3 * SHM_V;
  LAS float* ws = (LAS float*)(lds + 3 * SHM_V + 3 * SHM_K) + wid * 64; LAS float* li_l = ws; LAS float* al_l = ws + 32;
  float m1 = -1e30f, l1 = 0, m2 = -1e30f, l2 = 0;
#pragma unroll
  for (int d = 0; d < 4; ++d) { o1[d] = f32x16{}; o2[d] = f32x16{}; }
  bf16x8 q1[4], q2[4];
  const bf16_t* Qw = in.Q + (size_t)(wid * QBLK + r32) * in.ldq + hi * 8;
#pragma unroll
  for (int d0 = 0; d0 < 4; ++d0) { q1[d0] = *(const bf16x8*)(Qw + d0 * 16); q2[d0] = *(const bf16x8*)(Qw + 64 + d0 * 16); }
  const int krow = wid * 8 + (lane >> 3), kslot = (lane & 7) ^ ((krow >> 1) & 7);
  const unsigned koff = (unsigned)(krow * in.ldk + kslot * 8) * 2u;
  unsigned voff[2];
#pragma unroll
  for (int i = 0; i < 2; ++i) { const int p = i * 8192 + wid * 1024 + lane * 16, st = p >> 9, wq = (p & 511) >> 1, kk = (st >> 2) * 8 + (wq >> 5), cl = wq & 31;
    const int k = (kk & ~0xC) | ((kk & 4) << 1) | ((kk & 8) >> 1); voff[i] = (unsigned)(k * in.ldv + (st & 3) * 32 + cl) * 2u; }
  const int vb0 = (int)(unsigned)(size_t)V_lds + v_rd_base(lane);
  const unsigned ldsw = (unsigned)wid * 1024u;
#define GLDS(gp, lp) __builtin_amdgcn_global_load_lds((const unsigned*)(gp), (LAS unsigned*)(lp), 16, 0, 0)
#define ISSUE_KV(t, b) do { const char* kb_ = (const char*)in.K + (size_t)(t) * (KVBLK * 2) * in.ldk; const char* vb_ = (const char*)in.V + (size_t)(t) * (KVBLK * 2) * in.ldv; \
    GLDS(kb_ + koff, K_lds + (b) * SHM_K + ldsw); GLDS(kb_ + 128 + koff, K_lds + (b) * SHM_K + 8192 + ldsw); \
    GLDS(vb_ + voff[0], V_lds + (b) * SHM_V + ldsw); GLDS(vb_ + voff[1], V_lds + (b) * SHM_V + 8192 + ldsw); } while (0)
#define WAITV(n) asm volatile("s_waitcnt vmcnt(%0)" :: "n"(n) : "memory")
#define WBAR() do { asm volatile("" ::: "memory"); __builtin_amdgcn_s_barrier(); asm volatile("" ::: "memory"); } while (0)
#define RESC(oo, a) do { if (__any((a) < 1.f)) { if (hi == 0) al_l[r32] = (a); asm volatile("s_waitcnt lgkmcnt(0)" ::: "memory"); \
    _Pragma("unroll") for (int d = 0; d < 4; ++d) _Pragma("unroll") for (int r = 0; r < 16; ++r) oo[d][r] *= al_l[crow(r, hi)]; asm volatile("s_waitcnt lgkmcnt(0)" ::: "memory"); } } while (0)
#define NXT3(x) ((x) == 2 ? 0 : (x) + 1)
#define TILE_BODY(b) do { f32x16 p0, p1; float mn, al; bf16x8 pa0, pa1, pa2, pa3; \
    qkt<64>(p0, p1, K_lds + (b) * SHM_K, q1, r32, hi); partialSM(p0, p1, m1, mn, al, C, thr); RESC(o1, al); \
    finishSM(p0, p1, al, l1, pa0, pa1, pa2, pa3); SBAR(); pv_d0(o1, vb0 + (b) * SHM_V, pa0, pa1, pa2, pa3); SBAR(); \
    qkt<64>(p0, p1, K_lds + (b) * SHM_K + 8192, q2, r32, hi); partialSM(p0, p1, m2, mn, al, C, thr); RESC(o2, al); \
    finishSM(p0, p1, al, l2, pa0, pa1, pa2, pa3); SBAR(); pv_d0(o2, vb0 + (b) * SHM_V, pa0, pa1, pa2, pa3); SBAR(); } while (0)
  const int NT = seq / KVBLK;
  ISSUE_KV(0, 0); ISSUE_KV(1, 1);
  int bq = 0;
  for (int j = 0; j + 1 < NT; ++j) {
    const int b1 = NXT3(bq), b2 = NXT3(b1);
    WAITV(4); WBAR();
    if (j + 2 < NT) ISSUE_KV(j + 2, b2); else ISSUE_KV(NT - 1, b2);
    TILE_BODY(bq);
    bq = b1;
  }
  WAITV(4); WBAR();
  TILE_BODY(bq);
  WAITV(0);
  if (hi == 0) { li_l[r32] = l1; al_l[r32] = l2; } asm volatile("s_waitcnt lgkmcnt(0)" ::: "memory");
#pragma unroll
  for (int r = 0; r < 16; ++r) { const float ra = __builtin_amdgcn_rcpf(li_l[crow(r, hi)]), rb = __builtin_amdgcn_rcpf(al_l[crow(r, hi)]);
#pragma unroll
    for (int d = 0; d < 4; ++d) { o1[d][r] *= ra; o2[d][r] *= rb; } }
  asm volatile("s_waitcnt lgkmcnt(0)" ::: "memory"); WBAR();
#undef GLDS
#undef ISSUE_KV
#undef WAITV
#undef WBAR
#undef RESC
#undef NXT3
#undef TILE_BODY
}
}

constexpr int NWAVES = 8;
struct Args { const void* in[27]; float* out; unsigned char* ws; int ph_lo, ph_hi, li, pad; };

__constant__ float c_invA[8] = {1.0f, 0.19392274474868576f, 0.03760603093086393f, 0.007292664737217109f, 0.001414213562373095f, 0.0002742481756762073f, 5.318295896944988e-05f, 1.031338537721246e-05f};
__constant__ float c_invM[32] = {1.0f, 0.6636012376960885f, 0.44036660267178046f, 0.2922278225730151f, 0.19392274474868576f, 0.12868737343265052f, 0.08539710028576561f, 0.05666962144529105f,
    0.03760603093086393f, 0.024955408670558694f, 0.016560440080994446f, 0.010989528534539826f, 0.007292664737217109f, 0.004839421345719893f, 0.003211445994752591f, 0.0021311195369119653f,
    0.001414213562373095f, 0.0009384738703573802f, 0.000622772421914596f, 0.0004132725499855165f, 0.0002742481756762073f, 0.00018199142881462546f, 0.00012076973741146504f, 8.01429472224798e-05f,
    5.318295896944988e-05f, 3.529227739646723e-05f, 2.341999896140934e-05f, 1.5541540297632344e-05f, 1.031338537721246e-05f, 6.8439753011549275e-06f, 4.5416704806078695e-06f, 3.013858152139171e-06f};

__device__ __forceinline__ int permDA(int i) { return i < 16 ? (i >> 1) + 8 * (i & 1) : i; }
__device__ __forceinline__ int permM(int i) { return (i >> 1) + 32 * (i & 1); }
__device__ __forceinline__ int src_in(int j) {
    if (j < 2048) return (j & ~63) + permDA(j & 63);
    if (j < 4352) return j;
    if (j < 6400) return 4416 + (j - 4352);
    if (j < 6464) return 4352 + permM(j - 6400);
    return -1;
}
__device__ __forceinline__ int src_uq(int j) { const int hd = j / 192, off = j % 192; return off < 128 ? j : hd * 192 + 128 + permM(off - 128); }

__device__ __forceinline__ void tr_item(const float* W, int K, int N, bf16_t* WT, int n0, int k0, int scol, const float* rs, LAS float* scr, int lane) {
#pragma unroll 8
    for (int i = 0; i < 32; ++i) { const int kk = 2 * i + (lane >> 5); float v = 0.f; if (scol >= 0) { v = W[(size_t)(k0 + kk) * N + scol]; if (rs) v *= rs[k0 + kk]; } scr[kk * 33 + (lane & 31)] = v; }
    LDS_WAIT(); asm volatile("" ::: "memory");
    const int c = lane & 7;
#pragma unroll
    for (int j = 0; j < 4; ++j) { const int n = (lane >> 3) + 8 * j; const LAS float* s = scr + (8 * c) * 33 + n;
        u32x4 o; o.x = cvt_pk_bf16(s[0 * 33], s[1 * 33]); o.y = cvt_pk_bf16(s[2 * 33], s[3 * 33]); o.z = cvt_pk_bf16(s[4 * 33], s[5 * 33]); o.w = cvt_pk_bf16(s[6 * 33], s[7 * 33]);
        *(u32x4*)(WT + (size_t)(n0 + n) * K + k0 + 8 * c) = o; }
    LDS_WAIT(); asm volatile("" ::: "memory");
}

template <int MODE = 0>
__device__ __forceinline__ void cvt_tile64(const float* W, int N, bf16_t* WT, int Kd, int k0, int n0, int drow0, int lane, const float* rs = nullptr) {
    const int g = lane >> 4, x = lane & 15;
    const float* src = W + (size_t)(k0 + 16 * g) * N + n0 + 4 * x;
    f32x4 v[16];
#pragma unroll
    for (int i = 0; i < 16; ++i) v[i] = __builtin_nontemporal_load((const f32x4*)(src + (size_t)i * N));
    if (rs) {
#pragma unroll
        for (int i = 0; i < 16; ++i) v[i] = v[i] * rs[k0 + 16 * g + i];
    }
#pragma unroll
    for (int j = 0; j < 4; ++j) { u32x4 lo, hi;
        lo.x = cvt_pk_bf16(v[0][j], v[1][j]); lo.y = cvt_pk_bf16(v[2][j], v[3][j]); lo.z = cvt_pk_bf16(v[4][j], v[5][j]); lo.w = cvt_pk_bf16(v[6][j], v[7][j]);
        hi.x = cvt_pk_bf16(v[8][j], v[9][j]); hi.y = cvt_pk_bf16(v[10][j], v[11][j]); hi.z = cvt_pk_bf16(v[12][j], v[13][j]); hi.w = cvt_pk_bf16(v[14][j], v[15][j]);
        const int c = 4 * x + j;
        const int dr = MODE == 1 ? 2 * (c & 31) + (c >> 5) : (MODE == 2 ? (c < 16 ? 2 * (c & 7) + (c >> 3) : c) : c);
        bf16_t* d = WT + (size_t)(drow0 + dr) * Kd + k0 + 16 * g;
        *(u32x4*)d = lo; *(u32x4*)(d + 8) = hi; }
}

__global__ void __launch_bounds__(NWAVES * 64, 2) fwd(Args args) {
#define KARGS() const __attribute__((address_space(4))) unsigned long long* ka_ = (const __attribute__((address_space(4))) unsigned long long*)__builtin_amdgcn_kernarg_segment_ptr(); asm volatile("" : "+s"(ka_))
#define AIN(i) ((const void*)ka_[i])
#define AOUT ((float*)ka_[27])
#define AWS ((unsigned char*)ka_[28])
    extern __shared__ __attribute__((aligned(16))) unsigned char lds_raw[];
    LAS unsigned char* lds = (LAS unsigned char*)lds_raw;
    volatile LAS unsigned* MISC = (volatile LAS unsigned*)(lds + MISC_OFF);
    const int tid = threadIdx.x, wave = __builtin_amdgcn_readfirstlane(tid >> 6);
#define LANE_DECL int lane; asm volatile("v_and_b32 %0, 63, %1" : "=v"(lane) : "v"(threadIdx.x))
    const int G = gridDim.x, bx = blockIdx.x;
    unsigned* ctl = (unsigned*)(args.ws + WS_CTL);
    const int lo = args.ph_lo, hi_ph = args.ph_hi;
    if (tid < 32) MISC[tid] = 0u;
    __syncthreads();
    XcdBarrier bar; bar.bar = ctl + CW_BAR + args.li * XCD_BAR_WORDS; bar.x = 0; bar.st = nullptr;
    if (!MK_PER_PHASE) bar = xcd_barrier_post(ctl + CW_BAR + args.li * XCD_BAR_WORDS, MISC + 8);
#define IN(k) (((PH_MASK >> (k)) & 1) && lo <= (k) && (k) < hi_ph)
#define SEAM(k) do { if (IN(k) && IN((k) + 1)) xcd_barrier(bar); } while (0)
    const int gw = bx * NWAVES + wave, NGW = G * NWAVES;

#define xin ((const float*)AIN(0))
#define positions ((const int*)AIN(1))
#define Bt_in ((bf16_t*)(AWS + WS_BT_IN))
#define Bt_uq ((bf16_t*)(AWS + WS_BT_UQ))
#define Bt_ukv ((bf16_t*)(AWS + WS_BT_UKV))
#define Bt_od ((bf16_t*)(AWS + WS_BT_OD))
#define Bt_om ((bf16_t*)(AWS + WS_BT_OM))
#define Bt_out ((bf16_t*)(AWS + WS_BT_OUT))
#define ropeA ((float*)(AWS + WS_ROPEA))
#define ropeM ((float*)(AWS + WS_ROPEM))
#define sq ((float*)(AWS + WS_SQ2))
#define hbuf ((bf16_t*)(AWS + WS_H))
#define oa ((bf16_t*)(AWS + WS_H))
#define qa ((bf16_t*)(AWS + WS_QA))
#define ka ((bf16_t*)(AWS + WS_KA))
#define va ((bf16_t*)(AWS + WS_VA))
#define cq ((bf16_t*)(AWS + WS_CQ))
#define ckv ((bf16_t*)(AWS + WS_CKV))
#define kr ((bf16_t*)(AWS + WS_KR))
#define gates ((bf16_t*)(AWS + WS_GATES))
#define qm ((bf16_t*)(AWS + WS_QM))
#define kv ((bf16_t*)(AWS + WS_KV))
#define ob ((bf16_t*)(AWS + WS_OB))
#define mrg ((bf16_t*)(AWS + WS_MRG))
#define stash ((float*)(AWS + WS_STASH))
#define rowtok_p ((int*)(AWS + WS_ROWTOK))
#define assign ((u32x2*)(AWS + WS_ASSIGN))
#define Bt_d ((bf16_t*)(AWS + WS_BT_D))
#define Bt_gu ((bf16_t*)(AWS + WS_BT_GU))
#define h2 ((bf16_t*)(AWS + WS_H2))
#define act ((bf16_t*)(AWS + WS_ACT))
#define ybuf ((bf16_t*)(AWS + WS_Y))
#define count ((unsigned*)(AWS + WS_CTL) + CW_COUNT)

    if (IN(0)) {
        KARGS();
        LANE_DECL;
        const float* w_in = (const float*)AIN(3); const float* g_q = (const float*)AIN(9); const float* g_kv = (const float*)AIN(10);
        const float* w_uq = (const float*)AIN(11); const float* w_ukv = (const float*)AIN(12);
        const float* w_od = (const float*)AIN(13); const float* w_om = (const float*)AIN(14); const float* w_out = (const float*)AIN(16);
        constexpr int I_IN = 16 * 101, I_PAD = 16 * 3, I_UQ = 12 * 24, I_UKV = 8 * 32, I_O = 16 * 16;
        constexpr int NITEMS = I_IN + I_PAD + I_UQ + I_UKV + 3 * I_O;
        for (int it = gw; it < NITEMS; it += NGW) {
            int r = it;
            if (r < I_IN) { const int kb = r / 101, cb = r % 101, n0 = cb * 64;
                if (n0 < 2048) cvt_tile64<2>(w_in, 6464, Bt_in, D, kb * 64, n0, n0, lane);
                else if (n0 < 4352) cvt_tile64<0>(w_in, 6464, Bt_in, D, kb * 64, n0, n0, lane);
                else if (n0 < 4416) cvt_tile64<1>(w_in, 6464, Bt_in, D, kb * 64, n0, 5888, lane);
                else if (n0 < 4416 + 1536) cvt_tile64<0>(w_in, 6464, Bt_in, D, kb * 64, n0, n0 - 64, lane);
                else cvt_tile64<0>(w_in, 6464, Bt_in, D, kb * 64, n0, n0 - 64 + 256, lane);
                continue; } r -= I_IN;
            if (r < I_PAD) { const int kb = r / 3, rb = r % 3; const int g = lane >> 4, x4 = lane & 15;
#pragma unroll
                for (int j = 0; j < 4; ++j) { bf16_t* d = Bt_in + (size_t)(5952 + rb * 64 + 4 * x4 + j) * D + kb * 64 + 16 * g; *(u32x4*)d = (u32x4){0u, 0u, 0u, 0u}; *(u32x4*)(d + 8) = (u32x4){0u, 0u, 0u, 0u}; }
                continue; } r -= I_PAD;
            if (r < I_UQ) { const int kb = r / 24, cb = r % 24, n0 = cb * 64;
                if ((cb % 3) == 2) cvt_tile64<1>(w_uq, 1536, Bt_uq, QL, kb * 64, n0, n0, lane, g_q); else cvt_tile64<0>(w_uq, 1536, Bt_uq, QL, kb * 64, n0, n0, lane, g_q);
                continue; } r -= I_UQ;
            if (r < I_UKV) { const int kb = r / 32, cb = r % 32; cvt_tile64<0>(w_ukv, 2048, Bt_ukv, KVL, kb * 64, cb * 64, cb * 64, lane, g_kv); continue; } r -= I_UKV;
            const int which = r / I_O; r -= which * I_O; const int kb = r / 16, cb = r % 16;
            cvt_tile64<0>(which == 0 ? w_od : (which == 1 ? w_om : w_out), D, which == 0 ? Bt_od : (which == 1 ? Bt_om : Bt_out), D, kb * 64, cb * 64, cb * 64, lane);
        }
        const float* g_mix = (const float*)AIN(2);
        for (int m = gw * 4; m < T; m += NGW * 4) {
            f32x4 v[4][4]; float ss[4];
#pragma unroll
            for (int q = 0; q < 4; ++q) { const f32x4* xr = (const f32x4*)(xin + (size_t)(m + q) * D) + lane;
#pragma unroll
                for (int j = 0; j < 4; ++j) v[q][j] = xr[64 * j]; }
#pragma unroll
            for (int q = 0; q < 4; ++q) { float s = 0.f;
#pragma unroll
                for (int j = 0; j < 4; ++j) s += (v[q][j][0] * v[q][j][0] + v[q][j][1] * v[q][j][1]) + (v[q][j][2] * v[q][j][2] + v[q][j][3] * v[q][j][3]);
                ss[q] = __builtin_amdgcn_rsqf(wave_sum(s) * (1.f / D) + EPS); }
#pragma unroll
            for (int j = 0; j < 4; ++j) { const f32x4 gg = *((const f32x4*)g_mix + lane + 64 * j);
#pragma unroll
                for (int q = 0; q < 4; ++q) { u32x2 w; w.x = cvt_pk_bf16(v[q][j][0] * ss[q] * gg[0], v[q][j][1] * ss[q] * gg[1]); w.y = cvt_pk_bf16(v[q][j][2] * ss[q] * gg[2], v[q][j][3] * ss[q] * gg[3]);
                    ((u32x2*)(hbuf + (size_t)(m + q) * D) + lane)[64 * j] = w; } }
        }
        for (int idx = bx * 512 + tid; idx < T * 40; idx += G * 512) {
            const int t = idx / 40, i = idx % 40; const float inv = i < 8 ? c_invA[i] : c_invM[i - 8];
            const float ang = (float)positions[t] * inv;
            const double rev = (double)ang * 0.15915494309189535; const float fr_ = (float)(rev - __builtin_rint(rev));
            const float cs = __builtin_amdgcn_cosf(fr_), sn = __builtin_amdgcn_sinf(fr_);
            float* dst = i < 8 ? ropeA + ((size_t)t * 8 + i) * 2 : ropeM + ((size_t)t * 32 + (i - 8)) * 2; dst[0] = cs; dst[1] = sn;
        }
    }
    SEAM(0);
    if (IN(1)) {
        KARGS();
        pg8::Gemm g{hbuf, Bt_in, D}; pg8::DenseOrder S; S.init(T / 256, 24, G, bx);
        pg8::EpiIn E{qa, ka, va, cq, ckv, gates, kr, ropeA, ropeM, (const float*)AIN(15), sq};
        pg8::gemm_phase<pg8::EpiIn, pg8::DenseOrder, false, true>(lds, g, S, E);
    }
    SEAM(1);
    if (IN(2)) {
        KARGS();
        { pg8::Gemm g{hbuf, Bt_in, D}; pg8::DenseOrder S; S.init(T / 256, 2, G, bx, 24);
          pg8::EpiIn E{qa, ka, va, cq, ckv, gates, kr, ropeA, ropeM, (const float*)AIN(15), sq};
          pg8::gemm_phase<pg8::EpiIn, pg8::DenseOrder, false, true>(lds, g, S, E); }
        { pg8::Gemm g{cq, Bt_uq, QL}; pg8::DenseOrder S; S.init(T / 256, 1536 / 256, G, G - 1 - bx); pg8::EpiUp<true> E{qm, sq, ropeM};
          pg8::gemm_phase<pg8::EpiUp<true>, pg8::DenseOrder, false, true>(lds, g, S, E); }
        { pg8::Gemm g{ckv, Bt_ukv, KVL}; pg8::DenseOrder S; S.init(T / 256, 2048 / 256, G, bx); pg8::EpiUp<false> E{kv, sq, ropeM};
          pg8::gemm_phase<pg8::EpiUp<false>, pg8::DenseOrder, false, true>(lds, g, S, E); }
    }
    SEAM(2);
    if (IN(3)) {
        KARGS();
        const int lane = threadIdx.x & 63;
        const int wid = wave;
#define UNIT_DECODE(L) int u = (L) & 511; if (G == 256) { const int c = (L) & 255; u = ((L) & 256) + (c & 7) * 32 + (c >> 3); } \
            const int bh = u >> 4, qb = u & 15, b = bh >> 3, h = bh & 7; const size_t q0 = (size_t)b * SEQ + qb * 256, k0 = (size_t)b * SEQ
        for (int L = bx; L < 512; L += G) {
#if PROBE_PHASE == 3 && defined(PROBE_ATT)
            if (args.li == 1 && lo == 3 && PROBE_ATT != 0) continue;
#endif
            UNIT_DECODE(L);
            f32x16 o[4], o2[4];
            { att::Src in{qa + q0 * 1024 + h * 128, ka + k0 * 1024 + h * 128, nullptr, va + k0 * 1024 + h * 128, 1024, 1024, 0, 1024};
              att::attn_core_da2(in, 0.125f * 1.4426950408889634f, 8.f / 0.125f, SEQ, (LAS char*)lds, o, o2); }
            float lam;
            { const float* lq1 = (const float*)AIN(4); const float* lk1 = (const float*)AIN(5); const float* lq2 = (const float*)AIN(6); const float* lk2 = (const float*)AIN(7);
              const float s1 = wave_sum(lq1[lane] * lk1[lane]), s2 = wave_sum(lq2[lane] * lk2[lane]); lam = __expf(s1) - __expf(s2) + LAM_INIT; }
            float ss[16];
#pragma unroll
            for (int r = 0; r < 16; ++r) ss[r] = 0.f;
#pragma unroll
            for (int d = 0; d < 4; ++d)
#pragma unroll
                for (int r = 0; r < 16; ++r) { const float v = o[d][r] - lam * o2[d][r]; o[d][r] = v; ss[r] += v * v; }
#pragma unroll
            for (int r = 0; r < 16; ++r) {
#pragma unroll
                for (int msk = 1; msk < 32; msk <<= 1) ss[r] += __shfl_xor(ss[r], msk);
                ss[r] = __builtin_amdgcn_rsqf(ss[r] * (1.0f / 128.0f) + EPS); }
            int ln2; asm volatile("v_and_b32 %0, 63, %1" : "=v"(ln2) : "v"(threadIdx.x));
            const int hi2 = ln2 >> 5, r32e = ln2 & 31;
            bf16_t* Ow = oa + (q0 + wid * 32 + 4 * hi2) * 1024 + h * 128 + r32e;
            float gs[4];
#pragma unroll
            for (int d = 0; d < 4; ++d) gs[d] = ((const float*)AIN(8))[d * 32 + r32e] * (1.0f - LAM_INIT);
#pragma unroll
            for (int r = 0; r < 16; ++r) { const int orow = att::crow(r, 0);
#pragma unroll
                for (int d = 0; d < 4; ++d) Ow[orow * 1024 + d * 32] = (bf16_t)(cvt_pk_bf16(o[d][r] * ss[r] * gs[d], 0.f) & 0xffffu); }
        }
        for (int L = 512 + bx; L < 1024; L += G) {
#if PROBE_PHASE == 3 && defined(PROBE_ATT)
            if (args.li == 1 && lo == 3 && PROBE_ATT != 1) continue;
#endif
            UNIT_DECODE(L);
            f32x16 o[4];
            { att::Src in{qm + q0 * 1536 + h * 192, kv + k0 * 2048 + h * 256, kr + k0 * 64, kv + k0 * 2048 + h * 256 + 128, 1536, 2048, 64, 2048};
              att::attn_core<192>(in, 0.07216878364870322f * 1.4426950408889634f, 8.f / 0.07216878364870322f, SEQ, (LAS char*)lds, o); }
            int ln2; asm volatile("v_and_b32 %0, 63, %1" : "=v"(ln2) : "v"(threadIdx.x));
            const int hi2 = ln2 >> 5, r32e = ln2 & 31;
            bf16_t* Ow = ob + (q0 + wid * 32 + 4 * hi2) * 1024 + h * 128 + r32e;
#pragma unroll
            for (int r = 0; r < 16; ++r) { const int orow = att::crow(r, 0);
#pragma unroll
                for (int d = 0; d < 4; ++d) Ow[orow * 1024 + d * 32] = (bf16_t)(cvt_pk_bf16(o[d][r], 0.f) & 0xffffu); }
        }
#undef UNIT_DECODE
    }
    SEAM(3);
    if (IN(4)) {
        KARGS();
        { pg8::Gemm g{oa, Bt_od, D}; pg8::DenseOrder S; S.init(T / 256, 4, G, bx); pg8::EpiGate<0> E{mrg, gates};
          pg8::gemm_phase<pg8::EpiGate<0>, pg8::DenseOrder, false, true>(lds, g, S, E); }
        VM_WAIT(); __syncthreads();
        { pg8::Gemm g{ob, Bt_om, D}; pg8::DenseOrder S; S.init(T / 256, 4, G, bx); pg8::EpiGate<1> E{mrg, gates};
          pg8::gemm_phase<pg8::EpiGate<1>, pg8::DenseOrder, false, true>(lds, g, S, E); }
    }
    SEAM(4);
    if (IN(5)) {
        KARGS();
        pg8::Gemm g{mrg, Bt_out, D}; pg8::DenseOrder S; S.init(T / 256, 4, G, bx); pg8::EpiRes E{xin, AOUT};
        pg8::gemm_phase<pg8::EpiRes, pg8::DenseOrder, false, true>(lds, g, S, E);
    }
    SEAM(5);
    if (IN(6)) {
        KARGS();
        LANE_DECL;
        const float* g_ffn = (const float*)AIN(17); const float* w_router = (const float*)AIN(18); const float* b_router = (const float*)AIN(19);
        constexpr int WRS = 1028;
        LAS float* wr_l = (LAS float*)lds;
        LAS int* lcount = (LAS int*)(lds + TAB_OFF + 1024); LAS int* gbase = lcount + 32; LAS unsigned* asg_e = (LAS unsigned*)(lcount + 64); LAS float* asg_w = (LAS float*)(lcount + 64 + 256);
        LAS int* sync_w = (LAS int*)(lds + TAB_OFF + 512);
        for (int i = tid; i < D * NEXP; i += 512) wr_l[(i & 31) * WRS + (i >> 5)] = w_router[i];
        if (tid < 32) lcount[tid] = 0;
        if (tid < 2) sync_w[tid] = 0;
        __syncthreads();
        const int ex = (lane >> 1) & 31;
        LAS float* lg = (LAS float*)(lds + TAB_OFF + 4096) + wave * 80;
        const int chunk = bx;
        if (wave < 4 && chunk < T / 64) {
            const float my_b = b_router[ex];
#pragma unroll 1
            for (int j2 = 0; j2 < 8; ++j2) {
                const int tl = wave * 16 + j2 * 2, t = chunk * 64 + tl;
                f32x4 xva[4], xvb[4]; float sa = 0.f, sb = 0.f;
                { const f32x4* xa = (const f32x4*)(AOUT + (size_t)t * D) + lane; const f32x4* xb = xa + D / 4;
#pragma unroll
                  for (int j = 0; j < 4; ++j) { xva[j] = xa[64 * j]; xvb[j] = xb[64 * j]; }
#pragma unroll
                  for (int j = 0; j < 4; ++j) { sa += (xva[j][0] * xva[j][0] + xva[j][1] * xva[j][1]) + (xva[j][2] * xva[j][2] + xva[j][3] * xva[j][3]); sb += (xvb[j][0] * xvb[j][0] + xvb[j][1] * xvb[j][1]) + (xvb[j][2] * xvb[j][2] + xvb[j][3] * xvb[j][3]); } }
                const float ra = __builtin_amdgcn_rsqf(wave_sum(sa) * (1.f / D) + EPS), rb = __builtin_amdgcn_rsqf(wave_sum(sb) * (1.f / D) + EPS);
                { u32x2* oa8 = (u32x2*)(h2 + (size_t)t * D) + lane; u32x2* ob8 = oa8 + D / 4;
#pragma unroll
                  for (int j = 0; j < 4; ++j) { const f32x4 gg = *((const f32x4*)g_ffn + lane + 64 * j); xva[j] = xva[j] * ra * gg; xvb[j] = xvb[j] * rb * gg;
                    u32x2 w; w.x = cvt_pk_bf16(xva[j][0], xva[j][1]); w.y = cvt_pk_bf16(xva[j][2], xva[j][3]); oa8[64 * j] = w;
                    w.x = cvt_pk_bf16(xvb[j][0], xvb[j][1]); w.y = cvt_pk_bf16(xvb[j][2], xvb[j][3]); ob8[64 * j] = w; } }
                float aa[32], ab[32];
#pragma unroll
                for (int e = 0; e < NEXP; ++e) { float a = 0.f, b = 0.f;
#pragma unroll
                    for (int j = 0; j < 4; ++j) { const f32x4 w4 = *(const LAS f32x4*)(wr_l + e * WRS + 4 * lane + 256 * j);
                        a += (xva[j][0] * w4[0] + xva[j][1] * w4[1]) + (xva[j][2] * w4[2] + xva[j][3] * w4[3]); b += (xvb[j][0] * w4[0] + xvb[j][1] * w4[1]) + (xvb[j][2] * w4[2] + xvb[j][3] * w4[3]); }
                    aa[e] = a; ab[e] = b; }
#define TRED(arr, n, msk) _Pragma("unroll") for (int i_ = 0; i_ < (n); ++i_) { const bool up_ = (lane & (msk)) != 0; const float keep_ = up_ ? arr[(n) + i_] : arr[i_], give_ = up_ ? arr[i_] : arr[(n) + i_]; arr[i_] = keep_ + __shfl_xor(give_, (msk)); }
                TRED(aa, 16, 32) TRED(aa, 8, 16) TRED(aa, 4, 8) TRED(aa, 2, 4) TRED(aa, 1, 2)
                TRED(ab, 16, 32) TRED(ab, 8, 16) TRED(ab, 4, 8) TRED(ab, 2, 4) TRED(ab, 1, 2)
#undef TRED
                const float la = aa[0] + __shfl_xor(aa[0], 1) + my_b, lb = ab[0] + __shfl_xor(ab[0], 1) + my_b;
#pragma unroll
                for (int tk = 0; tk < 2; ++tk) {
                    const float v = tk ? lb : la; int rank = 0;
                    if (!(lane & 1)) lg[tk * 32 + ex] = v;
                    LDS_WAIT();
#pragma unroll
                    for (int q = 0; q < 8; ++q) { const f32x4 s4 = *(const LAS f32x4*)(lg + tk * 32 + 4 * q);
#pragma unroll
                        for (int jj = 0; jj < 4; ++jj) rank += (s4[jj] > v || (s4[jj] == v && (4 * q + jj) < ex)) ? 1 : 0; }
                    if (rank < 4 && !(lane & 1)) lg[64 + tk * 4 + rank] = v;
                    LDS_WAIT();
                    const f32x4 tv = *(const LAS f32x4*)(lg + 64 + tk * 4);
                    const float p1 = __expf(tv[1] - tv[0]), p2 = __expf(tv[2] - tv[0]), p3 = __expf(tv[3] - tv[0]), inv = 1.0f / (1.0f + p1 + p2 + p3);
                    if (rank < 4 && !(lane & 1)) { const float w = (rank == 0 ? 1.0f : (rank == 1 ? p1 : (rank == 2 ? p2 : p3))) * inv;
                        const int lr = __hip_atomic_fetch_add((LAS int*)&lcount[ex], 1, __ATOMIC_RELAXED, __HIP_MEMORY_SCOPE_WORKGROUP);
                        asg_e[(tl + tk) * 4 + rank] = ((unsigned)ex << 16) | (unsigned)lr; asg_w[(tl + tk) * 4 + rank] = w; }
                }
            }
            LDS_WAIT();
            if (lane == 0) __hip_atomic_fetch_add((LAS int*)&sync_w[0], 1, __ATOMIC_RELAXED, __HIP_MEMORY_SCOPE_WORKGROUP);
            if (wave == 0) {
                while (__hip_atomic_load((LAS int*)&sync_w[0], __ATOMIC_RELAXED, __HIP_MEMORY_SCOPE_WORKGROUP) < 4) __builtin_amdgcn_s_sleep(4);
                asm volatile("s_waitcnt lgkmcnt(0)" ::: "memory");
                if (lane < 32) gbase[lane] = (int)__hip_atomic_fetch_add(count + lane, (unsigned)lcount[lane], __ATOMIC_RELAXED, __HIP_MEMORY_SCOPE_AGENT);
                LDS_WAIT();
#pragma unroll
                for (int q = 0; q < 4; ++q) { const int a_ = q * 64 + lane; const unsigned ae = asg_e[a_]; const int e = ae >> 16, rank = gbase[e] + (int)(ae & 0xffffu); const int t = chunk * 64 + (a_ >> 2);
                    rowtok_p[e * T + rank] = t; u32x2 av; av.x = ((unsigned)e << 16) | (unsigned)rank; av.y = __float_as_uint(asg_w[a_]); assign[(size_t)t * 4 + (a_ & 3)] = av; }
            }
        }
        const float* w_gate = (const float*)AIN(20); const float* w_up = (const float*)AIN(22); const float* w_down = (const float*)AIN(24);
        const int per_wg = (NEXP * 768 + G - 1) / G;
        for (;;) {
            int it = 0; if (lane == 0) it = __hip_atomic_fetch_add((LAS int*)&sync_w[1], 1, __ATOMIC_RELAXED, __HIP_MEMORY_SCOPE_WORKGROUP);
            it = __builtin_amdgcn_readfirstlane(it); const int item = bx * per_wg + it;
            if (it >= per_wg || item >= NEXP * 768) break;
            const int e = item / 768, r = item % 768, mat = r >> 8, kb = (r >> 4) & 15, nb = r & 15, f0 = nb * 64;
            if (mat < 2) cvt_tile64((mat ? w_up : w_gate) + (size_t)e * D * FF, FF, Bt_gu + (size_t)e * 2048 * D, D, kb * 64, f0, 256 * (f0 >> 7) + mat * 128 + (f0 & 127), lane);
            else cvt_tile64(w_down + (size_t)e * FF * D, D, Bt_d + (size_t)e * D * FF, FF, kb * 64, f0, f0, lane);
        }
    }
    SEAM(6);
    LAS int* t_cnt = (LAS int*)(lds + TAB_OFF + 4096); LAS int* t_start = t_cnt + 32; LAS int* t_t2e = t_start + 40;
    if (IN(7) || IN(8) || IN(9)) {
        KARGS();
        __syncthreads();
        if (tid < 32) t_cnt[tid] = (int)__hip_atomic_load(count + tid, __ATOMIC_RELAXED, __HIP_MEMORY_SCOPE_AGENT);
        __syncthreads();
        if (tid == 0) { int s = 0; for (int e = 0; e < NEXP; ++e) { t_start[e] = s; s += (t_cnt[e] + 255) >> 8; } t_start[32] = s; }
        __syncthreads();
        if (tid < 32) { for (int rt = t_start[tid]; rt < t_start[tid + 1]; ++rt) t_t2e[rt] = tid; }
        __syncthreads();
    }
    if (IN(7)) {
        KARGS();
        pg8::Gemm g{h2, Bt_gu, D}; pg8::MoeOrder S; S.init(__builtin_amdgcn_readfirstlane(t_start[32]), 8, G, bx); S.t2e = t_t2e; S.tstart = t_start; S.cnt = t_cnt; S.rowtok = rowtok_p;
        pg8::EpiSwiglu E{act, (const float*)AIN(21), (const float*)AIN(23)};
        pg8::gemm_phase<pg8::EpiSwiglu, pg8::MoeOrder, true, true>(lds, g, S, E);
    }
    SEAM(7);
    if (IN(8)) {
        KARGS();
        pg8::Gemm g{act, Bt_d, FF}; pg8::MoeOrder S; S.init(__builtin_amdgcn_readfirstlane(t_start[32]), 4, G, bx); S.t2e = t_t2e; S.tstart = t_start; S.cnt = t_cnt; S.rowtok = rowtok_p;
        pg8::EpiDown E{ybuf, (const float*)AIN(25)};
        pg8::gemm_phase<pg8::EpiDown, pg8::MoeOrder, false, true>(lds, g, S, E);
    }
    SEAM(8);
    if (IN(9) && DBG_OUT) {
        KARGS();
        const bf16_t* src = DBG_OUT == 1 ? gates : DBG_OUT == 2 ? gates + 1024 : DBG_OUT == 3 ? qa : DBG_OUT == 4 ? ka : DBG_OUT == 5 ? va : DBG_OUT == 6 ? mrg : DBG_OUT == 7 ? oa : DBG_OUT == 9 ? Bt_in : ob;
        const int ld = DBG_OUT <= 2 ? 2048 : 1024;
        for (size_t i = (size_t)bx * 512 + tid; i < (size_t)T * 1024; i += (size_t)G * 512) AOUT[i] = (DBG_OUT == 9 && i >= (size_t)N_IN * 1024) ? 0.f : __uint_as_float((unsigned)src[(i >> 10) * ld + (i & 1023)] << 16);
    } else
    if (IN(9)) {
        KARGS();
        LANE_DECL;
        const float* g_fin = (const float*)AIN(26);
        for (int t0 = gw * 2; t0 < T; t0 += NGW * 2) {
            f32x4 v[2][4]; u32x2 as_[2][4];
#pragma unroll
            for (int q = 0; q < 2; ++q) { const f32x4* xr = (const f32x4*)(AOUT + (size_t)(t0 + q) * D) + lane;
#pragma unroll
                for (int j = 0; j < 4; ++j) v[q][j] = xr[64 * j];
#pragma unroll
                for (int k = 0; k < 4; ++k) as_[q][k] = assign[(size_t)(t0 + q) * 4 + k]; }
            u32x2 yw[2][4][4];
#pragma unroll
            for (int q = 0; q < 2; ++q)
#pragma unroll
                for (int k = 0; k < 4; ++k) { const int e = as_[q][k].x >> 16, rank = as_[q][k].x & 0xffffu;
                    const u32x2* yr = (const u32x2*)(ybuf + ((size_t)t_start[e] * 256 + rank) * D) + lane;
#pragma unroll
                    for (int j = 0; j < 4; ++j) yw[q][k][j] = yr[64 * j]; }
#pragma unroll
            for (int q = 0; q < 2; ++q) {
#pragma unroll
                for (int k = 0; k < 4; ++k) { const float w = (DBG_SKIP & 1) ? 0.f : __uint_as_float(as_[q][k].y);
#pragma unroll
                    for (int j = 0; j < 4; ++j) { const u32x2 y = yw[q][k][j]; v[q][j][0] += w * bf_lo(y.x); v[q][j][1] += w * bf_hi(y.x); v[q][j][2] += w * bf_lo(y.y); v[q][j][3] += w * bf_hi(y.y); } }
                float s = 0.f;
#pragma unroll
                for (int j = 0; j < 4; ++j) s += (v[q][j][0] * v[q][j][0] + v[q][j][1] * v[q][j][1]) + (v[q][j][2] * v[q][j][2] + v[q][j][3] * v[q][j][3]);
                const float rstd = __builtin_amdgcn_rsqf(wave_sum(s) * (1.f / D) + EPS);
                f32x4* xo = (f32x4*)(AOUT + (size_t)(t0 + q) * D) + lane;
#pragma unroll
                for (int j = 0; j < 4; ++j) { const f32x4 gg = *((const f32x4*)g_fin + lane + 64 * j); xo[64 * j] = v[q][j] * rstd * gg; } }
        }
    }
#undef IN
#undef SEAM
#undef KARGS
#undef AIN
#undef AOUT
#undef AWS
#undef xin
#undef positions
#undef Bt_in
#undef Bt_uq
#undef Bt_ukv
#undef Bt_od
#undef Bt_om
#undef Bt_out
#undef ropeA
#undef ropeM
#undef sq
#undef hbuf
#undef oa
#undef qa
#undef ka
#undef va
#undef cq
#undef ckv
#undef kr
#undef gates
#undef qm
#undef kv
#undef ob
#undef mrg
#undef stash
#undef rowtok_p
#undef assign
#undef Bt_d
#undef Bt_gu
#undef h2
#undef act
#undef ybuf
#undef count
}

extern "C" void kernel_launch(void* const* d_in, const int* in_sizes, int n_in, void* d_out, int out_size, void* d_ws, size_t ws_size, hipStream_t stream) {
    static int grid = 0;
    if (grid == 0) {
        if (n_in != 27 || in_sizes[0] != T * D || out_size != T * D || ws_size < WS_END) { fprintf(stderr, "kernel_launch: unexpected shapes (n_in %d, in0 %d, out %d, ws %zu < %zu)\n", n_in, n_in > 0 ? in_sizes[0] : -1, out_size, ws_size, (size_t)WS_END); grid = -1; return; }
        int dev = 0, cus = 0, per_cu = 0;
        if (hipGetDevice(&dev) != hipSuccess || hipDeviceGetAttribute(&cus, hipDeviceAttributeMultiprocessorCount, dev) != hipSuccess) { grid = -1; return; }
        if (hipFuncSetAttribute((const void*)fwd, hipFuncAttributeMaxDynamicSharedMemorySize, LDS_BYTES) != hipSuccess) { fprintf(stderr, "kernel_launch: hipFuncSetAttribute failed\n"); grid = -1; return; }
        if (hipOccupancyMaxActiveBlocksPerMultiprocessor(&per_cu, (const void*)fwd, NWAVES * 64, LDS_BYTES) != hipSuccess || per_cu < 1) fprintf(stderr, "kernel_launch: occupancy query says %d\n", per_cu);
        (void)hipGetLastError();
        grid = cus;
    }
    if (grid < 0) return;
    if (hipMemsetAsync((char*)d_ws + WS_CTL, 0, CTL_ZERO_BYTES, stream) != hipSuccess) return;
    Args a{};
    for (int i = 0; i < 27; ++i) a.in[i] = d_in[i];
    a.out = (float*)d_out; a.ws = (unsigned char*)d_ws;
#if MK_PER_PHASE
    for (int p = 0; p < NPHASE; ++p) { a.ph_lo = p; a.ph_hi = p + 1; hipLaunchKernelGGL(fwd, dim3(grid), dim3(NWAVES * 64), LDS_BYTES, stream, a); }
#elif PROBE_PHASE >= 0
    a.ph_lo = 0; a.ph_hi = PROBE_PHASE + 1; a.li = 0; hipLaunchKernelGGL(fwd, dim3(grid), dim3(NWAVES * 64), LDS_BYTES, stream, a);
    a.ph_lo = PROBE_PHASE; a.ph_hi = NPHASE; a.li = 1; hipLaunchKernelGGL(fwd, dim3(grid), dim3(NWAVES * 64), LDS_BYTES, stream, a);
#else
    a.ph_lo = 0; a.ph_hi = NPHASE; hipLaunchKernelGGL(fwd, dim3(grid), dim3(NWAVES * 64), LDS_BYTES, stream, a);
#endif
}
```

```cpp
#include <hip/hip_runtime.h>
#include <cstdio>
#include <cstdint>

#ifndef MK_PER_PHASE
#define MK_PER_PHASE 0
#endif

#ifndef PROBE_PHASE
#define PROBE_PHASE -1
#endif
#ifndef ATT_DUP
#define ATT_DUP 0
#endif
#ifndef DBG_OUT
#define DBG_OUT 0
#endif
#ifndef DBG_SKIP
#define DBG_SKIP 0
#endif
#ifndef ATT_MASK
#define ATT_MASK 3
#endif
#ifndef PH_MASK
#define PH_MASK 0x3ff
#endif
#define LAS __attribute__((address_space(3)))
#define GAS __attribute__((address_space(1)))
typedef unsigned short bf16_t;
typedef short bf16x8 __attribute__((ext_vector_type(8)));
typedef short s16x4 __attribute__((ext_vector_type(4)));
typedef float f32x2 __attribute__((ext_vector_type(2)));
typedef float f32x4 __attribute__((ext_vector_type(4)));
typedef float f32x16 __attribute__((ext_vector_type(16)));
typedef unsigned u32x2 __attribute__((ext_vector_type(2)));
typedef unsigned u32x4 __attribute__((ext_vector_type(4)));

constexpr int NB = 4, SEQ = 4096, T = NB * SEQ, D = 1024;
constexpr int NEXP = 32, TOPK = 4, FF = 1024;
constexpr int N_IN = 6656;
constexpr int QL = 768, KVL = 512;
constexpr float EPS = 1e-6f;
constexpr float LAM_INIT = 0.2f;
constexpr int NPHASE = 10;

constexpr size_t MiB = 1u << 20;
constexpr size_t WS_CTL = 0, CTL_ZERO_BYTES = 1 * MiB;
constexpr size_t WS_BT_IN = 2 * MiB;
constexpr size_t WS_BT_UQ = 15 * MiB;
constexpr size_t WS_BT_UKV = 18 * MiB;
constexpr size_t WS_BT_OD = 20 * MiB, WS_BT_OM = 22 * MiB, WS_BT_OUT = 24 * MiB;
constexpr size_t WS_ROPEA = 26 * MiB;
constexpr size_t WS_ROPEM = 27 * MiB;
constexpr size_t WS_SQ = 31 * MiB;
constexpr size_t WS_SQP = 1 * MiB;
constexpr size_t WS_H = 32 * MiB;
constexpr size_t WS_QA = 64 * MiB, WS_KA = 96 * MiB, WS_VA = 128 * MiB;
constexpr size_t WS_CQ = 160 * MiB, WS_CKV = 184 * MiB, WS_KR = 200 * MiB;
constexpr size_t WS_SQ2 = 202 * MiB;
constexpr size_t WS_GATES = 208 * MiB;
constexpr size_t WS_QM = 272 * MiB;
constexpr size_t WS_KV = 320 * MiB;
constexpr size_t WS_OB = 384 * MiB;
constexpr size_t WS_MRG = 416 * MiB;
constexpr size_t WS_STASH = 448 * MiB;
constexpr size_t WS_ROWTOK = 2 * MiB;
constexpr size_t WS_ASSIGN = 4 * MiB;
constexpr size_t WS_BT_D = 32 * MiB;
constexpr size_t WS_BT_GU = 96 * MiB;
constexpr size_t WS_H2 = 224 * MiB;
constexpr size_t WS_ACT = 256 * MiB;
constexpr size_t WS_Y = 96 * MiB;
constexpr size_t WS_END = 512 * MiB;
constexpr int CW_COUNT = 64;
constexpr int CW_BAR = 4096;

constexpr int RING_BYTES = 131072;
constexpr int TAB_OFF = RING_BYTES;
constexpr int TAB_BYTES = 8192;
constexpr int MISC_OFF = TAB_OFF + TAB_BYTES;
constexpr int LDS_BYTES = 147456;

typedef __bf16 bf16x2_t __attribute__((ext_vector_type(2)));
__device__ __forceinline__ unsigned cvt_pk_bf16(float lo, float hi) { const f32x2 v = {lo, hi}; return __builtin_bit_cast(unsigned, __builtin_convertvector(v, bf16x2_t)); }
__device__ __forceinline__ float bf_lo(unsigned w) { return __uint_as_float(w << 16); }
__device__ __forceinline__ float bf_hi(unsigned w) { return __uint_as_float(w & 0xffff0000u); }
__device__ __forceinline__ float wave_sum(float v) {
#pragma unroll
    for (int o = 1; o < 64; o <<= 1) v += __shfl_xor(v, o);
    return v;
}
__device__ __forceinline__ float sigmoidf_(float x) { return __builtin_amdgcn_rcpf(1.0f + __builtin_amdgcn_exp2f(-1.4426950408889634f * x)); }
#define LDS_WAIT() asm volatile("s_waitcnt lgkmcnt(0)" ::: "memory")
#define VM_WAIT() asm volatile("s_waitcnt vmcnt(0)" ::: "memory")

#define XB_TMO      128
#define XB_XCNT(j)  (256  + 64 * (j))
#define XB_XSUB(j)  (1280 + 64 * (j))
#define XB_XGEN(j)  (2304 + 64 * (j))
#define XB_TOP      3328
#define XB_TOPGEN   3392
#define XCD_BAR_WORDS 3456
#define XB_SPIN_CAP (1u << 20)
__device__ __forceinline__ unsigned xb_ld(unsigned* p)              { return __hip_atomic_load(p, __ATOMIC_RELAXED, __HIP_MEMORY_SCOPE_AGENT); }
__device__ __forceinline__ unsigned xb_add(unsigned* p, unsigned v) { return __hip_atomic_fetch_add(p, v, __ATOMIC_RELAXED, __HIP_MEMORY_SCOPE_AGENT); }
__device__ __forceinline__ unsigned xb_xcc_id() { return (unsigned)__builtin_amdgcn_s_getreg((3 << 11) | 20) & 0xFu; }
#define XB_SPIN(cond, bar) do { unsigned _sp = 0; while (cond) { __builtin_amdgcn_s_sleep(1); \
    if ((++_sp & 255u) == 0u) { if (xb_ld(&(bar)[XB_TMO])) break; if (_sp > XB_SPIN_CAP) { atomicAdd(&(bar)[XB_TMO], 1u); break; } } } } while (0)
struct XcdBarrier { unsigned* bar; unsigned x; volatile LAS unsigned* st; };
__device__ __forceinline__ XcdBarrier xcd_barrier_post(unsigned* bar, volatile LAS unsigned* st) {
    XcdBarrier b; b.bar = bar; b.x = xb_xcc_id(); b.st = st;
    if (threadIdx.x == 0) (void)xb_add(&bar[XB_XCNT(b.x)], 1u);
    return b;
}
__device__ __forceinline__ void xcd_barrier_complete(unsigned* bar, unsigned x, unsigned& nloc, unsigned& nx) {
    const unsigned G = gridDim.x * gridDim.y * gridDim.z;
    unsigned sum, cnt, mine, sp = 0u;
    for (;;) {
        sum = 0u; cnt = 0u; mine = 0u;
#pragma unroll
        for (unsigned j = 0; j < 16; ++j) { const unsigned c = xb_ld(&bar[XB_XCNT(j)]); sum += c; cnt += (c > 0u) ? 1u : 0u; mine = (j == x) ? c : mine; }
        if (sum == G) break;
        __builtin_amdgcn_s_sleep(1);
        if ((++sp & 255u) == 0u) { if (xb_ld(&bar[XB_TMO])) break; if (sp > XB_SPIN_CAP) { atomicAdd(&bar[XB_TMO], 1u); break; } }
    }
    nloc = mine > 0u ? mine : 1u; nx = cnt > 0u ? cnt : 1u;
}
__device__ __forceinline__ void xcd_barrier(const XcdBarrier& b) {
    asm volatile("s_waitcnt vmcnt(0)" ::: "memory");
    __syncthreads();
    if (threadIdx.x == 0) {
        unsigned* bar = b.bar;
        __builtin_amdgcn_s_waitcnt(0);
        unsigned nloc = b.st[0], nx = b.st[1];
        if (nloc == 0u) { xcd_barrier_complete(bar, b.x, nloc, nx); b.st[0] = nloc; b.st[1] = nx; }
        const unsigned old = xb_add(&bar[XB_XSUB(b.x)], 1u);
        const unsigned gen = old / nloc;
        if (old + 1u == (gen + 1u) * nloc) {
            __builtin_amdgcn_fence(__ATOMIC_RELEASE, "agent");
            asm volatile("s_waitcnt vmcnt(0)" ::: "memory");
            const unsigned og = xb_add(&bar[XB_TOP], 1u);
            const unsigned tg = og / nx;
            if (og + 1u == (tg + 1u) * nx) xb_add(&bar[XB_TOPGEN], 1u);
            else XB_SPIN(xb_ld(&bar[XB_TOPGEN]) == tg, bar);
            __builtin_amdgcn_fence(__ATOMIC_ACQUIRE, "agent");
            xb_add(&bar[XB_XGEN(b.x)], 1u);
            asm volatile("s_waitcnt vmcnt(0)" ::: "memory");
        } else {
            XB_SPIN(xb_ld(&bar[XB_XGEN(b.x)]) == gen, bar);
            __builtin_amdgcn_fence(__ATOMIC_ACQUIRE, "agent");
            asm volatile("s_waitcnt vmcnt(0)" ::: "memory");
        }
    }
    __syncthreads();
}

namespace pg8 {
constexpr int BM = 256, BK = 64, HALF = 128, HTB = HALF * BK * 2, STAGE_BYTES = 8 * HTB, NXCD = 8, WGM = 8;
__host__ __device__ __forceinline__ int lds_byte(int r, int c) { const int st = (r >> 4) * 2 + (c >> 5), rr = r & 15, cc = c & 31, ob = rr * 64 + cc * 2; return st * 1024 + (ob ^ (((ob >> 9) & 1) << 5)); }
__host__ __device__ __forceinline__ void stage_rc(int b, int& R, int& C) { const int st = b / 1024, sb = b % 1024, swz = sb ^ (((sb >> 9) & 1) << 5); R = (st >> 1) * 16 + swz / 64; C = (st & 1) * 32 + (swz % 64) / 2; }
__host__ __device__ __forceinline__ int perm32(int rho) { const int n = rho >> 4, i = rho & 15; return 8 * (i >> 2) + 4 * n + (i & 3); }

struct Unit { int pm, pn, pb, e, rbase, cnt; };
struct Gemm { const bf16_t* A; const bf16_t* Bt; int K; };

struct DenseOrder {
    int nM, nN, nwg, G, c, pn0;
    __device__ void init(int nM_, int nN_, int G_, int c_, int pn0_ = 0) { nM = nM_; nN = nN_; nwg = nM * nN; G = G_; c = c_; pn0 = pn0_; }
    __device__ __forceinline__ bool next(int i, Unit& u) const {
        const long L = (long)i * G + c; if (L >= nwg) return false;
        int wgid = (int)L; { const int q = nwg / NXCD, r = nwg % NXCD, xcd = wgid % NXCD, off = wgid / NXCD; wgid = (xcd < r ? xcd * (q + 1) : r * (q + 1) + (xcd - r) * q) + off; }
        const int nig = WGM * nN, gid = wgid / nig, fm = gid * WGM, gsz = (nM - fm) < WGM ? (nM - fm) : WGM;
        u.pm = fm + ((wgid % nig) % gsz); u.pn = pn0 + (wgid % nig) / gsz; u.pb = u.pn; u.e = 0; u.rbase = 0; u.cnt = 0; return true;
    }
    __device__ __forceinline__ int a_row(const Unit&, int) const { return 0; }
};
struct MoeOrder {
    int nM, nN, nwg, G, c; const LAS int* t2e; const LAS int* tstart; const LAS int* cnt; const int* rowtok;
    __device__ void init(int nM_, int nN_, int G_, int c_) { nM = nM_; nN = nN_; nwg = nM * nN; G = G_; c = c_; }
    __device__ __forceinline__ bool next(int i, Unit& u) const {
        const long L = (long)i * G + c; if (L >= nwg) return false;
        int wgid = (int)L; { const int q = nwg / NXCD, r = nwg % NXCD, xcd = wgid % NXCD, off = wgid / NXCD; wgid = (xcd < r ? xcd * (q + 1) : r * (q + 1) + (xcd - r) * q) + off; }
        const int nig = WGM * nN, gid = wgid / nig, fm = gid * WGM, gsz = (nM - fm) < WGM ? (nM - fm) : WGM;
        u.pm = fm + ((wgid % nig) % gsz); u.pn = (wgid % nig) / gsz;
        const int e = __builtin_amdgcn_readfirstlane(t2e[u.pm]); u.e = e; u.pb = e * nN + u.pn; u.rbase = (u.pm - __builtin_amdgcn_readfirstlane(tstart[e])) * 256; u.cnt = __builtin_amdgcn_readfirstlane(cnt[e]); return true;
    }
    __device__ __forceinline__ int a_row(const Unit& u, int r) const { const int rank = u.rbase + r; return rank < u.cnt ? rowtok[u.e * T + rank] : 0; }
};

template <class Epi, class Sched, bool GATHER, bool ALIGN_EPI>
__device__ __forceinline__ void gemm_phase(LAS unsigned char* lds, const Gemm g, const Sched& S, const Epi& E) {
    const int tid = threadIdx.x, wid = __builtin_amdgcn_readfirstlane(tid >> 6), lane = tid & 63, wr = wid >> 2, wc = wid & 3, fr = lane & 15, fq = lane >> 4;
    const int K = g.K, nt = K / BK;
    unsigned voffA[2], voffB[2]; int Rv[2], Cv[2];
#pragma unroll
    for (int i = 0; i < 2; ++i) { int R, C; stage_rc(tid * 16 + i * 8192, R, C); const int Rb = Epi::PERM ? ((R & ~31) + perm32(R & 31)) : R;
        voffA[i] = (unsigned)(R * K + C) * 2u; voffB[i] = (unsigned)(Rb * K + C) * 2u; Rv[i] = R; Cv[i] = C; }
    const size_t kstep = (size_t)(BK * 2);
    const size_t hstep = (size_t)HALF * K * 2;
    const size_t tstep = 2 * hstep;
    const unsigned ldsw = (unsigned)wid * 1024u;
    const int aoff = lds_byte(wr * 64 + fr, fq * 8), boff = lds_byte(wc * 32 + fr, fq * 8);
#define PG8_SA(b, h) (((b) * 2 + (h)) * HTB)
#define PG8_SB(b, h) ((4 + (b) * 2 + (h)) * HTB)
#define PG8_STAGE(bufoff, gbase, voff) do { _Pragma("unroll") for (int _i = 0; _i < 2; ++_i) \
        __builtin_amdgcn_global_load_lds((const unsigned*)((const char*)(gbase) + (voff)[_i]), (LAS unsigned*)(lds + (bufoff) + ldsw + _i * 8192), 16, 0, 0); } while (0)
#define PG8_LDA(dst, b, h) do { _Pragma("unroll") for (int m = 0; m < 4; ++m) _Pragma("unroll") for (int k = 0; k < 2; ++k) dst[m][k] = *(const LAS bf16x8*)(lds + PG8_SA(b, h) + aoff + m * 2048 + k * 1024); } while (0)
#define PG8_LDB(dst, b, h) do { _Pragma("unroll") for (int n = 0; n < 2; ++n) _Pragma("unroll") for (int k = 0; k < 2; ++k) dst[n][k] = *(const LAS bf16x8*)(lds + PG8_SB(b, h) + boff + n * 2048 + k * 1024); } while (0)
#define PG8_MMA(ai, bj, At, Bt) do { __builtin_amdgcn_s_setprio(1); _Pragma("unroll") for (int m = 0; m < 4; ++m) _Pragma("unroll") for (int n = 0; n < 2; ++n) _Pragma("unroll") for (int k = 0; k < 2; ++k) \
        acc[ai][bj][m][n] = __builtin_amdgcn_mfma_f32_16x16x32_bf16(Bt[n][k], At[m][k], acc[ai][bj][m][n], 0, 0, 0); __builtin_amdgcn_s_setprio(0); } while (0)
#define PG8_WAIT_V(n) asm volatile("s_waitcnt vmcnt(" #n ")" ::: "memory")
#define PG8_WAIT_L(n) asm volatile("s_waitcnt lgkmcnt(" #n ")" ::: "memory")
#define PG8_BAR __builtin_amdgcn_s_barrier()
#define PG8_SCHED __builtin_amdgcn_sched_barrier(0)
    Unit cur, nxt; int ui = 0;
    if (!S.next(0, cur)) return;
    f32x4 acc[2][2][4][2];
#pragma unroll
    for (int a = 0; a < 2; ++a)
#pragma unroll
        for (int b = 0; b < 2; ++b)
#pragma unroll
            for (int m = 0; m < 4; ++m)
#pragma unroll
                for (int n = 0; n < 2; ++n) acc[a][b][m][n] = (f32x4){0.f, 0.f, 0.f, 0.f};
    bf16x8 At[4][2], B0[2][2], B1[2][2];
    unsigned gC0[2], gC1[2], gN0[2], gN1[2];
    if constexpr (GATHER) {
#pragma unroll
        for (int i = 0; i < 2; ++i) { gC0[i] = (unsigned)S.a_row(cur, Rv[i]) * (unsigned)(K * 2) + (unsigned)Cv[i] * 2u; gC1[i] = (unsigned)S.a_row(cur, HALF + Rv[i]) * (unsigned)(K * 2) + (unsigned)Cv[i] * 2u; gN0[i] = gC0[i]; gN1[i] = gC1[i]; }
    }
    const char* cA = GATHER ? (const char*)g.A : (const char*)g.A + (size_t)cur.pm * tstep; const char* cB = (const char*)g.Bt + (size_t)cur.pb * tstep;
#define PG8_STAGE_A(bufoff, p, h, o0, o1) do { if constexpr (GATHER) { if ((h) == 0) PG8_STAGE(bufoff, p, o0); else PG8_STAGE(bufoff, p, o1); } else { PG8_STAGE(bufoff, (p) + (h) * hstep, voffA); } } while (0)
    PG8_STAGE(PG8_SB(0, 0), cB, voffB); PG8_STAGE(PG8_SB(0, 1), cB + hstep, voffB); PG8_STAGE_A(PG8_SA(0, 0), cA, 0, gC0, gC1); PG8_STAGE_A(PG8_SA(0, 1), cA, 1, gC0, gC1);
    if (wr == 1) PG8_BAR;
    PG8_WAIT_V(2); PG8_BAR;
    PG8_STAGE(PG8_SB(1, 0), cB + kstep, voffB); PG8_STAGE_A(PG8_SA(1, 0), cA + kstep, 0, gC0, gC1); PG8_STAGE(PG8_SB(1, 1), cB + hstep + kstep, voffB);
    PG8_WAIT_V(6); PG8_BAR;
    for (;;) {
        const bool has_next = S.next(ui + 1, nxt);
        const char* nA = GATHER ? (const char*)g.A : (has_next ? (const char*)g.A + (size_t)nxt.pm * tstep : cA); const char* nB = has_next ? (const char*)g.Bt + (size_t)nxt.pb * tstep : cB;
        if constexpr (GATHER) { if (has_next) {
#pragma unroll
            for (int i = 0; i < 2; ++i) { gN0[i] = (unsigned)S.a_row(nxt, Rv[i]) * (unsigned)(K * 2) + (unsigned)Cv[i] * 2u; gN1[i] = (unsigned)S.a_row(nxt, HALF + Rv[i]) * (unsigned)(K * 2) + (unsigned)Cv[i] * 2u; } } }
        for (int t = 0; t < nt; t += 2) {
            const bool last = (t == nt - 2);
            const char* a1 = cA + (size_t)(t + 1) * kstep;
            const char* a2 = last ? nA : cA + (size_t)(t + 2) * kstep; const char* b2 = last ? nB : cB + (size_t)(t + 2) * kstep;
            const char* a3 = a2 + kstep; const char* b3 = b2 + kstep;
            unsigned s0[2], s1[2];
            if constexpr (GATHER) { s0[0] = last ? gN0[0] : gC0[0]; s0[1] = last ? gN0[1] : gC0[1]; s1[0] = last ? gN1[0] : gC1[0]; s1[1] = last ? gN1[1] : gC1[1]; }
            PG8_LDB(B0, 0, 0); PG8_LDB(B1, 0, 1); PG8_SCHED; PG8_LDA(At, 0, 0); PG8_STAGE_A(PG8_SA(1, 1), a1, 1, gC0, gC1);
            PG8_WAIT_V(8); PG8_WAIT_L(0); PG8_BAR; PG8_MMA(0, 0, At, B0); PG8_MMA(0, 1, At, B1); PG8_BAR; PG8_SCHED;
            PG8_LDA(At, 0, 1); PG8_STAGE(PG8_SB(0, 0), b2, voffB); PG8_STAGE(PG8_SB(0, 1), b2 + hstep, voffB); PG8_STAGE_A(PG8_SA(0, 0), a2, 0, s0, s1);
            PG8_WAIT_V(8); PG8_WAIT_L(0); PG8_BAR; PG8_MMA(1, 0, At, B0); PG8_MMA(1, 1, At, B1); PG8_BAR; PG8_SCHED;
            PG8_LDB(B0, 1, 0); PG8_LDB(B1, 1, 1); PG8_SCHED; PG8_LDA(At, 1, 0); PG8_STAGE_A(PG8_SA(0, 1), a2, 1, s0, s1);
            PG8_WAIT_V(8); PG8_WAIT_L(0); PG8_BAR; PG8_MMA(0, 0, At, B0); PG8_MMA(0, 1, At, B1); PG8_BAR; PG8_SCHED;
            PG8_LDA(At, 1, 1); PG8_STAGE(PG8_SB(1, 0), b3, voffB); PG8_STAGE(PG8_SB(1, 1), b3 + hstep, voffB); PG8_STAGE_A(PG8_SA(1, 0), a3, 0, s0, s1);
            PG8_WAIT_V(8); PG8_WAIT_L(0); PG8_BAR; PG8_MMA(1, 0, At, B0); PG8_MMA(1, 1, At, B1); PG8_BAR; PG8_SCHED;
        }
        if constexpr (ALIGN_EPI) { if (wr == 0) PG8_BAR; }
        E(acc, cur, wr, wc, fr, fq);
        if (!has_next) break;
#pragma unroll
        for (int a = 0; a < 2; ++a)
#pragma unroll
            for (int b = 0; b < 2; ++b)
#pragma unroll
                for (int m = 0; m < 4; ++m)
#pragma unroll
                    for (int n = 0; n < 2; ++n) acc[a][b][m][n] = (f32x4){0.f, 0.f, 0.f, 0.f};
        cur = nxt; cA = nA; cB = nB; ++ui;
        if constexpr (GATHER) { gC0[0] = gN0[0]; gC0[1] = gN0[1]; gC1[0] = gN1[0]; gC1[1] = gN1[1]; }
        if constexpr (ALIGN_EPI) { if (wr == 1) PG8_BAR; }
    }
    PG8_WAIT_V(0);
    if constexpr (!ALIGN_EPI) { if (wr == 0) PG8_BAR; }
    PG8_BAR;
#undef PG8_SA
#undef PG8_SB
#undef PG8_STAGE
#undef PG8_STAGE_A
#undef PG8_LDA
#undef PG8_LDB
#undef PG8_MMA
#undef PG8_WAIT_V
#undef PG8_WAIT_L
#undef PG8_BAR
#undef PG8_SCHED
}

__device__ __forceinline__ u32x4 pack8(const f32x4& v0, const f32x4& v1) { u32x4 w; w.x = cvt_pk_bf16(v0[0], v0[1]); w.y = cvt_pk_bf16(v0[2], v0[3]); w.z = cvt_pk_bf16(v1[0], v1[1]); w.w = cvt_pk_bf16(v1[2], v1[3]); return w; }
__device__ __forceinline__ void rope4(f32x4& v0, f32x4& v1, const float* cs) {
    const f32x4 a = *(const f32x4*)cs, b = *(const f32x4*)(cs + 4);
    float x1, x2;
    x1 = v0[0]; x2 = v0[1]; v0[0] = x1 * a[0] - x2 * a[1]; v0[1] = x2 * a[0] + x1 * a[1];
    x1 = v0[2]; x2 = v0[3]; v0[2] = x1 * a[2] - x2 * a[3]; v0[3] = x2 * a[2] + x1 * a[3];
    x1 = v1[0]; x2 = v1[1]; v1[0] = x1 * b[0] - x2 * b[1]; v1[1] = x2 * b[0] + x1 * b[1];
    x1 = v1[2]; x2 = v1[3]; v1[2] = x1 * b[2] - x2 * b[3]; v1[3] = x2 * b[2] + x1 * b[3];
}

struct EpiIn {
    static constexpr bool PERM = true;
    bf16_t *qa, *ka, *va, *cq, *ckv, *gates, *kr; const float *ropeA, *ropeM, *bg; float* sq;
    __device__ __forceinline__ void operator()(const f32x4 (&acc)[2][2][4][2], const Unit& u, int wr, int wc, int fr, int fq) const {
        const int pn = u.pn, row0 = u.pm * BM + wr * 64 + fr, cl = wc * 32 + 8 * fq;
        if (pn < 8) {
            bf16_t* dst = pn < 4 ? qa : ka; const int colt = (pn & 3) * 256; const bool rot = ((wc & 1) == 0) && (fq < 2);
#pragma unroll
            for (int ai = 0; ai < 2; ++ai)
#pragma unroll
                for (int m = 0; m < 4; ++m) { const int row = row0 + ai * HALF + m * 16;
#pragma unroll
                    for (int bj = 0; bj < 2; ++bj) { f32x4 v0 = acc[ai][bj][m][0], v1 = acc[ai][bj][m][1];
                        if (rot) rope4(v0, v1, ropeA + (size_t)row * 16 + fq * 8);
                        *(u32x4*)(dst + (size_t)row * 1024 + colt + bj * HALF + cl) = pack8(v0, v1); } }
        } else if (pn < 12) {
            const int colt = (pn - 8) * 256;
#pragma unroll
            for (int ai = 0; ai < 2; ++ai)
#pragma unroll
                for (int m = 0; m < 4; ++m) { const int row = row0 + ai * HALF + m * 16;
#pragma unroll
                    for (int bj = 0; bj < 2; ++bj) *(u32x4*)(va + (size_t)row * 1024 + colt + bj * HALF + cl) = pack8(acc[ai][bj][m][0], acc[ai][bj][m][1]); }
        } else if (pn < 17) {
            const bool isq = pn < 15; bf16_t* dst = isq ? cq : ckv; const int ld = isq ? QL : KVL, colt = (isq ? pn - 12 : pn - 15) * 256, tq = pn - 12;
#pragma unroll
            for (int ai = 0; ai < 2; ++ai)
#pragma unroll
                for (int m = 0; m < 4; ++m) { const int row = row0 + ai * HALF + m * 16; float s = 0.f;
#pragma unroll
                    for (int bj = 0; bj < 2; ++bj) { const f32x4 v0 = acc[ai][bj][m][0], v1 = acc[ai][bj][m][1];
                        s += (v0[0] * v0[0] + v0[1] * v0[1]) + (v0[2] * v0[2] + v0[3] * v0[3]) + (v1[0] * v1[0] + v1[1] * v1[1]) + (v1[2] * v1[2] + v1[3] * v1[3]);
                        *(u32x4*)(dst + (size_t)row * ld + colt + bj * HALF + cl) = pack8(v0, v1); }
                    s += __shfl_xor(s, 16); s += __shfl_xor(s, 32);
                    if (fq == 0) sq[(size_t)row * 20 + tq * 4 + wc] = s; }
        } else if (pn != 23) {
            const int colt = (pn < 23 ? pn - 17 : pn - 18) * 256;
            f32x4 bv[2][2];
#pragma unroll
            for (int bj = 0; bj < 2; ++bj) { bv[bj][0] = *(const f32x4*)(bg + colt + bj * HALF + cl); bv[bj][1] = *(const f32x4*)(bg + colt + bj * HALF + cl + 4); if (DBG_SKIP & 256) { bv[bj][0] = bv[bj][0] * 0.f; bv[bj][1] = bv[bj][1] * 0.f; } }
#pragma unroll
            for (int ai = 0; ai < 2; ++ai)
#pragma unroll
                for (int m = 0; m < 4; ++m) { const int row = row0 + ai * HALF + m * 16;
#pragma unroll
                    for (int bj = 0; bj < 2; ++bj) { f32x4 v0 = acc[ai][bj][m][0] + bv[bj][0], v1 = acc[ai][bj][m][1] + bv[bj][1];
#pragma unroll
                        for (int j = 0; j < 4; ++j) { if (!(DBG_SKIP & 512)) { v0[j] = sigmoidf_(v0[j]); v1[j] = sigmoidf_(v1[j]); } }
                        *(u32x4*)(gates + (size_t)row * 2048 + colt + bj * HALF + cl) = pack8(v0, v1); } }
        } else {
            if (wc < 2) {
#pragma unroll
                for (int ai = 0; ai < 2; ++ai)
#pragma unroll
                    for (int m = 0; m < 4; ++m) { const int row = row0 + ai * HALF + m * 16;
                        f32x4 v0 = acc[ai][0][m][0], v1 = acc[ai][0][m][1];
                        rope4(v0, v1, ropeM + (size_t)row * 64 + (wc * 16 + fq * 4) * 2);
                        *(u32x4*)(kr + (size_t)row * 64 + cl) = pack8(v0, v1); }
            }
        }
    }
};
template <bool ISQ> struct EpiUp {
    static constexpr bool PERM = true;
    bf16_t* out; const float* sq; const float* ropeM;
    __device__ __forceinline__ void operator()(const f32x4 (&acc)[2][2][4][2], const Unit& u, int wr, int wc, int fr, int fq) const {
        const int row0 = u.pm * BM + wr * 64 + fr, cl = wc * 32 + 8 * fq; constexpr int LD = ISQ ? 1536 : 2048;
#pragma unroll
        for (int ai = 0; ai < 2; ++ai)
#pragma unroll
            for (int m = 0; m < 4; ++m) { const int row = row0 + ai * HALF + m * 16; float s;
                if (ISQ) { const f32x4 a = *(const f32x4*)(sq + (size_t)row * 20), b = *(const f32x4*)(sq + (size_t)row * 20 + 4), c = *(const f32x4*)(sq + (size_t)row * 20 + 8);
                    s = ((a[0] + a[1]) + (a[2] + a[3])) + ((b[0] + b[1]) + (b[2] + b[3])) + ((c[0] + c[1]) + (c[2] + c[3])); }
                else { const f32x4 a = *(const f32x4*)(sq + (size_t)row * 20 + 12), b = *(const f32x4*)(sq + (size_t)row * 20 + 16);
                    s = ((a[0] + a[1]) + (a[2] + a[3])) + ((b[0] + b[1]) + (b[2] + b[3])); }
                const float rstd = __builtin_amdgcn_rsqf(s * (ISQ ? 1.0f / QL : 1.0f / KVL) + EPS);
#pragma unroll
                for (int bj = 0; bj < 2; ++bj) { const int col = u.pn * BM + bj * HALF + cl; f32x4 v0 = acc[ai][bj][m][0] * rstd, v1 = acc[ai][bj][m][1] * rstd;
                    if (ISQ) { const int off = col % 192; if (off >= 128) rope4(v0, v1, ropeM + (size_t)row * 64 + (off - 128)); }
                    *(u32x4*)(out + (size_t)row * LD + col) = pack8(v0, v1); } }
    }
};
template <int WHICH> struct EpiGate {
    static constexpr bool PERM = true;
    bf16_t* mrg; const bf16_t* gates;
    __device__ __forceinline__ void operator()(const f32x4 (&acc)[2][2][4][2], const Unit& u, int wr, int wc, int fr, int fq) const {
        const int row0 = u.pm * BM + wr * 64 + fr, cl = wc * 32 + 8 * fq;
#pragma unroll
        for (int ai = 0; ai < 2; ++ai)
#pragma unroll
            for (int m = 0; m < 4; ++m) { const int row = row0 + ai * HALF + m * 16;
#pragma unroll
                for (int bj = 0; bj < 2; ++bj) { const int col = u.pn * BM + bj * HALF + cl;
                    const u32x4 gw = *(const u32x4*)(gates + (size_t)row * 2048 + WHICH * 1024 + col);
                    f32x4 v0 = acc[ai][bj][m][0], v1 = acc[ai][bj][m][1];
                    if ((DBG_SKIP & 8) && WHICH == 0) { v0 = v0 * 0.f; v1 = v1 * 0.f; } if ((DBG_SKIP & 16) && WHICH == 1) { v0 = v0 * 0.f; v1 = v1 * 0.f; }
                    v0[0] *= bf_lo(gw.x); v0[1] *= bf_hi(gw.x); v0[2] *= bf_lo(gw.y); v0[3] *= bf_hi(gw.y); v1[0] *= bf_lo(gw.z); v1[1] *= bf_hi(gw.z); v1[2] *= bf_lo(gw.w); v1[3] *= bf_hi(gw.w);
                    if (WHICH == 1) { const u32x4 tw = *(const u32x4*)(mrg + (size_t)row * 1024 + col);
                        v0[0] += bf_lo(tw.x); v0[1] += bf_hi(tw.x); v0[2] += bf_lo(tw.y); v0[3] += bf_hi(tw.y); v1[0] += bf_lo(tw.z); v1[1] += bf_hi(tw.z); v1[2] += bf_lo(tw.w); v1[3] += bf_hi(tw.w); }
                    *(u32x4*)(mrg + (size_t)row * 1024 + col) = pack8(v0, v1); } }
    }
};
struct EpiRes {
    static constexpr bool PERM = false;
    const float* x; float* out;
    __device__ __forceinline__ void operator()(const f32x4 (&acc)[2][2][4][2], const Unit& u, int wr, int wc, int fr, int fq) const {
        const int row0 = u.pm * BM + wr * 64 + fr, col0 = u.pn * BM + wc * 32 + 4 * fq;
#pragma unroll
        for (int ai = 0; ai < 2; ++ai)
#pragma unroll
            for (int m = 0; m < 4; ++m) { const size_t off = (size_t)(row0 + ai * HALF + m * 16) * 1024 + col0;
#pragma unroll
                for (int bj = 0; bj < 2; ++bj)
#pragma unroll
                    for (int n = 0; n < 2; ++n) *(f32x4*)(out + off + bj * HALF + n * 16) = *(const f32x4*)(x + off + bj * HALF + n * 16) + ((DBG_SKIP & 2) ? 0.f : 1.f) * acc[ai][bj][m][n]; }
    }
};
struct EpiSwiglu {
    static constexpr bool PERM = true;
    bf16_t* act; const float *bgate, *bup;
    __device__ __forceinline__ void operator()(const f32x4 (&acc)[2][2][4][2], const Unit& u, int wr, int wc, int fr, int fq) const {
        const int row0 = u.pm * BM + wr * 64 + fr, f0 = u.pn * HALF + wc * 32 + 8 * fq;
        f32x4 bgv[2], buv[2];
#pragma unroll
        for (int n = 0; n < 2; ++n) { bgv[n] = *(const f32x4*)(bgate + (size_t)u.e * FF + f0 + 4 * n); buv[n] = *(const f32x4*)(bup + (size_t)u.e * FF + f0 + 4 * n); }
#pragma unroll
        for (int ai = 0; ai < 2; ++ai)
#pragma unroll
            for (int m = 0; m < 4; ++m) { const int row = row0 + ai * HALF + m * 16; f32x4 o[2];
#pragma unroll
                for (int n = 0; n < 2; ++n) { const f32x4 gt = acc[ai][0][m][n] + bgv[n], up = acc[ai][1][m][n] + buv[n];
#pragma unroll
                    for (int j = 0; j < 4; ++j) { const float gg = fminf(gt[j], 7.0f), uu = fminf(fmaxf(up[j], -7.0f), 7.0f); o[n][j] = (uu + 1.0f) * (gg * sigmoidf_(1.702f * gg)); } }
                *(u32x4*)(act + (size_t)row * FF + f0) = pack8(o[0], o[1]); }
    }
};
struct EpiDown {
    static constexpr bool PERM = true;
    bf16_t* y; const float* bd;
    __device__ __forceinline__ void operator()(const f32x4 (&acc)[2][2][4][2], const Unit& u, int wr, int wc, int fr, int fq) const {
        const int row0 = u.pm * BM + wr * 64 + fr, cl = wc * 32 + 8 * fq;
        f32x4 bv[2][2];
#pragma unroll
        for (int bj = 0; bj < 2; ++bj) { const int col = u.pn * BM + bj * HALF + cl; bv[bj][0] = *(const f32x4*)(bd + (size_t)u.e * D + col); bv[bj][1] = *(const f32x4*)(bd + (size_t)u.e * D + col + 4); }
#pragma unroll
        for (int ai = 0; ai < 2; ++ai)
#pragma unroll
            for (int m = 0; m < 4; ++m) { const int row = row0 + ai * HALF + m * 16;
#pragma unroll
                for (int bj = 0; bj < 2; ++bj) { const int col = u.pn * BM + bj * HALF + cl;
                    *(u32x4*)(y + (size_t)row * D + col) = pack8(acc[ai][bj][m][0] + bv[bj][0], acc[ai][bj][m][1] + bv[bj][1]); } }
    }
};
}

namespace att {
constexpr int NW = 8, QBLK = 32, KVBLK = 64;
constexpr int SHM_V = KVBLK * 128 * 2;
#define SBAR() __builtin_amdgcn_sched_barrier(0)
#define KSW(row, colB) ((row) * 128 + ((colB) ^ ((((row) >> 1) & 7) << 4)))
__device__ __forceinline__ int crow(int r, int hi) { return (r & 3) + 8 * (r >> 2) + 4 * hi; }
struct Src { const bf16_t* Q; const bf16_t* K; const bf16_t* K2; const bf16_t* V; int ldq, ldk, ldk2, ldv; };

__device__ __forceinline__ void partialSM(f32x16& p0, f32x16& p1, float& m_reg, float& mn, float& alpha, const float C, const float thr) {
  float pmax;
  { float a0 = fmaxf(fmaxf(p0[0], p0[1]), p0[2]), a1 = fmaxf(fmaxf(p0[3], p0[4]), p0[5]), a2 = fmaxf(fmaxf(p1[0], p1[1]), p1[2]), a3 = fmaxf(fmaxf(p1[3], p1[4]), p1[5]);
#pragma unroll
    for (int r = 6; r < 16; r += 2) { a0 = fmaxf(fmaxf(a0, p0[r]), p0[r + 1]); a2 = fmaxf(fmaxf(a2, p1[r]), p1[r + 1]); }
    pmax = fmaxf(fmaxf(a0, a1), fmaxf(a2, a3)); }
  { auto rr = __builtin_amdgcn_permlane32_swap(__float_as_uint(pmax), __float_as_uint(pmax), false, false);
    pmax = fmaxf(__uint_as_float(rr[0]), __uint_as_float(rr[1])); }
  if (__builtin_expect(__all(pmax - m_reg <= thr), 1)) { mn = m_reg; alpha = 1.f; }
  else { mn = fmaxf(m_reg, pmax); alpha = __builtin_amdgcn_exp2f((m_reg - mn) * C); m_reg = mn; }
  const float mnC = -mn * C;
#pragma unroll
  for (int r = 0; r < 16; ++r) p0[r] = fmaf(p0[r], C, mnC);
#pragma unroll
  for (int r = 0; r < 16; ++r) p1[r] = fmaf(p1[r], C, mnC);
#pragma unroll
  for (int r = 0; r < 16; ++r) p0[r] = __builtin_amdgcn_exp2f(p0[r]);
#if ATT_DUP == 1
  { float d_[16];
#pragma unroll
    for (int r = 0; r < 16; ++r) { d_[r] = __builtin_amdgcn_exp2f(p1[r]); d_[r] = fmaf(d_[r], C, mnC); }
#pragma unroll
    for (int r = 0; r < 16; ++r) asm volatile("" :: "v"(d_[r])); }
#endif
}
__device__ __forceinline__ void finishSM(f32x16& p0, f32x16& p1, float alpha, float& l_reg, bf16x8& pa0, bf16x8& pa1, bf16x8& pa2, bf16x8& pa3) {
#pragma unroll
  for (int r = 0; r < 16; ++r) p1[r] = __builtin_amdgcn_exp2f(p1[r]);
  float ps;
  { float s0 = p0[0] + p0[1], s1 = p0[2] + p0[3], s2 = p1[0] + p1[1], s3 = p1[2] + p1[3];
#pragma unroll
    for (int r = 4; r < 16; r += 4) { s0 += p0[r] + p0[r + 1]; s1 += p0[r + 2] + p0[r + 3]; s2 += p1[r] + p1[r + 1]; s3 += p1[r + 2] + p1[r + 3]; }
    ps = (s0 + s1) + (s2 + s3); }
  { auto rr = __builtin_amdgcn_permlane32_swap(__float_as_uint(ps), __float_as_uint(ps), false, false);
    ps = __uint_as_float(rr[0]) + __uint_as_float(rr[1]); }
  l_reg = l_reg * alpha + ps;
#define PK4(P, BASE, OUT) do { unsigned a0 = cvt_pk_bf16(P[BASE + 0], P[BASE + 1]), a1 = cvt_pk_bf16(P[BASE + 2], P[BASE + 3]);   \
    unsigned b0 = cvt_pk_bf16(P[BASE + 4], P[BASE + 5]), b1 = cvt_pk_bf16(P[BASE + 6], P[BASE + 7]);                              \
    auto r0 = __builtin_amdgcn_permlane32_swap(a0, b0, false, false); auto r1 = __builtin_amdgcn_permlane32_swap(a1, b1, false, false); \
    u32x4 w = {r0[0], r1[0], r0[1], r1[1]}; OUT = *reinterpret_cast<bf16x8*>(&w); } while (0)
  PK4(p0, 0, pa0); PK4(p0, 8, pa1); PK4(p1, 0, pa2); PK4(p1, 8, pa3);
#undef PK4
}
template <int DQK> __device__ __forceinline__ void qkt(f32x16& p0, f32x16& p1, const LAS char* Ks, const bf16x8* qr, int r32, int hi) {
  p0 = f32x16{}; p1 = f32x16{};
#pragma unroll
  for (int d0 = 0; d0 < DQK / 16; ++d0) { const int sub = d0 >> 2, cb = ((d0 & 3) * 16 + hi * 8) * 2;
    const bf16x8 b0 = *(const LAS bf16x8*)(Ks + sub * 8192 + KSW(r32, cb));
    const bf16x8 b1 = *(const LAS bf16x8*)(Ks + sub * 8192 + KSW(32 + r32, cb));
    p0 = __builtin_amdgcn_mfma_f32_32x32x16_bf16(b0, qr[d0], p0, 0, 0, 0);
    p1 = __builtin_amdgcn_mfma_f32_32x32x16_bf16(b1, qr[d0], p1, 0, 0, 0); }
#if ATT_DUP == 2
  if constexpr (DQK == 64) { bf16x8 zq = {0, 0, 0, 0, 0, 0, 0, 0}; asm volatile("" : "+v"(zq));
    const bf16x8 bz = *(const LAS bf16x8*)(Ks + KSW(r32, hi * 16));
#pragma unroll
    for (int d0 = 0; d0 < 2; ++d0) { p0 = __builtin_amdgcn_mfma_f32_32x32x16_bf16(bz, zq, p0, 0, 0, 0); p1 = __builtin_amdgcn_mfma_f32_32x32x16_bf16(bz, zq, p1, 0, 0, 0); } }
#endif
}
__device__ __forceinline__ int v_st(int k, int c) { const int kk = (k & ~0xC) | ((k & 4) << 1) | ((k & 8) >> 1); return ((kk >> 3) * 4 + (c >> 5)) * 512 + ((kk & 7) * 32 + (c & 31)) * 2; }
__device__ __forceinline__ int v_rd_base(int lane) { return ((lane & 3) << 3) | (((lane >> 2) & 3) << 6) | (((lane >> 4) & 1) << 5) | (((lane >> 5) & 1) << 8); }
constexpr int v_rd_off(int d0, int ks, int half) { return d0 * 512 + ks * 4096 + half * 2048; }
template <int OFF> __device__ __forceinline__ s16x4 tr_read(int vb) {
  s16x4 r; asm volatile("ds_read_b64_tr_b16 %0, %1 offset:%2" : "=&v"(r) : "v"(vb), "i"(OFF) : "memory"); return r;
}
template <int KS> __device__ __forceinline__ void pv_step(f32x16* o, int vb, bf16x8 pa) {
  s16x4 l0, h0, l1, h1, l2, h2, l3, h3;
  l0 = tr_read<v_rd_off(0, KS, 0)>(vb); h0 = tr_read<v_rd_off(0, KS, 1)>(vb); l1 = tr_read<v_rd_off(1, KS, 0)>(vb); h1 = tr_read<v_rd_off(1, KS, 1)>(vb);
  l2 = tr_read<v_rd_off(2, KS, 0)>(vb); h2 = tr_read<v_rd_off(2, KS, 1)>(vb); l3 = tr_read<v_rd_off(3, KS, 0)>(vb); h3 = tr_read<v_rd_off(3, KS, 1)>(vb);
  asm volatile("s_waitcnt lgkmcnt(0)" ::: "memory"); SBAR();
#define PK(L, H) (bf16x8){L[0], L[1], L[2], L[3], H[0], H[1], H[2], H[3]}
  o[0] = __builtin_amdgcn_mfma_f32_32x32x16_bf16(pa, PK(l0, h0), o[0], 0, 0, 0);
  o[1] = __builtin_amdgcn_mfma_f32_32x32x16_bf16(pa, PK(l1, h1), o[1], 0, 0, 0);
  o[2] = __builtin_amdgcn_mfma_f32_32x32x16_bf16(pa, PK(l2, h2), o[2], 0, 0, 0);
  o[3] = __builtin_amdgcn_mfma_f32_32x32x16_bf16(pa, PK(l3, h3), o[3], 0, 0, 0);
#undef PK
}
__device__ __forceinline__ void pv_d0(f32x16* o, int vb, bf16x8 pa0, bf16x8 pa1, bf16x8 pa2, bf16x8 pa3) {
  pv_step<0>(o, vb, pa0); pv_step<1>(o, vb, pa1); pv_step<2>(o, vb, pa2); pv_step<3>(o, vb, pa3);
}
template <int DQK>
__device__ __forceinline__ void attn_core(const Src in, const float C, const float thr, const int seq, LAS char* lds, f32x16 (&o)[4]) {
  constexpr int NSUB = DQK / 64, SHM_K = NSUB * 8192;
  int lane; asm volatile("v_and_b32 %0, 63, %1" : "=v"(lane) : "v"(threadIdx.x));
  const int tid = threadIdx.x, wid = __builtin_amdgcn_readfirstlane(tid >> 6), r32 = lane & 31, hi = (lane >> 5) & 1;
  LAS char* V_lds = lds; LAS char* K_lds = lds + 3 * SHM_V;
  LAS float* ws = (LAS float*)(lds + 3 * SHM_V + 3 * SHM_K) + wid * 64; LAS float* li_l = ws; LAS float* al_l = ws + 32;
  float m_reg = -1e30f, l_reg = 0;
#pragma unroll
  for (int d = 0; d < 4; ++d) o[d] = f32x16{};
  bf16x8 qr[DQK / 16];
  const bf16_t* Qw = in.Q + (size_t)(wid * QBLK + r32) * in.ldq + hi * 8;
#pragma unroll
  for (int d0 = 0; d0 < DQK / 16; ++d0) qr[d0] = *(const bf16x8*)(Qw + d0 * 16);
  const int krow = wid * 8 + (lane >> 3), kslot = (lane & 7) ^ ((krow >> 1) & 7);
  const unsigned koff = (unsigned)(krow * in.ldk + kslot * 8) * 2u, k2off = (unsigned)(krow * in.ldk2 + kslot * 8) * 2u;
  unsigned voff[2];
#pragma unroll
  for (int i = 0; i < 2; ++i) { const int p = i * 8192 + wid * 1024 + lane * 16, st = p >> 9, wq = (p & 511) >> 1, kk = (st >> 2) * 8 + (wq >> 5), cl = wq & 31;
    const int k = (kk & ~0xC) | ((kk & 4) << 1) | ((kk & 8) >> 1); voff[i] = (unsigned)(k * in.ldv + (st & 3) * 32 + cl) * 2u; }
  const int vb0 = (int)(unsigned)(size_t)V_lds + v_rd_base(lane);
  const unsigned ldsw = (unsigned)wid * 1024u;
#define GLDS(gp, lp) __builtin_amdgcn_global_load_lds((const unsigned*)(gp), (LAS unsigned*)(lp), 16, 0, 0)
#define ISSUE_K(t, b) do { const char* kb_ = (const char*)in.K + (size_t)(t) * (KVBLK * 2) * in.ldk; \
    _Pragma("unroll") for (int s_ = 0; s_ < NSUB; ++s_) { if (s_ < 2) GLDS(kb_ + s_ * 128 + koff, K_lds + (b) * SHM_K + s_ * 8192 + ldsw); \
      else GLDS((const char*)in.K2 + (size_t)(t) * (KVBLK * 2) * in.ldk2 + k2off, K_lds + (b) * SHM_K + s_ * 8192 + ldsw); } } while (0)
#define ISSUE_V(t, b) do { const char* vb_ = (const char*)in.V + (size_t)(t) * (KVBLK * 2) * in.ldv; \
    GLDS(vb_ + voff[0], V_lds + (b) * SHM_V + ldsw); GLDS(vb_ + voff[1], V_lds + (b) * SHM_V + 8192 + ldsw); \
    if (ATT_DUP == 3) { GLDS(vb_ + voff[0], V_lds + (b) * SHM_V + ldsw); GLDS(vb_ + voff[1], V_lds + (b) * SHM_V + 8192 + ldsw); } } while (0)
#define WAITV(n) asm volatile("s_waitcnt vmcnt(%0)" :: "n"((DBG_SKIP & 4) ? 0 : (n)) : "memory")
#define WBAR() do { asm volatile("" ::: "memory"); __builtin_amdgcn_s_barrier(); asm volatile("" ::: "memory"); } while (0)
#define RESC(a) do { if (__any((a) < 1.f)) { if (hi == 0) al_l[r32] = (a); asm volatile("s_waitcnt lgkmcnt(0)" ::: "memory"); \
    _Pragma("unroll") for (int d = 0; d < 4; ++d) _Pragma("unroll") for (int r = 0; r < 16; ++r) o[d][r] *= al_l[crow(r, hi)]; } } while (0)
#define NXT3(x) ((x) == 2 ? 0 : (x) + 1)
  constexpr int NI = NSUB + (ATT_DUP == 3 ? 4 : 2), NV = (ATT_DUP == 3 ? 4 : 2);
  f32x16 pA0, pA1, pB0, pB1; float mnA, mnB, alA, alB; bf16x8 pa0, pa1, pa2, pa3; const int NT = seq / KVBLK;
  const bool lead = wid < 4;
  ISSUE_K(0, 0); ISSUE_K(1, 1); ISSUE_V(0, 0);
  if (!lead) { WAITV(NI); WBAR(); }
  WAITV(NI); WBAR();
  ISSUE_K(2, 2);
  qkt<DQK>(pA0, pA1, K_lds, qr, r32, hi);
  WAITV(NI); WBAR();
  ISSUE_V(1, 1);
  partialSM(pA0, pA1, m_reg, mnA, alA, C, thr);
  WAITV(NI); WBAR();
  int bq = 1;
  for (int j = 1; j + 3 < NT; j += 2) {
    { const int b1 = NXT3(bq), b2 = NXT3(b1);
      ISSUE_K(j + 2, b2);
      SBAR(); qkt<DQK>(pB0, pB1, K_lds + bq * SHM_K, qr, r32, hi);
      finishSM(pA0, pA1, alA, l_reg, pa0, pa1, pa2, pa3); SBAR();
      WAITV(NI); WBAR();
      ISSUE_V(j + 1, b1);
      pv_d0(o, vb0 + b2 * SHM_V, pa0, pa1, pa2, pa3); partialSM(pB0, pB1, m_reg, mnB, alB, C, thr);
      RESC(alB); bq = b1;
      WAITV(NI); WBAR(); }
    { const int b1 = NXT3(bq), b2 = NXT3(b1);
      ISSUE_K(j + 3, b2);
      SBAR(); qkt<DQK>(pA0, pA1, K_lds + bq * SHM_K, qr, r32, hi);
      finishSM(pB0, pB1, alB, l_reg, pa0, pa1, pa2, pa3); SBAR();
      WAITV(NI); WBAR();
      ISSUE_V(j + 2, b1);
      pv_d0(o, vb0 + b2 * SHM_V, pa0, pa1, pa2, pa3); partialSM(pA0, pA1, m_reg, mnA, alA, C, thr);
      RESC(alA); bq = b1;
      WAITV(NI); WBAR(); }
  }
  { const int b1 = NXT3(bq), b2 = NXT3(b1);
    ISSUE_K(NT - 1, b2);
    SBAR(); qkt<DQK>(pB0, pB1, K_lds + bq * SHM_K, qr, r32, hi);
    finishSM(pA0, pA1, alA, l_reg, pa0, pa1, pa2, pa3); SBAR();
    WAITV(NI); WBAR();
    ISSUE_V(NT - 2, b1);
    pv_d0(o, vb0 + b2 * SHM_V, pa0, pa1, pa2, pa3); partialSM(pB0, pB1, m_reg, mnB, alB, C, thr);
    RESC(alB); bq = b1;
    WAITV(NI); WBAR(); }
  { const int b1 = NXT3(bq), b2 = NXT3(b1);
    SBAR(); qkt<DQK>(pA0, pA1, K_lds + bq * SHM_K, qr, r32, hi);
    finishSM(pB0, pB1, alB, l_reg, pa0, pa1, pa2, pa3); SBAR();
    WAITV(NV); WBAR();
    ISSUE_V(NT - 1, b1);
    pv_d0(o, vb0 + b2 * SHM_V, pa0, pa1, pa2, pa3); partialSM(pA0, pA1, m_reg, mnA, alA, C, thr);
    RESC(alA); bq = b1;
    WAITV(NV); WBAR(); }
  { const int b2 = NXT3(NXT3(bq));
    SBAR(); qkt<DQK>(pB0, pB1, K_lds + bq * SHM_K, qr, r32, hi);
    finishSM(pA0, pA1, alA, l_reg, pa0, pa1, pa2, pa3); SBAR();
    WAITV(0); WBAR();
    pv_d0(o, vb0 + b2 * SHM_V, pa0, pa1, pa2, pa3); partialSM(pB0, pB1, m_reg, mnB, alB, C, thr);
    RESC(alB);
    WBAR(); }
  finishSM(pB0, pB1, alB, l_reg, pa0, pa1, pa2, pa3); SBAR();
  pv_d0(o, vb0 + bq * SHM_V, pa0, pa1, pa2, pa3);
  if (lead) { WBAR(); }
  if (hi == 0) li_l[r32] = l_reg; asm volatile("s_waitcnt lgkmcnt(0)" ::: "memory");
#pragma unroll
  for (int r = 0; r < 16; ++r) { const float rl = __builtin_amdgcn_rcpf(li_l[crow(r, hi)]);
#pragma unroll
    for (int d = 0; d < 4; ++d) o[d][r] *= rl; }
  asm volatile("s_waitcnt lgkmcnt(0)" ::: "memory"); WBAR();
#undef GLDS
#undef ISSUE_K
#undef ISSUE_V
#undef WAITV
#undef WBAR
#undef RESC
#undef NXT3
}
template <int DQK>
__device__ __forceinline__ void attn_core_seq(const Src in, const float C, const float thr, const int seq, LAS char* lds, f32x16 (&o)[4]) {
  constexpr int NSUB = DQK / 64, SHM_K = NSUB * 8192;
  int lane; asm volatile("v_and_b32 %0, 63, %1" : "=v"(lane) : "v"(threadIdx.x));
  const int tid = threadIdx.x, wid = __builtin_amdgcn_readfirstlane(tid >> 6), r32 = lane & 31, hi = (lane >> 5) & 1;
  LAS char* V_lds = lds; LAS char* K_lds = lds + 3 * SHM_V;
  LAS float* ws = (LAS float*)(lds + 3 * SHM_V + 3 * SHM_K) + wid * 64; LAS float* li_l = ws; LAS float* al_l = ws + 32;
  float m_reg = -1e30f, l_reg = 0;
#pragma unroll
  for (int d = 0; d < 4; ++d) o[d] = f32x16{};
  bf16x8 qr[DQK / 16];
  const bf16_t* Qw = in.Q + (size_t)(wid * QBLK + r32) * in.ldq + hi * 8;
#pragma unroll
  for (int d0 = 0; d0 < DQK / 16; ++d0) qr[d0] = *(const bf16x8*)(Qw + d0 * 16);
  const int krow = wid * 8 + (lane >> 3), kslot = (lane & 7) ^ ((krow >> 1) & 7);
  const unsigned koff = (unsigned)(krow * in.ldk + kslot * 8) * 2u, k2off = (unsigned)(krow * in.ldk2 + kslot * 8) * 2u;
  unsigned voff[2];
#pragma unroll
  for (int i = 0; i < 2; ++i) { const int p = i * 8192 + wid * 1024 + lane * 16, st = p >> 9, wq = (p & 511) >> 1, kk = (st >> 2) * 8 + (wq >> 5), cl = wq & 31;
    const int k = (kk & ~0xC) | ((kk & 4) << 1) | ((kk & 8) >> 1); voff[i] = (unsigned)(k * in.ldv + (st & 3) * 32 + cl) * 2u; }
  const int vb0 = (int)(unsigned)(size_t)V_lds + v_rd_base(lane);
  const unsigned ldsw = (unsigned)wid * 1024u;
#define GLDS(gp, lp) __builtin_amdgcn_global_load_lds((const unsigned*)(gp), (LAS unsigned*)(lp), 16, 0, 0)
#define ISSUE_K(t, b) do { const char* kb_ = (const char*)in.K + (size_t)(t) * (KVBLK * 2) * in.ldk; \
    _Pragma("unroll") for (int s_ = 0; s_ < NSUB; ++s_) { if (s_ < 2) GLDS(kb_ + s_ * 128 + koff, K_lds + (b) * SHM_K + s_ * 8192 + ldsw); \
      else GLDS((const char*)in.K2 + (size_t)(t) * (KVBLK * 2) * in.ldk2 + k2off, K_lds + (b) * SHM_K + s_ * 8192 + ldsw); } } while (0)
#define ISSUE_V(t, b) do { const char* vb_ = (const char*)in.V + (size_t)(t) * (KVBLK * 2) * in.ldv; \
    GLDS(vb_ + voff[0], V_lds + (b) * SHM_V + ldsw); GLDS(vb_ + voff[1], V_lds + (b) * SHM_V + 8192 + ldsw); } while (0)
#define WAITV(n) asm volatile("s_waitcnt vmcnt(%0)" :: "n"(n) : "memory")
#define WBAR() do { asm volatile("" ::: "memory"); __builtin_amdgcn_s_barrier(); asm volatile("" ::: "memory"); } while (0)
#define RESC(a) do { if (__any((a) < 1.f)) { if (hi == 0) al_l[r32] = (a); asm volatile("s_waitcnt lgkmcnt(0)" ::: "memory"); \
    _Pragma("unroll") for (int d = 0; d < 4; ++d) _Pragma("unroll") for (int r = 0; r < 16; ++r) o[d][r] *= al_l[crow(r, hi)]; } } while (0)
#define NXT3(x) ((x) == 2 ? 0 : (x) + 1)
#define SEG_B(b) do { float mn, al; bf16x8 pa0, pa1, pa2, pa3; partialSM(p0, p1, m_reg, mn, al, C, thr); RESC(al); finishSM(p0, p1, al, l_reg, pa0, pa1, pa2, pa3); SBAR(); \
    pv_d0(o, vb0 + (b) * SHM_V, pa0, pa1, pa2, pa3); } while (0)
  constexpr int NI = NSUB + 2;
  f32x16 p0, p1; const int NT = seq / KVBLK; const bool lead = wid < 4;
  ISSUE_K(0, 0); ISSUE_V(0, 0); ISSUE_K(1, 1); ISSUE_V(1, 1);
  if (!lead) { WAITV(NI); WBAR(); }
  WAITV(NI); WBAR();
  int bq = 0;
  for (int j = 0; j + 2 < NT; ++j) {
    const int b1 = NXT3(bq), b2 = NXT3(b1);
    ISSUE_K(j + 2, b2);
    qkt<DQK>(p0, p1, K_lds + bq * SHM_K, qr, r32, hi);
    WAITV(NI); WBAR();
    ISSUE_V(j + 2, b2);
    SEG_B(bq);
    WAITV(NI); WBAR();
    bq = b1;
  }
#pragma unroll
  for (int jj = 0; jj < 2; ++jj) {
    qkt<DQK>(p0, p1, K_lds + bq * SHM_K, qr, r32, hi);
    WAITV(0); WBAR();
    SEG_B(bq);
    WBAR();
    bq = NXT3(bq);
  }
  if (lead) { WBAR(); }
  if (hi == 0) li_l[r32] = l_reg; asm volatile("s_waitcnt lgkmcnt(0)" ::: "memory");
#pragma unroll
  for (int r = 0; r < 16; ++r) { const float rl = __builtin_amdgcn_rcpf(li_l[crow(r, hi)]);
#pragma unroll
    for (int d = 0; d < 4; ++d) o[d][r] *= rl; }
  asm volatile("s_waitcnt lgkmcnt(0)" ::: "memory"); WBAR();
#undef GLDS
#undef ISSUE_K
#undef ISSUE_V
#undef WAITV
#undef WBAR
#undef RESC
#undef NXT3
#undef SEG_B
}
__device__ __forceinline__ void attn_core_da2(const Src in, const float C, const float thr, const int seq, LAS char* lds, f32x16 (&o1)[4], f32x16 (&o2)[4]) {
  constexpr int NSUB = 2, SHM_K = NSUB * 8192;
  const int tid = threadIdx.x, wid = __builtin_amdgcn_readfirstlane(tid >> 6), lane = tid & 63, r32 = lane & 31, hi = lane >> 5;
  LAS char* V_lds = lds; LAS char* K_lds = lds + 3 * SHM_V;
  LAS float* ws = (LAS float*)(lds + 3 * SHM_V + 3 * SHM_K) + wid * 64; LAS float* li_l = ws; LAS float* al_l = ws + 32;
  float m1 = -1e30f, l1 = 0, m2 = -1e30f, l2 = 0;
#pragma unroll
  for (int d = 0; d < 4; ++d) { o1[d] = f32x16{}; o2[d] = f32x16{}; }
  bf16x8 q1[4], q2[4];
  const bf16_t* Qw = in.Q + (size_t)(wid * QBLK + r32) * in.ldq + hi * 8;
#pragma unroll
  for (int d0 = 0; d0 < 4; ++d0) { q1[d0] = *(const bf16x8*)(Qw + d0 * 16); q2[d0] = *(const bf16x8*)(Qw + 64 + d0 * 16); }
  const int krow = wid * 8 + (lane >> 3), kslot = (lane & 7) ^ ((krow >> 1) & 7);
  const unsigned koff = (unsigned)(krow * in.ldk + kslot * 8) * 2u;
  unsigned voff[2];
#pragma unroll
  for (int i = 0; i < 2; ++i) { const int p = i * 8192 + wid * 1024 + lane * 16, st = p >> 9, wq = (p & 511) >> 1, kk = (st >> 2) * 8 + (wq >> 5), cl = wq & 31;
    const int k = (kk & ~0xC) | ((kk & 4) << 1) | ((kk & 8) >> 1); voff[i] = (unsigned)(k * in.ldv + (st & 3) * 32 + cl) * 2u; }
  const int vb0 = (int)(unsigned)(size_t)V_lds + v_rd_base(lane);
  const unsigned ldsw = (unsigned)wid * 1024u;
#define GLDS(gp, lp) __builtin_amdgcn_global_load_lds((const unsigned*)(gp), (LAS unsigned*)(lp), 16, 0, 0)
#define ISSUE_KV(t, b) do { const char* kb_ = (const char*)in.K + (size_t)(t) * (KVBLK * 2) * in.ldk; const char* vb_ = (const char*)in.V + (size_t)(t) * (KVBLK * 2) * in.ldv; \
    GLDS(kb_ + koff, K_lds + (b) * SHM_K + ldsw); GLDS(kb_ + 128 + koff, K_lds + (b) * SHM_K + 8192 + ldsw); \
    GLDS(vb_ + voff[0], V_lds + (b) * SHM_V + ldsw); GLDS(vb_ + voff[1], V_lds + (b) * SHM_V + 8192 + ldsw); } while (0)
#define WAITV(n) asm volatile("s_waitcnt vmcnt(%0)" :: "n"(n) : "memory")
#define WBAR() do { asm volatile("" ::: "memory"); __builtin_amdgcn_s_barrier(); asm volatile("" ::: "memory"); } while (0)
#define RESC(oo, a) do { if (__any((a) < 1.f)) { if (hi == 0) al_l[r32] = (a); asm volatile("s_waitcnt lgkmcnt(0)" ::: "memory"); \
    _Pragma("unroll") for (int d = 0; d < 4; ++d) _Pragma("unroll") for (int r = 0; r < 16; ++r) oo[d][r] *= al_l[crow(r, hi)]; asm volatile("s_waitcnt lgkmcnt(0)" ::: "memory"); } } while (0)
#define NXT3(x) ((x) == 2 ? 0 : (x) + 1)
#define TILE_BODY(b) do { f32x16 p0, p1; float mn, al; bf16x8 pa0, pa1, pa2, pa3; \
    qkt<64>(p0, p1, K_lds + (b) * SHM_K, q1, r32, hi); partialSM(p0, p1, m1, mn, al, C, thr); RESC(o1, al); \
    finishSM(p0, p1, al, l1, pa0, pa1, pa2, pa3); SBAR(); pv_d0(o1, vb0 + (b) * SHM_V, pa0, pa1, pa2, pa3); SBAR(); \
    qkt<64>(p0, p1, K_lds + (b) * SHM_K + 8192, q2, r32, hi); partialSM(p0, p1, m2, mn, al, C, thr); RESC(o2, al); \
    finishSM(p0, p1, al, l2, pa0, pa1, pa2, pa3); SBAR(); pv_d0(o2, vb0 + (b) * SHM_V, pa0, pa1, pa2, pa3); SBAR(); } while (0)
  const int NT = seq / KVBLK;
  ISSUE_KV(0, 0); ISSUE_KV(1, 1);
  int bq = 0;
  for (int j = 0; j + 1 < NT; ++j) {
    const int b1 = NXT3(bq), b2 = NXT3(b1);
    WAITV(4); WBAR();
    if (j + 2 < NT) ISSUE_KV(j + 2, b2); else ISSUE_KV(NT - 1, b2);
    TILE_BODY(bq);
    bq = b1;
  }
  WAITV(4); WBAR();
  TILE_BODY(bq);
  WAITV(0);
  if (hi == 0) { li_l[r32] = l1; al_l[r32] = l2; } asm volatile("s_waitcnt lgkmcnt(0)" ::: "memory");
#pragma unroll
  for (int r = 0; r < 16; ++r) { const float ra = __builtin_amdgcn_rcpf(li_l[crow(r, hi)]), rb = __builtin_amdgcn_rcpf(al_l[crow(r, hi)]);
#pragma unroll
    for (int d = 0; d < 4; ++d) { o1[d][r] *= ra; o2[d][r] *= rb; } }
  asm volatile("s_waitcnt lgkmcnt(0)" ::: "memory"); WBAR();
#undef GLDS
#undef ISSUE_KV
#undef WAITV
#undef WBAR
#undef RESC
#undef NXT3
#undef TILE_BODY
}
}

constexpr int NWAVES = 8;
struct Args { const void* in[27]; float* out; unsigned char* ws; int ph_lo, ph_hi, li, pad; };

__constant__ float c_invA[8] = {1.0f, 0.19392274474868576f, 0.03760603093086393f, 0.007292664737217109f, 0.001414213562373095f, 0.0002742481756762073f, 5.318295896944988e-05f, 1.031338537721246e-05f};
__constant__ float c_invM[32] = {1.0f, 0.6636012376960885f, 0.44036660267178046f, 0.2922278225730151f, 0.19392274474868576f, 0.12868737343265052f, 0.08539710028576561f, 0.05666962144529105f,
    0.03760603093086393f, 0.024955408670558694f, 0.016560440080994446f, 0.010989528534539826f, 0.007292664737217109f, 0.004839421345719893f, 0.003211445994752591f, 0.0021311195369119653f,
    0.001414213562373095f, 0.0009384738703573802f, 0.000622772421914596f, 0.0004132725499855165f, 0.0002742481756762073f, 0.00018199142881462546f, 0.00012076973741146504f, 8.01429472224798e-05f,
    5.318295896944988e-05f, 3.529227739646723e-05f, 2.341999896140934e-05f, 1.5541540297632344e-05f, 1.031338537721246e-05f, 6.8439753011549275e-06f, 4.5416704806078695e-06f, 3.013858152139171e-06f};

__device__ __forceinline__ int permDA(int i) { return i < 16 ? (i >> 1) + 8 * (i & 1) : i; }
__device__ __forceinline__ int permM(int i) { return (i >> 1) + 32 * (i & 1); }
__device__ __forceinline__ int src_in(int j) {
    if (j < 2048) return (j & ~63) + permDA(j & 63);
    if (j < 4352) return j;
    if (j < 6400) return 4416 + (j - 4352);
    if (j < 6464) return 4352 + permM(j - 6400);
    return -1;
}
__device__ __forceinline__ int src_uq(int j) { const int hd = j / 192, off = j % 192; return off < 128 ? j : hd * 192 + 128 + permM(off - 128); }

__device__ __forceinline__ void tr_item(const float* W, int K, int N, bf16_t* WT, int n0, int k0, int scol, const float* rs, LAS float* scr, int lane) {
#pragma unroll 8
    for (int i = 0; i < 32; ++i) { const int kk = 2 * i + (lane >> 5); float v = 0.f; if (scol >= 0) { v = W[(size_t)(k0 + kk) * N + scol]; if (rs) v *= rs[k0 + kk]; } scr[kk * 33 + (lane & 31)] = v; }
    LDS_WAIT(); asm volatile("" ::: "memory");
    const int c = lane & 7;
#pragma unroll
    for (int j = 0; j < 4; ++j) { const int n = (lane >> 3) + 8 * j; const LAS float* s = scr + (8 * c) * 33 + n;
        u32x4 o; o.x = cvt_pk_bf16(s[0 * 33], s[1 * 33]); o.y = cvt_pk_bf16(s[2 * 33], s[3 * 33]); o.z = cvt_pk_bf16(s[4 * 33], s[5 * 33]); o.w = cvt_pk_bf16(s[6 * 33], s[7 * 33]);
        *(u32x4*)(WT + (size_t)(n0 + n) * K + k0 + 8 * c) = o; }
    LDS_WAIT(); asm volatile("" ::: "memory");
}

template <int MODE = 0>
__device__ __forceinline__ void cvt_tile64(const float* W, int N, bf16_t* WT, int Kd, int k0, int n0, int drow0, int lane, const float* rs = nullptr) {
    const int g = lane >> 4, x = lane & 15;
    const float* src = W + (size_t)(k0 + 16 * g) * N + n0 + 4 * x;
    f32x4 v[16];
#pragma unroll
    for (int i = 0; i < 16; ++i) v[i] = __builtin_nontemporal_load((const f32x4*)(src + (size_t)i * N));
    if (rs) {
#pragma unroll
        for (int i = 0; i < 16; ++i) v[i] = v[i] * rs[k0 + 16 * g + i];
    }
#pragma unroll
    for (int j = 0; j < 4; ++j) { u32x4 lo, hi;
        lo.x = cvt_pk_bf16(v[0][j], v[1][j]); lo.y = cvt_pk_bf16(v[2][j], v[3][j]); lo.z = cvt_pk_bf16(v[4][j], v[5][j]); lo.w = cvt_pk_bf16(v[6][j], v[7][j]);
        hi.x = cvt_pk_bf16(v[8][j], v[9][j]); hi.y = cvt_pk_bf16(v[10][j], v[11][j]); hi.z = cvt_pk_bf16(v[12][j], v[13][j]); hi.w = cvt_pk_bf16(v[14][j], v[15][j]);
        const int c = 4 * x + j;
        const int dr = MODE == 1 ? 2 * (c & 31) + (c >> 5) : (MODE == 2 ? (c < 16 ? 2 * (c & 7) + (c >> 3) : c) : c);
        bf16_t* d = WT + (size_t)(drow0 + dr) * Kd + k0 + 16 * g;
        *(u32x4*)d = lo; *(u32x4*)(d + 8) = hi; }
}

__global__ void __launch_bounds__(NWAVES * 64, 2) fwd(Args args) {
#define KARGS() const __attribute__((address_space(4))) unsigned long long* ka_ = (const __attribute__((address_space(4))) unsigned long long*)__builtin_amdgcn_kernarg_segment_ptr(); asm volatile("" : "+s"(ka_))
#define AIN(i) ((const void*)ka_[i])
#define AOUT ((float*)ka_[27])
#define AWS ((unsigned char*)ka_[28])
    extern __shared__ __attribute__((aligned(16))) unsigned char lds_raw[];
    LAS unsigned char* lds = (LAS unsigned char*)lds_raw;
    volatile LAS unsigned* MISC = (volatile LAS unsigned*)(lds + MISC_OFF);
    const int tid = threadIdx.x, wave = __builtin_amdgcn_readfirstlane(tid >> 6);
#define LANE_DECL int lane; asm volatile("v_and_b32 %0, 63, %1" : "=v"(lane) : "v"(threadIdx.x))
    const int G = gridDim.x, bx = blockIdx.x;
    unsigned* ctl = (unsigned*)(args.ws + WS_CTL);
    const int lo = args.ph_lo, hi_ph = args.ph_hi;
    if (tid < 32) MISC[tid] = 0u;
    __syncthreads();
    XcdBarrier bar; bar.bar = ctl + CW_BAR + args.li * XCD_BAR_WORDS; bar.x = 0; bar.st = nullptr;
    if (!MK_PER_PHASE) bar = xcd_barrier_post(ctl + CW_BAR + args.li * XCD_BAR_WORDS, MISC + 8);
#define IN(k) (((PH_MASK >> (k)) & 1) && lo <= (k) && (k) < hi_ph)
#define SEAM(k) do { if (IN(k) && IN((k) + 1)) xcd_barrier(bar); } while (0)
    const int gw = bx * NWAVES + wave, NGW = G * NWAVES;

#define xin ((const float*)AIN(0))
#define positions ((const int*)AIN(1))
#define Bt_in ((bf16_t*)(AWS + WS_BT_IN))
#define Bt_uq ((bf16_t*)(AWS + WS_BT_UQ))
#define Bt_ukv ((bf16_t*)(AWS + WS_BT_UKV))
#define Bt_od ((bf16_t*)(AWS + WS_BT_OD))
#define Bt_om ((bf16_t*)(AWS + WS_BT_OM))
#define Bt_out ((bf16_t*)(AWS + WS_BT_OUT))
#define ropeA ((float*)(AWS + WS_ROPEA))
#define ropeM ((float*)(AWS + WS_ROPEM))
#define sq ((float*)(AWS + WS_SQ2))
#define hbuf ((bf16_t*)(AWS + WS_H))
#define oa ((bf16_t*)(AWS + WS_H))
#define qa ((bf16_t*)(AWS + WS_QA))
#define ka ((bf16_t*)(AWS + WS_KA))
#define va ((bf16_t*)(AWS + WS_VA))
#define cq ((bf16_t*)(AWS + WS_CQ))
#define ckv ((bf16_t*)(AWS + WS_CKV))
#define kr ((bf16_t*)(AWS + WS_KR))
#define gates ((bf16_t*)(AWS + WS_GATES))
#define qm ((bf16_t*)(AWS + WS_QM))
#define kv ((bf16_t*)(AWS + WS_KV))
#define ob ((bf16_t*)(AWS + WS_OB))
#define mrg ((bf16_t*)(AWS + WS_MRG))
#define stash ((float*)(AWS + WS_STASH))
#define rowtok_p ((int*)(AWS + WS_ROWTOK))
#define assign ((u32x2*)(AWS + WS_ASSIGN))
#define Bt_d ((bf16_t*)(AWS + WS_BT_D))
#define Bt_gu ((bf16_t*)(AWS + WS_BT_GU))
#define h2 ((bf16_t*)(AWS + WS_H2))
#define act ((bf16_t*)(AWS + WS_ACT))
#define ybuf ((bf16_t*)(AWS + WS_Y))
#define count ((unsigned*)(AWS + WS_CTL) + CW_COUNT)

    if (IN(0)) {
        KARGS();
        LANE_DECL;
        const float* w_in = (const float*)AIN(3); const float* g_q = (const float*)AIN(9); const float* g_kv = (const float*)AIN(10);
        const float* w_uq = (const float*)AIN(11); const float* w_ukv = (const float*)AIN(12);
        const float* w_od = (const float*)AIN(13); const float* w_om = (const float*)AIN(14); const float* w_out = (const float*)AIN(16);
        constexpr int I_IN = 16 * 101, I_PAD = 16 * 3, I_UQ = 12 * 24, I_UKV = 8 * 32, I_O = 16 * 16;
        constexpr int NITEMS = I_IN + I_PAD + I_UQ + I_UKV + 3 * I_O;
        for (int it = gw; it < NITEMS; it += NGW) {
            int r = it;
            if (r < I_IN) { const int kb = r / 101, cb = r % 101, n0 = cb * 64;
                if (n0 < 2048) cvt_tile64<2>(w_in, 6464, Bt_in, D, kb * 64, n0, n0, lane);
                else if (n0 < 4352) cvt_tile64<0>(w_in, 6464, Bt_in, D, kb * 64, n0, n0, lane);
                else if (n0 < 4416) cvt_tile64<1>(w_in, 6464, Bt_in, D, kb * 64, n0, 5888, lane);
                else if (n0 < 4416 + 1536) cvt_tile64<0>(w_in, 6464, Bt_in, D, kb * 64, n0, n0 - 64, lane);
                else cvt_tile64<0>(w_in, 6464, Bt_in, D, kb * 64, n0, n0 - 64 + 256, lane);
                continue; } r -= I_IN;
            if (r < I_PAD) { const int kb = r / 3, rb = r % 3; const int g = lane >> 4, x4 = lane & 15;
#pragma unroll
                for (int j = 0; j < 4; ++j) { bf16_t* d = Bt_in + (size_t)(5952 + rb * 64 + 4 * x4 + j) * D + kb * 64 + 16 * g; *(u32x4*)d = (u32x4){0u, 0u, 0u, 0u}; *(u32x4*)(d + 8) = (u32x4){0u, 0u, 0u, 0u}; }
                continue; } r -= I_PAD;
            if (r < I_UQ) { const int kb = r / 24, cb = r % 24, n0 = cb * 64;
                if ((cb % 3) == 2) cvt_tile64<1>(w_uq, 1536, Bt_uq, QL, kb * 64, n0, n0, lane, g_q); else cvt_tile64<0>(w_uq, 1536, Bt_uq, QL, kb * 64, n0, n0, lane, g_q);
                continue; } r -= I_UQ;
            if (r < I_UKV) { const int kb = r / 32, cb = r % 32; cvt_tile64<0>(w_ukv, 2048, Bt_ukv, KVL, kb * 64, cb * 64, cb * 64, lane, g_kv); continue; } r -= I_UKV;
            const int which = r / I_O; r -= which * I_O; const int kb = r / 16, cb = r % 16;
            cvt_tile64<0>(which == 0 ? w_od : (which == 1 ? w_om : w_out), D, which == 0 ? Bt_od : (which == 1 ? Bt_om : Bt_out), D, kb * 64, cb * 64, cb * 64, lane);
        }
        const float* g_mix = (const float*)AIN(2);
        for (int m = gw * 4; m < T; m += NGW * 4) {
            f32x4 v[4][4]; float ss[4];
#pragma unroll
            for (int q = 0; q < 4; ++q) { const f32x4* xr = (const f32x4*)(xin + (size_t)(m + q) * D) + lane;
#pragma unroll
                for (int j = 0; j < 4; ++j) v[q][j] = xr[64 * j]; }
#pragma unroll
            for (int q = 0; q < 4; ++q) { float s = 0.f;
#pragma unroll
                for (int j = 0; j < 4; ++j) s += (v[q][j][0] * v[q][j][0] + v[q][j][1] * v[q][j][1]) + (v[q][j][2] * v[q][j][2] + v[q][j][3] * v[q][j][3]);
                ss[q] = __builtin_amdgcn_rsqf(wave_sum(s) * (1.f / D) + EPS); }
#pragma unroll
            for (int j = 0; j < 4; ++j) { const f32x4 gg = *((const f32x4*)g_mix + lane + 64 * j);
#pragma unroll
                for (int q = 0; q < 4; ++q) { u32x2 w; w.x = cvt_pk_bf16(v[q][j][0] * ss[q] * gg[0], v[q][j][1] * ss[q] * gg[1]); w.y = cvt_pk_bf16(v[q][j][2] * ss[q] * gg[2], v[q][j][3] * ss[q] * gg[3]);
                    ((u32x2*)(hbuf + (size_t)(m + q) * D) + lane)[64 * j] = w; } }
        }
        for (int idx = bx * 512 + tid; idx < T * 40; idx += G * 512) {
            const int t = idx / 40, i = idx % 40; const float inv = i < 8 ? c_invA[i] : c_invM[i - 8];
            const float ang = (float)positions[t] * inv;
            const double rev = (double)ang * 0.15915494309189535; const float fr_ = (float)(rev - __builtin_rint(rev));
            const float cs = __builtin_amdgcn_cosf(fr_), sn = __builtin_amdgcn_sinf(fr_);
            float* dst = i < 8 ? ropeA + ((size_t)t * 8 + i) * 2 : ropeM + ((size_t)t * 32 + (i - 8)) * 2; dst[0] = cs; dst[1] = sn;
        }
    }
    SEAM(0);
    if (IN(1)) {
        KARGS();
        pg8::Gemm g{hbuf, Bt_in, D}; pg8::DenseOrder S; S.init(T / 256, 24, G, bx);
        pg8::EpiIn E{qa, ka, va, cq, ckv, gates, kr, ropeA, ropeM, (const float*)AIN(15), sq};
        pg8::gemm_phase<pg8::EpiIn, pg8::DenseOrder, false, true>(lds, g, S, E);
    }
    SEAM(1);
    if (IN(2)) {
        KARGS();
        { pg8::Gemm g{hbuf, Bt_in, D}; pg8::DenseOrder S; S.init(T / 256, 2, G, bx, 24);
          pg8::EpiIn E{qa, ka, va, cq, ckv, gates, kr, ropeA, ropeM, (const float*)AIN(15), sq};
          pg8::gemm_phase<pg8::EpiIn, pg8::DenseOrder, false, true>(lds, g, S, E); }
        { pg8::Gemm g{cq, Bt_uq, QL}; pg8::DenseOrder S; S.init(T / 256, 1536 / 256, G, G - 1 - bx); pg8::EpiUp<true> E{qm, sq, ropeM};
          pg8::gemm_phase<pg8::EpiUp<true>, pg8::DenseOrder, false, true>(lds, g, S, E); }
        { pg8::Gemm g{ckv, Bt_ukv, KVL}; pg8::DenseOrder S; S.init(T / 256, 2048 / 256, G, bx); pg8::EpiUp<false> E{kv, sq, ropeM};
          pg8::gemm_phase<pg8::EpiUp<false>, pg8::DenseOrder, false, true>(lds, g, S, E); }
    }
    SEAM(2);
    if (IN(3)) {
        KARGS();
        const int lane = threadIdx.x & 63;
        const int wid = wave;
#define UNIT_DECODE(L) int u = (L) & 511; if (G == 256) { const int c = (L) & 255; u = ((L) & 256) + (c & 7) * 32 + (c >> 3); } \
            const int bh = u >> 4, qb = u & 15, b = bh >> 3, h = bh & 7; const size_t q0 = (size_t)b * SEQ + qb * 256, k0 = (size_t)b * SEQ
        for (int L = bx; L < 512; L += G) {
#if PROBE_PHASE == 3 && defined(PROBE_ATT)
            if (args.li == 1 && lo == 3 && PROBE_ATT != 0) continue;
#endif
            UNIT_DECODE(L);
            f32x16 o[4], o2[4];
            { att::Src in{qa + q0 * 1024 + h * 128, ka + k0 * 1024 + h * 128, nullptr, va + k0 * 1024 + h * 128, 1024, 1024, 0, 1024};
              att::attn_core_da2(in, 0.125f * 1.4426950408889634f, 8.f / 0.125f, SEQ, (LAS char*)lds, o, o2); }
            float lam;
            { const float* lq1 = (const float*)AIN(4); const float* lk1 = (const float*)AIN(5); const float* lq2 = (const float*)AIN(6); const float* lk2 = (const float*)AIN(7);
              const float s1 = wave_sum(lq1[lane] * lk1[lane]), s2 = wave_sum(lq2[lane] * lk2[lane]); lam = __expf(s1) - __expf(s2) + LAM_INIT; }
            float ss[16];
#pragma unroll
            for (int r = 0; r < 16; ++r) ss[r] = 0.f;
#pragma unroll
            for (int d = 0; d < 4; ++d)
#pragma unroll
                for (int r = 0; r < 16; ++r) { const float v = o[d][r] - lam * o2[d][r]; o[d][r] = v; ss[r] += v * v; }
#pragma unroll
            for (int r = 0; r < 16; ++r) {
#pragma unroll
                for (int msk = 1; msk < 32; msk <<= 1) ss[r] += __shfl_xor(ss[r], msk);
                ss[r] = __builtin_amdgcn_rsqf(ss[r] * (1.0f / 128.0f) + EPS); }
            int ln2; asm volatile("v_and_b32 %0, 63, %1" : "=v"(ln2) : "v"(threadIdx.x));
            const int hi2 = ln2 >> 5, r32e = ln2 & 31;
            bf16_t* Ow = oa + (q0 + wid * 32 + 4 * hi2) * 1024 + h * 128 + r32e;
            float gs[4];
#pragma unroll
            for (int d = 0; d < 4; ++d) gs[d] = ((const float*)AIN(8))[d * 32 + r32e] * (1.0f - LAM_INIT);
#pragma unroll
            for (int r = 0; r < 16; ++r) { const int orow = att::crow(r, 0);
#pragma unroll
                for (int d = 0; d < 4; ++d) Ow[orow * 1024 + d * 32] = (bf16_t)(cvt_pk_bf16(o[d][r] * ss[r] * gs[d], 0.f) & 0xffffu); }
        }
        for (int L = 512 + bx; L < 1024; L += G) {
#if PROBE_PHASE == 3 && defined(PROBE_ATT)
            if (args.li == 1 && lo == 3 && PROBE_ATT != 1) continue;
#endif
            UNIT_DECODE(L);
            f32x16 o[4];
            { att::Src in{qm + q0 * 1536 + h * 192, kv + k0 * 2048 + h * 256, kr + k0 * 64, kv + k0 * 2048 + h * 256 + 128, 1536, 2048, 64, 2048};
              att::attn_core_seq<192>(in, 0.07216878364870322f * 1.4426950408889634f, 8.f / 0.07216878364870322f, SEQ, (LAS char*)lds, o); }
            int ln2; asm volatile("v_and_b32 %0, 63, %1" : "=v"(ln2) : "v"(threadIdx.x));
            const int hi2 = ln2 >> 5, r32e = ln2 & 31;
            bf16_t* Ow = ob + (q0 + wid * 32 + 4 * hi2) * 1024 + h * 128 + r32e;
#pragma unroll
            for (int r = 0; r < 16; ++r) { const int orow = att::crow(r, 0);
#pragma unroll
                for (int d = 0; d < 4; ++d) Ow[orow * 1024 + d * 32] = (bf16_t)(cvt_pk_bf16(o[d][r], 0.f) & 0xffffu); }
        }
#undef UNIT_DECODE
    }
    SEAM(3);
    if (IN(4)) {
        KARGS();
        { pg8::Gemm g{oa, Bt_od, D}; pg8::DenseOrder S; S.init(T / 256, 4, G, bx); pg8::EpiGate<0> E{mrg, gates};
          pg8::gemm_phase<pg8::EpiGate<0>, pg8::DenseOrder, false, true>(lds, g, S, E); }
        VM_WAIT(); __syncthreads();
        { pg8::Gemm g{ob, Bt_om, D}; pg8::DenseOrder S; S.init(T / 256, 4, G, bx); pg8::EpiGate<1> E{mrg, gates};
          pg8::gemm_phase<pg8::EpiGate<1>, pg8::DenseOrder, false, true>(lds, g, S, E); }
    }
    SEAM(4);
    if (IN(5)) {
        KARGS();
        pg8::Gemm g{mrg, Bt_out, D}; pg8::DenseOrder S; S.init(T / 256, 4, G, bx); pg8::EpiRes E{xin, AOUT};
        pg8::gemm_phase<pg8::EpiRes, pg8::DenseOrder, false, true>(lds, g, S, E);
    }
    SEAM(5);
    if (IN(6)) {
        KARGS();
        LANE_DECL;
        const float* g_ffn = (const float*)AIN(17); const float* w_router = (const float*)AIN(18); const float* b_router = (const float*)AIN(19);
        constexpr int WRS = 1028;
        LAS float* wr_l = (LAS float*)lds;
        LAS int* lcount = (LAS int*)(lds + TAB_OFF + 1024); LAS int* gbase = lcount + 32; LAS unsigned* asg_e = (LAS unsigned*)(lcount + 64); LAS float* asg_w = (LAS float*)(lcount + 64 + 256);
        LAS int* sync_w = (LAS int*)(lds + TAB_OFF + 512);
        for (int i = tid; i < D * NEXP; i += 512) wr_l[(i & 31) * WRS + (i >> 5)] = w_router[i];
        if (tid < 32) lcount[tid] = 0;
        if (tid < 2) sync_w[tid] = 0;
        __syncthreads();
        const int ex = (lane >> 1) & 31;
        LAS float* lg = (LAS float*)(lds + TAB_OFF + 4096) + wave * 80;
        const int chunk = bx;
        if (wave < 4 && chunk < T / 64) {
            const float my_b = b_router[ex];
#pragma unroll 1
            for (int j2 = 0; j2 < 8; ++j2) {
                const int tl = wave * 16 + j2 * 2, t = chunk * 64 + tl;
                f32x4 xva[4], xvb[4]; float sa = 0.f, sb = 0.f;
                { const f32x4* xa = (const f32x4*)(AOUT + (size_t)t * D) + lane; const f32x4* xb = xa + D / 4;
#pragma unroll
                  for (int j = 0; j < 4; ++j) { xva[j] = xa[64 * j]; xvb[j] = xb[64 * j]; }
#pragma unroll
                  for (int j = 0; j < 4; ++j) { sa += (xva[j][0] * xva[j][0] + xva[j][1] * xva[j][1]) + (xva[j][2] * xva[j][2] + xva[j][3] * xva[j][3]); sb += (xvb[j][0] * xvb[j][0] + xvb[j][1] * xvb[j][1]) + (xvb[j][2] * xvb[j][2] + xvb[j][3] * xvb[j][3]); } }
                const float ra = __builtin_amdgcn_rsqf(wave_sum(sa) * (1.f / D) + EPS), rb = __builtin_amdgcn_rsqf(wave_sum(sb) * (1.f / D) + EPS);
                { u32x2* oa8 = (u32x2*)(h2 + (size_t)t * D) + lane; u32x2* ob8 = oa8 + D / 4;
#pragma unroll
                  for (int j = 0; j < 4; ++j) { const f32x4 gg = *((const f32x4*)g_ffn + lane + 64 * j); xva[j] = xva[j] * ra * gg; xvb[j] = xvb[j] * rb * gg;
                    u32x2 w; w.x = cvt_pk_bf16(xva[j][0], xva[j][1]); w.y = cvt_pk_bf16(xva[j][2], xva[j][3]); oa8[64 * j] = w;
                    w.x = cvt_pk_bf16(xvb[j][0], xvb[j][1]); w.y = cvt_pk_bf16(xvb[j][2], xvb[j][3]); ob8[64 * j] = w; } }
                float aa[32], ab[32];
#pragma unroll
                for (int e = 0; e < NEXP; ++e) { float a = 0.f, b = 0.f;
#pragma unroll
                    for (int j = 0; j < 4; ++j) { const f32x4 w4 = *(const LAS f32x4*)(wr_l + e * WRS + 4 * lane + 256 * j);
                        a += (xva[j][0] * w4[0] + xva[j][1] * w4[1]) + (xva[j][2] * w4[2] + xva[j][3] * w4[3]); b += (xvb[j][0] * w4[0] + xvb[j][1] * w4[1]) + (xvb[j][2] * w4[2] + xvb[j][3] * w4[3]); }
                    aa[e] = a; ab[e] = b; }
#define TRED(arr, n, msk) _Pragma("unroll") for (int i_ = 0; i_ < (n); ++i_) { const bool up_ = (lane & (msk)) != 0; const float keep_ = up_ ? arr[(n) + i_] : arr[i_], give_ = up_ ? arr[i_] : arr[(n) + i_]; arr[i_] = keep_ + __shfl_xor(give_, (msk)); }
                TRED(aa, 16, 32) TRED(aa, 8, 16) TRED(aa, 4, 8) TRED(aa, 2, 4) TRED(aa, 1, 2)
                TRED(ab, 16, 32) TRED(ab, 8, 16) TRED(ab, 4, 8) TRED(ab, 2, 4) TRED(ab, 1, 2)
#undef TRED
                const float la = aa[0] + __shfl_xor(aa[0], 1) + my_b, lb = ab[0] + __shfl_xor(ab[0], 1) + my_b;
#pragma unroll
                for (int tk = 0; tk < 2; ++tk) {
                    const float v = tk ? lb : la; int rank = 0;
                    if (!(lane & 1)) lg[tk * 32 + ex] = v;
                    LDS_WAIT();
#pragma unroll
                    for (int q = 0; q < 8; ++q) { const f32x4 s4 = *(const LAS f32x4*)(lg + tk * 32 + 4 * q);
#pragma unroll
                        for (int jj = 0; jj < 4; ++jj) rank += (s4[jj] > v || (s4[jj] == v && (4 * q + jj) < ex)) ? 1 : 0; }
                    if (rank < 4 && !(lane & 1)) lg[64 + tk * 4 + rank] = v;
                    LDS_WAIT();
                    const f32x4 tv = *(const LAS f32x4*)(lg + 64 + tk * 4);
                    const float p1 = __expf(tv[1] - tv[0]), p2 = __expf(tv[2] - tv[0]), p3 = __expf(tv[3] - tv[0]), inv = 1.0f / (1.0f + p1 + p2 + p3);
                    if (rank < 4 && !(lane & 1)) { const float w = (rank == 0 ? 1.0f : (rank == 1 ? p1 : (rank == 2 ? p2 : p3))) * inv;
                        const int lr = __hip_atomic_fetch_add((LAS int*)&lcount[ex], 1, __ATOMIC_RELAXED, __HIP_MEMORY_SCOPE_WORKGROUP);
                        asg_e[(tl + tk) * 4 + rank] = ((unsigned)ex << 16) | (unsigned)lr; asg_w[(tl + tk) * 4 + rank] = w; }
                }
            }
            LDS_WAIT();
            if (lane == 0) __hip_atomic_fetch_add((LAS int*)&sync_w[0], 1, __ATOMIC_RELAXED, __HIP_MEMORY_SCOPE_WORKGROUP);
            if (wave == 0) {
                while (__hip_atomic_load((LAS int*)&sync_w[0], __ATOMIC_RELAXED, __HIP_MEMORY_SCOPE_WORKGROUP) < 4) __builtin_amdgcn_s_sleep(4);
                asm volatile("s_waitcnt lgkmcnt(0)" ::: "memory");
                if (lane < 32) gbase[lane] = (int)__hip_atomic_fetch_add(count + lane, (unsigned)lcount[lane], __ATOMIC_RELAXED, __HIP_MEMORY_SCOPE_AGENT);
                LDS_WAIT();
#pragma unroll
                for (int q = 0; q < 4; ++q) { const int a_ = q * 64 + lane; const unsigned ae = asg_e[a_]; const int e = ae >> 16, rank = gbase[e] + (int)(ae & 0xffffu); const int t = chunk * 64 + (a_ >> 2);
                    rowtok_p[e * T + rank] = t; u32x2 av; av.x = ((unsigned)e << 16) | (unsigned)rank; av.y = __float_as_uint(asg_w[a_]); assign[(size_t)t * 4 + (a_ & 3)] = av; }
            }
        }
        const float* w_gate = (const float*)AIN(20); const float* w_up = (const float*)AIN(22); const float* w_down = (const float*)AIN(24);
        const int per_wg = (NEXP * 768 + G - 1) / G;
        for (;;) {
            int it = 0; if (lane == 0) it = __hip_atomic_fetch_add((LAS int*)&sync_w[1], 1, __ATOMIC_RELAXED, __HIP_MEMORY_SCOPE_WORKGROUP);
            it = __builtin_amdgcn_readfirstlane(it); const int item = bx * per_wg + it;
            if (it >= per_wg || item >= NEXP * 768) break;
            const int e = item / 768, r = item % 768, mat = r >> 8, kb = (r >> 4) & 15, nb = r & 15, f0 = nb * 64;
            if (mat < 2) cvt_tile64((mat ? w_up : w_gate) + (size_t)e * D * FF, FF, Bt_gu + (size_t)e * 2048 * D, D, kb * 64, f0, 256 * (f0 >> 7) + mat * 128 + (f0 & 127), lane);
            else cvt_tile64(w_down + (size_t)e * FF * D, D, Bt_d + (size_t)e * D * FF, FF, kb * 64, f0, f0, lane);
        }
    }
    SEAM(6);
    LAS int* t_cnt = (LAS int*)(lds + TAB_OFF + 4096); LAS int* t_start = t_cnt + 32; LAS int* t_t2e = t_start + 40;
    if (IN(7) || IN(8) || IN(9)) {
        KARGS();
        __syncthreads();
        if (tid < 32) t_cnt[tid] = (int)__hip_atomic_load(count + tid, __ATOMIC_RELAXED, __HIP_MEMORY_SCOPE_AGENT);
        __syncthreads();
        if (tid == 0) { int s = 0; for (int e = 0; e < NEXP; ++e) { t_start[e] = s; s += (t_cnt[e] + 255) >> 8; } t_start[32] = s; }
        __syncthreads();
        if (tid < 32) { for (int rt = t_start[tid]; rt < t_start[tid + 1]; ++rt) t_t2e[rt] = tid; }
        __syncthreads();
    }
    if (IN(7)) {
        KARGS();
        pg8::Gemm g{h2, Bt_gu, D}; pg8::MoeOrder S; S.init(__builtin_amdgcn_readfirstlane(t_start[32]), 8, G, bx); S.t2e = t_t2e; S.tstart = t_start; S.cnt = t_cnt; S.rowtok = rowtok_p;
        pg8::EpiSwiglu E{act, (const float*)AIN(21), (const float*)AIN(23)};
        pg8::gemm_phase<pg8::EpiSwiglu, pg8::MoeOrder, true, true>(lds, g, S, E);
    }
    SEAM(7);
    if (IN(8)) {
        KARGS();
        pg8::Gemm g{act, Bt_d, FF}; pg8::MoeOrder S; S.init(__builtin_amdgcn_readfirstlane(t_start[32]), 4, G, bx); S.t2e = t_t2e; S.tstart = t_start; S.cnt = t_cnt; S.rowtok = rowtok_p;
        pg8::EpiDown E{ybuf, (const float*)AIN(25)};
        pg8::gemm_phase<pg8::EpiDown, pg8::MoeOrder, false, true>(lds, g, S, E);
    }
    SEAM(8);
    if (IN(9) && DBG_OUT) {
        KARGS();
        const bf16_t* src = DBG_OUT == 1 ? gates : DBG_OUT == 2 ? gates + 1024 : DBG_OUT == 3 ? qa : DBG_OUT == 4 ? ka : DBG_OUT == 5 ? va : DBG_OUT == 6 ? mrg : DBG_OUT == 7 ? oa : DBG_OUT == 9 ? Bt_in : ob;
        const int ld = DBG_OUT <= 2 ? 2048 : 1024;
        for (size_t i = (size_t)bx * 512 + tid; i < (size_t)T * 1024; i += (size_t)G * 512) AOUT[i] = (DBG_OUT == 9 && i >= (size_t)N_IN * 1024) ? 0.f : __uint_as_float((unsigned)src[(i >> 10) * ld + (i & 1023)] << 16);
    } else
    if (IN(9)) {
        KARGS();
        LANE_DECL;
        const float* g_fin = (const float*)AIN(26);
        for (int t0 = gw * 2; t0 < T; t0 += NGW * 2) {
            f32x4 v[2][4]; u32x2 as_[2][4];
#pragma unroll
            for (int q = 0; q < 2; ++q) { const f32x4* xr = (const f32x4*)(AOUT + (size_t)(t0 + q) * D) + lane;
#pragma unroll
                for (int j = 0; j < 4; ++j) v[q][j] = xr[64 * j];
#pragma unroll
                for (int k = 0; k < 4; ++k) as_[q][k] = assign[(size_t)(t0 + q) * 4 + k]; }
            u32x2 yw[2][4][4];
#pragma unroll
            for (int q = 0; q < 2; ++q)
#pragma unroll
                for (int k = 0; k < 4; ++k) { const int e = as_[q][k].x >> 16, rank = as_[q][k].x & 0xffffu;
                    const u32x2* yr = (const u32x2*)(ybuf + ((size_t)t_start[e] * 256 + rank) * D) + lane;
#pragma unroll
                    for (int j = 0; j < 4; ++j) yw[q][k][j] = yr[64 * j]; }
#pragma unroll
            for (int q = 0; q < 2; ++q) {
#pragma unroll
                for (int k = 0; k < 4; ++k) { const float w = (DBG_SKIP & 1) ? 0.f : __uint_as_float(as_[q][k].y);
#pragma unroll
                    for (int j = 0; j < 4; ++j) { const u32x2 y = yw[q][k][j]; v[q][j][0] += w * bf_lo(y.x); v[q][j][1] += w * bf_hi(y.x); v[q][j][2] += w * bf_lo(y.y); v[q][j][3] += w * bf_hi(y.y); } }
                float s = 0.f;
#pragma unroll
                for (int j = 0; j < 4; ++j) s += (v[q][j][0] * v[q][j][0] + v[q][j][1] * v[q][j][1]) + (v[q][j][2] * v[q][j][2] + v[q][j][3] * v[q][j][3]);
                const float rstd = __builtin_amdgcn_rsqf(wave_sum(s) * (1.f / D) + EPS);
                f32x4* xo = (f32x4*)(AOUT + (size_t)(t0 + q) * D) + lane;
#pragma unroll
                for (int j = 0; j < 4; ++j) { const f32x4 gg = *((const f32x4*)g_fin + lane + 64 * j); xo[64 * j] = v[q][j] * rstd * gg; } }
        }
    }
#undef IN
#undef SEAM
#undef KARGS
#undef AIN
#undef AOUT
#undef AWS
#undef xin
#undef positions
#undef Bt_in
#undef Bt_uq
#undef Bt_ukv
#undef Bt_od
#undef Bt_om
#undef Bt_out
#undef ropeA
#undef ropeM
#undef sq
#undef hbuf
#undef oa
#undef qa
#undef ka
#undef va
#undef cq
#undef ckv
#undef kr
#undef gates
#undef qm
#undef kv
#undef ob
#undef mrg
#undef stash
#undef rowtok_p
#undef assign
#undef Bt_d
#undef Bt_gu
#undef h2
#undef act
#undef ybuf
#undef count
}

extern "C" void kernel_launch(void* const* d_in, const int* in_sizes, int n_in, void* d_out, int out_size, void* d_ws, size_t ws_size, hipStream_t stream) {
    static int grid = 0;
    if (grid == 0) {
        if (n_in != 27 || in_sizes[0] != T * D || out_size != T * D || ws_size < WS_END) { fprintf(stderr, "kernel_launch: unexpected shapes (n_in %d, in0 %d, out %d, ws %zu < %zu)\n", n_in, n_in > 0 ? in_sizes[0] : -1, out_size, ws_size, (size_t)WS_END); grid = -1; return; }
        int dev = 0, cus = 0, per_cu = 0;
        if (hipGetDevice(&dev) != hipSuccess || hipDeviceGetAttribute(&cus, hipDeviceAttributeMultiprocessorCount, dev) != hipSuccess) { grid = -1; return; }
        if (hipFuncSetAttribute((const void*)fwd, hipFuncAttributeMaxDynamicSharedMemorySize, LDS_BYTES) != hipSuccess) { fprintf(stderr, "kernel_launch: hipFuncSetAttribute failed\n"); grid = -1; return; }
        if (hipOccupancyMaxActiveBlocksPerMultiprocessor(&per_cu, (const void*)fwd, NWAVES * 64, LDS_BYTES) != hipSuccess || per_cu < 1) fprintf(stderr, "kernel_launch: occupancy query says %d\n", per_cu);
        (void)hipGetLastError();
        grid = cus;
    }
    if (grid < 0) return;
    if (hipMemsetAsync((char*)d_ws + WS_CTL, 0, CTL_ZERO_BYTES, stream) != hipSuccess) return;
    Args a{};
    for (int i = 0; i < 27; ++i) a.in[i] = d_in[i];
    a.out = (float*)d_out; a.ws = (unsigned char*)d_ws;
#if MK_PER_PHASE
    for (int p = 0; p < NPHASE; ++p) { a.ph_lo = p; a.ph_hi = p + 1; hipLaunchKernelGGL(fwd, dim3(grid), dim3(NWAVES * 64), LDS_BYTES, stream, a); }
#elif PROBE_PHASE >= 0
    a.ph_lo = 0; a.ph_hi = PROBE_PHASE + 1; a.li = 0; hipLaunchKernelGGL(fwd, dim3(grid), dim3(NWAVES * 64), LDS_BYTES, stream, a);
    a.ph_lo = PROBE_PHASE; a.ph_hi = NPHASE; a.li = 1; hipLaunchKernelGGL(fwd, dim3(grid), dim3(NWAVES * 64), LDS_BYTES, stream, a);
#else
    a.ph_lo = 0; a.ph_hi = NPHASE; hipLaunchKernelGGL(fwd, dim3(grid), dim3(NWAVES * 64), LDS_BYTES, stream, a);
#endif
}
```

```cpp
#include <hip/hip_runtime.h>
#include <cstdio>
#include <cstdint>

#ifndef MK_PER_PHASE
#define MK_PER_PHASE 0
#endif

#ifndef PROBE_PHASE
#define PROBE_PHASE -1
#endif
#ifndef ATT_DUP
#define ATT_DUP 0
#endif
#ifndef DBG_OUT
#define DBG_OUT 0
#endif
#ifndef DBG_SKIP
#define DBG_SKIP 0
#endif
#ifndef ATT_MASK
#define ATT_MASK 3
#endif
#ifndef PH_MASK
#define PH_MASK 0x3ff
#endif
#define LAS __attribute__((address_space(3)))
#define GAS __attribute__((address_space(1)))
typedef unsigned short bf16_t;
typedef short bf16x8 __attribute__((ext_vector_type(8)));
typedef short s16x4 __attribute__((ext_vector_type(4)));
typedef float f32x2 __attribute__((ext_vector_type(2)));
typedef float f32x4 __attribute__((ext_vector_type(4)));
typedef float f32x16 __attribute__((ext_vector_type(16)));
typedef unsigned u32x2 __attribute__((ext_vector_type(2)));
typedef unsigned u32x4 __attribute__((ext_vector_type(4)));

constexpr int NB = 4, SEQ = 4096, T = NB * SEQ, D = 1024;
constexpr int NEXP = 32, TOPK = 4, FF = 1024;
constexpr int N_IN = 6656;
constexpr int QL = 768, KVL = 512;
constexpr float EPS = 1e-6f;
constexpr float LAM_INIT = 0.2f;
constexpr int NPHASE = 10;

constexpr size_t MiB = 1u << 20;
constexpr size_t WS_CTL = 0, CTL_ZERO_BYTES = 1 * MiB;
constexpr size_t WS_BT_IN = 2 * MiB;
constexpr size_t WS_BT_UQ = 15 * MiB;
constexpr size_t WS_BT_UKV = 18 * MiB;
constexpr size_t WS_BT_OD = 20 * MiB, WS_BT_OM = 22 * MiB, WS_BT_OUT = 24 * MiB;
constexpr size_t WS_ROPEA = 26 * MiB;
constexpr size_t WS_ROPEM = 27 * MiB;
constexpr size_t WS_SQ = 31 * MiB;
constexpr size_t WS_SQP = 1 * MiB;
constexpr size_t WS_H = 32 * MiB;
constexpr size_t WS_QA = 64 * MiB, WS_KA = 96 * MiB, WS_VA = 128 * MiB;
constexpr size_t WS_CQ = 160 * MiB, WS_CKV = 184 * MiB, WS_KR = 200 * MiB;
constexpr size_t WS_SQ2 = 202 * MiB;
constexpr size_t WS_GATES = 208 * MiB;
constexpr size_t WS_QM = 272 * MiB;
constexpr size_t WS_KV = 320 * MiB;
constexpr size_t WS_OB = 384 * MiB;
constexpr size_t WS_MRG = 416 * MiB;
constexpr size_t WS_STASH = 448 * MiB;
constexpr size_t WS_ROWTOK = 2 * MiB;
constexpr size_t WS_ASSIGN = 4 * MiB;
constexpr size_t WS_BT_D = 32 * MiB;
constexpr size_t WS_BT_GU = 96 * MiB;
constexpr size_t WS_H2 = 224 * MiB;
constexpr size_t WS_ACT = 256 * MiB;
constexpr size_t WS_Y = 96 * MiB;
constexpr size_t WS_END = 512 * MiB;
constexpr int CW_COUNT = 64;
constexpr int CW_BAR = 4096;

constexpr int RING_BYTES = 131072;
constexpr int TAB_OFF = RING_BYTES;
constexpr int TAB_BYTES = 8192;
constexpr int MISC_OFF = TAB_OFF + TAB_BYTES;
constexpr int LDS_BYTES = 147456;

typedef __bf16 bf16x2_t __attribute__((ext_vector_type(2)));
__device__ __forceinline__ unsigned cvt_pk_bf16(float lo, float hi) { const f32x2 v = {lo, hi}; return __builtin_bit_cast(unsigned, __builtin_convertvector(v, bf16x2_t)); }
__device__ __forceinline__ float bf_lo(unsigned w) { return __uint_as_float(w << 16); }
__device__ __forceinline__ float bf_hi(unsigned w) { return __uint_as_float(w & 0xffff0000u); }
__device__ __forceinline__ float wave_sum(float v) {
#pragma unroll
    for (int o = 1; o < 64; o <<= 1) v += __shfl_xor(v, o);
    return v;
}
__device__ __forceinline__ float sigmoidf_(float x) { return __builtin_amdgcn_rcpf(1.0f + __builtin_amdgcn_exp2f(-1.4426950408889634f * x)); }
#define LDS_WAIT() asm volatile("s_waitcnt lgkmcnt(0)" ::: "memory")
#define VM_WAIT() asm volatile("s_waitcnt vmcnt(0)" ::: "memory")

#define XB_TMO      128
#define XB_XCNT(j)  (256  + 64 * (j))
#define XB_XSUB(j)  (1280 + 64 * (j))
#define XB_XGEN(j)  (2304 + 64 * (j))
#define XB_TOP      3328
#define XB_TOPGEN   3392
#define XCD_BAR_WORDS 3456
#define XB_SPIN_CAP (1u << 20)
__device__ __forceinline__ unsigned xb_ld(unsigned* p)              { return __hip_atomic_load(p, __ATOMIC_RELAXED, __HIP_MEMORY_SCOPE_AGENT); }
__device__ __forceinline__ unsigned xb_add(unsigned* p, unsigned v) { return __hip_atomic_fetch_add(p, v, __ATOMIC_RELAXED, __HIP_MEMORY_SCOPE_AGENT); }
__device__ __forceinline__ unsigned xb_xcc_id() { return (unsigned)__builtin_amdgcn_s_getreg((3 << 11) | 20) & 0xFu; }
#define XB_SPIN(cond, bar) do { unsigned _sp = 0; while (cond) { __builtin_amdgcn_s_sleep(1); \
    if ((++_sp & 255u) == 0u) { if (xb_ld(&(bar)[XB_TMO])) break; if (_sp > XB_SPIN_CAP) { atomicAdd(&(bar)[XB_TMO], 1u); break; } } } } while (0)
struct XcdBarrier { unsigned* bar; unsigned x; volatile LAS unsigned* st; };
__device__ __forceinline__ XcdBarrier xcd_barrier_post(unsigned* bar, volatile LAS unsigned* st) {
    XcdBarrier b; b.bar = bar; b.x = xb_xcc_id(); b.st = st;
    if (threadIdx.x == 0) (void)xb_add(&bar[XB_XCNT(b.x)], 1u);
    return b;
}
__device__ __forceinline__ void xcd_barrier_complete(unsigned* bar, unsigned x, unsigned& nloc, unsigned& nx) {
    const unsigned G = gridDim.x * gridDim.y * gridDim.z;
    unsigned sum, cnt, mine, sp = 0u;
    for (;;) {
        sum = 0u; cnt = 0u; mine = 0u;
#pragma unroll
        for (unsigned j = 0; j < 16; ++j) { const unsigned c = xb_ld(&bar[XB_XCNT(j)]); sum += c; cnt += (c > 0u) ? 1u : 0u; mine = (j == x) ? c : mine; }
        if (sum == G) break;
        __builtin_amdgcn_s_sleep(1);
        if ((++sp & 255u) == 0u) { if (xb_ld(&bar[XB_TMO])) break; if (sp > XB_SPIN_CAP) { atomicAdd(&bar[XB_TMO], 1u); break; } }
    }
    nloc = mine > 0u ? mine : 1u; nx = cnt > 0u ? cnt : 1u;
}
__device__ __forceinline__ void xcd_barrier(const XcdBarrier& b) {
    asm volatile("s_waitcnt vmcnt(0)" ::: "memory");
    __syncthreads();
    if (threadIdx.x == 0) {
        unsigned* bar = b.bar;
        __builtin_amdgcn_s_waitcnt(0);
        unsigned nloc = b.st[0], nx = b.st[1];
        if (nloc == 0u) { xcd_barrier_complete(bar, b.x, nloc, nx); b.st[0] = nloc; b.st[1] = nx; }
        const unsigned old = xb_add(&bar[XB_XSUB(b.x)], 1u);
        const unsigned gen = old / nloc;
        if (old + 1u == (gen + 1u) * nloc) {
            __builtin_amdgcn_fence(__ATOMIC_RELEASE, "agent");
            asm volatile("s_waitcnt vmcnt(0)" ::: "memory");
            const unsigned og = xb_add(&bar[XB_TOP], 1u);
            const unsigned tg = og / nx;
            if (og + 1u == (tg + 1u) * nx) xb_add(&bar[XB_TOPGEN], 1u);
            else XB_SPIN(xb_ld(&bar[XB_TOPGEN]) == tg, bar);
            __builtin_amdgcn_fence(__ATOMIC_ACQUIRE, "agent");
            xb_add(&bar[XB_XGEN(b.x)], 1u);
            asm volatile("s_waitcnt vmcnt(0)" ::: "memory");
        } else {
            XB_SPIN(xb_ld(&bar[XB_XGEN(b.x)]) == gen, bar);
            __builtin_amdgcn_fence(__ATOMIC_ACQUIRE, "agent");
            asm volatile("s_waitcnt vmcnt(0)" ::: "memory");
        }
    }
    __syncthreads();
}

namespace pg8 {
constexpr int BM = 256, BK = 64, HALF = 128, HTB = HALF * BK * 2, STAGE_BYTES = 8 * HTB, NXCD = 8, WGM = 8;
__host__ __device__ __forceinline__ int lds_byte(int r, int c) { const int st = (r >> 4) * 2 + (c >> 5), rr = r & 15, cc = c & 31, ob = rr * 64 + cc * 2; return st * 1024 + (ob ^ (((ob >> 9) & 1) << 5)); }
__host__ __device__ __forceinline__ void stage_rc(int b, int& R, int& C) { const int st = b / 1024, sb = b % 1024, swz = sb ^ (((sb >> 9) & 1) << 5); R = (st >> 1) * 16 + swz / 64; C = (st & 1) * 32 + (swz % 64) / 2; }
__host__ __device__ __forceinline__ int perm32(int rho) { const int n = rho >> 4, i = rho & 15; return 8 * (i >> 2) + 4 * n + (i & 3); }

struct Unit { int pm, pn, pb, e, rbase, cnt; };
struct Gemm { const bf16_t* A; const bf16_t* Bt; int K; };

struct DenseOrder {
    int nM, nN, nwg, G, c, pn0;
    __device__ void init(int nM_, int nN_, int G_, int c_, int pn0_ = 0) { nM = nM_; nN = nN_; nwg = nM * nN; G = G_; c = c_; pn0 = pn0_; }
    __device__ __forceinline__ bool next(int i, Unit& u) const {
        const long L = (long)i * G + c; if (L >= nwg) return false;
        int wgid = (int)L; { const int q = nwg / NXCD, r = nwg % NXCD, xcd = wgid % NXCD, off = wgid / NXCD; wgid = (xcd < r ? xcd * (q + 1) : r * (q + 1) + (xcd - r) * q) + off; }
        const int nig = WGM * nN, gid = wgid / nig, fm = gid * WGM, gsz = (nM - fm) < WGM ? (nM - fm) : WGM;
        u.pm = fm + ((wgid % nig) % gsz); u.pn = pn0 + (wgid % nig) / gsz; u.pb = u.pn; u.e = 0; u.rbase = 0; u.cnt = 0; return true;
    }
    __device__ __forceinline__ int a_row(const Unit&, int) const { return 0; }
};
struct MoeOrder {
    int nM, nN, nwg, G, c; const LAS int* t2e; const LAS int* tstart; const LAS int* cnt; const int* rowtok;
    __device__ void init(int nM_, int nN_, int G_, int c_) { nM = nM_; nN = nN_; nwg = nM * nN; G = G_; c = c_; }
    __device__ __forceinline__ bool next(int i, Unit& u) const {
        const long L = (long)i * G + c; if (L >= nwg) return false;
        int wgid = (int)L; { const int q = nwg / NXCD, r = nwg % NXCD, xcd = wgid % NXCD, off = wgid / NXCD; wgid = (xcd < r ? xcd * (q + 1) : r * (q + 1) + (xcd - r) * q) + off; }
        const int nig = WGM * nN, gid = wgid / nig, fm = gid * WGM, gsz = (nM - fm) < WGM ? (nM - fm) : WGM;
        u.pm = fm + ((wgid % nig) % gsz); u.pn = (wgid % nig) / gsz;
        const int e = __builtin_amdgcn_readfirstlane(t2e[u.pm]); u.e = e; u.pb = e * nN + u.pn; u.rbase = (u.pm - __builtin_amdgcn_readfirstlane(tstart[e])) * 256; u.cnt = __builtin_amdgcn_readfirstlane(cnt[e]); return true;
    }
    __device__ __forceinline__ int a_row(const Unit& u, int r) const { const int rank = u.rbase + r; return rank < u.cnt ? rowtok[u.e * T + rank] : 0; }
};

template <class Epi, class Sched, bool GATHER, bool ALIGN_EPI>
__device__ __forceinline__ void gemm_phase(LAS unsigned char* lds, const Gemm g, const Sched& S, const Epi& E) {
    const int tid = threadIdx.x, wid = __builtin_amdgcn_readfirstlane(tid >> 6), lane = tid & 63, wr = wid >> 2, wc = wid & 3, fr = lane & 15, fq = lane >> 4;
    const int K = g.K, nt = K / BK;
    unsigned voffA[2], voffB[2]; int Rv[2], Cv[2];
#pragma unroll
    for (int i = 0; i < 2; ++i) { int R, C; stage_rc(tid * 16 + i * 8192, R, C); const int Rb = Epi::PERM ? ((R & ~31) + perm32(R & 31)) : R;
        voffA[i] = (unsigned)(R * K + C) * 2u; voffB[i] = (unsigned)(Rb * K + C) * 2u; Rv[i] = R; Cv[i] = C; }
    const size_t kstep = (size_t)(BK * 2);
    const size_t hstep = (size_t)HALF * K * 2;
    const size_t tstep = 2 * hstep;
    const unsigned ldsw = (unsigned)wid * 1024u;
    const int aoff = lds_byte(wr * 64 + fr, fq * 8), boff = lds_byte(wc * 32 + fr, fq * 8);
#define PG8_SA(b, h) (((b) * 2 + (h)) * HTB)
#define PG8_SB(b, h) ((4 + (b) * 2 + (h)) * HTB)
#define PG8_STAGE(bufoff, gbase, voff) do { _Pragma("unroll") for (int _i = 0; _i < 2; ++_i) \
        __builtin_amdgcn_global_load_lds((const unsigned*)((const char*)(gbase) + (voff)[_i]), (LAS unsigned*)(lds + (bufoff) + ldsw + _i * 8192), 16, 0, 0); } while (0)
#define PG8_LDA(dst, b, h) do { _Pragma("unroll") for (int m = 0; m < 4; ++m) _Pragma("unroll") for (int k = 0; k < 2; ++k) dst[m][k] = *(const LAS bf16x8*)(lds + PG8_SA(b, h) + aoff + m * 2048 + k * 1024); } while (0)
#define PG8_LDB(dst, b, h) do { _Pragma("unroll") for (int n = 0; n < 2; ++n) _Pragma("unroll") for (int k = 0; k < 2; ++k) dst[n][k] = *(const LAS bf16x8*)(lds + PG8_SB(b, h) + boff + n * 2048 + k * 1024); } while (0)
#define PG8_MMA(ai, bj, At, Bt) do { __builtin_amdgcn_s_setprio(1); _Pragma("unroll") for (int m = 0; m < 4; ++m) _Pragma("unroll") for (int n = 0; n < 2; ++n) _Pragma("unroll") for (int k = 0; k < 2; ++k) \
        acc[ai][bj][m][n] = __builtin_amdgcn_mfma_f32_16x16x32_bf16(Bt[n][k], At[m][k], acc[ai][bj][m][n], 0, 0, 0); __builtin_amdgcn_s_setprio(0); } while (0)
#define PG8_WAIT_V(n) asm volatile("s_waitcnt vmcnt(" #n ")" ::: "memory")
#define PG8_WAIT_L(n) asm volatile("s_waitcnt lgkmcnt(" #n ")" ::: "memory")
#define PG8_BAR __builtin_amdgcn_s_barrier()
#define PG8_SCHED __builtin_amdgcn_sched_barrier(0)
    Unit cur, nxt; int ui = 0;
    if (!S.next(0, cur)) return;
    f32x4 acc[2][2][4][2];
#pragma unroll
    for (int a = 0; a < 2; ++a)
#pragma unroll
        for (int b = 0; b < 2; ++b)
#pragma unroll
            for (int m = 0; m < 4; ++m)
#pragma unroll
                for (int n = 0; n < 2; ++n) acc[a][b][m][n] = (f32x4){0.f, 0.f, 0.f, 0.f};
    bf16x8 At[4][2], B0[2][2], B1[2][2];
    unsigned gC0[2], gC1[2], gN0[2], gN1[2];
    if constexpr (GATHER) {
#pragma unroll
        for (int i = 0; i < 2; ++i) { gC0[i] = (unsigned)S.a_row(cur, Rv[i]) * (unsigned)(K * 2) + (unsigned)Cv[i] * 2u; gC1[i] = (unsigned)S.a_row(cur, HALF + Rv[i]) * (unsigned)(K * 2) + (unsigned)Cv[i] * 2u; gN0[i] = gC0[i]; gN1[i] = gC1[i]; }
    }
    const char* cA = GATHER ? (const char*)g.A : (const char*)g.A + (size_t)cur.pm * tstep; const char* cB = (const char*)g.Bt + (size_t)cur.pb * tstep;
#define PG8_STAGE_A(bufoff, p, h, o0, o1) do { if constexpr (GATHER) { if ((h) == 0) PG8_STAGE(bufoff, p, o0); else PG8_STAGE(bufoff, p, o1); } else { PG8_STAGE(bufoff, (p) + (h) * hstep, voffA); } } while (0)
    PG8_STAGE(PG8_SB(0, 0), cB, voffB); PG8_STAGE(PG8_SB(0, 1), cB + hstep, voffB); PG8_STAGE_A(PG8_SA(0, 0), cA, 0, gC0, gC1); PG8_STAGE_A(PG8_SA(0, 1), cA, 1, gC0, gC1);
    if (wr == 1) PG8_BAR;
    PG8_WAIT_V(2); PG8_BAR;
    PG8_STAGE(PG8_SB(1, 0), cB + kstep, voffB); PG8_STAGE_A(PG8_SA(1, 0), cA + kstep, 0, gC0, gC1); PG8_STAGE(PG8_SB(1, 1), cB + hstep + kstep, voffB);
    PG8_WAIT_V(6); PG8_BAR;
    for (;;) {
        const bool has_next = S.next(ui + 1, nxt);
        const char* nA = GATHER ? (const char*)g.A : (has_next ? (const char*)g.A + (size_t)nxt.pm * tstep : cA); const char* nB = has_next ? (const char*)g.Bt + (size_t)nxt.pb * tstep : cB;
        if constexpr (GATHER) { if (has_next) {
#pragma unroll
            for (int i = 0; i < 2; ++i) { gN0[i] = (unsigned)S.a_row(nxt, Rv[i]) * (unsigned)(K * 2) + (unsigned)Cv[i] * 2u; gN1[i] = (unsigned)S.a_row(nxt, HALF + Rv[i]) * (unsigned)(K * 2) + (unsigned)Cv[i] * 2u; } } }
        for (int t = 0; t < nt; t += 2) {
            const bool last = (t == nt - 2);
            const char* a1 = cA + (size_t)(t + 1) * kstep;
            const char* a2 = last ? nA : cA + (size_t)(t + 2) * kstep; const char* b2 = last ? nB : cB + (size_t)(t + 2) * kstep;
            const char* a3 = a2 + kstep; const char* b3 = b2 + kstep;
            unsigned s0[2], s1[2];
            if constexpr (GATHER) { s0[0] = last ? gN0[0] : gC0[0]; s0[1] = last ? gN0[1] : gC0[1]; s1[0] = last ? gN1[0] : gC1[0]; s1[1] = last ? gN1[1] : gC1[1]; }
            PG8_LDB(B0, 0, 0); PG8_LDB(B1, 0, 1); PG8_SCHED; PG8_LDA(At, 0, 0); PG8_STAGE_A(PG8_SA(1, 1), a1, 1, gC0, gC1);
            PG8_WAIT_V(8); PG8_WAIT_L(0); PG8_BAR; PG8_MMA(0, 0, At, B0); PG8_MMA(0, 1, At, B1); PG8_BAR; PG8_SCHED;
            PG8_LDA(At, 0, 1); PG8_STAGE(PG8_SB(0, 0), b2, voffB); PG8_STAGE(PG8_SB(0, 1), b2 + hstep, voffB); PG8_STAGE_A(PG8_SA(0, 0), a2, 0, s0, s1);
            PG8_WAIT_V(8); PG8_WAIT_L(0); PG8_BAR; PG8_MMA(1, 0, At, B0); PG8_MMA(1, 1, At, B1); PG8_BAR; PG8_SCHED;
            PG8_LDB(B0, 1, 0); PG8_LDB(B1, 1, 1); PG8_SCHED; PG8_LDA(At, 1, 0); PG8_STAGE_A(PG8_SA(0, 1), a2, 1, s0, s1);
            PG8_WAIT_V(8); PG8_WAIT_L(0); PG8_BAR; PG8_MMA(0, 0, At, B0); PG8_MMA(0, 1, At, B1); PG8_BAR; PG8_SCHED;
            PG8_LDA(At, 1, 1); PG8_STAGE(PG8_SB(1, 0), b3, voffB); PG8_STAGE(PG8_SB(1, 1), b3 + hstep, voffB); PG8_STAGE_A(PG8_SA(1, 0), a3, 0, s0, s1);
            PG8_WAIT_V(8); PG8_WAIT_L(0); PG8_BAR; PG8_MMA(1, 0, At, B0); PG8_MMA(1, 1, At, B1); PG8_BAR; PG8_SCHED;
        }
        if constexpr (ALIGN_EPI) { if (wr == 0) PG8_BAR; }
        E(acc, cur, wr, wc, fr, fq);
        if (!has_next) break;
#pragma unroll
        for (int a = 0; a < 2; ++a)
#pragma unroll
            for (int b = 0; b < 2; ++b)
#pragma unroll
                for (int m = 0; m < 4; ++m)
#pragma unroll
                    for (int n = 0; n < 2; ++n) acc[a][b][m][n] = (f32x4){0.f, 0.f, 0.f, 0.f};
        cur = nxt; cA = nA; cB = nB; ++ui;
        if constexpr (GATHER) { gC0[0] = gN0[0]; gC0[1] = gN0[1]; gC1[0] = gN1[0]; gC1[1] = gN1[1]; }
        if constexpr (ALIGN_EPI) { if (wr == 1) PG8_BAR; }
    }
    PG8_WAIT_V(0);
    if constexpr (!ALIGN_EPI) { if (wr == 0) PG8_BAR; }
    PG8_BAR;
#undef PG8_SA
#undef PG8_SB
#undef PG8_STAGE
#undef PG8_STAGE_A
#undef PG8_LDA
#undef PG8_LDB
#undef PG8_MMA
#undef PG8_WAIT_V
#undef PG8_WAIT_L
#undef PG8_BAR
#undef PG8_SCHED
}

__device__ __forceinline__ u32x4 pack8(const f32x4& v0, const f32x4& v1) { u32x4 w; w.x = cvt_pk_bf16(v0[0], v0[1]); w.y = cvt_pk_bf16(v0[2], v0[3]); w.z = cvt_pk_bf16(v1[0], v1[1]); w.w = cvt_pk_bf16(v1[2], v1[3]); return w; }
__device__ __forceinline__ void rope4(f32x4& v0, f32x4& v1, const float* cs) {
    const f32x4 a = *(const f32x4*)cs, b = *(const f32x4*)(cs + 4);
    float x1, x2;
    x1 = v0[0]; x2 = v0[1]; v0[0] = x1 * a[0] - x2 * a[1]; v0[1] = x2 * a[0] + x1 * a[1];
    x1 = v0[2]; x2 = v0[3]; v0[2] = x1 * a[2] - x2 * a[3]; v0[3] = x2 * a[2] + x1 * a[3];
    x1 = v1[0]; x2 = v1[1]; v1[0] = x1 * b[0] - x2 * b[1]; v1[1] = x2 * b[0] + x1 * b[1];
    x1 = v1[2]; x2 = v1[3]; v1[2] = x1 * b[2] - x2 * b[3]; v1[3] = x2 * b[2] + x1 * b[3];
}

struct EpiIn {
    static constexpr bool PERM = true;
    bf16_t *qa, *ka, *va, *cq, *ckv, *gates, *kr; const float *ropeA, *ropeM, *bg; float* sq;
    __device__ __forceinline__ void operator()(const f32x4 (&acc)[2][2][4][2], const Unit& u, int wr, int wc, int fr, int fq) const {
        const int pn = u.pn, row0 = u.pm * BM + wr * 64 + fr, cl = wc * 32 + 8 * fq;
        if (pn < 8) {
            bf16_t* dst = pn < 4 ? qa : ka; const int colt = (pn & 3) * 256; const bool rot = ((wc & 1) == 0) && (fq < 2);
#pragma unroll
            for (int ai = 0; ai < 2; ++ai)
#pragma unroll
                for (int m = 0; m < 4; ++m) { const int row = row0 + ai * HALF + m * 16;
#pragma unroll
                    for (int bj = 0; bj < 2; ++bj) { f32x4 v0 = acc[ai][bj][m][0], v1 = acc[ai][bj][m][1];
                        if (rot) rope4(v0, v1, ropeA + (size_t)row * 16 + fq * 8);
                        *(u32x4*)(dst + (size_t)row * 1024 + colt + bj * HALF + cl) = pack8(v0, v1); } }
        } else if (pn < 12) {
            const int colt = (pn - 8) * 256;
#pragma unroll
            for (int ai = 0; ai < 2; ++ai)
#pragma unroll
                for (int m = 0; m < 4; ++m) { const int row = row0 + ai * HALF + m * 16;
#pragma unroll
                    for (int bj = 0; bj < 2; ++bj) *(u32x4*)(va + (size_t)row * 1024 + colt + bj * HALF + cl) = pack8(acc[ai][bj][m][0], acc[ai][bj][m][1]); }
        } else if (pn < 17) {
            const bool isq = pn < 15; bf16_t* dst = isq ? cq : ckv; const int ld = isq ? QL : KVL, colt = (isq ? pn - 12 : pn - 15) * 256, tq = pn - 12;
#pragma unroll
            for (int ai = 0; ai < 2; ++ai)
#pragma unroll
                for (int m = 0; m < 4; ++m) { const int row = row0 + ai * HALF + m * 16; float s = 0.f;
#pragma unroll
                    for (int bj = 0; bj < 2; ++bj) { const f32x4 v0 = acc[ai][bj][m][0], v1 = acc[ai][bj][m][1];
                        s += (v0[0] * v0[0] + v0[1] * v0[1]) + (v0[2] * v0[2] + v0[3] * v0[3]) + (v1[0] * v1[0] + v1[1] * v1[1]) + (v1[2] * v1[2] + v1[3] * v1[3]);
                        *(u32x4*)(dst + (size_t)row * ld + colt + bj * HALF + cl) = pack8(v0, v1); }
                    s += __shfl_xor(s, 16); s += __shfl_xor(s, 32);
                    if (fq == 0) sq[(size_t)row * 20 + tq * 4 + wc] = s; }
        } else if (pn != 23) {
            const int colt = (pn < 23 ? pn - 17 : pn - 18) * 256;
            f32x4 bv[2][2];
#pragma unroll
            for (int bj = 0; bj < 2; ++bj) { bv[bj][0] = *(const f32x4*)(bg + colt + bj * HALF + cl); bv[bj][1] = *(const f32x4*)(bg + colt + bj * HALF + cl + 4); if (DBG_SKIP & 256) { bv[bj][0] = bv[bj][0] * 0.f; bv[bj][1] = bv[bj][1] * 0.f; } }
#pragma unroll
            for (int ai = 0; ai < 2; ++ai)
#pragma unroll
                for (int m = 0; m < 4; ++m) { const int row = row0 + ai * HALF + m * 16;
#pragma unroll
                    for (int bj = 0; bj < 2; ++bj) { f32x4 v0 = acc[ai][bj][m][0] + bv[bj][0], v1 = acc[ai][bj][m][1] + bv[bj][1];
#pragma unroll
                        for (int j = 0; j < 4; ++j) { if (!(DBG_SKIP & 512)) { v0[j] = sigmoidf_(v0[j]); v1[j] = sigmoidf_(v1[j]); } }
                        *(u32x4*)(gates + (size_t)row * 2048 + colt + bj * HALF + cl) = pack8(v0, v1); } }
        } else {
            if (wc < 2) {
#pragma unroll
                for (int ai = 0; ai < 2; ++ai)
#pragma unroll
                    for (int m = 0; m < 4; ++m) { const int row = row0 + ai * HALF + m * 16;
                        f32x4 v0 = acc[ai][0][m][0], v1 = acc[ai][0][m][1];
                        rope4(v0, v1, ropeM + (size_t)row * 64 + (wc * 16 + fq * 4) * 2);
                        *(u32x4*)(kr + (size_t)row * 64 + cl) = pack8(v0, v1); }
            }
        }
    }
};
template <bool ISQ> struct EpiUp {
    static constexpr bool PERM = true;
    bf16_t* out; const float* sq; const float* ropeM;
    __device__ __forceinline__ void operator()(const f32x4 (&acc)[2][2][4][2], const Unit& u, int wr, int wc, int fr, int fq) const {
        const int row0 = u.pm * BM + wr * 64 + fr, cl = wc * 32 + 8 * fq; constexpr int LD = ISQ ? 1536 : 2048;
#pragma unroll
        for (int ai = 0; ai < 2; ++ai)
#pragma unroll
            for (int m = 0; m < 4; ++m) { const int row = row0 + ai * HALF + m * 16; float s;
                if (ISQ) { const f32x4 a = *(const f32x4*)(sq + (size_t)row * 20), b = *(const f32x4*)(sq + (size_t)row * 20 + 4), c = *(const f32x4*)(sq + (size_t)row * 20 + 8);
                    s = ((a[0] + a[1]) + (a[2] + a[3])) + ((b[0] + b[1]) + (b[2] + b[3])) + ((c[0] + c[1]) + (c[2] + c[3])); }
                else { const f32x4 a = *(const f32x4*)(sq + (size_t)row * 20 + 12), b = *(const f32x4*)(sq + (size_t)row * 20 + 16);
                    s = ((a[0] + a[1]) + (a[2] + a[3])) + ((b[0] + b[1]) + (b[2] + b[3])); }
                const float rstd = __builtin_amdgcn_rsqf(s * (ISQ ? 1.0f / QL : 1.0f / KVL) + EPS);
#pragma unroll
                for (int bj = 0; bj < 2; ++bj) { const int col = u.pn * BM + bj * HALF + cl; f32x4 v0 = acc[ai][bj][m][0] * rstd, v1 = acc[ai][bj][m][1] * rstd;
                    if (ISQ) { const int off = col % 192; if (off >= 128) rope4(v0, v1, ropeM + (size_t)row * 64 + (off - 128)); }
                    *(u32x4*)(out + (size_t)row * LD + col) = pack8(v0, v1); } }
    }
};
template <int WHICH> struct EpiGate {
    static constexpr bool PERM = true;
    bf16_t* mrg; const bf16_t* gates;
    __device__ __forceinline__ void operator()(const f32x4 (&acc)[2][2][4][2], const Unit& u, int wr, int wc, int fr, int fq) const {
        const int row0 = u.pm * BM + wr * 64 + fr, cl = wc * 32 + 8 * fq;
#pragma unroll
        for (int ai = 0; ai < 2; ++ai)
#pragma unroll
            for (int m = 0; m < 4; ++m) { const int row = row0 + ai * HALF + m * 16;
#pragma unroll
                for (int bj = 0; bj < 2; ++bj) { const int col = u.pn * BM + bj * HALF + cl;
                    const u32x4 gw = *(const u32x4*)(gates + (size_t)row * 2048 + WHICH * 1024 + col);
                    f32x4 v0 = acc[ai][bj][m][0], v1 = acc[ai][bj][m][1];
                    if ((DBG_SKIP & 8) && WHICH == 0) { v0 = v0 * 0.f; v1 = v1 * 0.f; } if ((DBG_SKIP & 16) && WHICH == 1) { v0 = v0 * 0.f; v1 = v1 * 0.f; }
                    v0[0] *= bf_lo(gw.x); v0[1] *= bf_hi(gw.x); v0[2] *= bf_lo(gw.y); v0[3] *= bf_hi(gw.y); v1[0] *= bf_lo(gw.z); v1[1] *= bf_hi(gw.z); v1[2] *= bf_lo(gw.w); v1[3] *= bf_hi(gw.w);
                    if (WHICH == 1) { const u32x4 tw = *(const u32x4*)(mrg + (size_t)row * 1024 + col);
                        v0[0] += bf_lo(tw.x); v0[1] += bf_hi(tw.x); v0[2] += bf_lo(tw.y); v0[3] += bf_hi(tw.y); v1[0] += bf_lo(tw.z); v1[1] += bf_hi(tw.z); v1[2] += bf_lo(tw.w); v1[3] += bf_hi(tw.w); }
                    *(u32x4*)(mrg + (size_t)row * 1024 + col) = pack8(v0, v1); } }
    }
};
struct EpiRes {
    static constexpr bool PERM = false;
    const float* x; float* out;
    __device__ __forceinline__ void operator()(const f32x4 (&acc)[2][2][4][2], const Unit& u, int wr, int wc, int fr, int fq) const {
        const int row0 = u.pm * BM + wr * 64 + fr, col0 = u.pn * BM + wc * 32 + 4 * fq;
#pragma unroll
        for (int ai = 0; ai < 2; ++ai)
#pragma unroll
            for (int m = 0; m < 4; ++m) { const size_t off = (size_t)(row0 + ai * HALF + m * 16) * 1024 + col0;
#pragma unroll
                for (int bj = 0; bj < 2; ++bj)
#pragma unroll
                    for (int n = 0; n < 2; ++n) *(f32x4*)(out + off + bj * HALF + n * 16) = *(const f32x4*)(x + off + bj * HALF + n * 16) + ((DBG_SKIP & 2) ? 0.f : 1.f) * acc[ai][bj][m][n]; }
    }
};
struct EpiSwiglu {
    static constexpr bool PERM = true;
    bf16_t* act; const float *bgate, *bup;
    __device__ __forceinline__ void operator()(const f32x4 (&acc)[2][2][4][2], const Unit& u, int wr, int wc, int fr, int fq) const {
        const int row0 = u.pm * BM + wr * 64 + fr, f0 = u.pn * HALF + wc * 32 + 8 * fq;
        f32x4 bgv[2], buv[2];
#pragma unroll
        for (int n = 0; n < 2; ++n) { bgv[n] = *(const f32x4*)(bgate + (size_t)u.e * FF + f0 + 4 * n); buv[n] = *(const f32x4*)(bup + (size_t)u.e * FF + f0 + 4 * n); }
#pragma unroll
        for (int ai = 0; ai < 2; ++ai)
#pragma unroll
            for (int m = 0; m < 4; ++m) { const int row = row0 + ai * HALF + m * 16; f32x4 o[2];
#pragma unroll
                for (int n = 0; n < 2; ++n) { const f32x4 gt = acc[ai][0][m][n] + bgv[n], up = acc[ai][1][m][n] + buv[n];
#pragma unroll
                    for (int j = 0; j < 4; ++j) { const float gg = fminf(gt[j], 7.0f), uu = fminf(fmaxf(up[j], -7.0f), 7.0f); o[n][j] = (uu + 1.0f) * (gg * sigmoidf_(1.702f * gg)); } }
                *(u32x4*)(act + (size_t)row * FF + f0) = pack8(o[0], o[1]); }
    }
};
struct EpiDown {
    static constexpr bool PERM = true;
    bf16_t* y; const float* bd;
    __device__ __forceinline__ void operator()(const f32x4 (&acc)[2][2][4][2], const Unit& u, int wr, int wc, int fr, int fq) const {
        const int row0 = u.pm * BM + wr * 64 + fr, cl = wc * 32 + 8 * fq;
        f32x4 bv[2][2];
#pragma unroll
        for (int bj = 0; bj < 2; ++bj) { const int col = u.pn * BM + bj * HALF + cl; bv[bj][0] = *(const f32x4*)(bd + (size_t)u.e * D + col); bv[bj][1] = *(const f32x4*)(bd + (size_t)u.e * D + col + 4); }
#pragma unroll
        for (int ai = 0; ai < 2; ++ai)
#pragma unroll
            for (int m = 0; m < 4; ++m) { const int row = row0 + ai * HALF + m * 16;
#pragma unroll
                for (int bj = 0; bj < 2; ++bj) { const int col = u.pn * BM + bj * HALF + cl;
                    *(u32x4*)(y + (size_t)row * D + col) = pack8(acc[ai][bj][m][0] + bv[bj][0], acc[ai][bj][m][1] + bv[bj][1]); } }
    }
};
}

namespace att {
constexpr int NW = 8, QBLK = 32, KVBLK = 64;
constexpr int SHM_V = KVBLK * 128 * 2;
#define SBAR() __builtin_amdgcn_sched_barrier(0)
#define KSW(row, colB) ((row) * 128 + ((colB) ^ ((((row) >> 1) & 7) << 4)))
__device__ __forceinline__ int crow(int r, int hi) { return (r & 3) + 8 * (r >> 2) + 4 * hi; }
struct Src { const bf16_t* Q; const bf16_t* K; const bf16_t* K2; const bf16_t* V; int ldq, ldk, ldk2, ldv; };

__device__ __forceinline__ void partialSM(f32x16& p0, f32x16& p1, float& m_reg, float& mn, float& alpha, const float C, const float thr) {
  float pmax;
  { float a0 = fmaxf(fmaxf(p0[0], p0[1]), p0[2]), a1 = fmaxf(fmaxf(p0[3], p0[4]), p0[5]), a2 = fmaxf(fmaxf(p1[0], p1[1]), p1[2]), a3 = fmaxf(fmaxf(p1[3], p1[4]), p1[5]);
#pragma unroll
    for (int r = 6; r < 16; r += 2) { a0 = fmaxf(fmaxf(a0, p0[r]), p0[r + 1]); a2 = fmaxf(fmaxf(a2, p1[r]), p1[r + 1]); }
    pmax = fmaxf(fmaxf(a0, a1), fmaxf(a2, a3)); }
  { auto rr = __builtin_amdgcn_permlane32_swap(__float_as_uint(pmax), __float_as_uint(pmax), false, false);
    pmax = fmaxf(__uint_as_float(rr[0]), __uint_as_float(rr[1])); }
  if (__builtin_expect(__all(pmax - m_reg <= thr), 1)) { mn = m_reg; alpha = 1.f; }
  else { mn = fmaxf(m_reg, pmax); alpha = __builtin_amdgcn_exp2f((m_reg - mn) * C); m_reg = mn; }
  const float mnC = -mn * C;
#pragma unroll
  for (int r = 0; r < 16; ++r) p0[r] = fmaf(p0[r], C, mnC);
#pragma unroll
  for (int r = 0; r < 16; ++r) p1[r] = fmaf(p1[r], C, mnC);
#pragma unroll
  for (int r = 0; r < 16; ++r) p0[r] = __builtin_amdgcn_exp2f(p0[r]);
#if ATT_DUP == 1
  { float d_[16];
#pragma unroll
    for (int r = 0; r < 16; ++r) { d_[r] = __builtin_amdgcn_exp2f(p1[r]); d_[r] = fmaf(d_[r], C, mnC); }
#pragma unroll
    for (int r = 0; r < 16; ++r) asm volatile("" :: "v"(d_[r])); }
#endif
}
__device__ __forceinline__ void finishSM(f32x16& p0, f32x16& p1, float alpha, float& l_reg, bf16x8& pa0, bf16x8& pa1, bf16x8& pa2, bf16x8& pa3) {
#pragma unroll
  for (int r = 0; r < 16; ++r) p1[r] = __builtin_amdgcn_exp2f(p1[r]);
  float ps;
  { float s0 = p0[0] + p0[1], s1 = p0[2] + p0[3], s2 = p1[0] + p1[1], s3 = p1[2] + p1[3];
#pragma unroll
    for (int r = 4; r < 16; r += 4) { s0 += p0[r] + p0[r + 1]; s1 += p0[r + 2] + p0[r + 3]; s2 += p1[r] + p1[r + 1]; s3 += p1[r + 2] + p1[r + 3]; }
    ps = (s0 + s1) + (s2 + s3); }
  { auto rr = __builtin_amdgcn_permlane32_swap(__float_as_uint(ps), __float_as_uint(ps), false, false);
    ps = __uint_as_float(rr[0]) + __uint_as_float(rr[1]); }
  l_reg = l_reg * alpha + ps;
#define PK4(P, BASE, OUT) do { unsigned a0 = cvt_pk_bf16(P[BASE + 0], P[BASE + 1]), a1 = cvt_pk_bf16(P[BASE + 2], P[BASE + 3]);   \
    unsigned b0 = cvt_pk_bf16(P[BASE + 4], P[BASE + 5]), b1 = cvt_pk_bf16(P[BASE + 6], P[BASE + 7]);                              \
    auto r0 = __builtin_amdgcn_permlane32_swap(a0, b0, false, false); auto r1 = __builtin_amdgcn_permlane32_swap(a1, b1, false, false); \
    u32x4 w = {r0[0], r1[0], r0[1], r1[1]}; OUT = *reinterpret_cast<bf16x8*>(&w); } while (0)
  PK4(p0, 0, pa0); PK4(p0, 8, pa1); PK4(p1, 0, pa2); PK4(p1, 8, pa3);
#undef PK4
}
template <int DQK> __device__ __forceinline__ void qkt(f32x16& p0, f32x16& p1, const LAS char* Ks, const bf16x8* qr, int r32, int hi) {
  p0 = f32x16{}; p1 = f32x16{};
#pragma unroll
  for (int d0 = 0; d0 < DQK / 16; d0 += 2) {
    bf16x8 kf[2][2];
#pragma unroll
    for (int d = 0; d < 2; ++d) { const int sub = (d0 + d) >> 2, cb = (((d0 + d) & 3) * 16 + hi * 8) * 2;
      kf[d][0] = *(const LAS bf16x8*)(Ks + sub * 8192 + KSW(r32, cb)); kf[d][1] = *(const LAS bf16x8*)(Ks + sub * 8192 + KSW(32 + r32, cb)); }
    SBAR();
#pragma unroll
    for (int d = 0; d < 2; ++d) {
      p0 = __builtin_amdgcn_mfma_f32_32x32x16_bf16(kf[d][0], qr[d0 + d], p0, 0, 0, 0);
      p1 = __builtin_amdgcn_mfma_f32_32x32x16_bf16(kf[d][1], qr[d0 + d], p1, 0, 0, 0); }
  }
}
__device__ __forceinline__ int v_st(int k, int c) { const int kk = (k & ~0xC) | ((k & 4) << 1) | ((k & 8) >> 1); return ((kk >> 3) * 4 + (c >> 5)) * 512 + ((kk & 7) * 32 + (c & 31)) * 2; }
__device__ __forceinline__ int v_rd_base(int lane) { return ((lane & 3) << 3) | (((lane >> 2) & 3) << 6) | (((lane >> 4) & 1) << 5) | (((lane >> 5) & 1) << 8); }
constexpr int v_rd_off(int d0, int ks, int half) { return d0 * 512 + ks * 4096 + half * 2048; }
template <int OFF> __device__ __forceinline__ s16x4 tr_read(int vb) {
  s16x4 r; asm volatile("ds_read_b64_tr_b16 %0, %1 offset:%2" : "=&v"(r) : "v"(vb), "i"(OFF) : "memory"); return r;
}
template <int KS> __device__ __forceinline__ void pv_step(f32x16* o, int vb, bf16x8 pa) {
  s16x4 l0, h0, l1, h1, l2, h2, l3, h3;
  l0 = tr_read<v_rd_off(0, KS, 0)>(vb); h0 = tr_read<v_rd_off(0, KS, 1)>(vb); l1 = tr_read<v_rd_off(1, KS, 0)>(vb); h1 = tr_read<v_rd_off(1, KS, 1)>(vb);
  l2 = tr_read<v_rd_off(2, KS, 0)>(vb); h2 = tr_read<v_rd_off(2, KS, 1)>(vb); l3 = tr_read<v_rd_off(3, KS, 0)>(vb); h3 = tr_read<v_rd_off(3, KS, 1)>(vb);
  asm volatile("s_waitcnt lgkmcnt(0)" ::: "memory"); SBAR();
#define PK(L, H) (bf16x8){L[0], L[1], L[2], L[3], H[0], H[1], H[2], H[3]}
  o[0] = __builtin_amdgcn_mfma_f32_32x32x16_bf16(pa, PK(l0, h0), o[0], 0, 0, 0);
  o[1] = __builtin_amdgcn_mfma_f32_32x32x16_bf16(pa, PK(l1, h1), o[1], 0, 0, 0);
  o[2] = __builtin_amdgcn_mfma_f32_32x32x16_bf16(pa, PK(l2, h2), o[2], 0, 0, 0);
  o[3] = __builtin_amdgcn_mfma_f32_32x32x16_bf16(pa, PK(l3, h3), o[3], 0, 0, 0);
#undef PK
}
__device__ __forceinline__ void pv_d0(f32x16* o, int vb, bf16x8 pa0, bf16x8 pa1, bf16x8 pa2, bf16x8 pa3) {
  pv_step<0>(o, vb, pa0); pv_step<1>(o, vb, pa1); pv_step<2>(o, vb, pa2); pv_step<3>(o, vb, pa3);
}
template <int DQK>
__device__ __forceinline__ void attn_core(const Src in, const float C, const float thr, const int seq, LAS char* lds, f32x16 (&o)[4]) {
  constexpr int NSUB = DQK / 64, SHM_K = NSUB * 8192;
  int lane; asm volatile("v_and_b32 %0, 63, %1" : "=v"(lane) : "v"(threadIdx.x));
  const int tid = threadIdx.x, wid = __builtin_amdgcn_readfirstlane(tid >> 6), r32 = lane & 31, hi = (lane >> 5) & 1;
  LAS char* V_lds = lds; LAS char* K_lds = lds + 3 * SHM_V;
  LAS float* ws = (LAS float*)(lds + 3 * SHM_V + 3 * SHM_K) + wid * 64; LAS float* li_l = ws; LAS float* al_l = ws + 32;
  float m_reg = -1e30f, l_reg = 0;
#pragma unroll
  for (int d = 0; d < 4; ++d) o[d] = f32x16{};
  bf16x8 qr[DQK / 16];
  const bf16_t* Qw = in.Q + (size_t)(wid * QBLK + r32) * in.ldq + hi * 8;
#pragma unroll
  for (int d0 = 0; d0 < DQK / 16; ++d0) qr[d0] = *(const bf16x8*)(Qw + d0 * 16);
  const int krow = wid * 8 + (lane >> 3), kslot = (lane & 7) ^ ((krow >> 1) & 7);
  const unsigned koff = (unsigned)(krow * in.ldk + kslot * 8) * 2u, k2off = (unsigned)(krow * in.ldk2 + kslot * 8) * 2u;
  unsigned voff[2];
#pragma unroll
  for (int i = 0; i < 2; ++i) { const int p = i * 8192 + wid * 1024 + lane * 16, st = p >> 9, wq = (p & 511) >> 1, kk = (st >> 2) * 8 + (wq >> 5), cl = wq & 31;
    const int k = (kk & ~0xC) | ((kk & 4) << 1) | ((kk & 8) >> 1); voff[i] = (unsigned)(k * in.ldv + (st & 3) * 32 + cl) * 2u; }
  const int vb0 = (int)(unsigned)(size_t)V_lds + v_rd_base(lane);
  const unsigned ldsw = (unsigned)wid * 1024u;
#define GLDS(gp, lp) __builtin_amdgcn_global_load_lds((const unsigned*)(gp), (LAS unsigned*)(lp), 16, 0, 0)
#define ISSUE_K(t, b) do { const char* kb_ = (const char*)in.K + (size_t)(t) * (KVBLK * 2) * in.ldk; \
    _Pragma("unroll") for (int s_ = 0; s_ < NSUB; ++s_) { if (s_ < 2) GLDS(kb_ + s_ * 128 + koff, K_lds + (b) * SHM_K + s_ * 8192 + ldsw); \
      else GLDS((const char*)in.K2 + (size_t)(t) * (KVBLK * 2) * in.ldk2 + k2off, K_lds + (b) * SHM_K + s_ * 8192 + ldsw); } } while (0)
#define ISSUE_V(t, b) do { const char* vb_ = (const char*)in.V + (size_t)(t) * (KVBLK * 2) * in.ldv; \
    GLDS(vb_ + voff[0], V_lds + (b) * SHM_V + ldsw); GLDS(vb_ + voff[1], V_lds + (b) * SHM_V + 8192 + ldsw); \
    if (ATT_DUP == 3) { GLDS(vb_ + voff[0], V_lds + (b) * SHM_V + ldsw); GLDS(vb_ + voff[1], V_lds + (b) * SHM_V + 8192 + ldsw); } } while (0)
#define WAITV(n) asm volatile("s_waitcnt vmcnt(%0)" :: "n"((DBG_SKIP & 4) ? 0 : (n)) : "memory")
#define WBAR() do { asm volatile("" ::: "memory"); __builtin_amdgcn_s_barrier(); asm volatile("" ::: "memory"); } while (0)
#define RESC(a) do { if (__any((a) < 1.f)) { if (hi == 0) al_l[r32] = (a); asm volatile("s_waitcnt lgkmcnt(0)" ::: "memory"); \
    _Pragma("unroll") for (int d = 0; d < 4; ++d) _Pragma("unroll") for (int r = 0; r < 16; ++r) o[d][r] *= al_l[crow(r, hi)]; } } while (0)
#define NXT3(x) ((x) == 2 ? 0 : (x) + 1)
  constexpr int NI = NSUB + (ATT_DUP == 3 ? 4 : 2), NV = (ATT_DUP == 3 ? 4 : 2);
  f32x16 pA0, pA1, pB0, pB1; float mnA, mnB, alA, alB; bf16x8 pa0, pa1, pa2, pa3; const int NT = seq / KVBLK;
  const bool lead = wid < 4;
  ISSUE_K(0, 0); ISSUE_K(1, 1); ISSUE_V(0, 0);
  if (!lead) { WAITV(NI); WBAR(); }
  WAITV(NI); WBAR();
  ISSUE_K(2, 2);
  qkt<DQK>(pA0, pA1, K_lds, qr, r32, hi);
  WAITV(NI); WBAR();
  ISSUE_V(1, 1);
  partialSM(pA0, pA1, m_reg, mnA, alA, C, thr);
  WAITV(NI); WBAR();
  int bq = 1;
  for (int j = 1; j + 3 < NT; j += 2) {
    { const int b1 = NXT3(bq), b2 = NXT3(b1);
      ISSUE_K(j + 2, b2);
      SBAR(); qkt<DQK>(pB0, pB1, K_lds + bq * SHM_K, qr, r32, hi);
      finishSM(pA0, pA1, alA, l_reg, pa0, pa1, pa2, pa3); SBAR();
      WAITV(NI); WBAR();
      ISSUE_V(j + 1, b1);
      pv_d0(o, vb0 + b2 * SHM_V, pa0, pa1, pa2, pa3); partialSM(pB0, pB1, m_reg, mnB, alB, C, thr);
      RESC(alB); bq = b1;
      WAITV(NI); WBAR(); }
    { const int b1 = NXT3(bq), b2 = NXT3(b1);
      ISSUE_K(j + 3, b2);
      SBAR(); qkt<DQK>(pA0, pA1, K_lds + bq * SHM_K, qr, r32, hi);
      finishSM(pB0, pB1, alB, l_reg, pa0, pa1, pa2, pa3); SBAR();
      WAITV(NI); WBAR();
      ISSUE_V(j + 2, b1);
      pv_d0(o, vb0 + b2 * SHM_V, pa0, pa1, pa2, pa3); partialSM(pA0, pA1, m_reg, mnA, alA, C, thr);
      RESC(alA); bq = b1;
      WAITV(NI); WBAR(); }
  }
  { const int b1 = NXT3(bq), b2 = NXT3(b1);
    ISSUE_K(NT - 1, b2);
    SBAR(); qkt<DQK>(pB0, pB1, K_lds + bq * SHM_K, qr, r32, hi);
    finishSM(pA0, pA1, alA, l_reg, pa0, pa1, pa2, pa3); SBAR();
    WAITV(NI); WBAR();
    ISSUE_V(NT - 2, b1);
    pv_d0(o, vb0 + b2 * SHM_V, pa0, pa1, pa2, pa3); partialSM(pB0, pB1, m_reg, mnB, alB, C, thr);
    RESC(alB); bq = b1;
    WAITV(NI); WBAR(); }
  { const int b1 = NXT3(bq), b2 = NXT3(b1);
    SBAR(); qkt<DQK>(pA0, pA1, K_lds + bq * SHM_K, qr, r32, hi);
    finishSM(pB0, pB1, alB, l_reg, pa0, pa1, pa2, pa3); SBAR();
    WAITV(NV); WBAR();
    ISSUE_V(NT - 1, b1);
    pv_d0(o, vb0 + b2 * SHM_V, pa0, pa1, pa2, pa3); partialSM(pA0, pA1, m_reg, mnA, alA, C, thr);
    RESC(alA); bq = b1;
    WAITV(NV); WBAR(); }
  { const int b2 = NXT3(NXT3(bq));
    SBAR(); qkt<DQK>(pB0, pB1, K_lds + bq * SHM_K, qr, r32, hi);
    finishSM(pA0, pA1, alA, l_reg, pa0, pa1, pa2, pa3); SBAR();
    WAITV(0); WBAR();
    pv_d0(o, vb0 + b2 * SHM_V, pa0, pa1, pa2, pa3); partialSM(pB0, pB1, m_reg, mnB, alB, C, thr);
    RESC(alB);
    WBAR(); }
  finishSM(pB0, pB1, alB, l_reg, pa0, pa1, pa2, pa3); SBAR();
  pv_d0(o, vb0 + bq * SHM_V, pa0, pa1, pa2, pa3);
  if (lead) { WBAR(); }
  if (hi == 0) li_l[r32] = l_reg; asm volatile("s_waitcnt lgkmcnt(0)" ::: "memory");
#pragma unroll
  for (int r = 0; r < 16; ++r) { const float rl = __builtin_amdgcn_rcpf(li_l[crow(r, hi)]);
#pragma unroll
    for (int d = 0; d < 4; ++d) o[d][r] *= rl; }
  asm volatile("s_waitcnt lgkmcnt(0)" ::: "memory"); WBAR();
#undef GLDS
#undef ISSUE_K
#undef ISSUE_V
#undef WAITV
#undef WBAR
#undef RESC
#undef NXT3
}
template <int DQK>
__device__ __forceinline__ void attn_core_seq(const Src in, const float C, const float thr, const int seq, LAS char* lds, f32x16 (&o)[4]) {
  constexpr int NSUB = DQK / 64, SHM_K = NSUB * 8192;
  int lane; asm volatile("v_and_b32 %0, 63, %1" : "=v"(lane) : "v"(threadIdx.x));
  const int tid = threadIdx.x, wid = __builtin_amdgcn_readfirstlane(tid >> 6), r32 = lane & 31, hi = (lane >> 5) & 1;
  LAS char* V_lds = lds; LAS char* K_lds = lds + 3 * SHM_V;
  LAS float* ws = (LAS float*)(lds + 3 * SHM_V + 3 * SHM_K) + wid * 64; LAS float* li_l = ws; LAS float* al_l = ws + 32;
  float m_reg = -1e30f, l_reg = 0;
#pragma unroll
  for (int d = 0; d < 4; ++d) o[d] = f32x16{};
  bf16x8 qr[DQK / 16];
  const bf16_t* Qw = in.Q + (size_t)(wid * QBLK + r32) * in.ldq + hi * 8;
#pragma unroll
  for (int d0 = 0; d0 < DQK / 16; ++d0) qr[d0] = *(const bf16x8*)(Qw + d0 * 16);
  const int krow = wid * 8 + (lane >> 3), kslot = (lane & 7) ^ ((krow >> 1) & 7);
  const unsigned koff = (unsigned)(krow * in.ldk + kslot * 8) * 2u, k2off = (unsigned)(krow * in.ldk2 + kslot * 8) * 2u;
  unsigned voff[2];
#pragma unroll
  for (int i = 0; i < 2; ++i) { const int p = i * 8192 + wid * 1024 + lane * 16, st = p >> 9, wq = (p & 511) >> 1, kk = (st >> 2) * 8 + (wq >> 5), cl = wq & 31;
    const int k = (kk & ~0xC) | ((kk & 4) << 1) | ((kk & 8) >> 1); voff[i] = (unsigned)(k * in.ldv + (st & 3) * 32 + cl) * 2u; }
  const int vb0 = (int)(unsigned)(size_t)V_lds + v_rd_base(lane);
  const unsigned ldsw = (unsigned)wid * 1024u;
#define GLDS(gp, lp) __builtin_amdgcn_global_load_lds((const unsigned*)(gp), (LAS unsigned*)(lp), 16, 0, 0)
#define ISSUE_K(t, b) do { const char* kb_ = (const char*)in.K + (size_t)(t) * (KVBLK * 2) * in.ldk; \
    _Pragma("unroll") for (int s_ = 0; s_ < NSUB; ++s_) { if (s_ < 2) GLDS(kb_ + s_ * 128 + koff, K_lds + (b) * SHM_K + s_ * 8192 + ldsw); \
      else GLDS((const char*)in.K2 + (size_t)(t) * (KVBLK * 2) * in.ldk2 + k2off, K_lds + (b) * SHM_K + s_ * 8192 + ldsw); } } while (0)
#define ISSUE_V(t, b) do { const char* vb_ = (const char*)in.V + (size_t)(t) * (KVBLK * 2) * in.ldv; \
    GLDS(vb_ + voff[0], V_lds + (b) * SHM_V + ldsw); GLDS(vb_ + voff[1], V_lds + (b) * SHM_V + 8192 + ldsw); } while (0)
#define WAITV(n) asm volatile("s_waitcnt vmcnt(%0)" :: "n"(n) : "memory")
#define WBAR() do { asm volatile("" ::: "memory"); __builtin_amdgcn_s_barrier(); asm volatile("" ::: "memory"); } while (0)
#define RESC(a) do { if (__any((a) < 1.f)) { if (hi == 0) al_l[r32] = (a); asm volatile("s_waitcnt lgkmcnt(0)" ::: "memory"); \
    _Pragma("unroll") for (int d = 0; d < 4; ++d) _Pragma("unroll") for (int r = 0; r < 16; ++r) o[d][r] *= al_l[crow(r, hi)]; } } while (0)
#define NXT3(x) ((x) == 2 ? 0 : (x) + 1)
#define SEG_B(b) do { float mn, al; bf16x8 pa0, pa1, pa2, pa3; partialSM(p0, p1, m_reg, mn, al, C, thr); RESC(al); finishSM(p0, p1, al, l_reg, pa0, pa1, pa2, pa3); SBAR(); \
    pv_d0(o, vb0 + (b) * SHM_V, pa0, pa1, pa2, pa3); } while (0)
  constexpr int NI = NSUB + 2;
  f32x16 p0, p1; const int NT = seq / KVBLK; const bool lead = wid < 4;
  ISSUE_K(0, 0); ISSUE_V(0, 0); ISSUE_K(1, 1); ISSUE_V(1, 1);
  if (!lead) { WAITV(NI); WBAR(); }
  WAITV(NI); WBAR();
  int bq = 0;
  for (int j = 0; j + 2 < NT; ++j) {
    const int b1 = NXT3(bq), b2 = NXT3(b1);
    ISSUE_K(j + 2, b2);
    qkt<DQK>(p0, p1, K_lds + bq * SHM_K, qr, r32, hi);
    WAITV(NI); WBAR();
    ISSUE_V(j + 2, b2);
    SEG_B(bq);
    WAITV(NI); WBAR();
    bq = b1;
  }
#pragma unroll
  for (int jj = 0; jj < 2; ++jj) {
    qkt<DQK>(p0, p1, K_lds + bq * SHM_K, qr, r32, hi);
    WAITV(0); WBAR();
    SEG_B(bq);
    WBAR();
    bq = NXT3(bq);
  }
  if (lead) { WBAR(); }
  if (hi == 0) li_l[r32] = l_reg; asm volatile("s_waitcnt lgkmcnt(0)" ::: "memory");
#pragma unroll
  for (int r = 0; r < 16; ++r) { const float rl = __builtin_amdgcn_rcpf(li_l[crow(r, hi)]);
#pragma unroll
    for (int d = 0; d < 4; ++d) o[d][r] *= rl; }
  asm volatile("s_waitcnt lgkmcnt(0)" ::: "memory"); WBAR();
#undef GLDS
#undef ISSUE_K
#undef ISSUE_V
#undef WAITV
#undef WBAR
#undef RESC
#undef NXT3
#undef SEG_B
}
__device__ __forceinline__ void attn_core_da2(const Src in, const float C, const float thr, const int seq, LAS char* lds, f32x16 (&o1)[4], f32x16 (&o2)[4]) {
  constexpr int NSUB = 2, SHM_K = NSUB * 8192;
  int lane; asm volatile("v_and_b32 %0, 63, %1" : "=v"(lane) : "v"(threadIdx.x));
  const int tid = threadIdx.x, wid = __builtin_amdgcn_readfirstlane(tid >> 6), r32 = lane & 31, hi = (lane >> 5) & 1;
  LAS char* V_lds = lds; LAS char* K_lds = lds + 3 * SHM_V;
  LAS float* ws = (LAS float*)(lds + 3 * SHM_V + 3 * SHM_K) + wid * 64; LAS float* li_l = ws; LAS float* al_l = ws + 32;
  float m1 = -1e30f, l1 = 0, m2 = -1e30f, l2 = 0;
#pragma unroll
  for (int d = 0; d < 4; ++d) { o1[d] = f32x16{}; o2[d] = f32x16{}; }
  bf16x8 q1[4], q2[4];
  const bf16_t* Qw = in.Q + (size_t)(wid * QBLK + r32) * in.ldq + hi * 8;
#pragma unroll
  for (int d0 = 0; d0 < 4; ++d0) { q1[d0] = *(const bf16x8*)(Qw + d0 * 16); q2[d0] = *(const bf16x8*)(Qw + 64 + d0 * 16); }
  const int krow = wid * 8 + (lane >> 3), kslot = (lane & 7) ^ ((krow >> 1) & 7);
  const unsigned koff = (unsigned)(krow * in.ldk + kslot * 8) * 2u;
  unsigned voff[2];
#pragma unroll
  for (int i = 0; i < 2; ++i) { const int p = i * 8192 + wid * 1024 + lane * 16, st = p >> 9, wq = (p & 511) >> 1, kk = (st >> 2) * 8 + (wq >> 5), cl = wq & 31;
    const int k = (kk & ~0xC) | ((kk & 4) << 1) | ((kk & 8) >> 1); voff[i] = (unsigned)(k * in.ldv + (st & 3) * 32 + cl) * 2u; }
  const int vb0 = (int)(unsigned)(size_t)V_lds + v_rd_base(lane);
  const unsigned ldsw = (unsigned)wid * 1024u;
#define GLDS(gp, lp) __builtin_amdgcn_global_load_lds((const unsigned*)(gp), (LAS unsigned*)(lp), 16, 0, 0)
#define ISSUE_KV(t, b) do { const char* kb_ = (const char*)in.K + (size_t)(t) * (KVBLK * 2) * in.ldk; const char* vb_ = (const char*)in.V + (size_t)(t) * (KVBLK * 2) * in.ldv; \
    GLDS(kb_ + koff, K_lds + (b) * SHM_K + ldsw); GLDS(kb_ + 128 + koff, K_lds + (b) * SHM_K + 8192 + ldsw); \
    GLDS(vb_ + voff[0], V_lds + (b) * SHM_V + ldsw); GLDS(vb_ + voff[1], V_lds + (b) * SHM_V + 8192 + ldsw); } while (0)
#define WAITV(n) asm volatile("s_waitcnt vmcnt(%0)" :: "n"(n) : "memory")
#define WBAR() do { asm volatile("" ::: "memory"); __builtin_amdgcn_s_barrier(); asm volatile("" ::: "memory"); } while (0)
#define RESC(oo, a) do { if (__any((a) < 1.f)) { if (hi == 0) al_l[r32] = (a); asm volatile("s_waitcnt lgkmcnt(0)" ::: "memory"); \
    _Pragma("unroll") for (int d = 0; d < 4; ++d) _Pragma("unroll") for (int r = 0; r < 16; ++r) oo[d][r] *= al_l[crow(r, hi)]; asm volatile("s_waitcnt lgkmcnt(0)" ::: "memory"); } } while (0)
#define NXT3(x) ((x) == 2 ? 0 : (x) + 1)
#define TILE_BODY(b) do { f32x16 p0, p1; float mn, al; bf16x8 pa0, pa1, pa2, pa3; \
    qkt<64>(p0, p1, K_lds + (b) * SHM_K, q1, r32, hi); partialSM(p0, p1, m1, mn, al, C, thr); RESC(o1, al); \
    finishSM(p0, p1, al, l1, pa0, pa1, pa2, pa3); SBAR(); pv_d0(o1, vb0 + (b) * SHM_V, pa0, pa1, pa2, pa3); SBAR(); \
    qkt<64>(p0, p1, K_lds + (b) * SHM_K + 8192, q2, r32, hi); partialSM(p0, p1, m2, mn, al, C, thr); RESC(o2, al); \
    finishSM(p0, p1, al, l2, pa0, pa1, pa2, pa3); SBAR(); pv_d0(o2, vb0 + (b) * SHM_V, pa0, pa1, pa2, pa3); SBAR(); } while (0)
  const int NT = seq / KVBLK;
  ISSUE_KV(0, 0); ISSUE_KV(1, 1);
  int bq = 0;
  for (int j = 0; j + 1 < NT; ++j) {
    const int b1 = NXT3(bq), b2 = NXT3(b1);
    WAITV(4); WBAR();
    if (j + 2 < NT) ISSUE_KV(j + 2, b2); else ISSUE_KV(NT - 1, b2);
    TILE_BODY(bq);
    bq = b1;
  }
  WAITV(4); WBAR();
  TILE_BODY(bq);
  WAITV(0);
  if (hi == 0) { li_l[r32] = l1; al_l[r32] = l2; } asm volatile("s_waitcnt lgkmcnt(0)" ::: "memory");
#pragma unroll
  for (int r = 0; r < 16; ++r) { const float ra = __builtin_amdgcn_rcpf(li_l[crow(r, hi)]), rb = __builtin_amdgcn_rcpf(al_l[crow(r, hi)]);
#pragma unroll
    for (int d = 0; d < 4; ++d) { o1[d][r] *= ra; o2[d][r] *= rb; } }
  asm volatile("s_waitcnt lgkmcnt(0)" ::: "memory"); WBAR();
#undef GLDS
#undef ISSUE_KV
#undef WAITV
#undef WBAR
#undef RESC
#undef NXT3
#undef TILE_BODY
}
}

constexpr int NWAVES = 8;
struct Args { const void* in[27]; float* out; unsigned char* ws; int ph_lo, ph_hi, li, pad; };

__constant__ float c_invA[8] = {1.0f, 0.19392274474868576f, 0.03760603093086393f, 0.007292664737217109f, 0.001414213562373095f, 0.0002742481756762073f, 5.318295896944988e-05f, 1.031338537721246e-05f};
__constant__ float c_invM[32] = {1.0f, 0.6636012376960885f, 0.44036660267178046f, 0.2922278225730151f, 0.19392274474868576f, 0.12868737343265052f, 0.08539710028576561f, 0.05666962144529105f,
    0.03760603093086393f, 0.024955408670558694f, 0.016560440080994446f, 0.010989528534539826f, 0.007292664737217109f, 0.004839421345719893f, 0.003211445994752591f, 0.0021311195369119653f,
    0.001414213562373095f, 0.0009384738703573802f, 0.000622772421914596f, 0.0004132725499855165f, 0.0002742481756762073f, 0.00018199142881462546f, 0.00012076973741146504f, 8.01429472224798e-05f,
    5.318295896944988e-05f, 3.529227739646723e-05f, 2.341999896140934e-05f, 1.5541540297632344e-05f, 1.031338537721246e-05f, 6.8439753011549275e-06f, 4.5416704806078695e-06f, 3.013858152139171e-06f};

__device__ __forceinline__ int permDA(int i) { return i < 16 ? (i >> 1) + 8 * (i & 1) : i; }
__device__ __forceinline__ int permM(int i) { return (i >> 1) + 32 * (i & 1); }
__device__ __forceinline__ int src_in(int j) {
    if (j < 2048) return (j & ~63) + permDA(j & 63);
    if (j < 4352) return j;
    if (j < 6400) return 4416 + (j - 4352);
    if (j < 6464) return 4352 + permM(j - 6400);
    return -1;
}
__device__ __forceinline__ int src_uq(int j) { const int hd = j / 192, off = j % 192; return off < 128 ? j : hd * 192 + 128 + permM(off - 128); }

__device__ __forceinline__ void tr_item(const float* W, int K, int N, bf16_t* WT, int n0, int k0, int scol, const float* rs, LAS float* scr, int lane) {
#pragma unroll 8
    for (int i = 0; i < 32; ++i) { const int kk = 2 * i + (lane >> 5); float v = 0.f; if (scol >= 0) { v = W[(size_t)(k0 + kk) * N + scol]; if (rs) v *= rs[k0 + kk]; } scr[kk * 33 + (lane & 31)] = v; }
    LDS_WAIT(); asm volatile("" ::: "memory");
    const int c = lane & 7;
#pragma unroll
    for (int j = 0; j < 4; ++j) { const int n = (lane >> 3) + 8 * j; const LAS float* s = scr + (8 * c) * 33 + n;
        u32x4 o; o.x = cvt_pk_bf16(s[0 * 33], s[1 * 33]); o.y = cvt_pk_bf16(s[2 * 33], s[3 * 33]); o.z = cvt_pk_bf16(s[4 * 33], s[5 * 33]); o.w = cvt_pk_bf16(s[6 * 33], s[7 * 33]);
        *(u32x4*)(WT + (size_t)(n0 + n) * K + k0 + 8 * c) = o; }
    LDS_WAIT(); asm volatile("" ::: "memory");
}

template <int MODE = 0>
__device__ __forceinline__ void cvt_tile64(const float* W, int N, bf16_t* WT, int Kd, int k0, int n0, int drow0, int lane, const float* rs = nullptr) {
    const int g = lane >> 4, x = lane & 15;
    const float* src = W + (size_t)(k0 + 16 * g) * N + n0 + 4 * x;
    f32x4 v[16];
#pragma unroll
    for (int i = 0; i < 16; ++i) v[i] = __builtin_nontemporal_load((const f32x4*)(src + (size_t)i * N));
    if (rs) {
#pragma unroll
        for (int i = 0; i < 16; ++i) v[i] = v[i] * rs[k0 + 16 * g + i];
    }
#pragma unroll
    for (int j = 0; j < 4; ++j) { u32x4 lo, hi;
        lo.x = cvt_pk_bf16(v[0][j], v[1][j]); lo.y = cvt_pk_bf16(v[2][j], v[3][j]); lo.z = cvt_pk_bf16(v[4][j], v[5][j]); lo.w = cvt_pk_bf16(v[6][j], v[7][j]);
        hi.x = cvt_pk_bf16(v[8][j], v[9][j]); hi.y = cvt_pk_bf16(v[10][j], v[11][j]); hi.z = cvt_pk_bf16(v[12][j], v[13][j]); hi.w = cvt_pk_bf16(v[14][j], v[15][j]);
        const int c = 4 * x + j;
        const int dr = MODE == 1 ? 2 * (c & 31) + (c >> 5) : (MODE == 2 ? (c < 16 ? 2 * (c & 7) + (c >> 3) : c) : c);
        bf16_t* d = WT + (size_t)(drow0 + dr) * Kd + k0 + 16 * g;
        *(u32x4*)d = lo; *(u32x4*)(d + 8) = hi; }
}

__global__ void __launch_bounds__(NWAVES * 64, 2) fwd(Args args) {
#define KARGS() const __attribute__((address_space(4))) unsigned long long* ka_ = (const __attribute__((address_space(4))) unsigned long long*)__builtin_amdgcn_kernarg_segment_ptr(); asm volatile("" : "+s"(ka_))
#define AIN(i) ((const void*)ka_[i])
#define AOUT ((float*)ka_[27])
#define AWS ((unsigned char*)ka_[28])
    extern __shared__ __attribute__((aligned(16))) unsigned char lds_raw[];
    LAS unsigned char* lds = (LAS unsigned char*)lds_raw;
    volatile LAS unsigned* MISC = (volatile LAS unsigned*)(lds + MISC_OFF);
    const int tid = threadIdx.x, wave = __builtin_amdgcn_readfirstlane(tid >> 6);
#define LANE_DECL int lane; asm volatile("v_and_b32 %0, 63, %1" : "=v"(lane) : "v"(threadIdx.x))
    const int G = gridDim.x, bx = blockIdx.x;
    unsigned* ctl = (unsigned*)(args.ws + WS_CTL);
    const int lo = args.ph_lo, hi_ph = args.ph_hi;
    if (tid < 32) MISC[tid] = 0u;
    __syncthreads();
    XcdBarrier bar; bar.bar = ctl + CW_BAR + args.li * XCD_BAR_WORDS; bar.x = 0; bar.st = nullptr;
    if (!MK_PER_PHASE) bar = xcd_barrier_post(ctl + CW_BAR + args.li * XCD_BAR_WORDS, MISC + 8);
#define IN(k) (((PH_MASK >> (k)) & 1) && lo <= (k) && (k) < hi_ph)
#define SEAM(k) do { if (IN(k) && IN((k) + 1)) xcd_barrier(bar); } while (0)
    const int gw = bx * NWAVES + wave, NGW = G * NWAVES;

#define xin ((const float*)AIN(0))
#define positions ((const int*)AIN(1))
#define Bt_in ((bf16_t*)(AWS + WS_BT_IN))
#define Bt_uq ((bf16_t*)(AWS + WS_BT_UQ))
#define Bt_ukv ((bf16_t*)(AWS + WS_BT_UKV))
#define Bt_od ((bf16_t*)(AWS + WS_BT_OD))
#define Bt_om ((bf16_t*)(AWS + WS_BT_OM))
#define Bt_out ((bf16_t*)(AWS + WS_BT_OUT))
#define ropeA ((float*)(AWS + WS_ROPEA))
#define ropeM ((float*)(AWS + WS_ROPEM))
#define sq ((float*)(AWS + WS_SQ2))
#define hbuf ((bf16_t*)(AWS + WS_H))
#define oa ((bf16_t*)(AWS + WS_H))
#define qa ((bf16_t*)(AWS + WS_QA))
#define ka ((bf16_t*)(AWS + WS_KA))
#define va ((bf16_t*)(AWS + WS_VA))
#define cq ((bf16_t*)(AWS + WS_CQ))
#define ckv ((bf16_t*)(AWS + WS_CKV))
#define kr ((bf16_t*)(AWS + WS_KR))
#define gates ((bf16_t*)(AWS + WS_GATES))
#define qm ((bf16_t*)(AWS + WS_QM))
#define kv ((bf16_t*)(AWS + WS_KV))
#define ob ((bf16_t*)(AWS + WS_OB))
#define mrg ((bf16_t*)(AWS + WS_MRG))
#define stash ((float*)(AWS + WS_STASH))
#define rowtok_p ((int*)(AWS + WS_ROWTOK))
#define assign ((u32x2*)(AWS + WS_ASSIGN))
#define Bt_d ((bf16_t*)(AWS + WS_BT_D))
#define Bt_gu ((bf16_t*)(AWS + WS_BT_GU))
#define h2 ((bf16_t*)(AWS + WS_H2))
#define act ((bf16_t*)(AWS + WS_ACT))
#define ybuf ((bf16_t*)(AWS + WS_Y))
#define count ((unsigned*)(AWS + WS_CTL) + CW_COUNT)

    if (IN(0)) {
        KARGS();
        LANE_DECL;
        const float* w_in = (const float*)AIN(3); const float* g_q = (const float*)AIN(9); const float* g_kv = (const float*)AIN(10);
        const float* w_uq = (const float*)AIN(11); const float* w_ukv = (const float*)AIN(12);
        const float* w_od = (const float*)AIN(13); const float* w_om = (const float*)AIN(14); const float* w_out = (const float*)AIN(16);
        constexpr int I_IN = 16 * 101, I_PAD = 16 * 3, I_UQ = 12 * 24, I_UKV = 8 * 32, I_O = 16 * 16;
        constexpr int NITEMS = I_IN + I_PAD + I_UQ + I_UKV + 3 * I_O;
        for (int it = gw; it < NITEMS; it += NGW) {
            int r = it;
            if (r < I_IN) { const int kb = r / 101, cb = r % 101, n0 = cb * 64;
                if (n0 < 2048) cvt_tile64<2>(w_in, 6464, Bt_in, D, kb * 64, n0, n0, lane);
                else if (n0 < 4352) cvt_tile64<0>(w_in, 6464, Bt_in, D, kb * 64, n0, n0, lane);
                else if (n0 < 4416) cvt_tile64<1>(w_in, 6464, Bt_in, D, kb * 64, n0, 5888, lane);
                else if (n0 < 4416 + 1536) cvt_tile64<0>(w_in, 6464, Bt_in, D, kb * 64, n0, n0 - 64, lane);
                else cvt_tile64<0>(w_in, 6464, Bt_in, D, kb * 64, n0, n0 - 64 + 256, lane);
                continue; } r -= I_IN;
            if (r < I_PAD) { const int kb = r / 3, rb = r % 3; const int g = lane >> 4, x4 = lane & 15;
#pragma unroll
                for (int j = 0; j < 4; ++j) { bf16_t* d = Bt_in + (size_t)(5952 + rb * 64 + 4 * x4 + j) * D + kb * 64 + 16 * g; *(u32x4*)d = (u32x4){0u, 0u, 0u, 0u}; *(u32x4*)(d + 8) = (u32x4){0u, 0u, 0u, 0u}; }
                continue; } r -= I_PAD;
            if (r < I_UQ) { const int kb = r / 24, cb = r % 24, n0 = cb * 64;
                if ((cb % 3) == 2) cvt_tile64<1>(w_uq, 1536, Bt_uq, QL, kb * 64, n0, n0, lane, g_q); else cvt_tile64<0>(w_uq, 1536, Bt_uq, QL, kb * 64, n0, n0, lane, g_q);
                continue; } r -= I_UQ;
            if (r < I_UKV) { const int kb = r / 32, cb = r % 32; cvt_tile64<0>(w_ukv, 2048, Bt_ukv, KVL, kb * 64, cb * 64, cb * 64, lane, g_kv); continue; } r -= I_UKV;
            const int which = r / I_O; r -= which * I_O; const int kb = r / 16, cb = r % 16;
            cvt_tile64<0>(which == 0 ? w_od : (which == 1 ? w_om : w_out), D, which == 0 ? Bt_od : (which == 1 ? Bt_om : Bt_out), D, kb * 64, cb * 64, cb * 64, lane);
        }
        const float* g_mix = (const float*)AIN(2);
        for (int m = gw * 4; m < T; m += NGW * 4) {
            f32x4 v[4][4]; float ss[4];
#pragma unroll
            for (int q = 0; q < 4; ++q) { const f32x4* xr = (const f32x4*)(xin + (size_t)(m + q) * D) + lane;
#pragma unroll
                for (int j = 0; j < 4; ++j) v[q][j] = xr[64 * j]; }
#pragma unroll
            for (int q = 0; q < 4; ++q) { float s = 0.f;
#pragma unroll
                for (int j = 0; j < 4; ++j) s += (v[q][j][0] * v[q][j][0] + v[q][j][1] * v[q][j][1]) + (v[q][j][2] * v[q][j][2] + v[q][j][3] * v[q][j][3]);
                ss[q] = __builtin_amdgcn_rsqf(wave_sum(s) * (1.f / D) + EPS); }
#pragma unroll
            for (int j = 0; j < 4; ++j) { const f32x4 gg = *((const f32x4*)g_mix + lane + 64 * j);
#pragma unroll
                for (int q = 0; q < 4; ++q) { u32x2 w; w.x = cvt_pk_bf16(v[q][j][0] * ss[q] * gg[0], v[q][j][1] * ss[q] * gg[1]); w.y = cvt_pk_bf16(v[q][j][2] * ss[q] * gg[2], v[q][j][3] * ss[q] * gg[3]);
                    ((u32x2*)(hbuf + (size_t)(m + q) * D) + lane)[64 * j] = w; } }
        }
        for (int idx = bx * 512 + tid; idx < T * 40; idx += G * 512) {
            const int t = idx / 40, i = idx % 40; const float inv = i < 8 ? c_invA[i] : c_invM[i - 8];
            const float ang = (float)positions[t] * inv;
            const double rev = (double)ang * 0.15915494309189535; const float fr_ = (float)(rev - __builtin_rint(rev));
            const float cs = __builtin_amdgcn_cosf(fr_), sn = __builtin_amdgcn_sinf(fr_);
            float* dst = i < 8 ? ropeA + ((size_t)t * 8 + i) * 2 : ropeM + ((size_t)t * 32 + (i - 8)) * 2; dst[0] = cs; dst[1] = sn;
        }
    }
    SEAM(0);
    if (IN(1)) {
        KARGS();
        pg8::Gemm g{hbuf, Bt_in, D}; pg8::DenseOrder S; S.init(T / 256, 24, G, bx);
        pg8::EpiIn E{qa, ka, va, cq, ckv, gates, kr, ropeA, ropeM, (const float*)AIN(15), sq};
        pg8::gemm_phase<pg8::EpiIn, pg8::DenseOrder, false, true>(lds, g, S, E);
    }
    SEAM(1);
    if (IN(2)) {
        KARGS();
        { pg8::Gemm g{hbuf, Bt_in, D}; pg8::DenseOrder S; S.init(T / 256, 2, G, bx, 24);
          pg8::EpiIn E{qa, ka, va, cq, ckv, gates, kr, ropeA, ropeM, (const float*)AIN(15), sq};
          pg8::gemm_phase<pg8::EpiIn, pg8::DenseOrder, false, true>(lds, g, S, E); }
        { pg8::Gemm g{cq, Bt_uq, QL}; pg8::DenseOrder S; S.init(T / 256, 1536 / 256, G, G - 1 - bx); pg8::EpiUp<true> E{qm, sq, ropeM};
          pg8::gemm_phase<pg8::EpiUp<true>, pg8::DenseOrder, false, true>(lds, g, S, E); }
        { pg8::Gemm g{ckv, Bt_ukv, KVL}; pg8::DenseOrder S; S.init(T / 256, 2048 / 256, G, bx); pg8::EpiUp<false> E{kv, sq, ropeM};
          pg8::gemm_phase<pg8::EpiUp<false>, pg8::DenseOrder, false, true>(lds, g, S, E); }
    }
    SEAM(2);
    if (IN(3)) {
        KARGS();
        const int wid = wave;
#define UNIT_DECODE(L) int u = (L) & 511; if (G == 256) { const int c = (L) & 255; u = ((L) & 256) + (c & 7) * 32 + (c >> 3); } \
            const int bh = u >> 4, qb = u & 15, b = bh >> 3, h = bh & 7; const size_t q0 = (size_t)b * SEQ + qb * 256, k0 = (size_t)b * SEQ
        for (int L = bx; L < 512; L += G) {
#if PROBE_PHASE == 3 && defined(PROBE_ATT)
            if (args.li == 1 && lo == 3 && PROBE_ATT != 0) continue;
#endif
            UNIT_DECODE(L);
            f32x16 o[4], o2[4];
            { att::Src in{qa + q0 * 1024 + h * 128, ka + k0 * 1024 + h * 128, nullptr, va + k0 * 1024 + h * 128, 1024, 1024, 0, 1024};
              att::attn_core_da2(in, 0.125f * 1.4426950408889634f, 8.f / 0.125f, SEQ, (LAS char*)lds, o, o2); }
            int ln2; asm volatile("v_and_b32 %0, 63, %1" : "=v"(ln2) : "v"(threadIdx.x));
            float lam;
            { const float* lq1 = (const float*)AIN(4); const float* lk1 = (const float*)AIN(5); const float* lq2 = (const float*)AIN(6); const float* lk2 = (const float*)AIN(7);
              const float s1 = wave_sum(lq1[ln2] * lk1[ln2]), s2 = wave_sum(lq2[ln2] * lk2[ln2]); lam = __expf(s1) - __expf(s2) + LAM_INIT; }
            float ss[16];
#pragma unroll
            for (int r = 0; r < 16; ++r) ss[r] = 0.f;
#pragma unroll
            for (int d = 0; d < 4; ++d)
#pragma unroll
                for (int r = 0; r < 16; ++r) { const float v = o[d][r] - lam * o2[d][r]; o[d][r] = v; ss[r] += v * v; }
#pragma unroll
            for (int r = 0; r < 16; ++r) {
#pragma unroll
                for (int msk = 1; msk < 32; msk <<= 1) ss[r] += __shfl_xor(ss[r], msk);
                ss[r] = __builtin_amdgcn_rsqf(ss[r] * (1.0f / 128.0f) + EPS); }
            const int hi2 = ln2 >> 5, r32e = ln2 & 31;
            bf16_t* Ow = oa + (q0 + wid * 32 + 4 * hi2) * 1024 + h * 128 + r32e;
            float gs[4];
#pragma unroll
            for (int d = 0; d < 4; ++d) gs[d] = ((const float*)AIN(8))[d * 32 + r32e] * (1.0f - LAM_INIT);
#pragma unroll
            for (int r = 0; r < 16; ++r) { const int orow = att::crow(r, 0);
#pragma unroll
                for (int d = 0; d < 4; ++d) Ow[orow * 1024 + d * 32] = (bf16_t)(cvt_pk_bf16(o[d][r] * ss[r] * gs[d], 0.f) & 0xffffu); }
        }
        for (int L = 512 + bx; L < 1024; L += G) {
#if PROBE_PHASE == 3 && defined(PROBE_ATT)
            if (args.li == 1 && lo == 3 && PROBE_ATT != 1) continue;
#endif
            UNIT_DECODE(L);
            f32x16 o[4];
            { att::Src in{qm + q0 * 1536 + h * 192, kv + k0 * 2048 + h * 256, kr + k0 * 64, kv + k0 * 2048 + h * 256 + 128, 1536, 2048, 64, 2048};
              att::attn_core_seq<192>(in, 0.07216878364870322f * 1.4426950408889634f, 8.f / 0.07216878364870322f, SEQ, (LAS char*)lds, o); }
            int ln2; asm volatile("v_and_b32 %0, 63, %1" : "=v"(ln2) : "v"(threadIdx.x));
            const int hi2 = ln2 >> 5, r32e = ln2 & 31;
            bf16_t* Ow = ob + (q0 + wid * 32 + 4 * hi2) * 1024 + h * 128 + r32e;
#pragma unroll
            for (int r = 0; r < 16; ++r) { const int orow = att::crow(r, 0);
#pragma unroll
                for (int d = 0; d < 4; ++d) Ow[orow * 1024 + d * 32] = (bf16_t)(cvt_pk_bf16(o[d][r], 0.f) & 0xffffu); }
        }
#undef UNIT_DECODE
    }
    SEAM(3);
    if (IN(4)) {
        KARGS();
        { pg8::Gemm g{oa, Bt_od, D}; pg8::DenseOrder S; S.init(T / 256, 4, G, bx); pg8::EpiGate<0> E{mrg, gates};
          pg8::gemm_phase<pg8::EpiGate<0>, pg8::DenseOrder, false, true>(lds, g, S, E); }
        VM_WAIT(); __syncthreads();
        { pg8::Gemm g{ob, Bt_om, D}; pg8::DenseOrder S; S.init(T / 256, 4, G, bx); pg8::EpiGate<1> E{mrg, gates};
          pg8::gemm_phase<pg8::EpiGate<1>, pg8::DenseOrder, false, true>(lds, g, S, E); }
    }
    SEAM(4);
    if (IN(5)) {
        KARGS();
        pg8::Gemm g{mrg, Bt_out, D}; pg8::DenseOrder S; S.init(T / 256, 4, G, bx); pg8::EpiRes E{xin, AOUT};
        pg8::gemm_phase<pg8::EpiRes, pg8::DenseOrder, false, true>(lds, g, S, E);
    }
    SEAM(5);
    if (IN(6)) {
        KARGS();
        LANE_DECL;
        const float* g_ffn = (const float*)AIN(17); const float* w_router = (const float*)AIN(18); const float* b_router = (const float*)AIN(19);
        constexpr int WRS = 1028;
        LAS float* wr_l = (LAS float*)lds;
        LAS int* lcount = (LAS int*)(lds + TAB_OFF + 1024); LAS int* gbase = lcount + 32; LAS unsigned* asg_e = (LAS unsigned*)(lcount + 64); LAS float* asg_w = (LAS float*)(lcount + 64 + 256);
        LAS int* sync_w = (LAS int*)(lds + TAB_OFF + 512);
        for (int i = tid; i < D * NEXP; i += 512) wr_l[(i & 31) * WRS + (i >> 5)] = w_router[i];
        if (tid < 32) lcount[tid] = 0;
        if (tid < 2) sync_w[tid] = 0;
        __syncthreads();
        const int ex = (lane >> 1) & 31;
        LAS float* lg = (LAS float*)(lds + TAB_OFF + 4096) + wave * 80;
        const int chunk = bx;
        if (wave < 4 && chunk < T / 64) {
            const float my_b = b_router[ex];
#pragma unroll 1
            for (int j2 = 0; j2 < 8; ++j2) {
                const int tl = wave * 16 + j2 * 2, t = chunk * 64 + tl;
                f32x4 xva[4], xvb[4]; float sa = 0.f, sb = 0.f;
                { const f32x4* xa = (const f32x4*)(AOUT + (size_t)t * D) + lane; const f32x4* xb = xa + D / 4;
#pragma unroll
                  for (int j = 0; j < 4; ++j) { xva[j] = xa[64 * j]; xvb[j] = xb[64 * j]; }
#pragma unroll
                  for (int j = 0; j < 4; ++j) { sa += (xva[j][0] * xva[j][0] + xva[j][1] * xva[j][1]) + (xva[j][2] * xva[j][2] + xva[j][3] * xva[j][3]); sb += (xvb[j][0] * xvb[j][0] + xvb[j][1] * xvb[j][1]) + (xvb[j][2] * xvb[j][2] + xvb[j][3] * xvb[j][3]); } }
                const float ra = __builtin_amdgcn_rsqf(wave_sum(sa) * (1.f / D) + EPS), rb = __builtin_amdgcn_rsqf(wave_sum(sb) * (1.f / D) + EPS);
                { u32x2* oa8 = (u32x2*)(h2 + (size_t)t * D) + lane; u32x2* ob8 = oa8 + D / 4;
#pragma unroll
                  for (int j = 0; j < 4; ++j) { const f32x4 gg = *((const f32x4*)g_ffn + lane + 64 * j); xva[j] = xva[j] * ra * gg; xvb[j] = xvb[j] * rb * gg;
                    u32x2 w; w.x = cvt_pk_bf16(xva[j][0], xva[j][1]); w.y = cvt_pk_bf16(xva[j][2], xva[j][3]); oa8[64 * j] = w;
                    w.x = cvt_pk_bf16(xvb[j][0], xvb[j][1]); w.y = cvt_pk_bf16(xvb[j][2], xvb[j][3]); ob8[64 * j] = w; } }
                float aa[32], ab[32];
#pragma unroll
                for (int e = 0; e < NEXP; ++e) { float a = 0.f, b = 0.f;
#pragma unroll
                    for (int j = 0; j < 4; ++j) { const f32x4 w4 = *(const LAS f32x4*)(wr_l + e * WRS + 4 * lane + 256 * j);
                        a += (xva[j][0] * w4[0] + xva[j][1] * w4[1]) + (xva[j][2] * w4[2] + xva[j][3] * w4[3]); b += (xvb[j][0] * w4[0] + xvb[j][1] * w4[1]) + (xvb[j][2] * w4[2] + xvb[j][3] * w4[3]); }
                    aa[e] = a; ab[e] = b; }
#define TRED(arr, n, msk) _Pragma("unroll") for (int i_ = 0; i_ < (n); ++i_) { const bool up_ = (lane & (msk)) != 0; const float keep_ = up_ ? arr[(n) + i_] : arr[i_], give_ = up_ ? arr[i_] : arr[(n) + i_]; arr[i_] = keep_ + __shfl_xor(give_, (msk)); }
                TRED(aa, 16, 32) TRED(aa, 8, 16) TRED(aa, 4, 8) TRED(aa, 2, 4) TRED(aa, 1, 2)
                TRED(ab, 16, 32) TRED(ab, 8, 16) TRED(ab, 4, 8) TRED(ab, 2, 4) TRED(ab, 1, 2)
#undef TRED
                const float la = aa[0] + __shfl_xor(aa[0], 1) + my_b, lb = ab[0] + __shfl_xor(ab[0], 1) + my_b;
#pragma unroll
                for (int tk = 0; tk < 2; ++tk) {
                    const float v = tk ? lb : la; int rank = 0;
                    if (!(lane & 1)) lg[tk * 32 + ex] = v;
                    LDS_WAIT();
#pragma unroll
                    for (int q = 0; q < 8; ++q) { const f32x4 s4 = *(const LAS f32x4*)(lg + tk * 32 + 4 * q);
#pragma unroll
                        for (int jj = 0; jj < 4; ++jj) rank += (s4[jj] > v || (s4[jj] == v && (4 * q + jj) < ex)) ? 1 : 0; }
                    if (rank < 4 && !(lane & 1)) lg[64 + tk * 4 + rank] = v;
                    LDS_WAIT();
                    const f32x4 tv = *(const LAS f32x4*)(lg + 64 + tk * 4);
                    const float p1 = __expf(tv[1] - tv[0]), p2 = __expf(tv[2] - tv[0]), p3 = __expf(tv[3] - tv[0]), inv = 1.0f / (1.0f + p1 + p2 + p3);
                    if (rank < 4 && !(lane & 1)) { const float w = (rank == 0 ? 1.0f : (rank == 1 ? p1 : (rank == 2 ? p2 : p3))) * inv;
                        const int lr = __hip_atomic_fetch_add((LAS int*)&lcount[ex], 1, __ATOMIC_RELAXED, __HIP_MEMORY_SCOPE_WORKGROUP);
                        asg_e[(tl + tk) * 4 + rank] = ((unsigned)ex << 16) | (unsigned)lr; asg_w[(tl + tk) * 4 + rank] = w; }
                }
            }
            LDS_WAIT();
            if (lane == 0) __hip_atomic_fetch_add((LAS int*)&sync_w[0], 1, __ATOMIC_RELAXED, __HIP_MEMORY_SCOPE_WORKGROUP);
            if (wave == 0) {
                while (__hip_atomic_load((LAS int*)&sync_w[0], __ATOMIC_RELAXED, __HIP_MEMORY_SCOPE_WORKGROUP) < 4) __builtin_amdgcn_s_sleep(4);
                asm volatile("s_waitcnt lgkmcnt(0)" ::: "memory");
                if (lane < 32) gbase[lane] = (int)__hip_atomic_fetch_add(count + lane, (unsigned)lcount[lane], __ATOMIC_RELAXED, __HIP_MEMORY_SCOPE_AGENT);
                LDS_WAIT();
#pragma unroll
                for (int q = 0; q < 4; ++q) { const int a_ = q * 64 + lane; const unsigned ae = asg_e[a_]; const int e = ae >> 16, rank = gbase[e] + (int)(ae & 0xffffu); const int t = chunk * 64 + (a_ >> 2);
                    rowtok_p[e * T + rank] = t; u32x2 av; av.x = ((unsigned)e << 16) | (unsigned)rank; av.y = __float_as_uint(asg_w[a_]); assign[(size_t)t * 4 + (a_ & 3)] = av; }
            }
        }
        const float* w_gate = (const float*)AIN(20); const float* w_up = (const float*)AIN(22); const float* w_down = (const float*)AIN(24);
        const int per_wg = (NEXP * 768 + G - 1) / G;
        for (;;) {
            int it = 0; if (lane == 0) it = __hip_atomic_fetch_add((LAS int*)&sync_w[1], 1, __ATOMIC_RELAXED, __HIP_MEMORY_SCOPE_WORKGROUP);
            it = __builtin_amdgcn_readfirstlane(it); const int item = bx * per_wg + it;
            if (it >= per_wg || item >= NEXP * 768) break;
            const int e = item / 768, r = item % 768, mat = r >> 8, kb = (r >> 4) & 15, nb = r & 15, f0 = nb * 64;
            if (mat < 2) cvt_tile64((mat ? w_up : w_gate) + (size_t)e * D * FF, FF, Bt_gu + (size_t)e * 2048 * D, D, kb * 64, f0, 256 * (f0 >> 7) + mat * 128 + (f0 & 127), lane);
            else cvt_tile64(w_down + (size_t)e * FF * D, D, Bt_d + (size_t)e * D * FF, FF, kb * 64, f0, f0, lane);
        }
    }
    SEAM(6);
    LAS int* t_cnt = (LAS int*)(lds + TAB_OFF + 4096); LAS int* t_start = t_cnt + 32; LAS int* t_t2e = t_start + 40;
    if (IN(7) || IN(8) || IN(9)) {
        KARGS();
        __syncthreads();
        if (tid < 32) t_cnt[tid] = (int)__hip_atomic_load(count + tid, __ATOMIC_RELAXED, __HIP_MEMORY_SCOPE_AGENT);
        __syncthreads();
        if (tid == 0) { int s = 0; for (int e = 0; e < NEXP; ++e) { t_start[e] = s; s += (t_cnt[e] + 255) >> 8; } t_start[32] = s; }
        __syncthreads();
        if (tid < 32) { for (int rt = t_start[tid]; rt < t_start[tid + 1]; ++rt) t_t2e[rt] = tid; }
        __syncthreads();
    }
    if (IN(7)) {
        KARGS();
        pg8::Gemm g{h2, Bt_gu, D}; pg8::MoeOrder S; S.init(__builtin_amdgcn_readfirstlane(t_start[32]), 8, G, bx); S.t2e = t_t2e; S.tstart = t_start; S.cnt = t_cnt; S.rowtok = rowtok_p;
        pg8::EpiSwiglu E{act, (const float*)AIN(21), (const float*)AIN(23)};
        pg8::gemm_phase<pg8::EpiSwiglu, pg8::MoeOrder, true, true>(lds, g, S, E);
    }
    SEAM(7);
    if (IN(8)) {
        KARGS();
        pg8::Gemm g{act, Bt_d, FF}; pg8::MoeOrder S; S.init(__builtin_amdgcn_readfirstlane(t_start[32]), 4, G, bx); S.t2e = t_t2e; S.tstart = t_start; S.cnt = t_cnt; S.rowtok = rowtok_p;
        pg8::EpiDown E{ybuf, (const float*)AIN(25)};
        pg8::gemm_phase<pg8::EpiDown, pg8::MoeOrder, false, true>(lds, g, S, E);
    }
    SEAM(8);
    if (IN(9) && DBG_OUT) {
        KARGS();
        const bf16_t* src = DBG_OUT == 1 ? gates : DBG_OUT == 2 ? gates + 1024 : DBG_OUT == 3 ? qa : DBG_OUT == 4 ? ka : DBG_OUT == 5 ? va : DBG_OUT == 6 ? mrg : DBG_OUT == 7 ? oa : DBG_OUT == 9 ? Bt_in : ob;
        const int ld = DBG_OUT <= 2 ? 2048 : 1024;
        for (size_t i = (size_t)bx * 512 + tid; i < (size_t)T * 1024; i += (size_t)G * 512) AOUT[i] = (DBG_OUT == 9 && i >= (size_t)N_IN * 1024) ? 0.f : __uint_as_float((unsigned)src[(i >> 10) * ld + (i & 1023)] << 16);
    } else
    if (IN(9)) {
        KARGS();
        LANE_DECL;
        const float* g_fin = (const float*)AIN(26);
        for (int t0 = gw * 2; t0 < T; t0 += NGW * 2) {
            f32x4 v[2][4]; u32x2 as_[2][4];
#pragma unroll
            for (int q = 0; q < 2; ++q) { const f32x4* xr = (const f32x4*)(AOUT + (size_t)(t0 + q) * D) + lane;
#pragma unroll
                for (int j = 0; j < 4; ++j) v[q][j] = xr[64 * j];
#pragma unroll
                for (int k = 0; k < 4; ++k) as_[q][k] = assign[(size_t)(t0 + q) * 4 + k]; }
            u32x2 yw[2][4][4];
#pragma unroll
            for (int q = 0; q < 2; ++q)
#pragma unroll
                for (int k = 0; k < 4; ++k) { const int e = as_[q][k].x >> 16, rank = as_[q][k].x & 0xffffu;
                    const u32x2* yr = (const u32x2*)(ybuf + ((size_t)t_start[e] * 256 + rank) * D) + lane;
#pragma unroll
                    for (int j = 0; j < 4; ++j) yw[q][k][j] = yr[64 * j]; }
#pragma unroll
            for (int q = 0; q < 2; ++q) {
#pragma unroll
                for (int k = 0; k < 4; ++k) { const float w = (DBG_SKIP & 1) ? 0.f : __uint_as_float(as_[q][k].y);
#pragma unroll
                    for (int j = 0; j < 4; ++j) { const u32x2 y = yw[q][k][j]; v[q][j][0] += w * bf_lo(y.x); v[q][j][1] += w * bf_hi(y.x); v[q][j][2] += w * bf_lo(y.y); v[q][j][3] += w * bf_hi(y.y); } }
                float s = 0.f;
#pragma unroll
                for (int j = 0; j < 4; ++j) s += (v[q][j][0] * v[q][j][0] + v[q][j][1] * v[q][j][1]) + (v[q][j][2] * v[q][j][2] + v[q][j][3] * v[q][j][3]);
                const float rstd = __builtin_amdgcn_rsqf(wave_sum(s) * (1.f / D) + EPS);
                f32x4* xo = (f32x4*)(AOUT + (size_t)(t0 + q) * D) + lane;
#pragma unroll
                for (int j = 0; j < 4; ++j) { const f32x4 gg = *((const f32x4*)g_fin + lane + 64 * j); xo[64 * j] = v[q][j] * rstd * gg; } }
        }
    }
#undef IN
#undef SEAM
#undef KARGS
#undef AIN
#undef AOUT
#undef AWS
#undef xin
#undef positions
#undef Bt_in
#undef Bt_uq
#undef Bt_ukv
#undef Bt_od
#undef Bt_om
#undef Bt_out
#undef ropeA
#undef ropeM
#undef sq
#undef hbuf
#undef oa
#undef qa
#undef ka
#undef va
#undef cq
#undef ckv
#undef kr
#undef gates
#undef qm
#undef kv
#undef ob
#undef mrg
#undef stash
#undef rowtok_p
#undef assign
#undef Bt_d
#undef Bt_gu
#undef h2
#undef act
#undef ybuf
#undef count
}

extern "C" void kernel_launch(void* const* d_in, const int* in_sizes, int n_in, void* d_out, int out_size, void* d_ws, size_t ws_size, hipStream_t stream) {
    static int grid = 0;
    if (grid == 0) {
        if (n_in != 27 || in_sizes[0] != T * D || out_size != T * D || ws_size < WS_END) { fprintf(stderr, "kernel_launch: unexpected shapes (n_in %d, in0 %d, out %d, ws %zu < %zu)\n", n_in, n_in > 0 ? in_sizes[0] : -1, out_size, ws_size, (size_t)WS_END); grid = -1; return; }
        int dev = 0, cus = 0, per_cu = 0;
        if (hipGetDevice(&dev) != hipSuccess || hipDeviceGetAttribute(&cus, hipDeviceAttributeMultiprocessorCount, dev) != hipSuccess) { grid = -1; return; }
        if (hipFuncSetAttribute((const void*)fwd, hipFuncAttributeMaxDynamicSharedMemorySize, LDS_BYTES) != hipSuccess) { fprintf(stderr, "kernel_launch: hipFuncSetAttribute failed\n"); grid = -1; return; }
        if (hipOccupancyMaxActiveBlocksPerMultiprocessor(&per_cu, (const void*)fwd, NWAVES * 64, LDS_BYTES) != hipSuccess || per_cu < 1) fprintf(stderr, "kernel_launch: occupancy query says %d\n", per_cu);
        (void)hipGetLastError();
        grid = cus;
    }
    if (grid < 0) return;
    if (hipMemsetAsync((char*)d_ws + WS_CTL, 0, CTL_ZERO_BYTES, stream) != hipSuccess) return;
    Args a{};
    for (int i = 0; i < 27; ++i) a.in[i] = d_in[i];
    a.out = (float*)d_out; a.ws = (unsigned char*)d_ws;
#if MK_PER_PHASE
    for (int p = 0; p < NPHASE; ++p) { a.ph_lo = p; a.ph_hi = p + 1; hipLaunchKernelGGL(fwd, dim3(grid), dim3(NWAVES * 64), LDS_BYTES, stream, a); }
#elif PROBE_PHASE >= 0
    a.ph_lo = 0; a.ph_hi = PROBE_PHASE + 1; a.li = 0; hipLaunchKernelGGL(fwd, dim3(grid), dim3(NWAVES * 64), LDS_BYTES, stream, a);
    a.ph_lo = PROBE_PHASE; a.ph_hi = NPHASE; a.li = 1; hipLaunchKernelGGL(fwd, dim3(grid), dim3(NWAVES * 64), LDS_BYTES, stream, a);
#else
    a.ph_lo = 0; a.ph_hi = NPHASE; hipLaunchKernelGGL(fwd, dim3(grid), dim3(NWAVES * 64), LDS_BYTES, stream, a);
#endif
}
```

```cpp
#include <hip/hip_runtime.h>
#include <cstdio>
#include <cstdint>

#ifndef MK_PER_PHASE
#define MK_PER_PHASE 0
#endif

#ifndef PROBE_PHASE
#define PROBE_PHASE -1
#endif
#ifndef ATT_DUP
#define ATT_DUP 0
#endif
#ifndef DBG_OUT
#define DBG_OUT 0
#endif
#ifndef DBG_SKIP
#define DBG_SKIP 0
#endif
#ifndef ATT_MASK
#define ATT_MASK 3
#endif
#ifndef PH_MASK
#define PH_MASK 0x3ff
#endif
#define LAS __attribute__((address_space(3)))
#define GAS __attribute__((address_space(1)))
typedef unsigned short bf16_t;
typedef short bf16x8 __attribute__((ext_vector_type(8)));
typedef short s16x4 __attribute__((ext_vector_type(4)));
typedef float f32x2 __attribute__((ext_vector_type(2)));
typedef float f32x4 __attribute__((ext_vector_type(4)));
typedef float f32x16 __attribute__((ext_vector_type(16)));
typedef unsigned u32x2 __attribute__((ext_vector_type(2)));
typedef unsigned u32x4 __attribute__((ext_vector_type(4)));

constexpr int NB = 4, SEQ = 4096, T = NB * SEQ, D = 1024;
constexpr int NEXP = 32, TOPK = 4, FF = 1024;
constexpr int N_IN = 6656;
constexpr int QL = 768, KVL = 512;
constexpr float EPS = 1e-6f;
constexpr float LAM_INIT = 0.2f;
constexpr int NPHASE = 10;

constexpr size_t MiB = 1u << 20;
constexpr size_t WS_CTL = 0, CTL_ZERO_BYTES = 1 * MiB;
constexpr size_t WS_BT_IN = 2 * MiB;
constexpr size_t WS_BT_UQ = 15 * MiB;
constexpr size_t WS_BT_UKV = 18 * MiB;
constexpr size_t WS_BT_OD = 20 * MiB, WS_BT_OM = 22 * MiB, WS_BT_OUT = 24 * MiB;
constexpr size_t WS_ROPEA = 26 * MiB;
constexpr size_t WS_ROPEM = 27 * MiB;
constexpr size_t WS_SQ = 31 * MiB;
constexpr size_t WS_SQP = 1 * MiB;
constexpr size_t WS_H = 32 * MiB;
constexpr size_t WS_QA = 64 * MiB, WS_KA = 96 * MiB, WS_VA = 128 * MiB;
constexpr size_t WS_CQ = 160 * MiB, WS_CKV = 184 * MiB, WS_KR = 200 * MiB;
constexpr size_t WS_SQ2 = 202 * MiB;
constexpr size_t WS_GATES = 208 * MiB;
constexpr size_t WS_QM = 272 * MiB;
constexpr size_t WS_KV = 320 * MiB;
constexpr size_t WS_OB = 384 * MiB;
constexpr size_t WS_MRG = 416 * MiB;
constexpr size_t WS_STASH = 448 * MiB;
constexpr size_t WS_ROWTOK = 2 * MiB;
constexpr size_t WS_ASSIGN = 4 * MiB;
constexpr size_t WS_BT_D = 32 * MiB;
constexpr size_t WS_BT_GU = 96 * MiB;
constexpr size_t WS_H2 = 224 * MiB;
constexpr size_t WS_ACT = 256 * MiB;
constexpr size_t WS_Y = 96 * MiB;
constexpr size_t WS_END = 512 * MiB;
constexpr int CW_COUNT = 64;
constexpr int CW_BAR = 4096;

constexpr int RING_BYTES = 131072;
constexpr int TAB_OFF = RING_BYTES;
constexpr int TAB_BYTES = 8192;
constexpr int MISC_OFF = TAB_OFF + TAB_BYTES;
constexpr int LDS_BYTES = 147456;

typedef __bf16 bf16x2_t __attribute__((ext_vector_type(2)));
__device__ __forceinline__ unsigned cvt_pk_bf16(float lo, float hi) { const f32x2 v = {lo, hi}; return __builtin_bit_cast(unsigned, __builtin_convertvector(v, bf16x2_t)); }
__device__ __forceinline__ float bf_lo(unsigned w) { return __uint_as_float(w << 16); }
__device__ __forceinline__ float bf_hi(unsigned w) { return __uint_as_float(w & 0xffff0000u); }
__device__ __forceinline__ float wave_sum(float v) {
#pragma unroll
    for (int o = 1; o < 64; o <<= 1) v += __shfl_xor(v, o);
    return v;
}
__device__ __forceinline__ float sigmoidf_(float x) { return __builtin_amdgcn_rcpf(1.0f + __builtin_amdgcn_exp2f(-1.4426950408889634f * x)); }
__device__ __forceinline__ unsigned cvt_pk_fp8x4(float a, float b, float c, float d) {
    a = fminf(fmaxf(a, -448.f), 448.f); b = fminf(fmaxf(b, -448.f), 448.f); c = fminf(fmaxf(c, -448.f), 448.f); d = fminf(fmaxf(d, -448.f), 448.f);
    int r = __builtin_amdgcn_cvt_pk_fp8_f32(a, b, 0, false); r = __builtin_amdgcn_cvt_pk_fp8_f32(c, d, r, true); return (unsigned)r; }
#define LDS_WAIT() asm volatile("s_waitcnt lgkmcnt(0)" ::: "memory")
#define VM_WAIT() asm volatile("s_waitcnt vmcnt(0)" ::: "memory")

#define XB_TMO      128
#define XB_XCNT(j)  (256  + 64 * (j))
#define XB_XSUB(j)  (1280 + 64 * (j))
#define XB_XGEN(j)  (2304 + 64 * (j))
#define XB_TOP      3328
#define XB_TOPGEN   3392
#define XCD_BAR_WORDS 3456
#define XB_SPIN_CAP (1u << 20)
__device__ __forceinline__ unsigned xb_ld(unsigned* p)              { return __hip_atomic_load(p, __ATOMIC_RELAXED, __HIP_MEMORY_SCOPE_AGENT); }
__device__ __forceinline__ unsigned xb_add(unsigned* p, unsigned v) { return __hip_atomic_fetch_add(p, v, __ATOMIC_RELAXED, __HIP_MEMORY_SCOPE_AGENT); }
__device__ __forceinline__ unsigned xb_xcc_id() { return (unsigned)__builtin_amdgcn_s_getreg((3 << 11) | 20) & 0xFu; }
#define XB_SPIN(cond, bar) do { unsigned _sp = 0; while (cond) { __builtin_amdgcn_s_sleep(1); \
    if ((++_sp & 255u) == 0u) { if (xb_ld(&(bar)[XB_TMO])) break; if (_sp > XB_SPIN_CAP) { atomicAdd(&(bar)[XB_TMO], 1u); break; } } } } while (0)
struct XcdBarrier { unsigned* bar; unsigned x; volatile LAS unsigned* st; };
__device__ __forceinline__ XcdBarrier xcd_barrier_post(unsigned* bar, volatile LAS unsigned* st) {
    XcdBarrier b; b.bar = bar; b.x = xb_xcc_id(); b.st = st;
    if (threadIdx.x == 0) (void)xb_add(&bar[XB_XCNT(b.x)], 1u);
    return b;
}
__device__ __forceinline__ void xcd_barrier_complete(unsigned* bar, unsigned x, unsigned& nloc, unsigned& nx) {
    const unsigned G = gridDim.x * gridDim.y * gridDim.z;
    unsigned sum, cnt, mine, sp = 0u;
    for (;;) {
        sum = 0u; cnt = 0u; mine = 0u;
#pragma unroll
        for (unsigned j = 0; j < 16; ++j) { const unsigned c = xb_ld(&bar[XB_XCNT(j)]); sum += c; cnt += (c > 0u) ? 1u : 0u; mine = (j == x) ? c : mine; }
        if (sum == G) break;
        __builtin_amdgcn_s_sleep(1);
        if ((++sp & 255u) == 0u) { if (xb_ld(&bar[XB_TMO])) break; if (sp > XB_SPIN_CAP) { atomicAdd(&bar[XB_TMO], 1u); break; } }
    }
    nloc = mine > 0u ? mine : 1u; nx = cnt > 0u ? cnt : 1u;
}
__device__ __forceinline__ void xcd_barrier(const XcdBarrier& b) {
    asm volatile("s_waitcnt vmcnt(0)" ::: "memory");
    __syncthreads();
    if (threadIdx.x == 0) {
        unsigned* bar = b.bar;
        __builtin_amdgcn_s_waitcnt(0);
        unsigned nloc = b.st[0], nx = b.st[1];
        if (nloc == 0u) { xcd_barrier_complete(bar, b.x, nloc, nx); b.st[0] = nloc; b.st[1] = nx; }
        const unsigned old = xb_add(&bar[XB_XSUB(b.x)], 1u);
        const unsigned gen = old / nloc;
        if (old + 1u == (gen + 1u) * nloc) {
            __builtin_amdgcn_fence(__ATOMIC_RELEASE, "agent");
            asm volatile("s_waitcnt vmcnt(0)" ::: "memory");
            const unsigned og = xb_add(&bar[XB_TOP], 1u);
            const unsigned tg = og / nx;
            if (og + 1u == (tg + 1u) * nx) xb_add(&bar[XB_TOPGEN], 1u);
            else XB_SPIN(xb_ld(&bar[XB_TOPGEN]) == tg, bar);
            __builtin_amdgcn_fence(__ATOMIC_ACQUIRE, "agent");
            xb_add(&bar[XB_XGEN(b.x)], 1u);
            asm volatile("s_waitcnt vmcnt(0)" ::: "memory");
        } else {
            XB_SPIN(xb_ld(&bar[XB_XGEN(b.x)]) == gen, bar);
            __builtin_amdgcn_fence(__ATOMIC_ACQUIRE, "agent");
            asm volatile("s_waitcnt vmcnt(0)" ::: "memory");
        }
    }
    __syncthreads();
}

namespace pg8 {
constexpr int BM = 256, BK = 64, HALF = 128, HTB = HALF * BK * 2, STAGE_BYTES = 8 * HTB, NXCD = 8, WGM = 8;
__host__ __device__ __forceinline__ int lds_byte(int r, int c) { const int st = (r >> 4) * 2 + (c >> 5), rr = r & 15, cc = c & 31, ob = rr * 64 + cc * 2; return st * 1024 + (ob ^ (((ob >> 9) & 1) << 5)); }
__host__ __device__ __forceinline__ void stage_rc(int b, int& R, int& C) { const int st = b / 1024, sb = b % 1024, swz = sb ^ (((sb >> 9) & 1) << 5); R = (st >> 1) * 16 + swz / 64; C = (st & 1) * 32 + (swz % 64) / 2; }
__host__ __device__ __forceinline__ int perm32(int rho) { const int n = rho >> 4, i = rho & 15; return 8 * (i >> 2) + 4 * n + (i & 3); }

struct Unit { int pm, pn, pb, e, rbase, cnt; };
struct Gemm { const bf16_t* A; const bf16_t* Bt; int K; };

struct DenseOrder {
    int nM, nN, nwg, G, c, pn0;
    __device__ void init(int nM_, int nN_, int G_, int c_, int pn0_ = 0) { nM = nM_; nN = nN_; nwg = nM * nN; G = G_; c = c_; pn0 = pn0_; }
    __device__ __forceinline__ bool next(int i, Unit& u) const {
        const long L = (long)i * G + c; if (L >= nwg) return false;
        int wgid = (int)L; { const int q = nwg / NXCD, r = nwg % NXCD, xcd = wgid % NXCD, off = wgid / NXCD; wgid = (xcd < r ? xcd * (q + 1) : r * (q + 1) + (xcd - r) * q) + off; }
        const int nig = WGM * nN, gid = wgid / nig, fm = gid * WGM, gsz = (nM - fm) < WGM ? (nM - fm) : WGM;
        u.pm = fm + ((wgid % nig) % gsz); u.pn = pn0 + (wgid % nig) / gsz; u.pb = u.pn; u.e = 0; u.rbase = 0; u.cnt = 0; return true;
    }
    __device__ __forceinline__ int a_row(const Unit&, int) const { return 0; }
};
struct MoeOrder {
    int nM, nN, nwg, G, c; const LAS int* t2e; const LAS int* tstart; const LAS int* cnt; const int* rowtok;
    __device__ void init(int nM_, int nN_, int G_, int c_) { nM = nM_; nN = nN_; nwg = nM * nN; G = G_; c = c_; }
    __device__ __forceinline__ bool next(int i, Unit& u) const {
        const long L = (long)i * G + c; if (L >= nwg) return false;
        int wgid = (int)L; { const int q = nwg / NXCD, r = nwg % NXCD, xcd = wgid % NXCD, off = wgid / NXCD; wgid = (xcd < r ? xcd * (q + 1) : r * (q + 1) + (xcd - r) * q) + off; }
        const int nig = WGM * nN, gid = wgid / nig, fm = gid * WGM, gsz = (nM - fm) < WGM ? (nM - fm) : WGM;
        u.pm = fm + ((wgid % nig) % gsz); u.pn = (wgid % nig) / gsz;
        const int e = __builtin_amdgcn_readfirstlane(t2e[u.pm]); u.e = e; u.pb = e * nN + u.pn; u.rbase = (u.pm - __builtin_amdgcn_readfirstlane(tstart[e])) * 256; u.cnt = __builtin_amdgcn_readfirstlane(cnt[e]); return true;
    }
    __device__ __forceinline__ int a_row(const Unit& u, int r) const { const int rank = u.rbase + r; return rank < u.cnt ? rowtok[u.e * T + rank] : 0; }
};

template <class Epi, class Sched, bool GATHER, bool ALIGN_EPI>
__device__ __forceinline__ void gemm_phase(LAS unsigned char* lds, const Gemm g, const Sched& S, const Epi& E) {
    const int tid = threadIdx.x, wid = __builtin_amdgcn_readfirstlane(tid >> 6), lane = tid & 63, wr = wid >> 2, wc = wid & 3, fr = lane & 15, fq = lane >> 4;
    const int K = g.K, nt = K / BK;
    unsigned voffA[2], voffB[2]; int Rv[2], Cv[2];
#pragma unroll
    for (int i = 0; i < 2; ++i) { int R, C; stage_rc(tid * 16 + i * 8192, R, C); const int Rb = Epi::PERM ? ((R & ~31) + perm32(R & 31)) : R;
        voffA[i] = (unsigned)(R * K + C) * 2u; voffB[i] = (unsigned)(Rb * K + C) * 2u; Rv[i] = R; Cv[i] = C; }
    const size_t kstep = (size_t)(BK * 2);
    const size_t hstep = (size_t)HALF * K * 2;
    const size_t tstep = 2 * hstep;
    const unsigned ldsw = (unsigned)wid * 1024u;
    const int aoff = lds_byte(wr * 64 + fr, fq * 8), boff = lds_byte(wc * 32 + fr, fq * 8);
#define PG8_SA(b, h) (((b) * 2 + (h)) * HTB)
#define PG8_SB(b, h) ((4 + (b) * 2 + (h)) * HTB)
#define PG8_STAGE(bufoff, gbase, voff) do { _Pragma("unroll") for (int _i = 0; _i < 2; ++_i) \
        __builtin_amdgcn_global_load_lds((const unsigned*)((const char*)(gbase) + (voff)[_i]), (LAS unsigned*)(lds + (bufoff) + ldsw + _i * 8192), 16, 0, 0); } while (0)
#define PG8_LDA(dst, b, h) do { _Pragma("unroll") for (int m = 0; m < 4; ++m) _Pragma("unroll") for (int k = 0; k < 2; ++k) dst[m][k] = *(const LAS bf16x8*)(lds + PG8_SA(b, h) + aoff + m * 2048 + k * 1024); } while (0)
#define PG8_LDB(dst, b, h) do { _Pragma("unroll") for (int n = 0; n < 2; ++n) _Pragma("unroll") for (int k = 0; k < 2; ++k) dst[n][k] = *(const LAS bf16x8*)(lds + PG8_SB(b, h) + boff + n * 2048 + k * 1024); } while (0)
#define PG8_MMA(ai, bj, At, Bt) do { __builtin_amdgcn_s_setprio(1); _Pragma("unroll") for (int m = 0; m < 4; ++m) _Pragma("unroll") for (int n = 0; n < 2; ++n) _Pragma("unroll") for (int k = 0; k < 2; ++k) \
        acc[ai][bj][m][n] = __builtin_amdgcn_mfma_f32_16x16x32_bf16(Bt[n][k], At[m][k], acc[ai][bj][m][n], 0, 0, 0); __builtin_amdgcn_s_setprio(0); } while (0)
#define PG8_WAIT_V(n) asm volatile("s_waitcnt vmcnt(" #n ")" ::: "memory")
#define PG8_WAIT_L(n) asm volatile("s_waitcnt lgkmcnt(" #n ")" ::: "memory")
#define PG8_BAR __builtin_amdgcn_s_barrier()
#define PG8_SCHED __builtin_amdgcn_sched_barrier(0)
    Unit cur, nxt; int ui = 0;
    if (!S.next(0, cur)) return;
    f32x4 acc[2][2][4][2];
#pragma unroll
    for (int a = 0; a < 2; ++a)
#pragma unroll
        for (int b = 0; b < 2; ++b)
#pragma unroll
            for (int m = 0; m < 4; ++m)
#pragma unroll
                for (int n = 0; n < 2; ++n) acc[a][b][m][n] = (f32x4){0.f, 0.f, 0.f, 0.f};
    bf16x8 At[4][2], B0[2][2], B1[2][2];
    unsigned gC0[2], gC1[2], gN0[2], gN1[2];
    if constexpr (GATHER) {
#pragma unroll
        for (int i = 0; i < 2; ++i) { gC0[i] = (unsigned)S.a_row(cur, Rv[i]) * (unsigned)(K * 2) + (unsigned)Cv[i] * 2u; gC1[i] = (unsigned)S.a_row(cur, HALF + Rv[i]) * (unsigned)(K * 2) + (unsigned)Cv[i] * 2u; gN0[i] = gC0[i]; gN1[i] = gC1[i]; }
    }
    const char* cA = GATHER ? (const char*)g.A : (const char*)g.A + (size_t)cur.pm * tstep; const char* cB = (const char*)g.Bt + (size_t)cur.pb * tstep;
#define PG8_STAGE_A(bufoff, p, h, o0, o1) do { if constexpr (GATHER) { if ((h) == 0) PG8_STAGE(bufoff, p, o0); else PG8_STAGE(bufoff, p, o1); } else { PG8_STAGE(bufoff, (p) + (h) * hstep, voffA); } } while (0)
    PG8_STAGE(PG8_SB(0, 0), cB, voffB); PG8_STAGE(PG8_SB(0, 1), cB + hstep, voffB); PG8_STAGE_A(PG8_SA(0, 0), cA, 0, gC0, gC1); PG8_STAGE_A(PG8_SA(0, 1), cA, 1, gC0, gC1);
    if (wr == 1) PG8_BAR;
    PG8_WAIT_V(2); PG8_BAR;
    PG8_STAGE(PG8_SB(1, 0), cB + kstep, voffB); PG8_STAGE_A(PG8_SA(1, 0), cA + kstep, 0, gC0, gC1); PG8_STAGE(PG8_SB(1, 1), cB + hstep + kstep, voffB);
    PG8_WAIT_V(6); PG8_BAR;
    for (;;) {
        const bool has_next = S.next(ui + 1, nxt);
        const char* nA = GATHER ? (const char*)g.A : (has_next ? (const char*)g.A + (size_t)nxt.pm * tstep : cA); const char* nB = has_next ? (const char*)g.Bt + (size_t)nxt.pb * tstep : cB;
        if constexpr (GATHER) { if (has_next) {
#pragma unroll
            for (int i = 0; i < 2; ++i) { gN0[i] = (unsigned)S.a_row(nxt, Rv[i]) * (unsigned)(K * 2) + (unsigned)Cv[i] * 2u; gN1[i] = (unsigned)S.a_row(nxt, HALF + Rv[i]) * (unsigned)(K * 2) + (unsigned)Cv[i] * 2u; } } }
        for (int t = 0; t < nt; t += 2) {
            const bool last = (t == nt - 2);
            const char* a1 = cA + (size_t)(t + 1) * kstep;
            const char* a2 = last ? nA : cA + (size_t)(t + 2) * kstep; const char* b2 = last ? nB : cB + (size_t)(t + 2) * kstep;
            const char* a3 = a2 + kstep; const char* b3 = b2 + kstep;
            unsigned s0[2], s1[2];
            if constexpr (GATHER) { s0[0] = last ? gN0[0] : gC0[0]; s0[1] = last ? gN0[1] : gC0[1]; s1[0] = last ? gN1[0] : gC1[0]; s1[1] = last ? gN1[1] : gC1[1]; }
            PG8_LDB(B0, 0, 0); PG8_LDB(B1, 0, 1); PG8_SCHED; PG8_LDA(At, 0, 0); PG8_STAGE_A(PG8_SA(1, 1), a1, 1, gC0, gC1);
            PG8_WAIT_V(8); PG8_WAIT_L(0); PG8_BAR; PG8_MMA(0, 0, At, B0); PG8_MMA(0, 1, At, B1); PG8_BAR; PG8_SCHED;
            PG8_LDA(At, 0, 1); PG8_STAGE(PG8_SB(0, 0), b2, voffB); PG8_STAGE(PG8_SB(0, 1), b2 + hstep, voffB); PG8_STAGE_A(PG8_SA(0, 0), a2, 0, s0, s1);
            PG8_WAIT_V(8); PG8_WAIT_L(0); PG8_BAR; PG8_MMA(1, 0, At, B0); PG8_MMA(1, 1, At, B1); PG8_BAR; PG8_SCHED;
            PG8_LDB(B0, 1, 0); PG8_LDB(B1, 1, 1); PG8_SCHED; PG8_LDA(At, 1, 0); PG8_STAGE_A(PG8_SA(0, 1), a2, 1, s0, s1);
            PG8_WAIT_V(8); PG8_WAIT_L(0); PG8_BAR; PG8_MMA(0, 0, At, B0); PG8_MMA(0, 1, At, B1); PG8_BAR; PG8_SCHED;
            PG8_LDA(At, 1, 1); PG8_STAGE(PG8_SB(1, 0), b3, voffB); PG8_STAGE(PG8_SB(1, 1), b3 + hstep, voffB); PG8_STAGE_A(PG8_SA(1, 0), a3, 0, s0, s1);
            PG8_WAIT_V(8); PG8_WAIT_L(0); PG8_BAR; PG8_MMA(1, 0, At, B0); PG8_MMA(1, 1, At, B1); PG8_BAR; PG8_SCHED;
        }
        if constexpr (ALIGN_EPI) { if (wr == 0) PG8_BAR; }
        E(acc, cur, wr, wc, fr, fq);
        if (!has_next) break;
#pragma unroll
        for (int a = 0; a < 2; ++a)
#pragma unroll
            for (int b = 0; b < 2; ++b)
#pragma unroll
                for (int m = 0; m < 4; ++m)
#pragma unroll
                    for (int n = 0; n < 2; ++n) acc[a][b][m][n] = (f32x4){0.f, 0.f, 0.f, 0.f};
        cur = nxt; cA = nA; cB = nB; ++ui;
        if constexpr (GATHER) { gC0[0] = gN0[0]; gC0[1] = gN0[1]; gC1[0] = gN1[0]; gC1[1] = gN1[1]; }
        if constexpr (ALIGN_EPI) { if (wr == 1) PG8_BAR; }
    }
    PG8_WAIT_V(0);
    if constexpr (!ALIGN_EPI) { if (wr == 0) PG8_BAR; }
    PG8_BAR;
#undef PG8_SA
#undef PG8_SB
#undef PG8_STAGE
#undef PG8_STAGE_A
#undef PG8_LDA
#undef PG8_LDB
#undef PG8_MMA
#undef PG8_WAIT_V
#undef PG8_WAIT_L
#undef PG8_BAR
#undef PG8_SCHED
}

template <class Epi, class Sched>
__device__ __forceinline__ void gemm_phase_f8n(LAS unsigned char* lds, const Gemm g, const Sched& S, const Epi& E) {
    const int tid = threadIdx.x, wid = __builtin_amdgcn_readfirstlane(tid >> 6), lane = tid & 63, wr = wid >> 2, wc = wid & 3, fr = lane & 15, fq = lane >> 4;
    const int K = g.K, nt = K / BK;
    unsigned voffA[2], voffB[2];
#pragma unroll
    for (int i = 0; i < 2; ++i) { int R, C; stage_rc(tid * 16 + i * 8192, R, C); const int Rb = (R & ~31) + perm32(R & 31);
        voffA[i] = (unsigned)(R * K + C) * 2u; voffB[i] = (unsigned)(Rb * K + C) * 2u; }
    const size_t kstep = (size_t)(BK * 2), hstep = (size_t)HALF * K * 2, tstep = 2 * hstep;
    const unsigned ldsw = (unsigned)wid * 1024u;
    const int aoff = lds_byte(wr * 64 + fr, fq * 8), boff = lds_byte(wc * 32 + fr, fq * 8);
    typedef int v8i_t __attribute__((ext_vector_type(8))); typedef int v4i_t __attribute__((ext_vector_type(4)));
#define F8_SA(b, h) (((b) * 2 + (h)) * HTB)
#define F8_SB(b) ((4 + (b) * 2) * HTB)
#define F8_STAGE(bufoff, gbase, voff) do { _Pragma("unroll") for (int _i = 0; _i < 2; ++_i) \
        __builtin_amdgcn_global_load_lds((const unsigned*)((const char*)(gbase) + (voff)[_i]), (LAS unsigned*)(lds + (bufoff) + ldsw + _i * 8192), 16, 0, 0); } while (0)
#define F8_LDA(b, h) do { _Pragma("unroll") for (int m = 0; m < 4; ++m) _Pragma("unroll") for (int k = 0; k < 2; ++k) At[m][k] = *(const LAS bf16x8*)(lds + F8_SA(b, h) + aoff + m * 2048 + k * 1024); } while (0)
#define F8_LDB(b) do { _Pragma("unroll") for (int n = 0; n < 2; ++n) _Pragma("unroll") for (int k = 0; k < 2; ++k) B0[n][k] = *(const LAS bf16x8*)(lds + F8_SB(b) + boff + n * 2048 + k * 1024); } while (0)
#define F8_CAT(x0, x1) __builtin_shufflevector(__builtin_bit_cast(v4i_t, x0), __builtin_bit_cast(v4i_t, x1), 0, 1, 2, 3, 4, 5, 6, 7)
#define F8_MMA(ai) do { __builtin_amdgcn_s_setprio(1); _Pragma("unroll") for (int m = 0; m < 4; ++m) _Pragma("unroll") for (int n = 0; n < 2; ++n) \
        acc[ai][m][n] = __builtin_amdgcn_mfma_scale_f32_16x16x128_f8f6f4(F8_CAT(B0[n][0], B0[n][1]), F8_CAT(At[m][0], At[m][1]), acc[ai][m][n], 0, 0, 0, 0x79797979, 0, 0x7f7f7f7f); \
        __builtin_amdgcn_s_setprio(0); } while (0)
#define F8_WAIT_V(n) asm volatile("s_waitcnt vmcnt(" #n ")" ::: "memory")
#define F8_WAIT_L(n) asm volatile("s_waitcnt lgkmcnt(" #n ")" ::: "memory")
#define F8_BAR __builtin_amdgcn_s_barrier()
#define F8_SCHED __builtin_amdgcn_sched_barrier(0)
    Unit cur, nxt; int ui = 0;
    if (!S.next(0, cur)) return;
    f32x4 acc[2][4][2];
#pragma unroll
    for (int a = 0; a < 2; ++a)
#pragma unroll
        for (int m = 0; m < 4; ++m)
#pragma unroll
            for (int n = 0; n < 2; ++n) acc[a][m][n] = (f32x4){0.f, 0.f, 0.f, 0.f};
    bf16x8 At[4][2], B0[2][2];
    const char* cA = (const char*)g.A + (size_t)cur.pm * tstep; const char* cB = (const char*)g.Bt + (size_t)cur.pb * hstep;
    F8_STAGE(F8_SB(0), cB, voffB); F8_STAGE(F8_SA(0, 0), cA, voffA); F8_STAGE(F8_SA(0, 1), cA + hstep, voffA);
    if (wr == 1) F8_BAR;
    F8_WAIT_V(2); F8_BAR;
    F8_STAGE(F8_SB(1), cB + kstep, voffB); F8_STAGE(F8_SA(1, 0), cA + kstep, voffA);
    F8_WAIT_V(4); F8_BAR;
    for (;;) {
        const bool has_next = S.next(ui + 1, nxt);
        const char* nA = has_next ? (const char*)g.A + (size_t)nxt.pm * tstep : cA; const char* nB = has_next ? (const char*)g.Bt + (size_t)nxt.pb * hstep : cB;
#pragma unroll 1
        for (int t = 0; t < nt; t += 2) {
            const bool last = (t == nt - 2);
            const char* a1 = cA + (size_t)(t + 1) * kstep;
            const char* a2 = last ? nA : cA + (size_t)(t + 2) * kstep; const char* b2 = last ? nB : cB + (size_t)(t + 2) * kstep;
            const char* a3 = a2 + kstep; const char* b3 = b2 + kstep;
            F8_LDB(0); F8_SCHED; F8_LDA(0, 0); F8_STAGE(F8_SA(1, 1), a1 + hstep, voffA);
            F8_WAIT_V(6); F8_WAIT_L(0); F8_BAR; F8_MMA(0); F8_BAR; F8_SCHED;
            F8_LDA(0, 1); F8_STAGE(F8_SB(0), b2, voffB); F8_STAGE(F8_SA(0, 0), a2, voffA);
            F8_WAIT_V(6); F8_WAIT_L(0); F8_BAR; F8_MMA(1); F8_BAR; F8_SCHED;
            F8_LDB(1); F8_SCHED; F8_LDA(1, 0); F8_STAGE(F8_SA(0, 1), a2 + hstep, voffA);
            F8_WAIT_V(6); F8_WAIT_L(0); F8_BAR; F8_MMA(0); F8_BAR; F8_SCHED;
            F8_LDA(1, 1); F8_STAGE(F8_SB(1), b3, voffB); F8_STAGE(F8_SA(1, 0), a3, voffA);
            F8_WAIT_V(6); F8_WAIT_L(0); F8_BAR; F8_MMA(1); F8_BAR; F8_SCHED;
        }
        if (wr == 0) F8_BAR;
        E(acc, cur, wr, wc, fr, fq);
        if (!has_next) break;
#pragma unroll
        for (int a = 0; a < 2; ++a)
#pragma unroll
            for (int m = 0; m < 4; ++m)
#pragma unroll
                for (int n = 0; n < 2; ++n) acc[a][m][n] = (f32x4){0.f, 0.f, 0.f, 0.f};
        cur = nxt; cA = nA; cB = nB; ++ui;
        if (wr == 1) F8_BAR;
    }
    F8_WAIT_V(0);
    F8_BAR;
#undef F8_SA
#undef F8_SB
#undef F8_STAGE
#undef F8_LDA
#undef F8_LDB
#undef F8_CAT
#undef F8_MMA
#undef F8_WAIT_V
#undef F8_WAIT_L
#undef F8_BAR
#undef F8_SCHED
}

__device__ __forceinline__ u32x4 pack8(const f32x4& v0, const f32x4& v1) { u32x4 w; w.x = cvt_pk_bf16(v0[0], v0[1]); w.y = cvt_pk_bf16(v0[2], v0[3]); w.z = cvt_pk_bf16(v1[0], v1[1]); w.w = cvt_pk_bf16(v1[2], v1[3]); return w; }
__device__ __forceinline__ void rope4(f32x4& v0, f32x4& v1, const float* cs) {
    const f32x4 a = *(const f32x4*)cs, b = *(const f32x4*)(cs + 4);
    float x1, x2;
    x1 = v0[0]; x2 = v0[1]; v0[0] = x1 * a[0] - x2 * a[1]; v0[1] = x2 * a[0] + x1 * a[1];
    x1 = v0[2]; x2 = v0[3]; v0[2] = x1 * a[2] - x2 * a[3]; v0[3] = x2 * a[2] + x1 * a[3];
    x1 = v1[0]; x2 = v1[1]; v1[0] = x1 * b[0] - x2 * b[1]; v1[1] = x2 * b[0] + x1 * b[1];
    x1 = v1[2]; x2 = v1[3]; v1[2] = x1 * b[2] - x2 * b[3]; v1[3] = x2 * b[2] + x1 * b[3];
}

struct EpiIn {
    static constexpr bool PERM = true;
    bf16_t *qa, *ka, *va, *cq, *ckv, *gates, *kr; const float *ropeA, *ropeM, *bg; float* sq;
    __device__ __forceinline__ void operator()(const f32x4 (&acc)[2][2][4][2], const Unit& u, int wr, int wc, int fr, int fq) const {
        const int pn = u.pn, row0 = u.pm * BM + wr * 64 + fr, cl = wc * 32 + 8 * fq;
        if (pn < 8) {
            bf16_t* dst = pn < 4 ? qa : ka; const int colt = (pn & 3) * 256; const bool rot = ((wc & 1) == 0) && (fq < 2);
#pragma unroll
            for (int ai = 0; ai < 2; ++ai)
#pragma unroll
                for (int m = 0; m < 4; ++m) { const int row = row0 + ai * HALF + m * 16;
#pragma unroll
                    for (int bj = 0; bj < 2; ++bj) { f32x4 v0 = acc[ai][bj][m][0], v1 = acc[ai][bj][m][1];
                        if (rot) rope4(v0, v1, ropeA + (size_t)row * 16 + fq * 8);
                        *(u32x4*)(dst + (size_t)row * 1024 + colt + bj * HALF + cl) = pack8(v0, v1); } }
        } else if (pn < 12) {
            const int colt = (pn - 8) * 256;
#pragma unroll
            for (int ai = 0; ai < 2; ++ai)
#pragma unroll
                for (int m = 0; m < 4; ++m) { const int row = row0 + ai * HALF + m * 16;
#pragma unroll
                    for (int bj = 0; bj < 2; ++bj) *(u32x4*)(va + (size_t)row * 1024 + colt + bj * HALF + cl) = pack8(acc[ai][bj][m][0], acc[ai][bj][m][1]); }
        } else if (pn < 17) {
            const bool isq = pn < 15; bf16_t* dst = isq ? cq : ckv; const int ld = isq ? QL : KVL, colt = (isq ? pn - 12 : pn - 15) * 256, tq = pn - 12;
#pragma unroll
            for (int ai = 0; ai < 2; ++ai)
#pragma unroll
                for (int m = 0; m < 4; ++m) { const int row = row0 + ai * HALF + m * 16; float s = 0.f;
#pragma unroll
                    for (int bj = 0; bj < 2; ++bj) { const f32x4 v0 = acc[ai][bj][m][0], v1 = acc[ai][bj][m][1];
                        s += (v0[0] * v0[0] + v0[1] * v0[1]) + (v0[2] * v0[2] + v0[3] * v0[3]) + (v1[0] * v1[0] + v1[1] * v1[1]) + (v1[2] * v1[2] + v1[3] * v1[3]);
                        *(u32x4*)(dst + (size_t)row * ld + colt + bj * HALF + cl) = pack8(v0, v1); }
                    s += __shfl_xor(s, 16); s += __shfl_xor(s, 32);
                    if (fq == 0) sq[(size_t)row * 20 + tq * 4 + wc] = s; }
        } else if (pn != 23) {
            const int colt = (pn < 23 ? pn - 17 : pn - 18) * 256;
            f32x4 bv[2][2];
#pragma unroll
            for (int bj = 0; bj < 2; ++bj) { bv[bj][0] = *(const f32x4*)(bg + colt + bj * HALF + cl); bv[bj][1] = *(const f32x4*)(bg + colt + bj * HALF + cl + 4); if (DBG_SKIP & 256) { bv[bj][0] = bv[bj][0] * 0.f; bv[bj][1] = bv[bj][1] * 0.f; } }
#pragma unroll
            for (int ai = 0; ai < 2; ++ai)
#pragma unroll
                for (int m = 0; m < 4; ++m) { const int row = row0 + ai * HALF + m * 16;
#pragma unroll
                    for (int bj = 0; bj < 2; ++bj) { f32x4 v0 = acc[ai][bj][m][0] + bv[bj][0], v1 = acc[ai][bj][m][1] + bv[bj][1];
#pragma unroll
                        for (int j = 0; j < 4; ++j) { if (!(DBG_SKIP & 512)) { v0[j] = sigmoidf_(v0[j]); v1[j] = sigmoidf_(v1[j]); } }
                        *(u32x4*)(gates + (size_t)row * 2048 + colt + bj * HALF + cl) = pack8(v0, v1); } }
        } else {
            if (wc < 2) {
#pragma unroll
                for (int ai = 0; ai < 2; ++ai)
#pragma unroll
                    for (int m = 0; m < 4; ++m) { const int row = row0 + ai * HALF + m * 16;
                        f32x4 v0 = acc[ai][0][m][0], v1 = acc[ai][0][m][1];
                        rope4(v0, v1, ropeM + (size_t)row * 64 + (wc * 16 + fq * 4) * 2);
                        *(u32x4*)(kr + (size_t)row * 64 + cl) = pack8(v0, v1); }
            }
        }
    }
};
template <bool ISQ> struct EpiUp {
    static constexpr bool PERM = true;
    bf16_t* out; const float* sq; const float* ropeM;
    __device__ __forceinline__ void operator()(const f32x4 (&acc)[2][2][4][2], const Unit& u, int wr, int wc, int fr, int fq) const {
        const int row0 = u.pm * BM + wr * 64 + fr, cl = wc * 32 + 8 * fq; constexpr int LD = ISQ ? 1536 : 2048;
#pragma unroll
        for (int ai = 0; ai < 2; ++ai)
#pragma unroll
            for (int m = 0; m < 4; ++m) { const int row = row0 + ai * HALF + m * 16; float s;
                if (ISQ) { const f32x4 a = *(const f32x4*)(sq + (size_t)row * 20), b = *(const f32x4*)(sq + (size_t)row * 20 + 4), c = *(const f32x4*)(sq + (size_t)row * 20 + 8);
                    s = ((a[0] + a[1]) + (a[2] + a[3])) + ((b[0] + b[1]) + (b[2] + b[3])) + ((c[0] + c[1]) + (c[2] + c[3])); }
                else { const f32x4 a = *(const f32x4*)(sq + (size_t)row * 20 + 12), b = *(const f32x4*)(sq + (size_t)row * 20 + 16);
                    s = ((a[0] + a[1]) + (a[2] + a[3])) + ((b[0] + b[1]) + (b[2] + b[3])); }
                const float rstd = __builtin_amdgcn_rsqf(s * (ISQ ? 1.0f / QL : 1.0f / KVL) + EPS);
#pragma unroll
                for (int bj = 0; bj < 2; ++bj) { const int col = u.pn * BM + bj * HALF + cl; f32x4 v0 = acc[ai][bj][m][0] * rstd, v1 = acc[ai][bj][m][1] * rstd;
                    if (ISQ) { const int off = col % 192; if (off >= 128) rope4(v0, v1, ropeM + (size_t)row * 64 + (off - 128)); }
                    *(u32x4*)(out + (size_t)row * LD + col) = pack8(v0, v1); } }
    }
};
template <int WHICH> struct EpiGate {
    static constexpr bool PERM = true;
    bf16_t* mrg; const bf16_t* gates;
    __device__ __forceinline__ void operator()(const f32x4 (&acc)[2][2][4][2], const Unit& u, int wr, int wc, int fr, int fq) const {
        const int row0 = u.pm * BM + wr * 64 + fr, cl = wc * 32 + 8 * fq;
#pragma unroll
        for (int ai = 0; ai < 2; ++ai)
#pragma unroll
            for (int m = 0; m < 4; ++m) { const int row = row0 + ai * HALF + m * 16;
#pragma unroll
                for (int bj = 0; bj < 2; ++bj) { const int col = u.pn * BM + bj * HALF + cl;
                    const u32x4 gw = *(const u32x4*)(gates + (size_t)row * 2048 + WHICH * 1024 + col);
                    f32x4 v0 = acc[ai][bj][m][0], v1 = acc[ai][bj][m][1];
                    if ((DBG_SKIP & 8) && WHICH == 0) { v0 = v0 * 0.f; v1 = v1 * 0.f; } if ((DBG_SKIP & 16) && WHICH == 1) { v0 = v0 * 0.f; v1 = v1 * 0.f; }
                    v0[0] *= bf_lo(gw.x); v0[1] *= bf_hi(gw.x); v0[2] *= bf_lo(gw.y); v0[3] *= bf_hi(gw.y); v1[0] *= bf_lo(gw.z); v1[1] *= bf_hi(gw.z); v1[2] *= bf_lo(gw.w); v1[3] *= bf_hi(gw.w);
                    if (WHICH == 1) { const u32x4 tw = *(const u32x4*)(mrg + (size_t)row * 1024 + col);
                        v0[0] += bf_lo(tw.x); v0[1] += bf_hi(tw.x); v0[2] += bf_lo(tw.y); v0[3] += bf_hi(tw.y); v1[0] += bf_lo(tw.z); v1[1] += bf_hi(tw.z); v1[2] += bf_lo(tw.w); v1[3] += bf_hi(tw.w); }
                    *(u32x4*)(mrg + (size_t)row * 1024 + col) = pack8(v0, v1); } }
    }
};
struct EpiRes {
    static constexpr bool PERM = false;
    const float* x; float* out;
    __device__ __forceinline__ void operator()(const f32x4 (&acc)[2][2][4][2], const Unit& u, int wr, int wc, int fr, int fq) const {
        const int row0 = u.pm * BM + wr * 64 + fr, col0 = u.pn * BM + wc * 32 + 4 * fq;
#pragma unroll
        for (int ai = 0; ai < 2; ++ai)
#pragma unroll
            for (int m = 0; m < 4; ++m) { const size_t off = (size_t)(row0 + ai * HALF + m * 16) * 1024 + col0;
#pragma unroll
                for (int bj = 0; bj < 2; ++bj)
#pragma unroll
                    for (int n = 0; n < 2; ++n) *(f32x4*)(out + off + bj * HALF + n * 16) = *(const f32x4*)(x + off + bj * HALF + n * 16) + ((DBG_SKIP & 2) ? 0.f : 1.f) * acc[ai][bj][m][n]; }
    }
};
struct EpiSwiglu {
    static constexpr bool PERM = true;
    bf16_t* act; const float *bgate, *bup;
    __device__ __forceinline__ void operator()(const f32x4 (&acc)[2][2][4][2], const Unit& u, int wr, int wc, int fr, int fq) const {
        const int row0 = u.pm * BM + wr * 64 + fr, f0 = u.pn * HALF + wc * 32 + 8 * fq;
        f32x4 bgv[2], buv[2];
#pragma unroll
        for (int n = 0; n < 2; ++n) { bgv[n] = *(const f32x4*)(bgate + (size_t)u.e * FF + f0 + 4 * n); buv[n] = *(const f32x4*)(bup + (size_t)u.e * FF + f0 + 4 * n); }
#pragma unroll
        for (int ai = 0; ai < 2; ++ai)
#pragma unroll
            for (int m = 0; m < 4; ++m) { const int row = row0 + ai * HALF + m * 16; f32x4 o[2];
#pragma unroll
                for (int n = 0; n < 2; ++n) { const f32x4 gt = acc[ai][0][m][n] + bgv[n], up = acc[ai][1][m][n] + buv[n];
#pragma unroll
                    for (int j = 0; j < 4; ++j) { const float gg = fminf(gt[j], 7.0f), uu = fminf(fmaxf(up[j], -7.0f), 7.0f); o[n][j] = (uu + 1.0f) * (gg * sigmoidf_(1.702f * gg)); } }
                u32x2 w8; w8.x = cvt_pk_fp8x4(o[0][0], o[0][1], o[0][2], o[0][3]); w8.y = cvt_pk_fp8x4(o[1][0], o[1][1], o[1][2], o[1][3]);
                *(u32x2*)((unsigned char*)act + (size_t)row * FF + f0) = w8; }
    }
};
struct EpiDown {
    static constexpr bool PERM = true;
    bf16_t* y; const float* bd;
    __device__ __forceinline__ void operator()(const f32x4 (&acc)[2][2][4][2], const Unit& u, int wr, int wc, int fr, int fq) const {
        const int row0 = u.pm * BM + wr * 64 + fr, cl = wc * 32 + 8 * fq;
        f32x4 bv[2][2];
#pragma unroll
        for (int bj = 0; bj < 2; ++bj) { const int col = u.pn * BM + bj * HALF + cl; bv[bj][0] = *(const f32x4*)(bd + (size_t)u.e * D + col); bv[bj][1] = *(const f32x4*)(bd + (size_t)u.e * D + col + 4); }
#pragma unroll
        for (int ai = 0; ai < 2; ++ai)
#pragma unroll
            for (int m = 0; m < 4; ++m) { const int row = row0 + ai * HALF + m * 16;
#pragma unroll
                for (int bj = 0; bj < 2; ++bj) { const int col = u.pn * BM + bj * HALF + cl;
                    *(u32x4*)(y + (size_t)row * D + col) = pack8(acc[ai][bj][m][0] + bv[bj][0], acc[ai][bj][m][1] + bv[bj][1]); } }
    }
};
struct EpiDown8 {
    bf16_t* y; const float* bd;
    __device__ __forceinline__ void operator()(const f32x4 (&acc)[2][4][2], const Unit& u, int wr, int wc, int fr, int fq) const {
        const int row0 = u.pm * BM + wr * 64 + fr, col = u.pn * HALF + wc * 32 + 8 * fq;
        const f32x4 bv0 = *(const f32x4*)(bd + (size_t)u.e * D + col), bv1 = *(const f32x4*)(bd + (size_t)u.e * D + col + 4);
#pragma unroll
        for (int ai = 0; ai < 2; ++ai)
#pragma unroll
            for (int m = 0; m < 4; ++m) { const int row = row0 + ai * HALF + m * 16;
                *(u32x4*)(y + (size_t)row * D + col) = pack8(acc[ai][m][0] + bv0, acc[ai][m][1] + bv1); }
    }
};
}

namespace att {
constexpr int NW = 8, QBLK = 32, KVBLK = 64;
constexpr int SHM_V = KVBLK * 128 * 2;
#define SBAR() __builtin_amdgcn_sched_barrier(0)
#define KSW(row, colB) ((row) * 128 + ((colB) ^ ((((row) >> 1) & 7) << 4)))
__device__ __forceinline__ int crow(int r, int hi) { return (r & 3) + 8 * (r >> 2) + 4 * hi; }
struct Src { const bf16_t* Q; const bf16_t* K; const bf16_t* K2; const bf16_t* V; int ldq, ldk, ldk2, ldv; };

__device__ __forceinline__ void partialSM(f32x16& p0, f32x16& p1, float& m_reg, float& mn, float& alpha, const float C, const float thr) {
  float pmax;
  { float a0 = fmaxf(fmaxf(p0[0], p0[1]), p0[2]), a1 = fmaxf(fmaxf(p0[3], p0[4]), p0[5]), a2 = fmaxf(fmaxf(p1[0], p1[1]), p1[2]), a3 = fmaxf(fmaxf(p1[3], p1[4]), p1[5]);
#pragma unroll
    for (int r = 6; r < 16; r += 2) { a0 = fmaxf(fmaxf(a0, p0[r]), p0[r + 1]); a2 = fmaxf(fmaxf(a2, p1[r]), p1[r + 1]); }
    pmax = fmaxf(fmaxf(a0, a1), fmaxf(a2, a3)); }
  { auto rr = __builtin_amdgcn_permlane32_swap(__float_as_uint(pmax), __float_as_uint(pmax), false, false);
    pmax = fmaxf(__uint_as_float(rr[0]), __uint_as_float(rr[1])); }
  if (__builtin_expect(__all(pmax - m_reg <= thr), 1)) { mn = m_reg; alpha = 1.f; }
  else { mn = fmaxf(m_reg, pmax); alpha = __builtin_amdgcn_exp2f((m_reg - mn) * C); m_reg = mn; }
  const float mnC = -mn * C;
#pragma unroll
  for (int r = 0; r < 16; ++r) p0[r] = fmaf(p0[r], C, mnC);
#pragma unroll
  for (int r = 0; r < 16; ++r) p1[r] = fmaf(p1[r], C, mnC);
#pragma unroll
  for (int r = 0; r < 16; ++r) p0[r] = __builtin_amdgcn_exp2f(p0[r]);
#if ATT_DUP == 1
  { float d_[16];
#pragma unroll
    for (int r = 0; r < 16; ++r) { d_[r] = __builtin_amdgcn_exp2f(p1[r]); d_[r] = fmaf(d_[r], C, mnC); }
#pragma unroll
    for (int r = 0; r < 16; ++r) asm volatile("" :: "v"(d_[r])); }
#endif
}
__device__ __forceinline__ void finishSM(f32x16& p0, f32x16& p1, float alpha, float& l_reg, bf16x8& pa0, bf16x8& pa1, bf16x8& pa2, bf16x8& pa3) {
#pragma unroll
  for (int r = 0; r < 16; ++r) p1[r] = __builtin_amdgcn_exp2f(p1[r]);
  float ps;
  { float s0 = p0[0] + p0[1], s1 = p0[2] + p0[3], s2 = p1[0] + p1[1], s3 = p1[2] + p1[3];
#pragma unroll
    for (int r = 4; r < 16; r += 4) { s0 += p0[r] + p0[r + 1]; s1 += p0[r + 2] + p0[r + 3]; s2 += p1[r] + p1[r + 1]; s3 += p1[r + 2] + p1[r + 3]; }
    ps = (s0 + s1) + (s2 + s3); }
  { auto rr = __builtin_amdgcn_permlane32_swap(__float_as_uint(ps), __float_as_uint(ps), false, false);
    ps = __uint_as_float(rr[0]) + __uint_as_float(rr[1]); }
  l_reg = l_reg * alpha + ps;
#define PK4(P, BASE, OUT) do { unsigned a0 = cvt_pk_bf16(P[BASE + 0], P[BASE + 1]), a1 = cvt_pk_bf16(P[BASE + 2], P[BASE + 3]);   \
    unsigned b0 = cvt_pk_bf16(P[BASE + 4], P[BASE + 5]), b1 = cvt_pk_bf16(P[BASE + 6], P[BASE + 7]);                              \
    auto r0 = __builtin_amdgcn_permlane32_swap(a0, b0, false, false); auto r1 = __builtin_amdgcn_permlane32_swap(a1, b1, false, false); \
    u32x4 w = {r0[0], r1[0], r0[1], r1[1]}; OUT = *reinterpret_cast<bf16x8*>(&w); } while (0)
  PK4(p0, 0, pa0); PK4(p0, 8, pa1); PK4(p1, 0, pa2); PK4(p1, 8, pa3);
#undef PK4
}
template <int DQK> __device__ __forceinline__ void qkt(f32x16& p0, f32x16& p1, const LAS char* Ks, const bf16x8* qr, int r32, int hi) {
  p0 = f32x16{}; p1 = f32x16{};
#pragma unroll
  for (int d0 = 0; d0 < DQK / 16; d0 += 2) {
    bf16x8 kf[2][2];
#pragma unroll
    for (int d = 0; d < 2; ++d) { const int sub = (d0 + d) >> 2, cb = (((d0 + d) & 3) * 16 + hi * 8) * 2;
      kf[d][0] = *(const LAS bf16x8*)(Ks + sub * 8192 + KSW(r32, cb)); kf[d][1] = *(const LAS bf16x8*)(Ks + sub * 8192 + KSW(32 + r32, cb)); }
    SBAR();
#pragma unroll
    for (int d = 0; d < 2; ++d) {
      p0 = __builtin_amdgcn_mfma_f32_32x32x16_bf16(kf[d][0], qr[d0 + d], p0, 0, 0, 0);
      p1 = __builtin_amdgcn_mfma_f32_32x32x16_bf16(kf[d][1], qr[d0 + d], p1, 0, 0, 0); }
  }
}
__device__ __forceinline__ int v_st(int k, int c) { const int kk = (k & ~0xC) | ((k & 4) << 1) | ((k & 8) >> 1); return ((kk >> 3) * 4 + (c >> 5)) * 512 + ((kk & 7) * 32 + (c & 31)) * 2; }
__device__ __forceinline__ int v_rd_base(int lane) { return ((lane & 3) << 3) | (((lane >> 2) & 3) << 6) | (((lane >> 4) & 1) << 5) | (((lane >> 5) & 1) << 8); }
constexpr int v_rd_off(int d0, int ks, int half) { return d0 * 512 + ks * 4096 + half * 2048; }
template <int OFF> __device__ __forceinline__ s16x4 tr_read(int vb) {
  s16x4 r; asm volatile("ds_read_b64_tr_b16 %0, %1 offset:%2" : "=&v"(r) : "v"(vb), "i"(OFF) : "memory"); return r;
}
template <int KS> __device__ __forceinline__ void pv_step(f32x16* o, int vb, bf16x8 pa) {
  s16x4 l0, h0, l1, h1, l2, h2, l3, h3;
  l0 = tr_read<v_rd_off(0, KS, 0)>(vb); h0 = tr_read<v_rd_off(0, KS, 1)>(vb); l1 = tr_read<v_rd_off(1, KS, 0)>(vb); h1 = tr_read<v_rd_off(1, KS, 1)>(vb);
  l2 = tr_read<v_rd_off(2, KS, 0)>(vb); h2 = tr_read<v_rd_off(2, KS, 1)>(vb); l3 = tr_read<v_rd_off(3, KS, 0)>(vb); h3 = tr_read<v_rd_off(3, KS, 1)>(vb);
  asm volatile("s_waitcnt lgkmcnt(0)" ::: "memory"); SBAR();
#define PK(L, H) (bf16x8){L[0], L[1], L[2], L[3], H[0], H[1], H[2], H[3]}
  o[0] = __builtin_amdgcn_mfma_f32_32x32x16_bf16(pa, PK(l0, h0), o[0], 0, 0, 0);
  o[1] = __builtin_amdgcn_mfma_f32_32x32x16_bf16(pa, PK(l1, h1), o[1], 0, 0, 0);
  o[2] = __builtin_amdgcn_mfma_f32_32x32x16_bf16(pa, PK(l2, h2), o[2], 0, 0, 0);
  o[3] = __builtin_amdgcn_mfma_f32_32x32x16_bf16(pa, PK(l3, h3), o[3], 0, 0, 0);
#undef PK
}
__device__ __forceinline__ void pv_d0(f32x16* o, int vb, bf16x8 pa0, bf16x8 pa1, bf16x8 pa2, bf16x8 pa3) {
  pv_step<0>(o, vb, pa0); pv_step<1>(o, vb, pa1); pv_step<2>(o, vb, pa2); pv_step<3>(o, vb, pa3);
}
template <int DQK>
__device__ __forceinline__ void attn_core(const Src in, const float C, const float thr, const int seq, LAS char* lds, f32x16 (&o)[4]) {
  constexpr int NSUB = DQK / 64, SHM_K = NSUB * 8192;
  int lane; asm volatile("v_and_b32 %0, 63, %1" : "=v"(lane) : "v"(threadIdx.x));
  const int tid = threadIdx.x, wid = __builtin_amdgcn_readfirstlane(tid >> 6), r32 = lane & 31, hi = (lane >> 5) & 1;
  LAS char* V_lds = lds; LAS char* K_lds = lds + 3 * SHM_V;
  LAS float* ws = (LAS float*)(lds + 3 * SHM_V + 3 * SHM_K) + wid * 64; LAS float* li_l = ws; LAS float* al_l = ws + 32;
  float m_reg = -1e30f, l_reg = 0;
#pragma unroll
  for (int d = 0; d < 4; ++d) o[d] = f32x16{};
  bf16x8 qr[DQK / 16];
  const bf16_t* Qw = in.Q + (size_t)(wid * QBLK + r32) * in.ldq + hi * 8;
#pragma unroll
  for (int d0 = 0; d0 < DQK / 16; ++d0) qr[d0] = *(const bf16x8*)(Qw + d0 * 16);
  const int krow = wid * 8 + (lane >> 3), kslot = (lane & 7) ^ ((krow >> 1) & 7);
  const unsigned koff = (unsigned)(krow * in.ldk + kslot * 8) * 2u, k2off = (unsigned)(krow * in.ldk2 + kslot * 8) * 2u;
  unsigned voff[2];
#pragma unroll
  for (int i = 0; i < 2; ++i) { const int p = i * 8192 + wid * 1024 + lane * 16, st = p >> 9, wq = (p & 511) >> 1, kk = (st >> 2) * 8 + (wq >> 5), cl = wq & 31;
    const int k = (kk & ~0xC) | ((kk & 4) << 1) | ((kk & 8) >> 1); voff[i] = (unsigned)(k * in.ldv + (st & 3) * 32 + cl) * 2u; }
  const int vb0 = (int)(unsigned)(size_t)V_lds + v_rd_base(lane);
  const unsigned ldsw = (unsigned)wid * 1024u;
#define GLDS(gp, lp) __builtin_amdgcn_global_load_lds((const unsigned*)(gp), (LAS unsigned*)(lp), 16, 0, 0)
#define ISSUE_K(t, b) do { const char* kb_ = (const char*)in.K + (size_t)(t) * (KVBLK * 2) * in.ldk; \
    _Pragma("unroll") for (int s_ = 0; s_ < NSUB; ++s_) { if (s_ < 2) GLDS(kb_ + s_ * 128 + koff, K_lds + (b) * SHM_K + s_ * 8192 + ldsw); \
      else GLDS((const char*)in.K2 + (size_t)(t) * (KVBLK * 2) * in.ldk2 + k2off, K_lds + (b) * SHM_K + s_ * 8192 + ldsw); } } while (0)
#define ISSUE_V(t, b) do { const char* vb_ = (const char*)in.V + (size_t)(t) * (KVBLK * 2) * in.ldv; \
    GLDS(vb_ + voff[0], V_lds + (b) * SHM_V + ldsw); GLDS(vb_ + voff[1], V_lds + (b) * SHM_V + 8192 + ldsw); \
    if (ATT_DUP == 3) { GLDS(vb_ + voff[0], V_lds + (b) * SHM_V + ldsw); GLDS(vb_ + voff[1], V_lds + (b) * SHM_V + 8192 + ldsw); } } while (0)
#define WAITV(n) asm volatile("s_waitcnt vmcnt(%0)" :: "n"((DBG_SKIP & 4) ? 0 : (n)) : "memory")
#define WBAR() do { asm volatile("" ::: "memory"); __builtin_amdgcn_s_barrier(); asm volatile("" ::: "memory"); } while (0)
#define RESC(a) do { if (__any((a) < 1.f)) { if (hi == 0) al_l[r32] = (a); asm volatile("s_waitcnt lgkmcnt(0)" ::: "memory"); \
    _Pragma("unroll") for (int d = 0; d < 4; ++d) _Pragma("unroll") for (int r = 0; r < 16; ++r) o[d][r] *= al_l[crow(r, hi)]; } } while (0)
#define NXT3(x) ((x) == 2 ? 0 : (x) + 1)
  constexpr int NI = NSUB + (ATT_DUP == 3 ? 4 : 2), NV = (ATT_DUP == 3 ? 4 : 2);
  f32x16 pA0, pA1, pB0, pB1; float mnA, mnB, alA, alB; bf16x8 pa0, pa1, pa2, pa3; const int NT = seq / KVBLK;
  const bool lead = wid < 4;
  ISSUE_K(0, 0); ISSUE_K(1, 1); ISSUE_V(0, 0);
  if (!lead) { WAITV(NI); WBAR(); }
  WAITV(NI); WBAR();
  ISSUE_K(2, 2);
  qkt<DQK>(pA0, pA1, K_lds, qr, r32, hi);
  WAITV(NI); WBAR();
  ISSUE_V(1, 1);
  partialSM(pA0, pA1, m_reg, mnA, alA, C, thr);
  WAITV(NI); WBAR();
  int bq = 1;
  for (int j = 1; j + 3 < NT; j += 2) {
    { const int b1 = NXT3(bq), b2 = NXT3(b1);
      ISSUE_K(j + 2, b2);
      SBAR(); qkt<DQK>(pB0, pB1, K_lds + bq * SHM_K, qr, r32, hi);
      finishSM(pA0, pA1, alA, l_reg, pa0, pa1, pa2, pa3); SBAR();
      WAITV(NI); WBAR();
      ISSUE_V(j + 1, b1);
      pv_d0(o, vb0 + b2 * SHM_V, pa0, pa1, pa2, pa3); partialSM(pB0, pB1, m_reg, mnB, alB, C, thr);
      RESC(alB); bq = b1;
      WAITV(NI); WBAR(); }
    { const int b1 = NXT3(bq), b2 = NXT3(b1);
      ISSUE_K(j + 3, b2);
      SBAR(); qkt<DQK>(pA0, pA1, K_lds + bq * SHM_K, qr, r32, hi);
      finishSM(pB0, pB1, alB, l_reg, pa0, pa1, pa2, pa3); SBAR();
      WAITV(NI); WBAR();
      ISSUE_V(j + 2, b1);
      pv_d0(o, vb0 + b2 * SHM_V, pa0, pa1, pa2, pa3); partialSM(pA0, pA1, m_reg, mnA, alA, C, thr);
      RESC(alA); bq = b1;
      WAITV(NI); WBAR(); }
  }
  { const int b1 = NXT3(bq), b2 = NXT3(b1);
    ISSUE_K(NT - 1, b2);
    SBAR(); qkt<DQK>(pB0, pB1, K_lds + bq * SHM_K, qr, r32, hi);
    finishSM(pA0, pA1, alA, l_reg, pa0, pa1, pa2, pa3); SBAR();
    WAITV(NI); WBAR();
    ISSUE_V(NT - 2, b1);
    pv_d0(o, vb0 + b2 * SHM_V, pa0, pa1, pa2, pa3); partialSM(pB0, pB1, m_reg, mnB, alB, C, thr);
    RESC(alB); bq = b1;
    WAITV(NI); WBAR(); }
  { const int b1 = NXT3(bq), b2 = NXT3(b1);
    SBAR(); qkt<DQK>(pA0, pA1, K_lds + bq * SHM_K, qr, r32, hi);
    finishSM(pB0, pB1, alB, l_reg, pa0, pa1, pa2, pa3); SBAR();
    WAITV(NV); WBAR();
    ISSUE_V(NT - 1, b1);
    pv_d0(o, vb0 + b2 * SHM_V, pa0, pa1, pa2, pa3); partialSM(pA0, pA1, m_reg, mnA, alA, C, thr);
    RESC(alA); bq = b1;
    WAITV(NV); WBAR(); }
  { const int b2 = NXT3(NXT3(bq));
    SBAR(); qkt<DQK>(pB0, pB1, K_lds + bq * SHM_K, qr, r32, hi);
    finishSM(pA0, pA1, alA, l_reg, pa0, pa1, pa2, pa3); SBAR();
    WAITV(0); WBAR();
    pv_d0(o, vb0 + b2 * SHM_V, pa0, pa1, pa2, pa3); partialSM(pB0, pB1, m_reg, mnB, alB, C, thr);
    RESC(alB);
    WBAR(); }
  finishSM(pB0, pB1, alB, l_reg, pa0, pa1, pa2, pa3); SBAR();
  pv_d0(o, vb0 + bq * SHM_V, pa0, pa1, pa2, pa3);
  if (lead) { WBAR(); }
  if (hi == 0) li_l[r32] = l_reg; asm volatile("s_waitcnt lgkmcnt(0)" ::: "memory");
#pragma unroll
  for (int r = 0; r < 16; ++r) { const float rl = __builtin_amdgcn_rcpf(li_l[crow(r, hi)]);
#pragma unroll
    for (int d = 0; d < 4; ++d) o[d][r] *= rl; }
  asm volatile("s_waitcnt lgkmcnt(0)" ::: "memory"); WBAR();
#undef GLDS
#undef ISSUE_K
#undef ISSUE_V
#undef WAITV
#undef WBAR
#undef RESC
#undef NXT3
}
template <int DQK>
__device__ __forceinline__ void attn_core_seq(const Src in, const float C, const float thr, const int seq, LAS char* lds, f32x16 (&o)[4]) {
  constexpr int NSUB = DQK / 64, SHM_K = NSUB * 8192;
  int lane; asm volatile("v_and_b32 %0, 63, %1" : "=v"(lane) : "v"(threadIdx.x));
  const int tid = threadIdx.x, wid = __builtin_amdgcn_readfirstlane(tid >> 6), r32 = lane & 31, hi = (lane >> 5) & 1;
  LAS char* V_lds = lds; LAS char* K_lds = lds + 3 * SHM_V;
  LAS float* ws = (LAS float*)(lds + 3 * SHM_V + 3 * SHM_K) + wid * 64; LAS float* li_l = ws; LAS float* al_l = ws + 32;
  float m_reg = -1e30f, l_reg = 0;
#pragma unroll
  for (int d = 0; d < 4; ++d) o[d] = f32x16{};
  bf16x8 qr[DQK / 16];
  const bf16_t* Qw = in.Q + (size_t)(wid * QBLK + r32) * in.ldq + hi * 8;
#pragma unroll
  for (int d0 = 0; d0 < DQK / 16; ++d0) qr[d0] = *(const bf16x8*)(Qw + d0 * 16);
  const int krow = wid * 8 + (lane >> 3), kslot = (lane & 7) ^ ((krow >> 1) & 7);
  const unsigned koff = (unsigned)(krow * in.ldk + kslot * 8) * 2u, k2off = (unsigned)(krow * in.ldk2 + kslot * 8) * 2u;
  unsigned voff[2];
#pragma unroll
  for (int i = 0; i < 2; ++i) { const int p = i * 8192 + wid * 1024 + lane * 16, st = p >> 9, wq = (p & 511) >> 1, kk = (st >> 2) * 8 + (wq >> 5), cl = wq & 31;
    const int k = (kk & ~0xC) | ((kk & 4) << 1) | ((kk & 8) >> 1); voff[i] = (unsigned)(k * in.ldv + (st & 3) * 32 + cl) * 2u; }
  const int vb0 = (int)(unsigned)(size_t)V_lds + v_rd_base(lane);
  const unsigned ldsw = (unsigned)wid * 1024u;
#define GLDS(gp, lp) __builtin_amdgcn_global_load_lds((const unsigned*)(gp), (LAS unsigned*)(lp), 16, 0, 0)
#define ISSUE_K(t, b) do { const char* kb_ = (const char*)in.K + (size_t)(t) * (KVBLK * 2) * in.ldk; \
    _Pragma("unroll") for (int s_ = 0; s_ < NSUB; ++s_) { if (s_ < 2) GLDS(kb_ + s_ * 128 + koff, K_lds + (b) * SHM_K + s_ * 8192 + ldsw); \
      else GLDS((const char*)in.K2 + (size_t)(t) * (KVBLK * 2) * in.ldk2 + k2off, K_lds + (b) * SHM_K + s_ * 8192 + ldsw); } } while (0)
#define ISSUE_V(t, b) do { const char* vb_ = (const char*)in.V + (size_t)(t) * (KVBLK * 2) * in.ldv; \
    GLDS(vb_ + voff[0], V_lds + (b) * SHM_V + ldsw); GLDS(vb_ + voff[1], V_lds + (b) * SHM_V + 8192 + ldsw); } while (0)
#define WAITV(n) asm volatile("s_waitcnt vmcnt(%0)" :: "n"(n) : "memory")
#define WBAR() do { asm volatile("" ::: "memory"); __builtin_amdgcn_s_barrier(); asm volatile("" ::: "memory"); } while (0)
#define RESC(a) do { if (__any((a) < 1.f)) { if (hi == 0) al_l[r32] = (a); asm volatile("s_waitcnt lgkmcnt(0)" ::: "memory"); \
    _Pragma("unroll") for (int d = 0; d < 4; ++d) _Pragma("unroll") for (int r = 0; r < 16; ++r) o[d][r] *= al_l[crow(r, hi)]; } } while (0)
#define NXT3(x) ((x) == 2 ? 0 : (x) + 1)
#define SEG_B(b) do { float mn, al; bf16x8 pa0, pa1, pa2, pa3; partialSM(p0, p1, m_reg, mn, al, C, thr); RESC(al); finishSM(p0, p1, al, l_reg, pa0, pa1, pa2, pa3); SBAR(); \
    pv_d0(o, vb0 + (b) * SHM_V, pa0, pa1, pa2, pa3); } while (0)
  constexpr int NI = NSUB + 2;
  f32x16 p0, p1; const int NT = seq / KVBLK; const bool lead = wid < 4;
  ISSUE_K(0, 0); ISSUE_V(0, 0); ISSUE_K(1, 1); ISSUE_V(1, 1);
  if (!lead) { WAITV(NI); WBAR(); }
  WAITV(NI); WBAR();
  int bq = 0;
  for (int j = 0; j + 2 < NT; ++j) {
    const int b1 = NXT3(bq), b2 = NXT3(b1);
    ISSUE_K(j + 2, b2);
    qkt<DQK>(p0, p1, K_lds + bq * SHM_K, qr, r32, hi);
    WAITV(NI); WBAR();
    ISSUE_V(j + 2, b2);
    SEG_B(bq);
    WAITV(NI); WBAR();
    bq = b1;
  }
#pragma unroll
  for (int jj = 0; jj < 2; ++jj) {
    qkt<DQK>(p0, p1, K_lds + bq * SHM_K, qr, r32, hi);
    WAITV(0); WBAR();
    SEG_B(bq);
    WBAR();
    bq = NXT3(bq);
  }
  if (lead) { WBAR(); }
  if (hi == 0) li_l[r32] = l_reg; asm volatile("s_waitcnt lgkmcnt(0)" ::: "memory");
#pragma unroll
  for (int r = 0; r < 16; ++r) { const float rl = __builtin_amdgcn_rcpf(li_l[crow(r, hi)]);
#pragma unroll
    for (int d = 0; d < 4; ++d) o[d][r] *= rl; }
  asm volatile("s_waitcnt lgkmcnt(0)" ::: "memory"); WBAR();
#undef GLDS
#undef ISSUE_K
#undef ISSUE_V
#undef WAITV
#undef WBAR
#undef RESC
#undef NXT3
#undef SEG_B
}
__device__ __forceinline__ void attn_core_da2(const Src in, const float C, const float thr, const int seq, LAS char* lds, f32x16 (&o1)[4], f32x16 (&o2)[4]) {
  constexpr int NSUB = 2, SHM_K = NSUB * 8192;
  int lane; asm volatile("v_and_b32 %0, 63, %1" : "=v"(lane) : "v"(threadIdx.x));
  const int tid = threadIdx.x, wid = __builtin_amdgcn_readfirstlane(tid >> 6), r32 = lane & 31, hi = (lane >> 5) & 1;
  LAS char* V_lds = lds; LAS char* K_lds = lds + 3 * SHM_V;
  LAS float* ws = (LAS float*)(lds + 3 * SHM_V + 3 * SHM_K) + wid * 64; LAS float* li_l = ws; LAS float* al_l = ws + 32;
  float m1 = -1e30f, l1 = 0, m2 = -1e30f, l2 = 0;
#pragma unroll
  for (int d = 0; d < 4; ++d) { o1[d] = f32x16{}; o2[d] = f32x16{}; }
  bf16x8 q1[4], q2[4];
  const bf16_t* Qw = in.Q + (size_t)(wid * QBLK + r32) * in.ldq + hi * 8;
#pragma unroll
  for (int d0 = 0; d0 < 4; ++d0) { q1[d0] = *(const bf16x8*)(Qw + d0 * 16); q2[d0] = *(const bf16x8*)(Qw + 64 + d0 * 16); }
  const int krow = wid * 8 + (lane >> 3), kslot = (lane & 7) ^ ((krow >> 1) & 7);
  const unsigned koff = (unsigned)(krow * in.ldk + kslot * 8) * 2u;
  unsigned voff[2];
#pragma unroll
  for (int i = 0; i < 2; ++i) { const int p = i * 8192 + wid * 1024 + lane * 16, st = p >> 9, wq = (p & 511) >> 1, kk = (st >> 2) * 8 + (wq >> 5), cl = wq & 31;
    const int k = (kk & ~0xC) | ((kk & 4) << 1) | ((kk & 8) >> 1); voff[i] = (unsigned)(k * in.ldv + (st & 3) * 32 + cl) * 2u; }
  const int vb0 = (int)(unsigned)(size_t)V_lds + v_rd_base(lane);
  const unsigned ldsw = (unsigned)wid * 1024u;
#define GLDS(gp, lp) __builtin_amdgcn_global_load_lds((const unsigned*)(gp), (LAS unsigned*)(lp), 16, 0, 0)
#define ISSUE_KV(t, b) do { const char* kb_ = (const char*)in.K + (size_t)(t) * (KVBLK * 2) * in.ldk; const char* vb_ = (const char*)in.V + (size_t)(t) * (KVBLK * 2) * in.ldv; \
    GLDS(kb_ + koff, K_lds + (b) * SHM_K + ldsw); GLDS(kb_ + 128 + koff, K_lds + (b) * SHM_K + 8192 + ldsw); \
    GLDS(vb_ + voff[0], V_lds + (b) * SHM_V + ldsw); GLDS(vb_ + voff[1], V_lds + (b) * SHM_V + 8192 + ldsw); } while (0)
#define WAITV(n) asm volatile("s_waitcnt vmcnt(%0)" :: "n"(n) : "memory")
#define WBAR() do { asm volatile("" ::: "memory"); __builtin_amdgcn_s_barrier(); asm volatile("" ::: "memory"); } while (0)
#define RESC(oo, a) do { if (__any((a) < 1.f)) { if (hi == 0) al_l[r32] = (a); asm volatile("s_waitcnt lgkmcnt(0)" ::: "memory"); \
    _Pragma("unroll") for (int d = 0; d < 4; ++d) _Pragma("unroll") for (int r = 0; r < 16; ++r) oo[d][r] *= al_l[crow(r, hi)]; asm volatile("s_waitcnt lgkmcnt(0)" ::: "memory"); } } while (0)
#define NXT3(x) ((x) == 2 ? 0 : (x) + 1)
#define TILE_BODY(b) do { f32x16 p0, p1; float mn, al; bf16x8 pa0, pa1, pa2, pa3; \
    qkt<64>(p0, p1, K_lds + (b) * SHM_K, q1, r32, hi); partialSM(p0, p1, m1, mn, al, C, thr); RESC(o1, al); \
    finishSM(p0, p1, al, l1, pa0, pa1, pa2, pa3); SBAR(); pv_d0(o1, vb0 + (b) * SHM_V, pa0, pa1, pa2, pa3); SBAR(); \
    qkt<64>(p0, p1, K_lds + (b) * SHM_K + 8192, q2, r32, hi); partialSM(p0, p1, m2, mn, al, C, thr); RESC(o2, al); \
    finishSM(p0, p1, al, l2, pa0, pa1, pa2, pa3); SBAR(); pv_d0(o2, vb0 + (b) * SHM_V, pa0, pa1, pa2, pa3); SBAR(); } while (0)
  const int NT = seq / KVBLK;
  ISSUE_KV(0, 0); ISSUE_KV(1, 1);
  int bq = 0;
  for (int j = 0; j + 1 < NT; ++j) {
    const int b1 = NXT3(bq), b2 = NXT3(b1);
    WAITV(4); WBAR();
    if (j + 2 < NT) ISSUE_KV(j + 2, b2); else ISSUE_KV(NT - 1, b2);
    TILE_BODY(bq);
    bq = b1;
  }
  WAITV(4); WBAR();
  TILE_BODY(bq);
  WAITV(0);
  if (hi == 0) { li_l[r32] = l1; al_l[r32] = l2; } asm volatile("s_waitcnt lgkmcnt(0)" ::: "memory");
#pragma unroll
  for (int r = 0; r < 16; ++r) { const float ra = __builtin_amdgcn_rcpf(li_l[crow(r, hi)]), rb = __builtin_amdgcn_rcpf(al_l[crow(r, hi)]);
#pragma unroll
    for (int d = 0; d < 4; ++d) { o1[d][r] *= ra; o2[d][r] *= rb; } }
  asm volatile("s_waitcnt lgkmcnt(0)" ::: "memory"); WBAR();
#undef GLDS
#undef ISSUE_KV
#undef WAITV
#undef WBAR
#undef RESC
#undef NXT3
#undef TILE_BODY
}
}

constexpr int NWAVES = 8;
struct Args { const void* in[27]; float* out; unsigned char* ws; int ph_lo, ph_hi, li, pad; };

__constant__ float c_invA[8] = {1.0f, 0.19392274474868576f, 0.03760603093086393f, 0.007292664737217109f, 0.001414213562373095f, 0.0002742481756762073f, 5.318295896944988e-05f, 1.031338537721246e-05f};
__constant__ float c_invM[32] = {1.0f, 0.6636012376960885f, 0.44036660267178046f, 0.2922278225730151f, 0.19392274474868576f, 0.12868737343265052f, 0.08539710028576561f, 0.05666962144529105f,
    0.03760603093086393f, 0.024955408670558694f, 0.016560440080994446f, 0.010989528534539826f, 0.007292664737217109f, 0.004839421345719893f, 0.003211445994752591f, 0.0021311195369119653f,
    0.001414213562373095f, 0.0009384738703573802f, 0.000622772421914596f, 0.0004132725499855165f, 0.0002742481756762073f, 0.00018199142881462546f, 0.00012076973741146504f, 8.01429472224798e-05f,
    5.318295896944988e-05f, 3.529227739646723e-05f, 2.341999896140934e-05f, 1.5541540297632344e-05f, 1.031338537721246e-05f, 6.8439753011549275e-06f, 4.5416704806078695e-06f, 3.013858152139171e-06f};

__device__ __forceinline__ int permDA(int i) { return i < 16 ? (i >> 1) + 8 * (i & 1) : i; }
__device__ __forceinline__ int permM(int i) { return (i >> 1) + 32 * (i & 1); }
__device__ __forceinline__ int src_in(int j) {
    if (j < 2048) return (j & ~63) + permDA(j & 63);
    if (j < 4352) return j;
    if (j < 6400) return 4416 + (j - 4352);
    if (j < 6464) return 4352 + permM(j - 6400);
    return -1;
}
__device__ __forceinline__ int src_uq(int j) { const int hd = j / 192, off = j % 192; return off < 128 ? j : hd * 192 + 128 + permM(off - 128); }

__device__ __forceinline__ void tr_item(const float* W, int K, int N, bf16_t* WT, int n0, int k0, int scol, const float* rs, LAS float* scr, int lane) {
#pragma unroll 8
    for (int i = 0; i < 32; ++i) { const int kk = 2 * i + (lane >> 5); float v = 0.f; if (scol >= 0) { v = W[(size_t)(k0 + kk) * N + scol]; if (rs) v *= rs[k0 + kk]; } scr[kk * 33 + (lane & 31)] = v; }
    LDS_WAIT(); asm volatile("" ::: "memory");
    const int c = lane & 7;
#pragma unroll
    for (int j = 0; j < 4; ++j) { const int n = (lane >> 3) + 8 * j; const LAS float* s = scr + (8 * c) * 33 + n;
        u32x4 o; o.x = cvt_pk_bf16(s[0 * 33], s[1 * 33]); o.y = cvt_pk_bf16(s[2 * 33], s[3 * 33]); o.z = cvt_pk_bf16(s[4 * 33], s[5 * 33]); o.w = cvt_pk_bf16(s[6 * 33], s[7 * 33]);
        *(u32x4*)(WT + (size_t)(n0 + n) * K + k0 + 8 * c) = o; }
    LDS_WAIT(); asm volatile("" ::: "memory");
}

template <int MODE = 0, bool OUT8 = false>
__device__ __forceinline__ void cvt_tile64(const float* W, int N, bf16_t* WT, int Kd, int k0, int n0, int drow0, int lane, const float* rs = nullptr) {
    const int g = lane >> 4, x = lane & 15;
    const float* src = W + (size_t)(k0 + 16 * g) * N + n0 + 4 * x;
    f32x4 v[16];
#pragma unroll
    for (int i = 0; i < 16; ++i) v[i] = __builtin_nontemporal_load((const f32x4*)(src + (size_t)i * N));
    if (rs) {
#pragma unroll
        for (int i = 0; i < 16; ++i) v[i] = v[i] * rs[k0 + 16 * g + i];
    }
    if constexpr (OUT8) {
#pragma unroll
        for (int j = 0; j < 4; ++j) { u32x4 w;
            w.x = cvt_pk_fp8x4(v[0][j] * 64.f, v[1][j] * 64.f, v[2][j] * 64.f, v[3][j] * 64.f); w.y = cvt_pk_fp8x4(v[4][j] * 64.f, v[5][j] * 64.f, v[6][j] * 64.f, v[7][j] * 64.f);
            w.z = cvt_pk_fp8x4(v[8][j] * 64.f, v[9][j] * 64.f, v[10][j] * 64.f, v[11][j] * 64.f); w.w = cvt_pk_fp8x4(v[12][j] * 64.f, v[13][j] * 64.f, v[14][j] * 64.f, v[15][j] * 64.f);
            *(u32x4*)((unsigned char*)WT + (size_t)(drow0 + 4 * x + j) * Kd + k0 + 16 * g) = w; }
        return; }
#pragma unroll
    for (int j = 0; j < 4; ++j) { u32x4 lo, hi;
        lo.x = cvt_pk_bf16(v[0][j], v[1][j]); lo.y = cvt_pk_bf16(v[2][j], v[3][j]); lo.z = cvt_pk_bf16(v[4][j], v[5][j]); lo.w = cvt_pk_bf16(v[6][j], v[7][j]);
        hi.x = cvt_pk_bf16(v[8][j], v[9][j]); hi.y = cvt_pk_bf16(v[10][j], v[11][j]); hi.z = cvt_pk_bf16(v[12][j], v[13][j]); hi.w = cvt_pk_bf16(v[14][j], v[15][j]);
        const int c = 4 * x + j;
        const int dr = MODE == 1 ? 2 * (c & 31) + (c >> 5) : (MODE == 2 ? (c < 16 ? 2 * (c & 7) + (c >> 3) : c) : c);
        bf16_t* d = WT + (size_t)(drow0 + dr) * Kd + k0 + 16 * g;
        *(u32x4*)d = lo; *(u32x4*)(d + 8) = hi; }
}

__global__ void __launch_bounds__(NWAVES * 64, 2) fwd(Args args) {
#define KARGS() const __attribute__((address_space(4))) unsigned long long* ka_ = (const __attribute__((address_space(4))) unsigned long long*)__builtin_amdgcn_kernarg_segment_ptr(); asm volatile("" : "+s"(ka_))
#define AIN(i) ((const void*)ka_[i])
#define AOUT ((float*)ka_[27])
#define AWS ((unsigned char*)ka_[28])
    extern __shared__ __attribute__((aligned(16))) unsigned char lds_raw[];
    LAS unsigned char* lds = (LAS unsigned char*)lds_raw;
    volatile LAS unsigned* MISC = (volatile LAS unsigned*)(lds + MISC_OFF);
    const int tid = threadIdx.x, wave = __builtin_amdgcn_readfirstlane(tid >> 6);
#define LANE_DECL int lane; asm volatile("v_and_b32 %0, 63, %1" : "=v"(lane) : "v"(threadIdx.x))
    const int G = gridDim.x, bx = blockIdx.x;
    unsigned* ctl = (unsigned*)(args.ws + WS_CTL);
    const int lo = args.ph_lo, hi_ph = args.ph_hi;
    if (tid < 32) MISC[tid] = 0u;
    __syncthreads();
    XcdBarrier bar; bar.bar = ctl + CW_BAR + args.li * XCD_BAR_WORDS; bar.x = 0; bar.st = nullptr;
    if (!MK_PER_PHASE) bar = xcd_barrier_post(ctl + CW_BAR + args.li * XCD_BAR_WORDS, MISC + 8);
#define IN(k) (((PH_MASK >> (k)) & 1) && lo <= (k) && (k) < hi_ph)
#define SEAM(k) do { if (IN(k) && IN((k) + 1)) xcd_barrier(bar); } while (0)
    const int gw = bx * NWAVES + wave, NGW = G * NWAVES;

#define xin ((const float*)AIN(0))
#define positions ((const int*)AIN(1))
#define Bt_in ((bf16_t*)(AWS + WS_BT_IN))
#define Bt_uq ((bf16_t*)(AWS + WS_BT_UQ))
#define Bt_ukv ((bf16_t*)(AWS + WS_BT_UKV))
#define Bt_od ((bf16_t*)(AWS + WS_BT_OD))
#define Bt_om ((bf16_t*)(AWS + WS_BT_OM))
#define Bt_out ((bf16_t*)(AWS + WS_BT_OUT))
#define ropeA ((float*)(AWS + WS_ROPEA))
#define ropeM ((float*)(AWS + WS_ROPEM))
#define sq ((float*)(AWS + WS_SQ2))
#define hbuf ((bf16_t*)(AWS + WS_H))
#define oa ((bf16_t*)(AWS + WS_H))
#define qa ((bf16_t*)(AWS + WS_QA))
#define ka ((bf16_t*)(AWS + WS_KA))
#define va ((bf16_t*)(AWS + WS_VA))
#define cq ((bf16_t*)(AWS + WS_CQ))
#define ckv ((bf16_t*)(AWS + WS_CKV))
#define kr ((bf16_t*)(AWS + WS_KR))
#define gates ((bf16_t*)(AWS + WS_GATES))
#define qm ((bf16_t*)(AWS + WS_QM))
#define kv ((bf16_t*)(AWS + WS_KV))
#define ob ((bf16_t*)(AWS + WS_OB))
#define mrg ((bf16_t*)(AWS + WS_MRG))
#define stash ((float*)(AWS + WS_STASH))
#define rowtok_p ((int*)(AWS + WS_ROWTOK))
#define assign ((u32x2*)(AWS + WS_ASSIGN))
#define Bt_d ((bf16_t*)(AWS + WS_BT_D))
#define Bt_gu ((bf16_t*)(AWS + WS_BT_GU))
#define h2 ((bf16_t*)(AWS + WS_H2))
#define act ((bf16_t*)(AWS + WS_ACT))
#define ybuf ((bf16_t*)(AWS + WS_Y))
#define count ((unsigned*)(AWS + WS_CTL) + CW_COUNT)

    if (IN(0)) {
        KARGS();
        LANE_DECL;
        const float* w_in = (const float*)AIN(3); const float* g_q = (const float*)AIN(9); const float* g_kv = (const float*)AIN(10);
        const float* w_uq = (const float*)AIN(11); const float* w_ukv = (const float*)AIN(12);
        const float* w_od = (const float*)AIN(13); const float* w_om = (const float*)AIN(14); const float* w_out = (const float*)AIN(16);
        constexpr int I_IN = 16 * 101, I_PAD = 16 * 3, I_UQ = 12 * 24, I_UKV = 8 * 32, I_O = 16 * 16;
        constexpr int NITEMS = I_IN + I_PAD + I_UQ + I_UKV + 3 * I_O;
        for (int it = gw; it < NITEMS; it += NGW) {
            int r = it;
            if (r < I_IN) { const int kb = r / 101, cb = r % 101, n0 = cb * 64;
                if (n0 < 2048) cvt_tile64<2>(w_in, 6464, Bt_in, D, kb * 64, n0, n0, lane);
                else if (n0 < 4352) cvt_tile64<0>(w_in, 6464, Bt_in, D, kb * 64, n0, n0, lane);
                else if (n0 < 4416) cvt_tile64<1>(w_in, 6464, Bt_in, D, kb * 64, n0, 5888, lane);
                else if (n0 < 4416 + 1536) cvt_tile64<0>(w_in, 6464, Bt_in, D, kb * 64, n0, n0 - 64, lane);
                else cvt_tile64<0>(w_in, 6464, Bt_in, D, kb * 64, n0, n0 - 64 + 256, lane);
                continue; } r -= I_IN;
            if (r < I_PAD) { const int kb = r / 3, rb = r % 3; const int g = lane >> 4, x4 = lane & 15;
#pragma unroll
                for (int j = 0; j < 4; ++j) { bf16_t* d = Bt_in + (size_t)(5952 + rb * 64 + 4 * x4 + j) * D + kb * 64 + 16 * g; *(u32x4*)d = (u32x4){0u, 0u, 0u, 0u}; *(u32x4*)(d + 8) = (u32x4){0u, 0u, 0u, 0u}; }
                continue; } r -= I_PAD;
            if (r < I_UQ) { const int kb = r / 24, cb = r % 24, n0 = cb * 64;
                if ((cb % 3) == 2) cvt_tile64<1>(w_uq, 1536, Bt_uq, QL, kb * 64, n0, n0, lane, g_q); else cvt_tile64<0>(w_uq, 1536, Bt_uq, QL, kb * 64, n0, n0, lane, g_q);
                continue; } r -= I_UQ;
            if (r < I_UKV) { const int kb = r / 32, cb = r % 32; cvt_tile64<0>(w_ukv, 2048, Bt_ukv, KVL, kb * 64, cb * 64, cb * 64, lane, g_kv); continue; } r -= I_UKV;
            const int which = r / I_O; r -= which * I_O; const int kb = r / 16, cb = r % 16;
            cvt_tile64<0>(which == 0 ? w_od : (which == 1 ? w_om : w_out), D, which == 0 ? Bt_od : (which == 1 ? Bt_om : Bt_out), D, kb * 64, cb * 64, cb * 64, lane);
        }
        const float* g_mix = (const float*)AIN(2);
        for (int m = gw * 4; m < T; m += NGW * 4) {
            f32x4 v[4][4]; float ss[4];
#pragma unroll
            for (int q = 0; q < 4; ++q) { const f32x4* xr = (const f32x4*)(xin + (size_t)(m + q) * D) + lane;
#pragma unroll
                for (int j = 0; j < 4; ++j) v[q][j] = xr[64 * j]; }
#pragma unroll
            for (int q = 0; q < 4; ++q) { float s = 0.f;
#pragma unroll
                for (int j = 0; j < 4; ++j) s += (v[q][j][0] * v[q][j][0] + v[q][j][1] * v[q][j][1]) + (v[q][j][2] * v[q][j][2] + v[q][j][3] * v[q][j][3]);
                ss[q] = __builtin_amdgcn_rsqf(wave_sum(s) * (1.f / D) + EPS); }
#pragma unroll
            for (int j = 0; j < 4; ++j) { const f32x4 gg = *((const f32x4*)g_mix + lane + 64 * j);
#pragma unroll
                for (int q = 0; q < 4; ++q) { u32x2 w; w.x = cvt_pk_bf16(v[q][j][0] * ss[q] * gg[0], v[q][j][1] * ss[q] * gg[1]); w.y = cvt_pk_bf16(v[q][j][2] * ss[q] * gg[2], v[q][j][3] * ss[q] * gg[3]);
                    ((u32x2*)(hbuf + (size_t)(m + q) * D) + lane)[64 * j] = w; } }
        }
        for (int idx = bx * 512 + tid; idx < T * 40; idx += G * 512) {
            const int t = idx / 40, i = idx % 40; const float inv = i < 8 ? c_invA[i] : c_invM[i - 8];
            const float ang = (float)positions[t] * inv;
            const double rev = (double)ang * 0.15915494309189535; const float fr_ = (float)(rev - __builtin_rint(rev));
            const float cs = __builtin_amdgcn_cosf(fr_), sn = __builtin_amdgcn_sinf(fr_);
            float* dst = i < 8 ? ropeA + ((size_t)t * 8 + i) * 2 : ropeM + ((size_t)t * 32 + (i - 8)) * 2; dst[0] = cs; dst[1] = sn;
        }
    }
    SEAM(0);
    if (IN(1)) {
        KARGS();
        pg8::Gemm g{hbuf, Bt_in, D}; pg8::DenseOrder S; S.init(T / 256, 24, G, bx);
        pg8::EpiIn E{qa, ka, va, cq, ckv, gates, kr, ropeA, ropeM, (const float*)AIN(15), sq};
        pg8::gemm_phase<pg8::EpiIn, pg8::DenseOrder, false, true>(lds, g, S, E);
    }
    SEAM(1);
    if (IN(2)) {
        KARGS();
        { pg8::Gemm g{hbuf, Bt_in, D}; pg8::DenseOrder S; S.init(T / 256, 2, G, bx, 24);
          pg8::EpiIn E{qa, ka, va, cq, ckv, gates, kr, ropeA, ropeM, (const float*)AIN(15), sq};
          pg8::gemm_phase<pg8::EpiIn, pg8::DenseOrder, false, true>(lds, g, S, E); }
        { pg8::Gemm g{cq, Bt_uq, QL}; pg8::DenseOrder S; S.init(T / 256, 1536 / 256, G, G - 1 - bx); pg8::EpiUp<true> E{qm, sq, ropeM};
          pg8::gemm_phase<pg8::EpiUp<true>, pg8::DenseOrder, false, true>(lds, g, S, E); }
        { pg8::Gemm g{ckv, Bt_ukv, KVL}; pg8::DenseOrder S; S.init(T / 256, 2048 / 256, G, bx); pg8::EpiUp<false> E{kv, sq, ropeM};
          pg8::gemm_phase<pg8::EpiUp<false>, pg8::DenseOrder, false, true>(lds, g, S, E); }
    }
    SEAM(2);
    if (IN(3)) {
        KARGS();
        const int wid = wave;
#define UNIT_DECODE(L) int u = (L) & 511; if (G == 256) { const int c = (L) & 255; u = ((L) & 256) + (c & 7) * 32 + (c >> 3); } \
            const int bh = u >> 4, qb = u & 15, b = bh >> 3, h = bh & 7; const size_t q0 = (size_t)b * SEQ + qb * 256, k0 = (size_t)b * SEQ
        for (int L = bx; L < 512; L += G) {
#if PROBE_PHASE == 3 && defined(PROBE_ATT)
            if (args.li == 1 && lo == 3 && PROBE_ATT != 0) continue;
#endif
            UNIT_DECODE(L);
            f32x16 o[4], o2[4];
            { att::Src in{qa + q0 * 1024 + h * 128, ka + k0 * 1024 + h * 128, nullptr, va + k0 * 1024 + h * 128, 1024, 1024, 0, 1024};
              att::attn_core_da2(in, 0.125f * 1.4426950408889634f, 8.f / 0.125f, SEQ, (LAS char*)lds, o, o2); }
            int ln2; asm volatile("v_and_b32 %0, 63, %1" : "=v"(ln2) : "v"(threadIdx.x));
            float lam;
            { const float* lq1 = (const float*)AIN(4); const float* lk1 = (const float*)AIN(5); const float* lq2 = (const float*)AIN(6); const float* lk2 = (const float*)AIN(7);
              const float s1 = wave_sum(lq1[ln2] * lk1[ln2]), s2 = wave_sum(lq2[ln2] * lk2[ln2]); lam = __expf(s1) - __expf(s2) + LAM_INIT; }
            float ss[16];
#pragma unroll
            for (int r = 0; r < 16; ++r) ss[r] = 0.f;
#pragma unroll
            for (int d = 0; d < 4; ++d)
#pragma unroll
                for (int r = 0; r < 16; ++r) { const float v = o[d][r] - lam * o2[d][r]; o[d][r] = v; ss[r] += v * v; }
#pragma unroll
            for (int r = 0; r < 16; ++r) {
#pragma unroll
                for (int msk = 1; msk < 32; msk <<= 1) ss[r] += __shfl_xor(ss[r], msk);
                ss[r] = __builtin_amdgcn_rsqf(ss[r] * (1.0f / 128.0f) + EPS); }
            const int hi2 = ln2 >> 5, r32e = ln2 & 31;
            bf16_t* Ow = oa + (q0 + wid * 32 + 4 * hi2) * 1024 + h * 128 + r32e;
            float gs[4];
#pragma unroll
            for (int d = 0; d < 4; ++d) gs[d] = ((const float*)AIN(8))[d * 32 + r32e] * (1.0f - LAM_INIT);
#pragma unroll
            for (int r = 0; r < 16; ++r) { const int orow = att::crow(r, 0);
#pragma unroll
                for (int d = 0; d < 4; ++d) Ow[orow * 1024 + d * 32] = (bf16_t)(cvt_pk_bf16(o[d][r] * ss[r] * gs[d], 0.f) & 0xffffu); }
        }
        for (int L = 512 + bx; L < 1024; L += G) {
#if PROBE_PHASE == 3 && defined(PROBE_ATT)
            if (args.li == 1 && lo == 3 && PROBE_ATT != 1) continue;
#endif
            UNIT_DECODE(L);
            f32x16 o[4];
            { att::Src in{qm + q0 * 1536 + h * 192, kv + k0 * 2048 + h * 256, kr + k0 * 64, kv + k0 * 2048 + h * 256 + 128, 1536, 2048, 64, 2048};
              att::attn_core_seq<192>(in, 0.07216878364870322f * 1.4426950408889634f, 8.f / 0.07216878364870322f, SEQ, (LAS char*)lds, o); }
            int ln2; asm volatile("v_and_b32 %0, 63, %1" : "=v"(ln2) : "v"(threadIdx.x));
            const int hi2 = ln2 >> 5, r32e = ln2 & 31;
            bf16_t* Ow = ob + (q0 + wid * 32 + 4 * hi2) * 1024 + h * 128 + r32e;
#pragma unroll
            for (int r = 0; r < 16; ++r) { const int orow = att::crow(r, 0);
#pragma unroll
                for (int d = 0; d < 4; ++d) Ow[orow * 1024 + d * 32] = (bf16_t)(cvt_pk_bf16(o[d][r], 0.f) & 0xffffu); }
        }
#undef UNIT_DECODE
    }
    SEAM(3);
    if (IN(4)) {
        KARGS();
        { pg8::Gemm g{oa, Bt_od, D}; pg8::DenseOrder S; S.init(T / 256, 4, G, bx); pg8::EpiGate<0> E{mrg, gates};
          pg8::gemm_phase<pg8::EpiGate<0>, pg8::DenseOrder, false, true>(lds, g, S, E); }
        VM_WAIT(); __syncthreads();
        { pg8::Gemm g{ob, Bt_om, D}; pg8::DenseOrder S; S.init(T / 256, 4, G, bx); pg8::EpiGate<1> E{mrg, gates};
          pg8::gemm_phase<pg8::EpiGate<1>, pg8::DenseOrder, false, true>(lds, g, S, E); }
    }
    SEAM(4);
    if (IN(5)) {
        KARGS();
        pg8::Gemm g{mrg, Bt_out, D}; pg8::DenseOrder S; S.init(T / 256, 4, G, bx); pg8::EpiRes E{xin, AOUT};
        pg8::gemm_phase<pg8::EpiRes, pg8::DenseOrder, false, true>(lds, g, S, E);
    }
    SEAM(5);
    if (IN(6)) {
        KARGS();
        LANE_DECL;
        const float* g_ffn = (const float*)AIN(17); const float* w_router = (const float*)AIN(18); const float* b_router = (const float*)AIN(19);
        constexpr int WRS = 1028;
        LAS float* wr_l = (LAS float*)lds;
        LAS int* lcount = (LAS int*)(lds + TAB_OFF + 1024); LAS int* gbase = lcount + 32; LAS unsigned* asg_e = (LAS unsigned*)(lcount + 64); LAS float* asg_w = (LAS float*)(lcount + 64 + 256);
        LAS int* sync_w = (LAS int*)(lds + TAB_OFF + 512);
        for (int i = tid; i < D * NEXP; i += 512) wr_l[(i & 31) * WRS + (i >> 5)] = w_router[i];
        if (tid < 32) lcount[tid] = 0;
        if (tid < 2) sync_w[tid] = 0;
        __syncthreads();
        const int ex = (lane >> 1) & 31;
        LAS float* lg = (LAS float*)(lds + TAB_OFF + 4096) + wave * 80;
        const int chunk = bx;
        if (wave < 4 && chunk < T / 64) {
            const float my_b = b_router[ex];
#pragma unroll 1
            for (int j2 = 0; j2 < 8; ++j2) {
                const int tl = wave * 16 + j2 * 2, t = chunk * 64 + tl;
                f32x4 xva[4], xvb[4]; float sa = 0.f, sb = 0.f;
                { const f32x4* xa = (const f32x4*)(AOUT + (size_t)t * D) + lane; const f32x4* xb = xa + D / 4;
#pragma unroll
                  for (int j = 0; j < 4; ++j) { xva[j] = xa[64 * j]; xvb[j] = xb[64 * j]; }
#pragma unroll
                  for (int j = 0; j < 4; ++j) { sa += (xva[j][0] * xva[j][0] + xva[j][1] * xva[j][1]) + (xva[j][2] * xva[j][2] + xva[j][3] * xva[j][3]); sb += (xvb[j][0] * xvb[j][0] + xvb[j][1] * xvb[j][1]) + (xvb[j][2] * xvb[j][2] + xvb[j][3] * xvb[j][3]); } }
                const float ra = __builtin_amdgcn_rsqf(wave_sum(sa) * (1.f / D) + EPS), rb = __builtin_amdgcn_rsqf(wave_sum(sb) * (1.f / D) + EPS);
                { u32x2* oa8 = (u32x2*)(h2 + (size_t)t * D) + lane; u32x2* ob8 = oa8 + D / 4;
#pragma unroll
                  for (int j = 0; j < 4; ++j) { const f32x4 gg = *((const f32x4*)g_ffn + lane + 64 * j); xva[j] = xva[j] * ra * gg; xvb[j] = xvb[j] * rb * gg;
                    u32x2 w; w.x = cvt_pk_bf16(xva[j][0], xva[j][1]); w.y = cvt_pk_bf16(xva[j][2], xva[j][3]); oa8[64 * j] = w;
                    w.x = cvt_pk_bf16(xvb[j][0], xvb[j][1]); w.y = cvt_pk_bf16(xvb[j][2], xvb[j][3]); ob8[64 * j] = w; } }
                float aa[32], ab[32];
#pragma unroll
                for (int e = 0; e < NEXP; ++e) { float a = 0.f, b = 0.f;
#pragma unroll
                    for (int j = 0; j < 4; ++j) { const f32x4 w4 = *(const LAS f32x4*)(wr_l + e * WRS + 4 * lane + 256 * j);
                        a += (xva[j][0] * w4[0] + xva[j][1] * w4[1]) + (xva[j][2] * w4[2] + xva[j][3] * w4[3]); b += (xvb[j][0] * w4[0] + xvb[j][1] * w4[1]) + (xvb[j][2] * w4[2] + xvb[j][3] * w4[3]); }
                    aa[e] = a; ab[e] = b; }
#define TRED(arr, n, msk) _Pragma("unroll") for (int i_ = 0; i_ < (n); ++i_) { const bool up_ = (lane & (msk)) != 0; const float keep_ = up_ ? arr[(n) + i_] : arr[i_], give_ = up_ ? arr[i_] : arr[(n) + i_]; arr[i_] = keep_ + __shfl_xor(give_, (msk)); }
                TRED(aa, 16, 32) TRED(aa, 8, 16) TRED(aa, 4, 8) TRED(aa, 2, 4) TRED(aa, 1, 2)
                TRED(ab, 16, 32) TRED(ab, 8, 16) TRED(ab, 4, 8) TRED(ab, 2, 4) TRED(ab, 1, 2)
#undef TRED
                const float la = aa[0] + __shfl_xor(aa[0], 1) + my_b, lb = ab[0] + __shfl_xor(ab[0], 1) + my_b;
#pragma unroll
                for (int tk = 0; tk < 2; ++tk) {
                    const float v = tk ? lb : la; int rank = 0;
                    if (!(lane & 1)) lg[tk * 32 + ex] = v;
                    LDS_WAIT();
#pragma unroll
                    for (int q = 0; q < 8; ++q) { const f32x4 s4 = *(const LAS f32x4*)(lg + tk * 32 + 4 * q);
#pragma unroll
                        for (int jj = 0; jj < 4; ++jj) rank += (s4[jj] > v || (s4[jj] == v && (4 * q + jj) < ex)) ? 1 : 0; }
                    if (rank < 4 && !(lane & 1)) lg[64 + tk * 4 + rank] = v;
                    LDS_WAIT();
                    const f32x4 tv = *(const LAS f32x4*)(lg + 64 + tk * 4);
                    const float p1 = __expf(tv[1] - tv[0]), p2 = __expf(tv[2] - tv[0]), p3 = __expf(tv[3] - tv[0]), inv = 1.0f / (1.0f + p1 + p2 + p3);
                    if (rank < 4 && !(lane & 1)) { const float w = (rank == 0 ? 1.0f : (rank == 1 ? p1 : (rank == 2 ? p2 : p3))) * inv;
                        const int lr = __hip_atomic_fetch_add((LAS int*)&lcount[ex], 1, __ATOMIC_RELAXED, __HIP_MEMORY_SCOPE_WORKGROUP);
                        asg_e[(tl + tk) * 4 + rank] = ((unsigned)ex << 16) | (unsigned)lr; asg_w[(tl + tk) * 4 + rank] = w; }
                }
            }
            LDS_WAIT();
            if (lane == 0) __hip_atomic_fetch_add((LAS int*)&sync_w[0], 1, __ATOMIC_RELAXED, __HIP_MEMORY_SCOPE_WORKGROUP);
            if (wave == 0) {
                while (__hip_atomic_load((LAS int*)&sync_w[0], __ATOMIC_RELAXED, __HIP_MEMORY_SCOPE_WORKGROUP) < 4) __builtin_amdgcn_s_sleep(4);
                asm volatile("s_waitcnt lgkmcnt(0)" ::: "memory");
                if (lane < 32) gbase[lane] = (int)__hip_atomic_fetch_add(count + lane, (unsigned)lcount[lane], __ATOMIC_RELAXED, __HIP_MEMORY_SCOPE_AGENT);
                LDS_WAIT();
#pragma unroll
                for (int q = 0; q < 4; ++q) { const int a_ = q * 64 + lane; const unsigned ae = asg_e[a_]; const int e = ae >> 16, rank = gbase[e] + (int)(ae & 0xffffu); const int t = chunk * 64 + (a_ >> 2);
                    rowtok_p[e * T + rank] = t; u32x2 av; av.x = ((unsigned)e << 16) | (unsigned)rank; av.y = __float_as_uint(asg_w[a_]); assign[(size_t)t * 4 + (a_ & 3)] = av; }
            }
        }
        const float* w_gate = (const float*)AIN(20); const float* w_up = (const float*)AIN(22); const float* w_down = (const float*)AIN(24);
        const int per_wg = (NEXP * 768 + G - 1) / G;
        for (;;) {
            int it = 0; if (lane == 0) it = __hip_atomic_fetch_add((LAS int*)&sync_w[1], 1, __ATOMIC_RELAXED, __HIP_MEMORY_SCOPE_WORKGROUP);
            it = __builtin_amdgcn_readfirstlane(it); const int item = bx * per_wg + it;
            if (it >= per_wg || item >= NEXP * 768) break;
            const int e = item / 768, r = item % 768, mat = r >> 8, kb = (r >> 4) & 15, nb = r & 15, f0 = nb * 64;
            if (mat < 2) cvt_tile64((mat ? w_up : w_gate) + (size_t)e * D * FF, FF, Bt_gu + (size_t)e * 2048 * D, D, kb * 64, f0, 256 * (f0 >> 7) + mat * 128 + (f0 & 127), lane);
            else cvt_tile64<0, true>(w_down + (size_t)e * FF * D, D, (bf16_t*)((unsigned char*)Bt_d + (size_t)e * D * FF), FF, kb * 64, f0, f0, lane);
        }
    }
    SEAM(6);
    LAS int* t_cnt = (LAS int*)(lds + TAB_OFF + 4096); LAS int* t_start = t_cnt + 32; LAS int* t_t2e = t_start + 40;
    if (IN(7) || IN(8) || IN(9)) {
        KARGS();
        __syncthreads();
        if (tid < 32) t_cnt[tid] = (int)__hip_atomic_load(count + tid, __ATOMIC_RELAXED, __HIP_MEMORY_SCOPE_AGENT);
        __syncthreads();
        if (tid == 0) { int s = 0; for (int e = 0; e < NEXP; ++e) { t_start[e] = s; s += (t_cnt[e] + 255) >> 8; } t_start[32] = s; }
        __syncthreads();
        if (tid < 32) { for (int rt = t_start[tid]; rt < t_start[tid + 1]; ++rt) t_t2e[rt] = tid; }
        __syncthreads();
    }
    if (IN(7)) {
        KARGS();
        pg8::Gemm g{h2, Bt_gu, D}; pg8::MoeOrder S; S.init(__builtin_amdgcn_readfirstlane(t_start[32]), 8, G, bx); S.t2e = t_t2e; S.tstart = t_start; S.cnt = t_cnt; S.rowtok = rowtok_p;
        pg8::EpiSwiglu E{act, (const float*)AIN(21), (const float*)AIN(23)};
        pg8::gemm_phase<pg8::EpiSwiglu, pg8::MoeOrder, true, true>(lds, g, S, E);
    }
    SEAM(7);
    if (IN(8)) {
        KARGS();
        pg8::Gemm g{act, Bt_d, FF / 2}; pg8::MoeOrder S; S.init(__builtin_amdgcn_readfirstlane(t_start[32]), 8, G, bx); S.t2e = t_t2e; S.tstart = t_start; S.cnt = t_cnt; S.rowtok = rowtok_p;
        pg8::EpiDown8 E{ybuf, (const float*)AIN(25)};
        pg8::gemm_phase_f8n<pg8::EpiDown8, pg8::MoeOrder>(lds, g, S, E);
    }
    SEAM(8);
    if (IN(9) && DBG_OUT) {
        KARGS();
        const bf16_t* src = DBG_OUT == 1 ? gates : DBG_OUT == 2 ? gates + 1024 : DBG_OUT == 3 ? qa : DBG_OUT == 4 ? ka : DBG_OUT == 5 ? va : DBG_OUT == 6 ? mrg : DBG_OUT == 7 ? oa : DBG_OUT == 9 ? Bt_in : ob;
        const int ld = DBG_OUT <= 2 ? 2048 : 1024;
        for (size_t i = (size_t)bx * 512 + tid; i < (size_t)T * 1024; i += (size_t)G * 512) AOUT[i] = (DBG_OUT == 9 && i >= (size_t)N_IN * 1024) ? 0.f : __uint_as_float((unsigned)src[(i >> 10) * ld + (i & 1023)] << 16);
    } else
    if (IN(9)) {
        KARGS();
        LANE_DECL;
        const float* g_fin = (const float*)AIN(26);
        for (int t0 = gw * 2; t0 < T; t0 += NGW * 2) {
            f32x4 v[2][4]; u32x2 as_[2][4];
#pragma unroll
            for (int q = 0; q < 2; ++q) { const f32x4* xr = (const f32x4*)(AOUT + (size_t)(t0 + q) * D) + lane;
#pragma unroll
                for (int j = 0; j < 4; ++j) v[q][j] = xr[64 * j];
#pragma unroll
                for (int k = 0; k < 4; ++k) as_[q][k] = assign[(size_t)(t0 + q) * 4 + k]; }
            u32x2 yw[2][4][4];
#pragma unroll
            for (int q = 0; q < 2; ++q)
#pragma unroll
                for (int k = 0; k < 4; ++k) { const int e = as_[q][k].x >> 16, rank = as_[q][k].x & 0xffffu;
                    const u32x2* yr = (const u32x2*)(ybuf + ((size_t)t_start[e] * 256 + rank) * D) + lane;
#pragma unroll
                    for (int j = 0; j < 4; ++j) yw[q][k][j] = yr[64 * j]; }
#pragma unroll
            for (int q = 0; q < 2; ++q) {
#pragma unroll
                for (int k = 0; k < 4; ++k) { const float w = (DBG_SKIP & 1) ? 0.f : __uint_as_float(as_[q][k].y);
#pragma unroll
                    for (int j = 0; j < 4; ++j) { const u32x2 y = yw[q][k][j]; v[q][j][0] += w * bf_lo(y.x); v[q][j][1] += w * bf_hi(y.x); v[q][j][2] += w * bf_lo(y.y); v[q][j][3] += w * bf_hi(y.y); } }
                float s = 0.f;
#pragma unroll
                for (int j = 0; j < 4; ++j) s += (v[q][j][0] * v[q][j][0] + v[q][j][1] * v[q][j][1]) + (v[q][j][2] * v[q][j][2] + v[q][j][3] * v[q][j][3]);
                const float rstd = __builtin_amdgcn_rsqf(wave_sum(s) * (1.f / D) + EPS);
                f32x4* xo = (f32x4*)(AOUT + (size_t)(t0 + q) * D) + lane;
#pragma unroll
                for (int j = 0; j < 4; ++j) { const f32x4 gg = *((const f32x4*)g_fin + lane + 64 * j); xo[64 * j] = v[q][j] * rstd * gg; } }
        }
    }
#undef IN
#undef SEAM
#undef KARGS
#undef AIN
#undef AOUT
#undef AWS
#undef xin
#undef positions
#undef Bt_in
#undef Bt_uq
#undef Bt_ukv
#undef Bt_od
#undef Bt_om
#undef Bt_out
#undef ropeA
#undef ropeM
#undef sq
#undef hbuf
#undef oa
#undef qa
#undef ka
#undef va
#undef cq
#undef ckv
#undef kr
#undef gates
#undef qm
#undef kv
#undef ob
#undef mrg
#undef stash
#undef rowtok_p
#undef assign
#undef Bt_d
#undef Bt_gu
#undef h2
#undef act
#undef ybuf
#undef count
}

extern "C" void kernel_launch(void* const* d_in, const int* in_sizes, int n_in, void* d_out, int out_size, void* d_ws, size_t ws_size, hipStream_t stream) {
    static int grid = 0;
    if (grid == 0) {
        if (n_in != 27 || in_sizes[0] != T * D || out_size != T * D || ws_size < WS_END) { fprintf(stderr, "kernel_launch: unexpected shapes (n_in %d, in0 %d, out %d, ws %zu < %zu)\n", n_in, n_in > 0 ? in_sizes[0] : -1, out_size, ws_size, (size_t)WS_END); grid = -1; return; }
        int dev = 0, cus = 0, per_cu = 0;
        if (hipGetDevice(&dev) != hipSuccess || hipDeviceGetAttribute(&cus, hipDeviceAttributeMultiprocessorCount, dev) != hipSuccess) { grid = -1; return; }
        if (hipFuncSetAttribute((const void*)fwd, hipFuncAttributeMaxDynamicSharedMemorySize, LDS_BYTES) != hipSuccess) { fprintf(stderr, "kernel_launch: hipFuncSetAttribute failed\n"); grid = -1; return; }
        if (hipOccupancyMaxActiveBlocksPerMultiprocessor(&per_cu, (const void*)fwd, NWAVES * 64, LDS_BYTES) != hipSuccess || per_cu < 1) fprintf(stderr, "kernel_launch: occupancy query says %d\n", per_cu);
        (void)hipGetLastError();
        grid = cus;
    }
    if (grid < 0) return;
    if (hipMemsetAsync((char*)d_ws + WS_CTL, 0, CTL_ZERO_BYTES, stream) != hipSuccess) return;
    Args a{};
    for (int i = 0; i < 27; ++i) a.in[i] = d_in[i];
    a.out = (float*)d_out; a.ws = (unsigned char*)d_ws;
#if MK_PER_PHASE
    for (int p = 0; p < NPHASE; ++p) { a.ph_lo = p; a.ph_hi = p + 1; hipLaunchKernelGGL(fwd, dim3(grid), dim3(NWAVES * 64), LDS_BYTES, stream, a); }
#elif PROBE_PHASE >= 0
    a.ph_lo = 0; a.ph_hi = PROBE_PHASE + 1; a.li = 0; hipLaunchKernelGGL(fwd, dim3(grid), dim3(NWAVES * 64), LDS_BYTES, stream, a);
    a.ph_lo = PROBE_PHASE; a.ph_hi = NPHASE; a.li = 1; hipLaunchKernelGGL(fwd, dim3(grid), dim3(NWAVES * 64), LDS_BYTES, stream, a);
#else
    a.ph_lo = 0; a.ph_hi = NPHASE; hipLaunchKernelGGL(fwd, dim3(grid), dim3(NWAVES * 64), LDS_BYTES, stream, a);
#endif
}
```

```cpp
#include <hip/hip_runtime.h>
#include <cstdio>
#include <cstdint>

#ifndef MK_PER_PHASE
#define MK_PER_PHASE 0
#endif

#ifndef PROBE_PHASE
#define PROBE_PHASE -1
#endif
#ifndef ATT_DUP
#define ATT_DUP 0
#endif
#ifndef DBG_OUT
#define DBG_OUT 0
#endif
#ifndef DBG_SKIP
#define DBG_SKIP 0
#endif
#ifndef ATT_MASK
#define ATT_MASK 3
#endif
#ifndef PH_MASK
#define PH_MASK 0x3ff
#endif
#define LAS __attribute__((address_space(3)))
#define GAS __attribute__((address_space(1)))
typedef unsigned short bf16_t;
typedef short bf16x8 __attribute__((ext_vector_type(8)));
typedef short s16x4 __attribute__((ext_vector_type(4)));
typedef float f32x2 __attribute__((ext_vector_type(2)));
typedef float f32x4 __attribute__((ext_vector_type(4)));
typedef float f32x16 __attribute__((ext_vector_type(16)));
typedef unsigned u32x2 __attribute__((ext_vector_type(2)));
typedef unsigned u32x4 __attribute__((ext_vector_type(4)));

constexpr int NB = 4, SEQ = 4096, T = NB * SEQ, D = 1024;
constexpr int NEXP = 32, TOPK = 4, FF = 1024;
constexpr int N_IN = 6656;
constexpr int QL = 768, KVL = 512;
constexpr float EPS = 1e-6f;
constexpr float LAM_INIT = 0.2f;
constexpr int NPHASE = 10;

constexpr size_t MiB = 1u << 20;
constexpr size_t WS_CTL = 0, CTL_ZERO_BYTES = 1 * MiB;
constexpr size_t WS_BT_IN = 2 * MiB;
constexpr size_t WS_BT_UQ = 15 * MiB;
constexpr size_t WS_BT_UKV = 18 * MiB;
constexpr size_t WS_BT_OD = 20 * MiB, WS_BT_OM = 22 * MiB, WS_BT_OUT = 24 * MiB;
constexpr size_t WS_ROPEA = 26 * MiB;
constexpr size_t WS_ROPEM = 27 * MiB;
constexpr size_t WS_SQ = 31 * MiB;
constexpr size_t WS_SQP = 1 * MiB;
constexpr size_t WS_H = 32 * MiB;
constexpr size_t WS_QA = 64 * MiB, WS_KA = 96 * MiB, WS_VA = 128 * MiB;
constexpr size_t WS_CQ = 160 * MiB, WS_CKV = 184 * MiB, WS_KR = 200 * MiB;
constexpr size_t WS_SQ2 = 202 * MiB;
constexpr size_t WS_GATES = 208 * MiB;
constexpr size_t WS_QM = 272 * MiB;
constexpr size_t WS_KV = 320 * MiB;
constexpr size_t WS_OB = 384 * MiB;
constexpr size_t WS_MRG = 416 * MiB;
constexpr size_t WS_STASH = 448 * MiB;
constexpr size_t WS_ROWTOK = 2 * MiB;
constexpr size_t WS_ASSIGN = 4 * MiB;
constexpr size_t WS_BT_D = 32 * MiB;
constexpr size_t WS_BT_GU = 96 * MiB;
constexpr size_t WS_H2 = 224 * MiB;
constexpr size_t WS_ACT = 256 * MiB;
constexpr size_t WS_Y = 96 * MiB;
constexpr size_t WS_END = 512 * MiB;
constexpr int CW_COUNT = 64;
constexpr int CW_BAR = 4096;

constexpr int RING_BYTES = 131072;
constexpr int TAB_OFF = RING_BYTES;
constexpr int TAB_BYTES = 8192;
constexpr int MISC_OFF = TAB_OFF + TAB_BYTES;
constexpr int LDS_BYTES = 147456;

typedef __bf16 bf16x2_t __attribute__((ext_vector_type(2)));
__device__ __forceinline__ unsigned cvt_pk_bf16(float lo, float hi) { const f32x2 v = {lo, hi}; return __builtin_bit_cast(unsigned, __builtin_convertvector(v, bf16x2_t)); }
__device__ __forceinline__ float bf_lo(unsigned w) { return __uint_as_float(w << 16); }
__device__ __forceinline__ float bf_hi(unsigned w) { return __uint_as_float(w & 0xffff0000u); }
__device__ __forceinline__ float wave_sum(float v) {
#pragma unroll
    for (int o = 1; o < 64; o <<= 1) v += __shfl_xor(v, o);
    return v;
}
__device__ __forceinline__ float sigmoidf_(float x) { return __builtin_amdgcn_rcpf(1.0f + __builtin_amdgcn_exp2f(-1.4426950408889634f * x)); }
__device__ __forceinline__ unsigned cvt_pk_fp8x4(float a, float b, float c, float d) {
    a = fminf(fmaxf(a, -448.f), 448.f); b = fminf(fmaxf(b, -448.f), 448.f); c = fminf(fmaxf(c, -448.f), 448.f); d = fminf(fmaxf(d, -448.f), 448.f);
    int r = __builtin_amdgcn_cvt_pk_fp8_f32(a, b, 0, false); r = __builtin_amdgcn_cvt_pk_fp8_f32(c, d, r, true); return (unsigned)r; }
#define LDS_WAIT() asm volatile("s_waitcnt lgkmcnt(0)" ::: "memory")
#define VM_WAIT() asm volatile("s_waitcnt vmcnt(0)" ::: "memory")

#define XB_TMO      128
#define XB_XCNT(j)  (256  + 64 * (j))
#define XB_XSUB(j)  (1280 + 64 * (j))
#define XB_XGEN(j)  (2304 + 64 * (j))
#define XB_TOP      3328
#define XB_TOPGEN   3392
#define XCD_BAR_WORDS 3456
#define XB_SPIN_CAP (1u << 20)
__device__ __forceinline__ unsigned xb_ld(unsigned* p)              { return __hip_atomic_load(p, __ATOMIC_RELAXED, __HIP_MEMORY_SCOPE_AGENT); }
__device__ __forceinline__ unsigned xb_add(unsigned* p, unsigned v) { return __hip_atomic_fetch_add(p, v, __ATOMIC_RELAXED, __HIP_MEMORY_SCOPE_AGENT); }
__device__ __forceinline__ unsigned xb_xcc_id() { return (unsigned)__builtin_amdgcn_s_getreg((3 << 11) | 20) & 0xFu; }
#define XB_SPIN(cond, bar) do { unsigned _sp = 0; while (cond) { __builtin_amdgcn_s_sleep(1); \
    if ((++_sp & 255u) == 0u) { if (xb_ld(&(bar)[XB_TMO])) break; if (_sp > XB_SPIN_CAP) { atomicAdd(&(bar)[XB_TMO], 1u); break; } } } } while (0)
struct XcdBarrier { unsigned* bar; unsigned x; volatile LAS unsigned* st; };
__device__ __forceinline__ XcdBarrier xcd_barrier_post(unsigned* bar, volatile LAS unsigned* st) {
    XcdBarrier b; b.bar = bar; b.x = xb_xcc_id(); b.st = st;
    if (threadIdx.x == 0) (void)xb_add(&bar[XB_XCNT(b.x)], 1u);
    return b;
}
__device__ __forceinline__ void xcd_barrier_complete(unsigned* bar, unsigned x, unsigned& nloc, unsigned& nx) {
    const unsigned G = gridDim.x * gridDim.y * gridDim.z;
    unsigned sum, cnt, mine, sp = 0u;
    for (;;) {
        sum = 0u; cnt = 0u; mine = 0u;
#pragma unroll
        for (unsigned j = 0; j < 16; ++j) { const unsigned c = xb_ld(&bar[XB_XCNT(j)]); sum += c; cnt += (c > 0u) ? 1u : 0u; mine = (j == x) ? c : mine; }
        if (sum == G) break;
        __builtin_amdgcn_s_sleep(1);
        if ((++sp & 255u) == 0u) { if (xb_ld(&bar[XB_TMO])) break; if (sp > XB_SPIN_CAP) { atomicAdd(&bar[XB_TMO], 1u); break; } }
    }
    nloc = mine > 0u ? mine : 1u; nx = cnt > 0u ? cnt : 1u;
}
__device__ __forceinline__ void xcd_barrier(const XcdBarrier& b) {
    asm volatile("s_waitcnt vmcnt(0)" ::: "memory");
    __syncthreads();
    if (threadIdx.x == 0) {
        unsigned* bar = b.bar;
        __builtin_amdgcn_s_waitcnt(0);
        unsigned nloc = b.st[0], nx = b.st[1];
        if (nloc == 0u) { xcd_barrier_complete(bar, b.x, nloc, nx); b.st[0] = nloc; b.st[1] = nx; }
        const unsigned old = xb_add(&bar[XB_XSUB(b.x)], 1u);
        const unsigned gen = old / nloc;
        if (old + 1u == (gen + 1u) * nloc) {
            __builtin_amdgcn_fence(__ATOMIC_RELEASE, "agent");
            asm volatile("s_waitcnt vmcnt(0)" ::: "memory");
            const unsigned og = xb_add(&bar[XB_TOP], 1u);
            const unsigned tg = og / nx;
            if (og + 1u == (tg + 1u) * nx) xb_add(&bar[XB_TOPGEN], 1u);
            else XB_SPIN(xb_ld(&bar[XB_TOPGEN]) == tg, bar);
            __builtin_amdgcn_fence(__ATOMIC_ACQUIRE, "agent");
            xb_add(&bar[XB_XGEN(b.x)], 1u);
            asm volatile("s_waitcnt vmcnt(0)" ::: "memory");
        } else {
            XB_SPIN(xb_ld(&bar[XB_XGEN(b.x)]) == gen, bar);
            __builtin_amdgcn_fence(__ATOMIC_ACQUIRE, "agent");
            asm volatile("s_waitcnt vmcnt(0)" ::: "memory");
        }
    }
    __syncthreads();
}

namespace pg8 {
constexpr int BM = 256, BK = 64, HALF = 128, HTB = HALF * BK * 2, STAGE_BYTES = 8 * HTB, NXCD = 8, WGM = 8;
__host__ __device__ __forceinline__ int lds_byte(int r, int c) { const int st = (r >> 4) * 2 + (c >> 5), rr = r & 15, cc = c & 31, ob = rr * 64 + cc * 2; return st * 1024 + (ob ^ (((ob >> 9) & 1) << 5)); }
__host__ __device__ __forceinline__ void stage_rc(int b, int& R, int& C) { const int st = b / 1024, sb = b % 1024, swz = sb ^ (((sb >> 9) & 1) << 5); R = (st >> 1) * 16 + swz / 64; C = (st & 1) * 32 + (swz % 64) / 2; }
__host__ __device__ __forceinline__ int perm32(int rho) { const int n = rho >> 4, i = rho & 15; return 8 * (i >> 2) + 4 * n + (i & 3); }

struct Unit { int pm, pn, pb, e, rbase, cnt; };
struct Gemm { const bf16_t* A; const bf16_t* Bt; int K; };

struct DenseOrder {
    int nM, nN, nwg, G, c, pn0;
    __device__ void init(int nM_, int nN_, int G_, int c_, int pn0_ = 0) { nM = nM_; nN = nN_; nwg = nM * nN; G = G_; c = c_; pn0 = pn0_; }
    __device__ __forceinline__ bool next(int i, Unit& u) const {
        const long L = (long)i * G + c; if (L >= nwg) return false;
        int wgid = (int)L; { const int q = nwg / NXCD, r = nwg % NXCD, xcd = wgid % NXCD, off = wgid / NXCD; wgid = (xcd < r ? xcd * (q + 1) : r * (q + 1) + (xcd - r) * q) + off; }
        const int nig = WGM * nN, gid = wgid / nig, fm = gid * WGM, gsz = (nM - fm) < WGM ? (nM - fm) : WGM;
        u.pm = fm + ((wgid % nig) % gsz); u.pn = pn0 + (wgid % nig) / gsz; u.pb = u.pn; u.e = 0; u.rbase = 0; u.cnt = 0; return true;
    }
    __device__ __forceinline__ int a_row(const Unit&, int) const { return 0; }
};
struct MoeOrder {
    int nM, nN, nwg, G, c; const LAS int* t2e; const LAS int* tstart; const LAS int* cnt; const int* rowtok;
    __device__ void init(int nM_, int nN_, int G_, int c_) { nM = nM_; nN = nN_; nwg = nM * nN; G = G_; c = c_; }
    __device__ __forceinline__ bool next(int i, Unit& u) const {
        const long L = (long)i * G + c; if (L >= nwg) return false;
        int wgid = (int)L; { const int q = nwg / NXCD, r = nwg % NXCD, xcd = wgid % NXCD, off = wgid / NXCD; wgid = (xcd < r ? xcd * (q + 1) : r * (q + 1) + (xcd - r) * q) + off; }
        const int nig = WGM * nN, gid = wgid / nig, fm = gid * WGM, gsz = (nM - fm) < WGM ? (nM - fm) : WGM;
        u.pm = fm + ((wgid % nig) % gsz); u.pn = (wgid % nig) / gsz;
        const int e = __builtin_amdgcn_readfirstlane(t2e[u.pm]); u.e = e; u.pb = e * nN + u.pn; u.rbase = (u.pm - __builtin_amdgcn_readfirstlane(tstart[e])) * 256; u.cnt = __builtin_amdgcn_readfirstlane(cnt[e]); return true;
    }
    __device__ __forceinline__ int a_row(const Unit& u, int r) const { const int rank = u.rbase + r; return rank < u.cnt ? rowtok[u.e * T + rank] : 0; }
};

template <class Epi, class Sched, bool GATHER, bool ALIGN_EPI>
__device__ __forceinline__ void gemm_phase(LAS unsigned char* lds, const Gemm g, const Sched& S, const Epi& E) {
    const int tid = threadIdx.x, wid = __builtin_amdgcn_readfirstlane(tid >> 6), lane = tid & 63, wr = wid >> 2, wc = wid & 3, fr = lane & 15, fq = lane >> 4;
    const int K = g.K, nt = K / BK;
    unsigned voffA[2], voffB[2]; int Rv[2], Cv[2];
#pragma unroll
    for (int i = 0; i < 2; ++i) { int R, C; stage_rc(tid * 16 + i * 8192, R, C); const int Rb = Epi::PERM ? ((R & ~31) + perm32(R & 31)) : R;
        voffA[i] = (unsigned)(R * K + C) * 2u; voffB[i] = (unsigned)(Rb * K + C) * 2u; Rv[i] = R; Cv[i] = C; }
    const size_t kstep = (size_t)(BK * 2);
    const size_t hstep = (size_t)HALF * K * 2;
    const size_t tstep = 2 * hstep;
    const unsigned ldsw = (unsigned)wid * 1024u;
    const int aoff = lds_byte(wr * 64 + fr, fq * 8), boff = lds_byte(wc * 32 + fr, fq * 8);
#define PG8_SA(b, h) (((b) * 2 + (h)) * HTB)
#define PG8_SB(b, h) ((4 + (b) * 2 + (h)) * HTB)
#define PG8_STAGE(bufoff, gbase, voff) do { _Pragma("unroll") for (int _i = 0; _i < 2; ++_i) \
        __builtin_amdgcn_global_load_lds((const unsigned*)((const char*)(gbase) + (voff)[_i]), (LAS unsigned*)(lds + (bufoff) + ldsw + _i * 8192), 16, 0, 0); } while (0)
#define PG8_LDA(dst, b, h) do { _Pragma("unroll") for (int m = 0; m < 4; ++m) _Pragma("unroll") for (int k = 0; k < 2; ++k) dst[m][k] = *(const LAS bf16x8*)(lds + PG8_SA(b, h) + aoff + m * 2048 + k * 1024); } while (0)
#define PG8_LDB(dst, b, h) do { _Pragma("unroll") for (int n = 0; n < 2; ++n) _Pragma("unroll") for (int k = 0; k < 2; ++k) dst[n][k] = *(const LAS bf16x8*)(lds + PG8_SB(b, h) + boff + n * 2048 + k * 1024); } while (0)
#define PG8_MMA(ai, bj, At, Bt) do { __builtin_amdgcn_s_setprio(1); _Pragma("unroll") for (int m = 0; m < 4; ++m) _Pragma("unroll") for (int n = 0; n < 2; ++n) _Pragma("unroll") for (int k = 0; k < 2; ++k) \
        acc[ai][bj][m][n] = __builtin_amdgcn_mfma_f32_16x16x32_bf16(Bt[n][k], At[m][k], acc[ai][bj][m][n], 0, 0, 0); __builtin_amdgcn_s_setprio(0); } while (0)
#define PG8_WAIT_V(n) asm volatile("s_waitcnt vmcnt(" #n ")" ::: "memory")
#define PG8_WAIT_L(n) asm volatile("s_waitcnt lgkmcnt(" #n ")" ::: "memory")
#define PG8_BAR __builtin_amdgcn_s_barrier()
#define PG8_SCHED __builtin_amdgcn_sched_barrier(0)
    Unit cur, nxt; int ui = 0;
    if (!S.next(0, cur)) return;
    f32x4 acc[2][2][4][2];
#pragma unroll
    for (int a = 0; a < 2; ++a)
#pragma unroll
        for (int b = 0; b < 2; ++b)
#pragma unroll
            for (int m = 0; m < 4; ++m)
#pragma unroll
                for (int n = 0; n < 2; ++n) acc[a][b][m][n] = (f32x4){0.f, 0.f, 0.f, 0.f};
    bf16x8 At[4][2], B0[2][2], B1[2][2];
    unsigned gC0[2], gC1[2], gN0[2], gN1[2];
    if constexpr (GATHER) {
#pragma unroll
        for (int i = 0; i < 2; ++i) { gC0[i] = (unsigned)S.a_row(cur, Rv[i]) * (unsigned)(K * 2) + (unsigned)Cv[i] * 2u; gC1[i] = (unsigned)S.a_row(cur, HALF + Rv[i]) * (unsigned)(K * 2) + (unsigned)Cv[i] * 2u; gN0[i] = gC0[i]; gN1[i] = gC1[i]; }
    }
    const char* cA = GATHER ? (const char*)g.A : (const char*)g.A + (size_t)cur.pm * tstep; const char* cB = (const char*)g.Bt + (size_t)cur.pb * tstep;
#define PG8_STAGE_A(bufoff, p, h, o0, o1) do { if constexpr (GATHER) { if ((h) == 0) PG8_STAGE(bufoff, p, o0); else PG8_STAGE(bufoff, p, o1); } else { PG8_STAGE(bufoff, (p) + (h) * hstep, voffA); } } while (0)
    PG8_STAGE(PG8_SB(0, 0), cB, voffB); PG8_STAGE(PG8_SB(0, 1), cB + hstep, voffB); PG8_STAGE_A(PG8_SA(0, 0), cA, 0, gC0, gC1); PG8_STAGE_A(PG8_SA(0, 1), cA, 1, gC0, gC1);
    if (wr == 1) PG8_BAR;
    PG8_WAIT_V(2); PG8_BAR;
    PG8_STAGE(PG8_SB(1, 0), cB + kstep, voffB); PG8_STAGE_A(PG8_SA(1, 0), cA + kstep, 0, gC0, gC1); PG8_STAGE(PG8_SB(1, 1), cB + hstep + kstep, voffB);
    PG8_WAIT_V(6); PG8_BAR;
    for (;;) {
        const bool has_next = S.next(ui + 1, nxt);
        const char* nA = GATHER ? (const char*)g.A : (has_next ? (const char*)g.A + (size_t)nxt.pm * tstep : cA); const char* nB = has_next ? (const char*)g.Bt + (size_t)nxt.pb * tstep : cB;
        if constexpr (GATHER) { if (has_next) {
#pragma unroll
            for (int i = 0; i < 2; ++i) { gN0[i] = (unsigned)S.a_row(nxt, Rv[i]) * (unsigned)(K * 2) + (unsigned)Cv[i] * 2u; gN1[i] = (unsigned)S.a_row(nxt, HALF + Rv[i]) * (unsigned)(K * 2) + (unsigned)Cv[i] * 2u; } } }
        for (int t = 0; t < nt; t += 2) {
            const bool last = (t == nt - 2);
            const char* a1 = cA + (size_t)(t + 1) * kstep;
            const char* a2 = last ? nA : cA + (size_t)(t + 2) * kstep; const char* b2 = last ? nB : cB + (size_t)(t + 2) * kstep;
            const char* a3 = a2 + kstep; const char* b3 = b2 + kstep;
            unsigned s0[2], s1[2];
            if constexpr (GATHER) { s0[0] = last ? gN0[0] : gC0[0]; s0[1] = last ? gN0[1] : gC0[1]; s1[0] = last ? gN1[0] : gC1[0]; s1[1] = last ? gN1[1] : gC1[1]; }
            PG8_LDB(B0, 0, 0); PG8_LDB(B1, 0, 1); PG8_SCHED; PG8_LDA(At, 0, 0); PG8_STAGE_A(PG8_SA(1, 1), a1, 1, gC0, gC1);
            PG8_WAIT_V(8); PG8_WAIT_L(0); PG8_BAR; PG8_MMA(0, 0, At, B0); PG8_MMA(0, 1, At, B1); PG8_BAR; PG8_SCHED;
            PG8_LDA(At, 0, 1); PG8_STAGE(PG8_SB(0, 0), b2, voffB); PG8_STAGE(PG8_SB(0, 1), b2 + hstep, voffB); PG8_STAGE_A(PG8_SA(0, 0), a2, 0, s0, s1);
            PG8_WAIT_V(8); PG8_WAIT_L(0); PG8_BAR; PG8_MMA(1, 0, At, B0); PG8_MMA(1, 1, At, B1); PG8_BAR; PG8_SCHED;
            PG8_LDB(B0, 1, 0); PG8_LDB(B1, 1, 1); PG8_SCHED; PG8_LDA(At, 1, 0); PG8_STAGE_A(PG8_SA(0, 1), a2, 1, s0, s1);
            PG8_WAIT_V(8); PG8_WAIT_L(0); PG8_BAR; PG8_MMA(0, 0, At, B0); PG8_MMA(0, 1, At, B1); PG8_BAR; PG8_SCHED;
            PG8_LDA(At, 1, 1); PG8_STAGE(PG8_SB(1, 0), b3, voffB); PG8_STAGE(PG8_SB(1, 1), b3 + hstep, voffB); PG8_STAGE_A(PG8_SA(1, 0), a3, 0, s0, s1);
            PG8_WAIT_V(8); PG8_WAIT_L(0); PG8_BAR; PG8_MMA(1, 0, At, B0); PG8_MMA(1, 1, At, B1); PG8_BAR; PG8_SCHED;
        }
        if constexpr (ALIGN_EPI) { if (wr == 0) PG8_BAR; }
        E(acc, cur, wr, wc, fr, fq);
        if (!has_next) break;
#pragma unroll
        for (int a = 0; a < 2; ++a)
#pragma unroll
            for (int b = 0; b < 2; ++b)
#pragma unroll
                for (int m = 0; m < 4; ++m)
#pragma unroll
                    for (int n = 0; n < 2; ++n) acc[a][b][m][n] = (f32x4){0.f, 0.f, 0.f, 0.f};
        cur = nxt; cA = nA; cB = nB; ++ui;
        if constexpr (GATHER) { gC0[0] = gN0[0]; gC0[1] = gN0[1]; gC1[0] = gN1[0]; gC1[1] = gN1[1]; }
        if constexpr (ALIGN_EPI) { if (wr == 1) PG8_BAR; }
    }
    PG8_WAIT_V(0);
    if constexpr (!ALIGN_EPI) { if (wr == 0) PG8_BAR; }
    PG8_BAR;
#undef PG8_SA
#undef PG8_SB
#undef PG8_STAGE
#undef PG8_STAGE_A
#undef PG8_LDA
#undef PG8_LDB
#undef PG8_MMA
#undef PG8_WAIT_V
#undef PG8_WAIT_L
#undef PG8_BAR
#undef PG8_SCHED
}

template <class Epi, class Sched, bool GATHER = false>
__device__ __forceinline__ void gemm_phase_f8n(LAS unsigned char* lds, const Gemm g, const Sched& S, const Epi& E) {
    const int tid = threadIdx.x, wid = __builtin_amdgcn_readfirstlane(tid >> 6), lane = tid & 63, wr = wid >> 2, wc = wid & 3, fr = lane & 15, fq = lane >> 4;
    const int K = g.K, nt = K / BK;
    unsigned voffA[2], voffB[2]; int Rv[2], Cv[2];
#pragma unroll
    for (int i = 0; i < 2; ++i) { int R, C; stage_rc(tid * 16 + i * 8192, R, C); const int Rb = (R & ~31) + perm32(R & 31);
        voffA[i] = (unsigned)(R * K + C) * 2u; voffB[i] = (unsigned)(Rb * K + C) * 2u; Rv[i] = R; Cv[i] = C; }
    const size_t kstep = (size_t)(BK * 2), hstep = (size_t)HALF * K * 2, tstep = 2 * hstep;
    const unsigned ldsw = (unsigned)wid * 1024u;
    const int aoff = lds_byte(wr * 64 + fr, fq * 8), boff = lds_byte(wc * 32 + fr, fq * 8);
    typedef int v8i_t __attribute__((ext_vector_type(8))); typedef int v4i_t __attribute__((ext_vector_type(4)));
#define F8_SA(b, h) (((b) * 2 + (h)) * HTB)
#define F8_SB(b) ((4 + (b) * 2) * HTB)
#define F8_STAGE(bufoff, gbase, voff) do { _Pragma("unroll") for (int _i = 0; _i < 2; ++_i) \
        __builtin_amdgcn_global_load_lds((const unsigned*)((const char*)(gbase) + (voff)[_i]), (LAS unsigned*)(lds + (bufoff) + ldsw + _i * 8192), 16, 0, 0); } while (0)
#define F8_LDA(b, h) do { _Pragma("unroll") for (int m = 0; m < 4; ++m) _Pragma("unroll") for (int k = 0; k < 2; ++k) At[m][k] = *(const LAS bf16x8*)(lds + F8_SA(b, h) + aoff + m * 2048 + k * 1024); } while (0)
#define F8_LDB(b) do { _Pragma("unroll") for (int n = 0; n < 2; ++n) _Pragma("unroll") for (int k = 0; k < 2; ++k) B0[n][k] = *(const LAS bf16x8*)(lds + F8_SB(b) + boff + n * 2048 + k * 1024); } while (0)
#define F8_CAT(x0, x1) __builtin_shufflevector(__builtin_bit_cast(v4i_t, x0), __builtin_bit_cast(v4i_t, x1), 0, 1, 2, 3, 4, 5, 6, 7)
#define F8_MMA(ai) do { __builtin_amdgcn_s_setprio(1); _Pragma("unroll") for (int m = 0; m < 4; ++m) _Pragma("unroll") for (int n = 0; n < 2; ++n) \
        acc[ai][m][n] = __builtin_amdgcn_mfma_scale_f32_16x16x128_f8f6f4(F8_CAT(B0[n][0], B0[n][1]), F8_CAT(At[m][0], At[m][1]), acc[ai][m][n], 0, 0, 0, 0x79797979, 0, 0x7f7f7f7f); \
        __builtin_amdgcn_s_setprio(0); } while (0)
#define F8_WAIT_V(n) asm volatile("s_waitcnt vmcnt(" #n ")" ::: "memory")
#define F8_WAIT_L(n) asm volatile("s_waitcnt lgkmcnt(" #n ")" ::: "memory")
#define F8_BAR __builtin_amdgcn_s_barrier()
#define F8_SCHED __builtin_amdgcn_sched_barrier(0)
    Unit cur, nxt; int ui = 0;
    if (!S.next(0, cur)) return;
    f32x4 acc[2][4][2];
#pragma unroll
    for (int a = 0; a < 2; ++a)
#pragma unroll
        for (int m = 0; m < 4; ++m)
#pragma unroll
            for (int n = 0; n < 2; ++n) acc[a][m][n] = (f32x4){0.f, 0.f, 0.f, 0.f};
    bf16x8 At[4][2], B0[2][2];
    unsigned gC0[2], gC1[2], gN0[2], gN1[2];
    if constexpr (GATHER) {
#pragma unroll
        for (int i = 0; i < 2; ++i) { gC0[i] = (unsigned)S.a_row(cur, Rv[i]) * (unsigned)(K * 2) + (unsigned)Cv[i] * 2u; gC1[i] = (unsigned)S.a_row(cur, HALF + Rv[i]) * (unsigned)(K * 2) + (unsigned)Cv[i] * 2u; gN0[i] = gC0[i]; gN1[i] = gC1[i]; }
    }
    const char* cA = GATHER ? (const char*)g.A : (const char*)g.A + (size_t)cur.pm * tstep; const char* cB = (const char*)g.Bt + (size_t)cur.pb * hstep;
#define F8_STAGE_A(bufoff, p, h, o0, o1) do { if constexpr (GATHER) { if ((h) == 0) F8_STAGE(bufoff, p, o0); else F8_STAGE(bufoff, p, o1); } else { F8_STAGE(bufoff, (p) + (h) * hstep, voffA); } } while (0)
    F8_STAGE(F8_SB(0), cB, voffB); F8_STAGE_A(F8_SA(0, 0), cA, 0, gC0, gC1); F8_STAGE_A(F8_SA(0, 1), cA, 1, gC0, gC1);
    if (wr == 1) F8_BAR;
    F8_WAIT_V(2); F8_BAR;
    F8_STAGE(F8_SB(1), cB + kstep, voffB); F8_STAGE_A(F8_SA(1, 0), cA + kstep, 0, gC0, gC1);
    F8_WAIT_V(4); F8_BAR;
    for (;;) {
        const bool has_next = S.next(ui + 1, nxt);
        const char* nA = GATHER ? (const char*)g.A : (has_next ? (const char*)g.A + (size_t)nxt.pm * tstep : cA); const char* nB = has_next ? (const char*)g.Bt + (size_t)nxt.pb * hstep : cB;
        if constexpr (GATHER) { if (has_next) {
#pragma unroll
            for (int i = 0; i < 2; ++i) { gN0[i] = (unsigned)S.a_row(nxt, Rv[i]) * (unsigned)(K * 2) + (unsigned)Cv[i] * 2u; gN1[i] = (unsigned)S.a_row(nxt, HALF + Rv[i]) * (unsigned)(K * 2) + (unsigned)Cv[i] * 2u; } } }
#pragma unroll 1
        for (int t = 0; t < nt; t += 2) {
            const bool last = (t == nt - 2);
            const char* a1 = cA + (size_t)(t + 1) * kstep;
            const char* a2 = last ? nA : cA + (size_t)(t + 2) * kstep; const char* b2 = last ? nB : cB + (size_t)(t + 2) * kstep;
            const char* a3 = a2 + kstep; const char* b3 = b2 + kstep;
            unsigned s0[2], s1[2];
            if constexpr (GATHER) { s0[0] = last ? gN0[0] : gC0[0]; s0[1] = last ? gN0[1] : gC0[1]; s1[0] = last ? gN1[0] : gC1[0]; s1[1] = last ? gN1[1] : gC1[1]; }
            F8_LDB(0); F8_SCHED; F8_LDA(0, 0); F8_STAGE_A(F8_SA(1, 1), a1, 1, gC0, gC1);
            F8_WAIT_V(6); F8_WAIT_L(0); F8_BAR; F8_MMA(0); F8_BAR; F8_SCHED;
            F8_LDA(0, 1); F8_STAGE(F8_SB(0), b2, voffB); F8_STAGE_A(F8_SA(0, 0), a2, 0, s0, s1);
            F8_WAIT_V(6); F8_WAIT_L(0); F8_BAR; F8_MMA(1); F8_BAR; F8_SCHED;
            F8_LDB(1); F8_SCHED; F8_LDA(1, 0); F8_STAGE_A(F8_SA(0, 1), a2, 1, s0, s1);
            F8_WAIT_V(6); F8_WAIT_L(0); F8_BAR; F8_MMA(0); F8_BAR; F8_SCHED;
            F8_LDA(1, 1); F8_STAGE(F8_SB(1), b3, voffB); F8_STAGE_A(F8_SA(1, 0), a3, 0, s0, s1);
            F8_WAIT_V(6); F8_WAIT_L(0); F8_BAR; F8_MMA(1); F8_BAR; F8_SCHED;
        }
        if (wr == 0) F8_BAR;
        E(acc, cur, wr, wc, fr, fq);
        if (!has_next) break;
#pragma unroll
        for (int a = 0; a < 2; ++a)
#pragma unroll
            for (int m = 0; m < 4; ++m)
#pragma unroll
                for (int n = 0; n < 2; ++n) acc[a][m][n] = (f32x4){0.f, 0.f, 0.f, 0.f};
        cur = nxt; cA = nA; cB = nB; ++ui;
        if constexpr (GATHER) { gC0[0] = gN0[0]; gC0[1] = gN0[1]; gC1[0] = gN1[0]; gC1[1] = gN1[1]; }
        if (wr == 1) F8_BAR;
    }
    F8_WAIT_V(0);
    F8_BAR;
#undef F8_SA
#undef F8_SB
#undef F8_STAGE
#undef F8_LDA
#undef F8_LDB
#undef F8_CAT
#undef F8_MMA
#undef F8_WAIT_V
#undef F8_WAIT_L
#undef F8_BAR
#undef F8_SCHED
#undef F8_STAGE_A
}

__device__ __forceinline__ u32x4 pack8(const f32x4& v0, const f32x4& v1) { u32x4 w; w.x = cvt_pk_bf16(v0[0], v0[1]); w.y = cvt_pk_bf16(v0[2], v0[3]); w.z = cvt_pk_bf16(v1[0], v1[1]); w.w = cvt_pk_bf16(v1[2], v1[3]); return w; }
__device__ __forceinline__ void rope4(f32x4& v0, f32x4& v1, const float* cs) {
    const f32x4 a = *(const f32x4*)cs, b = *(const f32x4*)(cs + 4);
    float x1, x2;
    x1 = v0[0]; x2 = v0[1]; v0[0] = x1 * a[0] - x2 * a[1]; v0[1] = x2 * a[0] + x1 * a[1];
    x1 = v0[2]; x2 = v0[3]; v0[2] = x1 * a[2] - x2 * a[3]; v0[3] = x2 * a[2] + x1 * a[3];
    x1 = v1[0]; x2 = v1[1]; v1[0] = x1 * b[0] - x2 * b[1]; v1[1] = x2 * b[0] + x1 * b[1];
    x1 = v1[2]; x2 = v1[3]; v1[2] = x1 * b[2] - x2 * b[3]; v1[3] = x2 * b[2] + x1 * b[3];
}

struct EpiIn {
    static constexpr bool PERM = true;
    bf16_t *qa, *ka, *va, *cq, *ckv, *gates, *kr; const float *ropeA, *ropeM, *bg; float* sq;
    __device__ __forceinline__ void operator()(const f32x4 (&acc)[2][2][4][2], const Unit& u, int wr, int wc, int fr, int fq) const {
        const int pn = u.pn, row0 = u.pm * BM + wr * 64 + fr, cl = wc * 32 + 8 * fq;
        if (pn < 8) {
            bf16_t* dst = pn < 4 ? qa : ka; const int colt = (pn & 3) * 256; const bool rot = ((wc & 1) == 0) && (fq < 2);
#pragma unroll
            for (int ai = 0; ai < 2; ++ai)
#pragma unroll
                for (int m = 0; m < 4; ++m) { const int row = row0 + ai * HALF + m * 16;
#pragma unroll
                    for (int bj = 0; bj < 2; ++bj) { f32x4 v0 = acc[ai][bj][m][0], v1 = acc[ai][bj][m][1];
                        if (rot) rope4(v0, v1, ropeA + (size_t)row * 16 + fq * 8);
                        *(u32x4*)(dst + (size_t)row * 1024 + colt + bj * HALF + cl) = pack8(v0, v1); } }
        } else if (pn < 12) {
            const int colt = (pn - 8) * 256;
#pragma unroll
            for (int ai = 0; ai < 2; ++ai)
#pragma unroll
                for (int m = 0; m < 4; ++m) { const int row = row0 + ai * HALF + m * 16;
#pragma unroll
                    for (int bj = 0; bj < 2; ++bj) *(u32x4*)(va + (size_t)row * 1024 + colt + bj * HALF + cl) = pack8(acc[ai][bj][m][0], acc[ai][bj][m][1]); }
        } else if (pn < 17) {
            const bool isq = pn < 15; bf16_t* dst = isq ? cq : ckv; const int ld = isq ? QL : KVL, colt = (isq ? pn - 12 : pn - 15) * 256, tq = pn - 12;
#pragma unroll
            for (int ai = 0; ai < 2; ++ai)
#pragma unroll
                for (int m = 0; m < 4; ++m) { const int row = row0 + ai * HALF + m * 16; float s = 0.f;
#pragma unroll
                    for (int bj = 0; bj < 2; ++bj) { const f32x4 v0 = acc[ai][bj][m][0], v1 = acc[ai][bj][m][1];
                        s += (v0[0] * v0[0] + v0[1] * v0[1]) + (v0[2] * v0[2] + v0[3] * v0[3]) + (v1[0] * v1[0] + v1[1] * v1[1]) + (v1[2] * v1[2] + v1[3] * v1[3]);
                        *(u32x4*)(dst + (size_t)row * ld + colt + bj * HALF + cl) = pack8(v0, v1); }
                    s += __shfl_xor(s, 16); s += __shfl_xor(s, 32);
                    if (fq == 0) sq[(size_t)row * 20 + tq * 4 + wc] = s; }
        } else if (pn != 23) {
            const int colt = (pn < 23 ? pn - 17 : pn - 18) * 256;
            f32x4 bv[2][2];
#pragma unroll
            for (int bj = 0; bj < 2; ++bj) { bv[bj][0] = *(const f32x4*)(bg + colt + bj * HALF + cl); bv[bj][1] = *(const f32x4*)(bg + colt + bj * HALF + cl + 4); if (DBG_SKIP & 256) { bv[bj][0] = bv[bj][0] * 0.f; bv[bj][1] = bv[bj][1] * 0.f; } }
#pragma unroll
            for (int ai = 0; ai < 2; ++ai)
#pragma unroll
                for (int m = 0; m < 4; ++m) { const int row = row0 + ai * HALF + m * 16;
#pragma unroll
                    for (int bj = 0; bj < 2; ++bj) { f32x4 v0 = acc[ai][bj][m][0] + bv[bj][0], v1 = acc[ai][bj][m][1] + bv[bj][1];
#pragma unroll
                        for (int j = 0; j < 4; ++j) { if (!(DBG_SKIP & 512)) { v0[j] = sigmoidf_(v0[j]); v1[j] = sigmoidf_(v1[j]); } }
                        *(u32x4*)(gates + (size_t)row * 2048 + colt + bj * HALF + cl) = pack8(v0, v1); } }
        } else {
            if (wc < 2) {
#pragma unroll
                for (int ai = 0; ai < 2; ++ai)
#pragma unroll
                    for (int m = 0; m < 4; ++m) { const int row = row0 + ai * HALF + m * 16;
                        f32x4 v0 = acc[ai][0][m][0], v1 = acc[ai][0][m][1];
                        rope4(v0, v1, ropeM + (size_t)row * 64 + (wc * 16 + fq * 4) * 2);
                        *(u32x4*)(kr + (size_t)row * 64 + cl) = pack8(v0, v1); }
            }
        }
    }
};
template <bool ISQ> struct EpiUp {
    static constexpr bool PERM = true;
    bf16_t* out; const float* sq; const float* ropeM;
    __device__ __forceinline__ void operator()(const f32x4 (&acc)[2][2][4][2], const Unit& u, int wr, int wc, int fr, int fq) const {
        const int row0 = u.pm * BM + wr * 64 + fr, cl = wc * 32 + 8 * fq; constexpr int LD = ISQ ? 1536 : 2048;
#pragma unroll
        for (int ai = 0; ai < 2; ++ai)
#pragma unroll
            for (int m = 0; m < 4; ++m) { const int row = row0 + ai * HALF + m * 16; float s;
                if (ISQ) { const f32x4 a = *(const f32x4*)(sq + (size_t)row * 20), b = *(const f32x4*)(sq + (size_t)row * 20 + 4), c = *(const f32x4*)(sq + (size_t)row * 20 + 8);
                    s = ((a[0] + a[1]) + (a[2] + a[3])) + ((b[0] + b[1]) + (b[2] + b[3])) + ((c[0] + c[1]) + (c[2] + c[3])); }
                else { const f32x4 a = *(const f32x4*)(sq + (size_t)row * 20 + 12), b = *(const f32x4*)(sq + (size_t)row * 20 + 16);
                    s = ((a[0] + a[1]) + (a[2] + a[3])) + ((b[0] + b[1]) + (b[2] + b[3])); }
                const float rstd = __builtin_amdgcn_rsqf(s * (ISQ ? 1.0f / QL : 1.0f / KVL) + EPS);
#pragma unroll
                for (int bj = 0; bj < 2; ++bj) { const int col = u.pn * BM + bj * HALF + cl; f32x4 v0 = acc[ai][bj][m][0] * rstd, v1 = acc[ai][bj][m][1] * rstd;
                    if (ISQ) { const int off = col % 192; if (off >= 128) rope4(v0, v1, ropeM + (size_t)row * 64 + (off - 128)); }
                    *(u32x4*)(out + (size_t)row * LD + col) = pack8(v0, v1); } }
    }
};
template <int WHICH> struct EpiGate {
    static constexpr bool PERM = true;
    bf16_t* mrg; const bf16_t* gates;
    __device__ __forceinline__ void operator()(const f32x4 (&acc)[2][2][4][2], const Unit& u, int wr, int wc, int fr, int fq) const {
        const int row0 = u.pm * BM + wr * 64 + fr, cl = wc * 32 + 8 * fq;
#pragma unroll
        for (int ai = 0; ai < 2; ++ai)
#pragma unroll
            for (int m = 0; m < 4; ++m) { const int row = row0 + ai * HALF + m * 16;
#pragma unroll
                for (int bj = 0; bj < 2; ++bj) { const int col = u.pn * BM + bj * HALF + cl;
                    const u32x4 gw = *(const u32x4*)(gates + (size_t)row * 2048 + WHICH * 1024 + col);
                    f32x4 v0 = acc[ai][bj][m][0], v1 = acc[ai][bj][m][1];
                    if ((DBG_SKIP & 8) && WHICH == 0) { v0 = v0 * 0.f; v1 = v1 * 0.f; } if ((DBG_SKIP & 16) && WHICH == 1) { v0 = v0 * 0.f; v1 = v1 * 0.f; }
                    v0[0] *= bf_lo(gw.x); v0[1] *= bf_hi(gw.x); v0[2] *= bf_lo(gw.y); v0[3] *= bf_hi(gw.y); v1[0] *= bf_lo(gw.z); v1[1] *= bf_hi(gw.z); v1[2] *= bf_lo(gw.w); v1[3] *= bf_hi(gw.w);
                    if (WHICH == 1) { const u32x4 tw = *(const u32x4*)(mrg + (size_t)row * 1024 + col);
                        v0[0] += bf_lo(tw.x); v0[1] += bf_hi(tw.x); v0[2] += bf_lo(tw.y); v0[3] += bf_hi(tw.y); v1[0] += bf_lo(tw.z); v1[1] += bf_hi(tw.z); v1[2] += bf_lo(tw.w); v1[3] += bf_hi(tw.w); }
                    *(u32x4*)(mrg + (size_t)row * 1024 + col) = pack8(v0, v1); } }
    }
};
struct EpiRes {
    static constexpr bool PERM = false;
    const float* x; float* out;
    __device__ __forceinline__ void operator()(const f32x4 (&acc)[2][2][4][2], const Unit& u, int wr, int wc, int fr, int fq) const {
        const int row0 = u.pm * BM + wr * 64 + fr, col0 = u.pn * BM + wc * 32 + 4 * fq;
#pragma unroll
        for (int ai = 0; ai < 2; ++ai)
#pragma unroll
            for (int m = 0; m < 4; ++m) { const size_t off = (size_t)(row0 + ai * HALF + m * 16) * 1024 + col0;
#pragma unroll
                for (int bj = 0; bj < 2; ++bj)
#pragma unroll
                    for (int n = 0; n < 2; ++n) *(f32x4*)(out + off + bj * HALF + n * 16) = *(const f32x4*)(x + off + bj * HALF + n * 16) + ((DBG_SKIP & 2) ? 0.f : 1.f) * acc[ai][bj][m][n]; }
    }
};
struct EpiSwiglu {
    static constexpr bool PERM = true;
    bf16_t* act; const float *bgate, *bup;
    __device__ __forceinline__ void operator()(const f32x4 (&acc)[2][2][4][2], const Unit& u, int wr, int wc, int fr, int fq) const {
        const int row0 = u.pm * BM + wr * 64 + fr, f0 = u.pn * HALF + wc * 32 + 8 * fq;
        f32x4 bgv[2], buv[2];
#pragma unroll
        for (int n = 0; n < 2; ++n) { bgv[n] = *(const f32x4*)(bgate + (size_t)u.e * FF + f0 + 4 * n); buv[n] = *(const f32x4*)(bup + (size_t)u.e * FF + f0 + 4 * n); }
#pragma unroll
        for (int ai = 0; ai < 2; ++ai)
#pragma unroll
            for (int m = 0; m < 4; ++m) { const int row = row0 + ai * HALF + m * 16; f32x4 o[2];
#pragma unroll
                for (int n = 0; n < 2; ++n) { const f32x4 gt = acc[ai][0][m][n] + bgv[n], up = acc[ai][1][m][n] + buv[n];
#pragma unroll
                    for (int j = 0; j < 4; ++j) { const float gg = fminf(gt[j], 7.0f), uu = fminf(fmaxf(up[j], -7.0f), 7.0f); o[n][j] = (uu + 1.0f) * (gg * sigmoidf_(1.702f * gg)); } }
                u32x2 w8; w8.x = cvt_pk_fp8x4(o[0][0], o[0][1], o[0][2], o[0][3]); w8.y = cvt_pk_fp8x4(o[1][0], o[1][1], o[1][2], o[1][3]);
                *(u32x2*)((unsigned char*)act + (size_t)row * FF + f0) = w8; }
    }
};
struct EpiDown {
    static constexpr bool PERM = true;
    bf16_t* y; const float* bd;
    __device__ __forceinline__ void operator()(const f32x4 (&acc)[2][2][4][2], const Unit& u, int wr, int wc, int fr, int fq) const {
        const int row0 = u.pm * BM + wr * 64 + fr, cl = wc * 32 + 8 * fq;
        f32x4 bv[2][2];
#pragma unroll
        for (int bj = 0; bj < 2; ++bj) { const int col = u.pn * BM + bj * HALF + cl; bv[bj][0] = *(const f32x4*)(bd + (size_t)u.e * D + col); bv[bj][1] = *(const f32x4*)(bd + (size_t)u.e * D + col + 4); }
#pragma unroll
        for (int ai = 0; ai < 2; ++ai)
#pragma unroll
            for (int m = 0; m < 4; ++m) { const int row = row0 + ai * HALF + m * 16;
#pragma unroll
                for (int bj = 0; bj < 2; ++bj) { const int col = u.pn * BM + bj * HALF + cl;
                    *(u32x4*)(y + (size_t)row * D + col) = pack8(acc[ai][bj][m][0] + bv[bj][0], acc[ai][bj][m][1] + bv[bj][1]); } }
    }
};
struct EpiSwiglu8 {
    unsigned char* act; const float *bgate, *bup;
    __device__ __forceinline__ void operator()(const f32x4 (&acc)[2][4][2], const Unit& u, int wr, int wc, int fr, int fq) const {
        const int row0 = u.pm * BM + wr * 64 + fr, f0 = u.pn * 64 + wc * 16 + 4 * fq;
        const f32x4 bgv = *(const f32x4*)(bgate + (size_t)u.e * FF + f0), buv = *(const f32x4*)(bup + (size_t)u.e * FF + f0);
#pragma unroll
        for (int ai = 0; ai < 2; ++ai)
#pragma unroll
            for (int m = 0; m < 4; ++m) { const int row = row0 + ai * HALF + m * 16; const f32x4 gt = acc[ai][m][0] + bgv, up = acc[ai][m][1] + buv; float o[4];
#pragma unroll
                for (int j = 0; j < 4; ++j) { const float gg = fminf(gt[j], 7.0f), uu = fminf(fmaxf(up[j], -7.0f), 7.0f); o[j] = (uu + 1.0f) * (gg * sigmoidf_(1.702f * gg)); }
                *(unsigned*)(act + (size_t)row * FF + f0) = cvt_pk_fp8x4(o[0], o[1], o[2], o[3]); }
    }
};
struct EpiDown8 {
    bf16_t* y; const float* bd;
    __device__ __forceinline__ void operator()(const f32x4 (&acc)[2][4][2], const Unit& u, int wr, int wc, int fr, int fq) const {
        const int row0 = u.pm * BM + wr * 64 + fr, col = u.pn * HALF + wc * 32 + 8 * fq;
        const f32x4 bv0 = *(const f32x4*)(bd + (size_t)u.e * D + col), bv1 = *(const f32x4*)(bd + (size_t)u.e * D + col + 4);
#pragma unroll
        for (int ai = 0; ai < 2; ++ai)
#pragma unroll
            for (int m = 0; m < 4; ++m) { const int row = row0 + ai * HALF + m * 16;
                *(u32x4*)(y + (size_t)row * D + col) = pack8(acc[ai][m][0] + bv0, acc[ai][m][1] + bv1); }
    }
};
}

namespace att {
constexpr int NW = 8, QBLK = 32, KVBLK = 64;
constexpr int SHM_V = KVBLK * 128 * 2;
#define SBAR() __builtin_amdgcn_sched_barrier(0)
#define KSW(row, colB) ((row) * 128 + ((colB) ^ ((((row) >> 1) & 7) << 4)))
__device__ __forceinline__ int crow(int r, int hi) { return (r & 3) + 8 * (r >> 2) + 4 * hi; }
struct Src { const bf16_t* Q; const bf16_t* K; const bf16_t* K2; const bf16_t* V; int ldq, ldk, ldk2, ldv; };

__device__ __forceinline__ void partialSM(f32x16& p0, f32x16& p1, float& m_reg, float& mn, float& alpha, const float C, const float thr) {
  float pmax;
  { float a0 = fmaxf(fmaxf(p0[0], p0[1]), p0[2]), a1 = fmaxf(fmaxf(p0[3], p0[4]), p0[5]), a2 = fmaxf(fmaxf(p1[0], p1[1]), p1[2]), a3 = fmaxf(fmaxf(p1[3], p1[4]), p1[5]);
#pragma unroll
    for (int r = 6; r < 16; r += 2) { a0 = fmaxf(fmaxf(a0, p0[r]), p0[r + 1]); a2 = fmaxf(fmaxf(a2, p1[r]), p1[r + 1]); }
    pmax = fmaxf(fmaxf(a0, a1), fmaxf(a2, a3)); }
  { auto rr = __builtin_amdgcn_permlane32_swap(__float_as_uint(pmax), __float_as_uint(pmax), false, false);
    pmax = fmaxf(__uint_as_float(rr[0]), __uint_as_float(rr[1])); }
  if (__builtin_expect(__all(pmax - m_reg <= thr), 1)) { mn = m_reg; alpha = 1.f; }
  else { mn = fmaxf(m_reg, pmax); alpha = __builtin_amdgcn_exp2f((m_reg - mn) * C); m_reg = mn; }
  const float mnC = -mn * C;
#pragma unroll
  for (int r = 0; r < 16; ++r) p0[r] = fmaf(p0[r], C, mnC);
#pragma unroll
  for (int r = 0; r < 16; ++r) p1[r] = fmaf(p1[r], C, mnC);
#pragma unroll
  for (int r = 0; r < 16; ++r) p0[r] = __builtin_amdgcn_exp2f(p0[r]);
#if ATT_DUP == 1
  { float d_[16];
#pragma unroll
    for (int r = 0; r < 16; ++r) { d_[r] = __builtin_amdgcn_exp2f(p1[r]); d_[r] = fmaf(d_[r], C, mnC); }
#pragma unroll
    for (int r = 0; r < 16; ++r) asm volatile("" :: "v"(d_[r])); }
#endif
}
__device__ __forceinline__ void finishSM(f32x16& p0, f32x16& p1, float alpha, float& l_reg, bf16x8& pa0, bf16x8& pa1, bf16x8& pa2, bf16x8& pa3) {
#pragma unroll
  for (int r = 0; r < 16; ++r) p1[r] = __builtin_amdgcn_exp2f(p1[r]);
  float ps;
  { float s0 = p0[0] + p0[1], s1 = p0[2] + p0[3], s2 = p1[0] + p1[1], s3 = p1[2] + p1[3];
#pragma unroll
    for (int r = 4; r < 16; r += 4) { s0 += p0[r] + p0[r + 1]; s1 += p0[r + 2] + p0[r + 3]; s2 += p1[r] + p1[r + 1]; s3 += p1[r + 2] + p1[r + 3]; }
    ps = (s0 + s1) + (s2 + s3); }
  { auto rr = __builtin_amdgcn_permlane32_swap(__float_as_uint(ps), __float_as_uint(ps), false, false);
    ps = __uint_as_float(rr[0]) + __uint_as_float(rr[1]); }
  l_reg = l_reg * alpha + ps;
#define PK4(P, BASE, OUT) do { unsigned a0 = cvt_pk_bf16(P[BASE + 0], P[BASE + 1]), a1 = cvt_pk_bf16(P[BASE + 2], P[BASE + 3]);   \
    unsigned b0 = cvt_pk_bf16(P[BASE + 4], P[BASE + 5]), b1 = cvt_pk_bf16(P[BASE + 6], P[BASE + 7]);                              \
    auto r0 = __builtin_amdgcn_permlane32_swap(a0, b0, false, false); auto r1 = __builtin_amdgcn_permlane32_swap(a1, b1, false, false); \
    u32x4 w = {r0[0], r1[0], r0[1], r1[1]}; OUT = *reinterpret_cast<bf16x8*>(&w); } while (0)
  PK4(p0, 0, pa0); PK4(p0, 8, pa1); PK4(p1, 0, pa2); PK4(p1, 8, pa3);
#undef PK4
}
template <int DQK> __device__ __forceinline__ void qkt(f32x16& p0, f32x16& p1, const LAS char* Ks, const bf16x8* qr, int r32, int hi) {
  p0 = f32x16{}; p1 = f32x16{};
#pragma unroll
  for (int d0 = 0; d0 < DQK / 16; d0 += 2) {
    bf16x8 kf[2][2];
#pragma unroll
    for (int d = 0; d < 2; ++d) { const int sub = (d0 + d) >> 2, cb = (((d0 + d) & 3) * 16 + hi * 8) * 2;
      kf[d][0] = *(const LAS bf16x8*)(Ks + sub * 8192 + KSW(r32, cb)); kf[d][1] = *(const LAS bf16x8*)(Ks + sub * 8192 + KSW(32 + r32, cb)); }
    SBAR();
#pragma unroll
    for (int d = 0; d < 2; ++d) {
      p0 = __builtin_amdgcn_mfma_f32_32x32x16_bf16(kf[d][0], qr[d0 + d], p0, 0, 0, 0);
      p1 = __builtin_amdgcn_mfma_f32_32x32x16_bf16(kf[d][1], qr[d0 + d], p1, 0, 0, 0); }
  }
}
__device__ __forceinline__ int v_st(int k, int c) { const int kk = (k & ~0xC) | ((k & 4) << 1) | ((k & 8) >> 1); return ((kk >> 3) * 4 + (c >> 5)) * 512 + ((kk & 7) * 32 + (c & 31)) * 2; }
__device__ __forceinline__ int v_rd_base(int lane) { return ((lane & 3) << 3) | (((lane >> 2) & 3) << 6) | (((lane >> 4) & 1) << 5) | (((lane >> 5) & 1) << 8); }
constexpr int v_rd_off(int d0, int ks, int half) { return d0 * 512 + ks * 4096 + half * 2048; }
template <int OFF> __device__ __forceinline__ s16x4 tr_read(int vb) {
  s16x4 r; asm volatile("ds_read_b64_tr_b16 %0, %1 offset:%2" : "=&v"(r) : "v"(vb), "i"(OFF) : "memory"); return r;
}
template <int KS> __device__ __forceinline__ void pv_step(f32x16* o, int vb, bf16x8 pa) {
  s16x4 l0, h0, l1, h1, l2, h2, l3, h3;
  l0 = tr_read<v_rd_off(0, KS, 0)>(vb); h0 = tr_read<v_rd_off(0, KS, 1)>(vb); l1 = tr_read<v_rd_off(1, KS, 0)>(vb); h1 = tr_read<v_rd_off(1, KS, 1)>(vb);
  l2 = tr_read<v_rd_off(2, KS, 0)>(vb); h2 = tr_read<v_rd_off(2, KS, 1)>(vb); l3 = tr_read<v_rd_off(3, KS, 0)>(vb); h3 = tr_read<v_rd_off(3, KS, 1)>(vb);
  asm volatile("s_waitcnt lgkmcnt(0)" ::: "memory"); SBAR();
#define PK(L, H) (bf16x8){L[0], L[1], L[2], L[3], H[0], H[1], H[2], H[3]}
  o[0] = __builtin_amdgcn_mfma_f32_32x32x16_bf16(pa, PK(l0, h0), o[0], 0, 0, 0);
  o[1] = __builtin_amdgcn_mfma_f32_32x32x16_bf16(pa, PK(l1, h1), o[1], 0, 0, 0);
  o[2] = __builtin_amdgcn_mfma_f32_32x32x16_bf16(pa, PK(l2, h2), o[2], 0, 0, 0);
  o[3] = __builtin_amdgcn_mfma_f32_32x32x16_bf16(pa, PK(l3, h3), o[3], 0, 0, 0);
#undef PK
}
__device__ __forceinline__ void pv_d0(f32x16* o, int vb, bf16x8 pa0, bf16x8 pa1, bf16x8 pa2, bf16x8 pa3) {
  pv_step<0>(o, vb, pa0); pv_step<1>(o, vb, pa1); pv_step<2>(o, vb, pa2); pv_step<3>(o, vb, pa3);
}
template <int DQK>
__device__ __forceinline__ void attn_core(const Src in, const float C, const float thr, const int seq, LAS char* lds, f32x16 (&o)[4]) {
  constexpr int NSUB = DQK / 64, SHM_K = NSUB * 8192;
  int lane; asm volatile("v_and_b32 %0, 63, %1" : "=v"(lane) : "v"(threadIdx.x));
  const int tid = threadIdx.x, wid = __builtin_amdgcn_readfirstlane(tid >> 6), r32 = lane & 31, hi = (lane >> 5) & 1;
  LAS char* V_lds = lds; LAS char* K_lds = lds + 3 * SHM_V;
  LAS float* ws = (LAS float*)(lds + 3 * SHM_V + 3 * SHM_K) + wid * 64; LAS float* li_l = ws; LAS float* al_l = ws + 32;
  float m_reg = -1e30f, l_reg = 0;
#pragma unroll
  for (int d = 0; d < 4; ++d) o[d] = f32x16{};
  bf16x8 qr[DQK / 16];
  const bf16_t* Qw = in.Q + (size_t)(wid * QBLK + r32) * in.ldq + hi * 8;
#pragma unroll
  for (int d0 = 0; d0 < DQK / 16; ++d0) qr[d0] = *(const bf16x8*)(Qw + d0 * 16);
  const int krow = wid * 8 + (lane >> 3), kslot = (lane & 7) ^ ((krow >> 1) & 7);
  const unsigned koff = (unsigned)(krow * in.ldk + kslot * 8) * 2u, k2off = (unsigned)(krow * in.ldk2 + kslot * 8) * 2u;
  unsigned voff[2];
#pragma unroll
  for (int i = 0; i < 2; ++i) { const int p = i * 8192 + wid * 1024 + lane * 16, st = p >> 9, wq = (p & 511) >> 1, kk = (st >> 2) * 8 + (wq >> 5), cl = wq & 31;
    const int k = (kk & ~0xC) | ((kk & 4) << 1) | ((kk & 8) >> 1); voff[i] = (unsigned)(k * in.ldv + (st & 3) * 32 + cl) * 2u; }
  const int vb0 = (int)(unsigned)(size_t)V_lds + v_rd_base(lane);
  const unsigned ldsw = (unsigned)wid * 1024u;
#define GLDS(gp, lp) __builtin_amdgcn_global_load_lds((const unsigned*)(gp), (LAS unsigned*)(lp), 16, 0, 0)
#define ISSUE_K(t, b) do { const char* kb_ = (const char*)in.K + (size_t)(t) * (KVBLK * 2) * in.ldk; \
    _Pragma("unroll") for (int s_ = 0; s_ < NSUB; ++s_) { if (s_ < 2) GLDS(kb_ + s_ * 128 + koff, K_lds + (b) * SHM_K + s_ * 8192 + ldsw); \
      else GLDS((const char*)in.K2 + (size_t)(t) * (KVBLK * 2) * in.ldk2 + k2off, K_lds + (b) * SHM_K + s_ * 8192 + ldsw); } } while (0)
#define ISSUE_V(t, b) do { const char* vb_ = (const char*)in.V + (size_t)(t) * (KVBLK * 2) * in.ldv; \
    GLDS(vb_ + voff[0], V_lds + (b) * SHM_V + ldsw); GLDS(vb_ + voff[1], V_lds + (b) * SHM_V + 8192 + ldsw); \
    if (ATT_DUP == 3) { GLDS(vb_ + voff[0], V_lds + (b) * SHM_V + ldsw); GLDS(vb_ + voff[1], V_lds + (b) * SHM_V + 8192 + ldsw); } } while (0)
#define WAITV(n) asm volatile("s_waitcnt vmcnt(%0)" :: "n"((DBG_SKIP & 4) ? 0 : (n)) : "memory")
#define WBAR() do { asm volatile("" ::: "memory"); __builtin_amdgcn_s_barrier(); asm volatile("" ::: "memory"); } while (0)
#define RESC(a) do { if (__any((a) < 1.f)) { if (hi == 0) al_l[r32] = (a); asm volatile("s_waitcnt lgkmcnt(0)" ::: "memory"); \
    _Pragma("unroll") for (int d = 0; d < 4; ++d) _Pragma("unroll") for (int r = 0; r < 16; ++r) o[d][r] *= al_l[crow(r, hi)]; } } while (0)
#define NXT3(x) ((x) == 2 ? 0 : (x) + 1)
  constexpr int NI = NSUB + (ATT_DUP == 3 ? 4 : 2), NV = (ATT_DUP == 3 ? 4 : 2);
  f32x16 pA0, pA1, pB0, pB1; float mnA, mnB, alA, alB; bf16x8 pa0, pa1, pa2, pa3; const int NT = seq / KVBLK;
  const bool lead = wid < 4;
  ISSUE_K(0, 0); ISSUE_K(1, 1); ISSUE_V(0, 0);
  if (!lead) { WAITV(NI); WBAR(); }
  WAITV(NI); WBAR();
  ISSUE_K(2, 2);
  qkt<DQK>(pA0, pA1, K_lds, qr, r32, hi);
  WAITV(NI); WBAR();
  ISSUE_V(1, 1);
  partialSM(pA0, pA1, m_reg, mnA, alA, C, thr);
  WAITV(NI); WBAR();
  int bq = 1;
  for (int j = 1; j + 3 < NT; j += 2) {
    { const int b1 = NXT3(bq), b2 = NXT3(b1);
      ISSUE_K(j + 2, b2);
      SBAR(); qkt<DQK>(pB0, pB1, K_lds + bq * SHM_K, qr, r32, hi);
      finishSM(pA0, pA1, alA, l_reg, pa0, pa1, pa2, pa3); SBAR();
      WAITV(NI); WBAR();
      ISSUE_V(j + 1, b1);
      pv_d0(o, vb0 + b2 * SHM_V, pa0, pa1, pa2, pa3); partialSM(pB0, pB1, m_reg, mnB, alB, C, thr);
      RESC(alB); bq = b1;
      WAITV(NI); WBAR(); }
    { const int b1 = NXT3(bq), b2 = NXT3(b1);
      ISSUE_K(j + 3, b2);
      SBAR(); qkt<DQK>(pA0, pA1, K_lds + bq * SHM_K, qr, r32, hi);
      finishSM(pB0, pB1, alB, l_reg, pa0, pa1, pa2, pa3); SBAR();
      WAITV(NI); WBAR();
      ISSUE_V(j + 2, b1);
      pv_d0(o, vb0 + b2 * SHM_V, pa0, pa1, pa2, pa3); partialSM(pA0, pA1, m_reg, mnA, alA, C, thr);
      RESC(alA); bq = b1;
      WAITV(NI); WBAR(); }
  }
  { const int b1 = NXT3(bq), b2 = NXT3(b1);
    ISSUE_K(NT - 1, b2);
    SBAR(); qkt<DQK>(pB0, pB1, K_lds + bq * SHM_K, qr, r32, hi);
    finishSM(pA0, pA1, alA, l_reg, pa0, pa1, pa2, pa3); SBAR();
    WAITV(NI); WBAR();
    ISSUE_V(NT - 2, b1);
    pv_d0(o, vb0 + b2 * SHM_V, pa0, pa1, pa2, pa3); partialSM(pB0, pB1, m_reg, mnB, alB, C, thr);
    RESC(alB); bq = b1;
    WAITV(NI); WBAR(); }
  { const int b1 = NXT3(bq), b2 = NXT3(b1);
    SBAR(); qkt<DQK>(pA0, pA1, K_lds + bq * SHM_K, qr, r32, hi);
    finishSM(pB0, pB1, alB, l_reg, pa0, pa1, pa2, pa3); SBAR();
    WAITV(NV); WBAR();
    ISSUE_V(NT - 1, b1);
    pv_d0(o, vb0 + b2 * SHM_V, pa0, pa1, pa2, pa3); partialSM(pA0, pA1, m_reg, mnA, alA, C, thr);
    RESC(alA); bq = b1;
    WAITV(NV); WBAR(); }
  { const int b2 = NXT3(NXT3(bq));
    SBAR(); qkt<DQK>(pB0, pB1, K_lds + bq * SHM_K, qr, r32, hi);
    finishSM(pA0, pA1, alA, l_reg, pa0, pa1, pa2, pa3); SBAR();
    WAITV(0); WBAR();
    pv_d0(o, vb0 + b2 * SHM_V, pa0, pa1, pa2, pa3); partialSM(pB0, pB1, m_reg, mnB, alB, C, thr);
    RESC(alB);
    WBAR(); }
  finishSM(pB0, pB1, alB, l_reg, pa0, pa1, pa2, pa3); SBAR();
  pv_d0(o, vb0 + bq * SHM_V, pa0, pa1, pa2, pa3);
  if (lead) { WBAR(); }
  if (hi == 0) li_l[r32] = l_reg; asm volatile("s_waitcnt lgkmcnt(0)" ::: "memory");
#pragma unroll
  for (int r = 0; r < 16; ++r) { const float rl = __builtin_amdgcn_rcpf(li_l[crow(r, hi)]);
#pragma unroll
    for (int d = 0; d < 4; ++d) o[d][r] *= rl; }
  asm volatile("s_waitcnt lgkmcnt(0)" ::: "memory"); WBAR();
#undef GLDS
#undef ISSUE_K
#undef ISSUE_V
#undef WAITV
#undef WBAR
#undef RESC
#undef NXT3
}
template <int DQK>
__device__ __forceinline__ void attn_core_seq(const Src in, const float C, const float thr, const int seq, LAS char* lds, f32x16 (&o)[4]) {
  constexpr int NSUB = DQK / 64, SHM_K = NSUB * 8192;
  int lane; asm volatile("v_and_b32 %0, 63, %1" : "=v"(lane) : "v"(threadIdx.x));
  const int tid = threadIdx.x, wid = __builtin_amdgcn_readfirstlane(tid >> 6), r32 = lane & 31, hi = (lane >> 5) & 1;
  LAS char* V_lds = lds; LAS char* K_lds = lds + 3 * SHM_V;
  LAS float* ws = (LAS float*)(lds + 3 * SHM_V + 3 * SHM_K) + wid * 64; LAS float* li_l = ws; LAS float* al_l = ws + 32;
  float m_reg = -1e30f, l_reg = 0;
#pragma unroll
  for (int d = 0; d < 4; ++d) o[d] = f32x16{};
  bf16x8 qr[DQK / 16];
  const bf16_t* Qw = in.Q + (size_t)(wid * QBLK + r32) * in.ldq + hi * 8;
#pragma unroll
  for (int d0 = 0; d0 < DQK / 16; ++d0) qr[d0] = *(const bf16x8*)(Qw + d0 * 16);
  const int krow = wid * 8 + (lane >> 3), kslot = (lane & 7) ^ ((krow >> 1) & 7);
  const unsigned koff = (unsigned)(krow * in.ldk + kslot * 8) * 2u, k2off = (unsigned)(krow * in.ldk2 + kslot * 8) * 2u;
  unsigned voff[2];
#pragma unroll
  for (int i = 0; i < 2; ++i) { const int p = i * 8192 + wid * 1024 + lane * 16, st = p >> 9, wq = (p & 511) >> 1, kk = (st >> 2) * 8 + (wq >> 5), cl = wq & 31;
    const int k = (kk & ~0xC) | ((kk & 4) << 1) | ((kk & 8) >> 1); voff[i] = (unsigned)(k * in.ldv + (st & 3) * 32 + cl) * 2u; }
  const int vb0 = (int)(unsigned)(size_t)V_lds + v_rd_base(lane);
  const unsigned ldsw = (unsigned)wid * 1024u;
#define GLDS(gp, lp) __builtin_amdgcn_global_load_lds((const unsigned*)(gp), (LAS unsigned*)(lp), 16, 0, 0)
#define ISSUE_K(t, b) do { const char* kb_ = (const char*)in.K + (size_t)(t) * (KVBLK * 2) * in.ldk; \
    _Pragma("unroll") for (int s_ = 0; s_ < NSUB; ++s_) { if (s_ < 2) GLDS(kb_ + s_ * 128 + koff, K_lds + (b) * SHM_K + s_ * 8192 + ldsw); \
      else GLDS((const char*)in.K2 + (size_t)(t) * (KVBLK * 2) * in.ldk2 + k2off, K_lds + (b) * SHM_K + s_ * 8192 + ldsw); } } while (0)
#define ISSUE_V(t, b) do { const char* vb_ = (const char*)in.V + (size_t)(t) * (KVBLK * 2) * in.ldv; \
    GLDS(vb_ + voff[0], V_lds + (b) * SHM_V + ldsw); GLDS(vb_ + voff[1], V_lds + (b) * SHM_V + 8192 + ldsw); } while (0)
#define WAITV(n) asm volatile("s_waitcnt vmcnt(%0)" :: "n"(n) : "memory")
#define WBAR() do { asm volatile("" ::: "memory"); __builtin_amdgcn_s_barrier(); asm volatile("" ::: "memory"); } while (0)
#define RESC(a) do { if (__any((a) < 1.f)) { if (hi == 0) al_l[r32] = (a); asm volatile("s_waitcnt lgkmcnt(0)" ::: "memory"); \
    _Pragma("unroll") for (int d = 0; d < 4; ++d) _Pragma("unroll") for (int r = 0; r < 16; ++r) o[d][r] *= al_l[crow(r, hi)]; } } while (0)
#define NXT3(x) ((x) == 2 ? 0 : (x) + 1)
#define SEG_B(b) do { float mn, al; bf16x8 pa0, pa1, pa2, pa3; partialSM(p0, p1, m_reg, mn, al, C, thr); RESC(al); finishSM(p0, p1, al, l_reg, pa0, pa1, pa2, pa3); SBAR(); \
    pv_d0(o, vb0 + (b) * SHM_V, pa0, pa1, pa2, pa3); } while (0)
  constexpr int NI = NSUB + 2;
  f32x16 p0, p1; const int NT = seq / KVBLK; const bool lead = wid < 4;
  ISSUE_K(0, 0); ISSUE_V(0, 0); ISSUE_K(1, 1); ISSUE_V(1, 1);
  if (!lead) { WAITV(NI); WBAR(); }
  WAITV(NI); WBAR();
  int bq = 0;
  for (int j = 0; j + 2 < NT; ++j) {
    const int b1 = NXT3(bq), b2 = NXT3(b1);
    ISSUE_K(j + 2, b2);
    qkt<DQK>(p0, p1, K_lds + bq * SHM_K, qr, r32, hi);
    WAITV(NI); WBAR();
    ISSUE_V(j + 2, b2);
    SEG_B(bq);
    WAITV(NI); WBAR();
    bq = b1;
  }
#pragma unroll
  for (int jj = 0; jj < 2; ++jj) {
    qkt<DQK>(p0, p1, K_lds + bq * SHM_K, qr, r32, hi);
    WAITV(0); WBAR();
    SEG_B(bq);
    WBAR();
    bq = NXT3(bq);
  }
  if (lead) { WBAR(); }
  if (hi == 0) li_l[r32] = l_reg; asm volatile("s_waitcnt lgkmcnt(0)" ::: "memory");
#pragma unroll
  for (int r = 0; r < 16; ++r) { const float rl = __builtin_amdgcn_rcpf(li_l[crow(r, hi)]);
#pragma unroll
    for (int d = 0; d < 4; ++d) o[d][r] *= rl; }
  asm volatile("s_waitcnt lgkmcnt(0)" ::: "memory"); WBAR();
#undef GLDS
#undef ISSUE_K
#undef ISSUE_V
#undef WAITV
#undef WBAR
#undef RESC
#undef NXT3
#undef SEG_B
}
__device__ __forceinline__ void attn_core_da2(const Src in, const float C, const float thr, const int seq, LAS char* lds, f32x16 (&o1)[4], f32x16 (&o2)[4]) {
  constexpr int NSUB = 2, SHM_K = NSUB * 8192;
  int lane; asm volatile("v_and_b32 %0, 63, %1" : "=v"(lane) : "v"(threadIdx.x));
  const int tid = threadIdx.x, wid = __builtin_amdgcn_readfirstlane(tid >> 6), r32 = lane & 31, hi = (lane >> 5) & 1;
  LAS char* V_lds = lds; LAS char* K_lds = lds + 3 * SHM_V;
  LAS float* ws = (LAS float*)(lds + 3 * SHM_V + 3 * SHM_K) + wid * 64; LAS float* li_l = ws; LAS float* al_l = ws + 32;
  float m1 = -1e30f, l1 = 0, m2 = -1e30f, l2 = 0;
#pragma unroll
  for (int d = 0; d < 4; ++d) { o1[d] = f32x16{}; o2[d] = f32x16{}; }
  bf16x8 q1[4], q2[4];
  const bf16_t* Qw = in.Q + (size_t)(wid * QBLK + r32) * in.ldq + hi * 8;
#pragma unroll
  for (int d0 = 0; d0 < 4; ++d0) { q1[d0] = *(const bf16x8*)(Qw + d0 * 16); q2[d0] = *(const bf16x8*)(Qw + 64 + d0 * 16); }
  const int krow = wid * 8 + (lane >> 3), kslot = (lane & 7) ^ ((krow >> 1) & 7);
  const unsigned koff = (unsigned)(krow * in.ldk + kslot * 8) * 2u;
  unsigned voff[2];
#pragma unroll
  for (int i = 0; i < 2; ++i) { const int p = i * 8192 + wid * 1024 + lane * 16, st = p >> 9, wq = (p & 511) >> 1, kk = (st >> 2) * 8 + (wq >> 5), cl = wq & 31;
    const int k = (kk & ~0xC) | ((kk & 4) << 1) | ((kk & 8) >> 1); voff[i] = (unsigned)(k * in.ldv + (st & 3) * 32 + cl) * 2u; }
  const int vb0 = (int)(unsigned)(size_t)V_lds + v_rd_base(lane);
  const unsigned ldsw = (unsigned)wid * 1024u;
#define GLDS(gp, lp) __builtin_amdgcn_global_load_lds((const unsigned*)(gp), (LAS unsigned*)(lp), 16, 0, 0)
#define ISSUE_KV(t, b) do { const char* kb_ = (const char*)in.K + (size_t)(t) * (KVBLK * 2) * in.ldk; const char* vb_ = (const char*)in.V + (size_t)(t) * (KVBLK * 2) * in.ldv; \
    GLDS(kb_ + koff, K_lds + (b) * SHM_K + ldsw); GLDS(kb_ + 128 + koff, K_lds + (b) * SHM_K + 8192 + ldsw); \
    GLDS(vb_ + voff[0], V_lds + (b) * SHM_V + ldsw); GLDS(vb_ + voff[1], V_lds + (b) * SHM_V + 8192 + ldsw); } while (0)
#define WAITV(n) asm volatile("s_waitcnt vmcnt(%0)" :: "n"(n) : "memory")
#define WBAR() do { asm volatile("" ::: "memory"); __builtin_amdgcn_s_barrier(); asm volatile("" ::: "memory"); } while (0)
#define RESC(oo, a) do { if (__any((a) < 1.f)) { if (hi == 0) al_l[r32] = (a); asm volatile("s_waitcnt lgkmcnt(0)" ::: "memory"); \
    _Pragma("unroll") for (int d = 0; d < 4; ++d) _Pragma("unroll") for (int r = 0; r < 16; ++r) oo[d][r] *= al_l[crow(r, hi)]; asm volatile("s_waitcnt lgkmcnt(0)" ::: "memory"); } } while (0)
#define NXT3(x) ((x) == 2 ? 0 : (x) + 1)
#define TILE_BODY(b) do { f32x16 p0, p1; float mn, al; bf16x8 pa0, pa1, pa2, pa3; \
    qkt<64>(p0, p1, K_lds + (b) * SHM_K, q1, r32, hi); partialSM(p0, p1, m1, mn, al, C, thr); RESC(o1, al); \
    finishSM(p0, p1, al, l1, pa0, pa1, pa2, pa3); SBAR(); pv_d0(o1, vb0 + (b) * SHM_V, pa0, pa1, pa2, pa3); SBAR(); \
    qkt<64>(p0, p1, K_lds + (b) * SHM_K + 8192, q2, r32, hi); partialSM(p0, p1, m2, mn, al, C, thr); RESC(o2, al); \
    finishSM(p0, p1, al, l2, pa0, pa1, pa2, pa3); SBAR(); pv_d0(o2, vb0 + (b) * SHM_V, pa0, pa1, pa2, pa3); SBAR(); } while (0)
  const int NT = seq / KVBLK;
  ISSUE_KV(0, 0); ISSUE_KV(1, 1);
  int bq = 0;
  for (int j = 0; j + 1 < NT; ++j) {
    const int b1 = NXT3(bq), b2 = NXT3(b1);
    WAITV(4); WBAR();
    if (j + 2 < NT) ISSUE_KV(j + 2, b2); else ISSUE_KV(NT - 1, b2);
    TILE_BODY(bq);
    bq = b1;
  }
  WAITV(4); WBAR();
  TILE_BODY(bq);
  WAITV(0);
  if (hi == 0) { li_l[r32] = l1; al_l[r32] = l2; } asm volatile("s_waitcnt lgkmcnt(0)" ::: "memory");
#pragma unroll
  for (int r = 0; r < 16; ++r) { const float ra = __builtin_amdgcn_rcpf(li_l[crow(r, hi)]), rb = __builtin_amdgcn_rcpf(al_l[crow(r, hi)]);
#pragma unroll
    for (int d = 0; d < 4; ++d) { o1[d][r] *= ra; o2[d][r] *= rb; } }
  asm volatile("s_waitcnt lgkmcnt(0)" ::: "memory"); WBAR();
#undef GLDS
#undef ISSUE_KV
#undef WAITV
#undef WBAR
#undef RESC
#undef NXT3
#undef TILE_BODY
}
}

constexpr int NWAVES = 8;
struct Args { const void* in[27]; float* out; unsigned char* ws; int ph_lo, ph_hi, li, pad; };

__constant__ float c_invA[8] = {1.0f, 0.19392274474868576f, 0.03760603093086393f, 0.007292664737217109f, 0.001414213562373095f, 0.0002742481756762073f, 5.318295896944988e-05f, 1.031338537721246e-05f};
__constant__ float c_invM[32] = {1.0f, 0.6636012376960885f, 0.44036660267178046f, 0.2922278225730151f, 0.19392274474868576f, 0.12868737343265052f, 0.08539710028576561f, 0.05666962144529105f,
    0.03760603093086393f, 0.024955408670558694f, 0.016560440080994446f, 0.010989528534539826f, 0.007292664737217109f, 0.004839421345719893f, 0.003211445994752591f, 0.0021311195369119653f,
    0.001414213562373095f, 0.0009384738703573802f, 0.000622772421914596f, 0.0004132725499855165f, 0.0002742481756762073f, 0.00018199142881462546f, 0.00012076973741146504f, 8.01429472224798e-05f,
    5.318295896944988e-05f, 3.529227739646723e-05f, 2.341999896140934e-05f, 1.5541540297632344e-05f, 1.031338537721246e-05f, 6.8439753011549275e-06f, 4.5416704806078695e-06f, 3.013858152139171e-06f};

__device__ __forceinline__ int permDA(int i) { return i < 16 ? (i >> 1) + 8 * (i & 1) : i; }
__device__ __forceinline__ int permM(int i) { return (i >> 1) + 32 * (i & 1); }
__device__ __forceinline__ int src_in(int j) {
    if (j < 2048) return (j & ~63) + permDA(j & 63);
    if (j < 4352) return j;
    if (j < 6400) return 4416 + (j - 4352);
    if (j < 6464) return 4352 + permM(j - 6400);
    return -1;
}
__device__ __forceinline__ int src_uq(int j) { const int hd = j / 192, off = j % 192; return off < 128 ? j : hd * 192 + 128 + permM(off - 128); }

__device__ __forceinline__ void tr_item(const float* W, int K, int N, bf16_t* WT, int n0, int k0, int scol, const float* rs, LAS float* scr, int lane) {
#pragma unroll 8
    for (int i = 0; i < 32; ++i) { const int kk = 2 * i + (lane >> 5); float v = 0.f; if (scol >= 0) { v = W[(size_t)(k0 + kk) * N + scol]; if (rs) v *= rs[k0 + kk]; } scr[kk * 33 + (lane & 31)] = v; }
    LDS_WAIT(); asm volatile("" ::: "memory");
    const int c = lane & 7;
#pragma unroll
    for (int j = 0; j < 4; ++j) { const int n = (lane >> 3) + 8 * j; const LAS float* s = scr + (8 * c) * 33 + n;
        u32x4 o; o.x = cvt_pk_bf16(s[0 * 33], s[1 * 33]); o.y = cvt_pk_bf16(s[2 * 33], s[3 * 33]); o.z = cvt_pk_bf16(s[4 * 33], s[5 * 33]); o.w = cvt_pk_bf16(s[6 * 33], s[7 * 33]);
        *(u32x4*)(WT + (size_t)(n0 + n) * K + k0 + 8 * c) = o; }
    LDS_WAIT(); asm volatile("" ::: "memory");
}

template <int MODE = 0, bool OUT8 = false>
__device__ __forceinline__ void cvt_tile64(const float* W, int N, bf16_t* WT, int Kd, int k0, int n0, int drow0, int lane, const float* rs = nullptr) {
    const int g = lane >> 4, x = lane & 15;
    const float* src = W + (size_t)(k0 + 16 * g) * N + n0 + 4 * x;
    f32x4 v[16];
#pragma unroll
    for (int i = 0; i < 16; ++i) v[i] = __builtin_nontemporal_load((const f32x4*)(src + (size_t)i * N));
    if (rs) {
#pragma unroll
        for (int i = 0; i < 16; ++i) v[i] = v[i] * rs[k0 + 16 * g + i];
    }
    if constexpr (OUT8) {
#pragma unroll
        for (int j = 0; j < 4; ++j) { u32x4 w;
            w.x = cvt_pk_fp8x4(v[0][j] * 64.f, v[1][j] * 64.f, v[2][j] * 64.f, v[3][j] * 64.f); w.y = cvt_pk_fp8x4(v[4][j] * 64.f, v[5][j] * 64.f, v[6][j] * 64.f, v[7][j] * 64.f);
            w.z = cvt_pk_fp8x4(v[8][j] * 64.f, v[9][j] * 64.f, v[10][j] * 64.f, v[11][j] * 64.f); w.w = cvt_pk_fp8x4(v[12][j] * 64.f, v[13][j] * 64.f, v[14][j] * 64.f, v[15][j] * 64.f);
            const int c8 = 4 * x + j;
            const int dr8 = (MODE == 3 || MODE == 4) ? 32 * (c8 >> 4) + 8 * ((c8 >> 2) & 3) + 4 * (MODE - 3) + (c8 & 3) : c8;
            *(u32x4*)((unsigned char*)WT + (size_t)(drow0 + dr8) * Kd + k0 + 16 * g) = w; }
        return; }
#pragma unroll
    for (int j = 0; j < 4; ++j) { u32x4 lo, hi;
        lo.x = cvt_pk_bf16(v[0][j], v[1][j]); lo.y = cvt_pk_bf16(v[2][j], v[3][j]); lo.z = cvt_pk_bf16(v[4][j], v[5][j]); lo.w = cvt_pk_bf16(v[6][j], v[7][j]);
        hi.x = cvt_pk_bf16(v[8][j], v[9][j]); hi.y = cvt_pk_bf16(v[10][j], v[11][j]); hi.z = cvt_pk_bf16(v[12][j], v[13][j]); hi.w = cvt_pk_bf16(v[14][j], v[15][j]);
        const int c = 4 * x + j;
        const int dr = MODE == 1 ? 2 * (c & 31) + (c >> 5) : (MODE == 2 ? (c < 16 ? 2 * (c & 7) + (c >> 3) : c) : c);
        bf16_t* d = WT + (size_t)(drow0 + dr) * Kd + k0 + 16 * g;
        *(u32x4*)d = lo; *(u32x4*)(d + 8) = hi; }
}

__global__ void __launch_bounds__(NWAVES * 64, 2) fwd(Args args) {
#define KARGS() const __attribute__((address_space(4))) unsigned long long* ka_ = (const __attribute__((address_space(4))) unsigned long long*)__builtin_amdgcn_kernarg_segment_ptr(); asm volatile("" : "+s"(ka_))
#define AIN(i) ((const void*)ka_[i])
#define AOUT ((float*)ka_[27])
#define AWS ((unsigned char*)ka_[28])
    extern __shared__ __attribute__((aligned(16))) unsigned char lds_raw[];
    LAS unsigned char* lds = (LAS unsigned char*)lds_raw;
    volatile LAS unsigned* MISC = (volatile LAS unsigned*)(lds + MISC_OFF);
    const int tid = threadIdx.x, wave = __builtin_amdgcn_readfirstlane(tid >> 6);
#define LANE_DECL int lane; asm volatile("v_and_b32 %0, 63, %1" : "=v"(lane) : "v"(threadIdx.x))
    const int G = gridDim.x, bx = blockIdx.x;
    unsigned* ctl = (unsigned*)(args.ws + WS_CTL);
    const int lo = args.ph_lo, hi_ph = args.ph_hi;
    if (tid < 32) MISC[tid] = 0u;
    __syncthreads();
    XcdBarrier bar; bar.bar = ctl + CW_BAR + args.li * XCD_BAR_WORDS; bar.x = 0; bar.st = nullptr;
    if (!MK_PER_PHASE) bar = xcd_barrier_post(ctl + CW_BAR + args.li * XCD_BAR_WORDS, MISC + 8);
#define IN(k) (((PH_MASK >> (k)) & 1) && lo <= (k) && (k) < hi_ph)
#define SEAM(k) do { if (IN(k) && IN((k) + 1)) xcd_barrier(bar); } while (0)
    const int gw = bx * NWAVES + wave, NGW = G * NWAVES;

#define xin ((const float*)AIN(0))
#define positions ((const int*)AIN(1))
#define Bt_in ((bf16_t*)(AWS + WS_BT_IN))
#define Bt_uq ((bf16_t*)(AWS + WS_BT_UQ))
#define Bt_ukv ((bf16_t*)(AWS + WS_BT_UKV))
#define Bt_od ((bf16_t*)(AWS + WS_BT_OD))
#define Bt_om ((bf16_t*)(AWS + WS_BT_OM))
#define Bt_out ((bf16_t*)(AWS + WS_BT_OUT))
#define ropeA ((float*)(AWS + WS_ROPEA))
#define ropeM ((float*)(AWS + WS_ROPEM))
#define sq ((float*)(AWS + WS_SQ2))
#define hbuf ((bf16_t*)(AWS + WS_H))
#define oa ((bf16_t*)(AWS + WS_H))
#define qa ((bf16_t*)(AWS + WS_QA))
#define ka ((bf16_t*)(AWS + WS_KA))
#define va ((bf16_t*)(AWS + WS_VA))
#define cq ((bf16_t*)(AWS + WS_CQ))
#define ckv ((bf16_t*)(AWS + WS_CKV))
#define kr ((bf16_t*)(AWS + WS_KR))
#define gates ((bf16_t*)(AWS + WS_GATES))
#define qm ((bf16_t*)(AWS + WS_QM))
#define kv ((bf16_t*)(AWS + WS_KV))
#define ob ((bf16_t*)(AWS + WS_OB))
#define mrg ((bf16_t*)(AWS + WS_MRG))
#define stash ((float*)(AWS + WS_STASH))
#define rowtok_p ((int*)(AWS + WS_ROWTOK))
#define assign ((u32x2*)(AWS + WS_ASSIGN))
#define Bt_d ((bf16_t*)(AWS + WS_BT_D))
#define Bt_gu ((bf16_t*)(AWS + WS_BT_GU))
#define h2 ((bf16_t*)(AWS + WS_H2))
#define act ((bf16_t*)(AWS + WS_ACT))
#define ybuf ((bf16_t*)(AWS + WS_Y))
#define count ((unsigned*)(AWS + WS_CTL) + CW_COUNT)

    if (IN(0)) {
        KARGS();
        LANE_DECL;
        const float* w_in = (const float*)AIN(3); const float* g_q = (const float*)AIN(9); const float* g_kv = (const float*)AIN(10);
        const float* w_uq = (const float*)AIN(11); const float* w_ukv = (const float*)AIN(12);
        const float* w_od = (const float*)AIN(13); const float* w_om = (const float*)AIN(14); const float* w_out = (const float*)AIN(16);
        constexpr int I_IN = 16 * 101, I_PAD = 16 * 3, I_UQ = 12 * 24, I_UKV = 8 * 32, I_O = 16 * 16;
        constexpr int NITEMS = I_IN + I_PAD + I_UQ + I_UKV + 3 * I_O;
        for (int it = gw; it < NITEMS; it += NGW) {
            int r = it;
            if (r < I_IN) { const int kb = r / 101, cb = r % 101, n0 = cb * 64;
                if (n0 < 2048) cvt_tile64<2>(w_in, 6464, Bt_in, D, kb * 64, n0, n0, lane);
                else if (n0 < 4352) cvt_tile64<0>(w_in, 6464, Bt_in, D, kb * 64, n0, n0, lane);
                else if (n0 < 4416) cvt_tile64<1>(w_in, 6464, Bt_in, D, kb * 64, n0, 5888, lane);
                else if (n0 < 4416 + 1536) cvt_tile64<0>(w_in, 6464, Bt_in, D, kb * 64, n0, n0 - 64, lane);
                else cvt_tile64<0>(w_in, 6464, Bt_in, D, kb * 64, n0, n0 - 64 + 256, lane);
                continue; } r -= I_IN;
            if (r < I_PAD) { const int kb = r / 3, rb = r % 3; const int g = lane >> 4, x4 = lane & 15;
#pragma unroll
                for (int j = 0; j < 4; ++j) { bf16_t* d = Bt_in + (size_t)(5952 + rb * 64 + 4 * x4 + j) * D + kb * 64 + 16 * g; *(u32x4*)d = (u32x4){0u, 0u, 0u, 0u}; *(u32x4*)(d + 8) = (u32x4){0u, 0u, 0u, 0u}; }
                continue; } r -= I_PAD;
            if (r < I_UQ) { const int kb = r / 24, cb = r % 24, n0 = cb * 64;
                if ((cb % 3) == 2) cvt_tile64<1>(w_uq, 1536, Bt_uq, QL, kb * 64, n0, n0, lane, g_q); else cvt_tile64<0>(w_uq, 1536, Bt_uq, QL, kb * 64, n0, n0, lane, g_q);
                continue; } r -= I_UQ;
            if (r < I_UKV) { const int kb = r / 32, cb = r % 32; cvt_tile64<0>(w_ukv, 2048, Bt_ukv, KVL, kb * 64, cb * 64, cb * 64, lane, g_kv); continue; } r -= I_UKV;
            const int which = r / I_O; r -= which * I_O; const int kb = r / 16, cb = r % 16;
            cvt_tile64<0>(which == 0 ? w_od : (which == 1 ? w_om : w_out), D, which == 0 ? Bt_od : (which == 1 ? Bt_om : Bt_out), D, kb * 64, cb * 64, cb * 64, lane);
        }
        const float* g_mix = (const float*)AIN(2);
        for (int m = gw * 4; m < T; m += NGW * 4) {
            f32x4 v[4][4]; float ss[4];
#pragma unroll
            for (int q = 0; q < 4; ++q) { const f32x4* xr = (const f32x4*)(xin + (size_t)(m + q) * D) + lane;
#pragma unroll
                for (int j = 0; j < 4; ++j) v[q][j] = xr[64 * j]; }
#pragma unroll
            for (int q = 0; q < 4; ++q) { float s = 0.f;
#pragma unroll
                for (int j = 0; j < 4; ++j) s += (v[q][j][0] * v[q][j][0] + v[q][j][1] * v[q][j][1]) + (v[q][j][2] * v[q][j][2] + v[q][j][3] * v[q][j][3]);
                ss[q] = __builtin_amdgcn_rsqf(wave_sum(s) * (1.f / D) + EPS); }
#pragma unroll
            for (int j = 0; j < 4; ++j) { const f32x4 gg = *((const f32x4*)g_mix + lane + 64 * j);
#pragma unroll
                for (int q = 0; q < 4; ++q) { u32x2 w; w.x = cvt_pk_bf16(v[q][j][0] * ss[q] * gg[0], v[q][j][1] * ss[q] * gg[1]); w.y = cvt_pk_bf16(v[q][j][2] * ss[q] * gg[2], v[q][j][3] * ss[q] * gg[3]);
                    ((u32x2*)(hbuf + (size_t)(m + q) * D) + lane)[64 * j] = w; } }
        }
        for (int idx = bx * 512 + tid; idx < T * 40; idx += G * 512) {
            const int t = idx / 40, i = idx % 40; const float inv = i < 8 ? c_invA[i] : c_invM[i - 8];
            const float ang = (float)positions[t] * inv;
            const double rev = (double)ang * 0.15915494309189535; const float fr_ = (float)(rev - __builtin_rint(rev));
            const float cs = __builtin_amdgcn_cosf(fr_), sn = __builtin_amdgcn_sinf(fr_);
            float* dst = i < 8 ? ropeA + ((size_t)t * 8 + i) * 2 : ropeM + ((size_t)t * 32 + (i - 8)) * 2; dst[0] = cs; dst[1] = sn;
        }
    }
    SEAM(0);
    if (IN(1)) {
        KARGS();
        pg8::Gemm g{hbuf, Bt_in, D}; pg8::DenseOrder S; S.init(T / 256, 24, G, bx);
        pg8::EpiIn E{qa, ka, va, cq, ckv, gates, kr, ropeA, ropeM, (const float*)AIN(15), sq};
        pg8::gemm_phase<pg8::EpiIn, pg8::DenseOrder, false, true>(lds, g, S, E);
    }
    SEAM(1);
    if (IN(2)) {
        KARGS();
        { pg8::Gemm g{hbuf, Bt_in, D}; pg8::DenseOrder S; S.init(T / 256, 2, G, bx, 24);
          pg8::EpiIn E{qa, ka, va, cq, ckv, gates, kr, ropeA, ropeM, (const float*)AIN(15), sq};
          pg8::gemm_phase<pg8::EpiIn, pg8::DenseOrder, false, true>(lds, g, S, E); }
        { pg8::Gemm g{cq, Bt_uq, QL}; pg8::DenseOrder S; S.init(T / 256, 1536 / 256, G, G - 1 - bx); pg8::EpiUp<true> E{qm, sq, ropeM};
          pg8::gemm_phase<pg8::EpiUp<true>, pg8::DenseOrder, false, true>(lds, g, S, E); }
        { pg8::Gemm g{ckv, Bt_ukv, KVL}; pg8::DenseOrder S; S.init(T / 256, 2048 / 256, G, bx); pg8::EpiUp<false> E{kv, sq, ropeM};
          pg8::gemm_phase<pg8::EpiUp<false>, pg8::DenseOrder, false, true>(lds, g, S, E); }
    }
    SEAM(2);
    if (IN(3)) {
        KARGS();
        const int wid = wave;
#define UNIT_DECODE(L) int u = (L) & 511; if (G == 256) { const int c = (L) & 255; u = ((L) & 256) + (c & 7) * 32 + (c >> 3); } \
            const int bh = u >> 4, qb = u & 15, b = bh >> 3, h = bh & 7; const size_t q0 = (size_t)b * SEQ + qb * 256, k0 = (size_t)b * SEQ
        for (int L = bx; L < 512; L += G) {
#if PROBE_PHASE == 3 && defined(PROBE_ATT)
            if (args.li == 1 && lo == 3 && PROBE_ATT != 0) continue;
#endif
            UNIT_DECODE(L);
            f32x16 o[4], o2[4];
            { att::Src in{qa + q0 * 1024 + h * 128, ka + k0 * 1024 + h * 128, nullptr, va + k0 * 1024 + h * 128, 1024, 1024, 0, 1024};
              att::attn_core_da2(in, 0.125f * 1.4426950408889634f, 8.f / 0.125f, SEQ, (LAS char*)lds, o, o2); }
            int ln2; asm volatile("v_and_b32 %0, 63, %1" : "=v"(ln2) : "v"(threadIdx.x));
            float lam;
            { const float* lq1 = (const float*)AIN(4); const float* lk1 = (const float*)AIN(5); const float* lq2 = (const float*)AIN(6); const float* lk2 = (const float*)AIN(7);
              const float s1 = wave_sum(lq1[ln2] * lk1[ln2]), s2 = wave_sum(lq2[ln2] * lk2[ln2]); lam = __expf(s1) - __expf(s2) + LAM_INIT; }
            float ss[16];
#pragma unroll
            for (int r = 0; r < 16; ++r) ss[r] = 0.f;
#pragma unroll
            for (int d = 0; d < 4; ++d)
#pragma unroll
                for (int r = 0; r < 16; ++r) { const float v = o[d][r] - lam * o2[d][r]; o[d][r] = v; ss[r] += v * v; }
#pragma unroll
            for (int r = 0; r < 16; ++r) {
#pragma unroll
                for (int msk = 1; msk < 32; msk <<= 1) ss[r] += __shfl_xor(ss[r], msk);
                ss[r] = __builtin_amdgcn_rsqf(ss[r] * (1.0f / 128.0f) + EPS); }
            const int hi2 = ln2 >> 5, r32e = ln2 & 31;
            bf16_t* Ow = oa + (q0 + wid * 32 + 4 * hi2) * 1024 + h * 128 + r32e;
            float gs[4];
#pragma unroll
            for (int d = 0; d < 4; ++d) gs[d] = ((const float*)AIN(8))[d * 32 + r32e] * (1.0f - LAM_INIT);
#pragma unroll
            for (int r = 0; r < 16; ++r) { const int orow = att::crow(r, 0);
#pragma unroll
                for (int d = 0; d < 4; ++d) Ow[orow * 1024 + d * 32] = (bf16_t)(cvt_pk_bf16(o[d][r] * ss[r] * gs[d], 0.f) & 0xffffu); }
        }
        for (int L = 512 + bx; L < 1024; L += G) {
#if PROBE_PHASE == 3 && defined(PROBE_ATT)
            if (args.li == 1 && lo == 3 && PROBE_ATT != 1) continue;
#endif
            UNIT_DECODE(L);
            f32x16 o[4];
            { att::Src in{qm + q0 * 1536 + h * 192, kv + k0 * 2048 + h * 256, kr + k0 * 64, kv + k0 * 2048 + h * 256 + 128, 1536, 2048, 64, 2048};
              att::attn_core_seq<192>(in, 0.07216878364870322f * 1.4426950408889634f, 8.f / 0.07216878364870322f, SEQ, (LAS char*)lds, o); }
            int ln2; asm volatile("v_and_b32 %0, 63, %1" : "=v"(ln2) : "v"(threadIdx.x));
            const int hi2 = ln2 >> 5, r32e = ln2 & 31;
            bf16_t* Ow = ob + (q0 + wid * 32 + 4 * hi2) * 1024 + h * 128 + r32e;
#pragma unroll
            for (int r = 0; r < 16; ++r) { const int orow = att::crow(r, 0);
#pragma unroll
                for (int d = 0; d < 4; ++d) Ow[orow * 1024 + d * 32] = (bf16_t)(cvt_pk_bf16(o[d][r], 0.f) & 0xffffu); }
        }
#undef UNIT_DECODE
    }
    SEAM(3);
    if (IN(4)) {
        KARGS();
        { pg8::Gemm g{oa, Bt_od, D}; pg8::DenseOrder S; S.init(T / 256, 4, G, bx); pg8::EpiGate<0> E{mrg, gates};
          pg8::gemm_phase<pg8::EpiGate<0>, pg8::DenseOrder, false, true>(lds, g, S, E); }
        VM_WAIT(); __syncthreads();
        { pg8::Gemm g{ob, Bt_om, D}; pg8::DenseOrder S; S.init(T / 256, 4, G, bx); pg8::EpiGate<1> E{mrg, gates};
          pg8::gemm_phase<pg8::EpiGate<1>, pg8::DenseOrder, false, true>(lds, g, S, E); }
    }
    SEAM(4);
    if (IN(5)) {
        KARGS();
        pg8::Gemm g{mrg, Bt_out, D}; pg8::DenseOrder S; S.init(T / 256, 4, G, bx); pg8::EpiRes E{xin, AOUT};
        pg8::gemm_phase<pg8::EpiRes, pg8::DenseOrder, false, true>(lds, g, S, E);
    }
    SEAM(5);
    if (IN(6)) {
        KARGS();
        LANE_DECL;
        const float* g_ffn = (const float*)AIN(17); const float* w_router = (const float*)AIN(18); const float* b_router = (const float*)AIN(19);
        constexpr int WRS = 1028;
        LAS float* wr_l = (LAS float*)lds;
        LAS int* lcount = (LAS int*)(lds + TAB_OFF + 1024); LAS int* gbase = lcount + 32; LAS unsigned* asg_e = (LAS unsigned*)(lcount + 64); LAS float* asg_w = (LAS float*)(lcount + 64 + 256);
        LAS int* sync_w = (LAS int*)(lds + TAB_OFF + 512);
        for (int i = tid; i < D * NEXP; i += 512) wr_l[(i & 31) * WRS + (i >> 5)] = w_router[i];
        if (tid < 32) lcount[tid] = 0;
        if (tid < 2) sync_w[tid] = 0;
        __syncthreads();
        const int ex = (lane >> 1) & 31;
        LAS float* lg = (LAS float*)(lds + TAB_OFF + 4096) + wave * 80;
        const int chunk = bx;
        if (wave < 4 && chunk < T / 64) {
            const float my_b = b_router[ex];
#pragma unroll 1
            for (int j2 = 0; j2 < 8; ++j2) {
                const int tl = wave * 16 + j2 * 2, t = chunk * 64 + tl;
                f32x4 xva[4], xvb[4]; float sa = 0.f, sb = 0.f;
                { const f32x4* xa = (const f32x4*)(AOUT + (size_t)t * D) + lane; const f32x4* xb = xa + D / 4;
#pragma unroll
                  for (int j = 0; j < 4; ++j) { xva[j] = xa[64 * j]; xvb[j] = xb[64 * j]; }
#pragma unroll
                  for (int j = 0; j < 4; ++j) { sa += (xva[j][0] * xva[j][0] + xva[j][1] * xva[j][1]) + (xva[j][2] * xva[j][2] + xva[j][3] * xva[j][3]); sb += (xvb[j][0] * xvb[j][0] + xvb[j][1] * xvb[j][1]) + (xvb[j][2] * xvb[j][2] + xvb[j][3] * xvb[j][3]); } }
                const float ra = __builtin_amdgcn_rsqf(wave_sum(sa) * (1.f / D) + EPS), rb = __builtin_amdgcn_rsqf(wave_sum(sb) * (1.f / D) + EPS);
                { unsigned* oa8 = (unsigned*)((unsigned char*)h2 + (size_t)t * D) + lane; unsigned* ob8 = oa8 + D / 4;
#pragma unroll
                  for (int j = 0; j < 4; ++j) { const f32x4 gg = *((const f32x4*)g_ffn + lane + 64 * j); xva[j] = xva[j] * ra * gg; xvb[j] = xvb[j] * rb * gg;
                    oa8[64 * j] = cvt_pk_fp8x4(xva[j][0], xva[j][1], xva[j][2], xva[j][3]); ob8[64 * j] = cvt_pk_fp8x4(xvb[j][0], xvb[j][1], xvb[j][2], xvb[j][3]); } }
                float aa[32], ab[32];
#pragma unroll
                for (int e = 0; e < NEXP; ++e) { float a = 0.f, b = 0.f;
#pragma unroll
                    for (int j = 0; j < 4; ++j) { const f32x4 w4 = *(const LAS f32x4*)(wr_l + e * WRS + 4 * lane + 256 * j);
                        a += (xva[j][0] * w4[0] + xva[j][1] * w4[1]) + (xva[j][2] * w4[2] + xva[j][3] * w4[3]); b += (xvb[j][0] * w4[0] + xvb[j][1] * w4[1]) + (xvb[j][2] * w4[2] + xvb[j][3] * w4[3]); }
                    aa[e] = a; ab[e] = b; }
#define TRED(arr, n, msk) _Pragma("unroll") for (int i_ = 0; i_ < (n); ++i_) { const bool up_ = (lane & (msk)) != 0; const float keep_ = up_ ? arr[(n) + i_] : arr[i_], give_ = up_ ? arr[i_] : arr[(n) + i_]; arr[i_] = keep_ + __shfl_xor(give_, (msk)); }
                TRED(aa, 16, 32) TRED(aa, 8, 16) TRED(aa, 4, 8) TRED(aa, 2, 4) TRED(aa, 1, 2)
                TRED(ab, 16, 32) TRED(ab, 8, 16) TRED(ab, 4, 8) TRED(ab, 2, 4) TRED(ab, 1, 2)
#undef TRED
                const float la = aa[0] + __shfl_xor(aa[0], 1) + my_b, lb = ab[0] + __shfl_xor(ab[0], 1) + my_b;
#pragma unroll
                for (int tk = 0; tk < 2; ++tk) {
                    const float v = tk ? lb : la; int rank = 0;
                    if (!(lane & 1)) lg[tk * 32 + ex] = v;
                    LDS_WAIT();
#pragma unroll
                    for (int q = 0; q < 8; ++q) { const f32x4 s4 = *(const LAS f32x4*)(lg + tk * 32 + 4 * q);
#pragma unroll
                        for (int jj = 0; jj < 4; ++jj) rank += (s4[jj] > v || (s4[jj] == v && (4 * q + jj) < ex)) ? 1 : 0; }
                    if (rank < 4 && !(lane & 1)) lg[64 + tk * 4 + rank] = v;
                    LDS_WAIT();
                    const f32x4 tv = *(const LAS f32x4*)(lg + 64 + tk * 4);
                    const float p1 = __expf(tv[1] - tv[0]), p2 = __expf(tv[2] - tv[0]), p3 = __expf(tv[3] - tv[0]), inv = 1.0f / (1.0f + p1 + p2 + p3);
                    if (rank < 4 && !(lane & 1)) { const float w = (rank == 0 ? 1.0f : (rank == 1 ? p1 : (rank == 2 ? p2 : p3))) * inv;
                        const int lr = __hip_atomic_fetch_add((LAS int*)&lcount[ex], 1, __ATOMIC_RELAXED, __HIP_MEMORY_SCOPE_WORKGROUP);
                        asg_e[(tl + tk) * 4 + rank] = ((unsigned)ex << 16) | (unsigned)lr; asg_w[(tl + tk) * 4 + rank] = w; }
                }
            }
            LDS_WAIT();
            if (lane == 0) __hip_atomic_fetch_add((LAS int*)&sync_w[0], 1, __ATOMIC_RELAXED, __HIP_MEMORY_SCOPE_WORKGROUP);
            if (wave == 0) {
                while (__hip_atomic_load((LAS int*)&sync_w[0], __ATOMIC_RELAXED, __HIP_MEMORY_SCOPE_WORKGROUP) < 4) __builtin_amdgcn_s_sleep(4);
                asm volatile("s_waitcnt lgkmcnt(0)" ::: "memory");
                if (lane < 32) gbase[lane] = (int)__hip_atomic_fetch_add(count + lane, (unsigned)lcount[lane], __ATOMIC_RELAXED, __HIP_MEMORY_SCOPE_AGENT);
                LDS_WAIT();
#pragma unroll
                for (int q = 0; q < 4; ++q) { const int a_ = q * 64 + lane; const unsigned ae = asg_e[a_]; const int e = ae >> 16, rank = gbase[e] + (int)(ae & 0xffffu); const int t = chunk * 64 + (a_ >> 2);
                    rowtok_p[e * T + rank] = t; u32x2 av; av.x = ((unsigned)e << 16) | (unsigned)rank; av.y = __float_as_uint(asg_w[a_]); assign[(size_t)t * 4 + (a_ & 3)] = av; }
            }
        }
        const float* w_gate = (const float*)AIN(20); const float* w_up = (const float*)AIN(22); const float* w_down = (const float*)AIN(24);
        const int per_wg = (NEXP * 768 + G - 1) / G;
        for (;;) {
            int it = 0; if (lane == 0) it = __hip_atomic_fetch_add((LAS int*)&sync_w[1], 1, __ATOMIC_RELAXED, __HIP_MEMORY_SCOPE_WORKGROUP);
            it = __builtin_amdgcn_readfirstlane(it); const int item = bx * per_wg + it;
            if (it >= per_wg || item >= NEXP * 768) break;
            const int e = item / 768, r = item % 768, mat = r >> 8, kb = (r >> 4) & 15, nb = r & 15, f0 = nb * 64;
            if (mat == 0) cvt_tile64<3, true>(w_gate + (size_t)e * D * FF, FF, (bf16_t*)((unsigned char*)Bt_gu + (size_t)e * 2048 * D), D, kb * 64, f0, 2 * f0, lane);
            else if (mat == 1) cvt_tile64<4, true>(w_up + (size_t)e * D * FF, FF, (bf16_t*)((unsigned char*)Bt_gu + (size_t)e * 2048 * D), D, kb * 64, f0, 2 * f0, lane);
            else cvt_tile64<0, true>(w_down + (size_t)e * FF * D, D, (bf16_t*)((unsigned char*)Bt_d + (size_t)e * D * FF), FF, kb * 64, f0, f0, lane);
        }
    }
    SEAM(6);
    LAS int* t_cnt = (LAS int*)(lds + TAB_OFF + 4096); LAS int* t_start = t_cnt + 32; LAS int* t_t2e = t_start + 40;
    if (IN(7) || IN(8) || IN(9)) {
        KARGS();
        __syncthreads();
        if (tid < 32) t_cnt[tid] = (int)__hip_atomic_load(count + tid, __ATOMIC_RELAXED, __HIP_MEMORY_SCOPE_AGENT);
        __syncthreads();
        if (tid == 0) { int s = 0; for (int e = 0; e < NEXP; ++e) { t_start[e] = s; s += (t_cnt[e] + 255) >> 8; } t_start[32] = s; }
        __syncthreads();
        if (tid < 32) { for (int rt = t_start[tid]; rt < t_start[tid + 1]; ++rt) t_t2e[rt] = tid; }
        __syncthreads();
    }
    if (IN(7)) {
        KARGS();
        pg8::Gemm g{h2, Bt_gu, D / 2}; pg8::MoeOrder S; S.init(__builtin_amdgcn_readfirstlane(t_start[32]), 16, G, bx); S.t2e = t_t2e; S.tstart = t_start; S.cnt = t_cnt; S.rowtok = rowtok_p;
        pg8::EpiSwiglu8 E{(unsigned char*)act, (const float*)AIN(21), (const float*)AIN(23)};
        pg8::gemm_phase_f8n<pg8::EpiSwiglu8, pg8::MoeOrder, true>(lds, g, S, E);
    }
    SEAM(7);
    if (IN(8)) {
        KARGS();
        pg8::Gemm g{act, Bt_d, FF / 2}; pg8::MoeOrder S; S.init(__builtin_amdgcn_readfirstlane(t_start[32]), 8, G, bx); S.t2e = t_t2e; S.tstart = t_start; S.cnt = t_cnt; S.rowtok = rowtok_p;
        pg8::EpiDown8 E{ybuf, (const float*)AIN(25)};
        pg8::gemm_phase_f8n<pg8::EpiDown8, pg8::MoeOrder>(lds, g, S, E);
    }
    SEAM(8);
    if (IN(9) && DBG_OUT) {
        KARGS();
        const bf16_t* src = DBG_OUT == 1 ? gates : DBG_OUT == 2 ? gates + 1024 : DBG_OUT == 3 ? qa : DBG_OUT == 4 ? ka : DBG_OUT == 5 ? va : DBG_OUT == 6 ? mrg : DBG_OUT == 7 ? oa : DBG_OUT == 9 ? Bt_in : ob;
        const int ld = DBG_OUT <= 2 ? 2048 : 1024;
        for (size_t i = (size_t)bx * 512 + tid; i < (size_t)T * 1024; i += (size_t)G * 512) AOUT[i] = (DBG_OUT == 9 && i >= (size_t)N_IN * 1024) ? 0.f : __uint_as_float((unsigned)src[(i >> 10) * ld + (i & 1023)] << 16);
    } else
    if (IN(9)) {
        KARGS();
        LANE_DECL;
        const float* g_fin = (const float*)AIN(26);
        for (int t0 = gw * 2; t0 < T; t0 += NGW * 2) {
            f32x4 v[2][4]; u32x2 as_[2][4];
#pragma unroll
            for (int q = 0; q < 2; ++q) { const f32x4* xr = (const f32x4*)(AOUT + (size_t)(t0 + q) * D) + lane;
#pragma unroll
                for (int j = 0; j < 4; ++j) v[q][j] = xr[64 * j];
#pragma unroll
                for (int k = 0; k < 4; ++k) as_[q][k] = assign[(size_t)(t0 + q) * 4 + k]; }
            u32x2 yw[2][4][4];
#pragma unroll
            for (int q = 0; q < 2; ++q)
#pragma unroll
                for (int k = 0; k < 4; ++k) { const int e = as_[q][k].x >> 16, rank = as_[q][k].x & 0xffffu;
                    const u32x2* yr = (const u32x2*)(ybuf + ((size_t)t_start[e] * 256 + rank) * D) + lane;
#pragma unroll
                    for (int j = 0; j < 4; ++j) yw[q][k][j] = yr[64 * j]; }
#pragma unroll
            for (int q = 0; q < 2; ++q) {
#pragma unroll
                for (int k = 0; k < 4; ++k) { const float w = (DBG_SKIP & 1) ? 0.f : __uint_as_float(as_[q][k].y);
#pragma unroll
                    for (int j = 0; j < 4; ++j) { const u32x2 y = yw[q][k][j]; v[q][j][0] += w * bf_lo(y.x); v[q][j][1] += w * bf_hi(y.x); v[q][j][2] += w * bf_lo(y.y); v[q][j][3] += w * bf_hi(y.y); } }
                float s = 0.f;
#pragma unroll
                for (int j = 0; j < 4; ++j) s += (v[q][j][0] * v[q][j][0] + v[q][j][1] * v[q][j][1]) + (v[q][j][2] * v[q][j][2] + v[q][j][3] * v[q][j][3]);
                const float rstd = __builtin_amdgcn_rsqf(wave_sum(s) * (1.f / D) + EPS);
                f32x4* xo = (f32x4*)(AOUT + (size_t)(t0 + q) * D) + lane;
#pragma unroll
                for (int j = 0; j < 4; ++j) { const f32x4 gg = *((const f32x4*)g_fin + lane + 64 * j); xo[64 * j] = v[q][j] * rstd * gg; } }
        }
    }
#undef IN
#undef SEAM
#undef KARGS
#undef AIN
#undef AOUT
#undef AWS
#undef xin
#undef positions
#undef Bt_in
#undef Bt_uq
#undef Bt_ukv
#undef Bt_od
#undef Bt_om
#undef Bt_out
#undef ropeA
#undef ropeM
#undef sq
#undef hbuf
#undef oa
#undef qa
#undef ka
#undef va
#undef cq
#undef ckv
#undef kr
#undef gates
#undef qm
#undef kv
#undef ob
#undef mrg
#undef stash
#undef rowtok_p
#undef assign
#undef Bt_d
#undef Bt_gu
#undef h2
#undef act
#undef ybuf
#undef count
}

extern "C" void kernel_launch(void* const* d_in, const int* in_sizes, int n_in, void* d_out, int out_size, void* d_ws, size_t ws_size, hipStream_t stream) {
    static int grid = 0;
    if (grid == 0) {
        if (n_in != 27 || in_sizes[0] != T * D || out_size != T * D || ws_size < WS_END) { fprintf(stderr, "kernel_launch: unexpected shapes (n_in %d, in0 %d, out %d, ws %zu < %zu)\n", n_in, n_in > 0 ? in_sizes[0] : -1, out_size, ws_size, (size_t)WS_END); grid = -1; return; }
        int dev = 0, cus = 0, per_cu = 0;
        if (hipGetDevice(&dev) != hipSuccess || hipDeviceGetAttribute(&cus, hipDeviceAttributeMultiprocessorCount, dev) != hipSuccess) { grid = -1; return; }
        if (hipFuncSetAttribute((const void*)fwd, hipFuncAttributeMaxDynamicSharedMemorySize, LDS_BYTES) != hipSuccess) { fprintf(stderr, "kernel_launch: hipFuncSetAttribute failed\n"); grid = -1; return; }
        if (hipOccupancyMaxActiveBlocksPerMultiprocessor(&per_cu, (const void*)fwd, NWAVES * 64, LDS_BYTES) != hipSuccess || per_cu < 1) fprintf(stderr, "kernel_launch: occupancy query says %d\n", per_cu);
        (void)hipGetLastError();
        grid = cus;
    }
    if (grid < 0) return;
    if (hipMemsetAsync((char*)d_ws + WS_CTL, 0, CTL_ZERO_BYTES, stream) != hipSuccess) return;
    Args a{};
    for (int i = 0; i < 27; ++i) a.in[i] = d_in[i];
    a.out = (float*)d_out; a.ws = (unsigned char*)d_ws;
#if MK_PER_PHASE
    for (int p = 0; p < NPHASE; ++p) { a.ph_lo = p; a.ph_hi = p + 1; hipLaunchKernelGGL(fwd, dim3(grid), dim3(NWAVES * 64), LDS_BYTES, stream, a); }
#elif PROBE_PHASE >= 0
    a.ph_lo = 0; a.ph_hi = PROBE_PHASE + 1; a.li = 0; hipLaunchKernelGGL(fwd, dim3(grid), dim3(NWAVES * 64), LDS_BYTES, stream, a);
    a.ph_lo = PROBE_PHASE; a.ph_hi = NPHASE; a.li = 1; hipLaunchKernelGGL(fwd, dim3(grid), dim3(NWAVES * 64), LDS_BYTES, stream, a);
#else
    a.ph_lo = 0; a.ph_hi = NPHASE; hipLaunchKernelGGL(fwd, dim3(grid), dim3(NWAVES * 64), LDS_BYTES, stream, a);
#endif
}
```

```cpp
#include <hip/hip_runtime.h>
#include <cstdio>
#include <cstdint>

#ifndef MK_PER_PHASE
#define MK_PER_PHASE 0
#endif

#ifndef PROBE_PHASE
#define PROBE_PHASE -1
#endif
#ifndef ATT_DUP
#ifndef DMA_SPREAD
#define DMA_SPREAD 1
#endif
#ifndef PROBE_DMA2
#define PROBE_DMA2 0
#endif
#ifndef MLA_QK8
#define MLA_QK8 1
#endif
#ifndef DA_QK8
#define DA_QK8 1
#endif
#ifndef UP_F8
#define UP_F8 1
#endif
#ifndef BP_VLA
#define BP_VLA 3
#endif
#ifndef BP_KLA
#define BP_KLA 2
#endif
#ifndef PROBE_BASE
#define PROBE_BASE 2500.f
#endif
#ifndef PROBE_T
#define PROBE_T 0
#endif
#define ATT_DUP 0
#endif
#ifndef DBG_OUT
#define DBG_OUT 0
#endif
#ifndef DBG_SKIP
#define DBG_SKIP 0
#endif
#ifndef ATT_MASK
#define ATT_MASK 3
#endif
#ifndef PH_MASK
#define PH_MASK 0x3ff
#endif
#define LAS __attribute__((address_space(3)))
#define GAS __attribute__((address_space(1)))
typedef unsigned short bf16_t;
typedef short bf16x8 __attribute__((ext_vector_type(8)));
typedef short s16x4 __attribute__((ext_vector_type(4)));
typedef float f32x2 __attribute__((ext_vector_type(2)));
typedef float f32x4 __attribute__((ext_vector_type(4)));
typedef float f32x16 __attribute__((ext_vector_type(16)));
typedef unsigned u32x2 __attribute__((ext_vector_type(2)));
typedef unsigned u32x4 __attribute__((ext_vector_type(4)));

constexpr int NB = 4, SEQ = 4096, T = NB * SEQ, D = 1024;
constexpr int NEXP = 32, TOPK = 4, FF = 1024;
constexpr int N_IN = 6656;
constexpr int QL = 768, KVL = 512;
constexpr float EPS = 1e-6f;
constexpr float LAM_INIT = 0.2f;
constexpr int NPHASE = 10;

constexpr size_t MiB = 1u << 20;
constexpr size_t WS_CTL = 0, CTL_ZERO_BYTES = 1 * MiB;
constexpr size_t WS_BT_IN = 2 * MiB;
constexpr size_t WS_BT_UQ = 15 * MiB;
constexpr size_t WS_BT_UKV = 18 * MiB;
constexpr size_t WS_BT_OD = 20 * MiB, WS_BT_OM = 22 * MiB, WS_BT_OUT = 24 * MiB;
constexpr size_t WS_ROPEA = 26 * MiB;
constexpr size_t WS_ROPEM = 27 * MiB;
constexpr size_t WS_SQ = 31 * MiB;
constexpr size_t WS_SQP = 1 * MiB;
constexpr size_t WS_H = 32 * MiB;
constexpr size_t WS_QA = 64 * MiB, WS_KA = 96 * MiB, WS_VA = 128 * MiB;
constexpr size_t WS_X1B = 168 * MiB;
constexpr size_t WS_CQ = 160 * MiB, WS_CKV = 184 * MiB, WS_KR = 200 * MiB;
constexpr size_t WS_SQ2 = 202 * MiB;
constexpr size_t WS_GATES = 208 * MiB;
constexpr size_t WS_QM = 272 * MiB;
constexpr size_t WS_Q8 = 448 * MiB;
constexpr size_t WS_K8N = 472 * MiB;
constexpr size_t WS_Q8A = 416 * MiB;
constexpr size_t WS_K8A = 432 * MiB;
constexpr size_t WS_K8R = 488 * MiB;
constexpr size_t WS_KV = 320 * MiB;
constexpr size_t WS_OB = 384 * MiB;
constexpr size_t WS_MRG = 416 * MiB;
constexpr size_t WS_STASH = 448 * MiB;
constexpr size_t WS_ROWTOK = 2 * MiB;
constexpr size_t WS_ASSIGN = 4 * MiB;
constexpr size_t WS_BT_D = 32 * MiB;
constexpr size_t WS_BT_GU = 96 * MiB;
constexpr size_t WS_H2 = 224 * MiB;
constexpr size_t WS_ACT = 256 * MiB;
constexpr size_t WS_Y = 96 * MiB;
constexpr size_t WS_END = 512 * MiB;
constexpr int CW_COUNT = 64;
constexpr int CW_BAR = 4096;
constexpr int CW_PROBE = 128;

constexpr int RING_BYTES = 147456;
constexpr int TAB_OFF = RING_BYTES;
constexpr int TAB_BYTES = 8192;
constexpr int MISC_OFF = TAB_OFF + TAB_BYTES;
constexpr int LDS_BYTES = 157696;

typedef __bf16 bf16x2_t __attribute__((ext_vector_type(2)));
__device__ __forceinline__ unsigned cvt_pk_bf16(float lo, float hi) { const f32x2 v = {lo, hi}; return __builtin_bit_cast(unsigned, __builtin_convertvector(v, bf16x2_t)); }
__device__ __forceinline__ float bf_lo(unsigned w) { return __uint_as_float(w << 16); }
__device__ __forceinline__ float bf_hi(unsigned w) { return __uint_as_float(w & 0xffff0000u); }
__device__ __forceinline__ float wave_sum(float v) {
#pragma unroll
    for (int o = 1; o < 64; o <<= 1) v += __shfl_xor(v, o);
    return v;
}
__device__ __forceinline__ float sigmoidf_(float x) { return __builtin_amdgcn_rcpf(1.0f + __builtin_amdgcn_exp2f(-1.4426950408889634f * x)); }
__device__ __forceinline__ unsigned cvt_pk_fp8x4(float a, float b, float c, float d) {
    a = fminf(fmaxf(a, -448.f), 448.f); b = fminf(fmaxf(b, -448.f), 448.f); c = fminf(fmaxf(c, -448.f), 448.f); d = fminf(fmaxf(d, -448.f), 448.f);
    int r = __builtin_amdgcn_cvt_pk_fp8_f32(a, b, 0, false); r = __builtin_amdgcn_cvt_pk_fp8_f32(c, d, r, true); return (unsigned)r; }
#define LDS_WAIT() asm volatile("s_waitcnt lgkmcnt(0)" ::: "memory")
#define VM_WAIT() asm volatile("s_waitcnt vmcnt(0)" ::: "memory")

#define XB_TMO      128
#define XB_XCNT(j)  (256  + 64 * (j))
#define XB_XSUB(j)  (1280 + 64 * (j))
#define XB_XGEN(j)  (2304 + 64 * (j))
#define XB_TOP      3328
#define XB_TOPGEN   3392
#define XCD_BAR_WORDS 3456
#define XB_SPIN_CAP (1u << 20)
__device__ __forceinline__ unsigned xb_ld(unsigned* p)              { return __hip_atomic_load(p, __ATOMIC_RELAXED, __HIP_MEMORY_SCOPE_AGENT); }
__device__ __forceinline__ unsigned xb_add(unsigned* p, unsigned v) { return __hip_atomic_fetch_add(p, v, __ATOMIC_RELAXED, __HIP_MEMORY_SCOPE_AGENT); }
__device__ __forceinline__ unsigned xb_xcc_id() { return (unsigned)__builtin_amdgcn_s_getreg((3 << 11) | 20) & 0xFu; }
#define XB_SPIN(cond, bar) do { unsigned _sp = 0; while (cond) { __builtin_amdgcn_s_sleep(1); \
    if ((++_sp & 255u) == 0u) { if (xb_ld(&(bar)[XB_TMO])) break; if (_sp > XB_SPIN_CAP) { atomicAdd(&(bar)[XB_TMO], 1u); break; } } } } while (0)
struct XcdBarrier { unsigned* bar; unsigned x; volatile LAS unsigned* st; };
__device__ __forceinline__ XcdBarrier xcd_barrier_post(unsigned* bar, volatile LAS unsigned* st) {
    XcdBarrier b; b.bar = bar; b.x = xb_xcc_id(); b.st = st;
    if (threadIdx.x == 0) (void)xb_add(&bar[XB_XCNT(b.x)], 1u);
    return b;
}
__device__ __forceinline__ void xcd_barrier_complete(unsigned* bar, unsigned x, unsigned& nloc, unsigned& nx) {
    const unsigned G = gridDim.x * gridDim.y * gridDim.z;
    unsigned sum, cnt, mine, sp = 0u;
    for (;;) {
        sum = 0u; cnt = 0u; mine = 0u;
#pragma unroll
        for (unsigned j = 0; j < 16; ++j) { const unsigned c = xb_ld(&bar[XB_XCNT(j)]); sum += c; cnt += (c > 0u) ? 1u : 0u; mine = (j == x) ? c : mine; }
        if (sum == G) break;
        __builtin_amdgcn_s_sleep(1);
        if ((++sp & 255u) == 0u) { if (xb_ld(&bar[XB_TMO])) break; if (sp > XB_SPIN_CAP) { atomicAdd(&bar[XB_TMO], 1u); break; } }
    }
    nloc = mine > 0u ? mine : 1u; nx = cnt > 0u ? cnt : 1u;
}
__device__ __forceinline__ void xcd_barrier(const XcdBarrier& b) {
    asm volatile("s_waitcnt vmcnt(0)" ::: "memory");
    __syncthreads();
    if (threadIdx.x == 0) {
        unsigned* bar = b.bar;
        __builtin_amdgcn_s_waitcnt(0);
        unsigned nloc = b.st[0], nx = b.st[1];
        if (nloc == 0u) { xcd_barrier_complete(bar, b.x, nloc, nx); b.st[0] = nloc; b.st[1] = nx; }
        const unsigned old = xb_add(&bar[XB_XSUB(b.x)], 1u);
        const unsigned gen = old / nloc;
        if (old + 1u == (gen + 1u) * nloc) {
            __builtin_amdgcn_fence(__ATOMIC_RELEASE, "agent");
            asm volatile("s_waitcnt vmcnt(0)" ::: "memory");
            const unsigned og = xb_add(&bar[XB_TOP], 1u);
            const unsigned tg = og / nx;
            if (og + 1u == (tg + 1u) * nx) xb_add(&bar[XB_TOPGEN], 1u);
            else XB_SPIN(xb_ld(&bar[XB_TOPGEN]) == tg, bar);
            __builtin_amdgcn_fence(__ATOMIC_ACQUIRE, "agent");
            xb_add(&bar[XB_XGEN(b.x)], 1u);
            asm volatile("s_waitcnt vmcnt(0)" ::: "memory");
        } else {
            XB_SPIN(xb_ld(&bar[XB_XGEN(b.x)]) == gen, bar);
            __builtin_amdgcn_fence(__ATOMIC_ACQUIRE, "agent");
            asm volatile("s_waitcnt vmcnt(0)" ::: "memory");
        }
    }
    __syncthreads();
}

constexpr float YS = 16.0f;
constexpr float QS_MLA = 0.07216878364870322f * 1.4426950408889634f;
constexpr float QS_DA = 0.125f * 1.4426950408889634f;
namespace pg8 {
constexpr int BM = 256, BK = 64, HALF = 128, HTB = HALF * BK * 2, STAGE_BYTES = 8 * HTB, NXCD = 8, WGM = 8;
__host__ __device__ __forceinline__ int lds_byte(int r, int c) { const int st = (r >> 4) * 2 + (c >> 5), rr = r & 15, cc = c & 31, ob = rr * 64 + cc * 2; return st * 1024 + (ob ^ (((ob >> 9) & 1) << 5)); }
__host__ __device__ __forceinline__ void stage_rc(int b, int& R, int& C) { const int st = b / 1024, sb = b % 1024, swz = sb ^ (((sb >> 9) & 1) << 5); R = (st >> 1) * 16 + swz / 64; C = (st & 1) * 32 + (swz % 64) / 2; }
__host__ __device__ __forceinline__ int perm32(int rho) { const int n = rho >> 4, i = rho & 15; return 8 * (i >> 2) + 4 * n + (i & 3); }

struct Unit { int pm, pn, pb, e, rbase, cnt; };
struct Gemm { const bf16_t* A; const bf16_t* Bt; int K; };

struct DenseOrder {
    int nM, nN, nwg, G, c, pn0;
    __device__ void init(int nM_, int nN_, int G_, int c_, int pn0_ = 0) { nM = nM_; nN = nN_; nwg = nM * nN; G = G_; c = c_; pn0 = pn0_; }
    __device__ __forceinline__ bool next(int i, Unit& u) const {
        const long L = (long)i * G + c; if (L >= nwg) return false;
        int wgid = (int)L; { const int q = nwg / NXCD, r = nwg % NXCD, xcd = wgid % NXCD, off = wgid / NXCD; wgid = (xcd < r ? xcd * (q + 1) : r * (q + 1) + (xcd - r) * q) + off; }
        const int nig = WGM * nN, gid = wgid / nig, fm = gid * WGM, gsz = (nM - fm) < WGM ? (nM - fm) : WGM;
        u.pm = fm + ((wgid % nig) % gsz); u.pn = pn0 + (wgid % nig) / gsz; u.pb = u.pn; u.e = 0; u.rbase = 0; u.cnt = 0; return true;
    }
    __device__ __forceinline__ int a_row(const Unit&, int) const { return 0; }
};
struct MoeOrder {
    int nM, nN, nwg, G, c; const LAS int* t2e; const LAS int* tstart; const LAS int* cnt; const int* rowtok;
    __device__ void init(int nM_, int nN_, int G_, int c_) { nM = nM_; nN = nN_; nwg = nM * nN; G = G_; c = c_; }
    __device__ __forceinline__ bool next(int i, Unit& u) const {
        const long L = (long)i * G + c; if (L >= nwg) return false;
        int wgid = (int)L; { const int q = nwg / NXCD, r = nwg % NXCD, xcd = wgid % NXCD, off = wgid / NXCD; wgid = (xcd < r ? xcd * (q + 1) : r * (q + 1) + (xcd - r) * q) + off; }
        const int nig = WGM * nN, gid = wgid / nig, fm = gid * WGM, gsz = (nM - fm) < WGM ? (nM - fm) : WGM;
        u.pm = fm + ((wgid % nig) % gsz); u.pn = (wgid % nig) / gsz;
        const int e = __builtin_amdgcn_readfirstlane(t2e[u.pm]); u.e = e; u.pb = e * nN + u.pn; u.rbase = (u.pm - __builtin_amdgcn_readfirstlane(tstart[e])) * 256; u.cnt = __builtin_amdgcn_readfirstlane(cnt[e]); return true;
    }
    __device__ __forceinline__ int a_row(const Unit& u, int r) const { const int rank = u.rbase + r; return rank < u.cnt ? rowtok[u.e * T + rank] : 0; }
};

template <class Epi, class Sched, bool GATHER, bool ALIGN_EPI>
__device__ __forceinline__ void gemm_phase(LAS unsigned char* lds, const Gemm g, const Sched& S, const Epi& E) {
    const int tid = threadIdx.x, wid = __builtin_amdgcn_readfirstlane(tid >> 6), lane = tid & 63, wr = wid >> 2, wc = wid & 3, fr = lane & 15, fq = lane >> 4;
    const int K = g.K, nt = K / BK;
    unsigned voffA[2], voffB[2]; int Rv[2], Cv[2];
#pragma unroll
    for (int i = 0; i < 2; ++i) { int R, C; stage_rc(tid * 16 + i * 8192, R, C); const int Rb = Epi::PERM ? ((R & ~31) + perm32(R & 31)) : R;
        voffA[i] = (unsigned)(R * K + C) * 2u; voffB[i] = (unsigned)(Rb * K + C) * 2u; Rv[i] = R; Cv[i] = C; }
    const size_t kstep = (size_t)(BK * 2);
    const size_t hstep = (size_t)HALF * K * 2;
    const size_t tstep = 2 * hstep;
    const unsigned ldsw = (unsigned)wid * 1024u;
    const int aoff = lds_byte(wr * 64 + fr, fq * 8), boff = lds_byte(wc * 32 + fr, fq * 8);
#define PG8_SA(b, h) (((b) * 2 + (h)) * HTB)
#define PG8_SB(b, h) ((4 + (b) * 2 + (h)) * HTB)
#define PG8_STAGE(bufoff, gbase, voff) do { _Pragma("unroll") for (int _i = 0; _i < 2; ++_i) \
        __builtin_amdgcn_global_load_lds((const unsigned*)((const char*)(gbase) + (voff)[_i]), (LAS unsigned*)(lds + (bufoff) + ldsw + _i * 8192), 16, 0, 0); } while (0)
#define PG8_LDA(dst, b, h) do { _Pragma("unroll") for (int m = 0; m < 4; ++m) _Pragma("unroll") for (int k = 0; k < 2; ++k) dst[m][k] = *(const LAS bf16x8*)(lds + PG8_SA(b, h) + aoff + m * 2048 + k * 1024); } while (0)
#define PG8_LDB(dst, b, h) do { _Pragma("unroll") for (int n = 0; n < 2; ++n) _Pragma("unroll") for (int k = 0; k < 2; ++k) dst[n][k] = *(const LAS bf16x8*)(lds + PG8_SB(b, h) + boff + n * 2048 + k * 1024); } while (0)
#define PG8_MMA(ai, bj, At, Bt) do { __builtin_amdgcn_s_setprio(1); _Pragma("unroll") for (int m = 0; m < 4; ++m) _Pragma("unroll") for (int n = 0; n < 2; ++n) _Pragma("unroll") for (int k = 0; k < 2; ++k) \
        acc[ai][bj][m][n] = __builtin_amdgcn_mfma_f32_16x16x32_bf16(Bt[n][k], At[m][k], acc[ai][bj][m][n], 0, 0, 0); __builtin_amdgcn_s_setprio(0); } while (0)
#define PG8_WAIT_V(n) asm volatile("s_waitcnt vmcnt(" #n ")" ::: "memory")
#define PG8_WAIT_L(n) asm volatile("s_waitcnt lgkmcnt(" #n ")" ::: "memory")
#define PG8_BAR __builtin_amdgcn_s_barrier()
#define PG8_SCHED __builtin_amdgcn_sched_barrier(0)
    Unit cur, nxt; int ui = 0;
    if (!S.next(0, cur)) return;
    f32x4 acc[2][2][4][2];
#pragma unroll
    for (int a = 0; a < 2; ++a)
#pragma unroll
        for (int b = 0; b < 2; ++b)
#pragma unroll
            for (int m = 0; m < 4; ++m)
#pragma unroll
                for (int n = 0; n < 2; ++n) acc[a][b][m][n] = (f32x4){0.f, 0.f, 0.f, 0.f};
    bf16x8 At[4][2], B0[2][2], B1[2][2];
    unsigned gC0[2], gC1[2], gN0[2], gN1[2];
    if constexpr (GATHER) {
#pragma unroll
        for (int i = 0; i < 2; ++i) { gC0[i] = (unsigned)S.a_row(cur, Rv[i]) * (unsigned)(K * 2) + (unsigned)Cv[i] * 2u; gC1[i] = (unsigned)S.a_row(cur, HALF + Rv[i]) * (unsigned)(K * 2) + (unsigned)Cv[i] * 2u; gN0[i] = gC0[i]; gN1[i] = gC1[i]; }
    }
    const char* cA = GATHER ? (const char*)g.A : (const char*)g.A + (size_t)cur.pm * tstep; const char* cB = (const char*)g.Bt + (size_t)cur.pb * tstep;
#define PG8_STAGE_A(bufoff, p, h, o0, o1) do { if constexpr (GATHER) { if ((h) == 0) PG8_STAGE(bufoff, p, o0); else PG8_STAGE(bufoff, p, o1); } else { PG8_STAGE(bufoff, (p) + (h) * hstep, voffA); } } while (0)
    PG8_STAGE(PG8_SB(0, 0), cB, voffB); PG8_STAGE(PG8_SB(0, 1), cB + hstep, voffB); PG8_STAGE_A(PG8_SA(0, 0), cA, 0, gC0, gC1); PG8_STAGE_A(PG8_SA(0, 1), cA, 1, gC0, gC1);
    if (wr == 1) PG8_BAR;
    PG8_WAIT_V(2); PG8_BAR;
    PG8_STAGE(PG8_SB(1, 0), cB + kstep, voffB); PG8_STAGE_A(PG8_SA(1, 0), cA + kstep, 0, gC0, gC1); PG8_STAGE(PG8_SB(1, 1), cB + hstep + kstep, voffB);
    PG8_WAIT_V(6); PG8_BAR;
    for (;;) {
        const bool has_next = S.next(ui + 1, nxt);
        const char* nA = GATHER ? (const char*)g.A : (has_next ? (const char*)g.A + (size_t)nxt.pm * tstep : cA); const char* nB = has_next ? (const char*)g.Bt + (size_t)nxt.pb * tstep : cB;
        if constexpr (GATHER) { if (has_next) {
#pragma unroll
            for (int i = 0; i < 2; ++i) { gN0[i] = (unsigned)S.a_row(nxt, Rv[i]) * (unsigned)(K * 2) + (unsigned)Cv[i] * 2u; gN1[i] = (unsigned)S.a_row(nxt, HALF + Rv[i]) * (unsigned)(K * 2) + (unsigned)Cv[i] * 2u; } } }
        for (int t = 0; t < nt; t += 2) {
            const bool last = (t == nt - 2);
            const char* a1 = cA + (size_t)(t + 1) * kstep;
            const char* a2 = last ? nA : cA + (size_t)(t + 2) * kstep; const char* b2 = last ? nB : cB + (size_t)(t + 2) * kstep;
            const char* a3 = a2 + kstep; const char* b3 = b2 + kstep;
            unsigned s0[2], s1[2];
            if constexpr (GATHER) { s0[0] = last ? gN0[0] : gC0[0]; s0[1] = last ? gN0[1] : gC0[1]; s1[0] = last ? gN1[0] : gC1[0]; s1[1] = last ? gN1[1] : gC1[1]; }
            PG8_LDB(B0, 0, 0); PG8_LDB(B1, 0, 1); PG8_SCHED; PG8_LDA(At, 0, 0); PG8_STAGE_A(PG8_SA(1, 1), a1, 1, gC0, gC1);
            PG8_WAIT_V(8); PG8_WAIT_L(0); PG8_BAR; PG8_MMA(0, 0, At, B0); PG8_MMA(0, 1, At, B1); PG8_BAR; PG8_SCHED;
            PG8_LDA(At, 0, 1); PG8_STAGE(PG8_SB(0, 0), b2, voffB); PG8_STAGE(PG8_SB(0, 1), b2 + hstep, voffB); PG8_STAGE_A(PG8_SA(0, 0), a2, 0, s0, s1);
            PG8_WAIT_V(8); PG8_WAIT_L(0); PG8_BAR; PG8_MMA(1, 0, At, B0); PG8_MMA(1, 1, At, B1); PG8_BAR; PG8_SCHED;
            PG8_LDB(B0, 1, 0); PG8_LDB(B1, 1, 1); PG8_SCHED; PG8_LDA(At, 1, 0); PG8_STAGE_A(PG8_SA(0, 1), a2, 1, s0, s1);
            PG8_WAIT_V(8); PG8_WAIT_L(0); PG8_BAR; PG8_MMA(0, 0, At, B0); PG8_MMA(0, 1, At, B1); PG8_BAR; PG8_SCHED;
            PG8_LDA(At, 1, 1); PG8_STAGE(PG8_SB(1, 0), b3, voffB); PG8_STAGE(PG8_SB(1, 1), b3 + hstep, voffB); PG8_STAGE_A(PG8_SA(1, 0), a3, 0, s0, s1);
            PG8_WAIT_V(8); PG8_WAIT_L(0); PG8_BAR; PG8_MMA(1, 0, At, B0); PG8_MMA(1, 1, At, B1); PG8_BAR; PG8_SCHED;
        }
        if constexpr (ALIGN_EPI) { if (wr == 0) PG8_BAR; }
        E(acc, cur, wr, wc, fr, fq);
        if (!has_next) break;
#pragma unroll
        for (int a = 0; a < 2; ++a)
#pragma unroll
            for (int b = 0; b < 2; ++b)
#pragma unroll
                for (int m = 0; m < 4; ++m)
#pragma unroll
                    for (int n = 0; n < 2; ++n) acc[a][b][m][n] = (f32x4){0.f, 0.f, 0.f, 0.f};
        cur = nxt; cA = nA; cB = nB; ++ui;
        if constexpr (GATHER) { gC0[0] = gN0[0]; gC0[1] = gN0[1]; gC1[0] = gN1[0]; gC1[1] = gN1[1]; }
        if constexpr (ALIGN_EPI) { if (wr == 1) PG8_BAR; }
    }
    PG8_WAIT_V(0);
    if constexpr (!ALIGN_EPI) { if (wr == 0) PG8_BAR; }
    PG8_BAR;
#undef PG8_SA
#undef PG8_SB
#undef PG8_STAGE
#undef PG8_STAGE_A
#undef PG8_LDA
#undef PG8_LDB
#undef PG8_MMA
#undef PG8_WAIT_V
#undef PG8_WAIT_L
#undef PG8_BAR
#undef PG8_SCHED
}

template <class Epi, class Sched, bool GATHER = false>
__device__ __forceinline__ void gemm_phase_f8n(LAS unsigned char* lds, const Gemm g, const Sched& S, const Epi& E) {
    const int tid = threadIdx.x, wid = __builtin_amdgcn_readfirstlane(tid >> 6), lane = tid & 63, wr = wid >> 2, wc = wid & 3, fr = lane & 15, fq = lane >> 4;
    const int K = g.K, nt = K / BK;
    unsigned voffA[2], voffB[2]; int Rv[2], Cv[2];
#pragma unroll
    for (int i = 0; i < 2; ++i) { int R, C; stage_rc(tid * 16 + i * 8192, R, C); const int Rb = (R & ~31) + perm32(R & 31);
        voffA[i] = (unsigned)(R * K + C) * 2u; voffB[i] = (unsigned)(Rb * K + C) * 2u; Rv[i] = R; Cv[i] = C; }
    const size_t kstep = (size_t)(BK * 2), hstep = (size_t)HALF * K * 2, tstep = 2 * hstep;
    const unsigned ldsw = (unsigned)wid * 1024u;
    const int aoff = lds_byte(wr * 64 + fr, fq * 8), boff = lds_byte(wc * 32 + fr, fq * 8);
    typedef int v8i_t __attribute__((ext_vector_type(8))); typedef int v4i_t __attribute__((ext_vector_type(4)));
#define F8_SA(b, h) (((b) * 2 + (h)) * HTB)
#define F8_SB(b) ((4 + (b) * 2) * HTB)
#define F8_STAGE(bufoff, gbase, voff) do { _Pragma("unroll") for (int _i = 0; _i < 2; ++_i) \
        __builtin_amdgcn_global_load_lds((const unsigned*)((const char*)(gbase) + (voff)[_i]), (LAS unsigned*)(lds + (bufoff) + ldsw + _i * 8192), 16, 0, 0); } while (0)
#define F8_LDA(b, h) do { _Pragma("unroll") for (int m = 0; m < 4; ++m) _Pragma("unroll") for (int k = 0; k < 2; ++k) At[m][k] = *(const LAS bf16x8*)(lds + F8_SA(b, h) + aoff + m * 2048 + k * 1024); } while (0)
#define F8_LDB(b) do { _Pragma("unroll") for (int n = 0; n < 2; ++n) _Pragma("unroll") for (int k = 0; k < 2; ++k) B0[n][k] = *(const LAS bf16x8*)(lds + F8_SB(b) + boff + n * 2048 + k * 1024); } while (0)
#define F8_CAT(x0, x1) __builtin_shufflevector(__builtin_bit_cast(v4i_t, x0), __builtin_bit_cast(v4i_t, x1), 0, 1, 2, 3, 4, 5, 6, 7)
#define F8_MMA(ai) do { __builtin_amdgcn_s_setprio(1); _Pragma("unroll") for (int m = 0; m < 4; ++m) _Pragma("unroll") for (int n = 0; n < 2; ++n) \
        acc[ai][m][n] = __builtin_amdgcn_mfma_scale_f32_16x16x128_f8f6f4(F8_CAT(B0[n][0], B0[n][1]), F8_CAT(At[m][0], At[m][1]), acc[ai][m][n], 0, 0, 0, 0x79797979, 0, 0x7f7f7f7f); \
        __builtin_amdgcn_s_setprio(0); } while (0)
#define F8_WAIT_V(n) asm volatile("s_waitcnt vmcnt(" #n ")" ::: "memory")
#define F8_WAIT_L(n) asm volatile("s_waitcnt lgkmcnt(" #n ")" ::: "memory")
#define F8_BAR __builtin_amdgcn_s_barrier()
#define F8_SCHED __builtin_amdgcn_sched_barrier(0)
    Unit cur, nxt; int ui = 0;
    if (!S.next(0, cur)) return;
    f32x4 acc[2][4][2];
#pragma unroll
    for (int a = 0; a < 2; ++a)
#pragma unroll
        for (int m = 0; m < 4; ++m)
#pragma unroll
            for (int n = 0; n < 2; ++n) acc[a][m][n] = (f32x4){0.f, 0.f, 0.f, 0.f};
    bf16x8 At[4][2], B0[2][2];
    unsigned gC0[2], gC1[2], gN0[2], gN1[2];
    if constexpr (GATHER) {
#pragma unroll
        for (int i = 0; i < 2; ++i) { gC0[i] = (unsigned)S.a_row(cur, Rv[i]) * (unsigned)(K * 2) + (unsigned)Cv[i] * 2u; gC1[i] = (unsigned)S.a_row(cur, HALF + Rv[i]) * (unsigned)(K * 2) + (unsigned)Cv[i] * 2u; gN0[i] = gC0[i]; gN1[i] = gC1[i]; }
    }
    const char* cA = GATHER ? (const char*)g.A : (const char*)g.A + (size_t)cur.pm * tstep; const char* cB = (const char*)g.Bt + (size_t)cur.pb * hstep;
#define F8_STAGE_A(bufoff, p, h, o0, o1) do { if constexpr (GATHER) { if ((h) == 0) F8_STAGE(bufoff, p, o0); else F8_STAGE(bufoff, p, o1); } else { F8_STAGE(bufoff, (p) + (h) * hstep, voffA); } } while (0)
    F8_STAGE(F8_SB(0), cB, voffB); F8_STAGE_A(F8_SA(0, 0), cA, 0, gC0, gC1); F8_STAGE_A(F8_SA(0, 1), cA, 1, gC0, gC1);
    if (wr == 1) F8_BAR;
    F8_WAIT_V(2); F8_BAR;
    F8_STAGE(F8_SB(1), cB + kstep, voffB); F8_STAGE_A(F8_SA(1, 0), cA + kstep, 0, gC0, gC1);
    F8_WAIT_V(4); F8_BAR;
    for (;;) {
        const bool has_next = S.next(ui + 1, nxt);
        const char* nA = GATHER ? (const char*)g.A : (has_next ? (const char*)g.A + (size_t)nxt.pm * tstep : cA); const char* nB = has_next ? (const char*)g.Bt + (size_t)nxt.pb * hstep : cB;
        if constexpr (GATHER) { if (has_next) {
#pragma unroll
            for (int i = 0; i < 2; ++i) { gN0[i] = (unsigned)S.a_row(nxt, Rv[i]) * (unsigned)(K * 2) + (unsigned)Cv[i] * 2u; gN1[i] = (unsigned)S.a_row(nxt, HALF + Rv[i]) * (unsigned)(K * 2) + (unsigned)Cv[i] * 2u; } } }
#pragma unroll 1
        for (int t = 0; t < nt; t += 2) {
            const bool last = (t == nt - 2);
            const char* a1 = cA + (size_t)(t + 1) * kstep;
            const char* a2 = last ? nA : cA + (size_t)(t + 2) * kstep; const char* b2 = last ? nB : cB + (size_t)(t + 2) * kstep;
            const char* a3 = a2 + kstep; const char* b3 = b2 + kstep;
            unsigned s0[2], s1[2];
            if constexpr (GATHER) { s0[0] = last ? gN0[0] : gC0[0]; s0[1] = last ? gN0[1] : gC0[1]; s1[0] = last ? gN1[0] : gC1[0]; s1[1] = last ? gN1[1] : gC1[1]; }
            F8_LDB(0); F8_SCHED; F8_LDA(0, 0); F8_STAGE_A(F8_SA(1, 1), a1, 1, gC0, gC1);
            F8_WAIT_V(6); F8_WAIT_L(0); F8_BAR; F8_MMA(0); F8_BAR; F8_SCHED;
            F8_LDA(0, 1); F8_STAGE(F8_SB(0), b2, voffB); F8_STAGE_A(F8_SA(0, 0), a2, 0, s0, s1);
            F8_WAIT_V(6); F8_WAIT_L(0); F8_BAR; F8_MMA(1); F8_BAR; F8_SCHED;
            F8_LDB(1); F8_SCHED; F8_LDA(1, 0); F8_STAGE_A(F8_SA(0, 1), a2, 1, s0, s1);
            F8_WAIT_V(6); F8_WAIT_L(0); F8_BAR; F8_MMA(0); F8_BAR; F8_SCHED;
            F8_LDA(1, 1); F8_STAGE(F8_SB(1), b3, voffB); F8_STAGE_A(F8_SA(1, 0), a3, 0, s0, s1);
            F8_WAIT_V(6); F8_WAIT_L(0); F8_BAR; F8_MMA(1); F8_BAR; F8_SCHED;
        }
        if (wr == 0) F8_BAR;
        E(acc, cur, wr, wc, fr, fq);
        if (!has_next) break;
#pragma unroll
        for (int a = 0; a < 2; ++a)
#pragma unroll
            for (int m = 0; m < 4; ++m)
#pragma unroll
                for (int n = 0; n < 2; ++n) acc[a][m][n] = (f32x4){0.f, 0.f, 0.f, 0.f};
        cur = nxt; cA = nA; cB = nB; ++ui;
        if constexpr (GATHER) { gC0[0] = gN0[0]; gC0[1] = gN0[1]; gC1[0] = gN1[0]; gC1[1] = gN1[1]; }
        if (wr == 1) F8_BAR;
    }
    F8_WAIT_V(0);
    F8_BAR;
#undef F8_SA
#undef F8_SB
#undef F8_STAGE
#undef F8_LDA
#undef F8_LDB
#undef F8_CAT
#undef F8_MMA
#undef F8_WAIT_V
#undef F8_WAIT_L
#undef F8_BAR
#undef F8_SCHED
#undef F8_STAGE_A
}
template <int I> struct SIC { static constexpr int value = I; };
template <int LO, int HI, class F> __device__ __forceinline__ void ssfor(F&& f) { if constexpr (LO < HI) { f(SIC<LO>{}); ssfor<LO + 1, HI>(f); } }
template <class Epi, class Sched, bool GATHER = false>
__device__ __forceinline__ void gemm_phase_f8p(LAS unsigned char* lds, const Gemm g, const Sched& S, const Epi& E) {
    const int tid = threadIdx.x, wid = __builtin_amdgcn_readfirstlane(tid >> 6), lane = tid & 63, wr = wid >> 2, wc = wid & 3, fr = lane & 15, fq = lane >> 4;
    const int K = g.K, nt = K / BK;
    unsigned voffA[2], voffB[2]; int Rv[2], Cv[2];
#pragma unroll
    for (int i = 0; i < 2; ++i) { int R, C; stage_rc(tid * 16 + i * 8192, R, C); const int Rb = (R & ~31) + perm32(R & 31);
        voffA[i] = (unsigned)(R * K + C) * 2u; voffB[i] = (unsigned)(Rb * K + C) * 2u; Rv[i] = R; Cv[i] = C; }
    const size_t kstep = (size_t)(BK * 2), hstep = (size_t)HALF * K * 2, tstep = 2 * hstep;
    const unsigned ldsw = (unsigned)wid * 1024u;
    const int aoff = lds_byte(wr * 64 + fr, fq * 8), boff = lds_byte(wc * 32 + fr, fq * 8);
    constexpr int STG = 3 * HTB;
    typedef int v8i_t __attribute__((ext_vector_type(8))); typedef int v4i_t __attribute__((ext_vector_type(4)));
#define P8_CAT(x0, x1) __builtin_shufflevector(__builtin_bit_cast(v4i_t, x0), __builtin_bit_cast(v4i_t, x1), 0, 1, 2, 3, 4, 5, 6, 7)
#define P8_GLDS(src, dstoff) __builtin_amdgcn_global_load_lds((const unsigned*)(src), (LAS unsigned*)(lds + (dstoff)), 16, 0, 0)
#define P8_PIECE(p, pa, pb, o0, o1, st) do { constexpr int i_ = (p) & 1; \
        if constexpr ((p) < 2)      { if constexpr (GATHER) P8_GLDS((pa) + (o0)[i_], (st) * STG + ldsw + i_ * 8192); else P8_GLDS((pa) + voffA[i_], (st) * STG + ldsw + i_ * 8192); } \
        else if constexpr ((p) < 4) { if constexpr (GATHER) P8_GLDS((pa) + (o1)[i_], (st) * STG + HTB + ldsw + i_ * 8192); else P8_GLDS((pa) + hstep + voffA[i_], (st) * STG + HTB + ldsw + i_ * 8192); } \
        else                        P8_GLDS((pb) + voffB[i_], (st) * STG + 2 * HTB + ldsw + i_ * 8192); } while (0)
#define P8_WAIT_V(n) asm volatile("s_waitcnt vmcnt(" #n ")" ::: "memory")
#define P8_BAR do { asm volatile("" ::: "memory"); __builtin_amdgcn_s_barrier(); asm volatile("" ::: "memory"); } while (0)
#define P8_SCHED __builtin_amdgcn_sched_barrier(0)
    Unit cur, nxt; int ui = 0;
    if (!S.next(0, cur)) return;
    f32x4 acc[2][4][2];
#pragma unroll
    for (int a = 0; a < 2; ++a)
#pragma unroll
        for (int m = 0; m < 4; ++m)
#pragma unroll
            for (int n = 0; n < 2; ++n) acc[a][m][n] = (f32x4){0.f, 0.f, 0.f, 0.f};
    bf16x8 AX[4][2], AY[4][2], BX[2][2], BY[2][2];
    unsigned gC0[2], gC1[2], gN0[2], gN1[2];
    if constexpr (GATHER) {
#pragma unroll
        for (int i = 0; i < 2; ++i) { gC0[i] = (unsigned)S.a_row(cur, Rv[i]) * (unsigned)(K * 2) + (unsigned)Cv[i] * 2u; gC1[i] = (unsigned)S.a_row(cur, HALF + Rv[i]) * (unsigned)(K * 2) + (unsigned)Cv[i] * 2u; gN0[i] = gC0[i]; gN1[i] = gC1[i]; }
    }
    const char* cA = GATHER ? (const char*)g.A : (const char*)g.A + (size_t)cur.pm * tstep; const char* cB = (const char*)g.Bt + (size_t)cur.pb * hstep;
#define P8_SP(AI, Acur, Anxt, Bcur, Bnxt, RDB, sr, hr, P0, qa, qb, q0, q1, sd) do { \
        ssfor<0, 8>([&](auto gc) __attribute__((always_inline)) { constexpr int g_ = decltype(gc)::value, m_ = g_ >> 1, n_ = g_ & 1; \
            acc[AI][m_][n_] = __builtin_amdgcn_mfma_scale_f32_16x16x128_f8f6f4(P8_CAT(Bcur[n_][0], Bcur[n_][1]), P8_CAT(Acur[m_][0], Acur[m_][1]), acc[AI][m_][n_], 0, 0, 0, 0x79797979, 0, 0x7f7f7f7f); \
            if constexpr (g_ == 0) P8_SCHED;     \
            Anxt[m_][n_] = *(const LAS bf16x8*)(lds + (sr) * STG + (hr) * HTB + aoff + m_ * 2048 + n_ * 1024); \
            if constexpr ((RDB) && g_ < 4) Bnxt[m_][n_] = *(const LAS bf16x8*)(lds + (sr) * STG + 2 * HTB + boff + m_ * 2048 + n_ * 1024); \
            if constexpr (g_ == 1) P8_PIECE((P0) + 0, qa, qb, q0, q1, sd); \
            if constexpr (g_ == 3) P8_PIECE((P0) + 1, qa, qb, q0, q1, sd); \
            if constexpr (g_ == 5) P8_PIECE((P0) + 2, qa, qb, q0, q1, sd); \
            P8_SCHED; }); } while (0)
    { const char* pa_ = cA; const char* pb_ = cB;
      P8_PIECE(0, pa_, pb_, gC0, gC1, 0); P8_PIECE(1, pa_, pb_, gC0, gC1, 0); P8_PIECE(2, pa_, pb_, gC0, gC1, 0); P8_PIECE(3, pa_, pb_, gC0, gC1, 0); P8_PIECE(4, pa_, pb_, gC0, gC1, 0); P8_PIECE(5, pa_, pb_, gC0, gC1, 0);
      pa_ += kstep; pb_ += kstep;
      P8_PIECE(0, pa_, pb_, gC0, gC1, 1); P8_PIECE(1, pa_, pb_, gC0, gC1, 1); P8_PIECE(2, pa_, pb_, gC0, gC1, 1); P8_PIECE(3, pa_, pb_, gC0, gC1, 1); P8_PIECE(4, pa_, pb_, gC0, gC1, 1); P8_PIECE(5, pa_, pb_, gC0, gC1, 1);
      pa_ += kstep; pb_ += kstep;
      P8_PIECE(0, pa_, pb_, gC0, gC1, 2); P8_PIECE(1, pa_, pb_, gC0, gC1, 2); P8_PIECE(2, pa_, pb_, gC0, gC1, 2); }
    P8_WAIT_V(9); P8_BAR;
#pragma unroll
    for (int m = 0; m < 4; ++m)
#pragma unroll
        for (int k = 0; k < 2; ++k) AX[m][k] = *(const LAS bf16x8*)(lds + aoff + m * 2048 + k * 1024);
#pragma unroll
    for (int n = 0; n < 2; ++n)
#pragma unroll
        for (int k = 0; k < 2; ++k) BX[n][k] = *(const LAS bf16x8*)(lds + 2 * HTB + boff + n * 2048 + k * 1024);
    int sa = 0;
    for (;;) {
        const bool has_next = S.next(ui + 1, nxt);
        const char* nA = GATHER ? (const char*)g.A : (has_next ? (const char*)g.A + (size_t)nxt.pm * tstep : cA); const char* nB = has_next ? (const char*)g.Bt + (size_t)nxt.pb * hstep : cB;
        if constexpr (GATHER) { if (has_next) {
#pragma unroll
            for (int i = 0; i < 2; ++i) { gN0[i] = (unsigned)S.a_row(nxt, Rv[i]) * (unsigned)(K * 2) + (unsigned)Cv[i] * 2u; gN1[i] = (unsigned)S.a_row(nxt, HALF + Rv[i]) * (unsigned)(K * 2) + (unsigned)Cv[i] * 2u; } } }
#pragma unroll 1
        for (int t = 0; t < nt; t += 2) {
            const int sb = sa == 2 ? 0 : sa + 1, sc = sb == 2 ? 0 : sb + 1;
            const bool x2 = t + 2 >= nt, x3 = t + 3 >= nt, x4 = t + 4 >= nt;
            const char* a2 = x2 ? nA + (size_t)(t + 2 - nt) * kstep : cA + (size_t)(t + 2) * kstep; const char* b2 = x2 ? nB + (size_t)(t + 2 - nt) * kstep : cB + (size_t)(t + 2) * kstep;
            const char* a3 = x3 ? nA + (size_t)(t + 3 - nt) * kstep : cA + (size_t)(t + 3) * kstep; const char* b3 = x3 ? nB + (size_t)(t + 3 - nt) * kstep : cB + (size_t)(t + 3) * kstep;
            const char* a4 = x4 ? nA + (size_t)(t + 4 - nt) * kstep : cA + (size_t)(t + 4) * kstep; const char* b4 = x4 ? nB + (size_t)(t + 4 - nt) * kstep : cB + (size_t)(t + 4) * kstep;
            unsigned q20[2], q21[2], q30[2], q31[2], q40[2], q41[2];
            if constexpr (GATHER) {
#pragma unroll
                for (int i = 0; i < 2; ++i) { q20[i] = x2 ? gN0[i] : gC0[i]; q21[i] = x2 ? gN1[i] : gC1[i]; q30[i] = x3 ? gN0[i] : gC0[i]; q31[i] = x3 ? gN1[i] : gC1[i]; q40[i] = x4 ? gN0[i] : gC0[i]; q41[i] = x4 ? gN1[i] : gC1[i]; } }
            P8_SP(0, AX, AY, BX, BY, false, sa, 1, 3, a2, b2, q20, q21, sc);
            P8_WAIT_V(6); asm volatile("s_waitcnt lgkmcnt(0)" ::: "memory"); P8_BAR;
            P8_SP(1, AY, AX, BX, BY, true, sb, 0, 0, a3, b3, q30, q31, sa);
            P8_SP(0, AX, AY, BY, BX, false, sb, 1, 3, a3, b3, q30, q31, sa);
            P8_WAIT_V(6); asm volatile("s_waitcnt lgkmcnt(0)" ::: "memory"); P8_BAR;
            P8_SP(1, AY, AX, BY, BX, true, sc, 0, 0, a4, b4, q40, q41, sb);
            sa = sc;
        }
        E(acc, cur, wr, wc, fr, fq);
        if (!has_next) break;
#pragma unroll
        for (int a = 0; a < 2; ++a)
#pragma unroll
            for (int m = 0; m < 4; ++m)
#pragma unroll
                for (int n = 0; n < 2; ++n) acc[a][m][n] = (f32x4){0.f, 0.f, 0.f, 0.f};
        cur = nxt; cA = nA; cB = nB; ++ui;
        if constexpr (GATHER) { gC0[0] = gN0[0]; gC0[1] = gN0[1]; gC1[0] = gN1[0]; gC1[1] = gN1[1]; }
    }
    P8_WAIT_V(0);
    P8_BAR;
#undef P8_CAT
#undef P8_GLDS
#undef P8_PIECE
#undef P8_WAIT_V
#undef P8_BAR
#undef P8_SCHED
#undef P8_SP
}

__device__ __forceinline__ u32x4 pack8(const f32x4& v0, const f32x4& v1) { u32x4 w; w.x = cvt_pk_bf16(v0[0], v0[1]); w.y = cvt_pk_bf16(v0[2], v0[3]); w.z = cvt_pk_bf16(v1[0], v1[1]); w.w = cvt_pk_bf16(v1[2], v1[3]); return w; }
__device__ __forceinline__ void rope4(f32x4& v0, f32x4& v1, const float* cs) {
    const f32x4 a = *(const f32x4*)cs, b = *(const f32x4*)(cs + 4);
    float x1, x2;
    x1 = v0[0]; x2 = v0[1]; v0[0] = x1 * a[0] - x2 * a[1]; v0[1] = x2 * a[0] + x1 * a[1];
    x1 = v0[2]; x2 = v0[3]; v0[2] = x1 * a[2] - x2 * a[3]; v0[3] = x2 * a[2] + x1 * a[3];
    x1 = v1[0]; x2 = v1[1]; v1[0] = x1 * b[0] - x2 * b[1]; v1[1] = x2 * b[0] + x1 * b[1];
    x1 = v1[2]; x2 = v1[3]; v1[2] = x1 * b[2] - x2 * b[3]; v1[3] = x2 * b[2] + x1 * b[3];
}

struct EpiIn {
    static constexpr bool PERM = true;
    bf16_t *qa, *ka, *va, *cq, *ckv, *gates, *kr; const float *ropeA, *ropeM, *bg; float* sq; unsigned char* k8r; unsigned char *q8a, *k8a;
    __device__ __forceinline__ void operator()(const f32x4 (&acc)[2][2][4][2], const Unit& u, int wr, int wc, int fr, int fq) const {
        const int pn = u.pn, row0 = u.pm * BM + wr * 64 + fr, cl = wc * 32 + 8 * fq;
        if (pn < 8) {
            bf16_t* dst = pn < 4 ? qa : ka; const int colt = (pn & 3) * 256; const bool rot = ((wc & 1) == 0) && (fq < 2);
#pragma unroll
            for (int ai = 0; ai < 2; ++ai)
#pragma unroll
                for (int m = 0; m < 4; ++m) { const int row = row0 + ai * HALF + m * 16;
#pragma unroll
                    for (int bj = 0; bj < 2; ++bj) { f32x4 v0 = acc[ai][bj][m][0], v1 = acc[ai][bj][m][1];
                        if (rot) rope4(v0, v1, ropeA + (size_t)row * 16 + fq * 8);
                        if (pn < 4) { v0 *= QS_DA; v1 *= QS_DA; }
                        if (DA_QK8 != 1) *(u32x4*)(dst + (size_t)row * 1024 + colt + bj * HALF + cl) = pack8(v0, v1);
                        if (DA_QK8) { const float s8 = pn < 4 ? 8.f : 1.f; u32x2 w8; w8.x = cvt_pk_fp8x4(v0[0] * s8, v0[1] * s8, v0[2] * s8, v0[3] * s8); w8.y = cvt_pk_fp8x4(v1[0] * s8, v1[1] * s8, v1[2] * s8, v1[3] * s8);
                            *(u32x2*)((pn < 4 ? q8a : k8a) + (size_t)row * 1024 + colt + bj * HALF + cl) = w8; } } }
        } else if (pn < 12) {
            const int colt = (pn - 8) * 256;
#pragma unroll
            for (int ai = 0; ai < 2; ++ai)
#pragma unroll
                for (int m = 0; m < 4; ++m) { const int row = row0 + ai * HALF + m * 16;
#pragma unroll
                    for (int bj = 0; bj < 2; ++bj) *(u32x4*)(va + (size_t)row * 1024 + colt + bj * HALF + cl) = pack8(acc[ai][bj][m][0], acc[ai][bj][m][1]); }
        } else if (pn < 17) {
            const bool isq = pn < 15; bf16_t* dst = isq ? cq : ckv; const int ld = isq ? QL : KVL, colt = (isq ? pn - 12 : pn - 15) * 256, tq = pn - 12;
#pragma unroll
            for (int ai = 0; ai < 2; ++ai)
#pragma unroll
                for (int m = 0; m < 4; ++m) { const int row = row0 + ai * HALF + m * 16; float s = 0.f;
#pragma unroll
                    for (int bj = 0; bj < 2; ++bj) { const f32x4 v0 = acc[ai][bj][m][0], v1 = acc[ai][bj][m][1];
                        s += (v0[0] * v0[0] + v0[1] * v0[1]) + (v0[2] * v0[2] + v0[3] * v0[3]) + (v1[0] * v1[0] + v1[1] * v1[1]) + (v1[2] * v1[2] + v1[3] * v1[3]);
                        if (UP_F8) { u32x2 w8; w8.x = cvt_pk_fp8x4(v0[0], v0[1], v0[2], v0[3]); w8.y = cvt_pk_fp8x4(v1[0], v1[1], v1[2], v1[3]); *(u32x2*)((unsigned char*)dst + (size_t)row * ld + colt + bj * HALF + cl) = w8; }
                        else *(u32x4*)(dst + (size_t)row * ld + colt + bj * HALF + cl) = pack8(v0, v1); }
                    s += __shfl_xor(s, 16); s += __shfl_xor(s, 32);
                    if (fq == 0) sq[(size_t)row * 20 + tq * 4 + wc] = s; }
        } else if (pn != 23) {
            const int colt = (pn < 23 ? pn - 17 : pn - 18) * 256;
            f32x4 bv[2][2];
#pragma unroll
            for (int bj = 0; bj < 2; ++bj) { bv[bj][0] = *(const f32x4*)(bg + colt + bj * HALF + cl); bv[bj][1] = *(const f32x4*)(bg + colt + bj * HALF + cl + 4); if (DBG_SKIP & 256) { bv[bj][0] = bv[bj][0] * 0.f; bv[bj][1] = bv[bj][1] * 0.f; } }
#pragma unroll
            for (int ai = 0; ai < 2; ++ai)
#pragma unroll
                for (int m = 0; m < 4; ++m) { const int row = row0 + ai * HALF + m * 16;
#pragma unroll
                    for (int bj = 0; bj < 2; ++bj) { f32x4 v0 = acc[ai][bj][m][0] + bv[bj][0], v1 = acc[ai][bj][m][1] + bv[bj][1];
#pragma unroll
                        for (int j = 0; j < 4; ++j) { if (!(DBG_SKIP & 512)) { v0[j] = sigmoidf_(v0[j]); v1[j] = sigmoidf_(v1[j]); } }
                        *(u32x4*)(gates + (size_t)row * 2048 + colt + bj * HALF + cl) = pack8(v0, v1); } }
        } else {
            if (wc < 2) {
#pragma unroll
                for (int ai = 0; ai < 2; ++ai)
#pragma unroll
                    for (int m = 0; m < 4; ++m) { const int row = row0 + ai * HALF + m * 16;
                        f32x4 v0 = acc[ai][0][m][0], v1 = acc[ai][0][m][1];
                        rope4(v0, v1, ropeM + (size_t)row * 64 + (wc * 16 + fq * 4) * 2);
                        if (!MLA_QK8) *(u32x4*)(kr + (size_t)row * 64 + cl) = pack8(v0, v1);
                        if (MLA_QK8) { u32x2 w8; w8.x = cvt_pk_fp8x4(v0[0], v0[1], v0[2], v0[3]); w8.y = cvt_pk_fp8x4(v1[0], v1[1], v1[2], v1[3]); *(u32x2*)(k8r + (size_t)row * 64 + cl) = w8; } }
            }
        }
    }
};
template <bool ISQ> struct EpiUp {
    static constexpr bool PERM = true;
    bf16_t* out; const float* sq; const float* ropeM; unsigned char* out8;
    __device__ __forceinline__ void operator()(const f32x4 (&acc)[2][2][4][2], const Unit& u, int wr, int wc, int fr, int fq) const {
        const int row0 = u.pm * BM + wr * 64 + fr, cl = wc * 32 + 8 * fq; constexpr int LD = ISQ ? 1536 : 2048;
#pragma unroll
        for (int ai = 0; ai < 2; ++ai)
#pragma unroll
            for (int m = 0; m < 4; ++m) { const int row = row0 + ai * HALF + m * 16; float s;
                if (ISQ) { const f32x4 a = *(const f32x4*)(sq + (size_t)row * 20), b = *(const f32x4*)(sq + (size_t)row * 20 + 4), c = *(const f32x4*)(sq + (size_t)row * 20 + 8);
                    s = ((a[0] + a[1]) + (a[2] + a[3])) + ((b[0] + b[1]) + (b[2] + b[3])) + ((c[0] + c[1]) + (c[2] + c[3])); }
                else { const f32x4 a = *(const f32x4*)(sq + (size_t)row * 20 + 12), b = *(const f32x4*)(sq + (size_t)row * 20 + 16);
                    s = ((a[0] + a[1]) + (a[2] + a[3])) + ((b[0] + b[1]) + (b[2] + b[3])); }
                const float rstd = __builtin_amdgcn_rsqf(s * (ISQ ? 1.0f / QL : 1.0f / KVL) + EPS) * (ISQ ? QS_MLA : 1.0f);
#pragma unroll
                for (int bj = 0; bj < 2; ++bj) { const int col = u.pn * BM + bj * HALF + cl; f32x4 v0 = acc[ai][bj][m][0] * rstd, v1 = acc[ai][bj][m][1] * rstd;
                    if (ISQ) { const int off = col % 192; if (off >= 128) rope4(v0, v1, ropeM + (size_t)row * 64 + (off - 128)); }
                    if (!MLA_QK8 || (!ISQ && bj == 1)) *(u32x4*)(out + (size_t)row * LD + col) = pack8(v0, v1);
                    if (MLA_QK8) { u32x2 w8;
                        if (ISQ) { w8.x = cvt_pk_fp8x4(v0[0] * 8.f, v0[1] * 8.f, v0[2] * 8.f, v0[3] * 8.f); w8.y = cvt_pk_fp8x4(v1[0] * 8.f, v1[1] * 8.f, v1[2] * 8.f, v1[3] * 8.f); *(u32x2*)(out8 + (size_t)row * 1536 + col) = w8; }
                        else if (bj == 0) { w8.x = cvt_pk_fp8x4(v0[0], v0[1], v0[2], v0[3]); w8.y = cvt_pk_fp8x4(v1[0], v1[1], v1[2], v1[3]); *(u32x2*)(out8 + (size_t)row * 1024 + u.pn * 128 + cl) = w8; } } } }
    }
};
template <bool ISQ> struct EpiUp8 {
    bf16_t* out; const float* sq; const float* ropeM; unsigned char* out8;
    __device__ __forceinline__ void operator()(const f32x4 (&acc)[2][4][2], const Unit& u, int wr, int wc, int fr, int fq) const {
        const int row0 = u.pm * BM + wr * 64 + fr, col = u.pn * HALF + wc * 32 + 8 * fq;
#pragma unroll
        for (int ai = 0; ai < 2; ++ai)
#pragma unroll
            for (int m = 0; m < 4; ++m) { const int row = row0 + ai * HALF + m * 16; float s;
                if (ISQ) { const f32x4 a = *(const f32x4*)(sq + (size_t)row * 20), b = *(const f32x4*)(sq + (size_t)row * 20 + 4), c = *(const f32x4*)(sq + (size_t)row * 20 + 8);
                    s = ((a[0] + a[1]) + (a[2] + a[3])) + ((b[0] + b[1]) + (b[2] + b[3])) + ((c[0] + c[1]) + (c[2] + c[3])); }
                else { const f32x4 a = *(const f32x4*)(sq + (size_t)row * 20 + 12), b = *(const f32x4*)(sq + (size_t)row * 20 + 16);
                    s = ((a[0] + a[1]) + (a[2] + a[3])) + ((b[0] + b[1]) + (b[2] + b[3])); }
                const float rstd = __builtin_amdgcn_rsqf(s * (ISQ ? 1.0f / QL : 1.0f / KVL) + EPS) * (ISQ ? QS_MLA : 1.0f);
                f32x4 v0 = acc[ai][m][0] * rstd, v1 = acc[ai][m][1] * rstd;
                if (ISQ) { const int off = col % 192; if (off >= 128) rope4(v0, v1, ropeM + (size_t)row * 64 + (off - 128));
                    u32x2 w8; w8.x = cvt_pk_fp8x4(v0[0] * 8.f, v0[1] * 8.f, v0[2] * 8.f, v0[3] * 8.f); w8.y = cvt_pk_fp8x4(v1[0] * 8.f, v1[1] * 8.f, v1[2] * 8.f, v1[3] * 8.f); *(u32x2*)(out8 + (size_t)row * 1536 + col) = w8; }
                else if ((u.pn & 1) == 0) { u32x2 w8; w8.x = cvt_pk_fp8x4(v0[0], v0[1], v0[2], v0[3]); w8.y = cvt_pk_fp8x4(v1[0], v1[1], v1[2], v1[3]); *(u32x2*)(out8 + (size_t)row * 1024 + (u.pn >> 1) * 128 + wc * 32 + 8 * fq) = w8; }
                else *(u32x4*)(out + (size_t)row * 2048 + col) = pack8(v0, v1); }
    }
};
template <int WHICH> struct EpiGate {
    static constexpr bool PERM = true;
    bf16_t* mrg; const bf16_t* gates;
    __device__ __forceinline__ void operator()(const f32x4 (&acc)[2][2][4][2], const Unit& u, int wr, int wc, int fr, int fq) const {
        const int row0 = u.pm * BM + wr * 64 + fr, cl = wc * 32 + 8 * fq;
#pragma unroll
        for (int ai = 0; ai < 2; ++ai)
#pragma unroll
            for (int m = 0; m < 4; ++m) { const int row = row0 + ai * HALF + m * 16;
#pragma unroll
                for (int bj = 0; bj < 2; ++bj) { const int col = u.pn * BM + bj * HALF + cl;
                    const u32x4 gw = *(const u32x4*)(gates + (size_t)row * 2048 + WHICH * 1024 + col);
                    f32x4 v0 = acc[ai][bj][m][0], v1 = acc[ai][bj][m][1];
                    if ((DBG_SKIP & 8) && WHICH == 0) { v0 = v0 * 0.f; v1 = v1 * 0.f; } if ((DBG_SKIP & 16) && WHICH == 1) { v0 = v0 * 0.f; v1 = v1 * 0.f; }
                    v0[0] *= bf_lo(gw.x); v0[1] *= bf_hi(gw.x); v0[2] *= bf_lo(gw.y); v0[3] *= bf_hi(gw.y); v1[0] *= bf_lo(gw.z); v1[1] *= bf_hi(gw.z); v1[2] *= bf_lo(gw.w); v1[3] *= bf_hi(gw.w);
                    if (WHICH == 1) { const u32x4 tw = *(const u32x4*)(mrg + (size_t)row * 1024 + col);
                        v0[0] += bf_lo(tw.x); v0[1] += bf_hi(tw.x); v0[2] += bf_lo(tw.y); v0[3] += bf_hi(tw.y); v1[0] += bf_lo(tw.z); v1[1] += bf_hi(tw.z); v1[2] += bf_lo(tw.w); v1[3] += bf_hi(tw.w); }
                    *(u32x4*)(mrg + (size_t)row * 1024 + col) = pack8(v0, v1); } }
    }
};
struct EpiRes {
    static constexpr bool PERM = false;
    const float* x; bf16_t* out;
    __device__ __forceinline__ void operator()(const f32x4 (&acc)[2][2][4][2], const Unit& u, int wr, int wc, int fr, int fq) const {
        const int row0 = u.pm * BM + wr * 64 + fr, col0 = u.pn * BM + wc * 32 + 4 * fq;
#pragma unroll
        for (int ai = 0; ai < 2; ++ai)
#pragma unroll
            for (int m = 0; m < 4; ++m) { const size_t off = (size_t)(row0 + ai * HALF + m * 16) * 1024 + col0;
#pragma unroll
                for (int bj = 0; bj < 2; ++bj)
#pragma unroll
                    for (int n = 0; n < 2; ++n) { const f32x4 v = *(const f32x4*)(x + off + bj * HALF + n * 16) + ((DBG_SKIP & 2) ? 0.f : 1.f) * acc[ai][bj][m][n];
                        u32x2 w; w.x = cvt_pk_bf16(v[0], v[1]); w.y = cvt_pk_bf16(v[2], v[3]); *(u32x2*)(out + off + bj * HALF + n * 16) = w; } }
    }
};
struct EpiSwiglu {
    static constexpr bool PERM = true;
    bf16_t* act; const float *bgate, *bup;
    __device__ __forceinline__ void operator()(const f32x4 (&acc)[2][2][4][2], const Unit& u, int wr, int wc, int fr, int fq) const {
        const int row0 = u.pm * BM + wr * 64 + fr, f0 = u.pn * HALF + wc * 32 + 8 * fq;
        f32x4 bgv[2], buv[2];
#pragma unroll
        for (int n = 0; n < 2; ++n) { bgv[n] = *(const f32x4*)(bgate + (size_t)u.e * FF + f0 + 4 * n); buv[n] = *(const f32x4*)(bup + (size_t)u.e * FF + f0 + 4 * n); }
#pragma unroll
        for (int ai = 0; ai < 2; ++ai)
#pragma unroll
            for (int m = 0; m < 4; ++m) { const int row = row0 + ai * HALF + m * 16; f32x4 o[2];
#pragma unroll
                for (int n = 0; n < 2; ++n) { const f32x4 gt = acc[ai][0][m][n] + bgv[n], up = acc[ai][1][m][n] + buv[n];
#pragma unroll
                    for (int j = 0; j < 4; ++j) { const float gg = fminf(gt[j], 7.0f), uu = fminf(fmaxf(up[j], -7.0f), 7.0f); o[n][j] = (uu + 1.0f) * (gg * sigmoidf_(1.702f * gg)); } }
                u32x2 w8; w8.x = cvt_pk_fp8x4(o[0][0], o[0][1], o[0][2], o[0][3]); w8.y = cvt_pk_fp8x4(o[1][0], o[1][1], o[1][2], o[1][3]);
                *(u32x2*)((unsigned char*)act + (size_t)row * FF + f0) = w8; }
    }
};
struct EpiDown {
    static constexpr bool PERM = true;
    bf16_t* y; const float* bd;
    __device__ __forceinline__ void operator()(const f32x4 (&acc)[2][2][4][2], const Unit& u, int wr, int wc, int fr, int fq) const {
        const int row0 = u.pm * BM + wr * 64 + fr, cl = wc * 32 + 8 * fq;
        f32x4 bv[2][2];
#pragma unroll
        for (int bj = 0; bj < 2; ++bj) { const int col = u.pn * BM + bj * HALF + cl; bv[bj][0] = *(const f32x4*)(bd + (size_t)u.e * D + col); bv[bj][1] = *(const f32x4*)(bd + (size_t)u.e * D + col + 4); }
#pragma unroll
        for (int ai = 0; ai < 2; ++ai)
#pragma unroll
            for (int m = 0; m < 4; ++m) { const int row = row0 + ai * HALF + m * 16;
#pragma unroll
                for (int bj = 0; bj < 2; ++bj) { const int col = u.pn * BM + bj * HALF + cl;
                    *(u32x4*)(y + (size_t)row * D + col) = pack8(acc[ai][bj][m][0] + bv[bj][0], acc[ai][bj][m][1] + bv[bj][1]); } }
    }
};
struct EpiSwiglu8 {
    unsigned char* act; const float *bgate, *bup;
    __device__ __forceinline__ void operator()(const f32x4 (&acc)[2][4][2], const Unit& u, int wr, int wc, int fr, int fq) const {
        const int row0 = u.pm * BM + wr * 64 + fr, f0 = u.pn * 64 + wc * 16 + 4 * fq;
        const f32x4 bgv = *(const f32x4*)(bgate + (size_t)u.e * FF + f0), buv = *(const f32x4*)(bup + (size_t)u.e * FF + f0);
#pragma unroll
        for (int ai = 0; ai < 2; ++ai)
#pragma unroll
            for (int m = 0; m < 4; ++m) { const int row = row0 + ai * HALF + m * 16; const f32x4 gt = acc[ai][m][0] + bgv, up = acc[ai][m][1] + buv; float o[4];
#pragma unroll
                for (int j = 0; j < 4; ++j) { const float gg = fminf(gt[j], 7.0f), uu = fminf(fmaxf(up[j], -7.0f), 7.0f); o[j] = (uu + 1.0f) * (gg * sigmoidf_(1.702f * gg)); }
                *(unsigned*)(act + (size_t)row * FF + f0) = cvt_pk_fp8x4(o[0], o[1], o[2], o[3]); }
    }
};
struct EpiDown8 {
    unsigned char* y; const float* bd;
    __device__ __forceinline__ void operator()(const f32x4 (&acc)[2][4][2], const Unit& u, int wr, int wc, int fr, int fq) const {
        const int row0 = u.pm * BM + wr * 64 + fr, col = u.pn * HALF + wc * 32 + 8 * fq;
        const f32x4 bv0 = *(const f32x4*)(bd + (size_t)u.e * D + col), bv1 = *(const f32x4*)(bd + (size_t)u.e * D + col + 4);
#pragma unroll
        for (int ai = 0; ai < 2; ++ai)
#pragma unroll
            for (int m = 0; m < 4; ++m) { const int row = row0 + ai * HALF + m * 16; const f32x4 v0 = (acc[ai][m][0] + bv0) * YS, v1 = (acc[ai][m][1] + bv1) * YS;
                u32x2 w; w.x = cvt_pk_fp8x4(v0[0], v0[1], v0[2], v0[3]); w.y = cvt_pk_fp8x4(v1[0], v1[1], v1[2], v1[3]);
                *(u32x2*)(y + (size_t)row * D + col) = w; }
    }
};
}

namespace att {
constexpr int NW = 8, QBLK = 32, KVBLK = 64;
constexpr int SHM_V = KVBLK * 128 * 2;
#define SBAR() __builtin_amdgcn_sched_barrier(0)
#define KSW(row, colB) ((row) * 128 + ((colB) ^ ((((row) >> 1) & 7) << 4)))
__device__ __forceinline__ int crow(int r, int hi) { return (r & 3) + 8 * (r >> 2) + 4 * hi; }
struct Src { const bf16_t* Q; const bf16_t* K; const bf16_t* K2; const bf16_t* V; int ldq, ldk, ldk2, ldv; };

__device__ __forceinline__ void partialSM(f32x16& p0, f32x16& p1, float& m_reg, float& mn, float& alpha, const float C, const float thr) {
  float pmax;
  { float a0 = fmaxf(fmaxf(p0[0], p0[1]), p0[2]), a1 = fmaxf(fmaxf(p0[3], p0[4]), p0[5]), a2 = fmaxf(fmaxf(p1[0], p1[1]), p1[2]), a3 = fmaxf(fmaxf(p1[3], p1[4]), p1[5]);
#pragma unroll
    for (int r = 6; r < 16; r += 2) { a0 = fmaxf(fmaxf(a0, p0[r]), p0[r + 1]); a2 = fmaxf(fmaxf(a2, p1[r]), p1[r + 1]); }
    pmax = fmaxf(fmaxf(a0, a1), fmaxf(a2, a3)); }
  { auto rr = __builtin_amdgcn_permlane32_swap(__float_as_uint(pmax), __float_as_uint(pmax), false, false);
    pmax = fmaxf(__uint_as_float(rr[0]), __uint_as_float(rr[1])); }
  if (__builtin_expect(__all(pmax - m_reg <= thr), 1)) { mn = m_reg; alpha = 1.f; }
  else { mn = fmaxf(m_reg, pmax); alpha = __builtin_amdgcn_exp2f((m_reg - mn) * C); m_reg = mn; }
  const float mnC = -mn * C;
#pragma unroll
  for (int r = 0; r < 16; ++r) p0[r] = fmaf(p0[r], C, mnC);
#pragma unroll
  for (int r = 0; r < 16; ++r) p1[r] = fmaf(p1[r], C, mnC);
#pragma unroll
  for (int r = 0; r < 16; ++r) p0[r] = __builtin_amdgcn_exp2f(p0[r]);
#if ATT_DUP == 1
  { float d_[16];
#pragma unroll
    for (int r = 0; r < 16; ++r) { d_[r] = __builtin_amdgcn_exp2f(p1[r]); d_[r] = fmaf(d_[r], C, mnC); }
#pragma unroll
    for (int r = 0; r < 16; ++r) asm volatile("" :: "v"(d_[r])); }
#endif
}
__device__ __forceinline__ void finishSM(f32x16& p0, f32x16& p1, float alpha, float& l_reg, bf16x8& pa0, bf16x8& pa1, bf16x8& pa2, bf16x8& pa3) {
#pragma unroll
  for (int r = 0; r < 16; ++r) p1[r] = __builtin_amdgcn_exp2f(p1[r]);
  float ps;
  { float s0 = p0[0] + p0[1], s1 = p0[2] + p0[3], s2 = p1[0] + p1[1], s3 = p1[2] + p1[3];
#pragma unroll
    for (int r = 4; r < 16; r += 4) { s0 += p0[r] + p0[r + 1]; s1 += p0[r + 2] + p0[r + 3]; s2 += p1[r] + p1[r + 1]; s3 += p1[r + 2] + p1[r + 3]; }
    ps = (s0 + s1) + (s2 + s3); }
  { auto rr = __builtin_amdgcn_permlane32_swap(__float_as_uint(ps), __float_as_uint(ps), false, false);
    ps = __uint_as_float(rr[0]) + __uint_as_float(rr[1]); }
  l_reg = l_reg * alpha + ps;
#define PK4(P, BASE, OUT) do { unsigned a0 = cvt_pk_bf16(P[BASE + 0], P[BASE + 1]), a1 = cvt_pk_bf16(P[BASE + 2], P[BASE + 3]);   \
    unsigned b0 = cvt_pk_bf16(P[BASE + 4], P[BASE + 5]), b1 = cvt_pk_bf16(P[BASE + 6], P[BASE + 7]);                              \
    auto r0 = __builtin_amdgcn_permlane32_swap(a0, b0, false, false); auto r1 = __builtin_amdgcn_permlane32_swap(a1, b1, false, false); \
    u32x4 w = {r0[0], r1[0], r0[1], r1[1]}; OUT = *reinterpret_cast<bf16x8*>(&w); } while (0)
  PK4(p0, 0, pa0); PK4(p0, 8, pa1); PK4(p1, 0, pa2); PK4(p1, 8, pa3);
#undef PK4
}
template <int DQK> __device__ __forceinline__ void qkt(f32x16& p0, f32x16& p1, const LAS char* Ks, const bf16x8* qr, int r32, int hi) {
  p0 = f32x16{}; p1 = f32x16{};
#pragma unroll
  for (int d0 = 0; d0 < DQK / 16; d0 += 2) {
    bf16x8 kf[2][2];
#pragma unroll
    for (int d = 0; d < 2; ++d) { const int sub = (d0 + d) >> 2, cb = (((d0 + d) & 3) * 16 + hi * 8) * 2;
      kf[d][0] = *(const LAS bf16x8*)(Ks + sub * 8192 + KSW(r32, cb)); kf[d][1] = *(const LAS bf16x8*)(Ks + sub * 8192 + KSW(32 + r32, cb)); }
    SBAR();
#pragma unroll
    for (int d = 0; d < 2; ++d) {
      p0 = __builtin_amdgcn_mfma_f32_32x32x16_bf16(kf[d][0], qr[d0 + d], p0, 0, 0, 0);
      p1 = __builtin_amdgcn_mfma_f32_32x32x16_bf16(kf[d][1], qr[d0 + d], p1, 0, 0, 0); }
  }
}
__device__ __forceinline__ int v_st(int k, int c) { const int kk = (k & ~0xC) | ((k & 4) << 1) | ((k & 8) >> 1); return ((kk >> 3) * 4 + (c >> 5)) * 512 + ((kk & 7) * 32 + (c & 31)) * 2; }
__device__ __forceinline__ int v_rd_base(int lane) { return ((lane & 3) << 3) | (((lane >> 2) & 3) << 6) | (((lane >> 4) & 1) << 5) | (((lane >> 5) & 1) << 8); }
constexpr int v_rd_off(int d0, int ks, int half) { return d0 * 512 + ks * 4096 + half * 2048; }
template <int OFF> __device__ __forceinline__ s16x4 tr_read(int vb) {
  s16x4 r; asm volatile("ds_read_b64_tr_b16 %0, %1 offset:%2" : "=&v"(r) : "v"(vb), "i"(OFF) : "memory"); return r;
}
template <int KS> __device__ __forceinline__ void pv_step(f32x16* o, int vb, bf16x8 pa) {
  s16x4 l0, h0, l1, h1, l2, h2, l3, h3;
  l0 = tr_read<v_rd_off(0, KS, 0)>(vb); h0 = tr_read<v_rd_off(0, KS, 1)>(vb); l1 = tr_read<v_rd_off(1, KS, 0)>(vb); h1 = tr_read<v_rd_off(1, KS, 1)>(vb);
  l2 = tr_read<v_rd_off(2, KS, 0)>(vb); h2 = tr_read<v_rd_off(2, KS, 1)>(vb); l3 = tr_read<v_rd_off(3, KS, 0)>(vb); h3 = tr_read<v_rd_off(3, KS, 1)>(vb);
  asm volatile("s_waitcnt lgkmcnt(0)" ::: "memory"); SBAR();
#define PK(L, H) (bf16x8){L[0], L[1], L[2], L[3], H[0], H[1], H[2], H[3]}
  o[0] = __builtin_amdgcn_mfma_f32_32x32x16_bf16(pa, PK(l0, h0), o[0], 0, 0, 0);
  o[1] = __builtin_amdgcn_mfma_f32_32x32x16_bf16(pa, PK(l1, h1), o[1], 0, 0, 0);
  o[2] = __builtin_amdgcn_mfma_f32_32x32x16_bf16(pa, PK(l2, h2), o[2], 0, 0, 0);
  o[3] = __builtin_amdgcn_mfma_f32_32x32x16_bf16(pa, PK(l3, h3), o[3], 0, 0, 0);
#undef PK
}
__device__ __forceinline__ void pv_d0(f32x16* o, int vb, bf16x8 pa0, bf16x8 pa1, bf16x8 pa2, bf16x8 pa3) {
  pv_step<0>(o, vb, pa0); pv_step<1>(o, vb, pa1); pv_step<2>(o, vb, pa2); pv_step<3>(o, vb, pa3);
}
template <int DQK>
__device__ __forceinline__ void attn_core(const Src in, const float C, const float thr, const int seq, LAS char* lds, f32x16 (&o)[4]) {
  constexpr int NSUB = DQK / 64, SHM_K = NSUB * 8192;
  int lane; asm volatile("v_and_b32 %0, 63, %1" : "=v"(lane) : "v"(threadIdx.x));
  const int tid = threadIdx.x, wid = __builtin_amdgcn_readfirstlane(tid >> 6), r32 = lane & 31, hi = (lane >> 5) & 1;
  LAS char* V_lds = lds; LAS char* K_lds = lds + 3 * SHM_V;
  LAS float* ws = (LAS float*)(lds + 3 * SHM_V + 3 * SHM_K) + wid * 64; LAS float* li_l = ws; LAS float* al_l = ws + 32;
  float m_reg = -1e30f, l_reg = 0;
#pragma unroll
  for (int d = 0; d < 4; ++d) o[d] = f32x16{};
  bf16x8 qr[DQK / 16];
  const bf16_t* Qw = in.Q + (size_t)(wid * QBLK + r32) * in.ldq + hi * 8;
#pragma unroll
  for (int d0 = 0; d0 < DQK / 16; ++d0) qr[d0] = *(const bf16x8*)(Qw + d0 * 16);
  const int krow = wid * 8 + (lane >> 3), kslot = (lane & 7) ^ ((krow >> 1) & 7);
  const unsigned koff = (unsigned)(krow * in.ldk + kslot * 8) * 2u, k2off = (unsigned)(krow * in.ldk2 + kslot * 8) * 2u;
  unsigned voff[2];
#pragma unroll
  for (int i = 0; i < 2; ++i) { const int p = i * 8192 + wid * 1024 + lane * 16, st = p >> 9, wq = (p & 511) >> 1, kk = (st >> 2) * 8 + (wq >> 5), cl = wq & 31;
    const int k = (kk & ~0xC) | ((kk & 4) << 1) | ((kk & 8) >> 1); voff[i] = (unsigned)(k * in.ldv + (st & 3) * 32 + cl) * 2u; }
  const int vb0 = (int)(unsigned)(size_t)V_lds + v_rd_base(lane);
  const unsigned ldsw = (unsigned)wid * 1024u;
#define GLDS(gp, lp) __builtin_amdgcn_global_load_lds((const unsigned*)(gp), (LAS unsigned*)(lp), 16, 0, 0)
#define ISSUE_K(t, b) do { const char* kb_ = (const char*)in.K + (size_t)(t) * (KVBLK * 2) * in.ldk; \
    _Pragma("unroll") for (int s_ = 0; s_ < NSUB; ++s_) { if (s_ < 2) GLDS(kb_ + s_ * 128 + koff, K_lds + (b) * SHM_K + s_ * 8192 + ldsw); \
      else GLDS((const char*)in.K2 + (size_t)(t) * (KVBLK * 2) * in.ldk2 + k2off, K_lds + (b) * SHM_K + s_ * 8192 + ldsw); } } while (0)
#define ISSUE_V(t, b) do { const char* vb_ = (const char*)in.V + (size_t)(t) * (KVBLK * 2) * in.ldv; \
    GLDS(vb_ + voff[0], V_lds + (b) * SHM_V + ldsw); GLDS(vb_ + voff[1], V_lds + (b) * SHM_V + 8192 + ldsw); \
    if (ATT_DUP == 3) { GLDS(vb_ + voff[0], V_lds + (b) * SHM_V + ldsw); GLDS(vb_ + voff[1], V_lds + (b) * SHM_V + 8192 + ldsw); } } while (0)
#define WAITV(n) asm volatile("s_waitcnt vmcnt(%0)" :: "n"((DBG_SKIP & 4) ? 0 : (n)) : "memory")
#define WBAR() do { asm volatile("" ::: "memory"); __builtin_amdgcn_s_barrier(); asm volatile("" ::: "memory"); } while (0)
#define RESC(a) do { if (__any((a) < 1.f)) { if (hi == 0) al_l[r32] = (a); asm volatile("s_waitcnt lgkmcnt(0)" ::: "memory"); \
    _Pragma("unroll") for (int d = 0; d < 4; ++d) _Pragma("unroll") for (int r = 0; r < 16; ++r) o[d][r] *= al_l[crow(r, hi)]; } } while (0)
#define NXT3(x) ((x) == 2 ? 0 : (x) + 1)
  constexpr int NI = NSUB + (ATT_DUP == 3 ? 4 : 2), NV = (ATT_DUP == 3 ? 4 : 2);
  f32x16 pA0, pA1, pB0, pB1; float mnA, mnB, alA, alB; bf16x8 pa0, pa1, pa2, pa3; const int NT = seq / KVBLK;
  const bool lead = wid < 4;
  ISSUE_K(0, 0); ISSUE_K(1, 1); ISSUE_V(0, 0);
  if (!lead) { WAITV(NI); WBAR(); }
  WAITV(NI); WBAR();
  ISSUE_K(2, 2);
  qkt<DQK>(pA0, pA1, K_lds, qr, r32, hi);
  WAITV(NI); WBAR();
  ISSUE_V(1, 1);
  partialSM(pA0, pA1, m_reg, mnA, alA, C, thr);
  WAITV(NI); WBAR();
  int bq = 1;
  for (int j = 1; j + 3 < NT; j += 2) {
    { const int b1 = NXT3(bq), b2 = NXT3(b1);
      ISSUE_K(j + 2, b2);
      SBAR(); qkt<DQK>(pB0, pB1, K_lds + bq * SHM_K, qr, r32, hi);
      finishSM(pA0, pA1, alA, l_reg, pa0, pa1, pa2, pa3); SBAR();
      WAITV(NI); WBAR();
      ISSUE_V(j + 1, b1);
      pv_d0(o, vb0 + b2 * SHM_V, pa0, pa1, pa2, pa3); partialSM(pB0, pB1, m_reg, mnB, alB, C, thr);
      RESC(alB); bq = b1;
      WAITV(NI); WBAR(); }
    { const int b1 = NXT3(bq), b2 = NXT3(b1);
      ISSUE_K(j + 3, b2);
      SBAR(); qkt<DQK>(pA0, pA1, K_lds + bq * SHM_K, qr, r32, hi);
      finishSM(pB0, pB1, alB, l_reg, pa0, pa1, pa2, pa3); SBAR();
      WAITV(NI); WBAR();
      ISSUE_V(j + 2, b1);
      pv_d0(o, vb0 + b2 * SHM_V, pa0, pa1, pa2, pa3); partialSM(pA0, pA1, m_reg, mnA, alA, C, thr);
      RESC(alA); bq = b1;
      WAITV(NI); WBAR(); }
  }
  { const int b1 = NXT3(bq), b2 = NXT3(b1);
    ISSUE_K(NT - 1, b2);
    SBAR(); qkt<DQK>(pB0, pB1, K_lds + bq * SHM_K, qr, r32, hi);
    finishSM(pA0, pA1, alA, l_reg, pa0, pa1, pa2, pa3); SBAR();
    WAITV(NI); WBAR();
    ISSUE_V(NT - 2, b1);
    pv_d0(o, vb0 + b2 * SHM_V, pa0, pa1, pa2, pa3); partialSM(pB0, pB1, m_reg, mnB, alB, C, thr);
    RESC(alB); bq = b1;
    WAITV(NI); WBAR(); }
  { const int b1 = NXT3(bq), b2 = NXT3(b1);
    SBAR(); qkt<DQK>(pA0, pA1, K_lds + bq * SHM_K, qr, r32, hi);
    finishSM(pB0, pB1, alB, l_reg, pa0, pa1, pa2, pa3); SBAR();
    WAITV(NV); WBAR();
    ISSUE_V(NT - 1, b1);
    pv_d0(o, vb0 + b2 * SHM_V, pa0, pa1, pa2, pa3); partialSM(pA0, pA1, m_reg, mnA, alA, C, thr);
    RESC(alA); bq = b1;
    WAITV(NV); WBAR(); }
  { const int b2 = NXT3(NXT3(bq));
    SBAR(); qkt<DQK>(pB0, pB1, K_lds + bq * SHM_K, qr, r32, hi);
    finishSM(pA0, pA1, alA, l_reg, pa0, pa1, pa2, pa3); SBAR();
    WAITV(0); WBAR();
    pv_d0(o, vb0 + b2 * SHM_V, pa0, pa1, pa2, pa3); partialSM(pB0, pB1, m_reg, mnB, alB, C, thr);
    RESC(alB);
    WBAR(); }
  finishSM(pB0, pB1, alB, l_reg, pa0, pa1, pa2, pa3); SBAR();
  pv_d0(o, vb0 + bq * SHM_V, pa0, pa1, pa2, pa3);
  if (lead) { WBAR(); }
  if (hi == 0) li_l[r32] = l_reg; asm volatile("s_waitcnt lgkmcnt(0)" ::: "memory");
#pragma unroll
  for (int r = 0; r < 16; ++r) { const float rl = __builtin_amdgcn_rcpf(li_l[crow(r, hi)]);
#pragma unroll
    for (int d = 0; d < 4; ++d) o[d][r] *= rl; }
  asm volatile("s_waitcnt lgkmcnt(0)" ::: "memory"); WBAR();
#undef GLDS
#undef ISSUE_K
#undef ISSUE_V
#undef WAITV
#undef WBAR
#undef RESC
#undef NXT3
}
template <int DQK>
__device__ __forceinline__ void attn_core_seq(const Src in, const float C, const float thr, const int seq, LAS char* lds, f32x16 (&o)[4], float* probe = nullptr) {
  constexpr int NSUB = DQK / 64, SHM_K = NSUB * 8192;
  int lane; asm volatile("v_and_b32 %0, 63, %1" : "=v"(lane) : "v"(threadIdx.x));
  const int tid = threadIdx.x, wid = __builtin_amdgcn_readfirstlane(tid >> 6), r32 = lane & 31, hi = (lane >> 5) & 1;
  LAS char* V_lds = lds; LAS char* K_lds = lds + 3 * SHM_V;
  LAS float* ws = (LAS float*)(lds + 3 * SHM_V + 3 * SHM_K) + wid * 64; LAS float* li_l = ws; LAS float* al_l = ws + 32;
  float m_reg = -1e30f, l_reg = 0;
#pragma unroll
  for (int d = 0; d < 4; ++d) o[d] = f32x16{};
  bf16x8 qr[DQK / 16];
  const bf16_t* Qw = in.Q + (size_t)(wid * QBLK + r32) * in.ldq + hi * 8;
#pragma unroll
  for (int d0 = 0; d0 < DQK / 16; ++d0) qr[d0] = *(const bf16x8*)(Qw + d0 * 16);
  const int krow = wid * 8 + (lane >> 3), kslot = (lane & 7) ^ ((krow >> 1) & 7);
  const unsigned koff = (unsigned)(krow * in.ldk + kslot * 8) * 2u, k2off = (unsigned)(krow * in.ldk2 + kslot * 8) * 2u;
  unsigned voff[2];
#pragma unroll
  for (int i = 0; i < 2; ++i) { const int p = i * 8192 + wid * 1024 + lane * 16, st = p >> 9, wq = (p & 511) >> 1, kk = (st >> 2) * 8 + (wq >> 5), cl = wq & 31;
    const int k = (kk & ~0xC) | ((kk & 4) << 1) | ((kk & 8) >> 1); voff[i] = (unsigned)(k * in.ldv + (st & 3) * 32 + cl) * 2u; }
  const int vb0 = (int)(unsigned)(size_t)V_lds + v_rd_base(lane);
  const unsigned ldsw = (unsigned)wid * 1024u;
#define GLDS(gp, lp) __builtin_amdgcn_global_load_lds((const unsigned*)(gp), (LAS unsigned*)(lp), 16, 0, 0)
#define ISSUE_K(t, b) do { const char* kb_ = (const char*)in.K + (size_t)(t) * (KVBLK * 2) * in.ldk; \
    _Pragma("unroll") for (int s_ = 0; s_ < NSUB; ++s_) { if (s_ < 2) GLDS(kb_ + s_ * 128 + koff, K_lds + (b) * SHM_K + s_ * 8192 + ldsw); \
      else GLDS((const char*)in.K2 + (size_t)(t) * (KVBLK * 2) * in.ldk2 + k2off, K_lds + (b) * SHM_K + s_ * 8192 + ldsw); } } while (0)
#define ISSUE_V(t, b) do { const char* vb_ = (const char*)in.V + (size_t)(t) * (KVBLK * 2) * in.ldv; \
    GLDS(vb_ + voff[0], V_lds + (b) * SHM_V + ldsw); GLDS(vb_ + voff[1], V_lds + (b) * SHM_V + 8192 + ldsw); } while (0)
#define WAITV(n) asm volatile("s_waitcnt vmcnt(%0)" :: "n"(n) : "memory")
#define WBAR() do { asm volatile("" ::: "memory"); __builtin_amdgcn_s_barrier(); asm volatile("" ::: "memory"); } while (0)
#define RESC(a) do { if (__any((a) < 1.f)) { if (hi == 0) al_l[r32] = (a); asm volatile("s_waitcnt lgkmcnt(0)" ::: "memory"); \
    _Pragma("unroll") for (int d = 0; d < 4; ++d) _Pragma("unroll") for (int r = 0; r < 16; ++r) o[d][r] *= al_l[crow(r, hi)]; } } while (0)
#define NXT3(x) ((x) == 2 ? 0 : (x) + 1)
#define SEG_B(b) do { float mn, al; bf16x8 pa0, pa1, pa2, pa3; partialSM(p0, p1, m_reg, mn, al, C, thr); RESC(al); finishSM(p0, p1, al, l_reg, pa0, pa1, pa2, pa3); SBAR(); \
    pv_d0(o, vb0 + (b) * SHM_V, pa0, pa1, pa2, pa3); } while (0)
  constexpr int NI = NSUB + 2;
  f32x16 p0, p1; const int NT = seq / KVBLK; const bool lead = wid < 4;
  ISSUE_K(0, 0); ISSUE_V(0, 0); ISSUE_K(1, 1); ISSUE_V(1, 1);
  if (!lead) { WAITV(NI); WBAR(); }
  WAITV(NI); WBAR();
  int bq = 0;
#if PROBE_T == 4
  const unsigned long long t0 = __builtin_amdgcn_s_memtime();
#endif
  for (int j = 0; j + 2 < NT; ++j) {
    const int b1 = NXT3(bq), b2 = NXT3(b1);
    ISSUE_K(j + 2, b2);
    qkt<DQK>(p0, p1, K_lds + bq * SHM_K, qr, r32, hi);
    WAITV(NI); WBAR();
    ISSUE_V(j + 2, b2);
    SEG_B(bq);
    WAITV(NI); WBAR();
    bq = b1;
  }
#if PROBE_T == 4
  { const unsigned long long t1 = __builtin_amdgcn_s_memtime(); if (probe != nullptr && tid == 0) { probe[0] = 0.f; probe[1] = ((float)(t1 - t0) * (1.f / (NT - 2)) - 3000.f) * 0.02f; } }
#endif
#pragma unroll
  for (int jj = 0; jj < 2; ++jj) {
    qkt<DQK>(p0, p1, K_lds + bq * SHM_K, qr, r32, hi);
    WAITV(0); WBAR();
    SEG_B(bq);
    WBAR();
    bq = NXT3(bq);
  }
  if (lead) { WBAR(); }
  if (hi == 0) li_l[r32] = l_reg; asm volatile("s_waitcnt lgkmcnt(0)" ::: "memory");
#pragma unroll
  for (int r = 0; r < 16; ++r) { const float rl = __builtin_amdgcn_rcpf(li_l[crow(r, hi)]);
#pragma unroll
    for (int d = 0; d < 4; ++d) o[d][r] *= rl; }
  asm volatile("s_waitcnt lgkmcnt(0)" ::: "memory"); WBAR();
#undef GLDS
#undef ISSUE_K
#undef ISSUE_V
#undef WAITV
#undef WBAR
#undef RESC
#undef NXT3
#undef SEG_B
}
__device__ __forceinline__ void attn_core_da2(const Src in, const float C, const float thr, const int seq, LAS char* lds, f32x16 (&o1)[4], f32x16 (&o2)[4]) {
  constexpr int NSUB = 2, SHM_K = NSUB * 8192;
  int lane; asm volatile("v_and_b32 %0, 63, %1" : "=v"(lane) : "v"(threadIdx.x));
  const int tid = threadIdx.x, wid = __builtin_amdgcn_readfirstlane(tid >> 6), r32 = lane & 31, hi = (lane >> 5) & 1;
  LAS char* V_lds = lds; LAS char* K_lds = lds + 3 * SHM_V;
  LAS float* ws = (LAS float*)(lds + 3 * SHM_V + 3 * SHM_K) + wid * 64; LAS float* li_l = ws; LAS float* al_l = ws + 32;
  float m1 = -1e30f, l1 = 0, m2 = -1e30f, l2 = 0;
#pragma unroll
  for (int d = 0; d < 4; ++d) { o1[d] = f32x16{}; o2[d] = f32x16{}; }
  bf16x8 q1[4], q2[4];
  const bf16_t* Qw = in.Q + (size_t)(wid * QBLK + r32) * in.ldq + hi * 8;
#pragma unroll
  for (int d0 = 0; d0 < 4; ++d0) { q1[d0] = *(const bf16x8*)(Qw + d0 * 16); q2[d0] = *(const bf16x8*)(Qw + 64 + d0 * 16); }
  const int krow = wid * 8 + (lane >> 3), kslot = (lane & 7) ^ ((krow >> 1) & 7);
  const unsigned koff = (unsigned)(krow * in.ldk + kslot * 8) * 2u;
  unsigned voff[2];
#pragma unroll
  for (int i = 0; i < 2; ++i) { const int p = i * 8192 + wid * 1024 + lane * 16, st = p >> 9, wq = (p & 511) >> 1, kk = (st >> 2) * 8 + (wq >> 5), cl = wq & 31;
    const int k = (kk & ~0xC) | ((kk & 4) << 1) | ((kk & 8) >> 1); voff[i] = (unsigned)(k * in.ldv + (st & 3) * 32 + cl) * 2u; }
  const int vb0 = (int)(unsigned)(size_t)V_lds + v_rd_base(lane);
  const unsigned ldsw = (unsigned)wid * 1024u;
#define GLDS(gp, lp) __builtin_amdgcn_global_load_lds((const unsigned*)(gp), (LAS unsigned*)(lp), 16, 0, 0)
#define ISSUE_KV(t, b) do { const char* kb_ = (const char*)in.K + (size_t)(t) * (KVBLK * 2) * in.ldk; const char* vb_ = (const char*)in.V + (size_t)(t) * (KVBLK * 2) * in.ldv; \
    GLDS(kb_ + koff, K_lds + (b) * SHM_K + ldsw); GLDS(kb_ + 128 + koff, K_lds + (b) * SHM_K + 8192 + ldsw); \
    GLDS(vb_ + voff[0], V_lds + (b) * SHM_V + ldsw); GLDS(vb_ + voff[1], V_lds + (b) * SHM_V + 8192 + ldsw); } while (0)
#define WAITV(n) asm volatile("s_waitcnt vmcnt(%0)" :: "n"(n) : "memory")
#define WBAR() do { asm volatile("" ::: "memory"); __builtin_amdgcn_s_barrier(); asm volatile("" ::: "memory"); } while (0)
#define RESC(oo, a) do { if (__any((a) < 1.f)) { if (hi == 0) al_l[r32] = (a); asm volatile("s_waitcnt lgkmcnt(0)" ::: "memory"); \
    _Pragma("unroll") for (int d = 0; d < 4; ++d) _Pragma("unroll") for (int r = 0; r < 16; ++r) oo[d][r] *= al_l[crow(r, hi)]; asm volatile("s_waitcnt lgkmcnt(0)" ::: "memory"); } } while (0)
#define NXT3(x) ((x) == 2 ? 0 : (x) + 1)
#define TILE_BODY(b) do { f32x16 p0, p1; float mn, al; bf16x8 pa0, pa1, pa2, pa3; \
    qkt<64>(p0, p1, K_lds + (b) * SHM_K, q1, r32, hi); partialSM(p0, p1, m1, mn, al, C, thr); RESC(o1, al); \
    finishSM(p0, p1, al, l1, pa0, pa1, pa2, pa3); SBAR(); pv_d0(o1, vb0 + (b) * SHM_V, pa0, pa1, pa2, pa3); SBAR(); \
    qkt<64>(p0, p1, K_lds + (b) * SHM_K + 8192, q2, r32, hi); partialSM(p0, p1, m2, mn, al, C, thr); RESC(o2, al); \
    finishSM(p0, p1, al, l2, pa0, pa1, pa2, pa3); SBAR(); pv_d0(o2, vb0 + (b) * SHM_V, pa0, pa1, pa2, pa3); SBAR(); } while (0)
  const int NT = seq / KVBLK;
  ISSUE_KV(0, 0); ISSUE_KV(1, 1);
  int bq = 0;
  for (int j = 0; j + 1 < NT; ++j) {
    const int b1 = NXT3(bq), b2 = NXT3(b1);
    WAITV(4); WBAR();
    if (j + 2 < NT) ISSUE_KV(j + 2, b2); else ISSUE_KV(NT - 1, b2);
    TILE_BODY(bq);
    bq = b1;
  }
  WAITV(4); WBAR();
  TILE_BODY(bq);
  WAITV(0);
  if (hi == 0) { li_l[r32] = l1; al_l[r32] = l2; } asm volatile("s_waitcnt lgkmcnt(0)" ::: "memory");
#pragma unroll
  for (int r = 0; r < 16; ++r) { const float ra = __builtin_amdgcn_rcpf(li_l[crow(r, hi)]), rb = __builtin_amdgcn_rcpf(al_l[crow(r, hi)]);
#pragma unroll
    for (int d = 0; d < 4; ++d) { o1[d][r] *= ra; o2[d][r] *= rb; } }
  asm volatile("s_waitcnt lgkmcnt(0)" ::: "memory"); WBAR();
#undef GLDS
#undef ISSUE_KV
#undef WAITV
#undef WBAR
#undef RESC
#undef NXT3
#undef TILE_BODY
}
template <int I> struct IC { static constexpr int value = I; };
template <int LO, int HI, class F> __device__ __forceinline__ void sfor(F&& f) { if constexpr (LO < HI) { f(IC<LO>{}); sfor<LO + 1, HI>(f); } }
struct SMS { float a0, a1, a2, a3, dm; bool keep; };
__device__ __forceinline__ void mfma_c(f32x16& d, const bf16x8& a, const bf16x8& b, const f32x16& c) { asm("v_mfma_f32_32x32x16_bf16 %0, %1, %2, %3" : "=&v"(d) : "v"(a), "v"(b), "v"(c)); }
__device__ __forceinline__ void negm_bcast(f32x16& negm, float aone, float nm) { asm volatile("s_nop 1\n\tv_mfma_f32_32x32x2_f32 %0, %1, %2, 0\n\ts_nop 15\n\ts_nop 3" : "+v"(negm) : "v"(aone), "v"(nm)); }

struct VF { s16x4 l, h; };
template <int NEX> struct StartSched {
  static constexpr int NITEMS = 17 + NEX;
  static constexpr int kind(int n) { return n < 16 ? 0 : n == 16 ? 1 : 3; }
  static constexpr int idx(int n) { return n <= 16 ? n : n - 17; }
  static constexpr int weight(int n) { const int k = kind(n); return k == 3 ? 2 : k == 1 ? 3 : 1; }
  static constexpr int first(int g, int ng) { int W = 0; for (int i = 0; i < NITEMS; ++i) W += weight(i); int cum = 0; for (int i = 0; i < NITEMS; ++i) { if (cum * ng >= g * W) return i; cum += weight(i); } return NITEMS; }
};
template <int NEX> struct FinSched {
  static constexpr int NITEMS = NEX + 16;
  static constexpr int weight(int n) { return n < NEX ? 2 : 1; }
  static constexpr int first(int g, int ng) { int W = 0; for (int i = 0; i < NITEMS; ++i) W += weight(i); int cum = 0; for (int i = 0; i < NITEMS; ++i) { if (cum * ng >= g * W) return i; cum += weight(i); } return NITEMS; }
};
template <int N, int NEX> __device__ __forceinline__ void start_item(f32x16& P0, f32x16& P1, SMS& st, f32x16& negm, const float thr, const float hi_is0) {
  using SS = StartSched<NEX>; constexpr int K = SS::kind(N), I = SS::idx(N);
  if constexpr (K == 0) {
    if constexpr (I == 0) st.a0 = fmaxf(fmaxf(P0[0], P0[1]), P0[2]);
    else if constexpr (I == 1) st.a1 = fmaxf(fmaxf(P0[3], P0[4]), P0[5]);
    else if constexpr (I < 7) { if constexpr (I & 1) st.a1 = fmaxf(fmaxf(st.a1, P0[2 * I + 2]), P0[2 * I + 3]); else st.a0 = fmaxf(fmaxf(st.a0, P0[2 * I + 2]), P0[2 * I + 3]); }
    else if constexpr (I == 7) st.a2 = fmaxf(fmaxf(P1[0], P1[1]), P1[2]);
    else if constexpr (I == 8) st.a3 = fmaxf(fmaxf(P1[3], P1[4]), P1[5]);
    else if constexpr (I < 14) { constexpr int J = I - 7; if constexpr (J & 1) st.a3 = fmaxf(fmaxf(st.a3, P1[2 * J + 2]), P1[2 * J + 3]); else st.a2 = fmaxf(fmaxf(st.a2, P1[2 * J + 2]), P1[2 * J + 3]); }
    else if constexpr (I == 14) st.a0 = fmaxf(fmaxf(st.a0, st.a1), st.a2);
    else st.a0 = fmaxf(st.a0, st.a3);
  } else if constexpr (K == 1) {
    float pmax;
    { auto rr = __builtin_amdgcn_permlane32_swap(__float_as_uint(st.a0), __float_as_uint(st.a0), false, false); pmax = fmaxf(__uint_as_float(rr[0]), __uint_as_float(rr[1])); }
    st.keep = __all(pmax <= thr);
    if (__builtin_expect(!st.keep, 0)) {
      const float delta = fmaxf(pmax, 0.f); st.dm = -delta;
#pragma unroll
      for (int r = 0; r < 16; ++r) { P0[r] -= delta; P1[r] -= delta; }
      negm_bcast(negm, hi_is0, negm[0] - delta);
    }
  } else {
    if constexpr (I < 16) P0[I] = __builtin_amdgcn_exp2f(P0[I]); else P1[I - 16] = __builtin_amdgcn_exp2f(P1[I - 16]);
  }
}
template <int N, int NEX> __device__ __forceinline__ void fin_item(f32x16& P0, f32x16& P1, SMS& st, u32x4 (&pw)[4]) {
  if constexpr (N < NEX) { P1[16 - NEX + N] = __builtin_amdgcn_exp2f(P1[16 - NEX + N]); }
  else {
    constexpr int n = N - NEX, k = n / 4, j = n % 4, b = (k & 1) * 8 + 2 * j;
    f32x16& P = (k < 2) ? P0 : P1;
    pw[k][j] = cvt_pk_bf16(P[b], P[b + 1]);
  }
}
template <int N> __device__ __forceinline__ void v_wait(VF& f) { asm volatile("s_waitcnt lgkmcnt(%2)" : "+v"(f.l), "+v"(f.h) : "n"(N)); }
template <int G> __device__ __forceinline__ void v_issue(VF& f, int vb) { f.l = tr_read<v_rd_off(G & 3, G >> 2, 0)>(vb); f.h = tr_read<v_rd_off(G & 3, G >> 2, 1)>(vb); }

template <int DQK, int MAPS>
__device__ __forceinline__ void attn_core_pl(const Src in, const float C, const float thr, const int seq, LAS char* lds, f32x16 (&o)[4], float* probe = nullptr) {
  static_assert(DQK == 64 && MAPS == 2, "differential-attention configuration only");
  constexpr int SHM_K = 16384, NKS = DQK / 16, NG1 = 2 * NKS, NEXS = 32, NEXF = 0, VLA = 3;
  using SS = StartSched<NEXS>; using FS = FinSched<NEXF>;
  int lane; asm volatile("v_and_b32 %0, 63, %1" : "=v"(lane) : "v"(threadIdx.x));
  const int tid = threadIdx.x, wid = __builtin_amdgcn_readfirstlane(tid >> 6), r32 = lane & 31, hi = (lane >> 5) & 1, wq = wid & 3, mp = wid >> 2;
  LAS char* V_lds = lds; LAS char* K_lds = lds + 3 * SHM_V;
  LAS float* ws = (LAS float*)(lds + 3 * SHM_V + 3 * SHM_K) + wid * 64; LAS float* li_l = ws; LAS float* al_l = ws + 32;
  SMS st; st.dm = 0.f; st.keep = true;
  f32x16 negm = f32x16{};
#pragma unroll
  for (int d = 0; d < 4; ++d) o[d] = f32x16{};
  f32x16 osum = f32x16{};
  const bf16x8 ones = {16256, 16256, 16256, 16256, 16256, 16256, 16256, 16256};
  bf16x8 qr[NKS];
  const bf16_t* Qw = in.Q + (size_t)(wq * QBLK + r32) * in.ldq + mp * 64 + hi * 8;
#pragma unroll
  for (int d0 = 0; d0 < NKS; ++d0) qr[d0] = *(const bf16x8*)(Qw + d0 * 16);
  const int krow = wid * 8 + (lane >> 3), kslot = (lane & 7) ^ ((krow >> 1) & 7);
  const unsigned koff = (unsigned)(krow * in.ldk + kslot * 8) * 2u;
  unsigned voff[2];
#pragma unroll
  for (int i = 0; i < 2; ++i) { const int p = i * 8192 + wid * 1024 + lane * 16, s_ = p >> 9, wq_ = (p & 511) >> 1, kk = (s_ >> 2) * 8 + (wq_ >> 5), cl = wq_ & 31;
    voff[i] = (unsigned)(kk * in.ldv + (s_ & 3) * 32 + cl) * 2u; }
  const int vb0 = (int)(unsigned)(size_t)V_lds + v_rd_base(lane);
  const unsigned ldsw = (unsigned)wid * 1024u;
  const LAS char* Kw = K_lds + mp * 8192;
#define GLDS(gp, lp) __builtin_amdgcn_global_load_lds((const unsigned*)(gp), (LAS unsigned*)(lp), 16, 0, 0)
#define ISSUE_K(t, b) do { const char* kb_ = (const char*)in.K + (size_t)(t) * (KVBLK * 2) * in.ldk; \
    _Pragma("unroll") for (int rep_ = 0; rep_ < 1 + PROBE_DMA2; ++rep_) { GLDS(kb_ + koff, K_lds + (b) * SHM_K + ldsw); GLDS(kb_ + 128 + koff, K_lds + (b) * SHM_K + 8192 + ldsw); } } while (0)
#define ISSUE_V(t, b) do { const char* vb_ = (const char*)in.V + (size_t)(t) * (KVBLK * 2) * in.ldv; \
    _Pragma("unroll") for (int rep_ = 0; rep_ < 1 + PROBE_DMA2; ++rep_) { GLDS(vb_ + voff[0], V_lds + (b) * SHM_V + ldsw); GLDS(vb_ + voff[1], V_lds + (b) * SHM_V + 8192 + ldsw); } } while (0)
#define DMA_PIECE(i) do { DMA_PIECE1(i); if (PROBE_DMA2) DMA_PIECE1(i); } while (0)
#define DMA_PIECE1(i) do { if ((i) < 2) { const char* kb_ = (const char*)in.K + (size_t)tk_ * (KVBLK * 2) * in.ldk; GLDS(kb_ + (i) * 128 + koff, K_lds + bq * SHM_K + (i) * 8192 + ldsw); } \
    else { const char* vb_ = (const char*)in.V + (size_t)tv_ * (KVBLK * 2) * in.ldv; GLDS(vb_ + voff[(i) & 1], V_lds + b2 * SHM_V + ((i) & 1) * 8192 + ldsw); } } while (0)
#define WAITV(n) asm volatile("s_waitcnt vmcnt(%0)" :: "n"(n) : "memory")
#define WBAR() do { asm volatile("" ::: "memory"); __builtin_amdgcn_s_barrier(); asm volatile("" ::: "memory"); } while (0)
#define RESC() do { if (!st.keep) { int l2_; asm volatile("v_and_b32 %0, 63, %1" : "=v"(l2_) : "v"(threadIdx.x)); const int h2_ = l2_ >> 5; LAS float* al2_ = (LAS float*)(lds + 3 * SHM_V + 3 * SHM_K) + wid * 64 + 32; \
    if (h2_ == 0) al2_[l2_] = __builtin_amdgcn_exp2f(st.dm); asm volatile("s_waitcnt lgkmcnt(0)" ::: "memory"); \
    _Pragma("unroll") for (int r = 0; r < 16; ++r) { const float a_ = al2_[crow(r, h2_)]; osum[r] *= a_; _Pragma("unroll") for (int d = 0; d < 4; ++d) o[d][r] *= a_; } asm volatile("s_waitcnt lgkmcnt(0)" ::: "memory"); } } while (0)
#define NXT3(x) ((x) == 2 ? 0 : (x) + 1)
#define KFRAG(Ks, d, blk) (*(const LAS bf16x8*)((Ks) + KSW((blk) * 32 + r32, ((d) * 16 + hi * 8) * 2)))
#define PA(ks) (*reinterpret_cast<const bf16x8*>(&pw[ks]))
#define PKV(f) (bf16x8){f.l[0], f.l[1], f.l[2], f.l[3], f.h[0], f.h[1], f.h[2], f.h[3]}
#define PHASE1(PN0, PN1, PF0, PF1, Ks, vb) do { \
    bf16x8 kf[NKS][2]; kf[0][0] = KFRAG(Ks, 0, 0); kf[0][1] = KFRAG(Ks, 0, 1); \
    sfor<0, NG1>([&](auto gc) __attribute__((always_inline)) { constexpr int g = decltype(gc)::value, d = g >> 1, blk = g & 1; \
      if constexpr (blk == 0 && d + 1 < NKS) { kf[d + 1][0] = KFRAG(Ks, d + 1, 0); kf[d + 1][1] = KFRAG(Ks, d + 1, 1); } \
      if constexpr (blk == 0) { if constexpr (d == 0) mfma_c(PN0, kf[d][0], qr[d], negm); else PN0 = __builtin_amdgcn_mfma_f32_32x32x16_bf16(kf[d][0], qr[d], PN0, 0, 0, 0); } \
      else              { if constexpr (d == 0) mfma_c(PN1, kf[d][1], qr[d], negm); else PN1 = __builtin_amdgcn_mfma_f32_32x32x16_bf16(kf[d][1], qr[d], PN1, 0, 0, 0); } \
      if constexpr (DMA_SPREAD == 1 && g < 4) DMA_PIECE(g); \
      if constexpr (g >= NG1 - VLA) v_issue<g - (NG1 - VLA)>(vf[g - (NG1 - VLA)], vb); \
      sfor<FS::first(g, NG1), FS::first(g + 1, NG1)>([&](auto ic) __attribute__((always_inline)) { fin_item<decltype(ic)::value, NEXF>(PF0, PF1, st, pw); }); \
      SBAR(); }); } while (0)
#define PHASE2(PS0, PS1, vb) do { \
    sfor<0, 20>([&](auto gc) __attribute__((always_inline)) { constexpr int gg = decltype(gc)::value, ks = gg / 5, d = gg % 5, g = ks * 4 + d; \
      if constexpr (d < 4) { \
        v_wait<2 * (15 - g < VLA - 1 ? 15 - g : VLA - 1)>(vf[g]); \
        o[d] = __builtin_amdgcn_mfma_f32_32x32x16_bf16(PA(ks), PKV(vf[g]), o[d], 0, 0, 0); \
        if constexpr (g + VLA < 16) v_issue<g + VLA>(vf[g + VLA], vb); \
      } else { osum = __builtin_amdgcn_mfma_f32_32x32x16_bf16(PA(ks), ones, osum, 0, 0, 0); if constexpr (DMA_SPREAD == 2) DMA_PIECE(ks); } \
      sfor<SS::first(gg, 20), SS::first(gg + 1, 20)>([&](auto ic) __attribute__((always_inline)) { start_item<decltype(ic)::value, NEXS>(PS0, PS1, st, negm, thr, hi == 0 ? 1.f : 0.f); }); \
      SBAR(); }); \
    asm volatile("" : "+v"(PS0), "+v"(PS1)); \
    RESC(); } while (0)
  f32x16 pA0, pA1, pB0, pB1; u32x4 pw[4]; VF vf[16]; const int NT = seq / KVBLK;
  ISSUE_K(0, 0); ISSUE_K(1, 1); ISSUE_V(0, 0);
  WAITV(PROBE_DMA2 ? 8 : 4); WBAR();
  ISSUE_K(2, 2); ISSUE_V(1, 1);
  { bf16x8 kf[NKS][2];
#pragma unroll
    for (int d = 0; d < NKS; ++d) { kf[d][0] = KFRAG(Kw, d, 0); kf[d][1] = KFRAG(Kw, d, 1); }
    pA0 = f32x16{}; pA1 = f32x16{};
#pragma unroll
    for (int d = 0; d < NKS; ++d) { pA0 = __builtin_amdgcn_mfma_f32_32x32x16_bf16(kf[d][0], qr[d], pA0, 0, 0, 0); pA1 = __builtin_amdgcn_mfma_f32_32x32x16_bf16(kf[d][1], qr[d], pA1, 0, 0, 0); } }
  sfor<0, 16>([&](auto ic) __attribute__((always_inline)) { start_item<decltype(ic)::value, NEXS>(pA0, pA1, st, negm, thr, hi == 0 ? 1.f : 0.f); });
  { float pmax;
    { auto rr = __builtin_amdgcn_permlane32_swap(__float_as_uint(st.a0), __float_as_uint(st.a0), false, false); pmax = fmaxf(__uint_as_float(rr[0]), __uint_as_float(rr[1])); }
#pragma unroll
    for (int r = 0; r < 16; ++r) { pA0[r] -= pmax; pA1[r] -= pmax; negm[r] = -pmax; } }
  sfor<17, SS::NITEMS>([&](auto ic) __attribute__((always_inline)) { start_item<decltype(ic)::value, NEXS>(pA0, pA1, st, negm, thr, hi == 0 ? 1.f : 0.f); });
  int bq = 0;
#define ITER(j, PN0, PN1, PF0, PF1) do { const int b1 = NXT3(bq), b2 = NXT3(b1); \
    STAMP_A(); WAITV(PROBE_DMA2 ? 8 : 4); WBAR(); STAMP_B(); \
    const int tk_ = (j) + 3 < NT ? (j) + 3 : NT - 1, tv_ = (j) + 2 < NT ? (j) + 2 : NT - 1; if (DMA_SPREAD == 0) { ISSUE_K(tk_, bq); ISSUE_V(tv_, b2); } \
    PHASE1(PN0, PN1, PF0, PF1, Kw + b1 * SHM_K, vb0 + bq * SHM_V); STAMP_C(); \
    PHASE2(PN0, PN1, vb0 + bq * SHM_V); \
    bq = b1; } while (0)
#if PROBE_T
  unsigned long long tA = 0, tB = 0, accAB = 0, accBC = 0; const unsigned long long t0 = __builtin_amdgcn_s_memtime(), r0 = __builtin_amdgcn_s_memrealtime();
#define STAMP_A() do { if (PROBE_T >= 2) tA = __builtin_amdgcn_s_memtime(); } while (0)
#define STAMP_B() do { if (PROBE_T >= 2) { tB = __builtin_amdgcn_s_memtime(); accAB += tB - tA; } } while (0)
#define STAMP_C() do { if (PROBE_T == 3) { accBC += __builtin_amdgcn_s_memtime() - tB; } } while (0)
#else
#define STAMP_A()
#define STAMP_B()
#define STAMP_C()
#endif
  for (int j = 0; j + 2 < NT; j += 2) { ITER(j, pB0, pB1, pA0, pA1); ITER(j + 1, pA0, pA1, pB0, pB1); }
  ITER(NT - 2, pB0, pB1, pA0, pA1);
#if PROBE_T
  { const unsigned long long t1 = __builtin_amdgcn_s_memtime(), r1 = __builtin_amdgcn_s_memrealtime();
    if (probe != nullptr && tid == 0) {
      if (PROBE_T == 1) { probe[0] = (float)(t1 - t0) * (0.5e-6f / (NT - 1)); probe[1] = (float)(t1 - t0) / (float)(r1 - r0); }
      if (PROBE_T == 2) { probe[0] = (float)accAB * (0.5e-6f / (NT - 1)); probe[1] = ((float)(t1 - t0) * (1.f / (NT - 1)) - 1500.f) * 0.05f; }
      if (PROBE_T == 3) { probe[0] = (float)accBC * (0.5e-6f / (NT - 1)); probe[1] = (float)accAB * (0.01f / (NT - 1)); } } }
#endif
#undef STAMP_A
#undef STAMP_B
#undef STAMP_C
  sfor<0, FS::NITEMS>([&](auto ic) __attribute__((always_inline)) { fin_item<decltype(ic)::value, NEXF>(pB0, pB1, st, pw); });
  WAITV(0); WBAR();
  { const int vb = vb0 + bq * SHM_V;
    sfor<0, VLA>([&](auto gc) __attribute__((always_inline)) { v_issue<decltype(gc)::value>(vf[decltype(gc)::value], vb); });
    sfor<0, 16>([&](auto gc) __attribute__((always_inline)) { constexpr int g = decltype(gc)::value, ks = g >> 2, d = g & 3;
      v_wait<2 * (15 - g < VLA - 1 ? 15 - g : VLA - 1)>(vf[g]);
      o[d] = __builtin_amdgcn_mfma_f32_32x32x16_bf16(PA(ks), PKV(vf[g]), o[d], 0, 0, 0);
      if constexpr (g + VLA < 16) v_issue<g + VLA>(vf[g + VLA], vb);
      if constexpr (d == 3) osum = __builtin_amdgcn_mfma_f32_32x32x16_bf16(PA(ks), ones, osum, 0, 0, 0);
      SBAR(); }); }
#pragma unroll
  for (int r = 0; r < 16; ++r) { const float rl = __builtin_amdgcn_rcpf(osum[r]);
#pragma unroll
    for (int d = 0; d < 4; ++d) o[d][r] *= rl; }
  asm volatile("s_waitcnt lgkmcnt(0)" ::: "memory"); WBAR();
#undef GLDS
#undef ISSUE_K
#undef ISSUE_V
#undef WAITV
#undef WBAR
#undef RESC
#undef NXT3
#undef KFRAG
#undef PKV
#undef PA
#undef PHASE1
#undef DMA_PIECE
#undef DMA_PIECE1
#undef PHASE2
#undef ITER
}
struct BStart { static constexpr int NITEMS = 25;
  static constexpr int weight(int n) { return n < 8 ? 1 : n == 8 ? 3 : 2; }
  static constexpr int first(int g, int ng) { int W = 0; for (int i = 0; i < NITEMS; ++i) W += weight(i); int cum = 0; for (int i = 0; i < NITEMS; ++i) { if (cum * ng >= g * W) return i; cum += weight(i); } return NITEMS; } };
template <int N> __device__ __forceinline__ void bstart_item(f32x16& P, SMS& st, f32x16& negm, const float thr, const float hi_is0) {
  if constexpr (N == 0) st.a0 = fmaxf(fmaxf(P[0], P[1]), P[2]);
  else if constexpr (N == 1) st.a1 = fmaxf(fmaxf(P[3], P[4]), P[5]);
  else if constexpr (N < 7) { if constexpr (N & 1) st.a1 = fmaxf(fmaxf(st.a1, P[2 * N + 2]), P[2 * N + 3]); else st.a0 = fmaxf(fmaxf(st.a0, P[2 * N + 2]), P[2 * N + 3]); }
  else if constexpr (N == 7) st.a0 = fmaxf(st.a0, st.a1);
  else if constexpr (N == 8) {
    float pmax;
    { auto rr = __builtin_amdgcn_permlane32_swap(__float_as_uint(st.a0), __float_as_uint(st.a0), false, false); pmax = fmaxf(__uint_as_float(rr[0]), __uint_as_float(rr[1])); }
    st.keep = __all(pmax <= thr);
    if (__builtin_expect(!st.keep, 0)) {
      const float delta = fmaxf(pmax, 0.f); st.dm = -delta;
#pragma unroll
      for (int r = 0; r < 16; ++r) P[r] -= delta;
      negm_bcast(negm, hi_is0, negm[0] - delta);
    }
  } else { constexpr int I = N - 9; P[I] = __builtin_amdgcn_exp2f(P[I]); }
}
template <int N> __device__ __forceinline__ void bfin_item(f32x16& P, u32x4 (&pw)[2]) { constexpr int k = N / 4, j = N % 4; pw[k][j] = cvt_pk_bf16(P[8 * k + 2 * j], P[8 * k + 2 * j + 1]); }
constexpr int bfin_first(int g, int ng) { return g * 8 / ng; }

template <int OFF> __device__ __forceinline__ void k_read(bf16x8& r, int addr) { asm volatile("ds_read_b128 %0, %1 offset:%2" : "=&v"(r) : "v"(addr), "i"(OFF) : "memory"); }
template <int N> __device__ __forceinline__ void k_wait(bf16x8& f) { asm volatile("s_waitcnt lgkmcnt(%1)" : "+v"(f) : "n"(N)); }
constexpr int kwait_n(int g, int nks, int kla, int vla) {
  int kk = kla - 1 < nks - 1 - g ? kla - 1 : nks - 1 - g; if (kk < 0) kk = 0;
  int lo = nks - vla > g - kla ? nks - vla : g - kla; int vv = g - lo; if (vv < 0) vv = 0;
  return kk + 2 * vv; }
template <int DQK, int MAPS>
__device__ __forceinline__ void attn_core_bp(const Src in, const float thr, const int seq, LAS char* lds, f32x16 (&o)[4], float* probe = nullptr) {
  constexpr int NSUB = MAPS == 2 ? 2 : DQK / 64, SHM_K = NSUB * 8192, NKS = DQK / 16, NI = NSUB + 2, VLA = BP_VLA, KLA = BP_KLA;
  int lane; asm volatile("v_and_b32 %0, 63, %1" : "=v"(lane) : "v"(threadIdx.x));
  const int tid = threadIdx.x, wid = __builtin_amdgcn_readfirstlane(tid >> 6), r32 = lane & 31, hi = (lane >> 5) & 1, wq = MAPS == 2 ? (wid & 3) : wid, mp = MAPS == 2 ? (wid >> 2) : 0;
  LAS char* V_lds = lds; LAS char* K_lds = lds + 4 * SHM_V;
  SMS st; st.dm = 0.f; st.keep = true;
  f32x16 negm = f32x16{}, osum = f32x16{};
#pragma unroll
  for (int d = 0; d < 4; ++d) o[d] = f32x16{};
  const bf16x8 ones = {16256, 16256, 16256, 16256, 16256, 16256, 16256, 16256};
  bf16x8 qr[NKS];
  { const bf16_t* Qw = in.Q + (size_t)(wq * QBLK + r32) * in.ldq + mp * 64 + hi * 8;
#pragma unroll
    for (int d0 = 0; d0 < NKS; ++d0) qr[d0] = *(const bf16x8*)(Qw + d0 * 16); }
  const int krow = wid * 8 + (lane >> 3), kslot = (lane & 7) ^ ((krow >> 1) & 7);
  const unsigned koff = (unsigned)(krow * in.ldk + kslot * 8) * 2u, k2off = (unsigned)(krow * in.ldk2 + kslot * 8) * 2u;
  unsigned voff[2];
#pragma unroll
  for (int i = 0; i < 2; ++i) { const int p = i * 8192 + wid * 1024 + lane * 16, s_ = p >> 9, wq_ = (p & 511) >> 1, kk = (s_ >> 2) * 8 + (wq_ >> 5), cl = wq_ & 31;
    voff[i] = (unsigned)(kk * in.ldv + (s_ & 3) * 32 + cl) * 2u; }
  const int vb0 = (int)(unsigned)(size_t)V_lds + v_rd_base(lane);
  const unsigned ldsw = (unsigned)wid * 1024u;
  const LAS char* Kw = K_lds + mp * 8192;
  int kxo[4];
#pragma unroll
  for (int i = 0; i < 4; ++i) kxo[i] = r32 * 128 + ((i * 32 + hi * 16) ^ (((r32 >> 1) & 7) << 4));
#define GLDS(gp, lp) __builtin_amdgcn_global_load_lds((const unsigned*)(gp), (LAS unsigned*)(lp), 16, 0, 0)
#define PIECE(i, tk, bk, tv, bv) do { \
    if ((i) < NSUB) { if (MAPS == 2 || (i) < 2) GLDS((const char*)in.K + (size_t)(tk) * (KVBLK * 2) * in.ldk + (i) * 128 + koff, K_lds + (bk) * SHM_K + (i) * 8192 + ldsw); \
                      else GLDS((const char*)in.K2 + (size_t)(tk) * (KVBLK * 2) * in.ldk2 + k2off, K_lds + (bk) * SHM_K + (i) * 8192 + ldsw); } \
    else GLDS((const char*)in.V + (size_t)(tv) * (KVBLK * 2) * in.ldv + voff[((i) - NSUB) & 1], V_lds + (bv) * SHM_V + (((i) - NSUB) & 1) * 8192 + ldsw); } while (0)
#define WAITV(n) asm volatile("s_waitcnt vmcnt(%0)" :: "n"(n) : "memory")
#define WBAR() do { asm volatile("" ::: "memory"); __builtin_amdgcn_s_barrier(); asm volatile("" ::: "memory"); } while (0)
#define RESC() do { if (!st.keep) { int l2_; asm volatile("v_and_b32 %0, 63, %1" : "=v"(l2_) : "v"(threadIdx.x)); const int h2_ = l2_ >> 5; LAS float* al2_ = (LAS float*)(lds + MISC_OFF + 128) + wid * 32; \
    if (h2_ == 0) al2_[l2_] = __builtin_amdgcn_exp2f(st.dm); asm volatile("s_waitcnt lgkmcnt(0)" ::: "memory"); \
    _Pragma("unroll") for (int r = 0; r < 16; ++r) { const float a_ = al2_[crow(r, h2_)]; osum[r] *= a_; _Pragma("unroll") for (int d = 0; d < 4; ++d) o[d][r] *= a_; } asm volatile("s_waitcnt lgkmcnt(0)" ::: "memory"); } } while (0)
#define NXT3(x) ((x) == 2 ? 0 : (x) + 1)
#define KFRAG(Ks, d, blk) (*(const LAS bf16x8*)((Ks) + ((d) >> 2) * 8192 + KSW((blk) * 32 + r32, (((d) & 3) * 16 + hi * 8) * 2)))
#define PA(k) (*reinterpret_cast<const bf16x8*>(&pw[k]))
#define PKV(f) (bf16x8){f.l[0], f.l[1], f.l[2], f.l[3], f.h[0], f.h[1], f.h[2], f.h[3]}
#define BITER(BPAR, PN, PF, Kq, vb, DO_DMA) do { \
    { bf16x8 kf[NKS]; int ka_[4]; { const int kb_ = (int)(unsigned)(size_t)(Kq); _Pragma("unroll") for (int i_ = 0; i_ < 4; ++i_) ka_[i_] = kb_ + kxo[i_]; } \
      sfor<0, KLA>([&](auto dc) __attribute__((always_inline)) { constexpr int d_ = decltype(dc)::value; k_read<(d_ >> 2) * 8192 + (1 - (BPAR)) * 4096>(kf[d_], ka_[d_ & 3]); }); \
      sfor<0, NKS>([&](auto gc) __attribute__((always_inline)) { constexpr int g = decltype(gc)::value; \
        k_wait<kwait_n(g, NKS, KLA, VLA)>(kf[g]); \
        if constexpr (g + KLA < NKS) k_read<((g + KLA) >> 2) * 8192 + (1 - (BPAR)) * 4096>(kf[g + KLA], ka_[(g + KLA) & 3]); \
        if constexpr (g == 0) mfma_c(PN, kf[g], qr[g], negm); else PN = __builtin_amdgcn_mfma_f32_32x32x16_bf16(kf[g], qr[g], PN, 0, 0, 0); \
        if constexpr ((DO_DMA) && g < NI) PIECE(g, tk_, bk_, tv_, bv_); \
        if constexpr (g >= NKS - VLA) v_issue<8 * (BPAR) + g - (NKS - VLA)>(vf[g - (NKS - VLA)], vb); \
        sfor<bfin_first(g, NKS), bfin_first(g + 1, NKS)>([&](auto ic) __attribute__((always_inline)) { bfin_item<decltype(ic)::value>(PF, pw); }); \
        SBAR(); }); } \
    sfor<0, 10>([&](auto gc) __attribute__((always_inline)) { constexpr int gg = decltype(gc)::value, ksl = gg / 5, d = gg % 5, g = ksl * 4 + d; \
      if constexpr (d < 4) { \
        v_wait<2 * (7 - g < VLA - 1 ? 7 - g : VLA - 1)>(vf[g]); \
        o[d] = __builtin_amdgcn_mfma_f32_32x32x16_bf16(PA(ksl), PKV(vf[g]), o[d], 0, 0, 0); \
        if constexpr (g + VLA < 8) v_issue<8 * (BPAR) + g + VLA>(vf[g + VLA], vb); \
      } else osum = __builtin_amdgcn_mfma_f32_32x32x16_bf16(PA(ksl), ones, osum, 0, 0, 0); \
      if constexpr (gg > 0) sfor<BStart::first(gg - 1, 9), BStart::first(gg, 9)>([&](auto ic) __attribute__((always_inline)) { bstart_item<decltype(ic)::value>(PN, st, negm, thr, hi == 0 ? 1.f : 0.f); });     \
      SBAR(); }); \
    asm volatile("" : "+v"(PN)); \
    RESC(); } while (0)
  f32x16 pA, pB; u32x4 pw[2]; VF vf[8]; const int NT = seq / KVBLK;
#pragma unroll
  for (int t = 0; t < 3; ++t) {
#pragma unroll
    for (int i = 0; i < NI; ++i) PIECE(i, t, t, t, t); }
  WAITV(2 * NI); WBAR();
  { bf16x8 kf[NKS];
#pragma unroll
    for (int d = 0; d < NKS; ++d) kf[d] = KFRAG(Kw, d, 0);
    pA = f32x16{};
#pragma unroll
    for (int d = 0; d < NKS; ++d) pA = __builtin_amdgcn_mfma_f32_32x32x16_bf16(kf[d], qr[d], pA, 0, 0, 0); }
  sfor<0, 8>([&](auto ic) __attribute__((always_inline)) { bstart_item<decltype(ic)::value>(pA, st, negm, thr, hi == 0 ? 1.f : 0.f); });
  { float pmax;
    { auto rr = __builtin_amdgcn_permlane32_swap(__float_as_uint(st.a0), __float_as_uint(st.a0), false, false); pmax = fmaxf(__uint_as_float(rr[0]), __uint_as_float(rr[1])); }
#pragma unroll
    for (int r = 0; r < 16; ++r) { pA[r] -= pmax; negm[r] = -pmax; } }
  sfor<9, BStart::NITEMS>([&](auto ic) __attribute__((always_inline)) { bstart_item<decltype(ic)::value>(pA, st, negm, thr, hi == 0 ? 1.f : 0.f); });
  int kq = 0;
#if PROBE_T == 5
  const unsigned long long t0 = __builtin_amdgcn_s_memtime();
#endif
  for (int t = 0; t + 1 < NT; ++t) {
    const int k1 = NXT3(kq), vq = t & 3;
    const int tk_ = t + 3 < NT ? t + 3 : NT - 1, tv_ = tk_, bk_ = kq, bv_ = (t + 3) & 3;
    BITER(0, pB, pA, Kw + kq * SHM_K, vb0 + vq * SHM_V, false);
    WAITV(NI); WBAR();
    BITER(1, pA, pB, Kw + k1 * SHM_K, vb0 + vq * SHM_V, true);
    kq = k1;
  }
#if PROBE_T == 5
  { const unsigned long long t1 = __builtin_amdgcn_s_memtime(); if (probe != nullptr && tid == 0) { probe[0] = 0.f; probe[1] = ((float)(t1 - t0) * (1.f / (NT - 1)) - PROBE_BASE) * 0.05f; } }
#endif
  { const int vq = (NT - 1) & 3; const int tk_ = 0, tv_ = 0, bk_ = 0, bv_ = 0; (void)tk_; (void)tv_; (void)bk_; (void)bv_;
    BITER(0, pB, pA, Kw + kq * SHM_K, vb0 + vq * SHM_V, false);
    sfor<0, 8>([&](auto ic) __attribute__((always_inline)) { bfin_item<decltype(ic)::value>(pB, pw); });
    const int vb = vb0 + vq * SHM_V;
    sfor<0, VLA>([&](auto gc) __attribute__((always_inline)) { v_issue<8 + decltype(gc)::value>(vf[decltype(gc)::value], vb); });
    sfor<0, 8>([&](auto gc) __attribute__((always_inline)) { constexpr int g = decltype(gc)::value, ksl = g >> 2, d = g & 3;
      v_wait<2 * (7 - g < VLA - 1 ? 7 - g : VLA - 1)>(vf[g]);
      o[d] = __builtin_amdgcn_mfma_f32_32x32x16_bf16(PA(ksl), PKV(vf[g]), o[d], 0, 0, 0);
      if constexpr (g + VLA < 8) v_issue<8 + g + VLA>(vf[g + VLA], vb);
      if constexpr (d == 3) osum = __builtin_amdgcn_mfma_f32_32x32x16_bf16(PA(ksl), ones, osum, 0, 0, 0);
      SBAR(); }); }
#pragma unroll
  for (int r = 0; r < 16; ++r) { const float rl = __builtin_amdgcn_rcpf(osum[r]);
#pragma unroll
    for (int d = 0; d < 4; ++d) o[d][r] *= rl; }
  WAITV(0); asm volatile("s_waitcnt lgkmcnt(0)" ::: "memory"); WBAR();
#undef GLDS
#undef PIECE
#undef WAITV
#undef WBAR
#undef RESC
#undef NXT3
#undef KFRAG
#undef PA
#undef PKV
#undef BITER
}
struct Src8 { const unsigned char* q8; const unsigned char* k8n; const unsigned char* k8r; const bf16_t* V; int ldv; };
typedef int v8i_att __attribute__((ext_vector_type(8))); typedef int v4i_att __attribute__((ext_vector_type(4)));
__device__ __forceinline__ void attn_core_bp8(const Src8 in, const float thr, const int seq, LAS char* lds, f32x16 (&o)[4], float* probe = nullptr) {
  constexpr int SHM_K = 3 * 4096, NKS = 3, NI = 4, VLA = 3;
  int lane; asm volatile("v_and_b32 %0, 63, %1" : "=v"(lane) : "v"(threadIdx.x));
  const int tid = threadIdx.x, wid = __builtin_amdgcn_readfirstlane(tid >> 6), r32 = lane & 31, hi = (lane >> 5) & 1;
  LAS char* V_lds = lds; LAS char* K_lds = lds + 4 * SHM_V;
  SMS st; st.dm = 0.f; st.keep = true;
  f32x16 negm = f32x16{}, osum = f32x16{};
#pragma unroll
  for (int d = 0; d < 4; ++d) o[d] = f32x16{};
  const bf16x8 ones = {16256, 16256, 16256, 16256, 16256, 16256, 16256, 16256};
  v8i_att qf[NKS];
  { const unsigned char* Qw = in.q8 + (size_t)(wid * QBLK + r32) * 1536 + hi * 32;
#pragma unroll
    for (int s = 0; s < NKS; ++s) { const v4i_att lo = *(const v4i_att*)(Qw + s * 64), hh = *(const v4i_att*)(Qw + s * 64 + 16); qf[s] = __builtin_shufflevector(lo, hh, 0, 1, 2, 3, 4, 5, 6, 7); } }
  unsigned ksrc[2]; int kdst[2]; bool krot[2];
#pragma unroll
  for (int i = 0; i < 2; ++i) { const int p0 = wid * 2 + i, p = p0 < 12 ? p0 : p0 - 4, s = p >> 2, q = p & 3, row = q * 16 + (lane >> 2), lc = (lane & 3) ^ ((lane >> 4) & 3);
    krot[i] = (s == 2); ksrc[i] = krot[i] ? (unsigned)(row * 64 + lc * 16) : (unsigned)(row * 1024 + s * 64 + lc * 16); kdst[i] = s * 4096 + q * 1024 + lane * 16; }
  unsigned voff[2];
#pragma unroll
  for (int i = 0; i < 2; ++i) { const int p = i * 8192 + wid * 1024 + lane * 16, s_ = p >> 9, wq_ = (p & 511) >> 1, kk = (s_ >> 2) * 8 + (wq_ >> 5), cl = wq_ & 31;
    voff[i] = (unsigned)(kk * in.ldv + (s_ & 3) * 32 + cl) * 2u; }
  const int vb0 = (int)(unsigned)(size_t)V_lds + v_rd_base(lane);
  const unsigned ldsw = (unsigned)wid * 1024u;
  int kx[2];
#pragma unroll
  for (int c = 0; c < 2; ++c) kx[c] = r32 * 64 + (((2 * hi + c) ^ ((r32 >> 2) & 3)) << 4);
#define GLDS(gp, lp) __builtin_amdgcn_global_load_lds((const unsigned*)(gp), (LAS unsigned*)(lp), 16, 0, 0)
#define PIECE(i, tk, bk, tv, bv) do { \
    if ((i) < 2) { if (krot[(i) & 1]) GLDS(in.k8r + (size_t)(tk) * (KVBLK * 64) + ksrc[(i) & 1], K_lds + (bk) * SHM_K + kdst[(i) & 1]); \
                   else GLDS(in.k8n + (size_t)(tk) * (KVBLK * 1024) + ksrc[(i) & 1], K_lds + (bk) * SHM_K + kdst[(i) & 1]); } \
    else GLDS((const char*)in.V + (size_t)(tv) * (KVBLK * 2) * in.ldv + voff[(i) & 1], V_lds + (bv) * SHM_V + ((i) & 1) * 8192 + ldsw); } while (0)
#define WAITV(n) asm volatile("s_waitcnt vmcnt(%0)" :: "n"(n) : "memory")
#define WBAR() do { asm volatile("" ::: "memory"); __builtin_amdgcn_s_barrier(); asm volatile("" ::: "memory"); } while (0)
#define RESC() do { if (!st.keep) { int l2_; asm volatile("v_and_b32 %0, 63, %1" : "=v"(l2_) : "v"(threadIdx.x)); const int h2_ = l2_ >> 5; LAS float* al2_ = (LAS float*)(lds + MISC_OFF + 128) + wid * 32; \
    if (h2_ == 0) al2_[l2_] = __builtin_amdgcn_exp2f(st.dm); asm volatile("s_waitcnt lgkmcnt(0)" ::: "memory"); \
    _Pragma("unroll") for (int r = 0; r < 16; ++r) { const float a_ = al2_[crow(r, h2_)]; osum[r] *= a_; _Pragma("unroll") for (int d = 0; d < 4; ++d) o[d][r] *= a_; } asm volatile("s_waitcnt lgkmcnt(0)" ::: "memory"); } } while (0)
#define NXT3(x) ((x) == 2 ? 0 : (x) + 1)
#define PA(k) (*reinterpret_cast<const bf16x8*>(&pw[k]))
#define PKV(f) (bf16x8){f.l[0], f.l[1], f.l[2], f.l[3], f.h[0], f.h[1], f.h[2], f.h[3]}
#define KCAT(lo_, hi_) __builtin_shufflevector(__builtin_bit_cast(v4i_att, lo_), __builtin_bit_cast(v4i_att, hi_), 0, 1, 2, 3, 4, 5, 6, 7)
#define QK8(C_, s_) __builtin_amdgcn_mfma_scale_f32_32x32x64_f8f6f4(KCAT(kl[s_], kh[s_]), qf[s_], C_, 0, 0, 0, 0x7f7f7f7f, 0, 0x7c7c7c7c)
#define BITER(BPAR, PN, PF, Kq, vb, DO_DMA) do { \
    { bf16x8 kl[NKS], kh[NKS]; const int kb0_ = (int)(unsigned)(size_t)(Kq) + kx[0], kb1_ = (int)(unsigned)(size_t)(Kq) + kx[1]; \
      sfor<0, NKS>([&](auto dc) __attribute__((always_inline)) { constexpr int s_ = decltype(dc)::value; k_read<s_ * 4096 + (1 - (BPAR)) * 2048>(kl[s_], kb0_); k_read<s_ * 4096 + (1 - (BPAR)) * 2048>(kh[s_], kb1_); }); \
      sfor<0, NKS>([&](auto gc) __attribute__((always_inline)) { constexpr int g = decltype(gc)::value; \
        asm volatile("s_waitcnt lgkmcnt(4)" : "+v"(kl[g]), "+v"(kh[g])); \
        if constexpr (g == 0) PN = QK8(negm, 0); else PN = QK8(PN, g); \
        if constexpr (DO_DMA) { if constexpr (g == 0) { PIECE(0, tk_, bk_, tv_, bv_); PIECE(1, tk_, bk_, tv_, bv_); } else PIECE(g + 1, tk_, bk_, tv_, bv_); } \
        v_issue<8 * (BPAR) + g>(vf[g], vb); \
        sfor<g * 8 / 3, (g + 1) * 8 / 3>([&](auto ic) __attribute__((always_inline)) { bfin_item<decltype(ic)::value>(PF, pw); }); \
        SBAR(); }); } \
    sfor<0, 10>([&](auto gc) __attribute__((always_inline)) { constexpr int gg = decltype(gc)::value, ksl = gg / 5, d = gg % 5, g = ksl * 4 + d; \
      if constexpr (d < 4) { \
        v_wait<2 * (7 - g < VLA - 1 ? 7 - g : VLA - 1)>(vf[g]); \
        o[d] = __builtin_amdgcn_mfma_f32_32x32x16_bf16(PA(ksl), PKV(vf[g]), o[d], 0, 0, 0); \
        if constexpr (g + VLA < 8) v_issue<8 * (BPAR) + g + VLA>(vf[g + VLA], vb); \
      } else osum = __builtin_amdgcn_mfma_f32_32x32x16_bf16(PA(ksl), ones, osum, 0, 0, 0); \
      if constexpr (gg > 0) sfor<BStart::first(gg - 1, 9), BStart::first(gg, 9)>([&](auto ic) __attribute__((always_inline)) { bstart_item<decltype(ic)::value>(PN, st, negm, thr, hi == 0 ? 1.f : 0.f); }); \
      SBAR(); }); \
    asm volatile("" : "+v"(PN)); \
    RESC(); } while (0)
  f32x16 pA, pB; u32x4 pw[2]; VF vf[8]; const int NT = seq / KVBLK;
#pragma unroll
  for (int t = 0; t < 3; ++t) {
#pragma unroll
    for (int i = 0; i < NI; ++i) PIECE(i, t, t, t, t); }
  WAITV(2 * NI); WBAR();
  { const LAS char* K0 = K_lds; pA = f32x16{};
#pragma unroll
    for (int s = 0; s < NKS; ++s) { const bf16x8 lo = *(const LAS bf16x8*)(K0 + s * 4096 + kx[0]), hh = *(const LAS bf16x8*)(K0 + s * 4096 + kx[1]);
      pA = __builtin_amdgcn_mfma_scale_f32_32x32x64_f8f6f4(KCAT(lo, hh), qf[s], pA, 0, 0, 0, 0x7f7f7f7f, 0, 0x7c7c7c7c); } }
  sfor<0, 8>([&](auto ic) __attribute__((always_inline)) { bstart_item<decltype(ic)::value>(pA, st, negm, thr, hi == 0 ? 1.f : 0.f); });
  { float pmax;
    { auto rr = __builtin_amdgcn_permlane32_swap(__float_as_uint(st.a0), __float_as_uint(st.a0), false, false); pmax = fmaxf(__uint_as_float(rr[0]), __uint_as_float(rr[1])); }
#pragma unroll
    for (int r = 0; r < 16; ++r) { pA[r] -= pmax; negm[r] = -pmax; } }
  sfor<9, BStart::NITEMS>([&](auto ic) __attribute__((always_inline)) { bstart_item<decltype(ic)::value>(pA, st, negm, thr, hi == 0 ? 1.f : 0.f); });
  int kq = 0;
#if PROBE_T == 5
  const unsigned long long t0 = __builtin_amdgcn_s_memtime();
#endif
  for (int t = 0; t + 1 < NT; ++t) {
    const int k1 = NXT3(kq), vq = t & 3;
    const int tk_ = t + 3 < NT ? t + 3 : NT - 1, tv_ = tk_, bk_ = kq, bv_ = (t + 3) & 3;
    BITER(0, pB, pA, K_lds + kq * SHM_K, vb0 + vq * SHM_V, false);
    WAITV(NI); WBAR();
    BITER(1, pA, pB, K_lds + k1 * SHM_K, vb0 + vq * SHM_V, true);
    kq = k1;
  }
#if PROBE_T == 5
  { const unsigned long long t1 = __builtin_amdgcn_s_memtime(); if (probe != nullptr && tid == 0) { probe[0] = 0.f; probe[1] = ((float)(t1 - t0) * (1.f / (NT - 1)) - PROBE_BASE) * 0.05f; } }
#endif
  { const int vq = (NT - 1) & 3; const int tk_ = 0, tv_ = 0, bk_ = 0, bv_ = 0; (void)tk_; (void)tv_; (void)bk_; (void)bv_;
    BITER(0, pB, pA, K_lds + kq * SHM_K, vb0 + vq * SHM_V, false);
    sfor<0, 8>([&](auto ic) __attribute__((always_inline)) { bfin_item<decltype(ic)::value>(pB, pw); });
    const int vb = vb0 + vq * SHM_V;
    sfor<0, VLA>([&](auto gc) __attribute__((always_inline)) { v_issue<8 + decltype(gc)::value>(vf[decltype(gc)::value], vb); });
    sfor<0, 8>([&](auto gc) __attribute__((always_inline)) { constexpr int g = decltype(gc)::value, ksl = g >> 2, d = g & 3;
      v_wait<2 * (7 - g < VLA - 1 ? 7 - g : VLA - 1)>(vf[g]);
      o[d] = __builtin_amdgcn_mfma_f32_32x32x16_bf16(PA(ksl), PKV(vf[g]), o[d], 0, 0, 0);
      if constexpr (g + VLA < 8) v_issue<8 + g + VLA>(vf[g + VLA], vb);
      if constexpr (d == 3) osum = __builtin_amdgcn_mfma_f32_32x32x16_bf16(PA(ksl), ones, osum, 0, 0, 0);
      SBAR(); }); }
#pragma unroll
  for (int r = 0; r < 16; ++r) { const float rl = __builtin_amdgcn_rcpf(osum[r]);
#pragma unroll
    for (int d = 0; d < 4; ++d) o[d][r] *= rl; }
  WAITV(0); asm volatile("s_waitcnt lgkmcnt(0)" ::: "memory"); WBAR();
#undef GLDS
#undef PIECE
#undef WAITV
#undef WBAR
#undef RESC
#undef NXT3
#undef PA
#undef PKV
#undef KCAT
#undef QK8
#undef BITER
}
struct SrcD8 { const unsigned char* q8; const unsigned char* k8; const bf16_t* V; int ldv; };
__device__ __forceinline__ void attn_core_pl8(const SrcD8 in, const float thr, const int seq, LAS char* lds, f32x16 (&o)[4], float* probe = nullptr) {
  constexpr int SHM_K = 8192, NEXS = 32, NEXF = 0, VLA = 3;
  using SS = StartSched<NEXS>; using FS = FinSched<NEXF>;
  int lane; asm volatile("v_and_b32 %0, 63, %1" : "=v"(lane) : "v"(threadIdx.x));
  const int tid = threadIdx.x, wid = __builtin_amdgcn_readfirstlane(tid >> 6), r32 = lane & 31, hi = (lane >> 5) & 1, wq = wid & 3, mp = wid >> 2;
  LAS char* V_lds = lds; LAS char* K_lds = lds + 3 * SHM_V;
  SMS st; st.dm = 0.f; st.keep = true;
  f32x16 negm = f32x16{}, osum = f32x16{};
#pragma unroll
  for (int d = 0; d < 4; ++d) o[d] = f32x16{};
  const bf16x8 ones = {16256, 16256, 16256, 16256, 16256, 16256, 16256, 16256};
  v8i_att qf;
  { const unsigned char* Qw = in.q8 + (size_t)(wq * QBLK + r32) * 1024 + mp * 64 + hi * 32;
    const v4i_att lo = *(const v4i_att*)(Qw), hh = *(const v4i_att*)(Qw + 16); qf = __builtin_shufflevector(lo, hh, 0, 1, 2, 3, 4, 5, 6, 7); }
  const unsigned ksrc = (unsigned)(((wid & 3) * 16 + (lane >> 2)) * 1024 + (wid >> 2) * 64 + (((lane & 3) ^ ((lane >> 4) & 3)) << 4));
  const int kdst = wid * 1024 + lane * 16;
  unsigned voff[2];
#pragma unroll
  for (int i = 0; i < 2; ++i) { const int p = i * 8192 + wid * 1024 + lane * 16, s_ = p >> 9, wq_ = (p & 511) >> 1, kk = (s_ >> 2) * 8 + (wq_ >> 5), cl = wq_ & 31;
    voff[i] = (unsigned)(kk * in.ldv + (s_ & 3) * 32 + cl) * 2u; }
  const int vb0 = (int)(unsigned)(size_t)V_lds + v_rd_base(lane);
  const unsigned ldsw = (unsigned)wid * 1024u;
  const LAS char* Kw = K_lds + mp * 4096;
  int kx[2];
#pragma unroll
  for (int c = 0; c < 2; ++c) kx[c] = r32 * 64 + (((2 * hi + c) ^ ((r32 >> 2) & 3)) << 4);
#define GLDS(gp, lp) __builtin_amdgcn_global_load_lds((const unsigned*)(gp), (LAS unsigned*)(lp), 16, 0, 0)
#define ISSUE_K(t, b) GLDS(in.k8 + (size_t)(t) * (KVBLK * 1024) + ksrc, K_lds + (b) * SHM_K + kdst)
#define ISSUE_V(t, b) do { const char* vb_ = (const char*)in.V + (size_t)(t) * (KVBLK * 2) * in.ldv; GLDS(vb_ + voff[0], V_lds + (b) * SHM_V + ldsw); GLDS(vb_ + voff[1], V_lds + (b) * SHM_V + 8192 + ldsw); } while (0)
#define WAITV(n) asm volatile("s_waitcnt vmcnt(%0)" :: "n"(n) : "memory")
#define WBAR() do { asm volatile("" ::: "memory"); __builtin_amdgcn_s_barrier(); asm volatile("" ::: "memory"); } while (0)
#define RESC() do { if (!st.keep) { int l2_; asm volatile("v_and_b32 %0, 63, %1" : "=v"(l2_) : "v"(threadIdx.x)); const int h2_ = l2_ >> 5; LAS float* al2_ = (LAS float*)(lds + MISC_OFF + 128) + wid * 32; \
    if (h2_ == 0) al2_[l2_] = __builtin_amdgcn_exp2f(st.dm); asm volatile("s_waitcnt lgkmcnt(0)" ::: "memory"); \
    _Pragma("unroll") for (int r = 0; r < 16; ++r) { const float a_ = al2_[crow(r, h2_)]; osum[r] *= a_; _Pragma("unroll") for (int d = 0; d < 4; ++d) o[d][r] *= a_; } asm volatile("s_waitcnt lgkmcnt(0)" ::: "memory"); } } while (0)
#define NXT3(x) ((x) == 2 ? 0 : (x) + 1)
#define PA(ks) (*reinterpret_cast<const bf16x8*>(&pw[ks]))
#define PKV(f) (bf16x8){f.l[0], f.l[1], f.l[2], f.l[3], f.h[0], f.h[1], f.h[2], f.h[3]}
#define KCAT(lo_, hi_) __builtin_shufflevector(__builtin_bit_cast(v4i_att, lo_), __builtin_bit_cast(v4i_att, hi_), 0, 1, 2, 3, 4, 5, 6, 7)
#define PHASE1(PN0, PN1, PF0, PF1, Ks, vb) do { \
    bf16x8 kl0, kh0, kl1, kh1; { const int a0_ = (int)(unsigned)(size_t)(Ks) + kx[0], a1_ = (int)(unsigned)(size_t)(Ks) + kx[1]; \
      k_read<0>(kl0, a0_); k_read<0>(kh0, a1_); k_read<2048>(kl1, a0_); k_read<2048>(kh1, a1_); } \
    asm volatile("s_waitcnt lgkmcnt(2)" : "+v"(kl0), "+v"(kh0)); \
    PN0 = __builtin_amdgcn_mfma_scale_f32_32x32x64_f8f6f4(KCAT(kl0, kh0), qf, negm, 0, 0, 0, 0x7f7f7f7f, 0, 0x7c7c7c7c); \
    ISSUE_K(tk_, bq); GLDS((const char*)in.V + (size_t)tv_ * (KVBLK * 2) * in.ldv + voff[0], V_lds + b2 * SHM_V + ldsw); \
    v_issue<0>(vf[0], vb); \
    sfor<0, 8>([&](auto ic) __attribute__((always_inline)) { fin_item<decltype(ic)::value, NEXF>(PF0, PF1, st, pw); }); \
    SBAR(); \
    asm volatile("s_waitcnt lgkmcnt(2)" : "+v"(kl1), "+v"(kh1)); \
    PN1 = __builtin_amdgcn_mfma_scale_f32_32x32x64_f8f6f4(KCAT(kl1, kh1), qf, negm, 0, 0, 0, 0x7f7f7f7f, 0, 0x7c7c7c7c); \
    GLDS((const char*)in.V + (size_t)tv_ * (KVBLK * 2) * in.ldv + voff[1], V_lds + b2 * SHM_V + 8192 + ldsw); \
    v_issue<1>(vf[1], vb); v_issue<2>(vf[2], vb); \
    sfor<8, 16>([&](auto ic) __attribute__((always_inline)) { fin_item<decltype(ic)::value, NEXF>(PF0, PF1, st, pw); }); \
    SBAR(); } while (0)
#define PHASE2(PS0, PS1, vb) do { \
    sfor<0, 20>([&](auto gc) __attribute__((always_inline)) { constexpr int gg = decltype(gc)::value, ks = gg / 5, d = gg % 5, g = ks * 4 + d; \
      if constexpr (d < 4) { \
        v_wait<2 * (15 - g < VLA - 1 ? 15 - g : VLA - 1)>(vf[g]); \
        o[d] = __builtin_amdgcn_mfma_f32_32x32x16_bf16(PA(ks), PKV(vf[g]), o[d], 0, 0, 0); \
        if constexpr (g + VLA < 16) v_issue<g + VLA>(vf[g + VLA], vb); \
      } else osum = __builtin_amdgcn_mfma_f32_32x32x16_bf16(PA(ks), ones, osum, 0, 0, 0); \
      sfor<SS::first(gg, 20), SS::first(gg + 1, 20)>([&](auto ic) __attribute__((always_inline)) { start_item<decltype(ic)::value, NEXS>(PS0, PS1, st, negm, thr, hi == 0 ? 1.f : 0.f); }); \
      SBAR(); }); \
    asm volatile("" : "+v"(PS0), "+v"(PS1)); \
    RESC(); } while (0)
  f32x16 pA0, pA1, pB0, pB1; u32x4 pw[4]; VF vf[16]; const int NT = seq / KVBLK;
  ISSUE_K(0, 0); ISSUE_K(1, 1); ISSUE_V(0, 0);
  WAITV(3); WBAR();
  ISSUE_K(2, 2); ISSUE_V(1, 1);
  { const bf16x8 l0 = *(const LAS bf16x8*)(Kw + kx[0]), h0 = *(const LAS bf16x8*)(Kw + kx[1]), l1 = *(const LAS bf16x8*)(Kw + 2048 + kx[0]), h1 = *(const LAS bf16x8*)(Kw + 2048 + kx[1]);
    pA0 = __builtin_amdgcn_mfma_scale_f32_32x32x64_f8f6f4(KCAT(l0, h0), qf, f32x16{}, 0, 0, 0, 0x7f7f7f7f, 0, 0x7c7c7c7c);
    pA1 = __builtin_amdgcn_mfma_scale_f32_32x32x64_f8f6f4(KCAT(l1, h1), qf, f32x16{}, 0, 0, 0, 0x7f7f7f7f, 0, 0x7c7c7c7c); }
  sfor<0, 16>([&](auto ic) __attribute__((always_inline)) { start_item<decltype(ic)::value, NEXS>(pA0, pA1, st, negm, thr, hi == 0 ? 1.f : 0.f); });
  { float pmax;
    { auto rr = __builtin_amdgcn_permlane32_swap(__float_as_uint(st.a0), __float_as_uint(st.a0), false, false); pmax = fmaxf(__uint_as_float(rr[0]), __uint_as_float(rr[1])); }
#pragma unroll
    for (int r = 0; r < 16; ++r) { pA0[r] -= pmax; pA1[r] -= pmax; negm[r] = -pmax; } }
  sfor<17, SS::NITEMS>([&](auto ic) __attribute__((always_inline)) { start_item<decltype(ic)::value, NEXS>(pA0, pA1, st, negm, thr, hi == 0 ? 1.f : 0.f); });
  int bq = 0;
#define ITER(j, PN0, PN1, PF0, PF1) do { const int b1 = NXT3(bq), b2 = NXT3(b1); \
    WAITV(3); WBAR(); \
    const int tk_ = (j) + 3 < NT ? (j) + 3 : NT - 1, tv_ = (j) + 2 < NT ? (j) + 2 : NT - 1; \
    PHASE1(PN0, PN1, PF0, PF1, Kw + b1 * SHM_K, vb0 + bq * SHM_V); \
    PHASE2(PN0, PN1, vb0 + bq * SHM_V); \
    bq = b1; } while (0)
#if PROBE_T == 2
  const unsigned long long t0 = __builtin_amdgcn_s_memtime();
#endif
  for (int j = 0; j + 2 < NT; j += 2) { ITER(j, pB0, pB1, pA0, pA1); ITER(j + 1, pA0, pA1, pB0, pB1); }
  ITER(NT - 2, pB0, pB1, pA0, pA1);
#if PROBE_T == 2
  { const unsigned long long t1 = __builtin_amdgcn_s_memtime(); if (probe != nullptr && tid == 0) { probe[0] = 0.f; probe[1] = ((float)(t1 - t0) * (1.f / (NT - 1)) - 1500.f) * 0.05f; } }
#endif
  sfor<0, FS::NITEMS>([&](auto ic) __attribute__((always_inline)) { fin_item<decltype(ic)::value, NEXF>(pB0, pB1, st, pw); });
  WAITV(0); WBAR();
  { const int vb = vb0 + bq * SHM_V;
    sfor<0, VLA>([&](auto gc) __attribute__((always_inline)) { v_issue<decltype(gc)::value>(vf[decltype(gc)::value], vb); });
    sfor<0, 16>([&](auto gc) __attribute__((always_inline)) { constexpr int g = decltype(gc)::value, ks = g >> 2, d = g & 3;
      v_wait<2 * (15 - g < VLA - 1 ? 15 - g : VLA - 1)>(vf[g]);
      o[d] = __builtin_amdgcn_mfma_f32_32x32x16_bf16(PA(ks), PKV(vf[g]), o[d], 0, 0, 0);
      if constexpr (g + VLA < 16) v_issue<g + VLA>(vf[g + VLA], vb);
      if constexpr (d == 3) osum = __builtin_amdgcn_mfma_f32_32x32x16_bf16(PA(ks), ones, osum, 0, 0, 0);
      SBAR(); }); }
#pragma unroll
  for (int r = 0; r < 16; ++r) { const float rl = __builtin_amdgcn_rcpf(osum[r]);
#pragma unroll
    for (int d = 0; d < 4; ++d) o[d][r] *= rl; }
  asm volatile("s_waitcnt lgkmcnt(0)" ::: "memory"); WBAR();
#undef GLDS
#undef ISSUE_K
#undef ISSUE_V
#undef WAITV
#undef WBAR
#undef RESC
#undef NXT3
#undef PA
#undef PKV
#undef KCAT
#undef PHASE1
#undef PHASE2
#undef ITER
}
struct SrcDH { const bf16_t* Q; const bf16_t* K; const unsigned char* q8; const unsigned char* k8; const bf16_t* V; int ldv; };
template <int MP>
__device__ __forceinline__ void attn_core_plh(const SrcDH in, const float thr, const int seq, LAS char* lds, f32x16 (&o)[4], float* probe = nullptr) {
  constexpr int SHM_K = 12288, NKS = 4, NG1 = 8, NEXS = 32, NEXF = 0, VLA = 3;
  using SS = StartSched<NEXS>; using FS = FinSched<NEXF>;
  int lane; asm volatile("v_and_b32 %0, 63, %1" : "=v"(lane) : "v"(threadIdx.x));
  const int tid = threadIdx.x, wid = __builtin_amdgcn_readfirstlane(tid >> 6), r32 = lane & 31, hi = (lane >> 5) & 1, wq = wid & 3; constexpr int mp = MP;
  LAS char* V_lds = lds; LAS char* K_lds = lds + 3 * SHM_V;
  SMS st; st.dm = 0.f; st.keep = true;
  f32x16 negm = f32x16{}, osum = f32x16{};
#pragma unroll
  for (int d = 0; d < 4; ++d) o[d] = f32x16{};
  const bf16x8 ones = {16256, 16256, 16256, 16256, 16256, 16256, 16256, 16256};
  bf16x8 qr[NKS]; v8i_att qf = {};
  if constexpr (mp == 0) { const bf16_t* Qw = in.Q + (size_t)(wq * QBLK + r32) * 1024 + hi * 8;
#pragma unroll
    for (int d0 = 0; d0 < NKS; ++d0) qr[d0] = *(const bf16x8*)(Qw + d0 * 16); }
  else { const unsigned char* Qw = in.q8 + (size_t)(wq * QBLK + r32) * 1024 + 64 + hi * 32;
    const v4i_att lo = *(const v4i_att*)(Qw), hh = *(const v4i_att*)(Qw + 16); qf = __builtin_shufflevector(lo, hh, 0, 1, 2, 3, 4, 5, 6, 7);
#pragma unroll
    for (int d0 = 0; d0 < NKS; ++d0) qr[d0] = bf16x8{}; }
  const int krow = wid * 8 + (lane >> 3), kslot = (lane & 7) ^ ((krow >> 1) & 7);
  const unsigned koff = (unsigned)(krow * 1024 + kslot * 8) * 2u;
  const unsigned ksrc8 = (unsigned)(((wid & 3) * 16 + (lane >> 2)) * 1024 + 64 + (((lane & 3) ^ ((lane >> 4) & 3)) << 4));
  const int kdst8 = 8192 + (wid & 3) * 1024 + lane * 16;
  unsigned voff[2];
#pragma unroll
  for (int i = 0; i < 2; ++i) { const int p = i * 8192 + wid * 1024 + lane * 16, s_ = p >> 9, wq_ = (p & 511) >> 1, kk = (s_ >> 2) * 8 + (wq_ >> 5), cl = wq_ & 31;
    voff[i] = (unsigned)(kk * in.ldv + (s_ & 3) * 32 + cl) * 2u; }
  const int vb0 = (int)(unsigned)(size_t)V_lds + v_rd_base(lane);
  const unsigned ldsw = (unsigned)wid * 1024u;
  int kx[2];
#pragma unroll
  for (int c = 0; c < 2; ++c) kx[c] = 8192 + r32 * 64 + (((2 * hi + c) ^ ((r32 >> 2) & 3)) << 4);
#define GLDS(gp, lp) __builtin_amdgcn_global_load_lds((const unsigned*)(gp), (LAS unsigned*)(lp), 16, 0, 0)
#define ISSUE_K(t, b) do { GLDS((const char*)in.K + (size_t)(t) * (KVBLK * 2) * 1024 + koff, K_lds + (b) * SHM_K + ldsw); GLDS(in.k8 + (size_t)(t) * (KVBLK * 1024) + ksrc8, K_lds + (b) * SHM_K + kdst8); } while (0)
#define ISSUE_V(t, b) do { const char* vb_ = (const char*)in.V + (size_t)(t) * (KVBLK * 2) * in.ldv; GLDS(vb_ + voff[0], V_lds + (b) * SHM_V + ldsw); GLDS(vb_ + voff[1], V_lds + (b) * SHM_V + 8192 + ldsw); } while (0)
#define DMA_PIECE(i) do { if ((i) == 0) GLDS((const char*)in.K + (size_t)tk_ * (KVBLK * 2) * 1024 + koff, K_lds + bq * SHM_K + ldsw); \
    else if ((i) == 1) GLDS(in.k8 + (size_t)tk_ * (KVBLK * 1024) + ksrc8, K_lds + bq * SHM_K + kdst8); \
    else GLDS((const char*)in.V + (size_t)tv_ * (KVBLK * 2) * in.ldv + voff[(i) & 1], V_lds + b2 * SHM_V + ((i) & 1) * 8192 + ldsw); } while (0)
#define WAITV(n) asm volatile("s_waitcnt vmcnt(%0)" :: "n"(n) : "memory")
#define WBAR() do { asm volatile("" ::: "memory"); __builtin_amdgcn_s_barrier(); asm volatile("" ::: "memory"); } while (0)
#define RESC() do { if (!st.keep) { int l2_; asm volatile("v_and_b32 %0, 63, %1" : "=v"(l2_) : "v"(threadIdx.x)); const int h2_ = l2_ >> 5; LAS float* al2_ = (LAS float*)(lds + MISC_OFF + 128) + wid * 32; \
    if (h2_ == 0) al2_[l2_] = __builtin_amdgcn_exp2f(st.dm); asm volatile("s_waitcnt lgkmcnt(0)" ::: "memory"); \
    _Pragma("unroll") for (int r = 0; r < 16; ++r) { const float a_ = al2_[crow(r, h2_)]; osum[r] *= a_; _Pragma("unroll") for (int d = 0; d < 4; ++d) o[d][r] *= a_; } asm volatile("s_waitcnt lgkmcnt(0)" ::: "memory"); } } while (0)
#define NXT3(x) ((x) == 2 ? 0 : (x) + 1)
#define KFRAG(Ks, d, blk) (*(const LAS bf16x8*)((Ks) + KSW((blk) * 32 + r32, ((d) * 16 + hi * 8) * 2)))
#define PA(ks) (*reinterpret_cast<const bf16x8*>(&pw[ks]))
#define PKV(f) (bf16x8){f.l[0], f.l[1], f.l[2], f.l[3], f.h[0], f.h[1], f.h[2], f.h[3]}
#define KCAT(lo_, hi_) __builtin_shufflevector(__builtin_bit_cast(v4i_att, lo_), __builtin_bit_cast(v4i_att, hi_), 0, 1, 2, 3, 4, 5, 6, 7)
#define PHASE1_BF(PN0, PN1, PF0, PF1, Ks, vb) do { \
    bf16x8 kf[NKS][2]; kf[0][0] = KFRAG(Ks, 0, 0); kf[0][1] = KFRAG(Ks, 0, 1); \
    sfor<0, NG1>([&](auto gc) __attribute__((always_inline)) { constexpr int g = decltype(gc)::value, d = g >> 1, blk = g & 1; \
      if constexpr (blk == 0 && d + 1 < NKS) { kf[d + 1][0] = KFRAG(Ks, d + 1, 0); kf[d + 1][1] = KFRAG(Ks, d + 1, 1); } \
      if constexpr (blk == 0) { if constexpr (d == 0) mfma_c(PN0, kf[d][0], qr[d], negm); else PN0 = __builtin_amdgcn_mfma_f32_32x32x16_bf16(kf[d][0], qr[d], PN0, 0, 0, 0); } \
      else              { if constexpr (d == 0) mfma_c(PN1, kf[d][1], qr[d], negm); else PN1 = __builtin_amdgcn_mfma_f32_32x32x16_bf16(kf[d][1], qr[d], PN1, 0, 0, 0); } \
      if constexpr (g < 4) DMA_PIECE(g); \
      if constexpr (g >= NG1 - VLA) v_issue<g - (NG1 - VLA)>(vf[g - (NG1 - VLA)], vb); \
      sfor<FS::first(g, NG1), FS::first(g + 1, NG1)>([&](auto ic) __attribute__((always_inline)) { fin_item<decltype(ic)::value, NEXF>(PF0, PF1, st, pw); }); \
      SBAR(); }); } while (0)
#define PHASE1_F8(PN0, PN1, PF0, PF1, Ks, vb) do { \
    bf16x8 kl0, kh0, kl1, kh1; { const int a0_ = (int)(unsigned)(size_t)(Ks) + kx[0], a1_ = (int)(unsigned)(size_t)(Ks) + kx[1]; \
      k_read<0>(kl0, a0_); k_read<0>(kh0, a1_); k_read<2048>(kl1, a0_); k_read<2048>(kh1, a1_); } \
    asm volatile("s_waitcnt lgkmcnt(2)" : "+v"(kl0), "+v"(kh0)); \
    PN0 = __builtin_amdgcn_mfma_scale_f32_32x32x64_f8f6f4(KCAT(kl0, kh0), qf, negm, 0, 0, 0, 0x7f7f7f7f, 0, 0x7c7c7c7c); \
    DMA_PIECE(0); DMA_PIECE(1); \
    v_issue<0>(vf[0], vb); \
    sfor<0, 8>([&](auto ic) __attribute__((always_inline)) { fin_item<decltype(ic)::value, NEXF>(PF0, PF1, st, pw); }); \
    SBAR(); \
    asm volatile("s_waitcnt lgkmcnt(2)" : "+v"(kl1), "+v"(kh1)); \
    PN1 = __builtin_amdgcn_mfma_scale_f32_32x32x64_f8f6f4(KCAT(kl1, kh1), qf, negm, 0, 0, 0, 0x7f7f7f7f, 0, 0x7c7c7c7c); \
    DMA_PIECE(2); DMA_PIECE(3); \
    v_issue<1>(vf[1], vb); v_issue<2>(vf[2], vb); \
    sfor<8, 16>([&](auto ic) __attribute__((always_inline)) { fin_item<decltype(ic)::value, NEXF>(PF0, PF1, st, pw); }); \
    SBAR(); } while (0)
#define PHASE2(PS0, PS1, vb) do { \
    sfor<0, 20>([&](auto gc) __attribute__((always_inline)) { constexpr int gg = decltype(gc)::value, ks = gg / 5, d = gg % 5, g = ks * 4 + d; \
      if constexpr (d < 4) { \
        v_wait<2 * (15 - g < VLA - 1 ? 15 - g : VLA - 1)>(vf[g]); \
        o[d] = __builtin_amdgcn_mfma_f32_32x32x16_bf16(PA(ks), PKV(vf[g]), o[d], 0, 0, 0); \
        if constexpr (g + VLA < 16) v_issue<g + VLA>(vf[g + VLA], vb); \
      } else osum = __builtin_amdgcn_mfma_f32_32x32x16_bf16(PA(ks), ones, osum, 0, 0, 0); \
      sfor<SS::first(gg, 20), SS::first(gg + 1, 20)>([&](auto ic) __attribute__((always_inline)) { start_item<decltype(ic)::value, NEXS>(PS0, PS1, st, negm, thr, hi == 0 ? 1.f : 0.f); }); \
      SBAR(); }); \
    asm volatile("" : "+v"(PS0), "+v"(PS1)); \
    RESC(); } while (0)
  f32x16 pA0, pA1, pB0, pB1; u32x4 pw[4]; VF vf[16]; const int NT = seq / KVBLK;
  ISSUE_K(0, 0); ISSUE_K(1, 1); ISSUE_V(0, 0);
  WAITV(4); WBAR();
  ISSUE_K(2, 2); ISSUE_V(1, 1);
  if constexpr (mp == 0) { bf16x8 kf[NKS][2];
#pragma unroll
    for (int d = 0; d < NKS; ++d) { kf[d][0] = KFRAG(K_lds, d, 0); kf[d][1] = KFRAG(K_lds, d, 1); }
    pA0 = f32x16{}; pA1 = f32x16{};
#pragma unroll
    for (int d = 0; d < NKS; ++d) { pA0 = __builtin_amdgcn_mfma_f32_32x32x16_bf16(kf[d][0], qr[d], pA0, 0, 0, 0); pA1 = __builtin_amdgcn_mfma_f32_32x32x16_bf16(kf[d][1], qr[d], pA1, 0, 0, 0); } }
  else { const bf16x8 l0 = *(const LAS bf16x8*)(K_lds + kx[0]), h0 = *(const LAS bf16x8*)(K_lds + kx[1]), l1 = *(const LAS bf16x8*)(K_lds + 2048 + kx[0]), h1 = *(const LAS bf16x8*)(K_lds + 2048 + kx[1]);
    pA0 = __builtin_amdgcn_mfma_scale_f32_32x32x64_f8f6f4(KCAT(l0, h0), qf, f32x16{}, 0, 0, 0, 0x7f7f7f7f, 0, 0x7c7c7c7c);
    pA1 = __builtin_amdgcn_mfma_scale_f32_32x32x64_f8f6f4(KCAT(l1, h1), qf, f32x16{}, 0, 0, 0, 0x7f7f7f7f, 0, 0x7c7c7c7c); }
  sfor<0, 16>([&](auto ic) __attribute__((always_inline)) { start_item<decltype(ic)::value, NEXS>(pA0, pA1, st, negm, thr, hi == 0 ? 1.f : 0.f); });
  { float pmax;
    { auto rr = __builtin_amdgcn_permlane32_swap(__float_as_uint(st.a0), __float_as_uint(st.a0), false, false); pmax = fmaxf(__uint_as_float(rr[0]), __uint_as_float(rr[1])); }
#pragma unroll
    for (int r = 0; r < 16; ++r) { pA0[r] -= pmax; pA1[r] -= pmax; negm[r] = -pmax; } }
  sfor<17, SS::NITEMS>([&](auto ic) __attribute__((always_inline)) { start_item<decltype(ic)::value, NEXS>(pA0, pA1, st, negm, thr, hi == 0 ? 1.f : 0.f); });
  int bq = 0;
#define ITER(j, PN0, PN1, PF0, PF1) do { const int b1 = NXT3(bq), b2 = NXT3(b1); \
    WAITV(4); WBAR(); \
    const int tk_ = (j) + 3 < NT ? (j) + 3 : NT - 1, tv_ = (j) + 2 < NT ? (j) + 2 : NT - 1; \
    if constexpr (mp == 0) PHASE1_BF(PN0, PN1, PF0, PF1, K_lds + b1 * SHM_K, vb0 + bq * SHM_V); else PHASE1_F8(PN0, PN1, PF0, PF1, K_lds + b1 * SHM_K, vb0 + bq * SHM_V); \
    PHASE2(PN0, PN1, vb0 + bq * SHM_V); \
    bq = b1; } while (0)
#if PROBE_T == 2
  const unsigned long long t0 = __builtin_amdgcn_s_memtime();
#endif
  for (int j = 0; j + 2 < NT; j += 2) { ITER(j, pB0, pB1, pA0, pA1); ITER(j + 1, pA0, pA1, pB0, pB1); }
  ITER(NT - 2, pB0, pB1, pA0, pA1);
#if PROBE_T == 2
  { const unsigned long long t1 = __builtin_amdgcn_s_memtime(); if (probe != nullptr && tid == 0) { probe[0] = 0.f; probe[1] = ((float)(t1 - t0) * (1.f / (NT - 1)) - 1500.f) * 0.05f; } }
#endif
  sfor<0, FS::NITEMS>([&](auto ic) __attribute__((always_inline)) { fin_item<decltype(ic)::value, NEXF>(pB0, pB1, st, pw); });
  WAITV(0); WBAR();
  { const int vb = vb0 + bq * SHM_V;
    sfor<0, VLA>([&](auto gc) __attribute__((always_inline)) { v_issue<decltype(gc)::value>(vf[decltype(gc)::value], vb); });
    sfor<0, 16>([&](auto gc) __attribute__((always_inline)) { constexpr int g = decltype(gc)::value, ks = g >> 2, d = g & 3;
      v_wait<2 * (15 - g < VLA - 1 ? 15 - g : VLA - 1)>(vf[g]);
      o[d] = __builtin_amdgcn_mfma_f32_32x32x16_bf16(PA(ks), PKV(vf[g]), o[d], 0, 0, 0);
      if constexpr (g + VLA < 16) v_issue<g + VLA>(vf[g + VLA], vb);
      if constexpr (d == 3) osum = __builtin_amdgcn_mfma_f32_32x32x16_bf16(PA(ks), ones, osum, 0, 0, 0);
      SBAR(); }); }
#pragma unroll
  for (int r = 0; r < 16; ++r) { const float rl = __builtin_amdgcn_rcpf(osum[r]);
#pragma unroll
    for (int d = 0; d < 4; ++d) o[d][r] *= rl; }
  asm volatile("s_waitcnt lgkmcnt(0)" ::: "memory"); WBAR();
#undef GLDS
#undef ISSUE_K
#undef ISSUE_V
#undef DMA_PIECE
#undef WAITV
#undef WBAR
#undef RESC
#undef NXT3
#undef KFRAG
#undef PA
#undef PKV
#undef KCAT
#undef PHASE1_BF
#undef PHASE1_F8
#undef PHASE2
#undef ITER
}
}

constexpr int NWAVES = 8;
struct Args { const void* in[27]; float* out; unsigned char* ws; int ph_lo, ph_hi, li, pad; };

__constant__ float c_invA[8] = {1.0f, 0.19392274474868576f, 0.03760603093086393f, 0.007292664737217109f, 0.001414213562373095f, 0.0002742481756762073f, 5.318295896944988e-05f, 1.031338537721246e-05f};
__constant__ float c_invM[32] = {1.0f, 0.6636012376960885f, 0.44036660267178046f, 0.2922278225730151f, 0.19392274474868576f, 0.12868737343265052f, 0.08539710028576561f, 0.05666962144529105f,
    0.03760603093086393f, 0.024955408670558694f, 0.016560440080994446f, 0.010989528534539826f, 0.007292664737217109f, 0.004839421345719893f, 0.003211445994752591f, 0.0021311195369119653f,
    0.001414213562373095f, 0.0009384738703573802f, 0.000622772421914596f, 0.0004132725499855165f, 0.0002742481756762073f, 0.00018199142881462546f, 0.00012076973741146504f, 8.01429472224798e-05f,
    5.318295896944988e-05f, 3.529227739646723e-05f, 2.341999896140934e-05f, 1.5541540297632344e-05f, 1.031338537721246e-05f, 6.8439753011549275e-06f, 4.5416704806078695e-06f, 3.013858152139171e-06f};

__device__ __forceinline__ int permDA(int i) { return i < 16 ? (i >> 1) + 8 * (i & 1) : i; }
__device__ __forceinline__ int permM(int i) { return (i >> 1) + 32 * (i & 1); }
__device__ __forceinline__ int src_in(int j) {
    if (j < 2048) return (j & ~63) + permDA(j & 63);
    if (j < 4352) return j;
    if (j < 6400) return 4416 + (j - 4352);
    if (j < 6464) return 4352 + permM(j - 6400);
    return -1;
}
__device__ __forceinline__ int src_uq(int j) { const int hd = j / 192, off = j % 192; return off < 128 ? j : hd * 192 + 128 + permM(off - 128); }

__device__ __forceinline__ void tr_item(const float* W, int K, int N, bf16_t* WT, int n0, int k0, int scol, const float* rs, LAS float* scr, int lane) {
#pragma unroll 8
    for (int i = 0; i < 32; ++i) { const int kk = 2 * i + (lane >> 5); float v = 0.f; if (scol >= 0) { v = W[(size_t)(k0 + kk) * N + scol]; if (rs) v *= rs[k0 + kk]; } scr[kk * 33 + (lane & 31)] = v; }
    LDS_WAIT(); asm volatile("" ::: "memory");
    const int c = lane & 7;
#pragma unroll
    for (int j = 0; j < 4; ++j) { const int n = (lane >> 3) + 8 * j; const LAS float* s = scr + (8 * c) * 33 + n;
        u32x4 o; o.x = cvt_pk_bf16(s[0 * 33], s[1 * 33]); o.y = cvt_pk_bf16(s[2 * 33], s[3 * 33]); o.z = cvt_pk_bf16(s[4 * 33], s[5 * 33]); o.w = cvt_pk_bf16(s[6 * 33], s[7 * 33]);
        *(u32x4*)(WT + (size_t)(n0 + n) * K + k0 + 8 * c) = o; }
    LDS_WAIT(); asm volatile("" ::: "memory");
}

template <int MODE = 0, bool OUT8 = false>
__device__ __forceinline__ void cvt_tile64(const float* W, int N, bf16_t* WT, int Kd, int k0, int n0, int drow0, int lane, const float* rs = nullptr) {
    const int g = lane >> 4, x = lane & 15;
    const float* src = W + (size_t)(k0 + 16 * g) * N + n0 + 4 * x;
    f32x4 v[16];
#pragma unroll
    for (int i = 0; i < 16; ++i) v[i] = __builtin_nontemporal_load((const f32x4*)(src + (size_t)i * N));
    if (rs) {
#pragma unroll
        for (int i = 0; i < 16; ++i) v[i] = v[i] * rs[k0 + 16 * g + i];
    }
    if constexpr (OUT8) {
#pragma unroll
        for (int j = 0; j < 4; ++j) { u32x4 w;
            w.x = cvt_pk_fp8x4(v[0][j] * 64.f, v[1][j] * 64.f, v[2][j] * 64.f, v[3][j] * 64.f); w.y = cvt_pk_fp8x4(v[4][j] * 64.f, v[5][j] * 64.f, v[6][j] * 64.f, v[7][j] * 64.f);
            w.z = cvt_pk_fp8x4(v[8][j] * 64.f, v[9][j] * 64.f, v[10][j] * 64.f, v[11][j] * 64.f); w.w = cvt_pk_fp8x4(v[12][j] * 64.f, v[13][j] * 64.f, v[14][j] * 64.f, v[15][j] * 64.f);
            const int c8 = 4 * x + j;
            const int dr8 = (MODE == 3 || MODE == 4) ? 32 * (c8 >> 4) + 8 * ((c8 >> 2) & 3) + 4 * (MODE - 3) + (c8 & 3) : (MODE == 1 ? 2 * (c8 & 31) + (c8 >> 5) : c8);
            *(u32x4*)((unsigned char*)WT + (size_t)(drow0 + dr8) * Kd + k0 + 16 * g) = w; }
        return; }
#pragma unroll
    for (int j = 0; j < 4; ++j) { u32x4 lo, hi;
        lo.x = cvt_pk_bf16(v[0][j], v[1][j]); lo.y = cvt_pk_bf16(v[2][j], v[3][j]); lo.z = cvt_pk_bf16(v[4][j], v[5][j]); lo.w = cvt_pk_bf16(v[6][j], v[7][j]);
        hi.x = cvt_pk_bf16(v[8][j], v[9][j]); hi.y = cvt_pk_bf16(v[10][j], v[11][j]); hi.z = cvt_pk_bf16(v[12][j], v[13][j]); hi.w = cvt_pk_bf16(v[14][j], v[15][j]);
        const int c = 4 * x + j;
        const int dr = MODE == 1 ? 2 * (c & 31) + (c >> 5) : (MODE == 2 ? (c < 16 ? 2 * (c & 7) + (c >> 3) : c) : c);
        bf16_t* d = WT + (size_t)(drow0 + dr) * Kd + k0 + 16 * g;
        *(u32x4*)d = lo; *(u32x4*)(d + 8) = hi; }
}

__global__ void __launch_bounds__(NWAVES * 64, 2) fwd(Args args) {
#define KARGS() const __attribute__((address_space(4))) unsigned long long* ka_ = (const __attribute__((address_space(4))) unsigned long long*)__builtin_amdgcn_kernarg_segment_ptr(); asm volatile("" : "+s"(ka_))
#define AIN(i) ((const void*)ka_[i])
#define AOUT ((float*)ka_[27])
#define AWS ((unsigned char*)ka_[28])
    extern __shared__ __attribute__((aligned(16))) unsigned char lds_raw[];
    LAS unsigned char* lds = (LAS unsigned char*)lds_raw;
    volatile LAS unsigned* MISC = (volatile LAS unsigned*)(lds + MISC_OFF);
    const int tid = threadIdx.x, wave = __builtin_amdgcn_readfirstlane(tid >> 6);
#define LANE_DECL int lane; asm volatile("v_and_b32 %0, 63, %1" : "=v"(lane) : "v"(threadIdx.x))
    const int G = gridDim.x, bx = blockIdx.x;
    unsigned* ctl = (unsigned*)(args.ws + WS_CTL);
    const int lo = args.ph_lo, hi_ph = args.ph_hi;
    if (tid < 32) MISC[tid] = 0u;
    __syncthreads();
    XcdBarrier bar; bar.bar = ctl + CW_BAR + args.li * XCD_BAR_WORDS; bar.x = 0; bar.st = nullptr;
    if (!MK_PER_PHASE) bar = xcd_barrier_post(ctl + CW_BAR + args.li * XCD_BAR_WORDS, MISC + 8);
#define IN(k) (((PH_MASK >> (k)) & 1) && lo <= (k) && (k) < hi_ph)
#define SEAM(k) do { if (IN(k) && IN((k) + 1)) xcd_barrier(bar); } while (0)
    const int gw = bx * NWAVES + wave, NGW = G * NWAVES;

#define xin ((const float*)AIN(0))
#define positions ((const int*)AIN(1))
#define Bt_in ((bf16_t*)(AWS + WS_BT_IN))
#define Bt_uq ((bf16_t*)(AWS + WS_BT_UQ))
#define Bt_ukv ((bf16_t*)(AWS + WS_BT_UKV))
#define Bt_od ((bf16_t*)(AWS + WS_BT_OD))
#define Bt_om ((bf16_t*)(AWS + WS_BT_OM))
#define Bt_out ((bf16_t*)(AWS + WS_BT_OUT))
#define ropeA ((float*)(AWS + WS_ROPEA))
#define ropeM ((float*)(AWS + WS_ROPEM))
#define sq ((float*)(AWS + WS_SQ2))
#define hbuf ((bf16_t*)(AWS + WS_H))
#define oa ((bf16_t*)(AWS + WS_H))
#define qa ((bf16_t*)(AWS + WS_QA))
#define ka ((bf16_t*)(AWS + WS_KA))
#define va ((bf16_t*)(AWS + WS_VA))
#define cq ((bf16_t*)(AWS + WS_CQ))
#define ckv ((bf16_t*)(AWS + WS_CKV))
#define kr ((bf16_t*)(AWS + WS_KR))
#define gates ((bf16_t*)(AWS + WS_GATES))
#define qm ((bf16_t*)(AWS + WS_QM))
#define kv ((bf16_t*)(AWS + WS_KV))
#define ob ((bf16_t*)(AWS + WS_OB))
#define mrg ((bf16_t*)(AWS + WS_MRG))
#define stash ((float*)(AWS + WS_STASH))
#define rowtok_p ((int*)(AWS + WS_ROWTOK))
#define assign ((u32x2*)(AWS + WS_ASSIGN))
#define Bt_d ((bf16_t*)(AWS + WS_BT_D))
#define Bt_gu ((bf16_t*)(AWS + WS_BT_GU))
#define h2 ((bf16_t*)(AWS + WS_H2))
#define act ((bf16_t*)(AWS + WS_ACT))
#define ybuf ((unsigned char*)(AWS + WS_Y))
#define q8p ((unsigned char*)(AWS + WS_Q8))
#define k8np ((unsigned char*)(AWS + WS_K8N))
#define k8rp ((unsigned char*)(AWS + WS_K8R))
#define q8ap ((unsigned char*)(AWS + WS_Q8A))
#define k8ap ((unsigned char*)(AWS + WS_K8A))
#define x1b ((bf16_t*)(AWS + WS_X1B))
#define count ((unsigned*)(AWS + WS_CTL) + CW_COUNT)

    if (IN(0)) {
        KARGS();
        LANE_DECL;
        const float* w_in = (const float*)AIN(3); const float* g_q = (const float*)AIN(9); const float* g_kv = (const float*)AIN(10);
        const float* w_uq = (const float*)AIN(11); const float* w_ukv = (const float*)AIN(12);
        const float* w_od = (const float*)AIN(13); const float* w_om = (const float*)AIN(14); const float* w_out = (const float*)AIN(16);
        constexpr int I_IN = 16 * 101, I_PAD = 16 * 3, I_UQ = 12 * 24, I_UKV = 8 * 32, I_O = 16 * 16;
        constexpr int NITEMS = I_IN + I_PAD + I_UQ + I_UKV + 3 * I_O;
        for (int it = gw; it < NITEMS; it += NGW) {
            int r = it;
            if (r < I_IN) { const int kb = r / 101, cb = r % 101, n0 = cb * 64;
                if (n0 < 2048) cvt_tile64<2>(w_in, 6464, Bt_in, D, kb * 64, n0, n0, lane);
                else if (n0 < 4352) cvt_tile64<0>(w_in, 6464, Bt_in, D, kb * 64, n0, n0, lane);
                else if (n0 < 4416) cvt_tile64<1>(w_in, 6464, Bt_in, D, kb * 64, n0, 5888, lane);
                else if (n0 < 4416 + 1536) cvt_tile64<0>(w_in, 6464, Bt_in, D, kb * 64, n0, n0 - 64, lane);
                else cvt_tile64<0>(w_in, 6464, Bt_in, D, kb * 64, n0, n0 - 64 + 256, lane);
                continue; } r -= I_IN;
            if (r < I_PAD) { const int kb = r / 3, rb = r % 3; const int g = lane >> 4, x4 = lane & 15;
#pragma unroll
                for (int j = 0; j < 4; ++j) { bf16_t* d = Bt_in + (size_t)(5952 + rb * 64 + 4 * x4 + j) * D + kb * 64 + 16 * g; *(u32x4*)d = (u32x4){0u, 0u, 0u, 0u}; *(u32x4*)(d + 8) = (u32x4){0u, 0u, 0u, 0u}; }
                continue; } r -= I_PAD;
            if (r < I_UQ) { const int kb = r / 24, cb = r % 24, n0 = cb * 64;
                if (UP_F8) { if ((cb % 3) == 2) cvt_tile64<1, true>(w_uq, 1536, Bt_uq, QL, kb * 64, n0, n0, lane, g_q); else cvt_tile64<0, true>(w_uq, 1536, Bt_uq, QL, kb * 64, n0, n0, lane, g_q); }
                else if ((cb % 3) == 2) cvt_tile64<1>(w_uq, 1536, Bt_uq, QL, kb * 64, n0, n0, lane, g_q); else cvt_tile64<0>(w_uq, 1536, Bt_uq, QL, kb * 64, n0, n0, lane, g_q);
                continue; } r -= I_UQ;
            if (r < I_UKV) { const int kb = r / 32, cb = r % 32; if (UP_F8) cvt_tile64<0, true>(w_ukv, 2048, Bt_ukv, KVL, kb * 64, cb * 64, cb * 64, lane, g_kv); else cvt_tile64<0>(w_ukv, 2048, Bt_ukv, KVL, kb * 64, cb * 64, cb * 64, lane, g_kv); continue; } r -= I_UKV;
            const int which = r / I_O; r -= which * I_O; const int kb = r / 16, cb = r % 16;
            cvt_tile64<0>(which == 0 ? w_od : (which == 1 ? w_om : w_out), D, which == 0 ? Bt_od : (which == 1 ? Bt_om : Bt_out), D, kb * 64, cb * 64, cb * 64, lane);
        }
        const float* g_mix = (const float*)AIN(2);
        for (int m = gw * 4; m < T; m += NGW * 4) {
            f32x4 v[4][4]; float ss[4];
#pragma unroll
            for (int q = 0; q < 4; ++q) { const f32x4* xr = (const f32x4*)(xin + (size_t)(m + q) * D) + lane;
#pragma unroll
                for (int j = 0; j < 4; ++j) v[q][j] = xr[64 * j]; }
#pragma unroll
            for (int q = 0; q < 4; ++q) { float s = 0.f;
#pragma unroll
                for (int j = 0; j < 4; ++j) s += (v[q][j][0] * v[q][j][0] + v[q][j][1] * v[q][j][1]) + (v[q][j][2] * v[q][j][2] + v[q][j][3] * v[q][j][3]);
                ss[q] = __builtin_amdgcn_rsqf(wave_sum(s) * (1.f / D) + EPS); }
#pragma unroll
            for (int j = 0; j < 4; ++j) { const f32x4 gg = *((const f32x4*)g_mix + lane + 64 * j);
#pragma unroll
                for (int q = 0; q < 4; ++q) { u32x2 w; w.x = cvt_pk_bf16(v[q][j][0] * ss[q] * gg[0], v[q][j][1] * ss[q] * gg[1]); w.y = cvt_pk_bf16(v[q][j][2] * ss[q] * gg[2], v[q][j][3] * ss[q] * gg[3]);
                    ((u32x2*)(hbuf + (size_t)(m + q) * D) + lane)[64 * j] = w; } }
        }
        for (int idx = bx * 512 + tid; idx < T * 40; idx += G * 512) {
            const int t = idx / 40, i = idx % 40; const float inv = i < 8 ? c_invA[i] : c_invM[i - 8];
            const float ang = (float)positions[t] * inv;
            const double rev = (double)ang * 0.15915494309189535; const float fr_ = (float)(rev - __builtin_rint(rev));
            const float cs = __builtin_amdgcn_cosf(fr_), sn = __builtin_amdgcn_sinf(fr_);
            float* dst = i < 8 ? ropeA + ((size_t)t * 8 + i) * 2 : ropeM + ((size_t)t * 32 + (i - 8)) * 2; dst[0] = cs; dst[1] = sn;
        }
    }
    SEAM(0);
    if (IN(1)) {
        KARGS();
        pg8::Gemm g{hbuf, Bt_in, D}; pg8::DenseOrder S; S.init(T / 256, 24, G, bx);
        pg8::EpiIn E{qa, ka, va, cq, ckv, gates, kr, ropeA, ropeM, (const float*)AIN(15), sq, k8rp, q8ap, k8ap};
        pg8::gemm_phase<pg8::EpiIn, pg8::DenseOrder, false, true>(lds, g, S, E);
    }
    SEAM(1);
    if (IN(2)) {
        KARGS();
        { pg8::Gemm g{hbuf, Bt_in, D}; pg8::DenseOrder S; S.init(T / 256, 2, G, bx, 24);
          pg8::EpiIn E{qa, ka, va, cq, ckv, gates, kr, ropeA, ropeM, (const float*)AIN(15), sq, k8rp, q8ap, k8ap};
          pg8::gemm_phase<pg8::EpiIn, pg8::DenseOrder, false, true>(lds, g, S, E); }
#if UP_F8
        { pg8::Gemm g{cq, Bt_uq, QL / 2}; pg8::DenseOrder S; S.init(T / 256, 1536 / 128, G, G - 1 - bx); pg8::EpiUp8<true> E{qm, sq, ropeM, q8p};
          pg8::gemm_phase_f8p<pg8::EpiUp8<true>, pg8::DenseOrder>(lds, g, S, E); }
        { pg8::Gemm g{ckv, Bt_ukv, KVL / 2}; pg8::DenseOrder S; S.init(T / 256, 2048 / 128, G, bx); pg8::EpiUp8<false> E{kv, sq, ropeM, k8np};
          pg8::gemm_phase_f8p<pg8::EpiUp8<false>, pg8::DenseOrder>(lds, g, S, E); }
#else
        { pg8::Gemm g{cq, Bt_uq, QL}; pg8::DenseOrder S; S.init(T / 256, 1536 / 256, G, G - 1 - bx); pg8::EpiUp<true> E{qm, sq, ropeM, q8p};
          pg8::gemm_phase<pg8::EpiUp<true>, pg8::DenseOrder, false, true>(lds, g, S, E); }
        { pg8::Gemm g{ckv, Bt_ukv, KVL}; pg8::DenseOrder S; S.init(T / 256, 2048 / 256, G, bx); pg8::EpiUp<false> E{kv, sq, ropeM, k8np};
          pg8::gemm_phase<pg8::EpiUp<false>, pg8::DenseOrder, false, true>(lds, g, S, E); }
#endif
    }
    SEAM(2);
    if (IN(3)) {
        KARGS();
        const int wid = wave;
#define UNIT_DECODE(L) int u = (L) & 511; if (G == 256) { const int c = (L) & 255; u = ((L) & 256) + (c & 7) * 32 + (c >> 3); } \
            const int bh = u >> 4, qb = u & 15, b = bh >> 3, h = bh & 7; const size_t q0 = (size_t)b * SEQ + qb * 256, k0 = (size_t)b * SEQ
        for (int L = bx; L < 1024; L += G) {
#if PROBE_PHASE == 3 && defined(PROBE_ATT)
            if (args.li == 1 && lo == 3 && PROBE_ATT != 0) continue;
#endif
            int u = L; if (G == 256) { const int c = L & 255; u = (L & ~255) + (c & 7) * 32 + (c >> 3); }
            const int bh = u >> 5, qb = u & 31, b = bh >> 3, h = bh & 7; const size_t q0 = (size_t)b * SEQ + qb * 128, k0 = (size_t)b * SEQ;
            f32x16 o[4];
#if DA_QK8 == 2
            { att::SrcDH inh{qa + q0 * 1024 + h * 128, ka + k0 * 1024 + h * 128, q8ap + q0 * 1024 + h * 128, k8ap + k0 * 1024 + h * 128, va + k0 * 1024 + h * 128, 1024};
              if (wid < 4) att::attn_core_plh<0>(inh, 8.f * 1.4426950408889634f, SEQ, (LAS char*)lds, o, (PROBE_T == 2 && L == 0) ? (float*)((unsigned*)(AWS + WS_CTL) + CW_PROBE) : nullptr);
              else att::attn_core_plh<1>(inh, 8.f * 1.4426950408889634f, SEQ, (LAS char*)lds, o, nullptr); }
#elif DA_QK8
            { att::SrcD8 in8{q8ap + q0 * 1024 + h * 128, k8ap + k0 * 1024 + h * 128, va + k0 * 1024 + h * 128, 1024};
              att::attn_core_pl8(in8, 8.f * 1.4426950408889634f, SEQ, (LAS char*)lds, o, (PROBE_T == 2 && L == 0) ? (float*)((unsigned*)(AWS + WS_CTL) + CW_PROBE) : nullptr); }
#else
            { att::Src in{qa + q0 * 1024 + h * 128, ka + k0 * 1024 + h * 128, nullptr, va + k0 * 1024 + h * 128, 1024, 1024, 0, 1024};
              att::attn_core_pl<64, 2>(in, 0.125f * 1.4426950408889634f, 8.f * 1.4426950408889634f, SEQ, (LAS char*)lds, o, (PROBE_T && PROBE_T < 4 && L == 0) ? (float*)((unsigned*)(AWS + WS_CTL) + CW_PROBE) : nullptr); }
#endif
            int ln2; asm volatile("v_and_b32 %0, 63, %1" : "=v"(ln2) : "v"(threadIdx.x));
            LAS float* xch = (LAS float*)lds;
            if (wid >= 4) {
#pragma unroll
                for (int d = 0; d < 4; ++d)
#pragma unroll
                    for (int r = 0; r < 16; ++r) xch[((wid - 4) * 64 + d * 16 + r) * 64 + ln2] = o[d][r];
            }
            __syncthreads();
            if (wid < 4) {
            float lam;
            { const float* lq1 = (const float*)AIN(4); const float* lk1 = (const float*)AIN(5); const float* lq2 = (const float*)AIN(6); const float* lk2 = (const float*)AIN(7);
              const float s1 = wave_sum(lq1[ln2] * lk1[ln2]), s2 = wave_sum(lq2[ln2] * lk2[ln2]); lam = __expf(s1) - __expf(s2) + LAM_INIT; }
            float ss[16];
#pragma unroll
            for (int r = 0; r < 16; ++r) ss[r] = 0.f;
#pragma unroll
            for (int d = 0; d < 4; ++d)
#pragma unroll
                for (int r = 0; r < 16; ++r) { const float v = o[d][r] - lam * xch[(wid * 64 + d * 16 + r) * 64 + ln2]; o[d][r] = v; ss[r] += v * v; }
#pragma unroll
            for (int r = 0; r < 16; ++r) {
#pragma unroll
                for (int msk = 1; msk < 32; msk <<= 1) ss[r] += __shfl_xor(ss[r], msk);
                ss[r] = __builtin_amdgcn_rsqf(ss[r] * (1.0f / 128.0f) + EPS); }
            const int hi2 = ln2 >> 5, r32e = ln2 & 31;
            bf16_t* Ow = oa + (q0 + wid * 32 + 4 * hi2) * 1024 + h * 128 + r32e;
            float gs[4];
#pragma unroll
            for (int d = 0; d < 4; ++d) gs[d] = ((const float*)AIN(8))[d * 32 + r32e] * (1.0f - LAM_INIT);
#pragma unroll
            for (int r = 0; r < 16; ++r) { const int orow = att::crow(r, 0);
#pragma unroll
                for (int d = 0; d < 4; ++d) Ow[orow * 1024 + d * 32] = (bf16_t)(cvt_pk_bf16(o[d][r] * ss[r] * gs[d], 0.f) & 0xffffu); }
            }
            __syncthreads();
        }
        for (int L = 512 + bx; L < 1024; L += G) {
#if PROBE_PHASE == 3 && defined(PROBE_ATT)
            if (args.li == 1 && lo == 3 && PROBE_ATT != 1) continue;
#endif
            UNIT_DECODE(L);
            f32x16 o[4];
#if MLA_QK8
            { att::Src8 in8{q8p + q0 * 1536 + h * 192, k8np + k0 * 1024 + h * 128, k8rp + k0 * 64, kv + k0 * 2048 + h * 256 + 128, 2048};
              att::attn_core_bp8(in8, 8.f * 1.4426950408889634f, SEQ, (LAS char*)lds, o, (PROBE_T == 5 && L == 512) ? (float*)((unsigned*)(AWS + WS_CTL) + CW_PROBE) : nullptr); }
#else
            { att::Src in{qm + q0 * 1536 + h * 192, kv + k0 * 2048 + h * 256, kr + k0 * 64, kv + k0 * 2048 + h * 256 + 128, 1536, 2048, 64, 2048};
              att::attn_core_bp<192, 1>(in, 8.f * 1.4426950408889634f, SEQ, (LAS char*)lds, o, (PROBE_T == 5 && L == 512) ? (float*)((unsigned*)(AWS + WS_CTL) + CW_PROBE) : nullptr); }
#endif
#if PROBE_T == 6
            const unsigned long long te0 = __builtin_amdgcn_s_memtime();
#endif
            int ln2; asm volatile("v_and_b32 %0, 63, %1" : "=v"(ln2) : "v"(threadIdx.x));
            const int hi2 = ln2 >> 5, r32e = ln2 & 31;
            bf16_t* Ow = ob + (q0 + wid * 32 + 4 * hi2) * 1024 + h * 128 + r32e;
#pragma unroll
            for (int r = 0; r < 16; ++r) { const int orow = att::crow(r, 0);
#pragma unroll
                for (int d = 0; d < 4; ++d) Ow[orow * 1024 + d * 32] = (bf16_t)(cvt_pk_bf16(o[d][r], 0.f) & 0xffffu); }
#if PROBE_T == 6
            asm volatile("s_waitcnt vmcnt(0)" ::: "memory");
            { const unsigned long long te1 = __builtin_amdgcn_s_memtime(); if (L == 512 && tid == 0) { float* pr = (float*)((unsigned*)(AWS + WS_CTL) + CW_PROBE); pr[0] = 0.f; pr[1] = (float)(te1 - te0) * 0.002f; } }
#endif
        }
#undef UNIT_DECODE
    }
    SEAM(3);
    if (IN(4)) {
        KARGS();
        { pg8::Gemm g{oa, Bt_od, D}; pg8::DenseOrder S; S.init(T / 256, 4, G, bx); pg8::EpiGate<0> E{mrg, gates};
          pg8::gemm_phase<pg8::EpiGate<0>, pg8::DenseOrder, false, true>(lds, g, S, E); }
        VM_WAIT(); __syncthreads();
        { pg8::Gemm g{ob, Bt_om, D}; pg8::DenseOrder S; S.init(T / 256, 4, G, bx); pg8::EpiGate<1> E{mrg, gates};
          pg8::gemm_phase<pg8::EpiGate<1>, pg8::DenseOrder, false, true>(lds, g, S, E); }
    }
    SEAM(4);
    if (IN(5)) {
        KARGS();
        pg8::Gemm g{mrg, Bt_out, D}; pg8::DenseOrder S; S.init(T / 256, 4, G, bx); pg8::EpiRes E{xin, x1b};
        pg8::gemm_phase<pg8::EpiRes, pg8::DenseOrder, false, true>(lds, g, S, E);
    }
    SEAM(5);
    if (IN(6)) {
        KARGS();
        LANE_DECL;
        const float* g_ffn = (const float*)AIN(17); const float* w_router = (const float*)AIN(18); const float* b_router = (const float*)AIN(19);
        constexpr int WRS = 1028;
        LAS float* wr_l = (LAS float*)lds;
        LAS int* lcount = (LAS int*)(lds + TAB_OFF + 1024); LAS int* gbase = lcount + 32; LAS unsigned* asg_e = (LAS unsigned*)(lcount + 64); LAS float* asg_w = (LAS float*)(lcount + 64 + 256);
        LAS int* sync_w = (LAS int*)(lds + TAB_OFF + 512);
        for (int i = tid; i < D * NEXP; i += 512) wr_l[(i & 31) * WRS + (i >> 5)] = w_router[i];
        if (tid < 32) lcount[tid] = 0;
        if (tid < 2) sync_w[tid] = 0;
        __syncthreads();
        const int ex = (lane >> 1) & 31;
        LAS float* lg = (LAS float*)(lds + TAB_OFF + 4096) + wave * 80;
        const int chunk = bx;
        if (wave < 4 && chunk < T / 64) {
            const float my_b = b_router[ex];
#pragma unroll 1
            for (int j2 = 0; j2 < 8; ++j2) {
                const int tl = wave * 16 + j2 * 2, t = chunk * 64 + tl;
                f32x4 xva[4], xvb[4]; float sa = 0.f, sb = 0.f;
                { const u32x2* xa = (const u32x2*)(x1b + (size_t)t * D) + lane; const u32x2* xb = xa + D / 4;
#pragma unroll
                  for (int j = 0; j < 4; ++j) { const u32x2 wa = xa[64 * j], wb = xb[64 * j]; xva[j] = (f32x4){bf_lo(wa.x), bf_hi(wa.x), bf_lo(wa.y), bf_hi(wa.y)}; xvb[j] = (f32x4){bf_lo(wb.x), bf_hi(wb.x), bf_lo(wb.y), bf_hi(wb.y)}; }
#pragma unroll
                  for (int j = 0; j < 4; ++j) { sa += (xva[j][0] * xva[j][0] + xva[j][1] * xva[j][1]) + (xva[j][2] * xva[j][2] + xva[j][3] * xva[j][3]); sb += (xvb[j][0] * xvb[j][0] + xvb[j][1] * xvb[j][1]) + (xvb[j][2] * xvb[j][2] + xvb[j][3] * xvb[j][3]); } }
                const float ra = __builtin_amdgcn_rsqf(wave_sum(sa) * (1.f / D) + EPS), rb = __builtin_amdgcn_rsqf(wave_sum(sb) * (1.f / D) + EPS);
                { unsigned* oa8 = (unsigned*)((unsigned char*)h2 + (size_t)t * D) + lane; unsigned* ob8 = oa8 + D / 4;
#pragma unroll
                  for (int j = 0; j < 4; ++j) { const f32x4 gg = *((const f32x4*)g_ffn + lane + 64 * j); xva[j] = xva[j] * ra * gg; xvb[j] = xvb[j] * rb * gg;
                    oa8[64 * j] = cvt_pk_fp8x4(xva[j][0], xva[j][1], xva[j][2], xva[j][3]); ob8[64 * j] = cvt_pk_fp8x4(xvb[j][0], xvb[j][1], xvb[j][2], xvb[j][3]); } }
                float aa[32], ab[32];
#pragma unroll
                for (int e = 0; e < NEXP; ++e) { float a = 0.f, b = 0.f;
#pragma unroll
                    for (int j = 0; j < 4; ++j) { const f32x4 w4 = *(const LAS f32x4*)(wr_l + e * WRS + 4 * lane + 256 * j);
                        a += (xva[j][0] * w4[0] + xva[j][1] * w4[1]) + (xva[j][2] * w4[2] + xva[j][3] * w4[3]); b += (xvb[j][0] * w4[0] + xvb[j][1] * w4[1]) + (xvb[j][2] * w4[2] + xvb[j][3] * w4[3]); }
                    aa[e] = a; ab[e] = b; }
#define TRED(arr, n, msk) _Pragma("unroll") for (int i_ = 0; i_ < (n); ++i_) { const bool up_ = (lane & (msk)) != 0; const float keep_ = up_ ? arr[(n) + i_] : arr[i_], give_ = up_ ? arr[i_] : arr[(n) + i_]; arr[i_] = keep_ + __shfl_xor(give_, (msk)); }
                TRED(aa, 16, 32) TRED(aa, 8, 16) TRED(aa, 4, 8) TRED(aa, 2, 4) TRED(aa, 1, 2)
                TRED(ab, 16, 32) TRED(ab, 8, 16) TRED(ab, 4, 8) TRED(ab, 2, 4) TRED(ab, 1, 2)
#undef TRED
                const float la = aa[0] + __shfl_xor(aa[0], 1) + my_b, lb = ab[0] + __shfl_xor(ab[0], 1) + my_b;
#pragma unroll
                for (int tk = 0; tk < 2; ++tk) {
                    const float v = tk ? lb : la; int rank = 0;
                    if (!(lane & 1)) lg[tk * 32 + ex] = v;
                    LDS_WAIT();
#pragma unroll
                    for (int q = 0; q < 8; ++q) { const f32x4 s4 = *(const LAS f32x4*)(lg + tk * 32 + 4 * q);
#pragma unroll
                        for (int jj = 0; jj < 4; ++jj) rank += (s4[jj] > v || (s4[jj] == v && (4 * q + jj) < ex)) ? 1 : 0; }
                    if (rank < 4 && !(lane & 1)) lg[64 + tk * 4 + rank] = v;
                    LDS_WAIT();
                    const f32x4 tv = *(const LAS f32x4*)(lg + 64 + tk * 4);
                    const float p1 = __expf(tv[1] - tv[0]), p2 = __expf(tv[2] - tv[0]), p3 = __expf(tv[3] - tv[0]), inv = 1.0f / (1.0f + p1 + p2 + p3);
                    if (rank < 4 && !(lane & 1)) { const float w = (rank == 0 ? 1.0f : (rank == 1 ? p1 : (rank == 2 ? p2 : p3))) * inv;
                        const int lr = __hip_atomic_fetch_add((LAS int*)&lcount[ex], 1, __ATOMIC_RELAXED, __HIP_MEMORY_SCOPE_WORKGROUP);
                        asg_e[(tl + tk) * 4 + rank] = ((unsigned)ex << 16) | (unsigned)lr; asg_w[(tl + tk) * 4 + rank] = w; }
                }
            }
            LDS_WAIT();
            if (lane == 0) __hip_atomic_fetch_add((LAS int*)&sync_w[0], 1, __ATOMIC_RELAXED, __HIP_MEMORY_SCOPE_WORKGROUP);
            if (wave == 0) {
                while (__hip_atomic_load((LAS int*)&sync_w[0], __ATOMIC_RELAXED, __HIP_MEMORY_SCOPE_WORKGROUP) < 4) __builtin_amdgcn_s_sleep(4);
                asm volatile("s_waitcnt lgkmcnt(0)" ::: "memory");
                if (lane < 32) gbase[lane] = (int)__hip_atomic_fetch_add(count + lane, (unsigned)lcount[lane], __ATOMIC_RELAXED, __HIP_MEMORY_SCOPE_AGENT);
                LDS_WAIT();
#pragma unroll
                for (int q = 0; q < 4; ++q) { const int a_ = q * 64 + lane; const unsigned ae = asg_e[a_]; const int e = ae >> 16, rank = gbase[e] + (int)(ae & 0xffffu); const int t = chunk * 64 + (a_ >> 2);
                    rowtok_p[e * T + rank] = t; u32x2 av; av.x = ((unsigned)e << 16) | (unsigned)rank; av.y = __float_as_uint(asg_w[a_]); assign[(size_t)t * 4 + (a_ & 3)] = av; }
            }
        }
        const float* w_gate = (const float*)AIN(20); const float* w_up = (const float*)AIN(22); const float* w_down = (const float*)AIN(24);
        const int per_wg = (NEXP * 768 + G - 1) / G;
        for (;;) {
            int it = 0; if (lane == 0) it = __hip_atomic_fetch_add((LAS int*)&sync_w[1], 1, __ATOMIC_RELAXED, __HIP_MEMORY_SCOPE_WORKGROUP);
            it = __builtin_amdgcn_readfirstlane(it); const int item = bx * per_wg + it;
            if (it >= per_wg || item >= NEXP * 768) break;
            const int e = item / 768, r = item % 768, mat = r >> 8, kb = (r >> 4) & 15, nb = r & 15, f0 = nb * 64;
            if (mat == 0) cvt_tile64<3, true>(w_gate + (size_t)e * D * FF, FF, (bf16_t*)((unsigned char*)Bt_gu + (size_t)e * 2048 * D), D, kb * 64, f0, 2 * f0, lane);
            else if (mat == 1) cvt_tile64<4, true>(w_up + (size_t)e * D * FF, FF, (bf16_t*)((unsigned char*)Bt_gu + (size_t)e * 2048 * D), D, kb * 64, f0, 2 * f0, lane);
            else cvt_tile64<0, true>(w_down + (size_t)e * FF * D, D, (bf16_t*)((unsigned char*)Bt_d + (size_t)e * D * FF), FF, kb * 64, f0, f0, lane);
        }
    }
    SEAM(6);
    LAS int* t_cnt = (LAS int*)(lds + TAB_OFF + 4096); LAS int* t_start = t_cnt + 32; LAS int* t_t2e = t_start + 40;
    if (IN(7) || IN(8) || IN(9)) {
        KARGS();
        __syncthreads();
        if (tid < 32) t_cnt[tid] = (int)__hip_atomic_load(count + tid, __ATOMIC_RELAXED, __HIP_MEMORY_SCOPE_AGENT);
        __syncthreads();
        if (tid == 0) { int s = 0; for (int e = 0; e < NEXP; ++e) { t_start[e] = s; s += (t_cnt[e] + 255) >> 8; } t_start[32] = s; }
        __syncthreads();
        if (tid < 32) { for (int rt = t_start[tid]; rt < t_start[tid + 1]; ++rt) t_t2e[rt] = tid; }
        __syncthreads();
    }
    if (IN(7)) {
        KARGS();
        pg8::Gemm g{h2, Bt_gu, D / 2}; pg8::MoeOrder S; S.init(__builtin_amdgcn_readfirstlane(t_start[32]), 16, G, bx); S.t2e = t_t2e; S.tstart = t_start; S.cnt = t_cnt; S.rowtok = rowtok_p;
        pg8::EpiSwiglu8 E{(unsigned char*)act, (const float*)AIN(21), (const float*)AIN(23)};
        pg8::gemm_phase_f8p<pg8::EpiSwiglu8, pg8::MoeOrder, true>(lds, g, S, E);
    }
    SEAM(7);
    if (IN(8)) {
        KARGS();
        pg8::Gemm g{act, Bt_d, FF / 2}; pg8::MoeOrder S; S.init(__builtin_amdgcn_readfirstlane(t_start[32]), 8, G, bx); S.t2e = t_t2e; S.tstart = t_start; S.cnt = t_cnt; S.rowtok = rowtok_p;
        pg8::EpiDown8 E{ybuf, (const float*)AIN(25)};
        pg8::gemm_phase_f8p<pg8::EpiDown8, pg8::MoeOrder>(lds, g, S, E);
    }
    SEAM(8);
    if (IN(9) && DBG_OUT) {
        KARGS();
        const bf16_t* src = DBG_OUT == 1 ? gates : DBG_OUT == 2 ? gates + 1024 : DBG_OUT == 3 ? qa : DBG_OUT == 4 ? ka : DBG_OUT == 5 ? va : DBG_OUT == 6 ? mrg : DBG_OUT == 7 ? oa : DBG_OUT == 9 ? Bt_in : ob;
        const int ld = DBG_OUT <= 2 ? 2048 : 1024;
        for (size_t i = (size_t)bx * 512 + tid; i < (size_t)T * 1024; i += (size_t)G * 512) AOUT[i] = (DBG_OUT == 9 && i >= (size_t)N_IN * 1024) ? 0.f : __uint_as_float((unsigned)src[(i >> 10) * ld + (i & 1023)] << 16);
    } else
    if (IN(9)) {
        KARGS();
        LANE_DECL;
        const float* g_fin = (const float*)AIN(26);
        for (int t0 = gw * 2; t0 < T; t0 += NGW * 2) {
            f32x4 v[2][4]; u32x2 as_[2][4];
#pragma unroll
            for (int q = 0; q < 2; ++q) { const u32x2* xr = (const u32x2*)(x1b + (size_t)(t0 + q) * D) + lane;
#pragma unroll
                for (int j = 0; j < 4; ++j) { const u32x2 w = xr[64 * j]; v[q][j] = (f32x4){bf_lo(w.x), bf_hi(w.x), bf_lo(w.y), bf_hi(w.y)}; }
#pragma unroll
                for (int k = 0; k < 4; ++k) as_[q][k] = assign[(size_t)(t0 + q) * 4 + k]; }
            unsigned yw[2][4][4];
#pragma unroll
            for (int q = 0; q < 2; ++q)
#pragma unroll
                for (int k = 0; k < 4; ++k) { const int e = as_[q][k].x >> 16, rank = as_[q][k].x & 0xffffu;
                    const unsigned* yr = (const unsigned*)(ybuf + ((size_t)t_start[e] * 256 + rank) * D) + lane;
#pragma unroll
                    for (int j = 0; j < 4; ++j) yw[q][k][j] = yr[64 * j]; }
#pragma unroll
            for (int q = 0; q < 2; ++q) {
#pragma unroll
                for (int k = 0; k < 4; ++k) { const float w = (DBG_SKIP & 1) ? 0.f : __uint_as_float(as_[q][k].y) * (1.0f / YS);
#pragma unroll
                    for (int j = 0; j < 4; ++j) { const int y = (int)yw[q][k][j]; const auto lo = __builtin_amdgcn_cvt_pk_f32_fp8(y, false), hi = __builtin_amdgcn_cvt_pk_f32_fp8(y, true);
                        v[q][j][0] += w * lo[0]; v[q][j][1] += w * lo[1]; v[q][j][2] += w * hi[0]; v[q][j][3] += w * hi[1]; } }
                float s = 0.f;
#pragma unroll
                for (int j = 0; j < 4; ++j) s += (v[q][j][0] * v[q][j][0] + v[q][j][1] * v[q][j][1]) + (v[q][j][2] * v[q][j][2] + v[q][j][3] * v[q][j][3]);
                const float rstd = __builtin_amdgcn_rsqf(wave_sum(s) * (1.f / D) + EPS);
                f32x4* xo = (f32x4*)(AOUT + (size_t)(t0 + q) * D) + lane;
#pragma unroll
                for (int j = 0; j < 4; ++j) { const f32x4 gg = *((const f32x4*)g_fin + lane + 64 * j); f32x4 ov = v[q][j] * rstd * gg;
#if PROBE_T
                    { const float e1 = __builtin_sqrtf(__uint_as_float(xb_ld((unsigned*)(AWS + WS_CTL) + CW_PROBE))), e2 = __uint_as_float(xb_ld((unsigned*)(AWS + WS_CTL) + CW_PROBE + 1));
                      ov[0] *= 1.f + e1; ov[1] *= 1.f - e1; ov[2] *= 1.f + e1; ov[3] *= 1.f - e1; if (t0 + q == 0 && j == 0 && lane == 0) ov[0] += e2; }
#endif
                    xo[64 * j] = ov; } }
        }
    }
#undef IN
#undef SEAM
#undef KARGS
#undef AIN
#undef AOUT
#undef AWS
#undef xin
#undef positions
#undef Bt_in
#undef Bt_uq
#undef Bt_ukv
#undef Bt_od
#undef Bt_om
#undef Bt_out
#undef ropeA
#undef ropeM
#undef sq
#undef hbuf
#undef oa
#undef qa
#undef ka
#undef va
#undef cq
#undef ckv
#undef kr
#undef gates
#undef qm
#undef kv
#undef ob
#undef mrg
#undef stash
#undef rowtok_p
#undef assign
#undef Bt_d
#undef Bt_gu
#undef h2
#undef act
#undef ybuf
#undef q8p
#undef k8np
#undef k8rp
#undef q8ap
#undef k8ap
#undef x1b
#undef count
}

extern "C" void kernel_launch(void* const* d_in, const int* in_sizes, int n_in, void* d_out, int out_size, void* d_ws, size_t ws_size, hipStream_t stream) {
    static int grid = 0;
    if (grid == 0) {
        if (n_in != 27 || in_sizes[0] != T * D || out_size != T * D || ws_size < WS_END) { fprintf(stderr, "kernel_launch: unexpected shapes (n_in %d, in0 %d, out %d, ws %zu < %zu)\n", n_in, n_in > 0 ? in_sizes[0] : -1, out_size, ws_size, (size_t)WS_END); grid = -1; return; }
        int dev = 0, cus = 0, per_cu = 0;
        if (hipGetDevice(&dev) != hipSuccess || hipDeviceGetAttribute(&cus, hipDeviceAttributeMultiprocessorCount, dev) != hipSuccess) { grid = -1; return; }
        if (hipFuncSetAttribute((const void*)fwd, hipFuncAttributeMaxDynamicSharedMemorySize, LDS_BYTES) != hipSuccess) { fprintf(stderr, "kernel_launch: hipFuncSetAttribute failed\n"); grid = -1; return; }
        if (hipOccupancyMaxActiveBlocksPerMultiprocessor(&per_cu, (const void*)fwd, NWAVES * 64, LDS_BYTES) != hipSuccess || per_cu < 1) fprintf(stderr, "kernel_launch: occupancy query says %d\n", per_cu);
        (void)hipGetLastError();
        grid = cus;
    }
    if (grid < 0) return;
    if (hipMemsetAsync((char*)d_ws + WS_CTL, 0, CTL_ZERO_BYTES, stream) != hipSuccess) return;
    Args a{};
    for (int i = 0; i < 27; ++i) a.in[i] = d_in[i];
    a.out = (float*)d_out; a.ws = (unsigned char*)d_ws;
#if MK_PER_PHASE
    for (int p = 0; p < NPHASE; ++p) { a.ph_lo = p; a.ph_hi = p + 1; hipLaunchKernelGGL(fwd, dim3(grid), dim3(NWAVES * 64), LDS_BYTES, stream, a); }
#elif PROBE_PHASE >= 0
    a.ph_lo = 0; a.ph_hi = PROBE_PHASE + 1; a.li = 0; hipLaunchKernelGGL(fwd, dim3(grid), dim3(NWAVES * 64), LDS_BYTES, stream, a);
    a.ph_lo = PROBE_PHASE; a.ph_hi = NPHASE; a.li = 1; hipLaunchKernelGGL(fwd, dim3(grid), dim3(NWAVES * 64), LDS_BYTES, stream, a);
#else
    a.ph_lo = 0; a.ph_hi = NPHASE; hipLaunchKernelGGL(fwd, dim3(grid), dim3(NWAVES * 64), LDS_BYTES, stream, a);
#endif
}
```

```cpp
#include <hip/hip_runtime.h>
#include <cstdio>
#include <cstdint>

#ifndef MK_PER_PHASE
#define MK_PER_PHASE 0
#endif

#ifndef PROBE_PHASE
#define PROBE_PHASE -1
#endif
#ifndef ATT_DUP
#ifndef DMA_SPREAD
#define DMA_SPREAD 1
#endif
#ifndef PROBE_DMA2
#define PROBE_DMA2 0
#endif
#ifndef MLA_QK8
#define MLA_QK8 1
#endif
#ifndef DA_QK8
#define DA_QK8 1
#endif
#ifndef UP_F8
#define UP_F8 1
#endif
#ifndef MLA_PV8
#define MLA_PV8 1
#endif
#ifndef BP_VLA
#define BP_VLA 3
#endif
#ifndef BP_KLA
#define BP_KLA 2
#endif
#ifndef PROBE_BASE
#define PROBE_BASE 1000.f
#endif
#ifndef PROBE_T
#define PROBE_T 0
#endif
#define ATT_DUP 0
#endif
#ifndef DBG_OUT
#define DBG_OUT 0
#endif
#ifndef DBG_SKIP
#define DBG_SKIP 0
#endif
#ifndef ATT_MASK
#define ATT_MASK 3
#endif
#ifndef PH_MASK
#define PH_MASK 0x3ff
#endif
#define LAS __attribute__((address_space(3)))
#define GAS __attribute__((address_space(1)))
typedef unsigned short bf16_t;
typedef short bf16x8 __attribute__((ext_vector_type(8)));
typedef short s16x4 __attribute__((ext_vector_type(4)));
typedef float f32x2 __attribute__((ext_vector_type(2)));
typedef float f32x4 __attribute__((ext_vector_type(4)));
typedef float f32x16 __attribute__((ext_vector_type(16)));
typedef unsigned u32x2 __attribute__((ext_vector_type(2)));
typedef unsigned u32x4 __attribute__((ext_vector_type(4)));

constexpr int NB = 4, SEQ = 4096, T = NB * SEQ, D = 1024;
constexpr int NEXP = 32, TOPK = 4, FF = 1024;
constexpr int N_IN = 6656;
constexpr int QL = 768, KVL = 512;
constexpr float EPS = 1e-6f;
constexpr float LAM_INIT = 0.2f;
constexpr int NPHASE = 10;

constexpr size_t MiB = 1u << 20;
constexpr size_t WS_CTL = 0, CTL_ZERO_BYTES = 1 * MiB;
constexpr size_t WS_BT_IN = 2 * MiB;
constexpr size_t WS_BT_UQ = 15 * MiB;
constexpr size_t WS_BT_UKV = 18 * MiB;
constexpr size_t WS_BT_OD = 20 * MiB, WS_BT_OM = 22 * MiB, WS_BT_OUT = 24 * MiB;
constexpr size_t WS_ROPEA = 26 * MiB;
constexpr size_t WS_ROPEM = 27 * MiB;
constexpr size_t WS_SQ = 31 * MiB;
constexpr size_t WS_SQP = 1 * MiB;
constexpr size_t WS_H = 32 * MiB;
constexpr size_t WS_QA = 64 * MiB, WS_KA = 96 * MiB, WS_VA = 128 * MiB;
constexpr size_t WS_X1B = 168 * MiB;
constexpr size_t WS_CQ = 160 * MiB, WS_CKV = 184 * MiB, WS_KR = 200 * MiB;
constexpr size_t WS_SQ2 = 202 * MiB;
constexpr size_t WS_GATES = 208 * MiB;
constexpr size_t WS_QM = 272 * MiB;
constexpr size_t WS_Q8 = 448 * MiB;
constexpr size_t WS_K8N = 472 * MiB;
constexpr size_t WS_Q8A = 416 * MiB;
constexpr size_t WS_K8A = 432 * MiB;
constexpr size_t WS_V8 = 304 * MiB;
constexpr size_t WS_VT8 = 320 * MiB;
constexpr size_t WS_K8R = 488 * MiB;
constexpr size_t WS_KV = 320 * MiB;
constexpr size_t WS_OB = 384 * MiB;
constexpr size_t WS_MRG = 416 * MiB;
constexpr size_t WS_STASH = 448 * MiB;
constexpr size_t WS_ROWTOK = 2 * MiB;
constexpr size_t WS_ASSIGN = 4 * MiB;
constexpr size_t WS_BT_D = 32 * MiB;
constexpr size_t WS_BT_GU = 96 * MiB;
constexpr size_t WS_H2 = 224 * MiB;
constexpr size_t WS_ACT = 256 * MiB;
constexpr size_t WS_Y = 96 * MiB;
constexpr size_t WS_END = 512 * MiB;
constexpr int CW_COUNT = 64;
constexpr int CW_BAR = 4096;
constexpr int CW_PROBE = 128;

constexpr int RING_BYTES = 147456;
constexpr int TAB_OFF = RING_BYTES;
constexpr int TAB_BYTES = 8192;
constexpr int MISC_OFF = TAB_OFF + TAB_BYTES;
constexpr int LDS_BYTES = 157696;

typedef __bf16 bf16x2_t __attribute__((ext_vector_type(2)));
__device__ __forceinline__ unsigned cvt_pk_bf16(float lo, float hi) { const f32x2 v = {lo, hi}; return __builtin_bit_cast(unsigned, __builtin_convertvector(v, bf16x2_t)); }
__device__ __forceinline__ float bf_lo(unsigned w) { return __uint_as_float(w << 16); }
__device__ __forceinline__ float bf_hi(unsigned w) { return __uint_as_float(w & 0xffff0000u); }
__device__ __forceinline__ float wave_sum(float v) {
#pragma unroll
    for (int o = 1; o < 64; o <<= 1) v += __shfl_xor(v, o);
    return v;
}
__device__ __forceinline__ float sigmoidf_(float x) { return __builtin_amdgcn_rcpf(1.0f + __builtin_amdgcn_exp2f(-1.4426950408889634f * x)); }
__device__ __forceinline__ unsigned cvt_pk_fp8x4(float a, float b, float c, float d) {
    a = fminf(fmaxf(a, -448.f), 448.f); b = fminf(fmaxf(b, -448.f), 448.f); c = fminf(fmaxf(c, -448.f), 448.f); d = fminf(fmaxf(d, -448.f), 448.f);
    int r = __builtin_amdgcn_cvt_pk_fp8_f32(a, b, 0, false); r = __builtin_amdgcn_cvt_pk_fp8_f32(c, d, r, true); return (unsigned)r; }
#define LDS_WAIT() asm volatile("s_waitcnt lgkmcnt(0)" ::: "memory")
#define VM_WAIT() asm volatile("s_waitcnt vmcnt(0)" ::: "memory")

#define XB_TMO      128
#define XB_XCNT(j)  (256  + 64 * (j))
#define XB_XSUB(j)  (1280 + 64 * (j))
#define XB_XGEN(j)  (2304 + 64 * (j))
#define XB_TOP      3328
#define XB_TOPGEN   3392
#define XCD_BAR_WORDS 3456
#define XB_SPIN_CAP (1u << 20)
__device__ __forceinline__ unsigned xb_ld(unsigned* p)              { return __hip_atomic_load(p, __ATOMIC_RELAXED, __HIP_MEMORY_SCOPE_AGENT); }
__device__ __forceinline__ unsigned xb_add(unsigned* p, unsigned v) { return __hip_atomic_fetch_add(p, v, __ATOMIC_RELAXED, __HIP_MEMORY_SCOPE_AGENT); }
__device__ __forceinline__ unsigned xb_xcc_id() { return (unsigned)__builtin_amdgcn_s_getreg((3 << 11) | 20) & 0xFu; }
#define XB_SPIN(cond, bar) do { unsigned _sp = 0; while (cond) { __builtin_amdgcn_s_sleep(1); \
    if ((++_sp & 255u) == 0u) { if (xb_ld(&(bar)[XB_TMO])) break; if (_sp > XB_SPIN_CAP) { atomicAdd(&(bar)[XB_TMO], 1u); break; } } } } while (0)
struct XcdBarrier { unsigned* bar; unsigned x; volatile LAS unsigned* st; };
__device__ __forceinline__ XcdBarrier xcd_barrier_post(unsigned* bar, volatile LAS unsigned* st) {
    XcdBarrier b; b.bar = bar; b.x = xb_xcc_id(); b.st = st;
    if (threadIdx.x == 0) (void)xb_add(&bar[XB_XCNT(b.x)], 1u);
    return b;
}
__device__ __forceinline__ void xcd_barrier_complete(unsigned* bar, unsigned x, unsigned& nloc, unsigned& nx) {
    const unsigned G = gridDim.x * gridDim.y * gridDim.z;
    unsigned sum, cnt, mine, sp = 0u;
    for (;;) {
        sum = 0u; cnt = 0u; mine = 0u;
#pragma unroll
        for (unsigned j = 0; j < 16; ++j) { const unsigned c = xb_ld(&bar[XB_XCNT(j)]); sum += c; cnt += (c > 0u) ? 1u : 0u; mine = (j == x) ? c : mine; }
        if (sum == G) break;
        __builtin_amdgcn_s_sleep(1);
        if ((++sp & 255u) == 0u) { if (xb_ld(&bar[XB_TMO])) break; if (sp > XB_SPIN_CAP) { atomicAdd(&bar[XB_TMO], 1u); break; } }
    }
    nloc = mine > 0u ? mine : 1u; nx = cnt > 0u ? cnt : 1u;
}
__device__ __forceinline__ void xcd_barrier(const XcdBarrier& b) {
    asm volatile("s_waitcnt vmcnt(0)" ::: "memory");
    __syncthreads();
    if (threadIdx.x == 0) {
        unsigned* bar = b.bar;
        __builtin_amdgcn_s_waitcnt(0);
        unsigned nloc = b.st[0], nx = b.st[1];
        if (nloc == 0u) { xcd_barrier_complete(bar, b.x, nloc, nx); b.st[0] = nloc; b.st[1] = nx; }
        const unsigned old = xb_add(&bar[XB_XSUB(b.x)], 1u);
        const unsigned gen = old / nloc;
        if (old + 1u == (gen + 1u) * nloc) {
            __builtin_amdgcn_fence(__ATOMIC_RELEASE, "agent");
            asm volatile("s_waitcnt vmcnt(0)" ::: "memory");
            const unsigned og = xb_add(&bar[XB_TOP], 1u);
            const unsigned tg = og / nx;
            if (og + 1u == (tg + 1u) * nx) xb_add(&bar[XB_TOPGEN], 1u);
            else XB_SPIN(xb_ld(&bar[XB_TOPGEN]) == tg, bar);
            __builtin_amdgcn_fence(__ATOMIC_ACQUIRE, "agent");
            xb_add(&bar[XB_XGEN(b.x)], 1u);
            asm volatile("s_waitcnt vmcnt(0)" ::: "memory");
        } else {
            XB_SPIN(xb_ld(&bar[XB_XGEN(b.x)]) == gen, bar);
            __builtin_amdgcn_fence(__ATOMIC_ACQUIRE, "agent");
            asm volatile("s_waitcnt vmcnt(0)" ::: "memory");
        }
    }
    __syncthreads();
}

constexpr float YS = 16.0f;
constexpr float QS_MLA = 0.07216878364870322f * 1.4426950408889634f;
constexpr float QS_DA = 0.125f * 1.4426950408889634f;
namespace pg8 {
constexpr int BM = 256, BK = 64, HALF = 128, HTB = HALF * BK * 2, STAGE_BYTES = 8 * HTB, NXCD = 8, WGM = 8;
__host__ __device__ __forceinline__ int lds_byte(int r, int c) { const int st = (r >> 4) * 2 + (c >> 5), rr = r & 15, cc = c & 31, ob = rr * 64 + cc * 2; return st * 1024 + (ob ^ (((ob >> 9) & 1) << 5)); }
__host__ __device__ __forceinline__ void stage_rc(int b, int& R, int& C) { const int st = b / 1024, sb = b % 1024, swz = sb ^ (((sb >> 9) & 1) << 5); R = (st >> 1) * 16 + swz / 64; C = (st & 1) * 32 + (swz % 64) / 2; }
__host__ __device__ __forceinline__ int perm32(int rho) { const int n = rho >> 4, i = rho & 15; return 8 * (i >> 2) + 4 * n + (i & 3); }

struct Unit { int pm, pn, pb, e, rbase, cnt; };
struct Gemm { const bf16_t* A; const bf16_t* Bt; int K; };

struct DenseOrder {
    int nM, nN, nwg, G, c, pn0;
    __device__ void init(int nM_, int nN_, int G_, int c_, int pn0_ = 0) { nM = nM_; nN = nN_; nwg = nM * nN; G = G_; c = c_; pn0 = pn0_; }
    __device__ __forceinline__ bool next(int i, Unit& u) const {
        const long L = (long)i * G + c; if (L >= nwg) return false;
        int wgid = (int)L; { const int q = nwg / NXCD, r = nwg % NXCD, xcd = wgid % NXCD, off = wgid / NXCD; wgid = (xcd < r ? xcd * (q + 1) : r * (q + 1) + (xcd - r) * q) + off; }
        const int nig = WGM * nN, gid = wgid / nig, fm = gid * WGM, gsz = (nM - fm) < WGM ? (nM - fm) : WGM;
        u.pm = fm + ((wgid % nig) % gsz); u.pn = pn0 + (wgid % nig) / gsz; u.pb = u.pn; u.e = 0; u.rbase = 0; u.cnt = 0; return true;
    }
    __device__ __forceinline__ int a_row(const Unit&, int) const { return 0; }
};
struct MoeOrder {
    int nM, nN, nwg, G, c; const LAS int* t2e; const LAS int* tstart; const LAS int* cnt; const int* rowtok;
    __device__ void init(int nM_, int nN_, int G_, int c_) { nM = nM_; nN = nN_; nwg = nM * nN; G = G_; c = c_; }
    __device__ __forceinline__ bool next(int i, Unit& u) const {
        const long L = (long)i * G + c; if (L >= nwg) return false;
        int wgid = (int)L; { const int q = nwg / NXCD, r = nwg % NXCD, xcd = wgid % NXCD, off = wgid / NXCD; wgid = (xcd < r ? xcd * (q + 1) : r * (q + 1) + (xcd - r) * q) + off; }
        const int nig = WGM * nN, gid = wgid / nig, fm = gid * WGM, gsz = (nM - fm) < WGM ? (nM - fm) : WGM;
        u.pm = fm + ((wgid % nig) % gsz); u.pn = (wgid % nig) / gsz;
        const int e = __builtin_amdgcn_readfirstlane(t2e[u.pm]); u.e = e; u.pb = e * nN + u.pn; u.rbase = (u.pm - __builtin_amdgcn_readfirstlane(tstart[e])) * 256; u.cnt = __builtin_amdgcn_readfirstlane(cnt[e]); return true;
    }
    __device__ __forceinline__ int a_row(const Unit& u, int r) const { const int rank = u.rbase + r; return rank < u.cnt ? rowtok[u.e * T + rank] : 0; }
};

template <class Epi, class Sched, bool GATHER, bool ALIGN_EPI>
__device__ __forceinline__ void gemm_phase(LAS unsigned char* lds, const Gemm g, const Sched& S, const Epi& E) {
    const int tid = threadIdx.x, wid = __builtin_amdgcn_readfirstlane(tid >> 6), lane = tid & 63, wr = wid >> 2, wc = wid & 3, fr = lane & 15, fq = lane >> 4;
    const int K = g.K, nt = K / BK;
    unsigned voffA[2], voffB[2]; int Rv[2], Cv[2];
#pragma unroll
    for (int i = 0; i < 2; ++i) { int R, C; stage_rc(tid * 16 + i * 8192, R, C); const int Rb = Epi::PERM ? ((R & ~31) + perm32(R & 31)) : R;
        voffA[i] = (unsigned)(R * K + C) * 2u; voffB[i] = (unsigned)(Rb * K + C) * 2u; Rv[i] = R; Cv[i] = C; }
    const size_t kstep = (size_t)(BK * 2);
    const size_t hstep = (size_t)HALF * K * 2;
    const size_t tstep = 2 * hstep;
    const unsigned ldsw = (unsigned)wid * 1024u;
    const int aoff = lds_byte(wr * 64 + fr, fq * 8), boff = lds_byte(wc * 32 + fr, fq * 8);
#define PG8_SA(b, h) (((b) * 2 + (h)) * HTB)
#define PG8_SB(b, h) ((4 + (b) * 2 + (h)) * HTB)
#define PG8_STAGE(bufoff, gbase, voff) do { _Pragma("unroll") for (int _i = 0; _i < 2; ++_i) \
        __builtin_amdgcn_global_load_lds((const unsigned*)((const char*)(gbase) + (voff)[_i]), (LAS unsigned*)(lds + (bufoff) + ldsw + _i * 8192), 16, 0, 0); } while (0)
#define PG8_LDA(dst, b, h) do { _Pragma("unroll") for (int m = 0; m < 4; ++m) _Pragma("unroll") for (int k = 0; k < 2; ++k) dst[m][k] = *(const LAS bf16x8*)(lds + PG8_SA(b, h) + aoff + m * 2048 + k * 1024); } while (0)
#define PG8_LDB(dst, b, h) do { _Pragma("unroll") for (int n = 0; n < 2; ++n) _Pragma("unroll") for (int k = 0; k < 2; ++k) dst[n][k] = *(const LAS bf16x8*)(lds + PG8_SB(b, h) + boff + n * 2048 + k * 1024); } while (0)
#define PG8_MMA(ai, bj, At, Bt) do { __builtin_amdgcn_s_setprio(1); _Pragma("unroll") for (int m = 0; m < 4; ++m) _Pragma("unroll") for (int n = 0; n < 2; ++n) _Pragma("unroll") for (int k = 0; k < 2; ++k) \
        acc[ai][bj][m][n] = __builtin_amdgcn_mfma_f32_16x16x32_bf16(Bt[n][k], At[m][k], acc[ai][bj][m][n], 0, 0, 0); __builtin_amdgcn_s_setprio(0); } while (0)
#define PG8_WAIT_V(n) asm volatile("s_waitcnt vmcnt(" #n ")" ::: "memory")
#define PG8_WAIT_L(n) asm volatile("s_waitcnt lgkmcnt(" #n ")" ::: "memory")
#define PG8_BAR __builtin_amdgcn_s_barrier()
#define PG8_SCHED __builtin_amdgcn_sched_barrier(0)
    Unit cur, nxt; int ui = 0;
    if (!S.next(0, cur)) return;
    f32x4 acc[2][2][4][2];
#pragma unroll
    for (int a = 0; a < 2; ++a)
#pragma unroll
        for (int b = 0; b < 2; ++b)
#pragma unroll
            for (int m = 0; m < 4; ++m)
#pragma unroll
                for (int n = 0; n < 2; ++n) acc[a][b][m][n] = (f32x4){0.f, 0.f, 0.f, 0.f};
    bf16x8 At[4][2], B0[2][2], B1[2][2];
    unsigned gC0[2], gC1[2], gN0[2], gN1[2];
    if constexpr (GATHER) {
#pragma unroll
        for (int i = 0; i < 2; ++i) { gC0[i] = (unsigned)S.a_row(cur, Rv[i]) * (unsigned)(K * 2) + (unsigned)Cv[i] * 2u; gC1[i] = (unsigned)S.a_row(cur, HALF + Rv[i]) * (unsigned)(K * 2) + (unsigned)Cv[i] * 2u; gN0[i] = gC0[i]; gN1[i] = gC1[i]; }
    }
    const char* cA = GATHER ? (const char*)g.A : (const char*)g.A + (size_t)cur.pm * tstep; const char* cB = (const char*)g.Bt + (size_t)cur.pb * tstep;
#define PG8_STAGE_A(bufoff, p, h, o0, o1) do { if constexpr (GATHER) { if ((h) == 0) PG8_STAGE(bufoff, p, o0); else PG8_STAGE(bufoff, p, o1); } else { PG8_STAGE(bufoff, (p) + (h) * hstep, voffA); } } while (0)
    PG8_STAGE(PG8_SB(0, 0), cB, voffB); PG8_STAGE(PG8_SB(0, 1), cB + hstep, voffB); PG8_STAGE_A(PG8_SA(0, 0), cA, 0, gC0, gC1); PG8_STAGE_A(PG8_SA(0, 1), cA, 1, gC0, gC1);
    if (wr == 1) PG8_BAR;
    PG8_WAIT_V(2); PG8_BAR;
    PG8_STAGE(PG8_SB(1, 0), cB + kstep, voffB); PG8_STAGE_A(PG8_SA(1, 0), cA + kstep, 0, gC0, gC1); PG8_STAGE(PG8_SB(1, 1), cB + hstep + kstep, voffB);
    PG8_WAIT_V(6); PG8_BAR;
    for (;;) {
        const bool has_next = S.next(ui + 1, nxt);
        const char* nA = GATHER ? (const char*)g.A : (has_next ? (const char*)g.A + (size_t)nxt.pm * tstep : cA); const char* nB = has_next ? (const char*)g.Bt + (size_t)nxt.pb * tstep : cB;
        if constexpr (GATHER) { if (has_next) {
#pragma unroll
            for (int i = 0; i < 2; ++i) { gN0[i] = (unsigned)S.a_row(nxt, Rv[i]) * (unsigned)(K * 2) + (unsigned)Cv[i] * 2u; gN1[i] = (unsigned)S.a_row(nxt, HALF + Rv[i]) * (unsigned)(K * 2) + (unsigned)Cv[i] * 2u; } } }
        for (int t = 0; t < nt; t += 2) {
            const bool last = (t == nt - 2);
            const char* a1 = cA + (size_t)(t + 1) * kstep;
            const char* a2 = last ? nA : cA + (size_t)(t + 2) * kstep; const char* b2 = last ? nB : cB + (size_t)(t + 2) * kstep;
            const char* a3 = a2 + kstep; const char* b3 = b2 + kstep;
            unsigned s0[2], s1[2];
            if constexpr (GATHER) { s0[0] = last ? gN0[0] : gC0[0]; s0[1] = last ? gN0[1] : gC0[1]; s1[0] = last ? gN1[0] : gC1[0]; s1[1] = last ? gN1[1] : gC1[1]; }
            PG8_LDB(B0, 0, 0); PG8_LDB(B1, 0, 1); PG8_SCHED; PG8_LDA(At, 0, 0); PG8_STAGE_A(PG8_SA(1, 1), a1, 1, gC0, gC1);
            PG8_WAIT_V(8); PG8_WAIT_L(0); PG8_BAR; PG8_MMA(0, 0, At, B0); PG8_MMA(0, 1, At, B1); PG8_BAR; PG8_SCHED;
            PG8_LDA(At, 0, 1); PG8_STAGE(PG8_SB(0, 0), b2, voffB); PG8_STAGE(PG8_SB(0, 1), b2 + hstep, voffB); PG8_STAGE_A(PG8_SA(0, 0), a2, 0, s0, s1);
            PG8_WAIT_V(8); PG8_WAIT_L(0); PG8_BAR; PG8_MMA(1, 0, At, B0); PG8_MMA(1, 1, At, B1); PG8_BAR; PG8_SCHED;
            PG8_LDB(B0, 1, 0); PG8_LDB(B1, 1, 1); PG8_SCHED; PG8_LDA(At, 1, 0); PG8_STAGE_A(PG8_SA(0, 1), a2, 1, s0, s1);
            PG8_WAIT_V(8); PG8_WAIT_L(0); PG8_BAR; PG8_MMA(0, 0, At, B0); PG8_MMA(0, 1, At, B1); PG8_BAR; PG8_SCHED;
            PG8_LDA(At, 1, 1); PG8_STAGE(PG8_SB(1, 0), b3, voffB); PG8_STAGE(PG8_SB(1, 1), b3 + hstep, voffB); PG8_STAGE_A(PG8_SA(1, 0), a3, 0, s0, s1);
            PG8_WAIT_V(8); PG8_WAIT_L(0); PG8_BAR; PG8_MMA(1, 0, At, B0); PG8_MMA(1, 1, At, B1); PG8_BAR; PG8_SCHED;
        }
        if constexpr (ALIGN_EPI) { if (wr == 0) PG8_BAR; }
        E(acc, cur, wr, wc, fr, fq);
        if (!has_next) break;
#pragma unroll
        for (int a = 0; a < 2; ++a)
#pragma unroll
            for (int b = 0; b < 2; ++b)
#pragma unroll
                for (int m = 0; m < 4; ++m)
#pragma unroll
                    for (int n = 0; n < 2; ++n) acc[a][b][m][n] = (f32x4){0.f, 0.f, 0.f, 0.f};
        cur = nxt; cA = nA; cB = nB; ++ui;
        if constexpr (GATHER) { gC0[0] = gN0[0]; gC0[1] = gN0[1]; gC1[0] = gN1[0]; gC1[1] = gN1[1]; }
        if constexpr (ALIGN_EPI) { if (wr == 1) PG8_BAR; }
    }
    PG8_WAIT_V(0);
    if constexpr (!ALIGN_EPI) { if (wr == 0) PG8_BAR; }
    PG8_BAR;
#undef PG8_SA
#undef PG8_SB
#undef PG8_STAGE
#undef PG8_STAGE_A
#undef PG8_LDA
#undef PG8_LDB
#undef PG8_MMA
#undef PG8_WAIT_V
#undef PG8_WAIT_L
#undef PG8_BAR
#undef PG8_SCHED
}

template <class Epi, class Sched, bool GATHER = false>
__device__ __forceinline__ void gemm_phase_f8n(LAS unsigned char* lds, const Gemm g, const Sched& S, const Epi& E) {
    const int tid = threadIdx.x, wid = __builtin_amdgcn_readfirstlane(tid >> 6), lane = tid & 63, wr = wid >> 2, wc = wid & 3, fr = lane & 15, fq = lane >> 4;
    const int K = g.K, nt = K / BK;
    unsigned voffA[2], voffB[2]; int Rv[2], Cv[2];
#pragma unroll
    for (int i = 0; i < 2; ++i) { int R, C; stage_rc(tid * 16 + i * 8192, R, C); const int Rb = (R & ~31) + perm32(R & 31);
        voffA[i] = (unsigned)(R * K + C) * 2u; voffB[i] = (unsigned)(Rb * K + C) * 2u; Rv[i] = R; Cv[i] = C; }
    const size_t kstep = (size_t)(BK * 2), hstep = (size_t)HALF * K * 2, tstep = 2 * hstep;
    const unsigned ldsw = (unsigned)wid * 1024u;
    const int aoff = lds_byte(wr * 64 + fr, fq * 8), boff = lds_byte(wc * 32 + fr, fq * 8);
    typedef int v8i_t __attribute__((ext_vector_type(8))); typedef int v4i_t __attribute__((ext_vector_type(4)));
#define F8_SA(b, h) (((b) * 2 + (h)) * HTB)
#define F8_SB(b) ((4 + (b) * 2) * HTB)
#define F8_STAGE(bufoff, gbase, voff) do { _Pragma("unroll") for (int _i = 0; _i < 2; ++_i) \
        __builtin_amdgcn_global_load_lds((const unsigned*)((const char*)(gbase) + (voff)[_i]), (LAS unsigned*)(lds + (bufoff) + ldsw + _i * 8192), 16, 0, 0); } while (0)
#define F8_LDA(b, h) do { _Pragma("unroll") for (int m = 0; m < 4; ++m) _Pragma("unroll") for (int k = 0; k < 2; ++k) At[m][k] = *(const LAS bf16x8*)(lds + F8_SA(b, h) + aoff + m * 2048 + k * 1024); } while (0)
#define F8_LDB(b) do { _Pragma("unroll") for (int n = 0; n < 2; ++n) _Pragma("unroll") for (int k = 0; k < 2; ++k) B0[n][k] = *(const LAS bf16x8*)(lds + F8_SB(b) + boff + n * 2048 + k * 1024); } while (0)
#define F8_CAT(x0, x1) __builtin_shufflevector(__builtin_bit_cast(v4i_t, x0), __builtin_bit_cast(v4i_t, x1), 0, 1, 2, 3, 4, 5, 6, 7)
#define F8_MMA(ai) do { __builtin_amdgcn_s_setprio(1); _Pragma("unroll") for (int m = 0; m < 4; ++m) _Pragma("unroll") for (int n = 0; n < 2; ++n) \
        acc[ai][m][n] = __builtin_amdgcn_mfma_scale_f32_16x16x128_f8f6f4(F8_CAT(B0[n][0], B0[n][1]), F8_CAT(At[m][0], At[m][1]), acc[ai][m][n], 0, 0, 0, 0x79797979, 0, 0x7f7f7f7f); \
        __builtin_amdgcn_s_setprio(0); } while (0)
#define F8_WAIT_V(n) asm volatile("s_waitcnt vmcnt(" #n ")" ::: "memory")
#define F8_WAIT_L(n) asm volatile("s_waitcnt lgkmcnt(" #n ")" ::: "memory")
#define F8_BAR __builtin_amdgcn_s_barrier()
#define F8_SCHED __builtin_amdgcn_sched_barrier(0)
    Unit cur, nxt; int ui = 0;
    if (!S.next(0, cur)) return;
    f32x4 acc[2][4][2];
#pragma unroll
    for (int a = 0; a < 2; ++a)
#pragma unroll
        for (int m = 0; m < 4; ++m)
#pragma unroll
            for (int n = 0; n < 2; ++n) acc[a][m][n] = (f32x4){0.f, 0.f, 0.f, 0.f};
    bf16x8 At[4][2], B0[2][2];
    unsigned gC0[2], gC1[2], gN0[2], gN1[2];
    if constexpr (GATHER) {
#pragma unroll
        for (int i = 0; i < 2; ++i) { gC0[i] = (unsigned)S.a_row(cur, Rv[i]) * (unsigned)(K * 2) + (unsigned)Cv[i] * 2u; gC1[i] = (unsigned)S.a_row(cur, HALF + Rv[i]) * (unsigned)(K * 2) + (unsigned)Cv[i] * 2u; gN0[i] = gC0[i]; gN1[i] = gC1[i]; }
    }
    const char* cA = GATHER ? (const char*)g.A : (const char*)g.A + (size_t)cur.pm * tstep; const char* cB = (const char*)g.Bt + (size_t)cur.pb * hstep;
#define F8_STAGE_A(bufoff, p, h, o0, o1) do { if constexpr (GATHER) { if ((h) == 0) F8_STAGE(bufoff, p, o0); else F8_STAGE(bufoff, p, o1); } else { F8_STAGE(bufoff, (p) + (h) * hstep, voffA); } } while (0)
    F8_STAGE(F8_SB(0), cB, voffB); F8_STAGE_A(F8_SA(0, 0), cA, 0, gC0, gC1); F8_STAGE_A(F8_SA(0, 1), cA, 1, gC0, gC1);
    if (wr == 1) F8_BAR;
    F8_WAIT_V(2); F8_BAR;
    F8_STAGE(F8_SB(1), cB + kstep, voffB); F8_STAGE_A(F8_SA(1, 0), cA + kstep, 0, gC0, gC1);
    F8_WAIT_V(4); F8_BAR;
    for (;;) {
        const bool has_next = S.next(ui + 1, nxt);
        const char* nA = GATHER ? (const char*)g.A : (has_next ? (const char*)g.A + (size_t)nxt.pm * tstep : cA); const char* nB = has_next ? (const char*)g.Bt + (size_t)nxt.pb * hstep : cB;
        if constexpr (GATHER) { if (has_next) {
#pragma unroll
            for (int i = 0; i < 2; ++i) { gN0[i] = (unsigned)S.a_row(nxt, Rv[i]) * (unsigned)(K * 2) + (unsigned)Cv[i] * 2u; gN1[i] = (unsigned)S.a_row(nxt, HALF + Rv[i]) * (unsigned)(K * 2) + (unsigned)Cv[i] * 2u; } } }
#pragma unroll 1
        for (int t = 0; t < nt; t += 2) {
            const bool last = (t == nt - 2);
            const char* a1 = cA + (size_t)(t + 1) * kstep;
            const char* a2 = last ? nA : cA + (size_t)(t + 2) * kstep; const char* b2 = last ? nB : cB + (size_t)(t + 2) * kstep;
            const char* a3 = a2 + kstep; const char* b3 = b2 + kstep;
            unsigned s0[2], s1[2];
            if constexpr (GATHER) { s0[0] = last ? gN0[0] : gC0[0]; s0[1] = last ? gN0[1] : gC0[1]; s1[0] = last ? gN1[0] : gC1[0]; s1[1] = last ? gN1[1] : gC1[1]; }
            F8_LDB(0); F8_SCHED; F8_LDA(0, 0); F8_STAGE_A(F8_SA(1, 1), a1, 1, gC0, gC1);
            F8_WAIT_V(6); F8_WAIT_L(0); F8_BAR; F8_MMA(0); F8_BAR; F8_SCHED;
            F8_LDA(0, 1); F8_STAGE(F8_SB(0), b2, voffB); F8_STAGE_A(F8_SA(0, 0), a2, 0, s0, s1);
            F8_WAIT_V(6); F8_WAIT_L(0); F8_BAR; F8_MMA(1); F8_BAR; F8_SCHED;
            F8_LDB(1); F8_SCHED; F8_LDA(1, 0); F8_STAGE_A(F8_SA(0, 1), a2, 1, s0, s1);
            F8_WAIT_V(6); F8_WAIT_L(0); F8_BAR; F8_MMA(0); F8_BAR; F8_SCHED;
            F8_LDA(1, 1); F8_STAGE(F8_SB(1), b3, voffB); F8_STAGE_A(F8_SA(1, 0), a3, 0, s0, s1);
            F8_WAIT_V(6); F8_WAIT_L(0); F8_BAR; F8_MMA(1); F8_BAR; F8_SCHED;
        }
        if (wr == 0) F8_BAR;
        E(acc, cur, wr, wc, fr, fq);
        if (!has_next) break;
#pragma unroll
        for (int a = 0; a < 2; ++a)
#pragma unroll
            for (int m = 0; m < 4; ++m)
#pragma unroll
                for (int n = 0; n < 2; ++n) acc[a][m][n] = (f32x4){0.f, 0.f, 0.f, 0.f};
        cur = nxt; cA = nA; cB = nB; ++ui;
        if constexpr (GATHER) { gC0[0] = gN0[0]; gC0[1] = gN0[1]; gC1[0] = gN1[0]; gC1[1] = gN1[1]; }
        if (wr == 1) F8_BAR;
    }
    F8_WAIT_V(0);
    F8_BAR;
#undef F8_SA
#undef F8_SB
#undef F8_STAGE
#undef F8_LDA
#undef F8_LDB
#undef F8_CAT
#undef F8_MMA
#undef F8_WAIT_V
#undef F8_WAIT_L
#undef F8_BAR
#undef F8_SCHED
#undef F8_STAGE_A
}
template <int I> struct SIC { static constexpr int value = I; };
template <int LO, int HI, class F> __device__ __forceinline__ void ssfor(F&& f) { if constexpr (LO < HI) { f(SIC<LO>{}); ssfor<LO + 1, HI>(f); } }
template <class Epi, class Sched, bool GATHER = false>
__device__ __forceinline__ void gemm_phase_f8p(LAS unsigned char* lds, const Gemm g, const Sched& S, const Epi& E) {
    const int tid = threadIdx.x, wid = __builtin_amdgcn_readfirstlane(tid >> 6), lane = tid & 63, wr = wid >> 2, wc = wid & 3, fr = lane & 15, fq = lane >> 4;
    const int K = g.K, nt = K / BK;
    unsigned voffA[2], voffB[2]; int Rv[2], Cv[2];
#pragma unroll
    for (int i = 0; i < 2; ++i) { int R, C; stage_rc(tid * 16 + i * 8192, R, C); const int Rb = (R & ~31) + perm32(R & 31);
        voffA[i] = (unsigned)(R * K + C) * 2u; voffB[i] = (unsigned)(Rb * K + C) * 2u; Rv[i] = R; Cv[i] = C; }
    const size_t kstep = (size_t)(BK * 2), hstep = (size_t)HALF * K * 2, tstep = 2 * hstep;
    const unsigned ldsw = (unsigned)wid * 1024u;
    const int aoff = lds_byte(wr * 64 + fr, fq * 8), boff = lds_byte(wc * 32 + fr, fq * 8);
    constexpr int STG = 3 * HTB;
    typedef int v8i_t __attribute__((ext_vector_type(8))); typedef int v4i_t __attribute__((ext_vector_type(4)));
#define P8_CAT(x0, x1) __builtin_shufflevector(__builtin_bit_cast(v4i_t, x0), __builtin_bit_cast(v4i_t, x1), 0, 1, 2, 3, 4, 5, 6, 7)
#define P8_GLDS(src, dstoff) __builtin_amdgcn_global_load_lds((const unsigned*)(src), (LAS unsigned*)(lds + (dstoff)), 16, 0, 0)
#define P8_PIECE(p, pa, pb, o0, o1, st) do { constexpr int i_ = (p) & 1; \
        if constexpr ((p) < 2)      { if constexpr (GATHER) P8_GLDS((pa) + (o0)[i_], (st) * STG + ldsw + i_ * 8192); else P8_GLDS((pa) + voffA[i_], (st) * STG + ldsw + i_ * 8192); } \
        else if constexpr ((p) < 4) { if constexpr (GATHER) P8_GLDS((pa) + (o1)[i_], (st) * STG + HTB + ldsw + i_ * 8192); else P8_GLDS((pa) + hstep + voffA[i_], (st) * STG + HTB + ldsw + i_ * 8192); } \
        else                        P8_GLDS((pb) + voffB[i_], (st) * STG + 2 * HTB + ldsw + i_ * 8192); } while (0)
#define P8_WAIT_V(n) asm volatile("s_waitcnt vmcnt(" #n ")" ::: "memory")
#define P8_BAR do { asm volatile("" ::: "memory"); __builtin_amdgcn_s_barrier(); asm volatile("" ::: "memory"); } while (0)
#define P8_SCHED __builtin_amdgcn_sched_barrier(0)
    Unit cur, nxt; int ui = 0;
    if (!S.next(0, cur)) return;
    f32x4 acc[2][4][2];
#pragma unroll
    for (int a = 0; a < 2; ++a)
#pragma unroll
        for (int m = 0; m < 4; ++m)
#pragma unroll
            for (int n = 0; n < 2; ++n) acc[a][m][n] = (f32x4){0.f, 0.f, 0.f, 0.f};
    bf16x8 AX[4][2], AY[4][2], BX[2][2], BY[2][2];
    unsigned gC0[2], gC1[2], gN0[2], gN1[2];
    if constexpr (GATHER) {
#pragma unroll
        for (int i = 0; i < 2; ++i) { gC0[i] = (unsigned)S.a_row(cur, Rv[i]) * (unsigned)(K * 2) + (unsigned)Cv[i] * 2u; gC1[i] = (unsigned)S.a_row(cur, HALF + Rv[i]) * (unsigned)(K * 2) + (unsigned)Cv[i] * 2u; gN0[i] = gC0[i]; gN1[i] = gC1[i]; }
    }
    const char* cA = GATHER ? (const char*)g.A : (const char*)g.A + (size_t)cur.pm * tstep; const char* cB = (const char*)g.Bt + (size_t)cur.pb * hstep;
#define P8_SP(AI, Acur, Anxt, Bcur, Bnxt, RDB, sr, hr, P0, qa, qb, q0, q1, sd) do { \
        ssfor<0, 8>([&](auto gc) __attribute__((always_inline)) { constexpr int g_ = decltype(gc)::value, m_ = g_ >> 1, n_ = g_ & 1; \
            acc[AI][m_][n_] = __builtin_amdgcn_mfma_scale_f32_16x16x128_f8f6f4(P8_CAT(Bcur[n_][0], Bcur[n_][1]), P8_CAT(Acur[m_][0], Acur[m_][1]), acc[AI][m_][n_], 0, 0, 0, 0x79797979, 0, 0x7f7f7f7f); \
            if constexpr (g_ == 0) P8_SCHED;     \
            Anxt[m_][n_] = *(const LAS bf16x8*)(lds + (sr) * STG + (hr) * HTB + aoff + m_ * 2048 + n_ * 1024); \
            if constexpr ((RDB) && g_ < 4) Bnxt[m_][n_] = *(const LAS bf16x8*)(lds + (sr) * STG + 2 * HTB + boff + m_ * 2048 + n_ * 1024); \
            if constexpr (g_ == 1) P8_PIECE((P0) + 0, qa, qb, q0, q1, sd); \
            if constexpr (g_ == 3) P8_PIECE((P0) + 1, qa, qb, q0, q1, sd); \
            if constexpr (g_ == 5) P8_PIECE((P0) + 2, qa, qb, q0, q1, sd); \
            P8_SCHED; }); } while (0)
    { const char* pa_ = cA; const char* pb_ = cB;
      P8_PIECE(0, pa_, pb_, gC0, gC1, 0); P8_PIECE(1, pa_, pb_, gC0, gC1, 0); P8_PIECE(2, pa_, pb_, gC0, gC1, 0); P8_PIECE(3, pa_, pb_, gC0, gC1, 0); P8_PIECE(4, pa_, pb_, gC0, gC1, 0); P8_PIECE(5, pa_, pb_, gC0, gC1, 0);
      pa_ += kstep; pb_ += kstep;
      P8_PIECE(0, pa_, pb_, gC0, gC1, 1); P8_PIECE(1, pa_, pb_, gC0, gC1, 1); P8_PIECE(2, pa_, pb_, gC0, gC1, 1); P8_PIECE(3, pa_, pb_, gC0, gC1, 1); P8_PIECE(4, pa_, pb_, gC0, gC1, 1); P8_PIECE(5, pa_, pb_, gC0, gC1, 1);
      pa_ += kstep; pb_ += kstep;
      P8_PIECE(0, pa_, pb_, gC0, gC1, 2); P8_PIECE(1, pa_, pb_, gC0, gC1, 2); P8_PIECE(2, pa_, pb_, gC0, gC1, 2); }
    P8_WAIT_V(9); P8_BAR;
#pragma unroll
    for (int m = 0; m < 4; ++m)
#pragma unroll
        for (int k = 0; k < 2; ++k) AX[m][k] = *(const LAS bf16x8*)(lds + aoff + m * 2048 + k * 1024);
#pragma unroll
    for (int n = 0; n < 2; ++n)
#pragma unroll
        for (int k = 0; k < 2; ++k) BX[n][k] = *(const LAS bf16x8*)(lds + 2 * HTB + boff + n * 2048 + k * 1024);
    int sa = 0;
    for (;;) {
        const bool has_next = S.next(ui + 1, nxt);
        const char* nA = GATHER ? (const char*)g.A : (has_next ? (const char*)g.A + (size_t)nxt.pm * tstep : cA); const char* nB = has_next ? (const char*)g.Bt + (size_t)nxt.pb * hstep : cB;
        if constexpr (GATHER) { if (has_next) {
#pragma unroll
            for (int i = 0; i < 2; ++i) { gN0[i] = (unsigned)S.a_row(nxt, Rv[i]) * (unsigned)(K * 2) + (unsigned)Cv[i] * 2u; gN1[i] = (unsigned)S.a_row(nxt, HALF + Rv[i]) * (unsigned)(K * 2) + (unsigned)Cv[i] * 2u; } } }
#pragma unroll 1
        for (int t = 0; t < nt; t += 2) {
            const int sb = sa == 2 ? 0 : sa + 1, sc = sb == 2 ? 0 : sb + 1;
            const bool x2 = t + 2 >= nt, x3 = t + 3 >= nt, x4 = t + 4 >= nt;
            const char* a2 = x2 ? nA + (size_t)(t + 2 - nt) * kstep : cA + (size_t)(t + 2) * kstep; const char* b2 = x2 ? nB + (size_t)(t + 2 - nt) * kstep : cB + (size_t)(t + 2) * kstep;
            const char* a3 = x3 ? nA + (size_t)(t + 3 - nt) * kstep : cA + (size_t)(t + 3) * kstep; const char* b3 = x3 ? nB + (size_t)(t + 3 - nt) * kstep : cB + (size_t)(t + 3) * kstep;
            const char* a4 = x4 ? nA + (size_t)(t + 4 - nt) * kstep : cA + (size_t)(t + 4) * kstep; const char* b4 = x4 ? nB + (size_t)(t + 4 - nt) * kstep : cB + (size_t)(t + 4) * kstep;
            unsigned q20[2], q21[2], q30[2], q31[2], q40[2], q41[2];
            if constexpr (GATHER) {
#pragma unroll
                for (int i = 0; i < 2; ++i) { q20[i] = x2 ? gN0[i] : gC0[i]; q21[i] = x2 ? gN1[i] : gC1[i]; q30[i] = x3 ? gN0[i] : gC0[i]; q31[i] = x3 ? gN1[i] : gC1[i]; q40[i] = x4 ? gN0[i] : gC0[i]; q41[i] = x4 ? gN1[i] : gC1[i]; } }
            P8_SP(0, AX, AY, BX, BY, false, sa, 1, 3, a2, b2, q20, q21, sc);
            P8_WAIT_V(6); asm volatile("s_waitcnt lgkmcnt(0)" ::: "memory"); P8_BAR;
            P8_SP(1, AY, AX, BX, BY, true, sb, 0, 0, a3, b3, q30, q31, sa);
            P8_SP(0, AX, AY, BY, BX, false, sb, 1, 3, a3, b3, q30, q31, sa);
            P8_WAIT_V(6); asm volatile("s_waitcnt lgkmcnt(0)" ::: "memory"); P8_BAR;
            P8_SP(1, AY, AX, BY, BX, true, sc, 0, 0, a4, b4, q40, q41, sb);
            sa = sc;
        }
        E(acc, cur, wr, wc, fr, fq);
        if (!has_next) break;
#pragma unroll
        for (int a = 0; a < 2; ++a)
#pragma unroll
            for (int m = 0; m < 4; ++m)
#pragma unroll
                for (int n = 0; n < 2; ++n) acc[a][m][n] = (f32x4){0.f, 0.f, 0.f, 0.f};
        cur = nxt; cA = nA; cB = nB; ++ui;
        if constexpr (GATHER) { gC0[0] = gN0[0]; gC0[1] = gN0[1]; gC1[0] = gN1[0]; gC1[1] = gN1[1]; }
    }
    P8_WAIT_V(0);
    P8_BAR;
#undef P8_CAT
#undef P8_GLDS
#undef P8_PIECE
#undef P8_WAIT_V
#undef P8_BAR
#undef P8_SCHED
#undef P8_SP
}

__device__ __forceinline__ u32x4 pack8(const f32x4& v0, const f32x4& v1) { u32x4 w; w.x = cvt_pk_bf16(v0[0], v0[1]); w.y = cvt_pk_bf16(v0[2], v0[3]); w.z = cvt_pk_bf16(v1[0], v1[1]); w.w = cvt_pk_bf16(v1[2], v1[3]); return w; }
__device__ __forceinline__ void rope4(f32x4& v0, f32x4& v1, const float* cs) {
    const f32x4 a = *(const f32x4*)cs, b = *(const f32x4*)(cs + 4);
    float x1, x2;
    x1 = v0[0]; x2 = v0[1]; v0[0] = x1 * a[0] - x2 * a[1]; v0[1] = x2 * a[0] + x1 * a[1];
    x1 = v0[2]; x2 = v0[3]; v0[2] = x1 * a[2] - x2 * a[3]; v0[3] = x2 * a[2] + x1 * a[3];
    x1 = v1[0]; x2 = v1[1]; v1[0] = x1 * b[0] - x2 * b[1]; v1[1] = x2 * b[0] + x1 * b[1];
    x1 = v1[2]; x2 = v1[3]; v1[2] = x1 * b[2] - x2 * b[3]; v1[3] = x2 * b[2] + x1 * b[3];
}

struct EpiIn {
    static constexpr bool PERM = true;
    bf16_t *qa, *ka, *va, *cq, *ckv, *gates, *kr; const float *ropeA, *ropeM, *bg; float* sq; unsigned char* k8r; unsigned char *q8a, *k8a;
    __device__ __forceinline__ void operator()(const f32x4 (&acc)[2][2][4][2], const Unit& u, int wr, int wc, int fr, int fq) const {
        const int pn = u.pn, row0 = u.pm * BM + wr * 64 + fr, cl = wc * 32 + 8 * fq;
        if (pn < 8) {
            bf16_t* dst = pn < 4 ? qa : ka; const int colt = (pn & 3) * 256; const bool rot = ((wc & 1) == 0) && (fq < 2);
#pragma unroll
            for (int ai = 0; ai < 2; ++ai)
#pragma unroll
                for (int m = 0; m < 4; ++m) { const int row = row0 + ai * HALF + m * 16;
#pragma unroll
                    for (int bj = 0; bj < 2; ++bj) { f32x4 v0 = acc[ai][bj][m][0], v1 = acc[ai][bj][m][1];
                        if (rot) rope4(v0, v1, ropeA + (size_t)row * 16 + fq * 8);
                        if (pn < 4) { v0 *= QS_DA; v1 *= QS_DA; }
                        if (DA_QK8 != 1) *(u32x4*)(dst + (size_t)row * 1024 + colt + bj * HALF + cl) = pack8(v0, v1);
                        if (DA_QK8) { const float s8 = pn < 4 ? 8.f : 1.f; u32x2 w8; w8.x = cvt_pk_fp8x4(v0[0] * s8, v0[1] * s8, v0[2] * s8, v0[3] * s8); w8.y = cvt_pk_fp8x4(v1[0] * s8, v1[1] * s8, v1[2] * s8, v1[3] * s8);
                            *(u32x2*)((pn < 4 ? q8a : k8a) + (size_t)row * 1024 + colt + bj * HALF + cl) = w8; } } }
        } else if (pn < 12) {
            const int colt = (pn - 8) * 256;
#pragma unroll
            for (int ai = 0; ai < 2; ++ai)
#pragma unroll
                for (int m = 0; m < 4; ++m) { const int row = row0 + ai * HALF + m * 16;
#pragma unroll
                    for (int bj = 0; bj < 2; ++bj) *(u32x4*)(va + (size_t)row * 1024 + colt + bj * HALF + cl) = pack8(acc[ai][bj][m][0], acc[ai][bj][m][1]); }
        } else if (pn < 17) {
            const bool isq = pn < 15; bf16_t* dst = isq ? cq : ckv; const int ld = isq ? QL : KVL, colt = (isq ? pn - 12 : pn - 15) * 256, tq = pn - 12;
#pragma unroll
            for (int ai = 0; ai < 2; ++ai)
#pragma unroll
                for (int m = 0; m < 4; ++m) { const int row = row0 + ai * HALF + m * 16; float s = 0.f;
#pragma unroll
                    for (int bj = 0; bj < 2; ++bj) { const f32x4 v0 = acc[ai][bj][m][0], v1 = acc[ai][bj][m][1];
                        s += (v0[0] * v0[0] + v0[1] * v0[1]) + (v0[2] * v0[2] + v0[3] * v0[3]) + (v1[0] * v1[0] + v1[1] * v1[1]) + (v1[2] * v1[2] + v1[3] * v1[3]);
                        if (UP_F8) { u32x2 w8; w8.x = cvt_pk_fp8x4(v0[0], v0[1], v0[2], v0[3]); w8.y = cvt_pk_fp8x4(v1[0], v1[1], v1[2], v1[3]); *(u32x2*)((unsigned char*)dst + (size_t)row * ld + colt + bj * HALF + cl) = w8; }
                        else *(u32x4*)(dst + (size_t)row * ld + colt + bj * HALF + cl) = pack8(v0, v1); }
                    s += __shfl_xor(s, 16); s += __shfl_xor(s, 32);
                    if (fq == 0) sq[(size_t)row * 20 + tq * 4 + wc] = s; }
        } else if (pn != 23) {
            const int colt = (pn < 23 ? pn - 17 : pn - 18) * 256;
            f32x4 bv[2][2];
#pragma unroll
            for (int bj = 0; bj < 2; ++bj) { bv[bj][0] = *(const f32x4*)(bg + colt + bj * HALF + cl); bv[bj][1] = *(const f32x4*)(bg + colt + bj * HALF + cl + 4); if (DBG_SKIP & 256) { bv[bj][0] = bv[bj][0] * 0.f; bv[bj][1] = bv[bj][1] * 0.f; } }
#pragma unroll
            for (int ai = 0; ai < 2; ++ai)
#pragma unroll
                for (int m = 0; m < 4; ++m) { const int row = row0 + ai * HALF + m * 16;
#pragma unroll
                    for (int bj = 0; bj < 2; ++bj) { f32x4 v0 = acc[ai][bj][m][0] + bv[bj][0], v1 = acc[ai][bj][m][1] + bv[bj][1];
#pragma unroll
                        for (int j = 0; j < 4; ++j) { if (!(DBG_SKIP & 512)) { v0[j] = sigmoidf_(v0[j]); v1[j] = sigmoidf_(v1[j]); } }
                        *(u32x4*)(gates + (size_t)row * 2048 + colt + bj * HALF + cl) = pack8(v0, v1); } }
        } else {
            if (wc < 2) {
#pragma unroll
                for (int ai = 0; ai < 2; ++ai)
#pragma unroll
                    for (int m = 0; m < 4; ++m) { const int row = row0 + ai * HALF + m * 16;
                        f32x4 v0 = acc[ai][0][m][0], v1 = acc[ai][0][m][1];
                        rope4(v0, v1, ropeM + (size_t)row * 64 + (wc * 16 + fq * 4) * 2);
                        if (!MLA_QK8) *(u32x4*)(kr + (size_t)row * 64 + cl) = pack8(v0, v1);
                        if (MLA_QK8) { u32x2 w8; w8.x = cvt_pk_fp8x4(v0[0], v0[1], v0[2], v0[3]); w8.y = cvt_pk_fp8x4(v1[0], v1[1], v1[2], v1[3]); *(u32x2*)(k8r + (size_t)row * 64 + cl) = w8; } }
            }
        }
    }
};
template <bool ISQ> struct EpiUp {
    static constexpr bool PERM = true;
    bf16_t* out; const float* sq; const float* ropeM; unsigned char* out8;
    __device__ __forceinline__ void operator()(const f32x4 (&acc)[2][2][4][2], const Unit& u, int wr, int wc, int fr, int fq) const {
        const int row0 = u.pm * BM + wr * 64 + fr, cl = wc * 32 + 8 * fq; constexpr int LD = ISQ ? 1536 : 2048;
#pragma unroll
        for (int ai = 0; ai < 2; ++ai)
#pragma unroll
            for (int m = 0; m < 4; ++m) { const int row = row0 + ai * HALF + m * 16; float s;
                if (ISQ) { const f32x4 a = *(const f32x4*)(sq + (size_t)row * 20), b = *(const f32x4*)(sq + (size_t)row * 20 + 4), c = *(const f32x4*)(sq + (size_t)row * 20 + 8);
                    s = ((a[0] + a[1]) + (a[2] + a[3])) + ((b[0] + b[1]) + (b[2] + b[3])) + ((c[0] + c[1]) + (c[2] + c[3])); }
                else { const f32x4 a = *(const f32x4*)(sq + (size_t)row * 20 + 12), b = *(const f32x4*)(sq + (size_t)row * 20 + 16);
                    s = ((a[0] + a[1]) + (a[2] + a[3])) + ((b[0] + b[1]) + (b[2] + b[3])); }
                const float rstd = __builtin_amdgcn_rsqf(s * (ISQ ? 1.0f / QL : 1.0f / KVL) + EPS) * (ISQ ? QS_MLA : 1.0f);
#pragma unroll
                for (int bj = 0; bj < 2; ++bj) { const int col = u.pn * BM + bj * HALF + cl; f32x4 v0 = acc[ai][bj][m][0] * rstd, v1 = acc[ai][bj][m][1] * rstd;
                    if (ISQ) { const int off = col % 192; if (off >= 128) rope4(v0, v1, ropeM + (size_t)row * 64 + (off - 128)); }
                    if (!MLA_QK8 || (!ISQ && bj == 1)) *(u32x4*)(out + (size_t)row * LD + col) = pack8(v0, v1);
                    if (MLA_QK8) { u32x2 w8;
                        if (ISQ) { w8.x = cvt_pk_fp8x4(v0[0] * 8.f, v0[1] * 8.f, v0[2] * 8.f, v0[3] * 8.f); w8.y = cvt_pk_fp8x4(v1[0] * 8.f, v1[1] * 8.f, v1[2] * 8.f, v1[3] * 8.f); *(u32x2*)(out8 + (size_t)row * 1536 + col) = w8; }
                        else if (bj == 0) { w8.x = cvt_pk_fp8x4(v0[0], v0[1], v0[2], v0[3]); w8.y = cvt_pk_fp8x4(v1[0], v1[1], v1[2], v1[3]); *(u32x2*)(out8 + (size_t)row * 1024 + u.pn * 128 + cl) = w8; } } } }
    }
};
template <bool ISQ> struct EpiUp8 {
    bf16_t* out; const float* sq; const float* ropeM; unsigned char* out8; unsigned char* v8 = nullptr;
    __device__ __forceinline__ void operator()(const f32x4 (&acc)[2][4][2], const Unit& u, int wr, int wc, int fr, int fq) const {
        const int row0 = u.pm * BM + wr * 64 + fr, col = u.pn * HALF + wc * 32 + 8 * fq;
#pragma unroll
        for (int ai = 0; ai < 2; ++ai)
#pragma unroll
            for (int m = 0; m < 4; ++m) { const int row = row0 + ai * HALF + m * 16; float s;
                if (ISQ) { const f32x4 a = *(const f32x4*)(sq + (size_t)row * 20), b = *(const f32x4*)(sq + (size_t)row * 20 + 4), c = *(const f32x4*)(sq + (size_t)row * 20 + 8);
                    s = ((a[0] + a[1]) + (a[2] + a[3])) + ((b[0] + b[1]) + (b[2] + b[3])) + ((c[0] + c[1]) + (c[2] + c[3])); }
                else { const f32x4 a = *(const f32x4*)(sq + (size_t)row * 20 + 12), b = *(const f32x4*)(sq + (size_t)row * 20 + 16);
                    s = ((a[0] + a[1]) + (a[2] + a[3])) + ((b[0] + b[1]) + (b[2] + b[3])); }
                const float rstd = __builtin_amdgcn_rsqf(s * (ISQ ? 1.0f / QL : 1.0f / KVL) + EPS) * (ISQ ? QS_MLA : 1.0f);
                f32x4 v0 = acc[ai][m][0] * rstd, v1 = acc[ai][m][1] * rstd;
                if (ISQ) { const int off = col % 192; if (off >= 128) rope4(v0, v1, ropeM + (size_t)row * 64 + (off - 128));
                    u32x2 w8; w8.x = cvt_pk_fp8x4(v0[0] * 8.f, v0[1] * 8.f, v0[2] * 8.f, v0[3] * 8.f); w8.y = cvt_pk_fp8x4(v1[0] * 8.f, v1[1] * 8.f, v1[2] * 8.f, v1[3] * 8.f); *(u32x2*)(out8 + (size_t)row * 1536 + col) = w8; }
                else if ((u.pn & 1) == 0) { u32x2 w8; w8.x = cvt_pk_fp8x4(v0[0], v0[1], v0[2], v0[3]); w8.y = cvt_pk_fp8x4(v1[0], v1[1], v1[2], v1[3]); *(u32x2*)(out8 + (size_t)row * 1024 + (u.pn >> 1) * 128 + wc * 32 + 8 * fq) = w8; }
                else if (MLA_PV8) { u32x2 w8; w8.x = cvt_pk_fp8x4(v0[0], v0[1], v0[2], v0[3]); w8.y = cvt_pk_fp8x4(v1[0], v1[1], v1[2], v1[3]); *(u32x2*)(v8 + (size_t)row * 1024 + (u.pn >> 1) * 128 + wc * 32 + 8 * fq) = w8; }
                else *(u32x4*)(out + (size_t)row * 2048 + col) = pack8(v0, v1); }
    }
};
template <int WHICH> struct EpiGate {
    static constexpr bool PERM = true;
    bf16_t* mrg; const bf16_t* gates;
    __device__ __forceinline__ void operator()(const f32x4 (&acc)[2][2][4][2], const Unit& u, int wr, int wc, int fr, int fq) const {
        const int row0 = u.pm * BM + wr * 64 + fr, cl = wc * 32 + 8 * fq;
#pragma unroll
        for (int ai = 0; ai < 2; ++ai)
#pragma unroll
            for (int m = 0; m < 4; ++m) { const int row = row0 + ai * HALF + m * 16;
#pragma unroll
                for (int bj = 0; bj < 2; ++bj) { const int col = u.pn * BM + bj * HALF + cl;
                    const u32x4 gw = *(const u32x4*)(gates + (size_t)row * 2048 + WHICH * 1024 + col);
                    f32x4 v0 = acc[ai][bj][m][0], v1 = acc[ai][bj][m][1];
                    if ((DBG_SKIP & 8) && WHICH == 0) { v0 = v0 * 0.f; v1 = v1 * 0.f; } if ((DBG_SKIP & 16) && WHICH == 1) { v0 = v0 * 0.f; v1 = v1 * 0.f; }
                    v0[0] *= bf_lo(gw.x); v0[1] *= bf_hi(gw.x); v0[2] *= bf_lo(gw.y); v0[3] *= bf_hi(gw.y); v1[0] *= bf_lo(gw.z); v1[1] *= bf_hi(gw.z); v1[2] *= bf_lo(gw.w); v1[3] *= bf_hi(gw.w);
                    if (WHICH == 1) { const u32x4 tw = *(const u32x4*)(mrg + (size_t)row * 1024 + col);
                        v0[0] += bf_lo(tw.x); v0[1] += bf_hi(tw.x); v0[2] += bf_lo(tw.y); v0[3] += bf_hi(tw.y); v1[0] += bf_lo(tw.z); v1[1] += bf_hi(tw.z); v1[2] += bf_lo(tw.w); v1[3] += bf_hi(tw.w); }
                    *(u32x4*)(mrg + (size_t)row * 1024 + col) = pack8(v0, v1); } }
    }
};
struct EpiRes {
    static constexpr bool PERM = false;
    const float* x; bf16_t* out;
    __device__ __forceinline__ void operator()(const f32x4 (&acc)[2][2][4][2], const Unit& u, int wr, int wc, int fr, int fq) const {
        const int row0 = u.pm * BM + wr * 64 + fr, col0 = u.pn * BM + wc * 32 + 4 * fq;
#pragma unroll
        for (int ai = 0; ai < 2; ++ai)
#pragma unroll
            for (int m = 0; m < 4; ++m) { const size_t off = (size_t)(row0 + ai * HALF + m * 16) * 1024 + col0;
#pragma unroll
                for (int bj = 0; bj < 2; ++bj)
#pragma unroll
                    for (int n = 0; n < 2; ++n) { const f32x4 v = *(const f32x4*)(x + off + bj * HALF + n * 16) + ((DBG_SKIP & 2) ? 0.f : 1.f) * acc[ai][bj][m][n];
                        u32x2 w; w.x = cvt_pk_bf16(v[0], v[1]); w.y = cvt_pk_bf16(v[2], v[3]); *(u32x2*)(out + off + bj * HALF + n * 16) = w; } }
    }
};
struct EpiSwiglu {
    static constexpr bool PERM = true;
    bf16_t* act; const float *bgate, *bup;
    __device__ __forceinline__ void operator()(const f32x4 (&acc)[2][2][4][2], const Unit& u, int wr, int wc, int fr, int fq) const {
        const int row0 = u.pm * BM + wr * 64 + fr, f0 = u.pn * HALF + wc * 32 + 8 * fq;
        f32x4 bgv[2], buv[2];
#pragma unroll
        for (int n = 0; n < 2; ++n) { bgv[n] = *(const f32x4*)(bgate + (size_t)u.e * FF + f0 + 4 * n); buv[n] = *(const f32x4*)(bup + (size_t)u.e * FF + f0 + 4 * n); }
#pragma unroll
        for (int ai = 0; ai < 2; ++ai)
#pragma unroll
            for (int m = 0; m < 4; ++m) { const int row = row0 + ai * HALF + m * 16; f32x4 o[2];
#pragma unroll
                for (int n = 0; n < 2; ++n) { const f32x4 gt = acc[ai][0][m][n] + bgv[n], up = acc[ai][1][m][n] + buv[n];
#pragma unroll
                    for (int j = 0; j < 4; ++j) { const float gg = fminf(gt[j], 7.0f), uu = fminf(fmaxf(up[j], -7.0f), 7.0f); o[n][j] = (uu + 1.0f) * (gg * sigmoidf_(1.702f * gg)); } }
                u32x2 w8; w8.x = cvt_pk_fp8x4(o[0][0], o[0][1], o[0][2], o[0][3]); w8.y = cvt_pk_fp8x4(o[1][0], o[1][1], o[1][2], o[1][3]);
                *(u32x2*)((unsigned char*)act + (size_t)row * FF + f0) = w8; }
    }
};
struct EpiDown {
    static constexpr bool PERM = true;
    bf16_t* y; const float* bd;
    __device__ __forceinline__ void operator()(const f32x4 (&acc)[2][2][4][2], const Unit& u, int wr, int wc, int fr, int fq) const {
        const int row0 = u.pm * BM + wr * 64 + fr, cl = wc * 32 + 8 * fq;
        f32x4 bv[2][2];
#pragma unroll
        for (int bj = 0; bj < 2; ++bj) { const int col = u.pn * BM + bj * HALF + cl; bv[bj][0] = *(const f32x4*)(bd + (size_t)u.e * D + col); bv[bj][1] = *(const f32x4*)(bd + (size_t)u.e * D + col + 4); }
#pragma unroll
        for (int ai = 0; ai < 2; ++ai)
#pragma unroll
            for (int m = 0; m < 4; ++m) { const int row = row0 + ai * HALF + m * 16;
#pragma unroll
                for (int bj = 0; bj < 2; ++bj) { const int col = u.pn * BM + bj * HALF + cl;
                    *(u32x4*)(y + (size_t)row * D + col) = pack8(acc[ai][bj][m][0] + bv[bj][0], acc[ai][bj][m][1] + bv[bj][1]); } }
    }
};
struct EpiSwiglu8 {
    unsigned char* act; const float *bgate, *bup;
    __device__ __forceinline__ void operator()(const f32x4 (&acc)[2][4][2], const Unit& u, int wr, int wc, int fr, int fq) const {
        const int row0 = u.pm * BM + wr * 64 + fr, f0 = u.pn * 64 + wc * 16 + 4 * fq;
        const f32x4 bgv = *(const f32x4*)(bgate + (size_t)u.e * FF + f0), buv = *(const f32x4*)(bup + (size_t)u.e * FF + f0);
#pragma unroll
        for (int ai = 0; ai < 2; ++ai)
#pragma unroll
            for (int m = 0; m < 4; ++m) { const int row = row0 + ai * HALF + m * 16; const f32x4 gt = acc[ai][m][0] + bgv, up = acc[ai][m][1] + buv; float o[4];
#pragma unroll
                for (int j = 0; j < 4; ++j) { const float gg = fminf(gt[j], 7.0f), uu = fminf(fmaxf(up[j], -7.0f), 7.0f); o[j] = (uu + 1.0f) * (gg * sigmoidf_(1.702f * gg)); }
                *(unsigned*)(act + (size_t)row * FF + f0) = cvt_pk_fp8x4(o[0], o[1], o[2], o[3]); }
    }
};
struct EpiDown8 {
    unsigned char* y; const float* bd;
    __device__ __forceinline__ void operator()(const f32x4 (&acc)[2][4][2], const Unit& u, int wr, int wc, int fr, int fq) const {
        const int row0 = u.pm * BM + wr * 64 + fr, col = u.pn * HALF + wc * 32 + 8 * fq;
        const f32x4 bv0 = *(const f32x4*)(bd + (size_t)u.e * D + col), bv1 = *(const f32x4*)(bd + (size_t)u.e * D + col + 4);
#pragma unroll
        for (int ai = 0; ai < 2; ++ai)
#pragma unroll
            for (int m = 0; m < 4; ++m) { const int row = row0 + ai * HALF + m * 16; const f32x4 v0 = (acc[ai][m][0] + bv0) * YS, v1 = (acc[ai][m][1] + bv1) * YS;
                u32x2 w; w.x = cvt_pk_fp8x4(v0[0], v0[1], v0[2], v0[3]); w.y = cvt_pk_fp8x4(v1[0], v1[1], v1[2], v1[3]);
                *(u32x2*)(y + (size_t)row * D + col) = w; }
    }
};
}

namespace att {
constexpr int NW = 8, QBLK = 32, KVBLK = 64;
constexpr int SHM_V = KVBLK * 128 * 2;
#define SBAR() __builtin_amdgcn_sched_barrier(0)
#define KSW(row, colB) ((row) * 128 + ((colB) ^ ((((row) >> 1) & 7) << 4)))
__device__ __forceinline__ int crow(int r, int hi) { return (r & 3) + 8 * (r >> 2) + 4 * hi; }
struct Src { const bf16_t* Q; const bf16_t* K; const bf16_t* K2; const bf16_t* V; int ldq, ldk, ldk2, ldv; };

__device__ __forceinline__ void partialSM(f32x16& p0, f32x16& p1, float& m_reg, float& mn, float& alpha, const float C, const float thr) {
  float pmax;
  { float a0 = fmaxf(fmaxf(p0[0], p0[1]), p0[2]), a1 = fmaxf(fmaxf(p0[3], p0[4]), p0[5]), a2 = fmaxf(fmaxf(p1[0], p1[1]), p1[2]), a3 = fmaxf(fmaxf(p1[3], p1[4]), p1[5]);
#pragma unroll
    for (int r = 6; r < 16; r += 2) { a0 = fmaxf(fmaxf(a0, p0[r]), p0[r + 1]); a2 = fmaxf(fmaxf(a2, p1[r]), p1[r + 1]); }
    pmax = fmaxf(fmaxf(a0, a1), fmaxf(a2, a3)); }
  { auto rr = __builtin_amdgcn_permlane32_swap(__float_as_uint(pmax), __float_as_uint(pmax), false, false);
    pmax = fmaxf(__uint_as_float(rr[0]), __uint_as_float(rr[1])); }
  if (__builtin_expect(__all(pmax - m_reg <= thr), 1)) { mn = m_reg; alpha = 1.f; }
  else { mn = fmaxf(m_reg, pmax); alpha = __builtin_amdgcn_exp2f((m_reg - mn) * C); m_reg = mn; }
  const float mnC = -mn * C;
#pragma unroll
  for (int r = 0; r < 16; ++r) p0[r] = fmaf(p0[r], C, mnC);
#pragma unroll
  for (int r = 0; r < 16; ++r) p1[r] = fmaf(p1[r], C, mnC);
#pragma unroll
  for (int r = 0; r < 16; ++r) p0[r] = __builtin_amdgcn_exp2f(p0[r]);
#if ATT_DUP == 1
  { float d_[16];
#pragma unroll
    for (int r = 0; r < 16; ++r) { d_[r] = __builtin_amdgcn_exp2f(p1[r]); d_[r] = fmaf(d_[r], C, mnC); }
#pragma unroll
    for (int r = 0; r < 16; ++r) asm volatile("" :: "v"(d_[r])); }
#endif
}
__device__ __forceinline__ void finishSM(f32x16& p0, f32x16& p1, float alpha, float& l_reg, bf16x8& pa0, bf16x8& pa1, bf16x8& pa2, bf16x8& pa3) {
#pragma unroll
  for (int r = 0; r < 16; ++r) p1[r] = __builtin_amdgcn_exp2f(p1[r]);
  float ps;
  { float s0 = p0[0] + p0[1], s1 = p0[2] + p0[3], s2 = p1[0] + p1[1], s3 = p1[2] + p1[3];
#pragma unroll
    for (int r = 4; r < 16; r += 4) { s0 += p0[r] + p0[r + 1]; s1 += p0[r + 2] + p0[r + 3]; s2 += p1[r] + p1[r + 1]; s3 += p1[r + 2] + p1[r + 3]; }
    ps = (s0 + s1) + (s2 + s3); }
  { auto rr = __builtin_amdgcn_permlane32_swap(__float_as_uint(ps), __float_as_uint(ps), false, false);
    ps = __uint_as_float(rr[0]) + __uint_as_float(rr[1]); }
  l_reg = l_reg * alpha + ps;
#define PK4(P, BASE, OUT) do { unsigned a0 = cvt_pk_bf16(P[BASE + 0], P[BASE + 1]), a1 = cvt_pk_bf16(P[BASE + 2], P[BASE + 3]);   \
    unsigned b0 = cvt_pk_bf16(P[BASE + 4], P[BASE + 5]), b1 = cvt_pk_bf16(P[BASE + 6], P[BASE + 7]);                              \
    auto r0 = __builtin_amdgcn_permlane32_swap(a0, b0, false, false); auto r1 = __builtin_amdgcn_permlane32_swap(a1, b1, false, false); \
    u32x4 w = {r0[0], r1[0], r0[1], r1[1]}; OUT = *reinterpret_cast<bf16x8*>(&w); } while (0)
  PK4(p0, 0, pa0); PK4(p0, 8, pa1); PK4(p1, 0, pa2); PK4(p1, 8, pa3);
#undef PK4
}
template <int DQK> __device__ __forceinline__ void qkt(f32x16& p0, f32x16& p1, const LAS char* Ks, const bf16x8* qr, int r32, int hi) {
  p0 = f32x16{}; p1 = f32x16{};
#pragma unroll
  for (int d0 = 0; d0 < DQK / 16; d0 += 2) {
    bf16x8 kf[2][2];
#pragma unroll
    for (int d = 0; d < 2; ++d) { const int sub = (d0 + d) >> 2, cb = (((d0 + d) & 3) * 16 + hi * 8) * 2;
      kf[d][0] = *(const LAS bf16x8*)(Ks + sub * 8192 + KSW(r32, cb)); kf[d][1] = *(const LAS bf16x8*)(Ks + sub * 8192 + KSW(32 + r32, cb)); }
    SBAR();
#pragma unroll
    for (int d = 0; d < 2; ++d) {
      p0 = __builtin_amdgcn_mfma_f32_32x32x16_bf16(kf[d][0], qr[d0 + d], p0, 0, 0, 0);
      p1 = __builtin_amdgcn_mfma_f32_32x32x16_bf16(kf[d][1], qr[d0 + d], p1, 0, 0, 0); }
  }
}
__device__ __forceinline__ int v_st(int k, int c) { const int kk = (k & ~0xC) | ((k & 4) << 1) | ((k & 8) >> 1); return ((kk >> 3) * 4 + (c >> 5)) * 512 + ((kk & 7) * 32 + (c & 31)) * 2; }
__device__ __forceinline__ int v_rd_base(int lane) { return ((lane & 3) << 3) | (((lane >> 2) & 3) << 6) | (((lane >> 4) & 1) << 5) | (((lane >> 5) & 1) << 8); }
constexpr int v_rd_off(int d0, int ks, int half) { return d0 * 512 + ks * 4096 + half * 2048; }
template <int OFF> __device__ __forceinline__ s16x4 tr_read(int vb) {
  s16x4 r; asm volatile("ds_read_b64_tr_b16 %0, %1 offset:%2" : "=&v"(r) : "v"(vb), "i"(OFF) : "memory"); return r;
}
template <int KS> __device__ __forceinline__ void pv_step(f32x16* o, int vb, bf16x8 pa) {
  s16x4 l0, h0, l1, h1, l2, h2, l3, h3;
  l0 = tr_read<v_rd_off(0, KS, 0)>(vb); h0 = tr_read<v_rd_off(0, KS, 1)>(vb); l1 = tr_read<v_rd_off(1, KS, 0)>(vb); h1 = tr_read<v_rd_off(1, KS, 1)>(vb);
  l2 = tr_read<v_rd_off(2, KS, 0)>(vb); h2 = tr_read<v_rd_off(2, KS, 1)>(vb); l3 = tr_read<v_rd_off(3, KS, 0)>(vb); h3 = tr_read<v_rd_off(3, KS, 1)>(vb);
  asm volatile("s_waitcnt lgkmcnt(0)" ::: "memory"); SBAR();
#define PK(L, H) (bf16x8){L[0], L[1], L[2], L[3], H[0], H[1], H[2], H[3]}
  o[0] = __builtin_amdgcn_mfma_f32_32x32x16_bf16(pa, PK(l0, h0), o[0], 0, 0, 0);
  o[1] = __builtin_amdgcn_mfma_f32_32x32x16_bf16(pa, PK(l1, h1), o[1], 0, 0, 0);
  o[2] = __builtin_amdgcn_mfma_f32_32x32x16_bf16(pa, PK(l2, h2), o[2], 0, 0, 0);
  o[3] = __builtin_amdgcn_mfma_f32_32x32x16_bf16(pa, PK(l3, h3), o[3], 0, 0, 0);
#undef PK
}
__device__ __forceinline__ void pv_d0(f32x16* o, int vb, bf16x8 pa0, bf16x8 pa1, bf16x8 pa2, bf16x8 pa3) {
  pv_step<0>(o, vb, pa0); pv_step<1>(o, vb, pa1); pv_step<2>(o, vb, pa2); pv_step<3>(o, vb, pa3);
}
template <int DQK>
__device__ __forceinline__ void attn_core(const Src in, const float C, const float thr, const int seq, LAS char* lds, f32x16 (&o)[4]) {
  constexpr int NSUB = DQK / 64, SHM_K = NSUB * 8192;
  int lane; asm volatile("v_and_b32 %0, 63, %1" : "=v"(lane) : "v"(threadIdx.x));
  const int tid = threadIdx.x, wid = __builtin_amdgcn_readfirstlane(tid >> 6), r32 = lane & 31, hi = (lane >> 5) & 1;
  LAS char* V_lds = lds; LAS char* K_lds = lds + 3 * SHM_V;
  LAS float* ws = (LAS float*)(lds + 3 * SHM_V + 3 * SHM_K) + wid * 64; LAS float* li_l = ws; LAS float* al_l = ws + 32;
  float m_reg = -1e30f, l_reg = 0;
#pragma unroll
  for (int d = 0; d < 4; ++d) o[d] = f32x16{};
  bf16x8 qr[DQK / 16];
  const bf16_t* Qw = in.Q + (size_t)(wid * QBLK + r32) * in.ldq + hi * 8;
#pragma unroll
  for (int d0 = 0; d0 < DQK / 16; ++d0) qr[d0] = *(const bf16x8*)(Qw + d0 * 16);
  const int krow = wid * 8 + (lane >> 3), kslot = (lane & 7) ^ ((krow >> 1) & 7);
  const unsigned koff = (unsigned)(krow * in.ldk + kslot * 8) * 2u, k2off = (unsigned)(krow * in.ldk2 + kslot * 8) * 2u;
  unsigned voff[2];
#pragma unroll
  for (int i = 0; i < 2; ++i) { const int p = i * 8192 + wid * 1024 + lane * 16, st = p >> 9, wq = (p & 511) >> 1, kk = (st >> 2) * 8 + (wq >> 5), cl = wq & 31;
    const int k = (kk & ~0xC) | ((kk & 4) << 1) | ((kk & 8) >> 1); voff[i] = (unsigned)(k * in.ldv + (st & 3) * 32 + cl) * 2u; }
  const int vb0 = (int)(unsigned)(size_t)V_lds + v_rd_base(lane);
  const unsigned ldsw = (unsigned)wid * 1024u;
#define GLDS(gp, lp) __builtin_amdgcn_global_load_lds((const unsigned*)(gp), (LAS unsigned*)(lp), 16, 0, 0)
#define ISSUE_K(t, b) do { const char* kb_ = (const char*)in.K + (size_t)(t) * (KVBLK * 2) * in.ldk; \
    _Pragma("unroll") for (int s_ = 0; s_ < NSUB; ++s_) { if (s_ < 2) GLDS(kb_ + s_ * 128 + koff, K_lds + (b) * SHM_K + s_ * 8192 + ldsw); \
      else GLDS((const char*)in.K2 + (size_t)(t) * (KVBLK * 2) * in.ldk2 + k2off, K_lds + (b) * SHM_K + s_ * 8192 + ldsw); } } while (0)
#define ISSUE_V(t, b) do { const char* vb_ = (const char*)in.V + (size_t)(t) * (KVBLK * 2) * in.ldv; \
    GLDS(vb_ + voff[0], V_lds + (b) * SHM_V + ldsw); GLDS(vb_ + voff[1], V_lds + (b) * SHM_V + 8192 + ldsw); \
    if (ATT_DUP == 3) { GLDS(vb_ + voff[0], V_lds + (b) * SHM_V + ldsw); GLDS(vb_ + voff[1], V_lds + (b) * SHM_V + 8192 + ldsw); } } while (0)
#define WAITV(n) asm volatile("s_waitcnt vmcnt(%0)" :: "n"((DBG_SKIP & 4) ? 0 : (n)) : "memory")
#define WBAR() do { asm volatile("" ::: "memory"); __builtin_amdgcn_s_barrier(); asm volatile("" ::: "memory"); } while (0)
#define RESC(a) do { if (__any((a) < 1.f)) { if (hi == 0) al_l[r32] = (a); asm volatile("s_waitcnt lgkmcnt(0)" ::: "memory"); \
    _Pragma("unroll") for (int d = 0; d < 4; ++d) _Pragma("unroll") for (int r = 0; r < 16; ++r) o[d][r] *= al_l[crow(r, hi)]; } } while (0)
#define NXT3(x) ((x) == 2 ? 0 : (x) + 1)
  constexpr int NI = NSUB + (ATT_DUP == 3 ? 4 : 2), NV = (ATT_DUP == 3 ? 4 : 2);
  f32x16 pA0, pA1, pB0, pB1; float mnA, mnB, alA, alB; bf16x8 pa0, pa1, pa2, pa3; const int NT = seq / KVBLK;
  const bool lead = wid < 4;
  ISSUE_K(0, 0); ISSUE_K(1, 1); ISSUE_V(0, 0);
  if (!lead) { WAITV(NI); WBAR(); }
  WAITV(NI); WBAR();
  ISSUE_K(2, 2);
  qkt<DQK>(pA0, pA1, K_lds, qr, r32, hi);
  WAITV(NI); WBAR();
  ISSUE_V(1, 1);
  partialSM(pA0, pA1, m_reg, mnA, alA, C, thr);
  WAITV(NI); WBAR();
  int bq = 1;
  for (int j = 1; j + 3 < NT; j += 2) {
    { const int b1 = NXT3(bq), b2 = NXT3(b1);
      ISSUE_K(j + 2, b2);
      SBAR(); qkt<DQK>(pB0, pB1, K_lds + bq * SHM_K, qr, r32, hi);
      finishSM(pA0, pA1, alA, l_reg, pa0, pa1, pa2, pa3); SBAR();
      WAITV(NI); WBAR();
      ISSUE_V(j + 1, b1);
      pv_d0(o, vb0 + b2 * SHM_V, pa0, pa1, pa2, pa3); partialSM(pB0, pB1, m_reg, mnB, alB, C, thr);
      RESC(alB); bq = b1;
      WAITV(NI); WBAR(); }
    { const int b1 = NXT3(bq), b2 = NXT3(b1);
      ISSUE_K(j + 3, b2);
      SBAR(); qkt<DQK>(pA0, pA1, K_lds + bq * SHM_K, qr, r32, hi);
      finishSM(pB0, pB1, alB, l_reg, pa0, pa1, pa2, pa3); SBAR();
      WAITV(NI); WBAR();
      ISSUE_V(j + 2, b1);
      pv_d0(o, vb0 + b2 * SHM_V, pa0, pa1, pa2, pa3); partialSM(pA0, pA1, m_reg, mnA, alA, C, thr);
      RESC(alA); bq = b1;
      WAITV(NI); WBAR(); }
  }
  { const int b1 = NXT3(bq), b2 = NXT3(b1);
    ISSUE_K(NT - 1, b2);
    SBAR(); qkt<DQK>(pB0, pB1, K_lds + bq * SHM_K, qr, r32, hi);
    finishSM(pA0, pA1, alA, l_reg, pa0, pa1, pa2, pa3); SBAR();
    WAITV(NI); WBAR();
    ISSUE_V(NT - 2, b1);
    pv_d0(o, vb0 + b2 * SHM_V, pa0, pa1, pa2, pa3); partialSM(pB0, pB1, m_reg, mnB, alB, C, thr);
    RESC(alB); bq = b1;
    WAITV(NI); WBAR(); }
  { const int b1 = NXT3(bq), b2 = NXT3(b1);
    SBAR(); qkt<DQK>(pA0, pA1, K_lds + bq * SHM_K, qr, r32, hi);
    finishSM(pB0, pB1, alB, l_reg, pa0, pa1, pa2, pa3); SBAR();
    WAITV(NV); WBAR();
    ISSUE_V(NT - 1, b1);
    pv_d0(o, vb0 + b2 * SHM_V, pa0, pa1, pa2, pa3); partialSM(pA0, pA1, m_reg, mnA, alA, C, thr);
    RESC(alA); bq = b1;
    WAITV(NV); WBAR(); }
  { const int b2 = NXT3(NXT3(bq));
    SBAR(); qkt<DQK>(pB0, pB1, K_lds + bq * SHM_K, qr, r32, hi);
    finishSM(pA0, pA1, alA, l_reg, pa0, pa1, pa2, pa3); SBAR();
    WAITV(0); WBAR();
    pv_d0(o, vb0 + b2 * SHM_V, pa0, pa1, pa2, pa3); partialSM(pB0, pB1, m_reg, mnB, alB, C, thr);
    RESC(alB);
    WBAR(); }
  finishSM(pB0, pB1, alB, l_reg, pa0, pa1, pa2, pa3); SBAR();
  pv_d0(o, vb0 + bq * SHM_V, pa0, pa1, pa2, pa3);
  if (lead) { WBAR(); }
  if (hi == 0) li_l[r32] = l_reg; asm volatile("s_waitcnt lgkmcnt(0)" ::: "memory");
#pragma unroll
  for (int r = 0; r < 16; ++r) { const float rl = __builtin_amdgcn_rcpf(li_l[crow(r, hi)]);
#pragma unroll
    for (int d = 0; d < 4; ++d) o[d][r] *= rl; }
  asm volatile("s_waitcnt lgkmcnt(0)" ::: "memory"); WBAR();
#undef GLDS
#undef ISSUE_K
#undef ISSUE_V
#undef WAITV
#undef WBAR
#undef RESC
#undef NXT3
}
template <int DQK>
__device__ __forceinline__ void attn_core_seq(const Src in, const float C, const float thr, const int seq, LAS char* lds, f32x16 (&o)[4], float* probe = nullptr) {
  constexpr int NSUB = DQK / 64, SHM_K = NSUB * 8192;
  int lane; asm volatile("v_and_b32 %0, 63, %1" : "=v"(lane) : "v"(threadIdx.x));
  const int tid = threadIdx.x, wid = __builtin_amdgcn_readfirstlane(tid >> 6), r32 = lane & 31, hi = (lane >> 5) & 1;
  LAS char* V_lds = lds; LAS char* K_lds = lds + 3 * SHM_V;
  LAS float* ws = (LAS float*)(lds + 3 * SHM_V + 3 * SHM_K) + wid * 64; LAS float* li_l = ws; LAS float* al_l = ws + 32;
  float m_reg = -1e30f, l_reg = 0;
#pragma unroll
  for (int d = 0; d < 4; ++d) o[d] = f32x16{};
  bf16x8 qr[DQK / 16];
  const bf16_t* Qw = in.Q + (size_t)(wid * QBLK + r32) * in.ldq + hi * 8;
#pragma unroll
  for (int d0 = 0; d0 < DQK / 16; ++d0) qr[d0] = *(const bf16x8*)(Qw + d0 * 16);
  const int krow = wid * 8 + (lane >> 3), kslot = (lane & 7) ^ ((krow >> 1) & 7);
  const unsigned koff = (unsigned)(krow * in.ldk + kslot * 8) * 2u, k2off = (unsigned)(krow * in.ldk2 + kslot * 8) * 2u;
  unsigned voff[2];
#pragma unroll
  for (int i = 0; i < 2; ++i) { const int p = i * 8192 + wid * 1024 + lane * 16, st = p >> 9, wq = (p & 511) >> 1, kk = (st >> 2) * 8 + (wq >> 5), cl = wq & 31;
    const int k = (kk & ~0xC) | ((kk & 4) << 1) | ((kk & 8) >> 1); voff[i] = (unsigned)(k * in.ldv + (st & 3) * 32 + cl) * 2u; }
  const int vb0 = (int)(unsigned)(size_t)V_lds + v_rd_base(lane);
  const unsigned ldsw = (unsigned)wid * 1024u;
#define GLDS(gp, lp) __builtin_amdgcn_global_load_lds((const unsigned*)(gp), (LAS unsigned*)(lp), 16, 0, 0)
#define ISSUE_K(t, b) do { const char* kb_ = (const char*)in.K + (size_t)(t) * (KVBLK * 2) * in.ldk; \
    _Pragma("unroll") for (int s_ = 0; s_ < NSUB; ++s_) { if (s_ < 2) GLDS(kb_ + s_ * 128 + koff, K_lds + (b) * SHM_K + s_ * 8192 + ldsw); \
      else GLDS((const char*)in.K2 + (size_t)(t) * (KVBLK * 2) * in.ldk2 + k2off, K_lds + (b) * SHM_K + s_ * 8192 + ldsw); } } while (0)
#define ISSUE_V(t, b) do { const char* vb_ = (const char*)in.V + (size_t)(t) * (KVBLK * 2) * in.ldv; \
    GLDS(vb_ + voff[0], V_lds + (b) * SHM_V + ldsw); GLDS(vb_ + voff[1], V_lds + (b) * SHM_V + 8192 + ldsw); } while (0)
#define WAITV(n) asm volatile("s_waitcnt vmcnt(%0)" :: "n"(n) : "memory")
#define WBAR() do { asm volatile("" ::: "memory"); __builtin_amdgcn_s_barrier(); asm volatile("" ::: "memory"); } while (0)
#define RESC(a) do { if (__any((a) < 1.f)) { if (hi == 0) al_l[r32] = (a); asm volatile("s_waitcnt lgkmcnt(0)" ::: "memory"); \
    _Pragma("unroll") for (int d = 0; d < 4; ++d) _Pragma("unroll") for (int r = 0; r < 16; ++r) o[d][r] *= al_l[crow(r, hi)]; } } while (0)
#define NXT3(x) ((x) == 2 ? 0 : (x) + 1)
#define SEG_B(b) do { float mn, al; bf16x8 pa0, pa1, pa2, pa3; partialSM(p0, p1, m_reg, mn, al, C, thr); RESC(al); finishSM(p0, p1, al, l_reg, pa0, pa1, pa2, pa3); SBAR(); \
    pv_d0(o, vb0 + (b) * SHM_V, pa0, pa1, pa2, pa3); } while (0)
  constexpr int NI = NSUB + 2;
  f32x16 p0, p1; const int NT = seq / KVBLK; const bool lead = wid < 4;
  ISSUE_K(0, 0); ISSUE_V(0, 0); ISSUE_K(1, 1); ISSUE_V(1, 1);
  if (!lead) { WAITV(NI); WBAR(); }
  WAITV(NI); WBAR();
  int bq = 0;
#if PROBE_T == 4
  const unsigned long long t0 = __builtin_amdgcn_s_memtime();
#endif
  for (int j = 0; j + 2 < NT; ++j) {
    const int b1 = NXT3(bq), b2 = NXT3(b1);
    ISSUE_K(j + 2, b2);
    qkt<DQK>(p0, p1, K_lds + bq * SHM_K, qr, r32, hi);
    WAITV(NI); WBAR();
    ISSUE_V(j + 2, b2);
    SEG_B(bq);
    WAITV(NI); WBAR();
    bq = b1;
  }
#if PROBE_T == 4
  { const unsigned long long t1 = __builtin_amdgcn_s_memtime(); if (probe != nullptr && tid == 0) { probe[0] = 0.f; probe[1] = ((float)(t1 - t0) * (1.f / (NT - 2)) - 3000.f) * 0.02f; } }
#endif
#pragma unroll
  for (int jj = 0; jj < 2; ++jj) {
    qkt<DQK>(p0, p1, K_lds + bq * SHM_K, qr, r32, hi);
    WAITV(0); WBAR();
    SEG_B(bq);
    WBAR();
    bq = NXT3(bq);
  }
  if (lead) { WBAR(); }
  if (hi == 0) li_l[r32] = l_reg; asm volatile("s_waitcnt lgkmcnt(0)" ::: "memory");
#pragma unroll
  for (int r = 0; r < 16; ++r) { const float rl = __builtin_amdgcn_rcpf(li_l[crow(r, hi)]);
#pragma unroll
    for (int d = 0; d < 4; ++d) o[d][r] *= rl; }
  asm volatile("s_waitcnt lgkmcnt(0)" ::: "memory"); WBAR();
#undef GLDS
#undef ISSUE_K
#undef ISSUE_V
#undef WAITV
#undef WBAR
#undef RESC
#undef NXT3
#undef SEG_B
}
__device__ __forceinline__ void attn_core_da2(const Src in, const float C, const float thr, const int seq, LAS char* lds, f32x16 (&o1)[4], f32x16 (&o2)[4]) {
  constexpr int NSUB = 2, SHM_K = NSUB * 8192;
  int lane; asm volatile("v_and_b32 %0, 63, %1" : "=v"(lane) : "v"(threadIdx.x));
  const int tid = threadIdx.x, wid = __builtin_amdgcn_readfirstlane(tid >> 6), r32 = lane & 31, hi = (lane >> 5) & 1;
  LAS char* V_lds = lds; LAS char* K_lds = lds + 3 * SHM_V;
  LAS float* ws = (LAS float*)(lds + 3 * SHM_V + 3 * SHM_K) + wid * 64; LAS float* li_l = ws; LAS float* al_l = ws + 32;
  float m1 = -1e30f, l1 = 0, m2 = -1e30f, l2 = 0;
#pragma unroll
  for (int d = 0; d < 4; ++d) { o1[d] = f32x16{}; o2[d] = f32x16{}; }
  bf16x8 q1[4], q2[4];
  const bf16_t* Qw = in.Q + (size_t)(wid * QBLK + r32) * in.ldq + hi * 8;
#pragma unroll
  for (int d0 = 0; d0 < 4; ++d0) { q1[d0] = *(const bf16x8*)(Qw + d0 * 16); q2[d0] = *(const bf16x8*)(Qw + 64 + d0 * 16); }
  const int krow = wid * 8 + (lane >> 3), kslot = (lane & 7) ^ ((krow >> 1) & 7);
  const unsigned koff = (unsigned)(krow * in.ldk + kslot * 8) * 2u;
  unsigned voff[2];
#pragma unroll
  for (int i = 0; i < 2; ++i) { const int p = i * 8192 + wid * 1024 + lane * 16, st = p >> 9, wq = (p & 511) >> 1, kk = (st >> 2) * 8 + (wq >> 5), cl = wq & 31;
    const int k = (kk & ~0xC) | ((kk & 4) << 1) | ((kk & 8) >> 1); voff[i] = (unsigned)(k * in.ldv + (st & 3) * 32 + cl) * 2u; }
  const int vb0 = (int)(unsigned)(size_t)V_lds + v_rd_base(lane);
  const unsigned ldsw = (unsigned)wid * 1024u;
#define GLDS(gp, lp) __builtin_amdgcn_global_load_lds((const unsigned*)(gp), (LAS unsigned*)(lp), 16, 0, 0)
#define ISSUE_KV(t, b) do { const char* kb_ = (const char*)in.K + (size_t)(t) * (KVBLK * 2) * in.ldk; const char* vb_ = (const char*)in.V + (size_t)(t) * (KVBLK * 2) * in.ldv; \
    GLDS(kb_ + koff, K_lds + (b) * SHM_K + ldsw); GLDS(kb_ + 128 + koff, K_lds + (b) * SHM_K + 8192 + ldsw); \
    GLDS(vb_ + voff[0], V_lds + (b) * SHM_V + ldsw); GLDS(vb_ + voff[1], V_lds + (b) * SHM_V + 8192 + ldsw); } while (0)
#define WAITV(n) asm volatile("s_waitcnt vmcnt(%0)" :: "n"(n) : "memory")
#define WBAR() do { asm volatile("" ::: "memory"); __builtin_amdgcn_s_barrier(); asm volatile("" ::: "memory"); } while (0)
#define RESC(oo, a) do { if (__any((a) < 1.f)) { if (hi == 0) al_l[r32] = (a); asm volatile("s_waitcnt lgkmcnt(0)" ::: "memory"); \
    _Pragma("unroll") for (int d = 0; d < 4; ++d) _Pragma("unroll") for (int r = 0; r < 16; ++r) oo[d][r] *= al_l[crow(r, hi)]; asm volatile("s_waitcnt lgkmcnt(0)" ::: "memory"); } } while (0)
#define NXT3(x) ((x) == 2 ? 0 : (x) + 1)
#define TILE_BODY(b) do { f32x16 p0, p1; float mn, al; bf16x8 pa0, pa1, pa2, pa3; \
    qkt<64>(p0, p1, K_lds + (b) * SHM_K, q1, r32, hi); partialSM(p0, p1, m1, mn, al, C, thr); RESC(o1, al); \
    finishSM(p0, p1, al, l1, pa0, pa1, pa2, pa3); SBAR(); pv_d0(o1, vb0 + (b) * SHM_V, pa0, pa1, pa2, pa3); SBAR(); \
    qkt<64>(p0, p1, K_lds + (b) * SHM_K + 8192, q2, r32, hi); partialSM(p0, p1, m2, mn, al, C, thr); RESC(o2, al); \
    finishSM(p0, p1, al, l2, pa0, pa1, pa2, pa3); SBAR(); pv_d0(o2, vb0 + (b) * SHM_V, pa0, pa1, pa2, pa3); SBAR(); } while (0)
  const int NT = seq / KVBLK;
  ISSUE_KV(0, 0); ISSUE_KV(1, 1);
  int bq = 0;
  for (int j = 0; j + 1 < NT; ++j) {
    const int b1 = NXT3(bq), b2 = NXT3(b1);
    WAITV(4); WBAR();
    if (j + 2 < NT) ISSUE_KV(j + 2, b2); else ISSUE_KV(NT - 1, b2);
    TILE_BODY(bq);
    bq = b1;
  }
  WAITV(4); WBAR();
  TILE_BODY(bq);
  WAITV(0);
  if (hi == 0) { li_l[r32] = l1; al_l[r32] = l2; } asm volatile("s_waitcnt lgkmcnt(0)" ::: "memory");
#pragma unroll
  for (int r = 0; r < 16; ++r) { const float ra = __builtin_amdgcn_rcpf(li_l[crow(r, hi)]), rb = __builtin_amdgcn_rcpf(al_l[crow(r, hi)]);
#pragma unroll
    for (int d = 0; d < 4; ++d) { o1[d][r] *= ra; o2[d][r] *= rb; } }
  asm volatile("s_waitcnt lgkmcnt(0)" ::: "memory"); WBAR();
#undef GLDS
#undef ISSUE_KV
#undef WAITV
#undef WBAR
#undef RESC
#undef NXT3
#undef TILE_BODY
}
template <int I> struct IC { static constexpr int value = I; };
template <int LO, int HI, class F> __device__ __forceinline__ void sfor(F&& f) { if constexpr (LO < HI) { f(IC<LO>{}); sfor<LO + 1, HI>(f); } }
struct SMS { float a0, a1, a2, a3, dm; bool keep; };
__device__ __forceinline__ void mfma_c(f32x16& d, const bf16x8& a, const bf16x8& b, const f32x16& c) { asm("v_mfma_f32_32x32x16_bf16 %0, %1, %2, %3" : "=&v"(d) : "v"(a), "v"(b), "v"(c)); }
__device__ __forceinline__ void negm_bcast(f32x16& negm, float aone, float nm) { asm volatile("s_nop 1\n\tv_mfma_f32_32x32x2_f32 %0, %1, %2, 0\n\ts_nop 15\n\ts_nop 3" : "+v"(negm) : "v"(aone), "v"(nm)); }

struct VF { s16x4 l, h; };
template <int NEX> struct StartSched {
  static constexpr int NITEMS = 17 + NEX;
  static constexpr int kind(int n) { return n < 16 ? 0 : n == 16 ? 1 : 3; }
  static constexpr int idx(int n) { return n <= 16 ? n : n - 17; }
  static constexpr int weight(int n) { const int k = kind(n); return k == 3 ? 2 : k == 1 ? 3 : 1; }
  static constexpr int first(int g, int ng) { int W = 0; for (int i = 0; i < NITEMS; ++i) W += weight(i); int cum = 0; for (int i = 0; i < NITEMS; ++i) { if (cum * ng >= g * W) return i; cum += weight(i); } return NITEMS; }
};
template <int NEX> struct FinSched {
  static constexpr int NITEMS = NEX + 16;
  static constexpr int weight(int n) { return n < NEX ? 2 : 1; }
  static constexpr int first(int g, int ng) { int W = 0; for (int i = 0; i < NITEMS; ++i) W += weight(i); int cum = 0; for (int i = 0; i < NITEMS; ++i) { if (cum * ng >= g * W) return i; cum += weight(i); } return NITEMS; }
};
template <int N, int NEX> __device__ __forceinline__ void start_item(f32x16& P0, f32x16& P1, SMS& st, f32x16& negm, const float thr, const float hi_is0) {
  using SS = StartSched<NEX>; constexpr int K = SS::kind(N), I = SS::idx(N);
  if constexpr (K == 0) {
    if constexpr (I == 0) st.a0 = fmaxf(fmaxf(P0[0], P0[1]), P0[2]);
    else if constexpr (I == 1) st.a1 = fmaxf(fmaxf(P0[3], P0[4]), P0[5]);
    else if constexpr (I < 7) { if constexpr (I & 1) st.a1 = fmaxf(fmaxf(st.a1, P0[2 * I + 2]), P0[2 * I + 3]); else st.a0 = fmaxf(fmaxf(st.a0, P0[2 * I + 2]), P0[2 * I + 3]); }
    else if constexpr (I == 7) st.a2 = fmaxf(fmaxf(P1[0], P1[1]), P1[2]);
    else if constexpr (I == 8) st.a3 = fmaxf(fmaxf(P1[3], P1[4]), P1[5]);
    else if constexpr (I < 14) { constexpr int J = I - 7; if constexpr (J & 1) st.a3 = fmaxf(fmaxf(st.a3, P1[2 * J + 2]), P1[2 * J + 3]); else st.a2 = fmaxf(fmaxf(st.a2, P1[2 * J + 2]), P1[2 * J + 3]); }
    else if constexpr (I == 14) st.a0 = fmaxf(fmaxf(st.a0, st.a1), st.a2);
    else st.a0 = fmaxf(st.a0, st.a3);
  } else if constexpr (K == 1) {
    float pmax;
    { auto rr = __builtin_amdgcn_permlane32_swap(__float_as_uint(st.a0), __float_as_uint(st.a0), false, false); pmax = fmaxf(__uint_as_float(rr[0]), __uint_as_float(rr[1])); }
    st.keep = __all(pmax <= thr);
    if (__builtin_expect(!st.keep, 0)) {
      const float delta = fmaxf(pmax, 0.f); st.dm = -delta;
#pragma unroll
      for (int r = 0; r < 16; ++r) { P0[r] -= delta; P1[r] -= delta; }
      negm_bcast(negm, hi_is0, negm[0] - delta);
    }
  } else {
    if constexpr (I < 16) P0[I] = __builtin_amdgcn_exp2f(P0[I]); else P1[I - 16] = __builtin_amdgcn_exp2f(P1[I - 16]);
  }
}
template <int N, int NEX> __device__ __forceinline__ void fin_item(f32x16& P0, f32x16& P1, SMS& st, u32x4 (&pw)[4]) {
  if constexpr (N < NEX) { P1[16 - NEX + N] = __builtin_amdgcn_exp2f(P1[16 - NEX + N]); }
  else {
    constexpr int n = N - NEX, k = n / 4, j = n % 4, b = (k & 1) * 8 + 2 * j;
    f32x16& P = (k < 2) ? P0 : P1;
    pw[k][j] = cvt_pk_bf16(P[b], P[b + 1]);
  }
}
template <int N> __device__ __forceinline__ void v_wait(VF& f) { asm volatile("s_waitcnt lgkmcnt(%2)" : "+v"(f.l), "+v"(f.h) : "n"(N)); }
template <int G> __device__ __forceinline__ void v_issue(VF& f, int vb) { f.l = tr_read<v_rd_off(G & 3, G >> 2, 0)>(vb); f.h = tr_read<v_rd_off(G & 3, G >> 2, 1)>(vb); }

template <int DQK, int MAPS>
__device__ __forceinline__ void attn_core_pl(const Src in, const float C, const float thr, const int seq, LAS char* lds, f32x16 (&o)[4], float* probe = nullptr) {
  static_assert(DQK == 64 && MAPS == 2, "differential-attention configuration only");
  constexpr int SHM_K = 16384, NKS = DQK / 16, NG1 = 2 * NKS, NEXS = 32, NEXF = 0, VLA = 3;
  using SS = StartSched<NEXS>; using FS = FinSched<NEXF>;
  int lane; asm volatile("v_and_b32 %0, 63, %1" : "=v"(lane) : "v"(threadIdx.x));
  const int tid = threadIdx.x, wid = __builtin_amdgcn_readfirstlane(tid >> 6), r32 = lane & 31, hi = (lane >> 5) & 1, wq = wid & 3, mp = wid >> 2;
  LAS char* V_lds = lds; LAS char* K_lds = lds + 3 * SHM_V;
  LAS float* ws = (LAS float*)(lds + 3 * SHM_V + 3 * SHM_K) + wid * 64; LAS float* li_l = ws; LAS float* al_l = ws + 32;
  SMS st; st.dm = 0.f; st.keep = true;
  f32x16 negm = f32x16{};
#pragma unroll
  for (int d = 0; d < 4; ++d) o[d] = f32x16{};
  f32x16 osum = f32x16{};
  const bf16x8 ones = {16256, 16256, 16256, 16256, 16256, 16256, 16256, 16256};
  bf16x8 qr[NKS];
  const bf16_t* Qw = in.Q + (size_t)(wq * QBLK + r32) * in.ldq + mp * 64 + hi * 8;
#pragma unroll
  for (int d0 = 0; d0 < NKS; ++d0) qr[d0] = *(const bf16x8*)(Qw + d0 * 16);
  const int krow = wid * 8 + (lane >> 3), kslot = (lane & 7) ^ ((krow >> 1) & 7);
  const unsigned koff = (unsigned)(krow * in.ldk + kslot * 8) * 2u;
  unsigned voff[2];
#pragma unroll
  for (int i = 0; i < 2; ++i) { const int p = i * 8192 + wid * 1024 + lane * 16, s_ = p >> 9, wq_ = (p & 511) >> 1, kk = (s_ >> 2) * 8 + (wq_ >> 5), cl = wq_ & 31;
    voff[i] = (unsigned)(kk * in.ldv + (s_ & 3) * 32 + cl) * 2u; }
  const int vb0 = (int)(unsigned)(size_t)V_lds + v_rd_base(lane);
  const unsigned ldsw = (unsigned)wid * 1024u;
  const LAS char* Kw = K_lds + mp * 8192;
#define GLDS(gp, lp) __builtin_amdgcn_global_load_lds((const unsigned*)(gp), (LAS unsigned*)(lp), 16, 0, 0)
#define ISSUE_K(t, b) do { const char* kb_ = (const char*)in.K + (size_t)(t) * (KVBLK * 2) * in.ldk; \
    _Pragma("unroll") for (int rep_ = 0; rep_ < 1 + PROBE_DMA2; ++rep_) { GLDS(kb_ + koff, K_lds + (b) * SHM_K + ldsw); GLDS(kb_ + 128 + koff, K_lds + (b) * SHM_K + 8192 + ldsw); } } while (0)
#define ISSUE_V(t, b) do { const char* vb_ = (const char*)in.V + (size_t)(t) * (KVBLK * 2) * in.ldv; \
    _Pragma("unroll") for (int rep_ = 0; rep_ < 1 + PROBE_DMA2; ++rep_) { GLDS(vb_ + voff[0], V_lds + (b) * SHM_V + ldsw); GLDS(vb_ + voff[1], V_lds + (b) * SHM_V + 8192 + ldsw); } } while (0)
#define DMA_PIECE(i) do { DMA_PIECE1(i); if (PROBE_DMA2) DMA_PIECE1(i); } while (0)
#define DMA_PIECE1(i) do { if ((i) < 2) { const char* kb_ = (const char*)in.K + (size_t)tk_ * (KVBLK * 2) * in.ldk; GLDS(kb_ + (i) * 128 + koff, K_lds + bq * SHM_K + (i) * 8192 + ldsw); } \
    else { const char* vb_ = (const char*)in.V + (size_t)tv_ * (KVBLK * 2) * in.ldv; GLDS(vb_ + voff[(i) & 1], V_lds + b2 * SHM_V + ((i) & 1) * 8192 + ldsw); } } while (0)
#define WAITV(n) asm volatile("s_waitcnt vmcnt(%0)" :: "n"(n) : "memory")
#define WBAR() do { asm volatile("" ::: "memory"); __builtin_amdgcn_s_barrier(); asm volatile("" ::: "memory"); } while (0)
#define RESC() do { if (!st.keep) { int l2_; asm volatile("v_and_b32 %0, 63, %1" : "=v"(l2_) : "v"(threadIdx.x)); const int h2_ = l2_ >> 5; LAS float* al2_ = (LAS float*)(lds + 3 * SHM_V + 3 * SHM_K) + wid * 64 + 32; \
    if (h2_ == 0) al2_[l2_] = __builtin_amdgcn_exp2f(st.dm); asm volatile("s_waitcnt lgkmcnt(0)" ::: "memory"); \
    _Pragma("unroll") for (int r = 0; r < 16; ++r) { const float a_ = al2_[crow(r, h2_)]; osum[r] *= a_; _Pragma("unroll") for (int d = 0; d < 4; ++d) o[d][r] *= a_; } asm volatile("s_waitcnt lgkmcnt(0)" ::: "memory"); } } while (0)
#define NXT3(x) ((x) == 2 ? 0 : (x) + 1)
#define KFRAG(Ks, d, blk) (*(const LAS bf16x8*)((Ks) + KSW((blk) * 32 + r32, ((d) * 16 + hi * 8) * 2)))
#define PA(ks) (*reinterpret_cast<const bf16x8*>(&pw[ks]))
#define PKV(f) (bf16x8){f.l[0], f.l[1], f.l[2], f.l[3], f.h[0], f.h[1], f.h[2], f.h[3]}
#define PHASE1(PN0, PN1, PF0, PF1, Ks, vb) do { \
    bf16x8 kf[NKS][2]; kf[0][0] = KFRAG(Ks, 0, 0); kf[0][1] = KFRAG(Ks, 0, 1); \
    sfor<0, NG1>([&](auto gc) __attribute__((always_inline)) { constexpr int g = decltype(gc)::value, d = g >> 1, blk = g & 1; \
      if constexpr (blk == 0 && d + 1 < NKS) { kf[d + 1][0] = KFRAG(Ks, d + 1, 0); kf[d + 1][1] = KFRAG(Ks, d + 1, 1); } \
      if constexpr (blk == 0) { if constexpr (d == 0) mfma_c(PN0, kf[d][0], qr[d], negm); else PN0 = __builtin_amdgcn_mfma_f32_32x32x16_bf16(kf[d][0], qr[d], PN0, 0, 0, 0); } \
      else              { if constexpr (d == 0) mfma_c(PN1, kf[d][1], qr[d], negm); else PN1 = __builtin_amdgcn_mfma_f32_32x32x16_bf16(kf[d][1], qr[d], PN1, 0, 0, 0); } \
      if constexpr (DMA_SPREAD == 1 && g < 4) DMA_PIECE(g); \
      if constexpr (g >= NG1 - VLA) v_issue<g - (NG1 - VLA)>(vf[g - (NG1 - VLA)], vb); \
      sfor<FS::first(g, NG1), FS::first(g + 1, NG1)>([&](auto ic) __attribute__((always_inline)) { fin_item<decltype(ic)::value, NEXF>(PF0, PF1, st, pw); }); \
      SBAR(); }); } while (0)
#define PHASE2(PS0, PS1, vb) do { \
    sfor<0, 20>([&](auto gc) __attribute__((always_inline)) { constexpr int gg = decltype(gc)::value, ks = gg / 5, d = gg % 5, g = ks * 4 + d; \
      if constexpr (d < 4) { \
        v_wait<2 * (15 - g < VLA - 1 ? 15 - g : VLA - 1)>(vf[g]); \
        o[d] = __builtin_amdgcn_mfma_f32_32x32x16_bf16(PA(ks), PKV(vf[g]), o[d], 0, 0, 0); \
        if constexpr (g + VLA < 16) v_issue<g + VLA>(vf[g + VLA], vb); \
      } else { osum = __builtin_amdgcn_mfma_f32_32x32x16_bf16(PA(ks), ones, osum, 0, 0, 0); if constexpr (DMA_SPREAD == 2) DMA_PIECE(ks); } \
      sfor<SS::first(gg, 20), SS::first(gg + 1, 20)>([&](auto ic) __attribute__((always_inline)) { start_item<decltype(ic)::value, NEXS>(PS0, PS1, st, negm, thr, hi == 0 ? 1.f : 0.f); }); \
      SBAR(); }); \
    asm volatile("" : "+v"(PS0), "+v"(PS1)); \
    RESC(); } while (0)
  f32x16 pA0, pA1, pB0, pB1; u32x4 pw[4]; VF vf[16]; const int NT = seq / KVBLK;
  ISSUE_K(0, 0); ISSUE_K(1, 1); ISSUE_V(0, 0);
  WAITV(PROBE_DMA2 ? 8 : 4); WBAR();
  ISSUE_K(2, 2); ISSUE_V(1, 1);
  { bf16x8 kf[NKS][2];
#pragma unroll
    for (int d = 0; d < NKS; ++d) { kf[d][0] = KFRAG(Kw, d, 0); kf[d][1] = KFRAG(Kw, d, 1); }
    pA0 = f32x16{}; pA1 = f32x16{};
#pragma unroll
    for (int d = 0; d < NKS; ++d) { pA0 = __builtin_amdgcn_mfma_f32_32x32x16_bf16(kf[d][0], qr[d], pA0, 0, 0, 0); pA1 = __builtin_amdgcn_mfma_f32_32x32x16_bf16(kf[d][1], qr[d], pA1, 0, 0, 0); } }
  sfor<0, 16>([&](auto ic) __attribute__((always_inline)) { start_item<decltype(ic)::value, NEXS>(pA0, pA1, st, negm, thr, hi == 0 ? 1.f : 0.f); });
  { float pmax;
    { auto rr = __builtin_amdgcn_permlane32_swap(__float_as_uint(st.a0), __float_as_uint(st.a0), false, false); pmax = fmaxf(__uint_as_float(rr[0]), __uint_as_float(rr[1])); }
#pragma unroll
    for (int r = 0; r < 16; ++r) { pA0[r] -= pmax; pA1[r] -= pmax; negm[r] = -pmax; } }
  sfor<17, SS::NITEMS>([&](auto ic) __attribute__((always_inline)) { start_item<decltype(ic)::value, NEXS>(pA0, pA1, st, negm, thr, hi == 0 ? 1.f : 0.f); });
  int bq = 0;
#define ITER(j, PN0, PN1, PF0, PF1) do { const int b1 = NXT3(bq), b2 = NXT3(b1); \
    STAMP_A(); WAITV(PROBE_DMA2 ? 8 : 4); WBAR(); STAMP_B(); \
    const int tk_ = (j) + 3 < NT ? (j) + 3 : NT - 1, tv_ = (j) + 2 < NT ? (j) + 2 : NT - 1; if (DMA_SPREAD == 0) { ISSUE_K(tk_, bq); ISSUE_V(tv_, b2); } \
    PHASE1(PN0, PN1, PF0, PF1, Kw + b1 * SHM_K, vb0 + bq * SHM_V); STAMP_C(); \
    PHASE2(PN0, PN1, vb0 + bq * SHM_V); \
    bq = b1; } while (0)
#if PROBE_T
  unsigned long long tA = 0, tB = 0, accAB = 0, accBC = 0; const unsigned long long t0 = __builtin_amdgcn_s_memtime(), r0 = __builtin_amdgcn_s_memrealtime();
#define STAMP_A() do { if (PROBE_T >= 2) tA = __builtin_amdgcn_s_memtime(); } while (0)
#define STAMP_B() do { if (PROBE_T >= 2) { tB = __builtin_amdgcn_s_memtime(); accAB += tB - tA; } } while (0)
#define STAMP_C() do { if (PROBE_T == 3) { accBC += __builtin_amdgcn_s_memtime() - tB; } } while (0)
#else
#define STAMP_A()
#define STAMP_B()
#define STAMP_C()
#endif
  for (int j = 0; j + 2 < NT; j += 2) { ITER(j, pB0, pB1, pA0, pA1); ITER(j + 1, pA0, pA1, pB0, pB1); }
  ITER(NT - 2, pB0, pB1, pA0, pA1);
#if PROBE_T
  { const unsigned long long t1 = __builtin_amdgcn_s_memtime(), r1 = __builtin_amdgcn_s_memrealtime();
    if (probe != nullptr && tid == 0) {
      if (PROBE_T == 1) { probe[0] = (float)(t1 - t0) * (0.5e-6f / (NT - 1)); probe[1] = (float)(t1 - t0) / (float)(r1 - r0); }
      if (PROBE_T == 2) { probe[0] = (float)accAB * (0.5e-6f / (NT - 1)); probe[1] = ((float)(t1 - t0) * (1.f / (NT - 1)) - 1500.f) * 0.05f; }
      if (PROBE_T == 3) { probe[0] = (float)accBC * (0.5e-6f / (NT - 1)); probe[1] = (float)accAB * (0.01f / (NT - 1)); } } }
#endif
#undef STAMP_A
#undef STAMP_B
#undef STAMP_C
  sfor<0, FS::NITEMS>([&](auto ic) __attribute__((always_inline)) { fin_item<decltype(ic)::value, NEXF>(pB0, pB1, st, pw); });
  WAITV(0); WBAR();
  { const int vb = vb0 + bq * SHM_V;
    sfor<0, VLA>([&](auto gc) __attribute__((always_inline)) { v_issue<decltype(gc)::value>(vf[decltype(gc)::value], vb); });
    sfor<0, 16>([&](auto gc) __attribute__((always_inline)) { constexpr int g = decltype(gc)::value, ks = g >> 2, d = g & 3;
      v_wait<2 * (15 - g < VLA - 1 ? 15 - g : VLA - 1)>(vf[g]);
      o[d] = __builtin_amdgcn_mfma_f32_32x32x16_bf16(PA(ks), PKV(vf[g]), o[d], 0, 0, 0);
      if constexpr (g + VLA < 16) v_issue<g + VLA>(vf[g + VLA], vb);
      if constexpr (d == 3) osum = __builtin_amdgcn_mfma_f32_32x32x16_bf16(PA(ks), ones, osum, 0, 0, 0);
      SBAR(); }); }
#pragma unroll
  for (int r = 0; r < 16; ++r) { const float rl = __builtin_amdgcn_rcpf(osum[r]);
#pragma unroll
    for (int d = 0; d < 4; ++d) o[d][r] *= rl; }
  asm volatile("s_waitcnt lgkmcnt(0)" ::: "memory"); WBAR();
#undef GLDS
#undef ISSUE_K
#undef ISSUE_V
#undef WAITV
#undef WBAR
#undef RESC
#undef NXT3
#undef KFRAG
#undef PKV
#undef PA
#undef PHASE1
#undef DMA_PIECE
#undef DMA_PIECE1
#undef PHASE2
#undef ITER
}
struct BStart { static constexpr int NITEMS = 25;
  static constexpr int weight(int n) { return n < 8 ? 1 : n == 8 ? 3 : 2; }
  static constexpr int first(int g, int ng) { int W = 0; for (int i = 0; i < NITEMS; ++i) W += weight(i); int cum = 0; for (int i = 0; i < NITEMS; ++i) { if (cum * ng >= g * W) return i; cum += weight(i); } return NITEMS; } };
template <int N> __device__ __forceinline__ void bstart_item(f32x16& P, SMS& st, f32x16& negm, const float thr, const float hi_is0) {
  if constexpr (N == 0) st.a0 = fmaxf(fmaxf(P[0], P[1]), P[2]);
  else if constexpr (N == 1) st.a1 = fmaxf(fmaxf(P[3], P[4]), P[5]);
  else if constexpr (N < 7) { if constexpr (N & 1) st.a1 = fmaxf(fmaxf(st.a1, P[2 * N + 2]), P[2 * N + 3]); else st.a0 = fmaxf(fmaxf(st.a0, P[2 * N + 2]), P[2 * N + 3]); }
  else if constexpr (N == 7) st.a0 = fmaxf(st.a0, st.a1);
  else if constexpr (N == 8) {
    float pmax;
    { auto rr = __builtin_amdgcn_permlane32_swap(__float_as_uint(st.a0), __float_as_uint(st.a0), false, false); pmax = fmaxf(__uint_as_float(rr[0]), __uint_as_float(rr[1])); }
    st.keep = __all(pmax <= thr);
    if (__builtin_expect(!st.keep, 0)) {
      const float delta = fmaxf(pmax, 0.f); st.dm = -delta;
#pragma unroll
      for (int r = 0; r < 16; ++r) P[r] -= delta;
      negm_bcast(negm, hi_is0, negm[0] - delta);
    }
  } else { constexpr int I = N - 9; P[I] = __builtin_amdgcn_exp2f(P[I]); }
}
template <int N> __device__ __forceinline__ void bfin_item(f32x16& P, u32x4 (&pw)[2]) { constexpr int k = N / 4, j = N % 4; pw[k][j] = cvt_pk_bf16(P[8 * k + 2 * j], P[8 * k + 2 * j + 1]); }
constexpr int bfin_first(int g, int ng) { return g * 8 / ng; }

template <int OFF> __device__ __forceinline__ void k_read(bf16x8& r, int addr) { asm volatile("ds_read_b128 %0, %1 offset:%2" : "=&v"(r) : "v"(addr), "i"(OFF) : "memory"); }
template <int N> __device__ __forceinline__ void k_wait(bf16x8& f) { asm volatile("s_waitcnt lgkmcnt(%1)" : "+v"(f) : "n"(N)); }
constexpr int kwait_n(int g, int nks, int kla, int vla) {
  int kk = kla - 1 < nks - 1 - g ? kla - 1 : nks - 1 - g; if (kk < 0) kk = 0;
  int lo = nks - vla > g - kla ? nks - vla : g - kla; int vv = g - lo; if (vv < 0) vv = 0;
  return kk + 2 * vv; }
template <int DQK, int MAPS>
__device__ __forceinline__ void attn_core_bp(const Src in, const float thr, const int seq, LAS char* lds, f32x16 (&o)[4], float* probe = nullptr) {
  constexpr int NSUB = MAPS == 2 ? 2 : DQK / 64, SHM_K = NSUB * 8192, NKS = DQK / 16, NI = NSUB + 2, VLA = BP_VLA, KLA = BP_KLA;
  int lane; asm volatile("v_and_b32 %0, 63, %1" : "=v"(lane) : "v"(threadIdx.x));
  const int tid = threadIdx.x, wid = __builtin_amdgcn_readfirstlane(tid >> 6), r32 = lane & 31, hi = (lane >> 5) & 1, wq = MAPS == 2 ? (wid & 3) : wid, mp = MAPS == 2 ? (wid >> 2) : 0;
  LAS char* V_lds = lds; LAS char* K_lds = lds + 4 * SHM_V;
  SMS st; st.dm = 0.f; st.keep = true;
  f32x16 negm = f32x16{}, osum = f32x16{};
#pragma unroll
  for (int d = 0; d < 4; ++d) o[d] = f32x16{};
  const bf16x8 ones = {16256, 16256, 16256, 16256, 16256, 16256, 16256, 16256};
  bf16x8 qr[NKS];
  { const bf16_t* Qw = in.Q + (size_t)(wq * QBLK + r32) * in.ldq + mp * 64 + hi * 8;
#pragma unroll
    for (int d0 = 0; d0 < NKS; ++d0) qr[d0] = *(const bf16x8*)(Qw + d0 * 16); }
  const int krow = wid * 8 + (lane >> 3), kslot = (lane & 7) ^ ((krow >> 1) & 7);
  const unsigned koff = (unsigned)(krow * in.ldk + kslot * 8) * 2u, k2off = (unsigned)(krow * in.ldk2 + kslot * 8) * 2u;
  unsigned voff[2];
#pragma unroll
  for (int i = 0; i < 2; ++i) { const int p = i * 8192 + wid * 1024 + lane * 16, s_ = p >> 9, wq_ = (p & 511) >> 1, kk = (s_ >> 2) * 8 + (wq_ >> 5), cl = wq_ & 31;
    voff[i] = (unsigned)(kk * in.ldv + (s_ & 3) * 32 + cl) * 2u; }
  const int vb0 = (int)(unsigned)(size_t)V_lds + v_rd_base(lane);
  const unsigned ldsw = (unsigned)wid * 1024u;
  const LAS char* Kw = K_lds + mp * 8192;
  int kxo[4];
#pragma unroll
  for (int i = 0; i < 4; ++i) kxo[i] = r32 * 128 + ((i * 32 + hi * 16) ^ (((r32 >> 1) & 7) << 4));
#define GLDS(gp, lp) __builtin_amdgcn_global_load_lds((const unsigned*)(gp), (LAS unsigned*)(lp), 16, 0, 0)
#define PIECE(i, tk, bk, tv, bv) do { \
    if ((i) < NSUB) { if (MAPS == 2 || (i) < 2) GLDS((const char*)in.K + (size_t)(tk) * (KVBLK * 2) * in.ldk + (i) * 128 + koff, K_lds + (bk) * SHM_K + (i) * 8192 + ldsw); \
                      else GLDS((const char*)in.K2 + (size_t)(tk) * (KVBLK * 2) * in.ldk2 + k2off, K_lds + (bk) * SHM_K + (i) * 8192 + ldsw); } \
    else GLDS((const char*)in.V + (size_t)(tv) * (KVBLK * 2) * in.ldv + voff[((i) - NSUB) & 1], V_lds + (bv) * SHM_V + (((i) - NSUB) & 1) * 8192 + ldsw); } while (0)
#define WAITV(n) asm volatile("s_waitcnt vmcnt(%0)" :: "n"(n) : "memory")
#define WBAR() do { asm volatile("" ::: "memory"); __builtin_amdgcn_s_barrier(); asm volatile("" ::: "memory"); } while (0)
#define RESC() do { if (!st.keep) { int l2_; asm volatile("v_and_b32 %0, 63, %1" : "=v"(l2_) : "v"(threadIdx.x)); const int h2_ = l2_ >> 5; LAS float* al2_ = (LAS float*)(lds + MISC_OFF + 128) + wid * 32; \
    if (h2_ == 0) al2_[l2_] = __builtin_amdgcn_exp2f(st.dm); asm volatile("s_waitcnt lgkmcnt(0)" ::: "memory"); \
    _Pragma("unroll") for (int r = 0; r < 16; ++r) { const float a_ = al2_[crow(r, h2_)]; osum[r] *= a_; _Pragma("unroll") for (int d = 0; d < 4; ++d) o[d][r] *= a_; } asm volatile("s_waitcnt lgkmcnt(0)" ::: "memory"); } } while (0)
#define NXT3(x) ((x) == 2 ? 0 : (x) + 1)
#define KFRAG(Ks, d, blk) (*(const LAS bf16x8*)((Ks) + ((d) >> 2) * 8192 + KSW((blk) * 32 + r32, (((d) & 3) * 16 + hi * 8) * 2)))
#define PA(k) (*reinterpret_cast<const bf16x8*>(&pw[k]))
#define PKV(f) (bf16x8){f.l[0], f.l[1], f.l[2], f.l[3], f.h[0], f.h[1], f.h[2], f.h[3]}
#define BITER(BPAR, PN, PF, Kq, vb, DO_DMA) do { \
    { bf16x8 kf[NKS]; int ka_[4]; { const int kb_ = (int)(unsigned)(size_t)(Kq); _Pragma("unroll") for (int i_ = 0; i_ < 4; ++i_) ka_[i_] = kb_ + kxo[i_]; } \
      sfor<0, KLA>([&](auto dc) __attribute__((always_inline)) { constexpr int d_ = decltype(dc)::value; k_read<(d_ >> 2) * 8192 + (1 - (BPAR)) * 4096>(kf[d_], ka_[d_ & 3]); }); \
      sfor<0, NKS>([&](auto gc) __attribute__((always_inline)) { constexpr int g = decltype(gc)::value; \
        k_wait<kwait_n(g, NKS, KLA, VLA)>(kf[g]); \
        if constexpr (g + KLA < NKS) k_read<((g + KLA) >> 2) * 8192 + (1 - (BPAR)) * 4096>(kf[g + KLA], ka_[(g + KLA) & 3]); \
        if constexpr (g == 0) mfma_c(PN, kf[g], qr[g], negm); else PN = __builtin_amdgcn_mfma_f32_32x32x16_bf16(kf[g], qr[g], PN, 0, 0, 0); \
        if constexpr ((DO_DMA) && g < NI) PIECE(g, tk_, bk_, tv_, bv_); \
        if constexpr (g >= NKS - VLA) v_issue<8 * (BPAR) + g - (NKS - VLA)>(vf[g - (NKS - VLA)], vb); \
        sfor<bfin_first(g, NKS), bfin_first(g + 1, NKS)>([&](auto ic) __attribute__((always_inline)) { bfin_item<decltype(ic)::value>(PF, pw); }); \
        SBAR(); }); } \
    sfor<0, 10>([&](auto gc) __attribute__((always_inline)) { constexpr int gg = decltype(gc)::value, ksl = gg / 5, d = gg % 5, g = ksl * 4 + d; \
      if constexpr (d < 4) { \
        v_wait<2 * (7 - g < VLA - 1 ? 7 - g : VLA - 1)>(vf[g]); \
        o[d] = __builtin_amdgcn_mfma_f32_32x32x16_bf16(PA(ksl), PKV(vf[g]), o[d], 0, 0, 0); \
        if constexpr (g + VLA < 8) v_issue<8 * (BPAR) + g + VLA>(vf[g + VLA], vb); \
      } else osum = __builtin_amdgcn_mfma_f32_32x32x16_bf16(PA(ksl), ones, osum, 0, 0, 0); \
      if constexpr (gg > 0) sfor<BStart::first(gg - 1, 9), BStart::first(gg, 9)>([&](auto ic) __attribute__((always_inline)) { bstart_item<decltype(ic)::value>(PN, st, negm, thr, hi == 0 ? 1.f : 0.f); });     \
      SBAR(); }); \
    asm volatile("" : "+v"(PN)); \
    RESC(); } while (0)
  f32x16 pA, pB; u32x4 pw[2]; VF vf[8]; const int NT = seq / KVBLK;
#pragma unroll
  for (int t = 0; t < 3; ++t) {
#pragma unroll
    for (int i = 0; i < NI; ++i) PIECE(i, t, t, t, t); }
  WAITV(2 * NI); WBAR();
  { bf16x8 kf[NKS];
#pragma unroll
    for (int d = 0; d < NKS; ++d) kf[d] = KFRAG(Kw, d, 0);
    pA = f32x16{};
#pragma unroll
    for (int d = 0; d < NKS; ++d) pA = __builtin_amdgcn_mfma_f32_32x32x16_bf16(kf[d], qr[d], pA, 0, 0, 0); }
  sfor<0, 8>([&](auto ic) __attribute__((always_inline)) { bstart_item<decltype(ic)::value>(pA, st, negm, thr, hi == 0 ? 1.f : 0.f); });
  { float pmax;
    { auto rr = __builtin_amdgcn_permlane32_swap(__float_as_uint(st.a0), __float_as_uint(st.a0), false, false); pmax = fmaxf(__uint_as_float(rr[0]), __uint_as_float(rr[1])); }
#pragma unroll
    for (int r = 0; r < 16; ++r) { pA[r] -= pmax; negm[r] = -pmax; } }
  sfor<9, BStart::NITEMS>([&](auto ic) __attribute__((always_inline)) { bstart_item<decltype(ic)::value>(pA, st, negm, thr, hi == 0 ? 1.f : 0.f); });
  int kq = 0;
#if PROBE_T == 5
  const unsigned long long t0 = __builtin_amdgcn_s_memtime();
#endif
  for (int t = 0; t + 1 < NT; ++t) {
    const int k1 = NXT3(kq), vq = t & 3;
    const int tk_ = t + 3 < NT ? t + 3 : NT - 1, tv_ = tk_, bk_ = kq, bv_ = (t + 3) & 3;
    BITER(0, pB, pA, Kw + kq * SHM_K, vb0 + vq * SHM_V, false);
    WAITV(NI); WBAR();
    BITER(1, pA, pB, Kw + k1 * SHM_K, vb0 + vq * SHM_V, true);
    kq = k1;
  }
#if PROBE_T == 5
  { const unsigned long long t1 = __builtin_amdgcn_s_memtime(); if (probe != nullptr && tid == 0) { probe[0] = 0.f; probe[1] = ((float)(t1 - t0) * (1.f / (NT - 1)) - PROBE_BASE) * 0.05f; } }
#endif
  { const int vq = (NT - 1) & 3; const int tk_ = 0, tv_ = 0, bk_ = 0, bv_ = 0; (void)tk_; (void)tv_; (void)bk_; (void)bv_;
    BITER(0, pB, pA, Kw + kq * SHM_K, vb0 + vq * SHM_V, false);
    sfor<0, 8>([&](auto ic) __attribute__((always_inline)) { bfin_item<decltype(ic)::value>(pB, pw); });
    const int vb = vb0 + vq * SHM_V;
    sfor<0, VLA>([&](auto gc) __attribute__((always_inline)) { v_issue<8 + decltype(gc)::value>(vf[decltype(gc)::value], vb); });
    sfor<0, 8>([&](auto gc) __attribute__((always_inline)) { constexpr int g = decltype(gc)::value, ksl = g >> 2, d = g & 3;
      v_wait<2 * (7 - g < VLA - 1 ? 7 - g : VLA - 1)>(vf[g]);
      o[d] = __builtin_amdgcn_mfma_f32_32x32x16_bf16(PA(ksl), PKV(vf[g]), o[d], 0, 0, 0);
      if constexpr (g + VLA < 8) v_issue<8 + g + VLA>(vf[g + VLA], vb);
      if constexpr (d == 3) osum = __builtin_amdgcn_mfma_f32_32x32x16_bf16(PA(ksl), ones, osum, 0, 0, 0);
      SBAR(); }); }
#pragma unroll
  for (int r = 0; r < 16; ++r) { const float rl = __builtin_amdgcn_rcpf(osum[r]);
#pragma unroll
    for (int d = 0; d < 4; ++d) o[d][r] *= rl; }
  WAITV(0); asm volatile("s_waitcnt lgkmcnt(0)" ::: "memory"); WBAR();
#undef GLDS
#undef PIECE
#undef WAITV
#undef WBAR
#undef RESC
#undef NXT3
#undef KFRAG
#undef PA
#undef PKV
#undef BITER
}
struct Src8 { const unsigned char* q8; const unsigned char* k8n; const unsigned char* k8r; const bf16_t* V; int ldv; };
typedef int v8i_att __attribute__((ext_vector_type(8))); typedef int v4i_att __attribute__((ext_vector_type(4)));
__device__ __forceinline__ void attn_core_bp8(const Src8 in, const float thr, const int seq, LAS char* lds, f32x16 (&o)[4], float* probe = nullptr) {
  constexpr int SHM_K = 3 * 4096, NKS = 3, NI = 4, VLA = 3;
  int lane; asm volatile("v_and_b32 %0, 63, %1" : "=v"(lane) : "v"(threadIdx.x));
  const int tid = threadIdx.x, wid = __builtin_amdgcn_readfirstlane(tid >> 6), r32 = lane & 31, hi = (lane >> 5) & 1;
  LAS char* V_lds = lds; LAS char* K_lds = lds + 4 * SHM_V;
  SMS st; st.dm = 0.f; st.keep = true;
  f32x16 negm = f32x16{}, osum = f32x16{};
#pragma unroll
  for (int d = 0; d < 4; ++d) o[d] = f32x16{};
  const bf16x8 ones = {16256, 16256, 16256, 16256, 16256, 16256, 16256, 16256};
  v8i_att qf[NKS];
  { const unsigned char* Qw = in.q8 + (size_t)(wid * QBLK + r32) * 1536 + hi * 32;
#pragma unroll
    for (int s = 0; s < NKS; ++s) { const v4i_att lo = *(const v4i_att*)(Qw + s * 64), hh = *(const v4i_att*)(Qw + s * 64 + 16); qf[s] = __builtin_shufflevector(lo, hh, 0, 1, 2, 3, 4, 5, 6, 7); } }
  unsigned ksrc[2]; int kdst[2]; bool krot[2];
#pragma unroll
  for (int i = 0; i < 2; ++i) { const int p0 = wid * 2 + i, p = p0 < 12 ? p0 : p0 - 4, s = p >> 2, q = p & 3, row = q * 16 + (lane >> 2), lc = (lane & 3) ^ ((lane >> 4) & 3);
    krot[i] = (s == 2); ksrc[i] = krot[i] ? (unsigned)(row * 64 + lc * 16) : (unsigned)(row * 1024 + s * 64 + lc * 16); kdst[i] = s * 4096 + q * 1024 + lane * 16; }
  unsigned voff[2];
#pragma unroll
  for (int i = 0; i < 2; ++i) { const int p = i * 8192 + wid * 1024 + lane * 16, s_ = p >> 9, wq_ = (p & 511) >> 1, kk = (s_ >> 2) * 8 + (wq_ >> 5), cl = wq_ & 31;
    voff[i] = (unsigned)(kk * in.ldv + (s_ & 3) * 32 + cl) * 2u; }
  const int vb0 = (int)(unsigned)(size_t)V_lds + v_rd_base(lane);
  const unsigned ldsw = (unsigned)wid * 1024u;
  int kx[2];
#pragma unroll
  for (int c = 0; c < 2; ++c) kx[c] = r32 * 64 + (((2 * hi + c) ^ ((r32 >> 2) & 3)) << 4);
#define GLDS(gp, lp) __builtin_amdgcn_global_load_lds((const unsigned*)(gp), (LAS unsigned*)(lp), 16, 0, 0)
#define PIECE(i, tk, bk, tv, bv) do { \
    if ((i) < 2) { if (krot[(i) & 1]) GLDS(in.k8r + (size_t)(tk) * (KVBLK * 64) + ksrc[(i) & 1], K_lds + (bk) * SHM_K + kdst[(i) & 1]); \
                   else GLDS(in.k8n + (size_t)(tk) * (KVBLK * 1024) + ksrc[(i) & 1], K_lds + (bk) * SHM_K + kdst[(i) & 1]); } \
    else GLDS((const char*)in.V + (size_t)(tv) * (KVBLK * 2) * in.ldv + voff[(i) & 1], V_lds + (bv) * SHM_V + ((i) & 1) * 8192 + ldsw); } while (0)
#define WAITV(n) asm volatile("s_waitcnt vmcnt(%0)" :: "n"(n) : "memory")
#define WBAR() do { asm volatile("" ::: "memory"); __builtin_amdgcn_s_barrier(); asm volatile("" ::: "memory"); } while (0)
#define RESC() do { if (!st.keep) { int l2_; asm volatile("v_and_b32 %0, 63, %1" : "=v"(l2_) : "v"(threadIdx.x)); const int h2_ = l2_ >> 5; LAS float* al2_ = (LAS float*)(lds + MISC_OFF + 128) + wid * 32; \
    if (h2_ == 0) al2_[l2_] = __builtin_amdgcn_exp2f(st.dm); asm volatile("s_waitcnt lgkmcnt(0)" ::: "memory"); \
    _Pragma("unroll") for (int r = 0; r < 16; ++r) { const float a_ = al2_[crow(r, h2_)]; osum[r] *= a_; _Pragma("unroll") for (int d = 0; d < 4; ++d) o[d][r] *= a_; } asm volatile("s_waitcnt lgkmcnt(0)" ::: "memory"); } } while (0)
#define NXT3(x) ((x) == 2 ? 0 : (x) + 1)
#define PA(k) (*reinterpret_cast<const bf16x8*>(&pw[k]))
#define PKV(f) (bf16x8){f.l[0], f.l[1], f.l[2], f.l[3], f.h[0], f.h[1], f.h[2], f.h[3]}
#define KCAT(lo_, hi_) __builtin_shufflevector(__builtin_bit_cast(v4i_att, lo_), __builtin_bit_cast(v4i_att, hi_), 0, 1, 2, 3, 4, 5, 6, 7)
#define QK8(C_, s_) __builtin_amdgcn_mfma_scale_f32_32x32x64_f8f6f4(KCAT(kl[s_], kh[s_]), qf[s_], C_, 0, 0, 0, 0x7f7f7f7f, 0, 0x7c7c7c7c)
#define BITER(BPAR, PN, PF, Kq, vb, DO_DMA) do { \
    { bf16x8 kl[NKS], kh[NKS]; const int kb0_ = (int)(unsigned)(size_t)(Kq) + kx[0], kb1_ = (int)(unsigned)(size_t)(Kq) + kx[1]; \
      sfor<0, NKS>([&](auto dc) __attribute__((always_inline)) { constexpr int s_ = decltype(dc)::value; k_read<s_ * 4096 + (1 - (BPAR)) * 2048>(kl[s_], kb0_); k_read<s_ * 4096 + (1 - (BPAR)) * 2048>(kh[s_], kb1_); }); \
      sfor<0, NKS>([&](auto gc) __attribute__((always_inline)) { constexpr int g = decltype(gc)::value; \
        asm volatile("s_waitcnt lgkmcnt(4)" : "+v"(kl[g]), "+v"(kh[g])); \
        if constexpr (g == 0) PN = QK8(negm, 0); else PN = QK8(PN, g); \
        if constexpr (DO_DMA) { if constexpr (g == 0) { PIECE(0, tk_, bk_, tv_, bv_); PIECE(1, tk_, bk_, tv_, bv_); } else PIECE(g + 1, tk_, bk_, tv_, bv_); } \
        v_issue<8 * (BPAR) + g>(vf[g], vb); \
        sfor<g * 8 / 3, (g + 1) * 8 / 3>([&](auto ic) __attribute__((always_inline)) { bfin_item<decltype(ic)::value>(PF, pw); }); \
        SBAR(); }); } \
    sfor<0, 10>([&](auto gc) __attribute__((always_inline)) { constexpr int gg = decltype(gc)::value, ksl = gg / 5, d = gg % 5, g = ksl * 4 + d; \
      if constexpr (d < 4) { \
        v_wait<2 * (7 - g < VLA - 1 ? 7 - g : VLA - 1)>(vf[g]); \
        o[d] = __builtin_amdgcn_mfma_f32_32x32x16_bf16(PA(ksl), PKV(vf[g]), o[d], 0, 0, 0); \
        if constexpr (g + VLA < 8) v_issue<8 * (BPAR) + g + VLA>(vf[g + VLA], vb); \
      } else osum = __builtin_amdgcn_mfma_f32_32x32x16_bf16(PA(ksl), ones, osum, 0, 0, 0); \
      if constexpr (gg > 0) sfor<BStart::first(gg - 1, 9), BStart::first(gg, 9)>([&](auto ic) __attribute__((always_inline)) { bstart_item<decltype(ic)::value>(PN, st, negm, thr, hi == 0 ? 1.f : 0.f); }); \
      SBAR(); }); \
    asm volatile("" : "+v"(PN)); \
    RESC(); } while (0)
  f32x16 pA, pB; u32x4 pw[2]; VF vf[8]; const int NT = seq / KVBLK;
#pragma unroll
  for (int t = 0; t < 3; ++t) {
#pragma unroll
    for (int i = 0; i < NI; ++i) PIECE(i, t, t, t, t); }
  WAITV(2 * NI); WBAR();
  { const LAS char* K0 = K_lds; pA = f32x16{};
#pragma unroll
    for (int s = 0; s < NKS; ++s) { const bf16x8 lo = *(const LAS bf16x8*)(K0 + s * 4096 + kx[0]), hh = *(const LAS bf16x8*)(K0 + s * 4096 + kx[1]);
      pA = __builtin_amdgcn_mfma_scale_f32_32x32x64_f8f6f4(KCAT(lo, hh), qf[s], pA, 0, 0, 0, 0x7f7f7f7f, 0, 0x7c7c7c7c); } }
  sfor<0, 8>([&](auto ic) __attribute__((always_inline)) { bstart_item<decltype(ic)::value>(pA, st, negm, thr, hi == 0 ? 1.f : 0.f); });
  { float pmax;
    { auto rr = __builtin_amdgcn_permlane32_swap(__float_as_uint(st.a0), __float_as_uint(st.a0), false, false); pmax = fmaxf(__uint_as_float(rr[0]), __uint_as_float(rr[1])); }
#pragma unroll
    for (int r = 0; r < 16; ++r) { pA[r] -= pmax; negm[r] = -pmax; } }
  sfor<9, BStart::NITEMS>([&](auto ic) __attribute__((always_inline)) { bstart_item<decltype(ic)::value>(pA, st, negm, thr, hi == 0 ? 1.f : 0.f); });
  int kq = 0;
#if PROBE_T == 5
  const unsigned long long t0 = __builtin_amdgcn_s_memtime();
#endif
  for (int t = 0; t + 1 < NT; ++t) {
    const int k1 = NXT3(kq), vq = t & 3;
    const int tk_ = t + 3 < NT ? t + 3 : NT - 1, tv_ = tk_, bk_ = kq, bv_ = (t + 3) & 3;
    BITER(0, pB, pA, K_lds + kq * SHM_K, vb0 + vq * SHM_V, false);
    WAITV(NI); WBAR();
    BITER(1, pA, pB, K_lds + k1 * SHM_K, vb0 + vq * SHM_V, true);
    kq = k1;
  }
#if PROBE_T == 5
  { const unsigned long long t1 = __builtin_amdgcn_s_memtime(); if (probe != nullptr && tid == 0) { probe[0] = 0.f; probe[1] = ((float)(t1 - t0) * (1.f / (NT - 1)) - PROBE_BASE) * 0.05f; } }
#endif
  { const int vq = (NT - 1) & 3; const int tk_ = 0, tv_ = 0, bk_ = 0, bv_ = 0; (void)tk_; (void)tv_; (void)bk_; (void)bv_;
    BITER(0, pB, pA, K_lds + kq * SHM_K, vb0 + vq * SHM_V, false);
    sfor<0, 8>([&](auto ic) __attribute__((always_inline)) { bfin_item<decltype(ic)::value>(pB, pw); });
    const int vb = vb0 + vq * SHM_V;
    sfor<0, VLA>([&](auto gc) __attribute__((always_inline)) { v_issue<8 + decltype(gc)::value>(vf[decltype(gc)::value], vb); });
    sfor<0, 8>([&](auto gc) __attribute__((always_inline)) { constexpr int g = decltype(gc)::value, ksl = g >> 2, d = g & 3;
      v_wait<2 * (7 - g < VLA - 1 ? 7 - g : VLA - 1)>(vf[g]);
      o[d] = __builtin_amdgcn_mfma_f32_32x32x16_bf16(PA(ksl), PKV(vf[g]), o[d], 0, 0, 0);
      if constexpr (g + VLA < 8) v_issue<8 + g + VLA>(vf[g + VLA], vb);
      if constexpr (d == 3) osum = __builtin_amdgcn_mfma_f32_32x32x16_bf16(PA(ksl), ones, osum, 0, 0, 0);
      SBAR(); }); }
#pragma unroll
  for (int r = 0; r < 16; ++r) { const float rl = __builtin_amdgcn_rcpf(osum[r]);
#pragma unroll
    for (int d = 0; d < 4; ++d) o[d][r] *= rl; }
  WAITV(0); asm volatile("s_waitcnt lgkmcnt(0)" ::: "memory"); WBAR();
#undef GLDS
#undef PIECE
#undef WAITV
#undef WBAR
#undef RESC
#undef NXT3
#undef PA
#undef PKV
#undef KCAT
#undef QK8
#undef BITER
}
struct SrcD8 { const unsigned char* q8; const unsigned char* k8; const bf16_t* V; int ldv; };
__device__ __forceinline__ void attn_core_pl8(const SrcD8 in, const float thr, const int seq, LAS char* lds, f32x16 (&o)[4], float* probe = nullptr) {
  constexpr int SHM_K = 8192, NEXS = 32, NEXF = 0, VLA = 3;
  using SS = StartSched<NEXS>; using FS = FinSched<NEXF>;
  int lane; asm volatile("v_and_b32 %0, 63, %1" : "=v"(lane) : "v"(threadIdx.x));
  const int tid = threadIdx.x, wid = __builtin_amdgcn_readfirstlane(tid >> 6), r32 = lane & 31, hi = (lane >> 5) & 1, wq = wid & 3, mp = wid >> 2;
  LAS char* V_lds = lds; LAS char* K_lds = lds + 3 * SHM_V;
  SMS st; st.dm = 0.f; st.keep = true;
  f32x16 negm = f32x16{}, osum = f32x16{};
#pragma unroll
  for (int d = 0; d < 4; ++d) o[d] = f32x16{};
  const bf16x8 ones = {16256, 16256, 16256, 16256, 16256, 16256, 16256, 16256};
  v8i_att qf;
  { const unsigned char* Qw = in.q8 + (size_t)(wq * QBLK + r32) * 1024 + mp * 64 + hi * 32;
    const v4i_att lo = *(const v4i_att*)(Qw), hh = *(const v4i_att*)(Qw + 16); qf = __builtin_shufflevector(lo, hh, 0, 1, 2, 3, 4, 5, 6, 7); }
  const unsigned ksrc = (unsigned)(((wid & 3) * 16 + (lane >> 2)) * 1024 + (wid >> 2) * 64 + (((lane & 3) ^ ((lane >> 4) & 3)) << 4));
  const int kdst = wid * 1024 + lane * 16;
  unsigned voff[2];
#pragma unroll
  for (int i = 0; i < 2; ++i) { const int p = i * 8192 + wid * 1024 + lane * 16, s_ = p >> 9, wq_ = (p & 511) >> 1, kk = (s_ >> 2) * 8 + (wq_ >> 5), cl = wq_ & 31;
    voff[i] = (unsigned)(kk * in.ldv + (s_ & 3) * 32 + cl) * 2u; }
  const int vb0 = (int)(unsigned)(size_t)V_lds + v_rd_base(lane);
  const unsigned ldsw = (unsigned)wid * 1024u;
  const LAS char* Kw = K_lds + mp * 4096;
  int kx[2];
#pragma unroll
  for (int c = 0; c < 2; ++c) kx[c] = r32 * 64 + (((2 * hi + c) ^ ((r32 >> 2) & 3)) << 4);
#define GLDS(gp, lp) __builtin_amdgcn_global_load_lds((const unsigned*)(gp), (LAS unsigned*)(lp), 16, 0, 0)
#define ISSUE_K(t, b) GLDS(in.k8 + (size_t)(t) * (KVBLK * 1024) + ksrc, K_lds + (b) * SHM_K + kdst)
#define ISSUE_V(t, b) do { const char* vb_ = (const char*)in.V + (size_t)(t) * (KVBLK * 2) * in.ldv; GLDS(vb_ + voff[0], V_lds + (b) * SHM_V + ldsw); GLDS(vb_ + voff[1], V_lds + (b) * SHM_V + 8192 + ldsw); } while (0)
#define WAITV(n) asm volatile("s_waitcnt vmcnt(%0)" :: "n"(n) : "memory")
#define WBAR() do { asm volatile("" ::: "memory"); __builtin_amdgcn_s_barrier(); asm volatile("" ::: "memory"); } while (0)
#define RESC() do { if (!st.keep) { int l2_; asm volatile("v_and_b32 %0, 63, %1" : "=v"(l2_) : "v"(threadIdx.x)); const int h2_ = l2_ >> 5; LAS float* al2_ = (LAS float*)(lds + MISC_OFF + 128) + wid * 32; \
    if (h2_ == 0) al2_[l2_] = __builtin_amdgcn_exp2f(st.dm); asm volatile("s_waitcnt lgkmcnt(0)" ::: "memory"); \
    _Pragma("unroll") for (int r = 0; r < 16; ++r) { const float a_ = al2_[crow(r, h2_)]; osum[r] *= a_; _Pragma("unroll") for (int d = 0; d < 4; ++d) o[d][r] *= a_; } asm volatile("s_waitcnt lgkmcnt(0)" ::: "memory"); } } while (0)
#define NXT3(x) ((x) == 2 ? 0 : (x) + 1)
#define PA(ks) (*reinterpret_cast<const bf16x8*>(&pw[ks]))
#define PKV(f) (bf16x8){f.l[0], f.l[1], f.l[2], f.l[3], f.h[0], f.h[1], f.h[2], f.h[3]}
#define KCAT(lo_, hi_) __builtin_shufflevector(__builtin_bit_cast(v4i_att, lo_), __builtin_bit_cast(v4i_att, hi_), 0, 1, 2, 3, 4, 5, 6, 7)
#define PHASE1(PN0, PN1, PF0, PF1, Ks, vb) do { \
    bf16x8 kl0, kh0, kl1, kh1; { const int a0_ = (int)(unsigned)(size_t)(Ks) + kx[0], a1_ = (int)(unsigned)(size_t)(Ks) + kx[1]; \
      k_read<0>(kl0, a0_); k_read<0>(kh0, a1_); k_read<2048>(kl1, a0_); k_read<2048>(kh1, a1_); } \
    asm volatile("s_waitcnt lgkmcnt(2)" : "+v"(kl0), "+v"(kh0)); \
    PN0 = __builtin_amdgcn_mfma_scale_f32_32x32x64_f8f6f4(KCAT(kl0, kh0), qf, negm, 0, 0, 0, 0x7f7f7f7f, 0, 0x7c7c7c7c); \
    ISSUE_K(tk_, bq); GLDS((const char*)in.V + (size_t)tv_ * (KVBLK * 2) * in.ldv + voff[0], V_lds + b2 * SHM_V + ldsw); \
    v_issue<0>(vf[0], vb); \
    sfor<0, 8>([&](auto ic) __attribute__((always_inline)) { fin_item<decltype(ic)::value, NEXF>(PF0, PF1, st, pw); }); \
    SBAR(); \
    asm volatile("s_waitcnt lgkmcnt(2)" : "+v"(kl1), "+v"(kh1)); \
    PN1 = __builtin_amdgcn_mfma_scale_f32_32x32x64_f8f6f4(KCAT(kl1, kh1), qf, negm, 0, 0, 0, 0x7f7f7f7f, 0, 0x7c7c7c7c); \
    GLDS((const char*)in.V + (size_t)tv_ * (KVBLK * 2) * in.ldv + voff[1], V_lds + b2 * SHM_V + 8192 + ldsw); \
    v_issue<1>(vf[1], vb); v_issue<2>(vf[2], vb); \
    sfor<8, 16>([&](auto ic) __attribute__((always_inline)) { fin_item<decltype(ic)::value, NEXF>(PF0, PF1, st, pw); }); \
    SBAR(); } while (0)
#define PHASE2(PS0, PS1, vb) do { \
    sfor<0, 20>([&](auto gc) __attribute__((always_inline)) { constexpr int gg = decltype(gc)::value, ks = gg / 5, d = gg % 5, g = ks * 4 + d; \
      if constexpr (d < 4) { \
        v_wait<2 * (15 - g < VLA - 1 ? 15 - g : VLA - 1)>(vf[g]); \
        o[d] = __builtin_amdgcn_mfma_f32_32x32x16_bf16(PA(ks), PKV(vf[g]), o[d], 0, 0, 0); \
        if constexpr (g + VLA < 16) v_issue<g + VLA>(vf[g + VLA], vb); \
      } else osum = __builtin_amdgcn_mfma_f32_32x32x16_bf16(PA(ks), ones, osum, 0, 0, 0); \
      sfor<SS::first(gg, 20), SS::first(gg + 1, 20)>([&](auto ic) __attribute__((always_inline)) { start_item<decltype(ic)::value, NEXS>(PS0, PS1, st, negm, thr, hi == 0 ? 1.f : 0.f); }); \
      SBAR(); }); \
    asm volatile("" : "+v"(PS0), "+v"(PS1)); \
    RESC(); } while (0)
  f32x16 pA0, pA1, pB0, pB1; u32x4 pw[4]; VF vf[16]; const int NT = seq / KVBLK;
  ISSUE_K(0, 0); ISSUE_K(1, 1); ISSUE_V(0, 0);
  WAITV(3); WBAR();
  ISSUE_K(2, 2); ISSUE_V(1, 1);
  { const bf16x8 l0 = *(const LAS bf16x8*)(Kw + kx[0]), h0 = *(const LAS bf16x8*)(Kw + kx[1]), l1 = *(const LAS bf16x8*)(Kw + 2048 + kx[0]), h1 = *(const LAS bf16x8*)(Kw + 2048 + kx[1]);
    pA0 = __builtin_amdgcn_mfma_scale_f32_32x32x64_f8f6f4(KCAT(l0, h0), qf, f32x16{}, 0, 0, 0, 0x7f7f7f7f, 0, 0x7c7c7c7c);
    pA1 = __builtin_amdgcn_mfma_scale_f32_32x32x64_f8f6f4(KCAT(l1, h1), qf, f32x16{}, 0, 0, 0, 0x7f7f7f7f, 0, 0x7c7c7c7c); }
  sfor<0, 16>([&](auto ic) __attribute__((always_inline)) { start_item<decltype(ic)::value, NEXS>(pA0, pA1, st, negm, thr, hi == 0 ? 1.f : 0.f); });
  { float pmax;
    { auto rr = __builtin_amdgcn_permlane32_swap(__float_as_uint(st.a0), __float_as_uint(st.a0), false, false); pmax = fmaxf(__uint_as_float(rr[0]), __uint_as_float(rr[1])); }
#pragma unroll
    for (int r = 0; r < 16; ++r) { pA0[r] -= pmax; pA1[r] -= pmax; negm[r] = -pmax; } }
  sfor<17, SS::NITEMS>([&](auto ic) __attribute__((always_inline)) { start_item<decltype(ic)::value, NEXS>(pA0, pA1, st, negm, thr, hi == 0 ? 1.f : 0.f); });
  int bq = 0;
#define ITER(j, PN0, PN1, PF0, PF1) do { const int b1 = NXT3(bq), b2 = NXT3(b1); \
    WAITV(3); WBAR(); \
    const int tk_ = (j) + 3 < NT ? (j) + 3 : NT - 1, tv_ = (j) + 2 < NT ? (j) + 2 : NT - 1; \
    PHASE1(PN0, PN1, PF0, PF1, Kw + b1 * SHM_K, vb0 + bq * SHM_V); \
    PHASE2(PN0, PN1, vb0 + bq * SHM_V); \
    bq = b1; } while (0)
#if PROBE_T == 2
  const unsigned long long t0 = __builtin_amdgcn_s_memtime();
#endif
  for (int j = 0; j + 2 < NT; j += 2) { ITER(j, pB0, pB1, pA0, pA1); ITER(j + 1, pA0, pA1, pB0, pB1); }
  ITER(NT - 2, pB0, pB1, pA0, pA1);
#if PROBE_T == 2
  { const unsigned long long t1 = __builtin_amdgcn_s_memtime(); if (probe != nullptr && tid == 0) { probe[0] = 0.f; probe[1] = ((float)(t1 - t0) * (1.f / (NT - 1)) - 1500.f) * 0.05f; } }
#endif
  sfor<0, FS::NITEMS>([&](auto ic) __attribute__((always_inline)) { fin_item<decltype(ic)::value, NEXF>(pB0, pB1, st, pw); });
  WAITV(0); WBAR();
  { const int vb = vb0 + bq * SHM_V;
    sfor<0, VLA>([&](auto gc) __attribute__((always_inline)) { v_issue<decltype(gc)::value>(vf[decltype(gc)::value], vb); });
    sfor<0, 16>([&](auto gc) __attribute__((always_inline)) { constexpr int g = decltype(gc)::value, ks = g >> 2, d = g & 3;
      v_wait<2 * (15 - g < VLA - 1 ? 15 - g : VLA - 1)>(vf[g]);
      o[d] = __builtin_amdgcn_mfma_f32_32x32x16_bf16(PA(ks), PKV(vf[g]), o[d], 0, 0, 0);
      if constexpr (g + VLA < 16) v_issue<g + VLA>(vf[g + VLA], vb);
      if constexpr (d == 3) osum = __builtin_amdgcn_mfma_f32_32x32x16_bf16(PA(ks), ones, osum, 0, 0, 0);
      SBAR(); }); }
#pragma unroll
  for (int r = 0; r < 16; ++r) { const float rl = __builtin_amdgcn_rcpf(osum[r]);
#pragma unroll
    for (int d = 0; d < 4; ++d) o[d][r] *= rl; }
  asm volatile("s_waitcnt lgkmcnt(0)" ::: "memory"); WBAR();
#undef GLDS
#undef ISSUE_K
#undef ISSUE_V
#undef WAITV
#undef WBAR
#undef RESC
#undef NXT3
#undef PA
#undef PKV
#undef KCAT
#undef PHASE1
#undef PHASE2
#undef ITER
}
struct SrcDH { const bf16_t* Q; const bf16_t* K; const unsigned char* q8; const unsigned char* k8; const bf16_t* V; int ldv; };
template <int MP>
__device__ __forceinline__ void attn_core_plh(const SrcDH in, const float thr, const int seq, LAS char* lds, f32x16 (&o)[4], float* probe = nullptr) {
  constexpr int SHM_K = 12288, NKS = 4, NG1 = 8, NEXS = 32, NEXF = 0, VLA = 3;
  using SS = StartSched<NEXS>; using FS = FinSched<NEXF>;
  int lane; asm volatile("v_and_b32 %0, 63, %1" : "=v"(lane) : "v"(threadIdx.x));
  const int tid = threadIdx.x, wid = __builtin_amdgcn_readfirstlane(tid >> 6), r32 = lane & 31, hi = (lane >> 5) & 1, wq = wid & 3; constexpr int mp = MP;
  LAS char* V_lds = lds; LAS char* K_lds = lds + 3 * SHM_V;
  SMS st; st.dm = 0.f; st.keep = true;
  f32x16 negm = f32x16{}, osum = f32x16{};
#pragma unroll
  for (int d = 0; d < 4; ++d) o[d] = f32x16{};
  const bf16x8 ones = {16256, 16256, 16256, 16256, 16256, 16256, 16256, 16256};
  bf16x8 qr[NKS]; v8i_att qf = {};
  if constexpr (mp == 0) { const bf16_t* Qw = in.Q + (size_t)(wq * QBLK + r32) * 1024 + hi * 8;
#pragma unroll
    for (int d0 = 0; d0 < NKS; ++d0) qr[d0] = *(const bf16x8*)(Qw + d0 * 16); }
  else { const unsigned char* Qw = in.q8 + (size_t)(wq * QBLK + r32) * 1024 + 64 + hi * 32;
    const v4i_att lo = *(const v4i_att*)(Qw), hh = *(const v4i_att*)(Qw + 16); qf = __builtin_shufflevector(lo, hh, 0, 1, 2, 3, 4, 5, 6, 7);
#pragma unroll
    for (int d0 = 0; d0 < NKS; ++d0) qr[d0] = bf16x8{}; }
  const int krow = wid * 8 + (lane >> 3), kslot = (lane & 7) ^ ((krow >> 1) & 7);
  const unsigned koff = (unsigned)(krow * 1024 + kslot * 8) * 2u;
  const unsigned ksrc8 = (unsigned)(((wid & 3) * 16 + (lane >> 2)) * 1024 + 64 + (((lane & 3) ^ ((lane >> 4) & 3)) << 4));
  const int kdst8 = 8192 + (wid & 3) * 1024 + lane * 16;
  unsigned voff[2];
#pragma unroll
  for (int i = 0; i < 2; ++i) { const int p = i * 8192 + wid * 1024 + lane * 16, s_ = p >> 9, wq_ = (p & 511) >> 1, kk = (s_ >> 2) * 8 + (wq_ >> 5), cl = wq_ & 31;
    voff[i] = (unsigned)(kk * in.ldv + (s_ & 3) * 32 + cl) * 2u; }
  const int vb0 = (int)(unsigned)(size_t)V_lds + v_rd_base(lane);
  const unsigned ldsw = (unsigned)wid * 1024u;
  int kx[2];
#pragma unroll
  for (int c = 0; c < 2; ++c) kx[c] = 8192 + r32 * 64 + (((2 * hi + c) ^ ((r32 >> 2) & 3)) << 4);
#define GLDS(gp, lp) __builtin_amdgcn_global_load_lds((const unsigned*)(gp), (LAS unsigned*)(lp), 16, 0, 0)
#define ISSUE_K(t, b) do { GLDS((const char*)in.K + (size_t)(t) * (KVBLK * 2) * 1024 + koff, K_lds + (b) * SHM_K + ldsw); GLDS(in.k8 + (size_t)(t) * (KVBLK * 1024) + ksrc8, K_lds + (b) * SHM_K + kdst8); } while (0)
#define ISSUE_V(t, b) do { const char* vb_ = (const char*)in.V + (size_t)(t) * (KVBLK * 2) * in.ldv; GLDS(vb_ + voff[0], V_lds + (b) * SHM_V + ldsw); GLDS(vb_ + voff[1], V_lds + (b) * SHM_V + 8192 + ldsw); } while (0)
#define DMA_PIECE(i) do { if ((i) == 0) GLDS((const char*)in.K + (size_t)tk_ * (KVBLK * 2) * 1024 + koff, K_lds + bq * SHM_K + ldsw); \
    else if ((i) == 1) GLDS(in.k8 + (size_t)tk_ * (KVBLK * 1024) + ksrc8, K_lds + bq * SHM_K + kdst8); \
    else GLDS((const char*)in.V + (size_t)tv_ * (KVBLK * 2) * in.ldv + voff[(i) & 1], V_lds + b2 * SHM_V + ((i) & 1) * 8192 + ldsw); } while (0)
#define WAITV(n) asm volatile("s_waitcnt vmcnt(%0)" :: "n"(n) : "memory")
#define WBAR() do { asm volatile("" ::: "memory"); __builtin_amdgcn_s_barrier(); asm volatile("" ::: "memory"); } while (0)
#define RESC() do { if (!st.keep) { int l2_; asm volatile("v_and_b32 %0, 63, %1" : "=v"(l2_) : "v"(threadIdx.x)); const int h2_ = l2_ >> 5; LAS float* al2_ = (LAS float*)(lds + MISC_OFF + 128) + wid * 32; \
    if (h2_ == 0) al2_[l2_] = __builtin_amdgcn_exp2f(st.dm); asm volatile("s_waitcnt lgkmcnt(0)" ::: "memory"); \
    _Pragma("unroll") for (int r = 0; r < 16; ++r) { const float a_ = al2_[crow(r, h2_)]; osum[r] *= a_; _Pragma("unroll") for (int d = 0; d < 4; ++d) o[d][r] *= a_; } asm volatile("s_waitcnt lgkmcnt(0)" ::: "memory"); } } while (0)
#define NXT3(x) ((x) == 2 ? 0 : (x) + 1)
#define KFRAG(Ks, d, blk) (*(const LAS bf16x8*)((Ks) + KSW((blk) * 32 + r32, ((d) * 16 + hi * 8) * 2)))
#define PA(ks) (*reinterpret_cast<const bf16x8*>(&pw[ks]))
#define PKV(f) (bf16x8){f.l[0], f.l[1], f.l[2], f.l[3], f.h[0], f.h[1], f.h[2], f.h[3]}
#define KCAT(lo_, hi_) __builtin_shufflevector(__builtin_bit_cast(v4i_att, lo_), __builtin_bit_cast(v4i_att, hi_), 0, 1, 2, 3, 4, 5, 6, 7)
#define PHASE1_BF(PN0, PN1, PF0, PF1, Ks, vb) do { \
    bf16x8 kf[NKS][2]; kf[0][0] = KFRAG(Ks, 0, 0); kf[0][1] = KFRAG(Ks, 0, 1); \
    sfor<0, NG1>([&](auto gc) __attribute__((always_inline)) { constexpr int g = decltype(gc)::value, d = g >> 1, blk = g & 1; \
      if constexpr (blk == 0 && d + 1 < NKS) { kf[d + 1][0] = KFRAG(Ks, d + 1, 0); kf[d + 1][1] = KFRAG(Ks, d + 1, 1); } \
      if constexpr (blk == 0) { if constexpr (d == 0) mfma_c(PN0, kf[d][0], qr[d], negm); else PN0 = __builtin_amdgcn_mfma_f32_32x32x16_bf16(kf[d][0], qr[d], PN0, 0, 0, 0); } \
      else              { if constexpr (d == 0) mfma_c(PN1, kf[d][1], qr[d], negm); else PN1 = __builtin_amdgcn_mfma_f32_32x32x16_bf16(kf[d][1], qr[d], PN1, 0, 0, 0); } \
      if constexpr (g < 4) DMA_PIECE(g); \
      if constexpr (g >= NG1 - VLA) v_issue<g - (NG1 - VLA)>(vf[g - (NG1 - VLA)], vb); \
      sfor<FS::first(g, NG1), FS::first(g + 1, NG1)>([&](auto ic) __attribute__((always_inline)) { fin_item<decltype(ic)::value, NEXF>(PF0, PF1, st, pw); }); \
      SBAR(); }); } while (0)
#define PHASE1_F8(PN0, PN1, PF0, PF1, Ks, vb) do { \
    bf16x8 kl0, kh0, kl1, kh1; { const int a0_ = (int)(unsigned)(size_t)(Ks) + kx[0], a1_ = (int)(unsigned)(size_t)(Ks) + kx[1]; \
      k_read<0>(kl0, a0_); k_read<0>(kh0, a1_); k_read<2048>(kl1, a0_); k_read<2048>(kh1, a1_); } \
    asm volatile("s_waitcnt lgkmcnt(2)" : "+v"(kl0), "+v"(kh0)); \
    PN0 = __builtin_amdgcn_mfma_scale_f32_32x32x64_f8f6f4(KCAT(kl0, kh0), qf, negm, 0, 0, 0, 0x7f7f7f7f, 0, 0x7c7c7c7c); \
    DMA_PIECE(0); DMA_PIECE(1); \
    v_issue<0>(vf[0], vb); \
    sfor<0, 8>([&](auto ic) __attribute__((always_inline)) { fin_item<decltype(ic)::value, NEXF>(PF0, PF1, st, pw); }); \
    SBAR(); \
    asm volatile("s_waitcnt lgkmcnt(2)" : "+v"(kl1), "+v"(kh1)); \
    PN1 = __builtin_amdgcn_mfma_scale_f32_32x32x64_f8f6f4(KCAT(kl1, kh1), qf, negm, 0, 0, 0, 0x7f7f7f7f, 0, 0x7c7c7c7c); \
    DMA_PIECE(2); DMA_PIECE(3); \
    v_issue<1>(vf[1], vb); v_issue<2>(vf[2], vb); \
    sfor<8, 16>([&](auto ic) __attribute__((always_inline)) { fin_item<decltype(ic)::value, NEXF>(PF0, PF1, st, pw); }); \
    SBAR(); } while (0)
#define PHASE2(PS0, PS1, vb) do { \
    sfor<0, 20>([&](auto gc) __attribute__((always_inline)) { constexpr int gg = decltype(gc)::value, ks = gg / 5, d = gg % 5, g = ks * 4 + d; \
      if constexpr (d < 4) { \
        v_wait<2 * (15 - g < VLA - 1 ? 15 - g : VLA - 1)>(vf[g]); \
        o[d] = __builtin_amdgcn_mfma_f32_32x32x16_bf16(PA(ks), PKV(vf[g]), o[d], 0, 0, 0); \
        if constexpr (g + VLA < 16) v_issue<g + VLA>(vf[g + VLA], vb); \
      } else osum = __builtin_amdgcn_mfma_f32_32x32x16_bf16(PA(ks), ones, osum, 0, 0, 0); \
      sfor<SS::first(gg, 20), SS::first(gg + 1, 20)>([&](auto ic) __attribute__((always_inline)) { start_item<decltype(ic)::value, NEXS>(PS0, PS1, st, negm, thr, hi == 0 ? 1.f : 0.f); }); \
      SBAR(); }); \
    asm volatile("" : "+v"(PS0), "+v"(PS1)); \
    RESC(); } while (0)
  f32x16 pA0, pA1, pB0, pB1; u32x4 pw[4]; VF vf[16]; const int NT = seq / KVBLK;
  ISSUE_K(0, 0); ISSUE_K(1, 1); ISSUE_V(0, 0);
  WAITV(4); WBAR();
  ISSUE_K(2, 2); ISSUE_V(1, 1);
  if constexpr (mp == 0) { bf16x8 kf[NKS][2];
#pragma unroll
    for (int d = 0; d < NKS; ++d) { kf[d][0] = KFRAG(K_lds, d, 0); kf[d][1] = KFRAG(K_lds, d, 1); }
    pA0 = f32x16{}; pA1 = f32x16{};
#pragma unroll
    for (int d = 0; d < NKS; ++d) { pA0 = __builtin_amdgcn_mfma_f32_32x32x16_bf16(kf[d][0], qr[d], pA0, 0, 0, 0); pA1 = __builtin_amdgcn_mfma_f32_32x32x16_bf16(kf[d][1], qr[d], pA1, 0, 0, 0); } }
  else { const bf16x8 l0 = *(const LAS bf16x8*)(K_lds + kx[0]), h0 = *(const LAS bf16x8*)(K_lds + kx[1]), l1 = *(const LAS bf16x8*)(K_lds + 2048 + kx[0]), h1 = *(const LAS bf16x8*)(K_lds + 2048 + kx[1]);
    pA0 = __builtin_amdgcn_mfma_scale_f32_32x32x64_f8f6f4(KCAT(l0, h0), qf, f32x16{}, 0, 0, 0, 0x7f7f7f7f, 0, 0x7c7c7c7c);
    pA1 = __builtin_amdgcn_mfma_scale_f32_32x32x64_f8f6f4(KCAT(l1, h1), qf, f32x16{}, 0, 0, 0, 0x7f7f7f7f, 0, 0x7c7c7c7c); }
  sfor<0, 16>([&](auto ic) __attribute__((always_inline)) { start_item<decltype(ic)::value, NEXS>(pA0, pA1, st, negm, thr, hi == 0 ? 1.f : 0.f); });
  { float pmax;
    { auto rr = __builtin_amdgcn_permlane32_swap(__float_as_uint(st.a0), __float_as_uint(st.a0), false, false); pmax = fmaxf(__uint_as_float(rr[0]), __uint_as_float(rr[1])); }
#pragma unroll
    for (int r = 0; r < 16; ++r) { pA0[r] -= pmax; pA1[r] -= pmax; negm[r] = -pmax; } }
  sfor<17, SS::NITEMS>([&](auto ic) __attribute__((always_inline)) { start_item<decltype(ic)::value, NEXS>(pA0, pA1, st, negm, thr, hi == 0 ? 1.f : 0.f); });
  int bq = 0;
#define ITER(j, PN0, PN1, PF0, PF1) do { const int b1 = NXT3(bq), b2 = NXT3(b1); \
    WAITV(4); WBAR(); \
    const int tk_ = (j) + 3 < NT ? (j) + 3 : NT - 1, tv_ = (j) + 2 < NT ? (j) + 2 : NT - 1; \
    if constexpr (mp == 0) PHASE1_BF(PN0, PN1, PF0, PF1, K_lds + b1 * SHM_K, vb0 + bq * SHM_V); else PHASE1_F8(PN0, PN1, PF0, PF1, K_lds + b1 * SHM_K, vb0 + bq * SHM_V); \
    PHASE2(PN0, PN1, vb0 + bq * SHM_V); \
    bq = b1; } while (0)
#if PROBE_T == 2
  const unsigned long long t0 = __builtin_amdgcn_s_memtime();
#endif
  for (int j = 0; j + 2 < NT; j += 2) { ITER(j, pB0, pB1, pA0, pA1); ITER(j + 1, pA0, pA1, pB0, pB1); }
  ITER(NT - 2, pB0, pB1, pA0, pA1);
#if PROBE_T == 2
  { const unsigned long long t1 = __builtin_amdgcn_s_memtime(); if (probe != nullptr && tid == 0) { probe[0] = 0.f; probe[1] = ((float)(t1 - t0) * (1.f / (NT - 1)) - 1500.f) * 0.05f; } }
#endif
  sfor<0, FS::NITEMS>([&](auto ic) __attribute__((always_inline)) { fin_item<decltype(ic)::value, NEXF>(pB0, pB1, st, pw); });
  WAITV(0); WBAR();
  { const int vb = vb0 + bq * SHM_V;
    sfor<0, VLA>([&](auto gc) __attribute__((always_inline)) { v_issue<decltype(gc)::value>(vf[decltype(gc)::value], vb); });
    sfor<0, 16>([&](auto gc) __attribute__((always_inline)) { constexpr int g = decltype(gc)::value, ks = g >> 2, d = g & 3;
      v_wait<2 * (15 - g < VLA - 1 ? 15 - g : VLA - 1)>(vf[g]);
      o[d] = __builtin_amdgcn_mfma_f32_32x32x16_bf16(PA(ks), PKV(vf[g]), o[d], 0, 0, 0);
      if constexpr (g + VLA < 16) v_issue<g + VLA>(vf[g + VLA], vb);
      if constexpr (d == 3) osum = __builtin_amdgcn_mfma_f32_32x32x16_bf16(PA(ks), ones, osum, 0, 0, 0);
      SBAR(); }); }
#pragma unroll
  for (int r = 0; r < 16; ++r) { const float rl = __builtin_amdgcn_rcpf(osum[r]);
#pragma unroll
    for (int d = 0; d < 4; ++d) o[d][r] *= rl; }
  asm volatile("s_waitcnt lgkmcnt(0)" ::: "memory"); WBAR();
#undef GLDS
#undef ISSUE_K
#undef ISSUE_V
#undef DMA_PIECE
#undef WAITV
#undef WBAR
#undef RESC
#undef NXT3
#undef KFRAG
#undef PA
#undef PKV
#undef KCAT
#undef PHASE1_BF
#undef PHASE1_F8
#undef PHASE2
#undef ITER
}
struct SrcM8 { const unsigned char* q8; const unsigned char* k8n; const unsigned char* k8r; const unsigned char* vT; };
template <int N> __device__ __forceinline__ void fin8_item(f32x16& P0, f32x16& P1, v8i_att& p8, float& ls0, float& ls1) {
  if constexpr (N < 16) P1[N] = __builtin_amdgcn_exp2f(P1[N]);
  else if constexpr (N < 32) { constexpr int k = N - 16, e = 2 * k; const float a = e < 16 ? P0[e] : P1[e - 16], b = e < 16 ? P0[e + 1] : P1[e - 15];
    if constexpr ((k & 1) == 0) p8[k >> 1] = __builtin_amdgcn_cvt_pk_fp8_f32(a, b, 0, false); else p8[k >> 1] = __builtin_amdgcn_cvt_pk_fp8_f32(a, b, p8[k >> 1], true); }
  else { constexpr int e = N - 32; const float v = e < 16 ? P0[e] : P1[e - 16];
    if constexpr (e & 1) asm("v_add_f32_e32 %0, %1, %0" : "+v"(ls1) : "v"(v)); else asm("v_add_f32_e32 %0, %1, %0" : "+v"(ls0) : "v"(v)); }
}
constexpr int fin8_first(int g) { return g == 0 ? 0 : g == 1 ? 7 : g == 2 ? 14 : g == 3 ? 26 : g == 4 ? 39 : g == 5 ? 52 : 64; }
__device__ __forceinline__ void attn_core_mla8(const SrcM8 in, const float thr, const int seq, LAS char* lds, f32x16 (&o)[4], float* probe = nullptr) {
  constexpr int SHM_K = 3 * 4096, SHM_V8 = 8192, NKS = 3;
  using SS = StartSched<16>;
  int lane; asm volatile("v_and_b32 %0, 63, %1" : "=v"(lane) : "v"(threadIdx.x));
  const int tid = threadIdx.x, wid = __builtin_amdgcn_readfirstlane(tid >> 6), r32 = lane & 31, hi = (lane >> 5) & 1;
  LAS char* V_lds = lds; LAS char* K_lds = lds + 3 * SHM_V8;
  SMS st; st.dm = 0.f; st.keep = true;
  f32x16 negm = f32x16{};
  float ls0 = 0.f, ls1 = 0.f;
#pragma unroll
  for (int d = 0; d < 4; ++d) o[d] = f32x16{};
  v8i_att qf[NKS];
  { const unsigned char* Qw = in.q8 + (size_t)(wid * QBLK + r32) * 1536 + hi * 32;
#pragma unroll
    for (int s = 0; s < NKS; ++s) { const v4i_att lo = *(const v4i_att*)(Qw + s * 64), hh = *(const v4i_att*)(Qw + s * 64 + 16); qf[s] = __builtin_shufflevector(lo, hh, 0, 1, 2, 3, 4, 5, 6, 7); } }
  unsigned ksrc[2]; int kdst[2]; bool krot[2];
#pragma unroll
  for (int i = 0; i < 2; ++i) { const int p0 = wid * 2 + i, p = p0 < 12 ? p0 : p0 - 4, s = p >> 2, q = p & 3, row = q * 16 + (lane >> 2), lc = (lane & 3) ^ ((lane >> 4) & 3);
    krot[i] = (s == 2); ksrc[i] = krot[i] ? (unsigned)(row * 64 + lc * 16) : (unsigned)(row * 1024 + s * 64 + lc * 16); kdst[i] = s * 4096 + q * 1024 + lane * 16; }
  const unsigned vsrc = (unsigned)((wid * 16 + (lane >> 2)) * 4096 + (((lane & 3) ^ ((lane >> 4) & 3)) << 4));
  const int vdst = wid * 1024 + lane * 16;
  int kx[2];
#pragma unroll
  for (int c = 0; c < 2; ++c) kx[c] = r32 * 64 + (((2 * hi + c) ^ ((r32 >> 2) & 3)) << 4);
#define GLDS(gp, lp) __builtin_amdgcn_global_load_lds((const unsigned*)(gp), (LAS unsigned*)(lp), 16, 0, 0)
#define PIECE_K(i, tk, bk) do { if (krot[i]) GLDS(in.k8r + (size_t)(tk) * (KVBLK * 64) + ksrc[i], K_lds + (bk) * SHM_K + kdst[i]); \
                               else GLDS(in.k8n + (size_t)(tk) * (KVBLK * 1024) + ksrc[i], K_lds + (bk) * SHM_K + kdst[i]); } while (0)
#define PIECE_V(tv, bv) GLDS(in.vT + (size_t)(tv) * KVBLK + vsrc, V_lds + (bv) * SHM_V8 + vdst)
#define WAITV(n) asm volatile("s_waitcnt vmcnt(%0)" :: "n"(n) : "memory")
#define WBAR() do { asm volatile("" ::: "memory"); __builtin_amdgcn_s_barrier(); asm volatile("" ::: "memory"); } while (0)
#define RESC() do { if (!st.keep) { int l2_; asm volatile("v_and_b32 %0, 63, %1" : "=v"(l2_) : "v"(threadIdx.x)); const int h2_ = l2_ >> 5; LAS float* al2_ = (LAS float*)(lds + MISC_OFF + 128) + wid * 32; \
    { const float am_ = __builtin_amdgcn_exp2f(st.dm); ls0 *= am_; ls1 *= am_; if (h2_ == 0) al2_[l2_] = am_; } asm volatile("s_waitcnt lgkmcnt(0)" ::: "memory"); \
    _Pragma("unroll") for (int r = 0; r < 16; ++r) { const float a_ = al2_[crow(r, h2_)]; _Pragma("unroll") for (int d = 0; d < 4; ++d) o[d][r] *= a_; } asm volatile("s_waitcnt lgkmcnt(0)" ::: "memory"); } } while (0)
#define NXT3(x) ((x) == 2 ? 0 : (x) + 1)
#define KCAT(lo_, hi_) __builtin_shufflevector(__builtin_bit_cast(v4i_att, lo_), __builtin_bit_cast(v4i_att, hi_), 0, 1, 2, 3, 4, 5, 6, 7)
#define MF8(A_, B_, C_, SB_) __builtin_amdgcn_mfma_scale_f32_32x32x64_f8f6f4(A_, B_, C_, 0, 0, 0, 0x7f7f7f7f, 0, SB_)
#define PHASE1(PN0, PN1, PF0, PF1, Kq, vb) do { \
    bf16x8 kl[6], kh[6]; const int a0_ = (int)(unsigned)(size_t)(Kq) + kx[0], a1_ = (int)(unsigned)(size_t)(Kq) + kx[1]; \
    k_read<0>(kl[0], a0_); k_read<0>(kh[0], a1_); k_read<4096>(kl[1], a0_); k_read<4096>(kh[1], a1_); \
    sfor<0, 6>([&](auto gc) __attribute__((always_inline)) { constexpr int g = decltype(gc)::value, blk = g / 3, s = g % 3; \
      asm volatile("s_waitcnt lgkmcnt(2)" : "+v"(kl[g]), "+v"(kh[g])); \
      if constexpr (blk == 0) { if constexpr (s == 0) PN0 = MF8(KCAT(kl[g], kh[g]), qf[s], negm, 0x7c7c7c7c); else PN0 = MF8(KCAT(kl[g], kh[g]), qf[s], PN0, 0x7c7c7c7c); } \
      else              { if constexpr (s == 0) PN1 = MF8(KCAT(kl[g], kh[g]), qf[s], negm, 0x7c7c7c7c); else PN1 = MF8(KCAT(kl[g], kh[g]), qf[s], PN1, 0x7c7c7c7c); } \
      if constexpr (g + 2 < 6) { constexpr int g2 = g + 2; k_read<(g2 % 3) * 4096 + (g2 / 3) * 2048>(kl[g2], a0_); k_read<(g2 % 3) * 4096 + (g2 / 3) * 2048>(kh[g2], a1_); } \
      else { constexpr int d_ = g - 4; k_read<d_ * 2048>(vl[d_], (vb) + kx[0]); k_read<d_ * 2048>(vh[d_], (vb) + kx[1]); } \
      if constexpr (g == 0) PIECE_K(0, tk_, bq); else if constexpr (g == 1) PIECE_K(1, tk_, bq); else if constexpr (g == 2) PIECE_V(tv_, b2); \
      sfor<fin8_first(g), fin8_first(g + 1)>([&](auto ic) __attribute__((always_inline)) { fin8_item<decltype(ic)::value>(PF0, PF1, p8, ls0, ls1); }); \
      SBAR(); }); } while (0)
#define PHASE2(PS0, PS1, vb) do { \
    sfor<0, 4>([&](auto gc) __attribute__((always_inline)) { constexpr int d = decltype(gc)::value; \
      if constexpr (d < 3) asm volatile("s_waitcnt lgkmcnt(2)" : "+v"(vl[d]), "+v"(vh[d])); else asm volatile("s_waitcnt lgkmcnt(0)" : "+v"(vl[d]), "+v"(vh[d])); \
      o[d] = MF8(p8, KCAT(vl[d], vh[d]), o[d], 0x7f7f7f7f); \
      if constexpr (d + 2 < 4) { k_read<(d + 2) * 2048>(vl[d + 2], (vb) + kx[0]); k_read<(d + 2) * 2048>(vh[d + 2], (vb) + kx[1]); } \
      sfor<SS::first(d, 4), SS::first(d + 1, 4)>([&](auto ic) __attribute__((always_inline)) { start_item<decltype(ic)::value, 16>(PS0, PS1, st, negm, thr, hi == 0 ? 1.f : 0.f); }); \
      SBAR(); }); \
    asm volatile("" : "+v"(PS0), "+v"(PS1)); \
    RESC(); } while (0)
  f32x16 pA0, pA1, pB0, pB1; v8i_att p8 = {}; bf16x8 vl[4], vh[4]; const int NT = seq / KVBLK;
  PIECE_K(0, 0, 0); PIECE_K(1, 0, 0); PIECE_K(0, 1, 1); PIECE_K(1, 1, 1); PIECE_V(0, 0);
  WAITV(3); WBAR();
  PIECE_K(0, 2, 2); PIECE_K(1, 2, 2); PIECE_V(1, 1);
  { pA0 = f32x16{}; pA1 = f32x16{};
#pragma unroll
    for (int s = 0; s < NKS; ++s) { const bf16x8 l0 = *(const LAS bf16x8*)(K_lds + s * 4096 + kx[0]), h0 = *(const LAS bf16x8*)(K_lds + s * 4096 + kx[1]), l1 = *(const LAS bf16x8*)(K_lds + s * 4096 + 2048 + kx[0]), h1 = *(const LAS bf16x8*)(K_lds + s * 4096 + 2048 + kx[1]);
      pA0 = MF8(KCAT(l0, h0), qf[s], pA0, 0x7c7c7c7c); pA1 = MF8(KCAT(l1, h1), qf[s], pA1, 0x7c7c7c7c); } }
  sfor<0, 16>([&](auto ic) __attribute__((always_inline)) { start_item<decltype(ic)::value, 16>(pA0, pA1, st, negm, thr, hi == 0 ? 1.f : 0.f); });
  { float pmax;
    { auto rr = __builtin_amdgcn_permlane32_swap(__float_as_uint(st.a0), __float_as_uint(st.a0), false, false); pmax = fmaxf(__uint_as_float(rr[0]), __uint_as_float(rr[1])); }
#pragma unroll
    for (int r = 0; r < 16; ++r) { pA0[r] -= pmax; pA1[r] -= pmax; negm[r] = -pmax; } }
  sfor<17, SS::NITEMS>([&](auto ic) __attribute__((always_inline)) { start_item<decltype(ic)::value, 16>(pA0, pA1, st, negm, thr, hi == 0 ? 1.f : 0.f); });
  int bq = 0;
#define ITER(j, PN0, PN1, PF0, PF1) do { const int b1 = NXT3(bq), b2 = NXT3(b1); \
    WAITV(3); WBAR(); \
    const int tk_ = (j) + 3 < NT ? (j) + 3 : NT - 1, tv_ = (j) + 2 < NT ? (j) + 2 : NT - 1; \
    PHASE1(PN0, PN1, PF0, PF1, K_lds + b1 * SHM_K, (int)(unsigned)(size_t)(V_lds + bq * SHM_V8)); \
    PHASE2(PN0, PN1, (int)(unsigned)(size_t)(V_lds + bq * SHM_V8)); \
    bq = b1; } while (0)
#if PROBE_T == 5
  const unsigned long long t0 = __builtin_amdgcn_s_memtime();
#endif
  for (int j = 0; j + 2 < NT; j += 2) { ITER(j, pB0, pB1, pA0, pA1); ITER(j + 1, pA0, pA1, pB0, pB1); }
  ITER(NT - 2, pB0, pB1, pA0, pA1);
#if PROBE_T == 5
  { const unsigned long long t1 = __builtin_amdgcn_s_memtime(); if (probe != nullptr && tid == 0) { probe[0] = 0.f; probe[1] = ((float)(t1 - t0) * (1.f / (NT - 1)) - PROBE_BASE) * 0.05f; } }
#endif
  sfor<0, 64>([&](auto ic) __attribute__((always_inline)) { fin8_item<decltype(ic)::value>(pB0, pB1, p8, ls0, ls1); });
  WAITV(0); WBAR();
  { const int vb = (int)(unsigned)(size_t)(V_lds + bq * SHM_V8);
#pragma unroll
    for (int d = 0; d < 4; ++d) { const bf16x8 l_ = *(const LAS bf16x8*)(V_lds + bq * SHM_V8 + d * 2048 + kx[0]), h_ = *(const LAS bf16x8*)(V_lds + bq * SHM_V8 + d * 2048 + kx[1]);
      o[d] = MF8(p8, KCAT(l_, h_), o[d], 0x7f7f7f7f); } (void)vb; }
  { float ps = ls0 + ls1;
    { auto rr = __builtin_amdgcn_permlane32_swap(__float_as_uint(ps), __float_as_uint(ps), false, false); ps = __uint_as_float(rr[0]) + __uint_as_float(rr[1]); }
    LAS float* li_ = (LAS float*)(lds + MISC_OFF + 128) + wid * 32;
    if (hi == 0) li_[r32] = ps; asm volatile("s_waitcnt lgkmcnt(0)" ::: "memory");
#pragma unroll
    for (int r = 0; r < 16; ++r) { const float rl = __builtin_amdgcn_rcpf(li_[crow(r, hi)]);
#pragma unroll
      for (int d = 0; d < 4; ++d) o[d][r] *= rl; } }
  asm volatile("s_waitcnt lgkmcnt(0)" ::: "memory"); WBAR();
#undef GLDS
#undef PIECE_K
#undef PIECE_V
#undef WAITV
#undef WBAR
#undef RESC
#undef NXT3
#undef KCAT
#undef MF8
#undef PHASE1
#undef PHASE2
#undef ITER
}
}

constexpr int NWAVES = 8;
struct Args { const void* in[27]; float* out; unsigned char* ws; int ph_lo, ph_hi, li, pad; };

__constant__ float c_invA[8] = {1.0f, 0.19392274474868576f, 0.03760603093086393f, 0.007292664737217109f, 0.001414213562373095f, 0.0002742481756762073f, 5.318295896944988e-05f, 1.031338537721246e-05f};
__constant__ float c_invM[32] = {1.0f, 0.6636012376960885f, 0.44036660267178046f, 0.2922278225730151f, 0.19392274474868576f, 0.12868737343265052f, 0.08539710028576561f, 0.05666962144529105f,
    0.03760603093086393f, 0.024955408670558694f, 0.016560440080994446f, 0.010989528534539826f, 0.007292664737217109f, 0.004839421345719893f, 0.003211445994752591f, 0.0021311195369119653f,
    0.001414213562373095f, 0.0009384738703573802f, 0.000622772421914596f, 0.0004132725499855165f, 0.0002742481756762073f, 0.00018199142881462546f, 0.00012076973741146504f, 8.01429472224798e-05f,
    5.318295896944988e-05f, 3.529227739646723e-05f, 2.341999896140934e-05f, 1.5541540297632344e-05f, 1.031338537721246e-05f, 6.8439753011549275e-06f, 4.5416704806078695e-06f, 3.013858152139171e-06f};

__device__ __forceinline__ int permDA(int i) { return i < 16 ? (i >> 1) + 8 * (i & 1) : i; }
__device__ __forceinline__ int permM(int i) { return (i >> 1) + 32 * (i & 1); }
__device__ __forceinline__ int src_in(int j) {
    if (j < 2048) return (j & ~63) + permDA(j & 63);
    if (j < 4352) return j;
    if (j < 6400) return 4416 + (j - 4352);
    if (j < 6464) return 4352 + permM(j - 6400);
    return -1;
}
__device__ __forceinline__ int src_uq(int j) { const int hd = j / 192, off = j % 192; return off < 128 ? j : hd * 192 + 128 + permM(off - 128); }

__device__ __forceinline__ void tr_item(const float* W, int K, int N, bf16_t* WT, int n0, int k0, int scol, const float* rs, LAS float* scr, int lane) {
#pragma unroll 8
    for (int i = 0; i < 32; ++i) { const int kk = 2 * i + (lane >> 5); float v = 0.f; if (scol >= 0) { v = W[(size_t)(k0 + kk) * N + scol]; if (rs) v *= rs[k0 + kk]; } scr[kk * 33 + (lane & 31)] = v; }
    LDS_WAIT(); asm volatile("" ::: "memory");
    const int c = lane & 7;
#pragma unroll
    for (int j = 0; j < 4; ++j) { const int n = (lane >> 3) + 8 * j; const LAS float* s = scr + (8 * c) * 33 + n;
        u32x4 o; o.x = cvt_pk_bf16(s[0 * 33], s[1 * 33]); o.y = cvt_pk_bf16(s[2 * 33], s[3 * 33]); o.z = cvt_pk_bf16(s[4 * 33], s[5 * 33]); o.w = cvt_pk_bf16(s[6 * 33], s[7 * 33]);
        *(u32x4*)(WT + (size_t)(n0 + n) * K + k0 + 8 * c) = o; }
    LDS_WAIT(); asm volatile("" ::: "memory");
}

template <int MODE = 0, bool OUT8 = false>
__device__ __forceinline__ void cvt_tile64(const float* W, int N, bf16_t* WT, int Kd, int k0, int n0, int drow0, int lane, const float* rs = nullptr) {
    const int g = lane >> 4, x = lane & 15;
    const float* src = W + (size_t)(k0 + 16 * g) * N + n0 + 4 * x;
    f32x4 v[16];
#pragma unroll
    for (int i = 0; i < 16; ++i) v[i] = __builtin_nontemporal_load((const f32x4*)(src + (size_t)i * N));
    if (rs) {
#pragma unroll
        for (int i = 0; i < 16; ++i) v[i] = v[i] * rs[k0 + 16 * g + i];
    }
    if constexpr (OUT8) {
#pragma unroll
        for (int j = 0; j < 4; ++j) { u32x4 w;
            w.x = cvt_pk_fp8x4(v[0][j] * 64.f, v[1][j] * 64.f, v[2][j] * 64.f, v[3][j] * 64.f); w.y = cvt_pk_fp8x4(v[4][j] * 64.f, v[5][j] * 64.f, v[6][j] * 64.f, v[7][j] * 64.f);
            w.z = cvt_pk_fp8x4(v[8][j] * 64.f, v[9][j] * 64.f, v[10][j] * 64.f, v[11][j] * 64.f); w.w = cvt_pk_fp8x4(v[12][j] * 64.f, v[13][j] * 64.f, v[14][j] * 64.f, v[15][j] * 64.f);
            const int c8 = 4 * x + j;
            const int dr8 = (MODE == 3 || MODE == 4) ? 32 * (c8 >> 4) + 8 * ((c8 >> 2) & 3) + 4 * (MODE - 3) + (c8 & 3) : (MODE == 1 ? 2 * (c8 & 31) + (c8 >> 5) : c8);
            *(u32x4*)((unsigned char*)WT + (size_t)(drow0 + dr8) * Kd + k0 + 16 * g) = w; }
        return; }
#pragma unroll
    for (int j = 0; j < 4; ++j) { u32x4 lo, hi;
        lo.x = cvt_pk_bf16(v[0][j], v[1][j]); lo.y = cvt_pk_bf16(v[2][j], v[3][j]); lo.z = cvt_pk_bf16(v[4][j], v[5][j]); lo.w = cvt_pk_bf16(v[6][j], v[7][j]);
        hi.x = cvt_pk_bf16(v[8][j], v[9][j]); hi.y = cvt_pk_bf16(v[10][j], v[11][j]); hi.z = cvt_pk_bf16(v[12][j], v[13][j]); hi.w = cvt_pk_bf16(v[14][j], v[15][j]);
        const int c = 4 * x + j;
        const int dr = MODE == 1 ? 2 * (c & 31) + (c >> 5) : (MODE == 2 ? (c < 16 ? 2 * (c & 7) + (c >> 3) : c) : c);
        bf16_t* d = WT + (size_t)(drow0 + dr) * Kd + k0 + 16 * g;
        *(u32x4*)d = lo; *(u32x4*)(d + 8) = hi; }
}

__global__ void __launch_bounds__(NWAVES * 64, 2) fwd(Args args) {
#define KARGS() const __attribute__((address_space(4))) unsigned long long* ka_ = (const __attribute__((address_space(4))) unsigned long long*)__builtin_amdgcn_kernarg_segment_ptr(); asm volatile("" : "+s"(ka_))
#define AIN(i) ((const void*)ka_[i])
#define AOUT ((float*)ka_[27])
#define AWS ((unsigned char*)ka_[28])
    extern __shared__ __attribute__((aligned(16))) unsigned char lds_raw[];
    LAS unsigned char* lds = (LAS unsigned char*)lds_raw;
    volatile LAS unsigned* MISC = (volatile LAS unsigned*)(lds + MISC_OFF);
    const int tid = threadIdx.x, wave = __builtin_amdgcn_readfirstlane(tid >> 6);
#define LANE_DECL int lane; asm volatile("v_and_b32 %0, 63, %1" : "=v"(lane) : "v"(threadIdx.x))
    const int G = gridDim.x, bx = blockIdx.x;
    unsigned* ctl = (unsigned*)(args.ws + WS_CTL);
    const int lo = args.ph_lo, hi_ph = args.ph_hi;
    if (tid < 32) MISC[tid] = 0u;
    __syncthreads();
    XcdBarrier bar; bar.bar = ctl + CW_BAR + args.li * XCD_BAR_WORDS; bar.x = 0; bar.st = nullptr;
    if (!MK_PER_PHASE) bar = xcd_barrier_post(ctl + CW_BAR + args.li * XCD_BAR_WORDS, MISC + 8);
#define IN(k) (((PH_MASK >> (k)) & 1) && lo <= (k) && (k) < hi_ph)
#define SEAM(k) do { if (IN(k) && IN((k) + 1)) xcd_barrier(bar); } while (0)
    const int gw = bx * NWAVES + wave, NGW = G * NWAVES;

#define xin ((const float*)AIN(0))
#define positions ((const int*)AIN(1))
#define Bt_in ((bf16_t*)(AWS + WS_BT_IN))
#define Bt_uq ((bf16_t*)(AWS + WS_BT_UQ))
#define Bt_ukv ((bf16_t*)(AWS + WS_BT_UKV))
#define Bt_od ((bf16_t*)(AWS + WS_BT_OD))
#define Bt_om ((bf16_t*)(AWS + WS_BT_OM))
#define Bt_out ((bf16_t*)(AWS + WS_BT_OUT))
#define ropeA ((float*)(AWS + WS_ROPEA))
#define ropeM ((float*)(AWS + WS_ROPEM))
#define sq ((float*)(AWS + WS_SQ2))
#define hbuf ((bf16_t*)(AWS + WS_H))
#define oa ((bf16_t*)(AWS + WS_H))
#define qa ((bf16_t*)(AWS + WS_QA))
#define ka ((bf16_t*)(AWS + WS_KA))
#define va ((bf16_t*)(AWS + WS_VA))
#define cq ((bf16_t*)(AWS + WS_CQ))
#define ckv ((bf16_t*)(AWS + WS_CKV))
#define kr ((bf16_t*)(AWS + WS_KR))
#define gates ((bf16_t*)(AWS + WS_GATES))
#define qm ((bf16_t*)(AWS + WS_QM))
#define kv ((bf16_t*)(AWS + WS_KV))
#define ob ((bf16_t*)(AWS + WS_OB))
#define mrg ((bf16_t*)(AWS + WS_MRG))
#define stash ((float*)(AWS + WS_STASH))
#define rowtok_p ((int*)(AWS + WS_ROWTOK))
#define assign ((u32x2*)(AWS + WS_ASSIGN))
#define Bt_d ((bf16_t*)(AWS + WS_BT_D))
#define Bt_gu ((bf16_t*)(AWS + WS_BT_GU))
#define h2 ((bf16_t*)(AWS + WS_H2))
#define act ((bf16_t*)(AWS + WS_ACT))
#define ybuf ((unsigned char*)(AWS + WS_Y))
#define q8p ((unsigned char*)(AWS + WS_Q8))
#define k8np ((unsigned char*)(AWS + WS_K8N))
#define k8rp ((unsigned char*)(AWS + WS_K8R))
#define v8p ((unsigned char*)(AWS + WS_V8))
#define vt8p ((unsigned char*)(AWS + WS_VT8))
#define q8ap ((unsigned char*)(AWS + WS_Q8A))
#define k8ap ((unsigned char*)(AWS + WS_K8A))
#define x1b ((bf16_t*)(AWS + WS_X1B))
#define count ((unsigned*)(AWS + WS_CTL) + CW_COUNT)

    if (IN(0)) {
        KARGS();
        LANE_DECL;
        const float* w_in = (const float*)AIN(3); const float* g_q = (const float*)AIN(9); const float* g_kv = (const float*)AIN(10);
        const float* w_uq = (const float*)AIN(11); const float* w_ukv = (const float*)AIN(12);
        const float* w_od = (const float*)AIN(13); const float* w_om = (const float*)AIN(14); const float* w_out = (const float*)AIN(16);
        constexpr int I_IN = 16 * 101, I_PAD = 16 * 3, I_UQ = 12 * 24, I_UKV = 8 * 32, I_O = 16 * 16;
        constexpr int NITEMS = I_IN + I_PAD + I_UQ + I_UKV + 3 * I_O;
        for (int it = gw; it < NITEMS; it += NGW) {
            int r = it;
            if (r < I_IN) { const int kb = r / 101, cb = r % 101, n0 = cb * 64;
                if (n0 < 2048) cvt_tile64<2>(w_in, 6464, Bt_in, D, kb * 64, n0, n0, lane);
                else if (n0 < 4352) cvt_tile64<0>(w_in, 6464, Bt_in, D, kb * 64, n0, n0, lane);
                else if (n0 < 4416) cvt_tile64<1>(w_in, 6464, Bt_in, D, kb * 64, n0, 5888, lane);
                else if (n0 < 4416 + 1536) cvt_tile64<0>(w_in, 6464, Bt_in, D, kb * 64, n0, n0 - 64, lane);
                else cvt_tile64<0>(w_in, 6464, Bt_in, D, kb * 64, n0, n0 - 64 + 256, lane);
                continue; } r -= I_IN;
            if (r < I_PAD) { const int kb = r / 3, rb = r % 3; const int g = lane >> 4, x4 = lane & 15;
#pragma unroll
                for (int j = 0; j < 4; ++j) { bf16_t* d = Bt_in + (size_t)(5952 + rb * 64 + 4 * x4 + j) * D + kb * 64 + 16 * g; *(u32x4*)d = (u32x4){0u, 0u, 0u, 0u}; *(u32x4*)(d + 8) = (u32x4){0u, 0u, 0u, 0u}; }
                continue; } r -= I_PAD;
            if (r < I_UQ) { const int kb = r / 24, cb = r % 24, n0 = cb * 64;
                if (UP_F8) { if ((cb % 3) == 2) cvt_tile64<1, true>(w_uq, 1536, Bt_uq, QL, kb * 64, n0, n0, lane, g_q); else cvt_tile64<0, true>(w_uq, 1536, Bt_uq, QL, kb * 64, n0, n0, lane, g_q); }
                else if ((cb % 3) == 2) cvt_tile64<1>(w_uq, 1536, Bt_uq, QL, kb * 64, n0, n0, lane, g_q); else cvt_tile64<0>(w_uq, 1536, Bt_uq, QL, kb * 64, n0, n0, lane, g_q);
                continue; } r -= I_UQ;
            if (r < I_UKV) { const int kb = r / 32, cb = r % 32; if (UP_F8) cvt_tile64<0, true>(w_ukv, 2048, Bt_ukv, KVL, kb * 64, cb * 64, cb * 64, lane, g_kv); else cvt_tile64<0>(w_ukv, 2048, Bt_ukv, KVL, kb * 64, cb * 64, cb * 64, lane, g_kv); continue; } r -= I_UKV;
            const int which = r / I_O; r -= which * I_O; const int kb = r / 16, cb = r % 16;
            cvt_tile64<0>(which == 0 ? w_od : (which == 1 ? w_om : w_out), D, which == 0 ? Bt_od : (which == 1 ? Bt_om : Bt_out), D, kb * 64, cb * 64, cb * 64, lane);
        }
        const float* g_mix = (const float*)AIN(2);
        for (int m = gw * 4; m < T; m += NGW * 4) {
            f32x4 v[4][4]; float ss[4];
#pragma unroll
            for (int q = 0; q < 4; ++q) { const f32x4* xr = (const f32x4*)(xin + (size_t)(m + q) * D) + lane;
#pragma unroll
                for (int j = 0; j < 4; ++j) v[q][j] = xr[64 * j]; }
#pragma unroll
            for (int q = 0; q < 4; ++q) { float s = 0.f;
#pragma unroll
                for (int j = 0; j < 4; ++j) s += (v[q][j][0] * v[q][j][0] + v[q][j][1] * v[q][j][1]) + (v[q][j][2] * v[q][j][2] + v[q][j][3] * v[q][j][3]);
                ss[q] = __builtin_amdgcn_rsqf(wave_sum(s) * (1.f / D) + EPS); }
#pragma unroll
            for (int j = 0; j < 4; ++j) { const f32x4 gg = *((const f32x4*)g_mix + lane + 64 * j);
#pragma unroll
                for (int q = 0; q < 4; ++q) { u32x2 w; w.x = cvt_pk_bf16(v[q][j][0] * ss[q] * gg[0], v[q][j][1] * ss[q] * gg[1]); w.y = cvt_pk_bf16(v[q][j][2] * ss[q] * gg[2], v[q][j][3] * ss[q] * gg[3]);
                    ((u32x2*)(hbuf + (size_t)(m + q) * D) + lane)[64 * j] = w; } }
        }
        for (int idx = bx * 512 + tid; idx < T * 40; idx += G * 512) {
            const int t = idx / 40, i = idx % 40; const float inv = i < 8 ? c_invA[i] : c_invM[i - 8];
            const float ang = (float)positions[t] * inv;
            const double rev = (double)ang * 0.15915494309189535; const float fr_ = (float)(rev - __builtin_rint(rev));
            const float cs = __builtin_amdgcn_cosf(fr_), sn = __builtin_amdgcn_sinf(fr_);
            float* dst = i < 8 ? ropeA + ((size_t)t * 8 + i) * 2 : ropeM + ((size_t)t * 32 + (i - 8)) * 2; dst[0] = cs; dst[1] = sn;
        }
    }
    SEAM(0);
    if (IN(1)) {
        KARGS();
        pg8::Gemm g{hbuf, Bt_in, D}; pg8::DenseOrder S; S.init(T / 256, 24, G, bx);
        pg8::EpiIn E{qa, ka, va, cq, ckv, gates, kr, ropeA, ropeM, (const float*)AIN(15), sq, k8rp, q8ap, k8ap};
        pg8::gemm_phase<pg8::EpiIn, pg8::DenseOrder, false, true>(lds, g, S, E);
    }
    SEAM(1);
    if (IN(2)) {
        KARGS();
        { pg8::Gemm g{hbuf, Bt_in, D}; pg8::DenseOrder S; S.init(T / 256, 2, G, bx, 24);
          pg8::EpiIn E{qa, ka, va, cq, ckv, gates, kr, ropeA, ropeM, (const float*)AIN(15), sq, k8rp, q8ap, k8ap};
          pg8::gemm_phase<pg8::EpiIn, pg8::DenseOrder, false, true>(lds, g, S, E); }
#if UP_F8
        { pg8::Gemm g{cq, Bt_uq, QL / 2}; pg8::DenseOrder S; S.init(T / 256, 1536 / 128, G, G - 1 - bx); pg8::EpiUp8<true> E{qm, sq, ropeM, q8p};
          pg8::gemm_phase_f8p<pg8::EpiUp8<true>, pg8::DenseOrder>(lds, g, S, E); }
        { pg8::Gemm g{ckv, Bt_ukv, KVL / 2}; pg8::DenseOrder S; S.init(T / 256, 2048 / 128, G, bx); pg8::EpiUp8<false> E{kv, sq, ropeM, k8np, v8p};
          pg8::gemm_phase_f8p<pg8::EpiUp8<false>, pg8::DenseOrder>(lds, g, S, E); }
#else
        { pg8::Gemm g{cq, Bt_uq, QL}; pg8::DenseOrder S; S.init(T / 256, 1536 / 256, G, G - 1 - bx); pg8::EpiUp<true> E{qm, sq, ropeM, q8p};
          pg8::gemm_phase<pg8::EpiUp<true>, pg8::DenseOrder, false, true>(lds, g, S, E); }
        { pg8::Gemm g{ckv, Bt_ukv, KVL}; pg8::DenseOrder S; S.init(T / 256, 2048 / 256, G, bx); pg8::EpiUp<false> E{kv, sq, ropeM, k8np};
          pg8::gemm_phase<pg8::EpiUp<false>, pg8::DenseOrder, false, true>(lds, g, S, E); }
#endif
    }
    SEAM(2);
    if (IN(3)) {
        KARGS();
        const int wid = wave;
#if MLA_PV8
        { LAS unsigned char* tl = (LAS unsigned char*)lds;
          for (int ti = bx; ti < NB * 8 * (SEQ / 64); ti += G) {
              const int b_ = ti >> 9, h_ = (ti >> 6) & 7, t_ = ti & 63;
              { const int key = tid >> 3, ch = tid & 7;
                *(LAS u32x4*)(tl + key * 128 + ch * 16) = *(const u32x4*)(v8p + ((size_t)b_ * SEQ + t_ * 64 + key) * 1024 + h_ * 128 + ch * 16); }
              __syncthreads();
              { const int dim = tid >> 2, c = tid & 3; unsigned w[4];
#pragma unroll
                for (int q = 0; q < 4; ++q) { unsigned acc_ = 0;
#pragma unroll
                    for (int i = 0; i < 4; ++i) { const int pos = 16 * c + 4 * q + i, kg = pos >> 5, e = pos & 31, key = att::crow(e & 15, kg) + 32 * (e >> 4);
                        acc_ |= (unsigned)tl[key * 128 + dim] << (8 * i); }
                    w[q] = acc_; }
                *(u32x4*)(vt8p + (((size_t)(b_ * 8 + h_) * 128 + dim) * SEQ + t_ * 64 + 16 * c)) = (u32x4){w[0], w[1], w[2], w[3]}; }
              __syncthreads();
          }
          if (IN(2) || true) xcd_barrier(bar); }
#endif
#define UNIT_DECODE(L) int u = (L) & 511; if (G == 256) { const int c = (L) & 255; u = ((L) & 256) + (c & 7) * 32 + (c >> 3); } \
            const int bh = u >> 4, qb = u & 15, b = bh >> 3, h = bh & 7; const size_t q0 = (size_t)b * SEQ + qb * 256, k0 = (size_t)b * SEQ
        for (int L = bx; L < 1024; L += G) {
#if PROBE_PHASE == 3 && defined(PROBE_ATT)
            if (args.li == 1 && lo == 3 && PROBE_ATT != 0) continue;
#endif
            int u = L; if (G == 256) { const int c = L & 255; u = (L & ~255) + (c & 7) * 32 + (c >> 3); }
            const int bh = u >> 5, qb = u & 31, b = bh >> 3, h = bh & 7; const size_t q0 = (size_t)b * SEQ + qb * 128, k0 = (size_t)b * SEQ;
            f32x16 o[4];
#if DA_QK8 == 2
            { att::SrcDH inh{qa + q0 * 1024 + h * 128, ka + k0 * 1024 + h * 128, q8ap + q0 * 1024 + h * 128, k8ap + k0 * 1024 + h * 128, va + k0 * 1024 + h * 128, 1024};
              if (wid < 4) att::attn_core_plh<0>(inh, 8.f * 1.4426950408889634f, SEQ, (LAS char*)lds, o, (PROBE_T == 2 && L == 0) ? (float*)((unsigned*)(AWS + WS_CTL) + CW_PROBE) : nullptr);
              else att::attn_core_plh<1>(inh, 8.f * 1.4426950408889634f, SEQ, (LAS char*)lds, o, nullptr); }
#elif DA_QK8
            { att::SrcD8 in8{q8ap + q0 * 1024 + h * 128, k8ap + k0 * 1024 + h * 128, va + k0 * 1024 + h * 128, 1024};
              att::attn_core_pl8(in8, 8.f * 1.4426950408889634f, SEQ, (LAS char*)lds, o, (PROBE_T == 2 && L == 0) ? (float*)((unsigned*)(AWS + WS_CTL) + CW_PROBE) : nullptr); }
#else
            { att::Src in{qa + q0 * 1024 + h * 128, ka + k0 * 1024 + h * 128, nullptr, va + k0 * 1024 + h * 128, 1024, 1024, 0, 1024};
              att::attn_core_pl<64, 2>(in, 0.125f * 1.4426950408889634f, 8.f * 1.4426950408889634f, SEQ, (LAS char*)lds, o, (PROBE_T && PROBE_T < 4 && L == 0) ? (float*)((unsigned*)(AWS + WS_CTL) + CW_PROBE) : nullptr); }
#endif
            int ln2; asm volatile("v_and_b32 %0, 63, %1" : "=v"(ln2) : "v"(threadIdx.x));
            LAS float* xch = (LAS float*)lds;
            if (wid >= 4) {
#pragma unroll
                for (int d = 0; d < 4; ++d)
#pragma unroll
                    for (int r = 0; r < 16; ++r) xch[((wid - 4) * 64 + d * 16 + r) * 64 + ln2] = o[d][r];
            }
            __syncthreads();
            if (wid < 4) {
            float lam;
            { const float* lq1 = (const float*)AIN(4); const float* lk1 = (const float*)AIN(5); const float* lq2 = (const float*)AIN(6); const float* lk2 = (const float*)AIN(7);
              const float s1 = wave_sum(lq1[ln2] * lk1[ln2]), s2 = wave_sum(lq2[ln2] * lk2[ln2]); lam = __expf(s1) - __expf(s2) + LAM_INIT; }
            float ss[16];
#pragma unroll
            for (int r = 0; r < 16; ++r) ss[r] = 0.f;
#pragma unroll
            for (int d = 0; d < 4; ++d)
#pragma unroll
                for (int r = 0; r < 16; ++r) { const float v = o[d][r] - lam * xch[(wid * 64 + d * 16 + r) * 64 + ln2]; o[d][r] = v; ss[r] += v * v; }
#pragma unroll
            for (int r = 0; r < 16; ++r) {
#pragma unroll
                for (int msk = 1; msk < 32; msk <<= 1) ss[r] += __shfl_xor(ss[r], msk);
                ss[r] = __builtin_amdgcn_rsqf(ss[r] * (1.0f / 128.0f) + EPS); }
            const int hi2 = ln2 >> 5, r32e = ln2 & 31;
            bf16_t* Ow = oa + (q0 + wid * 32 + 4 * hi2) * 1024 + h * 128 + r32e;
            float gs[4];
#pragma unroll
            for (int d = 0; d < 4; ++d) gs[d] = ((const float*)AIN(8))[d * 32 + r32e] * (1.0f - LAM_INIT);
#pragma unroll
            for (int r = 0; r < 16; ++r) { const int orow = att::crow(r, 0);
#pragma unroll
                for (int d = 0; d < 4; ++d) Ow[orow * 1024 + d * 32] = (bf16_t)(cvt_pk_bf16(o[d][r] * ss[r] * gs[d], 0.f) & 0xffffu); }
            }
            __syncthreads();
        }
        for (int L = 512 + bx; L < 1024; L += G) {
#if PROBE_PHASE == 3 && defined(PROBE_ATT)
            if (args.li == 1 && lo == 3 && PROBE_ATT != 1) continue;
#endif
            UNIT_DECODE(L);
            f32x16 o[4];
#if MLA_PV8
            { att::SrcM8 inm{q8p + q0 * 1536 + h * 192, k8np + k0 * 1024 + h * 128, k8rp + k0 * 64, vt8p + (size_t)(b * 8 + h) * 128 * SEQ};
              att::attn_core_mla8(inm, 8.0f, SEQ, (LAS char*)lds, o, (PROBE_T == 5 && L == 512) ? (float*)((unsigned*)(AWS + WS_CTL) + CW_PROBE) : nullptr); }
#elif MLA_QK8
            { att::Src8 in8{q8p + q0 * 1536 + h * 192, k8np + k0 * 1024 + h * 128, k8rp + k0 * 64, kv + k0 * 2048 + h * 256 + 128, 2048};
              att::attn_core_bp8(in8, 8.f * 1.4426950408889634f, SEQ, (LAS char*)lds, o, (PROBE_T == 5 && L == 512) ? (float*)((unsigned*)(AWS + WS_CTL) + CW_PROBE) : nullptr); }
#else
            { att::Src in{qm + q0 * 1536 + h * 192, kv + k0 * 2048 + h * 256, kr + k0 * 64, kv + k0 * 2048 + h * 256 + 128, 1536, 2048, 64, 2048};
              att::attn_core_bp<192, 1>(in, 8.f * 1.4426950408889634f, SEQ, (LAS char*)lds, o, (PROBE_T == 5 && L == 512) ? (float*)((unsigned*)(AWS + WS_CTL) + CW_PROBE) : nullptr); }
#endif
#if PROBE_T == 6
            const unsigned long long te0 = __builtin_amdgcn_s_memtime();
#endif
            int ln2; asm volatile("v_and_b32 %0, 63, %1" : "=v"(ln2) : "v"(threadIdx.x));
            const int hi2 = ln2 >> 5, r32e = ln2 & 31;
            bf16_t* Ow = ob + (q0 + wid * 32 + 4 * hi2) * 1024 + h * 128 + r32e;
#pragma unroll
            for (int r = 0; r < 16; ++r) { const int orow = att::crow(r, 0);
#pragma unroll
                for (int d = 0; d < 4; ++d) Ow[orow * 1024 + d * 32] = (bf16_t)(cvt_pk_bf16(o[d][r], 0.f) & 0xffffu); }
#if PROBE_T == 6
            asm volatile("s_waitcnt vmcnt(0)" ::: "memory");
            { const unsigned long long te1 = __builtin_amdgcn_s_memtime(); if (L == 512 && tid == 0) { float* pr = (float*)((unsigned*)(AWS + WS_CTL) + CW_PROBE); pr[0] = 0.f; pr[1] = (float)(te1 - te0) * 0.002f; } }
#endif
        }
#undef UNIT_DECODE
    }
    SEAM(3);
    if (IN(4)) {
        KARGS();
        { pg8::Gemm g{oa, Bt_od, D}; pg8::DenseOrder S; S.init(T / 256, 4, G, bx); pg8::EpiGate<0> E{mrg, gates};
          pg8::gemm_phase<pg8::EpiGate<0>, pg8::DenseOrder, false, true>(lds, g, S, E); }
        VM_WAIT(); __syncthreads();
        { pg8::Gemm g{ob, Bt_om, D}; pg8::DenseOrder S; S.init(T / 256, 4, G, bx); pg8::EpiGate<1> E{mrg, gates};
          pg8::gemm_phase<pg8::EpiGate<1>, pg8::DenseOrder, false, true>(lds, g, S, E); }
    }
    SEAM(4);
    if (IN(5)) {
        KARGS();
        pg8::Gemm g{mrg, Bt_out, D}; pg8::DenseOrder S; S.init(T / 256, 4, G, bx); pg8::EpiRes E{xin, x1b};
        pg8::gemm_phase<pg8::EpiRes, pg8::DenseOrder, false, true>(lds, g, S, E);
    }
    SEAM(5);
    if (IN(6)) {
        KARGS();
        LANE_DECL;
        const float* g_ffn = (const float*)AIN(17); const float* w_router = (const float*)AIN(18); const float* b_router = (const float*)AIN(19);
        constexpr int WRS = 1028;
        LAS float* wr_l = (LAS float*)lds;
        LAS int* lcount = (LAS int*)(lds + TAB_OFF + 1024); LAS int* gbase = lcount + 32; LAS unsigned* asg_e = (LAS unsigned*)(lcount + 64); LAS float* asg_w = (LAS float*)(lcount + 64 + 256);
        LAS int* sync_w = (LAS int*)(lds + TAB_OFF + 512);
        for (int i = tid; i < D * NEXP; i += 512) wr_l[(i & 31) * WRS + (i >> 5)] = w_router[i];
        if (tid < 32) lcount[tid] = 0;
        if (tid < 2) sync_w[tid] = 0;
        __syncthreads();
        const int ex = (lane >> 1) & 31;
        LAS float* lg = (LAS float*)(lds + TAB_OFF + 4096) + wave * 80;
        const int chunk = bx;
        if (wave < 4 && chunk < T / 64) {
            const float my_b = b_router[ex];
#pragma unroll 1
            for (int j2 = 0; j2 < 8; ++j2) {
                const int tl = wave * 16 + j2 * 2, t = chunk * 64 + tl;
                f32x4 xva[4], xvb[4]; float sa = 0.f, sb = 0.f;
                { const u32x2* xa = (const u32x2*)(x1b + (size_t)t * D) + lane; const u32x2* xb = xa + D / 4;
#pragma unroll
                  for (int j = 0; j < 4; ++j) { const u32x2 wa = xa[64 * j], wb = xb[64 * j]; xva[j] = (f32x4){bf_lo(wa.x), bf_hi(wa.x), bf_lo(wa.y), bf_hi(wa.y)}; xvb[j] = (f32x4){bf_lo(wb.x), bf_hi(wb.x), bf_lo(wb.y), bf_hi(wb.y)}; }
#pragma unroll
                  for (int j = 0; j < 4; ++j) { sa += (xva[j][0] * xva[j][0] + xva[j][1] * xva[j][1]) + (xva[j][2] * xva[j][2] + xva[j][3] * xva[j][3]); sb += (xvb[j][0] * xvb[j][0] + xvb[j][1] * xvb[j][1]) + (xvb[j][2] * xvb[j][2] + xvb[j][3] * xvb[j][3]); } }
                const float ra = __builtin_amdgcn_rsqf(wave_sum(sa) * (1.f / D) + EPS), rb = __builtin_amdgcn_rsqf(wave_sum(sb) * (1.f / D) + EPS);
                { unsigned* oa8 = (unsigned*)((unsigned char*)h2 + (size_t)t * D) + lane; unsigned* ob8 = oa8 + D / 4;
#pragma unroll
                  for (int j = 0; j < 4; ++j) { const f32x4 gg = *((const f32x4*)g_ffn + lane + 64 * j); xva[j] = xva[j] * ra * gg; xvb[j] = xvb[j] * rb * gg;
                    oa8[64 * j] = cvt_pk_fp8x4(xva[j][0], xva[j][1], xva[j][2], xva[j][3]); ob8[64 * j] = cvt_pk_fp8x4(xvb[j][0], xvb[j][1], xvb[j][2], xvb[j][3]); } }
                float aa[32], ab[32];
#pragma unroll
                for (int e = 0; e < NEXP; ++e) { float a = 0.f, b = 0.f;
#pragma unroll
                    for (int j = 0; j < 4; ++j) { const f32x4 w4 = *(const LAS f32x4*)(wr_l + e * WRS + 4 * lane + 256 * j);
                        a += (xva[j][0] * w4[0] + xva[j][1] * w4[1]) + (xva[j][2] * w4[2] + xva[j][3] * w4[3]); b += (xvb[j][0] * w4[0] + xvb[j][1] * w4[1]) + (xvb[j][2] * w4[2] + xvb[j][3] * w4[3]); }
                    aa[e] = a; ab[e] = b; }
#define TRED(arr, n, msk) _Pragma("unroll") for (int i_ = 0; i_ < (n); ++i_) { const bool up_ = (lane & (msk)) != 0; const float keep_ = up_ ? arr[(n) + i_] : arr[i_], give_ = up_ ? arr[i_] : arr[(n) + i_]; arr[i_] = keep_ + __shfl_xor(give_, (msk)); }
                TRED(aa, 16, 32) TRED(aa, 8, 16) TRED(aa, 4, 8) TRED(aa, 2, 4) TRED(aa, 1, 2)
                TRED(ab, 16, 32) TRED(ab, 8, 16) TRED(ab, 4, 8) TRED(ab, 2, 4) TRED(ab, 1, 2)
#undef TRED
                const float la = aa[0] + __shfl_xor(aa[0], 1) + my_b, lb = ab[0] + __shfl_xor(ab[0], 1) + my_b;
#pragma unroll
                for (int tk = 0; tk < 2; ++tk) {
                    const float v = tk ? lb : la; int rank = 0;
                    if (!(lane & 1)) lg[tk * 32 + ex] = v;
                    LDS_WAIT();
#pragma unroll
                    for (int q = 0; q < 8; ++q) { const f32x4 s4 = *(const LAS f32x4*)(lg + tk * 32 + 4 * q);
#pragma unroll
                        for (int jj = 0; jj < 4; ++jj) rank += (s4[jj] > v || (s4[jj] == v && (4 * q + jj) < ex)) ? 1 : 0; }
                    if (rank < 4 && !(lane & 1)) lg[64 + tk * 4 + rank] = v;
                    LDS_WAIT();
                    const f32x4 tv = *(const LAS f32x4*)(lg + 64 + tk * 4);
                    const float p1 = __expf(tv[1] - tv[0]), p2 = __expf(tv[2] - tv[0]), p3 = __expf(tv[3] - tv[0]), inv = 1.0f / (1.0f + p1 + p2 + p3);
                    if (rank < 4 && !(lane & 1)) { const float w = (rank == 0 ? 1.0f : (rank == 1 ? p1 : (rank == 2 ? p2 : p3))) * inv;
                        const int lr = __hip_atomic_fetch_add((LAS int*)&lcount[ex], 1, __ATOMIC_RELAXED, __HIP_MEMORY_SCOPE_WORKGROUP);
                        asg_e[(tl + tk) * 4 + rank] = ((unsigned)ex << 16) | (unsigned)lr; asg_w[(tl + tk) * 4 + rank] = w; }
                }
            }
            LDS_WAIT();
            if (lane == 0) __hip_atomic_fetch_add((LAS int*)&sync_w[0], 1, __ATOMIC_RELAXED, __HIP_MEMORY_SCOPE_WORKGROUP);
            if (wave == 0) {
                while (__hip_atomic_load((LAS int*)&sync_w[0], __ATOMIC_RELAXED, __HIP_MEMORY_SCOPE_WORKGROUP) < 4) __builtin_amdgcn_s_sleep(4);
                asm volatile("s_waitcnt lgkmcnt(0)" ::: "memory");
                if (lane < 32) gbase[lane] = (int)__hip_atomic_fetch_add(count + lane, (unsigned)lcount[lane], __ATOMIC_RELAXED, __HIP_MEMORY_SCOPE_AGENT);
                LDS_WAIT();
#pragma unroll
                for (int q = 0; q < 4; ++q) { const int a_ = q * 64 + lane; const unsigned ae = asg_e[a_]; const int e = ae >> 16, rank = gbase[e] + (int)(ae & 0xffffu); const int t = chunk * 64 + (a_ >> 2);
                    rowtok_p[e * T + rank] = t; u32x2 av; av.x = ((unsigned)e << 16) | (unsigned)rank; av.y = __float_as_uint(asg_w[a_]); assign[(size_t)t * 4 + (a_ & 3)] = av; }
            }
        }
        const float* w_gate = (const float*)AIN(20); const float* w_up = (const float*)AIN(22); const float* w_down = (const float*)AIN(24);
        const int per_wg = (NEXP * 768 + G - 1) / G;
        for (;;) {
            int it = 0; if (lane == 0) it = __hip_atomic_fetch_add((LAS int*)&sync_w[1], 1, __ATOMIC_RELAXED, __HIP_MEMORY_SCOPE_WORKGROUP);
            it = __builtin_amdgcn_readfirstlane(it); const int item = bx * per_wg + it;
            if (it >= per_wg || item >= NEXP * 768) break;
            const int e = item / 768, r = item % 768, mat = r >> 8, kb = (r >> 4) & 15, nb = r & 15, f0 = nb * 64;
            if (mat == 0) cvt_tile64<3, true>(w_gate + (size_t)e * D * FF, FF, (bf16_t*)((unsigned char*)Bt_gu + (size_t)e * 2048 * D), D, kb * 64, f0, 2 * f0, lane);
            else if (mat == 1) cvt_tile64<4, true>(w_up + (size_t)e * D * FF, FF, (bf16_t*)((unsigned char*)Bt_gu + (size_t)e * 2048 * D), D, kb * 64, f0, 2 * f0, lane);
            else cvt_tile64<0, true>(w_down + (size_t)e * FF * D, D, (bf16_t*)((unsigned char*)Bt_d + (size_t)e * D * FF), FF, kb * 64, f0, f0, lane);
        }
    }
    SEAM(6);
    LAS int* t_cnt = (LAS int*)(lds + TAB_OFF + 4096); LAS int* t_start = t_cnt + 32; LAS int* t_t2e = t_start + 40;
    if (IN(7) || IN(8) || IN(9)) {
        KARGS();
        __syncthreads();
        if (tid < 32) t_cnt[tid] = (int)__hip_atomic_load(count + tid, __ATOMIC_RELAXED, __HIP_MEMORY_SCOPE_AGENT);
        __syncthreads();
        if (tid == 0) { int s = 0; for (int e = 0; e < NEXP; ++e) { t_start[e] = s; s += (t_cnt[e] + 255) >> 8; } t_start[32] = s; }
        __syncthreads();
        if (tid < 32) { for (int rt = t_start[tid]; rt < t_start[tid + 1]; ++rt) t_t2e[rt] = tid; }
        __syncthreads();
    }
    if (IN(7)) {
        KARGS();
        pg8::Gemm g{h2, Bt_gu, D / 2}; pg8::MoeOrder S; S.init(__builtin_amdgcn_readfirstlane(t_start[32]), 16, G, bx); S.t2e = t_t2e; S.tstart = t_start; S.cnt = t_cnt; S.rowtok = rowtok_p;
        pg8::EpiSwiglu8 E{(unsigned char*)act, (const float*)AIN(21), (const float*)AIN(23)};
        pg8::gemm_phase_f8p<pg8::EpiSwiglu8, pg8::MoeOrder, true>(lds, g, S, E);
    }
    SEAM(7);
    if (IN(8)) {
        KARGS();
        pg8::Gemm g{act, Bt_d, FF / 2}; pg8::MoeOrder S; S.init(__builtin_amdgcn_readfirstlane(t_start[32]), 8, G, bx); S.t2e = t_t2e; S.tstart = t_start; S.cnt = t_cnt; S.rowtok = rowtok_p;
        pg8::EpiDown8 E{ybuf, (const float*)AIN(25)};
        pg8::gemm_phase_f8p<pg8::EpiDown8, pg8::MoeOrder>(lds, g, S, E);
    }
    SEAM(8);
    if (IN(9) && DBG_OUT) {
        KARGS();
        const bf16_t* src = DBG_OUT == 1 ? gates : DBG_OUT == 2 ? gates + 1024 : DBG_OUT == 3 ? qa : DBG_OUT == 4 ? ka : DBG_OUT == 5 ? va : DBG_OUT == 6 ? mrg : DBG_OUT == 7 ? oa : DBG_OUT == 9 ? Bt_in : ob;
        const int ld = DBG_OUT <= 2 ? 2048 : 1024;
        for (size_t i = (size_t)bx * 512 + tid; i < (size_t)T * 1024; i += (size_t)G * 512) AOUT[i] = (DBG_OUT == 9 && i >= (size_t)N_IN * 1024) ? 0.f : __uint_as_float((unsigned)src[(i >> 10) * ld + (i & 1023)] << 16);
    } else
    if (IN(9)) {
        KARGS();
        LANE_DECL;
        const float* g_fin = (const float*)AIN(26);
        for (int t0 = gw * 2; t0 < T; t0 += NGW * 2) {
            f32x4 v[2][4]; u32x2 as_[2][4];
#pragma unroll
            for (int q = 0; q < 2; ++q) { const u32x2* xr = (const u32x2*)(x1b + (size_t)(t0 + q) * D) + lane;
#pragma unroll
                for (int j = 0; j < 4; ++j) { const u32x2 w = xr[64 * j]; v[q][j] = (f32x4){bf_lo(w.x), bf_hi(w.x), bf_lo(w.y), bf_hi(w.y)}; }
#pragma unroll
                for (int k = 0; k < 4; ++k) as_[q][k] = assign[(size_t)(t0 + q) * 4 + k]; }
            unsigned yw[2][4][4];
#pragma unroll
            for (int q = 0; q < 2; ++q)
#pragma unroll
                for (int k = 0; k < 4; ++k) { const int e = as_[q][k].x >> 16, rank = as_[q][k].x & 0xffffu;
                    const unsigned* yr = (const unsigned*)(ybuf + ((size_t)t_start[e] * 256 + rank) * D) + lane;
#pragma unroll
                    for (int j = 0; j < 4; ++j) yw[q][k][j] = yr[64 * j]; }
#pragma unroll
            for (int q = 0; q < 2; ++q) {
#pragma unroll
                for (int k = 0; k < 4; ++k) { const float w = (DBG_SKIP & 1) ? 0.f : __uint_as_float(as_[q][k].y) * (1.0f / YS);
#pragma unroll
                    for (int j = 0; j < 4; ++j) { const int y = (int)yw[q][k][j]; const auto lo = __builtin_amdgcn_cvt_pk_f32_fp8(y, false), hi = __builtin_amdgcn_cvt_pk_f32_fp8(y, true);
                        v[q][j][0] += w * lo[0]; v[q][j][1] += w * lo[1]; v[q][j][2] += w * hi[0]; v[q][j][3] += w * hi[1]; } }
                float s = 0.f;
#pragma unroll
                for (int j = 0; j < 4; ++j) s += (v[q][j][0] * v[q][j][0] + v[q][j][1] * v[q][j][1]) + (v[q][j][2] * v[q][j][2] + v[q][j][3] * v[q][j][3]);
                const float rstd = __builtin_amdgcn_rsqf(wave_sum(s) * (1.f / D) + EPS);
                f32x4* xo = (f32x4*)(AOUT + (size_t)(t0 + q) * D) + lane;
#pragma unroll
                for (int j = 0; j < 4; ++j) { const f32x4 gg = *((const f32x4*)g_fin + lane + 64 * j); f32x4 ov = v[q][j] * rstd * gg;
#if PROBE_T
                    { const float e1 = __builtin_sqrtf(__uint_as_float(xb_ld((unsigned*)(AWS + WS_CTL) + CW_PROBE))), e2 = __uint_as_float(xb_ld((unsigned*)(AWS + WS_CTL) + CW_PROBE + 1));
                      ov[0] *= 1.f + e1; ov[1] *= 1.f - e1; ov[2] *= 1.f + e1; ov[3] *= 1.f - e1; if (t0 + q == 0 && j == 0 && lane == 0) ov[0] += e2; }
#endif
                    xo[64 * j] = ov; } }
        }
    }
#undef IN
#undef SEAM
#undef KARGS
#undef AIN
#undef AOUT
#undef AWS
#undef xin
#undef positions
#undef Bt_in
#undef Bt_uq
#undef Bt_ukv
#undef Bt_od
#undef Bt_om
#undef Bt_out
#undef ropeA
#undef ropeM
#undef sq
#undef hbuf
#undef oa
#undef qa
#undef ka
#undef va
#undef cq
#undef ckv
#undef kr
#undef gates
#undef qm
#undef kv
#undef ob
#undef mrg
#undef stash
#undef rowtok_p
#undef assign
#undef Bt_d
#undef Bt_gu
#undef h2
#undef act
#undef ybuf
#undef q8p
#undef k8np
#undef k8rp
#undef v8p
#undef vt8p
#undef q8ap
#undef k8ap
#undef x1b
#undef count
}

extern "C" void kernel_launch(void* const* d_in, const int* in_sizes, int n_in, void* d_out, int out_size, void* d_ws, size_t ws_size, hipStream_t stream) {
    static int grid = 0;
    if (grid == 0) {
        if (n_in != 27 || in_sizes[0] != T * D || out_size != T * D || ws_size < WS_END) { fprintf(stderr, "kernel_launch: unexpected shapes (n_in %d, in0 %d, out %d, ws %zu < %zu)\n", n_in, n_in > 0 ? in_sizes[0] : -1, out_size, ws_size, (size_t)WS_END); grid = -1; return; }
        int dev = 0, cus = 0, per_cu = 0;
        if (hipGetDevice(&dev) != hipSuccess || hipDeviceGetAttribute(&cus, hipDeviceAttributeMultiprocessorCount, dev) != hipSuccess) { grid = -1; return; }
        if (hipFuncSetAttribute((const void*)fwd, hipFuncAttributeMaxDynamicSharedMemorySize, LDS_BYTES) != hipSuccess) { fprintf(stderr, "kernel_launch: hipFuncSetAttribute failed\n"); grid = -1; return; }
        if (hipOccupancyMaxActiveBlocksPerMultiprocessor(&per_cu, (const void*)fwd, NWAVES * 64, LDS_BYTES) != hipSuccess || per_cu < 1) fprintf(stderr, "kernel_launch: occupancy query says %d\n", per_cu);
        (void)hipGetLastError();
        grid = cus;
    }
    if (grid < 0) return;
    if (hipMemsetAsync((char*)d_ws + WS_CTL, 0, CTL_ZERO_BYTES, stream) != hipSuccess) return;
    Args a{};
    for (int i = 0; i < 27; ++i) a.in[i] = d_in[i];
    a.out = (float*)d_out; a.ws = (unsigned char*)d_ws;
#if MK_PER_PHASE
    for (int p = 0; p < NPHASE; ++p) { a.ph_lo = p; a.ph_hi = p + 1; hipLaunchKernelGGL(fwd, dim3(grid), dim3(NWAVES * 64), LDS_BYTES, stream, a); }
#elif PROBE_PHASE >= 0
    a.ph_lo = 0; a.ph_hi = PROBE_PHASE + 1; a.li = 0; hipLaunchKernelGGL(fwd, dim3(grid), dim3(NWAVES * 64), LDS_BYTES, stream, a);
    a.ph_lo = PROBE_PHASE; a.ph_hi = NPHASE; a.li = 1; hipLaunchKernelGGL(fwd, dim3(grid), dim3(NWAVES * 64), LDS_BYTES, stream, a);
#else
    a.ph_lo = 0; a.ph_hi = NPHASE; hipLaunchKernelGGL(fwd, dim3(grid), dim3(NWAVES * 64), LDS_BYTES, stream, a);
#endif
}
```

```cpp
#include <hip/hip_runtime.h>
#include <cstdio>
#include <cstdint>

#ifndef MK_PER_PHASE
#define MK_PER_PHASE 0
#endif

#ifndef PROBE_PHASE
#define PROBE_PHASE -1
#endif
#ifndef ATT_DUP
#ifndef DMA_SPREAD
#define DMA_SPREAD 1
#endif
#ifndef PROBE_DMA2
#define PROBE_DMA2 0
#endif
#ifndef MLA_QK8
#define MLA_QK8 1
#endif
#ifndef DA_QK8
#define DA_QK8 1
#endif
#ifndef UP_F8
#define UP_F8 1
#endif
#ifndef MLA_PV8
#define MLA_PV8 1
#endif
#ifndef DA_PV8
#define DA_PV8 2
#endif
#ifndef DA_QLO
#define DA_QLO 1
#endif
#ifndef BP_VLA
#define BP_VLA 3
#endif
#ifndef BP_KLA
#define BP_KLA 2
#endif
#ifndef PROBE_BASE
#define PROBE_BASE 1000.f
#endif
#ifndef PROBE_T
#define PROBE_T 0
#endif
#define ATT_DUP 0
#endif
#ifndef DBG_OUT
#define DBG_OUT 0
#endif
#ifndef DBG_SKIP
#define DBG_SKIP 0
#endif
#ifndef ATT_MASK
#define ATT_MASK 3
#endif
#ifndef PH_MASK
#define PH_MASK 0x3ff
#endif
#define LAS __attribute__((address_space(3)))
#define GAS __attribute__((address_space(1)))
typedef unsigned short bf16_t;
typedef short bf16x8 __attribute__((ext_vector_type(8)));
typedef short s16x4 __attribute__((ext_vector_type(4)));
typedef float f32x2 __attribute__((ext_vector_type(2)));
typedef float f32x4 __attribute__((ext_vector_type(4)));
typedef float f32x16 __attribute__((ext_vector_type(16)));
typedef unsigned u32x2 __attribute__((ext_vector_type(2)));
typedef unsigned u32x4 __attribute__((ext_vector_type(4)));

constexpr int NB = 4, SEQ = 4096, T = NB * SEQ, D = 1024;
constexpr int NEXP = 32, TOPK = 4, FF = 1024;
constexpr int N_IN = 6656;
constexpr int QL = 768, KVL = 512;
constexpr float EPS = 1e-6f;
constexpr float LAM_INIT = 0.2f;
constexpr int NPHASE = 10;

constexpr size_t MiB = 1u << 20;
constexpr size_t WS_CTL = 0, CTL_ZERO_BYTES = 1 * MiB;
constexpr size_t WS_BT_IN = 2 * MiB;
constexpr size_t WS_BT_UQ = 15 * MiB;
constexpr size_t WS_BT_UKV = 18 * MiB;
constexpr size_t WS_BT_OD = 20 * MiB, WS_BT_OM = 22 * MiB, WS_BT_OUT = 24 * MiB;
constexpr size_t WS_ROPEA = 26 * MiB;
constexpr size_t WS_ROPEM = 27 * MiB;
constexpr size_t WS_SQ = 31 * MiB;
constexpr size_t WS_SQP = 1 * MiB;
constexpr size_t WS_H = 32 * MiB;
constexpr size_t WS_QA = 64 * MiB, WS_KA = 96 * MiB, WS_VA = 128 * MiB;
constexpr size_t WS_X1B = 168 * MiB;
constexpr size_t WS_CQ = 160 * MiB, WS_CKV = 184 * MiB, WS_KR = 200 * MiB;
constexpr size_t WS_SQ2 = 202 * MiB;
constexpr size_t WS_GATES = 208 * MiB;
constexpr size_t WS_QM = 272 * MiB;
constexpr size_t WS_Q8 = 448 * MiB;
constexpr size_t WS_K8N = 472 * MiB;
constexpr size_t WS_Q8A = 416 * MiB;
constexpr size_t WS_K8A = 432 * MiB;
constexpr size_t WS_V8 = 304 * MiB;
constexpr size_t WS_VT8 = 320 * MiB;
constexpr size_t WS_V8A = 336 * MiB;
constexpr size_t WS_VT8A = 352 * MiB;
constexpr size_t WS_Q8L = 368 * MiB;
constexpr size_t WS_K8R = 488 * MiB;
constexpr size_t WS_KV = 320 * MiB;
constexpr size_t WS_OB = 384 * MiB;
constexpr size_t WS_MRG = 416 * MiB;
constexpr size_t WS_STASH = 448 * MiB;
constexpr size_t WS_ROWTOK = 2 * MiB;
constexpr size_t WS_ASSIGN = 4 * MiB;
constexpr size_t WS_BT_D = 32 * MiB;
constexpr size_t WS_BT_GU = 96 * MiB;
constexpr size_t WS_H2 = 224 * MiB;
constexpr size_t WS_ACT = 256 * MiB;
constexpr size_t WS_Y = 96 * MiB;
constexpr size_t WS_END = 512 * MiB;
constexpr int CW_COUNT = 64;
constexpr int CW_BAR = 4096;
constexpr int CW_PROBE = 128;

constexpr int RING_BYTES = 147456;
constexpr int TAB_OFF = RING_BYTES;
constexpr int TAB_BYTES = 8192;
constexpr int MISC_OFF = TAB_OFF + TAB_BYTES;
constexpr int LDS_BYTES = 157696;

typedef __bf16 bf16x2_t __attribute__((ext_vector_type(2)));
__device__ __forceinline__ unsigned cvt_pk_bf16(float lo, float hi) { const f32x2 v = {lo, hi}; return __builtin_bit_cast(unsigned, __builtin_convertvector(v, bf16x2_t)); }
__device__ __forceinline__ float bf_lo(unsigned w) { return __uint_as_float(w << 16); }
__device__ __forceinline__ float bf_hi(unsigned w) { return __uint_as_float(w & 0xffff0000u); }
__device__ __forceinline__ float wave_sum(float v) {
#pragma unroll
    for (int o = 1; o < 64; o <<= 1) v += __shfl_xor(v, o);
    return v;
}
__device__ __forceinline__ float sigmoidf_(float x) { return __builtin_amdgcn_rcpf(1.0f + __builtin_amdgcn_exp2f(-1.4426950408889634f * x)); }
__device__ __forceinline__ unsigned cvt_pk_fp8x4(float a, float b, float c, float d) {
    a = fminf(fmaxf(a, -448.f), 448.f); b = fminf(fmaxf(b, -448.f), 448.f); c = fminf(fmaxf(c, -448.f), 448.f); d = fminf(fmaxf(d, -448.f), 448.f);
    int r = __builtin_amdgcn_cvt_pk_fp8_f32(a, b, 0, false); r = __builtin_amdgcn_cvt_pk_fp8_f32(c, d, r, true); return (unsigned)r; }
#define LDS_WAIT() asm volatile("s_waitcnt lgkmcnt(0)" ::: "memory")
#define VM_WAIT() asm volatile("s_waitcnt vmcnt(0)" ::: "memory")

#define XB_TMO      128
#define XB_XCNT(j)  (256  + 64 * (j))
#define XB_XSUB(j)  (1280 + 64 * (j))
#define XB_XGEN(j)  (2304 + 64 * (j))
#define XB_TOP      3328
#define XB_TOPGEN   3392
#define XCD_BAR_WORDS 3456
#define XB_SPIN_CAP (1u << 20)
__device__ __forceinline__ unsigned xb_ld(unsigned* p)              { return __hip_atomic_load(p, __ATOMIC_RELAXED, __HIP_MEMORY_SCOPE_AGENT); }
__device__ __forceinline__ unsigned xb_add(unsigned* p, unsigned v) { return __hip_atomic_fetch_add(p, v, __ATOMIC_RELAXED, __HIP_MEMORY_SCOPE_AGENT); }
__device__ __forceinline__ unsigned xb_xcc_id() { return (unsigned)__builtin_amdgcn_s_getreg((3 << 11) | 20) & 0xFu; }
#define XB_SPIN(cond, bar) do { unsigned _sp = 0; while (cond) { __builtin_amdgcn_s_sleep(1); \
    if ((++_sp & 255u) == 0u) { if (xb_ld(&(bar)[XB_TMO])) break; if (_sp > XB_SPIN_CAP) { atomicAdd(&(bar)[XB_TMO], 1u); break; } } } } while (0)
struct XcdBarrier { unsigned* bar; unsigned x; volatile LAS unsigned* st; };
__device__ __forceinline__ XcdBarrier xcd_barrier_post(unsigned* bar, volatile LAS unsigned* st) {
    XcdBarrier b; b.bar = bar; b.x = xb_xcc_id(); b.st = st;
    if (threadIdx.x == 0) (void)xb_add(&bar[XB_XCNT(b.x)], 1u);
    return b;
}
__device__ __forceinline__ void xcd_barrier_complete(unsigned* bar, unsigned x, unsigned& nloc, unsigned& nx) {
    const unsigned G = gridDim.x * gridDim.y * gridDim.z;
    unsigned sum, cnt, mine, sp = 0u;
    for (;;) {
        sum = 0u; cnt = 0u; mine = 0u;
#pragma unroll
        for (unsigned j = 0; j < 16; ++j) { const unsigned c = xb_ld(&bar[XB_XCNT(j)]); sum += c; cnt += (c > 0u) ? 1u : 0u; mine = (j == x) ? c : mine; }
        if (sum == G) break;
        __builtin_amdgcn_s_sleep(1);
        if ((++sp & 255u) == 0u) { if (xb_ld(&bar[XB_TMO])) break; if (sp > XB_SPIN_CAP) { atomicAdd(&bar[XB_TMO], 1u); break; } }
    }
    nloc = mine > 0u ? mine : 1u; nx = cnt > 0u ? cnt : 1u;
}
__device__ __forceinline__ void xcd_barrier(const XcdBarrier& b) {
    asm volatile("s_waitcnt vmcnt(0)" ::: "memory");
    __syncthreads();
    if (threadIdx.x == 0) {
        unsigned* bar = b.bar;
        __builtin_amdgcn_s_waitcnt(0);
        unsigned nloc = b.st[0], nx = b.st[1];
        if (nloc == 0u) { xcd_barrier_complete(bar, b.x, nloc, nx); b.st[0] = nloc; b.st[1] = nx; }
        const unsigned old = xb_add(&bar[XB_XSUB(b.x)], 1u);
        const unsigned gen = old / nloc;
        if (old + 1u == (gen + 1u) * nloc) {
            __builtin_amdgcn_fence(__ATOMIC_RELEASE, "agent");
            asm volatile("s_waitcnt vmcnt(0)" ::: "memory");
            const unsigned og = xb_add(&bar[XB_TOP], 1u);
            const unsigned tg = og / nx;
            if (og + 1u == (tg + 1u) * nx) xb_add(&bar[XB_TOPGEN], 1u);
            else XB_SPIN(xb_ld(&bar[XB_TOPGEN]) == tg, bar);
            __builtin_amdgcn_fence(__ATOMIC_ACQUIRE, "agent");
            xb_add(&bar[XB_XGEN(b.x)], 1u);
            asm volatile("s_waitcnt vmcnt(0)" ::: "memory");
        } else {
            XB_SPIN(xb_ld(&bar[XB_XGEN(b.x)]) == gen, bar);
            __builtin_amdgcn_fence(__ATOMIC_ACQUIRE, "agent");
            asm volatile("s_waitcnt vmcnt(0)" ::: "memory");
        }
    }
    __syncthreads();
}

constexpr float YS = 16.0f;
constexpr float QS_MLA = 0.07216878364870322f * 1.4426950408889634f;
constexpr float QS_DA = 0.125f * 1.4426950408889634f;
namespace pg8 {
constexpr int BM = 256, BK = 64, HALF = 128, HTB = HALF * BK * 2, STAGE_BYTES = 8 * HTB, NXCD = 8, WGM = 8;
__host__ __device__ __forceinline__ int lds_byte(int r, int c) { const int st = (r >> 4) * 2 + (c >> 5), rr = r & 15, cc = c & 31, ob = rr * 64 + cc * 2; return st * 1024 + (ob ^ (((ob >> 9) & 1) << 5)); }
__host__ __device__ __forceinline__ void stage_rc(int b, int& R, int& C) { const int st = b / 1024, sb = b % 1024, swz = sb ^ (((sb >> 9) & 1) << 5); R = (st >> 1) * 16 + swz / 64; C = (st & 1) * 32 + (swz % 64) / 2; }
__host__ __device__ __forceinline__ int perm32(int rho) { const int n = rho >> 4, i = rho & 15; return 8 * (i >> 2) + 4 * n + (i & 3); }

struct Unit { int pm, pn, pb, e, rbase, cnt; };
struct Gemm { const bf16_t* A; const bf16_t* Bt; int K; };

struct DenseOrder {
    int nM, nN, nwg, G, c, pn0;
    __device__ void init(int nM_, int nN_, int G_, int c_, int pn0_ = 0) { nM = nM_; nN = nN_; nwg = nM * nN; G = G_; c = c_; pn0 = pn0_; }
    __device__ __forceinline__ bool next(int i, Unit& u) const {
        const long L = (long)i * G + c; if (L >= nwg) return false;
        int wgid = (int)L; { const int q = nwg / NXCD, r = nwg % NXCD, xcd = wgid % NXCD, off = wgid / NXCD; wgid = (xcd < r ? xcd * (q + 1) : r * (q + 1) + (xcd - r) * q) + off; }
        const int nig = WGM * nN, gid = wgid / nig, fm = gid * WGM, gsz = (nM - fm) < WGM ? (nM - fm) : WGM;
        u.pm = fm + ((wgid % nig) % gsz); u.pn = pn0 + (wgid % nig) / gsz; u.pb = u.pn; u.e = 0; u.rbase = 0; u.cnt = 0; return true;
    }
    __device__ __forceinline__ int a_row(const Unit&, int) const { return 0; }
};
struct MoeOrder {
    int nM, nN, nwg, G, c; const LAS int* t2e; const LAS int* tstart; const LAS int* cnt; const int* rowtok;
    __device__ void init(int nM_, int nN_, int G_, int c_) { nM = nM_; nN = nN_; nwg = nM * nN; G = G_; c = c_; }
    __device__ __forceinline__ bool next(int i, Unit& u) const {
        const long L = (long)i * G + c; if (L >= nwg) return false;
        int wgid = (int)L; { const int q = nwg / NXCD, r = nwg % NXCD, xcd = wgid % NXCD, off = wgid / NXCD; wgid = (xcd < r ? xcd * (q + 1) : r * (q + 1) + (xcd - r) * q) + off; }
        const int nig = WGM * nN, gid = wgid / nig, fm = gid * WGM, gsz = (nM - fm) < WGM ? (nM - fm) : WGM;
        u.pm = fm + ((wgid % nig) % gsz); u.pn = (wgid % nig) / gsz;
        const int e = __builtin_amdgcn_readfirstlane(t2e[u.pm]); u.e = e; u.pb = e * nN + u.pn; u.rbase = (u.pm - __builtin_amdgcn_readfirstlane(tstart[e])) * 256; u.cnt = __builtin_amdgcn_readfirstlane(cnt[e]); return true;
    }
    __device__ __forceinline__ int a_row(const Unit& u, int r) const { const int rank = u.rbase + r; return rank < u.cnt ? rowtok[u.e * T + rank] : 0; }
};

template <class Epi, class Sched, bool GATHER, bool ALIGN_EPI>
__device__ __forceinline__ void gemm_phase(LAS unsigned char* lds, const Gemm g, const Sched& S, const Epi& E) {
    const int tid = threadIdx.x, wid = __builtin_amdgcn_readfirstlane(tid >> 6), lane = tid & 63, wr = wid >> 2, wc = wid & 3, fr = lane & 15, fq = lane >> 4;
    const int K = g.K, nt = K / BK;
    unsigned voffA[2], voffB[2]; int Rv[2], Cv[2];
#pragma unroll
    for (int i = 0; i < 2; ++i) { int R, C; stage_rc(tid * 16 + i * 8192, R, C); const int Rb = Epi::PERM ? ((R & ~31) + perm32(R & 31)) : R;
        voffA[i] = (unsigned)(R * K + C) * 2u; voffB[i] = (unsigned)(Rb * K + C) * 2u; Rv[i] = R; Cv[i] = C; }
    const size_t kstep = (size_t)(BK * 2);
    const size_t hstep = (size_t)HALF * K * 2;
    const size_t tstep = 2 * hstep;
    const unsigned ldsw = (unsigned)wid * 1024u;
    const int aoff = lds_byte(wr * 64 + fr, fq * 8), boff = lds_byte(wc * 32 + fr, fq * 8);
#define PG8_SA(b, h) (((b) * 2 + (h)) * HTB)
#define PG8_SB(b, h) ((4 + (b) * 2 + (h)) * HTB)
#define PG8_STAGE(bufoff, gbase, voff) do { _Pragma("unroll") for (int _i = 0; _i < 2; ++_i) \
        __builtin_amdgcn_global_load_lds((const unsigned*)((const char*)(gbase) + (voff)[_i]), (LAS unsigned*)(lds + (bufoff) + ldsw + _i * 8192), 16, 0, 0); } while (0)
#define PG8_LDA(dst, b, h) do { _Pragma("unroll") for (int m = 0; m < 4; ++m) _Pragma("unroll") for (int k = 0; k < 2; ++k) dst[m][k] = *(const LAS bf16x8*)(lds + PG8_SA(b, h) + aoff + m * 2048 + k * 1024); } while (0)
#define PG8_LDB(dst, b, h) do { _Pragma("unroll") for (int n = 0; n < 2; ++n) _Pragma("unroll") for (int k = 0; k < 2; ++k) dst[n][k] = *(const LAS bf16x8*)(lds + PG8_SB(b, h) + boff + n * 2048 + k * 1024); } while (0)
#define PG8_MMA(ai, bj, At, Bt) do { __builtin_amdgcn_s_setprio(1); _Pragma("unroll") for (int m = 0; m < 4; ++m) _Pragma("unroll") for (int n = 0; n < 2; ++n) _Pragma("unroll") for (int k = 0; k < 2; ++k) \
        acc[ai][bj][m][n] = __builtin_amdgcn_mfma_f32_16x16x32_bf16(Bt[n][k], At[m][k], acc[ai][bj][m][n], 0, 0, 0); __builtin_amdgcn_s_setprio(0); } while (0)
#define PG8_WAIT_V(n) asm volatile("s_waitcnt vmcnt(" #n ")" ::: "memory")
#define PG8_WAIT_L(n) asm volatile("s_waitcnt lgkmcnt(" #n ")" ::: "memory")
#define PG8_BAR __builtin_amdgcn_s_barrier()
#define PG8_SCHED __builtin_amdgcn_sched_barrier(0)
    Unit cur, nxt; int ui = 0;
    if (!S.next(0, cur)) return;
    f32x4 acc[2][2][4][2];
#pragma unroll
    for (int a = 0; a < 2; ++a)
#pragma unroll
        for (int b = 0; b < 2; ++b)
#pragma unroll
            for (int m = 0; m < 4; ++m)
#pragma unroll
                for (int n = 0; n < 2; ++n) acc[a][b][m][n] = (f32x4){0.f, 0.f, 0.f, 0.f};
    bf16x8 At[4][2], B0[2][2], B1[2][2];
    unsigned gC0[2], gC1[2], gN0[2], gN1[2];
    if constexpr (GATHER) {
#pragma unroll
        for (int i = 0; i < 2; ++i) { gC0[i] = (unsigned)S.a_row(cur, Rv[i]) * (unsigned)(K * 2) + (unsigned)Cv[i] * 2u; gC1[i] = (unsigned)S.a_row(cur, HALF + Rv[i]) * (unsigned)(K * 2) + (unsigned)Cv[i] * 2u; gN0[i] = gC0[i]; gN1[i] = gC1[i]; }
    }
    const char* cA = GATHER ? (const char*)g.A : (const char*)g.A + (size_t)cur.pm * tstep; const char* cB = (const char*)g.Bt + (size_t)cur.pb * tstep;
#define PG8_STAGE_A(bufoff, p, h, o0, o1) do { if constexpr (GATHER) { if ((h) == 0) PG8_STAGE(bufoff, p, o0); else PG8_STAGE(bufoff, p, o1); } else { PG8_STAGE(bufoff, (p) + (h) * hstep, voffA); } } while (0)
    PG8_STAGE(PG8_SB(0, 0), cB, voffB); PG8_STAGE(PG8_SB(0, 1), cB + hstep, voffB); PG8_STAGE_A(PG8_SA(0, 0), cA, 0, gC0, gC1); PG8_STAGE_A(PG8_SA(0, 1), cA, 1, gC0, gC1);
    if (wr == 1) PG8_BAR;
    PG8_WAIT_V(2); PG8_BAR;
    PG8_STAGE(PG8_SB(1, 0), cB + kstep, voffB); PG8_STAGE_A(PG8_SA(1, 0), cA + kstep, 0, gC0, gC1); PG8_STAGE(PG8_SB(1, 1), cB + hstep + kstep, voffB);
    PG8_WAIT_V(6); PG8_BAR;
    for (;;) {
        const bool has_next = S.next(ui + 1, nxt);
        const char* nA = GATHER ? (const char*)g.A : (has_next ? (const char*)g.A + (size_t)nxt.pm * tstep : cA); const char* nB = has_next ? (const char*)g.Bt + (size_t)nxt.pb * tstep : cB;
        if constexpr (GATHER) { if (has_next) {
#pragma unroll
            for (int i = 0; i < 2; ++i) { gN0[i] = (unsigned)S.a_row(nxt, Rv[i]) * (unsigned)(K * 2) + (unsigned)Cv[i] * 2u; gN1[i] = (unsigned)S.a_row(nxt, HALF + Rv[i]) * (unsigned)(K * 2) + (unsigned)Cv[i] * 2u; } } }
        for (int t = 0; t < nt; t += 2) {
            const bool last = (t == nt - 2);
            const char* a1 = cA + (size_t)(t + 1) * kstep;
            const char* a2 = last ? nA : cA + (size_t)(t + 2) * kstep; const char* b2 = last ? nB : cB + (size_t)(t + 2) * kstep;
            const char* a3 = a2 + kstep; const char* b3 = b2 + kstep;
            unsigned s0[2], s1[2];
            if constexpr (GATHER) { s0[0] = last ? gN0[0] : gC0[0]; s0[1] = last ? gN0[1] : gC0[1]; s1[0] = last ? gN1[0] : gC1[0]; s1[1] = last ? gN1[1] : gC1[1]; }
            PG8_LDB(B0, 0, 0); PG8_LDB(B1, 0, 1); PG8_SCHED; PG8_LDA(At, 0, 0); PG8_STAGE_A(PG8_SA(1, 1), a1, 1, gC0, gC1);
            PG8_WAIT_V(8); PG8_WAIT_L(0); PG8_BAR; PG8_MMA(0, 0, At, B0); PG8_MMA(0, 1, At, B1); PG8_BAR; PG8_SCHED;
            PG8_LDA(At, 0, 1); PG8_STAGE(PG8_SB(0, 0), b2, voffB); PG8_STAGE(PG8_SB(0, 1), b2 + hstep, voffB); PG8_STAGE_A(PG8_SA(0, 0), a2, 0, s0, s1);
            PG8_WAIT_V(8); PG8_WAIT_L(0); PG8_BAR; PG8_MMA(1, 0, At, B0); PG8_MMA(1, 1, At, B1); PG8_BAR; PG8_SCHED;
            PG8_LDB(B0, 1, 0); PG8_LDB(B1, 1, 1); PG8_SCHED; PG8_LDA(At, 1, 0); PG8_STAGE_A(PG8_SA(0, 1), a2, 1, s0, s1);
            PG8_WAIT_V(8); PG8_WAIT_L(0); PG8_BAR; PG8_MMA(0, 0, At, B0); PG8_MMA(0, 1, At, B1); PG8_BAR; PG8_SCHED;
            PG8_LDA(At, 1, 1); PG8_STAGE(PG8_SB(1, 0), b3, voffB); PG8_STAGE(PG8_SB(1, 1), b3 + hstep, voffB); PG8_STAGE_A(PG8_SA(1, 0), a3, 0, s0, s1);
            PG8_WAIT_V(8); PG8_WAIT_L(0); PG8_BAR; PG8_MMA(1, 0, At, B0); PG8_MMA(1, 1, At, B1); PG8_BAR; PG8_SCHED;
        }
        if constexpr (ALIGN_EPI) { if (wr == 0) PG8_BAR; }
        E(acc, cur, wr, wc, fr, fq);
        if (!has_next) break;
#pragma unroll
        for (int a = 0; a < 2; ++a)
#pragma unroll
            for (int b = 0; b < 2; ++b)
#pragma unroll
                for (int m = 0; m < 4; ++m)
#pragma unroll
                    for (int n = 0; n < 2; ++n) acc[a][b][m][n] = (f32x4){0.f, 0.f, 0.f, 0.f};
        cur = nxt; cA = nA; cB = nB; ++ui;
        if constexpr (GATHER) { gC0[0] = gN0[0]; gC0[1] = gN0[1]; gC1[0] = gN1[0]; gC1[1] = gN1[1]; }
        if constexpr (ALIGN_EPI) { if (wr == 1) PG8_BAR; }
    }
    PG8_WAIT_V(0);
    if constexpr (!ALIGN_EPI) { if (wr == 0) PG8_BAR; }
    PG8_BAR;
#undef PG8_SA
#undef PG8_SB
#undef PG8_STAGE
#undef PG8_STAGE_A
#undef PG8_LDA
#undef PG8_LDB
#undef PG8_MMA
#undef PG8_WAIT_V
#undef PG8_WAIT_L
#undef PG8_BAR
#undef PG8_SCHED
}

template <class Epi, class Sched, bool GATHER = false>
__device__ __forceinline__ void gemm_phase_f8n(LAS unsigned char* lds, const Gemm g, const Sched& S, const Epi& E) {
    const int tid = threadIdx.x, wid = __builtin_amdgcn_readfirstlane(tid >> 6), lane = tid & 63, wr = wid >> 2, wc = wid & 3, fr = lane & 15, fq = lane >> 4;
    const int K = g.K, nt = K / BK;
    unsigned voffA[2], voffB[2]; int Rv[2], Cv[2];
#pragma unroll
    for (int i = 0; i < 2; ++i) { int R, C; stage_rc(tid * 16 + i * 8192, R, C); const int Rb = (R & ~31) + perm32(R & 31);
        voffA[i] = (unsigned)(R * K + C) * 2u; voffB[i] = (unsigned)(Rb * K + C) * 2u; Rv[i] = R; Cv[i] = C; }
    const size_t kstep = (size_t)(BK * 2), hstep = (size_t)HALF * K * 2, tstep = 2 * hstep;
    const unsigned ldsw = (unsigned)wid * 1024u;
    const int aoff = lds_byte(wr * 64 + fr, fq * 8), boff = lds_byte(wc * 32 + fr, fq * 8);
    typedef int v8i_t __attribute__((ext_vector_type(8))); typedef int v4i_t __attribute__((ext_vector_type(4)));
#define F8_SA(b, h) (((b) * 2 + (h)) * HTB)
#define F8_SB(b) ((4 + (b) * 2) * HTB)
#define F8_STAGE(bufoff, gbase, voff) do { _Pragma("unroll") for (int _i = 0; _i < 2; ++_i) \
        __builtin_amdgcn_global_load_lds((const unsigned*)((const char*)(gbase) + (voff)[_i]), (LAS unsigned*)(lds + (bufoff) + ldsw + _i * 8192), 16, 0, 0); } while (0)
#define F8_LDA(b, h) do { _Pragma("unroll") for (int m = 0; m < 4; ++m) _Pragma("unroll") for (int k = 0; k < 2; ++k) At[m][k] = *(const LAS bf16x8*)(lds + F8_SA(b, h) + aoff + m * 2048 + k * 1024); } while (0)
#define F8_LDB(b) do { _Pragma("unroll") for (int n = 0; n < 2; ++n) _Pragma("unroll") for (int k = 0; k < 2; ++k) B0[n][k] = *(const LAS bf16x8*)(lds + F8_SB(b) + boff + n * 2048 + k * 1024); } while (0)
#define F8_CAT(x0, x1) __builtin_shufflevector(__builtin_bit_cast(v4i_t, x0), __builtin_bit_cast(v4i_t, x1), 0, 1, 2, 3, 4, 5, 6, 7)
#define F8_MMA(ai) do { __builtin_amdgcn_s_setprio(1); _Pragma("unroll") for (int m = 0; m < 4; ++m) _Pragma("unroll") for (int n = 0; n < 2; ++n) \
        acc[ai][m][n] = __builtin_amdgcn_mfma_scale_f32_16x16x128_f8f6f4(F8_CAT(B0[n][0], B0[n][1]), F8_CAT(At[m][0], At[m][1]), acc[ai][m][n], 0, 0, 0, 0x79797979, 0, 0x7f7f7f7f); \
        __builtin_amdgcn_s_setprio(0); } while (0)
#define F8_WAIT_V(n) asm volatile("s_waitcnt vmcnt(" #n ")" ::: "memory")
#define F8_WAIT_L(n) asm volatile("s_waitcnt lgkmcnt(" #n ")" ::: "memory")
#define F8_BAR __builtin_amdgcn_s_barrier()
#define F8_SCHED __builtin_amdgcn_sched_barrier(0)
    Unit cur, nxt; int ui = 0;
    if (!S.next(0, cur)) return;
    f32x4 acc[2][4][2];
#pragma unroll
    for (int a = 0; a < 2; ++a)
#pragma unroll
        for (int m = 0; m < 4; ++m)
#pragma unroll
            for (int n = 0; n < 2; ++n) acc[a][m][n] = (f32x4){0.f, 0.f, 0.f, 0.f};
    bf16x8 At[4][2], B0[2][2];
    unsigned gC0[2], gC1[2], gN0[2], gN1[2];
    if constexpr (GATHER) {
#pragma unroll
        for (int i = 0; i < 2; ++i) { gC0[i] = (unsigned)S.a_row(cur, Rv[i]) * (unsigned)(K * 2) + (unsigned)Cv[i] * 2u; gC1[i] = (unsigned)S.a_row(cur, HALF + Rv[i]) * (unsigned)(K * 2) + (unsigned)Cv[i] * 2u; gN0[i] = gC0[i]; gN1[i] = gC1[i]; }
    }
    const char* cA = GATHER ? (const char*)g.A : (const char*)g.A + (size_t)cur.pm * tstep; const char* cB = (const char*)g.Bt + (size_t)cur.pb * hstep;
#define F8_STAGE_A(bufoff, p, h, o0, o1) do { if constexpr (GATHER) { if ((h) == 0) F8_STAGE(bufoff, p, o0); else F8_STAGE(bufoff, p, o1); } else { F8_STAGE(bufoff, (p) + (h) * hstep, voffA); } } while (0)
    F8_STAGE(F8_SB(0), cB, voffB); F8_STAGE_A(F8_SA(0, 0), cA, 0, gC0, gC1); F8_STAGE_A(F8_SA(0, 1), cA, 1, gC0, gC1);
    if (wr == 1) F8_BAR;
    F8_WAIT_V(2); F8_BAR;
    F8_STAGE(F8_SB(1), cB + kstep, voffB); F8_STAGE_A(F8_SA(1, 0), cA + kstep, 0, gC0, gC1);
    F8_WAIT_V(4); F8_BAR;
    for (;;) {
        const bool has_next = S.next(ui + 1, nxt);
        const char* nA = GATHER ? (const char*)g.A : (has_next ? (const char*)g.A + (size_t)nxt.pm * tstep : cA); const char* nB = has_next ? (const char*)g.Bt + (size_t)nxt.pb * hstep : cB;
        if constexpr (GATHER) { if (has_next) {
#pragma unroll
            for (int i = 0; i < 2; ++i) { gN0[i] = (unsigned)S.a_row(nxt, Rv[i]) * (unsigned)(K * 2) + (unsigned)Cv[i] * 2u; gN1[i] = (unsigned)S.a_row(nxt, HALF + Rv[i]) * (unsigned)(K * 2) + (unsigned)Cv[i] * 2u; } } }
#pragma unroll 1
        for (int t = 0; t < nt; t += 2) {
            const bool last = (t == nt - 2);
            const char* a1 = cA + (size_t)(t + 1) * kstep;
            const char* a2 = last ? nA : cA + (size_t)(t + 2) * kstep; const char* b2 = last ? nB : cB + (size_t)(t + 2) * kstep;
            const char* a3 = a2 + kstep; const char* b3 = b2 + kstep;
            unsigned s0[2], s1[2];
            if constexpr (GATHER) { s0[0] = last ? gN0[0] : gC0[0]; s0[1] = last ? gN0[1] : gC0[1]; s1[0] = last ? gN1[0] : gC1[0]; s1[1] = last ? gN1[1] : gC1[1]; }
            F8_LDB(0); F8_SCHED; F8_LDA(0, 0); F8_STAGE_A(F8_SA(1, 1), a1, 1, gC0, gC1);
            F8_WAIT_V(6); F8_WAIT_L(0); F8_BAR; F8_MMA(0); F8_BAR; F8_SCHED;
            F8_LDA(0, 1); F8_STAGE(F8_SB(0), b2, voffB); F8_STAGE_A(F8_SA(0, 0), a2, 0, s0, s1);
            F8_WAIT_V(6); F8_WAIT_L(0); F8_BAR; F8_MMA(1); F8_BAR; F8_SCHED;
            F8_LDB(1); F8_SCHED; F8_LDA(1, 0); F8_STAGE_A(F8_SA(0, 1), a2, 1, s0, s1);
            F8_WAIT_V(6); F8_WAIT_L(0); F8_BAR; F8_MMA(0); F8_BAR; F8_SCHED;
            F8_LDA(1, 1); F8_STAGE(F8_SB(1), b3, voffB); F8_STAGE_A(F8_SA(1, 0), a3, 0, s0, s1);
            F8_WAIT_V(6); F8_WAIT_L(0); F8_BAR; F8_MMA(1); F8_BAR; F8_SCHED;
        }
        if (wr == 0) F8_BAR;
        E(acc, cur, wr, wc, fr, fq);
        if (!has_next) break;
#pragma unroll
        for (int a = 0; a < 2; ++a)
#pragma unroll
            for (int m = 0; m < 4; ++m)
#pragma unroll
                for (int n = 0; n < 2; ++n) acc[a][m][n] = (f32x4){0.f, 0.f, 0.f, 0.f};
        cur = nxt; cA = nA; cB = nB; ++ui;
        if constexpr (GATHER) { gC0[0] = gN0[0]; gC0[1] = gN0[1]; gC1[0] = gN1[0]; gC1[1] = gN1[1]; }
        if (wr == 1) F8_BAR;
    }
    F8_WAIT_V(0);
    F8_BAR;
#undef F8_SA
#undef F8_SB
#undef F8_STAGE
#undef F8_LDA
#undef F8_LDB
#undef F8_CAT
#undef F8_MMA
#undef F8_WAIT_V
#undef F8_WAIT_L
#undef F8_BAR
#undef F8_SCHED
#undef F8_STAGE_A
}
template <int I> struct SIC { static constexpr int value = I; };
template <int LO, int HI, class F> __device__ __forceinline__ void ssfor(F&& f) { if constexpr (LO < HI) { f(SIC<LO>{}); ssfor<LO + 1, HI>(f); } }
template <class Epi, class Sched, bool GATHER = false>
__device__ __forceinline__ void gemm_phase_f8p(LAS unsigned char* lds, const Gemm g, const Sched& S, const Epi& E) {
    const int tid = threadIdx.x, wid = __builtin_amdgcn_readfirstlane(tid >> 6), lane = tid & 63, wr = wid >> 2, wc = wid & 3, fr = lane & 15, fq = lane >> 4;
    const int K = g.K, nt = K / BK;
    unsigned voffA[2], voffB[2]; int Rv[2], Cv[2];
#pragma unroll
    for (int i = 0; i < 2; ++i) { int R, C; stage_rc(tid * 16 + i * 8192, R, C); const int Rb = (R & ~31) + perm32(R & 31);
        voffA[i] = (unsigned)(R * K + C) * 2u; voffB[i] = (unsigned)(Rb * K + C) * 2u; Rv[i] = R; Cv[i] = C; }
    const size_t kstep = (size_t)(BK * 2), hstep = (size_t)HALF * K * 2, tstep = 2 * hstep;
    const unsigned ldsw = (unsigned)wid * 1024u;
    const int aoff = lds_byte(wr * 64 + fr, fq * 8), boff = lds_byte(wc * 32 + fr, fq * 8);
    constexpr int STG = 3 * HTB;
    typedef int v8i_t __attribute__((ext_vector_type(8))); typedef int v4i_t __attribute__((ext_vector_type(4)));
#define P8_CAT(x0, x1) __builtin_shufflevector(__builtin_bit_cast(v4i_t, x0), __builtin_bit_cast(v4i_t, x1), 0, 1, 2, 3, 4, 5, 6, 7)
#define P8_GLDS(src, dstoff) __builtin_amdgcn_global_load_lds((const unsigned*)(src), (LAS unsigned*)(lds + (dstoff)), 16, 0, 0)
#define P8_PIECE(p, pa, pb, o0, o1, st) do { constexpr int i_ = (p) & 1; \
        if constexpr ((p) < 2)      { if constexpr (GATHER) P8_GLDS((pa) + (o0)[i_], (st) * STG + ldsw + i_ * 8192); else P8_GLDS((pa) + voffA[i_], (st) * STG + ldsw + i_ * 8192); } \
        else if constexpr ((p) < 4) { if constexpr (GATHER) P8_GLDS((pa) + (o1)[i_], (st) * STG + HTB + ldsw + i_ * 8192); else P8_GLDS((pa) + hstep + voffA[i_], (st) * STG + HTB + ldsw + i_ * 8192); } \
        else                        P8_GLDS((pb) + voffB[i_], (st) * STG + 2 * HTB + ldsw + i_ * 8192); } while (0)
#define P8_WAIT_V(n) asm volatile("s_waitcnt vmcnt(" #n ")" ::: "memory")
#define P8_BAR do { asm volatile("" ::: "memory"); __builtin_amdgcn_s_barrier(); asm volatile("" ::: "memory"); } while (0)
#define P8_SCHED __builtin_amdgcn_sched_barrier(0)
    Unit cur, nxt; int ui = 0;
    if (!S.next(0, cur)) return;
    f32x4 acc[2][4][2];
#pragma unroll
    for (int a = 0; a < 2; ++a)
#pragma unroll
        for (int m = 0; m < 4; ++m)
#pragma unroll
            for (int n = 0; n < 2; ++n) acc[a][m][n] = (f32x4){0.f, 0.f, 0.f, 0.f};
    bf16x8 AX[4][2], AY[4][2], BX[2][2], BY[2][2];
    unsigned gC0[2], gC1[2], gN0[2], gN1[2];
    if constexpr (GATHER) {
#pragma unroll
        for (int i = 0; i < 2; ++i) { gC0[i] = (unsigned)S.a_row(cur, Rv[i]) * (unsigned)(K * 2) + (unsigned)Cv[i] * 2u; gC1[i] = (unsigned)S.a_row(cur, HALF + Rv[i]) * (unsigned)(K * 2) + (unsigned)Cv[i] * 2u; gN0[i] = gC0[i]; gN1[i] = gC1[i]; }
    }
    const char* cA = GATHER ? (const char*)g.A : (const char*)g.A + (size_t)cur.pm * tstep; const char* cB = (const char*)g.Bt + (size_t)cur.pb * hstep;
#define P8_SP(AI, Acur, Anxt, Bcur, Bnxt, RDB, sr, hr, P0, qa, qb, q0, q1, sd) do { \
        ssfor<0, 8>([&](auto gc) __attribute__((always_inline)) { constexpr int g_ = decltype(gc)::value, m_ = g_ >> 1, n_ = g_ & 1; \
            acc[AI][m_][n_] = __builtin_amdgcn_mfma_scale_f32_16x16x128_f8f6f4(P8_CAT(Bcur[n_][0], Bcur[n_][1]), P8_CAT(Acur[m_][0], Acur[m_][1]), acc[AI][m_][n_], 0, 0, 0, 0x79797979, 0, 0x7f7f7f7f); \
            if constexpr (g_ == 0) P8_SCHED;     \
            Anxt[m_][n_] = *(const LAS bf16x8*)(lds + (sr) * STG + (hr) * HTB + aoff + m_ * 2048 + n_ * 1024); \
            if constexpr ((RDB) && g_ < 4) Bnxt[m_][n_] = *(const LAS bf16x8*)(lds + (sr) * STG + 2 * HTB + boff + m_ * 2048 + n_ * 1024); \
            if constexpr (g_ == 1) P8_PIECE((P0) + 0, qa, qb, q0, q1, sd); \
            if constexpr (g_ == 3) P8_PIECE((P0) + 1, qa, qb, q0, q1, sd); \
            if constexpr (g_ == 5) P8_PIECE((P0) + 2, qa, qb, q0, q1, sd); \
            P8_SCHED; }); } while (0)
    { const char* pa_ = cA; const char* pb_ = cB;
      P8_PIECE(0, pa_, pb_, gC0, gC1, 0); P8_PIECE(1, pa_, pb_, gC0, gC1, 0); P8_PIECE(2, pa_, pb_, gC0, gC1, 0); P8_PIECE(3, pa_, pb_, gC0, gC1, 0); P8_PIECE(4, pa_, pb_, gC0, gC1, 0); P8_PIECE(5, pa_, pb_, gC0, gC1, 0);
      pa_ += kstep; pb_ += kstep;
      P8_PIECE(0, pa_, pb_, gC0, gC1, 1); P8_PIECE(1, pa_, pb_, gC0, gC1, 1); P8_PIECE(2, pa_, pb_, gC0, gC1, 1); P8_PIECE(3, pa_, pb_, gC0, gC1, 1); P8_PIECE(4, pa_, pb_, gC0, gC1, 1); P8_PIECE(5, pa_, pb_, gC0, gC1, 1);
      pa_ += kstep; pb_ += kstep;
      P8_PIECE(0, pa_, pb_, gC0, gC1, 2); P8_PIECE(1, pa_, pb_, gC0, gC1, 2); P8_PIECE(2, pa_, pb_, gC0, gC1, 2); }
    P8_WAIT_V(9); P8_BAR;
#pragma unroll
    for (int m = 0; m < 4; ++m)
#pragma unroll
        for (int k = 0; k < 2; ++k) AX[m][k] = *(const LAS bf16x8*)(lds + aoff + m * 2048 + k * 1024);
#pragma unroll
    for (int n = 0; n < 2; ++n)
#pragma unroll
        for (int k = 0; k < 2; ++k) BX[n][k] = *(const LAS bf16x8*)(lds + 2 * HTB + boff + n * 2048 + k * 1024);
    int sa = 0;
    for (;;) {
        const bool has_next = S.next(ui + 1, nxt);
        const char* nA = GATHER ? (const char*)g.A : (has_next ? (const char*)g.A + (size_t)nxt.pm * tstep : cA); const char* nB = has_next ? (const char*)g.Bt + (size_t)nxt.pb * hstep : cB;
        if constexpr (GATHER) { if (has_next) {
#pragma unroll
            for (int i = 0; i < 2; ++i) { gN0[i] = (unsigned)S.a_row(nxt, Rv[i]) * (unsigned)(K * 2) + (unsigned)Cv[i] * 2u; gN1[i] = (unsigned)S.a_row(nxt, HALF + Rv[i]) * (unsigned)(K * 2) + (unsigned)Cv[i] * 2u; } } }
#pragma unroll 1
        for (int t = 0; t < nt; t += 2) {
            const int sb = sa == 2 ? 0 : sa + 1, sc = sb == 2 ? 0 : sb + 1;
            const bool x2 = t + 2 >= nt, x3 = t + 3 >= nt, x4 = t + 4 >= nt;
            const char* a2 = x2 ? nA + (size_t)(t + 2 - nt) * kstep : cA + (size_t)(t + 2) * kstep; const char* b2 = x2 ? nB + (size_t)(t + 2 - nt) * kstep : cB + (size_t)(t + 2) * kstep;
            const char* a3 = x3 ? nA + (size_t)(t + 3 - nt) * kstep : cA + (size_t)(t + 3) * kstep; const char* b3 = x3 ? nB + (size_t)(t + 3 - nt) * kstep : cB + (size_t)(t + 3) * kstep;
            const char* a4 = x4 ? nA + (size_t)(t + 4 - nt) * kstep : cA + (size_t)(t + 4) * kstep; const char* b4 = x4 ? nB + (size_t)(t + 4 - nt) * kstep : cB + (size_t)(t + 4) * kstep;
            unsigned q20[2], q21[2], q30[2], q31[2], q40[2], q41[2];
            if constexpr (GATHER) {
#pragma unroll
                for (int i = 0; i < 2; ++i) { q20[i] = x2 ? gN0[i] : gC0[i]; q21[i] = x2 ? gN1[i] : gC1[i]; q30[i] = x3 ? gN0[i] : gC0[i]; q31[i] = x3 ? gN1[i] : gC1[i]; q40[i] = x4 ? gN0[i] : gC0[i]; q41[i] = x4 ? gN1[i] : gC1[i]; } }
            P8_SP(0, AX, AY, BX, BY, false, sa, 1, 3, a2, b2, q20, q21, sc);
            P8_WAIT_V(6); asm volatile("s_waitcnt lgkmcnt(0)" ::: "memory"); P8_BAR;
            P8_SP(1, AY, AX, BX, BY, true, sb, 0, 0, a3, b3, q30, q31, sa);
            P8_SP(0, AX, AY, BY, BX, false, sb, 1, 3, a3, b3, q30, q31, sa);
            P8_WAIT_V(6); asm volatile("s_waitcnt lgkmcnt(0)" ::: "memory"); P8_BAR;
            P8_SP(1, AY, AX, BY, BX, true, sc, 0, 0, a4, b4, q40, q41, sb);
            sa = sc;
        }
        E(acc, cur, wr, wc, fr, fq);
        if (!has_next) break;
#pragma unroll
        for (int a = 0; a < 2; ++a)
#pragma unroll
            for (int m = 0; m < 4; ++m)
#pragma unroll
                for (int n = 0; n < 2; ++n) acc[a][m][n] = (f32x4){0.f, 0.f, 0.f, 0.f};
        cur = nxt; cA = nA; cB = nB; ++ui;
        if constexpr (GATHER) { gC0[0] = gN0[0]; gC0[1] = gN0[1]; gC1[0] = gN1[0]; gC1[1] = gN1[1]; }
    }
    P8_WAIT_V(0);
    P8_BAR;
#undef P8_CAT
#undef P8_GLDS
#undef P8_PIECE
#undef P8_WAIT_V
#undef P8_BAR
#undef P8_SCHED
#undef P8_SP
}

__device__ __forceinline__ u32x4 pack8(const f32x4& v0, const f32x4& v1) { u32x4 w; w.x = cvt_pk_bf16(v0[0], v0[1]); w.y = cvt_pk_bf16(v0[2], v0[3]); w.z = cvt_pk_bf16(v1[0], v1[1]); w.w = cvt_pk_bf16(v1[2], v1[3]); return w; }
__device__ __forceinline__ void rope4(f32x4& v0, f32x4& v1, const float* cs) {
    const f32x4 a = *(const f32x4*)cs, b = *(const f32x4*)(cs + 4);
    float x1, x2;
    x1 = v0[0]; x2 = v0[1]; v0[0] = x1 * a[0] - x2 * a[1]; v0[1] = x2 * a[0] + x1 * a[1];
    x1 = v0[2]; x2 = v0[3]; v0[2] = x1 * a[2] - x2 * a[3]; v0[3] = x2 * a[2] + x1 * a[3];
    x1 = v1[0]; x2 = v1[1]; v1[0] = x1 * b[0] - x2 * b[1]; v1[1] = x2 * b[0] + x1 * b[1];
    x1 = v1[2]; x2 = v1[3]; v1[2] = x1 * b[2] - x2 * b[3]; v1[3] = x2 * b[2] + x1 * b[3];
}

struct EpiIn {
    static constexpr bool PERM = true;
    bf16_t *qa, *ka, *va, *cq, *ckv, *gates, *kr; const float *ropeA, *ropeM, *bg; float* sq; unsigned char* k8r; unsigned char *q8a, *k8a; unsigned char* v8a; unsigned char* q8l;
    __device__ __forceinline__ void operator()(const f32x4 (&acc)[2][2][4][2], const Unit& u, int wr, int wc, int fr, int fq) const {
        const int pn = u.pn, row0 = u.pm * BM + wr * 64 + fr, cl = wc * 32 + 8 * fq;
        if (pn < 8) {
            bf16_t* dst = pn < 4 ? qa : ka; const int colt = (pn & 3) * 256; const bool rot = ((wc & 1) == 0) && (fq < 2);
#pragma unroll
            for (int ai = 0; ai < 2; ++ai)
#pragma unroll
                for (int m = 0; m < 4; ++m) { const int row = row0 + ai * HALF + m * 16;
#pragma unroll
                    for (int bj = 0; bj < 2; ++bj) { f32x4 v0 = acc[ai][bj][m][0], v1 = acc[ai][bj][m][1];
                        if (rot) rope4(v0, v1, ropeA + (size_t)row * 16 + fq * 8);
                        if (pn < 4) { v0 *= QS_DA; v1 *= QS_DA; }
                        if (DA_QK8 != 1) *(u32x4*)(dst + (size_t)row * 1024 + colt + bj * HALF + cl) = pack8(v0, v1);
                        if (DA_QK8) { const float s8 = pn < 4 ? 8.f : 1.f; u32x2 w8; w8.x = cvt_pk_fp8x4(v0[0] * s8, v0[1] * s8, v0[2] * s8, v0[3] * s8); w8.y = cvt_pk_fp8x4(v1[0] * s8, v1[1] * s8, v1[2] * s8, v1[3] * s8);
                            *(u32x2*)((pn < 4 ? q8a : k8a) + (size_t)row * 1024 + colt + bj * HALF + cl) = w8;
                            if (DA_QLO && pn < 4) {
                                const auto b0 = __builtin_amdgcn_cvt_pk_f32_fp8((int)w8.x, false), b1 = __builtin_amdgcn_cvt_pk_f32_fp8((int)w8.x, true), b2 = __builtin_amdgcn_cvt_pk_f32_fp8((int)w8.y, false), b3 = __builtin_amdgcn_cvt_pk_f32_fp8((int)w8.y, true);
                                u32x2 wl; wl.x = cvt_pk_fp8x4((v0[0] * 8.f - b0[0]) * 16.f, (v0[1] * 8.f - b0[1]) * 16.f, (v0[2] * 8.f - b1[0]) * 16.f, (v0[3] * 8.f - b1[1]) * 16.f);
                                wl.y = cvt_pk_fp8x4((v1[0] * 8.f - b2[0]) * 16.f, (v1[1] * 8.f - b2[1]) * 16.f, (v1[2] * 8.f - b3[0]) * 16.f, (v1[3] * 8.f - b3[1]) * 16.f);
                                *(u32x2*)(q8l + (size_t)row * 1024 + colt + bj * HALF + cl) = wl; } } } }
        } else if (pn < 12) {
            const int colt = (pn - 8) * 256;
#pragma unroll
            for (int ai = 0; ai < 2; ++ai)
#pragma unroll
                for (int m = 0; m < 4; ++m) { const int row = row0 + ai * HALF + m * 16;
#pragma unroll
                    for (int bj = 0; bj < 2; ++bj) { const f32x4 v0 = acc[ai][bj][m][0], v1 = acc[ai][bj][m][1]; *(u32x4*)(va + (size_t)row * 1024 + colt + bj * HALF + cl) = pack8(v0, v1);
                        if (DA_PV8) { u32x2 w8; w8.x = cvt_pk_fp8x4(v0[0], v0[1], v0[2], v0[3]); w8.y = cvt_pk_fp8x4(v1[0], v1[1], v1[2], v1[3]); *(u32x2*)(v8a + (size_t)row * 1024 + colt + bj * HALF + cl) = w8; } } }
        } else if (pn < 17) {
            const bool isq = pn < 15; bf16_t* dst = isq ? cq : ckv; const int ld = isq ? QL : KVL, colt = (isq ? pn - 12 : pn - 15) * 256, tq = pn - 12;
#pragma unroll
            for (int ai = 0; ai < 2; ++ai)
#pragma unroll
                for (int m = 0; m < 4; ++m) { const int row = row0 + ai * HALF + m * 16; float s = 0.f;
#pragma unroll
                    for (int bj = 0; bj < 2; ++bj) { const f32x4 v0 = acc[ai][bj][m][0], v1 = acc[ai][bj][m][1];
                        s += (v0[0] * v0[0] + v0[1] * v0[1]) + (v0[2] * v0[2] + v0[3] * v0[3]) + (v1[0] * v1[0] + v1[1] * v1[1]) + (v1[2] * v1[2] + v1[3] * v1[3]);
                        if (UP_F8) { u32x2 w8; w8.x = cvt_pk_fp8x4(v0[0], v0[1], v0[2], v0[3]); w8.y = cvt_pk_fp8x4(v1[0], v1[1], v1[2], v1[3]); *(u32x2*)((unsigned char*)dst + (size_t)row * ld + colt + bj * HALF + cl) = w8; }
                        else *(u32x4*)(dst + (size_t)row * ld + colt + bj * HALF + cl) = pack8(v0, v1); }
                    s += __shfl_xor(s, 16); s += __shfl_xor(s, 32);
                    if (fq == 0) sq[(size_t)row * 20 + tq * 4 + wc] = s; }
        } else if (pn != 23) {
            const int colt = (pn < 23 ? pn - 17 : pn - 18) * 256;
            f32x4 bv[2][2];
#pragma unroll
            for (int bj = 0; bj < 2; ++bj) { bv[bj][0] = *(const f32x4*)(bg + colt + bj * HALF + cl); bv[bj][1] = *(const f32x4*)(bg + colt + bj * HALF + cl + 4); if (DBG_SKIP & 256) { bv[bj][0] = bv[bj][0] * 0.f; bv[bj][1] = bv[bj][1] * 0.f; } }
#pragma unroll
            for (int ai = 0; ai < 2; ++ai)
#pragma unroll
                for (int m = 0; m < 4; ++m) { const int row = row0 + ai * HALF + m * 16;
#pragma unroll
                    for (int bj = 0; bj < 2; ++bj) { f32x4 v0 = acc[ai][bj][m][0] + bv[bj][0], v1 = acc[ai][bj][m][1] + bv[bj][1];
#pragma unroll
                        for (int j = 0; j < 4; ++j) { if (!(DBG_SKIP & 512)) { v0[j] = sigmoidf_(v0[j]); v1[j] = sigmoidf_(v1[j]); } }
                        *(u32x4*)(gates + (size_t)row * 2048 + colt + bj * HALF + cl) = pack8(v0, v1); } }
        } else {
            if (wc < 2) {
#pragma unroll
                for (int ai = 0; ai < 2; ++ai)
#pragma unroll
                    for (int m = 0; m < 4; ++m) { const int row = row0 + ai * HALF + m * 16;
                        f32x4 v0 = acc[ai][0][m][0], v1 = acc[ai][0][m][1];
                        rope4(v0, v1, ropeM + (size_t)row * 64 + (wc * 16 + fq * 4) * 2);
                        if (!MLA_QK8) *(u32x4*)(kr + (size_t)row * 64 + cl) = pack8(v0, v1);
                        if (MLA_QK8) { u32x2 w8; w8.x = cvt_pk_fp8x4(v0[0], v0[1], v0[2], v0[3]); w8.y = cvt_pk_fp8x4(v1[0], v1[1], v1[2], v1[3]); *(u32x2*)(k8r + (size_t)row * 64 + cl) = w8; } }
            }
        }
    }
};
template <bool ISQ> struct EpiUp {
    static constexpr bool PERM = true;
    bf16_t* out; const float* sq; const float* ropeM; unsigned char* out8;
    __device__ __forceinline__ void operator()(const f32x4 (&acc)[2][2][4][2], const Unit& u, int wr, int wc, int fr, int fq) const {
        const int row0 = u.pm * BM + wr * 64 + fr, cl = wc * 32 + 8 * fq; constexpr int LD = ISQ ? 1536 : 2048;
#pragma unroll
        for (int ai = 0; ai < 2; ++ai)
#pragma unroll
            for (int m = 0; m < 4; ++m) { const int row = row0 + ai * HALF + m * 16; float s;
                if (ISQ) { const f32x4 a = *(const f32x4*)(sq + (size_t)row * 20), b = *(const f32x4*)(sq + (size_t)row * 20 + 4), c = *(const f32x4*)(sq + (size_t)row * 20 + 8);
                    s = ((a[0] + a[1]) + (a[2] + a[3])) + ((b[0] + b[1]) + (b[2] + b[3])) + ((c[0] + c[1]) + (c[2] + c[3])); }
                else { const f32x4 a = *(const f32x4*)(sq + (size_t)row * 20 + 12), b = *(const f32x4*)(sq + (size_t)row * 20 + 16);
                    s = ((a[0] + a[1]) + (a[2] + a[3])) + ((b[0] + b[1]) + (b[2] + b[3])); }
                const float rstd = __builtin_amdgcn_rsqf(s * (ISQ ? 1.0f / QL : 1.0f / KVL) + EPS) * (ISQ ? QS_MLA : 1.0f);
#pragma unroll
                for (int bj = 0; bj < 2; ++bj) { const int col = u.pn * BM + bj * HALF + cl; f32x4 v0 = acc[ai][bj][m][0] * rstd, v1 = acc[ai][bj][m][1] * rstd;
                    if (ISQ) { const int off = col % 192; if (off >= 128) rope4(v0, v1, ropeM + (size_t)row * 64 + (off - 128)); }
                    if (!MLA_QK8 || (!ISQ && bj == 1)) *(u32x4*)(out + (size_t)row * LD + col) = pack8(v0, v1);
                    if (MLA_QK8) { u32x2 w8;
                        if (ISQ) { w8.x = cvt_pk_fp8x4(v0[0] * 8.f, v0[1] * 8.f, v0[2] * 8.f, v0[3] * 8.f); w8.y = cvt_pk_fp8x4(v1[0] * 8.f, v1[1] * 8.f, v1[2] * 8.f, v1[3] * 8.f); *(u32x2*)(out8 + (size_t)row * 1536 + col) = w8; }
                        else if (bj == 0) { w8.x = cvt_pk_fp8x4(v0[0], v0[1], v0[2], v0[3]); w8.y = cvt_pk_fp8x4(v1[0], v1[1], v1[2], v1[3]); *(u32x2*)(out8 + (size_t)row * 1024 + u.pn * 128 + cl) = w8; } } } }
    }
};
template <bool ISQ> struct EpiUp8 {
    bf16_t* out; const float* sq; const float* ropeM; unsigned char* out8; unsigned char* v8 = nullptr;
    __device__ __forceinline__ void operator()(const f32x4 (&acc)[2][4][2], const Unit& u, int wr, int wc, int fr, int fq) const {
        const int row0 = u.pm * BM + wr * 64 + fr, col = u.pn * HALF + wc * 32 + 8 * fq;
#pragma unroll
        for (int ai = 0; ai < 2; ++ai)
#pragma unroll
            for (int m = 0; m < 4; ++m) { const int row = row0 + ai * HALF + m * 16; float s;
                if (ISQ) { const f32x4 a = *(const f32x4*)(sq + (size_t)row * 20), b = *(const f32x4*)(sq + (size_t)row * 20 + 4), c = *(const f32x4*)(sq + (size_t)row * 20 + 8);
                    s = ((a[0] + a[1]) + (a[2] + a[3])) + ((b[0] + b[1]) + (b[2] + b[3])) + ((c[0] + c[1]) + (c[2] + c[3])); }
                else { const f32x4 a = *(const f32x4*)(sq + (size_t)row * 20 + 12), b = *(const f32x4*)(sq + (size_t)row * 20 + 16);
                    s = ((a[0] + a[1]) + (a[2] + a[3])) + ((b[0] + b[1]) + (b[2] + b[3])); }
                const float rstd = __builtin_amdgcn_rsqf(s * (ISQ ? 1.0f / QL : 1.0f / KVL) + EPS) * (ISQ ? QS_MLA : 1.0f);
                f32x4 v0 = acc[ai][m][0] * rstd, v1 = acc[ai][m][1] * rstd;
                if (ISQ) { const int off = col % 192; if (off >= 128) rope4(v0, v1, ropeM + (size_t)row * 64 + (off - 128));
                    u32x2 w8; w8.x = cvt_pk_fp8x4(v0[0] * 8.f, v0[1] * 8.f, v0[2] * 8.f, v0[3] * 8.f); w8.y = cvt_pk_fp8x4(v1[0] * 8.f, v1[1] * 8.f, v1[2] * 8.f, v1[3] * 8.f); *(u32x2*)(out8 + (size_t)row * 1536 + col) = w8; }
                else if ((u.pn & 1) == 0) { u32x2 w8; w8.x = cvt_pk_fp8x4(v0[0], v0[1], v0[2], v0[3]); w8.y = cvt_pk_fp8x4(v1[0], v1[1], v1[2], v1[3]); *(u32x2*)(out8 + (size_t)row * 1024 + (u.pn >> 1) * 128 + wc * 32 + 8 * fq) = w8; }
                else if (MLA_PV8) { u32x2 w8; w8.x = cvt_pk_fp8x4(v0[0], v0[1], v0[2], v0[3]); w8.y = cvt_pk_fp8x4(v1[0], v1[1], v1[2], v1[3]); *(u32x2*)(v8 + (size_t)row * 1024 + (u.pn >> 1) * 128 + wc * 32 + 8 * fq) = w8; }
                else *(u32x4*)(out + (size_t)row * 2048 + col) = pack8(v0, v1); }
    }
};
template <int WHICH> struct EpiGate {
    static constexpr bool PERM = true;
    bf16_t* mrg; const bf16_t* gates;
    __device__ __forceinline__ void operator()(const f32x4 (&acc)[2][2][4][2], const Unit& u, int wr, int wc, int fr, int fq) const {
        const int row0 = u.pm * BM + wr * 64 + fr, cl = wc * 32 + 8 * fq;
#pragma unroll
        for (int ai = 0; ai < 2; ++ai)
#pragma unroll
            for (int m = 0; m < 4; ++m) { const int row = row0 + ai * HALF + m * 16;
#pragma unroll
                for (int bj = 0; bj < 2; ++bj) { const int col = u.pn * BM + bj * HALF + cl;
                    const u32x4 gw = *(const u32x4*)(gates + (size_t)row * 2048 + WHICH * 1024 + col);
                    f32x4 v0 = acc[ai][bj][m][0], v1 = acc[ai][bj][m][1];
                    if ((DBG_SKIP & 8) && WHICH == 0) { v0 = v0 * 0.f; v1 = v1 * 0.f; } if ((DBG_SKIP & 16) && WHICH == 1) { v0 = v0 * 0.f; v1 = v1 * 0.f; }
                    v0[0] *= bf_lo(gw.x); v0[1] *= bf_hi(gw.x); v0[2] *= bf_lo(gw.y); v0[3] *= bf_hi(gw.y); v1[0] *= bf_lo(gw.z); v1[1] *= bf_hi(gw.z); v1[2] *= bf_lo(gw.w); v1[3] *= bf_hi(gw.w);
                    if (WHICH == 1) { const u32x4 tw = *(const u32x4*)(mrg + (size_t)row * 1024 + col);
                        v0[0] += bf_lo(tw.x); v0[1] += bf_hi(tw.x); v0[2] += bf_lo(tw.y); v0[3] += bf_hi(tw.y); v1[0] += bf_lo(tw.z); v1[1] += bf_hi(tw.z); v1[2] += bf_lo(tw.w); v1[3] += bf_hi(tw.w); }
                    *(u32x4*)(mrg + (size_t)row * 1024 + col) = pack8(v0, v1); } }
    }
};
struct EpiRes {
    static constexpr bool PERM = false;
    const float* x; bf16_t* out;
    __device__ __forceinline__ void operator()(const f32x4 (&acc)[2][2][4][2], const Unit& u, int wr, int wc, int fr, int fq) const {
        const int row0 = u.pm * BM + wr * 64 + fr, col0 = u.pn * BM + wc * 32 + 4 * fq;
#pragma unroll
        for (int ai = 0; ai < 2; ++ai)
#pragma unroll
            for (int m = 0; m < 4; ++m) { const size_t off = (size_t)(row0 + ai * HALF + m * 16) * 1024 + col0;
#pragma unroll
                for (int bj = 0; bj < 2; ++bj)
#pragma unroll
                    for (int n = 0; n < 2; ++n) { const f32x4 v = *(const f32x4*)(x + off + bj * HALF + n * 16) + ((DBG_SKIP & 2) ? 0.f : 1.f) * acc[ai][bj][m][n];
                        u32x2 w; w.x = cvt_pk_bf16(v[0], v[1]); w.y = cvt_pk_bf16(v[2], v[3]); *(u32x2*)(out + off + bj * HALF + n * 16) = w; } }
    }
};
struct EpiSwiglu {
    static constexpr bool PERM = true;
    bf16_t* act; const float *bgate, *bup;
    __device__ __forceinline__ void operator()(const f32x4 (&acc)[2][2][4][2], const Unit& u, int wr, int wc, int fr, int fq) const {
        const int row0 = u.pm * BM + wr * 64 + fr, f0 = u.pn * HALF + wc * 32 + 8 * fq;
        f32x4 bgv[2], buv[2];
#pragma unroll
        for (int n = 0; n < 2; ++n) { bgv[n] = *(const f32x4*)(bgate + (size_t)u.e * FF + f0 + 4 * n); buv[n] = *(const f32x4*)(bup + (size_t)u.e * FF + f0 + 4 * n); }
#pragma unroll
        for (int ai = 0; ai < 2; ++ai)
#pragma unroll
            for (int m = 0; m < 4; ++m) { const int row = row0 + ai * HALF + m * 16; f32x4 o[2];
#pragma unroll
                for (int n = 0; n < 2; ++n) { const f32x4 gt = acc[ai][0][m][n] + bgv[n], up = acc[ai][1][m][n] + buv[n];
#pragma unroll
                    for (int j = 0; j < 4; ++j) { const float gg = fminf(gt[j], 7.0f), uu = fminf(fmaxf(up[j], -7.0f), 7.0f); o[n][j] = (uu + 1.0f) * (gg * sigmoidf_(1.702f * gg)); } }
                u32x2 w8; w8.x = cvt_pk_fp8x4(o[0][0], o[0][1], o[0][2], o[0][3]); w8.y = cvt_pk_fp8x4(o[1][0], o[1][1], o[1][2], o[1][3]);
                *(u32x2*)((unsigned char*)act + (size_t)row * FF + f0) = w8; }
    }
};
struct EpiDown {
    static constexpr bool PERM = true;
    bf16_t* y; const float* bd;
    __device__ __forceinline__ void operator()(const f32x4 (&acc)[2][2][4][2], const Unit& u, int wr, int wc, int fr, int fq) const {
        const int row0 = u.pm * BM + wr * 64 + fr, cl = wc * 32 + 8 * fq;
        f32x4 bv[2][2];
#pragma unroll
        for (int bj = 0; bj < 2; ++bj) { const int col = u.pn * BM + bj * HALF + cl; bv[bj][0] = *(const f32x4*)(bd + (size_t)u.e * D + col); bv[bj][1] = *(const f32x4*)(bd + (size_t)u.e * D + col + 4); }
#pragma unroll
        for (int ai = 0; ai < 2; ++ai)
#pragma unroll
            for (int m = 0; m < 4; ++m) { const int row = row0 + ai * HALF + m * 16;
#pragma unroll
                for (int bj = 0; bj < 2; ++bj) { const int col = u.pn * BM + bj * HALF + cl;
                    *(u32x4*)(y + (size_t)row * D + col) = pack8(acc[ai][bj][m][0] + bv[bj][0], acc[ai][bj][m][1] + bv[bj][1]); } }
    }
};
struct EpiSwiglu8 {
    unsigned char* act; const float *bgate, *bup;
    __device__ __forceinline__ void operator()(const f32x4 (&acc)[2][4][2], const Unit& u, int wr, int wc, int fr, int fq) const {
        const int row0 = u.pm * BM + wr * 64 + fr, f0 = u.pn * 64 + wc * 16 + 4 * fq;
        const f32x4 bgv = *(const f32x4*)(bgate + (size_t)u.e * FF + f0), buv = *(const f32x4*)(bup + (size_t)u.e * FF + f0);
#pragma unroll
        for (int ai = 0; ai < 2; ++ai)
#pragma unroll
            for (int m = 0; m < 4; ++m) { const int row = row0 + ai * HALF + m * 16; const f32x4 gt = acc[ai][m][0] + bgv, up = acc[ai][m][1] + buv; float o[4];
#pragma unroll
                for (int j = 0; j < 4; ++j) { const float gg = fminf(gt[j], 7.0f), uu = fminf(fmaxf(up[j], -7.0f), 7.0f); o[j] = (uu + 1.0f) * (gg * sigmoidf_(1.702f * gg)); }
                *(unsigned*)(act + (size_t)row * FF + f0) = cvt_pk_fp8x4(o[0], o[1], o[2], o[3]); }
    }
};
struct EpiDown8 {
    unsigned char* y; const float* bd;
    __device__ __forceinline__ void operator()(const f32x4 (&acc)[2][4][2], const Unit& u, int wr, int wc, int fr, int fq) const {
        const int row0 = u.pm * BM + wr * 64 + fr, col = u.pn * HALF + wc * 32 + 8 * fq;
        const f32x4 bv0 = *(const f32x4*)(bd + (size_t)u.e * D + col), bv1 = *(const f32x4*)(bd + (size_t)u.e * D + col + 4);
#pragma unroll
        for (int ai = 0; ai < 2; ++ai)
#pragma unroll
            for (int m = 0; m < 4; ++m) { const int row = row0 + ai * HALF + m * 16; const f32x4 v0 = (acc[ai][m][0] + bv0) * YS, v1 = (acc[ai][m][1] + bv1) * YS;
                u32x2 w; w.x = cvt_pk_fp8x4(v0[0], v0[1], v0[2], v0[3]); w.y = cvt_pk_fp8x4(v1[0], v1[1], v1[2], v1[3]);
                *(u32x2*)(y + (size_t)row * D + col) = w; }
    }
};
}

namespace att {
constexpr int NW = 8, QBLK = 32, KVBLK = 64;
constexpr int SHM_V = KVBLK * 128 * 2;
#define SBAR() __builtin_amdgcn_sched_barrier(0)
#define KSW(row, colB) ((row) * 128 + ((colB) ^ ((((row) >> 1) & 7) << 4)))
__device__ __forceinline__ int crow(int r, int hi) { return (r & 3) + 8 * (r >> 2) + 4 * hi; }
struct Src { const bf16_t* Q; const bf16_t* K; const bf16_t* K2; const bf16_t* V; int ldq, ldk, ldk2, ldv; };

__device__ __forceinline__ void partialSM(f32x16& p0, f32x16& p1, float& m_reg, float& mn, float& alpha, const float C, const float thr) {
  float pmax;
  { float a0 = fmaxf(fmaxf(p0[0], p0[1]), p0[2]), a1 = fmaxf(fmaxf(p0[3], p0[4]), p0[5]), a2 = fmaxf(fmaxf(p1[0], p1[1]), p1[2]), a3 = fmaxf(fmaxf(p1[3], p1[4]), p1[5]);
#pragma unroll
    for (int r = 6; r < 16; r += 2) { a0 = fmaxf(fmaxf(a0, p0[r]), p0[r + 1]); a2 = fmaxf(fmaxf(a2, p1[r]), p1[r + 1]); }
    pmax = fmaxf(fmaxf(a0, a1), fmaxf(a2, a3)); }
  { auto rr = __builtin_amdgcn_permlane32_swap(__float_as_uint(pmax), __float_as_uint(pmax), false, false);
    pmax = fmaxf(__uint_as_float(rr[0]), __uint_as_float(rr[1])); }
  if (__builtin_expect(__all(pmax - m_reg <= thr), 1)) { mn = m_reg; alpha = 1.f; }
  else { mn = fmaxf(m_reg, pmax); alpha = __builtin_amdgcn_exp2f((m_reg - mn) * C); m_reg = mn; }
  const float mnC = -mn * C;
#pragma unroll
  for (int r = 0; r < 16; ++r) p0[r] = fmaf(p0[r], C, mnC);
#pragma unroll
  for (int r = 0; r < 16; ++r) p1[r] = fmaf(p1[r], C, mnC);
#pragma unroll
  for (int r = 0; r < 16; ++r) p0[r] = __builtin_amdgcn_exp2f(p0[r]);
#if ATT_DUP == 1
  { float d_[16];
#pragma unroll
    for (int r = 0; r < 16; ++r) { d_[r] = __builtin_amdgcn_exp2f(p1[r]); d_[r] = fmaf(d_[r], C, mnC); }
#pragma unroll
    for (int r = 0; r < 16; ++r) asm volatile("" :: "v"(d_[r])); }
#endif
}
__device__ __forceinline__ void finishSM(f32x16& p0, f32x16& p1, float alpha, float& l_reg, bf16x8& pa0, bf16x8& pa1, bf16x8& pa2, bf16x8& pa3) {
#pragma unroll
  for (int r = 0; r < 16; ++r) p1[r] = __builtin_amdgcn_exp2f(p1[r]);
  float ps;
  { float s0 = p0[0] + p0[1], s1 = p0[2] + p0[3], s2 = p1[0] + p1[1], s3 = p1[2] + p1[3];
#pragma unroll
    for (int r = 4; r < 16; r += 4) { s0 += p0[r] + p0[r + 1]; s1 += p0[r + 2] + p0[r + 3]; s2 += p1[r] + p1[r + 1]; s3 += p1[r + 2] + p1[r + 3]; }
    ps = (s0 + s1) + (s2 + s3); }
  { auto rr = __builtin_amdgcn_permlane32_swap(__float_as_uint(ps), __float_as_uint(ps), false, false);
    ps = __uint_as_float(rr[0]) + __uint_as_float(rr[1]); }
  l_reg = l_reg * alpha + ps;
#define PK4(P, BASE, OUT) do { unsigned a0 = cvt_pk_bf16(P[BASE + 0], P[BASE + 1]), a1 = cvt_pk_bf16(P[BASE + 2], P[BASE + 3]);   \
    unsigned b0 = cvt_pk_bf16(P[BASE + 4], P[BASE + 5]), b1 = cvt_pk_bf16(P[BASE + 6], P[BASE + 7]);                              \
    auto r0 = __builtin_amdgcn_permlane32_swap(a0, b0, false, false); auto r1 = __builtin_amdgcn_permlane32_swap(a1, b1, false, false); \
    u32x4 w = {r0[0], r1[0], r0[1], r1[1]}; OUT = *reinterpret_cast<bf16x8*>(&w); } while (0)
  PK4(p0, 0, pa0); PK4(p0, 8, pa1); PK4(p1, 0, pa2); PK4(p1, 8, pa3);
#undef PK4
}
template <int DQK> __device__ __forceinline__ void qkt(f32x16& p0, f32x16& p1, const LAS char* Ks, const bf16x8* qr, int r32, int hi) {
  p0 = f32x16{}; p1 = f32x16{};
#pragma unroll
  for (int d0 = 0; d0 < DQK / 16; d0 += 2) {
    bf16x8 kf[2][2];
#pragma unroll
    for (int d = 0; d < 2; ++d) { const int sub = (d0 + d) >> 2, cb = (((d0 + d) & 3) * 16 + hi * 8) * 2;
      kf[d][0] = *(const LAS bf16x8*)(Ks + sub * 8192 + KSW(r32, cb)); kf[d][1] = *(const LAS bf16x8*)(Ks + sub * 8192 + KSW(32 + r32, cb)); }
    SBAR();
#pragma unroll
    for (int d = 0; d < 2; ++d) {
      p0 = __builtin_amdgcn_mfma_f32_32x32x16_bf16(kf[d][0], qr[d0 + d], p0, 0, 0, 0);
      p1 = __builtin_amdgcn_mfma_f32_32x32x16_bf16(kf[d][1], qr[d0 + d], p1, 0, 0, 0); }
  }
}
__device__ __forceinline__ int v_st(int k, int c) { const int kk = (k & ~0xC) | ((k & 4) << 1) | ((k & 8) >> 1); return ((kk >> 3) * 4 + (c >> 5)) * 512 + ((kk & 7) * 32 + (c & 31)) * 2; }
__device__ __forceinline__ int v_rd_base(int lane) { return ((lane & 3) << 3) | (((lane >> 2) & 3) << 6) | (((lane >> 4) & 1) << 5) | (((lane >> 5) & 1) << 8); }
constexpr int v_rd_off(int d0, int ks, int half) { return d0 * 512 + ks * 4096 + half * 2048; }
template <int OFF> __device__ __forceinline__ s16x4 tr_read(int vb) {
  s16x4 r; asm volatile("ds_read_b64_tr_b16 %0, %1 offset:%2" : "=&v"(r) : "v"(vb), "i"(OFF) : "memory"); return r;
}
template <int KS> __device__ __forceinline__ void pv_step(f32x16* o, int vb, bf16x8 pa) {
  s16x4 l0, h0, l1, h1, l2, h2, l3, h3;
  l0 = tr_read<v_rd_off(0, KS, 0)>(vb); h0 = tr_read<v_rd_off(0, KS, 1)>(vb); l1 = tr_read<v_rd_off(1, KS, 0)>(vb); h1 = tr_read<v_rd_off(1, KS, 1)>(vb);
  l2 = tr_read<v_rd_off(2, KS, 0)>(vb); h2 = tr_read<v_rd_off(2, KS, 1)>(vb); l3 = tr_read<v_rd_off(3, KS, 0)>(vb); h3 = tr_read<v_rd_off(3, KS, 1)>(vb);
  asm volatile("s_waitcnt lgkmcnt(0)" ::: "memory"); SBAR();
#define PK(L, H) (bf16x8){L[0], L[1], L[2], L[3], H[0], H[1], H[2], H[3]}
  o[0] = __builtin_amdgcn_mfma_f32_32x32x16_bf16(pa, PK(l0, h0), o[0], 0, 0, 0);
  o[1] = __builtin_amdgcn_mfma_f32_32x32x16_bf16(pa, PK(l1, h1), o[1], 0, 0, 0);
  o[2] = __builtin_amdgcn_mfma_f32_32x32x16_bf16(pa, PK(l2, h2), o[2], 0, 0, 0);
  o[3] = __builtin_amdgcn_mfma_f32_32x32x16_bf16(pa, PK(l3, h3), o[3], 0, 0, 0);
#undef PK
}
__device__ __forceinline__ void pv_d0(f32x16* o, int vb, bf16x8 pa0, bf16x8 pa1, bf16x8 pa2, bf16x8 pa3) {
  pv_step<0>(o, vb, pa0); pv_step<1>(o, vb, pa1); pv_step<2>(o, vb, pa2); pv_step<3>(o, vb, pa3);
}
template <int DQK>
__device__ __forceinline__ void attn_core(const Src in, const float C, const float thr, const int seq, LAS char* lds, f32x16 (&o)[4]) {
  constexpr int NSUB = DQK / 64, SHM_K = NSUB * 8192;
  int lane; asm volatile("v_and_b32 %0, 63, %1" : "=v"(lane) : "v"(threadIdx.x));
  const int tid = threadIdx.x, wid = __builtin_amdgcn_readfirstlane(tid >> 6), r32 = lane & 31, hi = (lane >> 5) & 1;
  LAS char* V_lds = lds; LAS char* K_lds = lds + 3 * SHM_V;
  LAS float* ws = (LAS float*)(lds + 3 * SHM_V + 3 * SHM_K) + wid * 64; LAS float* li_l = ws; LAS float* al_l = ws + 32;
  float m_reg = -1e30f, l_reg = 0;
#pragma unroll
  for (int d = 0; d < 4; ++d) o[d] = f32x16{};
  bf16x8 qr[DQK / 16];
  const bf16_t* Qw = in.Q + (size_t)(wid * QBLK + r32) * in.ldq + hi * 8;
#pragma unroll
  for (int d0 = 0; d0 < DQK / 16; ++d0) qr[d0] = *(const bf16x8*)(Qw + d0 * 16);
  const int krow = wid * 8 + (lane >> 3), kslot = (lane & 7) ^ ((krow >> 1) & 7);
  const unsigned koff = (unsigned)(krow * in.ldk + kslot * 8) * 2u, k2off = (unsigned)(krow * in.ldk2 + kslot * 8) * 2u;
  unsigned voff[2];
#pragma unroll
  for (int i = 0; i < 2; ++i) { const int p = i * 8192 + wid * 1024 + lane * 16, st = p >> 9, wq = (p & 511) >> 1, kk = (st >> 2) * 8 + (wq >> 5), cl = wq & 31;
    const int k = (kk & ~0xC) | ((kk & 4) << 1) | ((kk & 8) >> 1); voff[i] = (unsigned)(k * in.ldv + (st & 3) * 32 + cl) * 2u; }
  const int vb0 = (int)(unsigned)(size_t)V_lds + v_rd_base(lane);
  const unsigned ldsw = (unsigned)wid * 1024u;
#define GLDS(gp, lp) __builtin_amdgcn_global_load_lds((const unsigned*)(gp), (LAS unsigned*)(lp), 16, 0, 0)
#define ISSUE_K(t, b) do { const char* kb_ = (const char*)in.K + (size_t)(t) * (KVBLK * 2) * in.ldk; \
    _Pragma("unroll") for (int s_ = 0; s_ < NSUB; ++s_) { if (s_ < 2) GLDS(kb_ + s_ * 128 + koff, K_lds + (b) * SHM_K + s_ * 8192 + ldsw); \
      else GLDS((const char*)in.K2 + (size_t)(t) * (KVBLK * 2) * in.ldk2 + k2off, K_lds + (b) * SHM_K + s_ * 8192 + ldsw); } } while (0)
#define ISSUE_V(t, b) do { const char* vb_ = (const char*)in.V + (size_t)(t) * (KVBLK * 2) * in.ldv; \
    GLDS(vb_ + voff[0], V_lds + (b) * SHM_V + ldsw); GLDS(vb_ + voff[1], V_lds + (b) * SHM_V + 8192 + ldsw); \
    if (ATT_DUP == 3) { GLDS(vb_ + voff[0], V_lds + (b) * SHM_V + ldsw); GLDS(vb_ + voff[1], V_lds + (b) * SHM_V + 8192 + ldsw); } } while (0)
#define WAITV(n) asm volatile("s_waitcnt vmcnt(%0)" :: "n"((DBG_SKIP & 4) ? 0 : (n)) : "memory")
#define WBAR() do { asm volatile("" ::: "memory"); __builtin_amdgcn_s_barrier(); asm volatile("" ::: "memory"); } while (0)
#define RESC(a) do { if (__any((a) < 1.f)) { if (hi == 0) al_l[r32] = (a); asm volatile("s_waitcnt lgkmcnt(0)" ::: "memory"); \
    _Pragma("unroll") for (int d = 0; d < 4; ++d) _Pragma("unroll") for (int r = 0; r < 16; ++r) o[d][r] *= al_l[crow(r, hi)]; } } while (0)
#define NXT3(x) ((x) == 2 ? 0 : (x) + 1)
  constexpr int NI = NSUB + (ATT_DUP == 3 ? 4 : 2), NV = (ATT_DUP == 3 ? 4 : 2);
  f32x16 pA0, pA1, pB0, pB1; float mnA, mnB, alA, alB; bf16x8 pa0, pa1, pa2, pa3; const int NT = seq / KVBLK;
  const bool lead = wid < 4;
  ISSUE_K(0, 0); ISSUE_K(1, 1); ISSUE_V(0, 0);
  if (!lead) { WAITV(NI); WBAR(); }
  WAITV(NI); WBAR();
  ISSUE_K(2, 2);
  qkt<DQK>(pA0, pA1, K_lds, qr, r32, hi);
  WAITV(NI); WBAR();
  ISSUE_V(1, 1);
  partialSM(pA0, pA1, m_reg, mnA, alA, C, thr);
  WAITV(NI); WBAR();
  int bq = 1;
  for (int j = 1; j + 3 < NT; j += 2) {
    { const int b1 = NXT3(bq), b2 = NXT3(b1);
      ISSUE_K(j + 2, b2);
      SBAR(); qkt<DQK>(pB0, pB1, K_lds + bq * SHM_K, qr, r32, hi);
      finishSM(pA0, pA1, alA, l_reg, pa0, pa1, pa2, pa3); SBAR();
      WAITV(NI); WBAR();
      ISSUE_V(j + 1, b1);
      pv_d0(o, vb0 + b2 * SHM_V, pa0, pa1, pa2, pa3); partialSM(pB0, pB1, m_reg, mnB, alB, C, thr);
      RESC(alB); bq = b1;
      WAITV(NI); WBAR(); }
    { const int b1 = NXT3(bq), b2 = NXT3(b1);
      ISSUE_K(j + 3, b2);
      SBAR(); qkt<DQK>(pA0, pA1, K_lds + bq * SHM_K, qr, r32, hi);
      finishSM(pB0, pB1, alB, l_reg, pa0, pa1, pa2, pa3); SBAR();
      WAITV(NI); WBAR();
      ISSUE_V(j + 2, b1);
      pv_d0(o, vb0 + b2 * SHM_V, pa0, pa1, pa2, pa3); partialSM(pA0, pA1, m_reg, mnA, alA, C, thr);
      RESC(alA); bq = b1;
      WAITV(NI); WBAR(); }
  }
  { const int b1 = NXT3(bq), b2 = NXT3(b1);
    ISSUE_K(NT - 1, b2);
    SBAR(); qkt<DQK>(pB0, pB1, K_lds + bq * SHM_K, qr, r32, hi);
    finishSM(pA0, pA1, alA, l_reg, pa0, pa1, pa2, pa3); SBAR();
    WAITV(NI); WBAR();
    ISSUE_V(NT - 2, b1);
    pv_d0(o, vb0 + b2 * SHM_V, pa0, pa1, pa2, pa3); partialSM(pB0, pB1, m_reg, mnB, alB, C, thr);
    RESC(alB); bq = b1;
    WAITV(NI); WBAR(); }
  { const int b1 = NXT3(bq), b2 = NXT3(b1);
    SBAR(); qkt<DQK>(pA0, pA1, K_lds + bq * SHM_K, qr, r32, hi);
    finishSM(pB0, pB1, alB, l_reg, pa0, pa1, pa2, pa3); SBAR();
    WAITV(NV); WBAR();
    ISSUE_V(NT - 1, b1);
    pv_d0(o, vb0 + b2 * SHM_V, pa0, pa1, pa2, pa3); partialSM(pA0, pA1, m_reg, mnA, alA, C, thr);
    RESC(alA); bq = b1;
    WAITV(NV); WBAR(); }
  { const int b2 = NXT3(NXT3(bq));
    SBAR(); qkt<DQK>(pB0, pB1, K_lds + bq * SHM_K, qr, r32, hi);
    finishSM(pA0, pA1, alA, l_reg, pa0, pa1, pa2, pa3); SBAR();
    WAITV(0); WBAR();
    pv_d0(o, vb0 + b2 * SHM_V, pa0, pa1, pa2, pa3); partialSM(pB0, pB1, m_reg, mnB, alB, C, thr);
    RESC(alB);
    WBAR(); }
  finishSM(pB0, pB1, alB, l_reg, pa0, pa1, pa2, pa3); SBAR();
  pv_d0(o, vb0 + bq * SHM_V, pa0, pa1, pa2, pa3);
  if (lead) { WBAR(); }
  if (hi == 0) li_l[r32] = l_reg; asm volatile("s_waitcnt lgkmcnt(0)" ::: "memory");
#pragma unroll
  for (int r = 0; r < 16; ++r) { const float rl = __builtin_amdgcn_rcpf(li_l[crow(r, hi)]);
#pragma unroll
    for (int d = 0; d < 4; ++d) o[d][r] *= rl; }
  asm volatile("s_waitcnt lgkmcnt(0)" ::: "memory"); WBAR();
#undef GLDS
#undef ISSUE_K
#undef ISSUE_V
#undef WAITV
#undef WBAR
#undef RESC
#undef NXT3
}
template <int DQK>
__device__ __forceinline__ void attn_core_seq(const Src in, const float C, const float thr, const int seq, LAS char* lds, f32x16 (&o)[4], float* probe = nullptr) {
  constexpr int NSUB = DQK / 64, SHM_K = NSUB * 8192;
  int lane; asm volatile("v_and_b32 %0, 63, %1" : "=v"(lane) : "v"(threadIdx.x));
  const int tid = threadIdx.x, wid = __builtin_amdgcn_readfirstlane(tid >> 6), r32 = lane & 31, hi = (lane >> 5) & 1;
  LAS char* V_lds = lds; LAS char* K_lds = lds + 3 * SHM_V;
  LAS float* ws = (LAS float*)(lds + 3 * SHM_V + 3 * SHM_K) + wid * 64; LAS float* li_l = ws; LAS float* al_l = ws + 32;
  float m_reg = -1e30f, l_reg = 0;
#pragma unroll
  for (int d = 0; d < 4; ++d) o[d] = f32x16{};
  bf16x8 qr[DQK / 16];
  const bf16_t* Qw = in.Q + (size_t)(wid * QBLK + r32) * in.ldq + hi * 8;
#pragma unroll
  for (int d0 = 0; d0 < DQK / 16; ++d0) qr[d0] = *(const bf16x8*)(Qw + d0 * 16);
  const int krow = wid * 8 + (lane >> 3), kslot = (lane & 7) ^ ((krow >> 1) & 7);
  const unsigned koff = (unsigned)(krow * in.ldk + kslot * 8) * 2u, k2off = (unsigned)(krow * in.ldk2 + kslot * 8) * 2u;
  unsigned voff[2];
#pragma unroll
  for (int i = 0; i < 2; ++i) { const int p = i * 8192 + wid * 1024 + lane * 16, st = p >> 9, wq = (p & 511) >> 1, kk = (st >> 2) * 8 + (wq >> 5), cl = wq & 31;
    const int k = (kk & ~0xC) | ((kk & 4) << 1) | ((kk & 8) >> 1); voff[i] = (unsigned)(k * in.ldv + (st & 3) * 32 + cl) * 2u; }
  const int vb0 = (int)(unsigned)(size_t)V_lds + v_rd_base(lane);
  const unsigned ldsw = (unsigned)wid * 1024u;
#define GLDS(gp, lp) __builtin_amdgcn_global_load_lds((const unsigned*)(gp), (LAS unsigned*)(lp), 16, 0, 0)
#define ISSUE_K(t, b) do { const char* kb_ = (const char*)in.K + (size_t)(t) * (KVBLK * 2) * in.ldk; \
    _Pragma("unroll") for (int s_ = 0; s_ < NSUB; ++s_) { if (s_ < 2) GLDS(kb_ + s_ * 128 + koff, K_lds + (b) * SHM_K + s_ * 8192 + ldsw); \
      else GLDS((const char*)in.K2 + (size_t)(t) * (KVBLK * 2) * in.ldk2 + k2off, K_lds + (b) * SHM_K + s_ * 8192 + ldsw); } } while (0)
#define ISSUE_V(t, b) do { const char* vb_ = (const char*)in.V + (size_t)(t) * (KVBLK * 2) * in.ldv; \
    GLDS(vb_ + voff[0], V_lds + (b) * SHM_V + ldsw); GLDS(vb_ + voff[1], V_lds + (b) * SHM_V + 8192 + ldsw); } while (0)
#define WAITV(n) asm volatile("s_waitcnt vmcnt(%0)" :: "n"(n) : "memory")
#define WBAR() do { asm volatile("" ::: "memory"); __builtin_amdgcn_s_barrier(); asm volatile("" ::: "memory"); } while (0)
#define RESC(a) do { if (__any((a) < 1.f)) { if (hi == 0) al_l[r32] = (a); asm volatile("s_waitcnt lgkmcnt(0)" ::: "memory"); \
    _Pragma("unroll") for (int d = 0; d < 4; ++d) _Pragma("unroll") for (int r = 0; r < 16; ++r) o[d][r] *= al_l[crow(r, hi)]; } } while (0)
#define NXT3(x) ((x) == 2 ? 0 : (x) + 1)
#define SEG_B(b) do { float mn, al; bf16x8 pa0, pa1, pa2, pa3; partialSM(p0, p1, m_reg, mn, al, C, thr); RESC(al); finishSM(p0, p1, al, l_reg, pa0, pa1, pa2, pa3); SBAR(); \
    pv_d0(o, vb0 + (b) * SHM_V, pa0, pa1, pa2, pa3); } while (0)
  constexpr int NI = NSUB + 2;
  f32x16 p0, p1; const int NT = seq / KVBLK; const bool lead = wid < 4;
  ISSUE_K(0, 0); ISSUE_V(0, 0); ISSUE_K(1, 1); ISSUE_V(1, 1);
  if (!lead) { WAITV(NI); WBAR(); }
  WAITV(NI); WBAR();
  int bq = 0;
#if PROBE_T == 4
  const unsigned long long t0 = __builtin_amdgcn_s_memtime();
#endif
  for (int j = 0; j + 2 < NT; ++j) {
    const int b1 = NXT3(bq), b2 = NXT3(b1);
    ISSUE_K(j + 2, b2);
    qkt<DQK>(p0, p1, K_lds + bq * SHM_K, qr, r32, hi);
    WAITV(NI); WBAR();
    ISSUE_V(j + 2, b2);
    SEG_B(bq);
    WAITV(NI); WBAR();
    bq = b1;
  }
#if PROBE_T == 4
  { const unsigned long long t1 = __builtin_amdgcn_s_memtime(); if (probe != nullptr && tid == 0) { probe[0] = 0.f; probe[1] = ((float)(t1 - t0) * (1.f / (NT - 2)) - 3000.f) * 0.02f; } }
#endif
#pragma unroll
  for (int jj = 0; jj < 2; ++jj) {
    qkt<DQK>(p0, p1, K_lds + bq * SHM_K, qr, r32, hi);
    WAITV(0); WBAR();
    SEG_B(bq);
    WBAR();
    bq = NXT3(bq);
  }
  if (lead) { WBAR(); }
  if (hi == 0) li_l[r32] = l_reg; asm volatile("s_waitcnt lgkmcnt(0)" ::: "memory");
#pragma unroll
  for (int r = 0; r < 16; ++r) { const float rl = __builtin_amdgcn_rcpf(li_l[crow(r, hi)]);
#pragma unroll
    for (int d = 0; d < 4; ++d) o[d][r] *= rl; }
  asm volatile("s_waitcnt lgkmcnt(0)" ::: "memory"); WBAR();
#undef GLDS
#undef ISSUE_K
#undef ISSUE_V
#undef WAITV
#undef WBAR
#undef RESC
#undef NXT3
#undef SEG_B
}
__device__ __forceinline__ void attn_core_da2(const Src in, const float C, const float thr, const int seq, LAS char* lds, f32x16 (&o1)[4], f32x16 (&o2)[4]) {
  constexpr int NSUB = 2, SHM_K = NSUB * 8192;
  int lane; asm volatile("v_and_b32 %0, 63, %1" : "=v"(lane) : "v"(threadIdx.x));
  const int tid = threadIdx.x, wid = __builtin_amdgcn_readfirstlane(tid >> 6), r32 = lane & 31, hi = (lane >> 5) & 1;
  LAS char* V_lds = lds; LAS char* K_lds = lds + 3 * SHM_V;
  LAS float* ws = (LAS float*)(lds + 3 * SHM_V + 3 * SHM_K) + wid * 64; LAS float* li_l = ws; LAS float* al_l = ws + 32;
  float m1 = -1e30f, l1 = 0, m2 = -1e30f, l2 = 0;
#pragma unroll
  for (int d = 0; d < 4; ++d) { o1[d] = f32x16{}; o2[d] = f32x16{}; }
  bf16x8 q1[4], q2[4];
  const bf16_t* Qw = in.Q + (size_t)(wid * QBLK + r32) * in.ldq + hi * 8;
#pragma unroll
  for (int d0 = 0; d0 < 4; ++d0) { q1[d0] = *(const bf16x8*)(Qw + d0 * 16); q2[d0] = *(const bf16x8*)(Qw + 64 + d0 * 16); }
  const int krow = wid * 8 + (lane >> 3), kslot = (lane & 7) ^ ((krow >> 1) & 7);
  const unsigned koff = (unsigned)(krow * in.ldk + kslot * 8) * 2u;
  unsigned voff[2];
#pragma unroll
  for (int i = 0; i < 2; ++i) { const int p = i * 8192 + wid * 1024 + lane * 16, st = p >> 9, wq = (p & 511) >> 1, kk = (st >> 2) * 8 + (wq >> 5), cl = wq & 31;
    const int k = (kk & ~0xC) | ((kk & 4) << 1) | ((kk & 8) >> 1); voff[i] = (unsigned)(k * in.ldv + (st & 3) * 32 + cl) * 2u; }
  const int vb0 = (int)(unsigned)(size_t)V_lds + v_rd_base(lane);
  const unsigned ldsw = (unsigned)wid * 1024u;
#define GLDS(gp, lp) __builtin_amdgcn_global_load_lds((const unsigned*)(gp), (LAS unsigned*)(lp), 16, 0, 0)
#define ISSUE_KV(t, b) do { const char* kb_ = (const char*)in.K + (size_t)(t) * (KVBLK * 2) * in.ldk; const char* vb_ = (const char*)in.V + (size_t)(t) * (KVBLK * 2) * in.ldv; \
    GLDS(kb_ + koff, K_lds + (b) * SHM_K + ldsw); GLDS(kb_ + 128 + koff, K_lds + (b) * SHM_K + 8192 + ldsw); \
    GLDS(vb_ + voff[0], V_lds + (b) * SHM_V + ldsw); GLDS(vb_ + voff[1], V_lds + (b) * SHM_V + 8192 + ldsw); } while (0)
#define WAITV(n) asm volatile("s_waitcnt vmcnt(%0)" :: "n"(n) : "memory")
#define WBAR() do { asm volatile("" ::: "memory"); __builtin_amdgcn_s_barrier(); asm volatile("" ::: "memory"); } while (0)
#define RESC(oo, a) do { if (__any((a) < 1.f)) { if (hi == 0) al_l[r32] = (a); asm volatile("s_waitcnt lgkmcnt(0)" ::: "memory"); \
    _Pragma("unroll") for (int d = 0; d < 4; ++d) _Pragma("unroll") for (int r = 0; r < 16; ++r) oo[d][r] *= al_l[crow(r, hi)]; asm volatile("s_waitcnt lgkmcnt(0)" ::: "memory"); } } while (0)
#define NXT3(x) ((x) == 2 ? 0 : (x) + 1)
#define TILE_BODY(b) do { f32x16 p0, p1; float mn, al; bf16x8 pa0, pa1, pa2, pa3; \
    qkt<64>(p0, p1, K_lds + (b) * SHM_K, q1, r32, hi); partialSM(p0, p1, m1, mn, al, C, thr); RESC(o1, al); \
    finishSM(p0, p1, al, l1, pa0, pa1, pa2, pa3); SBAR(); pv_d0(o1, vb0 + (b) * SHM_V, pa0, pa1, pa2, pa3); SBAR(); \
    qkt<64>(p0, p1, K_lds + (b) * SHM_K + 8192, q2, r32, hi); partialSM(p0, p1, m2, mn, al, C, thr); RESC(o2, al); \
    finishSM(p0, p1, al, l2, pa0, pa1, pa2, pa3); SBAR(); pv_d0(o2, vb0 + (b) * SHM_V, pa0, pa1, pa2, pa3); SBAR(); } while (0)
  const int NT = seq / KVBLK;
  ISSUE_KV(0, 0); ISSUE_KV(1, 1);
  int bq = 0;
  for (int j = 0; j + 1 < NT; ++j) {
    const int b1 = NXT3(bq), b2 = NXT3(b1);
    WAITV(4); WBAR();
    if (j + 2 < NT) ISSUE_KV(j + 2, b2); else ISSUE_KV(NT - 1, b2);
    TILE_BODY(bq);
    bq = b1;
  }
  WAITV(4); WBAR();
  TILE_BODY(bq);
  WAITV(0);
  if (hi == 0) { li_l[r32] = l1; al_l[r32] = l2; } asm volatile("s_waitcnt lgkmcnt(0)" ::: "memory");
#pragma unroll
  for (int r = 0; r < 16; ++r) { const float ra = __builtin_amdgcn_rcpf(li_l[crow(r, hi)]), rb = __builtin_amdgcn_rcpf(al_l[crow(r, hi)]);
#pragma unroll
    for (int d = 0; d < 4; ++d) { o1[d][r] *= ra; o2[d][r] *= rb; } }
  asm volatile("s_waitcnt lgkmcnt(0)" ::: "memory"); WBAR();
#undef GLDS
#undef ISSUE_KV
#undef WAITV
#undef WBAR
#undef RESC
#undef NXT3
#undef TILE_BODY
}
template <int I> struct IC { static constexpr int value = I; };
template <int LO, int HI, class F> __device__ __forceinline__ void sfor(F&& f) { if constexpr (LO < HI) { f(IC<LO>{}); sfor<LO + 1, HI>(f); } }
struct SMS { float a0, a1, a2, a3, dm; bool keep; };
__device__ __forceinline__ void mfma_c(f32x16& d, const bf16x8& a, const bf16x8& b, const f32x16& c) { asm("v_mfma_f32_32x32x16_bf16 %0, %1, %2, %3" : "=&v"(d) : "v"(a), "v"(b), "v"(c)); }
__device__ __forceinline__ void negm_bcast(f32x16& negm, float aone, float nm) { asm volatile("s_nop 1\n\tv_mfma_f32_32x32x2_f32 %0, %1, %2, 0\n\ts_nop 15\n\ts_nop 3" : "+v"(negm) : "v"(aone), "v"(nm)); }

struct VF { s16x4 l, h; };
template <int NEX> struct StartSched {
  static constexpr int NITEMS = 17 + NEX;
  static constexpr int kind(int n) { return n < 16 ? 0 : n == 16 ? 1 : 3; }
  static constexpr int idx(int n) { return n <= 16 ? n : n - 17; }
  static constexpr int weight(int n) { const int k = kind(n); return k == 3 ? 2 : k == 1 ? 3 : 1; }
  static constexpr int first(int g, int ng) { int W = 0; for (int i = 0; i < NITEMS; ++i) W += weight(i); int cum = 0; for (int i = 0; i < NITEMS; ++i) { if (cum * ng >= g * W) return i; cum += weight(i); } return NITEMS; }
};
template <int NEX> struct FinSched {
  static constexpr int NITEMS = NEX + 16;
  static constexpr int weight(int n) { return n < NEX ? 2 : 1; }
  static constexpr int first(int g, int ng) { int W = 0; for (int i = 0; i < NITEMS; ++i) W += weight(i); int cum = 0; for (int i = 0; i < NITEMS; ++i) { if (cum * ng >= g * W) return i; cum += weight(i); } return NITEMS; }
};
template <int N, int NEX> __device__ __forceinline__ void start_item(f32x16& P0, f32x16& P1, SMS& st, f32x16& negm, const float thr, const float hi_is0) {
  using SS = StartSched<NEX>; constexpr int K = SS::kind(N), I = SS::idx(N);
  if constexpr (K == 0) {
    if constexpr (I == 0) st.a0 = fmaxf(fmaxf(P0[0], P0[1]), P0[2]);
    else if constexpr (I == 1) st.a1 = fmaxf(fmaxf(P0[3], P0[4]), P0[5]);
    else if constexpr (I < 7) { if constexpr (I & 1) st.a1 = fmaxf(fmaxf(st.a1, P0[2 * I + 2]), P0[2 * I + 3]); else st.a0 = fmaxf(fmaxf(st.a0, P0[2 * I + 2]), P0[2 * I + 3]); }
    else if constexpr (I == 7) st.a2 = fmaxf(fmaxf(P1[0], P1[1]), P1[2]);
    else if constexpr (I == 8) st.a3 = fmaxf(fmaxf(P1[3], P1[4]), P1[5]);
    else if constexpr (I < 14) { constexpr int J = I - 7; if constexpr (J & 1) st.a3 = fmaxf(fmaxf(st.a3, P1[2 * J + 2]), P1[2 * J + 3]); else st.a2 = fmaxf(fmaxf(st.a2, P1[2 * J + 2]), P1[2 * J + 3]); }
    else if constexpr (I == 14) st.a0 = fmaxf(fmaxf(st.a0, st.a1), st.a2);
    else st.a0 = fmaxf(st.a0, st.a3);
  } else if constexpr (K == 1) {
    float pmax;
    { auto rr = __builtin_amdgcn_permlane32_swap(__float_as_uint(st.a0), __float_as_uint(st.a0), false, false); pmax = fmaxf(__uint_as_float(rr[0]), __uint_as_float(rr[1])); }
    st.keep = __all(pmax <= thr);
    if (__builtin_expect(!st.keep, 0)) {
      const float delta = fmaxf(pmax, 0.f); st.dm = -delta;
#pragma unroll
      for (int r = 0; r < 16; ++r) { P0[r] -= delta; P1[r] -= delta; }
      negm_bcast(negm, hi_is0, negm[0] - delta);
    }
  } else {
    if constexpr (I < 16) P0[I] = __builtin_amdgcn_exp2f(P0[I]); else P1[I - 16] = __builtin_amdgcn_exp2f(P1[I - 16]);
  }
}
template <int N, int NEX> __device__ __forceinline__ void fin_item(f32x16& P0, f32x16& P1, SMS& st, u32x4 (&pw)[4]) {
  if constexpr (N < NEX) { P1[16 - NEX + N] = __builtin_amdgcn_exp2f(P1[16 - NEX + N]); }
  else {
    constexpr int n = N - NEX, k = n / 4, j = n % 4, b = (k & 1) * 8 + 2 * j;
    f32x16& P = (k < 2) ? P0 : P1;
    pw[k][j] = cvt_pk_bf16(P[b], P[b + 1]);
  }
}
template <int N> __device__ __forceinline__ void v_wait(VF& f) { asm volatile("s_waitcnt lgkmcnt(%2)" : "+v"(f.l), "+v"(f.h) : "n"(N)); }
template <int G> __device__ __forceinline__ void v_issue(VF& f, int vb) { f.l = tr_read<v_rd_off(G & 3, G >> 2, 0)>(vb); f.h = tr_read<v_rd_off(G & 3, G >> 2, 1)>(vb); }

template <int DQK, int MAPS>
__device__ __forceinline__ void attn_core_pl(const Src in, const float C, const float thr, const int seq, LAS char* lds, f32x16 (&o)[4], float* probe = nullptr) {
  static_assert(DQK == 64 && MAPS == 2, "differential-attention configuration only");
  constexpr int SHM_K = 16384, NKS = DQK / 16, NG1 = 2 * NKS, NEXS = 32, NEXF = 0, VLA = 3;
  using SS = StartSched<NEXS>; using FS = FinSched<NEXF>;
  int lane; asm volatile("v_and_b32 %0, 63, %1" : "=v"(lane) : "v"(threadIdx.x));
  const int tid = threadIdx.x, wid = __builtin_amdgcn_readfirstlane(tid >> 6), r32 = lane & 31, hi = (lane >> 5) & 1, wq = wid & 3, mp = wid >> 2;
  LAS char* V_lds = lds; LAS char* K_lds = lds + 3 * SHM_V;
  LAS float* ws = (LAS float*)(lds + 3 * SHM_V + 3 * SHM_K) + wid * 64; LAS float* li_l = ws; LAS float* al_l = ws + 32;
  SMS st; st.dm = 0.f; st.keep = true;
  f32x16 negm = f32x16{};
#pragma unroll
  for (int d = 0; d < 4; ++d) o[d] = f32x16{};
  f32x16 osum = f32x16{};
  const bf16x8 ones = {16256, 16256, 16256, 16256, 16256, 16256, 16256, 16256};
  bf16x8 qr[NKS];
  const bf16_t* Qw = in.Q + (size_t)(wq * QBLK + r32) * in.ldq + mp * 64 + hi * 8;
#pragma unroll
  for (int d0 = 0; d0 < NKS; ++d0) qr[d0] = *(const bf16x8*)(Qw + d0 * 16);
  const int krow = wid * 8 + (lane >> 3), kslot = (lane & 7) ^ ((krow >> 1) & 7);
  const unsigned koff = (unsigned)(krow * in.ldk + kslot * 8) * 2u;
  unsigned voff[2];
#pragma unroll
  for (int i = 0; i < 2; ++i) { const int p = i * 8192 + wid * 1024 + lane * 16, s_ = p >> 9, wq_ = (p & 511) >> 1, kk = (s_ >> 2) * 8 + (wq_ >> 5), cl = wq_ & 31;
    voff[i] = (unsigned)(kk * in.ldv + (s_ & 3) * 32 + cl) * 2u; }
  const int vb0 = (int)(unsigned)(size_t)V_lds + v_rd_base(lane);
  const unsigned ldsw = (unsigned)wid * 1024u;
  const LAS char* Kw = K_lds + mp * 8192;
#define GLDS(gp, lp) __builtin_amdgcn_global_load_lds((const unsigned*)(gp), (LAS unsigned*)(lp), 16, 0, 0)
#define ISSUE_K(t, b) do { const char* kb_ = (const char*)in.K + (size_t)(t) * (KVBLK * 2) * in.ldk; \
    _Pragma("unroll") for (int rep_ = 0; rep_ < 1 + PROBE_DMA2; ++rep_) { GLDS(kb_ + koff, K_lds + (b) * SHM_K + ldsw); GLDS(kb_ + 128 + koff, K_lds + (b) * SHM_K + 8192 + ldsw); } } while (0)
#define ISSUE_V(t, b) do { const char* vb_ = (const char*)in.V + (size_t)(t) * (KVBLK * 2) * in.ldv; \
    _Pragma("unroll") for (int rep_ = 0; rep_ < 1 + PROBE_DMA2; ++rep_) { GLDS(vb_ + voff[0], V_lds + (b) * SHM_V + ldsw); GLDS(vb_ + voff[1], V_lds + (b) * SHM_V + 8192 + ldsw); } } while (0)
#define DMA_PIECE(i) do { DMA_PIECE1(i); if (PROBE_DMA2) DMA_PIECE1(i); } while (0)
#define DMA_PIECE1(i) do { if ((i) < 2) { const char* kb_ = (const char*)in.K + (size_t)tk_ * (KVBLK * 2) * in.ldk; GLDS(kb_ + (i) * 128 + koff, K_lds + bq * SHM_K + (i) * 8192 + ldsw); } \
    else { const char* vb_ = (const char*)in.V + (size_t)tv_ * (KVBLK * 2) * in.ldv; GLDS(vb_ + voff[(i) & 1], V_lds + b2 * SHM_V + ((i) & 1) * 8192 + ldsw); } } while (0)
#define WAITV(n) asm volatile("s_waitcnt vmcnt(%0)" :: "n"(n) : "memory")
#define WBAR() do { asm volatile("" ::: "memory"); __builtin_amdgcn_s_barrier(); asm volatile("" ::: "memory"); } while (0)
#define RESC() do { if (!st.keep) { int l2_; asm volatile("v_and_b32 %0, 63, %1" : "=v"(l2_) : "v"(threadIdx.x)); const int h2_ = l2_ >> 5; LAS float* al2_ = (LAS float*)(lds + 3 * SHM_V + 3 * SHM_K) + wid * 64 + 32; \
    if (h2_ == 0) al2_[l2_] = __builtin_amdgcn_exp2f(st.dm); asm volatile("s_waitcnt lgkmcnt(0)" ::: "memory"); \
    _Pragma("unroll") for (int r = 0; r < 16; ++r) { const float a_ = al2_[crow(r, h2_)]; osum[r] *= a_; _Pragma("unroll") for (int d = 0; d < 4; ++d) o[d][r] *= a_; } asm volatile("s_waitcnt lgkmcnt(0)" ::: "memory"); } } while (0)
#define NXT3(x) ((x) == 2 ? 0 : (x) + 1)
#define KFRAG(Ks, d, blk) (*(const LAS bf16x8*)((Ks) + KSW((blk) * 32 + r32, ((d) * 16 + hi * 8) * 2)))
#define PA(ks) (*reinterpret_cast<const bf16x8*>(&pw[ks]))
#define PKV(f) (bf16x8){f.l[0], f.l[1], f.l[2], f.l[3], f.h[0], f.h[1], f.h[2], f.h[3]}
#define PHASE1(PN0, PN1, PF0, PF1, Ks, vb) do { \
    bf16x8 kf[NKS][2]; kf[0][0] = KFRAG(Ks, 0, 0); kf[0][1] = KFRAG(Ks, 0, 1); \
    sfor<0, NG1>([&](auto gc) __attribute__((always_inline)) { constexpr int g = decltype(gc)::value, d = g >> 1, blk = g & 1; \
      if constexpr (blk == 0 && d + 1 < NKS) { kf[d + 1][0] = KFRAG(Ks, d + 1, 0); kf[d + 1][1] = KFRAG(Ks, d + 1, 1); } \
      if constexpr (blk == 0) { if constexpr (d == 0) mfma_c(PN0, kf[d][0], qr[d], negm); else PN0 = __builtin_amdgcn_mfma_f32_32x32x16_bf16(kf[d][0], qr[d], PN0, 0, 0, 0); } \
      else              { if constexpr (d == 0) mfma_c(PN1, kf[d][1], qr[d], negm); else PN1 = __builtin_amdgcn_mfma_f32_32x32x16_bf16(kf[d][1], qr[d], PN1, 0, 0, 0); } \
      if constexpr (DMA_SPREAD == 1 && g < 4) DMA_PIECE(g); \
      if constexpr (g >= NG1 - VLA) v_issue<g - (NG1 - VLA)>(vf[g - (NG1 - VLA)], vb); \
      sfor<FS::first(g, NG1), FS::first(g + 1, NG1)>([&](auto ic) __attribute__((always_inline)) { fin_item<decltype(ic)::value, NEXF>(PF0, PF1, st, pw); }); \
      SBAR(); }); } while (0)
#define PHASE2(PS0, PS1, vb) do { \
    sfor<0, 20>([&](auto gc) __attribute__((always_inline)) { constexpr int gg = decltype(gc)::value, ks = gg / 5, d = gg % 5, g = ks * 4 + d; \
      if constexpr (d < 4) { \
        v_wait<2 * (15 - g < VLA - 1 ? 15 - g : VLA - 1)>(vf[g]); \
        o[d] = __builtin_amdgcn_mfma_f32_32x32x16_bf16(PA(ks), PKV(vf[g]), o[d], 0, 0, 0); \
        if constexpr (g + VLA < 16) v_issue<g + VLA>(vf[g + VLA], vb); \
      } else { osum = __builtin_amdgcn_mfma_f32_32x32x16_bf16(PA(ks), ones, osum, 0, 0, 0); if constexpr (DMA_SPREAD == 2) DMA_PIECE(ks); } \
      sfor<SS::first(gg, 20), SS::first(gg + 1, 20)>([&](auto ic) __attribute__((always_inline)) { start_item<decltype(ic)::value, NEXS>(PS0, PS1, st, negm, thr, hi == 0 ? 1.f : 0.f); }); \
      SBAR(); }); \
    asm volatile("" : "+v"(PS0), "+v"(PS1)); \
    RESC(); } while (0)
  f32x16 pA0, pA1, pB0, pB1; u32x4 pw[4]; VF vf[16]; const int NT = seq / KVBLK;
  ISSUE_K(0, 0); ISSUE_K(1, 1); ISSUE_V(0, 0);
  WAITV(PROBE_DMA2 ? 8 : 4); WBAR();
  ISSUE_K(2, 2); ISSUE_V(1, 1);
  { bf16x8 kf[NKS][2];
#pragma unroll
    for (int d = 0; d < NKS; ++d) { kf[d][0] = KFRAG(Kw, d, 0); kf[d][1] = KFRAG(Kw, d, 1); }
    pA0 = f32x16{}; pA1 = f32x16{};
#pragma unroll
    for (int d = 0; d < NKS; ++d) { pA0 = __builtin_amdgcn_mfma_f32_32x32x16_bf16(kf[d][0], qr[d], pA0, 0, 0, 0); pA1 = __builtin_amdgcn_mfma_f32_32x32x16_bf16(kf[d][1], qr[d], pA1, 0, 0, 0); } }
  sfor<0, 16>([&](auto ic) __attribute__((always_inline)) { start_item<decltype(ic)::value, NEXS>(pA0, pA1, st, negm, thr, hi == 0 ? 1.f : 0.f); });
  { float pmax;
    { auto rr = __builtin_amdgcn_permlane32_swap(__float_as_uint(st.a0), __float_as_uint(st.a0), false, false); pmax = fmaxf(__uint_as_float(rr[0]), __uint_as_float(rr[1])); }
#pragma unroll
    for (int r = 0; r < 16; ++r) { pA0[r] -= pmax; pA1[r] -= pmax; negm[r] = -pmax; } }
  sfor<17, SS::NITEMS>([&](auto ic) __attribute__((always_inline)) { start_item<decltype(ic)::value, NEXS>(pA0, pA1, st, negm, thr, hi == 0 ? 1.f : 0.f); });
  int bq = 0;
#define ITER(j, PN0, PN1, PF0, PF1) do { const int b1 = NXT3(bq), b2 = NXT3(b1); \
    STAMP_A(); WAITV(PROBE_DMA2 ? 8 : 4); WBAR(); STAMP_B(); \
    const int tk_ = (j) + 3 < NT ? (j) + 3 : NT - 1, tv_ = (j) + 2 < NT ? (j) + 2 : NT - 1; if (DMA_SPREAD == 0) { ISSUE_K(tk_, bq); ISSUE_V(tv_, b2); } \
    PHASE1(PN0, PN1, PF0, PF1, Kw + b1 * SHM_K, vb0 + bq * SHM_V); STAMP_C(); \
    PHASE2(PN0, PN1, vb0 + bq * SHM_V); \
    bq = b1; } while (0)
#if PROBE_T
  unsigned long long tA = 0, tB = 0, accAB = 0, accBC = 0; const unsigned long long t0 = __builtin_amdgcn_s_memtime(), r0 = __builtin_amdgcn_s_memrealtime();
#define STAMP_A() do { if (PROBE_T >= 2) tA = __builtin_amdgcn_s_memtime(); } while (0)
#define STAMP_B() do { if (PROBE_T >= 2) { tB = __builtin_amdgcn_s_memtime(); accAB += tB - tA; } } while (0)
#define STAMP_C() do { if (PROBE_T == 3) { accBC += __builtin_amdgcn_s_memtime() - tB; } } while (0)
#else
#define STAMP_A()
#define STAMP_B()
#define STAMP_C()
#endif
  for (int j = 0; j + 2 < NT; j += 2) { ITER(j, pB0, pB1, pA0, pA1); ITER(j + 1, pA0, pA1, pB0, pB1); }
  ITER(NT - 2, pB0, pB1, pA0, pA1);
#if PROBE_T
  { const unsigned long long t1 = __builtin_amdgcn_s_memtime(), r1 = __builtin_amdgcn_s_memrealtime();
    if (probe != nullptr && tid == 0) {
      if (PROBE_T == 1) { probe[0] = (float)(t1 - t0) * (0.5e-6f / (NT - 1)); probe[1] = (float)(t1 - t0) / (float)(r1 - r0); }
      if (PROBE_T == 2) { probe[0] = (float)accAB * (0.5e-6f / (NT - 1)); probe[1] = ((float)(t1 - t0) * (1.f / (NT - 1)) - 1500.f) * 0.05f; }
      if (PROBE_T == 3) { probe[0] = (float)accBC * (0.5e-6f / (NT - 1)); probe[1] = (float)accAB * (0.01f / (NT - 1)); } } }
#endif
#undef STAMP_A
#undef STAMP_B
#undef STAMP_C
  sfor<0, FS::NITEMS>([&](auto ic) __attribute__((always_inline)) { fin_item<decltype(ic)::value, NEXF>(pB0, pB1, st, pw); });
  WAITV(0); WBAR();
  { const int vb = vb0 + bq * SHM_V;
    sfor<0, VLA>([&](auto gc) __attribute__((always_inline)) { v_issue<decltype(gc)::value>(vf[decltype(gc)::value], vb); });
    sfor<0, 16>([&](auto gc) __attribute__((always_inline)) { constexpr int g = decltype(gc)::value, ks = g >> 2, d = g & 3;
      v_wait<2 * (15 - g < VLA - 1 ? 15 - g : VLA - 1)>(vf[g]);
      o[d] = __builtin_amdgcn_mfma_f32_32x32x16_bf16(PA(ks), PKV(vf[g]), o[d], 0, 0, 0);
      if constexpr (g + VLA < 16) v_issue<g + VLA>(vf[g + VLA], vb);
      if constexpr (d == 3) osum = __builtin_amdgcn_mfma_f32_32x32x16_bf16(PA(ks), ones, osum, 0, 0, 0);
      SBAR(); }); }
#pragma unroll
  for (int r = 0; r < 16; ++r) { const float rl = __builtin_amdgcn_rcpf(osum[r]);
#pragma unroll
    for (int d = 0; d < 4; ++d) o[d][r] *= rl; }
  asm volatile("s_waitcnt lgkmcnt(0)" ::: "memory"); WBAR();
#undef GLDS
#undef ISSUE_K
#undef ISSUE_V
#undef WAITV
#undef WBAR
#undef RESC
#undef NXT3
#undef KFRAG
#undef PKV
#undef PA
#undef PHASE1
#undef DMA_PIECE
#undef DMA_PIECE1
#undef PHASE2
#undef ITER
}
struct BStart { static constexpr int NITEMS = 25;
  static constexpr int weight(int n) { return n < 8 ? 1 : n == 8 ? 3 : 2; }
  static constexpr int first(int g, int ng) { int W = 0; for (int i = 0; i < NITEMS; ++i) W += weight(i); int cum = 0; for (int i = 0; i < NITEMS; ++i) { if (cum * ng >= g * W) return i; cum += weight(i); } return NITEMS; } };
template <int N> __device__ __forceinline__ void bstart_item(f32x16& P, SMS& st, f32x16& negm, const float thr, const float hi_is0) {
  if constexpr (N == 0) st.a0 = fmaxf(fmaxf(P[0], P[1]), P[2]);
  else if constexpr (N == 1) st.a1 = fmaxf(fmaxf(P[3], P[4]), P[5]);
  else if constexpr (N < 7) { if constexpr (N & 1) st.a1 = fmaxf(fmaxf(st.a1, P[2 * N + 2]), P[2 * N + 3]); else st.a0 = fmaxf(fmaxf(st.a0, P[2 * N + 2]), P[2 * N + 3]); }
  else if constexpr (N == 7) st.a0 = fmaxf(st.a0, st.a1);
  else if constexpr (N == 8) {
    float pmax;
    { auto rr = __builtin_amdgcn_permlane32_swap(__float_as_uint(st.a0), __float_as_uint(st.a0), false, false); pmax = fmaxf(__uint_as_float(rr[0]), __uint_as_float(rr[1])); }
    st.keep = __all(pmax <= thr);
    if (__builtin_expect(!st.keep, 0)) {
      const float delta = fmaxf(pmax, 0.f); st.dm = -delta;
#pragma unroll
      for (int r = 0; r < 16; ++r) P[r] -= delta;
      negm_bcast(negm, hi_is0, negm[0] - delta);
    }
  } else { constexpr int I = N - 9; P[I] = __builtin_amdgcn_exp2f(P[I]); }
}
template <int N> __device__ __forceinline__ void bfin_item(f32x16& P, u32x4 (&pw)[2]) { constexpr int k = N / 4, j = N % 4; pw[k][j] = cvt_pk_bf16(P[8 * k + 2 * j], P[8 * k + 2 * j + 1]); }
constexpr int bfin_first(int g, int ng) { return g * 8 / ng; }

template <int OFF> __device__ __forceinline__ void k_read(bf16x8& r, int addr) { asm volatile("ds_read_b128 %0, %1 offset:%2" : "=&v"(r) : "v"(addr), "i"(OFF) : "memory"); }
template <int N> __device__ __forceinline__ void k_wait(bf16x8& f) { asm volatile("s_waitcnt lgkmcnt(%1)" : "+v"(f) : "n"(N)); }
constexpr int kwait_n(int g, int nks, int kla, int vla) {
  int kk = kla - 1 < nks - 1 - g ? kla - 1 : nks - 1 - g; if (kk < 0) kk = 0;
  int lo = nks - vla > g - kla ? nks - vla : g - kla; int vv = g - lo; if (vv < 0) vv = 0;
  return kk + 2 * vv; }
template <int DQK, int MAPS>
__device__ __forceinline__ void attn_core_bp(const Src in, const float thr, const int seq, LAS char* lds, f32x16 (&o)[4], float* probe = nullptr) {
  constexpr int NSUB = MAPS == 2 ? 2 : DQK / 64, SHM_K = NSUB * 8192, NKS = DQK / 16, NI = NSUB + 2, VLA = BP_VLA, KLA = BP_KLA;
  int lane; asm volatile("v_and_b32 %0, 63, %1" : "=v"(lane) : "v"(threadIdx.x));
  const int tid = threadIdx.x, wid = __builtin_amdgcn_readfirstlane(tid >> 6), r32 = lane & 31, hi = (lane >> 5) & 1, wq = MAPS == 2 ? (wid & 3) : wid, mp = MAPS == 2 ? (wid >> 2) : 0;
  LAS char* V_lds = lds; LAS char* K_lds = lds + 4 * SHM_V;
  SMS st; st.dm = 0.f; st.keep = true;
  f32x16 negm = f32x16{}, osum = f32x16{};
#pragma unroll
  for (int d = 0; d < 4; ++d) o[d] = f32x16{};
  const bf16x8 ones = {16256, 16256, 16256, 16256, 16256, 16256, 16256, 16256};
  bf16x8 qr[NKS];
  { const bf16_t* Qw = in.Q + (size_t)(wq * QBLK + r32) * in.ldq + mp * 64 + hi * 8;
#pragma unroll
    for (int d0 = 0; d0 < NKS; ++d0) qr[d0] = *(const bf16x8*)(Qw + d0 * 16); }
  const int krow = wid * 8 + (lane >> 3), kslot = (lane & 7) ^ ((krow >> 1) & 7);
  const unsigned koff = (unsigned)(krow * in.ldk + kslot * 8) * 2u, k2off = (unsigned)(krow * in.ldk2 + kslot * 8) * 2u;
  unsigned voff[2];
#pragma unroll
  for (int i = 0; i < 2; ++i) { const int p = i * 8192 + wid * 1024 + lane * 16, s_ = p >> 9, wq_ = (p & 511) >> 1, kk = (s_ >> 2) * 8 + (wq_ >> 5), cl = wq_ & 31;
    voff[i] = (unsigned)(kk * in.ldv + (s_ & 3) * 32 + cl) * 2u; }
  const int vb0 = (int)(unsigned)(size_t)V_lds + v_rd_base(lane);
  const unsigned ldsw = (unsigned)wid * 1024u;
  const LAS char* Kw = K_lds + mp * 8192;
  int kxo[4];
#pragma unroll
  for (int i = 0; i < 4; ++i) kxo[i] = r32 * 128 + ((i * 32 + hi * 16) ^ (((r32 >> 1) & 7) << 4));
#define GLDS(gp, lp) __builtin_amdgcn_global_load_lds((const unsigned*)(gp), (LAS unsigned*)(lp), 16, 0, 0)
#define PIECE(i, tk, bk, tv, bv) do { \
    if ((i) < NSUB) { if (MAPS == 2 || (i) < 2) GLDS((const char*)in.K + (size_t)(tk) * (KVBLK * 2) * in.ldk + (i) * 128 + koff, K_lds + (bk) * SHM_K + (i) * 8192 + ldsw); \
                      else GLDS((const char*)in.K2 + (size_t)(tk) * (KVBLK * 2) * in.ldk2 + k2off, K_lds + (bk) * SHM_K + (i) * 8192 + ldsw); } \
    else GLDS((const char*)in.V + (size_t)(tv) * (KVBLK * 2) * in.ldv + voff[((i) - NSUB) & 1], V_lds + (bv) * SHM_V + (((i) - NSUB) & 1) * 8192 + ldsw); } while (0)
#define WAITV(n) asm volatile("s_waitcnt vmcnt(%0)" :: "n"(n) : "memory")
#define WBAR() do { asm volatile("" ::: "memory"); __builtin_amdgcn_s_barrier(); asm volatile("" ::: "memory"); } while (0)
#define RESC() do { if (!st.keep) { int l2_; asm volatile("v_and_b32 %0, 63, %1" : "=v"(l2_) : "v"(threadIdx.x)); const int h2_ = l2_ >> 5; LAS float* al2_ = (LAS float*)(lds + MISC_OFF + 128) + wid * 32; \
    if (h2_ == 0) al2_[l2_] = __builtin_amdgcn_exp2f(st.dm); asm volatile("s_waitcnt lgkmcnt(0)" ::: "memory"); \
    _Pragma("unroll") for (int r = 0; r < 16; ++r) { const float a_ = al2_[crow(r, h2_)]; osum[r] *= a_; _Pragma("unroll") for (int d = 0; d < 4; ++d) o[d][r] *= a_; } asm volatile("s_waitcnt lgkmcnt(0)" ::: "memory"); } } while (0)
#define NXT3(x) ((x) == 2 ? 0 : (x) + 1)
#define KFRAG(Ks, d, blk) (*(const LAS bf16x8*)((Ks) + ((d) >> 2) * 8192 + KSW((blk) * 32 + r32, (((d) & 3) * 16 + hi * 8) * 2)))
#define PA(k) (*reinterpret_cast<const bf16x8*>(&pw[k]))
#define PKV(f) (bf16x8){f.l[0], f.l[1], f.l[2], f.l[3], f.h[0], f.h[1], f.h[2], f.h[3]}
#define BITER(BPAR, PN, PF, Kq, vb, DO_DMA) do { \
    { bf16x8 kf[NKS]; int ka_[4]; { const int kb_ = (int)(unsigned)(size_t)(Kq); _Pragma("unroll") for (int i_ = 0; i_ < 4; ++i_) ka_[i_] = kb_ + kxo[i_]; } \
      sfor<0, KLA>([&](auto dc) __attribute__((always_inline)) { constexpr int d_ = decltype(dc)::value; k_read<(d_ >> 2) * 8192 + (1 - (BPAR)) * 4096>(kf[d_], ka_[d_ & 3]); }); \
      sfor<0, NKS>([&](auto gc) __attribute__((always_inline)) { constexpr int g = decltype(gc)::value; \
        k_wait<kwait_n(g, NKS, KLA, VLA)>(kf[g]); \
        if constexpr (g + KLA < NKS) k_read<((g + KLA) >> 2) * 8192 + (1 - (BPAR)) * 4096>(kf[g + KLA], ka_[(g + KLA) & 3]); \
        if constexpr (g == 0) mfma_c(PN, kf[g], qr[g], negm); else PN = __builtin_amdgcn_mfma_f32_32x32x16_bf16(kf[g], qr[g], PN, 0, 0, 0); \
        if constexpr ((DO_DMA) && g < NI) PIECE(g, tk_, bk_, tv_, bv_); \
        if constexpr (g >= NKS - VLA) v_issue<8 * (BPAR) + g - (NKS - VLA)>(vf[g - (NKS - VLA)], vb); \
        sfor<bfin_first(g, NKS), bfin_first(g + 1, NKS)>([&](auto ic) __attribute__((always_inline)) { bfin_item<decltype(ic)::value>(PF, pw); }); \
        SBAR(); }); } \
    sfor<0, 10>([&](auto gc) __attribute__((always_inline)) { constexpr int gg = decltype(gc)::value, ksl = gg / 5, d = gg % 5, g = ksl * 4 + d; \
      if constexpr (d < 4) { \
        v_wait<2 * (7 - g < VLA - 1 ? 7 - g : VLA - 1)>(vf[g]); \
        o[d] = __builtin_amdgcn_mfma_f32_32x32x16_bf16(PA(ksl), PKV(vf[g]), o[d], 0, 0, 0); \
        if constexpr (g + VLA < 8) v_issue<8 * (BPAR) + g + VLA>(vf[g + VLA], vb); \
      } else osum = __builtin_amdgcn_mfma_f32_32x32x16_bf16(PA(ksl), ones, osum, 0, 0, 0); \
      if constexpr (gg > 0) sfor<BStart::first(gg - 1, 9), BStart::first(gg, 9)>([&](auto ic) __attribute__((always_inline)) { bstart_item<decltype(ic)::value>(PN, st, negm, thr, hi == 0 ? 1.f : 0.f); });     \
      SBAR(); }); \
    asm volatile("" : "+v"(PN)); \
    RESC(); } while (0)
  f32x16 pA, pB; u32x4 pw[2]; VF vf[8]; const int NT = seq / KVBLK;
#pragma unroll
  for (int t = 0; t < 3; ++t) {
#pragma unroll
    for (int i = 0; i < NI; ++i) PIECE(i, t, t, t, t); }
  WAITV(2 * NI); WBAR();
  { bf16x8 kf[NKS];
#pragma unroll
    for (int d = 0; d < NKS; ++d) kf[d] = KFRAG(Kw, d, 0);
    pA = f32x16{};
#pragma unroll
    for (int d = 0; d < NKS; ++d) pA = __builtin_amdgcn_mfma_f32_32x32x16_bf16(kf[d], qr[d], pA, 0, 0, 0); }
  sfor<0, 8>([&](auto ic) __attribute__((always_inline)) { bstart_item<decltype(ic)::value>(pA, st, negm, thr, hi == 0 ? 1.f : 0.f); });
  { float pmax;
    { auto rr = __builtin_amdgcn_permlane32_swap(__float_as_uint(st.a0), __float_as_uint(st.a0), false, false); pmax = fmaxf(__uint_as_float(rr[0]), __uint_as_float(rr[1])); }
#pragma unroll
    for (int r = 0; r < 16; ++r) { pA[r] -= pmax; negm[r] = -pmax; } }
  sfor<9, BStart::NITEMS>([&](auto ic) __attribute__((always_inline)) { bstart_item<decltype(ic)::value>(pA, st, negm, thr, hi == 0 ? 1.f : 0.f); });
  int kq = 0;
#if PROBE_T == 5
  const unsigned long long t0 = __builtin_amdgcn_s_memtime();
#endif
  for (int t = 0; t + 1 < NT; ++t) {
    const int k1 = NXT3(kq), vq = t & 3;
    const int tk_ = t + 3 < NT ? t + 3 : NT - 1, tv_ = tk_, bk_ = kq, bv_ = (t + 3) & 3;
    BITER(0, pB, pA, Kw + kq * SHM_K, vb0 + vq * SHM_V, false);
    WAITV(NI); WBAR();
    BITER(1, pA, pB, Kw + k1 * SHM_K, vb0 + vq * SHM_V, true);
    kq = k1;
  }
#if PROBE_T == 5
  { const unsigned long long t1 = __builtin_amdgcn_s_memtime(); if (probe != nullptr && tid == 0) { probe[0] = 0.f; probe[1] = ((float)(t1 - t0) * (1.f / (NT - 1)) - PROBE_BASE) * 0.05f; } }
#endif
  { const int vq = (NT - 1) & 3; const int tk_ = 0, tv_ = 0, bk_ = 0, bv_ = 0; (void)tk_; (void)tv_; (void)bk_; (void)bv_;
    BITER(0, pB, pA, Kw + kq * SHM_K, vb0 + vq * SHM_V, false);
    sfor<0, 8>([&](auto ic) __attribute__((always_inline)) { bfin_item<decltype(ic)::value>(pB, pw); });
    const int vb = vb0 + vq * SHM_V;
    sfor<0, VLA>([&](auto gc) __attribute__((always_inline)) { v_issue<8 + decltype(gc)::value>(vf[decltype(gc)::value], vb); });
    sfor<0, 8>([&](auto gc) __attribute__((always_inline)) { constexpr int g = decltype(gc)::value, ksl = g >> 2, d = g & 3;
      v_wait<2 * (7 - g < VLA - 1 ? 7 - g : VLA - 1)>(vf[g]);
      o[d] = __builtin_amdgcn_mfma_f32_32x32x16_bf16(PA(ksl), PKV(vf[g]), o[d], 0, 0, 0);
      if constexpr (g + VLA < 8) v_issue<8 + g + VLA>(vf[g + VLA], vb);
      if constexpr (d == 3) osum = __builtin_amdgcn_mfma_f32_32x32x16_bf16(PA(ksl), ones, osum, 0, 0, 0);
      SBAR(); }); }
#pragma unroll
  for (int r = 0; r < 16; ++r) { const float rl = __builtin_amdgcn_rcpf(osum[r]);
#pragma unroll
    for (int d = 0; d < 4; ++d) o[d][r] *= rl; }
  WAITV(0); asm volatile("s_waitcnt lgkmcnt(0)" ::: "memory"); WBAR();
#undef GLDS
#undef PIECE
#undef WAITV
#undef WBAR
#undef RESC
#undef NXT3
#undef KFRAG
#undef PA
#undef PKV
#undef BITER
}
struct Src8 { const unsigned char* q8; const unsigned char* k8n; const unsigned char* k8r; const bf16_t* V; int ldv; };
typedef int v8i_att __attribute__((ext_vector_type(8))); typedef int v4i_att __attribute__((ext_vector_type(4)));
__device__ __forceinline__ void attn_core_bp8(const Src8 in, const float thr, const int seq, LAS char* lds, f32x16 (&o)[4], float* probe = nullptr) {
  constexpr int SHM_K = 3 * 4096, NKS = 3, NI = 4, VLA = 3;
  int lane; asm volatile("v_and_b32 %0, 63, %1" : "=v"(lane) : "v"(threadIdx.x));
  const int tid = threadIdx.x, wid = __builtin_amdgcn_readfirstlane(tid >> 6), r32 = lane & 31, hi = (lane >> 5) & 1;
  LAS char* V_lds = lds; LAS char* K_lds = lds + 4 * SHM_V;
  SMS st; st.dm = 0.f; st.keep = true;
  f32x16 negm = f32x16{}, osum = f32x16{};
#pragma unroll
  for (int d = 0; d < 4; ++d) o[d] = f32x16{};
  const bf16x8 ones = {16256, 16256, 16256, 16256, 16256, 16256, 16256, 16256};
  v8i_att qf[NKS];
  { const unsigned char* Qw = in.q8 + (size_t)(wid * QBLK + r32) * 1536 + hi * 32;
#pragma unroll
    for (int s = 0; s < NKS; ++s) { const v4i_att lo = *(const v4i_att*)(Qw + s * 64), hh = *(const v4i_att*)(Qw + s * 64 + 16); qf[s] = __builtin_shufflevector(lo, hh, 0, 1, 2, 3, 4, 5, 6, 7); } }
  unsigned ksrc[2]; int kdst[2]; bool krot[2];
#pragma unroll
  for (int i = 0; i < 2; ++i) { const int p0 = wid * 2 + i, p = p0 < 12 ? p0 : p0 - 4, s = p >> 2, q = p & 3, row = q * 16 + (lane >> 2), lc = (lane & 3) ^ ((lane >> 4) & 3);
    krot[i] = (s == 2); ksrc[i] = krot[i] ? (unsigned)(row * 64 + lc * 16) : (unsigned)(row * 1024 + s * 64 + lc * 16); kdst[i] = s * 4096 + q * 1024 + lane * 16; }
  unsigned voff[2];
#pragma unroll
  for (int i = 0; i < 2; ++i) { const int p = i * 8192 + wid * 1024 + lane * 16, s_ = p >> 9, wq_ = (p & 511) >> 1, kk = (s_ >> 2) * 8 + (wq_ >> 5), cl = wq_ & 31;
    voff[i] = (unsigned)(kk * in.ldv + (s_ & 3) * 32 + cl) * 2u; }
  const int vb0 = (int)(unsigned)(size_t)V_lds + v_rd_base(lane);
  const unsigned ldsw = (unsigned)wid * 1024u;
  int kx[2];
#pragma unroll
  for (int c = 0; c < 2; ++c) kx[c] = r32 * 64 + (((2 * hi + c) ^ ((r32 >> 2) & 3)) << 4);
#define GLDS(gp, lp) __builtin_amdgcn_global_load_lds((const unsigned*)(gp), (LAS unsigned*)(lp), 16, 0, 0)
#define PIECE(i, tk, bk, tv, bv) do { \
    if ((i) < 2) { if (krot[(i) & 1]) GLDS(in.k8r + (size_t)(tk) * (KVBLK * 64) + ksrc[(i) & 1], K_lds + (bk) * SHM_K + kdst[(i) & 1]); \
                   else GLDS(in.k8n + (size_t)(tk) * (KVBLK * 1024) + ksrc[(i) & 1], K_lds + (bk) * SHM_K + kdst[(i) & 1]); } \
    else GLDS((const char*)in.V + (size_t)(tv) * (KVBLK * 2) * in.ldv + voff[(i) & 1], V_lds + (bv) * SHM_V + ((i) & 1) * 8192 + ldsw); } while (0)
#define WAITV(n) asm volatile("s_waitcnt vmcnt(%0)" :: "n"(n) : "memory")
#define WBAR() do { asm volatile("" ::: "memory"); __builtin_amdgcn_s_barrier(); asm volatile("" ::: "memory"); } while (0)
#define RESC() do { if (!st.keep) { int l2_; asm volatile("v_and_b32 %0, 63, %1" : "=v"(l2_) : "v"(threadIdx.x)); const int h2_ = l2_ >> 5; LAS float* al2_ = (LAS float*)(lds + MISC_OFF + 128) + wid * 32; \
    if (h2_ == 0) al2_[l2_] = __builtin_amdgcn_exp2f(st.dm); asm volatile("s_waitcnt lgkmcnt(0)" ::: "memory"); \
    _Pragma("unroll") for (int r = 0; r < 16; ++r) { const float a_ = al2_[crow(r, h2_)]; osum[r] *= a_; _Pragma("unroll") for (int d = 0; d < 4; ++d) o[d][r] *= a_; } asm volatile("s_waitcnt lgkmcnt(0)" ::: "memory"); } } while (0)
#define NXT3(x) ((x) == 2 ? 0 : (x) + 1)
#define PA(k) (*reinterpret_cast<const bf16x8*>(&pw[k]))
#define PKV(f) (bf16x8){f.l[0], f.l[1], f.l[2], f.l[3], f.h[0], f.h[1], f.h[2], f.h[3]}
#define KCAT(lo_, hi_) __builtin_shufflevector(__builtin_bit_cast(v4i_att, lo_), __builtin_bit_cast(v4i_att, hi_), 0, 1, 2, 3, 4, 5, 6, 7)
#define QK8(C_, s_) __builtin_amdgcn_mfma_scale_f32_32x32x64_f8f6f4(KCAT(kl[s_], kh[s_]), qf[s_], C_, 0, 0, 0, 0x7f7f7f7f, 0, 0x7c7c7c7c)
#define BITER(BPAR, PN, PF, Kq, vb, DO_DMA) do { \
    { bf16x8 kl[NKS], kh[NKS]; const int kb0_ = (int)(unsigned)(size_t)(Kq) + kx[0], kb1_ = (int)(unsigned)(size_t)(Kq) + kx[1]; \
      sfor<0, NKS>([&](auto dc) __attribute__((always_inline)) { constexpr int s_ = decltype(dc)::value; k_read<s_ * 4096 + (1 - (BPAR)) * 2048>(kl[s_], kb0_); k_read<s_ * 4096 + (1 - (BPAR)) * 2048>(kh[s_], kb1_); }); \
      sfor<0, NKS>([&](auto gc) __attribute__((always_inline)) { constexpr int g = decltype(gc)::value; \
        asm volatile("s_waitcnt lgkmcnt(4)" : "+v"(kl[g]), "+v"(kh[g])); \
        if constexpr (g == 0) PN = QK8(negm, 0); else PN = QK8(PN, g); \
        if constexpr (DO_DMA) { if constexpr (g == 0) { PIECE(0, tk_, bk_, tv_, bv_); PIECE(1, tk_, bk_, tv_, bv_); } else PIECE(g + 1, tk_, bk_, tv_, bv_); } \
        v_issue<8 * (BPAR) + g>(vf[g], vb); \
        sfor<g * 8 / 3, (g + 1) * 8 / 3>([&](auto ic) __attribute__((always_inline)) { bfin_item<decltype(ic)::value>(PF, pw); }); \
        SBAR(); }); } \
    sfor<0, 10>([&](auto gc) __attribute__((always_inline)) { constexpr int gg = decltype(gc)::value, ksl = gg / 5, d = gg % 5, g = ksl * 4 + d; \
      if constexpr (d < 4) { \
        v_wait<2 * (7 - g < VLA - 1 ? 7 - g : VLA - 1)>(vf[g]); \
        o[d] = __builtin_amdgcn_mfma_f32_32x32x16_bf16(PA(ksl), PKV(vf[g]), o[d], 0, 0, 0); \
        if constexpr (g + VLA < 8) v_issue<8 * (BPAR) + g + VLA>(vf[g + VLA], vb); \
      } else osum = __builtin_amdgcn_mfma_f32_32x32x16_bf16(PA(ksl), ones, osum, 0, 0, 0); \
      if constexpr (gg > 0) sfor<BStart::first(gg - 1, 9), BStart::first(gg, 9)>([&](auto ic) __attribute__((always_inline)) { bstart_item<decltype(ic)::value>(PN, st, negm, thr, hi == 0 ? 1.f : 0.f); }); \
      SBAR(); }); \
    asm volatile("" : "+v"(PN)); \
    RESC(); } while (0)
  f32x16 pA, pB; u32x4 pw[2]; VF vf[8]; const int NT = seq / KVBLK;
#pragma unroll
  for (int t = 0; t < 3; ++t) {
#pragma unroll
    for (int i = 0; i < NI; ++i) PIECE(i, t, t, t, t); }
  WAITV(2 * NI); WBAR();
  { const LAS char* K0 = K_lds; pA = f32x16{};
#pragma unroll
    for (int s = 0; s < NKS; ++s) { const bf16x8 lo = *(const LAS bf16x8*)(K0 + s * 4096 + kx[0]), hh = *(const LAS bf16x8*)(K0 + s * 4096 + kx[1]);
      pA = __builtin_amdgcn_mfma_scale_f32_32x32x64_f8f6f4(KCAT(lo, hh), qf[s], pA, 0, 0, 0, 0x7f7f7f7f, 0, 0x7c7c7c7c); } }
  sfor<0, 8>([&](auto ic) __attribute__((always_inline)) { bstart_item<decltype(ic)::value>(pA, st, negm, thr, hi == 0 ? 1.f : 0.f); });
  { float pmax;
    { auto rr = __builtin_amdgcn_permlane32_swap(__float_as_uint(st.a0), __float_as_uint(st.a0), false, false); pmax = fmaxf(__uint_as_float(rr[0]), __uint_as_float(rr[1])); }
#pragma unroll
    for (int r = 0; r < 16; ++r) { pA[r] -= pmax; negm[r] = -pmax; } }
  sfor<9, BStart::NITEMS>([&](auto ic) __attribute__((always_inline)) { bstart_item<decltype(ic)::value>(pA, st, negm, thr, hi == 0 ? 1.f : 0.f); });
  int kq = 0;
#if PROBE_T == 5
  const unsigned long long t0 = __builtin_amdgcn_s_memtime();
#endif
  for (int t = 0; t + 1 < NT; ++t) {
    const int k1 = NXT3(kq), vq = t & 3;
    const int tk_ = t + 3 < NT ? t + 3 : NT - 1, tv_ = tk_, bk_ = kq, bv_ = (t + 3) & 3;
    BITER(0, pB, pA, K_lds + kq * SHM_K, vb0 + vq * SHM_V, false);
    WAITV(NI); WBAR();
    BITER(1, pA, pB, K_lds + k1 * SHM_K, vb0 + vq * SHM_V, true);
    kq = k1;
  }
#if PROBE_T == 5
  { const unsigned long long t1 = __builtin_amdgcn_s_memtime(); if (probe != nullptr && tid == 0) { probe[0] = 0.f; probe[1] = ((float)(t1 - t0) * (1.f / (NT - 1)) - PROBE_BASE) * 0.05f; } }
#endif
  { const int vq = (NT - 1) & 3; const int tk_ = 0, tv_ = 0, bk_ = 0, bv_ = 0; (void)tk_; (void)tv_; (void)bk_; (void)bv_;
    BITER(0, pB, pA, K_lds + kq * SHM_K, vb0 + vq * SHM_V, false);
    sfor<0, 8>([&](auto ic) __attribute__((always_inline)) { bfin_item<decltype(ic)::value>(pB, pw); });
    const int vb = vb0 + vq * SHM_V;
    sfor<0, VLA>([&](auto gc) __attribute__((always_inline)) { v_issue<8 + decltype(gc)::value>(vf[decltype(gc)::value], vb); });
    sfor<0, 8>([&](auto gc) __attribute__((always_inline)) { constexpr int g = decltype(gc)::value, ksl = g >> 2, d = g & 3;
      v_wait<2 * (7 - g < VLA - 1 ? 7 - g : VLA - 1)>(vf[g]);
      o[d] = __builtin_amdgcn_mfma_f32_32x32x16_bf16(PA(ksl), PKV(vf[g]), o[d], 0, 0, 0);
      if constexpr (g + VLA < 8) v_issue<8 + g + VLA>(vf[g + VLA], vb);
      if constexpr (d == 3) osum = __builtin_amdgcn_mfma_f32_32x32x16_bf16(PA(ksl), ones, osum, 0, 0, 0);
      SBAR(); }); }
#pragma unroll
  for (int r = 0; r < 16; ++r) { const float rl = __builtin_amdgcn_rcpf(osum[r]);
#pragma unroll
    for (int d = 0; d < 4; ++d) o[d][r] *= rl; }
  WAITV(0); asm volatile("s_waitcnt lgkmcnt(0)" ::: "memory"); WBAR();
#undef GLDS
#undef PIECE
#undef WAITV
#undef WBAR
#undef RESC
#undef NXT3
#undef PA
#undef PKV
#undef KCAT
#undef QK8
#undef BITER
}
struct SrcD8 { const unsigned char* q8; const unsigned char* k8; const bf16_t* V; int ldv; };
__device__ __forceinline__ void attn_core_pl8(const SrcD8 in, const float thr, const int seq, LAS char* lds, f32x16 (&o)[4], float* probe = nullptr) {
  constexpr int SHM_K = 8192, NEXS = 32, NEXF = 0, VLA = 3;
  using SS = StartSched<NEXS>; using FS = FinSched<NEXF>;
  int lane; asm volatile("v_and_b32 %0, 63, %1" : "=v"(lane) : "v"(threadIdx.x));
  const int tid = threadIdx.x, wid = __builtin_amdgcn_readfirstlane(tid >> 6), r32 = lane & 31, hi = (lane >> 5) & 1, wq = wid & 3, mp = wid >> 2;
  LAS char* V_lds = lds; LAS char* K_lds = lds + 3 * SHM_V;
  SMS st; st.dm = 0.f; st.keep = true;
  f32x16 negm = f32x16{}, osum = f32x16{};
#pragma unroll
  for (int d = 0; d < 4; ++d) o[d] = f32x16{};
  const bf16x8 ones = {16256, 16256, 16256, 16256, 16256, 16256, 16256, 16256};
  v8i_att qf;
  { const unsigned char* Qw = in.q8 + (size_t)(wq * QBLK + r32) * 1024 + mp * 64 + hi * 32;
    const v4i_att lo = *(const v4i_att*)(Qw), hh = *(const v4i_att*)(Qw + 16); qf = __builtin_shufflevector(lo, hh, 0, 1, 2, 3, 4, 5, 6, 7); }
  const unsigned ksrc = (unsigned)(((wid & 3) * 16 + (lane >> 2)) * 1024 + (wid >> 2) * 64 + (((lane & 3) ^ ((lane >> 4) & 3)) << 4));
  const int kdst = wid * 1024 + lane * 16;
  unsigned voff[2];
#pragma unroll
  for (int i = 0; i < 2; ++i) { const int p = i * 8192 + wid * 1024 + lane * 16, s_ = p >> 9, wq_ = (p & 511) >> 1, kk = (s_ >> 2) * 8 + (wq_ >> 5), cl = wq_ & 31;
    voff[i] = (unsigned)(kk * in.ldv + (s_ & 3) * 32 + cl) * 2u; }
  const int vb0 = (int)(unsigned)(size_t)V_lds + v_rd_base(lane);
  const unsigned ldsw = (unsigned)wid * 1024u;
  const LAS char* Kw = K_lds + mp * 4096;
  int kx[2];
#pragma unroll
  for (int c = 0; c < 2; ++c) kx[c] = r32 * 64 + (((2 * hi + c) ^ ((r32 >> 2) & 3)) << 4);
#define GLDS(gp, lp) __builtin_amdgcn_global_load_lds((const unsigned*)(gp), (LAS unsigned*)(lp), 16, 0, 0)
#define ISSUE_K(t, b) GLDS(in.k8 + (size_t)(t) * (KVBLK * 1024) + ksrc, K_lds + (b) * SHM_K + kdst)
#define ISSUE_V(t, b) do { const char* vb_ = (const char*)in.V + (size_t)(t) * (KVBLK * 2) * in.ldv; GLDS(vb_ + voff[0], V_lds + (b) * SHM_V + ldsw); GLDS(vb_ + voff[1], V_lds + (b) * SHM_V + 8192 + ldsw); } while (0)
#define WAITV(n) asm volatile("s_waitcnt vmcnt(%0)" :: "n"(n) : "memory")
#define WBAR() do { asm volatile("" ::: "memory"); __builtin_amdgcn_s_barrier(); asm volatile("" ::: "memory"); } while (0)
#define RESC() do { if (!st.keep) { int l2_; asm volatile("v_and_b32 %0, 63, %1" : "=v"(l2_) : "v"(threadIdx.x)); const int h2_ = l2_ >> 5; LAS float* al2_ = (LAS float*)(lds + MISC_OFF + 128) + wid * 32; \
    if (h2_ == 0) al2_[l2_] = __builtin_amdgcn_exp2f(st.dm); asm volatile("s_waitcnt lgkmcnt(0)" ::: "memory"); \
    _Pragma("unroll") for (int r = 0; r < 16; ++r) { const float a_ = al2_[crow(r, h2_)]; osum[r] *= a_; _Pragma("unroll") for (int d = 0; d < 4; ++d) o[d][r] *= a_; } asm volatile("s_waitcnt lgkmcnt(0)" ::: "memory"); } } while (0)
#define NXT3(x) ((x) == 2 ? 0 : (x) + 1)
#define PA(ks) (*reinterpret_cast<const bf16x8*>(&pw[ks]))
#define PKV(f) (bf16x8){f.l[0], f.l[1], f.l[2], f.l[3], f.h[0], f.h[1], f.h[2], f.h[3]}
#define KCAT(lo_, hi_) __builtin_shufflevector(__builtin_bit_cast(v4i_att, lo_), __builtin_bit_cast(v4i_att, hi_), 0, 1, 2, 3, 4, 5, 6, 7)
#define PHASE1(PN0, PN1, PF0, PF1, Ks, vb) do { \
    bf16x8 kl0, kh0, kl1, kh1; { const int a0_ = (int)(unsigned)(size_t)(Ks) + kx[0], a1_ = (int)(unsigned)(size_t)(Ks) + kx[1]; \
      k_read<0>(kl0, a0_); k_read<0>(kh0, a1_); k_read<2048>(kl1, a0_); k_read<2048>(kh1, a1_); } \
    asm volatile("s_waitcnt lgkmcnt(2)" : "+v"(kl0), "+v"(kh0)); \
    PN0 = __builtin_amdgcn_mfma_scale_f32_32x32x64_f8f6f4(KCAT(kl0, kh0), qf, negm, 0, 0, 0, 0x7f7f7f7f, 0, 0x7c7c7c7c); \
    ISSUE_K(tk_, bq); GLDS((const char*)in.V + (size_t)tv_ * (KVBLK * 2) * in.ldv + voff[0], V_lds + b2 * SHM_V + ldsw); \
    v_issue<0>(vf[0], vb); \
    sfor<0, 8>([&](auto ic) __attribute__((always_inline)) { fin_item<decltype(ic)::value, NEXF>(PF0, PF1, st, pw); }); \
    SBAR(); \
    asm volatile("s_waitcnt lgkmcnt(2)" : "+v"(kl1), "+v"(kh1)); \
    PN1 = __builtin_amdgcn_mfma_scale_f32_32x32x64_f8f6f4(KCAT(kl1, kh1), qf, negm, 0, 0, 0, 0x7f7f7f7f, 0, 0x7c7c7c7c); \
    GLDS((const char*)in.V + (size_t)tv_ * (KVBLK * 2) * in.ldv + voff[1], V_lds + b2 * SHM_V + 8192 + ldsw); \
    v_issue<1>(vf[1], vb); v_issue<2>(vf[2], vb); \
    sfor<8, 16>([&](auto ic) __attribute__((always_inline)) { fin_item<decltype(ic)::value, NEXF>(PF0, PF1, st, pw); }); \
    SBAR(); } while (0)
#define PHASE2(PS0, PS1, vb) do { \
    sfor<0, 20>([&](auto gc) __attribute__((always_inline)) { constexpr int gg = decltype(gc)::value, ks = gg / 5, d = gg % 5, g = ks * 4 + d; \
      if constexpr (d < 4) { \
        v_wait<2 * (15 - g < VLA - 1 ? 15 - g : VLA - 1)>(vf[g]); \
        o[d] = __builtin_amdgcn_mfma_f32_32x32x16_bf16(PA(ks), PKV(vf[g]), o[d], 0, 0, 0); \
        if constexpr (g + VLA < 16) v_issue<g + VLA>(vf[g + VLA], vb); \
      } else osum = __builtin_amdgcn_mfma_f32_32x32x16_bf16(PA(ks), ones, osum, 0, 0, 0); \
      sfor<SS::first(gg, 20), SS::first(gg + 1, 20)>([&](auto ic) __attribute__((always_inline)) { start_item<decltype(ic)::value, NEXS>(PS0, PS1, st, negm, thr, hi == 0 ? 1.f : 0.f); }); \
      SBAR(); }); \
    asm volatile("" : "+v"(PS0), "+v"(PS1)); \
    RESC(); } while (0)
  f32x16 pA0, pA1, pB0, pB1; u32x4 pw[4]; VF vf[16]; const int NT = seq / KVBLK;
  ISSUE_K(0, 0); ISSUE_K(1, 1); ISSUE_V(0, 0);
  WAITV(3); WBAR();
  ISSUE_K(2, 2); ISSUE_V(1, 1);
  { const bf16x8 l0 = *(const LAS bf16x8*)(Kw + kx[0]), h0 = *(const LAS bf16x8*)(Kw + kx[1]), l1 = *(const LAS bf16x8*)(Kw + 2048 + kx[0]), h1 = *(const LAS bf16x8*)(Kw + 2048 + kx[1]);
    pA0 = __builtin_amdgcn_mfma_scale_f32_32x32x64_f8f6f4(KCAT(l0, h0), qf, f32x16{}, 0, 0, 0, 0x7f7f7f7f, 0, 0x7c7c7c7c);
    pA1 = __builtin_amdgcn_mfma_scale_f32_32x32x64_f8f6f4(KCAT(l1, h1), qf, f32x16{}, 0, 0, 0, 0x7f7f7f7f, 0, 0x7c7c7c7c); }
  sfor<0, 16>([&](auto ic) __attribute__((always_inline)) { start_item<decltype(ic)::value, NEXS>(pA0, pA1, st, negm, thr, hi == 0 ? 1.f : 0.f); });
  { float pmax;
    { auto rr = __builtin_amdgcn_permlane32_swap(__float_as_uint(st.a0), __float_as_uint(st.a0), false, false); pmax = fmaxf(__uint_as_float(rr[0]), __uint_as_float(rr[1])); }
#pragma unroll
    for (int r = 0; r < 16; ++r) { pA0[r] -= pmax; pA1[r] -= pmax; negm[r] = -pmax; } }
  sfor<17, SS::NITEMS>([&](auto ic) __attribute__((always_inline)) { start_item<decltype(ic)::value, NEXS>(pA0, pA1, st, negm, thr, hi == 0 ? 1.f : 0.f); });
  int bq = 0;
#define ITER(j, PN0, PN1, PF0, PF1) do { const int b1 = NXT3(bq), b2 = NXT3(b1); \
    WAITV(3); WBAR(); \
    const int tk_ = (j) + 3 < NT ? (j) + 3 : NT - 1, tv_ = (j) + 2 < NT ? (j) + 2 : NT - 1; \
    PHASE1(PN0, PN1, PF0, PF1, Kw + b1 * SHM_K, vb0 + bq * SHM_V); \
    PHASE2(PN0, PN1, vb0 + bq * SHM_V); \
    bq = b1; } while (0)
#if PROBE_T == 2
  const unsigned long long t0 = __builtin_amdgcn_s_memtime();
#endif
  for (int j = 0; j + 2 < NT; j += 2) { ITER(j, pB0, pB1, pA0, pA1); ITER(j + 1, pA0, pA1, pB0, pB1); }
  ITER(NT - 2, pB0, pB1, pA0, pA1);
#if PROBE_T == 2
  { const unsigned long long t1 = __builtin_amdgcn_s_memtime(); if (probe != nullptr && tid == 0) { probe[0] = 0.f; probe[1] = ((float)(t1 - t0) * (1.f / (NT - 1)) - 1500.f) * 0.05f; } }
#endif
  sfor<0, FS::NITEMS>([&](auto ic) __attribute__((always_inline)) { fin_item<decltype(ic)::value, NEXF>(pB0, pB1, st, pw); });
  WAITV(0); WBAR();
  { const int vb = vb0 + bq * SHM_V;
    sfor<0, VLA>([&](auto gc) __attribute__((always_inline)) { v_issue<decltype(gc)::value>(vf[decltype(gc)::value], vb); });
    sfor<0, 16>([&](auto gc) __attribute__((always_inline)) { constexpr int g = decltype(gc)::value, ks = g >> 2, d = g & 3;
      v_wait<2 * (15 - g < VLA - 1 ? 15 - g : VLA - 1)>(vf[g]);
      o[d] = __builtin_amdgcn_mfma_f32_32x32x16_bf16(PA(ks), PKV(vf[g]), o[d], 0, 0, 0);
      if constexpr (g + VLA < 16) v_issue<g + VLA>(vf[g + VLA], vb);
      if constexpr (d == 3) osum = __builtin_amdgcn_mfma_f32_32x32x16_bf16(PA(ks), ones, osum, 0, 0, 0);
      SBAR(); }); }
#pragma unroll
  for (int r = 0; r < 16; ++r) { const float rl = __builtin_amdgcn_rcpf(osum[r]);
#pragma unroll
    for (int d = 0; d < 4; ++d) o[d][r] *= rl; }
  asm volatile("s_waitcnt lgkmcnt(0)" ::: "memory"); WBAR();
#undef GLDS
#undef ISSUE_K
#undef ISSUE_V
#undef WAITV
#undef WBAR
#undef RESC
#undef NXT3
#undef PA
#undef PKV
#undef KCAT
#undef PHASE1
#undef PHASE2
#undef ITER
}
struct SrcDH { const bf16_t* Q; const bf16_t* K; const unsigned char* q8; const unsigned char* k8; const bf16_t* V; int ldv; };
template <int MP>
__device__ __forceinline__ void attn_core_plh(const SrcDH in, const float thr, const int seq, LAS char* lds, f32x16 (&o)[4], float* probe = nullptr) {
  constexpr int SHM_K = 12288, NKS = 4, NG1 = 8, NEXS = 32, NEXF = 0, VLA = 3;
  using SS = StartSched<NEXS>; using FS = FinSched<NEXF>;
  int lane; asm volatile("v_and_b32 %0, 63, %1" : "=v"(lane) : "v"(threadIdx.x));
  const int tid = threadIdx.x, wid = __builtin_amdgcn_readfirstlane(tid >> 6), r32 = lane & 31, hi = (lane >> 5) & 1, wq = wid & 3; constexpr int mp = MP;
  LAS char* V_lds = lds; LAS char* K_lds = lds + 3 * SHM_V;
  SMS st; st.dm = 0.f; st.keep = true;
  f32x16 negm = f32x16{}, osum = f32x16{};
#pragma unroll
  for (int d = 0; d < 4; ++d) o[d] = f32x16{};
  const bf16x8 ones = {16256, 16256, 16256, 16256, 16256, 16256, 16256, 16256};
  bf16x8 qr[NKS]; v8i_att qf = {};
  if constexpr (mp == 0) { const bf16_t* Qw = in.Q + (size_t)(wq * QBLK + r32) * 1024 + hi * 8;
#pragma unroll
    for (int d0 = 0; d0 < NKS; ++d0) qr[d0] = *(const bf16x8*)(Qw + d0 * 16); }
  else { const unsigned char* Qw = in.q8 + (size_t)(wq * QBLK + r32) * 1024 + 64 + hi * 32;
    const v4i_att lo = *(const v4i_att*)(Qw), hh = *(const v4i_att*)(Qw + 16); qf = __builtin_shufflevector(lo, hh, 0, 1, 2, 3, 4, 5, 6, 7);
#pragma unroll
    for (int d0 = 0; d0 < NKS; ++d0) qr[d0] = bf16x8{}; }
  const int krow = wid * 8 + (lane >> 3), kslot = (lane & 7) ^ ((krow >> 1) & 7);
  const unsigned koff = (unsigned)(krow * 1024 + kslot * 8) * 2u;
  const unsigned ksrc8 = (unsigned)(((wid & 3) * 16 + (lane >> 2)) * 1024 + 64 + (((lane & 3) ^ ((lane >> 4) & 3)) << 4));
  const int kdst8 = 8192 + (wid & 3) * 1024 + lane * 16;
  unsigned voff[2];
#pragma unroll
  for (int i = 0; i < 2; ++i) { const int p = i * 8192 + wid * 1024 + lane * 16, s_ = p >> 9, wq_ = (p & 511) >> 1, kk = (s_ >> 2) * 8 + (wq_ >> 5), cl = wq_ & 31;
    voff[i] = (unsigned)(kk * in.ldv + (s_ & 3) * 32 + cl) * 2u; }
  const int vb0 = (int)(unsigned)(size_t)V_lds + v_rd_base(lane);
  const unsigned ldsw = (unsigned)wid * 1024u;
  int kx[2];
#pragma unroll
  for (int c = 0; c < 2; ++c) kx[c] = 8192 + r32 * 64 + (((2 * hi + c) ^ ((r32 >> 2) & 3)) << 4);
#define GLDS(gp, lp) __builtin_amdgcn_global_load_lds((const unsigned*)(gp), (LAS unsigned*)(lp), 16, 0, 0)
#define ISSUE_K(t, b) do { GLDS((const char*)in.K + (size_t)(t) * (KVBLK * 2) * 1024 + koff, K_lds + (b) * SHM_K + ldsw); GLDS(in.k8 + (size_t)(t) * (KVBLK * 1024) + ksrc8, K_lds + (b) * SHM_K + kdst8); } while (0)
#define ISSUE_V(t, b) do { const char* vb_ = (const char*)in.V + (size_t)(t) * (KVBLK * 2) * in.ldv; GLDS(vb_ + voff[0], V_lds + (b) * SHM_V + ldsw); GLDS(vb_ + voff[1], V_lds + (b) * SHM_V + 8192 + ldsw); } while (0)
#define DMA_PIECE(i) do { if ((i) == 0) GLDS((const char*)in.K + (size_t)tk_ * (KVBLK * 2) * 1024 + koff, K_lds + bq * SHM_K + ldsw); \
    else if ((i) == 1) GLDS(in.k8 + (size_t)tk_ * (KVBLK * 1024) + ksrc8, K_lds + bq * SHM_K + kdst8); \
    else GLDS((const char*)in.V + (size_t)tv_ * (KVBLK * 2) * in.ldv + voff[(i) & 1], V_lds + b2 * SHM_V + ((i) & 1) * 8192 + ldsw); } while (0)
#define WAITV(n) asm volatile("s_waitcnt vmcnt(%0)" :: "n"(n) : "memory")
#define WBAR() do { asm volatile("" ::: "memory"); __builtin_amdgcn_s_barrier(); asm volatile("" ::: "memory"); } while (0)
#define RESC() do { if (!st.keep) { int l2_; asm volatile("v_and_b32 %0, 63, %1" : "=v"(l2_) : "v"(threadIdx.x)); const int h2_ = l2_ >> 5; LAS float* al2_ = (LAS float*)(lds + MISC_OFF + 128) + wid * 32; \
    if (h2_ == 0) al2_[l2_] = __builtin_amdgcn_exp2f(st.dm); asm volatile("s_waitcnt lgkmcnt(0)" ::: "memory"); \
    _Pragma("unroll") for (int r = 0; r < 16; ++r) { const float a_ = al2_[crow(r, h2_)]; osum[r] *= a_; _Pragma("unroll") for (int d = 0; d < 4; ++d) o[d][r] *= a_; } asm volatile("s_waitcnt lgkmcnt(0)" ::: "memory"); } } while (0)
#define NXT3(x) ((x) == 2 ? 0 : (x) + 1)
#define KFRAG(Ks, d, blk) (*(const LAS bf16x8*)((Ks) + KSW((blk) * 32 + r32, ((d) * 16 + hi * 8) * 2)))
#define PA(ks) (*reinterpret_cast<const bf16x8*>(&pw[ks]))
#define PKV(f) (bf16x8){f.l[0], f.l[1], f.l[2], f.l[3], f.h[0], f.h[1], f.h[2], f.h[3]}
#define KCAT(lo_, hi_) __builtin_shufflevector(__builtin_bit_cast(v4i_att, lo_), __builtin_bit_cast(v4i_att, hi_), 0, 1, 2, 3, 4, 5, 6, 7)
#define PHASE1_BF(PN0, PN1, PF0, PF1, Ks, vb) do { \
    bf16x8 kf[NKS][2]; kf[0][0] = KFRAG(Ks, 0, 0); kf[0][1] = KFRAG(Ks, 0, 1); \
    sfor<0, NG1>([&](auto gc) __attribute__((always_inline)) { constexpr int g = decltype(gc)::value, d = g >> 1, blk = g & 1; \
      if constexpr (blk == 0 && d + 1 < NKS) { kf[d + 1][0] = KFRAG(Ks, d + 1, 0); kf[d + 1][1] = KFRAG(Ks, d + 1, 1); } \
      if constexpr (blk == 0) { if constexpr (d == 0) mfma_c(PN0, kf[d][0], qr[d], negm); else PN0 = __builtin_amdgcn_mfma_f32_32x32x16_bf16(kf[d][0], qr[d], PN0, 0, 0, 0); } \
      else              { if constexpr (d == 0) mfma_c(PN1, kf[d][1], qr[d], negm); else PN1 = __builtin_amdgcn_mfma_f32_32x32x16_bf16(kf[d][1], qr[d], PN1, 0, 0, 0); } \
      if constexpr (g < 4) DMA_PIECE(g); \
      if constexpr (g >= NG1 - VLA) v_issue<g - (NG1 - VLA)>(vf[g - (NG1 - VLA)], vb); \
      sfor<FS::first(g, NG1), FS::first(g + 1, NG1)>([&](auto ic) __attribute__((always_inline)) { fin_item<decltype(ic)::value, NEXF>(PF0, PF1, st, pw); }); \
      SBAR(); }); } while (0)
#define PHASE1_F8(PN0, PN1, PF0, PF1, Ks, vb) do { \
    bf16x8 kl0, kh0, kl1, kh1; { const int a0_ = (int)(unsigned)(size_t)(Ks) + kx[0], a1_ = (int)(unsigned)(size_t)(Ks) + kx[1]; \
      k_read<0>(kl0, a0_); k_read<0>(kh0, a1_); k_read<2048>(kl1, a0_); k_read<2048>(kh1, a1_); } \
    asm volatile("s_waitcnt lgkmcnt(2)" : "+v"(kl0), "+v"(kh0)); \
    PN0 = __builtin_amdgcn_mfma_scale_f32_32x32x64_f8f6f4(KCAT(kl0, kh0), qf, negm, 0, 0, 0, 0x7f7f7f7f, 0, 0x7c7c7c7c); \
    DMA_PIECE(0); DMA_PIECE(1); \
    v_issue<0>(vf[0], vb); \
    sfor<0, 8>([&](auto ic) __attribute__((always_inline)) { fin_item<decltype(ic)::value, NEXF>(PF0, PF1, st, pw); }); \
    SBAR(); \
    asm volatile("s_waitcnt lgkmcnt(2)" : "+v"(kl1), "+v"(kh1)); \
    PN1 = __builtin_amdgcn_mfma_scale_f32_32x32x64_f8f6f4(KCAT(kl1, kh1), qf, negm, 0, 0, 0, 0x7f7f7f7f, 0, 0x7c7c7c7c); \
    DMA_PIECE(2); DMA_PIECE(3); \
    v_issue<1>(vf[1], vb); v_issue<2>(vf[2], vb); \
    sfor<8, 16>([&](auto ic) __attribute__((always_inline)) { fin_item<decltype(ic)::value, NEXF>(PF0, PF1, st, pw); }); \
    SBAR(); } while (0)
#define PHASE2(PS0, PS1, vb) do { \
    sfor<0, 20>([&](auto gc) __attribute__((always_inline)) { constexpr int gg = decltype(gc)::value, ks = gg / 5, d = gg % 5, g = ks * 4 + d; \
      if constexpr (d < 4) { \
        v_wait<2 * (15 - g < VLA - 1 ? 15 - g : VLA - 1)>(vf[g]); \
        o[d] = __builtin_amdgcn_mfma_f32_32x32x16_bf16(PA(ks), PKV(vf[g]), o[d], 0, 0, 0); \
        if constexpr (g + VLA < 16) v_issue<g + VLA>(vf[g + VLA], vb); \
      } else osum = __builtin_amdgcn_mfma_f32_32x32x16_bf16(PA(ks), ones, osum, 0, 0, 0); \
      sfor<SS::first(gg, 20), SS::first(gg + 1, 20)>([&](auto ic) __attribute__((always_inline)) { start_item<decltype(ic)::value, NEXS>(PS0, PS1, st, negm, thr, hi == 0 ? 1.f : 0.f); }); \
      SBAR(); }); \
    asm volatile("" : "+v"(PS0), "+v"(PS1)); \
    RESC(); } while (0)
  f32x16 pA0, pA1, pB0, pB1; u32x4 pw[4]; VF vf[16]; const int NT = seq / KVBLK;
  ISSUE_K(0, 0); ISSUE_K(1, 1); ISSUE_V(0, 0);
  WAITV(4); WBAR();
  ISSUE_K(2, 2); ISSUE_V(1, 1);
  if constexpr (mp == 0) { bf16x8 kf[NKS][2];
#pragma unroll
    for (int d = 0; d < NKS; ++d) { kf[d][0] = KFRAG(K_lds, d, 0); kf[d][1] = KFRAG(K_lds, d, 1); }
    pA0 = f32x16{}; pA1 = f32x16{};
#pragma unroll
    for (int d = 0; d < NKS; ++d) { pA0 = __builtin_amdgcn_mfma_f32_32x32x16_bf16(kf[d][0], qr[d], pA0, 0, 0, 0); pA1 = __builtin_amdgcn_mfma_f32_32x32x16_bf16(kf[d][1], qr[d], pA1, 0, 0, 0); } }
  else { const bf16x8 l0 = *(const LAS bf16x8*)(K_lds + kx[0]), h0 = *(const LAS bf16x8*)(K_lds + kx[1]), l1 = *(const LAS bf16x8*)(K_lds + 2048 + kx[0]), h1 = *(const LAS bf16x8*)(K_lds + 2048 + kx[1]);
    pA0 = __builtin_amdgcn_mfma_scale_f32_32x32x64_f8f6f4(KCAT(l0, h0), qf, f32x16{}, 0, 0, 0, 0x7f7f7f7f, 0, 0x7c7c7c7c);
    pA1 = __builtin_amdgcn_mfma_scale_f32_32x32x64_f8f6f4(KCAT(l1, h1), qf, f32x16{}, 0, 0, 0, 0x7f7f7f7f, 0, 0x7c7c7c7c); }
  sfor<0, 16>([&](auto ic) __attribute__((always_inline)) { start_item<decltype(ic)::value, NEXS>(pA0, pA1, st, negm, thr, hi == 0 ? 1.f : 0.f); });
  { float pmax;
    { auto rr = __builtin_amdgcn_permlane32_swap(__float_as_uint(st.a0), __float_as_uint(st.a0), false, false); pmax = fmaxf(__uint_as_float(rr[0]), __uint_as_float(rr[1])); }
#pragma unroll
    for (int r = 0; r < 16; ++r) { pA0[r] -= pmax; pA1[r] -= pmax; negm[r] = -pmax; } }
  sfor<17, SS::NITEMS>([&](auto ic) __attribute__((always_inline)) { start_item<decltype(ic)::value, NEXS>(pA0, pA1, st, negm, thr, hi == 0 ? 1.f : 0.f); });
  int bq = 0;
#define ITER(j, PN0, PN1, PF0, PF1) do { const int b1 = NXT3(bq), b2 = NXT3(b1); \
    WAITV(4); WBAR(); \
    const int tk_ = (j) + 3 < NT ? (j) + 3 : NT - 1, tv_ = (j) + 2 < NT ? (j) + 2 : NT - 1; \
    if constexpr (mp == 0) PHASE1_BF(PN0, PN1, PF0, PF1, K_lds + b1 * SHM_K, vb0 + bq * SHM_V); else PHASE1_F8(PN0, PN1, PF0, PF1, K_lds + b1 * SHM_K, vb0 + bq * SHM_V); \
    PHASE2(PN0, PN1, vb0 + bq * SHM_V); \
    bq = b1; } while (0)
#if PROBE_T == 2
  const unsigned long long t0 = __builtin_amdgcn_s_memtime();
#endif
  for (int j = 0; j + 2 < NT; j += 2) { ITER(j, pB0, pB1, pA0, pA1); ITER(j + 1, pA0, pA1, pB0, pB1); }
  ITER(NT - 2, pB0, pB1, pA0, pA1);
#if PROBE_T == 2
  { const unsigned long long t1 = __builtin_amdgcn_s_memtime(); if (probe != nullptr && tid == 0) { probe[0] = 0.f; probe[1] = ((float)(t1 - t0) * (1.f / (NT - 1)) - 1500.f) * 0.05f; } }
#endif
  sfor<0, FS::NITEMS>([&](auto ic) __attribute__((always_inline)) { fin_item<decltype(ic)::value, NEXF>(pB0, pB1, st, pw); });
  WAITV(0); WBAR();
  { const int vb = vb0 + bq * SHM_V;
    sfor<0, VLA>([&](auto gc) __attribute__((always_inline)) { v_issue<decltype(gc)::value>(vf[decltype(gc)::value], vb); });
    sfor<0, 16>([&](auto gc) __attribute__((always_inline)) { constexpr int g = decltype(gc)::value, ks = g >> 2, d = g & 3;
      v_wait<2 * (15 - g < VLA - 1 ? 15 - g : VLA - 1)>(vf[g]);
      o[d] = __builtin_amdgcn_mfma_f32_32x32x16_bf16(PA(ks), PKV(vf[g]), o[d], 0, 0, 0);
      if constexpr (g + VLA < 16) v_issue<g + VLA>(vf[g + VLA], vb);
      if constexpr (d == 3) osum = __builtin_amdgcn_mfma_f32_32x32x16_bf16(PA(ks), ones, osum, 0, 0, 0);
      SBAR(); }); }
#pragma unroll
  for (int r = 0; r < 16; ++r) { const float rl = __builtin_amdgcn_rcpf(osum[r]);
#pragma unroll
    for (int d = 0; d < 4; ++d) o[d][r] *= rl; }
  asm volatile("s_waitcnt lgkmcnt(0)" ::: "memory"); WBAR();
#undef GLDS
#undef ISSUE_K
#undef ISSUE_V
#undef DMA_PIECE
#undef WAITV
#undef WBAR
#undef RESC
#undef NXT3
#undef KFRAG
#undef PA
#undef PKV
#undef KCAT
#undef PHASE1_BF
#undef PHASE1_F8
#undef PHASE2
#undef ITER
}
struct SrcM8 { const unsigned char* q8; const unsigned char* k8n; const unsigned char* k8r; const unsigned char* vT; };
template <int N> __device__ __forceinline__ void fin8_item(f32x16& P0, f32x16& P1, v8i_att& p8, float& ls0, float& ls1) {
  if constexpr (N < 16) P1[N] = __builtin_amdgcn_exp2f(P1[N]);
  else if constexpr (N < 32) { constexpr int k = N - 16, e = 2 * k; const float a = e < 16 ? P0[e] : P1[e - 16], b = e < 16 ? P0[e + 1] : P1[e - 15];
    if constexpr ((k & 1) == 0) p8[k >> 1] = __builtin_amdgcn_cvt_pk_fp8_f32(a, b, 0, false); else p8[k >> 1] = __builtin_amdgcn_cvt_pk_fp8_f32(a, b, p8[k >> 1], true); }
  else { constexpr int e = N - 32; const float v = e < 16 ? P0[e] : P1[e - 16];
    if constexpr (e & 1) asm("v_add_f32_e32 %0, %1, %0" : "+v"(ls1) : "v"(v)); else asm("v_add_f32_e32 %0, %1, %0" : "+v"(ls0) : "v"(v)); }
}
constexpr int fin8_first(int g) { return g == 0 ? 0 : g == 1 ? 7 : g == 2 ? 14 : g == 3 ? 26 : g == 4 ? 39 : g == 5 ? 52 : 64; }
__device__ __forceinline__ void attn_core_mla8(const SrcM8 in, const float thr, const int seq, LAS char* lds, f32x16 (&o)[4], float* probe = nullptr) {
  constexpr int SHM_K = 3 * 4096, SHM_V8 = 8192, NKS = 3;
  using SS = StartSched<16>;
  int lane; asm volatile("v_and_b32 %0, 63, %1" : "=v"(lane) : "v"(threadIdx.x));
  const int tid = threadIdx.x, wid = __builtin_amdgcn_readfirstlane(tid >> 6), r32 = lane & 31, hi = (lane >> 5) & 1;
  LAS char* V_lds = lds; LAS char* K_lds = lds + 3 * SHM_V8;
  SMS st; st.dm = 0.f; st.keep = true;
  f32x16 negm = f32x16{};
  float ls0 = 0.f, ls1 = 0.f;
#pragma unroll
  for (int d = 0; d < 4; ++d) o[d] = f32x16{};
  v8i_att qf[NKS];
  { const unsigned char* Qw = in.q8 + (size_t)(wid * QBLK + r32) * 1536 + hi * 32;
#pragma unroll
    for (int s = 0; s < NKS; ++s) { const v4i_att lo = *(const v4i_att*)(Qw + s * 64), hh = *(const v4i_att*)(Qw + s * 64 + 16); qf[s] = __builtin_shufflevector(lo, hh, 0, 1, 2, 3, 4, 5, 6, 7); } }
  unsigned ksrc[2]; int kdst[2]; bool krot[2];
#pragma unroll
  for (int i = 0; i < 2; ++i) { const int p0 = wid * 2 + i, p = p0 < 12 ? p0 : p0 - 4, s = p >> 2, q = p & 3, row = q * 16 + (lane >> 2), lc = (lane & 3) ^ ((lane >> 4) & 3);
    krot[i] = (s == 2); ksrc[i] = krot[i] ? (unsigned)(row * 64 + lc * 16) : (unsigned)(row * 1024 + s * 64 + lc * 16); kdst[i] = s * 4096 + q * 1024 + lane * 16; }
  const unsigned vsrc = (unsigned)((wid * 16 + (lane >> 2)) * 4096 + (((lane & 3) ^ ((lane >> 4) & 3)) << 4));
  const int vdst = wid * 1024 + lane * 16;
  int kx[2];
#pragma unroll
  for (int c = 0; c < 2; ++c) kx[c] = r32 * 64 + (((2 * hi + c) ^ ((r32 >> 2) & 3)) << 4);
#define GLDS(gp, lp) __builtin_amdgcn_global_load_lds((const unsigned*)(gp), (LAS unsigned*)(lp), 16, 0, 0)
#define PIECE_K(i, tk, bk) do { if (krot[i]) GLDS(in.k8r + (size_t)(tk) * (KVBLK * 64) + ksrc[i], K_lds + (bk) * SHM_K + kdst[i]); \
                               else GLDS(in.k8n + (size_t)(tk) * (KVBLK * 1024) + ksrc[i], K_lds + (bk) * SHM_K + kdst[i]); } while (0)
#define PIECE_V(tv, bv) GLDS(in.vT + (size_t)(tv) * KVBLK + vsrc, V_lds + (bv) * SHM_V8 + vdst)
#define WAITV(n) asm volatile("s_waitcnt vmcnt(%0)" :: "n"(n) : "memory")
#define WBAR() do { asm volatile("" ::: "memory"); __builtin_amdgcn_s_barrier(); asm volatile("" ::: "memory"); } while (0)
#define RESC() do { if (!st.keep) { int l2_; asm volatile("v_and_b32 %0, 63, %1" : "=v"(l2_) : "v"(threadIdx.x)); const int h2_ = l2_ >> 5; LAS float* al2_ = (LAS float*)(lds + MISC_OFF + 128) + wid * 32; \
    { const float am_ = __builtin_amdgcn_exp2f(st.dm); ls0 *= am_; ls1 *= am_; if (h2_ == 0) al2_[l2_] = am_; } asm volatile("s_waitcnt lgkmcnt(0)" ::: "memory"); \
    _Pragma("unroll") for (int r = 0; r < 16; ++r) { const float a_ = al2_[crow(r, h2_)]; _Pragma("unroll") for (int d = 0; d < 4; ++d) o[d][r] *= a_; } asm volatile("s_waitcnt lgkmcnt(0)" ::: "memory"); } } while (0)
#define NXT3(x) ((x) == 2 ? 0 : (x) + 1)
#define KCAT(lo_, hi_) __builtin_shufflevector(__builtin_bit_cast(v4i_att, lo_), __builtin_bit_cast(v4i_att, hi_), 0, 1, 2, 3, 4, 5, 6, 7)
#define MF8(A_, B_, C_, SB_) __builtin_amdgcn_mfma_scale_f32_32x32x64_f8f6f4(A_, B_, C_, 0, 0, 0, 0x7f7f7f7f, 0, SB_)
#define PHASE1(PN0, PN1, PF0, PF1, Kq, vb) do { \
    bf16x8 kl[6], kh[6]; const int a0_ = (int)(unsigned)(size_t)(Kq) + kx[0], a1_ = (int)(unsigned)(size_t)(Kq) + kx[1]; \
    k_read<0>(kl[0], a0_); k_read<0>(kh[0], a1_); k_read<4096>(kl[1], a0_); k_read<4096>(kh[1], a1_); \
    sfor<0, 6>([&](auto gc) __attribute__((always_inline)) { constexpr int g = decltype(gc)::value, blk = g / 3, s = g % 3; \
      asm volatile("s_waitcnt lgkmcnt(2)" : "+v"(kl[g]), "+v"(kh[g])); \
      if constexpr (blk == 0) { if constexpr (s == 0) PN0 = MF8(KCAT(kl[g], kh[g]), qf[s], negm, 0x7c7c7c7c); else PN0 = MF8(KCAT(kl[g], kh[g]), qf[s], PN0, 0x7c7c7c7c); } \
      else              { if constexpr (s == 0) PN1 = MF8(KCAT(kl[g], kh[g]), qf[s], negm, 0x7c7c7c7c); else PN1 = MF8(KCAT(kl[g], kh[g]), qf[s], PN1, 0x7c7c7c7c); } \
      if constexpr (g + 2 < 6) { constexpr int g2 = g + 2; k_read<(g2 % 3) * 4096 + (g2 / 3) * 2048>(kl[g2], a0_); k_read<(g2 % 3) * 4096 + (g2 / 3) * 2048>(kh[g2], a1_); } \
      else { constexpr int d_ = g - 4; k_read<d_ * 2048>(vl[d_], (vb) + kx[0]); k_read<d_ * 2048>(vh[d_], (vb) + kx[1]); } \
      if constexpr (g == 0) PIECE_K(0, tk_, bq); else if constexpr (g == 1) PIECE_K(1, tk_, bq); else if constexpr (g == 2) PIECE_V(tv_, b2); \
      sfor<fin8_first(g), fin8_first(g + 1)>([&](auto ic) __attribute__((always_inline)) { fin8_item<decltype(ic)::value>(PF0, PF1, p8, ls0, ls1); }); \
      SBAR(); }); } while (0)
#define PHASE2(PS0, PS1, vb) do { \
    sfor<0, 4>([&](auto gc) __attribute__((always_inline)) { constexpr int d = decltype(gc)::value; \
      if constexpr (d < 3) asm volatile("s_waitcnt lgkmcnt(2)" : "+v"(vl[d]), "+v"(vh[d])); else asm volatile("s_waitcnt lgkmcnt(0)" : "+v"(vl[d]), "+v"(vh[d])); \
      o[d] = MF8(p8, KCAT(vl[d], vh[d]), o[d], 0x7f7f7f7f); \
      if constexpr (d + 2 < 4) { k_read<(d + 2) * 2048>(vl[d + 2], (vb) + kx[0]); k_read<(d + 2) * 2048>(vh[d + 2], (vb) + kx[1]); } \
      sfor<SS::first(d, 4), SS::first(d + 1, 4)>([&](auto ic) __attribute__((always_inline)) { start_item<decltype(ic)::value, 16>(PS0, PS1, st, negm, thr, hi == 0 ? 1.f : 0.f); }); \
      SBAR(); }); \
    asm volatile("" : "+v"(PS0), "+v"(PS1)); \
    RESC(); } while (0)
  f32x16 pA0, pA1, pB0, pB1; v8i_att p8 = {}; bf16x8 vl[4], vh[4]; const int NT = seq / KVBLK;
  PIECE_K(0, 0, 0); PIECE_K(1, 0, 0); PIECE_K(0, 1, 1); PIECE_K(1, 1, 1); PIECE_V(0, 0);
  WAITV(3); WBAR();
  PIECE_K(0, 2, 2); PIECE_K(1, 2, 2); PIECE_V(1, 1);
  { pA0 = f32x16{}; pA1 = f32x16{};
#pragma unroll
    for (int s = 0; s < NKS; ++s) { const bf16x8 l0 = *(const LAS bf16x8*)(K_lds + s * 4096 + kx[0]), h0 = *(const LAS bf16x8*)(K_lds + s * 4096 + kx[1]), l1 = *(const LAS bf16x8*)(K_lds + s * 4096 + 2048 + kx[0]), h1 = *(const LAS bf16x8*)(K_lds + s * 4096 + 2048 + kx[1]);
      pA0 = MF8(KCAT(l0, h0), qf[s], pA0, 0x7c7c7c7c); pA1 = MF8(KCAT(l1, h1), qf[s], pA1, 0x7c7c7c7c); } }
  sfor<0, 16>([&](auto ic) __attribute__((always_inline)) { start_item<decltype(ic)::value, 16>(pA0, pA1, st, negm, thr, hi == 0 ? 1.f : 0.f); });
  { float pmax;
    { auto rr = __builtin_amdgcn_permlane32_swap(__float_as_uint(st.a0), __float_as_uint(st.a0), false, false); pmax = fmaxf(__uint_as_float(rr[0]), __uint_as_float(rr[1])); }
#pragma unroll
    for (int r = 0; r < 16; ++r) { pA0[r] -= pmax; pA1[r] -= pmax; negm[r] = -pmax; } }
  sfor<17, SS::NITEMS>([&](auto ic) __attribute__((always_inline)) { start_item<decltype(ic)::value, 16>(pA0, pA1, st, negm, thr, hi == 0 ? 1.f : 0.f); });
  int bq = 0;
#define ITER(j, PN0, PN1, PF0, PF1) do { const int b1 = NXT3(bq), b2 = NXT3(b1); \
    WAITV(3); WBAR(); \
    const int tk_ = (j) + 3 < NT ? (j) + 3 : NT - 1, tv_ = (j) + 2 < NT ? (j) + 2 : NT - 1; \
    PHASE1(PN0, PN1, PF0, PF1, K_lds + b1 * SHM_K, (int)(unsigned)(size_t)(V_lds + bq * SHM_V8)); \
    PHASE2(PN0, PN1, (int)(unsigned)(size_t)(V_lds + bq * SHM_V8)); \
    bq = b1; } while (0)
#if PROBE_T == 5
  const unsigned long long t0 = __builtin_amdgcn_s_memtime();
#endif
  for (int j = 0; j + 2 < NT; j += 2) { ITER(j, pB0, pB1, pA0, pA1); ITER(j + 1, pA0, pA1, pB0, pB1); }
  ITER(NT - 2, pB0, pB1, pA0, pA1);
#if PROBE_T == 5
  { const unsigned long long t1 = __builtin_amdgcn_s_memtime(); if (probe != nullptr && tid == 0) { probe[0] = 0.f; probe[1] = ((float)(t1 - t0) * (1.f / (NT - 1)) - PROBE_BASE) * 0.05f; } }
#endif
  sfor<0, 64>([&](auto ic) __attribute__((always_inline)) { fin8_item<decltype(ic)::value>(pB0, pB1, p8, ls0, ls1); });
  WAITV(0); WBAR();
  { const int vb = (int)(unsigned)(size_t)(V_lds + bq * SHM_V8);
#pragma unroll
    for (int d = 0; d < 4; ++d) { const bf16x8 l_ = *(const LAS bf16x8*)(V_lds + bq * SHM_V8 + d * 2048 + kx[0]), h_ = *(const LAS bf16x8*)(V_lds + bq * SHM_V8 + d * 2048 + kx[1]);
      o[d] = MF8(p8, KCAT(l_, h_), o[d], 0x7f7f7f7f); } (void)vb; }
  { float ps = ls0 + ls1;
    { auto rr = __builtin_amdgcn_permlane32_swap(__float_as_uint(ps), __float_as_uint(ps), false, false); ps = __uint_as_float(rr[0]) + __uint_as_float(rr[1]); }
    LAS float* li_ = (LAS float*)(lds + MISC_OFF + 128) + wid * 32;
    if (hi == 0) li_[r32] = ps; asm volatile("s_waitcnt lgkmcnt(0)" ::: "memory");
#pragma unroll
    for (int r = 0; r < 16; ++r) { const float rl = __builtin_amdgcn_rcpf(li_[crow(r, hi)]);
#pragma unroll
      for (int d = 0; d < 4; ++d) o[d][r] *= rl; } }
  asm volatile("s_waitcnt lgkmcnt(0)" ::: "memory"); WBAR();
#undef GLDS
#undef PIECE_K
#undef PIECE_V
#undef WAITV
#undef WBAR
#undef RESC
#undef NXT3
#undef KCAT
#undef MF8
#undef PHASE1
#undef PHASE2
#undef ITER
}
struct SrcDP { const unsigned char* q8; const unsigned char* k8; const bf16_t* V; const unsigned char* vT; int ldv; const unsigned char* q8l; };
template <int N> __device__ __forceinline__ void finp_item(f32x16& P0, f32x16& P1, v8i_att& p8) {
  constexpr int e = 2 * N; const float a = e < 16 ? P0[e] : P1[e - 16], b = e < 16 ? P0[e + 1] : P1[e - 15];
  if constexpr ((N & 1) == 0) p8[N >> 1] = __builtin_amdgcn_cvt_pk_fp8_f32(a, b, 0, false); else p8[N >> 1] = __builtin_amdgcn_cvt_pk_fp8_f32(a, b, p8[N >> 1], true);
}
template <int MAPI, int MP>
__device__ __forceinline__ void attn_core_plp(const SrcDP in, const float thr_, const int seq, LAS char* lds, f32x16 (&o)[4], float* probe = nullptr) {
  constexpr int SHM_K = 8192, SHM_V8 = 8192, NEXS = 32, NEXF = 0, VLA = 3;
  using SS = StartSched<NEXS>; using FS = FinSched<NEXF>;
  const float thr = MP == 1 ? 8.0f : thr_;
  int lane; asm volatile("v_and_b32 %0, 63, %1" : "=v"(lane) : "v"(threadIdx.x));
  const int tid = threadIdx.x, wid = __builtin_amdgcn_readfirstlane(tid >> 6), r32 = lane & 31, hi = (lane >> 5) & 1, wq = wid & 3; constexpr int mp = MAPI;
  LAS char* V_lds = lds; LAS char* K_lds = lds + 3 * SHM_V; LAS char* T_lds = lds + 3 * SHM_V + 3 * SHM_K;
  SMS st; st.dm = 0.f; st.keep = true;
  f32x16 negm = f32x16{}, osum = f32x16{};
#pragma unroll
  for (int d = 0; d < 4; ++d) o[d] = f32x16{};
  const bf16x8 ones = {16256, 16256, 16256, 16256, 16256, 16256, 16256, 16256};
  const v8i_att ones8 = {0x38383838, 0x38383838, 0x38383838, 0x38383838, 0x38383838, 0x38383838, 0x38383838, 0x38383838};
  v8i_att qf;
  { const unsigned char* Qw = in.q8 + (size_t)(wq * QBLK + r32) * 1024 + mp * 64 + hi * 32;
    const v4i_att lo = *(const v4i_att*)(Qw), hh = *(const v4i_att*)(Qw + 16); qf = __builtin_shufflevector(lo, hh, 0, 1, 2, 3, 4, 5, 6, 7); }
  constexpr bool QLO = DA_QLO && MAPI == 0;
  v8i_att ql = {};
  if constexpr (QLO) { const unsigned char* Qw = in.q8l + (size_t)(wq * QBLK + r32) * 1024 + mp * 64 + hi * 32;
    const v4i_att lo = *(const v4i_att*)(Qw), hh = *(const v4i_att*)(Qw + 16); ql = __builtin_shufflevector(lo, hh, 0, 1, 2, 3, 4, 5, 6, 7); }
  const unsigned ksrc = (unsigned)(((wid & 3) * 16 + (lane >> 2)) * 1024 + (wid >> 2) * 64 + (((lane & 3) ^ ((lane >> 4) & 3)) << 4));
  const int kdst = wid * 1024 + lane * 16;
  const unsigned tsrc = (unsigned)((wid * 16 + (lane >> 2)) * 4096 + (((lane & 3) ^ ((lane >> 4) & 3)) << 4));
  unsigned voff[2];
#pragma unroll
  for (int i = 0; i < 2; ++i) { const int p = i * 8192 + wid * 1024 + lane * 16, s_ = p >> 9, wq_ = (p & 511) >> 1, kk = (s_ >> 2) * 8 + (wq_ >> 5), cl = wq_ & 31;
    voff[i] = (unsigned)(kk * in.ldv + (s_ & 3) * 32 + cl) * 2u; }
  const int vb0 = (int)(unsigned)(size_t)V_lds + v_rd_base(lane);
  const unsigned ldsw = (unsigned)wid * 1024u;
  const LAS char* Kw = K_lds + mp * 4096;
  int kx[2];
#pragma unroll
  for (int c = 0; c < 2; ++c) kx[c] = r32 * 64 + (((2 * hi + c) ^ ((r32 >> 2) & 3)) << 4);
#define GLDS(gp, lp) __builtin_amdgcn_global_load_lds((const unsigned*)(gp), (LAS unsigned*)(lp), 16, 0, 0)
#define ISSUE_K(t, b) GLDS(in.k8 + (size_t)(t) * (KVBLK * 1024) + ksrc, K_lds + (b) * SHM_K + kdst)
#define ISSUE_V0(t, b) GLDS((const char*)in.V + (size_t)(t) * (KVBLK * 2) * in.ldv + voff[0], V_lds + (b) * SHM_V + ldsw)
#define ISSUE_V1(t, b) GLDS((const char*)in.V + (size_t)(t) * (KVBLK * 2) * in.ldv + voff[1], V_lds + (b) * SHM_V + 8192 + ldsw)
#define ISSUE_T(t, b) GLDS(in.vT + (size_t)(t) * KVBLK + tsrc, T_lds + (b) * SHM_V8 + kdst)
#define WAITV(n) asm volatile("s_waitcnt vmcnt(%0)" :: "n"(n) : "memory")
#define WBAR() do { asm volatile("" ::: "memory"); __builtin_amdgcn_s_barrier(); asm volatile("" ::: "memory"); } while (0)
#define RESC() do { if (!st.keep) { int l2_; asm volatile("v_and_b32 %0, 63, %1" : "=v"(l2_) : "v"(threadIdx.x)); const int h2_ = l2_ >> 5; LAS float* al2_ = (LAS float*)(lds + MISC_OFF + 128) + wid * 32; \
    if (h2_ == 0) al2_[l2_] = __builtin_amdgcn_exp2f(st.dm); asm volatile("s_waitcnt lgkmcnt(0)" ::: "memory"); \
    _Pragma("unroll") for (int r = 0; r < 16; ++r) { const float a_ = al2_[crow(r, h2_)]; osum[r] *= a_; _Pragma("unroll") for (int d = 0; d < 4; ++d) o[d][r] *= a_; } asm volatile("s_waitcnt lgkmcnt(0)" ::: "memory"); } } while (0)
#define NXT3(x) ((x) == 2 ? 0 : (x) + 1)
#define PA(ks) (*reinterpret_cast<const bf16x8*>(&pw[ks]))
#define PKV(f) (bf16x8){f.l[0], f.l[1], f.l[2], f.l[3], f.h[0], f.h[1], f.h[2], f.h[3]}
#define KCAT(lo_, hi_) __builtin_shufflevector(__builtin_bit_cast(v4i_att, lo_), __builtin_bit_cast(v4i_att, hi_), 0, 1, 2, 3, 4, 5, 6, 7)
#define MF8(A_, B_, C_, SB_) __builtin_amdgcn_mfma_scale_f32_32x32x64_f8f6f4(A_, B_, C_, 0, 0, 0, 0x7f7f7f7f, 0, SB_)
#define PHASE1(PN0, PN1, PF0, PF1, Ks, vb, tb) do { \
    bf16x8 kl0, kh0, kl1, kh1; { const int a0_ = (int)(unsigned)(size_t)(Ks) + kx[0], a1_ = (int)(unsigned)(size_t)(Ks) + kx[1]; \
      k_read<0>(kl0, a0_); k_read<0>(kh0, a1_); k_read<2048>(kl1, a0_); k_read<2048>(kh1, a1_); } \
    asm volatile("s_waitcnt lgkmcnt(2)" : "+v"(kl0), "+v"(kh0)); \
    PN0 = MF8(KCAT(kl0, kh0), qf, negm, 0x7c7c7c7c); if constexpr (QLO) PN0 = MF8(KCAT(kl0, kh0), ql, PN0, 0x78787878); \
    ISSUE_K(tk_, bq); ISSUE_V0(tv_, b2); \
    if constexpr (MP == 0) { v_issue<0>(vf[0], vb); sfor<0, 8>([&](auto ic) __attribute__((always_inline)) { fin_item<decltype(ic)::value, NEXF>(PF0, PF1, st, pw); }); } \
    else { k_read<0>(vl[0], (tb) + kx[0]); k_read<0>(vh[0], (tb) + kx[1]); sfor<0, 8>([&](auto ic) __attribute__((always_inline)) { finp_item<decltype(ic)::value>(PF0, PF1, p8); }); } \
    SBAR(); \
    asm volatile("s_waitcnt lgkmcnt(2)" : "+v"(kl1), "+v"(kh1)); \
    PN1 = MF8(KCAT(kl1, kh1), qf, negm, 0x7c7c7c7c); if constexpr (QLO) PN1 = MF8(KCAT(kl1, kh1), ql, PN1, 0x78787878); \
    ISSUE_V1(tv_, b2); ISSUE_T(tv_, b2); \
    if constexpr (MP == 0) { v_issue<1>(vf[1], vb); v_issue<2>(vf[2], vb); sfor<8, 16>([&](auto ic) __attribute__((always_inline)) { fin_item<decltype(ic)::value, NEXF>(PF0, PF1, st, pw); }); } \
    else { k_read<2048>(vl[1], (tb) + kx[0]); k_read<2048>(vh[1], (tb) + kx[1]); sfor<8, 16>([&](auto ic) __attribute__((always_inline)) { finp_item<decltype(ic)::value>(PF0, PF1, p8); }); } \
    SBAR(); } while (0)
#define PHASE2(PS0, PS1, vb, tb) do { \
    if constexpr (MP == 0) { \
      sfor<0, 20>([&](auto gc) __attribute__((always_inline)) { constexpr int gg = decltype(gc)::value, ks = gg / 5, d = gg % 5, g = ks * 4 + d; \
        if constexpr (d < 4) { \
          v_wait<2 * (15 - g < VLA - 1 ? 15 - g : VLA - 1)>(vf[g]); \
          o[d] = __builtin_amdgcn_mfma_f32_32x32x16_bf16(PA(ks), PKV(vf[g]), o[d], 0, 0, 0); \
          if constexpr (g + VLA < 16) v_issue<g + VLA>(vf[g + VLA], vb); \
        } else osum = __builtin_amdgcn_mfma_f32_32x32x16_bf16(PA(ks), ones, osum, 0, 0, 0); \
        sfor<SS::first(gg, 20), SS::first(gg + 1, 20)>([&](auto ic) __attribute__((always_inline)) { start_item<decltype(ic)::value, NEXS>(PS0, PS1, st, negm, thr, hi == 0 ? 1.f : 0.f); }); \
        SBAR(); }); \
    } else { \
      sfor<0, 5>([&](auto gc) __attribute__((always_inline)) { constexpr int d = decltype(gc)::value; \
        if constexpr (d < 4) { \
          if constexpr (d < 3) asm volatile("s_waitcnt lgkmcnt(2)" : "+v"(vl[d]), "+v"(vh[d])); else asm volatile("s_waitcnt lgkmcnt(0)" : "+v"(vl[d]), "+v"(vh[d])); \
          o[d] = MF8(p8, KCAT(vl[d], vh[d]), o[d], 0x7f7f7f7f); \
          if constexpr (d + 2 < 4) { k_read<(d + 2) * 2048>(vl[d + 2], (tb) + kx[0]); k_read<(d + 2) * 2048>(vh[d + 2], (tb) + kx[1]); } \
        } else osum = MF8(p8, ones8, osum, 0x7f7f7f7f); \
        sfor<SS::first(d, 5), SS::first(d + 1, 5)>([&](auto ic) __attribute__((always_inline)) { start_item<decltype(ic)::value, NEXS>(PS0, PS1, st, negm, thr, hi == 0 ? 1.f : 0.f); }); \
        SBAR(); }); \
    } \
    asm volatile("" : "+v"(PS0), "+v"(PS1)); \
    RESC(); } while (0)
  f32x16 pA0, pA1, pB0, pB1; u32x4 pw[4]; VF vf[16]; v8i_att p8 = {}; bf16x8 vl[4], vh[4]; const int NT = seq / KVBLK;
  ISSUE_K(0, 0); ISSUE_K(1, 1); ISSUE_V0(0, 0); ISSUE_V1(0, 0); ISSUE_T(0, 0);
  WAITV(4); WBAR();
  ISSUE_K(2, 2); ISSUE_V0(1, 1); ISSUE_V1(1, 1); ISSUE_T(1, 1);
  { const bf16x8 l0 = *(const LAS bf16x8*)(Kw + kx[0]), h0 = *(const LAS bf16x8*)(Kw + kx[1]), l1 = *(const LAS bf16x8*)(Kw + 2048 + kx[0]), h1 = *(const LAS bf16x8*)(Kw + 2048 + kx[1]);
    pA0 = MF8(KCAT(l0, h0), qf, f32x16{}, 0x7c7c7c7c); pA1 = MF8(KCAT(l1, h1), qf, f32x16{}, 0x7c7c7c7c);
    if constexpr (QLO) { pA0 = MF8(KCAT(l0, h0), ql, pA0, 0x78787878); pA1 = MF8(KCAT(l1, h1), ql, pA1, 0x78787878); } }
  sfor<0, 16>([&](auto ic) __attribute__((always_inline)) { start_item<decltype(ic)::value, NEXS>(pA0, pA1, st, negm, thr, hi == 0 ? 1.f : 0.f); });
  { float pmax;
    { auto rr = __builtin_amdgcn_permlane32_swap(__float_as_uint(st.a0), __float_as_uint(st.a0), false, false); pmax = fmaxf(__uint_as_float(rr[0]), __uint_as_float(rr[1])); }
#pragma unroll
    for (int r = 0; r < 16; ++r) { pA0[r] -= pmax; pA1[r] -= pmax; negm[r] = -pmax; } }
  sfor<17, SS::NITEMS>([&](auto ic) __attribute__((always_inline)) { start_item<decltype(ic)::value, NEXS>(pA0, pA1, st, negm, thr, hi == 0 ? 1.f : 0.f); });
  int bq = 0;
#define ITER(j, PN0, PN1, PF0, PF1) do { const int b1 = NXT3(bq), b2 = NXT3(b1); \
    WAITV(4); WBAR(); \
    const int tk_ = (j) + 3 < NT ? (j) + 3 : NT - 1, tv_ = (j) + 2 < NT ? (j) + 2 : NT - 1; \
    PHASE1(PN0, PN1, PF0, PF1, Kw + b1 * SHM_K, vb0 + bq * SHM_V, (int)(unsigned)(size_t)(T_lds + bq * SHM_V8)); \
    PHASE2(PN0, PN1, vb0 + bq * SHM_V, (int)(unsigned)(size_t)(T_lds + bq * SHM_V8)); \
    bq = b1; } while (0)
#if PROBE_T == 2
  const unsigned long long t0 = __builtin_amdgcn_s_memtime();
#endif
  for (int j = 0; j + 2 < NT; j += 2) { ITER(j, pB0, pB1, pA0, pA1); ITER(j + 1, pA0, pA1, pB0, pB1); }
  ITER(NT - 2, pB0, pB1, pA0, pA1);
#if PROBE_T == 2
  { const unsigned long long t1 = __builtin_amdgcn_s_memtime(); if (probe != nullptr && tid == 0) { probe[0] = 0.f; probe[1] = ((float)(t1 - t0) * (1.f / (NT - 1)) - 1500.f) * 0.05f; } }
#endif
  if constexpr (MP == 0) sfor<0, FS::NITEMS>([&](auto ic) __attribute__((always_inline)) { fin_item<decltype(ic)::value, NEXF>(pB0, pB1, st, pw); });
  else sfor<0, 16>([&](auto ic) __attribute__((always_inline)) { finp_item<decltype(ic)::value>(pB0, pB1, p8); });
  WAITV(0); WBAR();
  if constexpr (MP == 0) { const int vb = vb0 + bq * SHM_V;
    sfor<0, VLA>([&](auto gc) __attribute__((always_inline)) { v_issue<decltype(gc)::value>(vf[decltype(gc)::value], vb); });
    sfor<0, 16>([&](auto gc) __attribute__((always_inline)) { constexpr int g = decltype(gc)::value, ks = g >> 2, d = g & 3;
      v_wait<2 * (15 - g < VLA - 1 ? 15 - g : VLA - 1)>(vf[g]);
      o[d] = __builtin_amdgcn_mfma_f32_32x32x16_bf16(PA(ks), PKV(vf[g]), o[d], 0, 0, 0);
      if constexpr (g + VLA < 16) v_issue<g + VLA>(vf[g + VLA], vb);
      if constexpr (d == 3) osum = __builtin_amdgcn_mfma_f32_32x32x16_bf16(PA(ks), ones, osum, 0, 0, 0);
      SBAR(); }); }
  else {
#pragma unroll
    for (int d = 0; d < 4; ++d) { const bf16x8 l_ = *(const LAS bf16x8*)(T_lds + bq * SHM_V8 + d * 2048 + kx[0]), h_ = *(const LAS bf16x8*)(T_lds + bq * SHM_V8 + d * 2048 + kx[1]);
      o[d] = MF8(p8, KCAT(l_, h_), o[d], 0x7f7f7f7f); }
    osum = MF8(p8, ones8, osum, 0x7f7f7f7f); }
#pragma unroll
  for (int r = 0; r < 16; ++r) { const float rl = __builtin_amdgcn_rcpf(osum[r]);
#pragma unroll
    for (int d = 0; d < 4; ++d) o[d][r] *= rl; }
  asm volatile("s_waitcnt lgkmcnt(0)" ::: "memory"); WBAR();
#undef GLDS
#undef ISSUE_K
#undef ISSUE_V0
#undef ISSUE_V1
#undef ISSUE_T
#undef WAITV
#undef WBAR
#undef RESC
#undef NXT3
#undef PA
#undef PKV
#undef KCAT
#undef MF8
#undef PHASE1
#undef PHASE2
#undef ITER
}
}

constexpr int NWAVES = 8;
struct Args { const void* in[27]; float* out; unsigned char* ws; int ph_lo, ph_hi, li, pad; };

__constant__ float c_invA[8] = {1.0f, 0.19392274474868576f, 0.03760603093086393f, 0.007292664737217109f, 0.001414213562373095f, 0.0002742481756762073f, 5.318295896944988e-05f, 1.031338537721246e-05f};
__constant__ float c_invM[32] = {1.0f, 0.6636012376960885f, 0.44036660267178046f, 0.2922278225730151f, 0.19392274474868576f, 0.12868737343265052f, 0.08539710028576561f, 0.05666962144529105f,
    0.03760603093086393f, 0.024955408670558694f, 0.016560440080994446f, 0.010989528534539826f, 0.007292664737217109f, 0.004839421345719893f, 0.003211445994752591f, 0.0021311195369119653f,
    0.001414213562373095f, 0.0009384738703573802f, 0.000622772421914596f, 0.0004132725499855165f, 0.0002742481756762073f, 0.00018199142881462546f, 0.00012076973741146504f, 8.01429472224798e-05f,
    5.318295896944988e-05f, 3.529227739646723e-05f, 2.341999896140934e-05f, 1.5541540297632344e-05f, 1.031338537721246e-05f, 6.8439753011549275e-06f, 4.5416704806078695e-06f, 3.013858152139171e-06f};

__device__ __forceinline__ int permDA(int i) { return i < 16 ? (i >> 1) + 8 * (i & 1) : i; }
__device__ __forceinline__ int permM(int i) { return (i >> 1) + 32 * (i & 1); }
__device__ __forceinline__ int src_in(int j) {
    if (j < 2048) return (j & ~63) + permDA(j & 63);
    if (j < 4352) return j;
    if (j < 6400) return 4416 + (j - 4352);
    if (j < 6464) return 4352 + permM(j - 6400);
    return -1;
}
__device__ __forceinline__ int src_uq(int j) { const int hd = j / 192, off = j % 192; return off < 128 ? j : hd * 192 + 128 + permM(off - 128); }

__device__ __forceinline__ void tr_item(const float* W, int K, int N, bf16_t* WT, int n0, int k0, int scol, const float* rs, LAS float* scr, int lane) {
#pragma unroll 8
    for (int i = 0; i < 32; ++i) { const int kk = 2 * i + (lane >> 5); float v = 0.f; if (scol >= 0) { v = W[(size_t)(k0 + kk) * N + scol]; if (rs) v *= rs[k0 + kk]; } scr[kk * 33 + (lane & 31)] = v; }
    LDS_WAIT(); asm volatile("" ::: "memory");
    const int c = lane & 7;
#pragma unroll
    for (int j = 0; j < 4; ++j) { const int n = (lane >> 3) + 8 * j; const LAS float* s = scr + (8 * c) * 33 + n;
        u32x4 o; o.x = cvt_pk_bf16(s[0 * 33], s[1 * 33]); o.y = cvt_pk_bf16(s[2 * 33], s[3 * 33]); o.z = cvt_pk_bf16(s[4 * 33], s[5 * 33]); o.w = cvt_pk_bf16(s[6 * 33], s[7 * 33]);
        *(u32x4*)(WT + (size_t)(n0 + n) * K + k0 + 8 * c) = o; }
    LDS_WAIT(); asm volatile("" ::: "memory");
}

template <int MODE = 0, bool OUT8 = false>
__device__ __forceinline__ void cvt_tile64(const float* W, int N, bf16_t* WT, int Kd, int k0, int n0, int drow0, int lane, const float* rs = nullptr) {
    const int g = lane >> 4, x = lane & 15;
    const float* src = W + (size_t)(k0 + 16 * g) * N + n0 + 4 * x;
    f32x4 v[16];
#pragma unroll
    for (int i = 0; i < 16; ++i) v[i] = __builtin_nontemporal_load((const f32x4*)(src + (size_t)i * N));
    if (rs) {
#pragma unroll
        for (int i = 0; i < 16; ++i) v[i] = v[i] * rs[k0 + 16 * g + i];
    }
    if constexpr (OUT8) {
#pragma unroll
        for (int j = 0; j < 4; ++j) { u32x4 w;
            w.x = cvt_pk_fp8x4(v[0][j] * 64.f, v[1][j] * 64.f, v[2][j] * 64.f, v[3][j] * 64.f); w.y = cvt_pk_fp8x4(v[4][j] * 64.f, v[5][j] * 64.f, v[6][j] * 64.f, v[7][j] * 64.f);
            w.z = cvt_pk_fp8x4(v[8][j] * 64.f, v[9][j] * 64.f, v[10][j] * 64.f, v[11][j] * 64.f); w.w = cvt_pk_fp8x4(v[12][j] * 64.f, v[13][j] * 64.f, v[14][j] * 64.f, v[15][j] * 64.f);
            const int c8 = 4 * x + j;
            const int dr8 = (MODE == 3 || MODE == 4) ? 32 * (c8 >> 4) + 8 * ((c8 >> 2) & 3) + 4 * (MODE - 3) + (c8 & 3) : (MODE == 1 ? 2 * (c8 & 31) + (c8 >> 5) : c8);
            *(u32x4*)((unsigned char*)WT + (size_t)(drow0 + dr8) * Kd + k0 + 16 * g) = w; }
        return; }
#pragma unroll
    for (int j = 0; j < 4; ++j) { u32x4 lo, hi;
        lo.x = cvt_pk_bf16(v[0][j], v[1][j]); lo.y = cvt_pk_bf16(v[2][j], v[3][j]); lo.z = cvt_pk_bf16(v[4][j], v[5][j]); lo.w = cvt_pk_bf16(v[6][j], v[7][j]);
        hi.x = cvt_pk_bf16(v[8][j], v[9][j]); hi.y = cvt_pk_bf16(v[10][j], v[11][j]); hi.z = cvt_pk_bf16(v[12][j], v[13][j]); hi.w = cvt_pk_bf16(v[14][j], v[15][j]);
        const int c = 4 * x + j;
        const int dr = MODE == 1 ? 2 * (c & 31) + (c >> 5) : (MODE == 2 ? (c < 16 ? 2 * (c & 7) + (c >> 3) : c) : c);
        bf16_t* d = WT + (size_t)(drow0 + dr) * Kd + k0 + 16 * g;
        *(u32x4*)d = lo; *(u32x4*)(d + 8) = hi; }
}

__global__ void __launch_bounds__(NWAVES * 64, 2) fwd(Args args) {
#define KARGS() const __attribute__((address_space(4))) unsigned long long* ka_ = (const __attribute__((address_space(4))) unsigned long long*)__builtin_amdgcn_kernarg_segment_ptr(); asm volatile("" : "+s"(ka_))
#define AIN(i) ((const void*)ka_[i])
#define AOUT ((float*)ka_[27])
#define AWS ((unsigned char*)ka_[28])
    extern __shared__ __attribute__((aligned(16))) unsigned char lds_raw[];
    LAS unsigned char* lds = (LAS unsigned char*)lds_raw;
    volatile LAS unsigned* MISC = (volatile LAS unsigned*)(lds + MISC_OFF);
    const int tid = threadIdx.x, wave = __builtin_amdgcn_readfirstlane(tid >> 6);
#define LANE_DECL int lane; asm volatile("v_and_b32 %0, 63, %1" : "=v"(lane) : "v"(threadIdx.x))
    const int G = gridDim.x, bx = blockIdx.x;
    unsigned* ctl = (unsigned*)(args.ws + WS_CTL);
    const int lo = args.ph_lo, hi_ph = args.ph_hi;
    if (tid < 32) MISC[tid] = 0u;
    __syncthreads();
    XcdBarrier bar; bar.bar = ctl + CW_BAR + args.li * XCD_BAR_WORDS; bar.x = 0; bar.st = nullptr;
    if (!MK_PER_PHASE) bar = xcd_barrier_post(ctl + CW_BAR + args.li * XCD_BAR_WORDS, MISC + 8);
#define IN(k) (((PH_MASK >> (k)) & 1) && lo <= (k) && (k) < hi_ph)
#define SEAM(k) do { if (IN(k) && IN((k) + 1)) xcd_barrier(bar); } while (0)
    const int gw = bx * NWAVES + wave, NGW = G * NWAVES;

#define xin ((const float*)AIN(0))
#define positions ((const int*)AIN(1))
#define Bt_in ((bf16_t*)(AWS + WS_BT_IN))
#define Bt_uq ((bf16_t*)(AWS + WS_BT_UQ))
#define Bt_ukv ((bf16_t*)(AWS + WS_BT_UKV))
#define Bt_od ((bf16_t*)(AWS + WS_BT_OD))
#define Bt_om ((bf16_t*)(AWS + WS_BT_OM))
#define Bt_out ((bf16_t*)(AWS + WS_BT_OUT))
#define ropeA ((float*)(AWS + WS_ROPEA))
#define ropeM ((float*)(AWS + WS_ROPEM))
#define sq ((float*)(AWS + WS_SQ2))
#define hbuf ((bf16_t*)(AWS + WS_H))
#define oa ((bf16_t*)(AWS + WS_H))
#define qa ((bf16_t*)(AWS + WS_QA))
#define ka ((bf16_t*)(AWS + WS_KA))
#define va ((bf16_t*)(AWS + WS_VA))
#define cq ((bf16_t*)(AWS + WS_CQ))
#define ckv ((bf16_t*)(AWS + WS_CKV))
#define kr ((bf16_t*)(AWS + WS_KR))
#define gates ((bf16_t*)(AWS + WS_GATES))
#define qm ((bf16_t*)(AWS + WS_QM))
#define kv ((bf16_t*)(AWS + WS_KV))
#define ob ((bf16_t*)(AWS + WS_OB))
#define mrg ((bf16_t*)(AWS + WS_MRG))
#define stash ((float*)(AWS + WS_STASH))
#define rowtok_p ((int*)(AWS + WS_ROWTOK))
#define assign ((u32x2*)(AWS + WS_ASSIGN))
#define Bt_d ((bf16_t*)(AWS + WS_BT_D))
#define Bt_gu ((bf16_t*)(AWS + WS_BT_GU))
#define h2 ((bf16_t*)(AWS + WS_H2))
#define act ((bf16_t*)(AWS + WS_ACT))
#define ybuf ((unsigned char*)(AWS + WS_Y))
#define q8p ((unsigned char*)(AWS + WS_Q8))
#define k8np ((unsigned char*)(AWS + WS_K8N))
#define k8rp ((unsigned char*)(AWS + WS_K8R))
#define v8p ((unsigned char*)(AWS + WS_V8))
#define q8lp ((unsigned char*)(AWS + WS_Q8L))
#define v8ap ((unsigned char*)(AWS + WS_V8A))
#define vt8ap ((unsigned char*)(AWS + WS_VT8A))
#define vt8p ((unsigned char*)(AWS + WS_VT8))
#define q8ap ((unsigned char*)(AWS + WS_Q8A))
#define k8ap ((unsigned char*)(AWS + WS_K8A))
#define x1b ((bf16_t*)(AWS + WS_X1B))
#define count ((unsigned*)(AWS + WS_CTL) + CW_COUNT)

    if (IN(0)) {
        KARGS();
        LANE_DECL;
        const float* w_in = (const float*)AIN(3); const float* g_q = (const float*)AIN(9); const float* g_kv = (const float*)AIN(10);
        const float* w_uq = (const float*)AIN(11); const float* w_ukv = (const float*)AIN(12);
        const float* w_od = (const float*)AIN(13); const float* w_om = (const float*)AIN(14); const float* w_out = (const float*)AIN(16);
        constexpr int I_IN = 16 * 101, I_PAD = 16 * 3, I_UQ = 12 * 24, I_UKV = 8 * 32, I_O = 16 * 16;
        constexpr int NITEMS = I_IN + I_PAD + I_UQ + I_UKV + 3 * I_O;
        for (int it = gw; it < NITEMS; it += NGW) {
            int r = it;
            if (r < I_IN) { const int kb = r / 101, cb = r % 101, n0 = cb * 64;
                if (n0 < 2048) cvt_tile64<2>(w_in, 6464, Bt_in, D, kb * 64, n0, n0, lane);
                else if (n0 < 4352) cvt_tile64<0>(w_in, 6464, Bt_in, D, kb * 64, n0, n0, lane);
                else if (n0 < 4416) cvt_tile64<1>(w_in, 6464, Bt_in, D, kb * 64, n0, 5888, lane);
                else if (n0 < 4416 + 1536) cvt_tile64<0>(w_in, 6464, Bt_in, D, kb * 64, n0, n0 - 64, lane);
                else cvt_tile64<0>(w_in, 6464, Bt_in, D, kb * 64, n0, n0 - 64 + 256, lane);
                continue; } r -= I_IN;
            if (r < I_PAD) { const int kb = r / 3, rb = r % 3; const int g = lane >> 4, x4 = lane & 15;
#pragma unroll
                for (int j = 0; j < 4; ++j) { bf16_t* d = Bt_in + (size_t)(5952 + rb * 64 + 4 * x4 + j) * D + kb * 64 + 16 * g; *(u32x4*)d = (u32x4){0u, 0u, 0u, 0u}; *(u32x4*)(d + 8) = (u32x4){0u, 0u, 0u, 0u}; }
                continue; } r -= I_PAD;
            if (r < I_UQ) { const int kb = r / 24, cb = r % 24, n0 = cb * 64;
                if (UP_F8) { if ((cb % 3) == 2) cvt_tile64<1, true>(w_uq, 1536, Bt_uq, QL, kb * 64, n0, n0, lane, g_q); else cvt_tile64<0, true>(w_uq, 1536, Bt_uq, QL, kb * 64, n0, n0, lane, g_q); }
                else if ((cb % 3) == 2) cvt_tile64<1>(w_uq, 1536, Bt_uq, QL, kb * 64, n0, n0, lane, g_q); else cvt_tile64<0>(w_uq, 1536, Bt_uq, QL, kb * 64, n0, n0, lane, g_q);
                continue; } r -= I_UQ;
            if (r < I_UKV) { const int kb = r / 32, cb = r % 32; if (UP_F8) cvt_tile64<0, true>(w_ukv, 2048, Bt_ukv, KVL, kb * 64, cb * 64, cb * 64, lane, g_kv); else cvt_tile64<0>(w_ukv, 2048, Bt_ukv, KVL, kb * 64, cb * 64, cb * 64, lane, g_kv); continue; } r -= I_UKV;
            const int which = r / I_O; r -= which * I_O; const int kb = r / 16, cb = r % 16;
            cvt_tile64<0>(which == 0 ? w_od : (which == 1 ? w_om : w_out), D, which == 0 ? Bt_od : (which == 1 ? Bt_om : Bt_out), D, kb * 64, cb * 64, cb * 64, lane);
        }
        const float* g_mix = (const float*)AIN(2);
        for (int m = gw * 4; m < T; m += NGW * 4) {
            f32x4 v[4][4]; float ss[4];
#pragma unroll
            for (int q = 0; q < 4; ++q) { const f32x4* xr = (const f32x4*)(xin + (size_t)(m + q) * D) + lane;
#pragma unroll
                for (int j = 0; j < 4; ++j) v[q][j] = xr[64 * j]; }
#pragma unroll
            for (int q = 0; q < 4; ++q) { float s = 0.f;
#pragma unroll
                for (int j = 0; j < 4; ++j) s += (v[q][j][0] * v[q][j][0] + v[q][j][1] * v[q][j][1]) + (v[q][j][2] * v[q][j][2] + v[q][j][3] * v[q][j][3]);
                ss[q] = __builtin_amdgcn_rsqf(wave_sum(s) * (1.f / D) + EPS); }
#pragma unroll
            for (int j = 0; j < 4; ++j) { const f32x4 gg = *((const f32x4*)g_mix + lane + 64 * j);
#pragma unroll
                for (int q = 0; q < 4; ++q) { u32x2 w; w.x = cvt_pk_bf16(v[q][j][0] * ss[q] * gg[0], v[q][j][1] * ss[q] * gg[1]); w.y = cvt_pk_bf16(v[q][j][2] * ss[q] * gg[2], v[q][j][3] * ss[q] * gg[3]);
                    ((u32x2*)(hbuf + (size_t)(m + q) * D) + lane)[64 * j] = w; } }
        }
        for (int idx = bx * 512 + tid; idx < T * 40; idx += G * 512) {
            const int t = idx / 40, i = idx % 40; const float inv = i < 8 ? c_invA[i] : c_invM[i - 8];
            const float ang = (float)positions[t] * inv;
            const double rev = (double)ang * 0.15915494309189535; const float fr_ = (float)(rev - __builtin_rint(rev));
            const float cs = __builtin_amdgcn_cosf(fr_), sn = __builtin_amdgcn_sinf(fr_);
            float* dst = i < 8 ? ropeA + ((size_t)t * 8 + i) * 2 : ropeM + ((size_t)t * 32 + (i - 8)) * 2; dst[0] = cs; dst[1] = sn;
        }
    }
    SEAM(0);
    if (IN(1)) {
        KARGS();
        pg8::Gemm g{hbuf, Bt_in, D}; pg8::DenseOrder S; S.init(T / 256, 24, G, bx);
        pg8::EpiIn E{qa, ka, va, cq, ckv, gates, kr, ropeA, ropeM, (const float*)AIN(15), sq, k8rp, q8ap, k8ap, v8ap, q8lp};
        pg8::gemm_phase<pg8::EpiIn, pg8::DenseOrder, false, true>(lds, g, S, E);
    }
    SEAM(1);
    if (IN(2)) {
        KARGS();
        { pg8::Gemm g{hbuf, Bt_in, D}; pg8::DenseOrder S; S.init(T / 256, 2, G, bx, 24);
          pg8::EpiIn E{qa, ka, va, cq, ckv, gates, kr, ropeA, ropeM, (const float*)AIN(15), sq, k8rp, q8ap, k8ap, v8ap, q8lp};
          pg8::gemm_phase<pg8::EpiIn, pg8::DenseOrder, false, true>(lds, g, S, E); }
#if UP_F8
        { pg8::Gemm g{cq, Bt_uq, QL / 2}; pg8::DenseOrder S; S.init(T / 256, 1536 / 128, G, G - 1 - bx); pg8::EpiUp8<true> E{qm, sq, ropeM, q8p};
          pg8::gemm_phase_f8p<pg8::EpiUp8<true>, pg8::DenseOrder>(lds, g, S, E); }
        { pg8::Gemm g{ckv, Bt_ukv, KVL / 2}; pg8::DenseOrder S; S.init(T / 256, 2048 / 128, G, bx); pg8::EpiUp8<false> E{kv, sq, ropeM, k8np, v8p};
          pg8::gemm_phase_f8p<pg8::EpiUp8<false>, pg8::DenseOrder>(lds, g, S, E); }
#else
        { pg8::Gemm g{cq, Bt_uq, QL}; pg8::DenseOrder S; S.init(T / 256, 1536 / 256, G, G - 1 - bx); pg8::EpiUp<true> E{qm, sq, ropeM, q8p};
          pg8::gemm_phase<pg8::EpiUp<true>, pg8::DenseOrder, false, true>(lds, g, S, E); }
        { pg8::Gemm g{ckv, Bt_ukv, KVL}; pg8::DenseOrder S; S.init(T / 256, 2048 / 256, G, bx); pg8::EpiUp<false> E{kv, sq, ropeM, k8np};
          pg8::gemm_phase<pg8::EpiUp<false>, pg8::DenseOrder, false, true>(lds, g, S, E); }
#endif
    }
    SEAM(2);
    if (IN(3)) {
        KARGS();
        const int wid = wave;
#if MLA_PV8
        { LAS unsigned char* tl = (LAS unsigned char*)lds;
          for (int tj = bx; tj < (DA_PV8 ? 2 : 1) * NB * 8 * (SEQ / 64); tj += G) {
              const int ti = tj & 2047; const bool da_ = tj >= 2048; const unsigned char* vsrc_ = da_ ? v8ap : v8p; unsigned char* vdst_ = da_ ? vt8ap : vt8p;
              const int b_ = ti >> 9, h_ = (ti >> 6) & 7, t_ = ti & 63;
              { const int key = tid >> 3, ch = tid & 7;
                *(LAS u32x4*)(tl + key * 128 + ch * 16) = *(const u32x4*)(vsrc_ + ((size_t)b_ * SEQ + t_ * 64 + key) * 1024 + h_ * 128 + ch * 16); }
              __syncthreads();
              { const int dim = tid >> 2, c = tid & 3; unsigned w[4];
#pragma unroll
                for (int q = 0; q < 4; ++q) { unsigned acc_ = 0;
#pragma unroll
                    for (int i = 0; i < 4; ++i) { const int pos = 16 * c + 4 * q + i, kg = pos >> 5, e = pos & 31, key = att::crow(e & 15, kg) + 32 * (e >> 4);
                        acc_ |= (unsigned)tl[key * 128 + dim] << (8 * i); }
                    w[q] = acc_; }
                *(u32x4*)(vdst_ + (((size_t)(b_ * 8 + h_) * 128 + dim) * SEQ + t_ * 64 + 16 * c)) = (u32x4){w[0], w[1], w[2], w[3]}; }
              __syncthreads();
          }
          if (IN(2) || true) xcd_barrier(bar); }
#endif
#define UNIT_DECODE(L) int u = (L) & 511; if (G == 256) { const int c = (L) & 255; u = ((L) & 256) + (c & 7) * 32 + (c >> 3); } \
            const int bh = u >> 4, qb = u & 15, b = bh >> 3, h = bh & 7; const size_t q0 = (size_t)b * SEQ + qb * 256, k0 = (size_t)b * SEQ
        for (int L = bx; L < 1024; L += G) {
#if PROBE_PHASE == 3 && defined(PROBE_ATT)
            if (args.li == 1 && lo == 3 && PROBE_ATT != 0) continue;
#endif
            int u = L; if (G == 256) { const int c = L & 255; u = (L & ~255) + (c & 7) * 32 + (c >> 3); }
            const int bh = u >> 5, qb = u & 31, b = bh >> 3, h = bh & 7; const size_t q0 = (size_t)b * SEQ + qb * 128, k0 = (size_t)b * SEQ;
            f32x16 o[4];
#if DA_PV8
            { att::SrcDP inp{q8ap + q0 * 1024 + h * 128, k8ap + k0 * 1024 + h * 128, va + k0 * 1024 + h * 128, vt8ap + (size_t)(b * 8 + h) * 128 * SEQ, 1024, q8lp + q0 * 1024 + h * 128};
              if (wid < 4) att::attn_core_plp<0, (DA_PV8 == 2)>(inp, 8.f * 1.4426950408889634f, SEQ, (LAS char*)lds, o, (PROBE_T == 2 && L == 0) ? (float*)((unsigned*)(AWS + WS_CTL) + CW_PROBE) : nullptr);
              else att::attn_core_plp<1, 1>(inp, 8.f * 1.4426950408889634f, SEQ, (LAS char*)lds, o, nullptr); }
#elif DA_QK8 == 2
            { att::SrcDH inh{qa + q0 * 1024 + h * 128, ka + k0 * 1024 + h * 128, q8ap + q0 * 1024 + h * 128, k8ap + k0 * 1024 + h * 128, va + k0 * 1024 + h * 128, 1024};
              if (wid < 4) att::attn_core_plh<0>(inh, 8.f * 1.4426950408889634f, SEQ, (LAS char*)lds, o, (PROBE_T == 2 && L == 0) ? (float*)((unsigned*)(AWS + WS_CTL) + CW_PROBE) : nullptr);
              else att::attn_core_plh<1>(inh, 8.f * 1.4426950408889634f, SEQ, (LAS char*)lds, o, nullptr); }
#elif DA_QK8
            { att::SrcD8 in8{q8ap + q0 * 1024 + h * 128, k8ap + k0 * 1024 + h * 128, va + k0 * 1024 + h * 128, 1024};
              att::attn_core_pl8(in8, 8.f * 1.4426950408889634f, SEQ, (LAS char*)lds, o, (PROBE_T == 2 && L == 0) ? (float*)((unsigned*)(AWS + WS_CTL) + CW_PROBE) : nullptr); }
#else
            { att::Src in{qa + q0 * 1024 + h * 128, ka + k0 * 1024 + h * 128, nullptr, va + k0 * 1024 + h * 128, 1024, 1024, 0, 1024};
              att::attn_core_pl<64, 2>(in, 0.125f * 1.4426950408889634f, 8.f * 1.4426950408889634f, SEQ, (LAS char*)lds, o, (PROBE_T && PROBE_T < 4 && L == 0) ? (float*)((unsigned*)(AWS + WS_CTL) + CW_PROBE) : nullptr); }
#endif
            int ln2; asm volatile("v_and_b32 %0, 63, %1" : "=v"(ln2) : "v"(threadIdx.x));
            LAS float* xch = (LAS float*)lds;
            if (wid >= 4) {
#pragma unroll
                for (int d = 0; d < 4; ++d)
#pragma unroll
                    for (int r = 0; r < 16; ++r) xch[((wid - 4) * 64 + d * 16 + r) * 64 + ln2] = o[d][r];
            }
            __syncthreads();
            if (wid < 4) {
            float lam;
            { const float* lq1 = (const float*)AIN(4); const float* lk1 = (const float*)AIN(5); const float* lq2 = (const float*)AIN(6); const float* lk2 = (const float*)AIN(7);
              const float s1 = wave_sum(lq1[ln2] * lk1[ln2]), s2 = wave_sum(lq2[ln2] * lk2[ln2]); lam = __expf(s1) - __expf(s2) + LAM_INIT; }
            float ss[16];
#pragma unroll
            for (int r = 0; r < 16; ++r) ss[r] = 0.f;
#pragma unroll
            for (int d = 0; d < 4; ++d)
#pragma unroll
                for (int r = 0; r < 16; ++r) { const float v = o[d][r] - lam * xch[(wid * 64 + d * 16 + r) * 64 + ln2]; o[d][r] = v; ss[r] += v * v; }
#pragma unroll
            for (int r = 0; r < 16; ++r) {
#pragma unroll
                for (int msk = 1; msk < 32; msk <<= 1) ss[r] += __shfl_xor(ss[r], msk);
                ss[r] = __builtin_amdgcn_rsqf(ss[r] * (1.0f / 128.0f) + EPS); }
            const int hi2 = ln2 >> 5, r32e = ln2 & 31;
            bf16_t* Ow = oa + (q0 + wid * 32 + 4 * hi2) * 1024 + h * 128 + r32e;
            float gs[4];
#pragma unroll
            for (int d = 0; d < 4; ++d) gs[d] = ((const float*)AIN(8))[d * 32 + r32e] * (1.0f - LAM_INIT);
#pragma unroll
            for (int r = 0; r < 16; ++r) { const int orow = att::crow(r, 0);
#pragma unroll
                for (int d = 0; d < 4; ++d) Ow[orow * 1024 + d * 32] = (bf16_t)(cvt_pk_bf16(o[d][r] * ss[r] * gs[d], 0.f) & 0xffffu); }
            }
            __syncthreads();
        }
        for (int L = 512 + bx; L < 1024; L += G) {
#if PROBE_PHASE == 3 && defined(PROBE_ATT)
            if (args.li == 1 && lo == 3 && PROBE_ATT != 1) continue;
#endif
            UNIT_DECODE(L);
            f32x16 o[4];
#if MLA_PV8
            { att::SrcM8 inm{q8p + q0 * 1536 + h * 192, k8np + k0 * 1024 + h * 128, k8rp + k0 * 64, vt8p + (size_t)(b * 8 + h) * 128 * SEQ};
              att::attn_core_mla8(inm, 8.0f, SEQ, (LAS char*)lds, o, (PROBE_T == 5 && L == 512) ? (float*)((unsigned*)(AWS + WS_CTL) + CW_PROBE) : nullptr); }
#elif MLA_QK8
            { att::Src8 in8{q8p + q0 * 1536 + h * 192, k8np + k0 * 1024 + h * 128, k8rp + k0 * 64, kv + k0 * 2048 + h * 256 + 128, 2048};
              att::attn_core_bp8(in8, 8.f * 1.4426950408889634f, SEQ, (LAS char*)lds, o, (PROBE_T == 5 && L == 512) ? (float*)((unsigned*)(AWS + WS_CTL) + CW_PROBE) : nullptr); }
#else
            { att::Src in{qm + q0 * 1536 + h * 192, kv + k0 * 2048 + h * 256, kr + k0 * 64, kv + k0 * 2048 + h * 256 + 128, 1536, 2048, 64, 2048};
              att::attn_core_bp<192, 1>(in, 8.f * 1.4426950408889634f, SEQ, (LAS char*)lds, o, (PROBE_T == 5 && L == 512) ? (float*)((unsigned*)(AWS + WS_CTL) + CW_PROBE) : nullptr); }
#endif
#if PROBE_T == 6
            const unsigned long long te0 = __builtin_amdgcn_s_memtime();
#endif
            int ln2; asm volatile("v_and_b32 %0, 63, %1" : "=v"(ln2) : "v"(threadIdx.x));
            const int hi2 = ln2 >> 5, r32e = ln2 & 31;
            bf16_t* Ow = ob + (q0 + wid * 32 + 4 * hi2) * 1024 + h * 128 + r32e;
#pragma unroll
            for (int r = 0; r < 16; ++r) { const int orow = att::crow(r, 0);
#pragma unroll
                for (int d = 0; d < 4; ++d) Ow[orow * 1024 + d * 32] = (bf16_t)(cvt_pk_bf16(o[d][r], 0.f) & 0xffffu); }
#if PROBE_T == 6
            asm volatile("s_waitcnt vmcnt(0)" ::: "memory");
            { const unsigned long long te1 = __builtin_amdgcn_s_memtime(); if (L == 512 && tid == 0) { float* pr = (float*)((unsigned*)(AWS + WS_CTL) + CW_PROBE); pr[0] = 0.f; pr[1] = (float)(te1 - te0) * 0.002f; } }
#endif
        }
#undef UNIT_DECODE
    }
    SEAM(3);
    if (IN(4)) {
        KARGS();
        { pg8::Gemm g{oa, Bt_od, D}; pg8::DenseOrder S; S.init(T / 256, 4, G, bx); pg8::EpiGate<0> E{mrg, gates};
          pg8::gemm_phase<pg8::EpiGate<0>, pg8::DenseOrder, false, true>(lds, g, S, E); }
        VM_WAIT(); __syncthreads();
        { pg8::Gemm g{ob, Bt_om, D}; pg8::DenseOrder S; S.init(T / 256, 4, G, bx); pg8::EpiGate<1> E{mrg, gates};
          pg8::gemm_phase<pg8::EpiGate<1>, pg8::DenseOrder, false, true>(lds, g, S, E); }
    }
    SEAM(4);
    if (IN(5)) {
        KARGS();
        pg8::Gemm g{mrg, Bt_out, D}; pg8::DenseOrder S; S.init(T / 256, 4, G, bx); pg8::EpiRes E{xin, x1b};
        pg8::gemm_phase<pg8::EpiRes, pg8::DenseOrder, false, true>(lds, g, S, E);
    }
    SEAM(5);
    if (IN(6)) {
        KARGS();
        LANE_DECL;
        const float* g_ffn = (const float*)AIN(17); const float* w_router = (const float*)AIN(18); const float* b_router = (const float*)AIN(19);
        constexpr int WRS = 1028;
        LAS float* wr_l = (LAS float*)lds;
        LAS int* lcount = (LAS int*)(lds + TAB_OFF + 1024); LAS int* gbase = lcount + 32; LAS unsigned* asg_e = (LAS unsigned*)(lcount + 64); LAS float* asg_w = (LAS float*)(lcount + 64 + 256);
        LAS int* sync_w = (LAS int*)(lds + TAB_OFF + 512);
        for (int i = tid; i < D * NEXP; i += 512) wr_l[(i & 31) * WRS + (i >> 5)] = w_router[i];
        if (tid < 32) lcount[tid] = 0;
        if (tid < 2) sync_w[tid] = 0;
        __syncthreads();
        const int ex = (lane >> 1) & 31;
        LAS float* lg = (LAS float*)(lds + TAB_OFF + 4096) + wave * 80;
        const int chunk = bx;
        if (wave < 4 && chunk < T / 64) {
            const float my_b = b_router[ex];
#pragma unroll 1
            for (int j2 = 0; j2 < 8; ++j2) {
                const int tl = wave * 16 + j2 * 2, t = chunk * 64 + tl;
                f32x4 xva[4], xvb[4]; float sa = 0.f, sb = 0.f;
                { const u32x2* xa = (const u32x2*)(x1b + (size_t)t * D) + lane; const u32x2* xb = xa + D / 4;
#pragma unroll
                  for (int j = 0; j < 4; ++j) { const u32x2 wa = xa[64 * j], wb = xb[64 * j]; xva[j] = (f32x4){bf_lo(wa.x), bf_hi(wa.x), bf_lo(wa.y), bf_hi(wa.y)}; xvb[j] = (f32x4){bf_lo(wb.x), bf_hi(wb.x), bf_lo(wb.y), bf_hi(wb.y)}; }
#pragma unroll
                  for (int j = 0; j < 4; ++j) { sa += (xva[j][0] * xva[j][0] + xva[j][1] * xva[j][1]) + (xva[j][2] * xva[j][2] + xva[j][3] * xva[j][3]); sb += (xvb[j][0] * xvb[j][0] + xvb[j][1] * xvb[j][1]) + (xvb[j][2] * xvb[j][2] + xvb[j][3] * xvb[j][3]); } }
                const float ra = __builtin_amdgcn_rsqf(wave_sum(sa) * (1.f / D) + EPS), rb = __builtin_amdgcn_rsqf(wave_sum(sb) * (1.f / D) + EPS);
                { unsigned* oa8 = (unsigned*)((unsigned char*)h2 + (size_t)t * D) + lane; unsigned* ob8 = oa8 + D / 4;
#pragma unroll
                  for (int j = 0; j < 4; ++j) { const f32x4 gg = *((const f32x4*)g_ffn + lane + 64 * j); xva[j] = xva[j] * ra * gg; xvb[j] = xvb[j] * rb * gg;
                    oa8[64 * j] = cvt_pk_fp8x4(xva[j][0], xva[j][1], xva[j][2], xva[j][3]); ob8[64 * j] = cvt_pk_fp8x4(xvb[j][0], xvb[j][1], xvb[j][2], xvb[j][3]); } }
                float aa[32], ab[32];
#pragma unroll
                for (int e = 0; e < NEXP; ++e) { float a = 0.f, b = 0.f;
#pragma unroll
                    for (int j = 0; j < 4; ++j) { const f32x4 w4 = *(const LAS f32x4*)(wr_l + e * WRS + 4 * lane + 256 * j);
                        a += (xva[j][0] * w4[0] + xva[j][1] * w4[1]) + (xva[j][2] * w4[2] + xva[j][3] * w4[3]); b += (xvb[j][0] * w4[0] + xvb[j][1] * w4[1]) + (xvb[j][2] * w4[2] + xvb[j][3] * w4[3]); }
                    aa[e] = a; ab[e] = b; }
#define TRED(arr, n, msk) _Pragma("unroll") for (int i_ = 0; i_ < (n); ++i_) { const bool up_ = (lane & (msk)) != 0; const float keep_ = up_ ? arr[(n) + i_] : arr[i_], give_ = up_ ? arr[i_] : arr[(n) + i_]; arr[i_] = keep_ + __shfl_xor(give_, (msk)); }
                TRED(aa, 16, 32) TRED(aa, 8, 16) TRED(aa, 4, 8) TRED(aa, 2, 4) TRED(aa, 1, 2)
                TRED(ab, 16, 32) TRED(ab, 8, 16) TRED(ab, 4, 8) TRED(ab, 2, 4) TRED(ab, 1, 2)
#undef TRED
                const float la = aa[0] + __shfl_xor(aa[0], 1) + my_b, lb = ab[0] + __shfl_xor(ab[0], 1) + my_b;
#pragma unroll
                for (int tk = 0; tk < 2; ++tk) {
                    const float v = tk ? lb : la; int rank = 0;
                    if (!(lane & 1)) lg[tk * 32 + ex] = v;
                    LDS_WAIT();
#pragma unroll
                    for (int q = 0; q < 8; ++q) { const f32x4 s4 = *(const LAS f32x4*)(lg + tk * 32 + 4 * q);
#pragma unroll
                        for (int jj = 0; jj < 4; ++jj) rank += (s4[jj] > v || (s4[jj] == v && (4 * q + jj) < ex)) ? 1 : 0; }
                    if (rank < 4 && !(lane & 1)) lg[64 + tk * 4 + rank] = v;
                    LDS_WAIT();
                    const f32x4 tv = *(const LAS f32x4*)(lg + 64 + tk * 4);
                    const float p1 = __expf(tv[1] - tv[0]), p2 = __expf(tv[2] - tv[0]), p3 = __expf(tv[3] - tv[0]), inv = 1.0f / (1.0f + p1 + p2 + p3);
                    if (rank < 4 && !(lane & 1)) { const float w = (rank == 0 ? 1.0f : (rank == 1 ? p1 : (rank == 2 ? p2 : p3))) * inv;
                        const int lr = __hip_atomic_fetch_add((LAS int*)&lcount[ex], 1, __ATOMIC_RELAXED, __HIP_MEMORY_SCOPE_WORKGROUP);
                        asg_e[(tl + tk) * 4 + rank] = ((unsigned)ex << 16) | (unsigned)lr; asg_w[(tl + tk) * 4 + rank] = w; }
                }
            }
            LDS_WAIT();
            if (lane == 0) __hip_atomic_fetch_add((LAS int*)&sync_w[0], 1, __ATOMIC_RELAXED, __HIP_MEMORY_SCOPE_WORKGROUP);
            if (wave == 0) {
                while (__hip_atomic_load((LAS int*)&sync_w[0], __ATOMIC_RELAXED, __HIP_MEMORY_SCOPE_WORKGROUP) < 4) __builtin_amdgcn_s_sleep(4);
                asm volatile("s_waitcnt lgkmcnt(0)" ::: "memory");
                if (lane < 32) gbase[lane] = (int)__hip_atomic_fetch_add(count + lane, (unsigned)lcount[lane], __ATOMIC_RELAXED, __HIP_MEMORY_SCOPE_AGENT);
                LDS_WAIT();
#pragma unroll
                for (int q = 0; q < 4; ++q) { const int a_ = q * 64 + lane; const unsigned ae = asg_e[a_]; const int e = ae >> 16, rank = gbase[e] + (int)(ae & 0xffffu); const int t = chunk * 64 + (a_ >> 2);
                    rowtok_p[e * T + rank] = t; u32x2 av; av.x = ((unsigned)e << 16) | (unsigned)rank; av.y = __float_as_uint(asg_w[a_]); assign[(size_t)t * 4 + (a_ & 3)] = av; }
            }
        }
        const float* w_gate = (const float*)AIN(20); const float* w_up = (const float*)AIN(22); const float* w_down = (const float*)AIN(24);
        const int per_wg = (NEXP * 768 + G - 1) / G;
        for (;;) {
            int it = 0; if (lane == 0) it = __hip_atomic_fetch_add((LAS int*)&sync_w[1], 1, __ATOMIC_RELAXED, __HIP_MEMORY_SCOPE_WORKGROUP);
            it = __builtin_amdgcn_readfirstlane(it); const int item = bx * per_wg + it;
            if (it >= per_wg || item >= NEXP * 768) break;
            const int e = item / 768, r = item % 768, mat = r >> 8, kb = (r >> 4) & 15, nb = r & 15, f0 = nb * 64;
            if (mat == 0) cvt_tile64<3, true>(w_gate + (size_t)e * D * FF, FF, (bf16_t*)((unsigned char*)Bt_gu + (size_t)e * 2048 * D), D, kb * 64, f0, 2 * f0, lane);
            else if (mat == 1) cvt_tile64<4, true>(w_up + (size_t)e * D * FF, FF, (bf16_t*)((unsigned char*)Bt_gu + (size_t)e * 2048 * D), D, kb * 64, f0, 2 * f0, lane);
            else cvt_tile64<0, true>(w_down + (size_t)e * FF * D, D, (bf16_t*)((unsigned char*)Bt_d + (size_t)e * D * FF), FF, kb * 64, f0, f0, lane);
        }
    }
    SEAM(6);
    LAS int* t_cnt = (LAS int*)(lds + TAB_OFF + 4096); LAS int* t_start = t_cnt + 32; LAS int* t_t2e = t_start + 40;
    if (IN(7) || IN(8) || IN(9)) {
        KARGS();
        __syncthreads();
        if (tid < 32) t_cnt[tid] = (int)__hip_atomic_load(count + tid, __ATOMIC_RELAXED, __HIP_MEMORY_SCOPE_AGENT);
        __syncthreads();
        if (tid == 0) { int s = 0; for (int e = 0; e < NEXP; ++e) { t_start[e] = s; s += (t_cnt[e] + 255) >> 8; } t_start[32] = s; }
        __syncthreads();
        if (tid < 32) { for (int rt = t_start[tid]; rt < t_start[tid + 1]; ++rt) t_t2e[rt] = tid; }
        __syncthreads();
    }
    if (IN(7)) {
        KARGS();
        pg8::Gemm g{h2, Bt_gu, D / 2}; pg8::MoeOrder S; S.init(__builtin_amdgcn_readfirstlane(t_start[32]), 16, G, bx); S.t2e = t_t2e; S.tstart = t_start; S.cnt = t_cnt; S.rowtok = rowtok_p;
        pg8::EpiSwiglu8 E{(unsigned char*)act, (const float*)AIN(21), (const float*)AIN(23)};
        pg8::gemm_phase_f8p<pg8::EpiSwiglu8, pg8::MoeOrder, true>(lds, g, S, E);
    }
    SEAM(7);
    if (IN(8)) {
        KARGS();
        pg8::Gemm g{act, Bt_d, FF / 2}; pg8::MoeOrder S; S.init(__builtin_amdgcn_readfirstlane(t_start[32]), 8, G, bx); S.t2e = t_t2e; S.tstart = t_start; S.cnt = t_cnt; S.rowtok = rowtok_p;
        pg8::EpiDown8 E{ybuf, (const float*)AIN(25)};
        pg8::gemm_phase_f8p<pg8::EpiDown8, pg8::MoeOrder>(lds, g, S, E);
    }
    SEAM(8);
    if (IN(9) && DBG_OUT) {
        KARGS();
        const bf16_t* src = DBG_OUT == 1 ? gates : DBG_OUT == 2 ? gates + 1024 : DBG_OUT == 3 ? qa : DBG_OUT == 4 ? ka : DBG_OUT == 5 ? va : DBG_OUT == 6 ? mrg : DBG_OUT == 7 ? oa : DBG_OUT == 9 ? Bt_in : ob;
        const int ld = DBG_OUT <= 2 ? 2048 : 1024;
        for (size_t i = (size_t)bx * 512 + tid; i < (size_t)T * 1024; i += (size_t)G * 512) AOUT[i] = (DBG_OUT == 9 && i >= (size_t)N_IN * 1024) ? 0.f : __uint_as_float((unsigned)src[(i >> 10) * ld + (i & 1023)] << 16);
    } else
    if (IN(9)) {
        KARGS();
        LANE_DECL;
        const float* g_fin = (const float*)AIN(26);
        for (int t0 = gw * 2; t0 < T; t0 += NGW * 2) {
            f32x4 v[2][4]; u32x2 as_[2][4];
#pragma unroll
            for (int q = 0; q < 2; ++q) { const u32x2* xr = (const u32x2*)(x1b + (size_t)(t0 + q) * D) + lane;
#pragma unroll
                for (int j = 0; j < 4; ++j) { const u32x2 w = xr[64 * j]; v[q][j] = (f32x4){bf_lo(w.x), bf_hi(w.x), bf_lo(w.y), bf_hi(w.y)}; }
#pragma unroll
                for (int k = 0; k < 4; ++k) as_[q][k] = assign[(size_t)(t0 + q) * 4 + k]; }
            unsigned yw[2][4][4];
#pragma unroll
            for (int q = 0; q < 2; ++q)
#pragma unroll
                for (int k = 0; k < 4; ++k) { const int e = as_[q][k].x >> 16, rank = as_[q][k].x & 0xffffu;
                    const unsigned* yr = (const unsigned*)(ybuf + ((size_t)t_start[e] * 256 + rank) * D) + lane;
#pragma unroll
                    for (int j = 0; j < 4; ++j) yw[q][k][j] = yr[64 * j]; }
#pragma unroll
            for (int q = 0; q < 2; ++q) {
#pragma unroll
                for (int k = 0; k < 4; ++k) { const float w = (DBG_SKIP & 1) ? 0.f : __uint_as_float(as_[q][k].y) * (1.0f / YS);
#pragma unroll
                    for (int j = 0; j < 4; ++j) { const int y = (int)yw[q][k][j]; const auto lo = __builtin_amdgcn_cvt_pk_f32_fp8(y, false), hi = __builtin_amdgcn_cvt_pk_f32_fp8(y, true);
                        v[q][j][0] += w * lo[0]; v[q][j][1] += w * lo[1]; v[q][j][2] += w * hi[0]; v[q][j][3] += w * hi[1]; } }
                float s = 0.f;
#pragma unroll
                for (int j = 0; j < 4; ++j) s += (v[q][j][0] * v[q][j][0] + v[q][j][1] * v[q][j][1]) + (v[q][j][2] * v[q][j][2] + v[q][j][3] * v[q][j][3]);
                const float rstd = __builtin_amdgcn_rsqf(wave_sum(s) * (1.f / D) + EPS);
                f32x4* xo = (f32x4*)(AOUT + (size_t)(t0 + q) * D) + lane;
#pragma unroll
                for (int j = 0; j < 4; ++j) { const f32x4 gg = *((const f32x4*)g_fin + lane + 64 * j); f32x4 ov = v[q][j] * rstd * gg;
#if PROBE_T
                    { const float e1 = __builtin_sqrtf(__uint_as_float(xb_ld((unsigned*)(AWS + WS_CTL) + CW_PROBE))), e2 = __uint_as_float(xb_ld((unsigned*)(AWS + WS_CTL) + CW_PROBE + 1));
                      ov[0] *= 1.f + e1; ov[1] *= 1.f - e1; ov[2] *= 1.f + e1; ov[3] *= 1.f - e1; if (t0 + q == 0 && j == 0 && lane == 0) ov[0] += e2; }
#endif
                    xo[64 * j] = ov; } }
        }
    }
#undef IN
#undef SEAM
#undef KARGS
#undef AIN
#undef AOUT
#undef AWS
#undef xin
#undef positions
#undef Bt_in
#undef Bt_uq
#undef Bt_ukv
#undef Bt_od
#undef Bt_om
#undef Bt_out
#undef ropeA
#undef ropeM
#undef sq
#undef hbuf
#undef oa
#undef qa
#undef ka
#undef va
#undef cq
#undef ckv
#undef kr
#undef gates
#undef qm
#undef kv
#undef ob
#undef mrg
#undef stash
#undef rowtok_p
#undef assign
#undef Bt_d
#undef Bt_gu
#undef h2
#undef act
#undef ybuf
#undef q8p
#undef k8np
#undef k8rp
#undef v8p
#undef q8lp
#undef v8ap
#undef vt8ap
#undef vt8p
#undef q8ap
#undef k8ap
#undef x1b
#undef count
}

extern "C" void kernel_launch(void* const* d_in, const int* in_sizes, int n_in, void* d_out, int out_size, void* d_ws, size_t ws_size, hipStream_t stream) {
    static int grid = 0;
    if (grid == 0) {
        if (n_in != 27 || in_sizes[0] != T * D || out_size != T * D || ws_size < WS_END) { fprintf(stderr, "kernel_launch: unexpected shapes (n_in %d, in0 %d, out %d, ws %zu < %zu)\n", n_in, n_in > 0 ? in_sizes[0] : -1, out_size, ws_size, (size_t)WS_END); grid = -1; return; }
        int dev = 0, cus = 0, per_cu = 0;
        if (hipGetDevice(&dev) != hipSuccess || hipDeviceGetAttribute(&cus, hipDeviceAttributeMultiprocessorCount, dev) != hipSuccess) { grid = -1; return; }
        if (hipFuncSetAttribute((const void*)fwd, hipFuncAttributeMaxDynamicSharedMemorySize, LDS_BYTES) != hipSuccess) { fprintf(stderr, "kernel_launch: hipFuncSetAttribute failed\n"); grid = -1; return; }
        if (hipOccupancyMaxActiveBlocksPerMultiprocessor(&per_cu, (const void*)fwd, NWAVES * 64, LDS_BYTES) != hipSuccess || per_cu < 1) fprintf(stderr, "kernel_launch: occupancy query says %d\n", per_cu);
        (void)hipGetLastError();
        grid = cus;
    }
    if (grid < 0) return;
    if (hipMemsetAsync((char*)d_ws + WS_CTL, 0, CTL_ZERO_BYTES, stream) != hipSuccess) return;
    Args a{};
    for (int i = 0; i < 27; ++i) a.in[i] = d_in[i];
    a.out = (float*)d_out; a.ws = (unsigned char*)d_ws;
#if MK_PER_PHASE
    for (int p = 0; p < NPHASE; ++p) { a.ph_lo = p; a.ph_hi = p + 1; hipLaunchKernelGGL(fwd, dim3(grid), dim3(NWAVES * 64), LDS_BYTES, stream, a); }
#elif PROBE_PHASE >= 0
    a.ph_lo = 0; a.ph_hi = PROBE_PHASE + 1; a.li = 0; hipLaunchKernelGGL(fwd, dim3(grid), dim3(NWAVES * 64), LDS_BYTES, stream, a);
    a.ph_lo = PROBE_PHASE; a.ph_hi = NPHASE; a.li = 1; hipLaunchKernelGGL(fwd, dim3(grid), dim3(NWAVES * 64), LDS_BYTES, stream, a);
#else
    a.ph_lo = 0; a.ph_hi = NPHASE; hipLaunchKernelGGL(fwd, dim3(grid), dim3(NWAVES * 64), LDS_BYTES, stream, a);
#endif
}
```

```cpp
#include <hip/hip_runtime.h>
#include <cstdio>
#include <cstdint>

#ifndef MK_PER_PHASE
#define MK_PER_PHASE 0
#endif

#ifndef PROBE_PHASE
#define PROBE_PHASE -1
#endif
#ifndef ATT_DUP
#ifndef DMA_SPREAD
#define DMA_SPREAD 1
#endif
#ifndef PROBE_DMA2
#define PROBE_DMA2 0
#endif
#ifndef MLA_QK8
#define MLA_QK8 1
#endif
#ifndef DA_QK8
#define DA_QK8 1
#endif
#ifndef UP_F8
#define UP_F8 1
#endif
#ifndef MLA_PV8
#define MLA_PV8 1
#endif
#ifndef DA_PV8
#define DA_PV8 2
#endif
#ifndef DA_QLO
#define DA_QLO 0
#endif
#ifndef BP_VLA
#define BP_VLA 3
#endif
#ifndef BP_KLA
#define BP_KLA 2
#endif
#ifndef PROBE_BASE
#define PROBE_BASE 1000.f
#endif
#ifndef PROBE_T
#define PROBE_T 0
#endif
#define ATT_DUP 0
#endif
#ifndef DBG_OUT
#define DBG_OUT 0
#endif
#ifndef DBG_SKIP
#define DBG_SKIP 0
#endif
#ifndef ATT_MASK
#define ATT_MASK 3
#endif
#ifndef PH_MASK
#define PH_MASK 0x3ff
#endif
#define LAS __attribute__((address_space(3)))
#define GAS __attribute__((address_space(1)))
typedef unsigned short bf16_t;
typedef short bf16x8 __attribute__((ext_vector_type(8)));
typedef short s16x4 __attribute__((ext_vector_type(4)));
typedef float f32x2 __attribute__((ext_vector_type(2)));
typedef float f32x4 __attribute__((ext_vector_type(4)));
typedef float f32x16 __attribute__((ext_vector_type(16)));
typedef unsigned u32x2 __attribute__((ext_vector_type(2)));
typedef unsigned u32x4 __attribute__((ext_vector_type(4)));

constexpr int NB = 4, SEQ = 4096, T = NB * SEQ, D = 1024;
constexpr int NEXP = 32, TOPK = 4, FF = 1024;
constexpr int N_IN = 6656;
constexpr int QL = 768, KVL = 512;
constexpr float EPS = 1e-6f;
constexpr float LAM_INIT = 0.2f;
constexpr int NPHASE = 10;

constexpr size_t MiB = 1u << 20;
constexpr size_t WS_CTL = 0, CTL_ZERO_BYTES = 1 * MiB;
constexpr size_t WS_BT_IN = 2 * MiB;
constexpr size_t WS_BT_UQ = 15 * MiB;
constexpr size_t WS_BT_UKV = 18 * MiB;
constexpr size_t WS_BT_OD = 20 * MiB, WS_BT_OM = 22 * MiB, WS_BT_OUT = 24 * MiB;
constexpr size_t WS_ROPEA = 26 * MiB;
constexpr size_t WS_ROPEM = 27 * MiB;
constexpr size_t WS_SQ = 31 * MiB;
constexpr size_t WS_SQP = 1 * MiB;
constexpr size_t WS_H = 32 * MiB;
constexpr size_t WS_QA = 64 * MiB, WS_KA = 96 * MiB, WS_VA = 128 * MiB;
constexpr size_t WS_X1B = 168 * MiB;
constexpr size_t WS_CQ = 160 * MiB, WS_CKV = 184 * MiB, WS_KR = 200 * MiB;
constexpr size_t WS_SQ2 = 202 * MiB;
constexpr size_t WS_GATES = 208 * MiB;
constexpr size_t WS_QM = 272 * MiB;
constexpr size_t WS_Q8 = 448 * MiB;
constexpr size_t WS_K8N = 472 * MiB;
constexpr size_t WS_Q8A = 416 * MiB;
constexpr size_t WS_K8A = 432 * MiB;
constexpr size_t WS_V8 = 304 * MiB;
constexpr size_t WS_VT8 = 320 * MiB;
constexpr size_t WS_V8A = 336 * MiB;
constexpr size_t WS_VT8A = 352 * MiB;
constexpr size_t WS_Q8L = 368 * MiB;
constexpr size_t WS_K8R = 488 * MiB;
constexpr size_t WS_KV = 320 * MiB;
constexpr size_t WS_OB = 384 * MiB;
constexpr size_t WS_MRG = 416 * MiB;
constexpr size_t WS_STASH = 448 * MiB;
constexpr size_t WS_ROWTOK = 2 * MiB;
constexpr size_t WS_ASSIGN = 4 * MiB;
constexpr size_t WS_BT_D = 32 * MiB;
constexpr size_t WS_BT_GU = 96 * MiB;
constexpr size_t WS_H2 = 224 * MiB;
constexpr size_t WS_ACT = 256 * MiB;
constexpr size_t WS_Y = 96 * MiB;
constexpr size_t WS_END = 512 * MiB;
constexpr int CW_COUNT = 64;
constexpr int CW_BAR = 4096;
constexpr int CW_PROBE = 128;

constexpr int RING_BYTES = 147456;
constexpr int TAB_OFF = RING_BYTES;
constexpr int TAB_BYTES = 8192;
constexpr int MISC_OFF = TAB_OFF + TAB_BYTES;
constexpr int LDS_BYTES = 157696;

typedef __bf16 bf16x2_t __attribute__((ext_vector_type(2)));
__device__ __forceinline__ unsigned cvt_pk_bf16(float lo, float hi) { const f32x2 v = {lo, hi}; return __builtin_bit_cast(unsigned, __builtin_convertvector(v, bf16x2_t)); }
__device__ __forceinline__ float bf_lo(unsigned w) { return __uint_as_float(w << 16); }
__device__ __forceinline__ float bf_hi(unsigned w) { return __uint_as_float(w & 0xffff0000u); }
__device__ __forceinline__ float wave_sum(float v) {
#pragma unroll
    for (int o = 1; o < 64; o <<= 1) v += __shfl_xor(v, o);
    return v;
}
__device__ __forceinline__ float sigmoidf_(float x) { return __builtin_amdgcn_rcpf(1.0f + __builtin_amdgcn_exp2f(-1.4426950408889634f * x)); }
__device__ __forceinline__ unsigned cvt_pk_fp8x4(float a, float b, float c, float d) {
    a = fminf(fmaxf(a, -448.f), 448.f); b = fminf(fmaxf(b, -448.f), 448.f); c = fminf(fmaxf(c, -448.f), 448.f); d = fminf(fmaxf(d, -448.f), 448.f);
    int r = __builtin_amdgcn_cvt_pk_fp8_f32(a, b, 0, false); r = __builtin_amdgcn_cvt_pk_fp8_f32(c, d, r, true); return (unsigned)r; }
#define LDS_WAIT() asm volatile("s_waitcnt lgkmcnt(0)" ::: "memory")
#define VM_WAIT() asm volatile("s_waitcnt vmcnt(0)" ::: "memory")

#define XB_TMO      128
#define XB_XCNT(j)  (256  + 64 * (j))
#define XB_XSUB(j)  (1280 + 64 * (j))
#define XB_XGEN(j)  (2304 + 64 * (j))
#define XB_TOP      3328
#define XB_TOPGEN   3392
#define XCD_BAR_WORDS 3456
#define XB_SPIN_CAP (1u << 20)
__device__ __forceinline__ unsigned xb_ld(unsigned* p)              { return __hip_atomic_load(p, __ATOMIC_RELAXED, __HIP_MEMORY_SCOPE_AGENT); }
__device__ __forceinline__ unsigned xb_add(unsigned* p, unsigned v) { return __hip_atomic_fetch_add(p, v, __ATOMIC_RELAXED, __HIP_MEMORY_SCOPE_AGENT); }
__device__ __forceinline__ unsigned xb_xcc_id() { return (unsigned)__builtin_amdgcn_s_getreg((3 << 11) | 20) & 0xFu; }
#define XB_SPIN(cond, bar) do { unsigned _sp = 0; while (cond) { __builtin_amdgcn_s_sleep(1); \
    if ((++_sp & 255u) == 0u) { if (xb_ld(&(bar)[XB_TMO])) break; if (_sp > XB_SPIN_CAP) { atomicAdd(&(bar)[XB_TMO], 1u); break; } } } } while (0)
struct XcdBarrier { unsigned* bar; unsigned x; volatile LAS unsigned* st; };
__device__ __forceinline__ XcdBarrier xcd_barrier_post(unsigned* bar, volatile LAS unsigned* st) {
    XcdBarrier b; b.bar = bar; b.x = xb_xcc_id(); b.st = st;
    if (threadIdx.x == 0) (void)xb_add(&bar[XB_XCNT(b.x)], 1u);
    return b;
}
__device__ __forceinline__ void xcd_barrier_complete(unsigned* bar, unsigned x, unsigned& nloc, unsigned& nx) {
    const unsigned G = gridDim.x * gridDim.y * gridDim.z;
    unsigned sum, cnt, mine, sp = 0u;
    for (;;) {
        sum = 0u; cnt = 0u; mine = 0u;
#pragma unroll
        for (unsigned j = 0; j < 16; ++j) { const unsigned c = xb_ld(&bar[XB_XCNT(j)]); sum += c; cnt += (c > 0u) ? 1u : 0u; mine = (j == x) ? c : mine; }
        if (sum == G) break;
        __builtin_amdgcn_s_sleep(1);
        if ((++sp & 255u) == 0u) { if (xb_ld(&bar[XB_TMO])) break; if (sp > XB_SPIN_CAP) { atomicAdd(&bar[XB_TMO], 1u); break; } }
    }
    nloc = mine > 0u ? mine : 1u; nx = cnt > 0u ? cnt : 1u;
}
__device__ __forceinline__ void xcd_barrier(const XcdBarrier& b) {
    asm volatile("s_waitcnt vmcnt(0)" ::: "memory");
    __syncthreads();
    if (threadIdx.x == 0) {
        unsigned* bar = b.bar;
        __builtin_amdgcn_s_waitcnt(0);
        unsigned nloc = b.st[0], nx = b.st[1];
        if (nloc == 0u) { xcd_barrier_complete(bar, b.x, nloc, nx); b.st[0] = nloc; b.st[1] = nx; }
        const unsigned old = xb_add(&bar[XB_XSUB(b.x)], 1u);
        const unsigned gen = old / nloc;
        if (old + 1u == (gen + 1u) * nloc) {
            __builtin_amdgcn_fence(__ATOMIC_RELEASE, "agent");
            asm volatile("s_waitcnt vmcnt(0)" ::: "memory");
            const unsigned og = xb_add(&bar[XB_TOP], 1u);
            const unsigned tg = og / nx;
            if (og + 1u == (tg + 1u) * nx) xb_add(&bar[XB_TOPGEN], 1u);
            else XB_SPIN(xb_ld(&bar[XB_TOPGEN]) == tg, bar);
            __builtin_amdgcn_fence(__ATOMIC_ACQUIRE, "agent");
            xb_add(&bar[XB_XGEN(b.x)], 1u);
            asm volatile("s_waitcnt vmcnt(0)" ::: "memory");
        } else {
            XB_SPIN(xb_ld(&bar[XB_XGEN(b.x)]) == gen, bar);
            __builtin_amdgcn_fence(__ATOMIC_ACQUIRE, "agent");
            asm volatile("s_waitcnt vmcnt(0)" ::: "memory");
        }
    }
    __syncthreads();
}

constexpr float YS = 16.0f;
constexpr float QS_MLA = 0.07216878364870322f * 1.4426950408889634f;
constexpr float QS_DA = 0.125f * 1.4426950408889634f;
namespace pg8 {
constexpr int BM = 256, BK = 64, HALF = 128, HTB = HALF * BK * 2, STAGE_BYTES = 8 * HTB, NXCD = 8, WGM = 8;
__host__ __device__ __forceinline__ int lds_byte(int r, int c) { const int st = (r >> 4) * 2 + (c >> 5), rr = r & 15, cc = c & 31, ob = rr * 64 + cc * 2; return st * 1024 + (ob ^ (((ob >> 9) & 1) << 5)); }
__host__ __device__ __forceinline__ void stage_rc(int b, int& R, int& C) { const int st = b / 1024, sb = b % 1024, swz = sb ^ (((sb >> 9) & 1) << 5); R = (st >> 1) * 16 + swz / 64; C = (st & 1) * 32 + (swz % 64) / 2; }
__host__ __device__ __forceinline__ int perm32(int rho) { const int n = rho >> 4, i = rho & 15; return 8 * (i >> 2) + 4 * n + (i & 3); }

struct Unit { int pm, pn, pb, e, rbase, cnt; };
struct Gemm { const bf16_t* A; const bf16_t* Bt; int K; };

struct DenseOrder {
    int nM, nN, nwg, G, c, pn0;
    __device__ void init(int nM_, int nN_, int G_, int c_, int pn0_ = 0) { nM = nM_; nN = nN_; nwg = nM * nN; G = G_; c = c_; pn0 = pn0_; }
    __device__ __forceinline__ bool next(int i, Unit& u) const {
        const long L = (long)i * G + c; if (L >= nwg) return false;
        int wgid = (int)L; { const int q = nwg / NXCD, r = nwg % NXCD, xcd = wgid % NXCD, off = wgid / NXCD; wgid = (xcd < r ? xcd * (q + 1) : r * (q + 1) + (xcd - r) * q) + off; }
        const int nig = WGM * nN, gid = wgid / nig, fm = gid * WGM, gsz = (nM - fm) < WGM ? (nM - fm) : WGM;
        u.pm = fm + ((wgid % nig) % gsz); u.pn = pn0 + (wgid % nig) / gsz; u.pb = u.pn; u.e = 0; u.rbase = 0; u.cnt = 0; return true;
    }
    __device__ __forceinline__ int a_row(const Unit&, int) const { return 0; }
};
struct MoeOrder {
    int nM, nN, nwg, G, c; const LAS int* t2e; const LAS int* tstart; const LAS int* cnt; const int* rowtok;
    __device__ void init(int nM_, int nN_, int G_, int c_) { nM = nM_; nN = nN_; nwg = nM * nN; G = G_; c = c_; }
    __device__ __forceinline__ bool next(int i, Unit& u) const {
        const long L = (long)i * G + c; if (L >= nwg) return false;
        int wgid = (int)L; { const int q = nwg / NXCD, r = nwg % NXCD, xcd = wgid % NXCD, off = wgid / NXCD; wgid = (xcd < r ? xcd * (q + 1) : r * (q + 1) + (xcd - r) * q) + off; }
        const int nig = WGM * nN, gid = wgid / nig, fm = gid * WGM, gsz = (nM - fm) < WGM ? (nM - fm) : WGM;
        u.pm = fm + ((wgid % nig) % gsz); u.pn = (wgid % nig) / gsz;
        const int e = __builtin_amdgcn_readfirstlane(t2e[u.pm]); u.e = e; u.pb = e * nN + u.pn; u.rbase = (u.pm - __builtin_amdgcn_readfirstlane(tstart[e])) * 256; u.cnt = __builtin_amdgcn_readfirstlane(cnt[e]); return true;
    }
    __device__ __forceinline__ int a_row(const Unit& u, int r) const { const int rank = u.rbase + r; return rank < u.cnt ? rowtok[u.e * T + rank] : 0; }
};

template <class Epi, class Sched, bool GATHER, bool ALIGN_EPI>
__device__ __forceinline__ void gemm_phase(LAS unsigned char* lds, const Gemm g, const Sched& S, const Epi& E) {
    const int tid = threadIdx.x, wid = __builtin_amdgcn_readfirstlane(tid >> 6), lane = tid & 63, wr = wid >> 2, wc = wid & 3, fr = lane & 15, fq = lane >> 4;
    const int K = g.K, nt = K / BK;
    unsigned voffA[2], voffB[2]; int Rv[2], Cv[2];
#pragma unroll
    for (int i = 0; i < 2; ++i) { int R, C; stage_rc(tid * 16 + i * 8192, R, C); const int Rb = Epi::PERM ? ((R & ~31) + perm32(R & 31)) : R;
        voffA[i] = (unsigned)(R * K + C) * 2u; voffB[i] = (unsigned)(Rb * K + C) * 2u; Rv[i] = R; Cv[i] = C; }
    const size_t kstep = (size_t)(BK * 2);
    const size_t hstep = (size_t)HALF * K * 2;
    const size_t tstep = 2 * hstep;
    const unsigned ldsw = (unsigned)wid * 1024u;
    const int aoff = lds_byte(wr * 64 + fr, fq * 8), boff = lds_byte(wc * 32 + fr, fq * 8);
#define PG8_SA(b, h) (((b) * 2 + (h)) * HTB)
#define PG8_SB(b, h) ((4 + (b) * 2 + (h)) * HTB)
#define PG8_STAGE(bufoff, gbase, voff) do { _Pragma("unroll") for (int _i = 0; _i < 2; ++_i) \
        __builtin_amdgcn_global_load_lds((const unsigned*)((const char*)(gbase) + (voff)[_i]), (LAS unsigned*)(lds + (bufoff) + ldsw + _i * 8192), 16, 0, 0); } while (0)
#define PG8_LDA(dst, b, h) do { _Pragma("unroll") for (int m = 0; m < 4; ++m) _Pragma("unroll") for (int k = 0; k < 2; ++k) dst[m][k] = *(const LAS bf16x8*)(lds + PG8_SA(b, h) + aoff + m * 2048 + k * 1024); } while (0)
#define PG8_LDB(dst, b, h) do { _Pragma("unroll") for (int n = 0; n < 2; ++n) _Pragma("unroll") for (int k = 0; k < 2; ++k) dst[n][k] = *(const LAS bf16x8*)(lds + PG8_SB(b, h) + boff + n * 2048 + k * 1024); } while (0)
#define PG8_MMA(ai, bj, At, Bt) do { __builtin_amdgcn_s_setprio(1); _Pragma("unroll") for (int m = 0; m < 4; ++m) _Pragma("unroll") for (int n = 0; n < 2; ++n) _Pragma("unroll") for (int k = 0; k < 2; ++k) \
        acc[ai][bj][m][n] = __builtin_amdgcn_mfma_f32_16x16x32_bf16(Bt[n][k], At[m][k], acc[ai][bj][m][n], 0, 0, 0); __builtin_amdgcn_s_setprio(0); } while (0)
#define PG8_WAIT_V(n) asm volatile("s_waitcnt vmcnt(" #n ")" ::: "memory")
#define PG8_WAIT_L(n) asm volatile("s_waitcnt lgkmcnt(" #n ")" ::: "memory")
#define PG8_BAR __builtin_amdgcn_s_barrier()
#define PG8_SCHED __builtin_amdgcn_sched_barrier(0)
    Unit cur, nxt; int ui = 0;
    if (!S.next(0, cur)) return;
    f32x4 acc[2][2][4][2];
#pragma unroll
    for (int a = 0; a < 2; ++a)
#pragma unroll
        for (int b = 0; b < 2; ++b)
#pragma unroll
            for (int m = 0; m < 4; ++m)
#pragma unroll
                for (int n = 0; n < 2; ++n) acc[a][b][m][n] = (f32x4){0.f, 0.f, 0.f, 0.f};
    bf16x8 At[4][2], B0[2][2], B1[2][2];
    unsigned gC0[2], gC1[2], gN0[2], gN1[2];
    if constexpr (GATHER) {
#pragma unroll
        for (int i = 0; i < 2; ++i) { gC0[i] = (unsigned)S.a_row(cur, Rv[i]) * (unsigned)(K * 2) + (unsigned)Cv[i] * 2u; gC1[i] = (unsigned)S.a_row(cur, HALF + Rv[i]) * (unsigned)(K * 2) + (unsigned)Cv[i] * 2u; gN0[i] = gC0[i]; gN1[i] = gC1[i]; }
    }
    const char* cA = GATHER ? (const char*)g.A : (const char*)g.A + (size_t)cur.pm * tstep; const char* cB = (const char*)g.Bt + (size_t)cur.pb * tstep;
#define PG8_STAGE_A(bufoff, p, h, o0, o1) do { if constexpr (GATHER) { if ((h) == 0) PG8_STAGE(bufoff, p, o0); else PG8_STAGE(bufoff, p, o1); } else { PG8_STAGE(bufoff, (p) + (h) * hstep, voffA); } } while (0)
    PG8_STAGE(PG8_SB(0, 0), cB, voffB); PG8_STAGE(PG8_SB(0, 1), cB + hstep, voffB); PG8_STAGE_A(PG8_SA(0, 0), cA, 0, gC0, gC1); PG8_STAGE_A(PG8_SA(0, 1), cA, 1, gC0, gC1);
    if (wr == 1) PG8_BAR;
    PG8_WAIT_V(2); PG8_BAR;
    PG8_STAGE(PG8_SB(1, 0), cB + kstep, voffB); PG8_STAGE_A(PG8_SA(1, 0), cA + kstep, 0, gC0, gC1); PG8_STAGE(PG8_SB(1, 1), cB + hstep + kstep, voffB);
    PG8_WAIT_V(6); PG8_BAR;
    for (;;) {
        const bool has_next = S.next(ui + 1, nxt);
        const char* nA = GATHER ? (const char*)g.A : (has_next ? (const char*)g.A + (size_t)nxt.pm * tstep : cA); const char* nB = has_next ? (const char*)g.Bt + (size_t)nxt.pb * tstep : cB;
        if constexpr (GATHER) { if (has_next) {
#pragma unroll
            for (int i = 0; i < 2; ++i) { gN0[i] = (unsigned)S.a_row(nxt, Rv[i]) * (unsigned)(K * 2) + (unsigned)Cv[i] * 2u; gN1[i] = (unsigned)S.a_row(nxt, HALF + Rv[i]) * (unsigned)(K * 2) + (unsigned)Cv[i] * 2u; } } }
        for (int t = 0; t < nt; t += 2) {
            const bool last = (t == nt - 2);
            const char* a1 = cA + (size_t)(t + 1) * kstep;
            const char* a2 = last ? nA : cA + (size_t)(t + 2) * kstep; const char* b2 = last ? nB : cB + (size_t)(t + 2) * kstep;
            const char* a3 = a2 + kstep; const char* b3 = b2 + kstep;
            unsigned s0[2], s1[2];
            if constexpr (GATHER) { s0[0] = last ? gN0[0] : gC0[0]; s0[1] = last ? gN0[1] : gC0[1]; s1[0] = last ? gN1[0] : gC1[0]; s1[1] = last ? gN1[1] : gC1[1]; }
            PG8_LDB(B0, 0, 0); PG8_LDB(B1, 0, 1); PG8_SCHED; PG8_LDA(At, 0, 0); PG8_STAGE_A(PG8_SA(1, 1), a1, 1, gC0, gC1);
            PG8_WAIT_V(8); PG8_WAIT_L(0); PG8_BAR; PG8_MMA(0, 0, At, B0); PG8_MMA(0, 1, At, B1); PG8_BAR; PG8_SCHED;
            PG8_LDA(At, 0, 1); PG8_STAGE(PG8_SB(0, 0), b2, voffB); PG8_STAGE(PG8_SB(0, 1), b2 + hstep, voffB); PG8_STAGE_A(PG8_SA(0, 0), a2, 0, s0, s1);
            PG8_WAIT_V(8); PG8_WAIT_L(0); PG8_BAR; PG8_MMA(1, 0, At, B0); PG8_MMA(1, 1, At, B1); PG8_BAR; PG8_SCHED;
            PG8_LDB(B0, 1, 0); PG8_LDB(B1, 1, 1); PG8_SCHED; PG8_LDA(At, 1, 0); PG8_STAGE_A(PG8_SA(0, 1), a2, 1, s0, s1);
            PG8_WAIT_V(8); PG8_WAIT_L(0); PG8_BAR; PG8_MMA(0, 0, At, B0); PG8_MMA(0, 1, At, B1); PG8_BAR; PG8_SCHED;
            PG8_LDA(At, 1, 1); PG8_STAGE(PG8_SB(1, 0), b3, voffB); PG8_STAGE(PG8_SB(1, 1), b3 + hstep, voffB); PG8_STAGE_A(PG8_SA(1, 0), a3, 0, s0, s1);
            PG8_WAIT_V(8); PG8_WAIT_L(0); PG8_BAR; PG8_MMA(1, 0, At, B0); PG8_MMA(1, 1, At, B1); PG8_BAR; PG8_SCHED;
        }
        if constexpr (ALIGN_EPI) { if (wr == 0) PG8_BAR; }
        E(acc, cur, wr, wc, fr, fq);
        if (!has_next) break;
#pragma unroll
        for (int a = 0; a < 2; ++a)
#pragma unroll
            for (int b = 0; b < 2; ++b)
#pragma unroll
                for (int m = 0; m < 4; ++m)
#pragma unroll
                    for (int n = 0; n < 2; ++n) acc[a][b][m][n] = (f32x4){0.f, 0.f, 0.f, 0.f};
        cur = nxt; cA = nA; cB = nB; ++ui;
        if constexpr (GATHER) { gC0[0] = gN0[0]; gC0[1] = gN0[1]; gC1[0] = gN1[0]; gC1[1] = gN1[1]; }
        if constexpr (ALIGN_EPI) { if (wr == 1) PG8_BAR; }
    }
    PG8_WAIT_V(0);
    if constexpr (!ALIGN_EPI) { if (wr == 0) PG8_BAR; }
    PG8_BAR;
#undef PG8_SA
#undef PG8_SB
#undef PG8_STAGE
#undef PG8_STAGE_A
#undef PG8_LDA
#undef PG8_LDB
#undef PG8_MMA
#undef PG8_WAIT_V
#undef PG8_WAIT_L
#undef PG8_BAR
#undef PG8_SCHED
}

template <class Epi, class Sched, bool GATHER = false>
__device__ __forceinline__ void gemm_phase_f8n(LAS unsigned char* lds, const Gemm g, const Sched& S, const Epi& E) {
    const int tid = threadIdx.x, wid = __builtin_amdgcn_readfirstlane(tid >> 6), lane = tid & 63, wr = wid >> 2, wc = wid & 3, fr = lane & 15, fq = lane >> 4;
    const int K = g.K, nt = K / BK;
    unsigned voffA[2], voffB[2]; int Rv[2], Cv[2];
#pragma unroll
    for (int i = 0; i < 2; ++i) { int R, C; stage_rc(tid * 16 + i * 8192, R, C); const int Rb = (R & ~31) + perm32(R & 31);
        voffA[i] = (unsigned)(R * K + C) * 2u; voffB[i] = (unsigned)(Rb * K + C) * 2u; Rv[i] = R; Cv[i] = C; }
    const size_t kstep = (size_t)(BK * 2), hstep = (size_t)HALF * K * 2, tstep = 2 * hstep;
    const unsigned ldsw = (unsigned)wid * 1024u;
    const int aoff = lds_byte(wr * 64 + fr, fq * 8), boff = lds_byte(wc * 32 + fr, fq * 8);
    typedef int v8i_t __attribute__((ext_vector_type(8))); typedef int v4i_t __attribute__((ext_vector_type(4)));
#define F8_SA(b, h) (((b) * 2 + (h)) * HTB)
#define F8_SB(b) ((4 + (b) * 2) * HTB)
#define F8_STAGE(bufoff, gbase, voff) do { _Pragma("unroll") for (int _i = 0; _i < 2; ++_i) \
        __builtin_amdgcn_global_load_lds((const unsigned*)((const char*)(gbase) + (voff)[_i]), (LAS unsigned*)(lds + (bufoff) + ldsw + _i * 8192), 16, 0, 0); } while (0)
#define F8_LDA(b, h) do { _Pragma("unroll") for (int m = 0; m < 4; ++m) _Pragma("unroll") for (int k = 0; k < 2; ++k) At[m][k] = *(const LAS bf16x8*)(lds + F8_SA(b, h) + aoff + m * 2048 + k * 1024); } while (0)
#define F8_LDB(b) do { _Pragma("unroll") for (int n = 0; n < 2; ++n) _Pragma("unroll") for (int k = 0; k < 2; ++k) B0[n][k] = *(const LAS bf16x8*)(lds + F8_SB(b) + boff + n * 2048 + k * 1024); } while (0)
#define F8_CAT(x0, x1) __builtin_shufflevector(__builtin_bit_cast(v4i_t, x0), __builtin_bit_cast(v4i_t, x1), 0, 1, 2, 3, 4, 5, 6, 7)
#define F8_MMA(ai) do { __builtin_amdgcn_s_setprio(1); _Pragma("unroll") for (int m = 0; m < 4; ++m) _Pragma("unroll") for (int n = 0; n < 2; ++n) \
        acc[ai][m][n] = __builtin_amdgcn_mfma_scale_f32_16x16x128_f8f6f4(F8_CAT(B0[n][0], B0[n][1]), F8_CAT(At[m][0], At[m][1]), acc[ai][m][n], 0, 0, 0, 0x79797979, 0, 0x7f7f7f7f); \
        __builtin_amdgcn_s_setprio(0); } while (0)
#define F8_WAIT_V(n) asm volatile("s_waitcnt vmcnt(" #n ")" ::: "memory")
#define F8_WAIT_L(n) asm volatile("s_waitcnt lgkmcnt(" #n ")" ::: "memory")
#define F8_BAR __builtin_amdgcn_s_barrier()
#define F8_SCHED __builtin_amdgcn_sched_barrier(0)
    Unit cur, nxt; int ui = 0;
    if (!S.next(0, cur)) return;
    f32x4 acc[2][4][2];
#pragma unroll
    for (int a = 0; a < 2; ++a)
#pragma unroll
        for (int m = 0; m < 4; ++m)
#pragma unroll
            for (int n = 0; n < 2; ++n) acc[a][m][n] = (f32x4){0.f, 0.f, 0.f, 0.f};
    bf16x8 At[4][2], B0[2][2];
    unsigned gC0[2], gC1[2], gN0[2], gN1[2];
    if constexpr (GATHER) {
#pragma unroll
        for (int i = 0; i < 2; ++i) { gC0[i] = (unsigned)S.a_row(cur, Rv[i]) * (unsigned)(K * 2) + (unsigned)Cv[i] * 2u; gC1[i] = (unsigned)S.a_row(cur, HALF + Rv[i]) * (unsigned)(K * 2) + (unsigned)Cv[i] * 2u; gN0[i] = gC0[i]; gN1[i] = gC1[i]; }
    }
    const char* cA = GATHER ? (const char*)g.A : (const char*)g.A + (size_t)cur.pm * tstep; const char* cB = (const char*)g.Bt + (size_t)cur.pb * hstep;
#define F8_STAGE_A(bufoff, p, h, o0, o1) do { if constexpr (GATHER) { if ((h) == 0) F8_STAGE(bufoff, p, o0); else F8_STAGE(bufoff, p, o1); } else { F8_STAGE(bufoff, (p) + (h) * hstep, voffA); } } while (0)
    F8_STAGE(F8_SB(0), cB, voffB); F8_STAGE_A(F8_SA(0, 0), cA, 0, gC0, gC1); F8_STAGE_A(F8_SA(0, 1), cA, 1, gC0, gC1);
    if (wr == 1) F8_BAR;
    F8_WAIT_V(2); F8_BAR;
    F8_STAGE(F8_SB(1), cB + kstep, voffB); F8_STAGE_A(F8_SA(1, 0), cA + kstep, 0, gC0, gC1);
    F8_WAIT_V(4); F8_BAR;
    for (;;) {
        const bool has_next = S.next(ui + 1, nxt);
        const char* nA = GATHER ? (const char*)g.A : (has_next ? (const char*)g.A + (size_t)nxt.pm * tstep : cA); const char* nB = has_next ? (const char*)g.Bt + (size_t)nxt.pb * hstep : cB;
        if constexpr (GATHER) { if (has_next) {
#pragma unroll
            for (int i = 0; i < 2; ++i) { gN0[i] = (unsigned)S.a_row(nxt, Rv[i]) * (unsigned)(K * 2) + (unsigned)Cv[i] * 2u; gN1[i] = (unsigned)S.a_row(nxt, HALF + Rv[i]) * (unsigned)(K * 2) + (unsigned)Cv[i] * 2u; } } }
#pragma unroll 1
        for (int t = 0; t < nt; t += 2) {
            const bool last = (t == nt - 2);
            const char* a1 = cA + (size_t)(t + 1) * kstep;
            const char* a2 = last ? nA : cA + (size_t)(t + 2) * kstep; const char* b2 = last ? nB : cB + (size_t)(t + 2) * kstep;
            const char* a3 = a2 + kstep; const char* b3 = b2 + kstep;
            unsigned s0[2], s1[2];
            if constexpr (GATHER) { s0[0] = last ? gN0[0] : gC0[0]; s0[1] = last ? gN0[1] : gC0[1]; s1[0] = last ? gN1[0] : gC1[0]; s1[1] = last ? gN1[1] : gC1[1]; }
            F8_LDB(0); F8_SCHED; F8_LDA(0, 0); F8_STAGE_A(F8_SA(1, 1), a1, 1, gC0, gC1);
            F8_WAIT_V(6); F8_WAIT_L(0); F8_BAR; F8_MMA(0); F8_BAR; F8_SCHED;
            F8_LDA(0, 1); F8_STAGE(F8_SB(0), b2, voffB); F8_STAGE_A(F8_SA(0, 0), a2, 0, s0, s1);
            F8_WAIT_V(6); F8_WAIT_L(0); F8_BAR; F8_MMA(1); F8_BAR; F8_SCHED;
            F8_LDB(1); F8_SCHED; F8_LDA(1, 0); F8_STAGE_A(F8_SA(0, 1), a2, 1, s0, s1);
            F8_WAIT_V(6); F8_WAIT_L(0); F8_BAR; F8_MMA(0); F8_BAR; F8_SCHED;
            F8_LDA(1, 1); F8_STAGE(F8_SB(1), b3, voffB); F8_STAGE_A(F8_SA(1, 0), a3, 0, s0, s1);
            F8_WAIT_V(6); F8_WAIT_L(0); F8_BAR; F8_MMA(1); F8_BAR; F8_SCHED;
        }
        if (wr == 0) F8_BAR;
        E(acc, cur, wr, wc, fr, fq);
        if (!has_next) break;
#pragma unroll
        for (int a = 0; a < 2; ++a)
#pragma unroll
            for (int m = 0; m < 4; ++m)
#pragma unroll
                for (int n = 0; n < 2; ++n) acc[a][m][n] = (f32x4){0.f, 0.f, 0.f, 0.f};
        cur = nxt; cA = nA; cB = nB; ++ui;
        if constexpr (GATHER) { gC0[0] = gN0[0]; gC0[1] = gN0[1]; gC1[0] = gN1[0]; gC1[1] = gN1[1]; }
        if (wr == 1) F8_BAR;
    }
    F8_WAIT_V(0);
    F8_BAR;
#undef F8_SA
#undef F8_SB
#undef F8_STAGE
#undef F8_LDA
#undef F8_LDB
#undef F8_CAT
#undef F8_MMA
#undef F8_WAIT_V
#undef F8_WAIT_L
#undef F8_BAR
#undef F8_SCHED
#undef F8_STAGE_A
}
template <int I> struct SIC { static constexpr int value = I; };
template <int LO, int HI, class F> __device__ __forceinline__ void ssfor(F&& f) { if constexpr (LO < HI) { f(SIC<LO>{}); ssfor<LO + 1, HI>(f); } }
template <class Epi, class Sched, bool GATHER = false>
__device__ __forceinline__ void gemm_phase_f8p(LAS unsigned char* lds, const Gemm g, const Sched& S, const Epi& E) {
    const int tid = threadIdx.x, wid = __builtin_amdgcn_readfirstlane(tid >> 6), lane = tid & 63, wr = wid >> 2, wc = wid & 3, fr = lane & 15, fq = lane >> 4;
    const int K = g.K, nt = K / BK;
    unsigned voffA[2], voffB[2]; int Rv[2], Cv[2];
#pragma unroll
    for (int i = 0; i < 2; ++i) { int R, C; stage_rc(tid * 16 + i * 8192, R, C); const int Rb = (R & ~31) + perm32(R & 31);
        voffA[i] = (unsigned)(R * K + C) * 2u; voffB[i] = (unsigned)(Rb * K + C) * 2u; Rv[i] = R; Cv[i] = C; }
    const size_t kstep = (size_t)(BK * 2), hstep = (size_t)HALF * K * 2, tstep = 2 * hstep;
    const unsigned ldsw = (unsigned)wid * 1024u;
    const int aoff = lds_byte(wr * 64 + fr, fq * 8), boff = lds_byte(wc * 32 + fr, fq * 8);
    constexpr int STG = 3 * HTB;
    typedef int v8i_t __attribute__((ext_vector_type(8))); typedef int v4i_t __attribute__((ext_vector_type(4)));
#define P8_CAT(x0, x1) __builtin_shufflevector(__builtin_bit_cast(v4i_t, x0), __builtin_bit_cast(v4i_t, x1), 0, 1, 2, 3, 4, 5, 6, 7)
#define P8_GLDS(src, dstoff) __builtin_amdgcn_global_load_lds((const unsigned*)(src), (LAS unsigned*)(lds + (dstoff)), 16, 0, 0)
#define P8_PIECE(p, pa, pb, o0, o1, st) do { constexpr int i_ = (p) & 1; \
        if constexpr ((p) < 2)      { if constexpr (GATHER) P8_GLDS((pa) + (o0)[i_], (st) * STG + ldsw + i_ * 8192); else P8_GLDS((pa) + voffA[i_], (st) * STG + ldsw + i_ * 8192); } \
        else if constexpr ((p) < 4) { if constexpr (GATHER) P8_GLDS((pa) + (o1)[i_], (st) * STG + HTB + ldsw + i_ * 8192); else P8_GLDS((pa) + hstep + voffA[i_], (st) * STG + HTB + ldsw + i_ * 8192); } \
        else                        P8_GLDS((pb) + voffB[i_], (st) * STG + 2 * HTB + ldsw + i_ * 8192); } while (0)
#define P8_WAIT_V(n) asm volatile("s_waitcnt vmcnt(" #n ")" ::: "memory")
#define P8_BAR do { asm volatile("" ::: "memory"); __builtin_amdgcn_s_barrier(); asm volatile("" ::: "memory"); } while (0)
#define P8_SCHED __builtin_amdgcn_sched_barrier(0)
    Unit cur, nxt; int ui = 0;
    if (!S.next(0, cur)) return;
    f32x4 acc[2][4][2];
#pragma unroll
    for (int a = 0; a < 2; ++a)
#pragma unroll
        for (int m = 0; m < 4; ++m)
#pragma unroll
            for (int n = 0; n < 2; ++n) acc[a][m][n] = (f32x4){0.f, 0.f, 0.f, 0.f};
    bf16x8 AX[4][2], AY[4][2], BX[2][2], BY[2][2];
    unsigned gC0[2], gC1[2], gN0[2], gN1[2];
    if constexpr (GATHER) {
#pragma unroll
        for (int i = 0; i < 2; ++i) { gC0[i] = (unsigned)S.a_row(cur, Rv[i]) * (unsigned)(K * 2) + (unsigned)Cv[i] * 2u; gC1[i] = (unsigned)S.a_row(cur, HALF + Rv[i]) * (unsigned)(K * 2) + (unsigned)Cv[i] * 2u; gN0[i] = gC0[i]; gN1[i] = gC1[i]; }
    }
    const char* cA = GATHER ? (const char*)g.A : (const char*)g.A + (size_t)cur.pm * tstep; const char* cB = (const char*)g.Bt + (size_t)cur.pb * hstep;
#define P8_SP(AI, Acur, Anxt, Bcur, Bnxt, RDB, sr, hr, P0, qa, qb, q0, q1, sd) do { \
        ssfor<0, 8>([&](auto gc) __attribute__((always_inline)) { constexpr int g_ = decltype(gc)::value, m_ = g_ >> 1, n_ = g_ & 1; \
            acc[AI][m_][n_] = __builtin_amdgcn_mfma_scale_f32_16x16x128_f8f6f4(P8_CAT(Bcur[n_][0], Bcur[n_][1]), P8_CAT(Acur[m_][0], Acur[m_][1]), acc[AI][m_][n_], 0, 0, 0, 0x79797979, 0, 0x7f7f7f7f); \
            if constexpr (g_ == 0) P8_SCHED;     \
            Anxt[m_][n_] = *(const LAS bf16x8*)(lds + (sr) * STG + (hr) * HTB + aoff + m_ * 2048 + n_ * 1024); \
            if constexpr ((RDB) && g_ < 4) Bnxt[m_][n_] = *(const LAS bf16x8*)(lds + (sr) * STG + 2 * HTB + boff + m_ * 2048 + n_ * 1024); \
            if constexpr (g_ == 1) P8_PIECE((P0) + 0, qa, qb, q0, q1, sd); \
            if constexpr (g_ == 3) P8_PIECE((P0) + 1, qa, qb, q0, q1, sd); \
            if constexpr (g_ == 5) P8_PIECE((P0) + 2, qa, qb, q0, q1, sd); \
            P8_SCHED; }); } while (0)
    { const char* pa_ = cA; const char* pb_ = cB;
      P8_PIECE(0, pa_, pb_, gC0, gC1, 0); P8_PIECE(1, pa_, pb_, gC0, gC1, 0); P8_PIECE(2, pa_, pb_, gC0, gC1, 0); P8_PIECE(3, pa_, pb_, gC0, gC1, 0); P8_PIECE(4, pa_, pb_, gC0, gC1, 0); P8_PIECE(5, pa_, pb_, gC0, gC1, 0);
      pa_ += kstep; pb_ += kstep;
      P8_PIECE(0, pa_, pb_, gC0, gC1, 1); P8_PIECE(1, pa_, pb_, gC0, gC1, 1); P8_PIECE(2, pa_, pb_, gC0, gC1, 1); P8_PIECE(3, pa_, pb_, gC0, gC1, 1); P8_PIECE(4, pa_, pb_, gC0, gC1, 1); P8_PIECE(5, pa_, pb_, gC0, gC1, 1);
      pa_ += kstep; pb_ += kstep;
      P8_PIECE(0, pa_, pb_, gC0, gC1, 2); P8_PIECE(1, pa_, pb_, gC0, gC1, 2); P8_PIECE(2, pa_, pb_, gC0, gC1, 2); }
    P8_WAIT_V(9); P8_BAR;
#pragma unroll
    for (int m = 0; m < 4; ++m)
#pragma unroll
        for (int k = 0; k < 2; ++k) AX[m][k] = *(const LAS bf16x8*)(lds + aoff + m * 2048 + k * 1024);
#pragma unroll
    for (int n = 0; n < 2; ++n)
#pragma unroll
        for (int k = 0; k < 2; ++k) BX[n][k] = *(const LAS bf16x8*)(lds + 2 * HTB + boff + n * 2048 + k * 1024);
    int sa = 0;
    for (;;) {
        const bool has_next = S.next(ui + 1, nxt);
        const char* nA = GATHER ? (const char*)g.A : (has_next ? (const char*)g.A + (size_t)nxt.pm * tstep : cA); const char* nB = has_next ? (const char*)g.Bt + (size_t)nxt.pb * hstep : cB;
        if constexpr (GATHER) { if (has_next) {
#pragma unroll
            for (int i = 0; i < 2; ++i) { gN0[i] = (unsigned)S.a_row(nxt, Rv[i]) * (unsigned)(K * 2) + (unsigned)Cv[i] * 2u; gN1[i] = (unsigned)S.a_row(nxt, HALF + Rv[i]) * (unsigned)(K * 2) + (unsigned)Cv[i] * 2u; } } }
#pragma unroll 1
        for (int t = 0; t < nt; t += 2) {
            const int sb = sa == 2 ? 0 : sa + 1, sc = sb == 2 ? 0 : sb + 1;
            const bool x2 = t + 2 >= nt, x3 = t + 3 >= nt, x4 = t + 4 >= nt;
            const char* a2 = x2 ? nA + (size_t)(t + 2 - nt) * kstep : cA + (size_t)(t + 2) * kstep; const char* b2 = x2 ? nB + (size_t)(t + 2 - nt) * kstep : cB + (size_t)(t + 2) * kstep;
            const char* a3 = x3 ? nA + (size_t)(t + 3 - nt) * kstep : cA + (size_t)(t + 3) * kstep; const char* b3 = x3 ? nB + (size_t)(t + 3 - nt) * kstep : cB + (size_t)(t + 3) * kstep;
            const char* a4 = x4 ? nA + (size_t)(t + 4 - nt) * kstep : cA + (size_t)(t + 4) * kstep; const char* b4 = x4 ? nB + (size_t)(t + 4 - nt) * kstep : cB + (size_t)(t + 4) * kstep;
            unsigned q20[2], q21[2], q30[2], q31[2], q40[2], q41[2];
            if constexpr (GATHER) {
#pragma unroll
                for (int i = 0; i < 2; ++i) { q20[i] = x2 ? gN0[i] : gC0[i]; q21[i] = x2 ? gN1[i] : gC1[i]; q30[i] = x3 ? gN0[i] : gC0[i]; q31[i] = x3 ? gN1[i] : gC1[i]; q40[i] = x4 ? gN0[i] : gC0[i]; q41[i] = x4 ? gN1[i] : gC1[i]; } }
            P8_SP(0, AX, AY, BX, BY, false, sa, 1, 3, a2, b2, q20, q21, sc);
            P8_WAIT_V(6); asm volatile("s_waitcnt lgkmcnt(0)" ::: "memory"); P8_BAR;
            P8_SP(1, AY, AX, BX, BY, true, sb, 0, 0, a3, b3, q30, q31, sa);
            P8_SP(0, AX, AY, BY, BX, false, sb, 1, 3, a3, b3, q30, q31, sa);
            P8_WAIT_V(6); asm volatile("s_waitcnt lgkmcnt(0)" ::: "memory"); P8_BAR;
            P8_SP(1, AY, AX, BY, BX, true, sc, 0, 0, a4, b4, q40, q41, sb);
            sa = sc;
        }
        E(acc, cur, wr, wc, fr, fq);
        if (!has_next) break;
#pragma unroll
        for (int a = 0; a < 2; ++a)
#pragma unroll
            for (int m = 0; m < 4; ++m)
#pragma unroll
                for (int n = 0; n < 2; ++n) acc[a][m][n] = (f32x4){0.f, 0.f, 0.f, 0.f};
        cur = nxt; cA = nA; cB = nB; ++ui;
        if constexpr (GATHER) { gC0[0] = gN0[0]; gC0[1] = gN0[1]; gC1[0] = gN1[0]; gC1[1] = gN1[1]; }
    }
    P8_WAIT_V(0);
    P8_BAR;
#undef P8_CAT
#undef P8_GLDS
#undef P8_PIECE
#undef P8_WAIT_V
#undef P8_BAR
#undef P8_SCHED
#undef P8_SP
}

__device__ __forceinline__ u32x4 pack8(const f32x4& v0, const f32x4& v1) { u32x4 w; w.x = cvt_pk_bf16(v0[0], v0[1]); w.y = cvt_pk_bf16(v0[2], v0[3]); w.z = cvt_pk_bf16(v1[0], v1[1]); w.w = cvt_pk_bf16(v1[2], v1[3]); return w; }
__device__ __forceinline__ void rope4(f32x4& v0, f32x4& v1, const float* cs) {
    const f32x4 a = *(const f32x4*)cs, b = *(const f32x4*)(cs + 4);
    float x1, x2;
    x1 = v0[0]; x2 = v0[1]; v0[0] = x1 * a[0] - x2 * a[1]; v0[1] = x2 * a[0] + x1 * a[1];
    x1 = v0[2]; x2 = v0[3]; v0[2] = x1 * a[2] - x2 * a[3]; v0[3] = x2 * a[2] + x1 * a[3];
    x1 = v1[0]; x2 = v1[1]; v1[0] = x1 * b[0] - x2 * b[1]; v1[1] = x2 * b[0] + x1 * b[1];
    x1 = v1[2]; x2 = v1[3]; v1[2] = x1 * b[2] - x2 * b[3]; v1[3] = x2 * b[2] + x1 * b[3];
}

struct EpiIn {
    static constexpr bool PERM = true;
    bf16_t *qa, *ka, *va, *cq, *ckv, *gates, *kr; const float *ropeA, *ropeM, *bg; float* sq; unsigned char* k8r; unsigned char *q8a, *k8a; unsigned char* v8a; unsigned char* q8l;
    __device__ __forceinline__ void operator()(const f32x4 (&acc)[2][2][4][2], const Unit& u, int wr, int wc, int fr, int fq) const {
        const int pn = u.pn, row0 = u.pm * BM + wr * 64 + fr, cl = wc * 32 + 8 * fq;
        if (pn < 8) {
            bf16_t* dst = pn < 4 ? qa : ka; const int colt = (pn & 3) * 256; const bool rot = ((wc & 1) == 0) && (fq < 2);
#pragma unroll
            for (int ai = 0; ai < 2; ++ai)
#pragma unroll
                for (int m = 0; m < 4; ++m) { const int row = row0 + ai * HALF + m * 16;
#pragma unroll
                    for (int bj = 0; bj < 2; ++bj) { f32x4 v0 = acc[ai][bj][m][0], v1 = acc[ai][bj][m][1];
                        if (rot) rope4(v0, v1, ropeA + (size_t)row * 16 + fq * 8);
                        if (pn < 4) { v0 *= QS_DA; v1 *= QS_DA; }
                        if (DA_QK8 != 1) *(u32x4*)(dst + (size_t)row * 1024 + colt + bj * HALF + cl) = pack8(v0, v1);
                        if (DA_QK8) { const float s8 = pn < 4 ? 8.f : 1.f; u32x2 w8; w8.x = cvt_pk_fp8x4(v0[0] * s8, v0[1] * s8, v0[2] * s8, v0[3] * s8); w8.y = cvt_pk_fp8x4(v1[0] * s8, v1[1] * s8, v1[2] * s8, v1[3] * s8);
                            *(u32x2*)((pn < 4 ? q8a : k8a) + (size_t)row * 1024 + colt + bj * HALF + cl) = w8;
                            if (DA_QLO && pn < 4) {
                                const auto b0 = __builtin_amdgcn_cvt_pk_f32_fp8((int)w8.x, false), b1 = __builtin_amdgcn_cvt_pk_f32_fp8((int)w8.x, true), b2 = __builtin_amdgcn_cvt_pk_f32_fp8((int)w8.y, false), b3 = __builtin_amdgcn_cvt_pk_f32_fp8((int)w8.y, true);
                                u32x2 wl; wl.x = cvt_pk_fp8x4((v0[0] * 8.f - b0[0]) * 16.f, (v0[1] * 8.f - b0[1]) * 16.f, (v0[2] * 8.f - b1[0]) * 16.f, (v0[3] * 8.f - b1[1]) * 16.f);
                                wl.y = cvt_pk_fp8x4((v1[0] * 8.f - b2[0]) * 16.f, (v1[1] * 8.f - b2[1]) * 16.f, (v1[2] * 8.f - b3[0]) * 16.f, (v1[3] * 8.f - b3[1]) * 16.f);
                                *(u32x2*)(q8l + (size_t)row * 1024 + colt + bj * HALF + cl) = wl; } } } }
        } else if (pn < 12) {
            const int colt = (pn - 8) * 256;
#pragma unroll
            for (int ai = 0; ai < 2; ++ai)
#pragma unroll
                for (int m = 0; m < 4; ++m) { const int row = row0 + ai * HALF + m * 16;
#pragma unroll
                    for (int bj = 0; bj < 2; ++bj) { const f32x4 v0 = acc[ai][bj][m][0], v1 = acc[ai][bj][m][1]; *(u32x4*)(va + (size_t)row * 1024 + colt + bj * HALF + cl) = pack8(v0, v1);
                        if (DA_PV8) { u32x2 w8; w8.x = cvt_pk_fp8x4(v0[0], v0[1], v0[2], v0[3]); w8.y = cvt_pk_fp8x4(v1[0], v1[1], v1[2], v1[3]); *(u32x2*)(v8a + (size_t)row * 1024 + colt + bj * HALF + cl) = w8; } } }
        } else if (pn < 17) {
            const bool isq = pn < 15; bf16_t* dst = isq ? cq : ckv; const int ld = isq ? QL : KVL, colt = (isq ? pn - 12 : pn - 15) * 256, tq = pn - 12;
#pragma unroll
            for (int ai = 0; ai < 2; ++ai)
#pragma unroll
                for (int m = 0; m < 4; ++m) { const int row = row0 + ai * HALF + m * 16; float s = 0.f;
#pragma unroll
                    for (int bj = 0; bj < 2; ++bj) { const f32x4 v0 = acc[ai][bj][m][0], v1 = acc[ai][bj][m][1];
                        s += (v0[0] * v0[0] + v0[1] * v0[1]) + (v0[2] * v0[2] + v0[3] * v0[3]) + (v1[0] * v1[0] + v1[1] * v1[1]) + (v1[2] * v1[2] + v1[3] * v1[3]);
                        if (UP_F8) { u32x2 w8; w8.x = cvt_pk_fp8x4(v0[0], v0[1], v0[2], v0[3]); w8.y = cvt_pk_fp8x4(v1[0], v1[1], v1[2], v1[3]); *(u32x2*)((unsigned char*)dst + (size_t)row * ld + colt + bj * HALF + cl) = w8; }
                        else *(u32x4*)(dst + (size_t)row * ld + colt + bj * HALF + cl) = pack8(v0, v1); }
                    s += __shfl_xor(s, 16); s += __shfl_xor(s, 32);
                    if (fq == 0) sq[(size_t)row * 20 + tq * 4 + wc] = s; }
        } else if (pn != 23) {
            const int colt = (pn < 23 ? pn - 17 : pn - 18) * 256;
            f32x4 bv[2][2];
#pragma unroll
            for (int bj = 0; bj < 2; ++bj) { bv[bj][0] = *(const f32x4*)(bg + colt + bj * HALF + cl); bv[bj][1] = *(const f32x4*)(bg + colt + bj * HALF + cl + 4); if (DBG_SKIP & 256) { bv[bj][0] = bv[bj][0] * 0.f; bv[bj][1] = bv[bj][1] * 0.f; } }
#pragma unroll
            for (int ai = 0; ai < 2; ++ai)
#pragma unroll
                for (int m = 0; m < 4; ++m) { const int row = row0 + ai * HALF + m * 16;
#pragma unroll
                    for (int bj = 0; bj < 2; ++bj) { f32x4 v0 = acc[ai][bj][m][0] + bv[bj][0], v1 = acc[ai][bj][m][1] + bv[bj][1];
#pragma unroll
                        for (int j = 0; j < 4; ++j) { if (!(DBG_SKIP & 512)) { v0[j] = sigmoidf_(v0[j]); v1[j] = sigmoidf_(v1[j]); } }
                        *(u32x4*)(gates + (size_t)row * 2048 + colt + bj * HALF + cl) = pack8(v0, v1); } }
        } else {
            if (wc < 2) {
#pragma unroll
                for (int ai = 0; ai < 2; ++ai)
#pragma unroll
                    for (int m = 0; m < 4; ++m) { const int row = row0 + ai * HALF + m * 16;
                        f32x4 v0 = acc[ai][0][m][0], v1 = acc[ai][0][m][1];
                        rope4(v0, v1, ropeM + (size_t)row * 64 + (wc * 16 + fq * 4) * 2);
                        if (!MLA_QK8) *(u32x4*)(kr + (size_t)row * 64 + cl) = pack8(v0, v1);
                        if (MLA_QK8) { u32x2 w8; w8.x = cvt_pk_fp8x4(v0[0], v0[1], v0[2], v0[3]); w8.y = cvt_pk_fp8x4(v1[0], v1[1], v1[2], v1[3]); *(u32x2*)(k8r + (size_t)row * 64 + cl) = w8; } }
            }
        }
    }
};
template <bool ISQ> struct EpiUp {
    static constexpr bool PERM = true;
    bf16_t* out; const float* sq; const float* ropeM; unsigned char* out8;
    __device__ __forceinline__ void operator()(const f32x4 (&acc)[2][2][4][2], const Unit& u, int wr, int wc, int fr, int fq) const {
        const int row0 = u.pm * BM + wr * 64 + fr, cl = wc * 32 + 8 * fq; constexpr int LD = ISQ ? 1536 : 2048;
#pragma unroll
        for (int ai = 0; ai < 2; ++ai)
#pragma unroll
            for (int m = 0; m < 4; ++m) { const int row = row0 + ai * HALF + m * 16; float s;
                if (ISQ) { const f32x4 a = *(const f32x4*)(sq + (size_t)row * 20), b = *(const f32x4*)(sq + (size_t)row * 20 + 4), c = *(const f32x4*)(sq + (size_t)row * 20 + 8);
                    s = ((a[0] + a[1]) + (a[2] + a[3])) + ((b[0] + b[1]) + (b[2] + b[3])) + ((c[0] + c[1]) + (c[2] + c[3])); }
                else { const f32x4 a = *(const f32x4*)(sq + (size_t)row * 20 + 12), b = *(const f32x4*)(sq + (size_t)row * 20 + 16);
                    s = ((a[0] + a[1]) + (a[2] + a[3])) + ((b[0] + b[1]) + (b[2] + b[3])); }
                const float rstd = __builtin_amdgcn_rsqf(s * (ISQ ? 1.0f / QL : 1.0f / KVL) + EPS) * (ISQ ? QS_MLA : 1.0f);
#pragma unroll
                for (int bj = 0; bj < 2; ++bj) { const int col = u.pn * BM + bj * HALF + cl; f32x4 v0 = acc[ai][bj][m][0] * rstd, v1 = acc[ai][bj][m][1] * rstd;
                    if (ISQ) { const int off = col % 192; if (off >= 128) rope4(v0, v1, ropeM + (size_t)row * 64 + (off - 128)); }
                    if (!MLA_QK8 || (!ISQ && bj == 1)) *(u32x4*)(out + (size_t)row * LD + col) = pack8(v0, v1);
                    if (MLA_QK8) { u32x2 w8;
                        if (ISQ) { w8.x = cvt_pk_fp8x4(v0[0] * 8.f, v0[1] * 8.f, v0[2] * 8.f, v0[3] * 8.f); w8.y = cvt_pk_fp8x4(v1[0] * 8.f, v1[1] * 8.f, v1[2] * 8.f, v1[3] * 8.f); *(u32x2*)(out8 + (size_t)row * 1536 + col) = w8; }
                        else if (bj == 0) { w8.x = cvt_pk_fp8x4(v0[0], v0[1], v0[2], v0[3]); w8.y = cvt_pk_fp8x4(v1[0], v1[1], v1[2], v1[3]); *(u32x2*)(out8 + (size_t)row * 1024 + u.pn * 128 + cl) = w8; } } } }
    }
};
template <bool ISQ> struct EpiUp8 {
    bf16_t* out; const float* sq; const float* ropeM; unsigned char* out8; unsigned char* v8 = nullptr;
    __device__ __forceinline__ void operator()(const f32x4 (&acc)[2][4][2], const Unit& u, int wr, int wc, int fr, int fq) const {
        const int row0 = u.pm * BM + wr * 64 + fr, col = u.pn * HALF + wc * 32 + 8 * fq;
#pragma unroll
        for (int ai = 0; ai < 2; ++ai)
#pragma unroll
            for (int m = 0; m < 4; ++m) { const int row = row0 + ai * HALF + m * 16; float s;
                if (ISQ) { const f32x4 a = *(const f32x4*)(sq + (size_t)row * 20), b = *(const f32x4*)(sq + (size_t)row * 20 + 4), c = *(const f32x4*)(sq + (size_t)row * 20 + 8);
                    s = ((a[0] + a[1]) + (a[2] + a[3])) + ((b[0] + b[1]) + (b[2] + b[3])) + ((c[0] + c[1]) + (c[2] + c[3])); }
                else { const f32x4 a = *(const f32x4*)(sq + (size_t)row * 20 + 12), b = *(const f32x4*)(sq + (size_t)row * 20 + 16);
                    s = ((a[0] + a[1]) + (a[2] + a[3])) + ((b[0] + b[1]) + (b[2] + b[3])); }
                const float rstd = __builtin_amdgcn_rsqf(s * (ISQ ? 1.0f / QL : 1.0f / KVL) + EPS) * (ISQ ? QS_MLA : 1.0f);
                f32x4 v0 = acc[ai][m][0] * rstd, v1 = acc[ai][m][1] * rstd;
                if (ISQ) { const int off = col % 192; if (off >= 128) rope4(v0, v1, ropeM + (size_t)row * 64 + (off - 128));
                    u32x2 w8; w8.x = cvt_pk_fp8x4(v0[0] * 8.f, v0[1] * 8.f, v0[2] * 8.f, v0[3] * 8.f); w8.y = cvt_pk_fp8x4(v1[0] * 8.f, v1[1] * 8.f, v1[2] * 8.f, v1[3] * 8.f); *(u32x2*)(out8 + (size_t)row * 1536 + col) = w8; }
                else if ((u.pn & 1) == 0) { u32x2 w8; w8.x = cvt_pk_fp8x4(v0[0], v0[1], v0[2], v0[3]); w8.y = cvt_pk_fp8x4(v1[0], v1[1], v1[2], v1[3]); *(u32x2*)(out8 + (size_t)row * 1024 + (u.pn >> 1) * 128 + wc * 32 + 8 * fq) = w8; }
                else if (MLA_PV8) { u32x2 w8; w8.x = cvt_pk_fp8x4(v0[0], v0[1], v0[2], v0[3]); w8.y = cvt_pk_fp8x4(v1[0], v1[1], v1[2], v1[3]); *(u32x2*)(v8 + (size_t)row * 1024 + (u.pn >> 1) * 128 + wc * 32 + 8 * fq) = w8; }
                else *(u32x4*)(out + (size_t)row * 2048 + col) = pack8(v0, v1); }
    }
};
template <int WHICH> struct EpiGate {
    static constexpr bool PERM = true;
    bf16_t* mrg; const bf16_t* gates;
    __device__ __forceinline__ void operator()(const f32x4 (&acc)[2][2][4][2], const Unit& u, int wr, int wc, int fr, int fq) const {
        const int row0 = u.pm * BM + wr * 64 + fr, cl = wc * 32 + 8 * fq;
#pragma unroll
        for (int ai = 0; ai < 2; ++ai)
#pragma unroll
            for (int m = 0; m < 4; ++m) { const int row = row0 + ai * HALF + m * 16;
#pragma unroll
                for (int bj = 0; bj < 2; ++bj) { const int col = u.pn * BM + bj * HALF + cl;
                    const u32x4 gw = *(const u32x4*)(gates + (size_t)row * 2048 + WHICH * 1024 + col);
                    f32x4 v0 = acc[ai][bj][m][0], v1 = acc[ai][bj][m][1];
                    if ((DBG_SKIP & 8) && WHICH == 0) { v0 = v0 * 0.f; v1 = v1 * 0.f; } if ((DBG_SKIP & 16) && WHICH == 1) { v0 = v0 * 0.f; v1 = v1 * 0.f; }
                    v0[0] *= bf_lo(gw.x); v0[1] *= bf_hi(gw.x); v0[2] *= bf_lo(gw.y); v0[3] *= bf_hi(gw.y); v1[0] *= bf_lo(gw.z); v1[1] *= bf_hi(gw.z); v1[2] *= bf_lo(gw.w); v1[3] *= bf_hi(gw.w);
                    if (WHICH == 1) { const u32x4 tw = *(const u32x4*)(mrg + (size_t)row * 1024 + col);
                        v0[0] += bf_lo(tw.x); v0[1] += bf_hi(tw.x); v0[2] += bf_lo(tw.y); v0[3] += bf_hi(tw.y); v1[0] += bf_lo(tw.z); v1[1] += bf_hi(tw.z); v1[2] += bf_lo(tw.w); v1[3] += bf_hi(tw.w); }
                    *(u32x4*)(mrg + (size_t)row * 1024 + col) = pack8(v0, v1); } }
    }
};
struct EpiRes {
    static constexpr bool PERM = false;
    const float* x; bf16_t* out;
    __device__ __forceinline__ void operator()(const f32x4 (&acc)[2][2][4][2], const Unit& u, int wr, int wc, int fr, int fq) const {
        const int row0 = u.pm * BM + wr * 64 + fr, col0 = u.pn * BM + wc * 32 + 4 * fq;
#pragma unroll
        for (int ai = 0; ai < 2; ++ai)
#pragma unroll
            for (int m = 0; m < 4; ++m) { const size_t off = (size_t)(row0 + ai * HALF + m * 16) * 1024 + col0;
#pragma unroll
                for (int bj = 0; bj < 2; ++bj)
#pragma unroll
                    for (int n = 0; n < 2; ++n) { const f32x4 v = *(const f32x4*)(x + off + bj * HALF + n * 16) + ((DBG_SKIP & 2) ? 0.f : 1.f) * acc[ai][bj][m][n];
                        u32x2 w; w.x = cvt_pk_bf16(v[0], v[1]); w.y = cvt_pk_bf16(v[2], v[3]); *(u32x2*)(out + off + bj * HALF + n * 16) = w; } }
    }
};
struct EpiSwiglu {
    static constexpr bool PERM = true;
    bf16_t* act; const float *bgate, *bup;
    __device__ __forceinline__ void operator()(const f32x4 (&acc)[2][2][4][2], const Unit& u, int wr, int wc, int fr, int fq) const {
        const int row0 = u.pm * BM + wr * 64 + fr, f0 = u.pn * HALF + wc * 32 + 8 * fq;
        f32x4 bgv[2], buv[2];
#pragma unroll
        for (int n = 0; n < 2; ++n) { bgv[n] = *(const f32x4*)(bgate + (size_t)u.e * FF + f0 + 4 * n); buv[n] = *(const f32x4*)(bup + (size_t)u.e * FF + f0 + 4 * n); }
#pragma unroll
        for (int ai = 0; ai < 2; ++ai)
#pragma unroll
            for (int m = 0; m < 4; ++m) { const int row = row0 + ai * HALF + m * 16; f32x4 o[2];
#pragma unroll
                for (int n = 0; n < 2; ++n) { const f32x4 gt = acc[ai][0][m][n] + bgv[n], up = acc[ai][1][m][n] + buv[n];
#pragma unroll
                    for (int j = 0; j < 4; ++j) { const float gg = fminf(gt[j], 7.0f), uu = fminf(fmaxf(up[j], -7.0f), 7.0f); o[n][j] = (uu + 1.0f) * (gg * sigmoidf_(1.702f * gg)); } }
                u32x2 w8; w8.x = cvt_pk_fp8x4(o[0][0], o[0][1], o[0][2], o[0][3]); w8.y = cvt_pk_fp8x4(o[1][0], o[1][1], o[1][2], o[1][3]);
                *(u32x2*)((unsigned char*)act + (size_t)row * FF + f0) = w8; }
    }
};
struct EpiDown {
    static constexpr bool PERM = true;
    bf16_t* y; const float* bd;
    __device__ __forceinline__ void operator()(const f32x4 (&acc)[2][2][4][2], const Unit& u, int wr, int wc, int fr, int fq) const {
        const int row0 = u.pm * BM + wr * 64 + fr, cl = wc * 32 + 8 * fq;
        f32x4 bv[2][2];
#pragma unroll
        for (int bj = 0; bj < 2; ++bj) { const int col = u.pn * BM + bj * HALF + cl; bv[bj][0] = *(const f32x4*)(bd + (size_t)u.e * D + col); bv[bj][1] = *(const f32x4*)(bd + (size_t)u.e * D + col + 4); }
#pragma unroll
        for (int ai = 0; ai < 2; ++ai)
#pragma unroll
            for (int m = 0; m < 4; ++m) { const int row = row0 + ai * HALF + m * 16;
#pragma unroll
                for (int bj = 0; bj < 2; ++bj) { const int col = u.pn * BM + bj * HALF + cl;
                    *(u32x4*)(y + (size_t)row * D + col) = pack8(acc[ai][bj][m][0] + bv[bj][0], acc[ai][bj][m][1] + bv[bj][1]); } }
    }
};
struct EpiSwiglu8 {
    unsigned char* act; const float *bgate, *bup;
    __device__ __forceinline__ void operator()(const f32x4 (&acc)[2][4][2], const Unit& u, int wr, int wc, int fr, int fq) const {
        const int row0 = u.pm * BM + wr * 64 + fr, f0 = u.pn * 64 + wc * 16 + 4 * fq;
        const f32x4 bgv = *(const f32x4*)(bgate + (size_t)u.e * FF + f0), buv = *(const f32x4*)(bup + (size_t)u.e * FF + f0);
#pragma unroll
        for (int ai = 0; ai < 2; ++ai)
#pragma unroll
            for (int m = 0; m < 4; ++m) { const int row = row0 + ai * HALF + m * 16; const f32x4 gt = acc[ai][m][0] + bgv, up = acc[ai][m][1] + buv; float o[4];
#pragma unroll
                for (int j = 0; j < 4; ++j) { const float gg = fminf(gt[j], 7.0f), uu = fminf(fmaxf(up[j], -7.0f), 7.0f); o[j] = (uu + 1.0f) * (gg * sigmoidf_(1.702f * gg)); }
                *(unsigned*)(act + (size_t)row * FF + f0) = cvt_pk_fp8x4(o[0], o[1], o[2], o[3]); }
    }
};
struct EpiDown8 {
    unsigned char* y; const float* bd;
    __device__ __forceinline__ void operator()(const f32x4 (&acc)[2][4][2], const Unit& u, int wr, int wc, int fr, int fq) const {
        const int row0 = u.pm * BM + wr * 64 + fr, col = u.pn * HALF + wc * 32 + 8 * fq;
        const f32x4 bv0 = *(const f32x4*)(bd + (size_t)u.e * D + col), bv1 = *(const f32x4*)(bd + (size_t)u.e * D + col + 4);
#pragma unroll
        for (int ai = 0; ai < 2; ++ai)
#pragma unroll
            for (int m = 0; m < 4; ++m) { const int row = row0 + ai * HALF + m * 16; const f32x4 v0 = (acc[ai][m][0] + bv0) * YS, v1 = (acc[ai][m][1] + bv1) * YS;
                u32x2 w; w.x = cvt_pk_fp8x4(v0[0], v0[1], v0[2], v0[3]); w.y = cvt_pk_fp8x4(v1[0], v1[1], v1[2], v1[3]);
                *(u32x2*)(y + (size_t)row * D + col) = w; }
    }
};
}

namespace att {
constexpr int NW = 8, QBLK = 32, KVBLK = 64;
constexpr int SHM_V = KVBLK * 128 * 2;
#define SBAR() __builtin_amdgcn_sched_barrier(0)
#define KSW(row, colB) ((row) * 128 + ((colB) ^ ((((row) >> 1) & 7) << 4)))
__device__ __forceinline__ int crow(int r, int hi) { return (r & 3) + 8 * (r >> 2) + 4 * hi; }
struct Src { const bf16_t* Q; const bf16_t* K; const bf16_t* K2; const bf16_t* V; int ldq, ldk, ldk2, ldv; };

__device__ __forceinline__ void partialSM(f32x16& p0, f32x16& p1, float& m_reg, float& mn, float& alpha, const float C, const float thr) {
  float pmax;
  { float a0 = fmaxf(fmaxf(p0[0], p0[1]), p0[2]), a1 = fmaxf(fmaxf(p0[3], p0[4]), p0[5]), a2 = fmaxf(fmaxf(p1[0], p1[1]), p1[2]), a3 = fmaxf(fmaxf(p1[3], p1[4]), p1[5]);
#pragma unroll
    for (int r = 6; r < 16; r += 2) { a0 = fmaxf(fmaxf(a0, p0[r]), p0[r + 1]); a2 = fmaxf(fmaxf(a2, p1[r]), p1[r + 1]); }
    pmax = fmaxf(fmaxf(a0, a1), fmaxf(a2, a3)); }
  { auto rr = __builtin_amdgcn_permlane32_swap(__float_as_uint(pmax), __float_as_uint(pmax), false, false);
    pmax = fmaxf(__uint_as_float(rr[0]), __uint_as_float(rr[1])); }
  if (__builtin_expect(__all(pmax - m_reg <= thr), 1)) { mn = m_reg; alpha = 1.f; }
  else { mn = fmaxf(m_reg, pmax); alpha = __builtin_amdgcn_exp2f((m_reg - mn) * C); m_reg = mn; }
  const float mnC = -mn * C;
#pragma unroll
  for (int r = 0; r < 16; ++r) p0[r] = fmaf(p0[r], C, mnC);
#pragma unroll
  for (int r = 0; r < 16; ++r) p1[r] = fmaf(p1[r], C, mnC);
#pragma unroll
  for (int r = 0; r < 16; ++r) p0[r] = __builtin_amdgcn_exp2f(p0[r]);
#if ATT_DUP == 1
  { float d_[16];
#pragma unroll
    for (int r = 0; r < 16; ++r) { d_[r] = __builtin_amdgcn_exp2f(p1[r]); d_[r] = fmaf(d_[r], C, mnC); }
#pragma unroll
    for (int r = 0; r < 16; ++r) asm volatile("" :: "v"(d_[r])); }
#endif
}
__device__ __forceinline__ void finishSM(f32x16& p0, f32x16& p1, float alpha, float& l_reg, bf16x8& pa0, bf16x8& pa1, bf16x8& pa2, bf16x8& pa3) {
#pragma unroll
  for (int r = 0; r < 16; ++r) p1[r] = __builtin_amdgcn_exp2f(p1[r]);
  float ps;
  { float s0 = p0[0] + p0[1], s1 = p0[2] + p0[3], s2 = p1[0] + p1[1], s3 = p1[2] + p1[3];
#pragma unroll
    for (int r = 4; r < 16; r += 4) { s0 += p0[r] + p0[r + 1]; s1 += p0[r + 2] + p0[r + 3]; s2 += p1[r] + p1[r + 1]; s3 += p1[r + 2] + p1[r + 3]; }
    ps = (s0 + s1) + (s2 + s3); }
  { auto rr = __builtin_amdgcn_permlane32_swap(__float_as_uint(ps), __float_as_uint(ps), false, false);
    ps = __uint_as_float(rr[0]) + __uint_as_float(rr[1]); }
  l_reg = l_reg * alpha + ps;
#define PK4(P, BASE, OUT) do { unsigned a0 = cvt_pk_bf16(P[BASE + 0], P[BASE + 1]), a1 = cvt_pk_bf16(P[BASE + 2], P[BASE + 3]);   \
    unsigned b0 = cvt_pk_bf16(P[BASE + 4], P[BASE + 5]), b1 = cvt_pk_bf16(P[BASE + 6], P[BASE + 7]);                              \
    auto r0 = __builtin_amdgcn_permlane32_swap(a0, b0, false, false); auto r1 = __builtin_amdgcn_permlane32_swap(a1, b1, false, false); \
    u32x4 w = {r0[0], r1[0], r0[1], r1[1]}; OUT = *reinterpret_cast<bf16x8*>(&w); } while (0)
  PK4(p0, 0, pa0); PK4(p0, 8, pa1); PK4(p1, 0, pa2); PK4(p1, 8, pa3);
#undef PK4
}
template <int DQK> __device__ __forceinline__ void qkt(f32x16& p0, f32x16& p1, const LAS char* Ks, const bf16x8* qr, int r32, int hi) {
  p0 = f32x16{}; p1 = f32x16{};
#pragma unroll
  for (int d0 = 0; d0 < DQK / 16; d0 += 2) {
    bf16x8 kf[2][2];
#pragma unroll
    for (int d = 0; d < 2; ++d) { const int sub = (d0 + d) >> 2, cb = (((d0 + d) & 3) * 16 + hi * 8) * 2;
      kf[d][0] = *(const LAS bf16x8*)(Ks + sub * 8192 + KSW(r32, cb)); kf[d][1] = *(const LAS bf16x8*)(Ks + sub * 8192 + KSW(32 + r32, cb)); }
    SBAR();
#pragma unroll
    for (int d = 0; d < 2; ++d) {
      p0 = __builtin_amdgcn_mfma_f32_32x32x16_bf16(kf[d][0], qr[d0 + d], p0, 0, 0, 0);
      p1 = __builtin_amdgcn_mfma_f32_32x32x16_bf16(kf[d][1], qr[d0 + d], p1, 0, 0, 0); }
  }
}
__device__ __forceinline__ int v_st(int k, int c) { const int kk = (k & ~0xC) | ((k & 4) << 1) | ((k & 8) >> 1); return ((kk >> 3) * 4 + (c >> 5)) * 512 + ((kk & 7) * 32 + (c & 31)) * 2; }
__device__ __forceinline__ int v_rd_base(int lane) { return ((lane & 3) << 3) | (((lane >> 2) & 3) << 6) | (((lane >> 4) & 1) << 5) | (((lane >> 5) & 1) << 8); }
constexpr int v_rd_off(int d0, int ks, int half) { return d0 * 512 + ks * 4096 + half * 2048; }
template <int OFF> __device__ __forceinline__ s16x4 tr_read(int vb) {
  s16x4 r; asm volatile("ds_read_b64_tr_b16 %0, %1 offset:%2" : "=&v"(r) : "v"(vb), "i"(OFF) : "memory"); return r;
}
template <int KS> __device__ __forceinline__ void pv_step(f32x16* o, int vb, bf16x8 pa) {
  s16x4 l0, h0, l1, h1, l2, h2, l3, h3;
  l0 = tr_read<v_rd_off(0, KS, 0)>(vb); h0 = tr_read<v_rd_off(0, KS, 1)>(vb); l1 = tr_read<v_rd_off(1, KS, 0)>(vb); h1 = tr_read<v_rd_off(1, KS, 1)>(vb);
  l2 = tr_read<v_rd_off(2, KS, 0)>(vb); h2 = tr_read<v_rd_off(2, KS, 1)>(vb); l3 = tr_read<v_rd_off(3, KS, 0)>(vb); h3 = tr_read<v_rd_off(3, KS, 1)>(vb);
  asm volatile("s_waitcnt lgkmcnt(0)" ::: "memory"); SBAR();
#define PK(L, H) (bf16x8){L[0], L[1], L[2], L[3], H[0], H[1], H[2], H[3]}
  o[0] = __builtin_amdgcn_mfma_f32_32x32x16_bf16(pa, PK(l0, h0), o[0], 0, 0, 0);
  o[1] = __builtin_amdgcn_mfma_f32_32x32x16_bf16(pa, PK(l1, h1), o[1], 0, 0, 0);
  o[2] = __builtin_amdgcn_mfma_f32_32x32x16_bf16(pa, PK(l2, h2), o[2], 0, 0, 0);
  o[3] = __builtin_amdgcn_mfma_f32_32x32x16_bf16(pa, PK(l3, h3), o[3], 0, 0, 0);
#undef PK
}
__device__ __forceinline__ void pv_d0(f32x16* o, int vb, bf16x8 pa0, bf16x8 pa1, bf16x8 pa2, bf16x8 pa3) {
  pv_step<0>(o, vb, pa0); pv_step<1>(o, vb, pa1); pv_step<2>(o, vb, pa2); pv_step<3>(o, vb, pa3);
}
template <int DQK>
__device__ __forceinline__ void attn_core(const Src in, const float C, const float thr, const int seq, LAS char* lds, f32x16 (&o)[4]) {
  constexpr int NSUB = DQK / 64, SHM_K = NSUB * 8192;
  int lane; asm volatile("v_and_b32 %0, 63, %1" : "=v"(lane) : "v"(threadIdx.x));
  const int tid = threadIdx.x, wid = __builtin_amdgcn_readfirstlane(tid >> 6), r32 = lane & 31, hi = (lane >> 5) & 1;
  LAS char* V_lds = lds; LAS char* K_lds = lds + 3 * SHM_V;
  LAS float* ws = (LAS float*)(lds + 3 * SHM_V + 3 * SHM_K) + wid * 64; LAS float* li_l = ws; LAS float* al_l = ws + 32;
  float m_reg = -1e30f, l_reg = 0;
#pragma unroll
  for (int d = 0; d < 4; ++d) o[d] = f32x16{};
  bf16x8 qr[DQK / 16];
  const bf16_t* Qw = in.Q + (size_t)(wid * QBLK + r32) * in.ldq + hi * 8;
#pragma unroll
  for (int d0 = 0; d0 < DQK / 16; ++d0) qr[d0] = *(const bf16x8*)(Qw + d0 * 16);
  const int krow = wid * 8 + (lane >> 3), kslot = (lane & 7) ^ ((krow >> 1) & 7);
  const unsigned koff = (unsigned)(krow * in.ldk + kslot * 8) * 2u, k2off = (unsigned)(krow * in.ldk2 + kslot * 8) * 2u;
  unsigned voff[2];
#pragma unroll
  for (int i = 0; i < 2; ++i) { const int p = i * 8192 + wid * 1024 + lane * 16, st = p >> 9, wq = (p & 511) >> 1, kk = (st >> 2) * 8 + (wq >> 5), cl = wq & 31;
    const int k = (kk & ~0xC) | ((kk & 4) << 1) | ((kk & 8) >> 1); voff[i] = (unsigned)(k * in.ldv + (st & 3) * 32 + cl) * 2u; }
  const int vb0 = (int)(unsigned)(size_t)V_lds + v_rd_base(lane);
  const unsigned ldsw = (unsigned)wid * 1024u;
#define GLDS(gp, lp) __builtin_amdgcn_global_load_lds((const unsigned*)(gp), (LAS unsigned*)(lp), 16, 0, 0)
#define ISSUE_K(t, b) do { const char* kb_ = (const char*)in.K + (size_t)(t) * (KVBLK * 2) * in.ldk; \
    _Pragma("unroll") for (int s_ = 0; s_ < NSUB; ++s_) { if (s_ < 2) GLDS(kb_ + s_ * 128 + koff, K_lds + (b) * SHM_K + s_ * 8192 + ldsw); \
      else GLDS((const char*)in.K2 + (size_t)(t) * (KVBLK * 2) * in.ldk2 + k2off, K_lds + (b) * SHM_K + s_ * 8192 + ldsw); } } while (0)
#define ISSUE_V(t, b) do { const char* vb_ = (const char*)in.V + (size_t)(t) * (KVBLK * 2) * in.ldv; \
    GLDS(vb_ + voff[0], V_lds + (b) * SHM_V + ldsw); GLDS(vb_ + voff[1], V_lds + (b) * SHM_V + 8192 + ldsw); \
    if (ATT_DUP == 3) { GLDS(vb_ + voff[0], V_lds + (b) * SHM_V + ldsw); GLDS(vb_ + voff[1], V_lds + (b) * SHM_V + 8192 + ldsw); } } while (0)
#define WAITV(n) asm volatile("s_waitcnt vmcnt(%0)" :: "n"((DBG_SKIP & 4) ? 0 : (n)) : "memory")
#define WBAR() do { asm volatile("" ::: "memory"); __builtin_amdgcn_s_barrier(); asm volatile("" ::: "memory"); } while (0)
#define RESC(a) do { if (__any((a) < 1.f)) { if (hi == 0) al_l[r32] = (a); asm volatile("s_waitcnt lgkmcnt(0)" ::: "memory"); \
    _Pragma("unroll") for (int d = 0; d < 4; ++d) _Pragma("unroll") for (int r = 0; r < 16; ++r) o[d][r] *= al_l[crow(r, hi)]; } } while (0)
#define NXT3(x) ((x) == 2 ? 0 : (x) + 1)
  constexpr int NI = NSUB + (ATT_DUP == 3 ? 4 : 2), NV = (ATT_DUP == 3 ? 4 : 2);
  f32x16 pA0, pA1, pB0, pB1; float mnA, mnB, alA, alB; bf16x8 pa0, pa1, pa2, pa3; const int NT = seq / KVBLK;
  const bool lead = wid < 4;
  ISSUE_K(0, 0); ISSUE_K(1, 1); ISSUE_V(0, 0);
  if (!lead) { WAITV(NI); WBAR(); }
  WAITV(NI); WBAR();
  ISSUE_K(2, 2);
  qkt<DQK>(pA0, pA1, K_lds, qr, r32, hi);
  WAITV(NI); WBAR();
  ISSUE_V(1, 1);
  partialSM(pA0, pA1, m_reg, mnA, alA, C, thr);
  WAITV(NI); WBAR();
  int bq = 1;
  for (int j = 1; j + 3 < NT; j += 2) {
    { const int b1 = NXT3(bq), b2 = NXT3(b1);
      ISSUE_K(j + 2, b2);
      SBAR(); qkt<DQK>(pB0, pB1, K_lds + bq * SHM_K, qr, r32, hi);
      finishSM(pA0, pA1, alA, l_reg, pa0, pa1, pa2, pa3); SBAR();
      WAITV(NI); WBAR();
      ISSUE_V(j + 1, b1);
      pv_d0(o, vb0 + b2 * SHM_V, pa0, pa1, pa2, pa3); partialSM(pB0, pB1, m_reg, mnB, alB, C, thr);
      RESC(alB); bq = b1;
      WAITV(NI); WBAR(); }
    { const int b1 = NXT3(bq), b2 = NXT3(b1);
      ISSUE_K(j + 3, b2);
      SBAR(); qkt<DQK>(pA0, pA1, K_lds + bq * SHM_K, qr, r32, hi);
      finishSM(pB0, pB1, alB, l_reg, pa0, pa1, pa2, pa3); SBAR();
      WAITV(NI); WBAR();
      ISSUE_V(j + 2, b1);
      pv_d0(o, vb0 + b2 * SHM_V, pa0, pa1, pa2, pa3); partialSM(pA0, pA1, m_reg, mnA, alA, C, thr);
      RESC(alA); bq = b1;
      WAITV(NI); WBAR(); }
  }
  { const int b1 = NXT3(bq), b2 = NXT3(b1);
    ISSUE_K(NT - 1, b2);
    SBAR(); qkt<DQK>(pB0, pB1, K_lds + bq * SHM_K, qr, r32, hi);
    finishSM(pA0, pA1, alA, l_reg, pa0, pa1, pa2, pa3); SBAR();
    WAITV(NI); WBAR();
    ISSUE_V(NT - 2, b1);
    pv_d0(o, vb0 + b2 * SHM_V, pa0, pa1, pa2, pa3); partialSM(pB0, pB1, m_reg, mnB, alB, C, thr);
    RESC(alB); bq = b1;
    WAITV(NI); WBAR(); }
  { const int b1 = NXT3(bq), b2 = NXT3(b1);
    SBAR(); qkt<DQK>(pA0, pA1, K_lds + bq * SHM_K, qr, r32, hi);
    finishSM(pB0, pB1, alB, l_reg, pa0, pa1, pa2, pa3); SBAR();
    WAITV(NV); WBAR();
    ISSUE_V(NT - 1, b1);
    pv_d0(o, vb0 + b2 * SHM_V, pa0, pa1, pa2, pa3); partialSM(pA0, pA1, m_reg, mnA, alA, C, thr);
    RESC(alA); bq = b1;
    WAITV(NV); WBAR(); }
  { const int b2 = NXT3(NXT3(bq));
    SBAR(); qkt<DQK>(pB0, pB1, K_lds + bq * SHM_K, qr, r32, hi);
    finishSM(pA0, pA1, alA, l_reg, pa0, pa1, pa2, pa3); SBAR();
    WAITV(0); WBAR();
    pv_d0(o, vb0 + b2 * SHM_V, pa0, pa1, pa2, pa3); partialSM(pB0, pB1, m_reg, mnB, alB, C, thr);
    RESC(alB);
    WBAR(); }
  finishSM(pB0, pB1, alB, l_reg, pa0, pa1, pa2, pa3); SBAR();
  pv_d0(o, vb0 + bq * SHM_V, pa0, pa1, pa2, pa3);
  if (lead) { WBAR(); }
  if (hi == 0) li_l[r32] = l_reg; asm volatile("s_waitcnt lgkmcnt(0)" ::: "memory");
#pragma unroll
  for (int r = 0; r < 16; ++r) { const float rl = __builtin_amdgcn_rcpf(li_l[crow(r, hi)]);
#pragma unroll
    for (int d = 0; d < 4; ++d) o[d][r] *= rl; }
  asm volatile("s_waitcnt lgkmcnt(0)" ::: "memory"); WBAR();
#undef GLDS
#undef ISSUE_K
#undef ISSUE_V
#undef WAITV
#undef WBAR
#undef RESC
#undef NXT3
}
template <int DQK>
__device__ __forceinline__ void attn_core_seq(const Src in, const float C, const float thr, const int seq, LAS char* lds, f32x16 (&o)[4], float* probe = nullptr) {
  constexpr int NSUB = DQK / 64, SHM_K = NSUB * 8192;
  int lane; asm volatile("v_and_b32 %0, 63, %1" : "=v"(lane) : "v"(threadIdx.x));
  const int tid = threadIdx.x, wid = __builtin_amdgcn_readfirstlane(tid >> 6), r32 = lane & 31, hi = (lane >> 5) & 1;
  LAS char* V_lds = lds; LAS char* K_lds = lds + 3 * SHM_V;
  LAS float* ws = (LAS float*)(lds + 3 * SHM_V + 3 * SHM_K) + wid * 64; LAS float* li_l = ws; LAS float* al_l = ws + 32;
  float m_reg = -1e30f, l_reg = 0;
#pragma unroll
  for (int d = 0; d < 4; ++d) o[d] = f32x16{};
  bf16x8 qr[DQK / 16];
  const bf16_t* Qw = in.Q + (size_t)(wid * QBLK + r32) * in.ldq + hi * 8;
#pragma unroll
  for (int d0 = 0; d0 < DQK / 16; ++d0) qr[d0] = *(const bf16x8*)(Qw + d0 * 16);
  const int krow = wid * 8 + (lane >> 3), kslot = (lane & 7) ^ ((krow >> 1) & 7);
  const unsigned koff = (unsigned)(krow * in.ldk + kslot * 8) * 2u, k2off = (unsigned)(krow * in.ldk2 + kslot * 8) * 2u;
  unsigned voff[2];
#pragma unroll
  for (int i = 0; i < 2; ++i) { const int p = i * 8192 + wid * 1024 + lane * 16, st = p >> 9, wq = (p & 511) >> 1, kk = (st >> 2) * 8 + (wq >> 5), cl = wq & 31;
    const int k = (kk & ~0xC) | ((kk & 4) << 1) | ((kk & 8) >> 1); voff[i] = (unsigned)(k * in.ldv + (st & 3) * 32 + cl) * 2u; }
  const int vb0 = (int)(unsigned)(size_t)V_lds + v_rd_base(lane);
  const unsigned ldsw = (unsigned)wid * 1024u;
#define GLDS(gp, lp) __builtin_amdgcn_global_load_lds((const unsigned*)(gp), (LAS unsigned*)(lp), 16, 0, 0)
#define ISSUE_K(t, b) do { const char* kb_ = (const char*)in.K + (size_t)(t) * (KVBLK * 2) * in.ldk; \
    _Pragma("unroll") for (int s_ = 0; s_ < NSUB; ++s_) { if (s_ < 2) GLDS(kb_ + s_ * 128 + koff, K_lds + (b) * SHM_K + s_ * 8192 + ldsw); \
      else GLDS((const char*)in.K2 + (size_t)(t) * (KVBLK * 2) * in.ldk2 + k2off, K_lds + (b) * SHM_K + s_ * 8192 + ldsw); } } while (0)
#define ISSUE_V(t, b) do { const char* vb_ = (const char*)in.V + (size_t)(t) * (KVBLK * 2) * in.ldv; \
    GLDS(vb_ + voff[0], V_lds + (b) * SHM_V + ldsw); GLDS(vb_ + voff[1], V_lds + (b) * SHM_V + 8192 + ldsw); } while (0)
#define WAITV(n) asm volatile("s_waitcnt vmcnt(%0)" :: "n"(n) : "memory")
#define WBAR() do { asm volatile("" ::: "memory"); __builtin_amdgcn_s_barrier(); asm volatile("" ::: "memory"); } while (0)
#define RESC(a) do { if (__any((a) < 1.f)) { if (hi == 0) al_l[r32] = (a); asm volatile("s_waitcnt lgkmcnt(0)" ::: "memory"); \
    _Pragma("unroll") for (int d = 0; d < 4; ++d) _Pragma("unroll") for (int r = 0; r < 16; ++r) o[d][r] *= al_l[crow(r, hi)]; } } while (0)
#define NXT3(x) ((x) == 2 ? 0 : (x) + 1)
#define SEG_B(b) do { float mn, al; bf16x8 pa0, pa1, pa2, pa3; partialSM(p0, p1, m_reg, mn, al, C, thr); RESC(al); finishSM(p0, p1, al, l_reg, pa0, pa1, pa2, pa3); SBAR(); \
    pv_d0(o, vb0 + (b) * SHM_V, pa0, pa1, pa2, pa3); } while (0)
  constexpr int NI = NSUB + 2;
  f32x16 p0, p1; const int NT = seq / KVBLK; const bool lead = wid < 4;
  ISSUE_K(0, 0); ISSUE_V(0, 0); ISSUE_K(1, 1); ISSUE_V(1, 1);
  if (!lead) { WAITV(NI); WBAR(); }
  WAITV(NI); WBAR();
  int bq = 0;
#if PROBE_T == 4
  const unsigned long long t0 = __builtin_amdgcn_s_memtime();
#endif
  for (int j = 0; j + 2 < NT; ++j) {
    const int b1 = NXT3(bq), b2 = NXT3(b1);
    ISSUE_K(j + 2, b2);
    qkt<DQK>(p0, p1, K_lds + bq * SHM_K, qr, r32, hi);
    WAITV(NI); WBAR();
    ISSUE_V(j + 2, b2);
    SEG_B(bq);
    WAITV(NI); WBAR();
    bq = b1;
  }
#if PROBE_T == 4
  { const unsigned long long t1 = __builtin_amdgcn_s_memtime(); if (probe != nullptr && tid == 0) { probe[0] = 0.f; probe[1] = ((float)(t1 - t0) * (1.f / (NT - 2)) - 3000.f) * 0.02f; } }
#endif
#pragma unroll
  for (int jj = 0; jj < 2; ++jj) {
    qkt<DQK>(p0, p1, K_lds + bq * SHM_K, qr, r32, hi);
    WAITV(0); WBAR();
    SEG_B(bq);
    WBAR();
    bq = NXT3(bq);
  }
  if (lead) { WBAR(); }
  if (hi == 0) li_l[r32] = l_reg; asm volatile("s_waitcnt lgkmcnt(0)" ::: "memory");
#pragma unroll
  for (int r = 0; r < 16; ++r) { const float rl = __builtin_amdgcn_rcpf(li_l[crow(r, hi)]);
#pragma unroll
    for (int d = 0; d < 4; ++d) o[d][r] *= rl; }
  asm volatile("s_waitcnt lgkmcnt(0)" ::: "memory"); WBAR();
#undef GLDS
#undef ISSUE_K
#undef ISSUE_V
#undef WAITV
#undef WBAR
#undef RESC
#undef NXT3
#undef SEG_B
}
__device__ __forceinline__ void attn_core_da2(const Src in, const float C, const float thr, const int seq, LAS char* lds, f32x16 (&o1)[4], f32x16 (&o2)[4]) {
  constexpr int NSUB = 2, SHM_K = NSUB * 8192;
  int lane; asm volatile("v_and_b32 %0, 63, %1" : "=v"(lane) : "v"(threadIdx.x));
  const int tid = threadIdx.x, wid = __builtin_amdgcn_readfirstlane(tid >> 6), r32 = lane & 31, hi = (lane >> 5) & 1;
  LAS char* V_lds = lds; LAS char* K_lds = lds + 3 * SHM_V;
  LAS float* ws = (LAS float*)(lds + 3 * SHM_V + 3 * SHM_K) + wid * 64; LAS float* li_l = ws; LAS float* al_l = ws + 32;
  float m1 = -1e30f, l1 = 0, m2 = -1e30f, l2 = 0;
#pragma unroll
  for (int d = 0; d < 4; ++d) { o1[d] = f32x16{}; o2[d] = f32x16{}; }
  bf16x8 q1[4], q2[4];
  const bf16_t* Qw = in.Q + (size_t)(wid * QBLK + r32) * in.ldq + hi * 8;
#pragma unroll
  for (int d0 = 0; d0 < 4; ++d0) { q1[d0] = *(const bf16x8*)(Qw + d0 * 16); q2[d0] = *(const bf16x8*)(Qw + 64 + d0 * 16); }
  const int krow = wid * 8 + (lane >> 3), kslot = (lane & 7) ^ ((krow >> 1) & 7);
  const unsigned koff = (unsigned)(krow * in.ldk + kslot * 8) * 2u;
  unsigned voff[2];
#pragma unroll
  for (int i = 0; i < 2; ++i) { const int p = i * 8192 + wid * 1024 + lane * 16, st = p >> 9, wq = (p & 511) >> 1, kk = (st >> 2) * 8 + (wq >> 5), cl = wq & 31;
    const int k = (kk & ~0xC) | ((kk & 4) << 1) | ((kk & 8) >> 1); voff[i] = (unsigned)(k * in.ldv + (st & 3) * 32 + cl) * 2u; }
  const int vb0 = (int)(unsigned)(size_t)V_lds + v_rd_base(lane);
  const unsigned ldsw = (unsigned)wid * 1024u;
#define GLDS(gp, lp) __builtin_amdgcn_global_load_lds((const unsigned*)(gp), (LAS unsigned*)(lp), 16, 0, 0)
#define ISSUE_KV(t, b) do { const char* kb_ = (const char*)in.K + (size_t)(t) * (KVBLK * 2) * in.ldk; const char* vb_ = (const char*)in.V + (size_t)(t) * (KVBLK * 2) * in.ldv; \
    GLDS(kb_ + koff, K_lds + (b) * SHM_K + ldsw); GLDS(kb_ + 128 + koff, K_lds + (b) * SHM_K + 8192 + ldsw); \
    GLDS(vb_ + voff[0], V_lds + (b) * SHM_V + ldsw); GLDS(vb_ + voff[1], V_lds + (b) * SHM_V + 8192 + ldsw); } while (0)
#define WAITV(n) asm volatile("s_waitcnt vmcnt(%0)" :: "n"(n) : "memory")
#define WBAR() do { asm volatile("" ::: "memory"); __builtin_amdgcn_s_barrier(); asm volatile("" ::: "memory"); } while (0)
#define RESC(oo, a) do { if (__any((a) < 1.f)) { if (hi == 0) al_l[r32] = (a); asm volatile("s_waitcnt lgkmcnt(0)" ::: "memory"); \
    _Pragma("unroll") for (int d = 0; d < 4; ++d) _Pragma("unroll") for (int r = 0; r < 16; ++r) oo[d][r] *= al_l[crow(r, hi)]; asm volatile("s_waitcnt lgkmcnt(0)" ::: "memory"); } } while (0)
#define NXT3(x) ((x) == 2 ? 0 : (x) + 1)
#define TILE_BODY(b) do { f32x16 p0, p1; float mn, al; bf16x8 pa0, pa1, pa2, pa3; \
    qkt<64>(p0, p1, K_lds + (b) * SHM_K, q1, r32, hi); partialSM(p0, p1, m1, mn, al, C, thr); RESC(o1, al); \
    finishSM(p0, p1, al, l1, pa0, pa1, pa2, pa3); SBAR(); pv_d0(o1, vb0 + (b) * SHM_V, pa0, pa1, pa2, pa3); SBAR(); \
    qkt<64>(p0, p1, K_lds + (b) * SHM_K + 8192, q2, r32, hi); partialSM(p0, p1, m2, mn, al, C, thr); RESC(o2, al); \
    finishSM(p0, p1, al, l2, pa0, pa1, pa2, pa3); SBAR(); pv_d0(o2, vb0 + (b) * SHM_V, pa0, pa1, pa2, pa3); SBAR(); } while (0)
  const int NT = seq / KVBLK;
  ISSUE_KV(0, 0); ISSUE_KV(1, 1);
  int bq = 0;
  for (int j = 0; j + 1 < NT; ++j) {
    const int b1 = NXT3(bq), b2 = NXT3(b1);
    WAITV(4); WBAR();
    if (j + 2 < NT) ISSUE_KV(j + 2, b2); else ISSUE_KV(NT - 1, b2);
    TILE_BODY(bq);
    bq = b1;
  }
  WAITV(4); WBAR();
  TILE_BODY(bq);
  WAITV(0);
  if (hi == 0) { li_l[r32] = l1; al_l[r32] = l2; } asm volatile("s_waitcnt lgkmcnt(0)" ::: "memory");
#pragma unroll
  for (int r = 0; r < 16; ++r) { const float ra = __builtin_amdgcn_rcpf(li_l[crow(r, hi)]), rb = __builtin_amdgcn_rcpf(al_l[crow(r, hi)]);
#pragma unroll
    for (int d = 0; d < 4; ++d) { o1[d][r] *= ra; o2[d][r] *= rb; } }
  asm volatile("s_waitcnt lgkmcnt(0)" ::: "memory"); WBAR();
#undef GLDS
#undef ISSUE_KV
#undef WAITV
#undef WBAR
#undef RESC
#undef NXT3
#undef TILE_BODY
}
template <int I> struct IC { static constexpr int value = I; };
template <int LO, int HI, class F> __device__ __forceinline__ void sfor(F&& f) { if constexpr (LO < HI) { f(IC<LO>{}); sfor<LO + 1, HI>(f); } }
struct SMS { float a0, a1, a2, a3, dm; bool keep; };
__device__ __forceinline__ void mfma_c(f32x16& d, const bf16x8& a, const bf16x8& b, const f32x16& c) { asm("v_mfma_f32_32x32x16_bf16 %0, %1, %2, %3" : "=&v"(d) : "v"(a), "v"(b), "v"(c)); }
__device__ __forceinline__ void negm_bcast(f32x16& negm, float aone, float nm) { asm volatile("s_nop 1\n\tv_mfma_f32_32x32x2_f32 %0, %1, %2, 0\n\ts_nop 15\n\ts_nop 3" : "+v"(negm) : "v"(aone), "v"(nm)); }

struct VF { s16x4 l, h; };
template <int NEX> struct StartSched {
  static constexpr int NITEMS = 17 + NEX;
  static constexpr int kind(int n) { return n < 16 ? 0 : n == 16 ? 1 : 3; }
  static constexpr int idx(int n) { return n <= 16 ? n : n - 17; }
  static constexpr int weight(int n) { const int k = kind(n); return k == 3 ? 2 : k == 1 ? 3 : 1; }
  static constexpr int first(int g, int ng) { int W = 0; for (int i = 0; i < NITEMS; ++i) W += weight(i); int cum = 0; for (int i = 0; i < NITEMS; ++i) { if (cum * ng >= g * W) return i; cum += weight(i); } return NITEMS; }
};
template <int NEX> struct FinSched {
  static constexpr int NITEMS = NEX + 16;
  static constexpr int weight(int n) { return n < NEX ? 2 : 1; }
  static constexpr int first(int g, int ng) { int W = 0; for (int i = 0; i < NITEMS; ++i) W += weight(i); int cum = 0; for (int i = 0; i < NITEMS; ++i) { if (cum * ng >= g * W) return i; cum += weight(i); } return NITEMS; }
};
template <int N, int NEX> __device__ __forceinline__ void start_item(f32x16& P0, f32x16& P1, SMS& st, f32x16& negm, const float thr, const float hi_is0) {
  using SS = StartSched<NEX>; constexpr int K = SS::kind(N), I = SS::idx(N);
  if constexpr (K == 0) {
    if constexpr (I == 0) st.a0 = fmaxf(fmaxf(P0[0], P0[1]), P0[2]);
    else if constexpr (I == 1) st.a1 = fmaxf(fmaxf(P0[3], P0[4]), P0[5]);
    else if constexpr (I < 7) { if constexpr (I & 1) st.a1 = fmaxf(fmaxf(st.a1, P0[2 * I + 2]), P0[2 * I + 3]); else st.a0 = fmaxf(fmaxf(st.a0, P0[2 * I + 2]), P0[2 * I + 3]); }
    else if constexpr (I == 7) st.a2 = fmaxf(fmaxf(P1[0], P1[1]), P1[2]);
    else if constexpr (I == 8) st.a3 = fmaxf(fmaxf(P1[3], P1[4]), P1[5]);
    else if constexpr (I < 14) { constexpr int J = I - 7; if constexpr (J & 1) st.a3 = fmaxf(fmaxf(st.a3, P1[2 * J + 2]), P1[2 * J + 3]); else st.a2 = fmaxf(fmaxf(st.a2, P1[2 * J + 2]), P1[2 * J + 3]); }
    else if constexpr (I == 14) st.a0 = fmaxf(fmaxf(st.a0, st.a1), st.a2);
    else st.a0 = fmaxf(st.a0, st.a3);
  } else if constexpr (K == 1) {
    float pmax;
    { auto rr = __builtin_amdgcn_permlane32_swap(__float_as_uint(st.a0), __float_as_uint(st.a0), false, false); pmax = fmaxf(__uint_as_float(rr[0]), __uint_as_float(rr[1])); }
    st.keep = __all(pmax <= thr);
    if (__builtin_expect(!st.keep, 0)) {
      const float delta = fmaxf(pmax, 0.f); st.dm = -delta;
#pragma unroll
      for (int r = 0; r < 16; ++r) { P0[r] -= delta; P1[r] -= delta; }
      negm_bcast(negm, hi_is0, negm[0] - delta);
    }
  } else {
    if constexpr (I < 16) P0[I] = __builtin_amdgcn_exp2f(P0[I]); else P1[I - 16] = __builtin_amdgcn_exp2f(P1[I - 16]);
  }
}
template <int N, int NEX> __device__ __forceinline__ void fin_item(f32x16& P0, f32x16& P1, SMS& st, u32x4 (&pw)[4]) {
  if constexpr (N < NEX) { P1[16 - NEX + N] = __builtin_amdgcn_exp2f(P1[16 - NEX + N]); }
  else {
    constexpr int n = N - NEX, k = n / 4, j = n % 4, b = (k & 1) * 8 + 2 * j;
    f32x16& P = (k < 2) ? P0 : P1;
    pw[k][j] = cvt_pk_bf16(P[b], P[b + 1]);
  }
}
template <int N> __device__ __forceinline__ void v_wait(VF& f) { asm volatile("s_waitcnt lgkmcnt(%2)" : "+v"(f.l), "+v"(f.h) : "n"(N)); }
template <int G> __device__ __forceinline__ void v_issue(VF& f, int vb) { f.l = tr_read<v_rd_off(G & 3, G >> 2, 0)>(vb); f.h = tr_read<v_rd_off(G & 3, G >> 2, 1)>(vb); }

template <int DQK, int MAPS>
__device__ __forceinline__ void attn_core_pl(const Src in, const float C, const float thr, const int seq, LAS char* lds, f32x16 (&o)[4], float* probe = nullptr) {
  static_assert(DQK == 64 && MAPS == 2, "differential-attention configuration only");
  constexpr int SHM_K = 16384, NKS = DQK / 16, NG1 = 2 * NKS, NEXS = 32, NEXF = 0, VLA = 3;
  using SS = StartSched<NEXS>; using FS = FinSched<NEXF>;
  int lane; asm volatile("v_and_b32 %0, 63, %1" : "=v"(lane) : "v"(threadIdx.x));
  const int tid = threadIdx.x, wid = __builtin_amdgcn_readfirstlane(tid >> 6), r32 = lane & 31, hi = (lane >> 5) & 1, wq = wid & 3, mp = wid >> 2;
  LAS char* V_lds = lds; LAS char* K_lds = lds + 3 * SHM_V;
  LAS float* ws = (LAS float*)(lds + 3 * SHM_V + 3 * SHM_K) + wid * 64; LAS float* li_l = ws; LAS float* al_l = ws + 32;
  SMS st; st.dm = 0.f; st.keep = true;
  f32x16 negm = f32x16{};
#pragma unroll
  for (int d = 0; d < 4; ++d) o[d] = f32x16{};
  f32x16 osum = f32x16{};
  const bf16x8 ones = {16256, 16256, 16256, 16256, 16256, 16256, 16256, 16256};
  bf16x8 qr[NKS];
  const bf16_t* Qw = in.Q + (size_t)(wq * QBLK + r32) * in.ldq + mp * 64 + hi * 8;
#pragma unroll
  for (int d0 = 0; d0 < NKS; ++d0) qr[d0] = *(const bf16x8*)(Qw + d0 * 16);
  const int krow = wid * 8 + (lane >> 3), kslot = (lane & 7) ^ ((krow >> 1) & 7);
  const unsigned koff = (unsigned)(krow * in.ldk + kslot * 8) * 2u;
  unsigned voff[2];
#pragma unroll
  for (int i = 0; i < 2; ++i) { const int p = i * 8192 + wid * 1024 + lane * 16, s_ = p >> 9, wq_ = (p & 511) >> 1, kk = (s_ >> 2) * 8 + (wq_ >> 5), cl = wq_ & 31;
    voff[i] = (unsigned)(kk * in.ldv + (s_ & 3) * 32 + cl) * 2u; }
  const int vb0 = (int)(unsigned)(size_t)V_lds + v_rd_base(lane);
  const unsigned ldsw = (unsigned)wid * 1024u;
  const LAS char* Kw = K_lds + mp * 8192;
#define GLDS(gp, lp) __builtin_amdgcn_global_load_lds((const unsigned*)(gp), (LAS unsigned*)(lp), 16, 0, 0)
#define ISSUE_K(t, b) do { const char* kb_ = (const char*)in.K + (size_t)(t) * (KVBLK * 2) * in.ldk; \
    _Pragma("unroll") for (int rep_ = 0; rep_ < 1 + PROBE_DMA2; ++rep_) { GLDS(kb_ + koff, K_lds + (b) * SHM_K + ldsw); GLDS(kb_ + 128 + koff, K_lds + (b) * SHM_K + 8192 + ldsw); } } while (0)
#define ISSUE_V(t, b) do { const char* vb_ = (const char*)in.V + (size_t)(t) * (KVBLK * 2) * in.ldv; \
    _Pragma("unroll") for (int rep_ = 0; rep_ < 1 + PROBE_DMA2; ++rep_) { GLDS(vb_ + voff[0], V_lds + (b) * SHM_V + ldsw); GLDS(vb_ + voff[1], V_lds + (b) * SHM_V + 8192 + ldsw); } } while (0)
#define DMA_PIECE(i) do { DMA_PIECE1(i); if (PROBE_DMA2) DMA_PIECE1(i); } while (0)
#define DMA_PIECE1(i) do { if ((i) < 2) { const char* kb_ = (const char*)in.K + (size_t)tk_ * (KVBLK * 2) * in.ldk; GLDS(kb_ + (i) * 128 + koff, K_lds + bq * SHM_K + (i) * 8192 + ldsw); } \
    else { const char* vb_ = (const char*)in.V + (size_t)tv_ * (KVBLK * 2) * in.ldv; GLDS(vb_ + voff[(i) & 1], V_lds + b2 * SHM_V + ((i) & 1) * 8192 + ldsw); } } while (0)
#define WAITV(n) asm volatile("s_waitcnt vmcnt(%0)" :: "n"(n) : "memory")
#define WBAR() do { asm volatile("" ::: "memory"); __builtin_amdgcn_s_barrier(); asm volatile("" ::: "memory"); } while (0)
#define RESC() do { if (!st.keep) { int l2_; asm volatile("v_and_b32 %0, 63, %1" : "=v"(l2_) : "v"(threadIdx.x)); const int h2_ = l2_ >> 5; LAS float* al2_ = (LAS float*)(lds + 3 * SHM_V + 3 * SHM_K) + wid * 64 + 32; \
    if (h2_ == 0) al2_[l2_] = __builtin_amdgcn_exp2f(st.dm); asm volatile("s_waitcnt lgkmcnt(0)" ::: "memory"); \
    _Pragma("unroll") for (int r = 0; r < 16; ++r) { const float a_ = al2_[crow(r, h2_)]; osum[r] *= a_; _Pragma("unroll") for (int d = 0; d < 4; ++d) o[d][r] *= a_; } asm volatile("s_waitcnt lgkmcnt(0)" ::: "memory"); } } while (0)
#define NXT3(x) ((x) == 2 ? 0 : (x) + 1)
#define KFRAG(Ks, d, blk) (*(const LAS bf16x8*)((Ks) + KSW((blk) * 32 + r32, ((d) * 16 + hi * 8) * 2)))
#define PA(ks) (*reinterpret_cast<const bf16x8*>(&pw[ks]))
#define PKV(f) (bf16x8){f.l[0], f.l[1], f.l[2], f.l[3], f.h[0], f.h[1], f.h[2], f.h[3]}
#define PHASE1(PN0, PN1, PF0, PF1, Ks, vb) do { \
    bf16x8 kf[NKS][2]; kf[0][0] = KFRAG(Ks, 0, 0); kf[0][1] = KFRAG(Ks, 0, 1); \
    sfor<0, NG1>([&](auto gc) __attribute__((always_inline)) { constexpr int g = decltype(gc)::value, d = g >> 1, blk = g & 1; \
      if constexpr (blk == 0 && d + 1 < NKS) { kf[d + 1][0] = KFRAG(Ks, d + 1, 0); kf[d + 1][1] = KFRAG(Ks, d + 1, 1); } \
      if constexpr (blk == 0) { if constexpr (d == 0) mfma_c(PN0, kf[d][0], qr[d], negm); else PN0 = __builtin_amdgcn_mfma_f32_32x32x16_bf16(kf[d][0], qr[d], PN0, 0, 0, 0); } \
      else              { if constexpr (d == 0) mfma_c(PN1, kf[d][1], qr[d], negm); else PN1 = __builtin_amdgcn_mfma_f32_32x32x16_bf16(kf[d][1], qr[d], PN1, 0, 0, 0); } \
      if constexpr (DMA_SPREAD == 1 && g < 4) DMA_PIECE(g); \
      if constexpr (g >= NG1 - VLA) v_issue<g - (NG1 - VLA)>(vf[g - (NG1 - VLA)], vb); \
      sfor<FS::first(g, NG1), FS::first(g + 1, NG1)>([&](auto ic) __attribute__((always_inline)) { fin_item<decltype(ic)::value, NEXF>(PF0, PF1, st, pw); }); \
      SBAR(); }); } while (0)
#define PHASE2(PS0, PS1, vb) do { \
    sfor<0, 20>([&](auto gc) __attribute__((always_inline)) { constexpr int gg = decltype(gc)::value, ks = gg / 5, d = gg % 5, g = ks * 4 + d; \
      if constexpr (d < 4) { \
        v_wait<2 * (15 - g < VLA - 1 ? 15 - g : VLA - 1)>(vf[g]); \
        o[d] = __builtin_amdgcn_mfma_f32_32x32x16_bf16(PA(ks), PKV(vf[g]), o[d], 0, 0, 0); \
        if constexpr (g + VLA < 16) v_issue<g + VLA>(vf[g + VLA], vb); \
      } else { osum = __builtin_amdgcn_mfma_f32_32x32x16_bf16(PA(ks), ones, osum, 0, 0, 0); if constexpr (DMA_SPREAD == 2) DMA_PIECE(ks); } \
      sfor<SS::first(gg, 20), SS::first(gg + 1, 20)>([&](auto ic) __attribute__((always_inline)) { start_item<decltype(ic)::value, NEXS>(PS0, PS1, st, negm, thr, hi == 0 ? 1.f : 0.f); }); \
      SBAR(); }); \
    asm volatile("" : "+v"(PS0), "+v"(PS1)); \
    RESC(); } while (0)
  f32x16 pA0, pA1, pB0, pB1; u32x4 pw[4]; VF vf[16]; const int NT = seq / KVBLK;
  ISSUE_K(0, 0); ISSUE_K(1, 1); ISSUE_V(0, 0);
  WAITV(PROBE_DMA2 ? 8 : 4); WBAR();
  ISSUE_K(2, 2); ISSUE_V(1, 1);
  { bf16x8 kf[NKS][2];
#pragma unroll
    for (int d = 0; d < NKS; ++d) { kf[d][0] = KFRAG(Kw, d, 0); kf[d][1] = KFRAG(Kw, d, 1); }
    pA0 = f32x16{}; pA1 = f32x16{};
#pragma unroll
    for (int d = 0; d < NKS; ++d) { pA0 = __builtin_amdgcn_mfma_f32_32x32x16_bf16(kf[d][0], qr[d], pA0, 0, 0, 0); pA1 = __builtin_amdgcn_mfma_f32_32x32x16_bf16(kf[d][1], qr[d], pA1, 0, 0, 0); } }
  sfor<0, 16>([&](auto ic) __attribute__((always_inline)) { start_item<decltype(ic)::value, NEXS>(pA0, pA1, st, negm, thr, hi == 0 ? 1.f : 0.f); });
  { float pmax;
    { auto rr = __builtin_amdgcn_permlane32_swap(__float_as_uint(st.a0), __float_as_uint(st.a0), false, false); pmax = fmaxf(__uint_as_float(rr[0]), __uint_as_float(rr[1])); }
#pragma unroll
    for (int r = 0; r < 16; ++r) { pA0[r] -= pmax; pA1[r] -= pmax; negm[r] = -pmax; } }
  sfor<17, SS::NITEMS>([&](auto ic) __attribute__((always_inline)) { start_item<decltype(ic)::value, NEXS>(pA0, pA1, st, negm, thr, hi == 0 ? 1.f : 0.f); });
  int bq = 0;
#define ITER(j, PN0, PN1, PF0, PF1) do { const int b1 = NXT3(bq), b2 = NXT3(b1); \
    STAMP_A(); WAITV(PROBE_DMA2 ? 8 : 4); WBAR(); STAMP_B(); \
    const int tk_ = (j) + 3 < NT ? (j) + 3 : NT - 1, tv_ = (j) + 2 < NT ? (j) + 2 : NT - 1; if (DMA_SPREAD == 0) { ISSUE_K(tk_, bq); ISSUE_V(tv_, b2); } \
    PHASE1(PN0, PN1, PF0, PF1, Kw + b1 * SHM_K, vb0 + bq * SHM_V); STAMP_C(); \
    PHASE2(PN0, PN1, vb0 + bq * SHM_V); \
    bq = b1; } while (0)
#if PROBE_T
  unsigned long long tA = 0, tB = 0, accAB = 0, accBC = 0; const unsigned long long t0 = __builtin_amdgcn_s_memtime(), r0 = __builtin_amdgcn_s_memrealtime();
#define STAMP_A() do { if (PROBE_T >= 2) tA = __builtin_amdgcn_s_memtime(); } while (0)
#define STAMP_B() do { if (PROBE_T >= 2) { tB = __builtin_amdgcn_s_memtime(); accAB += tB - tA; } } while (0)
#define STAMP_C() do { if (PROBE_T == 3) { accBC += __builtin_amdgcn_s_memtime() - tB; } } while (0)
#else
#define STAMP_A()
#define STAMP_B()
#define STAMP_C()
#endif
  for (int j = 0; j + 2 < NT; j += 2) { ITER(j, pB0, pB1, pA0, pA1); ITER(j + 1, pA0, pA1, pB0, pB1); }
  ITER(NT - 2, pB0, pB1, pA0, pA1);
#if PROBE_T
  { const unsigned long long t1 = __builtin_amdgcn_s_memtime(), r1 = __builtin_amdgcn_s_memrealtime();
    if (probe != nullptr && tid == 0) {
      if (PROBE_T == 1) { probe[0] = (float)(t1 - t0) * (0.5e-6f / (NT - 1)); probe[1] = (float)(t1 - t0) / (float)(r1 - r0); }
      if (PROBE_T == 2) { probe[0] = (float)accAB * (0.5e-6f / (NT - 1)); probe[1] = ((float)(t1 - t0) * (1.f / (NT - 1)) - 1500.f) * 0.05f; }
      if (PROBE_T == 3) { probe[0] = (float)accBC * (0.5e-6f / (NT - 1)); probe[1] = (float)accAB * (0.01f / (NT - 1)); } } }
#endif
#undef STAMP_A
#undef STAMP_B
#undef STAMP_C
  sfor<0, FS::NITEMS>([&](auto ic) __attribute__((always_inline)) { fin_item<decltype(ic)::value, NEXF>(pB0, pB1, st, pw); });
  WAITV(0); WBAR();
  { const int vb = vb0 + bq * SHM_V;
    sfor<0, VLA>([&](auto gc) __attribute__((always_inline)) { v_issue<decltype(gc)::value>(vf[decltype(gc)::value], vb); });
    sfor<0, 16>([&](auto gc) __attribute__((always_inline)) { constexpr int g = decltype(gc)::value, ks = g >> 2, d = g & 3;
      v_wait<2 * (15 - g < VLA - 1 ? 15 - g : VLA - 1)>(vf[g]);
      o[d] = __builtin_amdgcn_mfma_f32_32x32x16_bf16(PA(ks), PKV(vf[g]), o[d], 0, 0, 0);
      if constexpr (g + VLA < 16) v_issue<g + VLA>(vf[g + VLA], vb);
      if constexpr (d == 3) osum = __builtin_amdgcn_mfma_f32_32x32x16_bf16(PA(ks), ones, osum, 0, 0, 0);
      SBAR(); }); }
#pragma unroll
  for (int r = 0; r < 16; ++r) { const float rl = __builtin_amdgcn_rcpf(osum[r]);
#pragma unroll
    for (int d = 0; d < 4; ++d) o[d][r] *= rl; }
  asm volatile("s_waitcnt lgkmcnt(0)" ::: "memory"); WBAR();
#undef GLDS
#undef ISSUE_K
#undef ISSUE_V
#undef WAITV
#undef WBAR
#undef RESC
#undef NXT3
#undef KFRAG
#undef PKV
#undef PA
#undef PHASE1
#undef DMA_PIECE
#undef DMA_PIECE1
#undef PHASE2
#undef ITER
}
struct BStart { static constexpr int NITEMS = 25;
  static constexpr int weight(int n) { return n < 8 ? 1 : n == 8 ? 3 : 2; }
  static constexpr int first(int g, int ng) { int W = 0; for (int i = 0; i < NITEMS; ++i) W += weight(i); int cum = 0; for (int i = 0; i < NITEMS; ++i) { if (cum * ng >= g * W) return i; cum += weight(i); } return NITEMS; } };
template <int N> __device__ __forceinline__ void bstart_item(f32x16& P, SMS& st, f32x16& negm, const float thr, const float hi_is0) {
  if constexpr (N == 0) st.a0 = fmaxf(fmaxf(P[0], P[1]), P[2]);
  else if constexpr (N == 1) st.a1 = fmaxf(fmaxf(P[3], P[4]), P[5]);
  else if constexpr (N < 7) { if constexpr (N & 1) st.a1 = fmaxf(fmaxf(st.a1, P[2 * N + 2]), P[2 * N + 3]); else st.a0 = fmaxf(fmaxf(st.a0, P[2 * N + 2]), P[2 * N + 3]); }
  else if constexpr (N == 7) st.a0 = fmaxf(st.a0, st.a1);
  else if constexpr (N == 8) {
    float pmax;
    { auto rr = __builtin_amdgcn_permlane32_swap(__float_as_uint(st.a0), __float_as_uint(st.a0), false, false); pmax = fmaxf(__uint_as_float(rr[0]), __uint_as_float(rr[1])); }
    st.keep = __all(pmax <= thr);
    if (__builtin_expect(!st.keep, 0)) {
      const float delta = fmaxf(pmax, 0.f); st.dm = -delta;
#pragma unroll
      for (int r = 0; r < 16; ++r) P[r] -= delta;
      negm_bcast(negm, hi_is0, negm[0] - delta);
    }
  } else { constexpr int I = N - 9; P[I] = __builtin_amdgcn_exp2f(P[I]); }
}
template <int N> __device__ __forceinline__ void bfin_item(f32x16& P, u32x4 (&pw)[2]) { constexpr int k = N / 4, j = N % 4; pw[k][j] = cvt_pk_bf16(P[8 * k + 2 * j], P[8 * k + 2 * j + 1]); }
constexpr int bfin_first(int g, int ng) { return g * 8 / ng; }

template <int OFF> __device__ __forceinline__ void k_read(bf16x8& r, int addr) { asm volatile("ds_read_b128 %0, %1 offset:%2" : "=&v"(r) : "v"(addr), "i"(OFF) : "memory"); }
template <int N> __device__ __forceinline__ void k_wait(bf16x8& f) { asm volatile("s_waitcnt lgkmcnt(%1)" : "+v"(f) : "n"(N)); }
constexpr int kwait_n(int g, int nks, int kla, int vla) {
  int kk = kla - 1 < nks - 1 - g ? kla - 1 : nks - 1 - g; if (kk < 0) kk = 0;
  int lo = nks - vla > g - kla ? nks - vla : g - kla; int vv = g - lo; if (vv < 0) vv = 0;
  return kk + 2 * vv; }
template <int DQK, int MAPS>
__device__ __forceinline__ void attn_core_bp(const Src in, const float thr, const int seq, LAS char* lds, f32x16 (&o)[4], float* probe = nullptr) {
  constexpr int NSUB = MAPS == 2 ? 2 : DQK / 64, SHM_K = NSUB * 8192, NKS = DQK / 16, NI = NSUB + 2, VLA = BP_VLA, KLA = BP_KLA;
  int lane; asm volatile("v_and_b32 %0, 63, %1" : "=v"(lane) : "v"(threadIdx.x));
  const int tid = threadIdx.x, wid = __builtin_amdgcn_readfirstlane(tid >> 6), r32 = lane & 31, hi = (lane >> 5) & 1, wq = MAPS == 2 ? (wid & 3) : wid, mp = MAPS == 2 ? (wid >> 2) : 0;
  LAS char* V_lds = lds; LAS char* K_lds = lds + 4 * SHM_V;
  SMS st; st.dm = 0.f; st.keep = true;
  f32x16 negm = f32x16{}, osum = f32x16{};
#pragma unroll
  for (int d = 0; d < 4; ++d) o[d] = f32x16{};
  const bf16x8 ones = {16256, 16256, 16256, 16256, 16256, 16256, 16256, 16256};
  bf16x8 qr[NKS];
  { const bf16_t* Qw = in.Q + (size_t)(wq * QBLK + r32) * in.ldq + mp * 64 + hi * 8;
#pragma unroll
    for (int d0 = 0; d0 < NKS; ++d0) qr[d0] = *(const bf16x8*)(Qw + d0 * 16); }
  const int krow = wid * 8 + (lane >> 3), kslot = (lane & 7) ^ ((krow >> 1) & 7);
  const unsigned koff = (unsigned)(krow * in.ldk + kslot * 8) * 2u, k2off = (unsigned)(krow * in.ldk2 + kslot * 8) * 2u;
  unsigned voff[2];
#pragma unroll
  for (int i = 0; i < 2; ++i) { const int p = i * 8192 + wid * 1024 + lane * 16, s_ = p >> 9, wq_ = (p & 511) >> 1, kk = (s_ >> 2) * 8 + (wq_ >> 5), cl = wq_ & 31;
    voff[i] = (unsigned)(kk * in.ldv + (s_ & 3) * 32 + cl) * 2u; }
  const int vb0 = (int)(unsigned)(size_t)V_lds + v_rd_base(lane);
  const unsigned ldsw = (unsigned)wid * 1024u;
  const LAS char* Kw = K_lds + mp * 8192;
  int kxo[4];
#pragma unroll
  for (int i = 0; i < 4; ++i) kxo[i] = r32 * 128 + ((i * 32 + hi * 16) ^ (((r32 >> 1) & 7) << 4));
#define GLDS(gp, lp) __builtin_amdgcn_global_load_lds((const unsigned*)(gp), (LAS unsigned*)(lp), 16, 0, 0)
#define PIECE(i, tk, bk, tv, bv) do { \
    if ((i) < NSUB) { if (MAPS == 2 || (i) < 2) GLDS((const char*)in.K + (size_t)(tk) * (KVBLK * 2) * in.ldk + (i) * 128 + koff, K_lds + (bk) * SHM_K + (i) * 8192 + ldsw); \
                      else GLDS((const char*)in.K2 + (size_t)(tk) * (KVBLK * 2) * in.ldk2 + k2off, K_lds + (bk) * SHM_K + (i) * 8192 + ldsw); } \
    else GLDS((const char*)in.V + (size_t)(tv) * (KVBLK * 2) * in.ldv + voff[((i) - NSUB) & 1], V_lds + (bv) * SHM_V + (((i) - NSUB) & 1) * 8192 + ldsw); } while (0)
#define WAITV(n) asm volatile("s_waitcnt vmcnt(%0)" :: "n"(n) : "memory")
#define WBAR() do { asm volatile("" ::: "memory"); __builtin_amdgcn_s_barrier(); asm volatile("" ::: "memory"); } while (0)
#define RESC() do { if (!st.keep) { int l2_; asm volatile("v_and_b32 %0, 63, %1" : "=v"(l2_) : "v"(threadIdx.x)); const int h2_ = l2_ >> 5; LAS float* al2_ = (LAS float*)(lds + MISC_OFF + 128) + wid * 32; \
    if (h2_ == 0) al2_[l2_] = __builtin_amdgcn_exp2f(st.dm); asm volatile("s_waitcnt lgkmcnt(0)" ::: "memory"); \
    _Pragma("unroll") for (int r = 0; r < 16; ++r) { const float a_ = al2_[crow(r, h2_)]; osum[r] *= a_; _Pragma("unroll") for (int d = 0; d < 4; ++d) o[d][r] *= a_; } asm volatile("s_waitcnt lgkmcnt(0)" ::: "memory"); } } while (0)
#define NXT3(x) ((x) == 2 ? 0 : (x) + 1)
#define KFRAG(Ks, d, blk) (*(const LAS bf16x8*)((Ks) + ((d) >> 2) * 8192 + KSW((blk) * 32 + r32, (((d) & 3) * 16 + hi * 8) * 2)))
#define PA(k) (*reinterpret_cast<const bf16x8*>(&pw[k]))
#define PKV(f) (bf16x8){f.l[0], f.l[1], f.l[2], f.l[3], f.h[0], f.h[1], f.h[2], f.h[3]}
#define BITER(BPAR, PN, PF, Kq, vb, DO_DMA) do { \
    { bf16x8 kf[NKS]; int ka_[4]; { const int kb_ = (int)(unsigned)(size_t)(Kq); _Pragma("unroll") for (int i_ = 0; i_ < 4; ++i_) ka_[i_] = kb_ + kxo[i_]; } \
      sfor<0, KLA>([&](auto dc) __attribute__((always_inline)) { constexpr int d_ = decltype(dc)::value; k_read<(d_ >> 2) * 8192 + (1 - (BPAR)) * 4096>(kf[d_], ka_[d_ & 3]); }); \
      sfor<0, NKS>([&](auto gc) __attribute__((always_inline)) { constexpr int g = decltype(gc)::value; \
        k_wait<kwait_n(g, NKS, KLA, VLA)>(kf[g]); \
        if constexpr (g + KLA < NKS) k_read<((g + KLA) >> 2) * 8192 + (1 - (BPAR)) * 4096>(kf[g + KLA], ka_[(g + KLA) & 3]); \
        if constexpr (g == 0) mfma_c(PN, kf[g], qr[g], negm); else PN = __builtin_amdgcn_mfma_f32_32x32x16_bf16(kf[g], qr[g], PN, 0, 0, 0); \
        if constexpr ((DO_DMA) && g < NI) PIECE(g, tk_, bk_, tv_, bv_); \
        if constexpr (g >= NKS - VLA) v_issue<8 * (BPAR) + g - (NKS - VLA)>(vf[g - (NKS - VLA)], vb); \
        sfor<bfin_first(g, NKS), bfin_first(g + 1, NKS)>([&](auto ic) __attribute__((always_inline)) { bfin_item<decltype(ic)::value>(PF, pw); }); \
        SBAR(); }); } \
    sfor<0, 10>([&](auto gc) __attribute__((always_inline)) { constexpr int gg = decltype(gc)::value, ksl = gg / 5, d = gg % 5, g = ksl * 4 + d; \
      if constexpr (d < 4) { \
        v_wait<2 * (7 - g < VLA - 1 ? 7 - g : VLA - 1)>(vf[g]); \
        o[d] = __builtin_amdgcn_mfma_f32_32x32x16_bf16(PA(ksl), PKV(vf[g]), o[d], 0, 0, 0); \
        if constexpr (g + VLA < 8) v_issue<8 * (BPAR) + g + VLA>(vf[g + VLA], vb); \
      } else osum = __builtin_amdgcn_mfma_f32_32x32x16_bf16(PA(ksl), ones, osum, 0, 0, 0); \
      if constexpr (gg > 0) sfor<BStart::first(gg - 1, 9), BStart::first(gg, 9)>([&](auto ic) __attribute__((always_inline)) { bstart_item<decltype(ic)::value>(PN, st, negm, thr, hi == 0 ? 1.f : 0.f); });     \
      SBAR(); }); \
    asm volatile("" : "+v"(PN)); \
    RESC(); } while (0)
  f32x16 pA, pB; u32x4 pw[2]; VF vf[8]; const int NT = seq / KVBLK;
#pragma unroll
  for (int t = 0; t < 3; ++t) {
#pragma unroll
    for (int i = 0; i < NI; ++i) PIECE(i, t, t, t, t); }
  WAITV(2 * NI); WBAR();
  { bf16x8 kf[NKS];
#pragma unroll
    for (int d = 0; d < NKS; ++d) kf[d] = KFRAG(Kw, d, 0);
    pA = f32x16{};
#pragma unroll
    for (int d = 0; d < NKS; ++d) pA = __builtin_amdgcn_mfma_f32_32x32x16_bf16(kf[d], qr[d], pA, 0, 0, 0); }
  sfor<0, 8>([&](auto ic) __attribute__((always_inline)) { bstart_item<decltype(ic)::value>(pA, st, negm, thr, hi == 0 ? 1.f : 0.f); });
  { float pmax;
    { auto rr = __builtin_amdgcn_permlane32_swap(__float_as_uint(st.a0), __float_as_uint(st.a0), false, false); pmax = fmaxf(__uint_as_float(rr[0]), __uint_as_float(rr[1])); }
#pragma unroll
    for (int r = 0; r < 16; ++r) { pA[r] -= pmax; negm[r] = -pmax; } }
  sfor<9, BStart::NITEMS>([&](auto ic) __attribute__((always_inline)) { bstart_item<decltype(ic)::value>(pA, st, negm, thr, hi == 0 ? 1.f : 0.f); });
  int kq = 0;
#if PROBE_T == 5
  const unsigned long long t0 = __builtin_amdgcn_s_memtime();
#endif
  for (int t = 0; t + 1 < NT; ++t) {
    const int k1 = NXT3(kq), vq = t & 3;
    const int tk_ = t + 3 < NT ? t + 3 : NT - 1, tv_ = tk_, bk_ = kq, bv_ = (t + 3) & 3;
    BITER(0, pB, pA, Kw + kq * SHM_K, vb0 + vq * SHM_V, false);
    WAITV(NI); WBAR();
    BITER(1, pA, pB, Kw + k1 * SHM_K, vb0 + vq * SHM_V, true);
    kq = k1;
  }
#if PROBE_T == 5
  { const unsigned long long t1 = __builtin_amdgcn_s_memtime(); if (probe != nullptr && tid == 0) { probe[0] = 0.f; probe[1] = ((float)(t1 - t0) * (1.f / (NT - 1)) - PROBE_BASE) * 0.05f; } }
#endif
  { const int vq = (NT - 1) & 3; const int tk_ = 0, tv_ = 0, bk_ = 0, bv_ = 0; (void)tk_; (void)tv_; (void)bk_; (void)bv_;
    BITER(0, pB, pA, Kw + kq * SHM_K, vb0 + vq * SHM_V, false);
    sfor<0, 8>([&](auto ic) __attribute__((always_inline)) { bfin_item<decltype(ic)::value>(pB, pw); });
    const int vb = vb0 + vq * SHM_V;
    sfor<0, VLA>([&](auto gc) __attribute__((always_inline)) { v_issue<8 + decltype(gc)::value>(vf[decltype(gc)::value], vb); });
    sfor<0, 8>([&](auto gc) __attribute__((always_inline)) { constexpr int g = decltype(gc)::value, ksl = g >> 2, d = g & 3;
      v_wait<2 * (7 - g < VLA - 1 ? 7 - g : VLA - 1)>(vf[g]);
      o[d] = __builtin_amdgcn_mfma_f32_32x32x16_bf16(PA(ksl), PKV(vf[g]), o[d], 0, 0, 0);
      if constexpr (g + VLA < 8) v_issue<8 + g + VLA>(vf[g + VLA], vb);
      if constexpr (d == 3) osum = __builtin_amdgcn_mfma_f32_32x32x16_bf16(PA(ksl), ones, osum, 0, 0, 0);
      SBAR(); }); }
#pragma unroll
  for (int r = 0; r < 16; ++r) { const float rl = __builtin_amdgcn_rcpf(osum[r]);
#pragma unroll
    for (int d = 0; d < 4; ++d) o[d][r] *= rl; }
  WAITV(0); asm volatile("s_waitcnt lgkmcnt(0)" ::: "memory"); WBAR();
#undef GLDS
#undef PIECE
#undef WAITV
#undef WBAR
#undef RESC
#undef NXT3
#undef KFRAG
#undef PA
#undef PKV
#undef BITER
}
struct Src8 { const unsigned char* q8; const unsigned char* k8n; const unsigned char* k8r; const bf16_t* V; int ldv; };
typedef int v8i_att __attribute__((ext_vector_type(8))); typedef int v4i_att __attribute__((ext_vector_type(4)));
__device__ __forceinline__ void attn_core_bp8(const Src8 in, const float thr, const int seq, LAS char* lds, f32x16 (&o)[4], float* probe = nullptr) {
  constexpr int SHM_K = 3 * 4096, NKS = 3, NI = 4, VLA = 3;
  int lane; asm volatile("v_and_b32 %0, 63, %1" : "=v"(lane) : "v"(threadIdx.x));
  const int tid = threadIdx.x, wid = __builtin_amdgcn_readfirstlane(tid >> 6), r32 = lane & 31, hi = (lane >> 5) & 1;
  LAS char* V_lds = lds; LAS char* K_lds = lds + 4 * SHM_V;
  SMS st; st.dm = 0.f; st.keep = true;
  f32x16 negm = f32x16{}, osum = f32x16{};
#pragma unroll
  for (int d = 0; d < 4; ++d) o[d] = f32x16{};
  const bf16x8 ones = {16256, 16256, 16256, 16256, 16256, 16256, 16256, 16256};
  v8i_att qf[NKS];
  { const unsigned char* Qw = in.q8 + (size_t)(wid * QBLK + r32) * 1536 + hi * 32;
#pragma unroll
    for (int s = 0; s < NKS; ++s) { const v4i_att lo = *(const v4i_att*)(Qw + s * 64), hh = *(const v4i_att*)(Qw + s * 64 + 16); qf[s] = __builtin_shufflevector(lo, hh, 0, 1, 2, 3, 4, 5, 6, 7); } }
  unsigned ksrc[2]; int kdst[2]; bool krot[2];
#pragma unroll
  for (int i = 0; i < 2; ++i) { const int p0 = wid * 2 + i, p = p0 < 12 ? p0 : p0 - 4, s = p >> 2, q = p & 3, row = q * 16 + (lane >> 2), lc = (lane & 3) ^ ((lane >> 4) & 3);
    krot[i] = (s == 2); ksrc[i] = krot[i] ? (unsigned)(row * 64 + lc * 16) : (unsigned)(row * 1024 + s * 64 + lc * 16); kdst[i] = s * 4096 + q * 1024 + lane * 16; }
  unsigned voff[2];
#pragma unroll
  for (int i = 0; i < 2; ++i) { const int p = i * 8192 + wid * 1024 + lane * 16, s_ = p >> 9, wq_ = (p & 511) >> 1, kk = (s_ >> 2) * 8 + (wq_ >> 5), cl = wq_ & 31;
    voff[i] = (unsigned)(kk * in.ldv + (s_ & 3) * 32 + cl) * 2u; }
  const int vb0 = (int)(unsigned)(size_t)V_lds + v_rd_base(lane);
  const unsigned ldsw = (unsigned)wid * 1024u;
  int kx[2];
#pragma unroll
  for (int c = 0; c < 2; ++c) kx[c] = r32 * 64 + (((2 * hi + c) ^ ((r32 >> 2) & 3)) << 4);
#define GLDS(gp, lp) __builtin_amdgcn_global_load_lds((const unsigned*)(gp), (LAS unsigned*)(lp), 16, 0, 0)
#define PIECE(i, tk, bk, tv, bv) do { \
    if ((i) < 2) { if (krot[(i) & 1]) GLDS(in.k8r + (size_t)(tk) * (KVBLK * 64) + ksrc[(i) & 1], K_lds + (bk) * SHM_K + kdst[(i) & 1]); \
                   else GLDS(in.k8n + (size_t)(tk) * (KVBLK * 1024) + ksrc[(i) & 1], K_lds + (bk) * SHM_K + kdst[(i) & 1]); } \
    else GLDS((const char*)in.V + (size_t)(tv) * (KVBLK * 2) * in.ldv + voff[(i) & 1], V_lds + (bv) * SHM_V + ((i) & 1) * 8192 + ldsw); } while (0)
#define WAITV(n) asm volatile("s_waitcnt vmcnt(%0)" :: "n"(n) : "memory")
#define WBAR() do { asm volatile("" ::: "memory"); __builtin_amdgcn_s_barrier(); asm volatile("" ::: "memory"); } while (0)
#define RESC() do { if (!st.keep) { int l2_; asm volatile("v_and_b32 %0, 63, %1" : "=v"(l2_) : "v"(threadIdx.x)); const int h2_ = l2_ >> 5; LAS float* al2_ = (LAS float*)(lds + MISC_OFF + 128) + wid * 32; \
    if (h2_ == 0) al2_[l2_] = __builtin_amdgcn_exp2f(st.dm); asm volatile("s_waitcnt lgkmcnt(0)" ::: "memory"); \
    _Pragma("unroll") for (int r = 0; r < 16; ++r) { const float a_ = al2_[crow(r, h2_)]; osum[r] *= a_; _Pragma("unroll") for (int d = 0; d < 4; ++d) o[d][r] *= a_; } asm volatile("s_waitcnt lgkmcnt(0)" ::: "memory"); } } while (0)
#define NXT3(x) ((x) == 2 ? 0 : (x) + 1)
#define PA(k) (*reinterpret_cast<const bf16x8*>(&pw[k]))
#define PKV(f) (bf16x8){f.l[0], f.l[1], f.l[2], f.l[3], f.h[0], f.h[1], f.h[2], f.h[3]}
#define KCAT(lo_, hi_) __builtin_shufflevector(__builtin_bit_cast(v4i_att, lo_), __builtin_bit_cast(v4i_att, hi_), 0, 1, 2, 3, 4, 5, 6, 7)
#define QK8(C_, s_) __builtin_amdgcn_mfma_scale_f32_32x32x64_f8f6f4(KCAT(kl[s_], kh[s_]), qf[s_], C_, 0, 0, 0, 0x7f7f7f7f, 0, 0x7c7c7c7c)
#define BITER(BPAR, PN, PF, Kq, vb, DO_DMA) do { \
    { bf16x8 kl[NKS], kh[NKS]; const int kb0_ = (int)(unsigned)(size_t)(Kq) + kx[0], kb1_ = (int)(unsigned)(size_t)(Kq) + kx[1]; \
      sfor<0, NKS>([&](auto dc) __attribute__((always_inline)) { constexpr int s_ = decltype(dc)::value; k_read<s_ * 4096 + (1 - (BPAR)) * 2048>(kl[s_], kb0_); k_read<s_ * 4096 + (1 - (BPAR)) * 2048>(kh[s_], kb1_); }); \
      sfor<0, NKS>([&](auto gc) __attribute__((always_inline)) { constexpr int g = decltype(gc)::value; \
        asm volatile("s_waitcnt lgkmcnt(4)" : "+v"(kl[g]), "+v"(kh[g])); \
        if constexpr (g == 0) PN = QK8(negm, 0); else PN = QK8(PN, g); \
        if constexpr (DO_DMA) { if constexpr (g == 0) { PIECE(0, tk_, bk_, tv_, bv_); PIECE(1, tk_, bk_, tv_, bv_); } else PIECE(g + 1, tk_, bk_, tv_, bv_); } \
        v_issue<8 * (BPAR) + g>(vf[g], vb); \
        sfor<g * 8 / 3, (g + 1) * 8 / 3>([&](auto ic) __attribute__((always_inline)) { bfin_item<decltype(ic)::value>(PF, pw); }); \
        SBAR(); }); } \
    sfor<0, 10>([&](auto gc) __attribute__((always_inline)) { constexpr int gg = decltype(gc)::value, ksl = gg / 5, d = gg % 5, g = ksl * 4 + d; \
      if constexpr (d < 4) { \
        v_wait<2 * (7 - g < VLA - 1 ? 7 - g : VLA - 1)>(vf[g]); \
        o[d] = __builtin_amdgcn_mfma_f32_32x32x16_bf16(PA(ksl), PKV(vf[g]), o[d], 0, 0, 0); \
        if constexpr (g + VLA < 8) v_issue<8 * (BPAR) + g + VLA>(vf[g + VLA], vb); \
      } else osum = __builtin_amdgcn_mfma_f32_32x32x16_bf16(PA(ksl), ones, osum, 0, 0, 0); \
      if constexpr (gg > 0) sfor<BStart::first(gg - 1, 9), BStart::first(gg, 9)>([&](auto ic) __attribute__((always_inline)) { bstart_item<decltype(ic)::value>(PN, st, negm, thr, hi == 0 ? 1.f : 0.f); }); \
      SBAR(); }); \
    asm volatile("" : "+v"(PN)); \
    RESC(); } while (0)
  f32x16 pA, pB; u32x4 pw[2]; VF vf[8]; const int NT = seq / KVBLK;
#pragma unroll
  for (int t = 0; t < 3; ++t) {
#pragma unroll
    for (int i = 0; i < NI; ++i) PIECE(i, t, t, t, t); }
  WAITV(2 * NI); WBAR();
  { const LAS char* K0 = K_lds; pA = f32x16{};
#pragma unroll
    for (int s = 0; s < NKS; ++s) { const bf16x8 lo = *(const LAS bf16x8*)(K0 + s * 4096 + kx[0]), hh = *(const LAS bf16x8*)(K0 + s * 4096 + kx[1]);
      pA = __builtin_amdgcn_mfma_scale_f32_32x32x64_f8f6f4(KCAT(lo, hh), qf[s], pA, 0, 0, 0, 0x7f7f7f7f, 0, 0x7c7c7c7c); } }
  sfor<0, 8>([&](auto ic) __attribute__((always_inline)) { bstart_item<decltype(ic)::value>(pA, st, negm, thr, hi == 0 ? 1.f : 0.f); });
  { float pmax;
    { auto rr = __builtin_amdgcn_permlane32_swap(__float_as_uint(st.a0), __float_as_uint(st.a0), false, false); pmax = fmaxf(__uint_as_float(rr[0]), __uint_as_float(rr[1])); }
#pragma unroll
    for (int r = 0; r < 16; ++r) { pA[r] -= pmax; negm[r] = -pmax; } }
  sfor<9, BStart::NITEMS>([&](auto ic) __attribute__((always_inline)) { bstart_item<decltype(ic)::value>(pA, st, negm, thr, hi == 0 ? 1.f : 0.f); });
  int kq = 0;
#if PROBE_T == 5
  const unsigned long long t0 = __builtin_amdgcn_s_memtime();
#endif
  for (int t = 0; t + 1 < NT; ++t) {
    const int k1 = NXT3(kq), vq = t & 3;
    const int tk_ = t + 3 < NT ? t + 3 : NT - 1, tv_ = tk_, bk_ = kq, bv_ = (t + 3) & 3;
    BITER(0, pB, pA, K_lds + kq * SHM_K, vb0 + vq * SHM_V, false);
    WAITV(NI); WBAR();
    BITER(1, pA, pB, K_lds + k1 * SHM_K, vb0 + vq * SHM_V, true);
    kq = k1;
  }
#if PROBE_T == 5
  { const unsigned long long t1 = __builtin_amdgcn_s_memtime(); if (probe != nullptr && tid == 0) { probe[0] = 0.f; probe[1] = ((float)(t1 - t0) * (1.f / (NT - 1)) - PROBE_BASE) * 0.05f; } }
#endif
  { const int vq = (NT - 1) & 3; const int tk_ = 0, tv_ = 0, bk_ = 0, bv_ = 0; (void)tk_; (void)tv_; (void)bk_; (void)bv_;
    BITER(0, pB, pA, K_lds + kq * SHM_K, vb0 + vq * SHM_V, false);
    sfor<0, 8>([&](auto ic) __attribute__((always_inline)) { bfin_item<decltype(ic)::value>(pB, pw); });
    const int vb = vb0 + vq * SHM_V;
    sfor<0, VLA>([&](auto gc) __attribute__((always_inline)) { v_issue<8 + decltype(gc)::value>(vf[decltype(gc)::value], vb); });
    sfor<0, 8>([&](auto gc) __attribute__((always_inline)) { constexpr int g = decltype(gc)::value, ksl = g >> 2, d = g & 3;
      v_wait<2 * (7 - g < VLA - 1 ? 7 - g : VLA - 1)>(vf[g]);
      o[d] = __builtin_amdgcn_mfma_f32_32x32x16_bf16(PA(ksl), PKV(vf[g]), o[d], 0, 0, 0);
      if constexpr (g + VLA < 8) v_issue<8 + g + VLA>(vf[g + VLA], vb);
      if constexpr (d == 3) osum = __builtin_amdgcn_mfma_f32_32x32x16_bf16(PA(ksl), ones, osum, 0, 0, 0);
      SBAR(); }); }
#pragma unroll
  for (int r = 0; r < 16; ++r) { const float rl = __builtin_amdgcn_rcpf(osum[r]);
#pragma unroll
    for (int d = 0; d < 4; ++d) o[d][r] *= rl; }
  WAITV(0); asm volatile("s_waitcnt lgkmcnt(0)" ::: "memory"); WBAR();
#undef GLDS
#undef PIECE
#undef WAITV
#undef WBAR
#undef RESC
#undef NXT3
#undef PA
#undef PKV
#undef KCAT
#undef QK8
#undef BITER
}
struct SrcD8 { const unsigned char* q8; const unsigned char* k8; const bf16_t* V; int ldv; };
__device__ __forceinline__ void attn_core_pl8(const SrcD8 in, const float thr, const int seq, LAS char* lds, f32x16 (&o)[4], float* probe = nullptr) {
  constexpr int SHM_K = 8192, NEXS = 32, NEXF = 0, VLA = 3;
  using SS = StartSched<NEXS>; using FS = FinSched<NEXF>;
  int lane; asm volatile("v_and_b32 %0, 63, %1" : "=v"(lane) : "v"(threadIdx.x));
  const int tid = threadIdx.x, wid = __builtin_amdgcn_readfirstlane(tid >> 6), r32 = lane & 31, hi = (lane >> 5) & 1, wq = wid & 3, mp = wid >> 2;
  LAS char* V_lds = lds; LAS char* K_lds = lds + 3 * SHM_V;
  SMS st; st.dm = 0.f; st.keep = true;
  f32x16 negm = f32x16{}, osum = f32x16{};
#pragma unroll
  for (int d = 0; d < 4; ++d) o[d] = f32x16{};
  const bf16x8 ones = {16256, 16256, 16256, 16256, 16256, 16256, 16256, 16256};
  v8i_att qf;
  { const unsigned char* Qw = in.q8 + (size_t)(wq * QBLK + r32) * 1024 + mp * 64 + hi * 32;
    const v4i_att lo = *(const v4i_att*)(Qw), hh = *(const v4i_att*)(Qw + 16); qf = __builtin_shufflevector(lo, hh, 0, 1, 2, 3, 4, 5, 6, 7); }
  const unsigned ksrc = (unsigned)(((wid & 3) * 16 + (lane >> 2)) * 1024 + (wid >> 2) * 64 + (((lane & 3) ^ ((lane >> 4) & 3)) << 4));
  const int kdst = wid * 1024 + lane * 16;
  unsigned voff[2];
#pragma unroll
  for (int i = 0; i < 2; ++i) { const int p = i * 8192 + wid * 1024 + lane * 16, s_ = p >> 9, wq_ = (p & 511) >> 1, kk = (s_ >> 2) * 8 + (wq_ >> 5), cl = wq_ & 31;
    voff[i] = (unsigned)(kk * in.ldv + (s_ & 3) * 32 + cl) * 2u; }
  const int vb0 = (int)(unsigned)(size_t)V_lds + v_rd_base(lane);
  const unsigned ldsw = (unsigned)wid * 1024u;
  const LAS char* Kw = K_lds + mp * 4096;
  int kx[2];
#pragma unroll
  for (int c = 0; c < 2; ++c) kx[c] = r32 * 64 + (((2 * hi + c) ^ ((r32 >> 2) & 3)) << 4);
#define GLDS(gp, lp) __builtin_amdgcn_global_load_lds((const unsigned*)(gp), (LAS unsigned*)(lp), 16, 0, 0)
#define ISSUE_K(t, b) GLDS(in.k8 + (size_t)(t) * (KVBLK * 1024) + ksrc, K_lds + (b) * SHM_K + kdst)
#define ISSUE_V(t, b) do { const char* vb_ = (const char*)in.V + (size_t)(t) * (KVBLK * 2) * in.ldv; GLDS(vb_ + voff[0], V_lds + (b) * SHM_V + ldsw); GLDS(vb_ + voff[1], V_lds + (b) * SHM_V + 8192 + ldsw); } while (0)
#define WAITV(n) asm volatile("s_waitcnt vmcnt(%0)" :: "n"(n) : "memory")
#define WBAR() do { asm volatile("" ::: "memory"); __builtin_amdgcn_s_barrier(); asm volatile("" ::: "memory"); } while (0)
#define RESC() do { if (!st.keep) { int l2_; asm volatile("v_and_b32 %0, 63, %1" : "=v"(l2_) : "v"(threadIdx.x)); const int h2_ = l2_ >> 5; LAS float* al2_ = (LAS float*)(lds + MISC_OFF + 128) + wid * 32; \
    if (h2_ == 0) al2_[l2_] = __builtin_amdgcn_exp2f(st.dm); asm volatile("s_waitcnt lgkmcnt(0)" ::: "memory"); \
    _Pragma("unroll") for (int r = 0; r < 16; ++r) { const float a_ = al2_[crow(r, h2_)]; osum[r] *= a_; _Pragma("unroll") for (int d = 0; d < 4; ++d) o[d][r] *= a_; } asm volatile("s_waitcnt lgkmcnt(0)" ::: "memory"); } } while (0)
#define NXT3(x) ((x) == 2 ? 0 : (x) + 1)
#define PA(ks) (*reinterpret_cast<const bf16x8*>(&pw[ks]))
#define PKV(f) (bf16x8){f.l[0], f.l[1], f.l[2], f.l[3], f.h[0], f.h[1], f.h[2], f.h[3]}
#define KCAT(lo_, hi_) __builtin_shufflevector(__builtin_bit_cast(v4i_att, lo_), __builtin_bit_cast(v4i_att, hi_), 0, 1, 2, 3, 4, 5, 6, 7)
#define PHASE1(PN0, PN1, PF0, PF1, Ks, vb) do { \
    bf16x8 kl0, kh0, kl1, kh1; { const int a0_ = (int)(unsigned)(size_t)(Ks) + kx[0], a1_ = (int)(unsigned)(size_t)(Ks) + kx[1]; \
      k_read<0>(kl0, a0_); k_read<0>(kh0, a1_); k_read<2048>(kl1, a0_); k_read<2048>(kh1, a1_); } \
    asm volatile("s_waitcnt lgkmcnt(2)" : "+v"(kl0), "+v"(kh0)); \
    PN0 = __builtin_amdgcn_mfma_scale_f32_32x32x64_f8f6f4(KCAT(kl0, kh0), qf, negm, 0, 0, 0, 0x7f7f7f7f, 0, 0x7c7c7c7c); \
    ISSUE_K(tk_, bq); GLDS((const char*)in.V + (size_t)tv_ * (KVBLK * 2) * in.ldv + voff[0], V_lds + b2 * SHM_V + ldsw); \
    v_issue<0>(vf[0], vb); \
    sfor<0, 8>([&](auto ic) __attribute__((always_inline)) { fin_item<decltype(ic)::value, NEXF>(PF0, PF1, st, pw); }); \
    SBAR(); \
    asm volatile("s_waitcnt lgkmcnt(2)" : "+v"(kl1), "+v"(kh1)); \
    PN1 = __builtin_amdgcn_mfma_scale_f32_32x32x64_f8f6f4(KCAT(kl1, kh1), qf, negm, 0, 0, 0, 0x7f7f7f7f, 0, 0x7c7c7c7c); \
    GLDS((const char*)in.V + (size_t)tv_ * (KVBLK * 2) * in.ldv + voff[1], V_lds + b2 * SHM_V + 8192 + ldsw); \
    v_issue<1>(vf[1], vb); v_issue<2>(vf[2], vb); \
    sfor<8, 16>([&](auto ic) __attribute__((always_inline)) { fin_item<decltype(ic)::value, NEXF>(PF0, PF1, st, pw); }); \
    SBAR(); } while (0)
#define PHASE2(PS0, PS1, vb) do { \
    sfor<0, 20>([&](auto gc) __attribute__((always_inline)) { constexpr int gg = decltype(gc)::value, ks = gg / 5, d = gg % 5, g = ks * 4 + d; \
      if constexpr (d < 4) { \
        v_wait<2 * (15 - g < VLA - 1 ? 15 - g : VLA - 1)>(vf[g]); \
        o[d] = __builtin_amdgcn_mfma_f32_32x32x16_bf16(PA(ks), PKV(vf[g]), o[d], 0, 0, 0); \
        if constexpr (g + VLA < 16) v_issue<g + VLA>(vf[g + VLA], vb); \
      } else osum = __builtin_amdgcn_mfma_f32_32x32x16_bf16(PA(ks), ones, osum, 0, 0, 0); \
      sfor<SS::first(gg, 20), SS::first(gg + 1, 20)>([&](auto ic) __attribute__((always_inline)) { start_item<decltype(ic)::value, NEXS>(PS0, PS1, st, negm, thr, hi == 0 ? 1.f : 0.f); }); \
      SBAR(); }); \
    asm volatile("" : "+v"(PS0), "+v"(PS1)); \
    RESC(); } while (0)
  f32x16 pA0, pA1, pB0, pB1; u32x4 pw[4]; VF vf[16]; const int NT = seq / KVBLK;
  ISSUE_K(0, 0); ISSUE_K(1, 1); ISSUE_V(0, 0);
  WAITV(3); WBAR();
  ISSUE_K(2, 2); ISSUE_V(1, 1);
  { const bf16x8 l0 = *(const LAS bf16x8*)(Kw + kx[0]), h0 = *(const LAS bf16x8*)(Kw + kx[1]), l1 = *(const LAS bf16x8*)(Kw + 2048 + kx[0]), h1 = *(const LAS bf16x8*)(Kw + 2048 + kx[1]);
    pA0 = __builtin_amdgcn_mfma_scale_f32_32x32x64_f8f6f4(KCAT(l0, h0), qf, f32x16{}, 0, 0, 0, 0x7f7f7f7f, 0, 0x7c7c7c7c);
    pA1 = __builtin_amdgcn_mfma_scale_f32_32x32x64_f8f6f4(KCAT(l1, h1), qf, f32x16{}, 0, 0, 0, 0x7f7f7f7f, 0, 0x7c7c7c7c); }
  sfor<0, 16>([&](auto ic) __attribute__((always_inline)) { start_item<decltype(ic)::value, NEXS>(pA0, pA1, st, negm, thr, hi == 0 ? 1.f : 0.f); });
  { float pmax;
    { auto rr = __builtin_amdgcn_permlane32_swap(__float_as_uint(st.a0), __float_as_uint(st.a0), false, false); pmax = fmaxf(__uint_as_float(rr[0]), __uint_as_float(rr[1])); }
#pragma unroll
    for (int r = 0; r < 16; ++r) { pA0[r] -= pmax; pA1[r] -= pmax; negm[r] = -pmax; } }
  sfor<17, SS::NITEMS>([&](auto ic) __attribute__((always_inline)) { start_item<decltype(ic)::value, NEXS>(pA0, pA1, st, negm, thr, hi == 0 ? 1.f : 0.f); });
  int bq = 0;
#define ITER(j, PN0, PN1, PF0, PF1) do { const int b1 = NXT3(bq), b2 = NXT3(b1); \
    WAITV(3); WBAR(); \
    const int tk_ = (j) + 3 < NT ? (j) + 3 : NT - 1, tv_ = (j) + 2 < NT ? (j) + 2 : NT - 1; \
    PHASE1(PN0, PN1, PF0, PF1, Kw + b1 * SHM_K, vb0 + bq * SHM_V); \
    PHASE2(PN0, PN1, vb0 + bq * SHM_V); \
    bq = b1; } while (0)
#if PROBE_T == 2
  const unsigned long long t0 = __builtin_amdgcn_s_memtime();
#endif
  for (int j = 0; j + 2 < NT; j += 2) { ITER(j, pB0, pB1, pA0, pA1); ITER(j + 1, pA0, pA1, pB0, pB1); }
  ITER(NT - 2, pB0, pB1, pA0, pA1);
#if PROBE_T == 2
  { const unsigned long long t1 = __builtin_amdgcn_s_memtime(); if (probe != nullptr && tid == 0) { probe[0] = 0.f; probe[1] = ((float)(t1 - t0) * (1.f / (NT - 1)) - 1500.f) * 0.05f; } }
#endif
  sfor<0, FS::NITEMS>([&](auto ic) __attribute__((always_inline)) { fin_item<decltype(ic)::value, NEXF>(pB0, pB1, st, pw); });
  WAITV(0); WBAR();
  { const int vb = vb0 + bq * SHM_V;
    sfor<0, VLA>([&](auto gc) __attribute__((always_inline)) { v_issue<decltype(gc)::value>(vf[decltype(gc)::value], vb); });
    sfor<0, 16>([&](auto gc) __attribute__((always_inline)) { constexpr int g = decltype(gc)::value, ks = g >> 2, d = g & 3;
      v_wait<2 * (15 - g < VLA - 1 ? 15 - g : VLA - 1)>(vf[g]);
      o[d] = __builtin_amdgcn_mfma_f32_32x32x16_bf16(PA(ks), PKV(vf[g]), o[d], 0, 0, 0);
      if constexpr (g + VLA < 16) v_issue<g + VLA>(vf[g + VLA], vb);
      if constexpr (d == 3) osum = __builtin_amdgcn_mfma_f32_32x32x16_bf16(PA(ks), ones, osum, 0, 0, 0);
      SBAR(); }); }
#pragma unroll
  for (int r = 0; r < 16; ++r) { const float rl = __builtin_amdgcn_rcpf(osum[r]);
#pragma unroll
    for (int d = 0; d < 4; ++d) o[d][r] *= rl; }
  asm volatile("s_waitcnt lgkmcnt(0)" ::: "memory"); WBAR();
#undef GLDS
#undef ISSUE_K
#undef ISSUE_V
#undef WAITV
#undef WBAR
#undef RESC
#undef NXT3
#undef PA
#undef PKV
#undef KCAT
#undef PHASE1
#undef PHASE2
#undef ITER
}
struct SrcDH { const bf16_t* Q; const bf16_t* K; const unsigned char* q8; const unsigned char* k8; const bf16_t* V; int ldv; };
template <int MP>
__device__ __forceinline__ void attn_core_plh(const SrcDH in, const float thr, const int seq, LAS char* lds, f32x16 (&o)[4], float* probe = nullptr) {
  constexpr int SHM_K = 12288, NKS = 4, NG1 = 8, NEXS = 32, NEXF = 0, VLA = 3;
  using SS = StartSched<NEXS>; using FS = FinSched<NEXF>;
  int lane; asm volatile("v_and_b32 %0, 63, %1" : "=v"(lane) : "v"(threadIdx.x));
  const int tid = threadIdx.x, wid = __builtin_amdgcn_readfirstlane(tid >> 6), r32 = lane & 31, hi = (lane >> 5) & 1, wq = wid & 3; constexpr int mp = MP;
  LAS char* V_lds = lds; LAS char* K_lds = lds + 3 * SHM_V;
  SMS st; st.dm = 0.f; st.keep = true;
  f32x16 negm = f32x16{}, osum = f32x16{};
#pragma unroll
  for (int d = 0; d < 4; ++d) o[d] = f32x16{};
  const bf16x8 ones = {16256, 16256, 16256, 16256, 16256, 16256, 16256, 16256};
  bf16x8 qr[NKS]; v8i_att qf = {};
  if constexpr (mp == 0) { const bf16_t* Qw = in.Q + (size_t)(wq * QBLK + r32) * 1024 + hi * 8;
#pragma unroll
    for (int d0 = 0; d0 < NKS; ++d0) qr[d0] = *(const bf16x8*)(Qw + d0 * 16); }
  else { const unsigned char* Qw = in.q8 + (size_t)(wq * QBLK + r32) * 1024 + 64 + hi * 32;
    const v4i_att lo = *(const v4i_att*)(Qw), hh = *(const v4i_att*)(Qw + 16); qf = __builtin_shufflevector(lo, hh, 0, 1, 2, 3, 4, 5, 6, 7);
#pragma unroll
    for (int d0 = 0; d0 < NKS; ++d0) qr[d0] = bf16x8{}; }
  const int krow = wid * 8 + (lane >> 3), kslot = (lane & 7) ^ ((krow >> 1) & 7);
  const unsigned koff = (unsigned)(krow * 1024 + kslot * 8) * 2u;
  const unsigned ksrc8 = (unsigned)(((wid & 3) * 16 + (lane >> 2)) * 1024 + 64 + (((lane & 3) ^ ((lane >> 4) & 3)) << 4));
  const int kdst8 = 8192 + (wid & 3) * 1024 + lane * 16;
  unsigned voff[2];
#pragma unroll
  for (int i = 0; i < 2; ++i) { const int p = i * 8192 + wid * 1024 + lane * 16, s_ = p >> 9, wq_ = (p & 511) >> 1, kk = (s_ >> 2) * 8 + (wq_ >> 5), cl = wq_ & 31;
    voff[i] = (unsigned)(kk * in.ldv + (s_ & 3) * 32 + cl) * 2u; }
  const int vb0 = (int)(unsigned)(size_t)V_lds + v_rd_base(lane);
  const unsigned ldsw = (unsigned)wid * 1024u;
  int kx[2];
#pragma unroll
  for (int c = 0; c < 2; ++c) kx[c] = 8192 + r32 * 64 + (((2 * hi + c) ^ ((r32 >> 2) & 3)) << 4);
#define GLDS(gp, lp) __builtin_amdgcn_global_load_lds((const unsigned*)(gp), (LAS unsigned*)(lp), 16, 0, 0)
#define ISSUE_K(t, b) do { GLDS((const char*)in.K + (size_t)(t) * (KVBLK * 2) * 1024 + koff, K_lds + (b) * SHM_K + ldsw); GLDS(in.k8 + (size_t)(t) * (KVBLK * 1024) + ksrc8, K_lds + (b) * SHM_K + kdst8); } while (0)
#define ISSUE_V(t, b) do { const char* vb_ = (const char*)in.V + (size_t)(t) * (KVBLK * 2) * in.ldv; GLDS(vb_ + voff[0], V_lds + (b) * SHM_V + ldsw); GLDS(vb_ + voff[1], V_lds + (b) * SHM_V + 8192 + ldsw); } while (0)
#define DMA_PIECE(i) do { if ((i) == 0) GLDS((const char*)in.K + (size_t)tk_ * (KVBLK * 2) * 1024 + koff, K_lds + bq * SHM_K + ldsw); \
    else if ((i) == 1) GLDS(in.k8 + (size_t)tk_ * (KVBLK * 1024) + ksrc8, K_lds + bq * SHM_K + kdst8); \
    else GLDS((const char*)in.V + (size_t)tv_ * (KVBLK * 2) * in.ldv + voff[(i) & 1], V_lds + b2 * SHM_V + ((i) & 1) * 8192 + ldsw); } while (0)
#define WAITV(n) asm volatile("s_waitcnt vmcnt(%0)" :: "n"(n) : "memory")
#define WBAR() do { asm volatile("" ::: "memory"); __builtin_amdgcn_s_barrier(); asm volatile("" ::: "memory"); } while (0)
#define RESC() do { if (!st.keep) { int l2_; asm volatile("v_and_b32 %0, 63, %1" : "=v"(l2_) : "v"(threadIdx.x)); const int h2_ = l2_ >> 5; LAS float* al2_ = (LAS float*)(lds + MISC_OFF + 128) + wid * 32; \
    if (h2_ == 0) al2_[l2_] = __builtin_amdgcn_exp2f(st.dm); asm volatile("s_waitcnt lgkmcnt(0)" ::: "memory"); \
    _Pragma("unroll") for (int r = 0; r < 16; ++r) { const float a_ = al2_[crow(r, h2_)]; osum[r] *= a_; _Pragma("unroll") for (int d = 0; d < 4; ++d) o[d][r] *= a_; } asm volatile("s_waitcnt lgkmcnt(0)" ::: "memory"); } } while (0)
#define NXT3(x) ((x) == 2 ? 0 : (x) + 1)
#define KFRAG(Ks, d, blk) (*(const LAS bf16x8*)((Ks) + KSW((blk) * 32 + r32, ((d) * 16 + hi * 8) * 2)))
#define PA(ks) (*reinterpret_cast<const bf16x8*>(&pw[ks]))
#define PKV(f) (bf16x8){f.l[0], f.l[1], f.l[2], f.l[3], f.h[0], f.h[1], f.h[2], f.h[3]}
#define KCAT(lo_, hi_) __builtin_shufflevector(__builtin_bit_cast(v4i_att, lo_), __builtin_bit_cast(v4i_att, hi_), 0, 1, 2, 3, 4, 5, 6, 7)
#define PHASE1_BF(PN0, PN1, PF0, PF1, Ks, vb) do { \
    bf16x8 kf[NKS][2]; kf[0][0] = KFRAG(Ks, 0, 0); kf[0][1] = KFRAG(Ks, 0, 1); \
    sfor<0, NG1>([&](auto gc) __attribute__((always_inline)) { constexpr int g = decltype(gc)::value, d = g >> 1, blk = g & 1; \
      if constexpr (blk == 0 && d + 1 < NKS) { kf[d + 1][0] = KFRAG(Ks, d + 1, 0); kf[d + 1][1] = KFRAG(Ks, d + 1, 1); } \
      if constexpr (blk == 0) { if constexpr (d == 0) mfma_c(PN0, kf[d][0], qr[d], negm); else PN0 = __builtin_amdgcn_mfma_f32_32x32x16_bf16(kf[d][0], qr[d], PN0, 0, 0, 0); } \
      else              { if constexpr (d == 0) mfma_c(PN1, kf[d][1], qr[d], negm); else PN1 = __builtin_amdgcn_mfma_f32_32x32x16_bf16(kf[d][1], qr[d], PN1, 0, 0, 0); } \
      if constexpr (g < 4) DMA_PIECE(g); \
      if constexpr (g >= NG1 - VLA) v_issue<g - (NG1 - VLA)>(vf[g - (NG1 - VLA)], vb); \
      sfor<FS::first(g, NG1), FS::first(g + 1, NG1)>([&](auto ic) __attribute__((always_inline)) { fin_item<decltype(ic)::value, NEXF>(PF0, PF1, st, pw); }); \
      SBAR(); }); } while (0)
#define PHASE1_F8(PN0, PN1, PF0, PF1, Ks, vb) do { \
    bf16x8 kl0, kh0, kl1, kh1; { const int a0_ = (int)(unsigned)(size_t)(Ks) + kx[0], a1_ = (int)(unsigned)(size_t)(Ks) + kx[1]; \
      k_read<0>(kl0, a0_); k_read<0>(kh0, a1_); k_read<2048>(kl1, a0_); k_read<2048>(kh1, a1_); } \
    asm volatile("s_waitcnt lgkmcnt(2)" : "+v"(kl0), "+v"(kh0)); \
    PN0 = __builtin_amdgcn_mfma_scale_f32_32x32x64_f8f6f4(KCAT(kl0, kh0), qf, negm, 0, 0, 0, 0x7f7f7f7f, 0, 0x7c7c7c7c); \
    DMA_PIECE(0); DMA_PIECE(1); \
    v_issue<0>(vf[0], vb); \
    sfor<0, 8>([&](auto ic) __attribute__((always_inline)) { fin_item<decltype(ic)::value, NEXF>(PF0, PF1, st, pw); }); \
    SBAR(); \
    asm volatile("s_waitcnt lgkmcnt(2)" : "+v"(kl1), "+v"(kh1)); \
    PN1 = __builtin_amdgcn_mfma_scale_f32_32x32x64_f8f6f4(KCAT(kl1, kh1), qf, negm, 0, 0, 0, 0x7f7f7f7f, 0, 0x7c7c7c7c); \
    DMA_PIECE(2); DMA_PIECE(3); \
    v_issue<1>(vf[1], vb); v_issue<2>(vf[2], vb); \
    sfor<8, 16>([&](auto ic) __attribute__((always_inline)) { fin_item<decltype(ic)::value, NEXF>(PF0, PF1, st, pw); }); \
    SBAR(); } while (0)
#define PHASE2(PS0, PS1, vb) do { \
    sfor<0, 20>([&](auto gc) __attribute__((always_inline)) { constexpr int gg = decltype(gc)::value, ks = gg / 5, d = gg % 5, g = ks * 4 + d; \
      if constexpr (d < 4) { \
        v_wait<2 * (15 - g < VLA - 1 ? 15 - g : VLA - 1)>(vf[g]); \
        o[d] = __builtin_amdgcn_mfma_f32_32x32x16_bf16(PA(ks), PKV(vf[g]), o[d], 0, 0, 0); \
        if constexpr (g + VLA < 16) v_issue<g + VLA>(vf[g + VLA], vb); \
      } else osum = __builtin_amdgcn_mfma_f32_32x32x16_bf16(PA(ks), ones, osum, 0, 0, 0); \
      sfor<SS::first(gg, 20), SS::first(gg + 1, 20)>([&](auto ic) __attribute__((always_inline)) { start_item<decltype(ic)::value, NEXS>(PS0, PS1, st, negm, thr, hi == 0 ? 1.f : 0.f); }); \
      SBAR(); }); \
    asm volatile("" : "+v"(PS0), "+v"(PS1)); \
    RESC(); } while (0)
  f32x16 pA0, pA1, pB0, pB1; u32x4 pw[4]; VF vf[16]; const int NT = seq / KVBLK;
  ISSUE_K(0, 0); ISSUE_K(1, 1); ISSUE_V(0, 0);
  WAITV(4); WBAR();
  ISSUE_K(2, 2); ISSUE_V(1, 1);
  if constexpr (mp == 0) { bf16x8 kf[NKS][2];
#pragma unroll
    for (int d = 0; d < NKS; ++d) { kf[d][0] = KFRAG(K_lds, d, 0); kf[d][1] = KFRAG(K_lds, d, 1); }
    pA0 = f32x16{}; pA1 = f32x16{};
#pragma unroll
    for (int d = 0; d < NKS; ++d) { pA0 = __builtin_amdgcn_mfma_f32_32x32x16_bf16(kf[d][0], qr[d], pA0, 0, 0, 0); pA1 = __builtin_amdgcn_mfma_f32_32x32x16_bf16(kf[d][1], qr[d], pA1, 0, 0, 0); } }
  else { const bf16x8 l0 = *(const LAS bf16x8*)(K_lds + kx[0]), h0 = *(const LAS bf16x8*)(K_lds + kx[1]), l1 = *(const LAS bf16x8*)(K_lds + 2048 + kx[0]), h1 = *(const LAS bf16x8*)(K_lds + 2048 + kx[1]);
    pA0 = __builtin_amdgcn_mfma_scale_f32_32x32x64_f8f6f4(KCAT(l0, h0), qf, f32x16{}, 0, 0, 0, 0x7f7f7f7f, 0, 0x7c7c7c7c);
    pA1 = __builtin_amdgcn_mfma_scale_f32_32x32x64_f8f6f4(KCAT(l1, h1), qf, f32x16{}, 0, 0, 0, 0x7f7f7f7f, 0, 0x7c7c7c7c); }
  sfor<0, 16>([&](auto ic) __attribute__((always_inline)) { start_item<decltype(ic)::value, NEXS>(pA0, pA1, st, negm, thr, hi == 0 ? 1.f : 0.f); });
  { float pmax;
    { auto rr = __builtin_amdgcn_permlane32_swap(__float_as_uint(st.a0), __float_as_uint(st.a0), false, false); pmax = fmaxf(__uint_as_float(rr[0]), __uint_as_float(rr[1])); }
#pragma unroll
    for (int r = 0; r < 16; ++r) { pA0[r] -= pmax; pA1[r] -= pmax; negm[r] = -pmax; } }
  sfor<17, SS::NITEMS>([&](auto ic) __attribute__((always_inline)) { start_item<decltype(ic)::value, NEXS>(pA0, pA1, st, negm, thr, hi == 0 ? 1.f : 0.f); });
  int bq = 0;
#define ITER(j, PN0, PN1, PF0, PF1) do { const int b1 = NXT3(bq), b2 = NXT3(b1); \
    WAITV(4); WBAR(); \
    const int tk_ = (j) + 3 < NT ? (j) + 3 : NT - 1, tv_ = (j) + 2 < NT ? (j) + 2 : NT - 1; \
    if constexpr (mp == 0) PHASE1_BF(PN0, PN1, PF0, PF1, K_lds + b1 * SHM_K, vb0 + bq * SHM_V); else PHASE1_F8(PN0, PN1, PF0, PF1, K_lds + b1 * SHM_K, vb0 + bq * SHM_V); \
    PHASE2(PN0, PN1, vb0 + bq * SHM_V); \
    bq = b1; } while (0)
#if PROBE_T == 2
  const unsigned long long t0 = __builtin_amdgcn_s_memtime();
#endif
  for (int j = 0; j + 2 < NT; j += 2) { ITER(j, pB0, pB1, pA0, pA1); ITER(j + 1, pA0, pA1, pB0, pB1); }
  ITER(NT - 2, pB0, pB1, pA0, pA1);
#if PROBE_T == 2
  { const unsigned long long t1 = __builtin_amdgcn_s_memtime(); if (probe != nullptr && tid == 0) { probe[0] = 0.f; probe[1] = ((float)(t1 - t0) * (1.f / (NT - 1)) - 1500.f) * 0.05f; } }
#endif
  sfor<0, FS::NITEMS>([&](auto ic) __attribute__((always_inline)) { fin_item<decltype(ic)::value, NEXF>(pB0, pB1, st, pw); });
  WAITV(0); WBAR();
  { const int vb = vb0 + bq * SHM_V;
    sfor<0, VLA>([&](auto gc) __attribute__((always_inline)) { v_issue<decltype(gc)::value>(vf[decltype(gc)::value], vb); });
    sfor<0, 16>([&](auto gc) __attribute__((always_inline)) { constexpr int g = decltype(gc)::value, ks = g >> 2, d = g & 3;
      v_wait<2 * (15 - g < VLA - 1 ? 15 - g : VLA - 1)>(vf[g]);
      o[d] = __builtin_amdgcn_mfma_f32_32x32x16_bf16(PA(ks), PKV(vf[g]), o[d], 0, 0, 0);
      if constexpr (g + VLA < 16) v_issue<g + VLA>(vf[g + VLA], vb);
      if constexpr (d == 3) osum = __builtin_amdgcn_mfma_f32_32x32x16_bf16(PA(ks), ones, osum, 0, 0, 0);
      SBAR(); }); }
#pragma unroll
  for (int r = 0; r < 16; ++r) { const float rl = __builtin_amdgcn_rcpf(osum[r]);
#pragma unroll
    for (int d = 0; d < 4; ++d) o[d][r] *= rl; }
  asm volatile("s_waitcnt lgkmcnt(0)" ::: "memory"); WBAR();
#undef GLDS
#undef ISSUE_K
#undef ISSUE_V
#undef DMA_PIECE
#undef WAITV
#undef WBAR
#undef RESC
#undef NXT3
#undef KFRAG
#undef PA
#undef PKV
#undef KCAT
#undef PHASE1_BF
#undef PHASE1_F8
#undef PHASE2
#undef ITER
}
struct SrcM8 { const unsigned char* q8; const unsigned char* k8n; const unsigned char* k8r; const unsigned char* vT; };
template <int N> __device__ __forceinline__ void fin8_item(f32x16& P0, f32x16& P1, v8i_att& p8, float& ls0, float& ls1) {
  if constexpr (N < 16) P1[N] = __builtin_amdgcn_exp2f(P1[N]);
  else if constexpr (N < 32) { constexpr int k = N - 16, e = 2 * k; const float a = e < 16 ? P0[e] : P1[e - 16], b = e < 16 ? P0[e + 1] : P1[e - 15];
    if constexpr ((k & 1) == 0) p8[k >> 1] = __builtin_amdgcn_cvt_pk_fp8_f32(a, b, 0, false); else p8[k >> 1] = __builtin_amdgcn_cvt_pk_fp8_f32(a, b, p8[k >> 1], true); }
  else { constexpr int e = N - 32; const float v = e < 16 ? P0[e] : P1[e - 16];
    if constexpr (e & 1) asm("v_add_f32_e32 %0, %1, %0" : "+v"(ls1) : "v"(v)); else asm("v_add_f32_e32 %0, %1, %0" : "+v"(ls0) : "v"(v)); }
}
constexpr int fin8_first(int g) { return g == 0 ? 0 : g == 1 ? 7 : g == 2 ? 14 : g == 3 ? 26 : g == 4 ? 39 : g == 5 ? 52 : 64; }
__device__ __forceinline__ void attn_core_mla8(const SrcM8 in, const float thr, const int seq, LAS char* lds, f32x16 (&o)[4], float* probe = nullptr) {
  constexpr int SHM_K = 3 * 4096, SHM_V8 = 8192, NKS = 3;
  using SS = StartSched<16>;
  int lane; asm volatile("v_and_b32 %0, 63, %1" : "=v"(lane) : "v"(threadIdx.x));
  const int tid = threadIdx.x, wid = __builtin_amdgcn_readfirstlane(tid >> 6), r32 = lane & 31, hi = (lane >> 5) & 1;
  LAS char* V_lds = lds; LAS char* K_lds = lds + 3 * SHM_V8;
  SMS st; st.dm = 0.f; st.keep = true;
  f32x16 negm = f32x16{};
  float ls0 = 0.f, ls1 = 0.f;
#pragma unroll
  for (int d = 0; d < 4; ++d) o[d] = f32x16{};
  v8i_att qf[NKS];
  { const unsigned char* Qw = in.q8 + (size_t)(wid * QBLK + r32) * 1536 + hi * 32;
#pragma unroll
    for (int s = 0; s < NKS; ++s) { const v4i_att lo = *(const v4i_att*)(Qw + s * 64), hh = *(const v4i_att*)(Qw + s * 64 + 16); qf[s] = __builtin_shufflevector(lo, hh, 0, 1, 2, 3, 4, 5, 6, 7); } }
  unsigned ksrc[2]; int kdst[2]; bool krot[2];
#pragma unroll
  for (int i = 0; i < 2; ++i) { const int p0 = wid * 2 + i, p = p0 < 12 ? p0 : p0 - 4, s = p >> 2, q = p & 3, row = q * 16 + (lane >> 2), lc = (lane & 3) ^ ((lane >> 4) & 3);
    krot[i] = (s == 2); ksrc[i] = krot[i] ? (unsigned)(row * 64 + lc * 16) : (unsigned)(row * 1024 + s * 64 + lc * 16); kdst[i] = s * 4096 + q * 1024 + lane * 16; }
  const unsigned vsrc = (unsigned)((wid * 16 + (lane >> 2)) * 4096 + (((lane & 3) ^ ((lane >> 4) & 3)) << 4));
  const int vdst = wid * 1024 + lane * 16;
  int kx[2];
#pragma unroll
  for (int c = 0; c < 2; ++c) kx[c] = r32 * 64 + (((2 * hi + c) ^ ((r32 >> 2) & 3)) << 4);
#define GLDS(gp, lp) __builtin_amdgcn_global_load_lds((const unsigned*)(gp), (LAS unsigned*)(lp), 16, 0, 0)
#define PIECE_K(i, tk, bk) do { if (krot[i]) GLDS(in.k8r + (size_t)(tk) * (KVBLK * 64) + ksrc[i], K_lds + (bk) * SHM_K + kdst[i]); \
                               else GLDS(in.k8n + (size_t)(tk) * (KVBLK * 1024) + ksrc[i], K_lds + (bk) * SHM_K + kdst[i]); } while (0)
#define PIECE_V(tv, bv) GLDS(in.vT + (size_t)(tv) * KVBLK + vsrc, V_lds + (bv) * SHM_V8 + vdst)
#define WAITV(n) asm volatile("s_waitcnt vmcnt(%0)" :: "n"(n) : "memory")
#define WBAR() do { asm volatile("" ::: "memory"); __builtin_amdgcn_s_barrier(); asm volatile("" ::: "memory"); } while (0)
#define RESC() do { if (!st.keep) { int l2_; asm volatile("v_and_b32 %0, 63, %1" : "=v"(l2_) : "v"(threadIdx.x)); const int h2_ = l2_ >> 5; LAS float* al2_ = (LAS float*)(lds + MISC_OFF + 128) + wid * 32; \
    { const float am_ = __builtin_amdgcn_exp2f(st.dm); ls0 *= am_; ls1 *= am_; if (h2_ == 0) al2_[l2_] = am_; } asm volatile("s_waitcnt lgkmcnt(0)" ::: "memory"); \
    _Pragma("unroll") for (int r = 0; r < 16; ++r) { const float a_ = al2_[crow(r, h2_)]; _Pragma("unroll") for (int d = 0; d < 4; ++d) o[d][r] *= a_; } asm volatile("s_waitcnt lgkmcnt(0)" ::: "memory"); } } while (0)
#define NXT3(x) ((x) == 2 ? 0 : (x) + 1)
#define KCAT(lo_, hi_) __builtin_shufflevector(__builtin_bit_cast(v4i_att, lo_), __builtin_bit_cast(v4i_att, hi_), 0, 1, 2, 3, 4, 5, 6, 7)
#define MF8(A_, B_, C_, SB_) __builtin_amdgcn_mfma_scale_f32_32x32x64_f8f6f4(A_, B_, C_, 0, 0, 0, 0x7f7f7f7f, 0, SB_)
#define PHASE1(PN0, PN1, PF0, PF1, Kq, vb) do { \
    bf16x8 kl[6], kh[6]; const int a0_ = (int)(unsigned)(size_t)(Kq) + kx[0], a1_ = (int)(unsigned)(size_t)(Kq) + kx[1]; \
    k_read<0>(kl[0], a0_); k_read<0>(kh[0], a1_); k_read<4096>(kl[1], a0_); k_read<4096>(kh[1], a1_); \
    sfor<0, 6>([&](auto gc) __attribute__((always_inline)) { constexpr int g = decltype(gc)::value, blk = g / 3, s = g % 3; \
      asm volatile("s_waitcnt lgkmcnt(2)" : "+v"(kl[g]), "+v"(kh[g])); \
      if constexpr (blk == 0) { if constexpr (s == 0) PN0 = MF8(KCAT(kl[g], kh[g]), qf[s], negm, 0x7c7c7c7c); else PN0 = MF8(KCAT(kl[g], kh[g]), qf[s], PN0, 0x7c7c7c7c); } \
      else              { if constexpr (s == 0) PN1 = MF8(KCAT(kl[g], kh[g]), qf[s], negm, 0x7c7c7c7c); else PN1 = MF8(KCAT(kl[g], kh[g]), qf[s], PN1, 0x7c7c7c7c); } \
      if constexpr (g + 2 < 6) { constexpr int g2 = g + 2; k_read<(g2 % 3) * 4096 + (g2 / 3) * 2048>(kl[g2], a0_); k_read<(g2 % 3) * 4096 + (g2 / 3) * 2048>(kh[g2], a1_); } \
      else { constexpr int d_ = g - 4; k_read<d_ * 2048>(vl[d_], (vb) + kx[0]); k_read<d_ * 2048>(vh[d_], (vb) + kx[1]); } \
      if constexpr (g == 0) PIECE_K(0, tk_, bq); else if constexpr (g == 1) PIECE_K(1, tk_, bq); else if constexpr (g == 2) PIECE_V(tv_, b2); \
      sfor<fin8_first(g), fin8_first(g + 1)>([&](auto ic) __attribute__((always_inline)) { fin8_item<decltype(ic)::value>(PF0, PF1, p8, ls0, ls1); }); \
      SBAR(); }); } while (0)
#define PHASE2(PS0, PS1, vb) do { \
    sfor<0, 4>([&](auto gc) __attribute__((always_inline)) { constexpr int d = decltype(gc)::value; \
      if constexpr (d < 3) asm volatile("s_waitcnt lgkmcnt(2)" : "+v"(vl[d]), "+v"(vh[d])); else asm volatile("s_waitcnt lgkmcnt(0)" : "+v"(vl[d]), "+v"(vh[d])); \
      o[d] = MF8(p8, KCAT(vl[d], vh[d]), o[d], 0x7f7f7f7f); \
      if constexpr (d + 2 < 4) { k_read<(d + 2) * 2048>(vl[d + 2], (vb) + kx[0]); k_read<(d + 2) * 2048>(vh[d + 2], (vb) + kx[1]); } \
      sfor<SS::first(d, 4), SS::first(d + 1, 4)>([&](auto ic) __attribute__((always_inline)) { start_item<decltype(ic)::value, 16>(PS0, PS1, st, negm, thr, hi == 0 ? 1.f : 0.f); }); \
      SBAR(); }); \
    asm volatile("" : "+v"(PS0), "+v"(PS1)); \
    RESC(); } while (0)
  f32x16 pA0, pA1, pB0, pB1; v8i_att p8 = {}; bf16x8 vl[4], vh[4]; const int NT = seq / KVBLK;
  PIECE_K(0, 0, 0); PIECE_K(1, 0, 0); PIECE_K(0, 1, 1); PIECE_K(1, 1, 1); PIECE_V(0, 0);
  WAITV(3); WBAR();
  PIECE_K(0, 2, 2); PIECE_K(1, 2, 2); PIECE_V(1, 1);
  { pA0 = f32x16{}; pA1 = f32x16{};
#pragma unroll
    for (int s = 0; s < NKS; ++s) { const bf16x8 l0 = *(const LAS bf16x8*)(K_lds + s * 4096 + kx[0]), h0 = *(const LAS bf16x8*)(K_lds + s * 4096 + kx[1]), l1 = *(const LAS bf16x8*)(K_lds + s * 4096 + 2048 + kx[0]), h1 = *(const LAS bf16x8*)(K_lds + s * 4096 + 2048 + kx[1]);
      pA0 = MF8(KCAT(l0, h0), qf[s], pA0, 0x7c7c7c7c); pA1 = MF8(KCAT(l1, h1), qf[s], pA1, 0x7c7c7c7c); } }
  sfor<0, 16>([&](auto ic) __attribute__((always_inline)) { start_item<decltype(ic)::value, 16>(pA0, pA1, st, negm, thr, hi == 0 ? 1.f : 0.f); });
  { float pmax;
    { auto rr = __builtin_amdgcn_permlane32_swap(__float_as_uint(st.a0), __float_as_uint(st.a0), false, false); pmax = fmaxf(__uint_as_float(rr[0]), __uint_as_float(rr[1])); }
#pragma unroll
    for (int r = 0; r < 16; ++r) { pA0[r] -= pmax; pA1[r] -= pmax; negm[r] = -pmax; } }
  sfor<17, SS::NITEMS>([&](auto ic) __attribute__((always_inline)) { start_item<decltype(ic)::value, 16>(pA0, pA1, st, negm, thr, hi == 0 ? 1.f : 0.f); });
  int bq = 0;
#define ITER(j, PN0, PN1, PF0, PF1) do { const int b1 = NXT3(bq), b2 = NXT3(b1); \
    WAITV(3); WBAR(); \
    const int tk_ = (j) + 3 < NT ? (j) + 3 : NT - 1, tv_ = (j) + 2 < NT ? (j) + 2 : NT - 1; \
    PHASE1(PN0, PN1, PF0, PF1, K_lds + b1 * SHM_K, (int)(unsigned)(size_t)(V_lds + bq * SHM_V8)); \
    PHASE2(PN0, PN1, (int)(unsigned)(size_t)(V_lds + bq * SHM_V8)); \
    bq = b1; } while (0)
#if PROBE_T == 5
  const unsigned long long t0 = __builtin_amdgcn_s_memtime();
#endif
  for (int j = 0; j + 2 < NT; j += 2) { ITER(j, pB0, pB1, pA0, pA1); ITER(j + 1, pA0, pA1, pB0, pB1); }
  ITER(NT - 2, pB0, pB1, pA0, pA1);
#if PROBE_T == 5
  { const unsigned long long t1 = __builtin_amdgcn_s_memtime(); if (probe != nullptr && tid == 0) { probe[0] = 0.f; probe[1] = ((float)(t1 - t0) * (1.f / (NT - 1)) - PROBE_BASE) * 0.05f; } }
#endif
  sfor<0, 64>([&](auto ic) __attribute__((always_inline)) { fin8_item<decltype(ic)::value>(pB0, pB1, p8, ls0, ls1); });
  WAITV(0); WBAR();
  { const int vb = (int)(unsigned)(size_t)(V_lds + bq * SHM_V8);
#pragma unroll
    for (int d = 0; d < 4; ++d) { const bf16x8 l_ = *(const LAS bf16x8*)(V_lds + bq * SHM_V8 + d * 2048 + kx[0]), h_ = *(const LAS bf16x8*)(V_lds + bq * SHM_V8 + d * 2048 + kx[1]);
      o[d] = MF8(p8, KCAT(l_, h_), o[d], 0x7f7f7f7f); } (void)vb; }
  { float ps = ls0 + ls1;
    { auto rr = __builtin_amdgcn_permlane32_swap(__float_as_uint(ps), __float_as_uint(ps), false, false); ps = __uint_as_float(rr[0]) + __uint_as_float(rr[1]); }
    LAS float* li_ = (LAS float*)(lds + MISC_OFF + 128) + wid * 32;
    if (hi == 0) li_[r32] = ps; asm volatile("s_waitcnt lgkmcnt(0)" ::: "memory");
#pragma unroll
    for (int r = 0; r < 16; ++r) { const float rl = __builtin_amdgcn_rcpf(li_[crow(r, hi)]);
#pragma unroll
      for (int d = 0; d < 4; ++d) o[d][r] *= rl; } }
  asm volatile("s_waitcnt lgkmcnt(0)" ::: "memory"); WBAR();
#undef GLDS
#undef PIECE_K
#undef PIECE_V
#undef WAITV
#undef WBAR
#undef RESC
#undef NXT3
#undef KCAT
#undef MF8
#undef PHASE1
#undef PHASE2
#undef ITER
}
struct SrcDP { const unsigned char* q8; const unsigned char* k8; const bf16_t* V; const unsigned char* vT; int ldv; const unsigned char* q8l; };
template <int N> __device__ __forceinline__ void finp_item(f32x16& P0, f32x16& P1, v8i_att& p8) {
  constexpr int e = 2 * N; const float a = e < 16 ? P0[e] : P1[e - 16], b = e < 16 ? P0[e + 1] : P1[e - 15];
  if constexpr ((N & 1) == 0) p8[N >> 1] = __builtin_amdgcn_cvt_pk_fp8_f32(a, b, 0, false); else p8[N >> 1] = __builtin_amdgcn_cvt_pk_fp8_f32(a, b, p8[N >> 1], true);
}
template <int MAPI, int MP>
__device__ __forceinline__ void attn_core_plp(const SrcDP in, const float thr_, const int seq, LAS char* lds, f32x16 (&o)[4], float* probe = nullptr) {
  constexpr int SHM_K = 8192, SHM_V8 = 8192, NEXS = 32, NEXF = 0, VLA = 3;
  using SS = StartSched<NEXS>; using FS = FinSched<NEXF>;
  const float thr = MP == 1 ? 8.0f : thr_;
  int lane; asm volatile("v_and_b32 %0, 63, %1" : "=v"(lane) : "v"(threadIdx.x));
  const int tid = threadIdx.x, wid = __builtin_amdgcn_readfirstlane(tid >> 6), r32 = lane & 31, hi = (lane >> 5) & 1, wq = wid & 3; constexpr int mp = MAPI;
  LAS char* V_lds = lds; LAS char* K_lds = lds + 3 * SHM_V; LAS char* T_lds = lds + 3 * SHM_V + 3 * SHM_K;
  SMS st; st.dm = 0.f; st.keep = true;
  f32x16 negm = f32x16{}, osum = f32x16{};
#pragma unroll
  for (int d = 0; d < 4; ++d) o[d] = f32x16{};
  const bf16x8 ones = {16256, 16256, 16256, 16256, 16256, 16256, 16256, 16256};
  const v8i_att ones8 = {0x38383838, 0x38383838, 0x38383838, 0x38383838, 0x38383838, 0x38383838, 0x38383838, 0x38383838};
  v8i_att qf;
  { const unsigned char* Qw = in.q8 + (size_t)(wq * QBLK + r32) * 1024 + mp * 64 + hi * 32;
    const v4i_att lo = *(const v4i_att*)(Qw), hh = *(const v4i_att*)(Qw + 16); qf = __builtin_shufflevector(lo, hh, 0, 1, 2, 3, 4, 5, 6, 7); }
  constexpr bool QLO = DA_QLO && MAPI == 0;
  v8i_att ql = {};
  if constexpr (QLO) { const unsigned char* Qw = in.q8l + (size_t)(wq * QBLK + r32) * 1024 + mp * 64 + hi * 32;
    const v4i_att lo = *(const v4i_att*)(Qw), hh = *(const v4i_att*)(Qw + 16); ql = __builtin_shufflevector(lo, hh, 0, 1, 2, 3, 4, 5, 6, 7); }
  const unsigned ksrc = (unsigned)(((wid & 3) * 16 + (lane >> 2)) * 1024 + (wid >> 2) * 64 + (((lane & 3) ^ ((lane >> 4) & 3)) << 4));
  const int kdst = wid * 1024 + lane * 16;
  const unsigned tsrc = (unsigned)((wid * 16 + (lane >> 2)) * 4096 + (((lane & 3) ^ ((lane >> 4) & 3)) << 4));
  unsigned voff[2];
#pragma unroll
  for (int i = 0; i < 2; ++i) { const int p = i * 8192 + wid * 1024 + lane * 16, s_ = p >> 9, wq_ = (p & 511) >> 1, kk = (s_ >> 2) * 8 + (wq_ >> 5), cl = wq_ & 31;
    voff[i] = (unsigned)(kk * in.ldv + (s_ & 3) * 32 + cl) * 2u; }
  const int vb0 = (int)(unsigned)(size_t)V_lds + v_rd_base(lane);
  const unsigned ldsw = (unsigned)wid * 1024u;
  const LAS char* Kw = K_lds + mp * 4096;
  int kx[2];
#pragma unroll
  for (int c = 0; c < 2; ++c) kx[c] = r32 * 64 + (((2 * hi + c) ^ ((r32 >> 2) & 3)) << 4);
#define GLDS(gp, lp) __builtin_amdgcn_global_load_lds((const unsigned*)(gp), (LAS unsigned*)(lp), 16, 0, 0)
#define ISSUE_K(t, b) GLDS(in.k8 + (size_t)(t) * (KVBLK * 1024) + ksrc, K_lds + (b) * SHM_K + kdst)
#define ISSUE_V0(t, b) GLDS((const char*)in.V + (size_t)(t) * (KVBLK * 2) * in.ldv + voff[0], V_lds + (b) * SHM_V + ldsw)
#define ISSUE_V1(t, b) GLDS((const char*)in.V + (size_t)(t) * (KVBLK * 2) * in.ldv + voff[1], V_lds + (b) * SHM_V + 8192 + ldsw)
#define ISSUE_T(t, b) GLDS(in.vT + (size_t)(t) * KVBLK + tsrc, T_lds + (b) * SHM_V8 + kdst)
#define WAITV(n) asm volatile("s_waitcnt vmcnt(%0)" :: "n"(n) : "memory")
#define WBAR() do { asm volatile("" ::: "memory"); __builtin_amdgcn_s_barrier(); asm volatile("" ::: "memory"); } while (0)
#define RESC() do { if (!st.keep) { int l2_; asm volatile("v_and_b32 %0, 63, %1" : "=v"(l2_) : "v"(threadIdx.x)); const int h2_ = l2_ >> 5; LAS float* al2_ = (LAS float*)(lds + MISC_OFF + 128) + wid * 32; \
    if (h2_ == 0) al2_[l2_] = __builtin_amdgcn_exp2f(st.dm); asm volatile("s_waitcnt lgkmcnt(0)" ::: "memory"); \
    _Pragma("unroll") for (int r = 0; r < 16; ++r) { const float a_ = al2_[crow(r, h2_)]; osum[r] *= a_; _Pragma("unroll") for (int d = 0; d < 4; ++d) o[d][r] *= a_; } asm volatile("s_waitcnt lgkmcnt(0)" ::: "memory"); } } while (0)
#define NXT3(x) ((x) == 2 ? 0 : (x) + 1)
#define PA(ks) (*reinterpret_cast<const bf16x8*>(&pw[ks]))
#define PKV(f) (bf16x8){f.l[0], f.l[1], f.l[2], f.l[3], f.h[0], f.h[1], f.h[2], f.h[3]}
#define KCAT(lo_, hi_) __builtin_shufflevector(__builtin_bit_cast(v4i_att, lo_), __builtin_bit_cast(v4i_att, hi_), 0, 1, 2, 3, 4, 5, 6, 7)
#define MF8(A_, B_, C_, SB_) __builtin_amdgcn_mfma_scale_f32_32x32x64_f8f6f4(A_, B_, C_, 0, 0, 0, 0x7f7f7f7f, 0, SB_)
#define PHASE1(PN0, PN1, PF0, PF1, Ks, vb, tb) do { \
    bf16x8 kl0, kh0, kl1, kh1; { const int a0_ = (int)(unsigned)(size_t)(Ks) + kx[0], a1_ = (int)(unsigned)(size_t)(Ks) + kx[1]; \
      k_read<0>(kl0, a0_); k_read<0>(kh0, a1_); k_read<2048>(kl1, a0_); k_read<2048>(kh1, a1_); } \
    asm volatile("s_waitcnt lgkmcnt(2)" : "+v"(kl0), "+v"(kh0)); \
    PN0 = MF8(KCAT(kl0, kh0), qf, negm, 0x7c7c7c7c); if constexpr (QLO) PN0 = MF8(KCAT(kl0, kh0), ql, PN0, 0x78787878); \
    ISSUE_K(tk_, bq); ISSUE_V0(tv_, b2); \
    if constexpr (MP == 0) { v_issue<0>(vf[0], vb); sfor<0, 8>([&](auto ic) __attribute__((always_inline)) { fin_item<decltype(ic)::value, NEXF>(PF0, PF1, st, pw); }); } \
    else { k_read<0>(vl[0], (tb) + kx[0]); k_read<0>(vh[0], (tb) + kx[1]); sfor<0, 8>([&](auto ic) __attribute__((always_inline)) { finp_item<decltype(ic)::value>(PF0, PF1, p8); }); } \
    SBAR(); \
    asm volatile("s_waitcnt lgkmcnt(2)" : "+v"(kl1), "+v"(kh1)); \
    PN1 = MF8(KCAT(kl1, kh1), qf, negm, 0x7c7c7c7c); if constexpr (QLO) PN1 = MF8(KCAT(kl1, kh1), ql, PN1, 0x78787878); \
    ISSUE_V1(tv_, b2); ISSUE_T(tv_, b2); \
    if constexpr (MP == 0) { v_issue<1>(vf[1], vb); v_issue<2>(vf[2], vb); sfor<8, 16>([&](auto ic) __attribute__((always_inline)) { fin_item<decltype(ic)::value, NEXF>(PF0, PF1, st, pw); }); } \
    else { k_read<2048>(vl[1], (tb) + kx[0]); k_read<2048>(vh[1], (tb) + kx[1]); sfor<8, 16>([&](auto ic) __attribute__((always_inline)) { finp_item<decltype(ic)::value>(PF0, PF1, p8); }); } \
    SBAR(); } while (0)
#define PHASE2(PS0, PS1, vb, tb) do { \
    if constexpr (MP == 0) { \
      sfor<0, 20>([&](auto gc) __attribute__((always_inline)) { constexpr int gg = decltype(gc)::value, ks = gg / 5, d = gg % 5, g = ks * 4 + d; \
        if constexpr (d < 4) { \
          v_wait<2 * (15 - g < VLA - 1 ? 15 - g : VLA - 1)>(vf[g]); \
          o[d] = __builtin_amdgcn_mfma_f32_32x32x16_bf16(PA(ks), PKV(vf[g]), o[d], 0, 0, 0); \
          if constexpr (g + VLA < 16) v_issue<g + VLA>(vf[g + VLA], vb); \
        } else osum = __builtin_amdgcn_mfma_f32_32x32x16_bf16(PA(ks), ones, osum, 0, 0, 0); \
        sfor<SS::first(gg, 20), SS::first(gg + 1, 20)>([&](auto ic) __attribute__((always_inline)) { start_item<decltype(ic)::value, NEXS>(PS0, PS1, st, negm, thr, hi == 0 ? 1.f : 0.f); }); \
        SBAR(); }); \
    } else { \
      sfor<0, 5>([&](auto gc) __attribute__((always_inline)) { constexpr int d = decltype(gc)::value; \
        if constexpr (d < 4) { \
          if constexpr (d < 3) asm volatile("s_waitcnt lgkmcnt(2)" : "+v"(vl[d]), "+v"(vh[d])); else asm volatile("s_waitcnt lgkmcnt(0)" : "+v"(vl[d]), "+v"(vh[d])); \
          o[d] = MF8(p8, KCAT(vl[d], vh[d]), o[d], 0x7f7f7f7f); \
          if constexpr (d + 2 < 4) { k_read<(d + 2) * 2048>(vl[d + 2], (tb) + kx[0]); k_read<(d + 2) * 2048>(vh[d + 2], (tb) + kx[1]); } \
        } else osum = MF8(p8, ones8, osum, 0x7f7f7f7f); \
        sfor<SS::first(d, 5), SS::first(d + 1, 5)>([&](auto ic) __attribute__((always_inline)) { start_item<decltype(ic)::value, NEXS>(PS0, PS1, st, negm, thr, hi == 0 ? 1.f : 0.f); }); \
        SBAR(); }); \
    } \
    asm volatile("" : "+v"(PS0), "+v"(PS1)); \
    RESC(); } while (0)
  f32x16 pA0, pA1, pB0, pB1; u32x4 pw[4]; VF vf[16]; v8i_att p8 = {}; bf16x8 vl[4], vh[4]; const int NT = seq / KVBLK;
  ISSUE_K(0, 0); ISSUE_K(1, 1); ISSUE_V0(0, 0); ISSUE_V1(0, 0); ISSUE_T(0, 0);
  WAITV(4); WBAR();
  ISSUE_K(2, 2); ISSUE_V0(1, 1); ISSUE_V1(1, 1); ISSUE_T(1, 1);
  { const bf16x8 l0 = *(const LAS bf16x8*)(Kw + kx[0]), h0 = *(const LAS bf16x8*)(Kw + kx[1]), l1 = *(const LAS bf16x8*)(Kw + 2048 + kx[0]), h1 = *(const LAS bf16x8*)(Kw + 2048 + kx[1]);
    pA0 = MF8(KCAT(l0, h0), qf, f32x16{}, 0x7c7c7c7c); pA1 = MF8(KCAT(l1, h1), qf, f32x16{}, 0x7c7c7c7c);
    if constexpr (QLO) { pA0 = MF8(KCAT(l0, h0), ql, pA0, 0x78787878); pA1 = MF8(KCAT(l1, h1), ql, pA1, 0x78787878); } }
  sfor<0, 16>([&](auto ic) __attribute__((always_inline)) { start_item<decltype(ic)::value, NEXS>(pA0, pA1, st, negm, thr, hi == 0 ? 1.f : 0.f); });
  { float pmax;
    { auto rr = __builtin_amdgcn_permlane32_swap(__float_as_uint(st.a0), __float_as_uint(st.a0), false, false); pmax = fmaxf(__uint_as_float(rr[0]), __uint_as_float(rr[1])); }
#pragma unroll
    for (int r = 0; r < 16; ++r) { pA0[r] -= pmax; pA1[r] -= pmax; negm[r] = -pmax; } }
  sfor<17, SS::NITEMS>([&](auto ic) __attribute__((always_inline)) { start_item<decltype(ic)::value, NEXS>(pA0, pA1, st, negm, thr, hi == 0 ? 1.f : 0.f); });
  int bq = 0;
#define ITER(j, PN0, PN1, PF0, PF1) do { const int b1 = NXT3(bq), b2 = NXT3(b1); \
    WAITV(4); WBAR(); \
    const int tk_ = (j) + 3 < NT ? (j) + 3 : NT - 1, tv_ = (j) + 2 < NT ? (j) + 2 : NT - 1; \
    PHASE1(PN0, PN1, PF0, PF1, Kw + b1 * SHM_K, vb0 + bq * SHM_V, (int)(unsigned)(size_t)(T_lds + bq * SHM_V8)); \
    PHASE2(PN0, PN1, vb0 + bq * SHM_V, (int)(unsigned)(size_t)(T_lds + bq * SHM_V8)); \
    bq = b1; } while (0)
#if PROBE_T == 2
  const unsigned long long t0 = __builtin_amdgcn_s_memtime();
#endif
  for (int j = 0; j + 2 < NT; j += 2) { ITER(j, pB0, pB1, pA0, pA1); ITER(j + 1, pA0, pA1, pB0, pB1); }
  ITER(NT - 2, pB0, pB1, pA0, pA1);
#if PROBE_T == 2
  { const unsigned long long t1 = __builtin_amdgcn_s_memtime(); if (probe != nullptr && tid == 0) { probe[0] = 0.f; probe[1] = ((float)(t1 - t0) * (1.f / (NT - 1)) - 1500.f) * 0.05f; } }
#endif
  if constexpr (MP == 0) sfor<0, FS::NITEMS>([&](auto ic) __attribute__((always_inline)) { fin_item<decltype(ic)::value, NEXF>(pB0, pB1, st, pw); });
  else sfor<0, 16>([&](auto ic) __attribute__((always_inline)) { finp_item<decltype(ic)::value>(pB0, pB1, p8); });
  WAITV(0); WBAR();
  if constexpr (MP == 0) { const int vb = vb0 + bq * SHM_V;
    sfor<0, VLA>([&](auto gc) __attribute__((always_inline)) { v_issue<decltype(gc)::value>(vf[decltype(gc)::value], vb); });
    sfor<0, 16>([&](auto gc) __attribute__((always_inline)) { constexpr int g = decltype(gc)::value, ks = g >> 2, d = g & 3;
      v_wait<2 * (15 - g < VLA - 1 ? 15 - g : VLA - 1)>(vf[g]);
      o[d] = __builtin_amdgcn_mfma_f32_32x32x16_bf16(PA(ks), PKV(vf[g]), o[d], 0, 0, 0);
      if constexpr (g + VLA < 16) v_issue<g + VLA>(vf[g + VLA], vb);
      if constexpr (d == 3) osum = __builtin_amdgcn_mfma_f32_32x32x16_bf16(PA(ks), ones, osum, 0, 0, 0);
      SBAR(); }); }
  else {
#pragma unroll
    for (int d = 0; d < 4; ++d) { const bf16x8 l_ = *(const LAS bf16x8*)(T_lds + bq * SHM_V8 + d * 2048 + kx[0]), h_ = *(const LAS bf16x8*)(T_lds + bq * SHM_V8 + d * 2048 + kx[1]);
      o[d] = MF8(p8, KCAT(l_, h_), o[d], 0x7f7f7f7f); }
    osum = MF8(p8, ones8, osum, 0x7f7f7f7f); }
#pragma unroll
  for (int r = 0; r < 16; ++r) { const float rl = __builtin_amdgcn_rcpf(osum[r]);
#pragma unroll
    for (int d = 0; d < 4; ++d) o[d][r] *= rl; }
  asm volatile("s_waitcnt lgkmcnt(0)" ::: "memory"); WBAR();
#undef GLDS
#undef ISSUE_K
#undef ISSUE_V0
#undef ISSUE_V1
#undef ISSUE_T
#undef WAITV
#undef WBAR
#undef RESC
#undef NXT3
#undef PA
#undef PKV
#undef KCAT
#undef MF8
#undef PHASE1
#undef PHASE2
#undef ITER
}
}

constexpr int NWAVES = 8;
struct Args { const void* in[27]; float* out; unsigned char* ws; int ph_lo, ph_hi, li, pad; };

__constant__ float c_invA[8] = {1.0f, 0.19392274474868576f, 0.03760603093086393f, 0.007292664737217109f, 0.001414213562373095f, 0.0002742481756762073f, 5.318295896944988e-05f, 1.031338537721246e-05f};
__constant__ float c_invM[32] = {1.0f, 0.6636012376960885f, 0.44036660267178046f, 0.2922278225730151f, 0.19392274474868576f, 0.12868737343265052f, 0.08539710028576561f, 0.05666962144529105f,
    0.03760603093086393f, 0.024955408670558694f, 0.016560440080994446f, 0.010989528534539826f, 0.007292664737217109f, 0.004839421345719893f, 0.003211445994752591f, 0.0021311195369119653f,
    0.001414213562373095f, 0.0009384738703573802f, 0.000622772421914596f, 0.0004132725499855165f, 0.0002742481756762073f, 0.00018199142881462546f, 0.00012076973741146504f, 8.01429472224798e-05f,
    5.318295896944988e-05f, 3.529227739646723e-05f, 2.341999896140934e-05f, 1.5541540297632344e-05f, 1.031338537721246e-05f, 6.8439753011549275e-06f, 4.5416704806078695e-06f, 3.013858152139171e-06f};

__device__ __forceinline__ int permDA(int i) { return i < 16 ? (i >> 1) + 8 * (i & 1) : i; }
__device__ __forceinline__ int permM(int i) { return (i >> 1) + 32 * (i & 1); }
__device__ __forceinline__ int src_in(int j) {
    if (j < 2048) return (j & ~63) + permDA(j & 63);
    if (j < 4352) return j;
    if (j < 6400) return 4416 + (j - 4352);
    if (j < 6464) return 4352 + permM(j - 6400);
    return -1;
}
__device__ __forceinline__ int src_uq(int j) { const int hd = j / 192, off = j % 192; return off < 128 ? j : hd * 192 + 128 + permM(off - 128); }

__device__ __forceinline__ void tr_item(const float* W, int K, int N, bf16_t* WT, int n0, int k0, int scol, const float* rs, LAS float* scr, int lane) {
#pragma unroll 8
    for (int i = 0; i < 32; ++i) { const int kk = 2 * i + (lane >> 5); float v = 0.f; if (scol >= 0) { v = W[(size_t)(k0 + kk) * N + scol]; if (rs) v *= rs[k0 + kk]; } scr[kk * 33 + (lane & 31)] = v; }
    LDS_WAIT(); asm volatile("" ::: "memory");
    const int c = lane & 7;
#pragma unroll
    for (int j = 0; j < 4; ++j) { const int n = (lane >> 3) + 8 * j; const LAS float* s = scr + (8 * c) * 33 + n;
        u32x4 o; o.x = cvt_pk_bf16(s[0 * 33], s[1 * 33]); o.y = cvt_pk_bf16(s[2 * 33], s[3 * 33]); o.z = cvt_pk_bf16(s[4 * 33], s[5 * 33]); o.w = cvt_pk_bf16(s[6 * 33], s[7 * 33]);
        *(u32x4*)(WT + (size_t)(n0 + n) * K + k0 + 8 * c) = o; }
    LDS_WAIT(); asm volatile("" ::: "memory");
}

template <int MODE = 0, bool OUT8 = false>
__device__ __forceinline__ void cvt_tile64(const float* W, int N, bf16_t* WT, int Kd, int k0, int n0, int drow0, int lane, const float* rs = nullptr) {
    const int g = lane >> 4, x = lane & 15;
    const float* src = W + (size_t)(k0 + 16 * g) * N + n0 + 4 * x;
    f32x4 v[16];
#pragma unroll
    for (int i = 0; i < 16; ++i) v[i] = __builtin_nontemporal_load((const f32x4*)(src + (size_t)i * N));
    if (rs) {
#pragma unroll
        for (int i = 0; i < 16; ++i) v[i] = v[i] * rs[k0 + 16 * g + i];
    }
    if constexpr (OUT8) {
#pragma unroll
        for (int j = 0; j < 4; ++j) { u32x4 w;
            w.x = cvt_pk_fp8x4(v[0][j] * 64.f, v[1][j] * 64.f, v[2][j] * 64.f, v[3][j] * 64.f); w.y = cvt_pk_fp8x4(v[4][j] * 64.f, v[5][j] * 64.f, v[6][j] * 64.f, v[7][j] * 64.f);
            w.z = cvt_pk_fp8x4(v[8][j] * 64.f, v[9][j] * 64.f, v[10][j] * 64.f, v[11][j] * 64.f); w.w = cvt_pk_fp8x4(v[12][j] * 64.f, v[13][j] * 64.f, v[14][j] * 64.f, v[15][j] * 64.f);
            const int c8 = 4 * x + j;
            const int dr8 = (MODE == 3 || MODE == 4) ? 32 * (c8 >> 4) + 8 * ((c8 >> 2) & 3) + 4 * (MODE - 3) + (c8 & 3) : (MODE == 1 ? 2 * (c8 & 31) + (c8 >> 5) : c8);
            *(u32x4*)((unsigned char*)WT + (size_t)(drow0 + dr8) * Kd + k0 + 16 * g) = w; }
        return; }
#pragma unroll
    for (int j = 0; j < 4; ++j) { u32x4 lo, hi;
        lo.x = cvt_pk_bf16(v[0][j], v[1][j]); lo.y = cvt_pk_bf16(v[2][j], v[3][j]); lo.z = cvt_pk_bf16(v[4][j], v[5][j]); lo.w = cvt_pk_bf16(v[6][j], v[7][j]);
        hi.x = cvt_pk_bf16(v[8][j], v[9][j]); hi.y = cvt_pk_bf16(v[10][j], v[11][j]); hi.z = cvt_pk_bf16(v[12][j], v[13][j]); hi.w = cvt_pk_bf16(v[14][j], v[15][j]);
        const int c = 4 * x + j;
        const int dr = MODE == 1 ? 2 * (c & 31) + (c >> 5) : (MODE == 2 ? (c < 16 ? 2 * (c & 7) + (c >> 3) : c) : c);
        bf16_t* d = WT + (size_t)(drow0 + dr) * Kd + k0 + 16 * g;
        *(u32x4*)d = lo; *(u32x4*)(d + 8) = hi; }
}

__global__ void __launch_bounds__(NWAVES * 64, 2) fwd(Args args) {
#define KARGS() const __attribute__((address_space(4))) unsigned long long* ka_ = (const __attribute__((address_space(4))) unsigned long long*)__builtin_amdgcn_kernarg_segment_ptr(); asm volatile("" : "+s"(ka_))
#define AIN(i) ((const void*)ka_[i])
#define AOUT ((float*)ka_[27])
#define AWS ((unsigned char*)ka_[28])
    extern __shared__ __attribute__((aligned(16))) unsigned char lds_raw[];
    LAS unsigned char* lds = (LAS unsigned char*)lds_raw;
    volatile LAS unsigned* MISC = (volatile LAS unsigned*)(lds + MISC_OFF);
    const int tid = threadIdx.x, wave = __builtin_amdgcn_readfirstlane(tid >> 6);
#define LANE_DECL int lane; asm volatile("v_and_b32 %0, 63, %1" : "=v"(lane) : "v"(threadIdx.x))
    const int G = gridDim.x, bx = blockIdx.x;
    unsigned* ctl = (unsigned*)(args.ws + WS_CTL);
    const int lo = args.ph_lo, hi_ph = args.ph_hi;
    if (tid < 32) MISC[tid] = 0u;
    __syncthreads();
    XcdBarrier bar; bar.bar = ctl + CW_BAR + args.li * XCD_BAR_WORDS; bar.x = 0; bar.st = nullptr;
    if (!MK_PER_PHASE) bar = xcd_barrier_post(ctl + CW_BAR + args.li * XCD_BAR_WORDS, MISC + 8);
#define IN(k) (((PH_MASK >> (k)) & 1) && lo <= (k) && (k) < hi_ph)
#define SEAM(k) do { if (IN(k) && IN((k) + 1)) xcd_barrier(bar); } while (0)
    const int gw = bx * NWAVES + wave, NGW = G * NWAVES;

#define xin ((const float*)AIN(0))
#define positions ((const int*)AIN(1))
#define Bt_in ((bf16_t*)(AWS + WS_BT_IN))
#define Bt_uq ((bf16_t*)(AWS + WS_BT_UQ))
#define Bt_ukv ((bf16_t*)(AWS + WS_BT_UKV))
#define Bt_od ((bf16_t*)(AWS + WS_BT_OD))
#define Bt_om ((bf16_t*)(AWS + WS_BT_OM))
#define Bt_out ((bf16_t*)(AWS + WS_BT_OUT))
#define ropeA ((float*)(AWS + WS_ROPEA))
#define ropeM ((float*)(AWS + WS_ROPEM))
#define sq ((float*)(AWS + WS_SQ2))
#define hbuf ((bf16_t*)(AWS + WS_H))
#define oa ((bf16_t*)(AWS + WS_H))
#define qa ((bf16_t*)(AWS + WS_QA))
#define ka ((bf16_t*)(AWS + WS_KA))
#define va ((bf16_t*)(AWS + WS_VA))
#define cq ((bf16_t*)(AWS + WS_CQ))
#define ckv ((bf16_t*)(AWS + WS_CKV))
#define kr ((bf16_t*)(AWS + WS_KR))
#define gates ((bf16_t*)(AWS + WS_GATES))
#define qm ((bf16_t*)(AWS + WS_QM))
#define kv ((bf16_t*)(AWS + WS_KV))
#define ob ((bf16_t*)(AWS + WS_OB))
#define mrg ((bf16_t*)(AWS + WS_MRG))
#define stash ((float*)(AWS + WS_STASH))
#define rowtok_p ((int*)(AWS + WS_ROWTOK))
#define assign ((u32x2*)(AWS + WS_ASSIGN))
#define Bt_d ((bf16_t*)(AWS + WS_BT_D))
#define Bt_gu ((bf16_t*)(AWS + WS_BT_GU))
#define h2 ((bf16_t*)(AWS + WS_H2))
#define act ((bf16_t*)(AWS + WS_ACT))
#define ybuf ((unsigned char*)(AWS + WS_Y))
#define q8p ((unsigned char*)(AWS + WS_Q8))
#define k8np ((unsigned char*)(AWS + WS_K8N))
#define k8rp ((unsigned char*)(AWS + WS_K8R))
#define v8p ((unsigned char*)(AWS + WS_V8))
#define q8lp ((unsigned char*)(AWS + WS_Q8L))
#define v8ap ((unsigned char*)(AWS + WS_V8A))
#define vt8ap ((unsigned char*)(AWS + WS_VT8A))
#define vt8p ((unsigned char*)(AWS + WS_VT8))
#define q8ap ((unsigned char*)(AWS + WS_Q8A))
#define k8ap ((unsigned char*)(AWS + WS_K8A))
#define x1b ((bf16_t*)(AWS + WS_X1B))
#define count ((unsigned*)(AWS + WS_CTL) + CW_COUNT)

    if (IN(0)) {
        KARGS();
        LANE_DECL;
        const float* w_in = (const float*)AIN(3); const float* g_q = (const float*)AIN(9); const float* g_kv = (const float*)AIN(10);
        const float* w_uq = (const float*)AIN(11); const float* w_ukv = (const float*)AIN(12);
        const float* w_od = (const float*)AIN(13); const float* w_om = (const float*)AIN(14); const float* w_out = (const float*)AIN(16);
        constexpr int I_IN = 16 * 101, I_PAD = 16 * 3, I_UQ = 12 * 24, I_UKV = 8 * 32, I_O = 16 * 16;
        constexpr int NITEMS = I_IN + I_PAD + I_UQ + I_UKV + 3 * I_O;
        for (int it = gw; it < NITEMS; it += NGW) {
            int r = it;
            if (r < I_IN) { const int kb = r / 101, cb = r % 101, n0 = cb * 64;
                if (n0 < 2048) cvt_tile64<2>(w_in, 6464, Bt_in, D, kb * 64, n0, n0, lane);
                else if (n0 < 4352) cvt_tile64<0>(w_in, 6464, Bt_in, D, kb * 64, n0, n0, lane);
                else if (n0 < 4416) cvt_tile64<1>(w_in, 6464, Bt_in, D, kb * 64, n0, 5888, lane);
                else if (n0 < 4416 + 1536) cvt_tile64<0>(w_in, 6464, Bt_in, D, kb * 64, n0, n0 - 64, lane);
                else cvt_tile64<0>(w_in, 6464, Bt_in, D, kb * 64, n0, n0 - 64 + 256, lane);
                continue; } r -= I_IN;
            if (r < I_PAD) { const int kb = r / 3, rb = r % 3; const int g = lane >> 4, x4 = lane & 15;
#pragma unroll
                for (int j = 0; j < 4; ++j) { bf16_t* d = Bt_in + (size_t)(5952 + rb * 64 + 4 * x4 + j) * D + kb * 64 + 16 * g; *(u32x4*)d = (u32x4){0u, 0u, 0u, 0u}; *(u32x4*)(d + 8) = (u32x4){0u, 0u, 0u, 0u}; }
                continue; } r -= I_PAD;
            if (r < I_UQ) { const int kb = r / 24, cb = r % 24, n0 = cb * 64;
                if (UP_F8) { if ((cb % 3) == 2) cvt_tile64<1, true>(w_uq, 1536, Bt_uq, QL, kb * 64, n0, n0, lane, g_q); else cvt_tile64<0, true>(w_uq, 1536, Bt_uq, QL, kb * 64, n0, n0, lane, g_q); }
                else if ((cb % 3) == 2) cvt_tile64<1>(w_uq, 1536, Bt_uq, QL, kb * 64, n0, n0, lane, g_q); else cvt_tile64<0>(w_uq, 1536, Bt_uq, QL, kb * 64, n0, n0, lane, g_q);
                continue; } r -= I_UQ;
            if (r < I_UKV) { const int kb = r / 32, cb = r % 32; if (UP_F8) cvt_tile64<0, true>(w_ukv, 2048, Bt_ukv, KVL, kb * 64, cb * 64, cb * 64, lane, g_kv); else cvt_tile64<0>(w_ukv, 2048, Bt_ukv, KVL, kb * 64, cb * 64, cb * 64, lane, g_kv); continue; } r -= I_UKV;
            const int which = r / I_O; r -= which * I_O; const int kb = r / 16, cb = r % 16;
            cvt_tile64<0>(which == 0 ? w_od : (which == 1 ? w_om : w_out), D, which == 0 ? Bt_od : (which == 1 ? Bt_om : Bt_out), D, kb * 64, cb * 64, cb * 64, lane);
        }
        const float* g_mix = (const float*)AIN(2);
        for (int m = gw * 4; m < T; m += NGW * 4) {
            f32x4 v[4][4]; float ss[4];
#pragma unroll
            for (int q = 0; q < 4; ++q) { const f32x4* xr = (const f32x4*)(xin + (size_t)(m + q) * D) + lane;
#pragma unroll
                for (int j = 0; j < 4; ++j) v[q][j] = xr[64 * j]; }
#pragma unroll
            for (int q = 0; q < 4; ++q) { float s = 0.f;
#pragma unroll
                for (int j = 0; j < 4; ++j) s += (v[q][j][0] * v[q][j][0] + v[q][j][1] * v[q][j][1]) + (v[q][j][2] * v[q][j][2] + v[q][j][3] * v[q][j][3]);
                ss[q] = __builtin_amdgcn_rsqf(wave_sum(s) * (1.f / D) + EPS); }
#pragma unroll
            for (int j = 0; j < 4; ++j) { const f32x4 gg = *((const f32x4*)g_mix + lane + 64 * j);
#pragma unroll
                for (int q = 0; q < 4; ++q) { u32x2 w; w.x = cvt_pk_bf16(v[q][j][0] * ss[q] * gg[0], v[q][j][1] * ss[q] * gg[1]); w.y = cvt_pk_bf16(v[q][j][2] * ss[q] * gg[2], v[q][j][3] * ss[q] * gg[3]);
                    ((u32x2*)(hbuf + (size_t)(m + q) * D) + lane)[64 * j] = w; } }
        }
        for (int idx = bx * 512 + tid; idx < T * 40; idx += G * 512) {
            const int t = idx / 40, i = idx % 40; const float inv = i < 8 ? c_invA[i] : c_invM[i - 8];
            const float ang = (float)positions[t] * inv;
            const double rev = (double)ang * 0.15915494309189535; const float fr_ = (float)(rev - __builtin_rint(rev));
            const float cs = __builtin_amdgcn_cosf(fr_), sn = __builtin_amdgcn_sinf(fr_);
            float* dst = i < 8 ? ropeA + ((size_t)t * 8 + i) * 2 : ropeM + ((size_t)t * 32 + (i - 8)) * 2; dst[0] = cs; dst[1] = sn;
        }
    }
    SEAM(0);
    if (IN(1)) {
        KARGS();
        pg8::Gemm g{hbuf, Bt_in, D}; pg8::DenseOrder S; S.init(T / 256, 24, G, bx);
        pg8::EpiIn E{qa, ka, va, cq, ckv, gates, kr, ropeA, ropeM, (const float*)AIN(15), sq, k8rp, q8ap, k8ap, v8ap, q8lp};
        pg8::gemm_phase<pg8::EpiIn, pg8::DenseOrder, false, true>(lds, g, S, E);
    }
    SEAM(1);
    if (IN(2)) {
        KARGS();
        { pg8::Gemm g{hbuf, Bt_in, D}; pg8::DenseOrder S; S.init(T / 256, 2, G, bx, 24);
          pg8::EpiIn E{qa, ka, va, cq, ckv, gates, kr, ropeA, ropeM, (const float*)AIN(15), sq, k8rp, q8ap, k8ap, v8ap, q8lp};
          pg8::gemm_phase<pg8::EpiIn, pg8::DenseOrder, false, true>(lds, g, S, E); }
#if UP_F8
        { pg8::Gemm g{cq, Bt_uq, QL / 2}; pg8::DenseOrder S; S.init(T / 256, 1536 / 128, G, G - 1 - bx); pg8::EpiUp8<true> E{qm, sq, ropeM, q8p};
          pg8::gemm_phase_f8p<pg8::EpiUp8<true>, pg8::DenseOrder>(lds, g, S, E); }
        { pg8::Gemm g{ckv, Bt_ukv, KVL / 2}; pg8::DenseOrder S; S.init(T / 256, 2048 / 128, G, bx); pg8::EpiUp8<false> E{kv, sq, ropeM, k8np, v8p};
          pg8::gemm_phase_f8p<pg8::EpiUp8<false>, pg8::DenseOrder>(lds, g, S, E); }
#else
        { pg8::Gemm g{cq, Bt_uq, QL}; pg8::DenseOrder S; S.init(T / 256, 1536 / 256, G, G - 1 - bx); pg8::EpiUp<true> E{qm, sq, ropeM, q8p};
          pg8::gemm_phase<pg8::EpiUp<true>, pg8::DenseOrder, false, true>(lds, g, S, E); }
        { pg8::Gemm g{ckv, Bt_ukv, KVL}; pg8::DenseOrder S; S.init(T / 256, 2048 / 256, G, bx); pg8::EpiUp<false> E{kv, sq, ropeM, k8np};
          pg8::gemm_phase<pg8::EpiUp<false>, pg8::DenseOrder, false, true>(lds, g, S, E); }
#endif
    }
    SEAM(2);
    if (IN(3)) {
        KARGS();
        const int wid = wave;
#if MLA_PV8
        { LAS unsigned char* tl = (LAS unsigned char*)lds;
          for (int tj = bx; tj < (DA_PV8 ? 2 : 1) * NB * 8 * (SEQ / 64); tj += G) {
              const int ti = tj & 2047; const bool da_ = tj >= 2048; const unsigned char* vsrc_ = da_ ? v8ap : v8p; unsigned char* vdst_ = da_ ? vt8ap : vt8p;
              const int b_ = ti >> 9, h_ = (ti >> 6) & 7, t_ = ti & 63;
              { const int key = tid >> 3, ch = tid & 7;
                *(LAS u32x4*)(tl + key * 128 + ch * 16) = *(const u32x4*)(vsrc_ + ((size_t)b_ * SEQ + t_ * 64 + key) * 1024 + h_ * 128 + ch * 16); }
              __syncthreads();
              { const int dim = tid >> 2, c = tid & 3; unsigned w[4];
#pragma unroll
                for (int q = 0; q < 4; ++q) { unsigned acc_ = 0;
#pragma unroll
                    for (int i = 0; i < 4; ++i) { const int pos = 16 * c + 4 * q + i, kg = pos >> 5, e = pos & 31, key = att::crow(e & 15, kg) + 32 * (e >> 4);
                        acc_ |= (unsigned)tl[key * 128 + dim] << (8 * i); }
                    w[q] = acc_; }
                *(u32x4*)(vdst_ + (((size_t)(b_ * 8 + h_) * 128 + dim) * SEQ + t_ * 64 + 16 * c)) = (u32x4){w[0], w[1], w[2], w[3]}; }
              __syncthreads();
          }
          if (IN(2) || true) xcd_barrier(bar); }
#endif
#define UNIT_DECODE(L) int u = (L) & 511; if (G == 256) { const int c = (L) & 255; u = ((L) & 256) + (c & 7) * 32 + (c >> 3); } \
            const int bh = u >> 4, qb = u & 15, b = bh >> 3, h = bh & 7; const size_t q0 = (size_t)b * SEQ + qb * 256, k0 = (size_t)b * SEQ
        for (int L = bx; L < 1024; L += G) {
#if PROBE_PHASE == 3 && defined(PROBE_ATT)
            if (args.li == 1 && lo == 3 && PROBE_ATT != 0) continue;
#endif
            int u = L; if (G == 256) { const int c = L & 255; u = (L & ~255) + (c & 7) * 32 + (c >> 3); }
            const int bh = u >> 5, qb = u & 31, b = bh >> 3, h = bh & 7; const size_t q0 = (size_t)b * SEQ + qb * 128, k0 = (size_t)b * SEQ;
            f32x16 o[4];
#if DA_PV8
            { att::SrcDP inp{q8ap + q0 * 1024 + h * 128, k8ap + k0 * 1024 + h * 128, va + k0 * 1024 + h * 128, vt8ap + (size_t)(b * 8 + h) * 128 * SEQ, 1024, q8lp + q0 * 1024 + h * 128};
              if (wid < 4) att::attn_core_plp<0, (DA_PV8 == 2)>(inp, 8.f * 1.4426950408889634f, SEQ, (LAS char*)lds, o, (PROBE_T == 2 && L == 0) ? (float*)((unsigned*)(AWS + WS_CTL) + CW_PROBE) : nullptr);
              else att::attn_core_plp<1, 1>(inp, 8.f * 1.4426950408889634f, SEQ, (LAS char*)lds, o, nullptr); }
#elif DA_QK8 == 2
            { att::SrcDH inh{qa + q0 * 1024 + h * 128, ka + k0 * 1024 + h * 128, q8ap + q0 * 1024 + h * 128, k8ap + k0 * 1024 + h * 128, va + k0 * 1024 + h * 128, 1024};
              if (wid < 4) att::attn_core_plh<0>(inh, 8.f * 1.4426950408889634f, SEQ, (LAS char*)lds, o, (PROBE_T == 2 && L == 0) ? (float*)((unsigned*)(AWS + WS_CTL) + CW_PROBE) : nullptr);
              else att::attn_core_plh<1>(inh, 8.f * 1.4426950408889634f, SEQ, (LAS char*)lds, o, nullptr); }
#elif DA_QK8
            { att::SrcD8 in8{q8ap + q0 * 1024 + h * 128, k8ap + k0 * 1024 + h * 128, va + k0 * 1024 + h * 128, 1024};
              att::attn_core_pl8(in8, 8.f * 1.4426950408889634f, SEQ, (LAS char*)lds, o, (PROBE_T == 2 && L == 0) ? (float*)((unsigned*)(AWS + WS_CTL) + CW_PROBE) : nullptr); }
#else
            { att::Src in{qa + q0 * 1024 + h * 128, ka + k0 * 1024 + h * 128, nullptr, va + k0 * 1024 + h * 128, 1024, 1024, 0, 1024};
              att::attn_core_pl<64, 2>(in, 0.125f * 1.4426950408889634f, 8.f * 1.4426950408889634f, SEQ, (LAS char*)lds, o, (PROBE_T && PROBE_T < 4 && L == 0) ? (float*)((unsigned*)(AWS + WS_CTL) + CW_PROBE) : nullptr); }
#endif
            int ln2; asm volatile("v_and_b32 %0, 63, %1" : "=v"(ln2) : "v"(threadIdx.x));
            LAS float* xch = (LAS float*)lds;
            if (wid >= 4) {
#pragma unroll
                for (int d = 0; d < 4; ++d)
#pragma unroll
                    for (int r = 0; r < 16; ++r) xch[((wid - 4) * 64 + d * 16 + r) * 64 + ln2] = o[d][r];
            }
            __syncthreads();
            if (wid < 4) {
            float lam;
            { const float* lq1 = (const float*)AIN(4); const float* lk1 = (const float*)AIN(5); const float* lq2 = (const float*)AIN(6); const float* lk2 = (const float*)AIN(7);
              const float s1 = wave_sum(lq1[ln2] * lk1[ln2]), s2 = wave_sum(lq2[ln2] * lk2[ln2]); lam = __expf(s1) - __expf(s2) + LAM_INIT; }
            float ss[16];
#pragma unroll
            for (int r = 0; r < 16; ++r) ss[r] = 0.f;
#pragma unroll
            for (int d = 0; d < 4; ++d)
#pragma unroll
                for (int r = 0; r < 16; ++r) { const float v = o[d][r] - lam * xch[(wid * 64 + d * 16 + r) * 64 + ln2]; o[d][r] = v; ss[r] += v * v; }
#pragma unroll
            for (int r = 0; r < 16; ++r) {
#pragma unroll
                for (int msk = 1; msk < 32; msk <<= 1) ss[r] += __shfl_xor(ss[r], msk);
                ss[r] = __builtin_amdgcn_rsqf(ss[r] * (1.0f / 128.0f) + EPS); }
            const int hi2 = ln2 >> 5, r32e = ln2 & 31;
            bf16_t* Ow = oa + (q0 + wid * 32 + 4 * hi2) * 1024 + h * 128 + r32e;
            float gs[4];
#pragma unroll
            for (int d = 0; d < 4; ++d) gs[d] = ((const float*)AIN(8))[d * 32 + r32e] * (1.0f - LAM_INIT);
#pragma unroll
            for (int r = 0; r < 16; ++r) { const int orow = att::crow(r, 0);
#pragma unroll
                for (int d = 0; d < 4; ++d) Ow[orow * 1024 + d * 32] = (bf16_t)(cvt_pk_bf16(o[d][r] * ss[r] * gs[d], 0.f) & 0xffffu); }
            }
            __syncthreads();
        }
        for (int L = 512 + bx; L < 1024; L += G) {
#if PROBE_PHASE == 3 && defined(PROBE_ATT)
            if (args.li == 1 && lo == 3 && PROBE_ATT != 1) continue;
#endif
            UNIT_DECODE(L);
            f32x16 o[4];
#if MLA_PV8
            { att::SrcM8 inm{q8p + q0 * 1536 + h * 192, k8np + k0 * 1024 + h * 128, k8rp + k0 * 64, vt8p + (size_t)(b * 8 + h) * 128 * SEQ};
              att::attn_core_mla8(inm, 8.0f, SEQ, (LAS char*)lds, o, (PROBE_T == 5 && L == 512) ? (float*)((unsigned*)(AWS + WS_CTL) + CW_PROBE) : nullptr); }
#elif MLA_QK8
            { att::Src8 in8{q8p + q0 * 1536 + h * 192, k8np + k0 * 1024 + h * 128, k8rp + k0 * 64, kv + k0 * 2048 + h * 256 + 128, 2048};
              att::attn_core_bp8(in8, 8.f * 1.4426950408889634f, SEQ, (LAS char*)lds, o, (PROBE_T == 5 && L == 512) ? (float*)((unsigned*)(AWS + WS_CTL) + CW_PROBE) : nullptr); }
#else
            { att::Src in{qm + q0 * 1536 + h * 192, kv + k0 * 2048 + h * 256, kr + k0 * 64, kv + k0 * 2048 + h * 256 + 128, 1536, 2048, 64, 2048};
              att::attn_core_bp<192, 1>(in, 8.f * 1.4426950408889634f, SEQ, (LAS char*)lds, o, (PROBE_T == 5 && L == 512) ? (float*)((unsigned*)(AWS + WS_CTL) + CW_PROBE) : nullptr); }
#endif
#if PROBE_T == 6
            const unsigned long long te0 = __builtin_amdgcn_s_memtime();
#endif
            int ln2; asm volatile("v_and_b32 %0, 63, %1" : "=v"(ln2) : "v"(threadIdx.x));
            const int hi2 = ln2 >> 5, r32e = ln2 & 31;
            bf16_t* Ow = ob + (q0 + wid * 32 + 4 * hi2) * 1024 + h * 128 + r32e;
#pragma unroll
            for (int r = 0; r < 16; ++r) { const int orow = att::crow(r, 0);
#pragma unroll
                for (int d = 0; d < 4; ++d) Ow[orow * 1024 + d * 32] = (bf16_t)(cvt_pk_bf16(o[d][r], 0.f) & 0xffffu); }
#if PROBE_T == 6
            asm volatile("s_waitcnt vmcnt(0)" ::: "memory");
            { const unsigned long long te1 = __builtin_amdgcn_s_memtime(); if (L == 512 && tid == 0) { float* pr = (float*)((unsigned*)(AWS + WS_CTL) + CW_PROBE); pr[0] = 0.f; pr[1] = (float)(te1 - te0) * 0.002f; } }
#endif
        }
#undef UNIT_DECODE
    }
    SEAM(3);
    if (IN(4)) {
        KARGS();
        { pg8::Gemm g{oa, Bt_od, D}; pg8::DenseOrder S; S.init(T / 256, 4, G, bx); pg8::EpiGate<0> E{mrg, gates};
          pg8::gemm_phase<pg8::EpiGate<0>, pg8::DenseOrder, false, true>(lds, g, S, E); }
        VM_WAIT(); __syncthreads();
        { pg8::Gemm g{ob, Bt_om, D}; pg8::DenseOrder S; S.init(T / 256, 4, G, bx); pg8::EpiGate<1> E{mrg, gates};
          pg8::gemm_phase<pg8::EpiGate<1>, pg8::DenseOrder, false, true>(lds, g, S, E); }
    }
    SEAM(4);
    if (IN(5)) {
        KARGS();
        pg8::Gemm g{mrg, Bt_out, D}; pg8::DenseOrder S; S.init(T / 256, 4, G, bx); pg8::EpiRes E{xin, x1b};
        pg8::gemm_phase<pg8::EpiRes, pg8::DenseOrder, false, true>(lds, g, S, E);
    }
    SEAM(5);
    if (IN(6)) {
        KARGS();
        LANE_DECL;
        const float* g_ffn = (const float*)AIN(17); const float* w_router = (const float*)AIN(18); const float* b_router = (const float*)AIN(19);
        constexpr int WRS = 1028;
        LAS float* wr_l = (LAS float*)lds;
        LAS int* lcount = (LAS int*)(lds + TAB_OFF + 1024); LAS int* gbase = lcount + 32; LAS unsigned* asg_e = (LAS unsigned*)(lcount + 64); LAS float* asg_w = (LAS float*)(lcount + 64 + 256);
        LAS int* sync_w = (LAS int*)(lds + TAB_OFF + 512);
        for (int i = tid; i < D * NEXP; i += 512) wr_l[(i & 31) * WRS + (i >> 5)] = w_router[i];
        if (tid < 32) lcount[tid] = 0;
        if (tid < 2) sync_w[tid] = 0;
        __syncthreads();
        const int ex = (lane >> 1) & 31;
        LAS float* lg = (LAS float*)(lds + TAB_OFF + 4096) + wave * 80;
        const int chunk = bx;
        if (wave < 4 && chunk < T / 64) {
            const float my_b = b_router[ex];
#pragma unroll 1
            for (int j2 = 0; j2 < 8; ++j2) {
                const int tl = wave * 16 + j2 * 2, t = chunk * 64 + tl;
                f32x4 xva[4], xvb[4]; float sa = 0.f, sb = 0.f;
                { const u32x2* xa = (const u32x2*)(x1b + (size_t)t * D) + lane; const u32x2* xb = xa + D / 4;
#pragma unroll
                  for (int j = 0; j < 4; ++j) { const u32x2 wa = xa[64 * j], wb = xb[64 * j]; xva[j] = (f32x4){bf_lo(wa.x), bf_hi(wa.x), bf_lo(wa.y), bf_hi(wa.y)}; xvb[j] = (f32x4){bf_lo(wb.x), bf_hi(wb.x), bf_lo(wb.y), bf_hi(wb.y)}; }
#pragma unroll
                  for (int j = 0; j < 4; ++j) { sa += (xva[j][0] * xva[j][0] + xva[j][1] * xva[j][1]) + (xva[j][2] * xva[j][2] + xva[j][3] * xva[j][3]); sb += (xvb[j][0] * xvb[j][0] + xvb[j][1] * xvb[j][1]) + (xvb[j][2] * xvb[j][2] + xvb[j][3] * xvb[j][3]); } }
                const float ra = __builtin_amdgcn_rsqf(wave_sum(sa) * (1.f / D) + EPS), rb = __builtin_amdgcn_rsqf(wave_sum(sb) * (1.f / D) + EPS);
                { unsigned* oa8 = (unsigned*)((unsigned char*)h2 + (size_t)t * D) + lane; unsigned* ob8 = oa8 + D / 4;
#pragma unroll
                  for (int j = 0; j < 4; ++j) { const f32x4 gg = *((const f32x4*)g_ffn + lane + 64 * j); xva[j] = xva[j] * ra * gg; xvb[j] = xvb[j] * rb * gg;
                    oa8[64 * j] = cvt_pk_fp8x4(xva[j][0], xva[j][1], xva[j][2], xva[j][3]); ob8[64 * j] = cvt_pk_fp8x4(xvb[j][0], xvb[j][1], xvb[j][2], xvb[j][3]); } }
                float aa[32], ab[32];
#pragma unroll
                for (int e = 0; e < NEXP; ++e) { float a = 0.f, b = 0.f;
#pragma unroll
                    for (int j = 0; j < 4; ++j) { const f32x4 w4 = *(const LAS f32x4*)(wr_l + e * WRS + 4 * lane + 256 * j);
                        a += (xva[j][0] * w4[0] + xva[j][1] * w4[1]) + (xva[j][2] * w4[2] + xva[j][3] * w4[3]); b += (xvb[j][0] * w4[0] + xvb[j][1] * w4[1]) + (xvb[j][2] * w4[2] + xvb[j][3] * w4[3]); }
                    aa[e] = a; ab[e] = b; }
#define TRED(arr, n, msk) _Pragma("unroll") for (int i_ = 0; i_ < (n); ++i_) { const bool up_ = (lane & (msk)) != 0; const float keep_ = up_ ? arr[(n) + i_] : arr[i_], give_ = up_ ? arr[i_] : arr[(n) + i_]; arr[i_] = keep_ + __shfl_xor(give_, (msk)); }
                TRED(aa, 16, 32) TRED(aa, 8, 16) TRED(aa, 4, 8) TRED(aa, 2, 4) TRED(aa, 1, 2)
                TRED(ab, 16, 32) TRED(ab, 8, 16) TRED(ab, 4, 8) TRED(ab, 2, 4) TRED(ab, 1, 2)
#undef TRED
                const float la = aa[0] + __shfl_xor(aa[0], 1) + my_b, lb = ab[0] + __shfl_xor(ab[0], 1) + my_b;
#pragma unroll
                for (int tk = 0; tk < 2; ++tk) {
                    const float v = tk ? lb : la; int rank = 0;
                    if (!(lane & 1)) lg[tk * 32 + ex] = v;
                    LDS_WAIT();
#pragma unroll
                    for (int q = 0; q < 8; ++q) { const f32x4 s4 = *(const LAS f32x4*)(lg + tk * 32 + 4 * q);
#pragma unroll
                        for (int jj = 0; jj < 4; ++jj) rank += (s4[jj] > v || (s4[jj] == v && (4 * q + jj) < ex)) ? 1 : 0; }
                    if (rank < 4 && !(lane & 1)) lg[64 + tk * 4 + rank] = v;
                    LDS_WAIT();
                    const f32x4 tv = *(const LAS f32x4*)(lg + 64 + tk * 4);
                    const float p1 = __expf(tv[1] - tv[0]), p2 = __expf(tv[2] - tv[0]), p3 = __expf(tv[3] - tv[0]), inv = 1.0f / (1.0f + p1 + p2 + p3);
                    if (rank < 4 && !(lane & 1)) { const float w = (rank == 0 ? 1.0f : (rank == 1 ? p1 : (rank == 2 ? p2 : p3))) * inv;
                        const int lr = __hip_atomic_fetch_add((LAS int*)&lcount[ex], 1, __ATOMIC_RELAXED, __HIP_MEMORY_SCOPE_WORKGROUP);
                        asg_e[(tl + tk) * 4 + rank] = ((unsigned)ex << 16) | (unsigned)lr; asg_w[(tl + tk) * 4 + rank] = w; }
                }
            }
            LDS_WAIT();
            if (lane == 0) __hip_atomic_fetch_add((LAS int*)&sync_w[0], 1, __ATOMIC_RELAXED, __HIP_MEMORY_SCOPE_WORKGROUP);
            if (wave == 0) {
                while (__hip_atomic_load((LAS int*)&sync_w[0], __ATOMIC_RELAXED, __HIP_MEMORY_SCOPE_WORKGROUP) < 4) __builtin_amdgcn_s_sleep(4);
                asm volatile("s_waitcnt lgkmcnt(0)" ::: "memory");
                if (lane < 32) gbase[lane] = (int)__hip_atomic_fetch_add(count + lane, (unsigned)lcount[lane], __ATOMIC_RELAXED, __HIP_MEMORY_SCOPE_AGENT);
                LDS_WAIT();
#pragma unroll
                for (int q = 0; q < 4; ++q) { const int a_ = q * 64 + lane; const unsigned ae = asg_e[a_]; const int e = ae >> 16, rank = gbase[e] + (int)(ae & 0xffffu); const int t = chunk * 64 + (a_ >> 2);
                    rowtok_p[e * T + rank] = t; u32x2 av; av.x = ((unsigned)e << 16) | (unsigned)rank; av.y = __float_as_uint(asg_w[a_]); assign[(size_t)t * 4 + (a_ & 3)] = av; }
            }
        }
        const float* w_gate = (const float*)AIN(20); const float* w_up = (const float*)AIN(22); const float* w_down = (const float*)AIN(24);
        const int per_wg = (NEXP * 768 + G - 1) / G;
        for (;;) {
            int it = 0; if (lane == 0) it = __hip_atomic_fetch_add((LAS int*)&sync_w[1], 1, __ATOMIC_RELAXED, __HIP_MEMORY_SCOPE_WORKGROUP);
            it = __builtin_amdgcn_readfirstlane(it); const int item = bx * per_wg + it;
            if (it >= per_wg || item >= NEXP * 768) break;
            const int e = item / 768, r = item % 768, mat = r >> 8, kb = (r >> 4) & 15, nb = r & 15, f0 = nb * 64;
            if (mat == 0) cvt_tile64<3, true>(w_gate + (size_t)e * D * FF, FF, (bf16_t*)((unsigned char*)Bt_gu + (size_t)e * 2048 * D), D, kb * 64, f0, 2 * f0, lane);
            else if (mat == 1) cvt_tile64<4, true>(w_up + (size_t)e * D * FF, FF, (bf16_t*)((unsigned char*)Bt_gu + (size_t)e * 2048 * D), D, kb * 64, f0, 2 * f0, lane);
            else cvt_tile64<0, true>(w_down + (size_t)e * FF * D, D, (bf16_t*)((unsigned char*)Bt_d + (size_t)e * D * FF), FF, kb * 64, f0, f0, lane);
        }
    }
    SEAM(6);
    LAS int* t_cnt = (LAS int*)(lds + TAB_OFF + 4096); LAS int* t_start = t_cnt + 32; LAS int* t_t2e = t_start + 40;
    if (IN(7) || IN(8) || IN(9)) {
        KARGS();
        __syncthreads();
        if (tid < 32) t_cnt[tid] = (int)__hip_atomic_load(count + tid, __ATOMIC_RELAXED, __HIP_MEMORY_SCOPE_AGENT);
        __syncthreads();
        if (tid == 0) { int s = 0; for (int e = 0; e < NEXP; ++e) { t_start[e] = s; s += (t_cnt[e] + 255) >> 8; } t_start[32] = s; }
        __syncthreads();
        if (tid < 32) { for (int rt = t_start[tid]; rt < t_start[tid + 1]; ++rt) t_t2e[rt] = tid; }
        __syncthreads();
    }
    if (IN(7)) {
        KARGS();
        pg8::Gemm g{h2, Bt_gu, D / 2}; pg8::MoeOrder S; S.init(__builtin_amdgcn_readfirstlane(t_start[32]), 16, G, bx); S.t2e = t_t2e; S.tstart = t_start; S.cnt = t_cnt; S.rowtok = rowtok_p;
        pg8::EpiSwiglu8 E{(unsigned char*)act, (const float*)AIN(21), (const float*)AIN(23)};
        pg8::gemm_phase_f8p<pg8::EpiSwiglu8, pg8::MoeOrder, true>(lds, g, S, E);
    }
    SEAM(7);
    if (IN(8)) {
        KARGS();
        pg8::Gemm g{act, Bt_d, FF / 2}; pg8::MoeOrder S; S.init(__builtin_amdgcn_readfirstlane(t_start[32]), 8, G, bx); S.t2e = t_t2e; S.tstart = t_start; S.cnt = t_cnt; S.rowtok = rowtok_p;
        pg8::EpiDown8 E{ybuf, (const float*)AIN(25)};
        pg8::gemm_phase_f8p<pg8::EpiDown8, pg8::MoeOrder>(lds, g, S, E);
    }
    SEAM(8);
    if (IN(9) && DBG_OUT) {
        KARGS();
        const bf16_t* src = DBG_OUT == 1 ? gates : DBG_OUT == 2 ? gates + 1024 : DBG_OUT == 3 ? qa : DBG_OUT == 4 ? ka : DBG_OUT == 5 ? va : DBG_OUT == 6 ? mrg : DBG_OUT == 7 ? oa : DBG_OUT == 9 ? Bt_in : ob;
        const int ld = DBG_OUT <= 2 ? 2048 : 1024;
        for (size_t i = (size_t)bx * 512 + tid; i < (size_t)T * 1024; i += (size_t)G * 512) AOUT[i] = (DBG_OUT == 9 && i >= (size_t)N_IN * 1024) ? 0.f : __uint_as_float((unsigned)src[(i >> 10) * ld + (i & 1023)] << 16);
    } else
    if (IN(9)) {
        KARGS();
        LANE_DECL;
        const float* g_fin = (const float*)AIN(26);
        for (int t0 = gw * 2; t0 < T; t0 += NGW * 2) {
            f32x4 v[2][4]; u32x2 as_[2][4];
#pragma unroll
            for (int q = 0; q < 2; ++q) { const u32x2* xr = (const u32x2*)(x1b + (size_t)(t0 + q) * D) + lane;
#pragma unroll
                for (int j = 0; j < 4; ++j) { const u32x2 w = xr[64 * j]; v[q][j] = (f32x4){bf_lo(w.x), bf_hi(w.x), bf_lo(w.y), bf_hi(w.y)}; }
#pragma unroll
                for (int k = 0; k < 4; ++k) as_[q][k] = assign[(size_t)(t0 + q) * 4 + k]; }
            unsigned yw[2][4][4];
#pragma unroll
            for (int q = 0; q < 2; ++q)
#pragma unroll
                for (int k = 0; k < 4; ++k) { const int e = as_[q][k].x >> 16, rank = as_[q][k].x & 0xffffu;
                    const unsigned* yr = (const unsigned*)(ybuf + ((size_t)t_start[e] * 256 + rank) * D) + lane;
#pragma unroll
                    for (int j = 0; j < 4; ++j) yw[q][k][j] = yr[64 * j]; }
#pragma unroll
            for (int q = 0; q < 2; ++q) {
#pragma unroll
                for (int k = 0; k < 4; ++k) { const float w = (DBG_SKIP & 1) ? 0.f : __uint_as_float(as_[q][k].y) * (1.0f / YS);
#pragma unroll
                    for (int j = 0; j < 4; ++j) { const int y = (int)yw[q][k][j]; const auto lo = __builtin_amdgcn_cvt_pk_f32_fp8(y, false), hi = __builtin_amdgcn_cvt_pk_f32_fp8(y, true);
                        v[q][j][0] += w * lo[0]; v[q][j][1] += w * lo[1]; v[q][j][2] += w * hi[0]; v[q][j][3] += w * hi[1]; } }
                float s = 0.f;
#pragma unroll
                for (int j = 0; j < 4; ++j) s += (v[q][j][0] * v[q][j][0] + v[q][j][1] * v[q][j][1]) + (v[q][j][2] * v[q][j][2] + v[q][j][3] * v[q][j][3]);
                const float rstd = __builtin_amdgcn_rsqf(wave_sum(s) * (1.f / D) + EPS);
                f32x4* xo = (f32x4*)(AOUT + (size_t)(t0 + q) * D) + lane;
#pragma unroll
                for (int j = 0; j < 4; ++j) { const f32x4 gg = *((const f32x4*)g_fin + lane + 64 * j); f32x4 ov = v[q][j] * rstd * gg;
#if PROBE_T
                    { const float e1 = __builtin_sqrtf(__uint_as_float(xb_ld((unsigned*)(AWS + WS_CTL) + CW_PROBE))), e2 = __uint_as_float(xb_ld((unsigned*)(AWS + WS_CTL) + CW_PROBE + 1));
                      ov[0] *= 1.f + e1; ov[1] *= 1.f - e1; ov[2] *= 1.f + e1; ov[3] *= 1.f - e1; if (t0 + q == 0 && j == 0 && lane == 0) ov[0] += e2; }
#endif
                    xo[64 * j] = ov; } }
        }
    }
#undef IN
#undef SEAM
#undef KARGS
#undef AIN
#undef AOUT
#undef AWS
#undef xin
#undef positions
#undef Bt_in
#undef Bt_uq
#undef Bt_ukv
#undef Bt_od
#undef Bt_om
#undef Bt_out
#undef ropeA
#undef ropeM
#undef sq
#undef hbuf
#undef oa
#undef qa
#undef ka
#undef va
#undef cq
#undef ckv
#undef kr
#undef gates
#undef qm
#undef kv
#undef ob
#undef mrg
#undef stash
#undef rowtok_p
#undef assign
#undef Bt_d
#undef Bt_gu
#undef h2
#undef act
#undef ybuf
#undef q8p
#undef k8np
#undef k8rp
#undef v8p
#undef q8lp
#undef v8ap
#undef vt8ap
#undef vt8p
#undef q8ap
#undef k8ap
#undef x1b
#undef count
}

extern "C" void kernel_launch(void* const* d_in, const int* in_sizes, int n_in, void* d_out, int out_size, void* d_ws, size_t ws_size, hipStream_t stream) {
    static int grid = 0;
    if (grid == 0) {
        if (n_in != 27 || in_sizes[0] != T * D || out_size != T * D || ws_size < WS_END) { fprintf(stderr, "kernel_launch: unexpected shapes (n_in %d, in0 %d, out %d, ws %zu < %zu)\n", n_in, n_in > 0 ? in_sizes[0] : -1, out_size, ws_size, (size_t)WS_END); grid = -1; return; }
        int dev = 0, cus = 0, per_cu = 0;
        if (hipGetDevice(&dev) != hipSuccess || hipDeviceGetAttribute(&cus, hipDeviceAttributeMultiprocessorCount, dev) != hipSuccess) { grid = -1; return; }
        if (hipFuncSetAttribute((const void*)fwd, hipFuncAttributeMaxDynamicSharedMemorySize, LDS_BYTES) != hipSuccess) { fprintf(stderr, "kernel_launch: hipFuncSetAttribute failed\n"); grid = -1; return; }
        if (hipOccupancyMaxActiveBlocksPerMultiprocessor(&per_cu, (const void*)fwd, NWAVES * 64, LDS_BYTES) != hipSuccess || per_cu < 1) fprintf(stderr, "kernel_launch: occupancy query says %d\n", per_cu);
        (void)hipGetLastError();
        grid = cus;
    }
    if (grid < 0) return;
    if (hipMemsetAsync((char*)d_ws + WS_CTL, 0, CTL_ZERO_BYTES, stream) != hipSuccess) return;
    Args a{};
    for (int i = 0; i < 27; ++i) a.in[i] = d_in[i];
    a.out = (float*)d_out; a.ws = (unsigned char*)d_ws;
#if MK_PER_PHASE
    for (int p = 0; p < NPHASE; ++p) { a.ph_lo = p; a.ph_hi = p + 1; hipLaunchKernelGGL(fwd, dim3(grid), dim3(NWAVES * 64), LDS_BYTES, stream, a); }
#elif PROBE_PHASE >= 0
    a.ph_lo = 0; a.ph_hi = PROBE_PHASE + 1; a.li = 0; hipLaunchKernelGGL(fwd, dim3(grid), dim3(NWAVES * 64), LDS_BYTES, stream, a);
    a.ph_lo = PROBE_PHASE; a.ph_hi = NPHASE; a.li = 1; hipLaunchKernelGGL(fwd, dim3(grid), dim3(NWAVES * 64), LDS_BYTES, stream, a);
#else
    a.ph_lo = 0; a.ph_hi = NPHASE; hipLaunchKernelGGL(fwd, dim3(grid), dim3(NWAVES * 64), LDS_BYTES, stream, a);
#endif
}
```

```cpp
#include <hip/hip_runtime.h>
#include <cstdio>
#include <cstdint>

#ifndef MK_PER_PHASE
#define MK_PER_PHASE 0
#endif

#ifndef PROBE_PHASE
#define PROBE_PHASE -1
#endif
#ifndef ATT_DUP
#ifndef DMA_SPREAD
#define DMA_SPREAD 1
#endif
#ifndef PROBE_DMA2
#define PROBE_DMA2 0
#endif
#ifndef MLA_QK8
#define MLA_QK8 1
#endif
#ifndef DA_QK8
#define DA_QK8 1
#endif
#ifndef UP_F8
#define UP_F8 1
#endif
#ifndef MLA_PV8
#define MLA_PV8 1
#endif
#ifndef DA_PV8
#define DA_PV8 2
#endif
#ifndef DA_QLO
#define DA_QLO 0
#endif
#ifndef VT_FUSED
#define VT_FUSED 1
#endif
#ifndef Q_X8
#define Q_X8 0
#endif
#ifndef BP_VLA
#define BP_VLA 3
#endif
#ifndef BP_KLA
#define BP_KLA 2
#endif
#ifndef PROBE_BASE
#define PROBE_BASE 1000.f
#endif
#ifndef PROBE_T
#define PROBE_T 0
#endif
#define ATT_DUP 0
#endif
#ifndef DBG_OUT
#define DBG_OUT 0
#endif
#ifndef DBG_SKIP
#define DBG_SKIP 0
#endif
#ifndef ATT_MASK
#define ATT_MASK 3
#endif
#ifndef PH_MASK
#define PH_MASK 0x3ff
#endif
#define LAS __attribute__((address_space(3)))
#define GAS __attribute__((address_space(1)))
typedef unsigned short bf16_t;
typedef short bf16x8 __attribute__((ext_vector_type(8)));
typedef short s16x4 __attribute__((ext_vector_type(4)));
typedef float f32x2 __attribute__((ext_vector_type(2)));
typedef float f32x4 __attribute__((ext_vector_type(4)));
typedef float f32x16 __attribute__((ext_vector_type(16)));
typedef unsigned u32x2 __attribute__((ext_vector_type(2)));
typedef unsigned u32x4 __attribute__((ext_vector_type(4)));

constexpr int NB = 4, SEQ = 4096, T = NB * SEQ, D = 1024;
constexpr int NEXP = 32, TOPK = 4, FF = 1024;
constexpr int N_IN = 6656;
constexpr int QL = 768, KVL = 512;
constexpr float EPS = 1e-6f;
constexpr float LAM_INIT = 0.2f;
constexpr int NPHASE = 10;

constexpr size_t MiB = 1u << 20;
constexpr size_t WS_CTL = 0, CTL_ZERO_BYTES = 1 * MiB;
constexpr size_t WS_BT_IN = 2 * MiB;
constexpr size_t WS_BT_UQ = 15 * MiB;
constexpr size_t WS_BT_UKV = 18 * MiB;
constexpr size_t WS_BT_OD = 20 * MiB, WS_BT_OM = 22 * MiB, WS_BT_OUT = 24 * MiB;
constexpr size_t WS_ROPEA = 26 * MiB;
constexpr size_t WS_ROPEM = 27 * MiB;
constexpr size_t WS_SQ = 31 * MiB;
constexpr size_t WS_SQP = 1 * MiB;
constexpr size_t WS_H = 32 * MiB;
constexpr size_t WS_QA = 64 * MiB, WS_KA = 96 * MiB, WS_VA = 128 * MiB;
constexpr size_t WS_X1B = 168 * MiB;
constexpr size_t WS_CQ = 160 * MiB, WS_CKV = 184 * MiB, WS_KR = 200 * MiB;
constexpr size_t WS_SQ2 = 202 * MiB;
constexpr size_t WS_GATES = 208 * MiB;
constexpr size_t WS_QM = 272 * MiB;
constexpr size_t WS_Q8 = 448 * MiB;
constexpr size_t WS_K8N = 472 * MiB;
constexpr size_t WS_Q8A = 416 * MiB;
constexpr size_t WS_K8A = 432 * MiB;
constexpr size_t WS_V8 = 304 * MiB;
constexpr size_t WS_VT8 = 320 * MiB;
constexpr size_t WS_V8A = 336 * MiB;
constexpr size_t WS_VT8A = 352 * MiB;
constexpr size_t WS_Q8L = 368 * MiB;
constexpr size_t WS_K8R = 488 * MiB;
constexpr size_t WS_KV = 320 * MiB;
constexpr size_t WS_OB = 384 * MiB;
constexpr size_t WS_MRG = 416 * MiB;
constexpr size_t WS_STASH = 448 * MiB;
constexpr size_t WS_ROWTOK = 2 * MiB;
constexpr size_t WS_ASSIGN = 4 * MiB;
constexpr size_t WS_BT_D = 32 * MiB;
constexpr size_t WS_BT_GU = 96 * MiB;
constexpr size_t WS_H2 = 224 * MiB;
constexpr size_t WS_ACT = 256 * MiB;
constexpr size_t WS_Y = 96 * MiB;
constexpr size_t WS_END = 512 * MiB;
constexpr int CW_COUNT = 64;
constexpr int CW_BAR = 4096;
constexpr int CW_PROBE = 128;

constexpr int RING_BYTES = 147456;
constexpr int TAB_OFF = RING_BYTES;
constexpr int TAB_BYTES = 8192;
constexpr int MISC_OFF = TAB_OFF + TAB_BYTES;
constexpr int LDS_BYTES = 157696;

typedef __bf16 bf16x2_t __attribute__((ext_vector_type(2)));
__device__ __forceinline__ unsigned cvt_pk_bf16(float lo, float hi) { const f32x2 v = {lo, hi}; return __builtin_bit_cast(unsigned, __builtin_convertvector(v, bf16x2_t)); }
__device__ __forceinline__ float bf_lo(unsigned w) { return __uint_as_float(w << 16); }
__device__ __forceinline__ float bf_hi(unsigned w) { return __uint_as_float(w & 0xffff0000u); }
__device__ __forceinline__ float wave_sum(float v) {
#pragma unroll
    for (int o = 1; o < 64; o <<= 1) v += __shfl_xor(v, o);
    return v;
}
__device__ __forceinline__ float sigmoidf_(float x) { return __builtin_amdgcn_rcpf(1.0f + __builtin_amdgcn_exp2f(-1.4426950408889634f * x)); }
__device__ __forceinline__ unsigned cvt_pk_fp8x4(float a, float b, float c, float d) {
    a = fminf(fmaxf(a, -448.f), 448.f); b = fminf(fmaxf(b, -448.f), 448.f); c = fminf(fmaxf(c, -448.f), 448.f); d = fminf(fmaxf(d, -448.f), 448.f);
    int r = __builtin_amdgcn_cvt_pk_fp8_f32(a, b, 0, false); r = __builtin_amdgcn_cvt_pk_fp8_f32(c, d, r, true); return (unsigned)r; }
#define LDS_WAIT() asm volatile("s_waitcnt lgkmcnt(0)" ::: "memory")
#define VM_WAIT() asm volatile("s_waitcnt vmcnt(0)" ::: "memory")

#define XB_TMO      128
#define XB_XCNT(j)  (256  + 64 * (j))
#define XB_XSUB(j)  (1280 + 64 * (j))
#define XB_XGEN(j)  (2304 + 64 * (j))
#define XB_TOP      3328
#define XB_TOPGEN   3392
#define XCD_BAR_WORDS 3456
#define XB_SPIN_CAP (1u << 20)
__device__ __forceinline__ unsigned xb_ld(unsigned* p)              { return __hip_atomic_load(p, __ATOMIC_RELAXED, __HIP_MEMORY_SCOPE_AGENT); }
__device__ __forceinline__ unsigned xb_add(unsigned* p, unsigned v) { return __hip_atomic_fetch_add(p, v, __ATOMIC_RELAXED, __HIP_MEMORY_SCOPE_AGENT); }
__device__ __forceinline__ unsigned xb_xcc_id() { return (unsigned)__builtin_amdgcn_s_getreg((3 << 11) | 20) & 0xFu; }
#define XB_SPIN(cond, bar) do { unsigned _sp = 0; while (cond) { __builtin_amdgcn_s_sleep(1); \
    if ((++_sp & 255u) == 0u) { if (xb_ld(&(bar)[XB_TMO])) break; if (_sp > XB_SPIN_CAP) { atomicAdd(&(bar)[XB_TMO], 1u); break; } } } } while (0)
struct XcdBarrier { unsigned* bar; unsigned x; volatile LAS unsigned* st; };
__device__ __forceinline__ XcdBarrier xcd_barrier_post(unsigned* bar, volatile LAS unsigned* st) {
    XcdBarrier b; b.bar = bar; b.x = xb_xcc_id(); b.st = st;
    if (threadIdx.x == 0) (void)xb_add(&bar[XB_XCNT(b.x)], 1u);
    return b;
}
__device__ __forceinline__ void xcd_barrier_complete(unsigned* bar, unsigned x, unsigned& nloc, unsigned& nx) {
    const unsigned G = gridDim.x * gridDim.y * gridDim.z;
    unsigned sum, cnt, mine, sp = 0u;
    for (;;) {
        sum = 0u; cnt = 0u; mine = 0u;
#pragma unroll
        for (unsigned j = 0; j < 16; ++j) { const unsigned c = xb_ld(&bar[XB_XCNT(j)]); sum += c; cnt += (c > 0u) ? 1u : 0u; mine = (j == x) ? c : mine; }
        if (sum == G) break;
        __builtin_amdgcn_s_sleep(1);
        if ((++sp & 255u) == 0u) { if (xb_ld(&bar[XB_TMO])) break; if (sp > XB_SPIN_CAP) { atomicAdd(&bar[XB_TMO], 1u); break; } }
    }
    nloc = mine > 0u ? mine : 1u; nx = cnt > 0u ? cnt : 1u;
}
__device__ __forceinline__ void xcd_barrier(const XcdBarrier& b) {
    asm volatile("s_waitcnt vmcnt(0)" ::: "memory");
    __syncthreads();
    if (threadIdx.x == 0) {
        unsigned* bar = b.bar;
        __builtin_amdgcn_s_waitcnt(0);
        unsigned nloc = b.st[0], nx = b.st[1];
        if (nloc == 0u) { xcd_barrier_complete(bar, b.x, nloc, nx); b.st[0] = nloc; b.st[1] = nx; }
        const unsigned old = xb_add(&bar[XB_XSUB(b.x)], 1u);
        const unsigned gen = old / nloc;
        if (old + 1u == (gen + 1u) * nloc) {
            __builtin_amdgcn_fence(__ATOMIC_RELEASE, "agent");
            asm volatile("s_waitcnt vmcnt(0)" ::: "memory");
            const unsigned og = xb_add(&bar[XB_TOP], 1u);
            const unsigned tg = og / nx;
            if (og + 1u == (tg + 1u) * nx) xb_add(&bar[XB_TOPGEN], 1u);
            else XB_SPIN(xb_ld(&bar[XB_TOPGEN]) == tg, bar);
            __builtin_amdgcn_fence(__ATOMIC_ACQUIRE, "agent");
            xb_add(&bar[XB_XGEN(b.x)], 1u);
            asm volatile("s_waitcnt vmcnt(0)" ::: "memory");
        } else {
            XB_SPIN(xb_ld(&bar[XB_XGEN(b.x)]) == gen, bar);
            __builtin_amdgcn_fence(__ATOMIC_ACQUIRE, "agent");
            asm volatile("s_waitcnt vmcnt(0)" ::: "memory");
        }
    }
    __syncthreads();
}

constexpr float W8S = 1.0f / 64.0f;
constexpr float YS = 16.0f;
constexpr float QS_MLA = 0.07216878364870322f * 1.4426950408889634f;
constexpr float QS_DA = 0.125f * 1.4426950408889634f;
namespace pg8 {
constexpr int BM = 256, BK = 64, HALF = 128, HTB = HALF * BK * 2, STAGE_BYTES = 8 * HTB, NXCD = 8, WGM = 8;
__host__ __device__ __forceinline__ int lds_byte(int r, int c) { const int st = (r >> 4) * 2 + (c >> 5), rr = r & 15, cc = c & 31, ob = rr * 64 + cc * 2; return st * 1024 + (ob ^ (((ob >> 9) & 1) << 5)); }
__host__ __device__ __forceinline__ void stage_rc(int b, int& R, int& C) { const int st = b / 1024, sb = b % 1024, swz = sb ^ (((sb >> 9) & 1) << 5); R = (st >> 1) * 16 + swz / 64; C = (st & 1) * 32 + (swz % 64) / 2; }
__host__ __device__ __forceinline__ int perm32(int rho) { const int n = rho >> 4, i = rho & 15; return 8 * (i >> 2) + 4 * n + (i & 3); }

struct Unit { int pm, pn, pb, e, rbase, cnt; };
struct Gemm { const bf16_t* A; const bf16_t* Bt; int K; };

struct DenseOrder {
    int nM, nN, nwg, G, c, pn0;
    __device__ void init(int nM_, int nN_, int G_, int c_, int pn0_ = 0) { nM = nM_; nN = nN_; nwg = nM * nN; G = G_; c = c_; pn0 = pn0_; }
    __device__ __forceinline__ bool next(int i, Unit& u) const {
        const long L = (long)i * G + c; if (L >= nwg) return false;
        int wgid = (int)L; { const int q = nwg / NXCD, r = nwg % NXCD, xcd = wgid % NXCD, off = wgid / NXCD; wgid = (xcd < r ? xcd * (q + 1) : r * (q + 1) + (xcd - r) * q) + off; }
        const int nig = WGM * nN, gid = wgid / nig, fm = gid * WGM, gsz = (nM - fm) < WGM ? (nM - fm) : WGM;
        u.pm = fm + ((wgid % nig) % gsz); u.pn = pn0 + (wgid % nig) / gsz; u.pb = u.pn; u.e = 0; u.rbase = 0; u.cnt = 0; return true;
    }
    __device__ __forceinline__ int a_row(const Unit&, int) const { return 0; }
};
struct MoeOrder {
    int nM, nN, nwg, G, c; const LAS int* t2e; const LAS int* tstart; const LAS int* cnt; const int* rowtok;
    __device__ void init(int nM_, int nN_, int G_, int c_) { nM = nM_; nN = nN_; nwg = nM * nN; G = G_; c = c_; }
    __device__ __forceinline__ bool next(int i, Unit& u) const {
        const long L = (long)i * G + c; if (L >= nwg) return false;
        int wgid = (int)L; { const int q = nwg / NXCD, r = nwg % NXCD, xcd = wgid % NXCD, off = wgid / NXCD; wgid = (xcd < r ? xcd * (q + 1) : r * (q + 1) + (xcd - r) * q) + off; }
        const int nig = WGM * nN, gid = wgid / nig, fm = gid * WGM, gsz = (nM - fm) < WGM ? (nM - fm) : WGM;
        u.pm = fm + ((wgid % nig) % gsz); u.pn = (wgid % nig) / gsz;
        const int e = __builtin_amdgcn_readfirstlane(t2e[u.pm]); u.e = e; u.pb = e * nN + u.pn; u.rbase = (u.pm - __builtin_amdgcn_readfirstlane(tstart[e])) * 256; u.cnt = __builtin_amdgcn_readfirstlane(cnt[e]); return true;
    }
    __device__ __forceinline__ int a_row(const Unit& u, int r) const { const int rank = u.rbase + r; return rank < u.cnt ? rowtok[u.e * T + rank] : 0; }
};

template <class Epi, class Sched, bool GATHER, bool ALIGN_EPI>
__device__ __forceinline__ void gemm_phase(LAS unsigned char* lds, const Gemm g, const Sched& S, const Epi& E) {
    const int tid = threadIdx.x, wid = __builtin_amdgcn_readfirstlane(tid >> 6), lane = tid & 63, wr = wid >> 2, wc = wid & 3, fr = lane & 15, fq = lane >> 4;
    const int K = g.K, nt = K / BK;
    unsigned voffA[2], voffB[2]; int Rv[2], Cv[2];
#pragma unroll
    for (int i = 0; i < 2; ++i) { int R, C; stage_rc(tid * 16 + i * 8192, R, C); const int Rb = Epi::PERM ? ((R & ~31) + perm32(R & 31)) : R;
        voffA[i] = (unsigned)(R * K + C) * 2u; voffB[i] = (unsigned)(Rb * K + C) * 2u; Rv[i] = R; Cv[i] = C; }
    const size_t kstep = (size_t)(BK * 2);
    const size_t hstep = (size_t)HALF * K * 2;
    const size_t tstep = 2 * hstep;
    const unsigned ldsw = (unsigned)wid * 1024u;
    const int aoff = lds_byte(wr * 64 + fr, fq * 8), boff = lds_byte(wc * 32 + fr, fq * 8);
#define PG8_SA(b, h) (((b) * 2 + (h)) * HTB)
#define PG8_SB(b, h) ((4 + (b) * 2 + (h)) * HTB)
#define PG8_STAGE(bufoff, gbase, voff) do { _Pragma("unroll") for (int _i = 0; _i < 2; ++_i) \
        __builtin_amdgcn_global_load_lds((const unsigned*)((const char*)(gbase) + (voff)[_i]), (LAS unsigned*)(lds + (bufoff) + ldsw + _i * 8192), 16, 0, 0); } while (0)
#define PG8_LDA(dst, b, h) do { _Pragma("unroll") for (int m = 0; m < 4; ++m) _Pragma("unroll") for (int k = 0; k < 2; ++k) dst[m][k] = *(const LAS bf16x8*)(lds + PG8_SA(b, h) + aoff + m * 2048 + k * 1024); } while (0)
#define PG8_LDB(dst, b, h) do { _Pragma("unroll") for (int n = 0; n < 2; ++n) _Pragma("unroll") for (int k = 0; k < 2; ++k) dst[n][k] = *(const LAS bf16x8*)(lds + PG8_SB(b, h) + boff + n * 2048 + k * 1024); } while (0)
#define PG8_MMA(ai, bj, At, Bt) do { __builtin_amdgcn_s_setprio(1); _Pragma("unroll") for (int m = 0; m < 4; ++m) _Pragma("unroll") for (int n = 0; n < 2; ++n) _Pragma("unroll") for (int k = 0; k < 2; ++k) \
        acc[ai][bj][m][n] = __builtin_amdgcn_mfma_f32_16x16x32_bf16(Bt[n][k], At[m][k], acc[ai][bj][m][n], 0, 0, 0); __builtin_amdgcn_s_setprio(0); } while (0)
#define PG8_WAIT_V(n) asm volatile("s_waitcnt vmcnt(" #n ")" ::: "memory")
#define PG8_WAIT_L(n) asm volatile("s_waitcnt lgkmcnt(" #n ")" ::: "memory")
#define PG8_BAR __builtin_amdgcn_s_barrier()
#define PG8_SCHED __builtin_amdgcn_sched_barrier(0)
    Unit cur, nxt; int ui = 0;
    if (!S.next(0, cur)) return;
    f32x4 acc[2][2][4][2];
#pragma unroll
    for (int a = 0; a < 2; ++a)
#pragma unroll
        for (int b = 0; b < 2; ++b)
#pragma unroll
            for (int m = 0; m < 4; ++m)
#pragma unroll
                for (int n = 0; n < 2; ++n) acc[a][b][m][n] = (f32x4){0.f, 0.f, 0.f, 0.f};
    bf16x8 At[4][2], B0[2][2], B1[2][2];
    unsigned gC0[2], gC1[2], gN0[2], gN1[2];
    if constexpr (GATHER) {
#pragma unroll
        for (int i = 0; i < 2; ++i) { gC0[i] = (unsigned)S.a_row(cur, Rv[i]) * (unsigned)(K * 2) + (unsigned)Cv[i] * 2u; gC1[i] = (unsigned)S.a_row(cur, HALF + Rv[i]) * (unsigned)(K * 2) + (unsigned)Cv[i] * 2u; gN0[i] = gC0[i]; gN1[i] = gC1[i]; }
    }
    const char* cA = GATHER ? (const char*)g.A : (const char*)g.A + (size_t)cur.pm * tstep; const char* cB = (const char*)g.Bt + (size_t)cur.pb * tstep;
#define PG8_STAGE_A(bufoff, p, h, o0, o1) do { if constexpr (GATHER) { if ((h) == 0) PG8_STAGE(bufoff, p, o0); else PG8_STAGE(bufoff, p, o1); } else { PG8_STAGE(bufoff, (p) + (h) * hstep, voffA); } } while (0)
    PG8_STAGE(PG8_SB(0, 0), cB, voffB); PG8_STAGE(PG8_SB(0, 1), cB + hstep, voffB); PG8_STAGE_A(PG8_SA(0, 0), cA, 0, gC0, gC1); PG8_STAGE_A(PG8_SA(0, 1), cA, 1, gC0, gC1);
    if (wr == 1) PG8_BAR;
    PG8_WAIT_V(2); PG8_BAR;
    PG8_STAGE(PG8_SB(1, 0), cB + kstep, voffB); PG8_STAGE_A(PG8_SA(1, 0), cA + kstep, 0, gC0, gC1); PG8_STAGE(PG8_SB(1, 1), cB + hstep + kstep, voffB);
    PG8_WAIT_V(6); PG8_BAR;
    for (;;) {
        const bool has_next = S.next(ui + 1, nxt);
        const char* nA = GATHER ? (const char*)g.A : (has_next ? (const char*)g.A + (size_t)nxt.pm * tstep : cA); const char* nB = has_next ? (const char*)g.Bt + (size_t)nxt.pb * tstep : cB;
        if constexpr (GATHER) { if (has_next) {
#pragma unroll
            for (int i = 0; i < 2; ++i) { gN0[i] = (unsigned)S.a_row(nxt, Rv[i]) * (unsigned)(K * 2) + (unsigned)Cv[i] * 2u; gN1[i] = (unsigned)S.a_row(nxt, HALF + Rv[i]) * (unsigned)(K * 2) + (unsigned)Cv[i] * 2u; } } }
        for (int t = 0; t < nt; t += 2) {
            const bool last = (t == nt - 2);
            const char* a1 = cA + (size_t)(t + 1) * kstep;
            const char* a2 = last ? nA : cA + (size_t)(t + 2) * kstep; const char* b2 = last ? nB : cB + (size_t)(t + 2) * kstep;
            const char* a3 = a2 + kstep; const char* b3 = b2 + kstep;
            unsigned s0[2], s1[2];
            if constexpr (GATHER) { s0[0] = last ? gN0[0] : gC0[0]; s0[1] = last ? gN0[1] : gC0[1]; s1[0] = last ? gN1[0] : gC1[0]; s1[1] = last ? gN1[1] : gC1[1]; }
            PG8_LDB(B0, 0, 0); PG8_LDB(B1, 0, 1); PG8_SCHED; PG8_LDA(At, 0, 0); PG8_STAGE_A(PG8_SA(1, 1), a1, 1, gC0, gC1);
            PG8_WAIT_V(8); PG8_WAIT_L(0); PG8_BAR; PG8_MMA(0, 0, At, B0); PG8_MMA(0, 1, At, B1); PG8_BAR; PG8_SCHED;
            PG8_LDA(At, 0, 1); PG8_STAGE(PG8_SB(0, 0), b2, voffB); PG8_STAGE(PG8_SB(0, 1), b2 + hstep, voffB); PG8_STAGE_A(PG8_SA(0, 0), a2, 0, s0, s1);
            PG8_WAIT_V(8); PG8_WAIT_L(0); PG8_BAR; PG8_MMA(1, 0, At, B0); PG8_MMA(1, 1, At, B1); PG8_BAR; PG8_SCHED;
            PG8_LDB(B0, 1, 0); PG8_LDB(B1, 1, 1); PG8_SCHED; PG8_LDA(At, 1, 0); PG8_STAGE_A(PG8_SA(0, 1), a2, 1, s0, s1);
            PG8_WAIT_V(8); PG8_WAIT_L(0); PG8_BAR; PG8_MMA(0, 0, At, B0); PG8_MMA(0, 1, At, B1); PG8_BAR; PG8_SCHED;
            PG8_LDA(At, 1, 1); PG8_STAGE(PG8_SB(1, 0), b3, voffB); PG8_STAGE(PG8_SB(1, 1), b3 + hstep, voffB); PG8_STAGE_A(PG8_SA(1, 0), a3, 0, s0, s1);
            PG8_WAIT_V(8); PG8_WAIT_L(0); PG8_BAR; PG8_MMA(1, 0, At, B0); PG8_MMA(1, 1, At, B1); PG8_BAR; PG8_SCHED;
        }
        if constexpr (ALIGN_EPI) { if (wr == 0) PG8_BAR; }
        E(acc, cur, wr, wc, fr, fq);
        if (!has_next) break;
#pragma unroll
        for (int a = 0; a < 2; ++a)
#pragma unroll
            for (int b = 0; b < 2; ++b)
#pragma unroll
                for (int m = 0; m < 4; ++m)
#pragma unroll
                    for (int n = 0; n < 2; ++n) acc[a][b][m][n] = (f32x4){0.f, 0.f, 0.f, 0.f};
        cur = nxt; cA = nA; cB = nB; ++ui;
        if constexpr (GATHER) { gC0[0] = gN0[0]; gC0[1] = gN0[1]; gC1[0] = gN1[0]; gC1[1] = gN1[1]; }
        if constexpr (ALIGN_EPI) { if (wr == 1) PG8_BAR; }
    }
    PG8_WAIT_V(0);
    if constexpr (!ALIGN_EPI) { if (wr == 0) PG8_BAR; }
    PG8_BAR;
#undef PG8_SA
#undef PG8_SB
#undef PG8_STAGE
#undef PG8_STAGE_A
#undef PG8_LDA
#undef PG8_LDB
#undef PG8_MMA
#undef PG8_WAIT_V
#undef PG8_WAIT_L
#undef PG8_BAR
#undef PG8_SCHED
}

template <class Epi, class Sched, bool GATHER = false>
__device__ __forceinline__ void gemm_phase_f8n(LAS unsigned char* lds, const Gemm g, const Sched& S, const Epi& E) {
    const int tid = threadIdx.x, wid = __builtin_amdgcn_readfirstlane(tid >> 6), lane = tid & 63, wr = wid >> 2, wc = wid & 3, fr = lane & 15, fq = lane >> 4;
    const int K = g.K, nt = K / BK;
    unsigned voffA[2], voffB[2]; int Rv[2], Cv[2];
#pragma unroll
    for (int i = 0; i < 2; ++i) { int R, C; stage_rc(tid * 16 + i * 8192, R, C); const int Rb = (R & ~31) + perm32(R & 31);
        voffA[i] = (unsigned)(R * K + C) * 2u; voffB[i] = (unsigned)(Rb * K + C) * 2u; Rv[i] = R; Cv[i] = C; }
    const size_t kstep = (size_t)(BK * 2), hstep = (size_t)HALF * K * 2, tstep = 2 * hstep;
    const unsigned ldsw = (unsigned)wid * 1024u;
    const int aoff = lds_byte(wr * 64 + fr, fq * 8), boff = lds_byte(wc * 32 + fr, fq * 8);
    typedef int v8i_t __attribute__((ext_vector_type(8))); typedef int v4i_t __attribute__((ext_vector_type(4)));
#define F8_SA(b, h) (((b) * 2 + (h)) * HTB)
#define F8_SB(b) ((4 + (b) * 2) * HTB)
#define F8_STAGE(bufoff, gbase, voff) do { _Pragma("unroll") for (int _i = 0; _i < 2; ++_i) \
        __builtin_amdgcn_global_load_lds((const unsigned*)((const char*)(gbase) + (voff)[_i]), (LAS unsigned*)(lds + (bufoff) + ldsw + _i * 8192), 16, 0, 0); } while (0)
#define F8_LDA(b, h) do { _Pragma("unroll") for (int m = 0; m < 4; ++m) _Pragma("unroll") for (int k = 0; k < 2; ++k) At[m][k] = *(const LAS bf16x8*)(lds + F8_SA(b, h) + aoff + m * 2048 + k * 1024); } while (0)
#define F8_LDB(b) do { _Pragma("unroll") for (int n = 0; n < 2; ++n) _Pragma("unroll") for (int k = 0; k < 2; ++k) B0[n][k] = *(const LAS bf16x8*)(lds + F8_SB(b) + boff + n * 2048 + k * 1024); } while (0)
#define F8_CAT(x0, x1) __builtin_shufflevector(__builtin_bit_cast(v4i_t, x0), __builtin_bit_cast(v4i_t, x1), 0, 1, 2, 3, 4, 5, 6, 7)
#define F8_MMA(ai) do { __builtin_amdgcn_s_setprio(1); _Pragma("unroll") for (int m = 0; m < 4; ++m) _Pragma("unroll") for (int n = 0; n < 2; ++n) \
        acc[ai][m][n] = __builtin_amdgcn_mfma_scale_f32_16x16x128_f8f6f4(F8_CAT(B0[n][0], B0[n][1]), F8_CAT(At[m][0], At[m][1]), acc[ai][m][n], 0, 0, 0, 0x79797979, 0, 0x7f7f7f7f); \
        __builtin_amdgcn_s_setprio(0); } while (0)
#define F8_WAIT_V(n) asm volatile("s_waitcnt vmcnt(" #n ")" ::: "memory")
#define F8_WAIT_L(n) asm volatile("s_waitcnt lgkmcnt(" #n ")" ::: "memory")
#define F8_BAR __builtin_amdgcn_s_barrier()
#define F8_SCHED __builtin_amdgcn_sched_barrier(0)
    Unit cur, nxt; int ui = 0;
    if (!S.next(0, cur)) return;
    f32x4 acc[2][4][2];
#pragma unroll
    for (int a = 0; a < 2; ++a)
#pragma unroll
        for (int m = 0; m < 4; ++m)
#pragma unroll
            for (int n = 0; n < 2; ++n) acc[a][m][n] = (f32x4){0.f, 0.f, 0.f, 0.f};
    bf16x8 At[4][2], B0[2][2];
    unsigned gC0[2], gC1[2], gN0[2], gN1[2];
    if constexpr (GATHER) {
#pragma unroll
        for (int i = 0; i < 2; ++i) { gC0[i] = (unsigned)S.a_row(cur, Rv[i]) * (unsigned)(K * 2) + (unsigned)Cv[i] * 2u; gC1[i] = (unsigned)S.a_row(cur, HALF + Rv[i]) * (unsigned)(K * 2) + (unsigned)Cv[i] * 2u; gN0[i] = gC0[i]; gN1[i] = gC1[i]; }
    }
    const char* cA = GATHER ? (const char*)g.A : (const char*)g.A + (size_t)cur.pm * tstep; const char* cB = (const char*)g.Bt + (size_t)cur.pb * hstep;
#define F8_STAGE_A(bufoff, p, h, o0, o1) do { if constexpr (GATHER) { if ((h) == 0) F8_STAGE(bufoff, p, o0); else F8_STAGE(bufoff, p, o1); } else { F8_STAGE(bufoff, (p) + (h) * hstep, voffA); } } while (0)
    F8_STAGE(F8_SB(0), cB, voffB); F8_STAGE_A(F8_SA(0, 0), cA, 0, gC0, gC1); F8_STAGE_A(F8_SA(0, 1), cA, 1, gC0, gC1);
    if (wr == 1) F8_BAR;
    F8_WAIT_V(2); F8_BAR;
    F8_STAGE(F8_SB(1), cB + kstep, voffB); F8_STAGE_A(F8_SA(1, 0), cA + kstep, 0, gC0, gC1);
    F8_WAIT_V(4); F8_BAR;
    for (;;) {
        const bool has_next = S.next(ui + 1, nxt);
        const char* nA = GATHER ? (const char*)g.A : (has_next ? (const char*)g.A + (size_t)nxt.pm * tstep : cA); const char* nB = has_next ? (const char*)g.Bt + (size_t)nxt.pb * hstep : cB;
        if constexpr (GATHER) { if (has_next) {
#pragma unroll
            for (int i = 0; i < 2; ++i) { gN0[i] = (unsigned)S.a_row(nxt, Rv[i]) * (unsigned)(K * 2) + (unsigned)Cv[i] * 2u; gN1[i] = (unsigned)S.a_row(nxt, HALF + Rv[i]) * (unsigned)(K * 2) + (unsigned)Cv[i] * 2u; } } }
#pragma unroll 1
        for (int t = 0; t < nt; t += 2) {
            const bool last = (t == nt - 2);
            const char* a1 = cA + (size_t)(t + 1) * kstep;
            const char* a2 = last ? nA : cA + (size_t)(t + 2) * kstep; const char* b2 = last ? nB : cB + (size_t)(t + 2) * kstep;
            const char* a3 = a2 + kstep; const char* b3 = b2 + kstep;
            unsigned s0[2], s1[2];
            if constexpr (GATHER) { s0[0] = last ? gN0[0] : gC0[0]; s0[1] = last ? gN0[1] : gC0[1]; s1[0] = last ? gN1[0] : gC1[0]; s1[1] = last ? gN1[1] : gC1[1]; }
            F8_LDB(0); F8_SCHED; F8_LDA(0, 0); F8_STAGE_A(F8_SA(1, 1), a1, 1, gC0, gC1);
            F8_WAIT_V(6); F8_WAIT_L(0); F8_BAR; F8_MMA(0); F8_BAR; F8_SCHED;
            F8_LDA(0, 1); F8_STAGE(F8_SB(0), b2, voffB); F8_STAGE_A(F8_SA(0, 0), a2, 0, s0, s1);
            F8_WAIT_V(6); F8_WAIT_L(0); F8_BAR; F8_MMA(1); F8_BAR; F8_SCHED;
            F8_LDB(1); F8_SCHED; F8_LDA(1, 0); F8_STAGE_A(F8_SA(0, 1), a2, 1, s0, s1);
            F8_WAIT_V(6); F8_WAIT_L(0); F8_BAR; F8_MMA(0); F8_BAR; F8_SCHED;
            F8_LDA(1, 1); F8_STAGE(F8_SB(1), b3, voffB); F8_STAGE_A(F8_SA(1, 0), a3, 0, s0, s1);
            F8_WAIT_V(6); F8_WAIT_L(0); F8_BAR; F8_MMA(1); F8_BAR; F8_SCHED;
        }
        if (wr == 0) F8_BAR;
        E(acc, cur, wr, wc, fr, fq);
        if (!has_next) break;
#pragma unroll
        for (int a = 0; a < 2; ++a)
#pragma unroll
            for (int m = 0; m < 4; ++m)
#pragma unroll
                for (int n = 0; n < 2; ++n) acc[a][m][n] = (f32x4){0.f, 0.f, 0.f, 0.f};
        cur = nxt; cA = nA; cB = nB; ++ui;
        if constexpr (GATHER) { gC0[0] = gN0[0]; gC0[1] = gN0[1]; gC1[0] = gN1[0]; gC1[1] = gN1[1]; }
        if (wr == 1) F8_BAR;
    }
    F8_WAIT_V(0);
    F8_BAR;
#undef F8_SA
#undef F8_SB
#undef F8_STAGE
#undef F8_LDA
#undef F8_LDB
#undef F8_CAT
#undef F8_MMA
#undef F8_WAIT_V
#undef F8_WAIT_L
#undef F8_BAR
#undef F8_SCHED
#undef F8_STAGE_A
}
template <int I> struct SIC { static constexpr int value = I; };
template <int LO, int HI, class F> __device__ __forceinline__ void ssfor(F&& f) { if constexpr (LO < HI) { f(SIC<LO>{}); ssfor<LO + 1, HI>(f); } }
template <class Epi, class Sched, bool GATHER = false>
__device__ __forceinline__ void gemm_phase_f8p(LAS unsigned char* lds, const Gemm g, const Sched& S, const Epi& E) {
    const int tid = threadIdx.x, wid = __builtin_amdgcn_readfirstlane(tid >> 6), lane = tid & 63, wr = wid >> 2, wc = wid & 3, fr = lane & 15, fq = lane >> 4;
    const int K = g.K, nt = K / BK;
    unsigned voffA[2], voffB[2]; int Rv[2], Cv[2];
#pragma unroll
    for (int i = 0; i < 2; ++i) { int R, C; stage_rc(tid * 16 + i * 8192, R, C); const int Rb = (R & ~31) + perm32(R & 31);
        voffA[i] = (unsigned)(R * K + C) * 2u; voffB[i] = (unsigned)(Rb * K + C) * 2u; Rv[i] = R; Cv[i] = C; }
    const size_t kstep = (size_t)(BK * 2), hstep = (size_t)HALF * K * 2, tstep = 2 * hstep;
    const unsigned ldsw = (unsigned)wid * 1024u;
    const int aoff = lds_byte(wr * 64 + fr, fq * 8), boff = lds_byte(wc * 32 + fr, fq * 8);
    constexpr int STG = 3 * HTB;
    typedef int v8i_t __attribute__((ext_vector_type(8))); typedef int v4i_t __attribute__((ext_vector_type(4)));
#define P8_CAT(x0, x1) __builtin_shufflevector(__builtin_bit_cast(v4i_t, x0), __builtin_bit_cast(v4i_t, x1), 0, 1, 2, 3, 4, 5, 6, 7)
#define P8_GLDS(src, dstoff) __builtin_amdgcn_global_load_lds((const unsigned*)(src), (LAS unsigned*)(lds + (dstoff)), 16, 0, 0)
#define P8_PIECE(p, pa, pb, o0, o1, st) do { constexpr int i_ = (p) & 1; \
        if constexpr ((p) < 2)      { if constexpr (GATHER) P8_GLDS((pa) + (o0)[i_], (st) * STG + ldsw + i_ * 8192); else P8_GLDS((pa) + voffA[i_], (st) * STG + ldsw + i_ * 8192); } \
        else if constexpr ((p) < 4) { if constexpr (GATHER) P8_GLDS((pa) + (o1)[i_], (st) * STG + HTB + ldsw + i_ * 8192); else P8_GLDS((pa) + hstep + voffA[i_], (st) * STG + HTB + ldsw + i_ * 8192); } \
        else                        P8_GLDS((pb) + voffB[i_], (st) * STG + 2 * HTB + ldsw + i_ * 8192); } while (0)
#define P8_WAIT_V(n) asm volatile("s_waitcnt vmcnt(" #n ")" ::: "memory")
#define P8_BAR do { asm volatile("" ::: "memory"); __builtin_amdgcn_s_barrier(); asm volatile("" ::: "memory"); } while (0)
#define P8_SCHED __builtin_amdgcn_sched_barrier(0)
    Unit cur, nxt; int ui = 0;
    if (!S.next(0, cur)) return;
    f32x4 acc[2][4][2];
#pragma unroll
    for (int a = 0; a < 2; ++a)
#pragma unroll
        for (int m = 0; m < 4; ++m)
#pragma unroll
            for (int n = 0; n < 2; ++n) acc[a][m][n] = (f32x4){0.f, 0.f, 0.f, 0.f};
    bf16x8 AX[4][2], AY[4][2], BX[2][2], BY[2][2];
    unsigned gC0[2], gC1[2], gN0[2], gN1[2];
    if constexpr (GATHER) {
#pragma unroll
        for (int i = 0; i < 2; ++i) { gC0[i] = (unsigned)S.a_row(cur, Rv[i]) * (unsigned)(K * 2) + (unsigned)Cv[i] * 2u; gC1[i] = (unsigned)S.a_row(cur, HALF + Rv[i]) * (unsigned)(K * 2) + (unsigned)Cv[i] * 2u; gN0[i] = gC0[i]; gN1[i] = gC1[i]; }
    }
    const char* cA = GATHER ? (const char*)g.A : (const char*)g.A + (size_t)cur.pm * tstep; const char* cB = (const char*)g.Bt + (size_t)cur.pb * hstep;
#define P8_SP(AI, Acur, Anxt, Bcur, Bnxt, RDB, sr, hr, P0, qa, qb, q0, q1, sd) do { \
        ssfor<0, 8>([&](auto gc) __attribute__((always_inline)) { constexpr int g_ = decltype(gc)::value, m_ = g_ >> 1, n_ = g_ & 1; \
            acc[AI][m_][n_] = __builtin_amdgcn_mfma_scale_f32_16x16x128_f8f6f4(P8_CAT(Bcur[n_][0], Bcur[n_][1]), P8_CAT(Acur[m_][0], Acur[m_][1]), acc[AI][m_][n_], 0, 0, 0, 0, 0, 0);     \
            if constexpr (g_ == 0) P8_SCHED;     \
            Anxt[m_][n_] = *(const LAS bf16x8*)(lds + (sr) * STG + (hr) * HTB + aoff + m_ * 2048 + n_ * 1024); \
            if constexpr ((RDB) && g_ < 4) Bnxt[m_][n_] = *(const LAS bf16x8*)(lds + (sr) * STG + 2 * HTB + boff + m_ * 2048 + n_ * 1024); \
            if constexpr (g_ == 1) P8_PIECE((P0) + 0, qa, qb, q0, q1, sd); \
            if constexpr (g_ == 3) P8_PIECE((P0) + 1, qa, qb, q0, q1, sd); \
            if constexpr (g_ == 5) P8_PIECE((P0) + 2, qa, qb, q0, q1, sd); \
            P8_SCHED; }); } while (0)
    { const char* pa_ = cA; const char* pb_ = cB;
      P8_PIECE(0, pa_, pb_, gC0, gC1, 0); P8_PIECE(1, pa_, pb_, gC0, gC1, 0); P8_PIECE(2, pa_, pb_, gC0, gC1, 0); P8_PIECE(3, pa_, pb_, gC0, gC1, 0); P8_PIECE(4, pa_, pb_, gC0, gC1, 0); P8_PIECE(5, pa_, pb_, gC0, gC1, 0);
      pa_ += kstep; pb_ += kstep;
      P8_PIECE(0, pa_, pb_, gC0, gC1, 1); P8_PIECE(1, pa_, pb_, gC0, gC1, 1); P8_PIECE(2, pa_, pb_, gC0, gC1, 1); P8_PIECE(3, pa_, pb_, gC0, gC1, 1); P8_PIECE(4, pa_, pb_, gC0, gC1, 1); P8_PIECE(5, pa_, pb_, gC0, gC1, 1);
      pa_ += kstep; pb_ += kstep;
      P8_PIECE(0, pa_, pb_, gC0, gC1, 2); P8_PIECE(1, pa_, pb_, gC0, gC1, 2); P8_PIECE(2, pa_, pb_, gC0, gC1, 2); }
    P8_WAIT_V(9); P8_BAR;
#pragma unroll
    for (int m = 0; m < 4; ++m)
#pragma unroll
        for (int k = 0; k < 2; ++k) AX[m][k] = *(const LAS bf16x8*)(lds + aoff + m * 2048 + k * 1024);
#pragma unroll
    for (int n = 0; n < 2; ++n)
#pragma unroll
        for (int k = 0; k < 2; ++k) BX[n][k] = *(const LAS bf16x8*)(lds + 2 * HTB + boff + n * 2048 + k * 1024);
    int sa = 0;
    for (;;) {
        const bool has_next = S.next(ui + 1, nxt);
        const char* nA = GATHER ? (const char*)g.A : (has_next ? (const char*)g.A + (size_t)nxt.pm * tstep : cA); const char* nB = has_next ? (const char*)g.Bt + (size_t)nxt.pb * hstep : cB;
        if constexpr (GATHER) { if (has_next) {
#pragma unroll
            for (int i = 0; i < 2; ++i) { gN0[i] = (unsigned)S.a_row(nxt, Rv[i]) * (unsigned)(K * 2) + (unsigned)Cv[i] * 2u; gN1[i] = (unsigned)S.a_row(nxt, HALF + Rv[i]) * (unsigned)(K * 2) + (unsigned)Cv[i] * 2u; } } }
#pragma unroll 1
        for (int t = 0; t < nt; t += 2) {
            const int sb = sa == 2 ? 0 : sa + 1, sc = sb == 2 ? 0 : sb + 1;
            const bool x2 = t + 2 >= nt, x3 = t + 3 >= nt, x4 = t + 4 >= nt;
            const char* a2 = x2 ? nA + (size_t)(t + 2 - nt) * kstep : cA + (size_t)(t + 2) * kstep; const char* b2 = x2 ? nB + (size_t)(t + 2 - nt) * kstep : cB + (size_t)(t + 2) * kstep;
            const char* a3 = x3 ? nA + (size_t)(t + 3 - nt) * kstep : cA + (size_t)(t + 3) * kstep; const char* b3 = x3 ? nB + (size_t)(t + 3 - nt) * kstep : cB + (size_t)(t + 3) * kstep;
            const char* a4 = x4 ? nA + (size_t)(t + 4 - nt) * kstep : cA + (size_t)(t + 4) * kstep; const char* b4 = x4 ? nB + (size_t)(t + 4 - nt) * kstep : cB + (size_t)(t + 4) * kstep;
            unsigned q20[2], q21[2], q30[2], q31[2], q40[2], q41[2];
            if constexpr (GATHER) {
#pragma unroll
                for (int i = 0; i < 2; ++i) { q20[i] = x2 ? gN0[i] : gC0[i]; q21[i] = x2 ? gN1[i] : gC1[i]; q30[i] = x3 ? gN0[i] : gC0[i]; q31[i] = x3 ? gN1[i] : gC1[i]; q40[i] = x4 ? gN0[i] : gC0[i]; q41[i] = x4 ? gN1[i] : gC1[i]; } }
            P8_SP(0, AX, AY, BX, BY, false, sa, 1, 3, a2, b2, q20, q21, sc);
            P8_WAIT_V(6); asm volatile("s_waitcnt lgkmcnt(0)" ::: "memory"); P8_BAR;
            P8_SP(1, AY, AX, BX, BY, true, sb, 0, 0, a3, b3, q30, q31, sa);
            P8_SP(0, AX, AY, BY, BX, false, sb, 1, 3, a3, b3, q30, q31, sa);
            P8_WAIT_V(6); asm volatile("s_waitcnt lgkmcnt(0)" ::: "memory"); P8_BAR;
            P8_SP(1, AY, AX, BY, BX, true, sc, 0, 0, a4, b4, q40, q41, sb);
            sa = sc;
        }
        E(acc, cur, wr, wc, fr, fq);
        if (!has_next) break;
#pragma unroll
        for (int a = 0; a < 2; ++a)
#pragma unroll
            for (int m = 0; m < 4; ++m)
#pragma unroll
                for (int n = 0; n < 2; ++n) acc[a][m][n] = (f32x4){0.f, 0.f, 0.f, 0.f};
        cur = nxt; cA = nA; cB = nB; ++ui;
        if constexpr (GATHER) { gC0[0] = gN0[0]; gC0[1] = gN0[1]; gC1[0] = gN1[0]; gC1[1] = gN1[1]; }
    }
    P8_WAIT_V(0);
    P8_BAR;
#undef P8_CAT
#undef P8_GLDS
#undef P8_PIECE
#undef P8_WAIT_V
#undef P8_BAR
#undef P8_SCHED
#undef P8_SP
}

__device__ __forceinline__ u32x4 pack8(const f32x4& v0, const f32x4& v1) { u32x4 w; w.x = cvt_pk_bf16(v0[0], v0[1]); w.y = cvt_pk_bf16(v0[2], v0[3]); w.z = cvt_pk_bf16(v1[0], v1[1]); w.w = cvt_pk_bf16(v1[2], v1[3]); return w; }
__device__ __forceinline__ void rope4(f32x4& v0, f32x4& v1, const float* cs) {
    const f32x4 a = *(const f32x4*)cs, b = *(const f32x4*)(cs + 4);
    float x1, x2;
    x1 = v0[0]; x2 = v0[1]; v0[0] = x1 * a[0] - x2 * a[1]; v0[1] = x2 * a[0] + x1 * a[1];
    x1 = v0[2]; x2 = v0[3]; v0[2] = x1 * a[2] - x2 * a[3]; v0[3] = x2 * a[2] + x1 * a[3];
    x1 = v1[0]; x2 = v1[1]; v1[0] = x1 * b[0] - x2 * b[1]; v1[1] = x2 * b[0] + x1 * b[1];
    x1 = v1[2]; x2 = v1[3]; v1[2] = x1 * b[2] - x2 * b[3]; v1[3] = x2 * b[2] + x1 * b[3];
}

struct EpiIn {
    static constexpr bool PERM = true;
    bf16_t *qa, *ka, *va, *cq, *ckv, *gates, *kr; const float *ropeA, *ropeM, *bg; float* sq; unsigned char* k8r; unsigned char *q8a, *k8a; unsigned char* v8a; unsigned char* q8l;
    __device__ __forceinline__ void operator()(const f32x4 (&acc)[2][2][4][2], const Unit& u, int wr, int wc, int fr, int fq) const {
        const int pn = u.pn, row0 = u.pm * BM + wr * 64 + fr, cl = wc * 32 + 8 * fq;
        if (pn < 8) {
            bf16_t* dst = pn < 4 ? qa : ka; const int colt = (pn & 3) * 256; const bool rot = ((wc & 1) == 0) && (fq < 2);
#pragma unroll
            for (int ai = 0; ai < 2; ++ai)
#pragma unroll
                for (int m = 0; m < 4; ++m) { const int row = row0 + ai * HALF + m * 16;
#pragma unroll
                    for (int bj = 0; bj < 2; ++bj) { f32x4 v0 = acc[ai][bj][m][0], v1 = acc[ai][bj][m][1];
                        if (rot) rope4(v0, v1, ropeA + (size_t)row * 16 + fq * 8);
                        if (pn < 4) { v0 *= QS_DA; v1 *= QS_DA; }
                        if (DA_QK8 != 1) *(u32x4*)(dst + (size_t)row * 1024 + colt + bj * HALF + cl) = pack8(v0, v1);
                        if (DA_QK8) { const float s8 = (Q_X8 && pn < 4) ? 8.f : 1.f; u32x2 w8; w8.x = cvt_pk_fp8x4(v0[0] * s8, v0[1] * s8, v0[2] * s8, v0[3] * s8); w8.y = cvt_pk_fp8x4(v1[0] * s8, v1[1] * s8, v1[2] * s8, v1[3] * s8);
                            *(u32x2*)((pn < 4 ? q8a : k8a) + (size_t)row * 1024 + colt + bj * HALF + cl) = w8;
                            if (DA_QLO && pn < 4) {
                                const auto b0 = __builtin_amdgcn_cvt_pk_f32_fp8((int)w8.x, false), b1 = __builtin_amdgcn_cvt_pk_f32_fp8((int)w8.x, true), b2 = __builtin_amdgcn_cvt_pk_f32_fp8((int)w8.y, false), b3 = __builtin_amdgcn_cvt_pk_f32_fp8((int)w8.y, true);
                                u32x2 wl; wl.x = cvt_pk_fp8x4((v0[0] * 8.f - b0[0]) * 16.f, (v0[1] * 8.f - b0[1]) * 16.f, (v0[2] * 8.f - b1[0]) * 16.f, (v0[3] * 8.f - b1[1]) * 16.f);
                                wl.y = cvt_pk_fp8x4((v1[0] * 8.f - b2[0]) * 16.f, (v1[1] * 8.f - b2[1]) * 16.f, (v1[2] * 8.f - b3[0]) * 16.f, (v1[3] * 8.f - b3[1]) * 16.f);
                                *(u32x2*)(q8l + (size_t)row * 1024 + colt + bj * HALF + cl) = wl; } } } }
        } else if (pn < 12) {
            const int colt = (pn - 8) * 256;
            if (VT_FUSED && DA_PV8 == 2) {
                const unsigned lofs = (unsigned)(cl * SEQ + 4 * fr);
#pragma unroll
                for (int ai = 0; ai < 2; ++ai) { const int tok = u.pm * BM + wr * 64 + ai * HALF, b_ = tok >> 12, kt = tok & (SEQ - 1);
#pragma unroll
                    for (int bj = 0; bj < 2; ++bj) { unsigned char* vb_ = v8a + ((size_t)((b_ * 8 + (pn - 8) * 2 + bj) * 128) * SEQ + kt);
#pragma unroll
                        for (int x = 0; x < 2; ++x)
#pragma unroll
                            for (int j = 0; j < 4; ++j)
                                *(unsigned*)(vb_ + (4 * x + j) * SEQ + lofs) = cvt_pk_fp8x4(acc[ai][bj][0][x][j], acc[ai][bj][1][x][j], acc[ai][bj][2][x][j], acc[ai][bj][3][x][j]); } }
            } else
#pragma unroll
            for (int ai = 0; ai < 2; ++ai)
#pragma unroll
                for (int m = 0; m < 4; ++m) { const int row = row0 + ai * HALF + m * 16;
#pragma unroll
                    for (int bj = 0; bj < 2; ++bj) { const f32x4 v0 = acc[ai][bj][m][0], v1 = acc[ai][bj][m][1]; if (DA_PV8 != 2) *(u32x4*)(va + (size_t)row * 1024 + colt + bj * HALF + cl) = pack8(v0, v1);
                        if (DA_PV8) { u32x2 w8; w8.x = cvt_pk_fp8x4(v0[0], v0[1], v0[2], v0[3]); w8.y = cvt_pk_fp8x4(v1[0], v1[1], v1[2], v1[3]); *(u32x2*)(v8a + (size_t)row * 1024 + colt + bj * HALF + cl) = w8; } } }
        } else if (pn < 17) {
            const bool isq = pn < 15; bf16_t* dst = isq ? cq : ckv; const int ld = isq ? QL : KVL, colt = (isq ? pn - 12 : pn - 15) * 256, tq = pn - 12;
#pragma unroll
            for (int ai = 0; ai < 2; ++ai)
#pragma unroll
                for (int m = 0; m < 4; ++m) { const int row = row0 + ai * HALF + m * 16; float s = 0.f;
#pragma unroll
                    for (int bj = 0; bj < 2; ++bj) { const f32x4 v0 = acc[ai][bj][m][0], v1 = acc[ai][bj][m][1];
                        s += (v0[0] * v0[0] + v0[1] * v0[1]) + (v0[2] * v0[2] + v0[3] * v0[3]) + (v1[0] * v1[0] + v1[1] * v1[1]) + (v1[2] * v1[2] + v1[3] * v1[3]);
                        if (UP_F8) { u32x2 w8; w8.x = cvt_pk_fp8x4(v0[0], v0[1], v0[2], v0[3]); w8.y = cvt_pk_fp8x4(v1[0], v1[1], v1[2], v1[3]); *(u32x2*)((unsigned char*)dst + (size_t)row * ld + colt + bj * HALF + cl) = w8; }
                        else *(u32x4*)(dst + (size_t)row * ld + colt + bj * HALF + cl) = pack8(v0, v1); }
                    s += __shfl_xor(s, 16); s += __shfl_xor(s, 32);
                    if (fq == 0) sq[(size_t)row * 20 + tq * 4 + wc] = s; }
        } else if (pn != 23) {
            const int colt = (pn < 23 ? pn - 17 : pn - 18) * 256;
            f32x4 bv[2][2];
#pragma unroll
            for (int bj = 0; bj < 2; ++bj) { bv[bj][0] = *(const f32x4*)(bg + colt + bj * HALF + cl); bv[bj][1] = *(const f32x4*)(bg + colt + bj * HALF + cl + 4); if (DBG_SKIP & 256) { bv[bj][0] = bv[bj][0] * 0.f; bv[bj][1] = bv[bj][1] * 0.f; } }
#pragma unroll
            for (int ai = 0; ai < 2; ++ai)
#pragma unroll
                for (int m = 0; m < 4; ++m) { const int row = row0 + ai * HALF + m * 16;
#pragma unroll
                    for (int bj = 0; bj < 2; ++bj) { f32x4 v0 = acc[ai][bj][m][0] + bv[bj][0], v1 = acc[ai][bj][m][1] + bv[bj][1];
#pragma unroll
                        for (int j = 0; j < 4; ++j) { if (!(DBG_SKIP & 512)) { v0[j] = sigmoidf_(v0[j]); v1[j] = sigmoidf_(v1[j]); } }
                        *(u32x4*)(gates + (size_t)row * 2048 + colt + bj * HALF + cl) = pack8(v0, v1); } }
        } else {
            if (wc < 2) {
#pragma unroll
                for (int ai = 0; ai < 2; ++ai)
#pragma unroll
                    for (int m = 0; m < 4; ++m) { const int row = row0 + ai * HALF + m * 16;
                        f32x4 v0 = acc[ai][0][m][0], v1 = acc[ai][0][m][1];
                        rope4(v0, v1, ropeM + (size_t)row * 64 + (wc * 16 + fq * 4) * 2);
                        if (!MLA_QK8) *(u32x4*)(kr + (size_t)row * 64 + cl) = pack8(v0, v1);
                        if (MLA_QK8) { u32x2 w8; w8.x = cvt_pk_fp8x4(v0[0], v0[1], v0[2], v0[3]); w8.y = cvt_pk_fp8x4(v1[0], v1[1], v1[2], v1[3]); *(u32x2*)(k8r + (size_t)row * 64 + cl) = w8; } }
            }
        }
    }
};
template <bool ISQ> struct EpiUp {
    static constexpr bool PERM = true;
    bf16_t* out; const float* sq; const float* ropeM; unsigned char* out8;
    __device__ __forceinline__ void operator()(const f32x4 (&acc)[2][2][4][2], const Unit& u, int wr, int wc, int fr, int fq) const {
        const int row0 = u.pm * BM + wr * 64 + fr, cl = wc * 32 + 8 * fq; constexpr int LD = ISQ ? 1536 : 2048;
#pragma unroll
        for (int ai = 0; ai < 2; ++ai)
#pragma unroll
            for (int m = 0; m < 4; ++m) { const int row = row0 + ai * HALF + m * 16; float s;
                if (ISQ) { const f32x4 a = *(const f32x4*)(sq + (size_t)row * 20), b = *(const f32x4*)(sq + (size_t)row * 20 + 4), c = *(const f32x4*)(sq + (size_t)row * 20 + 8);
                    s = ((a[0] + a[1]) + (a[2] + a[3])) + ((b[0] + b[1]) + (b[2] + b[3])) + ((c[0] + c[1]) + (c[2] + c[3])); }
                else { const f32x4 a = *(const f32x4*)(sq + (size_t)row * 20 + 12), b = *(const f32x4*)(sq + (size_t)row * 20 + 16);
                    s = ((a[0] + a[1]) + (a[2] + a[3])) + ((b[0] + b[1]) + (b[2] + b[3])); }
                const float rstd = __builtin_amdgcn_rsqf(s * (ISQ ? 1.0f / QL : 1.0f / KVL) + EPS) * (ISQ ? QS_MLA : 1.0f);
#pragma unroll
                for (int bj = 0; bj < 2; ++bj) { const int col = u.pn * BM + bj * HALF + cl; f32x4 v0 = acc[ai][bj][m][0] * rstd, v1 = acc[ai][bj][m][1] * rstd;
                    if (ISQ) { const int off = col % 192; if (off >= 128) rope4(v0, v1, ropeM + (size_t)row * 64 + (off - 128)); }
                    if (!MLA_QK8 || (!ISQ && bj == 1)) *(u32x4*)(out + (size_t)row * LD + col) = pack8(v0, v1);
                    if (MLA_QK8) { u32x2 w8;
                        if (ISQ) { w8.x = cvt_pk_fp8x4(v0[0] * 8.f, v0[1] * 8.f, v0[2] * 8.f, v0[3] * 8.f); w8.y = cvt_pk_fp8x4(v1[0] * 8.f, v1[1] * 8.f, v1[2] * 8.f, v1[3] * 8.f); *(u32x2*)(out8 + (size_t)row * 1536 + col) = w8; }
                        else if (bj == 0) { w8.x = cvt_pk_fp8x4(v0[0], v0[1], v0[2], v0[3]); w8.y = cvt_pk_fp8x4(v1[0], v1[1], v1[2], v1[3]); *(u32x2*)(out8 + (size_t)row * 1024 + u.pn * 128 + cl) = w8; } } } }
    }
};
template <bool ISQ> struct EpiUp8 {
    bf16_t* out; const float* sq; const float* ropeM; unsigned char* out8; unsigned char* v8 = nullptr;
    __device__ __forceinline__ void operator()(const f32x4 (&acc)[2][4][2], const Unit& u, int wr, int wc, int fr, int fq) const {
        const int row0 = u.pm * BM + wr * 64 + fr, col = u.pn * HALF + wc * 32 + 8 * fq;
        if constexpr (!ISQ && MLA_PV8 && VT_FUSED) { if (u.pn & 1) {
#pragma unroll
            for (int ai = 0; ai < 2; ++ai) { float rs[4];
#pragma unroll
                for (int m = 0; m < 4; ++m) { const int row = row0 + ai * HALF + m * 16; const f32x4 a = *(const f32x4*)(sq + (size_t)row * 20 + 12), b = *(const f32x4*)(sq + (size_t)row * 20 + 16);
                    rs[m] = __builtin_amdgcn_rsqf((((a[0] + a[1]) + (a[2] + a[3])) + ((b[0] + b[1]) + (b[2] + b[3]))) * (1.0f / KVL) + EPS) * W8S; }
                const int tok = u.pm * BM + wr * 64 + ai * HALF, b_ = tok >> 12, kt = tok & (SEQ - 1);
                unsigned char* vb_ = v8 + ((size_t)((b_ * 8 + (u.pn >> 1)) * 128 + wc * 32) * SEQ + kt);
                const unsigned lofs = (unsigned)(8 * fq * SEQ + 4 * fr);
#pragma unroll
                for (int x = 0; x < 2; ++x)
#pragma unroll
                    for (int j = 0; j < 4; ++j)
                        *(unsigned*)(vb_ + (4 * x + j) * SEQ + lofs) = cvt_pk_fp8x4(acc[ai][0][x][j] * rs[0], acc[ai][1][x][j] * rs[1], acc[ai][2][x][j] * rs[2], acc[ai][3][x][j] * rs[3]); }
            return; } }
#pragma unroll
        for (int ai = 0; ai < 2; ++ai)
#pragma unroll
            for (int m = 0; m < 4; ++m) { const int row = row0 + ai * HALF + m * 16; float s;
                if (ISQ) { const f32x4 a = *(const f32x4*)(sq + (size_t)row * 20), b = *(const f32x4*)(sq + (size_t)row * 20 + 4), c = *(const f32x4*)(sq + (size_t)row * 20 + 8);
                    s = ((a[0] + a[1]) + (a[2] + a[3])) + ((b[0] + b[1]) + (b[2] + b[3])) + ((c[0] + c[1]) + (c[2] + c[3])); }
                else { const f32x4 a = *(const f32x4*)(sq + (size_t)row * 20 + 12), b = *(const f32x4*)(sq + (size_t)row * 20 + 16);
                    s = ((a[0] + a[1]) + (a[2] + a[3])) + ((b[0] + b[1]) + (b[2] + b[3])); }
                const float rstd = __builtin_amdgcn_rsqf(s * (ISQ ? 1.0f / QL : 1.0f / KVL) + EPS) * (ISQ ? QS_MLA * W8S : W8S);
                f32x4 v0 = acc[ai][m][0] * rstd, v1 = acc[ai][m][1] * rstd;
                if (ISQ) { const int off = col % 192; if (off >= 128) rope4(v0, v1, ropeM + (size_t)row * 64 + (off - 128));
                    constexpr float q8_ = Q_X8 ? 8.f : 1.f; u32x2 w8; w8.x = cvt_pk_fp8x4(v0[0] * q8_, v0[1] * q8_, v0[2] * q8_, v0[3] * q8_); w8.y = cvt_pk_fp8x4(v1[0] * q8_, v1[1] * q8_, v1[2] * q8_, v1[3] * q8_); *(u32x2*)(out8 + (size_t)row * 1536 + col) = w8; }
                else if ((u.pn & 1) == 0) { u32x2 w8; w8.x = cvt_pk_fp8x4(v0[0], v0[1], v0[2], v0[3]); w8.y = cvt_pk_fp8x4(v1[0], v1[1], v1[2], v1[3]); *(u32x2*)(out8 + (size_t)row * 1024 + (u.pn >> 1) * 128 + wc * 32 + 8 * fq) = w8; }
                else if (MLA_PV8) { u32x2 w8; w8.x = cvt_pk_fp8x4(v0[0], v0[1], v0[2], v0[3]); w8.y = cvt_pk_fp8x4(v1[0], v1[1], v1[2], v1[3]); *(u32x2*)(v8 + (size_t)row * 1024 + (u.pn >> 1) * 128 + wc * 32 + 8 * fq) = w8; }
                else *(u32x4*)(out + (size_t)row * 2048 + col) = pack8(v0, v1); }
    }
};
template <int WHICH> struct EpiGate {
    static constexpr bool PERM = true;
    bf16_t* mrg; const bf16_t* gates;
    __device__ __forceinline__ void operator()(const f32x4 (&acc)[2][2][4][2], const Unit& u, int wr, int wc, int fr, int fq) const {
        const int row0 = u.pm * BM + wr * 64 + fr, cl = wc * 32 + 8 * fq;
#pragma unroll
        for (int ai = 0; ai < 2; ++ai)
#pragma unroll
            for (int m = 0; m < 4; ++m) { const int row = row0 + ai * HALF + m * 16;
#pragma unroll
                for (int bj = 0; bj < 2; ++bj) { const int col = u.pn * BM + bj * HALF + cl;
                    const u32x4 gw = *(const u32x4*)(gates + (size_t)row * 2048 + WHICH * 1024 + col);
                    f32x4 v0 = acc[ai][bj][m][0], v1 = acc[ai][bj][m][1];
                    if ((DBG_SKIP & 8) && WHICH == 0) { v0 = v0 * 0.f; v1 = v1 * 0.f; } if ((DBG_SKIP & 16) && WHICH == 1) { v0 = v0 * 0.f; v1 = v1 * 0.f; }
                    v0[0] *= bf_lo(gw.x); v0[1] *= bf_hi(gw.x); v0[2] *= bf_lo(gw.y); v0[3] *= bf_hi(gw.y); v1[0] *= bf_lo(gw.z); v1[1] *= bf_hi(gw.z); v1[2] *= bf_lo(gw.w); v1[3] *= bf_hi(gw.w);
                    if (WHICH == 1) { const u32x4 tw = *(const u32x4*)(mrg + (size_t)row * 1024 + col);
                        v0[0] += bf_lo(tw.x); v0[1] += bf_hi(tw.x); v0[2] += bf_lo(tw.y); v0[3] += bf_hi(tw.y); v1[0] += bf_lo(tw.z); v1[1] += bf_hi(tw.z); v1[2] += bf_lo(tw.w); v1[3] += bf_hi(tw.w); }
                    *(u32x4*)(mrg + (size_t)row * 1024 + col) = pack8(v0, v1); } }
    }
};
struct EpiRes {
    static constexpr bool PERM = false;
    const float* x; bf16_t* out;
    __device__ __forceinline__ void operator()(const f32x4 (&acc)[2][2][4][2], const Unit& u, int wr, int wc, int fr, int fq) const {
        const int row0 = u.pm * BM + wr * 64 + fr, col0 = u.pn * BM + wc * 32 + 4 * fq;
#pragma unroll
        for (int ai = 0; ai < 2; ++ai)
#pragma unroll
            for (int m = 0; m < 4; ++m) { const size_t off = (size_t)(row0 + ai * HALF + m * 16) * 1024 + col0;
#pragma unroll
                for (int bj = 0; bj < 2; ++bj)
#pragma unroll
                    for (int n = 0; n < 2; ++n) { const f32x4 v = *(const f32x4*)(x + off + bj * HALF + n * 16) + ((DBG_SKIP & 2) ? 0.f : 1.f) * acc[ai][bj][m][n];
                        u32x2 w; w.x = cvt_pk_bf16(v[0], v[1]); w.y = cvt_pk_bf16(v[2], v[3]); *(u32x2*)(out + off + bj * HALF + n * 16) = w; } }
    }
};
struct EpiSwiglu {
    static constexpr bool PERM = true;
    bf16_t* act; const float *bgate, *bup;
    __device__ __forceinline__ void operator()(const f32x4 (&acc)[2][2][4][2], const Unit& u, int wr, int wc, int fr, int fq) const {
        const int row0 = u.pm * BM + wr * 64 + fr, f0 = u.pn * HALF + wc * 32 + 8 * fq;
        f32x4 bgv[2], buv[2];
#pragma unroll
        for (int n = 0; n < 2; ++n) { bgv[n] = *(const f32x4*)(bgate + (size_t)u.e * FF + f0 + 4 * n); buv[n] = *(const f32x4*)(bup + (size_t)u.e * FF + f0 + 4 * n); }
#pragma unroll
        for (int ai = 0; ai < 2; ++ai)
#pragma unroll
            for (int m = 0; m < 4; ++m) { const int row = row0 + ai * HALF + m * 16; f32x4 o[2];
#pragma unroll
                for (int n = 0; n < 2; ++n) { const f32x4 gt = acc[ai][0][m][n] + bgv[n], up = acc[ai][1][m][n] + buv[n];
#pragma unroll
                    for (int j = 0; j < 4; ++j) { const float gg = fminf(gt[j], 7.0f), uu = fminf(fmaxf(up[j], -7.0f), 7.0f); o[n][j] = (uu + 1.0f) * (gg * sigmoidf_(1.702f * gg)); } }
                u32x2 w8; w8.x = cvt_pk_fp8x4(o[0][0], o[0][1], o[0][2], o[0][3]); w8.y = cvt_pk_fp8x4(o[1][0], o[1][1], o[1][2], o[1][3]);
                *(u32x2*)((unsigned char*)act + (size_t)row * FF + f0) = w8; }
    }
};
struct EpiDown {
    static constexpr bool PERM = true;
    bf16_t* y; const float* bd;
    __device__ __forceinline__ void operator()(const f32x4 (&acc)[2][2][4][2], const Unit& u, int wr, int wc, int fr, int fq) const {
        const int row0 = u.pm * BM + wr * 64 + fr, cl = wc * 32 + 8 * fq;
        f32x4 bv[2][2];
#pragma unroll
        for (int bj = 0; bj < 2; ++bj) { const int col = u.pn * BM + bj * HALF + cl; bv[bj][0] = *(const f32x4*)(bd + (size_t)u.e * D + col); bv[bj][1] = *(const f32x4*)(bd + (size_t)u.e * D + col + 4); }
#pragma unroll
        for (int ai = 0; ai < 2; ++ai)
#pragma unroll
            for (int m = 0; m < 4; ++m) { const int row = row0 + ai * HALF + m * 16;
#pragma unroll
                for (int bj = 0; bj < 2; ++bj) { const int col = u.pn * BM + bj * HALF + cl;
                    *(u32x4*)(y + (size_t)row * D + col) = pack8(acc[ai][bj][m][0] + bv[bj][0], acc[ai][bj][m][1] + bv[bj][1]); } }
    }
};
struct EpiSwiglu8 {
    unsigned char* act; const float *bgate, *bup;
    __device__ __forceinline__ void operator()(const f32x4 (&acc)[2][4][2], const Unit& u, int wr, int wc, int fr, int fq) const {
        const int row0 = u.pm * BM + wr * 64 + fr, f0 = u.pn * 64 + wc * 16 + 4 * fq;
        const f32x4 bgv = *(const f32x4*)(bgate + (size_t)u.e * FF + f0), buv = *(const f32x4*)(bup + (size_t)u.e * FF + f0);
#pragma unroll
        for (int ai = 0; ai < 2; ++ai)
#pragma unroll
            for (int m = 0; m < 4; ++m) { const int row = row0 + ai * HALF + m * 16; const f32x4 gt = acc[ai][m][0] * W8S + bgv, up = acc[ai][m][1] * W8S + buv; float o[4];
#pragma unroll
                for (int j = 0; j < 4; ++j) { const float gg = fminf(gt[j], 7.0f), uu = fminf(fmaxf(up[j], -7.0f), 7.0f); o[j] = (uu + 1.0f) * (gg * sigmoidf_(1.702f * gg)); }
                *(unsigned*)(act + (size_t)row * FF + f0) = cvt_pk_fp8x4(o[0], o[1], o[2], o[3]); }
    }
};
struct EpiDown8 {
    unsigned char* y; const float* bd;
    __device__ __forceinline__ void operator()(const f32x4 (&acc)[2][4][2], const Unit& u, int wr, int wc, int fr, int fq) const {
        const int row0 = u.pm * BM + wr * 64 + fr, col = u.pn * HALF + wc * 32 + 8 * fq;
        const f32x4 bv0 = *(const f32x4*)(bd + (size_t)u.e * D + col), bv1 = *(const f32x4*)(bd + (size_t)u.e * D + col + 4);
#pragma unroll
        for (int ai = 0; ai < 2; ++ai)
#pragma unroll
            for (int m = 0; m < 4; ++m) { const int row = row0 + ai * HALF + m * 16; const f32x4 v0 = (acc[ai][m][0] * W8S + bv0) * YS, v1 = (acc[ai][m][1] * W8S + bv1) * YS;
                u32x2 w; w.x = cvt_pk_fp8x4(v0[0], v0[1], v0[2], v0[3]); w.y = cvt_pk_fp8x4(v1[0], v1[1], v1[2], v1[3]);
                *(u32x2*)(y + (size_t)row * D + col) = w; }
    }
};
}

namespace att {
constexpr int NW = 8, QBLK = 32, KVBLK = 64;
constexpr int QSCALE8 = Q_X8 ? 0x7c7c7c7c : 0x7f7f7f7f;
static_assert(Q_X8 || !DA_QLO, "the q-residual path assumes the x8 q copies");
constexpr int SHM_V = KVBLK * 128 * 2;
#define SBAR() __builtin_amdgcn_sched_barrier(0)
#define KSW(row, colB) ((row) * 128 + ((colB) ^ ((((row) >> 1) & 7) << 4)))
__device__ __forceinline__ int crow(int r, int hi) { return (r & 3) + 8 * (r >> 2) + 4 * hi; }
__device__ __forceinline__ int kperm(int j) { if (!VT_FUSED) return j; const int jl = j & 31, p = 32 * ((jl >> 2) & 1) + 16 * (j >> 5) + (jl & 3) + 4 * (jl >> 3); return 16 * (p & 3) + (p >> 2); }
struct Src { const bf16_t* Q; const bf16_t* K; const bf16_t* K2; const bf16_t* V; int ldq, ldk, ldk2, ldv; };

__device__ __forceinline__ void partialSM(f32x16& p0, f32x16& p1, float& m_reg, float& mn, float& alpha, const float C, const float thr) {
  float pmax;
  { float a0 = fmaxf(fmaxf(p0[0], p0[1]), p0[2]), a1 = fmaxf(fmaxf(p0[3], p0[4]), p0[5]), a2 = fmaxf(fmaxf(p1[0], p1[1]), p1[2]), a3 = fmaxf(fmaxf(p1[3], p1[4]), p1[5]);
#pragma unroll
    for (int r = 6; r < 16; r += 2) { a0 = fmaxf(fmaxf(a0, p0[r]), p0[r + 1]); a2 = fmaxf(fmaxf(a2, p1[r]), p1[r + 1]); }
    pmax = fmaxf(fmaxf(a0, a1), fmaxf(a2, a3)); }
  { auto rr = __builtin_amdgcn_permlane32_swap(__float_as_uint(pmax), __float_as_uint(pmax), false, false);
    pmax = fmaxf(__uint_as_float(rr[0]), __uint_as_float(rr[1])); }
  if (__builtin_expect(__all(pmax - m_reg <= thr), 1)) { mn = m_reg; alpha = 1.f; }
  else { mn = fmaxf(m_reg, pmax); alpha = __builtin_amdgcn_exp2f((m_reg - mn) * C); m_reg = mn; }
  const float mnC = -mn * C;
#pragma unroll
  for (int r = 0; r < 16; ++r) p0[r] = fmaf(p0[r], C, mnC);
#pragma unroll
  for (int r = 0; r < 16; ++r) p1[r] = fmaf(p1[r], C, mnC);
#pragma unroll
  for (int r = 0; r < 16; ++r) p0[r] = __builtin_amdgcn_exp2f(p0[r]);
#if ATT_DUP == 1
  { float d_[16];
#pragma unroll
    for (int r = 0; r < 16; ++r) { d_[r] = __builtin_amdgcn_exp2f(p1[r]); d_[r] = fmaf(d_[r], C, mnC); }
#pragma unroll
    for (int r = 0; r < 16; ++r) asm volatile("" :: "v"(d_[r])); }
#endif
}
__device__ __forceinline__ void finishSM(f32x16& p0, f32x16& p1, float alpha, float& l_reg, bf16x8& pa0, bf16x8& pa1, bf16x8& pa2, bf16x8& pa3) {
#pragma unroll
  for (int r = 0; r < 16; ++r) p1[r] = __builtin_amdgcn_exp2f(p1[r]);
  float ps;
  { float s0 = p0[0] + p0[1], s1 = p0[2] + p0[3], s2 = p1[0] + p1[1], s3 = p1[2] + p1[3];
#pragma unroll
    for (int r = 4; r < 16; r += 4) { s0 += p0[r] + p0[r + 1]; s1 += p0[r + 2] + p0[r + 3]; s2 += p1[r] + p1[r + 1]; s3 += p1[r + 2] + p1[r + 3]; }
    ps = (s0 + s1) + (s2 + s3); }
  { auto rr = __builtin_amdgcn_permlane32_swap(__float_as_uint(ps), __float_as_uint(ps), false, false);
    ps = __uint_as_float(rr[0]) + __uint_as_float(rr[1]); }
  l_reg = l_reg * alpha + ps;
#define PK4(P, BASE, OUT) do { unsigned a0 = cvt_pk_bf16(P[BASE + 0], P[BASE + 1]), a1 = cvt_pk_bf16(P[BASE + 2], P[BASE + 3]);   \
    unsigned b0 = cvt_pk_bf16(P[BASE + 4], P[BASE + 5]), b1 = cvt_pk_bf16(P[BASE + 6], P[BASE + 7]);                              \
    auto r0 = __builtin_amdgcn_permlane32_swap(a0, b0, false, false); auto r1 = __builtin_amdgcn_permlane32_swap(a1, b1, false, false); \
    u32x4 w = {r0[0], r1[0], r0[1], r1[1]}; OUT = *reinterpret_cast<bf16x8*>(&w); } while (0)
  PK4(p0, 0, pa0); PK4(p0, 8, pa1); PK4(p1, 0, pa2); PK4(p1, 8, pa3);
#undef PK4
}
template <int DQK> __device__ __forceinline__ void qkt(f32x16& p0, f32x16& p1, const LAS char* Ks, const bf16x8* qr, int r32, int hi) {
  p0 = f32x16{}; p1 = f32x16{};
#pragma unroll
  for (int d0 = 0; d0 < DQK / 16; d0 += 2) {
    bf16x8 kf[2][2];
#pragma unroll
    for (int d = 0; d < 2; ++d) { const int sub = (d0 + d) >> 2, cb = (((d0 + d) & 3) * 16 + hi * 8) * 2;
      kf[d][0] = *(const LAS bf16x8*)(Ks + sub * 8192 + KSW(r32, cb)); kf[d][1] = *(const LAS bf16x8*)(Ks + sub * 8192 + KSW(32 + r32, cb)); }
    SBAR();
#pragma unroll
    for (int d = 0; d < 2; ++d) {
      p0 = __builtin_amdgcn_mfma_f32_32x32x16_bf16(kf[d][0], qr[d0 + d], p0, 0, 0, 0);
      p1 = __builtin_amdgcn_mfma_f32_32x32x16_bf16(kf[d][1], qr[d0 + d], p1, 0, 0, 0); }
  }
}
__device__ __forceinline__ int v_st(int k, int c) { const int kk = (k & ~0xC) | ((k & 4) << 1) | ((k & 8) >> 1); return ((kk >> 3) * 4 + (c >> 5)) * 512 + ((kk & 7) * 32 + (c & 31)) * 2; }
__device__ __forceinline__ int v_rd_base(int lane) { return ((lane & 3) << 3) | (((lane >> 2) & 3) << 6) | (((lane >> 4) & 1) << 5) | (((lane >> 5) & 1) << 8); }
constexpr int v_rd_off(int d0, int ks, int half) { return d0 * 512 + ks * 4096 + half * 2048; }
template <int OFF> __device__ __forceinline__ s16x4 tr_read(int vb) {
  s16x4 r; asm volatile("ds_read_b64_tr_b16 %0, %1 offset:%2" : "=&v"(r) : "v"(vb), "i"(OFF) : "memory"); return r;
}
template <int KS> __device__ __forceinline__ void pv_step(f32x16* o, int vb, bf16x8 pa) {
  s16x4 l0, h0, l1, h1, l2, h2, l3, h3;
  l0 = tr_read<v_rd_off(0, KS, 0)>(vb); h0 = tr_read<v_rd_off(0, KS, 1)>(vb); l1 = tr_read<v_rd_off(1, KS, 0)>(vb); h1 = tr_read<v_rd_off(1, KS, 1)>(vb);
  l2 = tr_read<v_rd_off(2, KS, 0)>(vb); h2 = tr_read<v_rd_off(2, KS, 1)>(vb); l3 = tr_read<v_rd_off(3, KS, 0)>(vb); h3 = tr_read<v_rd_off(3, KS, 1)>(vb);
  asm volatile("s_waitcnt lgkmcnt(0)" ::: "memory"); SBAR();
#define PK(L, H) (bf16x8){L[0], L[1], L[2], L[3], H[0], H[1], H[2], H[3]}
  o[0] = __builtin_amdgcn_mfma_f32_32x32x16_bf16(pa, PK(l0, h0), o[0], 0, 0, 0);
  o[1] = __builtin_amdgcn_mfma_f32_32x32x16_bf16(pa, PK(l1, h1), o[1], 0, 0, 0);
  o[2] = __builtin_amdgcn_mfma_f32_32x32x16_bf16(pa, PK(l2, h2), o[2], 0, 0, 0);
  o[3] = __builtin_amdgcn_mfma_f32_32x32x16_bf16(pa, PK(l3, h3), o[3], 0, 0, 0);
#undef PK
}
__device__ __forceinline__ void pv_d0(f32x16* o, int vb, bf16x8 pa0, bf16x8 pa1, bf16x8 pa2, bf16x8 pa3) {
  pv_step<0>(o, vb, pa0); pv_step<1>(o, vb, pa1); pv_step<2>(o, vb, pa2); pv_step<3>(o, vb, pa3);
}
template <int DQK>
__device__ __forceinline__ void attn_core(const Src in, const float C, const float thr, const int seq, LAS char* lds, f32x16 (&o)[4]) {
  constexpr int NSUB = DQK / 64, SHM_K = NSUB * 8192;
  int lane; asm volatile("v_and_b32 %0, 63, %1" : "=v"(lane) : "v"(threadIdx.x));
  const int tid = threadIdx.x, wid = __builtin_amdgcn_readfirstlane(tid >> 6), r32 = lane & 31, hi = (lane >> 5) & 1;
  LAS char* V_lds = lds; LAS char* K_lds = lds + 3 * SHM_V;
  LAS float* ws = (LAS float*)(lds + 3 * SHM_V + 3 * SHM_K) + wid * 64; LAS float* li_l = ws; LAS float* al_l = ws + 32;
  float m_reg = -1e30f, l_reg = 0;
#pragma unroll
  for (int d = 0; d < 4; ++d) o[d] = f32x16{};
  bf16x8 qr[DQK / 16];
  const bf16_t* Qw = in.Q + (size_t)(wid * QBLK + r32) * in.ldq + hi * 8;
#pragma unroll
  for (int d0 = 0; d0 < DQK / 16; ++d0) qr[d0] = *(const bf16x8*)(Qw + d0 * 16);
  const int krow = wid * 8 + (lane >> 3), kslot = (lane & 7) ^ ((krow >> 1) & 7);
  const unsigned koff = (unsigned)(krow * in.ldk + kslot * 8) * 2u, k2off = (unsigned)(krow * in.ldk2 + kslot * 8) * 2u;
  unsigned voff[2];
#pragma unroll
  for (int i = 0; i < 2; ++i) { const int p = i * 8192 + wid * 1024 + lane * 16, st = p >> 9, wq = (p & 511) >> 1, kk = (st >> 2) * 8 + (wq >> 5), cl = wq & 31;
    const int k = (kk & ~0xC) | ((kk & 4) << 1) | ((kk & 8) >> 1); voff[i] = (unsigned)(k * in.ldv + (st & 3) * 32 + cl) * 2u; }
  const int vb0 = (int)(unsigned)(size_t)V_lds + v_rd_base(lane);
  const unsigned ldsw = (unsigned)wid * 1024u;
#define GLDS(gp, lp) __builtin_amdgcn_global_load_lds((const unsigned*)(gp), (LAS unsigned*)(lp), 16, 0, 0)
#define ISSUE_K(t, b) do { const char* kb_ = (const char*)in.K + (size_t)(t) * (KVBLK * 2) * in.ldk; \
    _Pragma("unroll") for (int s_ = 0; s_ < NSUB; ++s_) { if (s_ < 2) GLDS(kb_ + s_ * 128 + koff, K_lds + (b) * SHM_K + s_ * 8192 + ldsw); \
      else GLDS((const char*)in.K2 + (size_t)(t) * (KVBLK * 2) * in.ldk2 + k2off, K_lds + (b) * SHM_K + s_ * 8192 + ldsw); } } while (0)
#define ISSUE_V(t, b) do { const char* vb_ = (const char*)in.V + (size_t)(t) * (KVBLK * 2) * in.ldv; \
    GLDS(vb_ + voff[0], V_lds + (b) * SHM_V + ldsw); GLDS(vb_ + voff[1], V_lds + (b) * SHM_V + 8192 + ldsw); \
    if (ATT_DUP == 3) { GLDS(vb_ + voff[0], V_lds + (b) * SHM_V + ldsw); GLDS(vb_ + voff[1], V_lds + (b) * SHM_V + 8192 + ldsw); } } while (0)
#define WAITV(n) asm volatile("s_waitcnt vmcnt(%0)" :: "n"((DBG_SKIP & 4) ? 0 : (n)) : "memory")
#define WBAR() do { asm volatile("" ::: "memory"); __builtin_amdgcn_s_barrier(); asm volatile("" ::: "memory"); } while (0)
#define RESC(a) do { if (__any((a) < 1.f)) { if (hi == 0) al_l[r32] = (a); asm volatile("s_waitcnt lgkmcnt(0)" ::: "memory"); \
    _Pragma("unroll") for (int d = 0; d < 4; ++d) _Pragma("unroll") for (int r = 0; r < 16; ++r) o[d][r] *= al_l[crow(r, hi)]; } } while (0)
#define NXT3(x) ((x) == 2 ? 0 : (x) + 1)
  constexpr int NI = NSUB + (ATT_DUP == 3 ? 4 : 2), NV = (ATT_DUP == 3 ? 4 : 2);
  f32x16 pA0, pA1, pB0, pB1; float mnA, mnB, alA, alB; bf16x8 pa0, pa1, pa2, pa3; const int NT = seq / KVBLK;
  const bool lead = wid < 4;
  ISSUE_K(0, 0); ISSUE_K(1, 1); ISSUE_V(0, 0);
  if (!lead) { WAITV(NI); WBAR(); }
  WAITV(NI); WBAR();
  ISSUE_K(2, 2);
  qkt<DQK>(pA0, pA1, K_lds, qr, r32, hi);
  WAITV(NI); WBAR();
  ISSUE_V(1, 1);
  partialSM(pA0, pA1, m_reg, mnA, alA, C, thr);
  WAITV(NI); WBAR();
  int bq = 1;
  for (int j = 1; j + 3 < NT; j += 2) {
    { const int b1 = NXT3(bq), b2 = NXT3(b1);
      ISSUE_K(j + 2, b2);
      SBAR(); qkt<DQK>(pB0, pB1, K_lds + bq * SHM_K, qr, r32, hi);
      finishSM(pA0, pA1, alA, l_reg, pa0, pa1, pa2, pa3); SBAR();
      WAITV(NI); WBAR();
      ISSUE_V(j + 1, b1);
      pv_d0(o, vb0 + b2 * SHM_V, pa0, pa1, pa2, pa3); partialSM(pB0, pB1, m_reg, mnB, alB, C, thr);
      RESC(alB); bq = b1;
      WAITV(NI); WBAR(); }
    { const int b1 = NXT3(bq), b2 = NXT3(b1);
      ISSUE_K(j + 3, b2);
      SBAR(); qkt<DQK>(pA0, pA1, K_lds + bq * SHM_K, qr, r32, hi);
      finishSM(pB0, pB1, alB, l_reg, pa0, pa1, pa2, pa3); SBAR();
      WAITV(NI); WBAR();
      ISSUE_V(j + 2, b1);
      pv_d0(o, vb0 + b2 * SHM_V, pa0, pa1, pa2, pa3); partialSM(pA0, pA1, m_reg, mnA, alA, C, thr);
      RESC(alA); bq = b1;
      WAITV(NI); WBAR(); }
  }
  { const int b1 = NXT3(bq), b2 = NXT3(b1);
    ISSUE_K(NT - 1, b2);
    SBAR(); qkt<DQK>(pB0, pB1, K_lds + bq * SHM_K, qr, r32, hi);
    finishSM(pA0, pA1, alA, l_reg, pa0, pa1, pa2, pa3); SBAR();
    WAITV(NI); WBAR();
    ISSUE_V(NT - 2, b1);
    pv_d0(o, vb0 + b2 * SHM_V, pa0, pa1, pa2, pa3); partialSM(pB0, pB1, m_reg, mnB, alB, C, thr);
    RESC(alB); bq = b1;
    WAITV(NI); WBAR(); }
  { const int b1 = NXT3(bq), b2 = NXT3(b1);
    SBAR(); qkt<DQK>(pA0, pA1, K_lds + bq * SHM_K, qr, r32, hi);
    finishSM(pB0, pB1, alB, l_reg, pa0, pa1, pa2, pa3); SBAR();
    WAITV(NV); WBAR();
    ISSUE_V(NT - 1, b1);
    pv_d0(o, vb0 + b2 * SHM_V, pa0, pa1, pa2, pa3); partialSM(pA0, pA1, m_reg, mnA, alA, C, thr);
    RESC(alA); bq = b1;
    WAITV(NV); WBAR(); }
  { const int b2 = NXT3(NXT3(bq));
    SBAR(); qkt<DQK>(pB0, pB1, K_lds + bq * SHM_K, qr, r32, hi);
    finishSM(pA0, pA1, alA, l_reg, pa0, pa1, pa2, pa3); SBAR();
    WAITV(0); WBAR();
    pv_d0(o, vb0 + b2 * SHM_V, pa0, pa1, pa2, pa3); partialSM(pB0, pB1, m_reg, mnB, alB, C, thr);
    RESC(alB);
    WBAR(); }
  finishSM(pB0, pB1, alB, l_reg, pa0, pa1, pa2, pa3); SBAR();
  pv_d0(o, vb0 + bq * SHM_V, pa0, pa1, pa2, pa3);
  if (lead) { WBAR(); }
  if (hi == 0) li_l[r32] = l_reg; asm volatile("s_waitcnt lgkmcnt(0)" ::: "memory");
#pragma unroll
  for (int r = 0; r < 16; ++r) { const float rl = __builtin_amdgcn_rcpf(li_l[crow(r, hi)]);
#pragma unroll
    for (int d = 0; d < 4; ++d) o[d][r] *= rl; }
  asm volatile("s_waitcnt lgkmcnt(0)" ::: "memory"); WBAR();
#undef GLDS
#undef ISSUE_K
#undef ISSUE_V
#undef WAITV
#undef WBAR
#undef RESC
#undef NXT3
}
template <int DQK>
__device__ __forceinline__ void attn_core_seq(const Src in, const float C, const float thr, const int seq, LAS char* lds, f32x16 (&o)[4], float* probe = nullptr) {
  constexpr int NSUB = DQK / 64, SHM_K = NSUB * 8192;
  int lane; asm volatile("v_and_b32 %0, 63, %1" : "=v"(lane) : "v"(threadIdx.x));
  const int tid = threadIdx.x, wid = __builtin_amdgcn_readfirstlane(tid >> 6), r32 = lane & 31, hi = (lane >> 5) & 1;
  LAS char* V_lds = lds; LAS char* K_lds = lds + 3 * SHM_V;
  LAS float* ws = (LAS float*)(lds + 3 * SHM_V + 3 * SHM_K) + wid * 64; LAS float* li_l = ws; LAS float* al_l = ws + 32;
  float m_reg = -1e30f, l_reg = 0;
#pragma unroll
  for (int d = 0; d < 4; ++d) o[d] = f32x16{};
  bf16x8 qr[DQK / 16];
  const bf16_t* Qw = in.Q + (size_t)(wid * QBLK + r32) * in.ldq + hi * 8;
#pragma unroll
  for (int d0 = 0; d0 < DQK / 16; ++d0) qr[d0] = *(const bf16x8*)(Qw + d0 * 16);
  const int krow = wid * 8 + (lane >> 3), kslot = (lane & 7) ^ ((krow >> 1) & 7);
  const unsigned koff = (unsigned)(krow * in.ldk + kslot * 8) * 2u, k2off = (unsigned)(krow * in.ldk2 + kslot * 8) * 2u;
  unsigned voff[2];
#pragma unroll
  for (int i = 0; i < 2; ++i) { const int p = i * 8192 + wid * 1024 + lane * 16, st = p >> 9, wq = (p & 511) >> 1, kk = (st >> 2) * 8 + (wq >> 5), cl = wq & 31;
    const int k = (kk & ~0xC) | ((kk & 4) << 1) | ((kk & 8) >> 1); voff[i] = (unsigned)(k * in.ldv + (st & 3) * 32 + cl) * 2u; }
  const int vb0 = (int)(unsigned)(size_t)V_lds + v_rd_base(lane);
  const unsigned ldsw = (unsigned)wid * 1024u;
#define GLDS(gp, lp) __builtin_amdgcn_global_load_lds((const unsigned*)(gp), (LAS unsigned*)(lp), 16, 0, 0)
#define ISSUE_K(t, b) do { const char* kb_ = (const char*)in.K + (size_t)(t) * (KVBLK * 2) * in.ldk; \
    _Pragma("unroll") for (int s_ = 0; s_ < NSUB; ++s_) { if (s_ < 2) GLDS(kb_ + s_ * 128 + koff, K_lds + (b) * SHM_K + s_ * 8192 + ldsw); \
      else GLDS((const char*)in.K2 + (size_t)(t) * (KVBLK * 2) * in.ldk2 + k2off, K_lds + (b) * SHM_K + s_ * 8192 + ldsw); } } while (0)
#define ISSUE_V(t, b) do { const char* vb_ = (const char*)in.V + (size_t)(t) * (KVBLK * 2) * in.ldv; \
    GLDS(vb_ + voff[0], V_lds + (b) * SHM_V + ldsw); GLDS(vb_ + voff[1], V_lds + (b) * SHM_V + 8192 + ldsw); } while (0)
#define WAITV(n) asm volatile("s_waitcnt vmcnt(%0)" :: "n"(n) : "memory")
#define WBAR() do { asm volatile("" ::: "memory"); __builtin_amdgcn_s_barrier(); asm volatile("" ::: "memory"); } while (0)
#define RESC(a) do { if (__any((a) < 1.f)) { if (hi == 0) al_l[r32] = (a); asm volatile("s_waitcnt lgkmcnt(0)" ::: "memory"); \
    _Pragma("unroll") for (int d = 0; d < 4; ++d) _Pragma("unroll") for (int r = 0; r < 16; ++r) o[d][r] *= al_l[crow(r, hi)]; } } while (0)
#define NXT3(x) ((x) == 2 ? 0 : (x) + 1)
#define SEG_B(b) do { float mn, al; bf16x8 pa0, pa1, pa2, pa3; partialSM(p0, p1, m_reg, mn, al, C, thr); RESC(al); finishSM(p0, p1, al, l_reg, pa0, pa1, pa2, pa3); SBAR(); \
    pv_d0(o, vb0 + (b) * SHM_V, pa0, pa1, pa2, pa3); } while (0)
  constexpr int NI = NSUB + 2;
  f32x16 p0, p1; const int NT = seq / KVBLK; const bool lead = wid < 4;
  ISSUE_K(0, 0); ISSUE_V(0, 0); ISSUE_K(1, 1); ISSUE_V(1, 1);
  if (!lead) { WAITV(NI); WBAR(); }
  WAITV(NI); WBAR();
  int bq = 0;
#if PROBE_T == 4
  const unsigned long long t0 = __builtin_amdgcn_s_memtime();
#endif
  for (int j = 0; j + 2 < NT; ++j) {
    const int b1 = NXT3(bq), b2 = NXT3(b1);
    ISSUE_K(j + 2, b2);
    qkt<DQK>(p0, p1, K_lds + bq * SHM_K, qr, r32, hi);
    WAITV(NI); WBAR();
    ISSUE_V(j + 2, b2);
    SEG_B(bq);
    WAITV(NI); WBAR();
    bq = b1;
  }
#if PROBE_T == 4
  { const unsigned long long t1 = __builtin_amdgcn_s_memtime(); if (probe != nullptr && tid == 0) { probe[0] = 0.f; probe[1] = ((float)(t1 - t0) * (1.f / (NT - 2)) - 3000.f) * 0.02f; } }
#endif
#pragma unroll
  for (int jj = 0; jj < 2; ++jj) {
    qkt<DQK>(p0, p1, K_lds + bq * SHM_K, qr, r32, hi);
    WAITV(0); WBAR();
    SEG_B(bq);
    WBAR();
    bq = NXT3(bq);
  }
  if (lead) { WBAR(); }
  if (hi == 0) li_l[r32] = l_reg; asm volatile("s_waitcnt lgkmcnt(0)" ::: "memory");
#pragma unroll
  for (int r = 0; r < 16; ++r) { const float rl = __builtin_amdgcn_rcpf(li_l[crow(r, hi)]);
#pragma unroll
    for (int d = 0; d < 4; ++d) o[d][r] *= rl; }
  asm volatile("s_waitcnt lgkmcnt(0)" ::: "memory"); WBAR();
#undef GLDS
#undef ISSUE_K
#undef ISSUE_V
#undef WAITV
#undef WBAR
#undef RESC
#undef NXT3
#undef SEG_B
}
__device__ __forceinline__ void attn_core_da2(const Src in, const float C, const float thr, const int seq, LAS char* lds, f32x16 (&o1)[4], f32x16 (&o2)[4]) {
  constexpr int NSUB = 2, SHM_K = NSUB * 8192;
  int lane; asm volatile("v_and_b32 %0, 63, %1" : "=v"(lane) : "v"(threadIdx.x));
  const int tid = threadIdx.x, wid = __builtin_amdgcn_readfirstlane(tid >> 6), r32 = lane & 31, hi = (lane >> 5) & 1;
  LAS char* V_lds = lds; LAS char* K_lds = lds + 3 * SHM_V;
  LAS float* ws = (LAS float*)(lds + 3 * SHM_V + 3 * SHM_K) + wid * 64; LAS float* li_l = ws; LAS float* al_l = ws + 32;
  float m1 = -1e30f, l1 = 0, m2 = -1e30f, l2 = 0;
#pragma unroll
  for (int d = 0; d < 4; ++d) { o1[d] = f32x16{}; o2[d] = f32x16{}; }
  bf16x8 q1[4], q2[4];
  const bf16_t* Qw = in.Q + (size_t)(wid * QBLK + r32) * in.ldq + hi * 8;
#pragma unroll
  for (int d0 = 0; d0 < 4; ++d0) { q1[d0] = *(const bf16x8*)(Qw + d0 * 16); q2[d0] = *(const bf16x8*)(Qw + 64 + d0 * 16); }
  const int krow = wid * 8 + (lane >> 3), kslot = (lane & 7) ^ ((krow >> 1) & 7);
  const unsigned koff = (unsigned)(krow * in.ldk + kslot * 8) * 2u;
  unsigned voff[2];
#pragma unroll
  for (int i = 0; i < 2; ++i) { const int p = i * 8192 + wid * 1024 + lane * 16, st = p >> 9, wq = (p & 511) >> 1, kk = (st >> 2) * 8 + (wq >> 5), cl = wq & 31;
    const int k = (kk & ~0xC) | ((kk & 4) << 1) | ((kk & 8) >> 1); voff[i] = (unsigned)(k * in.ldv + (st & 3) * 32 + cl) * 2u; }
  const int vb0 = (int)(unsigned)(size_t)V_lds + v_rd_base(lane);
  const unsigned ldsw = (unsigned)wid * 1024u;
#define GLDS(gp, lp) __builtin_amdgcn_global_load_lds((const unsigned*)(gp), (LAS unsigned*)(lp), 16, 0, 0)
#define ISSUE_KV(t, b) do { const char* kb_ = (const char*)in.K + (size_t)(t) * (KVBLK * 2) * in.ldk; const char* vb_ = (const char*)in.V + (size_t)(t) * (KVBLK * 2) * in.ldv; \
    GLDS(kb_ + koff, K_lds + (b) * SHM_K + ldsw); GLDS(kb_ + 128 + koff, K_lds + (b) * SHM_K + 8192 + ldsw); \
    GLDS(vb_ + voff[0], V_lds + (b) * SHM_V + ldsw); GLDS(vb_ + voff[1], V_lds + (b) * SHM_V + 8192 + ldsw); } while (0)
#define WAITV(n) asm volatile("s_waitcnt vmcnt(%0)" :: "n"(n) : "memory")
#define WBAR() do { asm volatile("" ::: "memory"); __builtin_amdgcn_s_barrier(); asm volatile("" ::: "memory"); } while (0)
#define RESC(oo, a) do { if (__any((a) < 1.f)) { if (hi == 0) al_l[r32] = (a); asm volatile("s_waitcnt lgkmcnt(0)" ::: "memory"); \
    _Pragma("unroll") for (int d = 0; d < 4; ++d) _Pragma("unroll") for (int r = 0; r < 16; ++r) oo[d][r] *= al_l[crow(r, hi)]; asm volatile("s_waitcnt lgkmcnt(0)" ::: "memory"); } } while (0)
#define NXT3(x) ((x) == 2 ? 0 : (x) + 1)
#define TILE_BODY(b) do { f32x16 p0, p1; float mn, al; bf16x8 pa0, pa1, pa2, pa3; \
    qkt<64>(p0, p1, K_lds + (b) * SHM_K, q1, r32, hi); partialSM(p0, p1, m1, mn, al, C, thr); RESC(o1, al); \
    finishSM(p0, p1, al, l1, pa0, pa1, pa2, pa3); SBAR(); pv_d0(o1, vb0 + (b) * SHM_V, pa0, pa1, pa2, pa3); SBAR(); \
    qkt<64>(p0, p1, K_lds + (b) * SHM_K + 8192, q2, r32, hi); partialSM(p0, p1, m2, mn, al, C, thr); RESC(o2, al); \
    finishSM(p0, p1, al, l2, pa0, pa1, pa2, pa3); SBAR(); pv_d0(o2, vb0 + (b) * SHM_V, pa0, pa1, pa2, pa3); SBAR(); } while (0)
  const int NT = seq / KVBLK;
  ISSUE_KV(0, 0); ISSUE_KV(1, 1);
  int bq = 0;
  for (int j = 0; j + 1 < NT; ++j) {
    const int b1 = NXT3(bq), b2 = NXT3(b1);
    WAITV(4); WBAR();
    if (j + 2 < NT) ISSUE_KV(j + 2, b2); else ISSUE_KV(NT - 1, b2);
    TILE_BODY(bq);
    bq = b1;
  }
  WAITV(4); WBAR();
  TILE_BODY(bq);
  WAITV(0);
  if (hi == 0) { li_l[r32] = l1; al_l[r32] = l2; } asm volatile("s_waitcnt lgkmcnt(0)" ::: "memory");
#pragma unroll
  for (int r = 0; r < 16; ++r) { const float ra = __builtin_amdgcn_rcpf(li_l[crow(r, hi)]), rb = __builtin_amdgcn_rcpf(al_l[crow(r, hi)]);
#pragma unroll
    for (int d = 0; d < 4; ++d) { o1[d][r] *= ra; o2[d][r] *= rb; } }
  asm volatile("s_waitcnt lgkmcnt(0)" ::: "memory"); WBAR();
#undef GLDS
#undef ISSUE_KV
#undef WAITV
#undef WBAR
#undef RESC
#undef NXT3
#undef TILE_BODY
}
template <int I> struct IC { static constexpr int value = I; };
template <int LO, int HI, class F> __device__ __forceinline__ void sfor(F&& f) { if constexpr (LO < HI) { f(IC<LO>{}); sfor<LO + 1, HI>(f); } }
struct SMS { float a0, a1, a2, a3, dm; bool keep; };
__device__ __forceinline__ void mfma_c(f32x16& d, const bf16x8& a, const bf16x8& b, const f32x16& c) { asm("v_mfma_f32_32x32x16_bf16 %0, %1, %2, %3" : "=&v"(d) : "v"(a), "v"(b), "v"(c)); }
__device__ __forceinline__ void negm_bcast(f32x16& negm, float aone, float nm) { asm volatile("s_nop 1\n\tv_mfma_f32_32x32x2_f32 %0, %1, %2, 0\n\ts_nop 15\n\ts_nop 3" : "+v"(negm) : "v"(aone), "v"(nm)); }

struct VF { s16x4 l, h; };
template <int NEX> struct StartSched {
  static constexpr int NITEMS = 17 + NEX;
  static constexpr int kind(int n) { return n < 16 ? 0 : n == 16 ? 1 : 3; }
  static constexpr int idx(int n) { return n <= 16 ? n : n - 17; }
  static constexpr int weight(int n) { const int k = kind(n); return k == 3 ? 2 : k == 1 ? 3 : 1; }
  static constexpr int first(int g, int ng) { int W = 0; for (int i = 0; i < NITEMS; ++i) W += weight(i); int cum = 0; for (int i = 0; i < NITEMS; ++i) { if (cum * ng >= g * W) return i; cum += weight(i); } return NITEMS; }
};
template <int NEX> struct FinSched {
  static constexpr int NITEMS = NEX + 16;
  static constexpr int weight(int n) { return n < NEX ? 2 : 1; }
  static constexpr int first(int g, int ng) { int W = 0; for (int i = 0; i < NITEMS; ++i) W += weight(i); int cum = 0; for (int i = 0; i < NITEMS; ++i) { if (cum * ng >= g * W) return i; cum += weight(i); } return NITEMS; }
};
template <int N, int NEX> __device__ __forceinline__ void start_item(f32x16& P0, f32x16& P1, SMS& st, f32x16& negm, const float thr, const float hi_is0) {
  using SS = StartSched<NEX>; constexpr int K = SS::kind(N), I = SS::idx(N);
  if constexpr (K == 0) {
    if constexpr (I == 0) st.a0 = fmaxf(fmaxf(P0[0], P0[1]), P0[2]);
    else if constexpr (I == 1) st.a1 = fmaxf(fmaxf(P0[3], P0[4]), P0[5]);
    else if constexpr (I < 7) { if constexpr (I & 1) st.a1 = fmaxf(fmaxf(st.a1, P0[2 * I + 2]), P0[2 * I + 3]); else st.a0 = fmaxf(fmaxf(st.a0, P0[2 * I + 2]), P0[2 * I + 3]); }
    else if constexpr (I == 7) st.a2 = fmaxf(fmaxf(P1[0], P1[1]), P1[2]);
    else if constexpr (I == 8) st.a3 = fmaxf(fmaxf(P1[3], P1[4]), P1[5]);
    else if constexpr (I < 14) { constexpr int J = I - 7; if constexpr (J & 1) st.a3 = fmaxf(fmaxf(st.a3, P1[2 * J + 2]), P1[2 * J + 3]); else st.a2 = fmaxf(fmaxf(st.a2, P1[2 * J + 2]), P1[2 * J + 3]); }
    else if constexpr (I == 14) st.a0 = fmaxf(fmaxf(st.a0, st.a1), st.a2);
    else st.a0 = fmaxf(st.a0, st.a3);
  } else if constexpr (K == 1) {
    float pmax;
    { auto rr = __builtin_amdgcn_permlane32_swap(__float_as_uint(st.a0), __float_as_uint(st.a0), false, false); pmax = fmaxf(__uint_as_float(rr[0]), __uint_as_float(rr[1])); }
    st.keep = __all(pmax <= thr);
    if (__builtin_expect(!st.keep, 0)) {
      const float delta = fmaxf(pmax, 0.f); st.dm = -delta;
#pragma unroll
      for (int r = 0; r < 16; ++r) { P0[r] -= delta; P1[r] -= delta; }
      negm_bcast(negm, hi_is0, negm[0] - delta);
    }
  } else {
    if constexpr (I < 16) P0[I] = __builtin_amdgcn_exp2f(P0[I]); else P1[I - 16] = __builtin_amdgcn_exp2f(P1[I - 16]);
  }
}
template <int N, int NEX> __device__ __forceinline__ void fin_item(f32x16& P0, f32x16& P1, SMS& st, u32x4 (&pw)[4]) {
  if constexpr (N < NEX) { P1[16 - NEX + N] = __builtin_amdgcn_exp2f(P1[16 - NEX + N]); }
  else {
    constexpr int n = N - NEX, k = n / 4, j = n % 4, b = (k & 1) * 8 + 2 * j;
    f32x16& P = (k < 2) ? P0 : P1;
    pw[k][j] = cvt_pk_bf16(P[b], P[b + 1]);
  }
}
template <int N> __device__ __forceinline__ void v_wait(VF& f) { asm volatile("s_waitcnt lgkmcnt(%2)" : "+v"(f.l), "+v"(f.h) : "n"(N)); }
template <int G> __device__ __forceinline__ void v_issue(VF& f, int vb) { f.l = tr_read<v_rd_off(G & 3, G >> 2, 0)>(vb); f.h = tr_read<v_rd_off(G & 3, G >> 2, 1)>(vb); }

template <int DQK, int MAPS>
__device__ __forceinline__ void attn_core_pl(const Src in, const float C, const float thr, const int seq, LAS char* lds, f32x16 (&o)[4], float* probe = nullptr) {
  static_assert(DQK == 64 && MAPS == 2, "differential-attention configuration only");
  constexpr int SHM_K = 16384, NKS = DQK / 16, NG1 = 2 * NKS, NEXS = 32, NEXF = 0, VLA = 3;
  using SS = StartSched<NEXS>; using FS = FinSched<NEXF>;
  int lane; asm volatile("v_and_b32 %0, 63, %1" : "=v"(lane) : "v"(threadIdx.x));
  const int tid = threadIdx.x, wid = __builtin_amdgcn_readfirstlane(tid >> 6), r32 = lane & 31, hi = (lane >> 5) & 1, wq = wid & 3, mp = wid >> 2;
  LAS char* V_lds = lds; LAS char* K_lds = lds + 3 * SHM_V;
  LAS float* ws = (LAS float*)(lds + 3 * SHM_V + 3 * SHM_K) + wid * 64; LAS float* li_l = ws; LAS float* al_l = ws + 32;
  SMS st; st.dm = 0.f; st.keep = true;
  f32x16 negm = f32x16{};
#pragma unroll
  for (int d = 0; d < 4; ++d) o[d] = f32x16{};
  f32x16 osum = f32x16{};
  const bf16x8 ones = {16256, 16256, 16256, 16256, 16256, 16256, 16256, 16256};
  bf16x8 qr[NKS];
  const bf16_t* Qw = in.Q + (size_t)(wq * QBLK + r32) * in.ldq + mp * 64 + hi * 8;
#pragma unroll
  for (int d0 = 0; d0 < NKS; ++d0) qr[d0] = *(const bf16x8*)(Qw + d0 * 16);
  const int krow = wid * 8 + (lane >> 3), kslot = (lane & 7) ^ ((krow >> 1) & 7);
  const unsigned koff = (unsigned)(krow * in.ldk + kslot * 8) * 2u;
  unsigned voff[2];
#pragma unroll
  for (int i = 0; i < 2; ++i) { const int p = i * 8192 + wid * 1024 + lane * 16, s_ = p >> 9, wq_ = (p & 511) >> 1, kk = (s_ >> 2) * 8 + (wq_ >> 5), cl = wq_ & 31;
    voff[i] = (unsigned)(kk * in.ldv + (s_ & 3) * 32 + cl) * 2u; }
  const int vb0 = (int)(unsigned)(size_t)V_lds + v_rd_base(lane);
  const unsigned ldsw = (unsigned)wid * 1024u;
  const LAS char* Kw = K_lds + mp * 8192;
#define GLDS(gp, lp) __builtin_amdgcn_global_load_lds((const unsigned*)(gp), (LAS unsigned*)(lp), 16, 0, 0)
#define ISSUE_K(t, b) do { const char* kb_ = (const char*)in.K + (size_t)(t) * (KVBLK * 2) * in.ldk; \
    _Pragma("unroll") for (int rep_ = 0; rep_ < 1 + PROBE_DMA2; ++rep_) { GLDS(kb_ + koff, K_lds + (b) * SHM_K + ldsw); GLDS(kb_ + 128 + koff, K_lds + (b) * SHM_K + 8192 + ldsw); } } while (0)
#define ISSUE_V(t, b) do { const char* vb_ = (const char*)in.V + (size_t)(t) * (KVBLK * 2) * in.ldv; \
    _Pragma("unroll") for (int rep_ = 0; rep_ < 1 + PROBE_DMA2; ++rep_) { GLDS(vb_ + voff[0], V_lds + (b) * SHM_V + ldsw); GLDS(vb_ + voff[1], V_lds + (b) * SHM_V + 8192 + ldsw); } } while (0)
#define DMA_PIECE(i) do { DMA_PIECE1(i); if (PROBE_DMA2) DMA_PIECE1(i); } while (0)
#define DMA_PIECE1(i) do { if ((i) < 2) { const char* kb_ = (const char*)in.K + (size_t)tk_ * (KVBLK * 2) * in.ldk; GLDS(kb_ + (i) * 128 + koff, K_lds + bq * SHM_K + (i) * 8192 + ldsw); } \
    else { const char* vb_ = (const char*)in.V + (size_t)tv_ * (KVBLK * 2) * in.ldv; GLDS(vb_ + voff[(i) & 1], V_lds + b2 * SHM_V + ((i) & 1) * 8192 + ldsw); } } while (0)
#define WAITV(n) asm volatile("s_waitcnt vmcnt(%0)" :: "n"(n) : "memory")
#define WBAR() do { asm volatile("" ::: "memory"); __builtin_amdgcn_s_barrier(); asm volatile("" ::: "memory"); } while (0)
#define RESC() do { if (!st.keep) { int l2_; asm volatile("v_and_b32 %0, 63, %1" : "=v"(l2_) : "v"(threadIdx.x)); const int h2_ = l2_ >> 5; LAS float* al2_ = (LAS float*)(lds + 3 * SHM_V + 3 * SHM_K) + wid * 64 + 32; \
    if (h2_ == 0) al2_[l2_] = __builtin_amdgcn_exp2f(st.dm); asm volatile("s_waitcnt lgkmcnt(0)" ::: "memory"); \
    _Pragma("unroll") for (int r = 0; r < 16; ++r) { const float a_ = al2_[crow(r, h2_)]; osum[r] *= a_; _Pragma("unroll") for (int d = 0; d < 4; ++d) o[d][r] *= a_; } asm volatile("s_waitcnt lgkmcnt(0)" ::: "memory"); } } while (0)
#define NXT3(x) ((x) == 2 ? 0 : (x) + 1)
#define KFRAG(Ks, d, blk) (*(const LAS bf16x8*)((Ks) + KSW((blk) * 32 + r32, ((d) * 16 + hi * 8) * 2)))
#define PA(ks) (*reinterpret_cast<const bf16x8*>(&pw[ks]))
#define PKV(f) (bf16x8){f.l[0], f.l[1], f.l[2], f.l[3], f.h[0], f.h[1], f.h[2], f.h[3]}
#define PHASE1(PN0, PN1, PF0, PF1, Ks, vb) do { \
    bf16x8 kf[NKS][2]; kf[0][0] = KFRAG(Ks, 0, 0); kf[0][1] = KFRAG(Ks, 0, 1); \
    sfor<0, NG1>([&](auto gc) __attribute__((always_inline)) { constexpr int g = decltype(gc)::value, d = g >> 1, blk = g & 1; \
      if constexpr (blk == 0 && d + 1 < NKS) { kf[d + 1][0] = KFRAG(Ks, d + 1, 0); kf[d + 1][1] = KFRAG(Ks, d + 1, 1); } \
      if constexpr (blk == 0) { if constexpr (d == 0) mfma_c(PN0, kf[d][0], qr[d], negm); else PN0 = __builtin_amdgcn_mfma_f32_32x32x16_bf16(kf[d][0], qr[d], PN0, 0, 0, 0); } \
      else              { if constexpr (d == 0) mfma_c(PN1, kf[d][1], qr[d], negm); else PN1 = __builtin_amdgcn_mfma_f32_32x32x16_bf16(kf[d][1], qr[d], PN1, 0, 0, 0); } \
      if constexpr (DMA_SPREAD == 1 && g < 4) DMA_PIECE(g); \
      if constexpr (g >= NG1 - VLA) v_issue<g - (NG1 - VLA)>(vf[g - (NG1 - VLA)], vb); \
      sfor<FS::first(g, NG1), FS::first(g + 1, NG1)>([&](auto ic) __attribute__((always_inline)) { fin_item<decltype(ic)::value, NEXF>(PF0, PF1, st, pw); }); \
      SBAR(); }); } while (0)
#define PHASE2(PS0, PS1, vb) do { \
    sfor<0, 20>([&](auto gc) __attribute__((always_inline)) { constexpr int gg = decltype(gc)::value, ks = gg / 5, d = gg % 5, g = ks * 4 + d; \
      if constexpr (d < 4) { \
        v_wait<2 * (15 - g < VLA - 1 ? 15 - g : VLA - 1)>(vf[g]); \
        o[d] = __builtin_amdgcn_mfma_f32_32x32x16_bf16(PA(ks), PKV(vf[g]), o[d], 0, 0, 0); \
        if constexpr (g + VLA < 16) v_issue<g + VLA>(vf[g + VLA], vb); \
      } else { osum = __builtin_amdgcn_mfma_f32_32x32x16_bf16(PA(ks), ones, osum, 0, 0, 0); if constexpr (DMA_SPREAD == 2) DMA_PIECE(ks); } \
      sfor<SS::first(gg, 20), SS::first(gg + 1, 20)>([&](auto ic) __attribute__((always_inline)) { start_item<decltype(ic)::value, NEXS>(PS0, PS1, st, negm, thr, hi == 0 ? 1.f : 0.f); }); \
      SBAR(); }); \
    asm volatile("" : "+v"(PS0), "+v"(PS1)); \
    RESC(); } while (0)
  f32x16 pA0, pA1, pB0, pB1; u32x4 pw[4]; VF vf[16]; const int NT = seq / KVBLK;
  ISSUE_K(0, 0); ISSUE_K(1, 1); ISSUE_V(0, 0);
  WAITV(PROBE_DMA2 ? 8 : 4); WBAR();
  ISSUE_K(2, 2); ISSUE_V(1, 1);
  { bf16x8 kf[NKS][2];
#pragma unroll
    for (int d = 0; d < NKS; ++d) { kf[d][0] = KFRAG(Kw, d, 0); kf[d][1] = KFRAG(Kw, d, 1); }
    pA0 = f32x16{}; pA1 = f32x16{};
#pragma unroll
    for (int d = 0; d < NKS; ++d) { pA0 = __builtin_amdgcn_mfma_f32_32x32x16_bf16(kf[d][0], qr[d], pA0, 0, 0, 0); pA1 = __builtin_amdgcn_mfma_f32_32x32x16_bf16(kf[d][1], qr[d], pA1, 0, 0, 0); } }
  sfor<0, 16>([&](auto ic) __attribute__((always_inline)) { start_item<decltype(ic)::value, NEXS>(pA0, pA1, st, negm, thr, hi == 0 ? 1.f : 0.f); });
  { float pmax;
    { auto rr = __builtin_amdgcn_permlane32_swap(__float_as_uint(st.a0), __float_as_uint(st.a0), false, false); pmax = fmaxf(__uint_as_float(rr[0]), __uint_as_float(rr[1])); }
#pragma unroll
    for (int r = 0; r < 16; ++r) { pA0[r] -= pmax; pA1[r] -= pmax; negm[r] = -pmax; } }
  sfor<17, SS::NITEMS>([&](auto ic) __attribute__((always_inline)) { start_item<decltype(ic)::value, NEXS>(pA0, pA1, st, negm, thr, hi == 0 ? 1.f : 0.f); });
  int bq = 0;
#define ITER(j, PN0, PN1, PF0, PF1) do { const int b1 = NXT3(bq), b2 = NXT3(b1); \
    STAMP_A(); WAITV(PROBE_DMA2 ? 8 : 4); WBAR(); STAMP_B(); \
    const int tk_ = (j) + 3 < NT ? (j) + 3 : NT - 1, tv_ = (j) + 2 < NT ? (j) + 2 : NT - 1; if (DMA_SPREAD == 0) { ISSUE_K(tk_, bq); ISSUE_V(tv_, b2); } \
    PHASE1(PN0, PN1, PF0, PF1, Kw + b1 * SHM_K, vb0 + bq * SHM_V); STAMP_C(); \
    PHASE2(PN0, PN1, vb0 + bq * SHM_V); \
    bq = b1; } while (0)
#if PROBE_T
  unsigned long long tA = 0, tB = 0, accAB = 0, accBC = 0; const unsigned long long t0 = __builtin_amdgcn_s_memtime(), r0 = __builtin_amdgcn_s_memrealtime();
#define STAMP_A() do { if (PROBE_T >= 2) tA = __builtin_amdgcn_s_memtime(); } while (0)
#define STAMP_B() do { if (PROBE_T >= 2) { tB = __builtin_amdgcn_s_memtime(); accAB += tB - tA; } } while (0)
#define STAMP_C() do { if (PROBE_T == 3) { accBC += __builtin_amdgcn_s_memtime() - tB; } } while (0)
#else
#define STAMP_A()
#define STAMP_B()
#define STAMP_C()
#endif
  for (int j = 0; j + 2 < NT; j += 2) { ITER(j, pB0, pB1, pA0, pA1); ITER(j + 1, pA0, pA1, pB0, pB1); }
  ITER(NT - 2, pB0, pB1, pA0, pA1);
#if PROBE_T
  { const unsigned long long t1 = __builtin_amdgcn_s_memtime(), r1 = __builtin_amdgcn_s_memrealtime();
    if (probe != nullptr && tid == 0) {
      if (PROBE_T == 1) { probe[0] = (float)(t1 - t0) * (0.5e-6f / (NT - 1)); probe[1] = (float)(t1 - t0) / (float)(r1 - r0); }
      if (PROBE_T == 2) { probe[0] = (float)accAB * (0.5e-6f / (NT - 1)); probe[1] = ((float)(t1 - t0) * (1.f / (NT - 1)) - 1500.f) * 0.05f; }
      if (PROBE_T == 3) { probe[0] = (float)accBC * (0.5e-6f / (NT - 1)); probe[1] = (float)accAB * (0.01f / (NT - 1)); } } }
#endif
#undef STAMP_A
#undef STAMP_B
#undef STAMP_C
  sfor<0, FS::NITEMS>([&](auto ic) __attribute__((always_inline)) { fin_item<decltype(ic)::value, NEXF>(pB0, pB1, st, pw); });
  WAITV(0); WBAR();
  { const int vb = vb0 + bq * SHM_V;
    sfor<0, VLA>([&](auto gc) __attribute__((always_inline)) { v_issue<decltype(gc)::value>(vf[decltype(gc)::value], vb); });
    sfor<0, 16>([&](auto gc) __attribute__((always_inline)) { constexpr int g = decltype(gc)::value, ks = g >> 2, d = g & 3;
      v_wait<2 * (15 - g < VLA - 1 ? 15 - g : VLA - 1)>(vf[g]);
      o[d] = __builtin_amdgcn_mfma_f32_32x32x16_bf16(PA(ks), PKV(vf[g]), o[d], 0, 0, 0);
      if constexpr (g + VLA < 16) v_issue<g + VLA>(vf[g + VLA], vb);
      if constexpr (d == 3) osum = __builtin_amdgcn_mfma_f32_32x32x16_bf16(PA(ks), ones, osum, 0, 0, 0);
      SBAR(); }); }
#pragma unroll
  for (int r = 0; r < 16; ++r) { const float rl = __builtin_amdgcn_rcpf(osum[r]);
#pragma unroll
    for (int d = 0; d < 4; ++d) o[d][r] *= rl; }
  asm volatile("s_waitcnt lgkmcnt(0)" ::: "memory"); WBAR();
#undef GLDS
#undef ISSUE_K
#undef ISSUE_V
#undef WAITV
#undef WBAR
#undef RESC
#undef NXT3
#undef KFRAG
#undef PKV
#undef PA
#undef PHASE1
#undef DMA_PIECE
#undef DMA_PIECE1
#undef PHASE2
#undef ITER
}
struct BStart { static constexpr int NITEMS = 25;
  static constexpr int weight(int n) { return n < 8 ? 1 : n == 8 ? 3 : 2; }
  static constexpr int first(int g, int ng) { int W = 0; for (int i = 0; i < NITEMS; ++i) W += weight(i); int cum = 0; for (int i = 0; i < NITEMS; ++i) { if (cum * ng >= g * W) return i; cum += weight(i); } return NITEMS; } };
template <int N> __device__ __forceinline__ void bstart_item(f32x16& P, SMS& st, f32x16& negm, const float thr, const float hi_is0) {
  if constexpr (N == 0) st.a0 = fmaxf(fmaxf(P[0], P[1]), P[2]);
  else if constexpr (N == 1) st.a1 = fmaxf(fmaxf(P[3], P[4]), P[5]);
  else if constexpr (N < 7) { if constexpr (N & 1) st.a1 = fmaxf(fmaxf(st.a1, P[2 * N + 2]), P[2 * N + 3]); else st.a0 = fmaxf(fmaxf(st.a0, P[2 * N + 2]), P[2 * N + 3]); }
  else if constexpr (N == 7) st.a0 = fmaxf(st.a0, st.a1);
  else if constexpr (N == 8) {
    float pmax;
    { auto rr = __builtin_amdgcn_permlane32_swap(__float_as_uint(st.a0), __float_as_uint(st.a0), false, false); pmax = fmaxf(__uint_as_float(rr[0]), __uint_as_float(rr[1])); }
    st.keep = __all(pmax <= thr);
    if (__builtin_expect(!st.keep, 0)) {
      const float delta = fmaxf(pmax, 0.f); st.dm = -delta;
#pragma unroll
      for (int r = 0; r < 16; ++r) P[r] -= delta;
      negm_bcast(negm, hi_is0, negm[0] - delta);
    }
  } else { constexpr int I = N - 9; P[I] = __builtin_amdgcn_exp2f(P[I]); }
}
template <int N> __device__ __forceinline__ void bfin_item(f32x16& P, u32x4 (&pw)[2]) { constexpr int k = N / 4, j = N % 4; pw[k][j] = cvt_pk_bf16(P[8 * k + 2 * j], P[8 * k + 2 * j + 1]); }
constexpr int bfin_first(int g, int ng) { return g * 8 / ng; }

template <int OFF> __device__ __forceinline__ void k_read(bf16x8& r, int addr) { asm volatile("ds_read_b128 %0, %1 offset:%2" : "=&v"(r) : "v"(addr), "i"(OFF) : "memory"); }
template <int N> __device__ __forceinline__ void k_wait(bf16x8& f) { asm volatile("s_waitcnt lgkmcnt(%1)" : "+v"(f) : "n"(N)); }
constexpr int kwait_n(int g, int nks, int kla, int vla) {
  int kk = kla - 1 < nks - 1 - g ? kla - 1 : nks - 1 - g; if (kk < 0) kk = 0;
  int lo = nks - vla > g - kla ? nks - vla : g - kla; int vv = g - lo; if (vv < 0) vv = 0;
  return kk + 2 * vv; }
template <int DQK, int MAPS>
__device__ __forceinline__ void attn_core_bp(const Src in, const float thr, const int seq, LAS char* lds, f32x16 (&o)[4], float* probe = nullptr) {
  constexpr int NSUB = MAPS == 2 ? 2 : DQK / 64, SHM_K = NSUB * 8192, NKS = DQK / 16, NI = NSUB + 2, VLA = BP_VLA, KLA = BP_KLA;
  int lane; asm volatile("v_and_b32 %0, 63, %1" : "=v"(lane) : "v"(threadIdx.x));
  const int tid = threadIdx.x, wid = __builtin_amdgcn_readfirstlane(tid >> 6), r32 = lane & 31, hi = (lane >> 5) & 1, wq = MAPS == 2 ? (wid & 3) : wid, mp = MAPS == 2 ? (wid >> 2) : 0;
  LAS char* V_lds = lds; LAS char* K_lds = lds + 4 * SHM_V;
  SMS st; st.dm = 0.f; st.keep = true;
  f32x16 negm = f32x16{}, osum = f32x16{};
#pragma unroll
  for (int d = 0; d < 4; ++d) o[d] = f32x16{};
  const bf16x8 ones = {16256, 16256, 16256, 16256, 16256, 16256, 16256, 16256};
  bf16x8 qr[NKS];
  { const bf16_t* Qw = in.Q + (size_t)(wq * QBLK + r32) * in.ldq + mp * 64 + hi * 8;
#pragma unroll
    for (int d0 = 0; d0 < NKS; ++d0) qr[d0] = *(const bf16x8*)(Qw + d0 * 16); }
  const int krow = wid * 8 + (lane >> 3), kslot = (lane & 7) ^ ((krow >> 1) & 7);
  const unsigned koff = (unsigned)(krow * in.ldk + kslot * 8) * 2u, k2off = (unsigned)(krow * in.ldk2 + kslot * 8) * 2u;
  unsigned voff[2];
#pragma unroll
  for (int i = 0; i < 2; ++i) { const int p = i * 8192 + wid * 1024 + lane * 16, s_ = p >> 9, wq_ = (p & 511) >> 1, kk = (s_ >> 2) * 8 + (wq_ >> 5), cl = wq_ & 31;
    voff[i] = (unsigned)(kk * in.ldv + (s_ & 3) * 32 + cl) * 2u; }
  const int vb0 = (int)(unsigned)(size_t)V_lds + v_rd_base(lane);
  const unsigned ldsw = (unsigned)wid * 1024u;
  const LAS char* Kw = K_lds + mp * 8192;
  int kxo[4];
#pragma unroll
  for (int i = 0; i < 4; ++i) kxo[i] = r32 * 128 + ((i * 32 + hi * 16) ^ (((r32 >> 1) & 7) << 4));
#define GLDS(gp, lp) __builtin_amdgcn_global_load_lds((const unsigned*)(gp), (LAS unsigned*)(lp), 16, 0, 0)
#define PIECE(i, tk, bk, tv, bv) do { \
    if ((i) < NSUB) { if (MAPS == 2 || (i) < 2) GLDS((const char*)in.K + (size_t)(tk) * (KVBLK * 2) * in.ldk + (i) * 128 + koff, K_lds + (bk) * SHM_K + (i) * 8192 + ldsw); \
                      else GLDS((const char*)in.K2 + (size_t)(tk) * (KVBLK * 2) * in.ldk2 + k2off, K_lds + (bk) * SHM_K + (i) * 8192 + ldsw); } \
    else GLDS((const char*)in.V + (size_t)(tv) * (KVBLK * 2) * in.ldv + voff[((i) - NSUB) & 1], V_lds + (bv) * SHM_V + (((i) - NSUB) & 1) * 8192 + ldsw); } while (0)
#define WAITV(n) asm volatile("s_waitcnt vmcnt(%0)" :: "n"(n) : "memory")
#define WBAR() do { asm volatile("" ::: "memory"); __builtin_amdgcn_s_barrier(); asm volatile("" ::: "memory"); } while (0)
#define RESC() do { if (!st.keep) { int l2_; asm volatile("v_and_b32 %0, 63, %1" : "=v"(l2_) : "v"(threadIdx.x)); const int h2_ = l2_ >> 5; LAS float* al2_ = (LAS float*)(lds + MISC_OFF + 128) + wid * 32; \
    if (h2_ == 0) al2_[l2_] = __builtin_amdgcn_exp2f(st.dm); asm volatile("s_waitcnt lgkmcnt(0)" ::: "memory"); \
    _Pragma("unroll") for (int r = 0; r < 16; ++r) { const float a_ = al2_[crow(r, h2_)]; osum[r] *= a_; _Pragma("unroll") for (int d = 0; d < 4; ++d) o[d][r] *= a_; } asm volatile("s_waitcnt lgkmcnt(0)" ::: "memory"); } } while (0)
#define NXT3(x) ((x) == 2 ? 0 : (x) + 1)
#define KFRAG(Ks, d, blk) (*(const LAS bf16x8*)((Ks) + ((d) >> 2) * 8192 + KSW((blk) * 32 + r32, (((d) & 3) * 16 + hi * 8) * 2)))
#define PA(k) (*reinterpret_cast<const bf16x8*>(&pw[k]))
#define PKV(f) (bf16x8){f.l[0], f.l[1], f.l[2], f.l[3], f.h[0], f.h[1], f.h[2], f.h[3]}
#define BITER(BPAR, PN, PF, Kq, vb, DO_DMA) do { \
    { bf16x8 kf[NKS]; int ka_[4]; { const int kb_ = (int)(unsigned)(size_t)(Kq); _Pragma("unroll") for (int i_ = 0; i_ < 4; ++i_) ka_[i_] = kb_ + kxo[i_]; } \
      sfor<0, KLA>([&](auto dc) __attribute__((always_inline)) { constexpr int d_ = decltype(dc)::value; k_read<(d_ >> 2) * 8192 + (1 - (BPAR)) * 4096>(kf[d_], ka_[d_ & 3]); }); \
      sfor<0, NKS>([&](auto gc) __attribute__((always_inline)) { constexpr int g = decltype(gc)::value; \
        k_wait<kwait_n(g, NKS, KLA, VLA)>(kf[g]); \
        if constexpr (g + KLA < NKS) k_read<((g + KLA) >> 2) * 8192 + (1 - (BPAR)) * 4096>(kf[g + KLA], ka_[(g + KLA) & 3]); \
        if constexpr (g == 0) mfma_c(PN, kf[g], qr[g], negm); else PN = __builtin_amdgcn_mfma_f32_32x32x16_bf16(kf[g], qr[g], PN, 0, 0, 0); \
        if constexpr ((DO_DMA) && g < NI) PIECE(g, tk_, bk_, tv_, bv_); \
        if constexpr (g >= NKS - VLA) v_issue<8 * (BPAR) + g - (NKS - VLA)>(vf[g - (NKS - VLA)], vb); \
        sfor<bfin_first(g, NKS), bfin_first(g + 1, NKS)>([&](auto ic) __attribute__((always_inline)) { bfin_item<decltype(ic)::value>(PF, pw); }); \
        SBAR(); }); } \
    sfor<0, 10>([&](auto gc) __attribute__((always_inline)) { constexpr int gg = decltype(gc)::value, ksl = gg / 5, d = gg % 5, g = ksl * 4 + d; \
      if constexpr (d < 4) { \
        v_wait<2 * (7 - g < VLA - 1 ? 7 - g : VLA - 1)>(vf[g]); \
        o[d] = __builtin_amdgcn_mfma_f32_32x32x16_bf16(PA(ksl), PKV(vf[g]), o[d], 0, 0, 0); \
        if constexpr (g + VLA < 8) v_issue<8 * (BPAR) + g + VLA>(vf[g + VLA], vb); \
      } else osum = __builtin_amdgcn_mfma_f32_32x32x16_bf16(PA(ksl), ones, osum, 0, 0, 0); \
      if constexpr (gg > 0) sfor<BStart::first(gg - 1, 9), BStart::first(gg, 9)>([&](auto ic) __attribute__((always_inline)) { bstart_item<decltype(ic)::value>(PN, st, negm, thr, hi == 0 ? 1.f : 0.f); });     \
      SBAR(); }); \
    asm volatile("" : "+v"(PN)); \
    RESC(); } while (0)
  f32x16 pA, pB; u32x4 pw[2]; VF vf[8]; const int NT = seq / KVBLK;
#pragma unroll
  for (int t = 0; t < 3; ++t) {
#pragma unroll
    for (int i = 0; i < NI; ++i) PIECE(i, t, t, t, t); }
  WAITV(2 * NI); WBAR();
  { bf16x8 kf[NKS];
#pragma unroll
    for (int d = 0; d < NKS; ++d) kf[d] = KFRAG(Kw, d, 0);
    pA = f32x16{};
#pragma unroll
    for (int d = 0; d < NKS; ++d) pA = __builtin_amdgcn_mfma_f32_32x32x16_bf16(kf[d], qr[d], pA, 0, 0, 0); }
  sfor<0, 8>([&](auto ic) __attribute__((always_inline)) { bstart_item<decltype(ic)::value>(pA, st, negm, thr, hi == 0 ? 1.f : 0.f); });
  { float pmax;
    { auto rr = __builtin_amdgcn_permlane32_swap(__float_as_uint(st.a0), __float_as_uint(st.a0), false, false); pmax = fmaxf(__uint_as_float(rr[0]), __uint_as_float(rr[1])); }
#pragma unroll
    for (int r = 0; r < 16; ++r) { pA[r] -= pmax; negm[r] = -pmax; } }
  sfor<9, BStart::NITEMS>([&](auto ic) __attribute__((always_inline)) { bstart_item<decltype(ic)::value>(pA, st, negm, thr, hi == 0 ? 1.f : 0.f); });
  int kq = 0;
#if PROBE_T == 5
  const unsigned long long t0 = __builtin_amdgcn_s_memtime();
#endif
  for (int t = 0; t + 1 < NT; ++t) {
    const int k1 = NXT3(kq), vq = t & 3;
    const int tk_ = t + 3 < NT ? t + 3 : NT - 1, tv_ = tk_, bk_ = kq, bv_ = (t + 3) & 3;
    BITER(0, pB, pA, Kw + kq * SHM_K, vb0 + vq * SHM_V, false);
    WAITV(NI); WBAR();
    BITER(1, pA, pB, Kw + k1 * SHM_K, vb0 + vq * SHM_V, true);
    kq = k1;
  }
#if PROBE_T == 5
  { const unsigned long long t1 = __builtin_amdgcn_s_memtime(); if (probe != nullptr && tid == 0) { probe[0] = 0.f; probe[1] = ((float)(t1 - t0) * (1.f / (NT - 1)) - PROBE_BASE) * 0.05f; } }
#endif
  { const int vq = (NT - 1) & 3; const int tk_ = 0, tv_ = 0, bk_ = 0, bv_ = 0; (void)tk_; (void)tv_; (void)bk_; (void)bv_;
    BITER(0, pB, pA, Kw + kq * SHM_K, vb0 + vq * SHM_V, false);
    sfor<0, 8>([&](auto ic) __attribute__((always_inline)) { bfin_item<decltype(ic)::value>(pB, pw); });
    const int vb = vb0 + vq * SHM_V;
    sfor<0, VLA>([&](auto gc) __attribute__((always_inline)) { v_issue<8 + decltype(gc)::value>(vf[decltype(gc)::value], vb); });
    sfor<0, 8>([&](auto gc) __attribute__((always_inline)) { constexpr int g = decltype(gc)::value, ksl = g >> 2, d = g & 3;
      v_wait<2 * (7 - g < VLA - 1 ? 7 - g : VLA - 1)>(vf[g]);
      o[d] = __builtin_amdgcn_mfma_f32_32x32x16_bf16(PA(ksl), PKV(vf[g]), o[d], 0, 0, 0);
      if constexpr (g + VLA < 8) v_issue<8 + g + VLA>(vf[g + VLA], vb);
      if constexpr (d == 3) osum = __builtin_amdgcn_mfma_f32_32x32x16_bf16(PA(ksl), ones, osum, 0, 0, 0);
      SBAR(); }); }
#pragma unroll
  for (int r = 0; r < 16; ++r) { const float rl = __builtin_amdgcn_rcpf(osum[r]);
#pragma unroll
    for (int d = 0; d < 4; ++d) o[d][r] *= rl; }
  WAITV(0); asm volatile("s_waitcnt lgkmcnt(0)" ::: "memory"); WBAR();
#undef GLDS
#undef PIECE
#undef WAITV
#undef WBAR
#undef RESC
#undef NXT3
#undef KFRAG
#undef PA
#undef PKV
#undef BITER
}
struct Src8 { const unsigned char* q8; const unsigned char* k8n; const unsigned char* k8r; const bf16_t* V; int ldv; };
typedef int v8i_att __attribute__((ext_vector_type(8))); typedef int v4i_att __attribute__((ext_vector_type(4)));
__device__ __forceinline__ void attn_core_bp8(const Src8 in, const float thr, const int seq, LAS char* lds, f32x16 (&o)[4], float* probe = nullptr) {
  constexpr int SHM_K = 3 * 4096, NKS = 3, NI = 4, VLA = 3;
  int lane; asm volatile("v_and_b32 %0, 63, %1" : "=v"(lane) : "v"(threadIdx.x));
  const int tid = threadIdx.x, wid = __builtin_amdgcn_readfirstlane(tid >> 6), r32 = lane & 31, hi = (lane >> 5) & 1;
  LAS char* V_lds = lds; LAS char* K_lds = lds + 4 * SHM_V;
  SMS st; st.dm = 0.f; st.keep = true;
  f32x16 negm = f32x16{}, osum = f32x16{};
#pragma unroll
  for (int d = 0; d < 4; ++d) o[d] = f32x16{};
  const bf16x8 ones = {16256, 16256, 16256, 16256, 16256, 16256, 16256, 16256};
  v8i_att qf[NKS];
  { const unsigned char* Qw = in.q8 + (size_t)(wid * QBLK + r32) * 1536 + hi * 32;
#pragma unroll
    for (int s = 0; s < NKS; ++s) { const v4i_att lo = *(const v4i_att*)(Qw + s * 64), hh = *(const v4i_att*)(Qw + s * 64 + 16); qf[s] = __builtin_shufflevector(lo, hh, 0, 1, 2, 3, 4, 5, 6, 7); } }
  unsigned ksrc[2]; int kdst[2]; bool krot[2];
#pragma unroll
  for (int i = 0; i < 2; ++i) { const int p0 = wid * 2 + i, p = p0 < 12 ? p0 : p0 - 4, s = p >> 2, q = p & 3, row = q * 16 + (lane >> 2), lc = (lane & 3) ^ ((lane >> 4) & 3);
    krot[i] = (s == 2); ksrc[i] = krot[i] ? (unsigned)(row * 64 + lc * 16) : (unsigned)(row * 1024 + s * 64 + lc * 16); kdst[i] = s * 4096 + q * 1024 + lane * 16; }
  unsigned voff[2];
#pragma unroll
  for (int i = 0; i < 2; ++i) { const int p = i * 8192 + wid * 1024 + lane * 16, s_ = p >> 9, wq_ = (p & 511) >> 1, kk = (s_ >> 2) * 8 + (wq_ >> 5), cl = wq_ & 31;
    voff[i] = (unsigned)(kk * in.ldv + (s_ & 3) * 32 + cl) * 2u; }
  const int vb0 = (int)(unsigned)(size_t)V_lds + v_rd_base(lane);
  const unsigned ldsw = (unsigned)wid * 1024u;
  int kx[2];
#pragma unroll
  for (int c = 0; c < 2; ++c) kx[c] = r32 * 64 + (((2 * hi + c) ^ ((r32 >> 2) & 3)) << 4);
#define GLDS(gp, lp) __builtin_amdgcn_global_load_lds((const unsigned*)(gp), (LAS unsigned*)(lp), 16, 0, 0)
#define PIECE(i, tk, bk, tv, bv) do { \
    if ((i) < 2) { if (krot[(i) & 1]) GLDS(in.k8r + (size_t)(tk) * (KVBLK * 64) + ksrc[(i) & 1], K_lds + (bk) * SHM_K + kdst[(i) & 1]); \
                   else GLDS(in.k8n + (size_t)(tk) * (KVBLK * 1024) + ksrc[(i) & 1], K_lds + (bk) * SHM_K + kdst[(i) & 1]); } \
    else GLDS((const char*)in.V + (size_t)(tv) * (KVBLK * 2) * in.ldv + voff[(i) & 1], V_lds + (bv) * SHM_V + ((i) & 1) * 8192 + ldsw); } while (0)
#define WAITV(n) asm volatile("s_waitcnt vmcnt(%0)" :: "n"(n) : "memory")
#define WBAR() do { asm volatile("" ::: "memory"); __builtin_amdgcn_s_barrier(); asm volatile("" ::: "memory"); } while (0)
#define RESC() do { if (!st.keep) { int l2_; asm volatile("v_and_b32 %0, 63, %1" : "=v"(l2_) : "v"(threadIdx.x)); const int h2_ = l2_ >> 5; LAS float* al2_ = (LAS float*)(lds + MISC_OFF + 128) + wid * 32; \
    if (h2_ == 0) al2_[l2_] = __builtin_amdgcn_exp2f(st.dm); asm volatile("s_waitcnt lgkmcnt(0)" ::: "memory"); \
    _Pragma("unroll") for (int r = 0; r < 16; ++r) { const float a_ = al2_[crow(r, h2_)]; osum[r] *= a_; _Pragma("unroll") for (int d = 0; d < 4; ++d) o[d][r] *= a_; } asm volatile("s_waitcnt lgkmcnt(0)" ::: "memory"); } } while (0)
#define NXT3(x) ((x) == 2 ? 0 : (x) + 1)
#define PA(k) (*reinterpret_cast<const bf16x8*>(&pw[k]))
#define PKV(f) (bf16x8){f.l[0], f.l[1], f.l[2], f.l[3], f.h[0], f.h[1], f.h[2], f.h[3]}
#define KCAT(lo_, hi_) __builtin_shufflevector(__builtin_bit_cast(v4i_att, lo_), __builtin_bit_cast(v4i_att, hi_), 0, 1, 2, 3, 4, 5, 6, 7)
#define QK8(C_, s_) __builtin_amdgcn_mfma_scale_f32_32x32x64_f8f6f4(KCAT(kl[s_], kh[s_]), qf[s_], C_, 0, 0, 0, 0x7f7f7f7f, 0, 0x7c7c7c7c)
#define BITER(BPAR, PN, PF, Kq, vb, DO_DMA) do { \
    { bf16x8 kl[NKS], kh[NKS]; const int kb0_ = (int)(unsigned)(size_t)(Kq) + kx[0], kb1_ = (int)(unsigned)(size_t)(Kq) + kx[1]; \
      sfor<0, NKS>([&](auto dc) __attribute__((always_inline)) { constexpr int s_ = decltype(dc)::value; k_read<s_ * 4096 + (1 - (BPAR)) * 2048>(kl[s_], kb0_); k_read<s_ * 4096 + (1 - (BPAR)) * 2048>(kh[s_], kb1_); }); \
      sfor<0, NKS>([&](auto gc) __attribute__((always_inline)) { constexpr int g = decltype(gc)::value; \
        asm volatile("s_waitcnt lgkmcnt(4)" : "+v"(kl[g]), "+v"(kh[g])); \
        if constexpr (g == 0) PN = QK8(negm, 0); else PN = QK8(PN, g); \
        if constexpr (DO_DMA) { if constexpr (g == 0) { PIECE(0, tk_, bk_, tv_, bv_); PIECE(1, tk_, bk_, tv_, bv_); } else PIECE(g + 1, tk_, bk_, tv_, bv_); } \
        v_issue<8 * (BPAR) + g>(vf[g], vb); \
        sfor<g * 8 / 3, (g + 1) * 8 / 3>([&](auto ic) __attribute__((always_inline)) { bfin_item<decltype(ic)::value>(PF, pw); }); \
        SBAR(); }); } \
    sfor<0, 10>([&](auto gc) __attribute__((always_inline)) { constexpr int gg = decltype(gc)::value, ksl = gg / 5, d = gg % 5, g = ksl * 4 + d; \
      if constexpr (d < 4) { \
        v_wait<2 * (7 - g < VLA - 1 ? 7 - g : VLA - 1)>(vf[g]); \
        o[d] = __builtin_amdgcn_mfma_f32_32x32x16_bf16(PA(ksl), PKV(vf[g]), o[d], 0, 0, 0); \
        if constexpr (g + VLA < 8) v_issue<8 * (BPAR) + g + VLA>(vf[g + VLA], vb); \
      } else osum = __builtin_amdgcn_mfma_f32_32x32x16_bf16(PA(ksl), ones, osum, 0, 0, 0); \
      if constexpr (gg > 0) sfor<BStart::first(gg - 1, 9), BStart::first(gg, 9)>([&](auto ic) __attribute__((always_inline)) { bstart_item<decltype(ic)::value>(PN, st, negm, thr, hi == 0 ? 1.f : 0.f); }); \
      SBAR(); }); \
    asm volatile("" : "+v"(PN)); \
    RESC(); } while (0)
  f32x16 pA, pB; u32x4 pw[2]; VF vf[8]; const int NT = seq / KVBLK;
#pragma unroll
  for (int t = 0; t < 3; ++t) {
#pragma unroll
    for (int i = 0; i < NI; ++i) PIECE(i, t, t, t, t); }
  WAITV(2 * NI); WBAR();
  { const LAS char* K0 = K_lds; pA = f32x16{};
#pragma unroll
    for (int s = 0; s < NKS; ++s) { const bf16x8 lo = *(const LAS bf16x8*)(K0 + s * 4096 + kx[0]), hh = *(const LAS bf16x8*)(K0 + s * 4096 + kx[1]);
      pA = __builtin_amdgcn_mfma_scale_f32_32x32x64_f8f6f4(KCAT(lo, hh), qf[s], pA, 0, 0, 0, 0x7f7f7f7f, 0, 0x7c7c7c7c); } }
  sfor<0, 8>([&](auto ic) __attribute__((always_inline)) { bstart_item<decltype(ic)::value>(pA, st, negm, thr, hi == 0 ? 1.f : 0.f); });
  { float pmax;
    { auto rr = __builtin_amdgcn_permlane32_swap(__float_as_uint(st.a0), __float_as_uint(st.a0), false, false); pmax = fmaxf(__uint_as_float(rr[0]), __uint_as_float(rr[1])); }
#pragma unroll
    for (int r = 0; r < 16; ++r) { pA[r] -= pmax; negm[r] = -pmax; } }
  sfor<9, BStart::NITEMS>([&](auto ic) __attribute__((always_inline)) { bstart_item<decltype(ic)::value>(pA, st, negm, thr, hi == 0 ? 1.f : 0.f); });
  int kq = 0;
#if PROBE_T == 5
  const unsigned long long t0 = __builtin_amdgcn_s_memtime();
#endif
  for (int t = 0; t + 1 < NT; ++t) {
    const int k1 = NXT3(kq), vq = t & 3;
    const int tk_ = t + 3 < NT ? t + 3 : NT - 1, tv_ = tk_, bk_ = kq, bv_ = (t + 3) & 3;
    BITER(0, pB, pA, K_lds + kq * SHM_K, vb0 + vq * SHM_V, false);
    WAITV(NI); WBAR();
    BITER(1, pA, pB, K_lds + k1 * SHM_K, vb0 + vq * SHM_V, true);
    kq = k1;
  }
#if PROBE_T == 5
  { const unsigned long long t1 = __builtin_amdgcn_s_memtime(); if (probe != nullptr && tid == 0) { probe[0] = 0.f; probe[1] = ((float)(t1 - t0) * (1.f / (NT - 1)) - PROBE_BASE) * 0.05f; } }
#endif
  { const int vq = (NT - 1) & 3; const int tk_ = 0, tv_ = 0, bk_ = 0, bv_ = 0; (void)tk_; (void)tv_; (void)bk_; (void)bv_;
    BITER(0, pB, pA, K_lds + kq * SHM_K, vb0 + vq * SHM_V, false);
    sfor<0, 8>([&](auto ic) __attribute__((always_inline)) { bfin_item<decltype(ic)::value>(pB, pw); });
    const int vb = vb0 + vq * SHM_V;
    sfor<0, VLA>([&](auto gc) __attribute__((always_inline)) { v_issue<8 + decltype(gc)::value>(vf[decltype(gc)::value], vb); });
    sfor<0, 8>([&](auto gc) __attribute__((always_inline)) { constexpr int g = decltype(gc)::value, ksl = g >> 2, d = g & 3;
      v_wait<2 * (7 - g < VLA - 1 ? 7 - g : VLA - 1)>(vf[g]);
      o[d] = __builtin_amdgcn_mfma_f32_32x32x16_bf16(PA(ksl), PKV(vf[g]), o[d], 0, 0, 0);
      if constexpr (g + VLA < 8) v_issue<8 + g + VLA>(vf[g + VLA], vb);
      if constexpr (d == 3) osum = __builtin_amdgcn_mfma_f32_32x32x16_bf16(PA(ksl), ones, osum, 0, 0, 0);
      SBAR(); }); }
#pragma unroll
  for (int r = 0; r < 16; ++r) { const float rl = __builtin_amdgcn_rcpf(osum[r]);
#pragma unroll
    for (int d = 0; d < 4; ++d) o[d][r] *= rl; }
  WAITV(0); asm volatile("s_waitcnt lgkmcnt(0)" ::: "memory"); WBAR();
#undef GLDS
#undef PIECE
#undef WAITV
#undef WBAR
#undef RESC
#undef NXT3
#undef PA
#undef PKV
#undef KCAT
#undef QK8
#undef BITER
}
struct SrcD8 { const unsigned char* q8; const unsigned char* k8; const bf16_t* V; int ldv; };
__device__ __forceinline__ void attn_core_pl8(const SrcD8 in, const float thr, const int seq, LAS char* lds, f32x16 (&o)[4], float* probe = nullptr) {
  constexpr int SHM_K = 8192, NEXS = 32, NEXF = 0, VLA = 3;
  using SS = StartSched<NEXS>; using FS = FinSched<NEXF>;
  int lane; asm volatile("v_and_b32 %0, 63, %1" : "=v"(lane) : "v"(threadIdx.x));
  const int tid = threadIdx.x, wid = __builtin_amdgcn_readfirstlane(tid >> 6), r32 = lane & 31, hi = (lane >> 5) & 1, wq = wid & 3, mp = wid >> 2;
  LAS char* V_lds = lds; LAS char* K_lds = lds + 3 * SHM_V;
  SMS st; st.dm = 0.f; st.keep = true;
  f32x16 negm = f32x16{}, osum = f32x16{};
#pragma unroll
  for (int d = 0; d < 4; ++d) o[d] = f32x16{};
  const bf16x8 ones = {16256, 16256, 16256, 16256, 16256, 16256, 16256, 16256};
  v8i_att qf;
  { const unsigned char* Qw = in.q8 + (size_t)(wq * QBLK + r32) * 1024 + mp * 64 + hi * 32;
    const v4i_att lo = *(const v4i_att*)(Qw), hh = *(const v4i_att*)(Qw + 16); qf = __builtin_shufflevector(lo, hh, 0, 1, 2, 3, 4, 5, 6, 7); }
  const unsigned ksrc = (unsigned)(((wid & 3) * 16 + (lane >> 2)) * 1024 + (wid >> 2) * 64 + (((lane & 3) ^ ((lane >> 4) & 3)) << 4));
  const int kdst = wid * 1024 + lane * 16;
  unsigned voff[2];
#pragma unroll
  for (int i = 0; i < 2; ++i) { const int p = i * 8192 + wid * 1024 + lane * 16, s_ = p >> 9, wq_ = (p & 511) >> 1, kk = (s_ >> 2) * 8 + (wq_ >> 5), cl = wq_ & 31;
    voff[i] = (unsigned)(kk * in.ldv + (s_ & 3) * 32 + cl) * 2u; }
  const int vb0 = (int)(unsigned)(size_t)V_lds + v_rd_base(lane);
  const unsigned ldsw = (unsigned)wid * 1024u;
  const LAS char* Kw = K_lds + mp * 4096;
  int kx[2];
#pragma unroll
  for (int c = 0; c < 2; ++c) kx[c] = r32 * 64 + (((2 * hi + c) ^ ((r32 >> 2) & 3)) << 4);
#define GLDS(gp, lp) __builtin_amdgcn_global_load_lds((const unsigned*)(gp), (LAS unsigned*)(lp), 16, 0, 0)
#define ISSUE_K(t, b) GLDS(in.k8 + (size_t)(t) * (KVBLK * 1024) + ksrc, K_lds + (b) * SHM_K + kdst)
#define ISSUE_V(t, b) do { const char* vb_ = (const char*)in.V + (size_t)(t) * (KVBLK * 2) * in.ldv; GLDS(vb_ + voff[0], V_lds + (b) * SHM_V + ldsw); GLDS(vb_ + voff[1], V_lds + (b) * SHM_V + 8192 + ldsw); } while (0)
#define WAITV(n) asm volatile("s_waitcnt vmcnt(%0)" :: "n"(n) : "memory")
#define WBAR() do { asm volatile("" ::: "memory"); __builtin_amdgcn_s_barrier(); asm volatile("" ::: "memory"); } while (0)
#define RESC() do { if (!st.keep) { int l2_; asm volatile("v_and_b32 %0, 63, %1" : "=v"(l2_) : "v"(threadIdx.x)); const int h2_ = l2_ >> 5; LAS float* al2_ = (LAS float*)(lds + MISC_OFF + 128) + wid * 32; \
    if (h2_ == 0) al2_[l2_] = __builtin_amdgcn_exp2f(st.dm); asm volatile("s_waitcnt lgkmcnt(0)" ::: "memory"); \
    _Pragma("unroll") for (int r = 0; r < 16; ++r) { const float a_ = al2_[crow(r, h2_)]; osum[r] *= a_; _Pragma("unroll") for (int d = 0; d < 4; ++d) o[d][r] *= a_; } asm volatile("s_waitcnt lgkmcnt(0)" ::: "memory"); } } while (0)
#define NXT3(x) ((x) == 2 ? 0 : (x) + 1)
#define PA(ks) (*reinterpret_cast<const bf16x8*>(&pw[ks]))
#define PKV(f) (bf16x8){f.l[0], f.l[1], f.l[2], f.l[3], f.h[0], f.h[1], f.h[2], f.h[3]}
#define KCAT(lo_, hi_) __builtin_shufflevector(__builtin_bit_cast(v4i_att, lo_), __builtin_bit_cast(v4i_att, hi_), 0, 1, 2, 3, 4, 5, 6, 7)
#define PHASE1(PN0, PN1, PF0, PF1, Ks, vb) do { \
    bf16x8 kl0, kh0, kl1, kh1; { const int a0_ = (int)(unsigned)(size_t)(Ks) + kx[0], a1_ = (int)(unsigned)(size_t)(Ks) + kx[1]; \
      k_read<0>(kl0, a0_); k_read<0>(kh0, a1_); k_read<2048>(kl1, a0_); k_read<2048>(kh1, a1_); } \
    asm volatile("s_waitcnt lgkmcnt(2)" : "+v"(kl0), "+v"(kh0)); \
    PN0 = __builtin_amdgcn_mfma_scale_f32_32x32x64_f8f6f4(KCAT(kl0, kh0), qf, negm, 0, 0, 0, 0x7f7f7f7f, 0, 0x7c7c7c7c); \
    ISSUE_K(tk_, bq); GLDS((const char*)in.V + (size_t)tv_ * (KVBLK * 2) * in.ldv + voff[0], V_lds + b2 * SHM_V + ldsw); \
    v_issue<0>(vf[0], vb); \
    sfor<0, 8>([&](auto ic) __attribute__((always_inline)) { fin_item<decltype(ic)::value, NEXF>(PF0, PF1, st, pw); }); \
    SBAR(); \
    asm volatile("s_waitcnt lgkmcnt(2)" : "+v"(kl1), "+v"(kh1)); \
    PN1 = __builtin_amdgcn_mfma_scale_f32_32x32x64_f8f6f4(KCAT(kl1, kh1), qf, negm, 0, 0, 0, 0x7f7f7f7f, 0, 0x7c7c7c7c); \
    GLDS((const char*)in.V + (size_t)tv_ * (KVBLK * 2) * in.ldv + voff[1], V_lds + b2 * SHM_V + 8192 + ldsw); \
    v_issue<1>(vf[1], vb); v_issue<2>(vf[2], vb); \
    sfor<8, 16>([&](auto ic) __attribute__((always_inline)) { fin_item<decltype(ic)::value, NEXF>(PF0, PF1, st, pw); }); \
    SBAR(); } while (0)
#define PHASE2(PS0, PS1, vb) do { \
    sfor<0, 20>([&](auto gc) __attribute__((always_inline)) { constexpr int gg = decltype(gc)::value, ks = gg / 5, d = gg % 5, g = ks * 4 + d; \
      if constexpr (d < 4) { \
        v_wait<2 * (15 - g < VLA - 1 ? 15 - g : VLA - 1)>(vf[g]); \
        o[d] = __builtin_amdgcn_mfma_f32_32x32x16_bf16(PA(ks), PKV(vf[g]), o[d], 0, 0, 0); \
        if constexpr (g + VLA < 16) v_issue<g + VLA>(vf[g + VLA], vb); \
      } else osum = __builtin_amdgcn_mfma_f32_32x32x16_bf16(PA(ks), ones, osum, 0, 0, 0); \
      sfor<SS::first(gg, 20), SS::first(gg + 1, 20)>([&](auto ic) __attribute__((always_inline)) { start_item<decltype(ic)::value, NEXS>(PS0, PS1, st, negm, thr, hi == 0 ? 1.f : 0.f); }); \
      SBAR(); }); \
    asm volatile("" : "+v"(PS0), "+v"(PS1)); \
    RESC(); } while (0)
  f32x16 pA0, pA1, pB0, pB1; u32x4 pw[4]; VF vf[16]; const int NT = seq / KVBLK;
  ISSUE_K(0, 0); ISSUE_K(1, 1); ISSUE_V(0, 0);
  WAITV(3); WBAR();
  ISSUE_K(2, 2); ISSUE_V(1, 1);
  { const bf16x8 l0 = *(const LAS bf16x8*)(Kw + kx[0]), h0 = *(const LAS bf16x8*)(Kw + kx[1]), l1 = *(const LAS bf16x8*)(Kw + 2048 + kx[0]), h1 = *(const LAS bf16x8*)(Kw + 2048 + kx[1]);
    pA0 = __builtin_amdgcn_mfma_scale_f32_32x32x64_f8f6f4(KCAT(l0, h0), qf, f32x16{}, 0, 0, 0, 0x7f7f7f7f, 0, 0x7c7c7c7c);
    pA1 = __builtin_amdgcn_mfma_scale_f32_32x32x64_f8f6f4(KCAT(l1, h1), qf, f32x16{}, 0, 0, 0, 0x7f7f7f7f, 0, 0x7c7c7c7c); }
  sfor<0, 16>([&](auto ic) __attribute__((always_inline)) { start_item<decltype(ic)::value, NEXS>(pA0, pA1, st, negm, thr, hi == 0 ? 1.f : 0.f); });
  { float pmax;
    { auto rr = __builtin_amdgcn_permlane32_swap(__float_as_uint(st.a0), __float_as_uint(st.a0), false, false); pmax = fmaxf(__uint_as_float(rr[0]), __uint_as_float(rr[1])); }
#pragma unroll
    for (int r = 0; r < 16; ++r) { pA0[r] -= pmax; pA1[r] -= pmax; negm[r] = -pmax; } }
  sfor<17, SS::NITEMS>([&](auto ic) __attribute__((always_inline)) { start_item<decltype(ic)::value, NEXS>(pA0, pA1, st, negm, thr, hi == 0 ? 1.f : 0.f); });
  int bq = 0;
#define ITER(j, PN0, PN1, PF0, PF1) do { const int b1 = NXT3(bq), b2 = NXT3(b1); \
    WAITV(3); WBAR(); \
    const int tk_ = (j) + 3 < NT ? (j) + 3 : NT - 1, tv_ = (j) + 2 < NT ? (j) + 2 : NT - 1; \
    PHASE1(PN0, PN1, PF0, PF1, Kw + b1 * SHM_K, vb0 + bq * SHM_V); \
    PHASE2(PN0, PN1, vb0 + bq * SHM_V); \
    bq = b1; } while (0)
#if PROBE_T == 2
  const unsigned long long t0 = __builtin_amdgcn_s_memtime();
#endif
  for (int j = 0; j + 2 < NT; j += 2) { ITER(j, pB0, pB1, pA0, pA1); ITER(j + 1, pA0, pA1, pB0, pB1); }
  ITER(NT - 2, pB0, pB1, pA0, pA1);
#if PROBE_T == 2
  { const unsigned long long t1 = __builtin_amdgcn_s_memtime(); if (probe != nullptr && tid == 0) { probe[0] = 0.f; probe[1] = ((float)(t1 - t0) * (1.f / (NT - 1)) - 1500.f) * 0.05f; } }
#endif
  sfor<0, FS::NITEMS>([&](auto ic) __attribute__((always_inline)) { fin_item<decltype(ic)::value, NEXF>(pB0, pB1, st, pw); });
  WAITV(0); WBAR();
  { const int vb = vb0 + bq * SHM_V;
    sfor<0, VLA>([&](auto gc) __attribute__((always_inline)) { v_issue<decltype(gc)::value>(vf[decltype(gc)::value], vb); });
    sfor<0, 16>([&](auto gc) __attribute__((always_inline)) { constexpr int g = decltype(gc)::value, ks = g >> 2, d = g & 3;
      v_wait<2 * (15 - g < VLA - 1 ? 15 - g : VLA - 1)>(vf[g]);
      o[d] = __builtin_amdgcn_mfma_f32_32x32x16_bf16(PA(ks), PKV(vf[g]), o[d], 0, 0, 0);
      if constexpr (g + VLA < 16) v_issue<g + VLA>(vf[g + VLA], vb);
      if constexpr (d == 3) osum = __builtin_amdgcn_mfma_f32_32x32x16_bf16(PA(ks), ones, osum, 0, 0, 0);
      SBAR(); }); }
#pragma unroll
  for (int r = 0; r < 16; ++r) { const float rl = __builtin_amdgcn_rcpf(osum[r]);
#pragma unroll
    for (int d = 0; d < 4; ++d) o[d][r] *= rl; }
  asm volatile("s_waitcnt lgkmcnt(0)" ::: "memory"); WBAR();
#undef GLDS
#undef ISSUE_K
#undef ISSUE_V
#undef WAITV
#undef WBAR
#undef RESC
#undef NXT3
#undef PA
#undef PKV
#undef KCAT
#undef PHASE1
#undef PHASE2
#undef ITER
}
struct SrcDH { const bf16_t* Q; const bf16_t* K; const unsigned char* q8; const unsigned char* k8; const bf16_t* V; int ldv; };
template <int MP>
__device__ __forceinline__ void attn_core_plh(const SrcDH in, const float thr, const int seq, LAS char* lds, f32x16 (&o)[4], float* probe = nullptr) {
  constexpr int SHM_K = 12288, NKS = 4, NG1 = 8, NEXS = 32, NEXF = 0, VLA = 3;
  using SS = StartSched<NEXS>; using FS = FinSched<NEXF>;
  int lane; asm volatile("v_and_b32 %0, 63, %1" : "=v"(lane) : "v"(threadIdx.x));
  const int tid = threadIdx.x, wid = __builtin_amdgcn_readfirstlane(tid >> 6), r32 = lane & 31, hi = (lane >> 5) & 1, wq = wid & 3; constexpr int mp = MP;
  LAS char* V_lds = lds; LAS char* K_lds = lds + 3 * SHM_V;
  SMS st; st.dm = 0.f; st.keep = true;
  f32x16 negm = f32x16{}, osum = f32x16{};
#pragma unroll
  for (int d = 0; d < 4; ++d) o[d] = f32x16{};
  const bf16x8 ones = {16256, 16256, 16256, 16256, 16256, 16256, 16256, 16256};
  bf16x8 qr[NKS]; v8i_att qf = {};
  if constexpr (mp == 0) { const bf16_t* Qw = in.Q + (size_t)(wq * QBLK + r32) * 1024 + hi * 8;
#pragma unroll
    for (int d0 = 0; d0 < NKS; ++d0) qr[d0] = *(const bf16x8*)(Qw + d0 * 16); }
  else { const unsigned char* Qw = in.q8 + (size_t)(wq * QBLK + r32) * 1024 + 64 + hi * 32;
    const v4i_att lo = *(const v4i_att*)(Qw), hh = *(const v4i_att*)(Qw + 16); qf = __builtin_shufflevector(lo, hh, 0, 1, 2, 3, 4, 5, 6, 7);
#pragma unroll
    for (int d0 = 0; d0 < NKS; ++d0) qr[d0] = bf16x8{}; }
  const int krow = wid * 8 + (lane >> 3), kslot = (lane & 7) ^ ((krow >> 1) & 7);
  const unsigned koff = (unsigned)(krow * 1024 + kslot * 8) * 2u;
  const unsigned ksrc8 = (unsigned)(((wid & 3) * 16 + (lane >> 2)) * 1024 + 64 + (((lane & 3) ^ ((lane >> 4) & 3)) << 4));
  const int kdst8 = 8192 + (wid & 3) * 1024 + lane * 16;
  unsigned voff[2];
#pragma unroll
  for (int i = 0; i < 2; ++i) { const int p = i * 8192 + wid * 1024 + lane * 16, s_ = p >> 9, wq_ = (p & 511) >> 1, kk = (s_ >> 2) * 8 + (wq_ >> 5), cl = wq_ & 31;
    voff[i] = (unsigned)(kk * in.ldv + (s_ & 3) * 32 + cl) * 2u; }
  const int vb0 = (int)(unsigned)(size_t)V_lds + v_rd_base(lane);
  const unsigned ldsw = (unsigned)wid * 1024u;
  int kx[2];
#pragma unroll
  for (int c = 0; c < 2; ++c) kx[c] = 8192 + r32 * 64 + (((2 * hi + c) ^ ((r32 >> 2) & 3)) << 4);
#define GLDS(gp, lp) __builtin_amdgcn_global_load_lds((const unsigned*)(gp), (LAS unsigned*)(lp), 16, 0, 0)
#define ISSUE_K(t, b) do { GLDS((const char*)in.K + (size_t)(t) * (KVBLK * 2) * 1024 + koff, K_lds + (b) * SHM_K + ldsw); GLDS(in.k8 + (size_t)(t) * (KVBLK * 1024) + ksrc8, K_lds + (b) * SHM_K + kdst8); } while (0)
#define ISSUE_V(t, b) do { const char* vb_ = (const char*)in.V + (size_t)(t) * (KVBLK * 2) * in.ldv; GLDS(vb_ + voff[0], V_lds + (b) * SHM_V + ldsw); GLDS(vb_ + voff[1], V_lds + (b) * SHM_V + 8192 + ldsw); } while (0)
#define DMA_PIECE(i) do { if ((i) == 0) GLDS((const char*)in.K + (size_t)tk_ * (KVBLK * 2) * 1024 + koff, K_lds + bq * SHM_K + ldsw); \
    else if ((i) == 1) GLDS(in.k8 + (size_t)tk_ * (KVBLK * 1024) + ksrc8, K_lds + bq * SHM_K + kdst8); \
    else GLDS((const char*)in.V + (size_t)tv_ * (KVBLK * 2) * in.ldv + voff[(i) & 1], V_lds + b2 * SHM_V + ((i) & 1) * 8192 + ldsw); } while (0)
#define WAITV(n) asm volatile("s_waitcnt vmcnt(%0)" :: "n"(n) : "memory")
#define WBAR() do { asm volatile("" ::: "memory"); __builtin_amdgcn_s_barrier(); asm volatile("" ::: "memory"); } while (0)
#define RESC() do { if (!st.keep) { int l2_; asm volatile("v_and_b32 %0, 63, %1" : "=v"(l2_) : "v"(threadIdx.x)); const int h2_ = l2_ >> 5; LAS float* al2_ = (LAS float*)(lds + MISC_OFF + 128) + wid * 32; \
    if (h2_ == 0) al2_[l2_] = __builtin_amdgcn_exp2f(st.dm); asm volatile("s_waitcnt lgkmcnt(0)" ::: "memory"); \
    _Pragma("unroll") for (int r = 0; r < 16; ++r) { const float a_ = al2_[crow(r, h2_)]; osum[r] *= a_; _Pragma("unroll") for (int d = 0; d < 4; ++d) o[d][r] *= a_; } asm volatile("s_waitcnt lgkmcnt(0)" ::: "memory"); } } while (0)
#define NXT3(x) ((x) == 2 ? 0 : (x) + 1)
#define KFRAG(Ks, d, blk) (*(const LAS bf16x8*)((Ks) + KSW((blk) * 32 + r32, ((d) * 16 + hi * 8) * 2)))
#define PA(ks) (*reinterpret_cast<const bf16x8*>(&pw[ks]))
#define PKV(f) (bf16x8){f.l[0], f.l[1], f.l[2], f.l[3], f.h[0], f.h[1], f.h[2], f.h[3]}
#define KCAT(lo_, hi_) __builtin_shufflevector(__builtin_bit_cast(v4i_att, lo_), __builtin_bit_cast(v4i_att, hi_), 0, 1, 2, 3, 4, 5, 6, 7)
#define PHASE1_BF(PN0, PN1, PF0, PF1, Ks, vb) do { \
    bf16x8 kf[NKS][2]; kf[0][0] = KFRAG(Ks, 0, 0); kf[0][1] = KFRAG(Ks, 0, 1); \
    sfor<0, NG1>([&](auto gc) __attribute__((always_inline)) { constexpr int g = decltype(gc)::value, d = g >> 1, blk = g & 1; \
      if constexpr (blk == 0 && d + 1 < NKS) { kf[d + 1][0] = KFRAG(Ks, d + 1, 0); kf[d + 1][1] = KFRAG(Ks, d + 1, 1); } \
      if constexpr (blk == 0) { if constexpr (d == 0) mfma_c(PN0, kf[d][0], qr[d], negm); else PN0 = __builtin_amdgcn_mfma_f32_32x32x16_bf16(kf[d][0], qr[d], PN0, 0, 0, 0); } \
      else              { if constexpr (d == 0) mfma_c(PN1, kf[d][1], qr[d], negm); else PN1 = __builtin_amdgcn_mfma_f32_32x32x16_bf16(kf[d][1], qr[d], PN1, 0, 0, 0); } \
      if constexpr (g < 4) DMA_PIECE(g); \
      if constexpr (g >= NG1 - VLA) v_issue<g - (NG1 - VLA)>(vf[g - (NG1 - VLA)], vb); \
      sfor<FS::first(g, NG1), FS::first(g + 1, NG1)>([&](auto ic) __attribute__((always_inline)) { fin_item<decltype(ic)::value, NEXF>(PF0, PF1, st, pw); }); \
      SBAR(); }); } while (0)
#define PHASE1_F8(PN0, PN1, PF0, PF1, Ks, vb) do { \
    bf16x8 kl0, kh0, kl1, kh1; { const int a0_ = (int)(unsigned)(size_t)(Ks) + kx[0], a1_ = (int)(unsigned)(size_t)(Ks) + kx[1]; \
      k_read<0>(kl0, a0_); k_read<0>(kh0, a1_); k_read<2048>(kl1, a0_); k_read<2048>(kh1, a1_); } \
    asm volatile("s_waitcnt lgkmcnt(2)" : "+v"(kl0), "+v"(kh0)); \
    PN0 = __builtin_amdgcn_mfma_scale_f32_32x32x64_f8f6f4(KCAT(kl0, kh0), qf, negm, 0, 0, 0, 0x7f7f7f7f, 0, 0x7c7c7c7c); \
    DMA_PIECE(0); DMA_PIECE(1); \
    v_issue<0>(vf[0], vb); \
    sfor<0, 8>([&](auto ic) __attribute__((always_inline)) { fin_item<decltype(ic)::value, NEXF>(PF0, PF1, st, pw); }); \
    SBAR(); \
    asm volatile("s_waitcnt lgkmcnt(2)" : "+v"(kl1), "+v"(kh1)); \
    PN1 = __builtin_amdgcn_mfma_scale_f32_32x32x64_f8f6f4(KCAT(kl1, kh1), qf, negm, 0, 0, 0, 0x7f7f7f7f, 0, 0x7c7c7c7c); \
    DMA_PIECE(2); DMA_PIECE(3); \
    v_issue<1>(vf[1], vb); v_issue<2>(vf[2], vb); \
    sfor<8, 16>([&](auto ic) __attribute__((always_inline)) { fin_item<decltype(ic)::value, NEXF>(PF0, PF1, st, pw); }); \
    SBAR(); } while (0)
#define PHASE2(PS0, PS1, vb) do { \
    sfor<0, 20>([&](auto gc) __attribute__((always_inline)) { constexpr int gg = decltype(gc)::value, ks = gg / 5, d = gg % 5, g = ks * 4 + d; \
      if constexpr (d < 4) { \
        v_wait<2 * (15 - g < VLA - 1 ? 15 - g : VLA - 1)>(vf[g]); \
        o[d] = __builtin_amdgcn_mfma_f32_32x32x16_bf16(PA(ks), PKV(vf[g]), o[d], 0, 0, 0); \
        if constexpr (g + VLA < 16) v_issue<g + VLA>(vf[g + VLA], vb); \
      } else osum = __builtin_amdgcn_mfma_f32_32x32x16_bf16(PA(ks), ones, osum, 0, 0, 0); \
      sfor<SS::first(gg, 20), SS::first(gg + 1, 20)>([&](auto ic) __attribute__((always_inline)) { start_item<decltype(ic)::value, NEXS>(PS0, PS1, st, negm, thr, hi == 0 ? 1.f : 0.f); }); \
      SBAR(); }); \
    asm volatile("" : "+v"(PS0), "+v"(PS1)); \
    RESC(); } while (0)
  f32x16 pA0, pA1, pB0, pB1; u32x4 pw[4]; VF vf[16]; const int NT = seq / KVBLK;
  ISSUE_K(0, 0); ISSUE_K(1, 1); ISSUE_V(0, 0);
  WAITV(4); WBAR();
  ISSUE_K(2, 2); ISSUE_V(1, 1);
  if constexpr (mp == 0) { bf16x8 kf[NKS][2];
#pragma unroll
    for (int d = 0; d < NKS; ++d) { kf[d][0] = KFRAG(K_lds, d, 0); kf[d][1] = KFRAG(K_lds, d, 1); }
    pA0 = f32x16{}; pA1 = f32x16{};
#pragma unroll
    for (int d = 0; d < NKS; ++d) { pA0 = __builtin_amdgcn_mfma_f32_32x32x16_bf16(kf[d][0], qr[d], pA0, 0, 0, 0); pA1 = __builtin_amdgcn_mfma_f32_32x32x16_bf16(kf[d][1], qr[d], pA1, 0, 0, 0); } }
  else { const bf16x8 l0 = *(const LAS bf16x8*)(K_lds + kx[0]), h0 = *(const LAS bf16x8*)(K_lds + kx[1]), l1 = *(const LAS bf16x8*)(K_lds + 2048 + kx[0]), h1 = *(const LAS bf16x8*)(K_lds + 2048 + kx[1]);
    pA0 = __builtin_amdgcn_mfma_scale_f32_32x32x64_f8f6f4(KCAT(l0, h0), qf, f32x16{}, 0, 0, 0, 0x7f7f7f7f, 0, 0x7c7c7c7c);
    pA1 = __builtin_amdgcn_mfma_scale_f32_32x32x64_f8f6f4(KCAT(l1, h1), qf, f32x16{}, 0, 0, 0, 0x7f7f7f7f, 0, 0x7c7c7c7c); }
  sfor<0, 16>([&](auto ic) __attribute__((always_inline)) { start_item<decltype(ic)::value, NEXS>(pA0, pA1, st, negm, thr, hi == 0 ? 1.f : 0.f); });
  { float pmax;
    { auto rr = __builtin_amdgcn_permlane32_swap(__float_as_uint(st.a0), __float_as_uint(st.a0), false, false); pmax = fmaxf(__uint_as_float(rr[0]), __uint_as_float(rr[1])); }
#pragma unroll
    for (int r = 0; r < 16; ++r) { pA0[r] -= pmax; pA1[r] -= pmax; negm[r] = -pmax; } }
  sfor<17, SS::NITEMS>([&](auto ic) __attribute__((always_inline)) { start_item<decltype(ic)::value, NEXS>(pA0, pA1, st, negm, thr, hi == 0 ? 1.f : 0.f); });
  int bq = 0;
#define ITER(j, PN0, PN1, PF0, PF1) do { const int b1 = NXT3(bq), b2 = NXT3(b1); \
    WAITV(4); WBAR(); \
    const int tk_ = (j) + 3 < NT ? (j) + 3 : NT - 1, tv_ = (j) + 2 < NT ? (j) + 2 : NT - 1; \
    if constexpr (mp == 0) PHASE1_BF(PN0, PN1, PF0, PF1, K_lds + b1 * SHM_K, vb0 + bq * SHM_V); else PHASE1_F8(PN0, PN1, PF0, PF1, K_lds + b1 * SHM_K, vb0 + bq * SHM_V); \
    PHASE2(PN0, PN1, vb0 + bq * SHM_V); \
    bq = b1; } while (0)
#if PROBE_T == 2
  const unsigned long long t0 = __builtin_amdgcn_s_memtime();
#endif
  for (int j = 0; j + 2 < NT; j += 2) { ITER(j, pB0, pB1, pA0, pA1); ITER(j + 1, pA0, pA1, pB0, pB1); }
  ITER(NT - 2, pB0, pB1, pA0, pA1);
#if PROBE_T == 2
  { const unsigned long long t1 = __builtin_amdgcn_s_memtime(); if (probe != nullptr && tid == 0) { probe[0] = 0.f; probe[1] = ((float)(t1 - t0) * (1.f / (NT - 1)) - 1500.f) * 0.05f; } }
#endif
  sfor<0, FS::NITEMS>([&](auto ic) __attribute__((always_inline)) { fin_item<decltype(ic)::value, NEXF>(pB0, pB1, st, pw); });
  WAITV(0); WBAR();
  { const int vb = vb0 + bq * SHM_V;
    sfor<0, VLA>([&](auto gc) __attribute__((always_inline)) { v_issue<decltype(gc)::value>(vf[decltype(gc)::value], vb); });
    sfor<0, 16>([&](auto gc) __attribute__((always_inline)) { constexpr int g = decltype(gc)::value, ks = g >> 2, d = g & 3;
      v_wait<2 * (15 - g < VLA - 1 ? 15 - g : VLA - 1)>(vf[g]);
      o[d] = __builtin_amdgcn_mfma_f32_32x32x16_bf16(PA(ks), PKV(vf[g]), o[d], 0, 0, 0);
      if constexpr (g + VLA < 16) v_issue<g + VLA>(vf[g + VLA], vb);
      if constexpr (d == 3) osum = __builtin_amdgcn_mfma_f32_32x32x16_bf16(PA(ks), ones, osum, 0, 0, 0);
      SBAR(); }); }
#pragma unroll
  for (int r = 0; r < 16; ++r) { const float rl = __builtin_amdgcn_rcpf(osum[r]);
#pragma unroll
    for (int d = 0; d < 4; ++d) o[d][r] *= rl; }
  asm volatile("s_waitcnt lgkmcnt(0)" ::: "memory"); WBAR();
#undef GLDS
#undef ISSUE_K
#undef ISSUE_V
#undef DMA_PIECE
#undef WAITV
#undef WBAR
#undef RESC
#undef NXT3
#undef KFRAG
#undef PA
#undef PKV
#undef KCAT
#undef PHASE1_BF
#undef PHASE1_F8
#undef PHASE2
#undef ITER
}
struct SrcM8 { const unsigned char* q8; const unsigned char* k8n; const unsigned char* k8r; const unsigned char* vT; };
template <int N> __device__ __forceinline__ void fin8_item(f32x16& P0, f32x16& P1, v8i_att& p8, float& ls0, float& ls1) {
  if constexpr (N < 16) P1[N] = __builtin_amdgcn_exp2f(P1[N]);
  else if constexpr (N < 32) { constexpr int k = N - 16, e = 2 * k; const float a = e < 16 ? P0[e] : P1[e - 16], b = e < 16 ? P0[e + 1] : P1[e - 15];
    if constexpr ((k & 1) == 0) p8[k >> 1] = __builtin_amdgcn_cvt_pk_fp8_f32(a, b, p8[k >> 1], false); else p8[k >> 1] = __builtin_amdgcn_cvt_pk_fp8_f32(a, b, p8[k >> 1], true); }
  else { constexpr int e = N - 32; const float v = e < 16 ? P0[e] : P1[e - 16];
    if constexpr (e & 1) asm("v_add_f32_e32 %0, %1, %0" : "+v"(ls1) : "v"(v)); else asm("v_add_f32_e32 %0, %1, %0" : "+v"(ls0) : "v"(v)); }
}
constexpr int fin8s_first(int g) { return g == 0 ? 0 : g == 1 ? 5 : g == 2 ? 10 : g == 3 ? 15 : g == 4 ? 21 : g == 5 ? 27 : 32; }
constexpr int fin8_first(int g) { return g == 0 ? 0 : g == 1 ? 7 : g == 2 ? 14 : g == 3 ? 26 : g == 4 ? 39 : g == 5 ? 52 : 64; }
__device__ __forceinline__ void attn_core_mla8(const SrcM8 in, const float thr, const int seq, LAS char* lds, f32x16 (&o)[4], float* probe = nullptr) {
  constexpr int SHM_K = 3 * 4096, SHM_V8 = 8192, NKS = 3;
  using SS = StartSched<16>;
  int lane; asm volatile("v_and_b32 %0, 63, %1" : "=v"(lane) : "v"(threadIdx.x));
  const int tid = threadIdx.x, wid = __builtin_amdgcn_readfirstlane(tid >> 6), r32 = lane & 31, hi = (lane >> 5) & 1;
  LAS char* V_lds = lds; LAS char* K_lds = lds + 3 * SHM_V8;
  SMS st; st.dm = 0.f; st.keep = true;
  f32x16 negm = f32x16{}, osum = f32x16{};
  float ls0 = 0.f, ls1 = 0.f; (void)ls0; (void)ls1;
  const v8i_att ones8 = {0x38383838, 0x38383838, 0x38383838, 0x38383838, 0x38383838, 0x38383838, 0x38383838, 0x38383838};
#pragma unroll
  for (int d = 0; d < 4; ++d) o[d] = f32x16{};
  v8i_att qf[NKS];
  { const unsigned char* Qw = in.q8 + (size_t)(wid * QBLK + r32) * 1536 + hi * 32;
#pragma unroll
    for (int s = 0; s < NKS; ++s) { const v4i_att lo = *(const v4i_att*)(Qw + s * 64), hh = *(const v4i_att*)(Qw + s * 64 + 16); qf[s] = __builtin_shufflevector(lo, hh, 0, 1, 2, 3, 4, 5, 6, 7); } }
  unsigned ksrc[2]; int kdst[2]; bool krot[2];
#pragma unroll
  for (int i = 0; i < 2; ++i) { const int p0 = wid * 2 + i, p = p0 < 12 ? p0 : p0 - 4, s = p >> 2, q = p & 3, row = kperm(q * 16 + (lane >> 2)), lc = (lane & 3) ^ ((lane >> 4) & 3);
    krot[i] = (s == 2); ksrc[i] = krot[i] ? (unsigned)(row * 64 + lc * 16) : (unsigned)(row * 1024 + s * 64 + lc * 16); kdst[i] = s * 4096 + q * 1024; }
  const unsigned vsrc = (unsigned)((wid * 16 + (lane >> 2)) * 4096 + (((lane & 3) ^ ((lane >> 4) & 3)) << 4));
  const int vdst = wid * 1024;
  int kx[2];
#pragma unroll
  for (int c = 0; c < 2; ++c) kx[c] = r32 * 64 + (((2 * hi + c) ^ ((r32 >> 2) & 3)) << 4);
#define GLDS(gp, lp) __builtin_amdgcn_global_load_lds((const unsigned*)(gp), (LAS unsigned*)(lp), 16, 0, 0)
#define PIECE_K(i, tk, bk) do { if (krot[i]) GLDS(in.k8r + (size_t)(tk) * (KVBLK * 64) + ksrc[i], K_lds + (bk) * SHM_K + kdst[i]); \
                               else GLDS(in.k8n + (size_t)(tk) * (KVBLK * 1024) + ksrc[i], K_lds + (bk) * SHM_K + kdst[i]); } while (0)
#define PIECE_V(tv, bv) GLDS(in.vT + (size_t)(tv) * KVBLK + vsrc, V_lds + (bv) * SHM_V8 + vdst)
#define WAITV(n) asm volatile("s_waitcnt vmcnt(%0)" :: "n"(n) : "memory")
#define WBAR() do { asm volatile("" ::: "memory"); __builtin_amdgcn_s_barrier(); asm volatile("" ::: "memory"); } while (0)
#define RESC() do { if (!st.keep) { int l2_; asm volatile("v_and_b32 %0, 63, %1" : "=v"(l2_) : "v"(threadIdx.x)); const int h2_ = l2_ >> 5; LAS float* al2_ = (LAS float*)(lds + MISC_OFF + 128) + wid * 32; \
    { const float am_ = __builtin_amdgcn_exp2f(st.dm); if (h2_ == 0) al2_[l2_] = am_; } asm volatile("s_waitcnt lgkmcnt(0)" ::: "memory"); \
    _Pragma("unroll") for (int r = 0; r < 16; ++r) { const float a_ = al2_[crow(r, h2_)]; osum[r] *= a_; _Pragma("unroll") for (int d = 0; d < 4; ++d) o[d][r] *= a_; } asm volatile("s_waitcnt lgkmcnt(0)" ::: "memory"); } } while (0)
#define NXT3(x) ((x) == 2 ? 0 : (x) + 1)
#define KCAT(lo_, hi_) __builtin_shufflevector(__builtin_bit_cast(v4i_att, lo_), __builtin_bit_cast(v4i_att, hi_), 0, 1, 2, 3, 4, 5, 6, 7)
#define MF8(A_, B_, C_, SB_) __builtin_amdgcn_mfma_scale_f32_32x32x64_f8f6f4(A_, B_, C_, 0, 0, 0, (SB_) == 0x7f7f7f7f ? 0 : 0x7f7f7f7f, 0, (SB_) == 0x7f7f7f7f ? 0 : (SB_))
#define PHASE1(PN0, PN1, PF0, PF1, Kq, vb) do { \
    bf16x8 kl[6], kh[6]; const int a0_ = (int)(unsigned)(size_t)(Kq) + kx[0], a1_ = (int)(unsigned)(size_t)(Kq) + kx[1]; \
    k_read<0>(kl[0], a0_); k_read<0>(kh[0], a1_); k_read<4096>(kl[1], a0_); k_read<4096>(kh[1], a1_); \
    sfor<0, 6>([&](auto gc) __attribute__((always_inline)) { constexpr int g = decltype(gc)::value, blk = g / 3, s = g % 3; \
      asm volatile("s_waitcnt lgkmcnt(2)" : "+v"(kl[g]), "+v"(kh[g])); \
      if constexpr (blk == 0) { if constexpr (s == 0) PN0 = MF8(KCAT(kl[g], kh[g]), qf[s], negm, QSCALE8); else PN0 = MF8(KCAT(kl[g], kh[g]), qf[s], PN0, QSCALE8); } \
      else              { if constexpr (s == 0) PN1 = MF8(KCAT(kl[g], kh[g]), qf[s], negm, QSCALE8); else PN1 = MF8(KCAT(kl[g], kh[g]), qf[s], PN1, QSCALE8); } \
      if constexpr (g + 2 < 6) { constexpr int g2 = g + 2; k_read<(g2 % 3) * 4096 + (g2 / 3) * 2048>(kl[g2], a0_); k_read<(g2 % 3) * 4096 + (g2 / 3) * 2048>(kh[g2], a1_); } \
      else { constexpr int d_ = g - 4; k_read<d_ * 2048>(vl[d_], (vb) + kx[0]); k_read<d_ * 2048>(vh[d_], (vb) + kx[1]); } \
      if constexpr (g == 0) PIECE_K(0, tk_, bq); else if constexpr (g == 1) PIECE_K(1, tk_, bq); else if constexpr (g == 2) PIECE_V(tv_, b2); \
      sfor<fin8s_first(g), fin8s_first(g + 1)>([&](auto ic) __attribute__((always_inline)) { fin8_item<decltype(ic)::value>(PF0, PF1, p8, ls0, ls1); }); \
      SBAR(); }); } while (0)
#define PHASE2(PS0, PS1, vb) do { \
    sfor<0, 5>([&](auto gc) __attribute__((always_inline)) { constexpr int d = decltype(gc)::value; \
      if constexpr (d < 4) { \
      if constexpr (d < 3) asm volatile("s_waitcnt lgkmcnt(2)" : "+v"(vl[d]), "+v"(vh[d])); else asm volatile("s_waitcnt lgkmcnt(0)" : "+v"(vl[d]), "+v"(vh[d])); \
      o[d] = MF8(p8, KCAT(vl[d], vh[d]), o[d], 0x7f7f7f7f); \
      if constexpr (d + 2 < 4) { k_read<(d + 2) * 2048>(vl[d + 2], (vb) + kx[0]); k_read<(d + 2) * 2048>(vh[d + 2], (vb) + kx[1]); } \
      } else osum = MF8(p8, ones8, osum, 0x7f7f7f7f); \
      sfor<SS::first(d, 5), SS::first(d + 1, 5)>([&](auto ic) __attribute__((always_inline)) { start_item<decltype(ic)::value, 16>(PS0, PS1, st, negm, thr, hi == 0 ? 1.f : 0.f); }); \
      SBAR(); }); \
    asm volatile("" : "+v"(PS0), "+v"(PS1)); \
    RESC(); } while (0)
  f32x16 pA0, pA1, pB0, pB1; v8i_att p8 = {}; bf16x8 vl[4], vh[4]; const int NT = seq / KVBLK;
  PIECE_K(0, 0, 0); PIECE_K(1, 0, 0); PIECE_K(0, 1, 1); PIECE_K(1, 1, 1); PIECE_V(0, 0);
  WAITV(3); WBAR();
  PIECE_K(0, 2, 2); PIECE_K(1, 2, 2); PIECE_V(1, 1);
  { pA0 = f32x16{}; pA1 = f32x16{};
#pragma unroll
    for (int s = 0; s < NKS; ++s) { const bf16x8 l0 = *(const LAS bf16x8*)(K_lds + s * 4096 + kx[0]), h0 = *(const LAS bf16x8*)(K_lds + s * 4096 + kx[1]), l1 = *(const LAS bf16x8*)(K_lds + s * 4096 + 2048 + kx[0]), h1 = *(const LAS bf16x8*)(K_lds + s * 4096 + 2048 + kx[1]);
      pA0 = MF8(KCAT(l0, h0), qf[s], pA0, QSCALE8); pA1 = MF8(KCAT(l1, h1), qf[s], pA1, QSCALE8); } }
  sfor<0, 16>([&](auto ic) __attribute__((always_inline)) { start_item<decltype(ic)::value, 16>(pA0, pA1, st, negm, thr, hi == 0 ? 1.f : 0.f); });
  { float pmax;
    { auto rr = __builtin_amdgcn_permlane32_swap(__float_as_uint(st.a0), __float_as_uint(st.a0), false, false); pmax = fmaxf(__uint_as_float(rr[0]), __uint_as_float(rr[1])); }
#pragma unroll
    for (int r = 0; r < 16; ++r) { pA0[r] -= pmax; pA1[r] -= pmax; negm[r] = -pmax; } }
  sfor<17, SS::NITEMS>([&](auto ic) __attribute__((always_inline)) { start_item<decltype(ic)::value, 16>(pA0, pA1, st, negm, thr, hi == 0 ? 1.f : 0.f); });
  int bq = 0;
#define ITER(j, PN0, PN1, PF0, PF1) do { const int b1 = NXT3(bq), b2 = NXT3(b1); \
    WAITV(3); WBAR(); \
    const int tk_ = (j) + 3 < NT ? (j) + 3 : NT - 1, tv_ = (j) + 2 < NT ? (j) + 2 : NT - 1; \
    PHASE1(PN0, PN1, PF0, PF1, K_lds + b1 * SHM_K, (int)(unsigned)(size_t)(V_lds + bq * SHM_V8)); \
    PHASE2(PN0, PN1, (int)(unsigned)(size_t)(V_lds + bq * SHM_V8)); \
    bq = b1; } while (0)
#if PROBE_T == 5
  const unsigned long long t0 = __builtin_amdgcn_s_memtime();
#endif
  if (wid >= 4) __builtin_amdgcn_s_setprio(1);
  for (int j = 0; j + 2 < NT; j += 2) { ITER(j, pB0, pB1, pA0, pA1); ITER(j + 1, pA0, pA1, pB0, pB1); }
  ITER(NT - 2, pB0, pB1, pA0, pA1);
  __builtin_amdgcn_s_setprio(0);
#if PROBE_T == 5
  { const unsigned long long t1 = __builtin_amdgcn_s_memtime(); if (probe != nullptr && tid == 0) { probe[0] = 0.f; probe[1] = ((float)(t1 - t0) * (1.f / (NT - 1)) - PROBE_BASE) * 0.05f; } }
#endif
  sfor<0, 32>([&](auto ic) __attribute__((always_inline)) { fin8_item<decltype(ic)::value>(pB0, pB1, p8, ls0, ls1); });
  WAITV(0); WBAR();
  { const int vb = (int)(unsigned)(size_t)(V_lds + bq * SHM_V8);
#pragma unroll
    for (int d = 0; d < 4; ++d) { const bf16x8 l_ = *(const LAS bf16x8*)(V_lds + bq * SHM_V8 + d * 2048 + kx[0]), h_ = *(const LAS bf16x8*)(V_lds + bq * SHM_V8 + d * 2048 + kx[1]);
      o[d] = MF8(p8, KCAT(l_, h_), o[d], 0x7f7f7f7f); } (void)vb; osum = MF8(p8, ones8, osum, 0x7f7f7f7f); }
#pragma unroll
  for (int r = 0; r < 16; ++r) { const float rl = __builtin_amdgcn_rcpf(osum[r]);
#pragma unroll
    for (int d = 0; d < 4; ++d) o[d][r] *= rl; }
  asm volatile("s_waitcnt lgkmcnt(0)" ::: "memory"); WBAR();
#undef GLDS
#undef PIECE_K
#undef PIECE_V
#undef WAITV
#undef WBAR
#undef RESC
#undef NXT3
#undef KCAT
#undef MF8
#undef PHASE1
#undef PHASE2
#undef ITER
}
struct SrcDP { const unsigned char* q8; const unsigned char* k8; const bf16_t* V; const unsigned char* vT; int ldv; const unsigned char* q8l; };
template <int N> __device__ __forceinline__ void finp_item(f32x16& P0, f32x16& P1, v8i_att& p8) {
  constexpr int e = 2 * N; const float a = e < 16 ? P0[e] : P1[e - 16], b = e < 16 ? P0[e + 1] : P1[e - 15];
  if constexpr ((N & 1) == 0) p8[N >> 1] = __builtin_amdgcn_cvt_pk_fp8_f32(a, b, p8[N >> 1], false); else p8[N >> 1] = __builtin_amdgcn_cvt_pk_fp8_f32(a, b, p8[N >> 1], true);
}
template <int MAPI, int MP>
__device__ __forceinline__ void attn_core_plp(const SrcDP in, const float thr_, const int seq, LAS char* lds, f32x16 (&o)[4], float* probe = nullptr) {
  constexpr int SHM_K = 8192, SHM_V8 = 8192, NEXF8 = (MP == 1) ? 8 : 0, NEXS = 32 - NEXF8, NEXF = 0, VLA = 3;
  constexpr bool VB = (DA_PV8 != 2);
  constexpr int NI = VB ? 4 : 2;
  using SS = StartSched<NEXS>; using FS = FinSched<NEXF>;
  const float thr = MP == 1 ? 8.0f : thr_;
  int lane; asm volatile("v_and_b32 %0, 63, %1" : "=v"(lane) : "v"(threadIdx.x));
  const int tid = threadIdx.x, wid = __builtin_amdgcn_readfirstlane(tid >> 6), r32 = lane & 31, hi = (lane >> 5) & 1, wq = wid & 3; constexpr int mp = MAPI;
  LAS char* V_lds = lds; LAS char* K_lds = lds + 3 * SHM_V; LAS char* T_lds = lds + 3 * SHM_V + 3 * SHM_K;
  SMS st; st.dm = 0.f; st.keep = true;
  f32x16 negm = f32x16{}, osum = f32x16{};
#pragma unroll
  for (int d = 0; d < 4; ++d) o[d] = f32x16{};
  const bf16x8 ones = {16256, 16256, 16256, 16256, 16256, 16256, 16256, 16256};
  v8i_att ones8 = {0x38383838, 0x38383838, 0x38383838, 0x38383838, 0x38383838, 0x38383838, 0x38383838, 0x38383838}; asm volatile("" : "+v"(ones8));
  v8i_att qf;
  { const unsigned char* Qw = in.q8 + (size_t)(wq * QBLK + r32) * 1024 + mp * 64 + hi * 32;
    const v4i_att lo = *(const v4i_att*)(Qw), hh = *(const v4i_att*)(Qw + 16); qf = __builtin_shufflevector(lo, hh, 0, 1, 2, 3, 4, 5, 6, 7); }
  constexpr bool QLO = DA_QLO && MAPI == 0;
  v8i_att ql = {};
  if constexpr (QLO) { const unsigned char* Qw = in.q8l + (size_t)(wq * QBLK + r32) * 1024 + mp * 64 + hi * 32;
    const v4i_att lo = *(const v4i_att*)(Qw), hh = *(const v4i_att*)(Qw + 16); ql = __builtin_shufflevector(lo, hh, 0, 1, 2, 3, 4, 5, 6, 7); }
  const unsigned ksrc = (unsigned)(kperm((wid & 3) * 16 + (lane >> 2)) * 1024 + (wid >> 2) * 64 + (((lane & 3) ^ ((lane >> 4) & 3)) << 4));
  const int kdst = wid * 1024;
  const unsigned tsrc = (unsigned)((wid * 16 + (lane >> 2)) * 4096 + (((lane & 3) ^ ((lane >> 4) & 3)) << 4));
  unsigned voff[2];
#pragma unroll
  for (int i = 0; i < 2; ++i) { const int p = i * 8192 + wid * 1024 + lane * 16, s_ = p >> 9, wq_ = (p & 511) >> 1, kk = (s_ >> 2) * 8 + (wq_ >> 5), cl = wq_ & 31;
    voff[i] = (unsigned)(kk * in.ldv + (s_ & 3) * 32 + cl) * 2u; }
  const int vb0 = (int)(unsigned)(size_t)V_lds + v_rd_base(lane);
  const unsigned ldsw = (unsigned)wid * 1024u;
  const LAS char* Kw = K_lds + mp * 4096;
  int kx[2];
#pragma unroll
  for (int c = 0; c < 2; ++c) kx[c] = r32 * 64 + (((2 * hi + c) ^ ((r32 >> 2) & 3)) << 4);
#define GLDS(gp, lp) __builtin_amdgcn_global_load_lds((const unsigned*)(gp), (LAS unsigned*)(lp), 16, 0, 0)
#define ISSUE_K(t, b) GLDS(in.k8 + (size_t)(t) * (KVBLK * 1024) + ksrc, K_lds + (b) * SHM_K + kdst)
#define ISSUE_V0(t, b) GLDS((const char*)in.V + (size_t)(t) * (KVBLK * 2) * in.ldv + voff[0], V_lds + (b) * SHM_V + ldsw)
#define ISSUE_V1(t, b) GLDS((const char*)in.V + (size_t)(t) * (KVBLK * 2) * in.ldv + voff[1], V_lds + (b) * SHM_V + 8192 + ldsw)
#define ISSUE_T(t, b) GLDS(in.vT + (size_t)(t) * KVBLK + tsrc, T_lds + (b) * SHM_V8 + kdst)
#define WAITV(n) asm volatile("s_waitcnt vmcnt(%0)" :: "n"(n) : "memory")
#define WBAR() do { asm volatile("" ::: "memory"); __builtin_amdgcn_s_barrier(); asm volatile("" ::: "memory"); } while (0)
#define RESC() do { if (!st.keep) { int l2_; asm volatile("v_and_b32 %0, 63, %1" : "=v"(l2_) : "v"(threadIdx.x)); const int h2_ = l2_ >> 5; LAS float* al2_ = (LAS float*)(lds + MISC_OFF + 128) + wid * 32; \
    if (h2_ == 0) al2_[l2_] = __builtin_amdgcn_exp2f(st.dm); asm volatile("s_waitcnt lgkmcnt(0)" ::: "memory"); \
    _Pragma("unroll") for (int r = 0; r < 16; ++r) { const float a_ = al2_[crow(r, h2_)]; osum[r] *= a_; _Pragma("unroll") for (int d = 0; d < 4; ++d) o[d][r] *= a_; } asm volatile("s_waitcnt lgkmcnt(0)" ::: "memory"); } } while (0)
#define NXT3(x) ((x) == 2 ? 0 : (x) + 1)
#define PA(ks) (*reinterpret_cast<const bf16x8*>(&pw[ks]))
#define PKV(f) (bf16x8){f.l[0], f.l[1], f.l[2], f.l[3], f.h[0], f.h[1], f.h[2], f.h[3]}
#define KCAT(lo_, hi_) __builtin_shufflevector(__builtin_bit_cast(v4i_att, lo_), __builtin_bit_cast(v4i_att, hi_), 0, 1, 2, 3, 4, 5, 6, 7)
#define MF8(A_, B_, C_, SB_) __builtin_amdgcn_mfma_scale_f32_32x32x64_f8f6f4(A_, B_, C_, 0, 0, 0, (SB_) == 0x7f7f7f7f ? 0 : 0x7f7f7f7f, 0, (SB_) == 0x7f7f7f7f ? 0 : (SB_))
#define PHASE1(PN0, PN1, PF0, PF1, Ks, vb, tb) do { \
    bf16x8 kl0, kh0, kl1, kh1; { const int a0_ = (int)(unsigned)(size_t)(Ks) + kx[0], a1_ = (int)(unsigned)(size_t)(Ks) + kx[1]; \
      k_read<0>(kl0, a0_); k_read<0>(kh0, a1_); k_read<2048>(kl1, a0_); k_read<2048>(kh1, a1_); } \
    asm volatile("s_waitcnt lgkmcnt(2)" : "+v"(kl0), "+v"(kh0)); \
    PN0 = MF8(KCAT(kl0, kh0), qf, negm, QSCALE8); if constexpr (QLO) PN0 = MF8(KCAT(kl0, kh0), ql, PN0, 0x78787878); \
    ISSUE_K(tk_, bq); if constexpr (VB) ISSUE_V0(tv_, b2); \
    if constexpr (MP == 0) { v_issue<0>(vf[0], vb); sfor<0, 8>([&](auto ic) __attribute__((always_inline)) { fin_item<decltype(ic)::value, NEXF>(PF0, PF1, st, pw); }); } \
    else { k_read<0>(vl[0], (tb) + kx[0]); k_read<0>(vh[0], (tb) + kx[1]); sfor<0, NEXF8>([&](auto ic) __attribute__((always_inline)) { constexpr int e_ = 16 - NEXF8 + decltype(ic)::value; PF1[e_] = __builtin_amdgcn_exp2f(PF1[e_]); }); sfor<0, 8>([&](auto ic) __attribute__((always_inline)) { finp_item<decltype(ic)::value>(PF0, PF1, p8); }); } \
    SBAR(); \
    asm volatile("s_waitcnt lgkmcnt(2)" : "+v"(kl1), "+v"(kh1)); \
    PN1 = MF8(KCAT(kl1, kh1), qf, negm, QSCALE8); if constexpr (QLO) PN1 = MF8(KCAT(kl1, kh1), ql, PN1, 0x78787878); \
    if constexpr (VB) ISSUE_V1(tv_, b2); ISSUE_T(tv_, b2); \
    if constexpr (MP == 0) { v_issue<1>(vf[1], vb); v_issue<2>(vf[2], vb); sfor<8, 16>([&](auto ic) __attribute__((always_inline)) { fin_item<decltype(ic)::value, NEXF>(PF0, PF1, st, pw); }); } \
    else { k_read<2048>(vl[1], (tb) + kx[0]); k_read<2048>(vh[1], (tb) + kx[1]); sfor<8, 16>([&](auto ic) __attribute__((always_inline)) { finp_item<decltype(ic)::value>(PF0, PF1, p8); }); } \
    SBAR(); } while (0)
#define PHASE2(PS0, PS1, vb, tb) do { \
    if constexpr (MP == 0) { \
      sfor<0, 20>([&](auto gc) __attribute__((always_inline)) { constexpr int gg = decltype(gc)::value, ks = gg / 5, d = gg % 5, g = ks * 4 + d; \
        if constexpr (d < 4) { \
          v_wait<2 * (15 - g < VLA - 1 ? 15 - g : VLA - 1)>(vf[g]); \
          o[d] = __builtin_amdgcn_mfma_f32_32x32x16_bf16(PA(ks), PKV(vf[g]), o[d], 0, 0, 0); \
          if constexpr (g + VLA < 16) v_issue<g + VLA>(vf[g + VLA], vb); \
        } else osum = __builtin_amdgcn_mfma_f32_32x32x16_bf16(PA(ks), ones, osum, 0, 0, 0); \
        sfor<SS::first(gg, 20), SS::first(gg + 1, 20)>([&](auto ic) __attribute__((always_inline)) { start_item<decltype(ic)::value, NEXS>(PS0, PS1, st, negm, thr, hi == 0 ? 1.f : 0.f); }); \
        SBAR(); }); \
    } else { \
      sfor<0, 5>([&](auto gc) __attribute__((always_inline)) { constexpr int d = decltype(gc)::value; \
        if constexpr (d < 4) { \
          if constexpr (d < 3) asm volatile("s_waitcnt lgkmcnt(2)" : "+v"(vl[d]), "+v"(vh[d])); else asm volatile("s_waitcnt lgkmcnt(0)" : "+v"(vl[d]), "+v"(vh[d])); \
          o[d] = MF8(p8, KCAT(vl[d], vh[d]), o[d], 0x7f7f7f7f); \
          if constexpr (d + 2 < 4) { k_read<(d + 2) * 2048>(vl[d + 2], (tb) + kx[0]); k_read<(d + 2) * 2048>(vh[d + 2], (tb) + kx[1]); } \
        } else osum = MF8(p8, ones8, osum, 0x7f7f7f7f); \
        sfor<SS::first(d, 5), SS::first(d + 1, 5)>([&](auto ic) __attribute__((always_inline)) { start_item<decltype(ic)::value, NEXS>(PS0, PS1, st, negm, thr, hi == 0 ? 1.f : 0.f); }); \
        SBAR(); }); \
    } \
    asm volatile("" : "+v"(PS0), "+v"(PS1)); \
    RESC(); } while (0)
  f32x16 pA0, pA1, pB0, pB1; u32x4 pw[4]; VF vf[16]; v8i_att p8 = {}; bf16x8 vl[4], vh[4]; const int NT = seq / KVBLK;
  ISSUE_K(0, 0); ISSUE_K(1, 1); if constexpr (VB) { ISSUE_V0(0, 0); ISSUE_V1(0, 0); } ISSUE_T(0, 0);
  WAITV(NI); WBAR();
  ISSUE_K(2, 2); if constexpr (VB) { ISSUE_V0(1, 1); ISSUE_V1(1, 1); } ISSUE_T(1, 1);
  { const bf16x8 l0 = *(const LAS bf16x8*)(Kw + kx[0]), h0 = *(const LAS bf16x8*)(Kw + kx[1]), l1 = *(const LAS bf16x8*)(Kw + 2048 + kx[0]), h1 = *(const LAS bf16x8*)(Kw + 2048 + kx[1]);
    pA0 = MF8(KCAT(l0, h0), qf, f32x16{}, QSCALE8); pA1 = MF8(KCAT(l1, h1), qf, f32x16{}, QSCALE8);
    if constexpr (QLO) { pA0 = MF8(KCAT(l0, h0), ql, pA0, 0x78787878); pA1 = MF8(KCAT(l1, h1), ql, pA1, 0x78787878); } }
  sfor<0, 16>([&](auto ic) __attribute__((always_inline)) { start_item<decltype(ic)::value, NEXS>(pA0, pA1, st, negm, thr, hi == 0 ? 1.f : 0.f); });
  { float pmax;
    { auto rr = __builtin_amdgcn_permlane32_swap(__float_as_uint(st.a0), __float_as_uint(st.a0), false, false); pmax = fmaxf(__uint_as_float(rr[0]), __uint_as_float(rr[1])); }
#pragma unroll
    for (int r = 0; r < 16; ++r) { pA0[r] -= pmax; pA1[r] -= pmax; negm[r] = -pmax; } }
  sfor<17, SS::NITEMS>([&](auto ic) __attribute__((always_inline)) { start_item<decltype(ic)::value, NEXS>(pA0, pA1, st, negm, thr, hi == 0 ? 1.f : 0.f); });
  int bq = 0;
#define ITER(j, PN0, PN1, PF0, PF1) do { const int b1 = NXT3(bq), b2 = NXT3(b1); \
    WAITV(NI); WBAR(); \
    const int tk_ = (j) + 3 < NT ? (j) + 3 : NT - 1, tv_ = (j) + 2 < NT ? (j) + 2 : NT - 1; \
    PHASE1(PN0, PN1, PF0, PF1, Kw + b1 * SHM_K, vb0 + bq * SHM_V, (int)(unsigned)(size_t)(T_lds + bq * SHM_V8)); \
    PHASE2(PN0, PN1, vb0 + bq * SHM_V, (int)(unsigned)(size_t)(T_lds + bq * SHM_V8)); \
    bq = b1; } while (0)
#if PROBE_T == 2
  const unsigned long long t0 = __builtin_amdgcn_s_memtime();
#endif
  if (wid >= 4) __builtin_amdgcn_s_setprio(1);
  for (int j = 0; j + 2 < NT; j += 2) { ITER(j, pB0, pB1, pA0, pA1); ITER(j + 1, pA0, pA1, pB0, pB1); }
  ITER(NT - 2, pB0, pB1, pA0, pA1);
  __builtin_amdgcn_s_setprio(0);
#if PROBE_T == 2
  { const unsigned long long t1 = __builtin_amdgcn_s_memtime(); if (probe != nullptr && tid == 0) { probe[0] = 0.f; probe[1] = ((float)(t1 - t0) * (1.f / (NT - 1)) - 1500.f) * 0.05f; } }
#endif
  if constexpr (MP == 0) sfor<0, FS::NITEMS>([&](auto ic) __attribute__((always_inline)) { fin_item<decltype(ic)::value, NEXF>(pB0, pB1, st, pw); });
  else { sfor<0, NEXF8>([&](auto ic) __attribute__((always_inline)) { constexpr int e_ = 16 - NEXF8 + decltype(ic)::value; pB1[e_] = __builtin_amdgcn_exp2f(pB1[e_]); }); sfor<0, 16>([&](auto ic) __attribute__((always_inline)) { finp_item<decltype(ic)::value>(pB0, pB1, p8); }); }
  WAITV(0); WBAR();
  if constexpr (MP == 0) { const int vb = vb0 + bq * SHM_V;
    sfor<0, VLA>([&](auto gc) __attribute__((always_inline)) { v_issue<decltype(gc)::value>(vf[decltype(gc)::value], vb); });
    sfor<0, 16>([&](auto gc) __attribute__((always_inline)) { constexpr int g = decltype(gc)::value, ks = g >> 2, d = g & 3;
      v_wait<2 * (15 - g < VLA - 1 ? 15 - g : VLA - 1)>(vf[g]);
      o[d] = __builtin_amdgcn_mfma_f32_32x32x16_bf16(PA(ks), PKV(vf[g]), o[d], 0, 0, 0);
      if constexpr (g + VLA < 16) v_issue<g + VLA>(vf[g + VLA], vb);
      if constexpr (d == 3) osum = __builtin_amdgcn_mfma_f32_32x32x16_bf16(PA(ks), ones, osum, 0, 0, 0);
      SBAR(); }); }
  else {
#pragma unroll
    for (int d = 0; d < 4; ++d) { const bf16x8 l_ = *(const LAS bf16x8*)(T_lds + bq * SHM_V8 + d * 2048 + kx[0]), h_ = *(const LAS bf16x8*)(T_lds + bq * SHM_V8 + d * 2048 + kx[1]);
      o[d] = MF8(p8, KCAT(l_, h_), o[d], 0x7f7f7f7f); }
    osum = MF8(p8, ones8, osum, 0x7f7f7f7f); }
#pragma unroll
  for (int r = 0; r < 16; ++r) { const float rl = __builtin_amdgcn_rcpf(osum[r]);
#pragma unroll
    for (int d = 0; d < 4; ++d) o[d][r] *= rl; }
  asm volatile("s_waitcnt lgkmcnt(0)" ::: "memory"); WBAR();
#undef GLDS
#undef ISSUE_K
#undef ISSUE_V0
#undef ISSUE_V1
#undef ISSUE_T
#undef WAITV
#undef WBAR
#undef RESC
#undef NXT3
#undef PA
#undef PKV
#undef KCAT
#undef MF8
#undef PHASE1
#undef PHASE2
#undef ITER
}
}

constexpr int NWAVES = 8;
struct Args { const void* in[27]; float* out; unsigned char* ws; int ph_lo, ph_hi, li, pad; };

__constant__ float c_invA[8] = {1.0f, 0.19392274474868576f, 0.03760603093086393f, 0.007292664737217109f, 0.001414213562373095f, 0.0002742481756762073f, 5.318295896944988e-05f, 1.031338537721246e-05f};
__constant__ float c_invM[32] = {1.0f, 0.6636012376960885f, 0.44036660267178046f, 0.2922278225730151f, 0.19392274474868576f, 0.12868737343265052f, 0.08539710028576561f, 0.05666962144529105f,
    0.03760603093086393f, 0.024955408670558694f, 0.016560440080994446f, 0.010989528534539826f, 0.007292664737217109f, 0.004839421345719893f, 0.003211445994752591f, 0.0021311195369119653f,
    0.001414213562373095f, 0.0009384738703573802f, 0.000622772421914596f, 0.0004132725499855165f, 0.0002742481756762073f, 0.00018199142881462546f, 0.00012076973741146504f, 8.01429472224798e-05f,
    5.318295896944988e-05f, 3.529227739646723e-05f, 2.341999896140934e-05f, 1.5541540297632344e-05f, 1.031338537721246e-05f, 6.8439753011549275e-06f, 4.5416704806078695e-06f, 3.013858152139171e-06f};

__device__ __forceinline__ int permDA(int i) { return i < 16 ? (i >> 1) + 8 * (i & 1) : i; }
__device__ __forceinline__ int permM(int i) { return (i >> 1) + 32 * (i & 1); }
__device__ __forceinline__ int src_in(int j) {
    if (j < 2048) return (j & ~63) + permDA(j & 63);
    if (j < 4352) return j;
    if (j < 6400) return 4416 + (j - 4352);
    if (j < 6464) return 4352 + permM(j - 6400);
    return -1;
}
__device__ __forceinline__ int src_uq(int j) { const int hd = j / 192, off = j % 192; return off < 128 ? j : hd * 192 + 128 + permM(off - 128); }

__device__ __forceinline__ void tr_item(const float* W, int K, int N, bf16_t* WT, int n0, int k0, int scol, const float* rs, LAS float* scr, int lane) {
#pragma unroll 8
    for (int i = 0; i < 32; ++i) { const int kk = 2 * i + (lane >> 5); float v = 0.f; if (scol >= 0) { v = W[(size_t)(k0 + kk) * N + scol]; if (rs) v *= rs[k0 + kk]; } scr[kk * 33 + (lane & 31)] = v; }
    LDS_WAIT(); asm volatile("" ::: "memory");
    const int c = lane & 7;
#pragma unroll
    for (int j = 0; j < 4; ++j) { const int n = (lane >> 3) + 8 * j; const LAS float* s = scr + (8 * c) * 33 + n;
        u32x4 o; o.x = cvt_pk_bf16(s[0 * 33], s[1 * 33]); o.y = cvt_pk_bf16(s[2 * 33], s[3 * 33]); o.z = cvt_pk_bf16(s[4 * 33], s[5 * 33]); o.w = cvt_pk_bf16(s[6 * 33], s[7 * 33]);
        *(u32x4*)(WT + (size_t)(n0 + n) * K + k0 + 8 * c) = o; }
    LDS_WAIT(); asm volatile("" ::: "memory");
}

template <int MODE = 0, bool OUT8 = false>
__device__ __forceinline__ void cvt_tile64(const float* W, int N, bf16_t* WT, int Kd, int k0, int n0, int drow0, int lane, const float* rs = nullptr) {
    const int g = lane >> 4, x = lane & 15;
    const float* src = W + (size_t)(k0 + 16 * g) * N + n0 + 4 * x;
    f32x4 v[16];
#pragma unroll
    for (int i = 0; i < 16; ++i) v[i] = __builtin_nontemporal_load((const f32x4*)(src + (size_t)i * N));
    if (rs) {
#pragma unroll
        for (int i = 0; i < 16; ++i) v[i] = v[i] * rs[k0 + 16 * g + i];
    }
    if constexpr (OUT8) {
#pragma unroll
        for (int j = 0; j < 4; ++j) { u32x4 w;
            w.x = cvt_pk_fp8x4(v[0][j] * 64.f, v[1][j] * 64.f, v[2][j] * 64.f, v[3][j] * 64.f); w.y = cvt_pk_fp8x4(v[4][j] * 64.f, v[5][j] * 64.f, v[6][j] * 64.f, v[7][j] * 64.f);
            w.z = cvt_pk_fp8x4(v[8][j] * 64.f, v[9][j] * 64.f, v[10][j] * 64.f, v[11][j] * 64.f); w.w = cvt_pk_fp8x4(v[12][j] * 64.f, v[13][j] * 64.f, v[14][j] * 64.f, v[15][j] * 64.f);
            const int c8 = 4 * x + j;
            const int dr8 = (MODE == 3 || MODE == 4) ? 32 * (c8 >> 4) + 8 * ((c8 >> 2) & 3) + 4 * (MODE - 3) + (c8 & 3) : (MODE == 1 ? 2 * (c8 & 31) + (c8 >> 5) : c8);
            *(u32x4*)((unsigned char*)WT + (size_t)(drow0 + dr8) * Kd + k0 + 16 * g) = w; }
        return; }
#pragma unroll
    for (int j = 0; j < 4; ++j) { u32x4 lo, hi;
        lo.x = cvt_pk_bf16(v[0][j], v[1][j]); lo.y = cvt_pk_bf16(v[2][j], v[3][j]); lo.z = cvt_pk_bf16(v[4][j], v[5][j]); lo.w = cvt_pk_bf16(v[6][j], v[7][j]);
        hi.x = cvt_pk_bf16(v[8][j], v[9][j]); hi.y = cvt_pk_bf16(v[10][j], v[11][j]); hi.z = cvt_pk_bf16(v[12][j], v[13][j]); hi.w = cvt_pk_bf16(v[14][j], v[15][j]);
        const int c = 4 * x + j;
        const int dr = MODE == 1 ? 2 * (c & 31) + (c >> 5) : (MODE == 2 ? (c < 16 ? 2 * (c & 7) + (c >> 3) : c) : c);
        bf16_t* d = WT + (size_t)(drow0 + dr) * Kd + k0 + 16 * g;
        *(u32x4*)d = lo; *(u32x4*)(d + 8) = hi; }
}

__global__ void __launch_bounds__(NWAVES * 64, 2) fwd(Args args) {
#define KARGS() const __attribute__((address_space(4))) unsigned long long* ka_ = (const __attribute__((address_space(4))) unsigned long long*)__builtin_amdgcn_kernarg_segment_ptr(); asm volatile("" : "+s"(ka_))
#define AIN(i) ((const void*)ka_[i])
#define AOUT ((float*)ka_[27])
#define AWS ((unsigned char*)ka_[28])
    extern __shared__ __attribute__((aligned(16))) unsigned char lds_raw[];
    LAS unsigned char* lds = (LAS unsigned char*)lds_raw;
    volatile LAS unsigned* MISC = (volatile LAS unsigned*)(lds + MISC_OFF);
    const int tid = threadIdx.x, wave = __builtin_amdgcn_readfirstlane(tid >> 6);
#define LANE_DECL int lane; asm volatile("v_and_b32 %0, 63, %1" : "=v"(lane) : "v"(threadIdx.x))
    const int G = gridDim.x, bx = blockIdx.x;
    unsigned* ctl = (unsigned*)(args.ws + WS_CTL);
    const int lo = args.ph_lo, hi_ph = args.ph_hi;
    if (tid < 32) MISC[tid] = 0u;
    __syncthreads();
    XcdBarrier bar; bar.bar = ctl + CW_BAR + args.li * XCD_BAR_WORDS; bar.x = 0; bar.st = nullptr;
    if (!MK_PER_PHASE) bar = xcd_barrier_post(ctl + CW_BAR + args.li * XCD_BAR_WORDS, MISC + 8);
#define IN(k) (((PH_MASK >> (k)) & 1) && lo <= (k) && (k) < hi_ph)
#define SEAM(k) do { if (IN(k) && IN((k) + 1)) xcd_barrier(bar); } while (0)
    const int gw = bx * NWAVES + wave, NGW = G * NWAVES;

#define xin ((const float*)AIN(0))
#define positions ((const int*)AIN(1))
#define Bt_in ((bf16_t*)(AWS + WS_BT_IN))
#define Bt_uq ((bf16_t*)(AWS + WS_BT_UQ))
#define Bt_ukv ((bf16_t*)(AWS + WS_BT_UKV))
#define Bt_od ((bf16_t*)(AWS + WS_BT_OD))
#define Bt_om ((bf16_t*)(AWS + WS_BT_OM))
#define Bt_out ((bf16_t*)(AWS + WS_BT_OUT))
#define ropeA ((float*)(AWS + WS_ROPEA))
#define ropeM ((float*)(AWS + WS_ROPEM))
#define sq ((float*)(AWS + WS_SQ2))
#define hbuf ((bf16_t*)(AWS + WS_H))
#define oa ((bf16_t*)(AWS + WS_H))
#define qa ((bf16_t*)(AWS + WS_QA))
#define ka ((bf16_t*)(AWS + WS_KA))
#define va ((bf16_t*)(AWS + WS_VA))
#define cq ((bf16_t*)(AWS + WS_CQ))
#define ckv ((bf16_t*)(AWS + WS_CKV))
#define kr ((bf16_t*)(AWS + WS_KR))
#define gates ((bf16_t*)(AWS + WS_GATES))
#define qm ((bf16_t*)(AWS + WS_QM))
#define kv ((bf16_t*)(AWS + WS_KV))
#define ob ((bf16_t*)(AWS + WS_OB))
#define mrg ((bf16_t*)(AWS + WS_MRG))
#define stash ((float*)(AWS + WS_STASH))
#define rowtok_p ((int*)(AWS + WS_ROWTOK))
#define assign ((u32x2*)(AWS + WS_ASSIGN))
#define Bt_d ((bf16_t*)(AWS + WS_BT_D))
#define Bt_gu ((bf16_t*)(AWS + WS_BT_GU))
#define h2 ((bf16_t*)(AWS + WS_H2))
#define act ((bf16_t*)(AWS + WS_ACT))
#define ybuf ((unsigned char*)(AWS + WS_Y))
#define q8p ((unsigned char*)(AWS + WS_Q8))
#define k8np ((unsigned char*)(AWS + WS_K8N))
#define k8rp ((unsigned char*)(AWS + WS_K8R))
#define v8p ((unsigned char*)(AWS + WS_V8))
#define q8lp ((unsigned char*)(AWS + WS_Q8L))
#define v8ap ((unsigned char*)(AWS + WS_V8A))
#define vt8ap ((unsigned char*)(AWS + WS_VT8A))
#define vt8p ((unsigned char*)(AWS + WS_VT8))
#define q8ap ((unsigned char*)(AWS + WS_Q8A))
#define k8ap ((unsigned char*)(AWS + WS_K8A))
#define x1b ((bf16_t*)(AWS + WS_X1B))
#define count ((unsigned*)(AWS + WS_CTL) + CW_COUNT)

    if (IN(0)) {
        KARGS();
        LANE_DECL;
        const float* w_in = (const float*)AIN(3); const float* g_q = (const float*)AIN(9); const float* g_kv = (const float*)AIN(10);
        const float* w_uq = (const float*)AIN(11); const float* w_ukv = (const float*)AIN(12);
        const float* w_od = (const float*)AIN(13); const float* w_om = (const float*)AIN(14); const float* w_out = (const float*)AIN(16);
        constexpr int I_IN = 16 * 101, I_PAD = 16 * 3, I_UQ = 12 * 24, I_UKV = 8 * 32, I_O = 16 * 16;
        constexpr int NITEMS = I_IN + I_PAD + I_UQ + I_UKV + 3 * I_O;
        for (int it = gw; it < NITEMS; it += NGW) {
            int r = it;
            if (r < I_IN) { const int kb = r / 101, cb = r % 101, n0 = cb * 64;
                if (n0 < 2048) cvt_tile64<2>(w_in, 6464, Bt_in, D, kb * 64, n0, n0, lane);
                else if (n0 < 4352) cvt_tile64<0>(w_in, 6464, Bt_in, D, kb * 64, n0, n0, lane);
                else if (n0 < 4416) cvt_tile64<1>(w_in, 6464, Bt_in, D, kb * 64, n0, 5888, lane);
                else if (n0 < 4416 + 1536) cvt_tile64<0>(w_in, 6464, Bt_in, D, kb * 64, n0, n0 - 64, lane);
                else cvt_tile64<0>(w_in, 6464, Bt_in, D, kb * 64, n0, n0 - 64 + 256, lane);
                continue; } r -= I_IN;
            if (r < I_PAD) { const int kb = r / 3, rb = r % 3; const int g = lane >> 4, x4 = lane & 15;
#pragma unroll
                for (int j = 0; j < 4; ++j) { bf16_t* d = Bt_in + (size_t)(5952 + rb * 64 + 4 * x4 + j) * D + kb * 64 + 16 * g; *(u32x4*)d = (u32x4){0u, 0u, 0u, 0u}; *(u32x4*)(d + 8) = (u32x4){0u, 0u, 0u, 0u}; }
                continue; } r -= I_PAD;
            if (r < I_UQ) { const int kb = r / 24, cb = r % 24, n0 = cb * 64;
                if (UP_F8) { if ((cb % 3) == 2) cvt_tile64<1, true>(w_uq, 1536, Bt_uq, QL, kb * 64, n0, n0, lane, g_q); else cvt_tile64<0, true>(w_uq, 1536, Bt_uq, QL, kb * 64, n0, n0, lane, g_q); }
                else if ((cb % 3) == 2) cvt_tile64<1>(w_uq, 1536, Bt_uq, QL, kb * 64, n0, n0, lane, g_q); else cvt_tile64<0>(w_uq, 1536, Bt_uq, QL, kb * 64, n0, n0, lane, g_q);
                continue; } r -= I_UQ;
            if (r < I_UKV) { const int kb = r / 32, cb = r % 32; if (UP_F8) cvt_tile64<0, true>(w_ukv, 2048, Bt_ukv, KVL, kb * 64, cb * 64, cb * 64, lane, g_kv); else cvt_tile64<0>(w_ukv, 2048, Bt_ukv, KVL, kb * 64, cb * 64, cb * 64, lane, g_kv); continue; } r -= I_UKV;
            const int which = r / I_O; r -= which * I_O; const int kb = r / 16, cb = r % 16;
            cvt_tile64<0>(which == 0 ? w_od : (which == 1 ? w_om : w_out), D, which == 0 ? Bt_od : (which == 1 ? Bt_om : Bt_out), D, kb * 64, cb * 64, cb * 64, lane);
        }
        const float* g_mix = (const float*)AIN(2);
        for (int m = gw * 4; m < T; m += NGW * 4) {
            f32x4 v[4][4]; float ss[4];
#pragma unroll
            for (int q = 0; q < 4; ++q) { const f32x4* xr = (const f32x4*)(xin + (size_t)(m + q) * D) + lane;
#pragma unroll
                for (int j = 0; j < 4; ++j) v[q][j] = xr[64 * j]; }
#pragma unroll
            for (int q = 0; q < 4; ++q) { float s = 0.f;
#pragma unroll
                for (int j = 0; j < 4; ++j) s += (v[q][j][0] * v[q][j][0] + v[q][j][1] * v[q][j][1]) + (v[q][j][2] * v[q][j][2] + v[q][j][3] * v[q][j][3]);
                ss[q] = __builtin_amdgcn_rsqf(wave_sum(s) * (1.f / D) + EPS); }
#pragma unroll
            for (int j = 0; j < 4; ++j) { const f32x4 gg = *((const f32x4*)g_mix + lane + 64 * j);
#pragma unroll
                for (int q = 0; q < 4; ++q) { u32x2 w; w.x = cvt_pk_bf16(v[q][j][0] * ss[q] * gg[0], v[q][j][1] * ss[q] * gg[1]); w.y = cvt_pk_bf16(v[q][j][2] * ss[q] * gg[2], v[q][j][3] * ss[q] * gg[3]);
                    ((u32x2*)(hbuf + (size_t)(m + q) * D) + lane)[64 * j] = w; } }
        }
        for (int idx = bx * 512 + tid; idx < T * 40; idx += G * 512) {
            const int t = idx / 40, i = idx % 40; const float inv = i < 8 ? c_invA[i] : c_invM[i - 8];
            const float ang = (float)positions[t] * inv;
            const double rev = (double)ang * 0.15915494309189535; const float fr_ = (float)(rev - __builtin_rint(rev));
            const float cs = __builtin_amdgcn_cosf(fr_), sn = __builtin_amdgcn_sinf(fr_);
            float* dst = i < 8 ? ropeA + ((size_t)t * 8 + i) * 2 : ropeM + ((size_t)t * 32 + (i - 8)) * 2; dst[0] = cs; dst[1] = sn;
        }
    }
    SEAM(0);
    if (IN(1)) {
        KARGS();
        pg8::Gemm g{hbuf, Bt_in, D}; pg8::DenseOrder S; S.init(T / 256, 24, G, bx);
        pg8::EpiIn E{qa, ka, va, cq, ckv, gates, kr, ropeA, ropeM, (const float*)AIN(15), sq, k8rp, q8ap, k8ap, (VT_FUSED && DA_PV8 == 2) ? vt8ap : v8ap, q8lp};
        pg8::gemm_phase<pg8::EpiIn, pg8::DenseOrder, false, true>(lds, g, S, E);
    }
    SEAM(1);
    if (IN(2)) {
        KARGS();
        { pg8::Gemm g{hbuf, Bt_in, D}; pg8::DenseOrder S; S.init(T / 256, 2, G, bx, 24);
          pg8::EpiIn E{qa, ka, va, cq, ckv, gates, kr, ropeA, ropeM, (const float*)AIN(15), sq, k8rp, q8ap, k8ap, (VT_FUSED && DA_PV8 == 2) ? vt8ap : v8ap, q8lp};
          pg8::gemm_phase<pg8::EpiIn, pg8::DenseOrder, false, true>(lds, g, S, E); }
#if UP_F8
        { pg8::Gemm g{cq, Bt_uq, QL / 2}; pg8::DenseOrder S; S.init(T / 256, 1536 / 128, G, G - 1 - bx); pg8::EpiUp8<true> E{qm, sq, ropeM, q8p};
          pg8::gemm_phase_f8p<pg8::EpiUp8<true>, pg8::DenseOrder>(lds, g, S, E); }
        { pg8::Gemm g{ckv, Bt_ukv, KVL / 2}; pg8::DenseOrder S; S.init(T / 256, 2048 / 128, G, bx); pg8::EpiUp8<false> E{kv, sq, ropeM, k8np, VT_FUSED ? vt8p : v8p};
          pg8::gemm_phase_f8p<pg8::EpiUp8<false>, pg8::DenseOrder>(lds, g, S, E); }
#else
        { pg8::Gemm g{cq, Bt_uq, QL}; pg8::DenseOrder S; S.init(T / 256, 1536 / 256, G, G - 1 - bx); pg8::EpiUp<true> E{qm, sq, ropeM, q8p};
          pg8::gemm_phase<pg8::EpiUp<true>, pg8::DenseOrder, false, true>(lds, g, S, E); }
        { pg8::Gemm g{ckv, Bt_ukv, KVL}; pg8::DenseOrder S; S.init(T / 256, 2048 / 256, G, bx); pg8::EpiUp<false> E{kv, sq, ropeM, k8np};
          pg8::gemm_phase<pg8::EpiUp<false>, pg8::DenseOrder, false, true>(lds, g, S, E); }
#endif
    }
    SEAM(2);
    if (IN(3)) {
        KARGS();
        const int wid = wave;
#if MLA_PV8 && !VT_FUSED
        { LAS unsigned char* tl = (LAS unsigned char*)lds;
          for (int tj = bx; tj < (DA_PV8 ? 2 : 1) * NB * 8 * (SEQ / 64); tj += G) {
              const int ti = tj & 2047; const bool da_ = tj >= 2048; const unsigned char* vsrc_ = da_ ? v8ap : v8p; unsigned char* vdst_ = da_ ? vt8ap : vt8p;
              const int b_ = ti >> 9, h_ = (ti >> 6) & 7, t_ = ti & 63;
              { const int key = tid >> 3, ch = tid & 7;
                *(LAS u32x4*)(tl + key * 128 + ch * 16) = *(const u32x4*)(vsrc_ + ((size_t)b_ * SEQ + t_ * 64 + key) * 1024 + h_ * 128 + ch * 16); }
              __syncthreads();
              { const int dim = tid >> 2, c = tid & 3; unsigned w[4];
#pragma unroll
                for (int q = 0; q < 4; ++q) { unsigned acc_ = 0;
#pragma unroll
                    for (int i = 0; i < 4; ++i) { const int pos = 16 * c + 4 * q + i, kg = pos >> 5, e = pos & 31, key = att::crow(e & 15, kg) + 32 * (e >> 4);
                        acc_ |= (unsigned)tl[key * 128 + dim] << (8 * i); }
                    w[q] = acc_; }
                *(u32x4*)(vdst_ + (((size_t)(b_ * 8 + h_) * 128 + dim) * SEQ + t_ * 64 + 16 * c)) = (u32x4){w[0], w[1], w[2], w[3]}; }
              __syncthreads();
          }
          if (IN(2) || true) xcd_barrier(bar); }
#endif
#define UNIT_DECODE(L) int u = (L) & 511; if (G == 256) { const int c = (L) & 255; u = ((L) & 256) + (c & 7) * 32 + (c >> 3); } \
            const int bh = u >> 4, qb = u & 15, b = bh >> 3, h = bh & 7; const size_t q0 = (size_t)b * SEQ + qb * 256, k0 = (size_t)b * SEQ
        for (int L = bx; L < 1024; L += G) {
#if PROBE_PHASE == 3 && defined(PROBE_ATT)
            if (args.li == 1 && lo == 3 && PROBE_ATT != 0) continue;
#endif
            int u = L; if (G == 256) { const int c = L & 255; u = (L & ~255) + (c & 7) * 32 + (c >> 3); }
            const int bh = u >> 5, qb = u & 31, b = bh >> 3, h = bh & 7; const size_t q0 = (size_t)b * SEQ + qb * 128, k0 = (size_t)b * SEQ;
            f32x16 o[4];
#if DA_PV8
            { att::SrcDP inp{q8ap + q0 * 1024 + h * 128, k8ap + k0 * 1024 + h * 128, va + k0 * 1024 + h * 128, vt8ap + (size_t)(b * 8 + h) * 128 * SEQ, 1024, q8lp + q0 * 1024 + h * 128};
              if (wid < 4) att::attn_core_plp<0, (DA_PV8 == 2)>(inp, 8.f * 1.4426950408889634f, SEQ, (LAS char*)lds, o, (PROBE_T == 2 && L == 0) ? (float*)((unsigned*)(AWS + WS_CTL) + CW_PROBE) : nullptr);
              else att::attn_core_plp<1, 1>(inp, 8.f * 1.4426950408889634f, SEQ, (LAS char*)lds, o, nullptr); }
#elif DA_QK8 == 2
            { att::SrcDH inh{qa + q0 * 1024 + h * 128, ka + k0 * 1024 + h * 128, q8ap + q0 * 1024 + h * 128, k8ap + k0 * 1024 + h * 128, va + k0 * 1024 + h * 128, 1024};
              if (wid < 4) att::attn_core_plh<0>(inh, 8.f * 1.4426950408889634f, SEQ, (LAS char*)lds, o, (PROBE_T == 2 && L == 0) ? (float*)((unsigned*)(AWS + WS_CTL) + CW_PROBE) : nullptr);
              else att::attn_core_plh<1>(inh, 8.f * 1.4426950408889634f, SEQ, (LAS char*)lds, o, nullptr); }
#elif DA_QK8
            { att::SrcD8 in8{q8ap + q0 * 1024 + h * 128, k8ap + k0 * 1024 + h * 128, va + k0 * 1024 + h * 128, 1024};
              att::attn_core_pl8(in8, 8.f * 1.4426950408889634f, SEQ, (LAS char*)lds, o, (PROBE_T == 2 && L == 0) ? (float*)((unsigned*)(AWS + WS_CTL) + CW_PROBE) : nullptr); }
#else
            { att::Src in{qa + q0 * 1024 + h * 128, ka + k0 * 1024 + h * 128, nullptr, va + k0 * 1024 + h * 128, 1024, 1024, 0, 1024};
              att::attn_core_pl<64, 2>(in, 0.125f * 1.4426950408889634f, 8.f * 1.4426950408889634f, SEQ, (LAS char*)lds, o, (PROBE_T && PROBE_T < 4 && L == 0) ? (float*)((unsigned*)(AWS + WS_CTL) + CW_PROBE) : nullptr); }
#endif
            int ln2; asm volatile("v_and_b32 %0, 63, %1" : "=v"(ln2) : "v"(threadIdx.x));
            LAS float* xch = (LAS float*)lds;
            if (wid >= 4) {
#pragma unroll
                for (int d = 0; d < 4; ++d)
#pragma unroll
                    for (int r = 0; r < 16; ++r) xch[((wid - 4) * 64 + d * 16 + r) * 64 + ln2] = o[d][r];
            }
            __syncthreads();
            if (wid < 4) {
            float lam;
            { const float* lq1 = (const float*)AIN(4); const float* lk1 = (const float*)AIN(5); const float* lq2 = (const float*)AIN(6); const float* lk2 = (const float*)AIN(7);
              const float s1 = wave_sum(lq1[ln2] * lk1[ln2]), s2 = wave_sum(lq2[ln2] * lk2[ln2]); lam = __expf(s1) - __expf(s2) + LAM_INIT; }
            float ss[16];
#pragma unroll
            for (int r = 0; r < 16; ++r) ss[r] = 0.f;
#pragma unroll
            for (int d = 0; d < 4; ++d)
#pragma unroll
                for (int r = 0; r < 16; ++r) { const float v = o[d][r] - lam * xch[(wid * 64 + d * 16 + r) * 64 + ln2]; o[d][r] = v; ss[r] += v * v; }
#pragma unroll
            for (int r = 0; r < 16; ++r) {
#pragma unroll
                for (int msk = 1; msk < 32; msk <<= 1) ss[r] += __shfl_xor(ss[r], msk);
                ss[r] = __builtin_amdgcn_rsqf(ss[r] * (1.0f / 128.0f) + EPS); }
            const int hi2 = ln2 >> 5, r32e = ln2 & 31;
            bf16_t* Ow = oa + (q0 + wid * 32 + 4 * hi2) * 1024 + h * 128 + r32e;
            float gs[4];
#pragma unroll
            for (int d = 0; d < 4; ++d) gs[d] = ((const float*)AIN(8))[d * 32 + r32e] * (1.0f - LAM_INIT);
#pragma unroll
            for (int r = 0; r < 16; ++r) { const int orow = att::crow(r, 0);
#pragma unroll
                for (int d = 0; d < 4; ++d) Ow[orow * 1024 + d * 32] = (bf16_t)(cvt_pk_bf16(o[d][r] * ss[r] * gs[d], 0.f) & 0xffffu); }
            }
            __syncthreads();
        }
        for (int L = 512 + bx; L < 1024; L += G) {
#if PROBE_PHASE == 3 && defined(PROBE_ATT)
            if (args.li == 1 && lo == 3 && PROBE_ATT != 1) continue;
#endif
            UNIT_DECODE(L);
            f32x16 o[4];
#if MLA_PV8
            { att::SrcM8 inm{q8p + q0 * 1536 + h * 192, k8np + k0 * 1024 + h * 128, k8rp + k0 * 64, vt8p + (size_t)(b * 8 + h) * 128 * SEQ};
              att::attn_core_mla8(inm, 8.0f, SEQ, (LAS char*)lds, o, (PROBE_T == 5 && L == 512) ? (float*)((unsigned*)(AWS + WS_CTL) + CW_PROBE) : nullptr); }
#elif MLA_QK8
            { att::Src8 in8{q8p + q0 * 1536 + h * 192, k8np + k0 * 1024 + h * 128, k8rp + k0 * 64, kv + k0 * 2048 + h * 256 + 128, 2048};
              att::attn_core_bp8(in8, 8.f * 1.4426950408889634f, SEQ, (LAS char*)lds, o, (PROBE_T == 5 && L == 512) ? (float*)((unsigned*)(AWS + WS_CTL) + CW_PROBE) : nullptr); }
#else
            { att::Src in{qm + q0 * 1536 + h * 192, kv + k0 * 2048 + h * 256, kr + k0 * 64, kv + k0 * 2048 + h * 256 + 128, 1536, 2048, 64, 2048};
              att::attn_core_bp<192, 1>(in, 8.f * 1.4426950408889634f, SEQ, (LAS char*)lds, o, (PROBE_T == 5 && L == 512) ? (float*)((unsigned*)(AWS + WS_CTL) + CW_PROBE) : nullptr); }
#endif
#if PROBE_T == 6
            const unsigned long long te0 = __builtin_amdgcn_s_memtime();
#endif
            int ln2; asm volatile("v_and_b32 %0, 63, %1" : "=v"(ln2) : "v"(threadIdx.x));
            const int hi2 = ln2 >> 5, r32e = ln2 & 31;
            bf16_t* Ow = ob + (q0 + wid * 32 + 4 * hi2) * 1024 + h * 128 + r32e;
#pragma unroll
            for (int r = 0; r < 16; ++r) { const int orow = att::crow(r, 0);
#pragma unroll
                for (int d = 0; d < 4; ++d) Ow[orow * 1024 + d * 32] = (bf16_t)(cvt_pk_bf16(o[d][r], 0.f) & 0xffffu); }
#if PROBE_T == 6
            asm volatile("s_waitcnt vmcnt(0)" ::: "memory");
            { const unsigned long long te1 = __builtin_amdgcn_s_memtime(); if (L == 512 && tid == 0) { float* pr = (float*)((unsigned*)(AWS + WS_CTL) + CW_PROBE); pr[0] = 0.f; pr[1] = (float)(te1 - te0) * 0.002f; } }
#endif
        }
#undef UNIT_DECODE
    }
    SEAM(3);
    if (IN(4)) {
        KARGS();
        { pg8::Gemm g{oa, Bt_od, D}; pg8::DenseOrder S; S.init(T / 256, 4, G, bx); pg8::EpiGate<0> E{mrg, gates};
          pg8::gemm_phase<pg8::EpiGate<0>, pg8::DenseOrder, false, true>(lds, g, S, E); }
        VM_WAIT(); __syncthreads();
        { pg8::Gemm g{ob, Bt_om, D}; pg8::DenseOrder S; S.init(T / 256, 4, G, bx); pg8::EpiGate<1> E{mrg, gates};
          pg8::gemm_phase<pg8::EpiGate<1>, pg8::DenseOrder, false, true>(lds, g, S, E); }
    }
    SEAM(4);
    if (IN(5)) {
        KARGS();
        pg8::Gemm g{mrg, Bt_out, D}; pg8::DenseOrder S; S.init(T / 256, 4, G, bx); pg8::EpiRes E{xin, x1b};
        pg8::gemm_phase<pg8::EpiRes, pg8::DenseOrder, false, true>(lds, g, S, E);
    }
    SEAM(5);
    if (IN(6)) {
        KARGS();
        LANE_DECL;
        const float* g_ffn = (const float*)AIN(17); const float* w_router = (const float*)AIN(18); const float* b_router = (const float*)AIN(19);
        constexpr int WRS = 1028;
        LAS float* wr_l = (LAS float*)lds;
        LAS int* lcount = (LAS int*)(lds + TAB_OFF + 1024); LAS int* gbase = lcount + 32; LAS unsigned* asg_e = (LAS unsigned*)(lcount + 64); LAS float* asg_w = (LAS float*)(lcount + 64 + 256);
        LAS int* sync_w = (LAS int*)(lds + TAB_OFF + 512);
        for (int i = tid; i < D * NEXP; i += 512) wr_l[(i & 31) * WRS + (i >> 5)] = w_router[i];
        if (tid < 32) lcount[tid] = 0;
        if (tid < 2) sync_w[tid] = 0;
        __syncthreads();
        const int ex = (lane >> 1) & 31;
        LAS float* lg = (LAS float*)(lds + TAB_OFF + 4096) + wave * 80;
        const int chunk = bx;
        if (wave < 4 && chunk < T / 64) {
            const float my_b = b_router[ex];
#pragma unroll 1
            for (int j2 = 0; j2 < 8; ++j2) {
                const int tl = wave * 16 + j2 * 2, t = chunk * 64 + tl;
                f32x4 xva[4], xvb[4]; float sa = 0.f, sb = 0.f;
                { const u32x2* xa = (const u32x2*)(x1b + (size_t)t * D) + lane; const u32x2* xb = xa + D / 4;
#pragma unroll
                  for (int j = 0; j < 4; ++j) { const u32x2 wa = xa[64 * j], wb = xb[64 * j]; xva[j] = (f32x4){bf_lo(wa.x), bf_hi(wa.x), bf_lo(wa.y), bf_hi(wa.y)}; xvb[j] = (f32x4){bf_lo(wb.x), bf_hi(wb.x), bf_lo(wb.y), bf_hi(wb.y)}; }
#pragma unroll
                  for (int j = 0; j < 4; ++j) { sa += (xva[j][0] * xva[j][0] + xva[j][1] * xva[j][1]) + (xva[j][2] * xva[j][2] + xva[j][3] * xva[j][3]); sb += (xvb[j][0] * xvb[j][0] + xvb[j][1] * xvb[j][1]) + (xvb[j][2] * xvb[j][2] + xvb[j][3] * xvb[j][3]); } }
                const float ra = __builtin_amdgcn_rsqf(wave_sum(sa) * (1.f / D) + EPS), rb = __builtin_amdgcn_rsqf(wave_sum(sb) * (1.f / D) + EPS);
                { unsigned* oa8 = (unsigned*)((unsigned char*)h2 + (size_t)t * D) + lane; unsigned* ob8 = oa8 + D / 4;
#pragma unroll
                  for (int j = 0; j < 4; ++j) { const f32x4 gg = *((const f32x4*)g_ffn + lane + 64 * j); xva[j] = xva[j] * ra * gg; xvb[j] = xvb[j] * rb * gg;
                    oa8[64 * j] = cvt_pk_fp8x4(xva[j][0], xva[j][1], xva[j][2], xva[j][3]); ob8[64 * j] = cvt_pk_fp8x4(xvb[j][0], xvb[j][1], xvb[j][2], xvb[j][3]); } }
                float aa[32], ab[32];
#pragma unroll
                for (int e = 0; e < NEXP; ++e) { float a = 0.f, b = 0.f;
#pragma unroll
                    for (int j = 0; j < 4; ++j) { const f32x4 w4 = *(const LAS f32x4*)(wr_l + e * WRS + 4 * lane + 256 * j);
                        a += (xva[j][0] * w4[0] + xva[j][1] * w4[1]) + (xva[j][2] * w4[2] + xva[j][3] * w4[3]); b += (xvb[j][0] * w4[0] + xvb[j][1] * w4[1]) + (xvb[j][2] * w4[2] + xvb[j][3] * w4[3]); }
                    aa[e] = a; ab[e] = b; }
#define TRED(arr, n, msk) _Pragma("unroll") for (int i_ = 0; i_ < (n); ++i_) { const bool up_ = (lane & (msk)) != 0; const float keep_ = up_ ? arr[(n) + i_] : arr[i_], give_ = up_ ? arr[i_] : arr[(n) + i_]; arr[i_] = keep_ + __shfl_xor(give_, (msk)); }
                TRED(aa, 16, 32) TRED(aa, 8, 16) TRED(aa, 4, 8) TRED(aa, 2, 4) TRED(aa, 1, 2)
                TRED(ab, 16, 32) TRED(ab, 8, 16) TRED(ab, 4, 8) TRED(ab, 2, 4) TRED(ab, 1, 2)
#undef TRED
                const float la = aa[0] + __shfl_xor(aa[0], 1) + my_b, lb = ab[0] + __shfl_xor(ab[0], 1) + my_b;
#pragma unroll
                for (int tk = 0; tk < 2; ++tk) {
                    const float v = tk ? lb : la; int rank = 0;
                    if (!(lane & 1)) lg[tk * 32 + ex] = v;
                    LDS_WAIT();
#pragma unroll
                    for (int q = 0; q < 8; ++q) { const f32x4 s4 = *(const LAS f32x4*)(lg + tk * 32 + 4 * q);
#pragma unroll
                        for (int jj = 0; jj < 4; ++jj) rank += (s4[jj] > v || (s4[jj] == v && (4 * q + jj) < ex)) ? 1 : 0; }
                    if (rank < 4 && !(lane & 1)) lg[64 + tk * 4 + rank] = v;
                    LDS_WAIT();
                    const f32x4 tv = *(const LAS f32x4*)(lg + 64 + tk * 4);
                    const float p1 = __expf(tv[1] - tv[0]), p2 = __expf(tv[2] - tv[0]), p3 = __expf(tv[3] - tv[0]), inv = 1.0f / (1.0f + p1 + p2 + p3);
                    if (rank < 4 && !(lane & 1)) { const float w = (rank == 0 ? 1.0f : (rank == 1 ? p1 : (rank == 2 ? p2 : p3))) * inv;
                        const int lr = __hip_atomic_fetch_add((LAS int*)&lcount[ex], 1, __ATOMIC_RELAXED, __HIP_MEMORY_SCOPE_WORKGROUP);
                        asg_e[(tl + tk) * 4 + rank] = ((unsigned)ex << 16) | (unsigned)lr; asg_w[(tl + tk) * 4 + rank] = w; }
                }
            }
            LDS_WAIT();
            if (lane == 0) __hip_atomic_fetch_add((LAS int*)&sync_w[0], 1, __ATOMIC_RELAXED, __HIP_MEMORY_SCOPE_WORKGROUP);
            if (wave == 0) {
                while (__hip_atomic_load((LAS int*)&sync_w[0], __ATOMIC_RELAXED, __HIP_MEMORY_SCOPE_WORKGROUP) < 4) __builtin_amdgcn_s_sleep(4);
                asm volatile("s_waitcnt lgkmcnt(0)" ::: "memory");
                if (lane < 32) gbase[lane] = (int)__hip_atomic_fetch_add(count + lane, (unsigned)lcount[lane], __ATOMIC_RELAXED, __HIP_MEMORY_SCOPE_AGENT);
                LDS_WAIT();
#pragma unroll
                for (int q = 0; q < 4; ++q) { const int a_ = q * 64 + lane; const unsigned ae = asg_e[a_]; const int e = ae >> 16, rank = gbase[e] + (int)(ae & 0xffffu); const int t = chunk * 64 + (a_ >> 2);
                    rowtok_p[e * T + rank] = t; u32x2 av; av.x = ((unsigned)e << 16) | (unsigned)rank; av.y = __float_as_uint(asg_w[a_]); assign[(size_t)t * 4 + (a_ & 3)] = av; }
            }
        }
        const float* w_gate = (const float*)AIN(20); const float* w_up = (const float*)AIN(22); const float* w_down = (const float*)AIN(24);
        const int per_wg = (NEXP * 768 + G - 1) / G;
        for (;;) {
            int it = 0; if (lane == 0) it = __hip_atomic_fetch_add((LAS int*)&sync_w[1], 1, __ATOMIC_RELAXED, __HIP_MEMORY_SCOPE_WORKGROUP);
            it = __builtin_amdgcn_readfirstlane(it); const int item = bx * per_wg + it;
            if (it >= per_wg || item >= NEXP * 768) break;
            const int e = item / 768, r = item % 768, mat = r >> 8, kb = (r >> 4) & 15, nb = r & 15, f0 = nb * 64;
            if (mat == 0) cvt_tile64<3, true>(w_gate + (size_t)e * D * FF, FF, (bf16_t*)((unsigned char*)Bt_gu + (size_t)e * 2048 * D), D, kb * 64, f0, 2 * f0, lane);
            else if (mat == 1) cvt_tile64<4, true>(w_up + (size_t)e * D * FF, FF, (bf16_t*)((unsigned char*)Bt_gu + (size_t)e * 2048 * D), D, kb * 64, f0, 2 * f0, lane);
            else cvt_tile64<0, true>(w_down + (size_t)e * FF * D, D, (bf16_t*)((unsigned char*)Bt_d + (size_t)e * D * FF), FF, kb * 64, f0, f0, lane);
        }
    }
    SEAM(6);
    LAS int* t_cnt = (LAS int*)(lds + TAB_OFF + 4096); LAS int* t_start = t_cnt + 32; LAS int* t_t2e = t_start + 40;
    if (IN(7) || IN(8) || IN(9)) {
        KARGS();
        __syncthreads();
        if (tid < 32) t_cnt[tid] = (int)__hip_atomic_load(count + tid, __ATOMIC_RELAXED, __HIP_MEMORY_SCOPE_AGENT);
        __syncthreads();
        if (tid == 0) { int s = 0; for (int e = 0; e < NEXP; ++e) { t_start[e] = s; s += (t_cnt[e] + 255) >> 8; } t_start[32] = s; }
        __syncthreads();
        if (tid < 32) { for (int rt = t_start[tid]; rt < t_start[tid + 1]; ++rt) t_t2e[rt] = tid; }
        __syncthreads();
    }
    if (IN(7)) {
        KARGS();
        pg8::Gemm g{h2, Bt_gu, D / 2}; pg8::MoeOrder S; S.init(__builtin_amdgcn_readfirstlane(t_start[32]), 16, G, bx); S.t2e = t_t2e; S.tstart = t_start; S.cnt = t_cnt; S.rowtok = rowtok_p;
        pg8::EpiSwiglu8 E{(unsigned char*)act, (const float*)AIN(21), (const float*)AIN(23)};
        pg8::gemm_phase_f8p<pg8::EpiSwiglu8, pg8::MoeOrder, true>(lds, g, S, E);
    }
    SEAM(7);
    if (IN(8)) {
        KARGS();
        pg8::Gemm g{act, Bt_d, FF / 2}; pg8::MoeOrder S; S.init(__builtin_amdgcn_readfirstlane(t_start[32]), 8, G, bx); S.t2e = t_t2e; S.tstart = t_start; S.cnt = t_cnt; S.rowtok = rowtok_p;
        pg8::EpiDown8 E{ybuf, (const float*)AIN(25)};
        pg8::gemm_phase_f8p<pg8::EpiDown8, pg8::MoeOrder>(lds, g, S, E);
    }
    SEAM(8);
    if (IN(9) && DBG_OUT) {
        KARGS();
        const bf16_t* src = DBG_OUT == 1 ? gates : DBG_OUT == 2 ? gates + 1024 : DBG_OUT == 3 ? qa : DBG_OUT == 4 ? ka : DBG_OUT == 5 ? va : DBG_OUT == 6 ? mrg : DBG_OUT == 7 ? oa : DBG_OUT == 9 ? Bt_in : ob;
        const int ld = DBG_OUT <= 2 ? 2048 : 1024;
        for (size_t i = (size_t)bx * 512 + tid; i < (size_t)T * 1024; i += (size_t)G * 512) AOUT[i] = (DBG_OUT == 9 && i >= (size_t)N_IN * 1024) ? 0.f : __uint_as_float((unsigned)src[(i >> 10) * ld + (i & 1023)] << 16);
    } else
    if (IN(9)) {
        KARGS();
        LANE_DECL;
        const float* g_fin = (const float*)AIN(26);
        for (int t0 = gw * 2; t0 < T; t0 += NGW * 2) {
            f32x4 v[2][4]; u32x2 as_[2][4];
#pragma unroll
            for (int q = 0; q < 2; ++q) { const u32x2* xr = (const u32x2*)(x1b + (size_t)(t0 + q) * D) + lane;
#pragma unroll
                for (int j = 0; j < 4; ++j) { const u32x2 w = xr[64 * j]; v[q][j] = (f32x4){bf_lo(w.x), bf_hi(w.x), bf_lo(w.y), bf_hi(w.y)}; }
#pragma unroll
                for (int k = 0; k < 4; ++k) as_[q][k] = assign[(size_t)(t0 + q) * 4 + k]; }
            unsigned yw[2][4][4];
#pragma unroll
            for (int q = 0; q < 2; ++q)
#pragma unroll
                for (int k = 0; k < 4; ++k) { const int e = as_[q][k].x >> 16, rank = as_[q][k].x & 0xffffu;
                    const unsigned* yr = (const unsigned*)(ybuf + ((size_t)t_start[e] * 256 + rank) * D) + lane;
#pragma unroll
                    for (int j = 0; j < 4; ++j) yw[q][k][j] = yr[64 * j]; }
#pragma unroll
            for (int q = 0; q < 2; ++q) {
#pragma unroll
                for (int k = 0; k < 4; ++k) { const float w = (DBG_SKIP & 1) ? 0.f : __uint_as_float(as_[q][k].y) * (1.0f / YS);
#pragma unroll
                    for (int j = 0; j < 4; ++j) { const int y = (int)yw[q][k][j]; const auto lo = __builtin_amdgcn_cvt_pk_f32_fp8(y, false), hi = __builtin_amdgcn_cvt_pk_f32_fp8(y, true);
                        v[q][j][0] += w * lo[0]; v[q][j][1] += w * lo[1]; v[q][j][2] += w * hi[0]; v[q][j][3] += w * hi[1]; } }
                float s = 0.f;
#pragma unroll
                for (int j = 0; j < 4; ++j) s += (v[q][j][0] * v[q][j][0] + v[q][j][1] * v[q][j][1]) + (v[q][j][2] * v[q][j][2] + v[q][j][3] * v[q][j][3]);
                const float rstd = __builtin_amdgcn_rsqf(wave_sum(s) * (1.f / D) + EPS);
                f32x4* xo = (f32x4*)(AOUT + (size_t)(t0 + q) * D) + lane;
#pragma unroll
                for (int j = 0; j < 4; ++j) { const f32x4 gg = *((const f32x4*)g_fin + lane + 64 * j); f32x4 ov = v[q][j] * rstd * gg;
#if PROBE_T
                    { const float e1 = __builtin_sqrtf(__uint_as_float(xb_ld((unsigned*)(AWS + WS_CTL) + CW_PROBE))), e2 = __uint_as_float(xb_ld((unsigned*)(AWS + WS_CTL) + CW_PROBE + 1));
                      ov[0] *= 1.f + e1; ov[1] *= 1.f - e1; ov[2] *= 1.f + e1; ov[3] *= 1.f - e1; if (t0 + q == 0 && j == 0 && lane == 0) ov[0] += e2; }
#endif
                    xo[64 * j] = ov; } }
        }
    }
#undef IN
#undef SEAM
#undef KARGS
#undef AIN
#undef AOUT
#undef AWS
#undef xin
#undef positions
#undef Bt_in
#undef Bt_uq
#undef Bt_ukv
#undef Bt_od
#undef Bt_om
#undef Bt_out
#undef ropeA
#undef ropeM
#undef sq
#undef hbuf
#undef oa
#undef qa
#undef ka
#undef va
#undef cq
#undef ckv
#undef kr
#undef gates
#undef qm
#undef kv
#undef ob
#undef mrg
#undef stash
#undef rowtok_p
#undef assign
#undef Bt_d
#undef Bt_gu
#undef h2
#undef act
#undef ybuf
#undef q8p
#undef k8np
#undef k8rp
#undef v8p
#undef q8lp
#undef v8ap
#undef vt8ap
#undef vt8p
#undef q8ap
#undef k8ap
#undef x1b
#undef count
}

extern "C" void kernel_launch(void* const* d_in, const int* in_sizes, int n_in, void* d_out, int out_size, void* d_ws, size_t ws_size, hipStream_t stream) {
    static int grid = 0;
    if (grid == 0) {
        if (n_in != 27 || in_sizes[0] != T * D || out_size != T * D || ws_size < WS_END) { fprintf(stderr, "kernel_launch: unexpected shapes (n_in %d, in0 %d, out %d, ws %zu < %zu)\n", n_in, n_in > 0 ? in_sizes[0] : -1, out_size, ws_size, (size_t)WS_END); grid = -1; return; }
        int dev = 0, cus = 0, per_cu = 0;
        if (hipGetDevice(&dev) != hipSuccess || hipDeviceGetAttribute(&cus, hipDeviceAttributeMultiprocessorCount, dev) != hipSuccess) { grid = -1; return; }
        if (hipFuncSetAttribute((const void*)fwd, hipFuncAttributeMaxDynamicSharedMemorySize, LDS_BYTES) != hipSuccess) { fprintf(stderr, "kernel_launch: hipFuncSetAttribute failed\n"); grid = -1; return; }
        if (hipOccupancyMaxActiveBlocksPerMultiprocessor(&per_cu, (const void*)fwd, NWAVES * 64, LDS_BYTES) != hipSuccess || per_cu < 1) fprintf(stderr, "kernel_launch: occupancy query says %d\n", per_cu);
        (void)hipGetLastError();
        grid = cus;
    }
    if (grid < 0) return;
    if (hipMemsetAsync((char*)d_ws + WS_CTL, 0, CTL_ZERO_BYTES, stream) != hipSuccess) return;
    Args a{};
    for (int i = 0; i < 27; ++i) a.in[i] = d_in[i];
    a.out = (float*)d_out; a.ws = (unsigned char*)d_ws;
#if MK_PER_PHASE
    for (int p = 0; p < NPHASE; ++p) { a.ph_lo = p; a.ph_hi = p + 1; hipLaunchKernelGGL(fwd, dim3(grid), dim3(NWAVES * 64), LDS_BYTES, stream, a); }
#elif PROBE_PHASE >= 0
    a.ph_lo = 0; a.ph_hi = PROBE_PHASE + 1; a.li = 0; hipLaunchKernelGGL(fwd, dim3(grid), dim3(NWAVES * 64), LDS_BYTES, stream, a);
    a.ph_lo = PROBE_PHASE; a.ph_hi = NPHASE; a.li = 1; hipLaunchKernelGGL(fwd, dim3(grid), dim3(NWAVES * 64), LDS_BYTES, stream, a);
#else
    a.ph_lo = 0; a.ph_hi = NPHASE; hipLaunchKernelGGL(fwd, dim3(grid), dim3(NWAVES * 64), LDS_BYTES, stream, a);
#endif
}
```
